# Optimizing an MI355X kernel written in HIP

```python
import jax, jax.numpy as jnp
from jax import lax
import numpy as np

D_MODEL = 1024
BATCH = 4
SEQ = 4096
DEPTH = 2

GRID_W = 64
CTX_LEN = 256
D_MIX = D_MODEL
POOL_WINDOWS = (2, 4, 8, 16)
POOL_GROUPS = len(POOL_WINDOWS)
POOL_WIDTH = D_MIX // 4
POOL_GC = POOL_WIDTH // POOL_GROUPS
HEAD_DIM = 64
N_HEADS = (D_MIX // 2) // HEAD_DIM
N_KV_HEADS = 2
GQA_GROUP = N_HEADS // N_KV_HEADS
ATTN_WIDTH = N_HEADS * HEAD_DIM
KV_WIDTH = N_KV_HEADS * HEAD_DIM
WINDOW = 128
BLOCK = 128
ROPE_BASE = 10000.0
FOUR_WIDTH = D_MIX - POOL_WIDTH - ATTN_WIDTH
FOUR_GROUPS = 4
FOUR_GC = FOUR_WIDTH // FOUR_GROUPS
POOL_OFF = 0
Q_OFF = POOL_OFF + POOL_WIDTH
K_OFF = Q_OFF + ATTN_WIDTH
V_OFF = K_OFF + KV_WIDTH
FOUR_OFF = V_OFF + KV_WIDTH
IN_WIDTH = FOUR_OFF + FOUR_WIDTH
N_EXPERT_GROUPS = 4
EXPERTS_PER_GROUP = 4
N_EXPERTS = N_EXPERT_GROUPS * EXPERTS_PER_GROUP
TOP_K_IN_GROUP = 2
D_EXPERT = D_MODEL // 2
EPS = 1e-6
NEG_INF = -1e30

kernel_name = "hybrid_pool_swa_fourier_hmoe_dit"


def rms_norm(x, g):
    xf = x.astype(jnp.float32)
    y = xf * lax.rsqrt(jnp.mean(xf * xf, axis=-1, keepdims=True) + EPS)
    return (y * g.astype(jnp.float32)).astype(x.dtype)


def axial_rope_tables(n_tokens, dtype):
    rows = n_tokens // GRID_W
    r = jnp.broadcast_to(jnp.arange(rows)[:, None], (rows, GRID_W)).reshape(-1).astype(jnp.float32)
    col = jnp.broadcast_to(jnp.arange(GRID_W)[None, :], (rows, GRID_W)).reshape(-1).astype(jnp.float32)
    half = HEAD_DIM // 2
    inv = 1.0 / (ROPE_BASE ** (jnp.arange(0, half, 2, dtype=jnp.float32) / half))
    ar = r[:, None] * inv
    ac = col[:, None] * inv
    ang = jnp.concatenate([ar, ar, ac, ac], axis=-1)
    return jnp.cos(ang).astype(dtype), jnp.sin(ang).astype(dtype)


def apply_axial_rope(x, cos, sin):
    a, b, c, d = jnp.split(x, 4, axis=-1)
    rot = jnp.concatenate([-b, a, -d, c], axis=-1)
    return x * cos[None, :, None, :] + rot * sin[None, :, None, :]


def pool_mixer(u, w, scale):
    B, N, _ = u.shape
    uf = u.astype(jnp.float32).reshape(B, N, POOL_GROUPS, POOL_GC)
    cs = jnp.concatenate([jnp.zeros_like(uf[:, :1]), jnp.cumsum(uf, axis=1)], axis=1)
    t = jnp.arange(N)
    outs = []
    for g, win in enumerate(POOL_WINDOWS):
        lo = jnp.clip(t - win // 2, 0, N - 1)
        hi = jnp.clip(t + win // 2 - 1, 0, N - 1)
        cnt = (hi - lo + 1).astype(jnp.float32)
        s = cs[:, hi + 1, g] - cs[:, lo, g]
        outs.append(s / cnt[None, :, None] - uf[:, :, g])
    y = jnp.stack(outs, axis=2).astype(u.dtype)
    y = jnp.einsum('bngc,gcd->bngd', y, w).reshape(B, N, POOL_WIDTH)
    return y * scale


def fourier_mixer(u, w):
    B, N, _ = u.shape
    uf = u.astype(jnp.float32).reshape(B, N, FOUR_GROUPS, FOUR_GC)
    y = jnp.fft.fftn(uf, axes=(1, 3), norm="ortho").real.astype(u.dtype)
    return jnp.einsum('bngc,gcd->bngd', y, w).reshape(B, N, FOUR_WIDTH)


def split_qkv(p, q_g, k_g):
    B, N, _ = p.shape
    q = rms_norm(p[..., Q_OFF:K_OFF].reshape(B, N, N_HEADS, HEAD_DIM), q_g)
    k = rms_norm(p[..., K_OFF:V_OFF].reshape(B, N, N_KV_HEADS, HEAD_DIM), k_g)
    v = p[..., V_OFF:FOUR_OFF].reshape(B, N, N_KV_HEADS, HEAD_DIM)
    return q, k, v


def latent_window_attention(q, k, v, kc, vc, sink):
    B, N = q.shape[:2]
    L = kc.shape[1]
    nb = N // BLOCK
    scale = HEAD_DIM ** -0.5
    qb = q.reshape(B, nb, BLOCK, N_KV_HEADS, GQA_GROUP, HEAD_DIM)

    def band(t):
        tp = jnp.pad(t, ((0, 0), (BLOCK, BLOCK), (0, 0), (0, 0))).reshape(B, nb + 2, BLOCK, N_KV_HEADS, HEAD_DIM)
        return jnp.concatenate([tp[:, :-2], tp[:, 1:-1], tp[:, 2:]], axis=2)

    kw, vw = band(k), band(v)
    s_loc = jnp.einsum('bnqhgd,bnkhd->bnhgqk', qb, kw).astype(jnp.float32) * scale
    qpos = jnp.arange(nb)[:, None, None] * BLOCK + jnp.arange(BLOCK)[None, :, None]
    kpos = (jnp.arange(nb)[:, None, None] - 1) * BLOCK + jnp.arange(3 * BLOCK)[None, None, :]
    valid = (jnp.abs(qpos - kpos) <= WINDOW) & (kpos >= 0) & (kpos < N)
    s_loc = jnp.where(valid[None, :, None, None], s_loc, NEG_INF)
    s_ctx = jnp.einsum('bnqhgd,blhd->bnhgql', qb, kc).astype(jnp.float32) * scale
    s_sink = jnp.broadcast_to(sink.astype(jnp.float32).reshape(1, 1, N_KV_HEADS, GQA_GROUP, 1, 1),
                              s_loc.shape[:-1] + (1,))
    p = jax.nn.softmax(jnp.concatenate([s_loc, s_ctx, s_sink], axis=-1), axis=-1).astype(v.dtype)
    o = (jnp.einsum('bnhgqk,bnkhd->bnqhgd', p[..., :3 * BLOCK], vw)
         + jnp.einsum('bnhgql,blhd->bnqhgd', p[..., 3 * BLOCK:3 * BLOCK + L], vc))
    return o.reshape(B, N, ATTN_WIDTH)


def context_attention(qc, kc, vc, sink):
    B, L = qc.shape[:2]
    scale = HEAD_DIM ** -0.5
    qg = qc.reshape(B, L, N_KV_HEADS, GQA_GROUP, HEAD_DIM)
    s = jnp.einsum('blhgd,bmhd->bhglm', qg, kc).astype(jnp.float32) * scale
    s_sink = jnp.broadcast_to(sink.astype(jnp.float32).reshape(1, N_KV_HEADS, GQA_GROUP, 1, 1), s.shape[:-1] + (1,))
    p = jax.nn.softmax(jnp.concatenate([s, s_sink], axis=-1), axis=-1)[..., :L].astype(vc.dtype)
    return jnp.einsum('bhglm,bmhd->blhgd', p, vc).reshape(B, L, ATTN_WIDTH)


def merge_heads(p, attn_out, pool_w, pool_scale, four_w, w_out):
    pool_out = pool_mixer(p[..., POOL_OFF:Q_OFF], pool_w, pool_scale)
    four_out = fourier_mixer(p[..., FOUR_OFF:IN_WIDTH], four_w)
    return jnp.concatenate([pool_out, attn_out, four_out], axis=-1) @ w_out


def hier_moe(h, w_grp, b_grp, w_rtr, b_rtr, w_gate, w_up, w_down):
    T = h.shape[0]
    p_grp = jax.nn.softmax((h @ w_grp + b_grp).astype(jnp.float32), axis=-1)
    pg, g = lax.top_k(p_grp, 1)
    logits_e = (h @ w_rtr + b_rtr).astype(jnp.float32).reshape(T, N_EXPERT_GROUPS, EXPERTS_PER_GROUP)
    logits_sel = jnp.einsum('tge,tg->te', logits_e, jax.nn.one_hot(g[:, 0], N_EXPERT_GROUPS, dtype=jnp.float32))
    pe, ie = lax.top_k(jax.nn.softmax(logits_sel, axis=-1), TOP_K_IN_GROUP)
    wts = pg * pe / jnp.sum(pe, axis=-1, keepdims=True)
    eid = g * EXPERTS_PER_GROUP + ie
    gates = jnp.sum(jax.nn.one_hot(eid, N_EXPERTS, dtype=jnp.float32) * wts[..., None], axis=1).astype(h.dtype)
    y = jnp.zeros_like(h)
    for e in range(N_EXPERTS):
        a = jax.nn.silu(h @ w_gate[e]) * (h @ w_up[e])
        y = y + gates[:, e:e + 1] * (a @ w_down[e])
    return y


def setup_inputs(seed: int = 0) -> dict:
    key = jax.random.key(seed)
    ks = jax.random.split(key, 24)
    f32 = jnp.float32
    D = D_MODEL
    nrm = lambda k, shape, s: jax.random.normal(k, shape, f32) * s
    return {
        "x": nrm(ks[0], (BATCH, SEQ, D), 1.0),
        "c": nrm(ks[1], (BATCH, D), 1.0),
        "ctx": nrm(ks[2], (BATCH, CTX_LEN, D), 1.0),
        "c_ctx": nrm(ks[3], (D,), 1.0),
        "w_mod": nrm(ks[4], (DEPTH, D, 6 * D), 0.5 * D ** -0.5),
        "b_mod": nrm(ks[5], (DEPTH, 6 * D), 0.02),
        "norm1_g": 1.0 + nrm(ks[6], (DEPTH, D), 0.05),
        "w_in": nrm(ks[7], (DEPTH, D, IN_WIDTH), D ** -0.5),
        "q_norm_g": 1.0 + nrm(ks[8], (DEPTH, HEAD_DIM), 0.05),
        "k_norm_g": 1.0 + nrm(ks[9], (DEPTH, HEAD_DIM), 0.05),
        "attn_sink": nrm(ks[10], (DEPTH, N_HEADS), 0.5),
        "pool_w": nrm(ks[11], (DEPTH, POOL_GROUPS, POOL_GC, POOL_GC), POOL_GC ** -0.5),
        "pool_scale": 1.0 + nrm(ks[12], (DEPTH, POOL_WIDTH), 0.05),
        "four_w": nrm(ks[13], (DEPTH, FOUR_GROUPS, FOUR_GC, FOUR_GC), FOUR_GC ** -0.5),
        "w_out": nrm(ks[14], (DEPTH, D_MIX, D), D_MIX ** -0.5),
        "norm2_g": 1.0 + nrm(ks[15], (DEPTH, D), 0.05),
        "w_grp": nrm(ks[16], (DEPTH, D, N_EXPERT_GROUPS), D ** -0.5),
        "b_grp": nrm(ks[17], (DEPTH, N_EXPERT_GROUPS), 0.01),
        "w_rtr": nrm(ks[18], (DEPTH, D, N_EXPERTS), D ** -0.5),
        "b_rtr": nrm(ks[19], (DEPTH, N_EXPERTS), 0.01),
        "w_gate": nrm(ks[20], (DEPTH, N_EXPERTS, D, D_EXPERT), D ** -0.5),
        "w_up": nrm(ks[21], (DEPTH, N_EXPERTS, D, D_EXPERT), D ** -0.5),
        "w_down": nrm(ks[22], (DEPTH, N_EXPERTS, D_EXPERT, D), D_EXPERT ** -0.5),
    }


def reference(x, c, ctx, c_ctx, w_mod, b_mod, norm1_g, w_in, q_norm_g, k_norm_g, attn_sink,
              pool_w, pool_scale, four_w, w_out, norm2_g, w_grp, b_grp, w_rtr, b_rtr,
              w_gate, w_up, w_down):
    B, N, D = x.shape
    L = ctx.shape[1]
    cos, sin = axial_rope_tables(N, x.dtype)
    s_lat = jax.nn.silu(c)
    s_ctx = jax.nn.silu(c_ctx)
    xc = ctx
    for l in range(DEPTH):
        last = l == DEPTH - 1
        mod = s_lat @ w_mod[l] + b_mod[l]
        sh1, sc1, g1, sh2, sc2, g2 = jnp.split(mod[:, None, :], 6, axis=-1)
        modc = s_ctx @ w_mod[l] + b_mod[l]
        ch1, cs1, cg1, ch2, cs2, cg2 = jnp.split(modc, 6)

        hc = rms_norm(xc, norm1_g[l]) * (1.0 + cs1) + ch1
        if last:
            pkv = hc @ w_in[l][:, K_OFF:FOUR_OFF]
            kc = rms_norm(pkv[..., :KV_WIDTH].reshape(B, L, N_KV_HEADS, HEAD_DIM), k_norm_g[l])
            vc = pkv[..., KV_WIDTH:].reshape(B, L, N_KV_HEADS, HEAD_DIM)
        else:
            pc = hc @ w_in[l]
            qc, kc, vc = split_qkv(pc, q_norm_g[l], k_norm_g[l])
            yc = merge_heads(pc, context_attention(qc, kc, vc, attn_sink[l]),
                             pool_w[l], pool_scale[l], four_w[l], w_out[l])
            xc = xc + cg1 * yc

        h = rms_norm(x, norm1_g[l]) * (1.0 + sc1) + sh1
        p = h @ w_in[l]
        q, k, v = split_qkv(p, q_norm_g[l], k_norm_g[l])
        q = apply_axial_rope(q, cos, sin)
        k = apply_axial_rope(k, cos, sin)
        y = merge_heads(p, latent_window_attention(q, k, v, kc, vc, attn_sink[l]),
                        pool_w[l], pool_scale[l], four_w[l], w_out[l])
        x = x + g1 * y

        h2 = (rms_norm(x, norm2_g[l]) * (1.0 + sc2) + sh2).reshape(B * N, D)
        moe_args = (w_grp[l], b_grp[l], w_rtr[l], b_rtr[l], w_gate[l], w_up[l], w_down[l])
        if last:
            x = x + g2 * hier_moe(h2, *moe_args).reshape(B, N, D)
        else:
            h2c = (rms_norm(xc, norm2_g[l]) * (1.0 + cs2) + ch2).reshape(B * L, D)
            out = hier_moe(jnp.concatenate([h2, h2c], axis=0), *moe_args)
            x = x + g2 * out[:B * N].reshape(B, N, D)
            xc = xc + cg2 * out[B * N:].reshape(B, L, D)
    return x
```

```cpp
#include <hip/hip_runtime.h>
#include <cstdio>
#include <cstdint>

#define DBG_NO_FOUR 0
#define DBG_NO_POOL 0
#define DBG_NO_ATT 0
#define DBG_NO_MOE 0
#define DBG_MOE_SCALE 1.0f
#define DBG_NAIVE_MOE 0
#define DBG_NAIVE_ROUTE 0
#define LAS __attribute__((address_space(3)))
#define GAS __attribute__((address_space(1)))
typedef unsigned short bf16;
typedef short bf16x8 __attribute__((ext_vector_type(8)));
typedef float f32x4 __attribute__((ext_vector_type(4)));
typedef float f32x16 __attribute__((ext_vector_type(16)));
typedef unsigned v4u __attribute__((ext_vector_type(4)));
typedef unsigned v2u __attribute__((ext_vector_type(2)));
typedef GAS unsigned gu32;

#ifndef MK_SPLIT
#define MK_SPLIT 0
#endif

constexpr int NB = 4, NSEQ = 4096, DM = 1024, LCTX = 256, DEPTH = 2;
constexpr int T = NB * NSEQ, TC = NB * LCTX, TT = T + TC;
constexpr int KVROWS = LCTX + NSEQ;
constexpr int NEXP = 16, DEXP = 512;
constexpr int NPHASE = 18;
constexpr int MAXTILES = 152;
constexpr float QSCALE = 0.125f * 1.4426950408889634f;
constexpr float LOG2E = 1.4426950408889634f;

constexpr size_t al256(size_t x) { return (x + 255) & ~(size_t)255; }
constexpr size_t O_CTL = 0, SZ_CTL = 1u << 20;
constexpr size_t O_MOD = O_CTL + SZ_CTL, SZ_MOD = (size_t)2 * 5 * 6144 * 4;
constexpr size_t O_ROPE = al256(O_MOD + SZ_MOD), SZ_ROPE = (size_t)4096 * 32 * 8;
constexpr size_t O_TW = al256(O_ROPE + SZ_ROPE), SZ_TW = 4096 * 8;
constexpr size_t O_FMA = al256(O_TW + SZ_TW), SZ_FMA = 128 * 128 * 2;
constexpr size_t O_FMB = al256(O_FMA + SZ_FMA), SZ_FMB = 64 * 128 * 2;
constexpr size_t O_FMC = al256(O_FMB + SZ_FMB), SZ_FMC = 256 * 512 * 2;
constexpr size_t O_WIN = al256(O_FMC + SZ_FMC), SZ_WIN1 = (size_t)1536 * 1024 * 2;
constexpr size_t O_WOUT = al256(O_WIN + 2 * SZ_WIN1), SZ_WOUT1 = (size_t)1024 * 1024 * 2;
constexpr size_t O_WGU = al256(O_WOUT + 2 * SZ_WOUT1), SZ_WGU1 = (size_t)16 * 1024 * 1024 * 2;
constexpr size_t O_WD = al256(O_WGU + 2 * SZ_WGU1), SZ_WD1 = (size_t)16 * 1024 * 512 * 2;
constexpr size_t O_H = al256(O_WD + 2 * SZ_WD1), SZ_H = (size_t)TT * 1024 * 2;
constexpr size_t O_KALL = al256(O_H + SZ_H), SZ_KV = (size_t)NB * KVROWS * 128 * 2;
constexpr size_t O_VALL = al256(O_KALL + SZ_KV);
constexpr size_t O_XC = al256(O_VALL + SZ_KV), SZ_XC = (size_t)TC * 1024 * 4;
constexpr size_t O_LIST = al256(O_XC + SZ_XC), SZ_LIST = (size_t)NEXP * TT * 4;
constexpr size_t O_WTS = al256(O_LIST + SZ_LIST), SZ_WTS = (size_t)TT * 2 * 4;
constexpr size_t O_EID = al256(O_WTS + SZ_WTS), SZ_EID = (size_t)TT * 2 * 4;
constexpr size_t O_ACT = al256(O_EID + SZ_EID), SZ_ACT = (size_t)MAXTILES * 256 * 512 * 2;
constexpr size_t O_T2 = O_ACT, SZ_T2 = (size_t)NB * 64 * 64 * 2 * 256 * 2;
constexpr size_t O_MRG = al256(O_ACT + SZ_ACT), SZ_MRG = (size_t)TT * 1024 * 2;
constexpr size_t O_Q = al256(O_MRG + SZ_MRG), SZ_Q = (size_t)TT * 512 * 2;
constexpr size_t O_PU = al256(O_Q + SZ_Q), SZ_PU = (size_t)TT * 256 * 2;
constexpr size_t O_Z = al256(O_PU + SZ_PU), SZ_Z = (size_t)TT * 512 * 2;
constexpr size_t O_Y2 = O_MRG, SZ_Y2 = (size_t)TT * 2 * 1024 * 2;
constexpr size_t WS_END = al256(O_Z + SZ_Z);
static_assert(SZ_T2 <= SZ_ACT, "T2 overlay");
static_assert(O_Y2 + SZ_Y2 <= WS_END, "y2 overlay");

constexpr int CW_TMO = 0;
constexpr int CW_BAR = 4096;
constexpr int CW_CNT = 16384;

constexpr int RING_BYTES = 131072;
constexpr int LDSCTL_OFF = RING_BYTES, MISC_OFF = LDSCTL_OFF + 320;
constexpr int TRIG_OFF = LDSCTL_OFF + 1024;
constexpr int TILE_OFF = LDSCTL_OFF + 2048;
constexpr int LDS_BYTES = 147456;

#define RLX_AGENT __ATOMIC_RELAXED, __HIP_MEMORY_SCOPE_AGENT
#define LDS_WAIT() asm volatile("s_waitcnt lgkmcnt(0)" ::: "memory")
#define VM_WAIT() asm volatile("s_waitcnt vmcnt(0)" ::: "memory")

__device__ __forceinline__ unsigned f2bf(float f) { unsigned u = __builtin_bit_cast(unsigned, f); return (u + 0x7fffu + ((u >> 16) & 1u)) >> 16; }
__device__ __forceinline__ unsigned pk2(float lo, float hi) { return f2bf(lo) | (f2bf(hi) << 16); }
__device__ __forceinline__ float bflo(unsigned w) { return __builtin_bit_cast(float, w << 16); }
__device__ __forceinline__ float bfhi(unsigned w) { return __builtin_bit_cast(float, w & 0xffff0000u); }
__device__ __forceinline__ float bf2f(bf16 h) { return __builtin_bit_cast(float, (unsigned)h << 16); }
template <int KX> __device__ __forceinline__ float swz_xor(float v) { return __builtin_bit_cast(float, __builtin_amdgcn_ds_swizzle(__builtin_bit_cast(int, v), (KX << 10) | 0x1f)); }
__device__ __forceinline__ float wave_sum(float v) {
    v += swz_xor<1>(v); v += swz_xor<2>(v); v += swz_xor<4>(v); v += swz_xor<8>(v); v += swz_xor<16>(v);
    const int bits_ = __builtin_bit_cast(int, v);
    return __builtin_bit_cast(float, __builtin_amdgcn_readlane(bits_, 0)) + __builtin_bit_cast(float, __builtin_amdgcn_readlane(bits_, 32));
}

#define XB_TMO      128
#define XB_XCNT(j)  (256  + 64 * (j))
#define XB_XSUB(j)  (1280 + 64 * (j))
#define XB_XGEN(j)  (2304 + 64 * (j))
#define XB_TOP      3328
#define XB_TOPGEN   3392
#define XCD_BAR_WORDS 3456
#define XB_SPIN_CAP (1u << 18)
__device__ __forceinline__ unsigned xb_ld(unsigned* p)              { return __hip_atomic_load(p, __ATOMIC_RELAXED, __HIP_MEMORY_SCOPE_AGENT); }
__device__ __forceinline__ unsigned xb_add(unsigned* p, unsigned v) { return __hip_atomic_fetch_add(p, v, __ATOMIC_RELAXED, __HIP_MEMORY_SCOPE_AGENT); }
__device__ __forceinline__ unsigned xb_xcc_id() { return (unsigned)__builtin_amdgcn_s_getreg((3 << 11) | 20) & 0xFu; }
#define XB_SPIN(cond, bar) do { unsigned _sp = 0; while (cond) { __builtin_amdgcn_s_sleep(1); \
    if ((++_sp & 255u) == 0u) { if (xb_ld(&(bar)[XB_TMO])) break; if (_sp > XB_SPIN_CAP) { atomicAdd(&(bar)[XB_TMO], 1u); break; } } } } while (0)
struct XcdBarrier { unsigned* bar; unsigned x; volatile LAS unsigned* st; };
__device__ __forceinline__ XcdBarrier xcd_barrier_post(unsigned* bar, volatile LAS unsigned* st) {
    XcdBarrier b; b.bar = bar; b.x = xb_xcc_id(); b.st = st;
    if (threadIdx.x == 0) (void)xb_add(&bar[XB_XCNT(b.x)], 1u);
    return b;
}
__device__ __forceinline__ void xcd_barrier_complete(unsigned* bar, unsigned x, unsigned& nloc, unsigned& nx) {
    const unsigned G = gridDim.x * gridDim.y * gridDim.z;
    unsigned sum, cnt, mine, sp = 0u;
    for (;;) {
        sum = 0u; cnt = 0u; mine = 0u;
#pragma unroll
        for (unsigned j = 0; j < 16; ++j) { const unsigned c = xb_ld(&bar[XB_XCNT(j)]); sum += c; cnt += (c > 0u) ? 1u : 0u; mine = (j == x) ? c : mine; }
        if (sum == G) break;
        __builtin_amdgcn_s_sleep(1);
        if ((++sp & 255u) == 0u) { if (xb_ld(&bar[XB_TMO])) break; if (sp > XB_SPIN_CAP) { atomicAdd(&bar[XB_TMO], 1u); break; } }
    }
    nloc = mine > 0u ? mine : 1u; nx = cnt > 0u ? cnt : 1u;
}
__device__ __forceinline__ void xcd_barrier(const XcdBarrier& b) {
    asm volatile("s_waitcnt vmcnt(0)" ::: "memory");
    __syncthreads();
    if (threadIdx.x == 0) {
        unsigned* bar = b.bar;
        __builtin_amdgcn_s_waitcnt(0);
        unsigned nloc = b.st[0], nx = b.st[1];
        if (nloc == 0u) { xcd_barrier_complete(bar, b.x, nloc, nx); b.st[0] = nloc; b.st[1] = nx; }
        const unsigned old = xb_add(&bar[XB_XSUB(b.x)], 1u);
        const unsigned gen = old / nloc;
        if (old + 1u == (gen + 1u) * nloc) {
            __builtin_amdgcn_fence(__ATOMIC_RELEASE, "agent");
            asm volatile("s_waitcnt vmcnt(0)" ::: "memory");
            const unsigned og = xb_add(&bar[XB_TOP], 1u);
            const unsigned tg = og / nx;
            if (og + 1u == (tg + 1u) * nx) xb_add(&bar[XB_TOPGEN], 1u);
            else XB_SPIN(xb_ld(&bar[XB_TOPGEN]) == tg, bar);
            __builtin_amdgcn_fence(__ATOMIC_ACQUIRE, "agent");
            xb_add(&bar[XB_XGEN(b.x)], 1u);
            asm volatile("s_waitcnt vmcnt(0)" ::: "memory");
        } else {
            XB_SPIN(xb_ld(&bar[XB_XGEN(b.x)]) == gen, bar);
            __builtin_amdgcn_fence(__ATOMIC_ACQUIRE, "agent");
            asm volatile("s_waitcnt vmcnt(0)" ::: "memory");
        }
    }
    __syncthreads();
}

namespace pg8 {
constexpr int BM = 256, BK = 64, HALF = 128, HTB = HALF * BK * 2;
__host__ __device__ __forceinline__ int lds_byte(int r, int c) { const int st = (r >> 4) * 2 + (c >> 5), rr = r & 15, cc = c & 31, ob = rr * 64 + cc * 2; return st * 1024 + (ob ^ (((ob >> 9) & 1) << 5)); }
__host__ __device__ __forceinline__ void stage_rc(int b, int& R, int& C) { const int st = b / 1024, sb = b % 1024, swz = sb ^ (((sb >> 9) & 1) << 5); R = (st >> 1) * 16 + swz / 64; C = (st & 1) * 32 + (swz % 64) / 2; }
__host__ __device__ __forceinline__ int perm32(int rho) { const int n = rho >> 4, i = rho & 15; return 8 * (i >> 2) + 4 * n + (i & 3); }

struct Unit { int pm, pn, e, cnt; };

template <class Epi, class Sched>
__device__ __forceinline__ void gemm_phase(LAS unsigned char* lds, const char* Abase, const int K, const Sched& S, const Epi& E) {
    int tid = threadIdx.x; asm volatile("" : "+v"(tid));
    const int wid = __builtin_amdgcn_readfirstlane(tid >> 6), lane = tid & 63, wr = wid >> 2, wc = wid & 3, fr = lane & 15, fq = lane >> 4;
    const int nt = K / BK;
    int RA[2], CA[2]; unsigned voffB[2];
#pragma unroll
    for (int i = 0; i < 2; ++i) { int R, C; stage_rc(tid * 16 + i * 8192, R, C); RA[i] = R; CA[i] = C; const int Rb = Epi::PERM ? ((R & ~31) + perm32(R & 31)) : R; voffB[i] = (unsigned)(Rb * K + C) * 2u; }
    const size_t kstep = (size_t)(BK * 2);
    const size_t hstep = (size_t)HALF * K * 2;
    const unsigned ldsw = (unsigned)wid * 1024u;
    const int aoff = lds_byte(wr * 64 + fr, fq * 8), boff = lds_byte(wc * 32 + fr, fq * 8);
#define PG8_SA(b, h) (((b) * 2 + (h)) * HTB)
#define PG8_SB(b, h) ((4 + (b) * 2 + (h)) * HTB)
#define PG8_STAGEB(bufoff, gbase) do { _Pragma("unroll") for (int _i = 0; _i < 2; ++_i) \
        __builtin_amdgcn_global_load_lds((const unsigned*)((const char*)(gbase) + voffB[_i]), (LAS unsigned*)(lds + (bufoff) + ldsw + _i * 8192), 16, 0, 0); } while (0)
#define PG8_STAGEA(bufoff, gbase, o0, o1) do { \
        __builtin_amdgcn_global_load_lds((const unsigned*)((const char*)(gbase) + (o0)), (LAS unsigned*)(lds + (bufoff) + ldsw), 16, 0, 0); \
        __builtin_amdgcn_global_load_lds((const unsigned*)((const char*)(gbase) + (o1)), (LAS unsigned*)(lds + (bufoff) + ldsw + 8192), 16, 0, 0); } while (0)
#define PG8_LDA(dst, b, h) do { _Pragma("unroll") for (int m = 0; m < 4; ++m) _Pragma("unroll") for (int k = 0; k < 2; ++k) dst[m][k] = *(const LAS bf16x8*)(lds + PG8_SA(b, h) + aoff + m * 2048 + k * 1024); } while (0)
#define PG8_LDB(dst, b, h) do { _Pragma("unroll") for (int n = 0; n < 2; ++n) _Pragma("unroll") for (int k = 0; k < 2; ++k) dst[n][k] = *(const LAS bf16x8*)(lds + PG8_SB(b, h) + boff + n * 2048 + k * 1024); } while (0)
#define PG8_MMA(ai, bj, At, Bt) do { __builtin_amdgcn_s_setprio(1); _Pragma("unroll") for (int m = 0; m < 4; ++m) _Pragma("unroll") for (int n = 0; n < 2; ++n) _Pragma("unroll") for (int k = 0; k < 2; ++k) \
        acc[ai][bj][m][n] = __builtin_amdgcn_mfma_f32_16x16x32_bf16(Bt[n][k], At[m][k], acc[ai][bj][m][n], 0, 0, 0); __builtin_amdgcn_s_setprio(0); } while (0)
#define PG8_WAIT_V(n) asm volatile("s_waitcnt vmcnt(" #n ")" ::: "memory")
#define PG8_WAIT_L(n) asm volatile("s_waitcnt lgkmcnt(" #n ")" ::: "memory")
#define PG8_BAR __builtin_amdgcn_s_barrier()
#define PG8_SCHED __builtin_amdgcn_sched_barrier(0)
    Unit cur, nxt; int ui = 0;
    if (!S.next(0, cur)) return;
    f32x4 acc[2][2][4][2];
#pragma unroll
    for (int a = 0; a < 2; ++a)
#pragma unroll
        for (int b = 0; b < 2; ++b)
#pragma unroll
            for (int m = 0; m < 4; ++m)
#pragma unroll
                for (int n = 0; n < 2; ++n) acc[a][b][m][n] = (f32x4){0.f, 0.f, 0.f, 0.f};
    bf16x8 At[4][2], B0[2][2], B1[2][2];
    unsigned oc00, oc01, oc10, oc11, on00, on01, on10, on11;
    oc00 = S.a_off(cur, RA[0], CA[0]); oc01 = S.a_off(cur, RA[1], CA[1]); oc10 = S.a_off(cur, HALF + RA[0], CA[0]); oc11 = S.a_off(cur, HALF + RA[1], CA[1]);
    const char* cB = S.b_ptr(cur);
    PG8_STAGEB(PG8_SB(0, 0), cB); PG8_STAGEB(PG8_SB(0, 1), cB + hstep); PG8_STAGEA(PG8_SA(0, 0), Abase, oc00, oc01); PG8_STAGEA(PG8_SA(0, 1), Abase, oc10, oc11);
    if (wr == 1) PG8_BAR;
    PG8_WAIT_V(2); PG8_BAR;
    PG8_STAGEB(PG8_SB(1, 0), cB + kstep); PG8_STAGEA(PG8_SA(1, 0), Abase + kstep, oc00, oc01); PG8_STAGEB(PG8_SB(1, 1), cB + hstep + kstep);
    PG8_WAIT_V(6); PG8_BAR;
    for (;;) {
        const bool has_next = S.next(ui + 1, nxt);
        const char* nB = cB;
        on00 = oc00; on01 = oc01; on10 = oc10; on11 = oc11;
        if (has_next) { nB = S.b_ptr(nxt); on00 = S.a_off(nxt, RA[0], CA[0]); on01 = S.a_off(nxt, RA[1], CA[1]); on10 = S.a_off(nxt, HALF + RA[0], CA[0]); on11 = S.a_off(nxt, HALF + RA[1], CA[1]); }
        for (int t = 0; t < nt; t += 2) {
            const bool last = (t == nt - 2);
            const char* a1 = Abase + (size_t)(t + 1) * kstep;
            const char* a2 = last ? Abase : Abase + (size_t)(t + 2) * kstep; const char* b2 = last ? nB : cB + (size_t)(t + 2) * kstep;
            const char* a3 = a2 + kstep; const char* b3 = b2 + kstep;
            const unsigned x00 = last ? on00 : oc00, x01 = last ? on01 : oc01, x10 = last ? on10 : oc10, x11 = last ? on11 : oc11;
            PG8_LDB(B0, 0, 0); PG8_LDB(B1, 0, 1); PG8_SCHED; PG8_LDA(At, 0, 0); PG8_STAGEA(PG8_SA(1, 1), a1, oc10, oc11);
            PG8_WAIT_V(8); PG8_WAIT_L(0); PG8_BAR; PG8_MMA(0, 0, At, B0); PG8_MMA(0, 1, At, B1); PG8_BAR; PG8_SCHED;
            PG8_LDA(At, 0, 1); PG8_STAGEB(PG8_SB(0, 0), b2); PG8_STAGEB(PG8_SB(0, 1), b2 + hstep); PG8_STAGEA(PG8_SA(0, 0), a2, x00, x01);
            PG8_WAIT_V(8); PG8_WAIT_L(0); PG8_BAR; PG8_MMA(1, 0, At, B0); PG8_MMA(1, 1, At, B1); PG8_BAR; PG8_SCHED;
            PG8_LDB(B0, 1, 0); PG8_LDB(B1, 1, 1); PG8_SCHED; PG8_LDA(At, 1, 0); PG8_STAGEA(PG8_SA(0, 1), a2, x10, x11);
            PG8_WAIT_V(8); PG8_WAIT_L(0); PG8_BAR; PG8_MMA(0, 0, At, B0); PG8_MMA(0, 1, At, B1); PG8_BAR; PG8_SCHED;
            PG8_LDA(At, 1, 1); PG8_STAGEB(PG8_SB(1, 0), b3); PG8_STAGEB(PG8_SB(1, 1), b3 + hstep); PG8_STAGEA(PG8_SA(1, 0), a3, x00, x01);
            PG8_WAIT_V(8); PG8_WAIT_L(0); PG8_BAR; PG8_MMA(1, 0, At, B0); PG8_MMA(1, 1, At, B1); PG8_BAR; PG8_SCHED;
        }
        if (wr == 0) PG8_BAR;
        E(acc, cur, wr, wc, fr, fq);
        if (!has_next) break;
#pragma unroll
        for (int a = 0; a < 2; ++a)
#pragma unroll
            for (int b = 0; b < 2; ++b)
#pragma unroll
                for (int m = 0; m < 4; ++m)
#pragma unroll
                    for (int n = 0; n < 2; ++n) acc[a][b][m][n] = (f32x4){0.f, 0.f, 0.f, 0.f};
        cur = nxt; cB = nB; oc00 = on00; oc01 = on01; oc10 = on10; oc11 = on11; ++ui;
        if (wr == 1) PG8_BAR;
    }
    PG8_WAIT_V(0);
    PG8_BAR;
#undef PG8_SA
#undef PG8_SB
#undef PG8_STAGEA
#undef PG8_STAGEB
#undef PG8_LDA
#undef PG8_LDB
#undef PG8_MMA
#undef PG8_WAIT_V
#undef PG8_WAIT_L
#undef PG8_BAR
#undef PG8_SCHED
}
}

__device__ __forceinline__ int krow_of(int r) {
    if (r < T) return (r >> 12) * KVROWS + LCTX + (r & 4095);
    const int rc = r - T; return (rc >> 8) * KVROWS + (rc & 255);
}
struct SchedPlain {
    int nM, nN, G, vcu, K; const char* B;
    __device__ __forceinline__ bool next(int i, pg8::Unit& u) const { const int L = i * G + vcu; if (L >= nM * nN) return false; u.pm = L / nN; u.pn = L % nN; u.e = 0; u.cnt = 256; return true; }
    __device__ __forceinline__ unsigned a_off(const pg8::Unit& u, int row, int col) const { return (unsigned)((u.pm * 256 + row) * K + col) * 2u; }
    __device__ __forceinline__ const char* b_ptr(const pg8::Unit& u) const { return B + (size_t)u.pn * 256 * K * 2; }
};
struct EpiG1 {
    static constexpr bool PERM = true;
    bf16 *pu, *q, *kall, *vall, *z;
    __device__ __forceinline__ void operator()(const f32x4 (&acc)[2][2][4][2], const pg8::Unit& u, int wr, int wc, int fr, int fq) const {
        const int row0 = u.pm * 256 + wr * 64 + fr, c8 = wc * 32 + 8 * fq;
#pragma unroll
        for (int ai = 0; ai < 2; ++ai)
#pragma unroll
            for (int m = 0; m < 4; ++m) {
                const int row = row0 + ai * 128 + m * 16;
#pragma unroll
                for (int bj = 0; bj < 2; ++bj) {
                    const f32x4 v0 = acc[ai][bj][m][0], v1 = acc[ai][bj][m][1];
                    v4u w; w.x = pk2(v0[0], v0[1]); w.y = pk2(v0[2], v0[3]); w.z = pk2(v1[0], v1[1]); w.w = pk2(v1[2], v1[3]);
                    bf16* dst;
                    if (u.pn == 0) dst = pu + (size_t)row * 256 + bj * 128 + c8;
                    else if (u.pn <= 2) dst = q + (size_t)row * 512 + (u.pn - 1) * 256 + bj * 128 + c8;
                    else if (u.pn == 3) dst = (bj == 0 ? kall : vall) + (size_t)krow_of(row) * 128 + c8;
                    else dst = z + (size_t)row * 512 + (u.pn - 4) * 256 + bj * 128 + c8;
                    *(v4u*)dst = w;
                }
            }
    }
};
struct EpiG2 {
    static constexpr bool PERM = false;
    const float* xin; const float* cin; float* xout; float* cout; const float* mod;
    __device__ __forceinline__ void operator()(const f32x4 (&acc)[2][2][4][2], const pg8::Unit& u, int wr, int wc, int fr, int fq) const {
        const int rt0 = u.pm * 256; const bool isc = rt0 >= T;
        const int bsel = isc ? 4 : (rt0 >> 12);
        const float* g1 = mod + bsel * 6144 + 2048;
        const float* base = isc ? cin - (size_t)T * 1024 : xin; float* out = isc ? cout - (size_t)T * 1024 : xout;
        const int row0 = rt0 + wr * 64 + fr, col0 = u.pn * 256 + wc * 32 + 4 * fq;
#pragma unroll
        for (int bj = 0; bj < 2; ++bj)
#pragma unroll
            for (int n = 0; n < 2; ++n) {
                const int col = col0 + bj * 128 + n * 16; const f32x4 gv = *(const f32x4*)(g1 + col);
#pragma unroll
                for (int ai = 0; ai < 2; ++ai)
#pragma unroll
                    for (int m = 0; m < 4; ++m) { const size_t off = (size_t)(row0 + ai * 128 + m * 16) * 1024 + col; const f32x4 bs = *(const f32x4*)(base + off); *(f32x4*)(out + off) = bs + gv * acc[ai][bj][m][n]; }
            }
    }
};
struct SchedMoe {
    int G, vcu, K, ntile, mode;
    const char* B; const unsigned* list; const LAS int* tt;
    __device__ __forceinline__ bool next(int i, pg8::Unit& u) const {
        const int L = i * G + vcu; if (L >= ntile * 4) return false;
        const int tau = L >> 2; u.pn = L & 3; u.pm = tau; int e = 0;
#pragma unroll
        for (int k = 1; k < 16; ++k) e += (tt[k] <= tau) ? 1 : 0;
        u.e = e; const int r0 = (tau - tt[e]) * 256; const int c = tt[17 + e] - r0; u.cnt = c < 256 ? c : 256; return true;
    }
    __device__ __forceinline__ unsigned a_off(const pg8::Unit& u, int row, int col) const {
        if (mode == 1) return (unsigned)((u.pm * 256 + row) * K + col) * 2u;
        const int r0 = (u.pm - tt[u.e]) * 256; unsigned tok = 0;
        if (row < u.cnt) tok = list[(size_t)u.e * TT + r0 + row] >> 1;
        return (tok * (unsigned)K + (unsigned)col) * 2u;
    }
    __device__ __forceinline__ const char* b_ptr(const pg8::Unit& u) const { return B + ((size_t)u.e * 1024 + (size_t)u.pn * 256) * K * 2; }
};
struct EpiG3 {
    static constexpr bool PERM = true;
    bf16* act;
    __device__ __forceinline__ void operator()(const f32x4 (&acc)[2][2][4][2], const pg8::Unit& u, int wr, int wc, int fr, int fq) const {
        const int row0 = u.pm * 256 + wr * 64 + fr, c8 = u.pn * 128 + wc * 32 + 8 * fq;
#pragma unroll
        for (int ai = 0; ai < 2; ++ai)
#pragma unroll
            for (int m = 0; m < 4; ++m) {
                float a[8];
#pragma unroll
                for (int n = 0; n < 2; ++n)
#pragma unroll
                    for (int k = 0; k < 4; ++k) { const float g = acc[ai][0][m][n][k], up = acc[ai][1][m][n][k]; a[n * 4 + k] = g / (1.f + __expf(-g)) * up; }
                v4u w; w.x = pk2(a[0], a[1]); w.y = pk2(a[2], a[3]); w.z = pk2(a[4], a[5]); w.w = pk2(a[6], a[7]);
                *(v4u*)(act + (size_t)(row0 + ai * 128 + m * 16) * 512 + c8) = w;
            }
    }
};
struct EpiG4 {
    static constexpr bool PERM = true;
    bf16* y2; const unsigned* list; const float* wts; const LAS int* tt;
    __device__ __forceinline__ void operator()(const f32x4 (&acc)[2][2][4][2], const pg8::Unit& u, int wr, int wc, int fr, int fq) const {
        const int r0 = (u.pm - tt[u.e]) * 256; const int c8 = u.pn * 256 + wc * 32 + 8 * fq;
#pragma unroll
        for (int ai = 0; ai < 2; ++ai)
#pragma unroll
            for (int m = 0; m < 4; ++m) {
                const int row = wr * 64 + fr + ai * 128 + m * 16;
                if (row < u.cnt) {
                    const unsigned ent = list[(size_t)u.e * TT + r0 + row]; const float w = wts[ent];
#pragma unroll
                    for (int bj = 0; bj < 2; ++bj) {
                        const f32x4 v0 = acc[ai][bj][m][0] * w, v1 = acc[ai][bj][m][1] * w;
                        v4u o; o.x = pk2(v0[0], v0[1]); o.y = pk2(v0[2], v0[3]); o.z = pk2(v1[0], v1[1]); o.w = pk2(v1[2], v1[3]);
                        *(v4u*)(y2 + (size_t)ent * 1024 + bj * 128 + c8) = o;
                    }
                }
            }
    }
};

constexpr int SLAB_PITCH = 136;
template <int MT, class RowAddr, class Epi>
__device__ __forceinline__ void slab_gemm(LAS unsigned char* lds, const bf16* Cmat, const int K, const RowAddr& RA, const Epi& E) {
    int tid = threadIdx.x; asm volatile("" : "+v"(tid));
    const int wid = tid >> 6, lane = tid & 63;
    LAS bf16* Dt = (LAS bf16*)lds;
    f32x16 acc[MT];
#pragma unroll
    for (int i = 0; i < MT; ++i)
#pragma unroll
        for (int r = 0; r < 16; ++r) acc[i][r] = 0.f;
    for (int kc = 0; kc < K; kc += 128) {
        {
            const int k = tid >> 2, qd = tid & 3;
            const bf16* src = RA(kc + k) + qd * 64;
            v4u v[8];
#pragma unroll
            for (int j = 0; j < 8; ++j) v[j] = *(const v4u*)(src + j * 8);
#pragma unroll
            for (int j = 0; j < 8; ++j) {
                const unsigned w[4] = {v[j].x, v[j].y, v[j].z, v[j].w};
#pragma unroll
                for (int e = 0; e < 4; ++e) {
                    const int ch = qd * 64 + j * 8 + e * 2;
                    Dt[(ch) * SLAB_PITCH + k] = (bf16)(w[e] & 0xffffu);
                    Dt[(ch + 1) * SLAB_PITCH + k] = (bf16)(w[e] >> 16);
                }
            }
        }
        __syncthreads();
        const int chl = wid * 32 + (lane & 31), kh = (lane >> 5) * 8;
#pragma unroll
        for (int s = 0; s < 8; ++s) {
            const bf16x8 bfrag = *(const LAS bf16x8*)(Dt + chl * SLAB_PITCH + s * 16 + kh);
#pragma unroll
            for (int mt = 0; mt < MT; ++mt) {
                const bf16x8 afrag = *(const bf16x8*)(Cmat + (size_t)(mt * 32 + (lane & 31)) * K + kc + s * 16 + kh);
                acc[mt] = __builtin_amdgcn_mfma_f32_32x32x16_bf16(afrag, bfrag, acc[mt], 0, 0, 0);
            }
        }
        __syncthreads();
    }
    E(acc, wid, lane);
}

struct Args { const float* in[23]; float* out; unsigned char* ws; int ph_lo, ph_hi; };

struct RowA { const bf16* z; int b, n2; __device__ __forceinline__ const bf16* operator()(int k) const { return z + (size_t)(b * 4096 + 64 * (k & 63) + n2) * 512 + (k >> 6) * 256; } };
struct EpiA { bf16* t2; const float2* tw; int b, n2;
    __device__ __forceinline__ void operator()(const f32x16 (&acc)[4], int wid, int lane) const {
        const int ch = wid * 32 + (lane & 31);
#pragma unroll
        for (int mt = 0; mt < 2; ++mt)
#pragma unroll
            for (int r = 0; r < 16; ++r) {
                const int k1 = 32 * mt + (r & 3) + 8 * (r >> 2) + 4 * (lane >> 5);
                const float2 cs = tw[n2 * k1]; const float re = acc[mt][r], im = acc[mt + 2][r];
                const float re2 = cs.x * re + cs.y * im, im2 = cs.x * im - cs.y * re;
                bf16* d = t2 + ((size_t)((b * 64 + n2) * 64 + k1) * 2) * 256 + ch;
                d[0] = (bf16)f2bf(re2); d[256] = (bf16)f2bf(im2);
            }
    } };
struct RowB { const bf16* t2; int b, k1; __device__ __forceinline__ const bf16* operator()(int k) const { return t2 + ((size_t)((b * 64 + (k & 63)) * 64 + k1) * 2 + (k >> 6)) * 256; } };
struct EpiB { bf16* mrg; int b, k1;
    __device__ __forceinline__ void operator()(const f32x16 (&acc)[2], int wid, int lane) const {
        const int ch = wid * 32 + (lane & 31);
#pragma unroll
        for (int mt = 0; mt < 2; ++mt)
#pragma unroll
            for (int r = 0; r < 16; ++r) { const int k2 = 32 * mt + (r & 3) + 8 * (r >> 2) + 4 * (lane >> 5); mrg[(size_t)(b * 4096 + k1 + 64 * k2) * 1024 + 768 + ch] = (bf16)f2bf(DBG_NO_FOUR ? 0.f : acc[mt][r]); }
    } };
struct RowC { const bf16* z; int b; __device__ __forceinline__ const bf16* operator()(int k) const { return z + (size_t)(T + b * 256 + (k & 255)) * 512 + (k >> 8) * 256; } };
struct EpiC { bf16* mrg; int b;
    __device__ __forceinline__ void operator()(const f32x16 (&acc)[8], int wid, int lane) const {
        const int ch = wid * 32 + (lane & 31);
#pragma unroll
        for (int mt = 0; mt < 8; ++mt)
#pragma unroll
            for (int r = 0; r < 16; ++r) { const int kk = 32 * mt + (r & 3) + 8 * (r >> 2) + 4 * (lane >> 5); mrg[(size_t)(T + b * 256 + kk) * 1024 + 768 + ch] = (bf16)f2bf(DBG_NO_FOUR ? 0.f : acc[mt][r]); }
    } };

__device__ __forceinline__ void tr_block(const float* src, int ldS, bf16* dst, int ldD, LAS float* scr, int lane) {
#pragma unroll 8
    for (int i = 0; i < 32; ++i) { const int kk = 2 * i + (lane >> 5); scr[kk * 33 + (lane & 31)] = src[(size_t)kk * ldS + (lane & 31)]; }
    LDS_WAIT(); asm volatile("" ::: "memory");
    const int c = lane & 7;
#pragma unroll
    for (int j = 0; j < 4; ++j) { const int n = (lane >> 3) + 8 * j; const LAS float* s = scr + (8 * c) * 33 + n;
        v4u o; o.x = pk2(s[0 * 33], s[1 * 33]); o.y = pk2(s[2 * 33], s[3 * 33]); o.z = pk2(s[4 * 33], s[5 * 33]); o.w = pk2(s[6 * 33], s[7 * 33]);
        *(GAS v4u*)(dst + (size_t)n * ldD + 8 * c) = o; }
    LDS_WAIT(); asm volatile("" ::: "memory");
}


typedef const __attribute__((address_space(4))) Args* kargs_t;
__device__ __forceinline__ kargs_t ka_launder() { kargs_t p = (kargs_t)__builtin_amdgcn_kernarg_segment_ptr(); asm volatile("" : "+s"(p)); return p; }
__device__ __forceinline__ int tid_launder() { int t = threadIdx.x; asm volatile("" : "+v"(t)); return t; }
#define KA_DECL const kargs_t KA = ka_launder(); const int tid = tid_launder(); const int lane = tid & 63; const int wave = __builtin_amdgcn_readfirstlane(tid >> 6); const int gw = vcu * 8 + wave; const int gt = vcu * 512 + tid; (void)lane; (void)wave; (void)gw; (void)gt;
#define ws (KA->ws)
#define ctl ((gu32*)(ws + O_CTL))
#define x_in (KA->in[0])
#define c_in (KA->in[1])
#define ctx_in (KA->in[2])
#define cctx_in (KA->in[3])
#define w_mod (KA->in[4])
#define b_mod (KA->in[5])
#define norm1_g (KA->in[6])
#define w_in (KA->in[7])
#define q_norm_g (KA->in[8])
#define k_norm_g (KA->in[9])
#define attn_sink (KA->in[10])
#define pool_w (KA->in[11])
#define pool_scale (KA->in[12])
#define four_w (KA->in[13])
#define w_out (KA->in[14])
#define norm2_g (KA->in[15])
#define w_grp (KA->in[16])
#define b_grp (KA->in[17])
#define w_rtr (KA->in[18])
#define b_rtr (KA->in[19])
#define w_gate (KA->in[20])
#define w_up (KA->in[21])
#define w_down (KA->in[22])
#define outp (KA->out)
#define modv ((float*)(ws + O_MOD))
#define rope ((float2*)(ws + O_ROPE))
#define twt ((float2*)(ws + O_TW))
#define fma ((bf16*)(ws + O_FMA))
#define fmb ((bf16*)(ws + O_FMB))
#define fmc ((bf16*)(ws + O_FMC))
#define hbuf ((bf16*)(ws + O_H))
#define kall ((bf16*)(ws + O_KALL))
#define vall ((bf16*)(ws + O_VALL))
#define xc ((float*)(ws + O_XC))
#define list ((unsigned*)(ws + O_LIST))
#define wts ((float*)(ws + O_WTS))
#define act ((bf16*)(ws + O_ACT))
#define t2 ((bf16*)(ws + O_T2))
#define mrg ((bf16*)(ws + O_MRG))
#define qb ((bf16*)(ws + O_Q))
#define pu ((bf16*)(ws + O_PU))
#define zb ((bf16*)(ws + O_Z))
#define y2 ((bf16*)(ws + O_Y2))

#ifndef PH_MASK
#define PH_MASK 0x3ffff
#endif
#define IN(k) (lo <= (k) && (k) < hi && ((PH_MASK >> (k)) & 1))
#define SEAM(k) do { if (IN(k) && IN((k) + 1)) xcd_barrier(bar); } while (0)
#define modl (modv + (size_t)l * 5 * 6144)
#define win_t ((bf16*)(ws + O_WIN + l * SZ_WIN1))
#define wout_t ((bf16*)(ws + O_WOUT + l * SZ_WOUT1))
#define wgu_t ((bf16*)(ws + O_WGU + l * SZ_WGU1))
#define wd_t ((bf16*)(ws + O_WD + l * SZ_WD1))
template <int l> __device__ __forceinline__ void layer_body(LAS unsigned char* lds, const int G, const int vcu, const XcdBarrier& bar, const int lo, const int hi) {
    const int NGW = G * 8, NGT = G * 512; LAS int* ttab = (LAS int*)(lds + TILE_OFF);
    constexpr int P = 1 + 8 * l;

        if (IN(P + 0)) {
            KA_DECL
            const float* modp = modv;
#pragma clang loop vectorize(disable) unroll(disable)
            for (int r = gw; r < TT; r += NGW) {
                const bool isc = r >= T; const int bsel = isc ? 4 : (r >> 12);
                const float* src = (l == 0) ? (isc ? ctx_in + (size_t)(r - T) * 1024 : x_in + (size_t)r * 1024) : (isc ? xc + (size_t)(r - T) * 1024 : outp + (size_t)r * 1024);
                f32x4 v[4];
#pragma unroll
                for (int j = 0; j < 4; ++j) v[j] = *(const f32x4*)(src + 4 * lane + 256 * j);
                if (l == 1) {
                    const float w0 = wts[2 * r], w1 = wts[2 * r + 1]; const float* g2 = modp + bsel * 6144 + 5 * 1024;
                    float* dst = isc ? xc + (size_t)(r - T) * 1024 : outp + (size_t)r * 1024;
#pragma unroll
                    for (int j = 0; j < 4; ++j) {
                        const v2u ya = *(const v2u*)(y2 + (size_t)(2 * r) * 1024 + 4 * lane + 256 * j), yb = *(const v2u*)(y2 + (size_t)(2 * r + 1) * 1024 + 4 * lane + 256 * j);
                        const f32x4 gv = *(const f32x4*)(g2 + 4 * lane + 256 * j);
                        f32x4 yy; yy[0] = bflo(ya.x) + bflo(yb.x); yy[1] = bfhi(ya.x) + bfhi(yb.x); yy[2] = bflo(ya.y) + bflo(yb.y); yy[3] = bfhi(ya.y) + bfhi(yb.y);
                        if (DBG_NO_MOE) yy = (f32x4){0.f, 0.f, 0.f, 0.f};
                yy = yy * DBG_MOE_SCALE;
                        yy = yy * DBG_MOE_SCALE;
                        v[j] = v[j] + gv * yy; *(f32x4*)(dst + 4 * lane + 256 * j) = v[j];
                    }
                    (void)w0; (void)w1;
                }
                float ss = 0.f;
#pragma unroll
                for (int j = 0; j < 4; ++j) ss += (v[j][0] * v[j][0] + v[j][1] * v[j][1]) + (v[j][2] * v[j][2] + v[j][3] * v[j][3]);
                const float rstd = 1.0f / sqrtf(wave_sum(ss) * (1.f / 1024.f) + 1e-6f);
                const float* sh = modl + bsel * 6144; const float* sc = sh + 1024; const float* gn = norm1_g + l * 1024;
#pragma unroll
                for (int j = 0; j < 4; ++j) {
                    const int c0 = 4 * lane + 256 * j; const f32x4 g = *(const f32x4*)(gn + c0), s1 = *(const f32x4*)(sc + c0), h1 = *(const f32x4*)(sh + c0);
                    const f32x4 y = (v[j] * rstd) * g * (s1 + 1.0f) + h1;
                    v2u o; o.x = pk2(y[0], y[1]); o.y = pk2(y[2], y[3]); *(v2u*)(hbuf + (size_t)r * 1024 + c0) = o;
                }
            }
        }
        SEAM(P + 0);
        if (IN(P + 1)) {
            KA_DECL
            SchedPlain S{TT / 256, 6, G, vcu, 1024, (const char*)win_t};
            EpiG1 E{pu, qb, kall, vall, zb};
            pg8::gemm_phase<EpiG1, SchedPlain>(lds, (const char*)hbuf, 1024, S, E);
        }
        SEAM(P + 1);
        if (IN(P + 2)) {
            KA_DECL
            for (int it = vcu; it < 256; it += G) {
                const int b = it >> 6, n2 = it & 63;
                RowA ra{zb, b, n2}; EpiA ea{t2, twt, b, n2};
                slab_gemm<4, RowA, EpiA>(lds, fma, 128, ra, ea);
            }
#pragma clang loop vectorize(disable) unroll(disable)
            for (int i = gt; i < TT * 10; i += NGT) {
                const int r = i / 10, hs = i % 10; const bool isk = hs >= 8; const bool isc = r >= T;
                bf16* p = isk ? kall + (size_t)krow_of(r) * 128 + (hs - 8) * 64 : qb + (size_t)r * 512 + hs * 64;
                float xv[64];
#pragma unroll
                for (int j = 0; j < 8; ++j) { const v4u w = *(const v4u*)(p + 8 * j); xv[8 * j] = bflo(w.x); xv[8 * j + 1] = bfhi(w.x); xv[8 * j + 2] = bflo(w.y); xv[8 * j + 3] = bfhi(w.y); xv[8 * j + 4] = bflo(w.z); xv[8 * j + 5] = bfhi(w.z); xv[8 * j + 6] = bflo(w.w); xv[8 * j + 7] = bfhi(w.w); }
                float ss = 0.f;
#pragma unroll
                for (int d = 0; d < 64; ++d) ss += xv[d] * xv[d];
                const float rstd = 1.0f / sqrtf(ss * (1.f / 64.f) + 1e-6f);
                const float* gg = (isk ? k_norm_g : q_norm_g) + l * 64;
#pragma unroll
                for (int d = 0; d < 64; ++d) { xv[d] = xv[d] * rstd * gg[d]; if ((d & 7) == 7) asm volatile("" ::: "memory"); }
                if (!isc) {
                    const float2* rp = rope + (size_t)(r & 4095) * 32;
#pragma unroll
                    for (int d = 0; d < 16; ++d) {
                        const float2 c1 = rp[d], c2 = rp[16 + d];
                        const float a = xv[d], bb = xv[16 + d], cc = xv[32 + d], dd = xv[48 + d];
                        xv[d] = a * c1.x - bb * c1.y; xv[16 + d] = bb * c1.x + a * c1.y;
                        xv[32 + d] = cc * c2.x - dd * c2.y; xv[48 + d] = dd * c2.x + cc * c2.y;
                        if ((d & 3) == 3) asm volatile("" ::: "memory");
                    }
                }
                const float sc = isk ? 1.0f : QSCALE;
#pragma unroll
                for (int j = 0; j < 8; ++j) { v4u w; w.x = pk2(xv[8 * j] * sc, xv[8 * j + 1] * sc); w.y = pk2(xv[8 * j + 2] * sc, xv[8 * j + 3] * sc); w.z = pk2(xv[8 * j + 4] * sc, xv[8 * j + 5] * sc); w.w = pk2(xv[8 * j + 6] * sc, xv[8 * j + 7] * sc); *(v4u*)(p + 8 * j) = w; }
            }
            const int prow = (l == 0) ? TT : T;
#pragma clang loop vectorize(disable) unroll(disable)
            for (int i = gt; i < prow * 32; i += NGT) {
                const int r = i >> 5, ck = i & 31, g = ck >> 3; const bool isc = r >= T;
                const int nseq = isc ? LCTX : NSEQ; const int rbase = isc ? T + ((r - T) & ~255) : (r & ~4095); const int n = r - rbase;
                const int hw = 1 << g;
                int lo_ = n - hw; lo_ = lo_ < 0 ? 0 : lo_; int hi_ = n + hw - 1; hi_ = hi_ > nseq - 1 ? nseq - 1 : hi_;
                float s[8] = {0.f, 0.f, 0.f, 0.f, 0.f, 0.f, 0.f, 0.f};
                for (int tpos = lo_; tpos <= hi_; ++tpos) { const v4u w = *(const v4u*)(pu + (size_t)(rbase + tpos) * 256 + ck * 8);
                    s[0] += bflo(w.x); s[1] += bfhi(w.x); s[2] += bflo(w.y); s[3] += bfhi(w.y); s[4] += bflo(w.z); s[5] += bfhi(w.z); s[6] += bflo(w.w); s[7] += bfhi(w.w); }
                const v4u w = *(const v4u*)(pu + (size_t)r * 256 + ck * 8); const float ic = 1.0f / (float)(hi_ - lo_ + 1);
                v4u o; o.x = pk2(s[0] * ic - bflo(w.x), s[1] * ic - bfhi(w.x)); o.y = pk2(s[2] * ic - bflo(w.y), s[3] * ic - bfhi(w.y));
                o.z = pk2(s[4] * ic - bflo(w.z), s[5] * ic - bfhi(w.z)); o.w = pk2(s[6] * ic - bflo(w.w), s[7] * ic - bfhi(w.w));
                if (DBG_NO_POOL) o = (v4u){0u, 0u, 0u, 0u};
                *(v4u*)(mrg + (size_t)r * 1024 + ck * 8) = o;
            }
        }
        SEAM(P + 2);
        if (IN(P + 3)) {
            KA_DECL
            const int n_att = 256 + (l == 0 ? 16 : 0), n_fb = 256, n_cf = (l == 0 ? 4 : 0);
            for (int it = vcu; it < n_att + n_fb + n_cf; it += G) {
#ifndef NO_ATT
                if (it < n_att) { {
                    const bool cu = it >= 256; const int uidx = cu ? it - 256 : it;
                    const int b = cu ? (uidx >> 2) : (uidx >> 6), kvh = cu ? ((uidx >> 1) & 1) : ((uidx >> 5) & 1), pb = cu ? (uidx & 1) : (uidx & 31);
                    const int p0 = pb * 128; const int hq = kvh * 4 + (tid >> 7); const int pos = p0 + (tid & 127);
                    const int qrow = cu ? T + b * 256 + pos : b * 4096 + pos;
                    LAS float* Kf = (LAS float*)lds; LAS float* Vf = Kf + 4096;
                    f32x4 qv[16], ov[16];
                    { const bf16* qp = qb + (size_t)qrow * 512 + hq * 64;
#pragma unroll
                      for (int j = 0; j < 8; ++j) { const v4u w = *(const v4u*)(qp + 8 * j); qv[2*j] = (f32x4){bflo(w.x), bfhi(w.x), bflo(w.y), bfhi(w.y)}; qv[2*j+1] = (f32x4){bflo(w.z), bfhi(w.z), bflo(w.w), bfhi(w.w)}; } }
#pragma unroll
                    for (int d = 0; d < 16; ++d) ov[d] = (f32x4){0.f,0.f,0.f,0.f};
                    float mrun = -1e30f, lrun = 0.f;
                    const int nch = cu ? 4 : 10;
                    for (int c = 0; c < nch; ++c) {
                        {
                            const int key = tid >> 3, dc = tid & 7; int krow;
                            if (c < 4) krow = b * KVROWS + c * 64 + key;
                            else { int kp = p0 - 128 + (c - 4) * 64 + key; kp = kp < 0 ? 0 : (kp > 4095 ? 4095 : kp); krow = b * KVROWS + LCTX + kp; }
                            const v4u kw = *(const v4u*)(kall + (size_t)krow * 128 + kvh * 64 + dc * 8), vw = *(const v4u*)(vall + (size_t)krow * 128 + kvh * 64 + dc * 8);
                            __syncthreads();
                            LAS float* kd = Kf + key * 64 + dc * 8; LAS float* vd = Vf + key * 64 + dc * 8;
                            *(LAS f32x4*)kd = (f32x4){bflo(kw.x), bfhi(kw.x), bflo(kw.y), bfhi(kw.y)}; *(LAS f32x4*)(kd + 4) = (f32x4){bflo(kw.z), bfhi(kw.z), bflo(kw.w), bfhi(kw.w)};
                            *(LAS f32x4*)vd = (f32x4){bflo(vw.x), bfhi(vw.x), bflo(vw.y), bfhi(vw.y)}; *(LAS f32x4*)(vd + 4) = (f32x4){bflo(vw.z), bfhi(vw.z), bflo(vw.w), bfhi(vw.w)};
                            __syncthreads();
                        }
#pragma unroll 1
                        for (int sub = 0; sub < 4; ++sub) {
                            float sv[16]; float mx = -1e30f;
#pragma unroll
                            for (int j = 0; j < 16; ++j) {
                                const LAS float* kr = Kf + (sub * 16 + j) * 64; f32x4 a4 = (f32x4){0.f,0.f,0.f,0.f};
#pragma unroll
                                for (int d4 = 0; d4 < 16; ++d4) { const f32x4 kk = *(const LAS f32x4*)(kr + 4 * d4); a4 += qv[d4] * kk; }
                                float a = (a4[0] + a4[1]) + (a4[2] + a4[3]);
                                if (c >= 4) { const int kp = p0 - 128 + (c - 4) * 64 + sub * 16 + j; const int df = pos - kp; if (kp < 0 || kp > 4095 || df > 128 || df < -128) a = -1e30f; }
                                sv[j] = a; mx = fmaxf(mx, a);
                                __builtin_amdgcn_sched_barrier(0);
                            }
                            const float mnew = fmaxf(mrun, mx); const float corr = __builtin_amdgcn_exp2f(mrun - mnew); mrun = mnew; lrun *= corr;
#pragma unroll
                            for (int d = 0; d < 16; ++d) ov[d] *= corr;
#pragma unroll
                            for (int j = 0; j < 16; ++j) {
                                const float p = __builtin_amdgcn_exp2f(sv[j] - mnew); lrun += p; const LAS float* vr = Vf + (sub * 16 + j) * 64;
#pragma unroll
                                for (int d4 = 0; d4 < 16; ++d4) { const f32x4 vv = *(const LAS f32x4*)(vr + 4 * d4); ov[d4] += vv * p; }
                                __builtin_amdgcn_sched_barrier(0);
                            }
                        }
                    }
                    lrun += __builtin_amdgcn_exp2f(attn_sink[l * 8 + hq] * LOG2E - mrun);
                    const float il = 1.0f / lrun; bf16* op = mrg + (size_t)qrow * 1024 + 256 + hq * 64;
#pragma unroll
                    for (int j = 0; j < 8; ++j) { const f32x4 a = ov[2*j] * il, bq = ov[2*j+1] * il; v4u w; w.x = pk2(a[0], a[1]); w.y = pk2(a[2], a[3]); w.z = pk2(bq[0], bq[1]); w.w = pk2(bq[2], bq[3]); if (DBG_NO_ATT) w = (v4u){0u, 0u, 0u, 0u}; *(v4u*)(op + 8 * j) = w; }
                    __syncthreads(); }
                } else
#endif
#ifndef NO_FB
                if (it < n_att + n_fb) { {
                    const int u2 = it - n_att; const int b = u2 >> 6, k1 = u2 & 63;
                    RowB rb{t2, b, k1}; EpiB eb{mrg, b, k1};
                    slab_gemm<2, RowB, EpiB>(lds, fmb, 128, rb, eb); }
                } else
#endif
                {
#ifndef NO_CF
                    {
                    const int b = it - n_att - n_fb;
                    RowC rc{zb, b}; EpiC ec{mrg, b};
                    slab_gemm<8, RowC, EpiC>(lds, fmc, 512, rc, ec); }
#endif
                }
            }
        }
        SEAM(P + 3);
        if (IN(P + 4)) {
            KA_DECL
            SchedPlain S{(l == 0 ? TT : T) / 256, 4, G, vcu, 1024, (const char*)wout_t};
            EpiG2 E{(l == 0) ? x_in : outp, ctx_in, outp, xc, modl};
            pg8::gemm_phase<EpiG2, SchedPlain>(lds, (const char*)mrg, 1024, S, E);
        }
        SEAM(P + 4);
        if (IN(P + 5)) {
            KA_DECL
            LAS float* rw = (LAS float*)lds;
            LAS int* lcnt = (LAS int*)(lds + 81920);
            LAS unsigned* lent = (LAS unsigned*)(lds + 81920 + 256);
            LAS unsigned* lrank = lent + 1024;
            for (int i = tid; i < 1024 * 20; i += 512) { const int d = i / 20, j = i % 20; rw[i] = (j < 4) ? w_grp[(size_t)l * 4096 + d * 4 + j] : w_rtr[(size_t)l * 16384 + d * 16 + (j - 4)]; }
            if (tid < 33) lcnt[tid] = 0;
            __syncthreads();
            const int nrows = (l == 0) ? TT : T; int nloc = 0;
#pragma clang loop vectorize(disable) unroll(disable)
            for (int r = gw; r < nrows; r += NGW) {
                const bool isc = r >= T; const int bsel = isc ? 4 : (r >> 12);
                const float* src = isc ? xc + (size_t)(r - T) * 1024 : outp + (size_t)r * 1024;
                f32x4 v[4]; float ss = 0.f;
#pragma unroll
                for (int j = 0; j < 4; ++j) { v[j] = *(const f32x4*)(src + 4 * lane + 256 * j); ss += (v[j][0] * v[j][0] + v[j][1] * v[j][1]) + (v[j][2] * v[j][2] + v[j][3] * v[j][3]); }
                const float rstd = 1.0f / sqrtf(wave_sum(ss) * (1.f / 1024.f) + 1e-6f);
                const float* sh = modl + bsel * 6144 + 3 * 1024; const float* sc = sh + 1024; const float* gn = norm2_g + l * 1024;
                float lg[20];
#pragma unroll
                for (int j = 0; j < 20; ++j) lg[j] = 0.f;
#pragma unroll
                for (int j = 0; j < 4; ++j) {
                    const int c0 = 4 * lane + 256 * j; const f32x4 g = *(const f32x4*)(gn + c0), s1 = *(const f32x4*)(sc + c0), h1 = *(const f32x4*)(sh + c0);
                    const f32x4 y = (v[j] * rstd) * g * (s1 + 1.0f) + h1;
                    v2u o; o.x = pk2(y[0], y[1]); o.y = pk2(y[2], y[3]); *(v2u*)(hbuf + (size_t)r * 1024 + c0) = o;
#pragma unroll
                    for (int e = 0; e < 4; ++e) { const LAS float* wr_ = rw + (c0 + e) * 20;
#pragma unroll
                        for (int q5 = 0; q5 < 5; ++q5) { const f32x4 wv = *(const LAS f32x4*)(wr_ + 4 * q5); lg[4 * q5] += y[e] * wv[0]; lg[4 * q5 + 1] += y[e] * wv[1]; lg[4 * q5 + 2] += y[e] * wv[2]; lg[4 * q5 + 3] += y[e] * wv[3]; }
                        __builtin_amdgcn_sched_barrier(0); }
                }
#pragma unroll
                for (int j = 0; j < 20; ++j) lg[j] = wave_sum(lg[j]);
                float gl[4]; float gm = -1e30f;
#pragma unroll
                for (int j = 0; j < 4; ++j) { gl[j] = lg[j] + b_grp[l * 4 + j]; gm = fmaxf(gm, gl[j]); }
                float gs = 0.f; int gi = 0; float gb = -1e30f;
#pragma unroll
                for (int j = 0; j < 4; ++j) { const float e = expf(gl[j] - gm); gs += e; if (gl[j] > gb) { gb = gl[j]; gi = j; } }
                const float pg = expf(gb - gm) / gs;
                float el[4]; float em = -1e30f;
#pragma unroll
                for (int j = 0; j < 4; ++j) { float t_ = 0.f;
#pragma unroll
                    for (int g4 = 0; g4 < 4; ++g4) t_ = (gi == g4) ? (lg[4 + g4 * 4 + j] + b_rtr[l * 16 + g4 * 4 + j]) : t_;
                    el[j] = t_; em = fmaxf(em, t_); }
                float pe[4];
#pragma unroll
                for (int j = 0; j < 4; ++j) pe[j] = expf(el[j] - em);
                int i0 = 0; float b0 = -1.f;
#pragma unroll
                for (int j = 0; j < 4; ++j) if (pe[j] > b0) { b0 = pe[j]; i0 = j; }
                int i1 = 0; float b1 = -1.f;
#pragma unroll
                for (int j = 0; j < 4; ++j) if (j != i0 && pe[j] > b1) { b1 = pe[j]; i1 = j; }
                const float wsum = b0 + b1; const float w0 = pg * b0 / wsum, w1 = pg * b1 / wsum;
                if (lane == 0) {
                    wts[2 * r] = w0; wts[2 * r + 1] = w1;
                    ((int*)(ws + O_EID))[2 * r] = gi * 4 + i0; ((int*)(ws + O_EID))[2 * r + 1] = gi * 4 + i1;
                    const int e0 = gi * 4 + i0, e1 = gi * 4 + i1;
                    const int s0 = __hip_atomic_fetch_add((LAS int*)(lcnt + 16 + 16), 1, __ATOMIC_RELAXED, __HIP_MEMORY_SCOPE_WORKGROUP);
                    const int k0 = __hip_atomic_fetch_add((LAS int*)(lcnt + e0), 1, __ATOMIC_RELAXED, __HIP_MEMORY_SCOPE_WORKGROUP);
                    const int k1 = __hip_atomic_fetch_add((LAS int*)(lcnt + e1), 1, __ATOMIC_RELAXED, __HIP_MEMORY_SCOPE_WORKGROUP);
                    lent[2 * s0] = ((unsigned)(2 * r) << 4) | (unsigned)e0; lrank[2 * s0] = (unsigned)k0;
                    lent[2 * s0 + 1] = ((unsigned)(2 * r + 1) << 4) | (unsigned)e1; lrank[2 * s0 + 1] = (unsigned)k1;
                }
                ++nloc;
            }
            (void)nloc;
            __syncthreads();
            if (tid < 16) { const int c = lcnt[tid]; lcnt[16 + tid] = c ? (int)__hip_atomic_fetch_add((unsigned*)(ctl + CW_CNT + (l * 16 + tid) * 64), (unsigned)c, RLX_AGENT) : 0; }
            __syncthreads();
            const int ntot = 2 * lcnt[32];
            for (int i = tid; i < ntot; i += 512) { const unsigned en = lent[i]; const int e = en & 15; list[(size_t)e * TT + lcnt[16 + e] + lrank[i]] = en >> 4; }
            __syncthreads();
        }
        SEAM(P + 5);
        if (IN(P + 6) || IN(P + 7)) {
            KA_DECL
            __syncthreads();
            if (tid == 0) { int acc_ = 0; for (int e = 0; e < 16; ++e) { const int c = (int)__hip_atomic_load((unsigned*)(ctl + CW_CNT + (l * 16 + e) * 64), RLX_AGENT); ttab[e] = acc_; ttab[17 + e] = c; acc_ += (c + 255) >> 8; } ttab[16] = acc_; }
            __syncthreads();
        }
        if (DBG_NAIVE_MOE && IN(P + 6)) {
            KA_DECL
            const int nrows = (l == 0) ? TT : T; LAS float* hs = (LAS float*)lds; LAS float* as = hs + 1024;
            const int* eidg = (const int*)(ws + O_EID);
            LAS float* lgs = as + 512; LAS float* rt = lgs + 32;
            for (int r = vcu; r < nrows; r += G) {
                __syncthreads();
                for (int i = tid; i < 1024; i += 512) hs[i] = bf2f(hbuf[(size_t)r * 1024 + i]);
                __syncthreads();
                if (tid < 20) { float a = 0.f; for (int k = 0; k < 1024; ++k) a += hs[k] * ((tid < 4) ? w_grp[(size_t)l * 4096 + k * 4 + tid] : w_rtr[(size_t)l * 16384 + k * 16 + (tid - 4)]);
                    lgs[tid] = a + ((tid < 4) ? b_grp[l * 4 + tid] : b_rtr[l * 16 + tid - 4]); }
                __syncthreads();
                if (tid == 0) { int gi = 0; for (int j = 1; j < 4; ++j) if (lgs[j] > lgs[gi]) gi = j; float gs = 0.f; for (int j = 0; j < 4; ++j) gs += expf(lgs[j] - lgs[gi]); const float pg = 1.f / gs;
                    int i0 = 0; for (int j = 1; j < 4; ++j) if (lgs[4 + gi * 4 + j] > lgs[4 + gi * 4 + i0]) i0 = j; int i1 = -1; for (int j = 0; j < 4; ++j) if (j != i0 && (i1 < 0 || lgs[4 + gi * 4 + j] > lgs[4 + gi * 4 + i1])) i1 = j;
                    const float p0 = 1.f, p1 = expf(lgs[4 + gi * 4 + i1] - lgs[4 + gi * 4 + i0]); rt[0] = (float)(gi * 4 + i0); rt[1] = (float)(gi * 4 + i1); rt[2] = pg * p0 / (p0 + p1); rt[3] = pg * p1 / (p0 + p1); }
                __syncthreads();
                for (int sl = 0; sl < 2; ++sl) {
                    const int e = (DBG_NAIVE_ROUTE & 1) ? (int)rt[sl] : eidg[2 * r + sl]; const float w = (DBG_NAIVE_ROUTE & 2) ? rt[2 + sl] : wts[2 * r + sl];
                    __syncthreads();
                    const float* Wg = w_gate + (size_t)(l * 16 + e) * 1024 * 512 + tid; const float* Wu = w_up + (size_t)(l * 16 + e) * 1024 * 512 + tid;
                    float g = 0.f, u = 0.f;
#pragma unroll 8
                    for (int k = 0; k < 1024; ++k) { g += hs[k] * Wg[(size_t)k * 512]; u += hs[k] * Wu[(size_t)k * 512]; }
                    as[tid] = g / (1.f + expf(-g)) * u;
                    __syncthreads();
                    const float* Wd = w_down + (size_t)(l * 16 + e) * 512 * 1024 + tid;
                    float y0 = 0.f, y1 = 0.f;
#pragma unroll 8
                    for (int j = 0; j < 512; ++j) { y0 += as[j] * Wd[(size_t)j * 1024]; y1 += as[j] * Wd[(size_t)j * 1024 + 512]; }
                    y2[(size_t)(2 * r + sl) * 1024 + tid] = (bf16)f2bf(y0 * w); y2[(size_t)(2 * r + sl) * 1024 + 512 + tid] = (bf16)f2bf(y1 * w);
                }
            }
        }
        if (!DBG_NAIVE_MOE && IN(P + 6)) {
            KA_DECL
            SchedMoe S{G, vcu, 1024, ttab[16], 0, (const char*)wgu_t, list, ttab};
            EpiG3 E{act};
            pg8::gemm_phase<EpiG3, SchedMoe>(lds, (const char*)hbuf, 1024, S, E);
        }
        SEAM(P + 6);
        if (!DBG_NAIVE_MOE && IN(P + 7)) {
            KA_DECL
            SchedMoe S{G, vcu, 512, ttab[16], 1, (const char*)wd_t, list, ttab};
            EpiG4 E{y2, list, wts, ttab};
            pg8::gemm_phase<EpiG4, SchedMoe>(lds, (const char*)act, 512, S, E);
        }
        SEAM(P + 7);
    }

__global__ void __launch_bounds__(512, 2) fwd_kernel(Args args) {
    extern __shared__ __attribute__((aligned(16))) unsigned char lds_raw[];
    LAS unsigned char* lds = (LAS unsigned char*)lds_raw;
    const int tid = threadIdx.x, lane = tid & 63, wave = __builtin_amdgcn_readfirstlane(tid >> 6);
    const int G = gridDim.x; const int bx = blockIdx.x; const int vcu = (G % 8 == 0) ? (bx % 8) * (G / 8) + bx / 8 : bx;
    volatile LAS unsigned* MISC = (volatile LAS unsigned*)(lds + MISC_OFF);
    LAS float* trig = (LAS float*)(lds + TRIG_OFF);
    LAS int* ttab = (LAS int*)(lds + TILE_OFF);
    for (int u = tid; u < (LDS_BYTES - LDSCTL_OFF) / 4; u += 512) ((LAS unsigned*)(lds + LDSCTL_OFF))[u] = 0u;
    __syncthreads();
    if (tid < 64) { float s, c; sincospif((float)tid / 32.f, &s, &c); trig[tid] = c; trig[64 + tid] = s; }
    __syncthreads();
    XcdBarrier bar; bar.bar = nullptr; bar.x = 0; bar.st = nullptr;
    if (!MK_SPLIT) { KA_DECL bar = xcd_barrier_post((unsigned*)(ctl + CW_BAR), MISC + 8); }
    const int lo = args.ph_lo, hi = args.ph_hi;
    const int NGW = G * 8, NGT = G * 512;

    if (IN(0)) {
        KA_DECL
        {
            LAS float* sl = (LAS float*)lds;
            bool have = false;
            for (int it = vcu; it < 192; it += G) {
                if (!have) {
                    for (int i = tid; i < 5120; i += 512) { const int r = i >> 10, k = i & 1023; const float v = (r < 4) ? c_in[r * 1024 + k] : cctx_in[k]; sl[i] = v / (1.f + expf(-v)); }
                    __syncthreads(); have = true;
                }
                const int l = it / 96, cb = it % 96;
                const float* W = w_mod + (size_t)l * 1024 * 6144 + cb * 64 + lane;
                float a0 = 0.f, a1 = 0.f, a2 = 0.f, a3 = 0.f, a4 = 0.f; const int k0 = wave * 128;
#pragma unroll 8
                for (int k = 0; k < 128; ++k) { const float wv = W[(size_t)(k0 + k) * 6144]; const int kk = k0 + k;
                    a0 += sl[kk] * wv; a1 += sl[1024 + kk] * wv; a2 += sl[2048 + kk] * wv; a3 += sl[3072 + kk] * wv; a4 += sl[4096 + kk] * wv; }
                LAS float* part = sl + 5120;
                part[(wave * 5 + 0) * 64 + lane] = a0; part[(wave * 5 + 1) * 64 + lane] = a1; part[(wave * 5 + 2) * 64 + lane] = a2; part[(wave * 5 + 3) * 64 + lane] = a3; part[(wave * 5 + 4) * 64 + lane] = a4;
                __syncthreads();
                if (tid < 320) { const int r = tid >> 6, n = tid & 63; float s = b_mod[l * 6144 + cb * 64 + n];
#pragma unroll
                    for (int w = 0; w < 8; ++w) s += part[(w * 5 + r) * 64 + n];
                    modv[(size_t)(l * 5 + r) * 6144 + cb * 64 + n] = s; }
                __syncthreads();
            }
            __syncthreads();
        }
#pragma clang loop vectorize(disable) unroll(disable)
        for (int i = gt; i < 4096 * 32; i += NGT) {
            const int n = i >> 5, j = i & 31; const int jj = j & 15;
            const float inv = 1.0f / powf(10000.0f, (float)(2 * jj) / 32.0f);
            const float pos = (j < 16) ? (float)(n >> 6) : (float)(n & 63);
            const float ang = pos * inv; rope[i] = make_float2(cosf(ang), sinf(ang));
        }
#pragma clang loop vectorize(disable) unroll(disable)
        for (int i = gt; i < 4096; i += NGT) { float s, c; sincospif((float)i / 2048.f, &s, &c); twt[i] = make_float2(c, s); }
#pragma clang loop vectorize(disable) unroll(disable)
        for (int i = gt; i < 128 * 128; i += NGT) {
            const int m = i >> 7, k = i & 127; const int ri = m >> 6, k1 = m & 63, part = k >> 6, n1 = k & 63;
            float s, c; sincospif((float)((n1 * k1) & 63) / 32.f, &s, &c);
            float v; if (ri == 0) v = (part == 0) ? c : -s; else v = (part == 0) ? -s : -c;
            fma[i] = (bf16)f2bf(v);
        }
#pragma clang loop vectorize(disable) unroll(disable)
        for (int i = gt; i < 64 * 128; i += NGT) {
            const int k2 = i >> 7, k = i & 127; const int ri = k >> 6, n2 = k & 63;
            float s, c; sincospif((float)((n2 * k2) & 63) / 32.f, &s, &c);
            fmb[i] = (bf16)f2bf((ri == 0 ? c : s) * (1.f / 512.f));
        }
#pragma clang loop vectorize(disable) unroll(disable)
        for (int i = gt; i < 256 * 512; i += NGT) {
            const int kk = i >> 9, k = i & 511; const int part = k >> 8, n = k & 255;
            float s, c; sincospif((float)((n * kk) & 255) / 128.f, &s, &c);
            fmc[i] = (bf16)f2bf((part == 0 ? c : -s) * (1.f / 128.f));
        }
        {
            LAS float* scr = (LAS float*)(lds + wave * 16384);
            constexpr int I_A = 512, I_B = 384, I_C = 8192, I_D = 4096, I_E = 512, I_F = 128, I_L = I_A + I_B + I_C + I_D + I_E + I_F;
#pragma clang loop vectorize(disable) unroll(disable)
            for (int it0 = gw; it0 < 2 * I_L; it0 += NGW) {
                const int l = it0 / I_L; int it = it0 % I_L;
                bf16* p_win_t = (bf16*)(ws + O_WIN + l * SZ_WIN1); bf16* p_wout_t = (bf16*)(ws + O_WOUT + l * SZ_WOUT1);
                bf16* p_wgu_t = (bf16*)(ws + O_WGU + l * SZ_WGU1); bf16* p_wd_t = (bf16*)(ws + O_WD + l * SZ_WD1);
                if (it < I_A) { const int kb = it >> 5, nb = it & 31; tr_block(w_in + (size_t)l * 1024 * 1280 + (size_t)kb * 64 * 1280 + nb * 32, 1280, p_win_t + (size_t)nb * 32 * 1024 + kb * 64, 1024, scr, lane); continue; } it -= I_A;
                if (it < I_B) { const int kb = 4 + (it >> 5), nb = it & 31; tr_block(w_out + (size_t)l * 1024 * 1024 + (size_t)kb * 64 * 1024 + nb * 32, 1024, p_wout_t + (size_t)nb * 32 * 1024 + kb * 64, 1024, scr, lane); continue; } it -= I_B;
                if (it < I_C) { const int up = it >> 12, r = it & 4095, e = r >> 8, kb = (r >> 4) & 15, nb = r & 15; const int n0 = nb * 32;
                    const float* src = (up ? w_up : w_gate) + ((size_t)(l * 16 + e) * 1024 + kb * 64) * 512 + n0;
                    const int drow = (n0 >> 7) * 256 + up * 128 + (n0 & 127);
                    tr_block(src, 512, p_wgu_t + ((size_t)e * 1024 + drow) * 1024 + kb * 64, 1024, scr, lane); continue; } it -= I_C;
                if (it < I_D) { const int e = it >> 8, kb = (it >> 5) & 7, nb = it & 31;
                    tr_block(w_down + ((size_t)(l * 16 + e) * 512 + kb * 64) * 1024 + nb * 32, 1024, p_wd_t + ((size_t)e * 1024 + nb * 32) * 512 + kb * 64, 512, scr, lane); continue; } it -= I_D;
                if (it < I_E) {
                    const int g = it >> 7, which = (it >> 6) & 1, jb = it & 63;
                    const float* Wg = four_w + (size_t)(l * 4 + g) * 4096;
                    float wreg[64];
#pragma unroll
                    for (int m = 0; m < 64; ++m) wreg[m] = Wg[m * 64 + lane];
                    const LAS float* tb = trig + which * 64;
#pragma unroll 1
                    for (int c = 0; c < 64; ++c) { float a = 0.f;
#pragma unroll
                        for (int m = 0; m < 64; ++m) a += tb[(m * c) & 63] * wreg[m];
                        scr[c * 64 + lane] = a; }
                    LDS_WAIT(); asm volatile("" ::: "memory");
                    const float* wi = w_in + (size_t)l * 1024 * 1280 + (size_t)(jb * 16) * 1280 + 1024 + g * 64;
                    bf16* d = p_win_t + (size_t)(1024 + which * 256 + g * 64 + lane) * 1024 + jb * 16;
#pragma unroll 1
                    for (int jp = 0; jp < 8; ++jp) { float o0 = 0.f, o1 = 0.f;
#pragma unroll 4
                        for (int c = 0; c < 64; ++c) { const float av = scr[c * 64 + lane]; o0 += wi[(size_t)(2 * jp) * 1280 + c] * av; o1 += wi[(size_t)(2 * jp + 1) * 1280 + c] * av; }
                        *(unsigned*)(d + 2 * jp) = pk2(o0, o1); }
                    LDS_WAIT(); asm volatile("" ::: "memory");
                    continue; } it -= I_E;
                {
                    const int g = it >> 5, nb = it & 31, n0 = nb * 32;
                    for (int i = lane; i < 2048; i += 64) { const int d = i >> 5, n = i & 31; scr[i] = pool_scale[l * 256 + g * 64 + d] * w_out[(size_t)l * 1024 * 1024 + (size_t)(g * 64 + d) * 1024 + n0 + n]; }
                    LDS_WAIT(); asm volatile("" ::: "memory");
                    const int n = lane & 31, ch = lane >> 5;
                    const float* pw = pool_w + (size_t)(l * 4 + g) * 4096 + (size_t)(ch * 32) * 64;
                    bf16* dd = p_wout_t + (size_t)(n0 + n) * 1024 + g * 64 + ch * 32;
#pragma unroll 1
                    for (int cp = 0; cp < 16; ++cp) { float o0 = 0.f, o1 = 0.f;
#pragma unroll 4
                        for (int d = 0; d < 64; ++d) { const float sv = scr[d * 32 + n]; o0 += pw[(2 * cp) * 64 + d] * sv; o1 += pw[(2 * cp + 1) * 64 + d] * sv; }
                        *(unsigned*)(dd + 2 * cp) = pk2(o0, o1); }
                    LDS_WAIT(); asm volatile("" ::: "memory");
                }
            }
        }
    }
    SEAM(0);

    layer_body<0>(lds, G, vcu, bar, lo, hi);
    layer_body<1>(lds, G, vcu, bar, lo, hi);
    if (IN(17)) {
        KA_DECL
        const float* modp = modv + (size_t)5 * 6144;
#pragma clang loop vectorize(disable) unroll(disable)
        for (int r = gw; r < T; r += NGW) {
            const float* g2 = modp + (r >> 12) * 6144 + 5 * 1024; float* dst = outp + (size_t)r * 1024;
#pragma unroll
            for (int j = 0; j < 4; ++j) {
                const int c0 = 4 * lane + 256 * j; f32x4 v = *(const f32x4*)(dst + c0);
                const v2u ya = *(const v2u*)(y2 + (size_t)(2 * r) * 1024 + c0), yb = *(const v2u*)(y2 + (size_t)(2 * r + 1) * 1024 + c0);
                const f32x4 gv = *(const f32x4*)(g2 + c0);
                f32x4 yy; yy[0] = bflo(ya.x) + bflo(yb.x); yy[1] = bfhi(ya.x) + bfhi(yb.x); yy[2] = bflo(ya.y) + bflo(yb.y); yy[3] = bfhi(ya.y) + bfhi(yb.y);
                if (DBG_NO_MOE) yy = (f32x4){0.f, 0.f, 0.f, 0.f};
                *(f32x4*)(dst + c0) = v + gv * yy;
            }
        }
    }
#undef IN
#undef SEAM
}

#undef KA_DECL
#undef ws
#undef ctl
#undef x_in
#undef c_in
#undef ctx_in
#undef cctx_in
#undef w_mod
#undef b_mod
#undef norm1_g
#undef w_in
#undef q_norm_g
#undef k_norm_g
#undef attn_sink
#undef pool_w
#undef pool_scale
#undef four_w
#undef w_out
#undef norm2_g
#undef w_grp
#undef b_grp
#undef w_rtr
#undef b_rtr
#undef w_gate
#undef w_up
#undef w_down
#undef outp
#undef modv
#undef rope
#undef twt
#undef fma
#undef fmb
#undef fmc
#undef hbuf
#undef kall
#undef vall
#undef xc
#undef list
#undef wts
#undef act
#undef t2
#undef mrg
#undef qb
#undef pu
#undef zb
#undef y2
#undef modl
#undef win_t
#undef wout_t
#undef wgu_t
#undef wd_t
extern "C" void kernel_launch(void* const* d_in, const int* in_sizes, int n_in, void* d_out, int out_size, void* d_ws, size_t ws_size, hipStream_t stream) {
    static int grid = 0;
    if (grid == 0) {
        if (n_in != 23 || out_size != T * DM || ws_size < WS_END) { fprintf(stderr, "kernel_launch: unexpected shapes (n_in %d out %d ws %zu need %zu)\n", n_in, out_size, ws_size, (size_t)WS_END); grid = -1; return; }
        int dev = 0, cus = 0;
        if (hipGetDevice(&dev) != hipSuccess || hipDeviceGetAttribute(&cus, hipDeviceAttributeMultiprocessorCount, dev) != hipSuccess) { grid = -1; return; }
        if (hipFuncSetAttribute((const void*)fwd_kernel, hipFuncAttributeMaxDynamicSharedMemorySize, LDS_BYTES) != hipSuccess) { fprintf(stderr, "kernel_launch: hipFuncSetAttribute failed\n"); grid = -1; return; }
        (void)hipGetLastError();
        grid = cus;
    }
    if (grid < 0) return;
    (void)hipMemsetAsync((char*)d_ws + O_CTL, 0, SZ_CTL, stream);
    Args a{};
    for (int i = 0; i < 23; ++i) a.in[i] = (const float*)d_in[i];
    a.out = (float*)d_out; a.ws = (unsigned char*)d_ws;
#if MK_SPLIT
    for (int p = 0; p < NPHASE; ++p) { a.ph_lo = p; a.ph_hi = p + 1; hipLaunchKernelGGL(fwd_kernel, dim3(grid), dim3(512), LDS_BYTES, stream, a); }
#else
    a.ph_lo = 0; a.ph_hi = NPHASE;
    hipLaunchKernelGGL(fwd_kernel, dim3(grid), dim3(512), LDS_BYTES, stream, a);
#endif
}
```

```cpp
#include <hip/hip_runtime.h>
#include <cstdio>
#include <cstdint>

#define DBG_NO_FOUR 0
#define DBG_NO_POOL 0
#define DBG_NO_ATT 0
#define DBG_NO_MOE 0
#define DBG_MOE_SCALE 1.0f
#define DBG_NAIVE_MOE 0
#define REP_MASK 0x0
#define DBG_NAIVE_ROUTE 0
#define LAS __attribute__((address_space(3)))
#define GAS __attribute__((address_space(1)))
typedef unsigned short bf16;
typedef short bf16x8 __attribute__((ext_vector_type(8)));
typedef float f32x4 __attribute__((ext_vector_type(4)));
typedef float f32x16 __attribute__((ext_vector_type(16)));
typedef unsigned v4u __attribute__((ext_vector_type(4)));
typedef unsigned v2u __attribute__((ext_vector_type(2)));
typedef GAS unsigned gu32;

#ifndef MK_SPLIT
#define MK_SPLIT 0
#endif

constexpr int NB = 4, NSEQ = 4096, DM = 1024, LCTX = 256, DEPTH = 2;
constexpr int T = NB * NSEQ, TC = NB * LCTX, TT = T + TC;
constexpr int KVROWS = LCTX + NSEQ;
constexpr int NEXP = 16, DEXP = 512;
constexpr int NPHASE = 18;
constexpr int MAXTILES = 152;
constexpr float QSCALE = 0.125f * 1.4426950408889634f;
constexpr float LOG2E = 1.4426950408889634f;

constexpr size_t al256(size_t x) { return (x + 255) & ~(size_t)255; }
constexpr size_t O_CTL = 0, SZ_CTL = 1u << 20;
constexpr size_t O_MOD = O_CTL + SZ_CTL, SZ_MOD = (size_t)2 * 5 * 6144 * 4;
constexpr size_t O_ROPE = al256(O_MOD + SZ_MOD), SZ_ROPE = (size_t)4096 * 32 * 8;
constexpr size_t O_TW = al256(O_ROPE + SZ_ROPE), SZ_TW = 4096 * 8;
constexpr size_t O_FMA = al256(O_TW + SZ_TW), SZ_FMA = 128 * 128 * 2;
constexpr size_t O_FMB = al256(O_FMA + SZ_FMA), SZ_FMB = 64 * 128 * 2;
constexpr size_t O_FMC = al256(O_FMB + SZ_FMB), SZ_FMC = 256 * 512 * 2;
constexpr size_t O_WIN = al256(O_FMC + SZ_FMC), SZ_WIN1 = (size_t)1536 * 1024 * 2;
constexpr size_t O_WOUT = al256(O_WIN + 2 * SZ_WIN1), SZ_WOUT1 = (size_t)1024 * 1024 * 2;
constexpr size_t O_WGU = al256(O_WOUT + 2 * SZ_WOUT1), SZ_WGU1 = (size_t)16 * 1024 * 1024 * 2;
constexpr size_t O_WD = al256(O_WGU + 2 * SZ_WGU1), SZ_WD1 = (size_t)16 * 1024 * 512 * 2;
constexpr size_t O_H = al256(O_WD + 2 * SZ_WD1), SZ_H = (size_t)TT * 1024 * 2;
constexpr size_t O_KALL = al256(O_H + SZ_H), SZ_KV = (size_t)NB * KVROWS * 128 * 2;
constexpr size_t O_VALL = al256(O_KALL + SZ_KV);
constexpr size_t O_XC = al256(O_VALL + SZ_KV), SZ_XC = (size_t)TC * 1024 * 4;
constexpr size_t O_LIST = al256(O_XC + SZ_XC), SZ_LIST = (size_t)NEXP * TT * 4;
constexpr size_t O_WTS = al256(O_LIST + SZ_LIST), SZ_WTS = (size_t)TT * 2 * 4;
constexpr size_t O_EID = al256(O_WTS + SZ_WTS), SZ_EID = (size_t)TT * 2 * 4;
constexpr size_t O_ACT = al256(O_EID + SZ_EID), SZ_ACT = (size_t)MAXTILES * 256 * 512 * 2;
constexpr size_t O_T2 = O_ACT, SZ_T2 = (size_t)NB * 64 * 64 * 2 * 256 * 2;
constexpr size_t O_MRG = al256(O_ACT + SZ_ACT), SZ_MRG = (size_t)TT * 1024 * 2;
constexpr size_t O_Q = al256(O_MRG + SZ_MRG), SZ_Q = (size_t)TT * 512 * 2;
constexpr size_t O_PU = al256(O_Q + SZ_Q), SZ_PU = (size_t)TT * 256 * 2;
constexpr size_t O_Z = al256(O_PU + SZ_PU), SZ_Z = (size_t)TT * 512 * 2;
constexpr size_t O_Y2 = O_MRG, SZ_Y2 = (size_t)TT * 2 * 1024 * 2;
constexpr size_t WS_END = al256(O_Z + SZ_Z);
static_assert(SZ_T2 <= SZ_ACT, "T2 overlay");
static_assert(O_Y2 + SZ_Y2 <= WS_END, "y2 overlay");

constexpr int CW_TMO = 0;
constexpr int CW_BAR = 4096;
constexpr int CW_CNT = 16384;

constexpr int RING_BYTES = 131072;
constexpr int LDSCTL_OFF = RING_BYTES, MISC_OFF = LDSCTL_OFF + 320;
constexpr int TRIG_OFF = LDSCTL_OFF + 1024;
constexpr int TILE_OFF = LDSCTL_OFF + 2048;
constexpr int LDS_BYTES = 147456;

#define RLX_AGENT __ATOMIC_RELAXED, __HIP_MEMORY_SCOPE_AGENT
#define LDS_WAIT() asm volatile("s_waitcnt lgkmcnt(0)" ::: "memory")
#define VM_WAIT() asm volatile("s_waitcnt vmcnt(0)" ::: "memory")

__device__ __forceinline__ unsigned f2bf(float f) { unsigned u = __builtin_bit_cast(unsigned, f); return (u + 0x7fffu + ((u >> 16) & 1u)) >> 16; }
__device__ __forceinline__ unsigned pk2(float lo, float hi) { return f2bf(lo) | (f2bf(hi) << 16); }
__device__ __forceinline__ float bflo(unsigned w) { return __builtin_bit_cast(float, w << 16); }
__device__ __forceinline__ float bfhi(unsigned w) { return __builtin_bit_cast(float, w & 0xffff0000u); }
__device__ __forceinline__ float bf2f(bf16 h) { return __builtin_bit_cast(float, (unsigned)h << 16); }
template <int KX> __device__ __forceinline__ float swz_xor(float v) { return __builtin_bit_cast(float, __builtin_amdgcn_ds_swizzle(__builtin_bit_cast(int, v), (KX << 10) | 0x1f)); }
__device__ __forceinline__ float wave_sum(float v) {
    v += swz_xor<1>(v); v += swz_xor<2>(v); v += swz_xor<4>(v); v += swz_xor<8>(v); v += swz_xor<16>(v);
    const int bits_ = __builtin_bit_cast(int, v);
    return __builtin_bit_cast(float, __builtin_amdgcn_readlane(bits_, 0)) + __builtin_bit_cast(float, __builtin_amdgcn_readlane(bits_, 32));
}

#define XB_TMO      128
#define XB_XCNT(j)  (256  + 64 * (j))
#define XB_XSUB(j)  (1280 + 64 * (j))
#define XB_XGEN(j)  (2304 + 64 * (j))
#define XB_TOP      3328
#define XB_TOPGEN   3392
#define XCD_BAR_WORDS 3456
#define XB_SPIN_CAP (1u << 18)
__device__ __forceinline__ unsigned xb_ld(unsigned* p)              { return __hip_atomic_load(p, __ATOMIC_RELAXED, __HIP_MEMORY_SCOPE_AGENT); }
__device__ __forceinline__ unsigned xb_add(unsigned* p, unsigned v) { return __hip_atomic_fetch_add(p, v, __ATOMIC_RELAXED, __HIP_MEMORY_SCOPE_AGENT); }
__device__ __forceinline__ unsigned xb_xcc_id() { return (unsigned)__builtin_amdgcn_s_getreg((3 << 11) | 20) & 0xFu; }
#define XB_SPIN(cond, bar) do { unsigned _sp = 0; while (cond) { __builtin_amdgcn_s_sleep(1); \
    if ((++_sp & 255u) == 0u) { if (xb_ld(&(bar)[XB_TMO])) break; if (_sp > XB_SPIN_CAP) { atomicAdd(&(bar)[XB_TMO], 1u); break; } } } } while (0)
struct XcdBarrier { unsigned* bar; unsigned x; volatile LAS unsigned* st; };
__device__ __forceinline__ XcdBarrier xcd_barrier_post(unsigned* bar, volatile LAS unsigned* st) {
    XcdBarrier b; b.bar = bar; b.x = xb_xcc_id(); b.st = st;
    if (threadIdx.x == 0) (void)xb_add(&bar[XB_XCNT(b.x)], 1u);
    return b;
}
__device__ __forceinline__ void xcd_barrier_complete(unsigned* bar, unsigned x, unsigned& nloc, unsigned& nx) {
    const unsigned G = gridDim.x * gridDim.y * gridDim.z;
    unsigned sum, cnt, mine, sp = 0u;
    for (;;) {
        sum = 0u; cnt = 0u; mine = 0u;
#pragma unroll
        for (unsigned j = 0; j < 16; ++j) { const unsigned c = xb_ld(&bar[XB_XCNT(j)]); sum += c; cnt += (c > 0u) ? 1u : 0u; mine = (j == x) ? c : mine; }
        if (sum == G) break;
        __builtin_amdgcn_s_sleep(1);
        if ((++sp & 255u) == 0u) { if (xb_ld(&bar[XB_TMO])) break; if (sp > XB_SPIN_CAP) { atomicAdd(&bar[XB_TMO], 1u); break; } }
    }
    nloc = mine > 0u ? mine : 1u; nx = cnt > 0u ? cnt : 1u;
}
__device__ __forceinline__ void xcd_barrier(const XcdBarrier& b) {
    asm volatile("s_waitcnt vmcnt(0)" ::: "memory");
    __syncthreads();
    if (threadIdx.x == 0) {
        unsigned* bar = b.bar;
        __builtin_amdgcn_s_waitcnt(0);
        unsigned nloc = b.st[0], nx = b.st[1];
        if (nloc == 0u) { xcd_barrier_complete(bar, b.x, nloc, nx); b.st[0] = nloc; b.st[1] = nx; }
        const unsigned old = xb_add(&bar[XB_XSUB(b.x)], 1u);
        const unsigned gen = old / nloc;
        if (old + 1u == (gen + 1u) * nloc) {
            __builtin_amdgcn_fence(__ATOMIC_RELEASE, "agent");
            asm volatile("s_waitcnt vmcnt(0)" ::: "memory");
            const unsigned og = xb_add(&bar[XB_TOP], 1u);
            const unsigned tg = og / nx;
            if (og + 1u == (tg + 1u) * nx) xb_add(&bar[XB_TOPGEN], 1u);
            else XB_SPIN(xb_ld(&bar[XB_TOPGEN]) == tg, bar);
            __builtin_amdgcn_fence(__ATOMIC_ACQUIRE, "agent");
            xb_add(&bar[XB_XGEN(b.x)], 1u);
            asm volatile("s_waitcnt vmcnt(0)" ::: "memory");
        } else {
            XB_SPIN(xb_ld(&bar[XB_XGEN(b.x)]) == gen, bar);
            __builtin_amdgcn_fence(__ATOMIC_ACQUIRE, "agent");
            asm volatile("s_waitcnt vmcnt(0)" ::: "memory");
        }
    }
    __syncthreads();
}

namespace pg8 {
constexpr int BM = 256, BK = 64, HALF = 128, HTB = HALF * BK * 2;
__host__ __device__ __forceinline__ int lds_byte(int r, int c) { const int st = (r >> 4) * 2 + (c >> 5), rr = r & 15, cc = c & 31, ob = rr * 64 + cc * 2; return st * 1024 + (ob ^ (((ob >> 9) & 1) << 5)); }
__host__ __device__ __forceinline__ void stage_rc(int b, int& R, int& C) { const int st = b / 1024, sb = b % 1024, swz = sb ^ (((sb >> 9) & 1) << 5); R = (st >> 1) * 16 + swz / 64; C = (st & 1) * 32 + (swz % 64) / 2; }
__host__ __device__ __forceinline__ int perm32(int rho) { const int n = rho >> 4, i = rho & 15; return 8 * (i >> 2) + 4 * n + (i & 3); }

struct Unit { int pm, pn, e, cnt; };

template <class Epi, class Sched>
__device__ __forceinline__ void gemm_phase(LAS unsigned char* lds, const char* Abase, const int K, const Sched& S, const Epi& E) {
    int tid = threadIdx.x; asm volatile("" : "+v"(tid));
    const int wid = __builtin_amdgcn_readfirstlane(tid >> 6), lane = tid & 63, wr = wid >> 2, wc = wid & 3, fr = lane & 15, fq = lane >> 4;
    const int nt = K / BK;
    int RA[2], CA[2]; unsigned voffB[2];
#pragma unroll
    for (int i = 0; i < 2; ++i) { int R, C; stage_rc(tid * 16 + i * 8192, R, C); RA[i] = R; CA[i] = C; const int Rb = Epi::PERM ? ((R & ~31) + perm32(R & 31)) : R; voffB[i] = (unsigned)(Rb * K + C) * 2u; }
    const size_t kstep = (size_t)(BK * 2);
    const size_t hstep = (size_t)HALF * K * 2;
    const unsigned ldsw = (unsigned)wid * 1024u;
    const int aoff = lds_byte(wr * 64 + fr, fq * 8), boff = lds_byte(wc * 32 + fr, fq * 8);
#define PG8_SA(b, h) (((b) * 2 + (h)) * HTB)
#define PG8_SB(b, h) ((4 + (b) * 2 + (h)) * HTB)
#define PG8_STAGEB(bufoff, gbase) do { _Pragma("unroll") for (int _i = 0; _i < 2; ++_i) \
        __builtin_amdgcn_global_load_lds((const unsigned*)((const char*)(gbase) + voffB[_i]), (LAS unsigned*)(lds + (bufoff) + ldsw + _i * 8192), 16, 0, 0); } while (0)
#define PG8_STAGEA(bufoff, gbase, o0, o1) do { \
        __builtin_amdgcn_global_load_lds((const unsigned*)((const char*)(gbase) + (o0)), (LAS unsigned*)(lds + (bufoff) + ldsw), 16, 0, 0); \
        __builtin_amdgcn_global_load_lds((const unsigned*)((const char*)(gbase) + (o1)), (LAS unsigned*)(lds + (bufoff) + ldsw + 8192), 16, 0, 0); } while (0)
#define PG8_LDA(dst, b, h) do { _Pragma("unroll") for (int m = 0; m < 4; ++m) _Pragma("unroll") for (int k = 0; k < 2; ++k) dst[m][k] = *(const LAS bf16x8*)(lds + PG8_SA(b, h) + aoff + m * 2048 + k * 1024); } while (0)
#define PG8_LDB(dst, b, h) do { _Pragma("unroll") for (int n = 0; n < 2; ++n) _Pragma("unroll") for (int k = 0; k < 2; ++k) dst[n][k] = *(const LAS bf16x8*)(lds + PG8_SB(b, h) + boff + n * 2048 + k * 1024); } while (0)
#define PG8_MMA(ai, bj, At, Bt) do { __builtin_amdgcn_s_setprio(1); _Pragma("unroll") for (int m = 0; m < 4; ++m) _Pragma("unroll") for (int n = 0; n < 2; ++n) _Pragma("unroll") for (int k = 0; k < 2; ++k) \
        acc[ai][bj][m][n] = __builtin_amdgcn_mfma_f32_16x16x32_bf16(Bt[n][k], At[m][k], acc[ai][bj][m][n], 0, 0, 0); __builtin_amdgcn_s_setprio(0); } while (0)
#define PG8_WAIT_V(n) asm volatile("s_waitcnt vmcnt(" #n ")" ::: "memory")
#define PG8_WAIT_L(n) asm volatile("s_waitcnt lgkmcnt(" #n ")" ::: "memory")
#define PG8_BAR __builtin_amdgcn_s_barrier()
#define PG8_SCHED __builtin_amdgcn_sched_barrier(0)
    Unit cur, nxt; int ui = 0;
    if (!S.next(0, cur)) return;
    f32x4 acc[2][2][4][2];
#pragma unroll
    for (int a = 0; a < 2; ++a)
#pragma unroll
        for (int b = 0; b < 2; ++b)
#pragma unroll
            for (int m = 0; m < 4; ++m)
#pragma unroll
                for (int n = 0; n < 2; ++n) acc[a][b][m][n] = (f32x4){0.f, 0.f, 0.f, 0.f};
    bf16x8 At[4][2], B0[2][2], B1[2][2];
    unsigned oc00, oc01, oc10, oc11, on00, on01, on10, on11;
    oc00 = S.a_off(cur, RA[0], CA[0]); oc01 = S.a_off(cur, RA[1], CA[1]); oc10 = S.a_off(cur, HALF + RA[0], CA[0]); oc11 = S.a_off(cur, HALF + RA[1], CA[1]);
    const char* cB = S.b_ptr(cur);
    PG8_STAGEB(PG8_SB(0, 0), cB); PG8_STAGEB(PG8_SB(0, 1), cB + hstep); PG8_STAGEA(PG8_SA(0, 0), Abase, oc00, oc01); PG8_STAGEA(PG8_SA(0, 1), Abase, oc10, oc11);
    if (wr == 1) PG8_BAR;
    PG8_WAIT_V(2); PG8_BAR;
    PG8_STAGEB(PG8_SB(1, 0), cB + kstep); PG8_STAGEA(PG8_SA(1, 0), Abase + kstep, oc00, oc01); PG8_STAGEB(PG8_SB(1, 1), cB + hstep + kstep);
    PG8_WAIT_V(6); PG8_BAR;
    for (;;) {
        const bool has_next = S.next(ui + 1, nxt);
        const char* nB = cB;
        on00 = oc00; on01 = oc01; on10 = oc10; on11 = oc11;
        if (has_next) { nB = S.b_ptr(nxt); on00 = S.a_off(nxt, RA[0], CA[0]); on01 = S.a_off(nxt, RA[1], CA[1]); on10 = S.a_off(nxt, HALF + RA[0], CA[0]); on11 = S.a_off(nxt, HALF + RA[1], CA[1]); }
        for (int t = 0; t < nt; t += 2) {
            const bool last = (t == nt - 2);
            const char* a1 = Abase + (size_t)(t + 1) * kstep;
            const char* a2 = last ? Abase : Abase + (size_t)(t + 2) * kstep; const char* b2 = last ? nB : cB + (size_t)(t + 2) * kstep;
            const char* a3 = a2 + kstep; const char* b3 = b2 + kstep;
            const unsigned x00 = last ? on00 : oc00, x01 = last ? on01 : oc01, x10 = last ? on10 : oc10, x11 = last ? on11 : oc11;
            PG8_LDB(B0, 0, 0); PG8_LDB(B1, 0, 1); PG8_SCHED; PG8_LDA(At, 0, 0); PG8_STAGEA(PG8_SA(1, 1), a1, oc10, oc11);
            PG8_WAIT_V(8); PG8_WAIT_L(0); PG8_BAR; PG8_MMA(0, 0, At, B0); PG8_MMA(0, 1, At, B1); PG8_BAR; PG8_SCHED;
            PG8_LDA(At, 0, 1); PG8_STAGEB(PG8_SB(0, 0), b2); PG8_STAGEB(PG8_SB(0, 1), b2 + hstep); PG8_STAGEA(PG8_SA(0, 0), a2, x00, x01);
            PG8_WAIT_V(8); PG8_WAIT_L(0); PG8_BAR; PG8_MMA(1, 0, At, B0); PG8_MMA(1, 1, At, B1); PG8_BAR; PG8_SCHED;
            PG8_LDB(B0, 1, 0); PG8_LDB(B1, 1, 1); PG8_SCHED; PG8_LDA(At, 1, 0); PG8_STAGEA(PG8_SA(0, 1), a2, x10, x11);
            PG8_WAIT_V(8); PG8_WAIT_L(0); PG8_BAR; PG8_MMA(0, 0, At, B0); PG8_MMA(0, 1, At, B1); PG8_BAR; PG8_SCHED;
            PG8_LDA(At, 1, 1); PG8_STAGEB(PG8_SB(1, 0), b3); PG8_STAGEB(PG8_SB(1, 1), b3 + hstep); PG8_STAGEA(PG8_SA(1, 0), a3, x00, x01);
            PG8_WAIT_V(8); PG8_WAIT_L(0); PG8_BAR; PG8_MMA(1, 0, At, B0); PG8_MMA(1, 1, At, B1); PG8_BAR; PG8_SCHED;
        }
        if (wr == 0) PG8_BAR;
        E(acc, cur, wr, wc, fr, fq);
        if (!has_next) break;
#pragma unroll
        for (int a = 0; a < 2; ++a)
#pragma unroll
            for (int b = 0; b < 2; ++b)
#pragma unroll
                for (int m = 0; m < 4; ++m)
#pragma unroll
                    for (int n = 0; n < 2; ++n) acc[a][b][m][n] = (f32x4){0.f, 0.f, 0.f, 0.f};
        cur = nxt; cB = nB; oc00 = on00; oc01 = on01; oc10 = on10; oc11 = on11; ++ui;
        if (wr == 1) PG8_BAR;
    }
    PG8_WAIT_V(0);
    PG8_BAR;
#undef PG8_SA
#undef PG8_SB
#undef PG8_STAGEA
#undef PG8_STAGEB
#undef PG8_LDA
#undef PG8_LDB
#undef PG8_MMA
#undef PG8_WAIT_V
#undef PG8_WAIT_L
#undef PG8_BAR
#undef PG8_SCHED
}
}

__device__ __forceinline__ int krow_of(int r) {
    if (r < T) return (r >> 12) * KVROWS + LCTX + (r & 4095);
    const int rc = r - T; return (rc >> 8) * KVROWS + (rc & 255);
}
struct SchedPlain {
    int nM, nN, G, vcu, K; const char* B;
    __device__ __forceinline__ bool next(int i, pg8::Unit& u) const { const int L = i * G + vcu; if (L >= nM * nN) return false; u.pm = L / nN; u.pn = L % nN; u.e = 0; u.cnt = 256; return true; }
    __device__ __forceinline__ unsigned a_off(const pg8::Unit& u, int row, int col) const { return (unsigned)((u.pm * 256 + row) * K + col) * 2u; }
    __device__ __forceinline__ const char* b_ptr(const pg8::Unit& u) const { return B + (size_t)u.pn * 256 * K * 2; }
};
struct EpiG1 {
    static constexpr bool PERM = true;
    bf16 *pu, *q, *kall, *vall, *z;
    __device__ __forceinline__ void operator()(const f32x4 (&acc)[2][2][4][2], const pg8::Unit& u, int wr, int wc, int fr, int fq) const {
        const int row0 = u.pm * 256 + wr * 64 + fr, c8 = wc * 32 + 8 * fq;
#pragma unroll
        for (int ai = 0; ai < 2; ++ai)
#pragma unroll
            for (int m = 0; m < 4; ++m) {
                const int row = row0 + ai * 128 + m * 16;
#pragma unroll
                for (int bj = 0; bj < 2; ++bj) {
                    const f32x4 v0 = acc[ai][bj][m][0], v1 = acc[ai][bj][m][1];
                    v4u w; w.x = pk2(v0[0], v0[1]); w.y = pk2(v0[2], v0[3]); w.z = pk2(v1[0], v1[1]); w.w = pk2(v1[2], v1[3]);
                    bf16* dst;
                    if (u.pn == 0) dst = pu + (size_t)row * 256 + bj * 128 + c8;
                    else if (u.pn <= 2) dst = q + (size_t)row * 512 + (u.pn - 1) * 256 + bj * 128 + c8;
                    else if (u.pn == 3) dst = (bj == 0 ? kall : vall) + (size_t)krow_of(row) * 128 + c8;
                    else dst = z + (size_t)row * 512 + (u.pn - 4) * 256 + bj * 128 + c8;
                    *(v4u*)dst = w;
                }
            }
    }
};
struct EpiG2 {
    static constexpr bool PERM = false;
    const float* xin; const float* cin; float* xout; float* cout; const float* mod;
    __device__ __forceinline__ void operator()(const f32x4 (&acc)[2][2][4][2], const pg8::Unit& u, int wr, int wc, int fr, int fq) const {
        const int rt0 = u.pm * 256; const bool isc = rt0 >= T;
        const int bsel = isc ? 4 : (rt0 >> 12);
        const float* g1 = mod + bsel * 6144 + 2048;
        const float* base = isc ? cin - (size_t)T * 1024 : xin; float* out = isc ? cout - (size_t)T * 1024 : xout;
        const int row0 = rt0 + wr * 64 + fr, col0 = u.pn * 256 + wc * 32 + 4 * fq;
#pragma unroll
        for (int bj = 0; bj < 2; ++bj)
#pragma unroll
            for (int n = 0; n < 2; ++n) {
                const int col = col0 + bj * 128 + n * 16; const f32x4 gv = *(const f32x4*)(g1 + col);
#pragma unroll
                for (int ai = 0; ai < 2; ++ai)
#pragma unroll
                    for (int m = 0; m < 4; ++m) { const size_t off = (size_t)(row0 + ai * 128 + m * 16) * 1024 + col; const f32x4 bs = *(const f32x4*)(base + off); *(f32x4*)(out + off) = bs + gv * acc[ai][bj][m][n]; }
            }
    }
};
struct SchedMoe {
    int G, vcu, K, ntile, mode;
    const char* B; const unsigned* list; const LAS int* tt;
    __device__ __forceinline__ bool next(int i, pg8::Unit& u) const {
        const int L = i * G + vcu; if (L >= ntile * 4) return false;
        const int tau = L >> 2; u.pn = L & 3; u.pm = tau; int e = 0;
#pragma unroll
        for (int k = 1; k < 16; ++k) e += (tt[k] <= tau) ? 1 : 0;
        u.e = e; const int r0 = (tau - tt[e]) * 256; const int c = tt[17 + e] - r0; u.cnt = c < 256 ? c : 256; return true;
    }
    __device__ __forceinline__ unsigned a_off(const pg8::Unit& u, int row, int col) const {
        if (mode == 1) return (unsigned)((u.pm * 256 + row) * K + col) * 2u;
        const int r0 = (u.pm - tt[u.e]) * 256; unsigned tok = 0;
        if (row < u.cnt) tok = list[(size_t)u.e * TT + r0 + row] >> 1;
        return (tok * (unsigned)K + (unsigned)col) * 2u;
    }
    __device__ __forceinline__ const char* b_ptr(const pg8::Unit& u) const { return B + ((size_t)u.e * 1024 + (size_t)u.pn * 256) * K * 2; }
};
struct EpiG3 {
    static constexpr bool PERM = true;
    bf16* act;
    __device__ __forceinline__ void operator()(const f32x4 (&acc)[2][2][4][2], const pg8::Unit& u, int wr, int wc, int fr, int fq) const {
        const int row0 = u.pm * 256 + wr * 64 + fr, c8 = u.pn * 128 + wc * 32 + 8 * fq;
#pragma unroll
        for (int ai = 0; ai < 2; ++ai)
#pragma unroll
            for (int m = 0; m < 4; ++m) {
                float a[8];
#pragma unroll
                for (int n = 0; n < 2; ++n)
#pragma unroll
                    for (int k = 0; k < 4; ++k) { const float g = acc[ai][0][m][n][k], up = acc[ai][1][m][n][k]; a[n * 4 + k] = g / (1.f + __expf(-g)) * up; }
                v4u w; w.x = pk2(a[0], a[1]); w.y = pk2(a[2], a[3]); w.z = pk2(a[4], a[5]); w.w = pk2(a[6], a[7]);
                *(v4u*)(act + (size_t)(row0 + ai * 128 + m * 16) * 512 + c8) = w;
            }
    }
};
struct EpiG4 {
    static constexpr bool PERM = true;
    bf16* y2; const unsigned* list; const float* wts; const LAS int* tt;
    __device__ __forceinline__ void operator()(const f32x4 (&acc)[2][2][4][2], const pg8::Unit& u, int wr, int wc, int fr, int fq) const {
        const int r0 = (u.pm - tt[u.e]) * 256; const int c8 = u.pn * 256 + wc * 32 + 8 * fq;
#pragma unroll
        for (int ai = 0; ai < 2; ++ai)
#pragma unroll
            for (int m = 0; m < 4; ++m) {
                const int row = wr * 64 + fr + ai * 128 + m * 16;
                if (row < u.cnt) {
                    const unsigned ent = list[(size_t)u.e * TT + r0 + row]; const float w = wts[ent];
#pragma unroll
                    for (int bj = 0; bj < 2; ++bj) {
                        const f32x4 v0 = acc[ai][bj][m][0] * w, v1 = acc[ai][bj][m][1] * w;
                        v4u o; o.x = pk2(v0[0], v0[1]); o.y = pk2(v0[2], v0[3]); o.z = pk2(v1[0], v1[1]); o.w = pk2(v1[2], v1[3]);
                        *(v4u*)(y2 + (size_t)ent * 1024 + bj * 128 + c8) = o;
                    }
                }
            }
    }
};

#include <hip/hip_bf16.h>
#include <cmath>
namespace attn_body {
using bf16=__hip_bfloat16;
using bf16x8=__attribute__((ext_vector_type(8)))short;
using s16x4=__attribute__((ext_vector_type(4)))short;
using f32x16=__attribute__((ext_vector_type(16)))float;
using u32x4=__attribute__((ext_vector_type(4)))unsigned;
constexpr int D=64,QP=512,KVP=128,OP=1024;
constexpr int NW=8,QBLK=32,KVBLK=64;
__device__ __forceinline__ int crow(int r,int hi){return (r&3)+8*(r>>2)+4*hi;}
#define SBAR() __builtin_amdgcn_sched_barrier(0)
__device__ __forceinline__ void wmask(f32x16&p0,f32x16&p1,int kp0,int qpos,int hi){
  const float NEG=-INFINITY; const bool tile_ok=(unsigned)kp0<4096u; const int base=kp0+4*hi-qpos+128;
  #pragma unroll
  for(int r=0;r<16;++r){const int dd=base+(r&3)+8*(r>>2); if(!tile_ok||(unsigned)dd>256u)p0[r]=NEG; if(!tile_ok||(unsigned)(dd+32)>256u)p1[r]=NEG;}
}
constexpr int NSLOT=3, SLOTB=8192;
constexpr int LDS_K=0, LDS_V=NSLOT*SLOTB, LDS_WS=2*NSLOT*SLOTB, LDS_OST=LDS_WS+NW*64*4, LDS_BYTES=LDS_OST+NW*4096;
constexpr float C2=0.125f*1.4426950408889634f;
__device__ __forceinline__ void glds16(const void*gsrc,unsigned lds_dst){unsigned keep;
  asm volatile("s_mov_b32 %0, m0\n\ts_mov_b32 m0, %2\n\ts_nop 0\n\tglobal_load_lds_dwordx4 %1, off\n\ts_mov_b32 m0, %0":"=&s"(keep):"v"(gsrc),"s"(lds_dst):"memory");}
__device__ __forceinline__ float max3f(float a,float b,float c){float r;asm("v_max3_f32 %0, %1, %2, %3":"=v"(r):"v"(a),"v"(b),"v"(c));return r;}
__device__ __forceinline__ float max2f(float a,float b){float r;asm("v_max_f32_e32 %0, %1, %2":"=v"(r):"v"(a),"v"(b));return r;}
__device__ __forceinline__ float fadd_s(float a,float b){float r;asm("v_add_f32_e32 %0, %1, %2":"=v"(r):"v"(a),"v"(b));return r;}
__device__ __forceinline__ float fsub_s(float a,float b){float r;asm("v_sub_f32_e32 %0, %1, %2":"=v"(r):"v"(a),"v"(b));return r;}
typedef float f32x2_t __attribute__((ext_vector_type(2))); typedef __bf16 bf16x2_t __attribute__((ext_vector_type(2)));
__device__ __forceinline__ unsigned cvtpk_s(float lo,float hi){f32x2_t v={lo,hi};bf16x2_t b=__builtin_convertvector(v,bf16x2_t);return __builtin_bit_cast(unsigned,b);}
#define WAIT_BAR(N) asm volatile("s_waitcnt vmcnt(" #N ") lgkmcnt(0)\n\ts_barrier":::"memory")

__device__ __forceinline__ void qkt(f32x16&p0,f32x16&p1,const char*Kslot,const bf16x8*qr,const f32x16&negm,int r32,int hi){
  const char*kb=Kslot+hi*1024+r32*16;
  #pragma unroll
  for(int d0=0;d0<4;++d0){
    const bf16x8 b0=*reinterpret_cast<const bf16x8*>(kb+d0*2048);
    const bf16x8 b1=*reinterpret_cast<const bf16x8*>(kb+d0*2048+512);
    if(d0==0){p0=__builtin_amdgcn_mfma_f32_32x32x16_bf16(b0,qr[0],negm,0,0,0);p1=__builtin_amdgcn_mfma_f32_32x32x16_bf16(b1,qr[0],negm,0,0,0);}
    else{p0=__builtin_amdgcn_mfma_f32_32x32x16_bf16(b0,qr[d0],p0,0,0,0);p1=__builtin_amdgcn_mfma_f32_32x32x16_bf16(b1,qr[d0],p1,0,0,0);}}
}
typedef __attribute__((address_space(3))) const char* lds_cptr;
typedef short v4i16_t __attribute__((ext_vector_type(4)));
__device__ __forceinline__ void kload8(bf16x8*kf,lds_cptr kp){
  kf[0]=*(const __attribute__((address_space(3))) bf16x8*)(kp);      kf[1]=*(const __attribute__((address_space(3))) bf16x8*)(kp+512);
  kf[2]=*(const __attribute__((address_space(3))) bf16x8*)(kp+2048); kf[3]=*(const __attribute__((address_space(3))) bf16x8*)(kp+2560);
  kf[4]=*(const __attribute__((address_space(3))) bf16x8*)(kp+4096); kf[5]=*(const __attribute__((address_space(3))) bf16x8*)(kp+4608);
  kf[6]=*(const __attribute__((address_space(3))) bf16x8*)(kp+6144); kf[7]=*(const __attribute__((address_space(3))) bf16x8*)(kp+6656);
}
__device__ __forceinline__ void kload2(bf16x8*kf,lds_cptr kp,int j){ kf[2*j]=*(const __attribute__((address_space(3))) bf16x8*)(kp+j*2048); kf[2*j+1]=*(const __attribute__((address_space(3))) bf16x8*)(kp+j*2048+512); }
__device__ __forceinline__ s16x4 vtr(lds_cptr p){ return __builtin_bit_cast(s16x4,__builtin_amdgcn_ds_read_tr16_b64_v4i16((__attribute__((address_space(3))) v4i16_t*)p)); }
__device__ __forceinline__ float rowmax(const f32x16&p0,const f32x16&p1){
  float a=max3f(p0[0],p0[1],p1[0]),b=max3f(p0[2],p0[3],p1[1]);a=max3f(a,p1[2],p1[3]);
  #pragma unroll
  for(int r=4;r<16;r+=4){a=max3f(a,p0[r],p0[r+1]);b=max3f(b,p0[r+2],p0[r+3]);a=max3f(a,p1[r],p1[r+1]);b=max3f(b,p1[r+2],p1[r+3]);}
  const float m=max2f(a,b);
  auto rr=__builtin_amdgcn_permlane32_swap(__float_as_uint(m),__float_as_uint(m),false,false);
  return max2f(__uint_as_float(rr[0]),__uint_as_float(rr[1]));
}
__device__ __forceinline__ void pv(f32x16*o,int vb,bf16x8 pa0,bf16x8 pa1,bf16x8 pa2,bf16x8 pa3){
  #pragma unroll
  for(int d0=0;d0<2;++d0){s16x4 lo[4],hi[4];
    #pragma unroll
    for(int ks=0;ks<4;++ks){
      asm volatile("ds_read_b64_tr_b16 %0,%1 offset:%c2":"=&v"(lo[ks]):"v"(vb),"i"(d0*4096+ks*1024):"memory");
      asm volatile("ds_read_b64_tr_b16 %0,%1 offset:%c2":"=&v"(hi[ks]):"v"(vb),"i"(d0*4096+ks*1024+512):"memory");}
    asm volatile("s_waitcnt lgkmcnt(0)":::"memory");SBAR();
    #define PK(k) (bf16x8){lo[k][0],lo[k][1],lo[k][2],lo[k][3],hi[k][0],hi[k][1],hi[k][2],hi[k][3]}
    o[d0]=__builtin_amdgcn_mfma_f32_32x32x16_bf16(pa0,PK(0),o[d0],0,0,0);
    o[d0]=__builtin_amdgcn_mfma_f32_32x32x16_bf16(pa1,PK(1),o[d0],0,0,0);
    o[d0]=__builtin_amdgcn_mfma_f32_32x32x16_bf16(pa2,PK(2),o[d0],0,0,0);
    o[d0]=__builtin_amdgcn_mfma_f32_32x32x16_bf16(pa3,PK(3),o[d0],0,0,0);
    #undef PK
  }
}

#ifndef ATTN_STORE16
#define ATTN_STORE16(p,v) (*(u32x4*)(p)=(v))
#endif
template<int THRL> __device__ __forceinline__ void attn_unit(const bf16*Qu,const bf16*__restrict__ Kh,const bf16*__restrict__ Vh,bf16*Ou,const int p0,const int NT,const float* sinkp,char*shm){
  int tid=threadIdx.x; asm volatile("":"+v"(tid)); const int lane=tid&63,r32=lane&31,hi=lane>>5; const int wid=__builtin_amdgcn_readfirstlane(tid>>6);
  const int hsub=wid>>1, psub=(wid&1)*QBLK;
  const bf16*Qw=Qu+(long)psub*QP+hsub*D;
  const unsigned lds0=(unsigned)(uintptr_t)shm;
  float*wsf=(float*)(shm+LDS_WS)+wid*64;
  const bf16*ksrc=Kh+(long)lane*KVP+wid*8;
  const bf16*vsrc=Vh+(long)(16*(wid&3)+(lane>>2))*KVP+(wid>>2)*32+(lane&3)*8;
  const unsigned kdst=lds0+LDS_K+wid*1024, vdst=lds0+LDS_V+wid*1024;
  #define KP0(t) (p0-128+64*((t)-4))
  #define TROW(t) ((t)<4?64*(t):(((unsigned)KP0(t)<4096u)?256+KP0(t):256))
  #define DMA_K(t,slot) glds16(ksrc+(long)TROW(t)*KVP,(unsigned)__builtin_amdgcn_readfirstlane(kdst+(slot)))
  #define DMA_V(t,slot) glds16(vsrc+(long)TROW(t)*KVP,(unsigned)__builtin_amdgcn_readfirstlane(vdst+(slot)))
  const int vb0=(int)(lds0+LDS_V)+((lane>>4)&1)*32+(lane&3)*8+(4*hi+((lane&15)>>2))*64;
  const char*Kbase=shm+LDS_K; bf16x8 kf[8];
  const lds_cptr shm3=(lds_cptr)shm; const lds_cptr kp0=shm3+LDS_K+hi*1024+r32*16; const lds_cptr vp0=shm3+LDS_V+((lane>>4)&1)*32+(lane&3)*8+(4*hi+((lane&15)>>2))*64;
  DMA_K(0,0);DMA_V(0,0);DMA_K(1,SLOTB);
  bf16x8 qr[4];
  #pragma unroll
  for(int d0=0;d0<4;++d0)qr[d0]=*reinterpret_cast<const bf16x8*>(&Qw[(long)r32*QP+d0*16+hi*8]);
  float mhat=0.f,l_reg=0.f;f32x16 o[2];o[0]=f32x16{};o[1]=f32x16{};f32x16 negm=f32x16{};asm volatile("":"+v"(negm));
  const int qpos=p0+psub+r32;
  #define CMASK(P0,P1,t) do{ if((t)>=4)wmask(P0,P1,KP0(t),qpos,hi); }while(0)
  bool resc=false;
  #define START(P0,P1) do{ const float rm=rowmax(P0,P1); resc=false; \
    { const float dl=rm; mhat=fadd_s(mhat,dl); \
      _Pragma("unroll") for(int r=0;r<16;++r){P0[r]=fsub_s(P0[r],dl);P1[r]=fsub_s(P1[r],dl);} \
      _Pragma("unroll") for(int r=0;r<16;++r)negm[r]=-mhat; asm volatile("":"+v"(negm)); } \
    _Pragma("unroll") for(int r=0;r<16;++r)P0[r]=__builtin_amdgcn_exp2f(P0[r]); }while(0)
  #define RESC() do{ if(resc){ asm volatile("s_waitcnt lgkmcnt(0)":::"memory"); \
      _Pragma("unroll") for(int d_=0;d_<2;++d_) _Pragma("unroll") for(int r=0;r<16;++r)o[d_][r]*=wsf[crow(r,hi)]; } }while(0)
  f32x16 pA0,pA1,pB0,pB1;
  int sl_prev=0,sl_cur=0,sl_next=SLOTB;
  #define ROT() do{sl_prev=sl_cur;sl_cur=sl_next;sl_next=(sl_next==(NSLOT-1)*SLOTB)?0:sl_next+SLOTB;}while(0)
  DMA_K(2,2*SLOTB);
  WAIT_BAR(3);
  qkt(pA0,pA1,Kbase,qr,negm,r32,hi);asm volatile("s_nop 15\n\ts_nop 7":"+v"(pA0),"+v"(pA1));CMASK(pA0,pA1,0);
  START(pA0,pA1);
  _Pragma("unroll") for(int r=0;r<16;++r)pA1[r]=__builtin_amdgcn_exp2f(pA1[r]);
  WAIT_BAR(0);
  DMA_K(3,0);DMA_V(1,SLOTB);
  ROT();
  kload8(kf,kp0+sl_cur);
  WAIT_BAR(2);
  s16x4 vlo[8],vhi[8]; u32x4 pw0,pw1,pw2,pw3;
  #define PKW(P,B) cvtpk_s(P[B],P[B+1])
  #define PAF(k) __builtin_bit_cast(bf16x8,pw##k)
  #define VFR(i) (bf16x8){vlo[i][0],vlo[i][1],vlo[i][2],vlo[i][3],vhi[i][0],vhi[i][1],vhi[i][2],vhi[i][3]}
  #define PIN(x) asm volatile("":"+v"(x))
  #define MX3(a,b,c) __builtin_fmaxf(__builtin_fmaxf((a),(b)),(c))
  #define GAPA(MF,A0,A1,A2,A3,W0,W1,PW) do{ MF; sacc+=A0; sacc+=A1; sacc+=A2; sacc+=A3; PIN(sacc); W0; W1; PIN(PW); SBAR(); }while(0)
  #define EX(v) __builtin_amdgcn_exp2f(v)
  #define GAPB(MF,X,B) do{ MF; X[B]=EX(X[B]); X[B+1]=EX(X[B+1]); X[B+2]=EX(X[B+2]); X[B+3]=EX(X[B+3]); PIN(X); SBAR(); }while(0)
  #define VRD(i) do{ vlo[i]=vtr(vp_+(((i)>>2)*4096+((i)&3)*1024)); vhi[i]=vtr(vp_+(((i)>>2)*4096+((i)&3)*1024+512)); }while(0)
  #define KRD(G,j) do{ if(G){ kload2(kf,kp0+sl_next,j); SBAR(); } }while(0)
  #define STEP(C0,C1,P0,P1,t,GK,GV,GL) do{ SBAR(); \
    const lds_cptr vp_=vp0+sl_prev; \
    VRD(0); SBAR(); float sacc=(P0[0]+P0[1]); \
    GAPA(C0=__builtin_amdgcn_mfma_f32_32x32x16_bf16(kf[0],qr[0],negm,0,0,0), P0[2],P0[3],P0[4],P0[5],     pw0[0]=PKW(P0,0), pw0[1]=PKW(P0,2), pw0); \
    VRD(4); SBAR(); GAPA(C1=__builtin_amdgcn_mfma_f32_32x32x16_bf16(kf[1],qr[0],negm,0,0,0), P0[6],P0[7],P0[8],P0[9],     pw0[2]=PKW(P0,4), pw0[3]=PKW(P0,6), pw0); \
    VRD(1); SBAR(); GAPA(C0=__builtin_amdgcn_mfma_f32_32x32x16_bf16(kf[2],qr[1],C0,0,0,0),   P0[10],P0[11],P0[12],P0[13], pw1[0]=PKW(P0,8), pw1[1]=PKW(P0,10), pw1); \
    VRD(5); SBAR(); GAPA(C1=__builtin_amdgcn_mfma_f32_32x32x16_bf16(kf[3],qr[1],C1,0,0,0),   P0[14],P0[15],P1[0],P1[1],   pw1[2]=PKW(P0,12),pw1[3]=PKW(P0,14), pw1); \
    VRD(2); SBAR(); GAPA(C0=__builtin_amdgcn_mfma_f32_32x32x16_bf16(kf[4],qr[2],C0,0,0,0),   P1[2],P1[3],P1[4],P1[5],     pw2[0]=PKW(P1,0), pw2[1]=PKW(P1,2), pw2); \
    VRD(6); SBAR(); GAPA(C1=__builtin_amdgcn_mfma_f32_32x32x16_bf16(kf[5],qr[2],C1,0,0,0),   P1[6],P1[7],P1[8],P1[9],     pw2[2]=PKW(P1,4), pw2[3]=PKW(P1,6), pw2); \
    VRD(3); SBAR(); GAPA(C0=__builtin_amdgcn_mfma_f32_32x32x16_bf16(kf[6],qr[3],C0,0,0,0),   P1[10],P1[11],P1[12],P1[13], pw3[0]=PKW(P1,8), pw3[1]=PKW(P1,10), pw3); \
    VRD(7); SBAR(); GAPA(C1=__builtin_amdgcn_mfma_f32_32x32x16_bf16(kf[7],qr[3],C1,0,0,0),   P1[14],P1[15],0.f,0.f,       pw3[2]=PKW(P1,12),pw3[3]=PKW(P1,14), pw3); \
    l_reg+=sacc; \
    if(GK){DMA_K((t)+3,sl_cur);} if(GV){DMA_V((t)+1,sl_next);} \
    CMASK(C0,C1,t); \
    { float a=MX3(C0[0],C0[1],C1[0]),b=MX3(C0[2],C0[3],C1[1]); a=MX3(a,C1[2],C1[3]); \
      _Pragma("unroll") for(int r=4;r<16;r+=4){a=MX3(a,C0[r],C0[r+1]);b=MX3(b,C0[r+2],C0[r+3]);a=MX3(a,C1[r],C1[r+1]);b=MX3(b,C1[r+2],C1[r+3]);} \
      float rm=__builtin_fmaxf(a,b); { auto rr=__builtin_amdgcn_permlane32_swap(__float_as_uint(rm),__float_as_uint(rm),false,false); rm=__builtin_fmaxf(__uint_as_float(rr[0]),__uint_as_float(rr[1])); } \
      resc=false; \
      if(__builtin_expect(__any(rm>(float)THRL),0)){ const float dl=__builtin_fmaxf(rm,0.f); mhat+=dl; \
        _Pragma("unroll") for(int r=0;r<16;++r){C0[r]-=dl;C1[r]-=dl;} \
        _Pragma("unroll") for(int r=0;r<16;++r)negm[r]=-mhat; asm volatile("":"+v"(negm)); \
        const float f=__builtin_amdgcn_exp2f(-dl); l_reg*=f; if(hi==0)wsf[r32]=f; resc=true; } } \
    SBAR(); \
    GAPB(o[0]=__builtin_amdgcn_mfma_f32_32x32x16_bf16(PAF(0),VFR(0),o[0],0,0,0), C0,0); \
    GAPB(o[1]=__builtin_amdgcn_mfma_f32_32x32x16_bf16(PAF(0),VFR(4),o[1],0,0,0), C0,4); \
    KRD(GL,0); GAPB(o[0]=__builtin_amdgcn_mfma_f32_32x32x16_bf16(PAF(1),VFR(1),o[0],0,0,0), C0,8); \
    KRD(GL,1); GAPB(o[1]=__builtin_amdgcn_mfma_f32_32x32x16_bf16(PAF(1),VFR(5),o[1],0,0,0), C0,12); \
    KRD(GL,2); GAPB(o[0]=__builtin_amdgcn_mfma_f32_32x32x16_bf16(PAF(2),VFR(2),o[0],0,0,0), C1,0); \
    KRD(GL,3); GAPB(o[1]=__builtin_amdgcn_mfma_f32_32x32x16_bf16(PAF(2),VFR(6),o[1],0,0,0), C1,4); \
    GAPB(o[0]=__builtin_amdgcn_mfma_f32_32x32x16_bf16(PAF(3),VFR(3),o[0],0,0,0), C1,8); \
    GAPB(o[1]=__builtin_amdgcn_mfma_f32_32x32x16_bf16(PAF(3),VFR(7),o[1],0,0,0), C1,12); \
    }while(0)
  int t=1;
  for(;t+5<NT;t+=2){
    STEP(pB0,pB1,pA0,pA1,t,true,true,true);     WAIT_BAR(2); RESC(); ROT();
    STEP(pA0,pA1,pB0,pB1,t+1,true,true,true);   WAIT_BAR(2); RESC(); ROT();
  }
  #define ENDW(tt) do{ if((tt)+3<NT){WAIT_BAR(2);} else if((tt)+2<NT){WAIT_BAR(1);} else {WAIT_BAR(0);} }while(0)
  for(;t+1<NT;t+=2){
    STEP(pB0,pB1,pA0,pA1,t,(t+3<NT),(t+1<NT),(t+1<NT));       ENDW(t);   RESC(); ROT();
    STEP(pA0,pA1,pB0,pB1,t+1,(t+4<NT),(t+2<NT),(t+2<NT));     ENDW(t+1); RESC(); ROT();
  }
  STEP(pB0,pB1,pA0,pA1,NT-1,false,false,false); RESC();
  { float sacc=pB0[0]+pB0[1]; _Pragma("unroll") for(int r=2;r<16;++r)sacc+=pB0[r]; _Pragma("unroll") for(int r=0;r<16;++r)sacc+=pB1[r]; l_reg+=sacc;
    pw0=(u32x4){PKW(pB0,0),PKW(pB0,2),PKW(pB0,4),PKW(pB0,6)};pw1=(u32x4){PKW(pB0,8),PKW(pB0,10),PKW(pB0,12),PKW(pB0,14)};pw2=(u32x4){PKW(pB1,0),PKW(pB1,2),PKW(pB1,4),PKW(pB1,6)};pw3=(u32x4){PKW(pB1,8),PKW(pB1,10),PKW(pB1,12),PKW(pB1,14)};
    SBAR(); pv(o,vb0+sl_cur,PAF(0),PAF(1),PAF(2),PAF(3)); }
  #undef PKW
  #undef PAF
  #undef VFR
  #undef PIN
  #undef MX3
  #undef GAPA
  #undef GAPB
  #undef EX
  #undef VRD
  #undef KRD
  #undef STEP
  #undef ENDW
  l_reg+=__shfl_xor(l_reg,32);
  l_reg+=__builtin_amdgcn_exp2f(sinkp[hsub]*1.4426950408889634f-mhat);
  if(hi==0)wsf[32+r32]=l_reg;asm volatile("s_waitcnt lgkmcnt(0)":::"memory");
  float rli[16];
  #pragma unroll
  for(int r=0;r<16;++r)rli[r]=__builtin_amdgcn_rcpf(wsf[32+crow(r,hi)]);
  bf16*Ow=Ou+(long)psub*OP+hsub*D;
  { bf16*stg=(bf16*)(shm+LDS_OST)+wid*2048;
    #pragma unroll
    for(int r=0;r<16;++r){const int orow=crow(r,hi);
      #pragma unroll
      for(int d0=0;d0<2;++d0)stg[orow*64+d0*32+r32]=__float2bfloat16(o[d0][r]*rli[r]);}
    asm volatile("s_waitcnt lgkmcnt(0)":::"memory");
    #pragma unroll
    for(int i=0;i<4;++i){const int row=i*8+(lane>>3),ch=lane&7; const u32x4 v=*(const u32x4*)(stg+row*64+ch*8); ATTN_STORE16(Ow+(long)row*OP+ch*8,v);} }
  asm volatile("s_waitcnt lgkmcnt(0)\n\ts_barrier":::"memory");
  #undef DMA_K
  #undef DMA_V
  #undef KP0
  #undef TROW
  #undef CMASK
  #undef START
  #undef RESC
  #undef ROT
}
constexpr int ATTN_LDS_BYTES=LDS_BYTES;
#undef SBAR
#undef WAIT_BAR
}

constexpr int SLAB_PITCH = 136;
template <int MT, class RowAddr, class Epi>
__device__ __forceinline__ void slab_gemm(LAS unsigned char* lds, const bf16* Cmat, const int K, const RowAddr& RA, const Epi& E) {
    int tid = threadIdx.x; asm volatile("" : "+v"(tid));
    const int wid = tid >> 6, lane = tid & 63;
    LAS bf16* Dt = (LAS bf16*)lds;
    f32x16 acc[MT];
#pragma unroll
    for (int i = 0; i < MT; ++i)
#pragma unroll
        for (int r = 0; r < 16; ++r) acc[i][r] = 0.f;
    for (int kc = 0; kc < K; kc += 128) {
        {
            const int k = tid >> 2, qd = tid & 3;
            const bf16* src = RA(kc + k) + qd * 64;
            v4u v[8];
#pragma unroll
            for (int j = 0; j < 8; ++j) v[j] = *(const v4u*)(src + j * 8);
#pragma unroll
            for (int j = 0; j < 8; ++j) {
                const unsigned w[4] = {v[j].x, v[j].y, v[j].z, v[j].w};
#pragma unroll
                for (int e = 0; e < 4; ++e) {
                    const int ch = qd * 64 + j * 8 + e * 2;
                    Dt[(ch) * SLAB_PITCH + k] = (bf16)(w[e] & 0xffffu);
                    Dt[(ch + 1) * SLAB_PITCH + k] = (bf16)(w[e] >> 16);
                }
            }
        }
        __syncthreads();
        const int chl = wid * 32 + (lane & 31), kh = (lane >> 5) * 8;
#pragma unroll
        for (int s = 0; s < 8; ++s) {
            const bf16x8 bfrag = *(const LAS bf16x8*)(Dt + chl * SLAB_PITCH + s * 16 + kh);
#pragma unroll
            for (int mt = 0; mt < MT; ++mt) {
                const bf16x8 afrag = *(const bf16x8*)(Cmat + (size_t)(mt * 32 + (lane & 31)) * K + kc + s * 16 + kh);
                acc[mt] = __builtin_amdgcn_mfma_f32_32x32x16_bf16(afrag, bfrag, acc[mt], 0, 0, 0);
            }
        }
        __syncthreads();
    }
    E(acc, wid, lane);
}

struct Args { const float* in[23]; float* out; unsigned char* ws; int ph_lo, ph_hi; };

struct RowA { const bf16* z; int b, n2; __device__ __forceinline__ const bf16* operator()(int k) const { return z + (size_t)(b * 4096 + 64 * (k & 63) + n2) * 512 + (k >> 6) * 256; } };
struct EpiA { bf16* t2; const float2* tw; int b, n2;
    __device__ __forceinline__ void operator()(const f32x16 (&acc)[4], int wid, int lane) const {
        const int ch = wid * 32 + (lane & 31);
#pragma unroll
        for (int mt = 0; mt < 2; ++mt)
#pragma unroll
            for (int r = 0; r < 16; ++r) {
                const int k1 = 32 * mt + (r & 3) + 8 * (r >> 2) + 4 * (lane >> 5);
                const float2 cs = tw[n2 * k1]; const float re = acc[mt][r], im = acc[mt + 2][r];
                const float re2 = cs.x * re + cs.y * im, im2 = cs.x * im - cs.y * re;
                bf16* d = t2 + ((size_t)((b * 64 + n2) * 64 + k1) * 2) * 256 + ch;
                d[0] = (bf16)f2bf(re2); d[256] = (bf16)f2bf(im2);
            }
    } };
struct RowB { const bf16* t2; int b, k1; __device__ __forceinline__ const bf16* operator()(int k) const { return t2 + ((size_t)((b * 64 + (k & 63)) * 64 + k1) * 2 + (k >> 6)) * 256; } };
struct EpiB { bf16* mrg; int b, k1;
    __device__ __forceinline__ void operator()(const f32x16 (&acc)[2], int wid, int lane) const {
        const int ch = wid * 32 + (lane & 31);
#pragma unroll
        for (int mt = 0; mt < 2; ++mt)
#pragma unroll
            for (int r = 0; r < 16; ++r) { const int k2 = 32 * mt + (r & 3) + 8 * (r >> 2) + 4 * (lane >> 5); mrg[(size_t)(b * 4096 + k1 + 64 * k2) * 1024 + 768 + ch] = (bf16)f2bf(DBG_NO_FOUR ? 0.f : acc[mt][r]); }
    } };
struct RowC { const bf16* z; int b; __device__ __forceinline__ const bf16* operator()(int k) const { return z + (size_t)(T + b * 256 + (k & 255)) * 512 + (k >> 8) * 256; } };
struct EpiC { bf16* mrg; int b;
    __device__ __forceinline__ void operator()(const f32x16 (&acc)[8], int wid, int lane) const {
        const int ch = wid * 32 + (lane & 31);
#pragma unroll
        for (int mt = 0; mt < 8; ++mt)
#pragma unroll
            for (int r = 0; r < 16; ++r) { const int kk = 32 * mt + (r & 3) + 8 * (r >> 2) + 4 * (lane >> 5); mrg[(size_t)(T + b * 256 + kk) * 1024 + 768 + ch] = (bf16)f2bf(DBG_NO_FOUR ? 0.f : acc[mt][r]); }
    } };

__device__ __forceinline__ void tr_block(const float* src, int ldS, bf16* dst, int ldD, LAS float* scr, int lane) {
#pragma unroll 8
    for (int i = 0; i < 32; ++i) { const int kk = 2 * i + (lane >> 5); scr[kk * 33 + (lane & 31)] = src[(size_t)kk * ldS + (lane & 31)]; }
    LDS_WAIT(); asm volatile("" ::: "memory");
    const int c = lane & 7;
#pragma unroll
    for (int j = 0; j < 4; ++j) { const int n = (lane >> 3) + 8 * j; const LAS float* s = scr + (8 * c) * 33 + n;
        v4u o; o.x = pk2(s[0 * 33], s[1 * 33]); o.y = pk2(s[2 * 33], s[3 * 33]); o.z = pk2(s[4 * 33], s[5 * 33]); o.w = pk2(s[6 * 33], s[7 * 33]);
        *(GAS v4u*)(dst + (size_t)n * ldD + 8 * c) = o; }
    LDS_WAIT(); asm volatile("" ::: "memory");
}


typedef const __attribute__((address_space(4))) Args* kargs_t;
__device__ __forceinline__ kargs_t ka_launder() { kargs_t p = (kargs_t)__builtin_amdgcn_kernarg_segment_ptr(); asm volatile("" : "+s"(p)); return p; }
__device__ __forceinline__ int tid_launder() { int t = threadIdx.x; asm volatile("" : "+v"(t)); return t; }
#define KA_DECL const kargs_t KA = ka_launder(); const int tid = tid_launder(); const int lane = tid & 63; const int wave = __builtin_amdgcn_readfirstlane(tid >> 6); const int gw = vcu * 8 + wave; const int gt = vcu * 512 + tid; (void)lane; (void)wave; (void)gw; (void)gt;
#define ws (KA->ws)
#define ctl ((gu32*)(ws + O_CTL))
#define x_in (KA->in[0])
#define c_in (KA->in[1])
#define ctx_in (KA->in[2])
#define cctx_in (KA->in[3])
#define w_mod (KA->in[4])
#define b_mod (KA->in[5])
#define norm1_g (KA->in[6])
#define w_in (KA->in[7])
#define q_norm_g (KA->in[8])
#define k_norm_g (KA->in[9])
#define attn_sink (KA->in[10])
#define pool_w (KA->in[11])
#define pool_scale (KA->in[12])
#define four_w (KA->in[13])
#define w_out (KA->in[14])
#define norm2_g (KA->in[15])
#define w_grp (KA->in[16])
#define b_grp (KA->in[17])
#define w_rtr (KA->in[18])
#define b_rtr (KA->in[19])
#define w_gate (KA->in[20])
#define w_up (KA->in[21])
#define w_down (KA->in[22])
#define outp (KA->out)
#define modv ((float*)(ws + O_MOD))
#define rope ((float2*)(ws + O_ROPE))
#define twt ((float2*)(ws + O_TW))
#define fma ((bf16*)(ws + O_FMA))
#define fmb ((bf16*)(ws + O_FMB))
#define fmc ((bf16*)(ws + O_FMC))
#define hbuf ((bf16*)(ws + O_H))
#define kall ((bf16*)(ws + O_KALL))
#define vall ((bf16*)(ws + O_VALL))
#define xc ((float*)(ws + O_XC))
#define list ((unsigned*)(ws + O_LIST))
#define wts ((float*)(ws + O_WTS))
#define act ((bf16*)(ws + O_ACT))
#define t2 ((bf16*)(ws + O_T2))
#define mrg ((bf16*)(ws + O_MRG))
#define qb ((bf16*)(ws + O_Q))
#define pu ((bf16*)(ws + O_PU))
#define zb ((bf16*)(ws + O_Z))
#define y2 ((bf16*)(ws + O_Y2))

#ifndef PH_MASK
#define PH_MASK 0x3ffff
#endif
#define IN(k) (lo <= (k) && (k) < hi && ((PH_MASK >> (k)) & 1))
#define SEAM(k) do { if (IN(k) && IN((k) + 1)) xcd_barrier(bar); } while (0)
#define modl (modv + (size_t)l * 5 * 6144)
#define win_t ((bf16*)(ws + O_WIN + l * SZ_WIN1))
#define wout_t ((bf16*)(ws + O_WOUT + l * SZ_WOUT1))
#define wgu_t ((bf16*)(ws + O_WGU + l * SZ_WGU1))
#define wd_t ((bf16*)(ws + O_WD + l * SZ_WD1))
template <int l> __device__ __forceinline__ void layer_body(LAS unsigned char* lds, const int G, const int vcu, const XcdBarrier& bar, const int lo, const int hi) {
    const int NGW = G * 8, NGT = G * 512; LAS int* ttab = (LAS int*)(lds + TILE_OFF);
    constexpr int P = 1 + 8 * l;

        for (int rep_ = 0; rep_ < 1 + ((l == 0) ? ((REP_MASK >> (1 + 0)) & 1) : 0); ++rep_)
        if (IN(P + 0)) {
            KA_DECL
            const float* modp = modv;
#pragma clang loop vectorize(disable) unroll(disable)
            for (int r = gw; r < TT; r += NGW) {
                const bool isc = r >= T; const int bsel = isc ? 4 : (r >> 12);
                const float* src = (l == 0) ? (isc ? ctx_in + (size_t)(r - T) * 1024 : x_in + (size_t)r * 1024) : (isc ? xc + (size_t)(r - T) * 1024 : outp + (size_t)r * 1024);
                f32x4 v[4];
#pragma unroll
                for (int j = 0; j < 4; ++j) v[j] = *(const f32x4*)(src + 4 * lane + 256 * j);
                if (l == 1) {
                    const float w0 = wts[2 * r], w1 = wts[2 * r + 1]; const float* g2 = modp + bsel * 6144 + 5 * 1024;
                    float* dst = isc ? xc + (size_t)(r - T) * 1024 : outp + (size_t)r * 1024;
#pragma unroll
                    for (int j = 0; j < 4; ++j) {
                        const v2u ya = *(const v2u*)(y2 + (size_t)(2 * r) * 1024 + 4 * lane + 256 * j), yb = *(const v2u*)(y2 + (size_t)(2 * r + 1) * 1024 + 4 * lane + 256 * j);
                        const f32x4 gv = *(const f32x4*)(g2 + 4 * lane + 256 * j);
                        f32x4 yy; yy[0] = bflo(ya.x) + bflo(yb.x); yy[1] = bfhi(ya.x) + bfhi(yb.x); yy[2] = bflo(ya.y) + bflo(yb.y); yy[3] = bfhi(ya.y) + bfhi(yb.y);
                        if (DBG_NO_MOE) yy = (f32x4){0.f, 0.f, 0.f, 0.f};
                yy = yy * DBG_MOE_SCALE;
                        yy = yy * DBG_MOE_SCALE;
                        v[j] = v[j] + gv * yy; *(f32x4*)(dst + 4 * lane + 256 * j) = v[j];
                    }
                    (void)w0; (void)w1;
                }
                float ss = 0.f;
#pragma unroll
                for (int j = 0; j < 4; ++j) ss += (v[j][0] * v[j][0] + v[j][1] * v[j][1]) + (v[j][2] * v[j][2] + v[j][3] * v[j][3]);
                const float rstd = 1.0f / sqrtf(wave_sum(ss) * (1.f / 1024.f) + 1e-6f);
                const float* sh = modl + bsel * 6144; const float* sc = sh + 1024; const float* gn = norm1_g + l * 1024;
#pragma unroll
                for (int j = 0; j < 4; ++j) {
                    const int c0 = 4 * lane + 256 * j; const f32x4 g = *(const f32x4*)(gn + c0), s1 = *(const f32x4*)(sc + c0), h1 = *(const f32x4*)(sh + c0);
                    const f32x4 y = (v[j] * rstd) * g * (s1 + 1.0f) + h1;
                    v2u o; o.x = pk2(y[0], y[1]); o.y = pk2(y[2], y[3]); *(v2u*)(hbuf + (size_t)r * 1024 + c0) = o;
                }
            }
        }
        SEAM(P + 0);
        for (int rep_ = 0; rep_ < 1 + ((l == 0) ? ((REP_MASK >> (1 + 1)) & 1) : 0); ++rep_)
        if (IN(P + 1)) {
            KA_DECL
            SchedPlain S{TT / 256, 6, G, vcu, 1024, (const char*)win_t};
            EpiG1 E{pu, qb, kall, vall, zb};
            pg8::gemm_phase<EpiG1, SchedPlain>(lds, (const char*)hbuf, 1024, S, E);
        }
        SEAM(P + 1);
        if (IN(P + 2)) {
            KA_DECL
            for (int it = vcu; it < 256; it += G) {
                const int b = it >> 6, n2 = it & 63;
                RowA ra{zb, b, n2}; EpiA ea{t2, twt, b, n2};
                slab_gemm<4, RowA, EpiA>(lds, fma, 128, ra, ea);
            }
#pragma clang loop vectorize(disable) unroll(disable)
            for (int i = gt; i < TT * 10; i += NGT) {
                const int r = i / 10, hs = i % 10; const bool isk = hs >= 8; const bool isc = r >= T;
                bf16* p = isk ? kall + (size_t)krow_of(r) * 128 + (hs - 8) * 64 : qb + (size_t)r * 512 + hs * 64;
                float xv[64];
#pragma unroll
                for (int j = 0; j < 8; ++j) { const v4u w = *(const v4u*)(p + 8 * j); xv[8 * j] = bflo(w.x); xv[8 * j + 1] = bfhi(w.x); xv[8 * j + 2] = bflo(w.y); xv[8 * j + 3] = bfhi(w.y); xv[8 * j + 4] = bflo(w.z); xv[8 * j + 5] = bfhi(w.z); xv[8 * j + 6] = bflo(w.w); xv[8 * j + 7] = bfhi(w.w); }
                float ss = 0.f;
#pragma unroll
                for (int d = 0; d < 64; ++d) ss += xv[d] * xv[d];
                const float rstd = 1.0f / sqrtf(ss * (1.f / 64.f) + 1e-6f);
                const float* gg = (isk ? k_norm_g : q_norm_g) + l * 64;
#pragma unroll
                for (int d = 0; d < 64; ++d) { xv[d] = xv[d] * rstd * gg[d]; if ((d & 7) == 7) asm volatile("" ::: "memory"); }
                if (!isc) {
                    const float2* rp = rope + (size_t)(r & 4095) * 32;
#pragma unroll
                    for (int d = 0; d < 16; ++d) {
                        const float2 c1 = rp[d], c2 = rp[16 + d];
                        const float a = xv[d], bb = xv[16 + d], cc = xv[32 + d], dd = xv[48 + d];
                        xv[d] = a * c1.x - bb * c1.y; xv[16 + d] = bb * c1.x + a * c1.y;
                        xv[32 + d] = cc * c2.x - dd * c2.y; xv[48 + d] = dd * c2.x + cc * c2.y;
                        if ((d & 3) == 3) asm volatile("" ::: "memory");
                    }
                }
                const float sc = isk ? 1.0f : QSCALE;
#pragma unroll
                for (int j = 0; j < 8; ++j) { v4u w; w.x = pk2(xv[8 * j] * sc, xv[8 * j + 1] * sc); w.y = pk2(xv[8 * j + 2] * sc, xv[8 * j + 3] * sc); w.z = pk2(xv[8 * j + 4] * sc, xv[8 * j + 5] * sc); w.w = pk2(xv[8 * j + 6] * sc, xv[8 * j + 7] * sc); *(v4u*)(p + 8 * j) = w; }
            }
            const int prow = (l == 0) ? TT : T;
#pragma clang loop vectorize(disable) unroll(disable)
            for (int i = gt; i < prow * 32; i += NGT) {
                const int r = i >> 5, ck = i & 31, g = ck >> 3; const bool isc = r >= T;
                const int nseq = isc ? LCTX : NSEQ; const int rbase = isc ? T + ((r - T) & ~255) : (r & ~4095); const int n = r - rbase;
                const int hw = 1 << g;
                int lo_ = n - hw; lo_ = lo_ < 0 ? 0 : lo_; int hi_ = n + hw - 1; hi_ = hi_ > nseq - 1 ? nseq - 1 : hi_;
                float s[8] = {0.f, 0.f, 0.f, 0.f, 0.f, 0.f, 0.f, 0.f};
                for (int tpos = lo_; tpos <= hi_; ++tpos) { const v4u w = *(const v4u*)(pu + (size_t)(rbase + tpos) * 256 + ck * 8);
                    s[0] += bflo(w.x); s[1] += bfhi(w.x); s[2] += bflo(w.y); s[3] += bfhi(w.y); s[4] += bflo(w.z); s[5] += bfhi(w.z); s[6] += bflo(w.w); s[7] += bfhi(w.w); }
                const v4u w = *(const v4u*)(pu + (size_t)r * 256 + ck * 8); const float ic = 1.0f / (float)(hi_ - lo_ + 1);
                v4u o; o.x = pk2(s[0] * ic - bflo(w.x), s[1] * ic - bfhi(w.x)); o.y = pk2(s[2] * ic - bflo(w.y), s[3] * ic - bfhi(w.y));
                o.z = pk2(s[4] * ic - bflo(w.z), s[5] * ic - bfhi(w.z)); o.w = pk2(s[6] * ic - bflo(w.w), s[7] * ic - bfhi(w.w));
                if (DBG_NO_POOL) o = (v4u){0u, 0u, 0u, 0u};
                *(v4u*)(mrg + (size_t)r * 1024 + ck * 8) = o;
            }
        }
        SEAM(P + 2);
        for (int rep_ = 0; rep_ < 1 + ((l == 0) ? ((REP_MASK >> (1 + 3)) & 1) : 0); ++rep_)
        if (IN(P + 3)) {
            KA_DECL
            const int n_att = 512 + (l == 0 ? 32 : 0), n_fb = 256, n_cf = (l == 0 ? 4 : 0);
            for (int it = vcu; it < n_att + n_fb + n_cf; it += G) {
#ifndef NO_ATT
                if (it < n_att) { {
                    const bool cu = it >= 512; const int uidx = cu ? it - 512 : it;
                    const int b = cu ? (uidx >> 3) : (uidx >> 7), kvh = cu ? ((uidx >> 2) & 1) : ((uidx >> 6) & 1), pb = cu ? (uidx & 3) : (uidx & 63);
                    const int p0 = pb * 64; const int qrow0 = cu ? T + b * 256 + p0 : b * 4096 + p0;
                    const attn_body::bf16* Qu = (const attn_body::bf16*)(qb + (size_t)qrow0 * 512 + kvh * 256);
                    const attn_body::bf16* Kh = (const attn_body::bf16*)(kall + (size_t)b * KVROWS * 128 + kvh * 64);
                    const attn_body::bf16* Vh = (const attn_body::bf16*)(vall + (size_t)b * KVROWS * 128 + kvh * 64);
                    attn_body::bf16* Ou = (attn_body::bf16*)(mrg + (size_t)qrow0 * 1024 + 256 + kvh * 256);
                    attn_body::attn_unit<8>(Qu, Kh, Vh, Ou, p0, cu ? 4 : 10, attn_sink + l * 8 + kvh * 4, (char*)lds);
                    __syncthreads(); }
                } else
#endif
#ifndef NO_FB
                if (it < n_att + n_fb) { {
                    const int u2 = it - n_att; const int b = u2 >> 6, k1 = u2 & 63;
                    RowB rb{t2, b, k1}; EpiB eb{mrg, b, k1};
                    slab_gemm<2, RowB, EpiB>(lds, fmb, 128, rb, eb); }
                } else
#endif
                {
#ifndef NO_CF
                    {
                    const int b = it - n_att - n_fb;
                    RowC rc{zb, b}; EpiC ec{mrg, b};
                    slab_gemm<8, RowC, EpiC>(lds, fmc, 512, rc, ec); }
#endif
                }
            }
        }
        SEAM(P + 3);
        for (int rep_ = 0; rep_ < 1 + ((l == 0) ? ((REP_MASK >> (1 + 4)) & 1) : 0); ++rep_)
        if (IN(P + 4)) {
            KA_DECL
            SchedPlain S{(l == 0 ? TT : T) / 256, 4, G, vcu, 1024, (const char*)wout_t};
            EpiG2 E{(l == 0) ? x_in : outp, ctx_in, outp, xc, modl};
            pg8::gemm_phase<EpiG2, SchedPlain>(lds, (const char*)mrg, 1024, S, E);
        }
        SEAM(P + 4);
        if (IN(P + 5)) {
            KA_DECL
            LAS float* rw = (LAS float*)lds;
            LAS int* lcnt = (LAS int*)(lds + 81920);
            LAS unsigned* lent = (LAS unsigned*)(lds + 81920 + 256);
            LAS unsigned* lrank = lent + 1024;
            for (int i = tid; i < 1024 * 20; i += 512) { const int d = i / 20, j = i % 20; rw[i] = (j < 4) ? w_grp[(size_t)l * 4096 + d * 4 + j] : w_rtr[(size_t)l * 16384 + d * 16 + (j - 4)]; }
            if (tid < 33) lcnt[tid] = 0;
            __syncthreads();
            const int nrows = (l == 0) ? TT : T; int nloc = 0;
#pragma clang loop vectorize(disable) unroll(disable)
            for (int r = gw; r < nrows; r += NGW) {
                const bool isc = r >= T; const int bsel = isc ? 4 : (r >> 12);
                const float* src = isc ? xc + (size_t)(r - T) * 1024 : outp + (size_t)r * 1024;
                f32x4 v[4]; float ss = 0.f;
#pragma unroll
                for (int j = 0; j < 4; ++j) { v[j] = *(const f32x4*)(src + 4 * lane + 256 * j); ss += (v[j][0] * v[j][0] + v[j][1] * v[j][1]) + (v[j][2] * v[j][2] + v[j][3] * v[j][3]); }
                const float rstd = 1.0f / sqrtf(wave_sum(ss) * (1.f / 1024.f) + 1e-6f);
                const float* sh = modl + bsel * 6144 + 3 * 1024; const float* sc = sh + 1024; const float* gn = norm2_g + l * 1024;
                float lg[20];
#pragma unroll
                for (int j = 0; j < 20; ++j) lg[j] = 0.f;
#pragma unroll
                for (int j = 0; j < 4; ++j) {
                    const int c0 = 4 * lane + 256 * j; const f32x4 g = *(const f32x4*)(gn + c0), s1 = *(const f32x4*)(sc + c0), h1 = *(const f32x4*)(sh + c0);
                    const f32x4 y = (v[j] * rstd) * g * (s1 + 1.0f) + h1;
                    v2u o; o.x = pk2(y[0], y[1]); o.y = pk2(y[2], y[3]); *(v2u*)(hbuf + (size_t)r * 1024 + c0) = o;
#pragma unroll
                    for (int e = 0; e < 4; ++e) { const LAS float* wr_ = rw + (c0 + e) * 20;
#pragma unroll
                        for (int q5 = 0; q5 < 5; ++q5) { const f32x4 wv = *(const LAS f32x4*)(wr_ + 4 * q5); lg[4 * q5] += y[e] * wv[0]; lg[4 * q5 + 1] += y[e] * wv[1]; lg[4 * q5 + 2] += y[e] * wv[2]; lg[4 * q5 + 3] += y[e] * wv[3]; }
                        __builtin_amdgcn_sched_barrier(0); }
                }
#pragma unroll
                for (int j = 0; j < 20; ++j) lg[j] = wave_sum(lg[j]);
                float gl[4]; float gm = -1e30f;
#pragma unroll
                for (int j = 0; j < 4; ++j) { gl[j] = lg[j] + b_grp[l * 4 + j]; gm = fmaxf(gm, gl[j]); }
                float gs = 0.f; int gi = 0; float gb = -1e30f;
#pragma unroll
                for (int j = 0; j < 4; ++j) { const float e = expf(gl[j] - gm); gs += e; if (gl[j] > gb) { gb = gl[j]; gi = j; } }
                const float pg = expf(gb - gm) / gs;
                float el[4]; float em = -1e30f;
#pragma unroll
                for (int j = 0; j < 4; ++j) { float t_ = 0.f;
#pragma unroll
                    for (int g4 = 0; g4 < 4; ++g4) t_ = (gi == g4) ? (lg[4 + g4 * 4 + j] + b_rtr[l * 16 + g4 * 4 + j]) : t_;
                    el[j] = t_; em = fmaxf(em, t_); }
                float pe[4];
#pragma unroll
                for (int j = 0; j < 4; ++j) pe[j] = expf(el[j] - em);
                int i0 = 0; float b0 = -1.f;
#pragma unroll
                for (int j = 0; j < 4; ++j) if (pe[j] > b0) { b0 = pe[j]; i0 = j; }
                int i1 = 0; float b1 = -1.f;
#pragma unroll
                for (int j = 0; j < 4; ++j) if (j != i0 && pe[j] > b1) { b1 = pe[j]; i1 = j; }
                const float wsum = b0 + b1; const float w0 = pg * b0 / wsum, w1 = pg * b1 / wsum;
                if (lane == 0) {
                    wts[2 * r] = w0; wts[2 * r + 1] = w1;
                    ((int*)(ws + O_EID))[2 * r] = gi * 4 + i0; ((int*)(ws + O_EID))[2 * r + 1] = gi * 4 + i1;
                    const int e0 = gi * 4 + i0, e1 = gi * 4 + i1;
                    const int s0 = __hip_atomic_fetch_add((LAS int*)(lcnt + 16 + 16), 1, __ATOMIC_RELAXED, __HIP_MEMORY_SCOPE_WORKGROUP);
                    const int k0 = __hip_atomic_fetch_add((LAS int*)(lcnt + e0), 1, __ATOMIC_RELAXED, __HIP_MEMORY_SCOPE_WORKGROUP);
                    const int k1 = __hip_atomic_fetch_add((LAS int*)(lcnt + e1), 1, __ATOMIC_RELAXED, __HIP_MEMORY_SCOPE_WORKGROUP);
                    lent[2 * s0] = ((unsigned)(2 * r) << 4) | (unsigned)e0; lrank[2 * s0] = (unsigned)k0;
                    lent[2 * s0 + 1] = ((unsigned)(2 * r + 1) << 4) | (unsigned)e1; lrank[2 * s0 + 1] = (unsigned)k1;
                }
                ++nloc;
            }
            (void)nloc;
            __syncthreads();
            if (tid < 16) { const int c = lcnt[tid]; lcnt[16 + tid] = c ? (int)__hip_atomic_fetch_add((unsigned*)(ctl + CW_CNT + (l * 16 + tid) * 64), (unsigned)c, RLX_AGENT) : 0; }
            __syncthreads();
            const int ntot = 2 * lcnt[32];
            for (int i = tid; i < ntot; i += 512) { const unsigned en = lent[i]; const int e = en & 15; list[(size_t)e * TT + lcnt[16 + e] + lrank[i]] = en >> 4; }
            __syncthreads();
        }
        SEAM(P + 5);
        if (IN(P + 6) || IN(P + 7)) {
            KA_DECL
            __syncthreads();
            if (tid == 0) { int acc_ = 0; for (int e = 0; e < 16; ++e) { const int c = (int)__hip_atomic_load((unsigned*)(ctl + CW_CNT + (l * 16 + e) * 64), RLX_AGENT); ttab[e] = acc_; ttab[17 + e] = c; acc_ += (c + 255) >> 8; } ttab[16] = acc_; }
            __syncthreads();
        }
        if (DBG_NAIVE_MOE && IN(P + 6)) {
            KA_DECL
            const int nrows = (l == 0) ? TT : T; LAS float* hs = (LAS float*)lds; LAS float* as = hs + 1024;
            const int* eidg = (const int*)(ws + O_EID);
            LAS float* lgs = as + 512; LAS float* rt = lgs + 32;
            for (int r = vcu; r < nrows; r += G) {
                __syncthreads();
                for (int i = tid; i < 1024; i += 512) hs[i] = bf2f(hbuf[(size_t)r * 1024 + i]);
                __syncthreads();
                if (tid < 20) { float a = 0.f; for (int k = 0; k < 1024; ++k) a += hs[k] * ((tid < 4) ? w_grp[(size_t)l * 4096 + k * 4 + tid] : w_rtr[(size_t)l * 16384 + k * 16 + (tid - 4)]);
                    lgs[tid] = a + ((tid < 4) ? b_grp[l * 4 + tid] : b_rtr[l * 16 + tid - 4]); }
                __syncthreads();
                if (tid == 0) { int gi = 0; for (int j = 1; j < 4; ++j) if (lgs[j] > lgs[gi]) gi = j; float gs = 0.f; for (int j = 0; j < 4; ++j) gs += expf(lgs[j] - lgs[gi]); const float pg = 1.f / gs;
                    int i0 = 0; for (int j = 1; j < 4; ++j) if (lgs[4 + gi * 4 + j] > lgs[4 + gi * 4 + i0]) i0 = j; int i1 = -1; for (int j = 0; j < 4; ++j) if (j != i0 && (i1 < 0 || lgs[4 + gi * 4 + j] > lgs[4 + gi * 4 + i1])) i1 = j;
                    const float p0 = 1.f, p1 = expf(lgs[4 + gi * 4 + i1] - lgs[4 + gi * 4 + i0]); rt[0] = (float)(gi * 4 + i0); rt[1] = (float)(gi * 4 + i1); rt[2] = pg * p0 / (p0 + p1); rt[3] = pg * p1 / (p0 + p1); }
                __syncthreads();
                for (int sl = 0; sl < 2; ++sl) {
                    const int e = (DBG_NAIVE_ROUTE & 1) ? (int)rt[sl] : eidg[2 * r + sl]; const float w = (DBG_NAIVE_ROUTE & 2) ? rt[2 + sl] : wts[2 * r + sl];
                    __syncthreads();
                    const float* Wg = w_gate + (size_t)(l * 16 + e) * 1024 * 512 + tid; const float* Wu = w_up + (size_t)(l * 16 + e) * 1024 * 512 + tid;
                    float g = 0.f, u = 0.f;
#pragma unroll 8
                    for (int k = 0; k < 1024; ++k) { g += hs[k] * Wg[(size_t)k * 512]; u += hs[k] * Wu[(size_t)k * 512]; }
                    as[tid] = g / (1.f + expf(-g)) * u;
                    __syncthreads();
                    const float* Wd = w_down + (size_t)(l * 16 + e) * 512 * 1024 + tid;
                    float y0 = 0.f, y1 = 0.f;
#pragma unroll 8
                    for (int j = 0; j < 512; ++j) { y0 += as[j] * Wd[(size_t)j * 1024]; y1 += as[j] * Wd[(size_t)j * 1024 + 512]; }
                    y2[(size_t)(2 * r + sl) * 1024 + tid] = (bf16)f2bf(y0 * w); y2[(size_t)(2 * r + sl) * 1024 + 512 + tid] = (bf16)f2bf(y1 * w);
                }
            }
        }
        for (int rep_ = 0; rep_ < 1 + ((l == 0) ? ((REP_MASK >> 7) & 1) : 0); ++rep_)
        if (!DBG_NAIVE_MOE && IN(P + 6)) {
            KA_DECL
            SchedMoe S{G, vcu, 1024, ttab[16], 0, (const char*)wgu_t, list, ttab};
            EpiG3 E{act};
            pg8::gemm_phase<EpiG3, SchedMoe>(lds, (const char*)hbuf, 1024, S, E);
        }
        SEAM(P + 6);
        for (int rep_ = 0; rep_ < 1 + ((l == 0) ? ((REP_MASK >> 8) & 1) : 0); ++rep_)
        if (!DBG_NAIVE_MOE && IN(P + 7)) {
            KA_DECL
            SchedMoe S{G, vcu, 512, ttab[16], 1, (const char*)wd_t, list, ttab};
            EpiG4 E{y2, list, wts, ttab};
            pg8::gemm_phase<EpiG4, SchedMoe>(lds, (const char*)act, 512, S, E);
        }
        SEAM(P + 7);
    }

__global__ void __launch_bounds__(512, 2) fwd_kernel(Args args) {
    extern __shared__ __attribute__((aligned(16))) unsigned char lds_raw[];
    LAS unsigned char* lds = (LAS unsigned char*)lds_raw;
    const int tid = threadIdx.x, lane = tid & 63, wave = __builtin_amdgcn_readfirstlane(tid >> 6);
    const int G = gridDim.x; const int bx = blockIdx.x; const int vcu = (G % 8 == 0) ? (bx % 8) * (G / 8) + bx / 8 : bx;
    volatile LAS unsigned* MISC = (volatile LAS unsigned*)(lds + MISC_OFF);
    LAS float* trig = (LAS float*)(lds + TRIG_OFF);
    LAS int* ttab = (LAS int*)(lds + TILE_OFF);
    for (int u = tid; u < (LDS_BYTES - LDSCTL_OFF) / 4; u += 512) ((LAS unsigned*)(lds + LDSCTL_OFF))[u] = 0u;
    __syncthreads();
    if (tid < 64) { float s, c; sincospif((float)tid / 32.f, &s, &c); trig[tid] = c; trig[64 + tid] = s; }
    __syncthreads();
    XcdBarrier bar; bar.bar = nullptr; bar.x = 0; bar.st = nullptr;
    if (!MK_SPLIT) { KA_DECL bar = xcd_barrier_post((unsigned*)(ctl + CW_BAR), MISC + 8); }
    const int lo = args.ph_lo, hi = args.ph_hi;
    const int NGW = G * 8, NGT = G * 512;

    for (int rep_ = 0; rep_ < 1 + ((REP_MASK >> 0) & 1); ++rep_)
    if (IN(0)) {
        KA_DECL
        {
            LAS float* sl = (LAS float*)lds;
            bool have = false;
            for (int it = vcu; it < 192; it += G) {
                if (!have) {
                    for (int i = tid; i < 5120; i += 512) { const int r = i >> 10, k = i & 1023; const float v = (r < 4) ? c_in[r * 1024 + k] : cctx_in[k]; sl[i] = v / (1.f + expf(-v)); }
                    __syncthreads(); have = true;
                }
                const int l = it / 96, cb = it % 96;
                const float* W = w_mod + (size_t)l * 1024 * 6144 + cb * 64 + lane;
                float a0 = 0.f, a1 = 0.f, a2 = 0.f, a3 = 0.f, a4 = 0.f; const int k0 = wave * 128;
#pragma unroll 8
                for (int k = 0; k < 128; ++k) { const float wv = W[(size_t)(k0 + k) * 6144]; const int kk = k0 + k;
                    a0 += sl[kk] * wv; a1 += sl[1024 + kk] * wv; a2 += sl[2048 + kk] * wv; a3 += sl[3072 + kk] * wv; a4 += sl[4096 + kk] * wv; }
                LAS float* part = sl + 5120;
                part[(wave * 5 + 0) * 64 + lane] = a0; part[(wave * 5 + 1) * 64 + lane] = a1; part[(wave * 5 + 2) * 64 + lane] = a2; part[(wave * 5 + 3) * 64 + lane] = a3; part[(wave * 5 + 4) * 64 + lane] = a4;
                __syncthreads();
                if (tid < 320) { const int r = tid >> 6, n = tid & 63; float s = b_mod[l * 6144 + cb * 64 + n];
#pragma unroll
                    for (int w = 0; w < 8; ++w) s += part[(w * 5 + r) * 64 + n];
                    modv[(size_t)(l * 5 + r) * 6144 + cb * 64 + n] = s; }
                __syncthreads();
            }
            __syncthreads();
        }
#pragma clang loop vectorize(disable) unroll(disable)
        for (int i = gt; i < 4096 * 32; i += NGT) {
            const int n = i >> 5, j = i & 31; const int jj = j & 15;
            const float inv = 1.0f / powf(10000.0f, (float)(2 * jj) / 32.0f);
            const float pos = (j < 16) ? (float)(n >> 6) : (float)(n & 63);
            const float ang = pos * inv; rope[i] = make_float2(cosf(ang), sinf(ang));
        }
#pragma clang loop vectorize(disable) unroll(disable)
        for (int i = gt; i < 4096; i += NGT) { float s, c; sincospif((float)i / 2048.f, &s, &c); twt[i] = make_float2(c, s); }
#pragma clang loop vectorize(disable) unroll(disable)
        for (int i = gt; i < 128 * 128; i += NGT) {
            const int m = i >> 7, k = i & 127; const int ri = m >> 6, k1 = m & 63, part = k >> 6, n1 = k & 63;
            float s, c; sincospif((float)((n1 * k1) & 63) / 32.f, &s, &c);
            float v; if (ri == 0) v = (part == 0) ? c : -s; else v = (part == 0) ? -s : -c;
            fma[i] = (bf16)f2bf(v);
        }
#pragma clang loop vectorize(disable) unroll(disable)
        for (int i = gt; i < 64 * 128; i += NGT) {
            const int k2 = i >> 7, k = i & 127; const int ri = k >> 6, n2 = k & 63;
            float s, c; sincospif((float)((n2 * k2) & 63) / 32.f, &s, &c);
            fmb[i] = (bf16)f2bf((ri == 0 ? c : s) * (1.f / 512.f));
        }
#pragma clang loop vectorize(disable) unroll(disable)
        for (int i = gt; i < 256 * 512; i += NGT) {
            const int kk = i >> 9, k = i & 511; const int part = k >> 8, n = k & 255;
            float s, c; sincospif((float)((n * kk) & 255) / 128.f, &s, &c);
            fmc[i] = (bf16)f2bf((part == 0 ? c : -s) * (1.f / 128.f));
        }
        {
            LAS float* scr = (LAS float*)(lds + wave * 16384);
            constexpr int I_A = 512, I_B = 384, I_C = 8192, I_D = 4096, I_E = 512, I_F = 128, I_L = I_A + I_B + I_C + I_D + I_E + I_F;
#pragma clang loop vectorize(disable) unroll(disable)
            for (int it0 = gw; it0 < 2 * I_L; it0 += NGW) {
                const int l = it0 / I_L; int it = it0 % I_L;
                bf16* p_win_t = (bf16*)(ws + O_WIN + l * SZ_WIN1); bf16* p_wout_t = (bf16*)(ws + O_WOUT + l * SZ_WOUT1);
                bf16* p_wgu_t = (bf16*)(ws + O_WGU + l * SZ_WGU1); bf16* p_wd_t = (bf16*)(ws + O_WD + l * SZ_WD1);
                if (it < I_A) { const int kb = it >> 5, nb = it & 31; tr_block(w_in + (size_t)l * 1024 * 1280 + (size_t)kb * 64 * 1280 + nb * 32, 1280, p_win_t + (size_t)nb * 32 * 1024 + kb * 64, 1024, scr, lane); continue; } it -= I_A;
                if (it < I_B) { const int kb = 4 + (it >> 5), nb = it & 31; tr_block(w_out + (size_t)l * 1024 * 1024 + (size_t)kb * 64 * 1024 + nb * 32, 1024, p_wout_t + (size_t)nb * 32 * 1024 + kb * 64, 1024, scr, lane); continue; } it -= I_B;
                if (it < I_C) { const int up = it >> 12, r = it & 4095, e = r >> 8, kb = (r >> 4) & 15, nb = r & 15; const int n0 = nb * 32;
                    const float* src = (up ? w_up : w_gate) + ((size_t)(l * 16 + e) * 1024 + kb * 64) * 512 + n0;
                    const int drow = (n0 >> 7) * 256 + up * 128 + (n0 & 127);
                    tr_block(src, 512, p_wgu_t + ((size_t)e * 1024 + drow) * 1024 + kb * 64, 1024, scr, lane); continue; } it -= I_C;
                if (it < I_D) { const int e = it >> 8, kb = (it >> 5) & 7, nb = it & 31;
                    tr_block(w_down + ((size_t)(l * 16 + e) * 512 + kb * 64) * 1024 + nb * 32, 1024, p_wd_t + ((size_t)e * 1024 + nb * 32) * 512 + kb * 64, 512, scr, lane); continue; } it -= I_D;
                if (it < I_E) {
                    const int g = it >> 7, which = (it >> 6) & 1, jb = it & 63;
                    const float* Wg = four_w + (size_t)(l * 4 + g) * 4096;
                    float wreg[64];
#pragma unroll
                    for (int m = 0; m < 64; ++m) wreg[m] = Wg[m * 64 + lane];
                    const LAS float* tb = trig + which * 64;
#pragma unroll 1
                    for (int c = 0; c < 64; ++c) { float a = 0.f;
#pragma unroll
                        for (int m = 0; m < 64; ++m) a += tb[(m * c) & 63] * wreg[m];
                        scr[c * 64 + lane] = a; }
                    LDS_WAIT(); asm volatile("" ::: "memory");
                    const float* wi = w_in + (size_t)l * 1024 * 1280 + (size_t)(jb * 16) * 1280 + 1024 + g * 64;
                    bf16* d = p_win_t + (size_t)(1024 + which * 256 + g * 64 + lane) * 1024 + jb * 16;
#pragma unroll 1
                    for (int jp = 0; jp < 8; ++jp) { float o0 = 0.f, o1 = 0.f;
#pragma unroll 4
                        for (int c = 0; c < 64; ++c) { const float av = scr[c * 64 + lane]; o0 += wi[(size_t)(2 * jp) * 1280 + c] * av; o1 += wi[(size_t)(2 * jp + 1) * 1280 + c] * av; }
                        *(unsigned*)(d + 2 * jp) = pk2(o0, o1); }
                    LDS_WAIT(); asm volatile("" ::: "memory");
                    continue; } it -= I_E;
                {
                    const int g = it >> 5, nb = it & 31, n0 = nb * 32;
                    for (int i = lane; i < 2048; i += 64) { const int d = i >> 5, n = i & 31; scr[i] = pool_scale[l * 256 + g * 64 + d] * w_out[(size_t)l * 1024 * 1024 + (size_t)(g * 64 + d) * 1024 + n0 + n]; }
                    LDS_WAIT(); asm volatile("" ::: "memory");
                    const int n = lane & 31, ch = lane >> 5;
                    const float* pw = pool_w + (size_t)(l * 4 + g) * 4096 + (size_t)(ch * 32) * 64;
                    bf16* dd = p_wout_t + (size_t)(n0 + n) * 1024 + g * 64 + ch * 32;
#pragma unroll 1
                    for (int cp = 0; cp < 16; ++cp) { float o0 = 0.f, o1 = 0.f;
#pragma unroll 4
                        for (int d = 0; d < 64; ++d) { const float sv = scr[d * 32 + n]; o0 += pw[(2 * cp) * 64 + d] * sv; o1 += pw[(2 * cp + 1) * 64 + d] * sv; }
                        *(unsigned*)(dd + 2 * cp) = pk2(o0, o1); }
                    LDS_WAIT(); asm volatile("" ::: "memory");
                }
            }
        }
    }
    SEAM(0);

    layer_body<0>(lds, G, vcu, bar, lo, hi);
    layer_body<1>(lds, G, vcu, bar, lo, hi);
    if (IN(17)) {
        KA_DECL
        const float* modp = modv + (size_t)5 * 6144;
#pragma clang loop vectorize(disable) unroll(disable)
        for (int r = gw; r < T; r += NGW) {
            const float* g2 = modp + (r >> 12) * 6144 + 5 * 1024; float* dst = outp + (size_t)r * 1024;
#pragma unroll
            for (int j = 0; j < 4; ++j) {
                const int c0 = 4 * lane + 256 * j; f32x4 v = *(const f32x4*)(dst + c0);
                const v2u ya = *(const v2u*)(y2 + (size_t)(2 * r) * 1024 + c0), yb = *(const v2u*)(y2 + (size_t)(2 * r + 1) * 1024 + c0);
                const f32x4 gv = *(const f32x4*)(g2 + c0);
                f32x4 yy; yy[0] = bflo(ya.x) + bflo(yb.x); yy[1] = bfhi(ya.x) + bfhi(yb.x); yy[2] = bflo(ya.y) + bflo(yb.y); yy[3] = bfhi(ya.y) + bfhi(yb.y);
                if (DBG_NO_MOE) yy = (f32x4){0.f, 0.f, 0.f, 0.f};
                *(f32x4*)(dst + c0) = v + gv * yy;
            }
        }
    }
#undef IN
#undef SEAM
}

#undef KA_DECL
#undef ws
#undef ctl
#undef x_in
#undef c_in
#undef ctx_in
#undef cctx_in
#undef w_mod
#undef b_mod
#undef norm1_g
#undef w_in
#undef q_norm_g
#undef k_norm_g
#undef attn_sink
#undef pool_w
#undef pool_scale
#undef four_w
#undef w_out
#undef norm2_g
#undef w_grp
#undef b_grp
#undef w_rtr
#undef b_rtr
#undef w_gate
#undef w_up
#undef w_down
#undef outp
#undef modv
#undef rope
#undef twt
#undef fma
#undef fmb
#undef fmc
#undef hbuf
#undef kall
#undef vall
#undef xc
#undef list
#undef wts
#undef act
#undef t2
#undef mrg
#undef qb
#undef pu
#undef zb
#undef y2
#undef modl
#undef win_t
#undef wout_t
#undef wgu_t
#undef wd_t
extern "C" void kernel_launch(void* const* d_in, const int* in_sizes, int n_in, void* d_out, int out_size, void* d_ws, size_t ws_size, hipStream_t stream) {
    static int grid = 0;
    if (grid == 0) {
        if (n_in != 23 || out_size != T * DM || ws_size < WS_END) { fprintf(stderr, "kernel_launch: unexpected shapes (n_in %d out %d ws %zu need %zu)\n", n_in, out_size, ws_size, (size_t)WS_END); grid = -1; return; }
        int dev = 0, cus = 0;
        if (hipGetDevice(&dev) != hipSuccess || hipDeviceGetAttribute(&cus, hipDeviceAttributeMultiprocessorCount, dev) != hipSuccess) { grid = -1; return; }
        if (hipFuncSetAttribute((const void*)fwd_kernel, hipFuncAttributeMaxDynamicSharedMemorySize, LDS_BYTES) != hipSuccess) { fprintf(stderr, "kernel_launch: hipFuncSetAttribute failed\n"); grid = -1; return; }
        (void)hipGetLastError();
        grid = cus;
    }
    if (grid < 0) return;
    (void)hipMemsetAsync((char*)d_ws + O_CTL, 0, SZ_CTL, stream);
    Args a{};
    for (int i = 0; i < 23; ++i) a.in[i] = (const float*)d_in[i];
    a.out = (float*)d_out; a.ws = (unsigned char*)d_ws;
#if MK_SPLIT
    for (int p = 0; p < NPHASE; ++p) { a.ph_lo = p; a.ph_hi = p + 1; hipLaunchKernelGGL(fwd_kernel, dim3(grid), dim3(512), LDS_BYTES, stream, a); }
#else
    a.ph_lo = 0; a.ph_hi = NPHASE;
    hipLaunchKernelGGL(fwd_kernel, dim3(grid), dim3(512), LDS_BYTES, stream, a);
#endif
}
```

```cpp
#include <hip/hip_runtime.h>
#include <cstdio>
#include <cstdint>

#define DBG_NO_FOUR 0
#define DBG_NO_POOL 0
#define DBG_NO_ATT 0
#define DBG_NO_MOE 0
#define DBG_MOE_SCALE 1.0f
#define DBG_NAIVE_MOE 0
#define REP_MASK 0x0
#define DBG_NAIVE_ROUTE 0
#define LAS __attribute__((address_space(3)))
#define GAS __attribute__((address_space(1)))
typedef unsigned short bf16;
typedef short bf16x8 __attribute__((ext_vector_type(8)));
typedef float f32x4 __attribute__((ext_vector_type(4)));
typedef float f32x16 __attribute__((ext_vector_type(16)));
typedef unsigned v4u __attribute__((ext_vector_type(4)));
typedef unsigned v2u __attribute__((ext_vector_type(2)));
typedef GAS unsigned gu32;

#ifndef MK_SPLIT
#define MK_SPLIT 0
#endif

constexpr int NB = 4, NSEQ = 4096, DM = 1024, LCTX = 256, DEPTH = 2;
constexpr int T = NB * NSEQ, TC = NB * LCTX, TT = T + TC;
constexpr int KVROWS = LCTX + NSEQ;
constexpr int NEXP = 16, DEXP = 512;
constexpr int NPHASE = 18;
constexpr int MAXTILES = 152;
constexpr float QSCALE = 0.125f * 1.4426950408889634f;
constexpr float LOG2E = 1.4426950408889634f;

constexpr size_t al256(size_t x) { return (x + 255) & ~(size_t)255; }
constexpr size_t O_CTL = 0, SZ_CTL = 1u << 20;
constexpr size_t O_MOD = O_CTL + SZ_CTL, SZ_MOD = (size_t)2 * 5 * 6144 * 4;
constexpr size_t O_ROPE = al256(O_MOD + SZ_MOD), SZ_ROPE = (size_t)4096 * 32 * 8;
constexpr size_t O_TW = al256(O_ROPE + SZ_ROPE), SZ_TW = 4096 * 8;
constexpr size_t O_FMA = al256(O_TW + SZ_TW), SZ_FMA = 128 * 128 * 2;
constexpr size_t O_FMB = al256(O_FMA + SZ_FMA), SZ_FMB = 64 * 128 * 2;
constexpr size_t O_FMC = al256(O_FMB + SZ_FMB), SZ_FMC = 256 * 512 * 2;
constexpr size_t O_WIN = al256(O_FMC + SZ_FMC), SZ_WIN1 = (size_t)1536 * 1024 * 2;
constexpr size_t O_WOUT = al256(O_WIN + 2 * SZ_WIN1), SZ_WOUT1 = (size_t)1024 * 1024 * 2;
constexpr size_t O_WGU = al256(O_WOUT + 2 * SZ_WOUT1), SZ_WGU1 = (size_t)16 * 1024 * 1024 * 2;
constexpr size_t O_WD = al256(O_WGU + 2 * SZ_WGU1), SZ_WD1 = (size_t)16 * 1024 * 512 * 2;
constexpr size_t O_H = al256(O_WD + 2 * SZ_WD1), SZ_H = (size_t)TT * 1024 * 2;
constexpr size_t O_KALL = al256(O_H + SZ_H), SZ_KV = (size_t)NB * KVROWS * 128 * 2;
constexpr size_t O_VALL = al256(O_KALL + SZ_KV);
constexpr size_t O_XC = al256(O_VALL + SZ_KV), SZ_XC = (size_t)TC * 1024 * 4;
constexpr size_t O_LIST = al256(O_XC + SZ_XC), SZ_LIST = (size_t)NEXP * TT * 4;
constexpr size_t O_WTS = al256(O_LIST + SZ_LIST), SZ_WTS = (size_t)TT * 2 * 4;
constexpr size_t O_EID = al256(O_WTS + SZ_WTS), SZ_EID = (size_t)TT * 2 * 4;
constexpr size_t O_ACT = al256(O_EID + SZ_EID), SZ_ACT = (size_t)MAXTILES * 256 * 512 * 2;
constexpr size_t O_T2 = O_ACT, SZ_T2 = (size_t)NB * 64 * 64 * 2 * 256 * 2;
constexpr size_t O_MRG = al256(O_ACT + SZ_ACT), SZ_MRG = (size_t)TT * 1024 * 2;
constexpr size_t O_Q = al256(O_MRG + SZ_MRG), SZ_Q = (size_t)TT * 512 * 2;
constexpr size_t O_PU = al256(O_Q + SZ_Q), SZ_PU = (size_t)TT * 256 * 2;
constexpr size_t O_Z = al256(O_PU + SZ_PU), SZ_Z = (size_t)TT * 512 * 2;
constexpr size_t O_Y2 = O_MRG, SZ_Y2 = (size_t)TT * 2 * 1024 * 2;
constexpr size_t WS_END = al256(O_Z + SZ_Z);
static_assert(SZ_T2 <= SZ_ACT, "T2 overlay");
static_assert(O_Y2 + SZ_Y2 <= WS_END, "y2 overlay");

constexpr int CW_TMO = 0;
constexpr int CW_BAR = 4096;
constexpr int CW_CNT = 16384;

constexpr int RING_BYTES = 131072;
constexpr int LDSCTL_OFF = RING_BYTES, MISC_OFF = LDSCTL_OFF + 320;
constexpr int TRIG_OFF = LDSCTL_OFF + 1024;
constexpr int TILE_OFF = LDSCTL_OFF + 2048;
constexpr int LDS_BYTES = 147456;

#define RLX_AGENT __ATOMIC_RELAXED, __HIP_MEMORY_SCOPE_AGENT
#define LDS_WAIT() asm volatile("s_waitcnt lgkmcnt(0)" ::: "memory")
#define VM_WAIT() asm volatile("s_waitcnt vmcnt(0)" ::: "memory")

__device__ __forceinline__ unsigned f2bf(float f) { unsigned u = __builtin_bit_cast(unsigned, f); return (u + 0x7fffu + ((u >> 16) & 1u)) >> 16; }
__device__ __forceinline__ unsigned pk2(float lo, float hi) { return f2bf(lo) | (f2bf(hi) << 16); }
__device__ __forceinline__ float bflo(unsigned w) { return __builtin_bit_cast(float, w << 16); }
__device__ __forceinline__ float bfhi(unsigned w) { return __builtin_bit_cast(float, w & 0xffff0000u); }
__device__ __forceinline__ float bf2f(bf16 h) { return __builtin_bit_cast(float, (unsigned)h << 16); }
template <int CTRL, int RM> __device__ __forceinline__ float dppf(float v) { return __builtin_bit_cast(float, __builtin_amdgcn_update_dpp(0, __builtin_bit_cast(int, v), CTRL, RM, 0xf, true)); }
__device__ __forceinline__ float wave_sum(float v) {
    v += dppf<0x111, 0xf>(v); v += dppf<0x112, 0xf>(v); v += dppf<0x114, 0xf>(v); v += dppf<0x118, 0xf>(v);
    v += dppf<0x142, 0xa>(v); v += dppf<0x143, 0xc>(v);
    return __builtin_bit_cast(float, __builtin_amdgcn_readlane(__builtin_bit_cast(int, v), 63));
}

#define XB_TMO      128
#define XB_XCNT(j)  (256  + 64 * (j))
#define XB_XSUB(j)  (1280 + 64 * (j))
#define XB_XGEN(j)  (2304 + 64 * (j))
#define XB_TOP      3328
#define XB_TOPGEN   3392
#define XCD_BAR_WORDS 3456
#define XB_SPIN_CAP (1u << 18)
__device__ __forceinline__ unsigned xb_ld(unsigned* p)              { return __hip_atomic_load(p, __ATOMIC_RELAXED, __HIP_MEMORY_SCOPE_AGENT); }
__device__ __forceinline__ unsigned xb_add(unsigned* p, unsigned v) { return __hip_atomic_fetch_add(p, v, __ATOMIC_RELAXED, __HIP_MEMORY_SCOPE_AGENT); }
__device__ __forceinline__ unsigned xb_xcc_id() { return (unsigned)__builtin_amdgcn_s_getreg((3 << 11) | 20) & 0xFu; }
#define XB_SPIN(cond, bar) do { unsigned _sp = 0; while (cond) { __builtin_amdgcn_s_sleep(1); \
    if ((++_sp & 255u) == 0u) { if (xb_ld(&(bar)[XB_TMO])) break; if (_sp > XB_SPIN_CAP) { atomicAdd(&(bar)[XB_TMO], 1u); break; } } } } while (0)
struct XcdBarrier { unsigned* bar; unsigned x; volatile LAS unsigned* st; };
__device__ __forceinline__ XcdBarrier xcd_barrier_post(unsigned* bar, volatile LAS unsigned* st) {
    XcdBarrier b; b.bar = bar; b.x = xb_xcc_id(); b.st = st;
    if (threadIdx.x == 0) (void)xb_add(&bar[XB_XCNT(b.x)], 1u);
    return b;
}
__device__ __forceinline__ void xcd_barrier_complete(unsigned* bar, unsigned x, unsigned& nloc, unsigned& nx) {
    const unsigned G = gridDim.x * gridDim.y * gridDim.z;
    unsigned sum, cnt, mine, sp = 0u;
    for (;;) {
        sum = 0u; cnt = 0u; mine = 0u;
#pragma unroll
        for (unsigned j = 0; j < 16; ++j) { const unsigned c = xb_ld(&bar[XB_XCNT(j)]); sum += c; cnt += (c > 0u) ? 1u : 0u; mine = (j == x) ? c : mine; }
        if (sum == G) break;
        __builtin_amdgcn_s_sleep(1);
        if ((++sp & 255u) == 0u) { if (xb_ld(&bar[XB_TMO])) break; if (sp > XB_SPIN_CAP) { atomicAdd(&bar[XB_TMO], 1u); break; } }
    }
    nloc = mine > 0u ? mine : 1u; nx = cnt > 0u ? cnt : 1u;
}
__device__ __forceinline__ void xcd_barrier(const XcdBarrier& b) {
    asm volatile("s_waitcnt vmcnt(0)" ::: "memory");
    __syncthreads();
    if (threadIdx.x == 0) {
        unsigned* bar = b.bar;
        __builtin_amdgcn_s_waitcnt(0);
        unsigned nloc = b.st[0], nx = b.st[1];
        if (nloc == 0u) { xcd_barrier_complete(bar, b.x, nloc, nx); b.st[0] = nloc; b.st[1] = nx; }
        const unsigned old = xb_add(&bar[XB_XSUB(b.x)], 1u);
        const unsigned gen = old / nloc;
        if (old + 1u == (gen + 1u) * nloc) {
            __builtin_amdgcn_fence(__ATOMIC_RELEASE, "agent");
            asm volatile("s_waitcnt vmcnt(0)" ::: "memory");
            const unsigned og = xb_add(&bar[XB_TOP], 1u);
            const unsigned tg = og / nx;
            if (og + 1u == (tg + 1u) * nx) xb_add(&bar[XB_TOPGEN], 1u);
            else XB_SPIN(xb_ld(&bar[XB_TOPGEN]) == tg, bar);
            __builtin_amdgcn_fence(__ATOMIC_ACQUIRE, "agent");
            xb_add(&bar[XB_XGEN(b.x)], 1u);
            asm volatile("s_waitcnt vmcnt(0)" ::: "memory");
        } else {
            XB_SPIN(xb_ld(&bar[XB_XGEN(b.x)]) == gen, bar);
            __builtin_amdgcn_fence(__ATOMIC_ACQUIRE, "agent");
            asm volatile("s_waitcnt vmcnt(0)" ::: "memory");
        }
    }
    __syncthreads();
}

namespace pg8 {
constexpr int BM = 256, BK = 64, HALF = 128, HTB = HALF * BK * 2;
__host__ __device__ __forceinline__ int lds_byte(int r, int c) { const int st = (r >> 4) * 2 + (c >> 5), rr = r & 15, cc = c & 31, ob = rr * 64 + cc * 2; return st * 1024 + (ob ^ (((ob >> 9) & 1) << 5)); }
__host__ __device__ __forceinline__ void stage_rc(int b, int& R, int& C) { const int st = b / 1024, sb = b % 1024, swz = sb ^ (((sb >> 9) & 1) << 5); R = (st >> 1) * 16 + swz / 64; C = (st & 1) * 32 + (swz % 64) / 2; }
__host__ __device__ __forceinline__ int perm32(int rho) { const int n = rho >> 4, i = rho & 15; return 8 * (i >> 2) + 4 * n + (i & 3); }

struct Unit { int pm, pn, e, cnt; };

template <class Epi, class Sched>
__device__ __forceinline__ void gemm_phase(LAS unsigned char* lds, const char* Abase, const int K, const Sched& S, const Epi& E) {
    int tid = threadIdx.x; asm volatile("" : "+v"(tid));
    const int wid = __builtin_amdgcn_readfirstlane(tid >> 6), lane = tid & 63, wr = wid >> 2, wc = wid & 3, fr = lane & 15, fq = lane >> 4;
    const int nt = K / BK;
    int RA[2], CA[2]; unsigned voffB[2];
#pragma unroll
    for (int i = 0; i < 2; ++i) { int R, C; stage_rc(tid * 16 + i * 8192, R, C); RA[i] = R; CA[i] = C; const int Rb = Epi::PERM ? ((R & ~31) + perm32(R & 31)) : R; voffB[i] = (unsigned)(Rb * K + C) * 2u; }
    const size_t kstep = (size_t)(BK * 2);
    const size_t hstep = (size_t)HALF * K * 2;
    const unsigned ldsw = (unsigned)wid * 1024u;
    const int aoff = lds_byte(wr * 64 + fr, fq * 8), boff = lds_byte(wc * 32 + fr, fq * 8);
#define PG8_SA(b, h) (((b) * 2 + (h)) * HTB)
#define PG8_SB(b, h) ((4 + (b) * 2 + (h)) * HTB)
#define PG8_STAGEB(bufoff, gbase) do { _Pragma("unroll") for (int _i = 0; _i < 2; ++_i) \
        __builtin_amdgcn_global_load_lds((const unsigned*)((const char*)(gbase) + voffB[_i]), (LAS unsigned*)(lds + (bufoff) + ldsw + _i * 8192), 16, 0, 0); } while (0)
#define PG8_STAGEA(bufoff, gbase, o0, o1) do { \
        __builtin_amdgcn_global_load_lds((const unsigned*)((const char*)(gbase) + (o0)), (LAS unsigned*)(lds + (bufoff) + ldsw), 16, 0, 0); \
        __builtin_amdgcn_global_load_lds((const unsigned*)((const char*)(gbase) + (o1)), (LAS unsigned*)(lds + (bufoff) + ldsw + 8192), 16, 0, 0); } while (0)
#define PG8_LDA(dst, b, h) do { _Pragma("unroll") for (int m = 0; m < 4; ++m) _Pragma("unroll") for (int k = 0; k < 2; ++k) dst[m][k] = *(const LAS bf16x8*)(lds + PG8_SA(b, h) + aoff + m * 2048 + k * 1024); } while (0)
#define PG8_LDB(dst, b, h) do { _Pragma("unroll") for (int n = 0; n < 2; ++n) _Pragma("unroll") for (int k = 0; k < 2; ++k) dst[n][k] = *(const LAS bf16x8*)(lds + PG8_SB(b, h) + boff + n * 2048 + k * 1024); } while (0)
#define PG8_MMA(ai, bj, At, Bt) do { __builtin_amdgcn_s_setprio(1); _Pragma("unroll") for (int m = 0; m < 4; ++m) _Pragma("unroll") for (int n = 0; n < 2; ++n) _Pragma("unroll") for (int k = 0; k < 2; ++k) \
        acc[ai][bj][m][n] = __builtin_amdgcn_mfma_f32_16x16x32_bf16(Bt[n][k], At[m][k], acc[ai][bj][m][n], 0, 0, 0); __builtin_amdgcn_s_setprio(0); } while (0)
#define PG8_WAIT_V(n) asm volatile("s_waitcnt vmcnt(" #n ")" ::: "memory")
#define PG8_WAIT_L(n) asm volatile("s_waitcnt lgkmcnt(" #n ")" ::: "memory")
#define PG8_BAR __builtin_amdgcn_s_barrier()
#define PG8_SCHED __builtin_amdgcn_sched_barrier(0)
    Unit cur, nxt; int ui = 0;
    if (!S.next(0, cur)) return;
    f32x4 acc[2][2][4][2];
#pragma unroll
    for (int a = 0; a < 2; ++a)
#pragma unroll
        for (int b = 0; b < 2; ++b)
#pragma unroll
            for (int m = 0; m < 4; ++m)
#pragma unroll
                for (int n = 0; n < 2; ++n) acc[a][b][m][n] = (f32x4){0.f, 0.f, 0.f, 0.f};
    bf16x8 At[4][2], B0[2][2], B1[2][2];
    unsigned oc00, oc01, oc10, oc11, on00, on01, on10, on11;
    oc00 = S.a_off(cur, RA[0], CA[0]); oc01 = S.a_off(cur, RA[1], CA[1]); oc10 = S.a_off(cur, HALF + RA[0], CA[0]); oc11 = S.a_off(cur, HALF + RA[1], CA[1]);
    const char* cB = S.b_ptr(cur);
    PG8_STAGEB(PG8_SB(0, 0), cB); PG8_STAGEB(PG8_SB(0, 1), cB + hstep); PG8_STAGEA(PG8_SA(0, 0), Abase, oc00, oc01); PG8_STAGEA(PG8_SA(0, 1), Abase, oc10, oc11);
    if (wr == 1) PG8_BAR;
    PG8_WAIT_V(2); PG8_BAR;
    PG8_STAGEB(PG8_SB(1, 0), cB + kstep); PG8_STAGEA(PG8_SA(1, 0), Abase + kstep, oc00, oc01); PG8_STAGEB(PG8_SB(1, 1), cB + hstep + kstep);
    PG8_WAIT_V(6); PG8_BAR;
    for (;;) {
        const bool has_next = S.next(ui + 1, nxt);
        const char* nB = cB;
        on00 = oc00; on01 = oc01; on10 = oc10; on11 = oc11;
        if (has_next) { nB = S.b_ptr(nxt); on00 = S.a_off(nxt, RA[0], CA[0]); on01 = S.a_off(nxt, RA[1], CA[1]); on10 = S.a_off(nxt, HALF + RA[0], CA[0]); on11 = S.a_off(nxt, HALF + RA[1], CA[1]); }
        for (int t = 0; t < nt; t += 2) {
            const bool last = (t == nt - 2);
            const char* a1 = Abase + (size_t)(t + 1) * kstep;
            const char* a2 = last ? Abase : Abase + (size_t)(t + 2) * kstep; const char* b2 = last ? nB : cB + (size_t)(t + 2) * kstep;
            const char* a3 = a2 + kstep; const char* b3 = b2 + kstep;
            const unsigned x00 = last ? on00 : oc00, x01 = last ? on01 : oc01, x10 = last ? on10 : oc10, x11 = last ? on11 : oc11;
            PG8_LDB(B0, 0, 0); PG8_LDB(B1, 0, 1); PG8_SCHED; PG8_LDA(At, 0, 0); PG8_STAGEA(PG8_SA(1, 1), a1, oc10, oc11);
            PG8_WAIT_V(8); PG8_WAIT_L(0); PG8_BAR; PG8_MMA(0, 0, At, B0); PG8_MMA(0, 1, At, B1); PG8_BAR; PG8_SCHED;
            PG8_LDA(At, 0, 1); PG8_STAGEB(PG8_SB(0, 0), b2); PG8_STAGEB(PG8_SB(0, 1), b2 + hstep); PG8_STAGEA(PG8_SA(0, 0), a2, x00, x01);
            PG8_WAIT_V(8); PG8_WAIT_L(0); PG8_BAR; PG8_MMA(1, 0, At, B0); PG8_MMA(1, 1, At, B1); PG8_BAR; PG8_SCHED;
            PG8_LDB(B0, 1, 0); PG8_LDB(B1, 1, 1); PG8_SCHED; PG8_LDA(At, 1, 0); PG8_STAGEA(PG8_SA(0, 1), a2, x10, x11);
            PG8_WAIT_V(8); PG8_WAIT_L(0); PG8_BAR; PG8_MMA(0, 0, At, B0); PG8_MMA(0, 1, At, B1); PG8_BAR; PG8_SCHED;
            PG8_LDA(At, 1, 1); PG8_STAGEB(PG8_SB(1, 0), b3); PG8_STAGEB(PG8_SB(1, 1), b3 + hstep); PG8_STAGEA(PG8_SA(1, 0), a3, x00, x01);
            PG8_WAIT_V(8); PG8_WAIT_L(0); PG8_BAR; PG8_MMA(1, 0, At, B0); PG8_MMA(1, 1, At, B1); PG8_BAR; PG8_SCHED;
        }
        if (wr == 0) PG8_BAR;
        E(acc, cur, wr, wc, fr, fq);
        if (!has_next) break;
#pragma unroll
        for (int a = 0; a < 2; ++a)
#pragma unroll
            for (int b = 0; b < 2; ++b)
#pragma unroll
                for (int m = 0; m < 4; ++m)
#pragma unroll
                    for (int n = 0; n < 2; ++n) acc[a][b][m][n] = (f32x4){0.f, 0.f, 0.f, 0.f};
        cur = nxt; cB = nB; oc00 = on00; oc01 = on01; oc10 = on10; oc11 = on11; ++ui;
        if (wr == 1) PG8_BAR;
    }
    PG8_WAIT_V(0);
    PG8_BAR;
#undef PG8_SA
#undef PG8_SB
#undef PG8_STAGEA
#undef PG8_STAGEB
#undef PG8_LDA
#undef PG8_LDB
#undef PG8_MMA
#undef PG8_WAIT_V
#undef PG8_WAIT_L
#undef PG8_BAR
#undef PG8_SCHED
}
}

__device__ __forceinline__ int krow_of(int r) {
    if (r < T) return (r >> 12) * KVROWS + LCTX + (r & 4095);
    const int rc = r - T; return (rc >> 8) * KVROWS + (rc & 255);
}
struct SchedPlain {
    int nM, nN, G, vcu, K; const char* B;
    __device__ __forceinline__ bool next(int i, pg8::Unit& u) const { const int L = i * G + vcu; if (L >= nM * nN) return false; u.pm = L / nN; u.pn = L % nN; u.e = 0; u.cnt = 256; return true; }
    __device__ __forceinline__ unsigned a_off(const pg8::Unit& u, int row, int col) const { return (unsigned)((u.pm * 256 + row) * K + col) * 2u; }
    __device__ __forceinline__ const char* b_ptr(const pg8::Unit& u) const { return B + (size_t)u.pn * 256 * K * 2; }
};
struct EpiG1 {
    static constexpr bool PERM = true;
    bf16 *pu, *q, *kall, *vall, *z;
    __device__ __forceinline__ void operator()(const f32x4 (&acc)[2][2][4][2], const pg8::Unit& u, int wr, int wc, int fr, int fq) const {
        const int row0 = u.pm * 256 + wr * 64 + fr, c8 = wc * 32 + 8 * fq;
#pragma unroll
        for (int ai = 0; ai < 2; ++ai)
#pragma unroll
            for (int m = 0; m < 4; ++m) {
                const int row = row0 + ai * 128 + m * 16;
#pragma unroll
                for (int bj = 0; bj < 2; ++bj) {
                    const f32x4 v0 = acc[ai][bj][m][0], v1 = acc[ai][bj][m][1];
                    v4u w; w.x = pk2(v0[0], v0[1]); w.y = pk2(v0[2], v0[3]); w.z = pk2(v1[0], v1[1]); w.w = pk2(v1[2], v1[3]);
                    bf16* dst;
                    if (u.pn == 0) dst = pu + (size_t)row * 256 + bj * 128 + c8;
                    else if (u.pn <= 2) dst = q + (size_t)row * 512 + (u.pn - 1) * 256 + bj * 128 + c8;
                    else if (u.pn == 3) dst = (bj == 0 ? kall : vall) + (size_t)krow_of(row) * 128 + c8;
                    else dst = z + (size_t)row * 512 + (u.pn - 4) * 256 + bj * 128 + c8;
                    *(v4u*)dst = w;
                }
            }
    }
};
struct EpiG2 {
    static constexpr bool PERM = false;
    const float* xin; const float* cin; float* xout; float* cout; const float* mod;
    __device__ __forceinline__ void operator()(const f32x4 (&acc)[2][2][4][2], const pg8::Unit& u, int wr, int wc, int fr, int fq) const {
        const int rt0 = u.pm * 256; const bool isc = rt0 >= T;
        const int bsel = isc ? 4 : (rt0 >> 12);
        const float* g1 = mod + bsel * 6144 + 2048;
        const float* base = isc ? cin - (size_t)T * 1024 : xin; float* out = isc ? cout - (size_t)T * 1024 : xout;
        const int row0 = rt0 + wr * 64 + fr, col0 = u.pn * 256 + wc * 32 + 4 * fq;
#pragma unroll
        for (int bj = 0; bj < 2; ++bj)
#pragma unroll
            for (int n = 0; n < 2; ++n) {
                const int col = col0 + bj * 128 + n * 16; const f32x4 gv = *(const f32x4*)(g1 + col);
#pragma unroll
                for (int ai = 0; ai < 2; ++ai)
#pragma unroll
                    for (int m = 0; m < 4; ++m) { const size_t off = (size_t)(row0 + ai * 128 + m * 16) * 1024 + col; const f32x4 bs = *(const f32x4*)(base + off); *(f32x4*)(out + off) = bs + gv * acc[ai][bj][m][n]; }
            }
    }
};
struct SchedMoe {
    int G, vcu, K, ntile, mode;
    const char* B; const unsigned* list; const LAS int* tt;
    __device__ __forceinline__ bool next(int i, pg8::Unit& u) const {
        const int L = i * G + vcu; if (L >= ntile * 4) return false;
        const int tau = L >> 2; u.pn = L & 3; u.pm = tau; int e = 0;
#pragma unroll
        for (int k = 1; k < 16; ++k) e += (tt[k] <= tau) ? 1 : 0;
        u.e = e; const int r0 = (tau - tt[e]) * 256; const int c = tt[17 + e] - r0; u.cnt = c < 256 ? c : 256; return true;
    }
    __device__ __forceinline__ unsigned a_off(const pg8::Unit& u, int row, int col) const {
        if (mode == 1) return (unsigned)((u.pm * 256 + row) * K + col) * 2u;
        const int r0 = (u.pm - tt[u.e]) * 256; unsigned tok = 0;
        if (row < u.cnt) tok = list[(size_t)u.e * TT + r0 + row] >> 1;
        return (tok * (unsigned)K + (unsigned)col) * 2u;
    }
    __device__ __forceinline__ const char* b_ptr(const pg8::Unit& u) const { return B + ((size_t)u.e * 1024 + (size_t)u.pn * 256) * K * 2; }
};
struct EpiG3 {
    static constexpr bool PERM = true;
    bf16* act;
    __device__ __forceinline__ void operator()(const f32x4 (&acc)[2][2][4][2], const pg8::Unit& u, int wr, int wc, int fr, int fq) const {
        const int row0 = u.pm * 256 + wr * 64 + fr, c8 = u.pn * 128 + wc * 32 + 8 * fq;
#pragma unroll
        for (int ai = 0; ai < 2; ++ai)
#pragma unroll
            for (int m = 0; m < 4; ++m) {
                float a[8];
#pragma unroll
                for (int n = 0; n < 2; ++n)
#pragma unroll
                    for (int k = 0; k < 4; ++k) { const float g = acc[ai][0][m][n][k], up = acc[ai][1][m][n][k]; a[n * 4 + k] = g / (1.f + __expf(-g)) * up; }
                v4u w; w.x = pk2(a[0], a[1]); w.y = pk2(a[2], a[3]); w.z = pk2(a[4], a[5]); w.w = pk2(a[6], a[7]);
                *(v4u*)(act + (size_t)(row0 + ai * 128 + m * 16) * 512 + c8) = w;
            }
    }
};
struct EpiG4 {
    static constexpr bool PERM = true;
    bf16* y2; const unsigned* list; const float* wts; const LAS int* tt;
    __device__ __forceinline__ void operator()(const f32x4 (&acc)[2][2][4][2], const pg8::Unit& u, int wr, int wc, int fr, int fq) const {
        const int r0 = (u.pm - tt[u.e]) * 256; const int c8 = u.pn * 256 + wc * 32 + 8 * fq;
#pragma unroll
        for (int ai = 0; ai < 2; ++ai)
#pragma unroll
            for (int m = 0; m < 4; ++m) {
                const int row = wr * 64 + fr + ai * 128 + m * 16;
                if (row < u.cnt) {
                    const unsigned ent = list[(size_t)u.e * TT + r0 + row]; const float w = wts[ent];
#pragma unroll
                    for (int bj = 0; bj < 2; ++bj) {
                        const f32x4 v0 = acc[ai][bj][m][0] * w, v1 = acc[ai][bj][m][1] * w;
                        v4u o; o.x = pk2(v0[0], v0[1]); o.y = pk2(v0[2], v0[3]); o.z = pk2(v1[0], v1[1]); o.w = pk2(v1[2], v1[3]);
                        *(v4u*)(y2 + (size_t)ent * 1024 + bj * 128 + c8) = o;
                    }
                }
            }
    }
};

#include <hip/hip_bf16.h>
#include <cmath>
namespace attn_body {
using bf16=__hip_bfloat16;
using bf16x8=__attribute__((ext_vector_type(8)))short;
using s16x4=__attribute__((ext_vector_type(4)))short;
using f32x16=__attribute__((ext_vector_type(16)))float;
using u32x4=__attribute__((ext_vector_type(4)))unsigned;
constexpr int D=64,QP=512,KVP=128,OP=1024;
constexpr int NW=8,QBLK=32,KVBLK=64;
__device__ __forceinline__ int crow(int r,int hi){return (r&3)+8*(r>>2)+4*hi;}
#define SBAR() __builtin_amdgcn_sched_barrier(0)
__device__ __forceinline__ void wmask(f32x16&p0,f32x16&p1,int kp0,int qpos,int hi){
  const float NEG=-INFINITY; const bool tile_ok=(unsigned)kp0<4096u; const int base=kp0+4*hi-qpos+128;
  #pragma unroll
  for(int r=0;r<16;++r){const int dd=base+(r&3)+8*(r>>2); if(!tile_ok||(unsigned)dd>256u)p0[r]=NEG; if(!tile_ok||(unsigned)(dd+32)>256u)p1[r]=NEG;}
}
constexpr int NSLOT=3, SLOTB=8192;
constexpr int LDS_K=0, LDS_V=NSLOT*SLOTB, LDS_WS=2*NSLOT*SLOTB, LDS_OST=LDS_WS+NW*64*4, LDS_BYTES=LDS_OST+NW*4096;
constexpr float C2=0.125f*1.4426950408889634f;
__device__ __forceinline__ void glds16(const void*gsrc,unsigned lds_dst){unsigned keep;
  asm volatile("s_mov_b32 %0, m0\n\ts_mov_b32 m0, %2\n\ts_nop 0\n\tglobal_load_lds_dwordx4 %1, off\n\ts_mov_b32 m0, %0":"=&s"(keep):"v"(gsrc),"s"(lds_dst):"memory");}
__device__ __forceinline__ float max3f(float a,float b,float c){float r;asm("v_max3_f32 %0, %1, %2, %3":"=v"(r):"v"(a),"v"(b),"v"(c));return r;}
__device__ __forceinline__ float max2f(float a,float b){float r;asm("v_max_f32_e32 %0, %1, %2":"=v"(r):"v"(a),"v"(b));return r;}
__device__ __forceinline__ float fadd_s(float a,float b){float r;asm("v_add_f32_e32 %0, %1, %2":"=v"(r):"v"(a),"v"(b));return r;}
__device__ __forceinline__ float fsub_s(float a,float b){float r;asm("v_sub_f32_e32 %0, %1, %2":"=v"(r):"v"(a),"v"(b));return r;}
typedef float f32x2_t __attribute__((ext_vector_type(2))); typedef __bf16 bf16x2_t __attribute__((ext_vector_type(2)));
__device__ __forceinline__ unsigned cvtpk_s(float lo,float hi){f32x2_t v={lo,hi};bf16x2_t b=__builtin_convertvector(v,bf16x2_t);return __builtin_bit_cast(unsigned,b);}
#define WAIT_BAR(N) asm volatile("s_waitcnt vmcnt(" #N ") lgkmcnt(0)\n\ts_barrier":::"memory")

__device__ __forceinline__ void qkt(f32x16&p0,f32x16&p1,const char*Kslot,const bf16x8*qr,const f32x16&negm,int r32,int hi){
  const char*kb=Kslot+hi*1024+r32*16;
  #pragma unroll
  for(int d0=0;d0<4;++d0){
    const bf16x8 b0=*reinterpret_cast<const bf16x8*>(kb+d0*2048);
    const bf16x8 b1=*reinterpret_cast<const bf16x8*>(kb+d0*2048+512);
    if(d0==0){p0=__builtin_amdgcn_mfma_f32_32x32x16_bf16(b0,qr[0],negm,0,0,0);p1=__builtin_amdgcn_mfma_f32_32x32x16_bf16(b1,qr[0],negm,0,0,0);}
    else{p0=__builtin_amdgcn_mfma_f32_32x32x16_bf16(b0,qr[d0],p0,0,0,0);p1=__builtin_amdgcn_mfma_f32_32x32x16_bf16(b1,qr[d0],p1,0,0,0);}}
}
typedef __attribute__((address_space(3))) const char* lds_cptr;
typedef short v4i16_t __attribute__((ext_vector_type(4)));
__device__ __forceinline__ void kload8(bf16x8*kf,lds_cptr kp){
  kf[0]=*(const __attribute__((address_space(3))) bf16x8*)(kp);      kf[1]=*(const __attribute__((address_space(3))) bf16x8*)(kp+512);
  kf[2]=*(const __attribute__((address_space(3))) bf16x8*)(kp+2048); kf[3]=*(const __attribute__((address_space(3))) bf16x8*)(kp+2560);
  kf[4]=*(const __attribute__((address_space(3))) bf16x8*)(kp+4096); kf[5]=*(const __attribute__((address_space(3))) bf16x8*)(kp+4608);
  kf[6]=*(const __attribute__((address_space(3))) bf16x8*)(kp+6144); kf[7]=*(const __attribute__((address_space(3))) bf16x8*)(kp+6656);
}
__device__ __forceinline__ void kload2(bf16x8*kf,lds_cptr kp,int j){ kf[2*j]=*(const __attribute__((address_space(3))) bf16x8*)(kp+j*2048); kf[2*j+1]=*(const __attribute__((address_space(3))) bf16x8*)(kp+j*2048+512); }
__device__ __forceinline__ s16x4 vtr(lds_cptr p){ return __builtin_bit_cast(s16x4,__builtin_amdgcn_ds_read_tr16_b64_v4i16((__attribute__((address_space(3))) v4i16_t*)p)); }
__device__ __forceinline__ float rowmax(const f32x16&p0,const f32x16&p1){
  float a=max3f(p0[0],p0[1],p1[0]),b=max3f(p0[2],p0[3],p1[1]);a=max3f(a,p1[2],p1[3]);
  #pragma unroll
  for(int r=4;r<16;r+=4){a=max3f(a,p0[r],p0[r+1]);b=max3f(b,p0[r+2],p0[r+3]);a=max3f(a,p1[r],p1[r+1]);b=max3f(b,p1[r+2],p1[r+3]);}
  const float m=max2f(a,b);
  auto rr=__builtin_amdgcn_permlane32_swap(__float_as_uint(m),__float_as_uint(m),false,false);
  return max2f(__uint_as_float(rr[0]),__uint_as_float(rr[1]));
}
__device__ __forceinline__ void pv(f32x16*o,int vb,bf16x8 pa0,bf16x8 pa1,bf16x8 pa2,bf16x8 pa3){
  #pragma unroll
  for(int d0=0;d0<2;++d0){s16x4 lo[4],hi[4];
    #pragma unroll
    for(int ks=0;ks<4;++ks){
      asm volatile("ds_read_b64_tr_b16 %0,%1 offset:%c2":"=&v"(lo[ks]):"v"(vb),"i"(d0*4096+ks*1024):"memory");
      asm volatile("ds_read_b64_tr_b16 %0,%1 offset:%c2":"=&v"(hi[ks]):"v"(vb),"i"(d0*4096+ks*1024+512):"memory");}
    asm volatile("s_waitcnt lgkmcnt(0)":::"memory");SBAR();
    #define PK(k) (bf16x8){lo[k][0],lo[k][1],lo[k][2],lo[k][3],hi[k][0],hi[k][1],hi[k][2],hi[k][3]}
    o[d0]=__builtin_amdgcn_mfma_f32_32x32x16_bf16(pa0,PK(0),o[d0],0,0,0);
    o[d0]=__builtin_amdgcn_mfma_f32_32x32x16_bf16(pa1,PK(1),o[d0],0,0,0);
    o[d0]=__builtin_amdgcn_mfma_f32_32x32x16_bf16(pa2,PK(2),o[d0],0,0,0);
    o[d0]=__builtin_amdgcn_mfma_f32_32x32x16_bf16(pa3,PK(3),o[d0],0,0,0);
    #undef PK
  }
}

#ifndef ATTN_STORE16
#define ATTN_STORE16(p,v) (*(u32x4*)(p)=(v))
#endif
template<int THRL> __device__ __forceinline__ void attn_unit(const bf16*Qu,const bf16*__restrict__ Kh,const bf16*__restrict__ Vh,bf16*Ou,const int p0,const int NT,const float* sinkp,const float* qg,const float2* ropet,char*shm){
  int tid=threadIdx.x; asm volatile("":"+v"(tid)); const int lane=tid&63,r32=lane&31,hi=lane>>5; const int wid=__builtin_amdgcn_readfirstlane(tid>>6);
  const int hsub=wid>>1, psub=(wid&1)*QBLK;
  const bf16*Qw=Qu+(long)psub*QP+hsub*D;
  const unsigned lds0=(unsigned)(uintptr_t)shm;
  float*wsf=(float*)(shm+LDS_WS)+wid*64;
  const bf16*ksrc=Kh+(long)lane*KVP+wid*8;
  const bf16*vsrc=Vh+(long)(16*(wid&3)+(lane>>2))*KVP+(wid>>2)*32+(lane&3)*8;
  const unsigned kdst=lds0+LDS_K+wid*1024, vdst=lds0+LDS_V+wid*1024;
  #define KP0(t) (p0-128+64*((t)-4))
  #define TROW(t) ((t)<4?64*(t):(((unsigned)KP0(t)<4096u)?256+KP0(t):256))
  #define DMA_K(t,slot) glds16(ksrc+(long)TROW(t)*KVP,(unsigned)__builtin_amdgcn_readfirstlane(kdst+(slot)))
  #define DMA_V(t,slot) glds16(vsrc+(long)TROW(t)*KVP,(unsigned)__builtin_amdgcn_readfirstlane(vdst+(slot)))
  const int vb0=(int)(lds0+LDS_V)+((lane>>4)&1)*32+(lane&3)*8+(4*hi+((lane&15)>>2))*64;
  const char*Kbase=shm+LDS_K; bf16x8 kf[8];
  const lds_cptr shm3=(lds_cptr)shm; const lds_cptr kp0=shm3+LDS_K+hi*1024+r32*16; const lds_cptr vp0=shm3+LDS_V+((lane>>4)&1)*32+(lane&3)*8+(4*hi+((lane&15)>>2))*64;
  DMA_K(0,0);DMA_V(0,0);DMA_K(1,SLOTB);
  bf16x8 qr[4];
  { bf16x8 qraw[4];
    #pragma unroll
    for(int d0=0;d0<4;++d0)qraw[d0]=*reinterpret_cast<const bf16x8*>(&Qw[(long)r32*QP+d0*16+hi*8]);
    float qf[4][8]; float ss=0.f;
    #pragma unroll
    for(int d0=0;d0<4;++d0)
      #pragma unroll
      for(int j=0;j<8;++j){ qf[d0][j]=__builtin_bit_cast(float,(unsigned)(unsigned short)qraw[d0][j]<<16); ss+=qf[d0][j]*qf[d0][j]; }
    ss+=__shfl_xor(ss,32);
    const float rstd=1.0f/sqrtf(ss*(1.f/64.f)+1e-6f)*C2;
    #pragma unroll
    for(int d0=0;d0<4;++d0)
      #pragma unroll
      for(int j=0;j<8;++j) qf[d0][j]*=rstd*qg[16*d0+8*hi+j];
    if(ropet){ const float2* rp=ropet+(long)(p0+psub+r32)*32+8*hi;
      #pragma unroll
      for(int j=0;j<8;++j){ const float2 c1=rp[j],c2=rp[16+j];
        const float a=qf[0][j],b=qf[1][j],c=qf[2][j],d=qf[3][j];
        qf[0][j]=a*c1.x-b*c1.y; qf[1][j]=b*c1.x+a*c1.y; qf[2][j]=c*c2.x-d*c2.y; qf[3][j]=d*c2.x+c*c2.y; } }
    #pragma unroll
    for(int d0=0;d0<4;++d0){ u32x4 w; w[0]=cvtpk_s(qf[d0][0],qf[d0][1]); w[1]=cvtpk_s(qf[d0][2],qf[d0][3]); w[2]=cvtpk_s(qf[d0][4],qf[d0][5]); w[3]=cvtpk_s(qf[d0][6],qf[d0][7]); qr[d0]=__builtin_bit_cast(bf16x8,w); } }
  float mhat=0.f,l_reg=0.f;f32x16 o[2];o[0]=f32x16{};o[1]=f32x16{};f32x16 negm=f32x16{};asm volatile("":"+v"(negm));
  const int qpos=p0+psub+r32;
  #define CMASK(P0,P1,t) do{ if((t)>=4)wmask(P0,P1,KP0(t),qpos,hi); }while(0)
  bool resc=false;
  #define START(P0,P1) do{ const float rm=rowmax(P0,P1); resc=false; \
    { const float dl=rm; mhat=fadd_s(mhat,dl); \
      _Pragma("unroll") for(int r=0;r<16;++r){P0[r]=fsub_s(P0[r],dl);P1[r]=fsub_s(P1[r],dl);} \
      _Pragma("unroll") for(int r=0;r<16;++r)negm[r]=-mhat; asm volatile("":"+v"(negm)); } \
    _Pragma("unroll") for(int r=0;r<16;++r)P0[r]=__builtin_amdgcn_exp2f(P0[r]); }while(0)
  #define RESC() do{ if(resc){ asm volatile("s_waitcnt lgkmcnt(0)":::"memory"); \
      _Pragma("unroll") for(int d_=0;d_<2;++d_) _Pragma("unroll") for(int r=0;r<16;++r)o[d_][r]*=wsf[crow(r,hi)]; } }while(0)
  f32x16 pA0,pA1,pB0,pB1;
  int sl_prev=0,sl_cur=0,sl_next=SLOTB;
  #define ROT() do{sl_prev=sl_cur;sl_cur=sl_next;sl_next=(sl_next==(NSLOT-1)*SLOTB)?0:sl_next+SLOTB;}while(0)
  DMA_K(2,2*SLOTB);
  WAIT_BAR(3);
  qkt(pA0,pA1,Kbase,qr,negm,r32,hi);asm volatile("s_nop 15\n\ts_nop 7":"+v"(pA0),"+v"(pA1));CMASK(pA0,pA1,0);
  START(pA0,pA1);
  _Pragma("unroll") for(int r=0;r<16;++r)pA1[r]=__builtin_amdgcn_exp2f(pA1[r]);
  WAIT_BAR(0);
  DMA_K(3,0);DMA_V(1,SLOTB);
  ROT();
  kload8(kf,kp0+sl_cur);
  WAIT_BAR(2);
  s16x4 vlo[8],vhi[8]; u32x4 pw0,pw1,pw2,pw3;
  #define PKW(P,B) cvtpk_s(P[B],P[B+1])
  #define PAF(k) __builtin_bit_cast(bf16x8,pw##k)
  #define VFR(i) (bf16x8){vlo[i][0],vlo[i][1],vlo[i][2],vlo[i][3],vhi[i][0],vhi[i][1],vhi[i][2],vhi[i][3]}
  #define PIN(x) asm volatile("":"+v"(x))
  #define MX3(a,b,c) __builtin_fmaxf(__builtin_fmaxf((a),(b)),(c))
  #define GAPA(MF,A0,A1,A2,A3,W0,W1,PW) do{ MF; sacc+=A0; sacc+=A1; sacc+=A2; sacc+=A3; PIN(sacc); W0; W1; PIN(PW); SBAR(); }while(0)
  #define EX(v) __builtin_amdgcn_exp2f(v)
  #define GAPB(MF,X,B) do{ MF; X[B]=EX(X[B]); X[B+1]=EX(X[B+1]); X[B+2]=EX(X[B+2]); X[B+3]=EX(X[B+3]); PIN(X); SBAR(); }while(0)
  #define VRD(i) do{ vlo[i]=vtr(vp_+(((i)>>2)*4096+((i)&3)*1024)); vhi[i]=vtr(vp_+(((i)>>2)*4096+((i)&3)*1024+512)); }while(0)
  #define KRD(G,j) do{ if(G){ kload2(kf,kp0+sl_next,j); SBAR(); } }while(0)
  #define STEP(C0,C1,P0,P1,t,GK,GV,GL) do{ SBAR(); \
    const lds_cptr vp_=vp0+sl_prev; \
    VRD(0); SBAR(); float sacc=(P0[0]+P0[1]); \
    GAPA(C0=__builtin_amdgcn_mfma_f32_32x32x16_bf16(kf[0],qr[0],negm,0,0,0), P0[2],P0[3],P0[4],P0[5],     pw0[0]=PKW(P0,0), pw0[1]=PKW(P0,2), pw0); \
    VRD(4); SBAR(); GAPA(C1=__builtin_amdgcn_mfma_f32_32x32x16_bf16(kf[1],qr[0],negm,0,0,0), P0[6],P0[7],P0[8],P0[9],     pw0[2]=PKW(P0,4), pw0[3]=PKW(P0,6), pw0); \
    VRD(1); SBAR(); GAPA(C0=__builtin_amdgcn_mfma_f32_32x32x16_bf16(kf[2],qr[1],C0,0,0,0),   P0[10],P0[11],P0[12],P0[13], pw1[0]=PKW(P0,8), pw1[1]=PKW(P0,10), pw1); \
    VRD(5); SBAR(); GAPA(C1=__builtin_amdgcn_mfma_f32_32x32x16_bf16(kf[3],qr[1],C1,0,0,0),   P0[14],P0[15],P1[0],P1[1],   pw1[2]=PKW(P0,12),pw1[3]=PKW(P0,14), pw1); \
    VRD(2); SBAR(); GAPA(C0=__builtin_amdgcn_mfma_f32_32x32x16_bf16(kf[4],qr[2],C0,0,0,0),   P1[2],P1[3],P1[4],P1[5],     pw2[0]=PKW(P1,0), pw2[1]=PKW(P1,2), pw2); \
    VRD(6); SBAR(); GAPA(C1=__builtin_amdgcn_mfma_f32_32x32x16_bf16(kf[5],qr[2],C1,0,0,0),   P1[6],P1[7],P1[8],P1[9],     pw2[2]=PKW(P1,4), pw2[3]=PKW(P1,6), pw2); \
    VRD(3); SBAR(); GAPA(C0=__builtin_amdgcn_mfma_f32_32x32x16_bf16(kf[6],qr[3],C0,0,0,0),   P1[10],P1[11],P1[12],P1[13], pw3[0]=PKW(P1,8), pw3[1]=PKW(P1,10), pw3); \
    VRD(7); SBAR(); GAPA(C1=__builtin_amdgcn_mfma_f32_32x32x16_bf16(kf[7],qr[3],C1,0,0,0),   P1[14],P1[15],0.f,0.f,       pw3[2]=PKW(P1,12),pw3[3]=PKW(P1,14), pw3); \
    l_reg+=sacc; \
    if(GK){DMA_K((t)+3,sl_cur);} if(GV){DMA_V((t)+1,sl_next);} \
    CMASK(C0,C1,t); \
    { float a=MX3(C0[0],C0[1],C1[0]),b=MX3(C0[2],C0[3],C1[1]); a=MX3(a,C1[2],C1[3]); \
      _Pragma("unroll") for(int r=4;r<16;r+=4){a=MX3(a,C0[r],C0[r+1]);b=MX3(b,C0[r+2],C0[r+3]);a=MX3(a,C1[r],C1[r+1]);b=MX3(b,C1[r+2],C1[r+3]);} \
      float rm=__builtin_fmaxf(a,b); { auto rr=__builtin_amdgcn_permlane32_swap(__float_as_uint(rm),__float_as_uint(rm),false,false); rm=__builtin_fmaxf(__uint_as_float(rr[0]),__uint_as_float(rr[1])); } \
      resc=false; \
      if(__builtin_expect(__any(rm>(float)THRL),0)){ const float dl=__builtin_fmaxf(rm,0.f); mhat+=dl; \
        _Pragma("unroll") for(int r=0;r<16;++r){C0[r]-=dl;C1[r]-=dl;} \
        _Pragma("unroll") for(int r=0;r<16;++r)negm[r]=-mhat; asm volatile("":"+v"(negm)); \
        const float f=__builtin_amdgcn_exp2f(-dl); l_reg*=f; if(hi==0)wsf[r32]=f; resc=true; } } \
    SBAR(); \
    GAPB(o[0]=__builtin_amdgcn_mfma_f32_32x32x16_bf16(PAF(0),VFR(0),o[0],0,0,0), C0,0); \
    GAPB(o[1]=__builtin_amdgcn_mfma_f32_32x32x16_bf16(PAF(0),VFR(4),o[1],0,0,0), C0,4); \
    KRD(GL,0); GAPB(o[0]=__builtin_amdgcn_mfma_f32_32x32x16_bf16(PAF(1),VFR(1),o[0],0,0,0), C0,8); \
    KRD(GL,1); GAPB(o[1]=__builtin_amdgcn_mfma_f32_32x32x16_bf16(PAF(1),VFR(5),o[1],0,0,0), C0,12); \
    KRD(GL,2); GAPB(o[0]=__builtin_amdgcn_mfma_f32_32x32x16_bf16(PAF(2),VFR(2),o[0],0,0,0), C1,0); \
    KRD(GL,3); GAPB(o[1]=__builtin_amdgcn_mfma_f32_32x32x16_bf16(PAF(2),VFR(6),o[1],0,0,0), C1,4); \
    GAPB(o[0]=__builtin_amdgcn_mfma_f32_32x32x16_bf16(PAF(3),VFR(3),o[0],0,0,0), C1,8); \
    GAPB(o[1]=__builtin_amdgcn_mfma_f32_32x32x16_bf16(PAF(3),VFR(7),o[1],0,0,0), C1,12); \
    }while(0)
  int t=1;
  for(;t+5<NT;t+=2){
    STEP(pB0,pB1,pA0,pA1,t,true,true,true);     WAIT_BAR(2); RESC(); ROT();
    STEP(pA0,pA1,pB0,pB1,t+1,true,true,true);   WAIT_BAR(2); RESC(); ROT();
  }
  #define ENDW(tt) do{ if((tt)+3<NT){WAIT_BAR(2);} else if((tt)+2<NT){WAIT_BAR(1);} else {WAIT_BAR(0);} }while(0)
  for(;t+1<NT;t+=2){
    STEP(pB0,pB1,pA0,pA1,t,(t+3<NT),(t+1<NT),(t+1<NT));       ENDW(t);   RESC(); ROT();
    STEP(pA0,pA1,pB0,pB1,t+1,(t+4<NT),(t+2<NT),(t+2<NT));     ENDW(t+1); RESC(); ROT();
  }
  STEP(pB0,pB1,pA0,pA1,NT-1,false,false,false); RESC();
  { float sacc=pB0[0]+pB0[1]; _Pragma("unroll") for(int r=2;r<16;++r)sacc+=pB0[r]; _Pragma("unroll") for(int r=0;r<16;++r)sacc+=pB1[r]; l_reg+=sacc;
    pw0=(u32x4){PKW(pB0,0),PKW(pB0,2),PKW(pB0,4),PKW(pB0,6)};pw1=(u32x4){PKW(pB0,8),PKW(pB0,10),PKW(pB0,12),PKW(pB0,14)};pw2=(u32x4){PKW(pB1,0),PKW(pB1,2),PKW(pB1,4),PKW(pB1,6)};pw3=(u32x4){PKW(pB1,8),PKW(pB1,10),PKW(pB1,12),PKW(pB1,14)};
    SBAR(); pv(o,vb0+sl_cur,PAF(0),PAF(1),PAF(2),PAF(3)); }
  #undef PKW
  #undef PAF
  #undef VFR
  #undef PIN
  #undef MX3
  #undef GAPA
  #undef GAPB
  #undef EX
  #undef VRD
  #undef KRD
  #undef STEP
  #undef ENDW
  l_reg+=__shfl_xor(l_reg,32);
  l_reg+=__builtin_amdgcn_exp2f(sinkp[hsub]*1.4426950408889634f-mhat);
  if(hi==0)wsf[32+r32]=l_reg;asm volatile("s_waitcnt lgkmcnt(0)":::"memory");
  float rli[16];
  #pragma unroll
  for(int r=0;r<16;++r)rli[r]=__builtin_amdgcn_rcpf(wsf[32+crow(r,hi)]);
  bf16*Ow=Ou+(long)psub*OP+hsub*D;
  { bf16*stg=(bf16*)(shm+LDS_OST)+wid*2048;
    #pragma unroll
    for(int r=0;r<16;++r){const int orow=crow(r,hi);
      #pragma unroll
      for(int d0=0;d0<2;++d0)stg[orow*64+d0*32+r32]=__float2bfloat16(o[d0][r]*rli[r]);}
    asm volatile("s_waitcnt lgkmcnt(0)":::"memory");
    #pragma unroll
    for(int i=0;i<4;++i){const int row=i*8+(lane>>3),ch=lane&7; const u32x4 v=*(const u32x4*)(stg+row*64+ch*8); ATTN_STORE16(Ow+(long)row*OP+ch*8,v);} }
  asm volatile("s_waitcnt lgkmcnt(0)\n\ts_barrier":::"memory");
  #undef DMA_K
  #undef DMA_V
  #undef KP0
  #undef TROW
  #undef CMASK
  #undef START
  #undef RESC
  #undef ROT
}
constexpr int ATTN_LDS_BYTES=LDS_BYTES;
#undef SBAR
#undef WAIT_BAR
}

constexpr int SLAB_PITCH = 288;
typedef short v4i16_t __attribute__((ext_vector_type(4)));
template <int MT, class RowAddr, class Epi>
__device__ __forceinline__ void slab_gemm(LAS unsigned char* lds, const bf16* Cmat, const int K, const RowAddr& RA, const Epi& E) {
    int tid = threadIdx.x; asm volatile("" : "+v"(tid));
    const int wid = tid >> 6, lane = tid & 63;
    LAS bf16* Dr = (LAS bf16*)lds;
    f32x16 acc[MT];
#pragma unroll
    for (int i = 0; i < MT; ++i)
#pragma unroll
        for (int r = 0; r < 16; ++r) acc[i][r] = 0.f;
    const int g = (lane >> 4) & 1, h = lane >> 5, qq = (lane & 15) >> 2, pp = lane & 3;
    const LAS bf16* trp = Dr + (8 * h + qq) * SLAB_PITCH + wid * 32 + 16 * g + 4 * pp;
    for (int kc = 0; kc < K; kc += 128) {
        {
            const int k = tid >> 2, qd = tid & 3;
            const bf16* src = RA(kc + k) + qd * 64;
            v4u v[8];
#pragma unroll
            for (int j = 0; j < 8; ++j) v[j] = *(const v4u*)(src + j * 8);
#pragma unroll
            for (int j = 0; j < 8; ++j) *(LAS v4u*)(Dr + k * SLAB_PITCH + qd * 64 + j * 8) = v[j];
        }
        __syncthreads();
        const int kh = h * 8;
#pragma unroll
        for (int s = 0; s < 8; ++s) {
            const v4i16_t b0 = __builtin_amdgcn_ds_read_tr16_b64_v4i16((LAS v4i16_t*)(trp + (16 * s) * SLAB_PITCH));
            const v4i16_t b1 = __builtin_amdgcn_ds_read_tr16_b64_v4i16((LAS v4i16_t*)(trp + (16 * s + 4) * SLAB_PITCH));
            const bf16x8 bfrag = (bf16x8){b0[0], b0[1], b0[2], b0[3], b1[0], b1[1], b1[2], b1[3]};
#pragma unroll
            for (int mt = 0; mt < MT; ++mt) {
                const bf16x8 afrag = *(const bf16x8*)(Cmat + (size_t)(mt * 32 + (lane & 31)) * K + kc + s * 16 + kh);
                acc[mt] = __builtin_amdgcn_mfma_f32_32x32x16_bf16(afrag, bfrag, acc[mt], 0, 0, 0);
            }
        }
        __syncthreads();
    }
    E(acc, wid, lane);
}

struct Args { const float* in[23]; float* out; unsigned char* ws; int ph_lo, ph_hi; };

struct RowA { const bf16* z; int b, n2; __device__ __forceinline__ const bf16* operator()(int k) const { return z + (size_t)(b * 4096 + 64 * (k & 63) + n2) * 512 + (k >> 6) * 256; } };
struct EpiA { bf16* t2; const float2* tw; int b, n2;
    __device__ __forceinline__ void operator()(const f32x16 (&acc)[4], int wid, int lane) const {
        const int ch = wid * 32 + (lane & 31);
#pragma unroll
        for (int mt = 0; mt < 2; ++mt)
#pragma unroll
            for (int r = 0; r < 16; ++r) {
                const int k1 = 32 * mt + (r & 3) + 8 * (r >> 2) + 4 * (lane >> 5);
                const float2 cs = tw[n2 * k1]; const float re = acc[mt][r], im = acc[mt + 2][r];
                const float re2 = cs.x * re + cs.y * im, im2 = cs.x * im - cs.y * re;
                bf16* d = t2 + ((size_t)((b * 64 + n2) * 64 + k1) * 2) * 256 + ch;
                d[0] = (bf16)f2bf(re2); d[256] = (bf16)f2bf(im2);
            }
    } };
struct RowB { const bf16* t2; int b, k1; __device__ __forceinline__ const bf16* operator()(int k) const { return t2 + ((size_t)((b * 64 + (k & 63)) * 64 + k1) * 2 + (k >> 6)) * 256; } };
struct EpiB { bf16* mrg; int b, k1;
    __device__ __forceinline__ void operator()(const f32x16 (&acc)[2], int wid, int lane) const {
        const int ch = wid * 32 + (lane & 31);
#pragma unroll
        for (int mt = 0; mt < 2; ++mt)
#pragma unroll
            for (int r = 0; r < 16; ++r) { const int k2 = 32 * mt + (r & 3) + 8 * (r >> 2) + 4 * (lane >> 5); mrg[(size_t)(b * 4096 + k1 + 64 * k2) * 1024 + 768 + ch] = (bf16)f2bf(DBG_NO_FOUR ? 0.f : acc[mt][r]); }
    } };
struct RowC { const bf16* z; int b; __device__ __forceinline__ const bf16* operator()(int k) const { return z + (size_t)(T + b * 256 + (k & 255)) * 512 + (k >> 8) * 256; } };
struct EpiC { bf16* mrg; int b, mt0;
    __device__ __forceinline__ void operator()(const f32x16 (&acc)[1], int wid, int lane) const {
        const int ch = wid * 32 + (lane & 31);
#pragma unroll
        for (int mt = 0; mt < 1; ++mt)
#pragma unroll
            for (int r = 0; r < 16; ++r) { const int kk = 32 * (mt0 + mt) + (r & 3) + 8 * (r >> 2) + 4 * (lane >> 5); mrg[(size_t)(T + b * 256 + kk) * 1024 + 768 + ch] = (bf16)f2bf(DBG_NO_FOUR ? 0.f : acc[mt][r]); }
    } };

__device__ __forceinline__ void tr_block(const float* src, int ldS, bf16* dst, int ldD, LAS float* scr, int lane) {
#pragma unroll 8
    for (int i = 0; i < 32; ++i) { const int kk = 2 * i + (lane >> 5); scr[kk * 33 + (lane & 31)] = src[(size_t)kk * ldS + (lane & 31)]; }
    LDS_WAIT(); asm volatile("" ::: "memory");
    const int c = lane & 7;
#pragma unroll
    for (int j = 0; j < 4; ++j) { const int n = (lane >> 3) + 8 * j; const LAS float* s = scr + (8 * c) * 33 + n;
        v4u o; o.x = pk2(s[0 * 33], s[1 * 33]); o.y = pk2(s[2 * 33], s[3 * 33]); o.z = pk2(s[4 * 33], s[5 * 33]); o.w = pk2(s[6 * 33], s[7 * 33]);
        *(GAS v4u*)(dst + (size_t)n * ldD + 8 * c) = o; }
    LDS_WAIT(); asm volatile("" ::: "memory");
}


__device__ __forceinline__ void tr_block64(const float* src, int ldS, bf16* dst, int ldD, LAS bf16* scr, int lane) {
    const int kr = lane >> 4, nc = lane & 15;
    f32x4 v[16];
#pragma unroll
    for (int i = 0; i < 16; ++i) v[i] = *(const f32x4*)(src + (size_t)(4 * i + kr) * ldS + 4 * nc);
#pragma unroll
    for (int i = 0; i < 16; ++i) { const int k = 4 * i + kr;
#pragma unroll
        for (int j = 0; j < 4; ++j) scr[(4 * nc + j) * 66 + k] = (bf16)f2bf(v[i][j]); }
    LDS_WAIT(); asm volatile("" ::: "memory");
    const int c = lane & 7;
#pragma unroll
    for (int j = 0; j < 8; ++j) { const int n = (lane >> 3) + 8 * j; const LAS unsigned* p = (const LAS unsigned*)(scr + n * 66 + 8 * c);
        v4u o; o.x = p[0]; o.y = p[1]; o.z = p[2]; o.w = p[3];
        *(GAS v4u*)(dst + (size_t)n * ldD + 8 * c) = o; }
    LDS_WAIT(); asm volatile("" ::: "memory");
}

typedef const __attribute__((address_space(4))) Args* kargs_t;
__device__ __forceinline__ kargs_t ka_launder() { kargs_t p = (kargs_t)__builtin_amdgcn_kernarg_segment_ptr(); asm volatile("" : "+s"(p)); return p; }
__device__ __forceinline__ int tid_launder() { int t = threadIdx.x; asm volatile("" : "+v"(t)); return t; }
#define KA_DECL const kargs_t KA = ka_launder(); const int tid = tid_launder(); const int lane = tid & 63; const int wave = __builtin_amdgcn_readfirstlane(tid >> 6); const int gw = vcu * 8 + wave; const int gt = vcu * 512 + tid; (void)lane; (void)wave; (void)gw; (void)gt;
#define ws (KA->ws)
#define ctl ((gu32*)(ws + O_CTL))
#define x_in (KA->in[0])
#define c_in (KA->in[1])
#define ctx_in (KA->in[2])
#define cctx_in (KA->in[3])
#define w_mod (KA->in[4])
#define b_mod (KA->in[5])
#define norm1_g (KA->in[6])
#define w_in (KA->in[7])
#define q_norm_g (KA->in[8])
#define k_norm_g (KA->in[9])
#define attn_sink (KA->in[10])
#define pool_w (KA->in[11])
#define pool_scale (KA->in[12])
#define four_w (KA->in[13])
#define w_out (KA->in[14])
#define norm2_g (KA->in[15])
#define w_grp (KA->in[16])
#define b_grp (KA->in[17])
#define w_rtr (KA->in[18])
#define b_rtr (KA->in[19])
#define w_gate (KA->in[20])
#define w_up (KA->in[21])
#define w_down (KA->in[22])
#define outp (KA->out)
#define modv ((float*)(ws + O_MOD))
#define rope ((float2*)(ws + O_ROPE))
#define twt ((float2*)(ws + O_TW))
#define fma ((bf16*)(ws + O_FMA))
#define fmb ((bf16*)(ws + O_FMB))
#define fmc ((bf16*)(ws + O_FMC))
#define hbuf ((bf16*)(ws + O_H))
#define kall ((bf16*)(ws + O_KALL))
#define vall ((bf16*)(ws + O_VALL))
#define xc ((float*)(ws + O_XC))
#define list ((unsigned*)(ws + O_LIST))
#define wts ((float*)(ws + O_WTS))
#define act ((bf16*)(ws + O_ACT))
#define t2 ((bf16*)(ws + O_T2))
#define mrg ((bf16*)(ws + O_MRG))
#define qb ((bf16*)(ws + O_Q))
#define pu ((bf16*)(ws + O_PU))
#define zb ((bf16*)(ws + O_Z))
#define y2 ((bf16*)(ws + O_Y2))

#ifndef PH_MASK
#define PH_MASK 0x3ffff
#endif
#define IN(k) (lo <= (k) && (k) < hi && ((PH_MASK >> (k)) & 1))
#define SEAM(k) do { if (IN(k) && IN((k) + 1)) xcd_barrier(bar); } while (0)
#define modl (modv + (size_t)l * 5 * 6144)
#define win_t ((bf16*)(ws + O_WIN + l * SZ_WIN1))
#define wout_t ((bf16*)(ws + O_WOUT + l * SZ_WOUT1))
#define wgu_t ((bf16*)(ws + O_WGU + l * SZ_WGU1))
#define wd_t ((bf16*)(ws + O_WD + l * SZ_WD1))
template <int l> __device__ __forceinline__ void layer_body(LAS unsigned char* lds, const int G, const int vcu, const XcdBarrier& bar, const int lo, const int hi) {
    const int NGW = G * 8, NGT = G * 512; LAS int* ttab = (LAS int*)(lds + TILE_OFF);
    constexpr int P = 1 + 8 * l;

        for (int rep_ = 0; rep_ < 1 + ((l == 0) ? ((REP_MASK >> (1 + 0)) & 1) : 0); ++rep_)
        if (IN(P + 0)) {
            KA_DECL
            const float* modp = modv;
#pragma clang loop vectorize(disable) unroll(disable)
            for (int r = gw; r < TT; r += NGW) {
                const bool isc = r >= T; const int bsel = isc ? 4 : (r >> 12);
                const float* src = (l == 0) ? (isc ? ctx_in + (size_t)(r - T) * 1024 : x_in + (size_t)r * 1024) : (isc ? xc + (size_t)(r - T) * 1024 : outp + (size_t)r * 1024);
                f32x4 v[4];
#pragma unroll
                for (int j = 0; j < 4; ++j) v[j] = *(const f32x4*)(src + 4 * lane + 256 * j);
                if (l == 1) {
                    const float w0 = wts[2 * r], w1 = wts[2 * r + 1]; const float* g2 = modp + bsel * 6144 + 5 * 1024;
                    float* dst = isc ? xc + (size_t)(r - T) * 1024 : outp + (size_t)r * 1024;
#pragma unroll
                    for (int j = 0; j < 4; ++j) {
                        const v2u ya = *(const v2u*)(y2 + (size_t)(2 * r) * 1024 + 4 * lane + 256 * j), yb = *(const v2u*)(y2 + (size_t)(2 * r + 1) * 1024 + 4 * lane + 256 * j);
                        const f32x4 gv = *(const f32x4*)(g2 + 4 * lane + 256 * j);
                        f32x4 yy; yy[0] = bflo(ya.x) + bflo(yb.x); yy[1] = bfhi(ya.x) + bfhi(yb.x); yy[2] = bflo(ya.y) + bflo(yb.y); yy[3] = bfhi(ya.y) + bfhi(yb.y);
                        if (DBG_NO_MOE) yy = (f32x4){0.f, 0.f, 0.f, 0.f};
                yy = yy * DBG_MOE_SCALE;
                        yy = yy * DBG_MOE_SCALE;
                        v[j] = v[j] + gv * yy; *(f32x4*)(dst + 4 * lane + 256 * j) = v[j];
                    }
                    (void)w0; (void)w1;
                }
                float ss = 0.f;
#pragma unroll
                for (int j = 0; j < 4; ++j) ss += (v[j][0] * v[j][0] + v[j][1] * v[j][1]) + (v[j][2] * v[j][2] + v[j][3] * v[j][3]);
                const float rstd = 1.0f / sqrtf(wave_sum(ss) * (1.f / 1024.f) + 1e-6f);
                const float* sh = modl + bsel * 6144; const float* sc = sh + 1024; const float* gn = norm1_g + l * 1024;
#pragma unroll
                for (int j = 0; j < 4; ++j) {
                    const int c0 = 4 * lane + 256 * j; const f32x4 g = *(const f32x4*)(gn + c0), s1 = *(const f32x4*)(sc + c0), h1 = *(const f32x4*)(sh + c0);
                    const f32x4 y = (v[j] * rstd) * g * (s1 + 1.0f) + h1;
                    v2u o; o.x = pk2(y[0], y[1]); o.y = pk2(y[2], y[3]); *(v2u*)(hbuf + (size_t)r * 1024 + c0) = o;
                }
            }
        }
        SEAM(P + 0);
        for (int rep_ = 0; rep_ < 1 + ((l == 0) ? ((REP_MASK >> (1 + 1)) & 1) : 0); ++rep_)
        if (IN(P + 1)) {
            KA_DECL
            SchedPlain S{TT / 256, 6, G, vcu, 1024, (const char*)win_t};
            EpiG1 E{pu, qb, kall, vall, zb};
            pg8::gemm_phase<EpiG1, SchedPlain>(lds, (const char*)hbuf, 1024, S, E);
        }
        SEAM(P + 1);
        for (int rep_ = 0; rep_ < 1 + ((l == 0) ? ((REP_MASK >> 3) & 1) : 0); ++rep_)
        if (IN(P + 2)) {
            KA_DECL
            __syncthreads();
            for (int it = vcu; it < 256; it += G) {
                const int b = it >> 6, n2 = it & 63;
                RowA ra{zb, b, n2}; EpiA ea{t2, twt, b, n2};
                slab_gemm<4, RowA, EpiA>(lds, fma, 128, ra, ea);
            }
            if (rep_ == 0)
#pragma clang loop vectorize(disable) unroll(disable)
            for (int i = gt; i < TT * 2; i += NGT) {
                const int r = i >> 1, hs = 8 + (i & 1); const bool isk = true; const bool isc = r >= T;
                bf16* p = isk ? kall + (size_t)krow_of(r) * 128 + (hs - 8) * 64 : qb + (size_t)r * 512 + hs * 64;
                float xv[64];
#pragma unroll
                for (int j = 0; j < 8; ++j) { const v4u w = *(const v4u*)(p + 8 * j); xv[8 * j] = bflo(w.x); xv[8 * j + 1] = bfhi(w.x); xv[8 * j + 2] = bflo(w.y); xv[8 * j + 3] = bfhi(w.y); xv[8 * j + 4] = bflo(w.z); xv[8 * j + 5] = bfhi(w.z); xv[8 * j + 6] = bflo(w.w); xv[8 * j + 7] = bfhi(w.w); }
                float ss = 0.f;
#pragma unroll
                for (int d = 0; d < 64; ++d) ss += xv[d] * xv[d];
                const float rstd = 1.0f / sqrtf(ss * (1.f / 64.f) + 1e-6f);
                const float* gg = (isk ? k_norm_g : q_norm_g) + l * 64;
#pragma unroll
                for (int d = 0; d < 64; ++d) { xv[d] = xv[d] * rstd * gg[d]; if ((d & 7) == 7) asm volatile("" ::: "memory"); }
                if (!isc) {
                    const float2* rp = rope + (size_t)(r & 4095) * 32;
#pragma unroll
                    for (int d = 0; d < 16; ++d) {
                        const float2 c1 = rp[d], c2 = rp[16 + d];
                        const float a = xv[d], bb = xv[16 + d], cc = xv[32 + d], dd = xv[48 + d];
                        xv[d] = a * c1.x - bb * c1.y; xv[16 + d] = bb * c1.x + a * c1.y;
                        xv[32 + d] = cc * c2.x - dd * c2.y; xv[48 + d] = dd * c2.x + cc * c2.y;
                        if ((d & 3) == 3) asm volatile("" ::: "memory");
                    }
                }
                const float sc = isk ? 1.0f : QSCALE;
#pragma unroll
                for (int j = 0; j < 8; ++j) { v4u w; w.x = pk2(xv[8 * j] * sc, xv[8 * j + 1] * sc); w.y = pk2(xv[8 * j + 2] * sc, xv[8 * j + 3] * sc); w.z = pk2(xv[8 * j + 4] * sc, xv[8 * j + 5] * sc); w.w = pk2(xv[8 * j + 6] * sc, xv[8 * j + 7] * sc); *(v4u*)(p + 8 * j) = w; }
            }
            const int prow = (l == 0) ? TT : T;
#pragma clang loop vectorize(disable) unroll(disable)
            for (int i = gt; i < prow * 32; i += NGT) {
                const int r = i >> 5, ck = i & 31, g = ck >> 3; const bool isc = r >= T;
                const int nseq = isc ? LCTX : NSEQ; const int rbase = isc ? T + ((r - T) & ~255) : (r & ~4095); const int n = r - rbase;
                const int hw = 1 << g;
                int lo_ = n - hw; lo_ = lo_ < 0 ? 0 : lo_; int hi_ = n + hw - 1; hi_ = hi_ > nseq - 1 ? nseq - 1 : hi_;
                float s[8] = {0.f, 0.f, 0.f, 0.f, 0.f, 0.f, 0.f, 0.f};
                for (int tpos = lo_; tpos <= hi_; ++tpos) { const v4u w = *(const v4u*)(pu + (size_t)(rbase + tpos) * 256 + ck * 8);
                    s[0] += bflo(w.x); s[1] += bfhi(w.x); s[2] += bflo(w.y); s[3] += bfhi(w.y); s[4] += bflo(w.z); s[5] += bfhi(w.z); s[6] += bflo(w.w); s[7] += bfhi(w.w); }
                const v4u w = *(const v4u*)(pu + (size_t)r * 256 + ck * 8); const float ic = 1.0f / (float)(hi_ - lo_ + 1);
                v4u o; o.x = pk2(s[0] * ic - bflo(w.x), s[1] * ic - bfhi(w.x)); o.y = pk2(s[2] * ic - bflo(w.y), s[3] * ic - bfhi(w.y));
                o.z = pk2(s[4] * ic - bflo(w.z), s[5] * ic - bfhi(w.z)); o.w = pk2(s[6] * ic - bflo(w.w), s[7] * ic - bfhi(w.w));
                if (DBG_NO_POOL) o = (v4u){0u, 0u, 0u, 0u};
                *(v4u*)(mrg + (size_t)r * 1024 + ck * 8) = o;
            }
        }
        SEAM(P + 2);
        for (int rep_ = 0; rep_ < 1 + ((l == 0) ? ((REP_MASK >> (1 + 3)) & 1) : 0); ++rep_)
        if (IN(P + 3)) {
            KA_DECL
            const int n_att = 512 + (l == 0 ? 32 : 0), n_fb = 256, n_cf = (l == 0 ? 32 : 0);
            for (int it = vcu; it < n_att + n_fb + n_cf; it += G) {
#ifndef NO_ATT
                if (it < n_att) { if (rep_ == 0 || ((REP_MASK >> 9) & 1)) {
                    const bool cu = it >= 512; const int uidx = cu ? it - 512 : it;
                    const int b = cu ? (uidx >> 3) : (uidx >> 7), kvh = cu ? ((uidx >> 2) & 1) : ((uidx >> 6) & 1), pb = cu ? (uidx & 3) : (uidx & 63);
                    const int p0 = pb * 64; const int qrow0 = cu ? T + b * 256 + p0 : b * 4096 + p0;
                    const attn_body::bf16* Qu = (const attn_body::bf16*)(qb + (size_t)qrow0 * 512 + kvh * 256);
                    const attn_body::bf16* Kh = (const attn_body::bf16*)(kall + (size_t)b * KVROWS * 128 + kvh * 64);
                    const attn_body::bf16* Vh = (const attn_body::bf16*)(vall + (size_t)b * KVROWS * 128 + kvh * 64);
                    attn_body::bf16* Ou = (attn_body::bf16*)(mrg + (size_t)qrow0 * 1024 + 256 + kvh * 256);
                    attn_body::attn_unit<8>(Qu, Kh, Vh, Ou, p0, cu ? 4 : 10, attn_sink + l * 8 + kvh * 4, q_norm_g + l * 64, cu ? (const float2*)nullptr : (const float2*)rope, (char*)lds);
                    __syncthreads(); }
                } else
#endif
#ifndef NO_FB
                if (it < n_att + n_fb) { if (rep_ == 0 || ((REP_MASK >> 10) & 1)) {
                    const int u2 = it - n_att; const int b = u2 >> 6, k1 = u2 & 63;
                    RowB rb{t2, b, k1}; EpiB eb{mrg, b, k1};
                    slab_gemm<2, RowB, EpiB>(lds, fmb, 128, rb, eb); }
                } else
#endif
                {
#ifndef NO_CF
                    if (rep_ == 0 || ((REP_MASK >> 11) & 1)) {
                    const int b = (it - n_att - n_fb) >> 3, mt0 = (it - n_att - n_fb) & 7;
                    RowC rc{zb, b}; EpiC ec{mrg, b, mt0};
                    slab_gemm<1, RowC, EpiC>(lds, fmc + (size_t)mt0 * 32 * 512, 512, rc, ec); }
#endif
                }
            }
        }
        SEAM(P + 3);
        for (int rep_ = 0; rep_ < 1 + ((l == 0) ? ((REP_MASK >> (1 + 4)) & 1) : 0); ++rep_)
        if (IN(P + 4)) {
            KA_DECL
            SchedPlain S{(l == 0 ? TT : T) / 256, 4, G, vcu, 1024, (const char*)wout_t};
            EpiG2 E{(l == 0) ? x_in : outp, ctx_in, outp, xc, modl};
            pg8::gemm_phase<EpiG2, SchedPlain>(lds, (const char*)mrg, 1024, S, E);
        }
        SEAM(P + 4);
        for (int rep_ = 0; rep_ < 1 + ((l == 0) ? ((REP_MASK >> 6) & 1) : 0); ++rep_)
        if (IN(P + 5)) {
            KA_DECL
            __syncthreads();
            LAS float* rw = (LAS float*)lds;
            LAS int* lcnt = (LAS int*)(lds + 81920);
            LAS unsigned* lent = (LAS unsigned*)(lds + 81920 + 256);
            LAS unsigned* lrank = lent + 1024;
            for (int i = tid; i < 1024 * 20; i += 512) { const int d = i / 20, j = i % 20;
                rw[((((j >> 2) * 4 + (d >> 8)) * 4 + (d & 3)) * 64 + ((d & 255) >> 2)) * 4 + (j & 3)] = (j < 4) ? w_grp[(size_t)l * 4096 + d * 4 + j] : w_rtr[(size_t)l * 16384 + d * 16 + (j - 4)]; }
            if (tid < 33) lcnt[tid] = 0;
            __syncthreads();
            const int nrows = (l == 0) ? TT : T; int nloc = 0;
#pragma clang loop vectorize(disable) unroll(disable)
            for (int r = gw; r < nrows; r += NGW) {
                const bool isc = r >= T; const int bsel = isc ? 4 : (r >> 12);
                const float* src = isc ? xc + (size_t)(r - T) * 1024 : outp + (size_t)r * 1024;
                f32x4 v[4]; float ss = 0.f;
#pragma unroll
                for (int j = 0; j < 4; ++j) { v[j] = *(const f32x4*)(src + 4 * lane + 256 * j); ss += (v[j][0] * v[j][0] + v[j][1] * v[j][1]) + (v[j][2] * v[j][2] + v[j][3] * v[j][3]); }
                const float rstd = 1.0f / sqrtf(wave_sum(ss) * (1.f / 1024.f) + 1e-6f);
                const float* sh = modl + bsel * 6144 + 3 * 1024; const float* sc = sh + 1024; const float* gn = norm2_g + l * 1024;
                float lg[20];
#pragma unroll
                for (int j = 0; j < 20; ++j) lg[j] = 0.f;
#pragma unroll
                for (int j = 0; j < 4; ++j) {
                    const int c0 = 4 * lane + 256 * j; const f32x4 g = *(const f32x4*)(gn + c0), s1 = *(const f32x4*)(sc + c0), h1 = *(const f32x4*)(sh + c0);
                    const f32x4 y = (v[j] * rstd) * g * (s1 + 1.0f) + h1;
                    v2u o; o.x = pk2(y[0], y[1]); o.y = pk2(y[2], y[3]); *(v2u*)(hbuf + (size_t)r * 1024 + c0) = o;
#pragma unroll
                    for (int e = 0; e < 4; ++e) {
#pragma unroll
                        for (int q5 = 0; q5 < 5; ++q5) { const f32x4 wv = *(const LAS f32x4*)(rw + (((q5 * 4 + j) * 4 + e) * 64 + lane) * 4); lg[4 * q5] += y[e] * wv[0]; lg[4 * q5 + 1] += y[e] * wv[1]; lg[4 * q5 + 2] += y[e] * wv[2]; lg[4 * q5 + 3] += y[e] * wv[3]; }
                        __builtin_amdgcn_sched_barrier(0); }
                }
#pragma unroll
                for (int j = 0; j < 20; ++j) lg[j] = wave_sum(lg[j]);
                float gl[4]; float gm = -1e30f;
#pragma unroll
                for (int j = 0; j < 4; ++j) { gl[j] = lg[j] + b_grp[l * 4 + j]; gm = fmaxf(gm, gl[j]); }
                float gs = 0.f; int gi = 0; float gb = -1e30f;
#pragma unroll
                for (int j = 0; j < 4; ++j) { const float e = expf(gl[j] - gm); gs += e; if (gl[j] > gb) { gb = gl[j]; gi = j; } }
                const float pg = expf(gb - gm) / gs;
                float el[4]; float em = -1e30f;
#pragma unroll
                for (int j = 0; j < 4; ++j) { float t_ = 0.f;
#pragma unroll
                    for (int g4 = 0; g4 < 4; ++g4) t_ = (gi == g4) ? (lg[4 + g4 * 4 + j] + b_rtr[l * 16 + g4 * 4 + j]) : t_;
                    el[j] = t_; em = fmaxf(em, t_); }
                float pe[4];
#pragma unroll
                for (int j = 0; j < 4; ++j) pe[j] = expf(el[j] - em);
                int i0 = 0; float b0 = -1.f;
#pragma unroll
                for (int j = 0; j < 4; ++j) if (pe[j] > b0) { b0 = pe[j]; i0 = j; }
                int i1 = 0; float b1 = -1.f;
#pragma unroll
                for (int j = 0; j < 4; ++j) if (j != i0 && pe[j] > b1) { b1 = pe[j]; i1 = j; }
                const float wsum = b0 + b1; const float w0 = pg * b0 / wsum, w1 = pg * b1 / wsum;
                if (lane == 0 && rep_ == 0) {
                    wts[2 * r] = w0; wts[2 * r + 1] = w1;
                    ((int*)(ws + O_EID))[2 * r] = gi * 4 + i0; ((int*)(ws + O_EID))[2 * r + 1] = gi * 4 + i1;
                    const int e0 = gi * 4 + i0, e1 = gi * 4 + i1;
                    const int s0 = __hip_atomic_fetch_add((LAS int*)(lcnt + 16 + 16), 1, __ATOMIC_RELAXED, __HIP_MEMORY_SCOPE_WORKGROUP);
                    const int k0 = __hip_atomic_fetch_add((LAS int*)(lcnt + e0), 1, __ATOMIC_RELAXED, __HIP_MEMORY_SCOPE_WORKGROUP);
                    const int k1 = __hip_atomic_fetch_add((LAS int*)(lcnt + e1), 1, __ATOMIC_RELAXED, __HIP_MEMORY_SCOPE_WORKGROUP);
                    lent[2 * s0] = ((unsigned)(2 * r) << 4) | (unsigned)e0; lrank[2 * s0] = (unsigned)k0;
                    lent[2 * s0 + 1] = ((unsigned)(2 * r + 1) << 4) | (unsigned)e1; lrank[2 * s0 + 1] = (unsigned)k1;
                }
                ++nloc;
            }
            (void)nloc;
            __syncthreads();
            if (tid < 16 && rep_ == 0) { const int c = lcnt[tid]; lcnt[16 + tid] = c ? (int)__hip_atomic_fetch_add((unsigned*)(ctl + CW_CNT + (l * 16 + tid) * 64), (unsigned)c, RLX_AGENT) : 0; }
            __syncthreads();
            const int ntot = rep_ == 0 ? 2 * lcnt[32] : 0;
            for (int i = tid; i < ntot; i += 512) { const unsigned en = lent[i]; const int e = en & 15; list[(size_t)e * TT + lcnt[16 + e] + lrank[i]] = en >> 4; }
            __syncthreads();
        }
        SEAM(P + 5);
        if (IN(P + 6) || IN(P + 7)) {
            KA_DECL
            __syncthreads();
            if (tid == 0) { int acc_ = 0; for (int e = 0; e < 16; ++e) { const int c = (int)__hip_atomic_load((unsigned*)(ctl + CW_CNT + (l * 16 + e) * 64), RLX_AGENT); ttab[e] = acc_; ttab[17 + e] = c; acc_ += (c + 255) >> 8; } ttab[16] = acc_; }
            __syncthreads();
        }
        if (DBG_NAIVE_MOE && IN(P + 6)) {
            KA_DECL
            const int nrows = (l == 0) ? TT : T; LAS float* hs = (LAS float*)lds; LAS float* as = hs + 1024;
            const int* eidg = (const int*)(ws + O_EID);
            LAS float* lgs = as + 512; LAS float* rt = lgs + 32;
            for (int r = vcu; r < nrows; r += G) {
                __syncthreads();
                for (int i = tid; i < 1024; i += 512) hs[i] = bf2f(hbuf[(size_t)r * 1024 + i]);
                __syncthreads();
                if (tid < 20) { float a = 0.f; for (int k = 0; k < 1024; ++k) a += hs[k] * ((tid < 4) ? w_grp[(size_t)l * 4096 + k * 4 + tid] : w_rtr[(size_t)l * 16384 + k * 16 + (tid - 4)]);
                    lgs[tid] = a + ((tid < 4) ? b_grp[l * 4 + tid] : b_rtr[l * 16 + tid - 4]); }
                __syncthreads();
                if (tid == 0) { int gi = 0; for (int j = 1; j < 4; ++j) if (lgs[j] > lgs[gi]) gi = j; float gs = 0.f; for (int j = 0; j < 4; ++j) gs += expf(lgs[j] - lgs[gi]); const float pg = 1.f / gs;
                    int i0 = 0; for (int j = 1; j < 4; ++j) if (lgs[4 + gi * 4 + j] > lgs[4 + gi * 4 + i0]) i0 = j; int i1 = -1; for (int j = 0; j < 4; ++j) if (j != i0 && (i1 < 0 || lgs[4 + gi * 4 + j] > lgs[4 + gi * 4 + i1])) i1 = j;
                    const float p0 = 1.f, p1 = expf(lgs[4 + gi * 4 + i1] - lgs[4 + gi * 4 + i0]); rt[0] = (float)(gi * 4 + i0); rt[1] = (float)(gi * 4 + i1); rt[2] = pg * p0 / (p0 + p1); rt[3] = pg * p1 / (p0 + p1); }
                __syncthreads();
                for (int sl = 0; sl < 2; ++sl) {
                    const int e = (DBG_NAIVE_ROUTE & 1) ? (int)rt[sl] : eidg[2 * r + sl]; const float w = (DBG_NAIVE_ROUTE & 2) ? rt[2 + sl] : wts[2 * r + sl];
                    __syncthreads();
                    const float* Wg = w_gate + (size_t)(l * 16 + e) * 1024 * 512 + tid; const float* Wu = w_up + (size_t)(l * 16 + e) * 1024 * 512 + tid;
                    float g = 0.f, u = 0.f;
#pragma unroll 8
                    for (int k = 0; k < 1024; ++k) { g += hs[k] * Wg[(size_t)k * 512]; u += hs[k] * Wu[(size_t)k * 512]; }
                    as[tid] = g / (1.f + expf(-g)) * u;
                    __syncthreads();
                    const float* Wd = w_down + (size_t)(l * 16 + e) * 512 * 1024 + tid;
                    float y0 = 0.f, y1 = 0.f;
#pragma unroll 8
                    for (int j = 0; j < 512; ++j) { y0 += as[j] * Wd[(size_t)j * 1024]; y1 += as[j] * Wd[(size_t)j * 1024 + 512]; }
                    y2[(size_t)(2 * r + sl) * 1024 + tid] = (bf16)f2bf(y0 * w); y2[(size_t)(2 * r + sl) * 1024 + 512 + tid] = (bf16)f2bf(y1 * w);
                }
            }
        }
        for (int rep_ = 0; rep_ < 1 + ((l == 0) ? ((REP_MASK >> 7) & 1) : 0); ++rep_)
        if (!DBG_NAIVE_MOE && IN(P + 6)) {
            KA_DECL
            SchedMoe S{G, vcu, 1024, ttab[16], 0, (const char*)wgu_t, list, ttab};
            EpiG3 E{act};
            pg8::gemm_phase<EpiG3, SchedMoe>(lds, (const char*)hbuf, 1024, S, E);
        }
        SEAM(P + 6);
        for (int rep_ = 0; rep_ < 1 + ((l == 0) ? ((REP_MASK >> 8) & 1) : 0); ++rep_)
        if (!DBG_NAIVE_MOE && IN(P + 7)) {
            KA_DECL
            SchedMoe S{G, vcu, 512, ttab[16], 1, (const char*)wd_t, list, ttab};
            EpiG4 E{y2, list, wts, ttab};
            pg8::gemm_phase<EpiG4, SchedMoe>(lds, (const char*)act, 512, S, E);
        }
        SEAM(P + 7);
    }

__global__ void __launch_bounds__(512, 2) fwd_kernel(Args args) {
    extern __shared__ __attribute__((aligned(16))) unsigned char lds_raw[];
    LAS unsigned char* lds = (LAS unsigned char*)lds_raw;
    const int tid = threadIdx.x, lane = tid & 63, wave = __builtin_amdgcn_readfirstlane(tid >> 6);
    const int G = gridDim.x; const int bx = blockIdx.x; const int vcu = (G % 8 == 0) ? (bx % 8) * (G / 8) + bx / 8 : bx;
    volatile LAS unsigned* MISC = (volatile LAS unsigned*)(lds + MISC_OFF);
    LAS float* trig = (LAS float*)(lds + TRIG_OFF);
    LAS int* ttab = (LAS int*)(lds + TILE_OFF);
    for (int u = tid; u < (LDS_BYTES - LDSCTL_OFF) / 4; u += 512) ((LAS unsigned*)(lds + LDSCTL_OFF))[u] = 0u;
    __syncthreads();
    if (tid < 64) { float s, c; sincospif((float)tid / 32.f, &s, &c); trig[tid] = c; trig[64 + tid] = s; }
    __syncthreads();
    XcdBarrier bar; bar.bar = nullptr; bar.x = 0; bar.st = nullptr;
    if (!MK_SPLIT) { KA_DECL bar = xcd_barrier_post((unsigned*)(ctl + CW_BAR), MISC + 8); }
    const int lo = args.ph_lo, hi = args.ph_hi;
    const int NGW = G * 8, NGT = G * 512;

    for (int rep_ = 0; rep_ < 1 + ((REP_MASK >> 0) & 1); ++rep_)
    if (IN(0)) {
        KA_DECL
        __syncthreads();
        {
            LAS float* sl = (LAS float*)lds;
            bool have = false;
            for (int it = vcu; it < 192; it += G) {
                if (!have) {
                    for (int i = tid; i < 5120; i += 512) { const int r = i >> 10, k = i & 1023; const float v = (r < 4) ? c_in[r * 1024 + k] : cctx_in[k]; sl[i] = v / (1.f + expf(-v)); }
                    __syncthreads(); have = true;
                }
                const int l = it / 96, cb = it % 96;
                const float* W = w_mod + (size_t)l * 1024 * 6144 + cb * 64 + lane;
                float a0 = 0.f, a1 = 0.f, a2 = 0.f, a3 = 0.f, a4 = 0.f; const int k0 = wave * 128;
#pragma unroll 16
                for (int k = 0; k < 128; ++k) { const float wv = W[(size_t)(k0 + k) * 6144]; const int kk = k0 + k;
                    a0 += sl[kk] * wv; a1 += sl[1024 + kk] * wv; a2 += sl[2048 + kk] * wv; a3 += sl[3072 + kk] * wv; a4 += sl[4096 + kk] * wv; }
                LAS float* part = sl + 5120;
                part[(wave * 5 + 0) * 64 + lane] = a0; part[(wave * 5 + 1) * 64 + lane] = a1; part[(wave * 5 + 2) * 64 + lane] = a2; part[(wave * 5 + 3) * 64 + lane] = a3; part[(wave * 5 + 4) * 64 + lane] = a4;
                __syncthreads();
                if (tid < 320) { const int r = tid >> 6, n = tid & 63; float s = b_mod[l * 6144 + cb * 64 + n];
#pragma unroll
                    for (int w = 0; w < 8; ++w) s += part[(w * 5 + r) * 64 + n];
                    modv[(size_t)(l * 5 + r) * 6144 + cb * 64 + n] = s; }
                __syncthreads();
            }
            __syncthreads();
        }
#pragma clang loop vectorize(disable) unroll(disable)
        for (int i = gt; i < 4096 * 32; i += NGT) {
            const int n = i >> 5, j = i & 31; const int jj = j & 15;
            const float inv = 1.0f / powf(10000.0f, (float)(2 * jj) / 32.0f);
            const float pos = (j < 16) ? (float)(n >> 6) : (float)(n & 63);
            const float ang = pos * inv; rope[i] = make_float2(cosf(ang), sinf(ang));
        }
#pragma clang loop vectorize(disable) unroll(disable)
        for (int i = gt; i < 4096; i += NGT) { float s, c; sincospif((float)i / 2048.f, &s, &c); twt[i] = make_float2(c, s); }
#pragma clang loop vectorize(disable) unroll(disable)
        for (int i = gt; i < 128 * 128; i += NGT) {
            const int m = i >> 7, k = i & 127; const int ri = m >> 6, k1 = m & 63, part = k >> 6, n1 = k & 63;
            float s, c; sincospif((float)((n1 * k1) & 63) / 32.f, &s, &c);
            float v; if (ri == 0) v = (part == 0) ? c : -s; else v = (part == 0) ? -s : -c;
            fma[i] = (bf16)f2bf(v);
        }
#pragma clang loop vectorize(disable) unroll(disable)
        for (int i = gt; i < 64 * 128; i += NGT) {
            const int k2 = i >> 7, k = i & 127; const int ri = k >> 6, n2 = k & 63;
            float s, c; sincospif((float)((n2 * k2) & 63) / 32.f, &s, &c);
            fmb[i] = (bf16)f2bf((ri == 0 ? c : s) * (1.f / 512.f));
        }
#pragma clang loop vectorize(disable) unroll(disable)
        for (int i = gt; i < 256 * 512; i += NGT) {
            const int kk = i >> 9, k = i & 511; const int part = k >> 8, n = k & 255;
            float s, c; sincospif((float)((n * kk) & 255) / 128.f, &s, &c);
            fmc[i] = (bf16)f2bf((part == 0 ? c : -s) * (1.f / 128.f));
        }
        {
            LAS float* Al = (LAS float*)lds;
            for (int it = vcu; it < 256; it += G) {
                const int combo = it & 15, jb = it >> 4; const int l = combo >> 3, g = (combo >> 1) & 3, which = combo & 1;
                const float* Wg = four_w + (size_t)(l * 4 + g) * 4096; const LAS float* tb = trig + which * 64;
                __syncthreads();
                { const int d = tid & 63, c0 = tid >> 6;
#pragma unroll 1
                  for (int i = 0; i < 8; ++i) { const int c = c0 + 8 * i; float a = 0.f;
#pragma unroll 8
                      for (int m = 0; m < 64; ++m) a += tb[(m * c) & 63] * Wg[m * 64 + d];
                      Al[c * 64 + d] = a; } }
                __syncthreads();
                { const int d = tid & 63, j0 = jb * 64 + 8 * (tid >> 6);
                  const float* wi = w_in + (size_t)l * 1024 * 1280 + (size_t)j0 * 1280 + 1024 + g * 64;
                  float o[8] = {0.f, 0.f, 0.f, 0.f, 0.f, 0.f, 0.f, 0.f};
#pragma unroll 2
                  for (int c = 0; c < 64; ++c) { const float av = Al[c * 64 + d];
#pragma unroll
                      for (int i = 0; i < 8; ++i) o[i] += wi[(size_t)i * 1280 + c] * av; }
                  v4u w; w.x = pk2(o[0], o[1]); w.y = pk2(o[2], o[3]); w.z = pk2(o[4], o[5]); w.w = pk2(o[6], o[7]);
                  *(v4u*)((bf16*)(ws + O_WIN + l * SZ_WIN1) + (size_t)(1024 + which * 256 + g * 64 + d) * 1024 + j0) = w; }
            }
            for (int it = vcu; it < 256; it += G) {
                const int combo = it & 7, nb = it >> 3; const int l = combo >> 2, g = combo & 3, n0 = nb * 32;
                __syncthreads();
                for (int i = tid; i < 2048; i += 512) { const int d = i >> 5, n = i & 31; Al[i] = pool_scale[l * 256 + g * 64 + d] * w_out[(size_t)l * 1024 * 1024 + (size_t)(g * 64 + d) * 1024 + n0 + n]; }
                __syncthreads();
                { const int n = tid & 31, c0 = 4 * (tid >> 5);
                  const float* pw = pool_w + (size_t)(l * 4 + g) * 4096 + (size_t)c0 * 64;
                  float o[4] = {0.f, 0.f, 0.f, 0.f};
#pragma unroll 4
                  for (int d = 0; d < 64; ++d) { const float sv = Al[d * 32 + n];
#pragma unroll
                      for (int i = 0; i < 4; ++i) o[i] += pw[i * 64 + d] * sv; }
                  v2u w; w.x = pk2(o[0], o[1]); w.y = pk2(o[2], o[3]);
                  *(v2u*)((bf16*)(ws + O_WOUT + l * SZ_WOUT1) + (size_t)(n0 + n) * 1024 + g * 64 + c0) = w; }
            }
            __syncthreads();
        }
        {
            LAS bf16* scr = (LAS bf16*)(lds + wave * 16384);
            constexpr int I_A = 256, I_B = 192, I_C = 4096, I_D = 2048, I_L = I_A + I_B + I_C + I_D;
#pragma clang loop vectorize(disable) unroll(disable)
            for (int it0 = gw; it0 < 2 * I_L; it0 += NGW) {
                const int l = it0 / I_L; int it = it0 % I_L;
                bf16* p_win_t = (bf16*)(ws + O_WIN + l * SZ_WIN1); bf16* p_wout_t = (bf16*)(ws + O_WOUT + l * SZ_WOUT1);
                bf16* p_wgu_t = (bf16*)(ws + O_WGU + l * SZ_WGU1); bf16* p_wd_t = (bf16*)(ws + O_WD + l * SZ_WD1);
                if (it < I_A) { const int kb = it >> 4, nb = it & 15; tr_block64(w_in + (size_t)l * 1024 * 1280 + (size_t)kb * 64 * 1280 + nb * 64, 1280, p_win_t + (size_t)nb * 64 * 1024 + kb * 64, 1024, scr, lane); continue; } it -= I_A;
                if (it < I_B) { const int kb = 4 + (it >> 4), nb = it & 15; tr_block64(w_out + (size_t)l * 1024 * 1024 + (size_t)kb * 64 * 1024 + nb * 64, 1024, p_wout_t + (size_t)nb * 64 * 1024 + kb * 64, 1024, scr, lane); continue; } it -= I_B;
                if (it < I_C) { const int up = it >> 11, r = it & 2047, e = r >> 7, kb = (r >> 3) & 15, nb = r & 7; const int n0 = nb * 64;
                    const float* src = (up ? w_up : w_gate) + ((size_t)(l * 16 + e) * 1024 + kb * 64) * 512 + n0;
                    const int drow = (n0 >> 7) * 256 + up * 128 + (n0 & 127);
                    tr_block64(src, 512, p_wgu_t + ((size_t)e * 1024 + drow) * 1024 + kb * 64, 1024, scr, lane); continue; } it -= I_C;
                { const int e = it >> 7, kb = (it >> 4) & 7, nb = it & 15;
                    tr_block64(w_down + ((size_t)(l * 16 + e) * 512 + kb * 64) * 1024 + nb * 64, 1024, p_wd_t + ((size_t)e * 1024 + nb * 64) * 512 + kb * 64, 512, scr, lane); }
            }
        }
    }
    SEAM(0);

    layer_body<0>(lds, G, vcu, bar, lo, hi);
    layer_body<1>(lds, G, vcu, bar, lo, hi);
    if (IN(17)) {
        KA_DECL
        const float* modp = modv + (size_t)5 * 6144;
#pragma clang loop vectorize(disable) unroll(disable)
        for (int r = gw; r < T; r += NGW) {
            const float* g2 = modp + (r >> 12) * 6144 + 5 * 1024; float* dst = outp + (size_t)r * 1024;
#pragma unroll
            for (int j = 0; j < 4; ++j) {
                const int c0 = 4 * lane + 256 * j; f32x4 v = *(const f32x4*)(dst + c0);
                const v2u ya = *(const v2u*)(y2 + (size_t)(2 * r) * 1024 + c0), yb = *(const v2u*)(y2 + (size_t)(2 * r + 1) * 1024 + c0);
                const f32x4 gv = *(const f32x4*)(g2 + c0);
                f32x4 yy; yy[0] = bflo(ya.x) + bflo(yb.x); yy[1] = bfhi(ya.x) + bfhi(yb.x); yy[2] = bflo(ya.y) + bflo(yb.y); yy[3] = bfhi(ya.y) + bfhi(yb.y);
                if (DBG_NO_MOE) yy = (f32x4){0.f, 0.f, 0.f, 0.f};
                *(f32x4*)(dst + c0) = v + gv * yy;
            }
        }
    }
#undef IN
#undef SEAM
}

#undef KA_DECL
#undef ws
#undef ctl
#undef x_in
#undef c_in
#undef ctx_in
#undef cctx_in
#undef w_mod
#undef b_mod
#undef norm1_g
#undef w_in
#undef q_norm_g
#undef k_norm_g
#undef attn_sink
#undef pool_w
#undef pool_scale
#undef four_w
#undef w_out
#undef norm2_g
#undef w_grp
#undef b_grp
#undef w_rtr
#undef b_rtr
#undef w_gate
#undef w_up
#undef w_down
#undef outp
#undef modv
#undef rope
#undef twt
#undef fma
#undef fmb
#undef fmc
#undef hbuf
#undef kall
#undef vall
#undef xc
#undef list
#undef wts
#undef act
#undef t2
#undef mrg
#undef qb
#undef pu
#undef zb
#undef y2
#undef modl
#undef win_t
#undef wout_t
#undef wgu_t
#undef wd_t
extern "C" void kernel_launch(void* const* d_in, const int* in_sizes, int n_in, void* d_out, int out_size, void* d_ws, size_t ws_size, hipStream_t stream) {
    static int grid = 0;
    if (grid == 0) {
        if (n_in != 23 || out_size != T * DM || ws_size < WS_END) { fprintf(stderr, "kernel_launch: unexpected shapes (n_in %d out %d ws %zu need %zu)\n", n_in, out_size, ws_size, (size_t)WS_END); grid = -1; return; }
        int dev = 0, cus = 0;
        if (hipGetDevice(&dev) != hipSuccess || hipDeviceGetAttribute(&cus, hipDeviceAttributeMultiprocessorCount, dev) != hipSuccess) { grid = -1; return; }
        if (hipFuncSetAttribute((const void*)fwd_kernel, hipFuncAttributeMaxDynamicSharedMemorySize, LDS_BYTES) != hipSuccess) { fprintf(stderr, "kernel_launch: hipFuncSetAttribute failed\n"); grid = -1; return; }
        (void)hipGetLastError();
        grid = cus;
    }
    if (grid < 0) return;
    (void)hipMemsetAsync((char*)d_ws + O_CTL, 0, SZ_CTL, stream);
    Args a{};
    for (int i = 0; i < 23; ++i) a.in[i] = (const float*)d_in[i];
    a.out = (float*)d_out; a.ws = (unsigned char*)d_ws;
#if MK_SPLIT
    for (int p = 0; p < NPHASE; ++p) { a.ph_lo = p; a.ph_hi = p + 1; hipLaunchKernelGGL(fwd_kernel, dim3(grid), dim3(512), LDS_BYTES, stream, a); }
#else
    a.ph_lo = 0; a.ph_hi = NPHASE;
    hipLaunchKernelGGL(fwd_kernel, dim3(grid), dim3(512), LDS_BYTES, stream, a);
#endif
}
```

```cpp
#include <hip/hip_runtime.h>
#include <cstdio>
#include <cstdint>

#define DBG_NO_FOUR 0
#define DBG_NO_POOL 0
#define DBG_NO_ATT 0
#define DBG_NO_MOE 0
#define DBG_MOE_SCALE 1.0f
#define DBG_NAIVE_MOE 0
#define REP_MASK 0x0
#define DBG_NAIVE_ROUTE 0
#define LAS __attribute__((address_space(3)))
#define GAS __attribute__((address_space(1)))
typedef unsigned short bf16;
typedef short bf16x8 __attribute__((ext_vector_type(8)));
typedef float f32x4 __attribute__((ext_vector_type(4)));
typedef float f32x16 __attribute__((ext_vector_type(16)));
typedef unsigned v4u __attribute__((ext_vector_type(4)));
typedef unsigned v2u __attribute__((ext_vector_type(2)));
typedef GAS unsigned gu32;

#ifndef MK_SPLIT
#define MK_SPLIT 0
#endif

constexpr int NB = 4, NSEQ = 4096, DM = 1024, LCTX = 256, DEPTH = 2;
constexpr int T = NB * NSEQ, TC = NB * LCTX, TT = T + TC;
constexpr int KVROWS = LCTX + NSEQ;
constexpr int NEXP = 16, DEXP = 512;
constexpr int NPHASE = 18;
constexpr int MAXTILES = 152;
constexpr float QSCALE = 0.125f * 1.4426950408889634f;
constexpr float LOG2E = 1.4426950408889634f;

constexpr size_t al256(size_t x) { return (x + 255) & ~(size_t)255; }
constexpr size_t O_CTL = 0, SZ_CTL = 1u << 20;
constexpr size_t O_MOD = O_CTL + SZ_CTL, SZ_MOD = (size_t)2 * 5 * 6144 * 4;
constexpr size_t O_ROPE = al256(O_MOD + SZ_MOD), SZ_ROPE = (size_t)4096 * 32 * 8;
constexpr size_t O_TW = al256(O_ROPE + SZ_ROPE), SZ_TW = 4096 * 8;
constexpr size_t O_FMA = al256(O_TW + SZ_TW), SZ_FMA = 128 * 128 * 2;
constexpr size_t O_FMB = al256(O_FMA + SZ_FMA), SZ_FMB = 64 * 128 * 2;
constexpr size_t O_FMC = al256(O_FMB + SZ_FMB), SZ_FMC = 256 * 512 * 2;
constexpr size_t O_WIN = al256(O_FMC + SZ_FMC), SZ_WIN1 = (size_t)1536 * 1024 * 2;
constexpr size_t O_WOUT = al256(O_WIN + 2 * SZ_WIN1), SZ_WOUT1 = (size_t)1024 * 1024 * 2;
constexpr size_t O_WGU = al256(O_WOUT + 2 * SZ_WOUT1), SZ_WGU1 = (size_t)16 * 1024 * 1024 * 2;
constexpr size_t O_WD = al256(O_WGU + 2 * SZ_WGU1), SZ_WD1 = (size_t)16 * 1024 * 512 * 2;
constexpr size_t O_H = al256(O_WD + 2 * SZ_WD1), SZ_H = (size_t)TT * 1024 * 2;
constexpr size_t O_KALL = al256(O_H + SZ_H), SZ_KV = (size_t)NB * KVROWS * 128 * 2;
constexpr size_t O_VALL = al256(O_KALL + SZ_KV);
constexpr size_t O_XC = al256(O_VALL + SZ_KV), SZ_XC = (size_t)TC * 1024 * 4;
constexpr size_t O_LIST = al256(O_XC + SZ_XC), SZ_LIST = (size_t)NEXP * TT * 4;
constexpr size_t O_WTS = al256(O_LIST + SZ_LIST), SZ_WTS = (size_t)TT * 2 * 4;
constexpr size_t O_EID = al256(O_WTS + SZ_WTS), SZ_EID = (size_t)TT * 2 * 4;
constexpr size_t O_ACT = al256(O_EID + SZ_EID), SZ_ACT = (size_t)MAXTILES * 256 * 512 * 2;
constexpr size_t O_T2 = O_ACT, SZ_T2 = (size_t)NB * 64 * 64 * 2 * 256 * 2;
constexpr size_t O_MRG = al256(O_ACT + SZ_ACT), SZ_MRG = (size_t)TT * 1024 * 2;
constexpr size_t O_Q = al256(O_MRG + SZ_MRG), SZ_Q = (size_t)TT * 512 * 2;
constexpr size_t O_PU = al256(O_Q + SZ_Q), SZ_PU = (size_t)TT * 256 * 2;
constexpr size_t O_Z = al256(O_PU + SZ_PU), SZ_Z = (size_t)TT * 512 * 2;
constexpr size_t O_Y2 = O_MRG, SZ_Y2 = (size_t)TT * 2 * 1024 * 2;
constexpr size_t WS_END = al256(O_Z + SZ_Z);
static_assert(SZ_T2 <= SZ_ACT, "T2 overlay");
static_assert(O_Y2 + SZ_Y2 <= WS_END, "y2 overlay");

constexpr int CW_TMO = 0;
constexpr int CW_BAR = 4096;
constexpr int CW_CNT = 16384;

constexpr int RING_BYTES = 131072;
constexpr int LDSCTL_OFF = RING_BYTES, MISC_OFF = LDSCTL_OFF + 320;
constexpr int TRIG_OFF = LDSCTL_OFF + 1024;
constexpr int TILE_OFF = LDSCTL_OFF + 2048;
constexpr int LDS_BYTES = 147456;

#define RLX_AGENT __ATOMIC_RELAXED, __HIP_MEMORY_SCOPE_AGENT
#define LDS_WAIT() asm volatile("s_waitcnt lgkmcnt(0)" ::: "memory")
#define VM_WAIT() asm volatile("s_waitcnt vmcnt(0)" ::: "memory")

__device__ __forceinline__ unsigned f2bf(float f) { unsigned u = __builtin_bit_cast(unsigned, f); return (u + 0x7fffu + ((u >> 16) & 1u)) >> 16; }
__device__ __forceinline__ unsigned pk2(float lo, float hi) { return f2bf(lo) | (f2bf(hi) << 16); }
__device__ __forceinline__ float bflo(unsigned w) { return __builtin_bit_cast(float, w << 16); }
__device__ __forceinline__ float bfhi(unsigned w) { return __builtin_bit_cast(float, w & 0xffff0000u); }
__device__ __forceinline__ float bf2f(bf16 h) { return __builtin_bit_cast(float, (unsigned)h << 16); }
template <int CTRL, int RM> __device__ __forceinline__ float dppf(float v) { return __builtin_bit_cast(float, __builtin_amdgcn_update_dpp(0, __builtin_bit_cast(int, v), CTRL, RM, 0xf, true)); }
__device__ __forceinline__ float wave_sum(float v) {
    v += dppf<0x111, 0xf>(v); v += dppf<0x112, 0xf>(v); v += dppf<0x114, 0xf>(v); v += dppf<0x118, 0xf>(v);
    v += dppf<0x142, 0xa>(v); v += dppf<0x143, 0xc>(v);
    return __builtin_bit_cast(float, __builtin_amdgcn_readlane(__builtin_bit_cast(int, v), 63));
}

__device__ __forceinline__ float swap32_sum(float x, float y) {
    const auto rr = __builtin_amdgcn_permlane32_swap(__builtin_bit_cast(unsigned, x), __builtin_bit_cast(unsigned, y), false, false);
    unsigned r0 = rr[0], r1 = rr[1]; asm volatile("" : "+v"(r0), "+v"(r1));
    return __builtin_bit_cast(float, r0) + __builtin_bit_cast(float, r1);
}
__device__ __forceinline__ float swap16_sum(float x, float y) {
    const auto rr = __builtin_amdgcn_permlane16_swap(__builtin_bit_cast(unsigned, x), __builtin_bit_cast(unsigned, y), false, false);
    unsigned r0 = rr[0], r1 = rr[1]; asm volatile("" : "+v"(r0), "+v"(r1));
    return __builtin_bit_cast(float, r0) + __builtin_bit_cast(float, r1);
}

#define XB_TMO      128
#define XB_XCNT(j)  (256  + 64 * (j))
#define XB_XSUB(j)  (1280 + 64 * (j))
#define XB_XGEN(j)  (2304 + 64 * (j))
#define XB_TOP      3328
#define XB_TOPGEN   3392
#define XCD_BAR_WORDS 3456
#define XB_SPIN_CAP (1u << 18)
__device__ __forceinline__ unsigned xb_ld(unsigned* p)              { return __hip_atomic_load(p, __ATOMIC_RELAXED, __HIP_MEMORY_SCOPE_AGENT); }
__device__ __forceinline__ unsigned xb_add(unsigned* p, unsigned v) { return __hip_atomic_fetch_add(p, v, __ATOMIC_RELAXED, __HIP_MEMORY_SCOPE_AGENT); }
__device__ __forceinline__ unsigned xb_xcc_id() { return (unsigned)__builtin_amdgcn_s_getreg((3 << 11) | 20) & 0xFu; }
#define XB_SPIN(cond, bar) do { unsigned _sp = 0; while (cond) { __builtin_amdgcn_s_sleep(1); \
    if ((++_sp & 255u) == 0u) { if (xb_ld(&(bar)[XB_TMO])) break; if (_sp > XB_SPIN_CAP) { atomicAdd(&(bar)[XB_TMO], 1u); break; } } } } while (0)
struct XcdBarrier { unsigned* bar; unsigned x; volatile LAS unsigned* st; };
__device__ __forceinline__ XcdBarrier xcd_barrier_post(unsigned* bar, volatile LAS unsigned* st) {
    XcdBarrier b; b.bar = bar; b.x = xb_xcc_id(); b.st = st;
    if (threadIdx.x == 0) (void)xb_add(&bar[XB_XCNT(b.x)], 1u);
    return b;
}
__device__ __forceinline__ void xcd_barrier_complete(unsigned* bar, unsigned x, unsigned& nloc, unsigned& nx) {
    const unsigned G = gridDim.x * gridDim.y * gridDim.z;
    unsigned sum, cnt, mine, sp = 0u;
    for (;;) {
        sum = 0u; cnt = 0u; mine = 0u;
#pragma unroll
        for (unsigned j = 0; j < 16; ++j) { const unsigned c = xb_ld(&bar[XB_XCNT(j)]); sum += c; cnt += (c > 0u) ? 1u : 0u; mine = (j == x) ? c : mine; }
        if (sum == G) break;
        __builtin_amdgcn_s_sleep(1);
        if ((++sp & 255u) == 0u) { if (xb_ld(&bar[XB_TMO])) break; if (sp > XB_SPIN_CAP) { atomicAdd(&bar[XB_TMO], 1u); break; } }
    }
    nloc = mine > 0u ? mine : 1u; nx = cnt > 0u ? cnt : 1u;
}
__device__ __forceinline__ void xcd_barrier(const XcdBarrier& b) {
    asm volatile("s_waitcnt vmcnt(0)" ::: "memory");
    __syncthreads();
    if (threadIdx.x == 0) {
        unsigned* bar = b.bar;
        __builtin_amdgcn_s_waitcnt(0);
        unsigned nloc = b.st[0], nx = b.st[1];
        if (nloc == 0u) { xcd_barrier_complete(bar, b.x, nloc, nx); b.st[0] = nloc; b.st[1] = nx; }
        const unsigned old = xb_add(&bar[XB_XSUB(b.x)], 1u);
        const unsigned gen = old / nloc;
        if (old + 1u == (gen + 1u) * nloc) {
            __builtin_amdgcn_fence(__ATOMIC_RELEASE, "agent");
            asm volatile("s_waitcnt vmcnt(0)" ::: "memory");
            const unsigned og = xb_add(&bar[XB_TOP], 1u);
            const unsigned tg = og / nx;
            if (og + 1u == (tg + 1u) * nx) xb_add(&bar[XB_TOPGEN], 1u);
            else XB_SPIN(xb_ld(&bar[XB_TOPGEN]) == tg, bar);
            __builtin_amdgcn_fence(__ATOMIC_ACQUIRE, "agent");
            xb_add(&bar[XB_XGEN(b.x)], 1u);
            asm volatile("s_waitcnt vmcnt(0)" ::: "memory");
        } else {
            XB_SPIN(xb_ld(&bar[XB_XGEN(b.x)]) == gen, bar);
            __builtin_amdgcn_fence(__ATOMIC_ACQUIRE, "agent");
            asm volatile("s_waitcnt vmcnt(0)" ::: "memory");
        }
    }
    __syncthreads();
}

namespace pg8 {
constexpr int BM = 256, BK = 64, HALF = 128, HTB = HALF * BK * 2;
__host__ __device__ __forceinline__ int lds_byte(int r, int c) { const int st = (r >> 4) * 2 + (c >> 5), rr = r & 15, cc = c & 31, ob = rr * 64 + cc * 2; return st * 1024 + (ob ^ (((ob >> 9) & 1) << 5)); }
__host__ __device__ __forceinline__ void stage_rc(int b, int& R, int& C) { const int st = b / 1024, sb = b % 1024, swz = sb ^ (((sb >> 9) & 1) << 5); R = (st >> 1) * 16 + swz / 64; C = (st & 1) * 32 + (swz % 64) / 2; }
__host__ __device__ __forceinline__ int perm32(int rho) { const int n = rho >> 4, i = rho & 15; return 8 * (i >> 2) + 4 * n + (i & 3); }

struct Unit { int pm, pn, e, cnt; };

template <class Epi, class Sched>
__device__ __forceinline__ void gemm_phase(LAS unsigned char* lds, const char* Abase, const int K, const Sched& S, const Epi& E) {
    int tid = threadIdx.x; asm volatile("" : "+v"(tid));
    const int wid = __builtin_amdgcn_readfirstlane(tid >> 6), lane = tid & 63, wr = wid >> 2, wc = wid & 3, fr = lane & 15, fq = lane >> 4;
    const int nt = K / BK;
    int RA[2], CA[2]; unsigned voffB[2];
#pragma unroll
    for (int i = 0; i < 2; ++i) { int R, C; stage_rc(tid * 16 + i * 8192, R, C); RA[i] = R; CA[i] = C; const int Rb = Epi::PERM ? ((R & ~31) + perm32(R & 31)) : R; voffB[i] = (unsigned)(Rb * K + C) * 2u; }
    const size_t kstep = (size_t)(BK * 2);
    const size_t hstep = (size_t)HALF * K * 2;
    const unsigned ldsw = (unsigned)wid * 1024u;
    const int aoff = lds_byte(wr * 64 + fr, fq * 8), boff = lds_byte(wc * 32 + fr, fq * 8);
#define PG8_SA(b, h) (((b) * 2 + (h)) * HTB)
#define PG8_SB(b, h) ((4 + (b) * 2 + (h)) * HTB)
#define PG8_STAGEB(bufoff, gbase) do { _Pragma("unroll") for (int _i = 0; _i < 2; ++_i) \
        __builtin_amdgcn_global_load_lds((const unsigned*)((const char*)(gbase) + voffB[_i]), (LAS unsigned*)(lds + (bufoff) + ldsw + _i * 8192), 16, 0, 0); } while (0)
#define PG8_STAGEA(bufoff, gbase, o0, o1) do { \
        __builtin_amdgcn_global_load_lds((const unsigned*)((const char*)(gbase) + (o0)), (LAS unsigned*)(lds + (bufoff) + ldsw), 16, 0, 0); \
        __builtin_amdgcn_global_load_lds((const unsigned*)((const char*)(gbase) + (o1)), (LAS unsigned*)(lds + (bufoff) + ldsw + 8192), 16, 0, 0); } while (0)
#define PG8_LDA(dst, b, h) do { _Pragma("unroll") for (int m = 0; m < 4; ++m) _Pragma("unroll") for (int k = 0; k < 2; ++k) dst[m][k] = *(const LAS bf16x8*)(lds + PG8_SA(b, h) + aoff + m * 2048 + k * 1024); } while (0)
#define PG8_LDB(dst, b, h) do { _Pragma("unroll") for (int n = 0; n < 2; ++n) _Pragma("unroll") for (int k = 0; k < 2; ++k) dst[n][k] = *(const LAS bf16x8*)(lds + PG8_SB(b, h) + boff + n * 2048 + k * 1024); } while (0)
#define PG8_MMA(ai, bj, At, Bt) do { __builtin_amdgcn_s_setprio(1); _Pragma("unroll") for (int m = 0; m < 4; ++m) _Pragma("unroll") for (int n = 0; n < 2; ++n) _Pragma("unroll") for (int k = 0; k < 2; ++k) \
        acc[ai][bj][m][n] = __builtin_amdgcn_mfma_f32_16x16x32_bf16(Bt[n][k], At[m][k], acc[ai][bj][m][n], 0, 0, 0); __builtin_amdgcn_s_setprio(0); } while (0)
#define PG8_WAIT_V(n) asm volatile("s_waitcnt vmcnt(" #n ")" ::: "memory")
#define PG8_WAIT_L(n) asm volatile("s_waitcnt lgkmcnt(" #n ")" ::: "memory")
#define PG8_BAR __builtin_amdgcn_s_barrier()
#define PG8_SCHED __builtin_amdgcn_sched_barrier(0)
    Unit cur, nxt; int ui = 0;
    if (!S.next(0, cur)) return;
    f32x4 acc[2][2][4][2];
#pragma unroll
    for (int a = 0; a < 2; ++a)
#pragma unroll
        for (int b = 0; b < 2; ++b)
#pragma unroll
            for (int m = 0; m < 4; ++m)
#pragma unroll
                for (int n = 0; n < 2; ++n) acc[a][b][m][n] = (f32x4){0.f, 0.f, 0.f, 0.f};
    bf16x8 At[4][2], B0[2][2], B1[2][2];
    unsigned oc00, oc01, oc10, oc11, on00, on01, on10, on11;
    oc00 = S.a_off(cur, RA[0], CA[0]); oc01 = S.a_off(cur, RA[1], CA[1]); oc10 = S.a_off(cur, HALF + RA[0], CA[0]); oc11 = S.a_off(cur, HALF + RA[1], CA[1]);
    const char* cB = S.b_ptr(cur);
    PG8_STAGEB(PG8_SB(0, 0), cB); PG8_STAGEB(PG8_SB(0, 1), cB + hstep); PG8_STAGEA(PG8_SA(0, 0), Abase, oc00, oc01); PG8_STAGEA(PG8_SA(0, 1), Abase, oc10, oc11);
    if (wr == 1) PG8_BAR;
    PG8_WAIT_V(2); PG8_BAR;
    PG8_STAGEB(PG8_SB(1, 0), cB + kstep); PG8_STAGEA(PG8_SA(1, 0), Abase + kstep, oc00, oc01); PG8_STAGEB(PG8_SB(1, 1), cB + hstep + kstep);
    PG8_WAIT_V(6); PG8_BAR;
    for (;;) {
        const bool has_next = S.next(ui + 1, nxt);
        const char* nB = cB;
        on00 = oc00; on01 = oc01; on10 = oc10; on11 = oc11;
        if (has_next) { nB = S.b_ptr(nxt); on00 = S.a_off(nxt, RA[0], CA[0]); on01 = S.a_off(nxt, RA[1], CA[1]); on10 = S.a_off(nxt, HALF + RA[0], CA[0]); on11 = S.a_off(nxt, HALF + RA[1], CA[1]); }
        for (int t = 0; t < nt; t += 2) {
            const bool last = (t == nt - 2);
            const char* a1 = Abase + (size_t)(t + 1) * kstep;
            const char* a2 = last ? Abase : Abase + (size_t)(t + 2) * kstep; const char* b2 = last ? nB : cB + (size_t)(t + 2) * kstep;
            const char* a3 = a2 + kstep; const char* b3 = b2 + kstep;
            const unsigned x00 = last ? on00 : oc00, x01 = last ? on01 : oc01, x10 = last ? on10 : oc10, x11 = last ? on11 : oc11;
            PG8_LDB(B0, 0, 0); PG8_LDB(B1, 0, 1); PG8_SCHED; PG8_LDA(At, 0, 0); PG8_STAGEA(PG8_SA(1, 1), a1, oc10, oc11);
            PG8_WAIT_V(8); PG8_WAIT_L(0); PG8_BAR; PG8_MMA(0, 0, At, B0); PG8_MMA(0, 1, At, B1); PG8_BAR; PG8_SCHED;
            PG8_LDA(At, 0, 1); PG8_STAGEB(PG8_SB(0, 0), b2); PG8_STAGEB(PG8_SB(0, 1), b2 + hstep); PG8_STAGEA(PG8_SA(0, 0), a2, x00, x01);
            PG8_WAIT_V(8); PG8_WAIT_L(0); PG8_BAR; PG8_MMA(1, 0, At, B0); PG8_MMA(1, 1, At, B1); PG8_BAR; PG8_SCHED;
            PG8_LDB(B0, 1, 0); PG8_LDB(B1, 1, 1); PG8_SCHED; PG8_LDA(At, 1, 0); PG8_STAGEA(PG8_SA(0, 1), a2, x10, x11);
            PG8_WAIT_V(8); PG8_WAIT_L(0); PG8_BAR; PG8_MMA(0, 0, At, B0); PG8_MMA(0, 1, At, B1); PG8_BAR; PG8_SCHED;
            PG8_LDA(At, 1, 1); PG8_STAGEB(PG8_SB(1, 0), b3); PG8_STAGEB(PG8_SB(1, 1), b3 + hstep); PG8_STAGEA(PG8_SA(1, 0), a3, x00, x01);
            PG8_WAIT_V(8); PG8_WAIT_L(0); PG8_BAR; PG8_MMA(1, 0, At, B0); PG8_MMA(1, 1, At, B1); PG8_BAR; PG8_SCHED;
        }
        if (wr == 0) PG8_BAR;
        E(acc, cur, wr, wc, fr, fq);
        if (!has_next) break;
#pragma unroll
        for (int a = 0; a < 2; ++a)
#pragma unroll
            for (int b = 0; b < 2; ++b)
#pragma unroll
                for (int m = 0; m < 4; ++m)
#pragma unroll
                    for (int n = 0; n < 2; ++n) acc[a][b][m][n] = (f32x4){0.f, 0.f, 0.f, 0.f};
        cur = nxt; cB = nB; oc00 = on00; oc01 = on01; oc10 = on10; oc11 = on11; ++ui;
        if (wr == 1) PG8_BAR;
    }
    PG8_WAIT_V(0);
    PG8_BAR;
#undef PG8_SA
#undef PG8_SB
#undef PG8_STAGEA
#undef PG8_STAGEB
#undef PG8_LDA
#undef PG8_LDB
#undef PG8_MMA
#undef PG8_WAIT_V
#undef PG8_WAIT_L
#undef PG8_BAR
#undef PG8_SCHED
}
}

__device__ __forceinline__ int krow_of(int r) {
    if (r < T) return (r >> 12) * KVROWS + LCTX + (r & 4095);
    const int rc = r - T; return (rc >> 8) * KVROWS + (rc & 255);
}
struct SchedPlain {
    int nM, nN, G, vcu, K; const char* B;
    __device__ __forceinline__ bool next(int i, pg8::Unit& u) const { const int L = i * G + vcu; if (L >= nM * nN) return false; u.pm = L / nN; u.pn = L % nN; u.e = 0; u.cnt = 256; return true; }
    __device__ __forceinline__ unsigned a_off(const pg8::Unit& u, int row, int col) const { return (unsigned)((u.pm * 256 + row) * K + col) * 2u; }
    __device__ __forceinline__ const char* b_ptr(const pg8::Unit& u) const { return B + (size_t)u.pn * 256 * K * 2; }
};
struct EpiG1 {
    static constexpr bool PERM = true;
    bf16 *pu, *q, *kall, *vall, *z;
    __device__ __forceinline__ void operator()(const f32x4 (&acc)[2][2][4][2], const pg8::Unit& u, int wr, int wc, int fr, int fq) const {
        const int row0 = u.pm * 256 + wr * 64 + fr, c8 = wc * 32 + 8 * fq;
#pragma unroll
        for (int ai = 0; ai < 2; ++ai)
#pragma unroll
            for (int m = 0; m < 4; ++m) {
                const int row = row0 + ai * 128 + m * 16;
#pragma unroll
                for (int bj = 0; bj < 2; ++bj) {
                    const f32x4 v0 = acc[ai][bj][m][0], v1 = acc[ai][bj][m][1];
                    v4u w; w.x = pk2(v0[0], v0[1]); w.y = pk2(v0[2], v0[3]); w.z = pk2(v1[0], v1[1]); w.w = pk2(v1[2], v1[3]);
                    bf16* dst;
                    if (u.pn == 0) dst = pu + (size_t)row * 256 + bj * 128 + c8;
                    else if (u.pn <= 2) dst = q + (size_t)row * 512 + (u.pn - 1) * 256 + bj * 128 + c8;
                    else if (u.pn == 3) dst = (bj == 0 ? kall : vall) + (size_t)krow_of(row) * 128 + c8;
                    else dst = z + (size_t)row * 512 + (u.pn - 4) * 256 + bj * 128 + c8;
                    *(v4u*)dst = w;
                }
            }
    }
};
struct EpiG2 {
    static constexpr bool PERM = false;
    const float* xin; const float* cin; float* xout; float* cout; const float* mod;
    __device__ __forceinline__ void operator()(const f32x4 (&acc)[2][2][4][2], const pg8::Unit& u, int wr, int wc, int fr, int fq) const {
        const int rt0 = u.pm * 256; const bool isc = rt0 >= T;
        const int bsel = isc ? 4 : (rt0 >> 12);
        const float* g1 = mod + bsel * 6144 + 2048;
        const float* base = isc ? cin - (size_t)T * 1024 : xin; float* out = isc ? cout - (size_t)T * 1024 : xout;
        const int row0 = rt0 + wr * 64 + fr, col0 = u.pn * 256 + wc * 32 + 4 * fq;
#pragma unroll
        for (int bj = 0; bj < 2; ++bj)
#pragma unroll
            for (int n = 0; n < 2; ++n) {
                const int col = col0 + bj * 128 + n * 16; const f32x4 gv = *(const f32x4*)(g1 + col);
#pragma unroll
                for (int ai = 0; ai < 2; ++ai)
#pragma unroll
                    for (int m = 0; m < 4; ++m) { const size_t off = (size_t)(row0 + ai * 128 + m * 16) * 1024 + col; const f32x4 bs = *(const f32x4*)(base + off); *(f32x4*)(out + off) = bs + gv * acc[ai][bj][m][n]; }
            }
    }
};
struct SchedMoe {
    int G, vcu, K, ntile, mode;
    const char* B; const unsigned* list; const LAS int* tt;
    __device__ __forceinline__ bool next(int i, pg8::Unit& u) const {
        const int L = i * G + vcu; if (L >= ntile * 4) return false;
        const int tau = L >> 2; u.pn = L & 3; u.pm = tau; int e = 0;
#pragma unroll
        for (int k = 1; k < 16; ++k) e += (tt[k] <= tau) ? 1 : 0;
        u.e = e; const int r0 = (tau - tt[e]) * 256; const int c = tt[17 + e] - r0; u.cnt = c < 256 ? c : 256; return true;
    }
    __device__ __forceinline__ unsigned a_off(const pg8::Unit& u, int row, int col) const {
        if (mode == 1) return (unsigned)((u.pm * 256 + row) * K + col) * 2u;
        const int r0 = (u.pm - tt[u.e]) * 256; unsigned tok = 0;
        if (row < u.cnt) tok = list[(size_t)u.e * TT + r0 + row] >> 1;
        return (tok * (unsigned)K + (unsigned)col) * 2u;
    }
    __device__ __forceinline__ const char* b_ptr(const pg8::Unit& u) const { return B + ((size_t)u.e * 1024 + (size_t)u.pn * 256) * K * 2; }
};
struct EpiG3 {
    static constexpr bool PERM = true;
    bf16* act;
    __device__ __forceinline__ void operator()(const f32x4 (&acc)[2][2][4][2], const pg8::Unit& u, int wr, int wc, int fr, int fq) const {
        const int row0 = u.pm * 256 + wr * 64 + fr, c8 = u.pn * 128 + wc * 32 + 8 * fq;
#pragma unroll
        for (int ai = 0; ai < 2; ++ai)
#pragma unroll
            for (int m = 0; m < 4; ++m) {
                float a[8];
#pragma unroll
                for (int n = 0; n < 2; ++n)
#pragma unroll
                    for (int k = 0; k < 4; ++k) { const float g = acc[ai][0][m][n][k], up = acc[ai][1][m][n][k]; a[n * 4 + k] = g / (1.f + __expf(-g)) * up; }
                v4u w; w.x = pk2(a[0], a[1]); w.y = pk2(a[2], a[3]); w.z = pk2(a[4], a[5]); w.w = pk2(a[6], a[7]);
                *(v4u*)(act + (size_t)(row0 + ai * 128 + m * 16) * 512 + c8) = w;
            }
    }
};
struct EpiG4 {
    static constexpr bool PERM = true;
    bf16* y2; const unsigned* list; const float* wts; const LAS int* tt;
    __device__ __forceinline__ void operator()(const f32x4 (&acc)[2][2][4][2], const pg8::Unit& u, int wr, int wc, int fr, int fq) const {
        const int r0 = (u.pm - tt[u.e]) * 256; const int c8 = u.pn * 256 + wc * 32 + 8 * fq;
#pragma unroll
        for (int ai = 0; ai < 2; ++ai)
#pragma unroll
            for (int m = 0; m < 4; ++m) {
                const int row = wr * 64 + fr + ai * 128 + m * 16;
                if (row < u.cnt) {
                    const unsigned ent = list[(size_t)u.e * TT + r0 + row]; const float w = wts[ent];
#pragma unroll
                    for (int bj = 0; bj < 2; ++bj) {
                        const f32x4 v0 = acc[ai][bj][m][0] * w, v1 = acc[ai][bj][m][1] * w;
                        v4u o; o.x = pk2(v0[0], v0[1]); o.y = pk2(v0[2], v0[3]); o.z = pk2(v1[0], v1[1]); o.w = pk2(v1[2], v1[3]);
                        *(v4u*)(y2 + (size_t)ent * 1024 + bj * 128 + c8) = o;
                    }
                }
            }
    }
};

#include <hip/hip_bf16.h>
#include <cmath>
namespace attn_body {
using bf16=__hip_bfloat16;
using bf16x8=__attribute__((ext_vector_type(8)))short;
using s16x4=__attribute__((ext_vector_type(4)))short;
using f32x16=__attribute__((ext_vector_type(16)))float;
using u32x4=__attribute__((ext_vector_type(4)))unsigned;
constexpr int D=64,QP=512,KVP=128,OP=1024;
constexpr int NW=8,QBLK=32,KVBLK=64;
__device__ __forceinline__ int crow(int r,int hi){return (r&3)+8*(r>>2)+4*hi;}
#define SBAR() __builtin_amdgcn_sched_barrier(0)
__device__ __forceinline__ void wmask(f32x16&p0,f32x16&p1,int kp0,int qpos,int hi){
  const float NEG=-INFINITY; const bool tile_ok=(unsigned)kp0<4096u; const int base=kp0+4*hi-qpos+128;
  #pragma unroll
  for(int r=0;r<16;++r){const int dd=base+(r&3)+8*(r>>2); if(!tile_ok||(unsigned)dd>256u)p0[r]=NEG; if(!tile_ok||(unsigned)(dd+32)>256u)p1[r]=NEG;}
}
constexpr int NSLOT=3, SLOTB=8192;
constexpr int LDS_K=0, LDS_V=NSLOT*SLOTB, LDS_WS=2*NSLOT*SLOTB, LDS_OST=LDS_WS+NW*64*4, LDS_BYTES=LDS_OST+NW*4096;
constexpr float C2=0.125f*1.4426950408889634f;
__device__ __forceinline__ void glds16(const void*gsrc,unsigned lds_dst){unsigned keep;
  asm volatile("s_mov_b32 %0, m0\n\ts_mov_b32 m0, %2\n\ts_nop 0\n\tglobal_load_lds_dwordx4 %1, off\n\ts_mov_b32 m0, %0":"=&s"(keep):"v"(gsrc),"s"(lds_dst):"memory");}
__device__ __forceinline__ float max3f(float a,float b,float c){float r;asm("v_max3_f32 %0, %1, %2, %3":"=v"(r):"v"(a),"v"(b),"v"(c));return r;}
__device__ __forceinline__ float max2f(float a,float b){float r;asm("v_max_f32_e32 %0, %1, %2":"=v"(r):"v"(a),"v"(b));return r;}
__device__ __forceinline__ float fadd_s(float a,float b){float r;asm("v_add_f32_e32 %0, %1, %2":"=v"(r):"v"(a),"v"(b));return r;}
__device__ __forceinline__ float fsub_s(float a,float b){float r;asm("v_sub_f32_e32 %0, %1, %2":"=v"(r):"v"(a),"v"(b));return r;}
typedef float f32x2_t __attribute__((ext_vector_type(2))); typedef __bf16 bf16x2_t __attribute__((ext_vector_type(2)));
__device__ __forceinline__ unsigned cvtpk_s(float lo,float hi){f32x2_t v={lo,hi};bf16x2_t b=__builtin_convertvector(v,bf16x2_t);return __builtin_bit_cast(unsigned,b);}
#define WAIT_BAR(N) asm volatile("s_waitcnt vmcnt(" #N ") lgkmcnt(0)\n\ts_barrier":::"memory")

__device__ __forceinline__ void qkt(f32x16&p0,f32x16&p1,const char*Kslot,const bf16x8*qr,const f32x16&negm,int r32,int hi){
  const char*kb=Kslot+hi*1024+r32*16;
  #pragma unroll
  for(int d0=0;d0<4;++d0){
    const bf16x8 b0=*reinterpret_cast<const bf16x8*>(kb+d0*2048);
    const bf16x8 b1=*reinterpret_cast<const bf16x8*>(kb+d0*2048+512);
    if(d0==0){p0=__builtin_amdgcn_mfma_f32_32x32x16_bf16(b0,qr[0],negm,0,0,0);p1=__builtin_amdgcn_mfma_f32_32x32x16_bf16(b1,qr[0],negm,0,0,0);}
    else{p0=__builtin_amdgcn_mfma_f32_32x32x16_bf16(b0,qr[d0],p0,0,0,0);p1=__builtin_amdgcn_mfma_f32_32x32x16_bf16(b1,qr[d0],p1,0,0,0);}}
}
typedef __attribute__((address_space(3))) const char* lds_cptr;
typedef short v4i16_t __attribute__((ext_vector_type(4)));
__device__ __forceinline__ void kload8(bf16x8*kf,lds_cptr kp){
  kf[0]=*(const __attribute__((address_space(3))) bf16x8*)(kp);      kf[1]=*(const __attribute__((address_space(3))) bf16x8*)(kp+512);
  kf[2]=*(const __attribute__((address_space(3))) bf16x8*)(kp+2048); kf[3]=*(const __attribute__((address_space(3))) bf16x8*)(kp+2560);
  kf[4]=*(const __attribute__((address_space(3))) bf16x8*)(kp+4096); kf[5]=*(const __attribute__((address_space(3))) bf16x8*)(kp+4608);
  kf[6]=*(const __attribute__((address_space(3))) bf16x8*)(kp+6144); kf[7]=*(const __attribute__((address_space(3))) bf16x8*)(kp+6656);
}
__device__ __forceinline__ void kload2(bf16x8*kf,lds_cptr kp,int j){ kf[2*j]=*(const __attribute__((address_space(3))) bf16x8*)(kp+j*2048); kf[2*j+1]=*(const __attribute__((address_space(3))) bf16x8*)(kp+j*2048+512); }
__device__ __forceinline__ s16x4 vtr(lds_cptr p){ return __builtin_bit_cast(s16x4,__builtin_amdgcn_ds_read_tr16_b64_v4i16((__attribute__((address_space(3))) v4i16_t*)p)); }
__device__ __forceinline__ float rowmax(const f32x16&p0,const f32x16&p1){
  float a=max3f(p0[0],p0[1],p1[0]),b=max3f(p0[2],p0[3],p1[1]);a=max3f(a,p1[2],p1[3]);
  #pragma unroll
  for(int r=4;r<16;r+=4){a=max3f(a,p0[r],p0[r+1]);b=max3f(b,p0[r+2],p0[r+3]);a=max3f(a,p1[r],p1[r+1]);b=max3f(b,p1[r+2],p1[r+3]);}
  const float m=max2f(a,b);
  auto rr=__builtin_amdgcn_permlane32_swap(__float_as_uint(m),__float_as_uint(m),false,false);
  return max2f(__uint_as_float(rr[0]),__uint_as_float(rr[1]));
}
__device__ __forceinline__ void pv(f32x16*o,int vb,bf16x8 pa0,bf16x8 pa1,bf16x8 pa2,bf16x8 pa3){
  #pragma unroll
  for(int d0=0;d0<2;++d0){s16x4 lo[4],hi[4];
    #pragma unroll
    for(int ks=0;ks<4;++ks){
      asm volatile("ds_read_b64_tr_b16 %0,%1 offset:%c2":"=&v"(lo[ks]):"v"(vb),"i"(d0*4096+ks*1024):"memory");
      asm volatile("ds_read_b64_tr_b16 %0,%1 offset:%c2":"=&v"(hi[ks]):"v"(vb),"i"(d0*4096+ks*1024+512):"memory");}
    asm volatile("s_waitcnt lgkmcnt(0)":::"memory");SBAR();
    #define PK(k) (bf16x8){lo[k][0],lo[k][1],lo[k][2],lo[k][3],hi[k][0],hi[k][1],hi[k][2],hi[k][3]}
    o[d0]=__builtin_amdgcn_mfma_f32_32x32x16_bf16(pa0,PK(0),o[d0],0,0,0);
    o[d0]=__builtin_amdgcn_mfma_f32_32x32x16_bf16(pa1,PK(1),o[d0],0,0,0);
    o[d0]=__builtin_amdgcn_mfma_f32_32x32x16_bf16(pa2,PK(2),o[d0],0,0,0);
    o[d0]=__builtin_amdgcn_mfma_f32_32x32x16_bf16(pa3,PK(3),o[d0],0,0,0);
    #undef PK
  }
}

#ifndef ATTN_STORE16
#define ATTN_STORE16(p,v) (*(u32x4*)(p)=(v))
#endif
template<int THRL> __device__ __forceinline__ void attn_unit(const bf16*Qu,const bf16*__restrict__ Kh,const bf16*__restrict__ Vh,bf16*Ou,const int p0,const int NT,const float* sinkp,const float* qg,const float2* ropet,char*shm){
  int tid=threadIdx.x; asm volatile("":"+v"(tid)); const int lane=tid&63,r32=lane&31,hi=lane>>5; const int wid=__builtin_amdgcn_readfirstlane(tid>>6);
  const int hsub=wid>>1, psub=(wid&1)*QBLK;
  const bf16*Qw=Qu+(long)psub*QP+hsub*D;
  const unsigned lds0=(unsigned)(uintptr_t)shm;
  float*wsf=(float*)(shm+LDS_WS)+wid*64;
  const bf16*ksrc=Kh+(long)lane*KVP+wid*8;
  const bf16*vsrc=Vh+(long)(16*(wid&3)+(lane>>2))*KVP+(wid>>2)*32+(lane&3)*8;
  const unsigned kdst=lds0+LDS_K+wid*1024, vdst=lds0+LDS_V+wid*1024;
  #define KP0(t) (p0-128+64*((t)-4))
  #define TROW(t) ((t)<4?64*(t):(((unsigned)KP0(t)<4096u)?256+KP0(t):256))
  #define DMA_K(t,slot) glds16(ksrc+(long)TROW(t)*KVP,(unsigned)__builtin_amdgcn_readfirstlane(kdst+(slot)))
  #define DMA_V(t,slot) glds16(vsrc+(long)TROW(t)*KVP,(unsigned)__builtin_amdgcn_readfirstlane(vdst+(slot)))
  const int vb0=(int)(lds0+LDS_V)+((lane>>4)&1)*32+(lane&3)*8+(4*hi+((lane&15)>>2))*64;
  const char*Kbase=shm+LDS_K; bf16x8 kf[8];
  const lds_cptr shm3=(lds_cptr)shm; const lds_cptr kp0=shm3+LDS_K+hi*1024+r32*16; const lds_cptr vp0=shm3+LDS_V+((lane>>4)&1)*32+(lane&3)*8+(4*hi+((lane&15)>>2))*64;
  DMA_K(0,0);DMA_V(0,0);DMA_K(1,SLOTB);
  bf16x8 qr[4];
  { bf16x8 qraw[4];
    #pragma unroll
    for(int d0=0;d0<4;++d0)qraw[d0]=*reinterpret_cast<const bf16x8*>(&Qw[(long)r32*QP+d0*16+hi*8]);
    float qf[4][8]; float ss=0.f;
    #pragma unroll
    for(int d0=0;d0<4;++d0)
      #pragma unroll
      for(int j=0;j<8;++j){ qf[d0][j]=__builtin_bit_cast(float,(unsigned)(unsigned short)qraw[d0][j]<<16); ss+=qf[d0][j]*qf[d0][j]; }
    ss+=__shfl_xor(ss,32);
    const float rstd=1.0f/sqrtf(ss*(1.f/64.f)+1e-6f)*C2;
    #pragma unroll
    for(int d0=0;d0<4;++d0)
      #pragma unroll
      for(int j=0;j<8;++j) qf[d0][j]*=rstd*qg[16*d0+8*hi+j];
    if(ropet){ const float2* rp=ropet+(long)(p0+psub+r32)*32+8*hi;
      #pragma unroll
      for(int j=0;j<8;++j){ const float2 c1=rp[j],c2=rp[16+j];
        const float a=qf[0][j],b=qf[1][j],c=qf[2][j],d=qf[3][j];
        qf[0][j]=a*c1.x-b*c1.y; qf[1][j]=b*c1.x+a*c1.y; qf[2][j]=c*c2.x-d*c2.y; qf[3][j]=d*c2.x+c*c2.y; } }
    #pragma unroll
    for(int d0=0;d0<4;++d0){ u32x4 w; w[0]=cvtpk_s(qf[d0][0],qf[d0][1]); w[1]=cvtpk_s(qf[d0][2],qf[d0][3]); w[2]=cvtpk_s(qf[d0][4],qf[d0][5]); w[3]=cvtpk_s(qf[d0][6],qf[d0][7]); qr[d0]=__builtin_bit_cast(bf16x8,w); } }
  float mhat=0.f,l_reg=0.f;f32x16 o[2];o[0]=f32x16{};o[1]=f32x16{};f32x16 negm=f32x16{};asm volatile("":"+v"(negm));
  const int qpos=p0+psub+r32;
  #define CMASK(P0,P1,t) do{ if((t)>=4)wmask(P0,P1,KP0(t),qpos,hi); }while(0)
  bool resc=false;
  #define START(P0,P1) do{ const float rm=rowmax(P0,P1); resc=false; \
    { const float dl=rm; mhat=fadd_s(mhat,dl); \
      _Pragma("unroll") for(int r=0;r<16;++r){P0[r]=fsub_s(P0[r],dl);P1[r]=fsub_s(P1[r],dl);} \
      _Pragma("unroll") for(int r=0;r<16;++r)negm[r]=-mhat; asm volatile("":"+v"(negm)); } \
    _Pragma("unroll") for(int r=0;r<16;++r)P0[r]=__builtin_amdgcn_exp2f(P0[r]); }while(0)
  #define RESC() do{ if(resc){ asm volatile("s_waitcnt lgkmcnt(0)":::"memory"); \
      _Pragma("unroll") for(int d_=0;d_<2;++d_) _Pragma("unroll") for(int r=0;r<16;++r)o[d_][r]*=wsf[crow(r,hi)]; } }while(0)
  f32x16 pA0,pA1,pB0,pB1;
  int sl_prev=0,sl_cur=0,sl_next=SLOTB;
  #define ROT() do{sl_prev=sl_cur;sl_cur=sl_next;sl_next=(sl_next==(NSLOT-1)*SLOTB)?0:sl_next+SLOTB;}while(0)
  DMA_K(2,2*SLOTB);
  WAIT_BAR(3);
  qkt(pA0,pA1,Kbase,qr,negm,r32,hi);asm volatile("s_nop 15\n\ts_nop 7":"+v"(pA0),"+v"(pA1));CMASK(pA0,pA1,0);
  START(pA0,pA1);
  _Pragma("unroll") for(int r=0;r<16;++r)pA1[r]=__builtin_amdgcn_exp2f(pA1[r]);
  WAIT_BAR(0);
  DMA_K(3,0);DMA_V(1,SLOTB);
  ROT();
  kload8(kf,kp0+sl_cur);
  WAIT_BAR(2);
  s16x4 vlo[8],vhi[8]; u32x4 pw0,pw1,pw2,pw3;
  #define PKW(P,B) cvtpk_s(P[B],P[B+1])
  #define PAF(k) __builtin_bit_cast(bf16x8,pw##k)
  #define VFR(i) (bf16x8){vlo[i][0],vlo[i][1],vlo[i][2],vlo[i][3],vhi[i][0],vhi[i][1],vhi[i][2],vhi[i][3]}
  #define PIN(x) asm volatile("":"+v"(x))
  #define MX3(a,b,c) __builtin_fmaxf(__builtin_fmaxf((a),(b)),(c))
  #define GAPA(MF,A0,A1,A2,A3,W0,W1,PW) do{ MF; sacc+=A0; sacc+=A1; sacc+=A2; sacc+=A3; PIN(sacc); W0; W1; PIN(PW); SBAR(); }while(0)
  #define EX(v) __builtin_amdgcn_exp2f(v)
  #define GAPB(MF,X,B) do{ MF; X[B]=EX(X[B]); X[B+1]=EX(X[B+1]); X[B+2]=EX(X[B+2]); X[B+3]=EX(X[B+3]); PIN(X); SBAR(); }while(0)
  #define VRD(i) do{ vlo[i]=vtr(vp_+(((i)>>2)*4096+((i)&3)*1024)); vhi[i]=vtr(vp_+(((i)>>2)*4096+((i)&3)*1024+512)); }while(0)
  #define KRD(G,j) do{ if(G){ kload2(kf,kp0+sl_next,j); SBAR(); } }while(0)
  #define STEP(C0,C1,P0,P1,t,GK,GV,GL) do{ SBAR(); \
    const lds_cptr vp_=vp0+sl_prev; \
    VRD(0); SBAR(); float sacc=(P0[0]+P0[1]); \
    GAPA(C0=__builtin_amdgcn_mfma_f32_32x32x16_bf16(kf[0],qr[0],negm,0,0,0), P0[2],P0[3],P0[4],P0[5],     pw0[0]=PKW(P0,0), pw0[1]=PKW(P0,2), pw0); \
    VRD(4); SBAR(); GAPA(C1=__builtin_amdgcn_mfma_f32_32x32x16_bf16(kf[1],qr[0],negm,0,0,0), P0[6],P0[7],P0[8],P0[9],     pw0[2]=PKW(P0,4), pw0[3]=PKW(P0,6), pw0); \
    VRD(1); SBAR(); GAPA(C0=__builtin_amdgcn_mfma_f32_32x32x16_bf16(kf[2],qr[1],C0,0,0,0),   P0[10],P0[11],P0[12],P0[13], pw1[0]=PKW(P0,8), pw1[1]=PKW(P0,10), pw1); \
    VRD(5); SBAR(); GAPA(C1=__builtin_amdgcn_mfma_f32_32x32x16_bf16(kf[3],qr[1],C1,0,0,0),   P0[14],P0[15],P1[0],P1[1],   pw1[2]=PKW(P0,12),pw1[3]=PKW(P0,14), pw1); \
    VRD(2); SBAR(); GAPA(C0=__builtin_amdgcn_mfma_f32_32x32x16_bf16(kf[4],qr[2],C0,0,0,0),   P1[2],P1[3],P1[4],P1[5],     pw2[0]=PKW(P1,0), pw2[1]=PKW(P1,2), pw2); \
    VRD(6); SBAR(); GAPA(C1=__builtin_amdgcn_mfma_f32_32x32x16_bf16(kf[5],qr[2],C1,0,0,0),   P1[6],P1[7],P1[8],P1[9],     pw2[2]=PKW(P1,4), pw2[3]=PKW(P1,6), pw2); \
    VRD(3); SBAR(); GAPA(C0=__builtin_amdgcn_mfma_f32_32x32x16_bf16(kf[6],qr[3],C0,0,0,0),   P1[10],P1[11],P1[12],P1[13], pw3[0]=PKW(P1,8), pw3[1]=PKW(P1,10), pw3); \
    VRD(7); SBAR(); GAPA(C1=__builtin_amdgcn_mfma_f32_32x32x16_bf16(kf[7],qr[3],C1,0,0,0),   P1[14],P1[15],0.f,0.f,       pw3[2]=PKW(P1,12),pw3[3]=PKW(P1,14), pw3); \
    l_reg+=sacc; \
    if(GK){DMA_K((t)+3,sl_cur);} if(GV){DMA_V((t)+1,sl_next);} \
    CMASK(C0,C1,t); \
    { float a=MX3(C0[0],C0[1],C1[0]),b=MX3(C0[2],C0[3],C1[1]); a=MX3(a,C1[2],C1[3]); \
      _Pragma("unroll") for(int r=4;r<16;r+=4){a=MX3(a,C0[r],C0[r+1]);b=MX3(b,C0[r+2],C0[r+3]);a=MX3(a,C1[r],C1[r+1]);b=MX3(b,C1[r+2],C1[r+3]);} \
      float rm=__builtin_fmaxf(a,b); { auto rr=__builtin_amdgcn_permlane32_swap(__float_as_uint(rm),__float_as_uint(rm),false,false); rm=__builtin_fmaxf(__uint_as_float(rr[0]),__uint_as_float(rr[1])); } \
      resc=false; \
      if(__builtin_expect(__any(rm>(float)THRL),0)){ const float dl=__builtin_fmaxf(rm,0.f); mhat+=dl; \
        _Pragma("unroll") for(int r=0;r<16;++r){C0[r]-=dl;C1[r]-=dl;} \
        _Pragma("unroll") for(int r=0;r<16;++r)negm[r]=-mhat; asm volatile("":"+v"(negm)); \
        const float f=__builtin_amdgcn_exp2f(-dl); l_reg*=f; if(hi==0)wsf[r32]=f; resc=true; } } \
    SBAR(); \
    GAPB(o[0]=__builtin_amdgcn_mfma_f32_32x32x16_bf16(PAF(0),VFR(0),o[0],0,0,0), C0,0); \
    GAPB(o[1]=__builtin_amdgcn_mfma_f32_32x32x16_bf16(PAF(0),VFR(4),o[1],0,0,0), C0,4); \
    KRD(GL,0); GAPB(o[0]=__builtin_amdgcn_mfma_f32_32x32x16_bf16(PAF(1),VFR(1),o[0],0,0,0), C0,8); \
    KRD(GL,1); GAPB(o[1]=__builtin_amdgcn_mfma_f32_32x32x16_bf16(PAF(1),VFR(5),o[1],0,0,0), C0,12); \
    KRD(GL,2); GAPB(o[0]=__builtin_amdgcn_mfma_f32_32x32x16_bf16(PAF(2),VFR(2),o[0],0,0,0), C1,0); \
    KRD(GL,3); GAPB(o[1]=__builtin_amdgcn_mfma_f32_32x32x16_bf16(PAF(2),VFR(6),o[1],0,0,0), C1,4); \
    GAPB(o[0]=__builtin_amdgcn_mfma_f32_32x32x16_bf16(PAF(3),VFR(3),o[0],0,0,0), C1,8); \
    GAPB(o[1]=__builtin_amdgcn_mfma_f32_32x32x16_bf16(PAF(3),VFR(7),o[1],0,0,0), C1,12); \
    }while(0)
  int t=1;
  for(;t+5<NT;t+=2){
    STEP(pB0,pB1,pA0,pA1,t,true,true,true);     WAIT_BAR(2); RESC(); ROT();
    STEP(pA0,pA1,pB0,pB1,t+1,true,true,true);   WAIT_BAR(2); RESC(); ROT();
  }
  #define ENDW(tt) do{ if((tt)+3<NT){WAIT_BAR(2);} else if((tt)+2<NT){WAIT_BAR(1);} else {WAIT_BAR(0);} }while(0)
  for(;t+1<NT;t+=2){
    STEP(pB0,pB1,pA0,pA1,t,(t+3<NT),(t+1<NT),(t+1<NT));       ENDW(t);   RESC(); ROT();
    STEP(pA0,pA1,pB0,pB1,t+1,(t+4<NT),(t+2<NT),(t+2<NT));     ENDW(t+1); RESC(); ROT();
  }
  STEP(pB0,pB1,pA0,pA1,NT-1,false,false,false); RESC();
  { float sacc=pB0[0]+pB0[1]; _Pragma("unroll") for(int r=2;r<16;++r)sacc+=pB0[r]; _Pragma("unroll") for(int r=0;r<16;++r)sacc+=pB1[r]; l_reg+=sacc;
    pw0=(u32x4){PKW(pB0,0),PKW(pB0,2),PKW(pB0,4),PKW(pB0,6)};pw1=(u32x4){PKW(pB0,8),PKW(pB0,10),PKW(pB0,12),PKW(pB0,14)};pw2=(u32x4){PKW(pB1,0),PKW(pB1,2),PKW(pB1,4),PKW(pB1,6)};pw3=(u32x4){PKW(pB1,8),PKW(pB1,10),PKW(pB1,12),PKW(pB1,14)};
    SBAR(); pv(o,vb0+sl_cur,PAF(0),PAF(1),PAF(2),PAF(3)); }
  #undef PKW
  #undef PAF
  #undef VFR
  #undef PIN
  #undef MX3
  #undef GAPA
  #undef GAPB
  #undef EX
  #undef VRD
  #undef KRD
  #undef STEP
  #undef ENDW
  l_reg+=__shfl_xor(l_reg,32);
  l_reg+=__builtin_amdgcn_exp2f(sinkp[hsub]*1.4426950408889634f-mhat);
  if(hi==0)wsf[32+r32]=l_reg;asm volatile("s_waitcnt lgkmcnt(0)":::"memory");
  float rli[16];
  #pragma unroll
  for(int r=0;r<16;++r)rli[r]=__builtin_amdgcn_rcpf(wsf[32+crow(r,hi)]);
  bf16*Ow=Ou+(long)psub*OP+hsub*D;
  { bf16*stg=(bf16*)(shm+LDS_OST)+wid*2048;
    #pragma unroll
    for(int r=0;r<16;++r){const int orow=crow(r,hi);
      #pragma unroll
      for(int d0=0;d0<2;++d0)stg[orow*64+d0*32+r32]=__float2bfloat16(o[d0][r]*rli[r]);}
    asm volatile("s_waitcnt lgkmcnt(0)":::"memory");
    #pragma unroll
    for(int i=0;i<4;++i){const int row=i*8+(lane>>3),ch=lane&7; const u32x4 v=*(const u32x4*)(stg+row*64+ch*8); ATTN_STORE16(Ow+(long)row*OP+ch*8,v);} }
  asm volatile("s_waitcnt lgkmcnt(0)\n\ts_barrier":::"memory");
  #undef DMA_K
  #undef DMA_V
  #undef KP0
  #undef TROW
  #undef CMASK
  #undef START
  #undef RESC
  #undef ROT
}
constexpr int ATTN_LDS_BYTES=LDS_BYTES;
#undef SBAR
#undef WAIT_BAR
}

constexpr int SLAB_PITCH = 288;
typedef short v4i16_t __attribute__((ext_vector_type(4)));
template <int MT, class RowAddr, class Epi>
__device__ __forceinline__ void slab_gemm(LAS unsigned char* lds, const bf16* Cmat, const int K, const RowAddr& RA, const Epi& E) {
    int tid = threadIdx.x; asm volatile("" : "+v"(tid));
    const int wid = tid >> 6, lane = tid & 63;
    LAS bf16* Dr = (LAS bf16*)lds;
    f32x16 acc[MT];
#pragma unroll
    for (int i = 0; i < MT; ++i)
#pragma unroll
        for (int r = 0; r < 16; ++r) acc[i][r] = 0.f;
    const int g = (lane >> 4) & 1, h = lane >> 5, qq = (lane & 15) >> 2, pp = lane & 3;
    const LAS bf16* trp = Dr + (8 * h + qq) * SLAB_PITCH + wid * 32 + 16 * g + 4 * pp;
    for (int kc = 0; kc < K; kc += 128) {
        {
            const int k = tid >> 2, qd = tid & 3;
            const bf16* src = RA(kc + k) + qd * 64;
            v4u v[8];
#pragma unroll
            for (int j = 0; j < 8; ++j) v[j] = *(const v4u*)(src + j * 8);
#pragma unroll
            for (int j = 0; j < 8; ++j) *(LAS v4u*)(Dr + k * SLAB_PITCH + qd * 64 + j * 8) = v[j];
        }
        __syncthreads();
        const int kh = h * 8;
#pragma unroll
        for (int s = 0; s < 8; ++s) {
            const v4i16_t b0 = __builtin_amdgcn_ds_read_tr16_b64_v4i16((LAS v4i16_t*)(trp + (16 * s) * SLAB_PITCH));
            const v4i16_t b1 = __builtin_amdgcn_ds_read_tr16_b64_v4i16((LAS v4i16_t*)(trp + (16 * s + 4) * SLAB_PITCH));
            const bf16x8 bfrag = (bf16x8){b0[0], b0[1], b0[2], b0[3], b1[0], b1[1], b1[2], b1[3]};
#pragma unroll
            for (int mt = 0; mt < MT; ++mt) {
                const bf16x8 afrag = *(const bf16x8*)(Cmat + (size_t)(mt * 32 + (lane & 31)) * K + kc + s * 16 + kh);
                acc[mt] = __builtin_amdgcn_mfma_f32_32x32x16_bf16(afrag, bfrag, acc[mt], 0, 0, 0);
            }
        }
        __syncthreads();
    }
    E(acc, wid, lane);
}

struct Args { const float* in[23]; float* out; unsigned char* ws; int ph_lo, ph_hi; };

struct RowA { const bf16* z; int b, n2; __device__ __forceinline__ const bf16* operator()(int k) const { return z + (size_t)(b * 4096 + 64 * (k & 63) + n2) * 512 + (k >> 6) * 256; } };
struct EpiA { bf16* t2; const float2* tw; int b, n2;
    __device__ __forceinline__ void operator()(const f32x16 (&acc)[4], int wid, int lane) const {
        const int ch = wid * 32 + (lane & 31);
#pragma unroll
        for (int mt = 0; mt < 2; ++mt)
#pragma unroll
            for (int r = 0; r < 16; ++r) {
                const int k1 = 32 * mt + (r & 3) + 8 * (r >> 2) + 4 * (lane >> 5);
                const float2 cs = tw[n2 * k1]; const float re = acc[mt][r], im = acc[mt + 2][r];
                const float re2 = cs.x * re + cs.y * im, im2 = cs.x * im - cs.y * re;
                bf16* d = t2 + ((size_t)((b * 64 + n2) * 64 + k1) * 2) * 256 + ch;
                d[0] = (bf16)f2bf(re2); d[256] = (bf16)f2bf(im2);
            }
    } };
struct RowB { const bf16* t2; int b, k1; __device__ __forceinline__ const bf16* operator()(int k) const { return t2 + ((size_t)((b * 64 + (k & 63)) * 64 + k1) * 2 + (k >> 6)) * 256; } };
struct EpiB { bf16* mrg; int b, k1;
    __device__ __forceinline__ void operator()(const f32x16 (&acc)[2], int wid, int lane) const {
        const int ch = wid * 32 + (lane & 31);
#pragma unroll
        for (int mt = 0; mt < 2; ++mt)
#pragma unroll
            for (int r = 0; r < 16; ++r) { const int k2 = 32 * mt + (r & 3) + 8 * (r >> 2) + 4 * (lane >> 5); mrg[(size_t)(b * 4096 + k1 + 64 * k2) * 1024 + 768 + ch] = (bf16)f2bf(DBG_NO_FOUR ? 0.f : acc[mt][r]); }
    } };
struct RowC { const bf16* z; int b; __device__ __forceinline__ const bf16* operator()(int k) const { return z + (size_t)(T + b * 256 + (k & 255)) * 512 + (k >> 8) * 256; } };
struct EpiC { bf16* mrg; int b, mt0;
    __device__ __forceinline__ void operator()(const f32x16 (&acc)[1], int wid, int lane) const {
        const int ch = wid * 32 + (lane & 31);
#pragma unroll
        for (int mt = 0; mt < 1; ++mt)
#pragma unroll
            for (int r = 0; r < 16; ++r) { const int kk = 32 * (mt0 + mt) + (r & 3) + 8 * (r >> 2) + 4 * (lane >> 5); mrg[(size_t)(T + b * 256 + kk) * 1024 + 768 + ch] = (bf16)f2bf(DBG_NO_FOUR ? 0.f : acc[mt][r]); }
    } };

__device__ __forceinline__ void tr_block(const float* src, int ldS, bf16* dst, int ldD, LAS float* scr, int lane) {
#pragma unroll 8
    for (int i = 0; i < 32; ++i) { const int kk = 2 * i + (lane >> 5); scr[kk * 33 + (lane & 31)] = src[(size_t)kk * ldS + (lane & 31)]; }
    LDS_WAIT(); asm volatile("" ::: "memory");
    const int c = lane & 7;
#pragma unroll
    for (int j = 0; j < 4; ++j) { const int n = (lane >> 3) + 8 * j; const LAS float* s = scr + (8 * c) * 33 + n;
        v4u o; o.x = pk2(s[0 * 33], s[1 * 33]); o.y = pk2(s[2 * 33], s[3 * 33]); o.z = pk2(s[4 * 33], s[5 * 33]); o.w = pk2(s[6 * 33], s[7 * 33]);
        *(GAS v4u*)(dst + (size_t)n * ldD + 8 * c) = o; }
    LDS_WAIT(); asm volatile("" ::: "memory");
}


__device__ __forceinline__ void tr_block64(const float* src, int ldS, bf16* dst, int ldD, LAS bf16* scr, int lane) {
    const int kr = lane >> 4, nc = lane & 15;
    f32x4 v[16];
#pragma unroll
    for (int i = 0; i < 16; ++i) v[i] = *(const f32x4*)(src + (size_t)(4 * i + kr) * ldS + 4 * nc);
#pragma unroll
    for (int i = 0; i < 16; ++i) { const int k = 4 * i + kr;
#pragma unroll
        for (int j = 0; j < 4; ++j) scr[(4 * nc + j) * 66 + k] = (bf16)f2bf(v[i][j]); }
    LDS_WAIT(); asm volatile("" ::: "memory");
    const int c = lane & 7;
#pragma unroll
    for (int j = 0; j < 8; ++j) { const int n = (lane >> 3) + 8 * j; const LAS unsigned* p = (const LAS unsigned*)(scr + n * 66 + 8 * c);
        v4u o; o.x = p[0]; o.y = p[1]; o.z = p[2]; o.w = p[3];
        *(GAS v4u*)(dst + (size_t)n * ldD + 8 * c) = o; }
    LDS_WAIT(); asm volatile("" ::: "memory");
}

typedef const __attribute__((address_space(4))) Args* kargs_t;
__device__ __forceinline__ kargs_t ka_launder() { kargs_t p = (kargs_t)__builtin_amdgcn_kernarg_segment_ptr(); asm volatile("" : "+s"(p)); return p; }
__device__ __forceinline__ int tid_launder() { int t = threadIdx.x; asm volatile("" : "+v"(t)); return t; }
#define KA_DECL const kargs_t KA = ka_launder(); const int tid = tid_launder(); const int lane = tid & 63; const int wave = __builtin_amdgcn_readfirstlane(tid >> 6); const int gw = vcu * 8 + wave; const int gt = vcu * 512 + tid; (void)lane; (void)wave; (void)gw; (void)gt;
#define ws (KA->ws)
#define ctl ((gu32*)(ws + O_CTL))
#define x_in (KA->in[0])
#define c_in (KA->in[1])
#define ctx_in (KA->in[2])
#define cctx_in (KA->in[3])
#define w_mod (KA->in[4])
#define b_mod (KA->in[5])
#define norm1_g (KA->in[6])
#define w_in (KA->in[7])
#define q_norm_g (KA->in[8])
#define k_norm_g (KA->in[9])
#define attn_sink (KA->in[10])
#define pool_w (KA->in[11])
#define pool_scale (KA->in[12])
#define four_w (KA->in[13])
#define w_out (KA->in[14])
#define norm2_g (KA->in[15])
#define w_grp (KA->in[16])
#define b_grp (KA->in[17])
#define w_rtr (KA->in[18])
#define b_rtr (KA->in[19])
#define w_gate (KA->in[20])
#define w_up (KA->in[21])
#define w_down (KA->in[22])
#define outp (KA->out)
#define modv ((float*)(ws + O_MOD))
#define rope ((float2*)(ws + O_ROPE))
#define twt ((float2*)(ws + O_TW))
#define fma ((bf16*)(ws + O_FMA))
#define fmb ((bf16*)(ws + O_FMB))
#define fmc ((bf16*)(ws + O_FMC))
#define hbuf ((bf16*)(ws + O_H))
#define kall ((bf16*)(ws + O_KALL))
#define vall ((bf16*)(ws + O_VALL))
#define xc ((float*)(ws + O_XC))
#define list ((unsigned*)(ws + O_LIST))
#define wts ((float*)(ws + O_WTS))
#define act ((bf16*)(ws + O_ACT))
#define t2 ((bf16*)(ws + O_T2))
#define mrg ((bf16*)(ws + O_MRG))
#define qb ((bf16*)(ws + O_Q))
#define pu ((bf16*)(ws + O_PU))
#define zb ((bf16*)(ws + O_Z))
#define y2 ((bf16*)(ws + O_Y2))

#ifndef PH_MASK
#define PH_MASK 0x3ffff
#endif
#define IN(k) (lo <= (k) && (k) < hi && ((PH_MASK >> (k)) & 1))
#define SEAM(k) do { if (IN(k) && IN((k) + 1)) xcd_barrier(bar); } while (0)
#define modl (modv + (size_t)l * 5 * 6144)
#define win_t ((bf16*)(ws + O_WIN + l * SZ_WIN1))
#define wout_t ((bf16*)(ws + O_WOUT + l * SZ_WOUT1))
#define wgu_t ((bf16*)(ws + O_WGU + l * SZ_WGU1))
#define wd_t ((bf16*)(ws + O_WD + l * SZ_WD1))
template <int l> __device__ __forceinline__ void layer_body(LAS unsigned char* lds, const int G, const int vcu, const XcdBarrier& bar, const int lo, const int hi) {
    const int NGW = G * 8, NGT = G * 512; LAS int* ttab = (LAS int*)(lds + TILE_OFF);
    constexpr int P = 1 + 8 * l;

        for (int rep_ = 0; rep_ < 1 + ((l == 0) ? ((REP_MASK >> (1 + 0)) & 1) : 0); ++rep_)
        if (IN(P + 0)) {
            KA_DECL
            const float* modp = modv;
#pragma clang loop vectorize(disable) unroll(disable)
            for (int r0 = gw; r0 < TT; r0 += 2 * NGW) {
                const int r1 = r0 + NGW; const bool has1 = r1 < TT;
                f32x4 va[4], vb[4]; v2u yaa[4], yab[4], yba[4], ybb[4];
                const float* srca; const float* srcb;
                { const bool isc = r0 >= T; srca = (l == 0) ? (isc ? ctx_in + (size_t)(r0 - T) * 1024 : x_in + (size_t)r0 * 1024) : (isc ? xc + (size_t)(r0 - T) * 1024 : outp + (size_t)r0 * 1024); }
                { const int rr = has1 ? r1 : r0; const bool isc = rr >= T; srcb = (l == 0) ? (isc ? ctx_in + (size_t)(rr - T) * 1024 : x_in + (size_t)rr * 1024) : (isc ? xc + (size_t)(rr - T) * 1024 : outp + (size_t)rr * 1024); }
#pragma unroll
                for (int j = 0; j < 4; ++j) { va[j] = *(const f32x4*)(srca + 4 * lane + 256 * j); vb[j] = *(const f32x4*)(srcb + 4 * lane + 256 * j); }
                if (l == 1) {
                    const int rr = has1 ? r1 : r0;
#pragma unroll
                    for (int j = 0; j < 4; ++j) { yaa[j] = *(const v2u*)(y2 + (size_t)(2 * r0) * 1024 + 4 * lane + 256 * j); yab[j] = *(const v2u*)(y2 + (size_t)(2 * r0 + 1) * 1024 + 4 * lane + 256 * j);
                        yba[j] = *(const v2u*)(y2 + (size_t)(2 * rr) * 1024 + 4 * lane + 256 * j); ybb[j] = *(const v2u*)(y2 + (size_t)(2 * rr + 1) * 1024 + 4 * lane + 256 * j); }
                }
#pragma unroll
                for (int half = 0; half < 2; ++half) {
                    if (half == 1 && !has1) break;
                    const int r = half ? r1 : r0; f32x4 (&v)[4] = half ? vb : va; v2u (&ya)[4] = half ? yba : yaa; v2u (&yb)[4] = half ? ybb : yab;
                    const bool isc = r >= T; const int bsel = isc ? 4 : (r >> 12);
                    if (l == 1) {
                        const float* g2 = modp + bsel * 6144 + 5 * 1024; float* dst = isc ? xc + (size_t)(r - T) * 1024 : outp + (size_t)r * 1024;
#pragma unroll
                        for (int j = 0; j < 4; ++j) {
                            const f32x4 gv = *(const f32x4*)(g2 + 4 * lane + 256 * j);
                            f32x4 yy; yy[0] = bflo(ya[j].x) + bflo(yb[j].x); yy[1] = bfhi(ya[j].x) + bfhi(yb[j].x); yy[2] = bflo(ya[j].y) + bflo(yb[j].y); yy[3] = bfhi(ya[j].y) + bfhi(yb[j].y);
                            if (DBG_NO_MOE) yy = (f32x4){0.f, 0.f, 0.f, 0.f};
                            v[j] = v[j] + gv * yy; *(f32x4*)(dst + 4 * lane + 256 * j) = v[j];
                        }
                    }
                    float ss = 0.f;
#pragma unroll
                    for (int j = 0; j < 4; ++j) ss += (v[j][0] * v[j][0] + v[j][1] * v[j][1]) + (v[j][2] * v[j][2] + v[j][3] * v[j][3]);
                    const float rstd = 1.0f / sqrtf(wave_sum(ss) * (1.f / 1024.f) + 1e-6f);
                    const float* sh = modl + bsel * 6144; const float* sc = sh + 1024; const float* gn = norm1_g + l * 1024;
#pragma unroll
                    for (int j = 0; j < 4; ++j) {
                        const int c0 = 4 * lane + 256 * j; const f32x4 g = *(const f32x4*)(gn + c0), s1 = *(const f32x4*)(sc + c0), h1 = *(const f32x4*)(sh + c0);
                        const f32x4 y = (v[j] * rstd) * g * (s1 + 1.0f) + h1;
                        v2u o; o.x = pk2(y[0], y[1]); o.y = pk2(y[2], y[3]); *(v2u*)(hbuf + (size_t)r * 1024 + c0) = o;
                    }
                }
            }
        }
        SEAM(P + 0);
        for (int rep_ = 0; rep_ < 1 + ((l == 0) ? ((REP_MASK >> (1 + 1)) & 1) : 0); ++rep_)
        if (IN(P + 1)) {
            KA_DECL
            SchedPlain S{TT / 256, 6, G, vcu, 1024, (const char*)win_t};
            EpiG1 E{pu, qb, kall, vall, zb};
            pg8::gemm_phase<EpiG1, SchedPlain>(lds, (const char*)hbuf, 1024, S, E);
        }
        SEAM(P + 1);
        for (int rep_ = 0; rep_ < 1 + ((l == 0) ? ((REP_MASK >> 3) & 1) : 0); ++rep_)
        if (IN(P + 2)) {
            KA_DECL
            __syncthreads();
            for (int it = vcu; it < 256; it += G) {
                const int b = it >> 6, n2 = it & 63;
                RowA ra{zb, b, n2}; EpiA ea{t2, twt, b, n2};
                slab_gemm<4, RowA, EpiA>(lds, fma, 128, ra, ea);
            }
            if (rep_ == 0)
#pragma clang loop vectorize(disable) unroll(disable)
            for (int i = gt; i < TT * 2; i += NGT) {
                const int r = i >> 1, hs = 8 + (i & 1); const bool isk = true; const bool isc = r >= T;
                bf16* p = isk ? kall + (size_t)krow_of(r) * 128 + (hs - 8) * 64 : qb + (size_t)r * 512 + hs * 64;
                float xv[64];
#pragma unroll
                for (int j = 0; j < 8; ++j) { const v4u w = *(const v4u*)(p + 8 * j); xv[8 * j] = bflo(w.x); xv[8 * j + 1] = bfhi(w.x); xv[8 * j + 2] = bflo(w.y); xv[8 * j + 3] = bfhi(w.y); xv[8 * j + 4] = bflo(w.z); xv[8 * j + 5] = bfhi(w.z); xv[8 * j + 6] = bflo(w.w); xv[8 * j + 7] = bfhi(w.w); }
                float ss = 0.f;
#pragma unroll
                for (int d = 0; d < 64; ++d) ss += xv[d] * xv[d];
                const float rstd = 1.0f / sqrtf(ss * (1.f / 64.f) + 1e-6f);
                const float* gg = (isk ? k_norm_g : q_norm_g) + l * 64;
#pragma unroll
                for (int d = 0; d < 64; ++d) { xv[d] = xv[d] * rstd * gg[d]; if ((d & 7) == 7) asm volatile("" ::: "memory"); }
                if (!isc) {
                    const float2* rp = rope + (size_t)(r & 4095) * 32;
#pragma unroll
                    for (int d = 0; d < 16; ++d) {
                        const float2 c1 = rp[d], c2 = rp[16 + d];
                        const float a = xv[d], bb = xv[16 + d], cc = xv[32 + d], dd = xv[48 + d];
                        xv[d] = a * c1.x - bb * c1.y; xv[16 + d] = bb * c1.x + a * c1.y;
                        xv[32 + d] = cc * c2.x - dd * c2.y; xv[48 + d] = dd * c2.x + cc * c2.y;
                        if ((d & 3) == 3) asm volatile("" ::: "memory");
                    }
                }
                const float sc = isk ? 1.0f : QSCALE;
#pragma unroll
                for (int j = 0; j < 8; ++j) { v4u w; w.x = pk2(xv[8 * j] * sc, xv[8 * j + 1] * sc); w.y = pk2(xv[8 * j + 2] * sc, xv[8 * j + 3] * sc); w.z = pk2(xv[8 * j + 4] * sc, xv[8 * j + 5] * sc); w.w = pk2(xv[8 * j + 6] * sc, xv[8 * j + 7] * sc); *(v4u*)(p + 8 * j) = w; }
            }
            const int prow = (l == 0) ? TT : T; const int nrb = prow >> 3;
#pragma clang loop vectorize(disable) unroll(disable)
            for (int i = gt; i < 32 * nrb; i += NGT) {
                const int ck8 = i & 7, rb = (i >> 3) % nrb, g = (i >> 3) / nrb;
                const int r0 = rb * 8; const bool isc = r0 >= T;
                const int nseq = isc ? LCTX : NSEQ; const int rbase = isc ? T + ((r0 - T) & ~255) : (r0 & ~4095); const int n0 = r0 - rbase;
                const int hw = 1 << g; const int col = g * 64 + ck8 * 8;
                const bf16* up = pu + (size_t)rbase * 256 + col;
                float sm[8] = {0.f, 0.f, 0.f, 0.f, 0.f, 0.f, 0.f, 0.f};
#define POOL_ACC(W, SGN) do { sm[0] += SGN bflo(W.x); sm[1] += SGN bfhi(W.x); sm[2] += SGN bflo(W.y); sm[3] += SGN bfhi(W.y); sm[4] += SGN bflo(W.z); sm[5] += SGN bfhi(W.z); sm[6] += SGN bflo(W.w); sm[7] += SGN bfhi(W.w); } while (0)
                for (int tpos = n0 - hw; tpos < n0 + hw; ++tpos) if (tpos >= 0 && tpos < nseq) { const v4u w = *(const v4u*)(up + (size_t)tpos * 256); POOL_ACC(w, +); }
#pragma unroll
                for (int k = 0; k < 8; ++k) {
                    const int n = n0 + k; int lo_ = n - hw; lo_ = lo_ < 0 ? 0 : lo_; int hi_ = n + hw - 1; hi_ = hi_ > nseq - 1 ? nseq - 1 : hi_;
                    const v4u w = *(const v4u*)(up + (size_t)n * 256); const float ic = 1.0f / (float)(hi_ - lo_ + 1);
                    v4u o; o.x = pk2(sm[0] * ic - bflo(w.x), sm[1] * ic - bfhi(w.x)); o.y = pk2(sm[2] * ic - bflo(w.y), sm[3] * ic - bfhi(w.y));
                    o.z = pk2(sm[4] * ic - bflo(w.z), sm[5] * ic - bfhi(w.z)); o.w = pk2(sm[6] * ic - bflo(w.w), sm[7] * ic - bfhi(w.w));
                    if (DBG_NO_POOL) o = (v4u){0u, 0u, 0u, 0u};
                    *(v4u*)(mrg + (size_t)(rbase + n) * 1024 + col) = o;
                    if (k < 7) { const int tin = n + hw, tout = n - hw;
                        if (tin < nseq) { const v4u wi = *(const v4u*)(up + (size_t)tin * 256); POOL_ACC(wi, +); }
                        if (tout >= 0) { const v4u wo = *(const v4u*)(up + (size_t)tout * 256); POOL_ACC(wo, -); } }
                }
#undef POOL_ACC
            }
        }
        SEAM(P + 2);
        for (int rep_ = 0; rep_ < 1 + ((l == 0) ? ((REP_MASK >> (1 + 3)) & 1) : 0); ++rep_)
        if (IN(P + 3)) {
            KA_DECL
            const int n_att = 512 + (l == 0 ? 32 : 0), n_fb = 256, n_cf = (l == 0 ? 32 : 0);
            for (int it = vcu; it < n_att + n_fb + n_cf; it += G) {
#ifndef NO_ATT
                if (it < n_att) { if (rep_ == 0 || ((REP_MASK >> 9) & 1)) {
                    const bool cu = it >= 512; const int uidx = cu ? it - 512 : it;
                    const int b = cu ? (uidx >> 3) : (uidx >> 7), kvh = cu ? ((uidx >> 2) & 1) : ((uidx >> 6) & 1), pb = cu ? (uidx & 3) : (uidx & 63);
                    const int p0 = pb * 64; const int qrow0 = cu ? T + b * 256 + p0 : b * 4096 + p0;
                    const attn_body::bf16* Qu = (const attn_body::bf16*)(qb + (size_t)qrow0 * 512 + kvh * 256);
                    const attn_body::bf16* Kh = (const attn_body::bf16*)(kall + (size_t)b * KVROWS * 128 + kvh * 64);
                    const attn_body::bf16* Vh = (const attn_body::bf16*)(vall + (size_t)b * KVROWS * 128 + kvh * 64);
                    attn_body::bf16* Ou = (attn_body::bf16*)(mrg + (size_t)qrow0 * 1024 + 256 + kvh * 256);
                    attn_body::attn_unit<8>(Qu, Kh, Vh, Ou, p0, cu ? 4 : 10, attn_sink + l * 8 + kvh * 4, q_norm_g + l * 64, cu ? (const float2*)nullptr : (const float2*)rope, (char*)lds);
                    __syncthreads(); }
                } else
#endif
#ifndef NO_FB
                if (it < n_att + n_fb) { if (rep_ == 0 || ((REP_MASK >> 10) & 1)) {
                    const int u2 = it - n_att; const int b = u2 >> 6, k1 = u2 & 63;
                    RowB rb{t2, b, k1}; EpiB eb{mrg, b, k1};
                    slab_gemm<2, RowB, EpiB>(lds, fmb, 128, rb, eb); }
                } else
#endif
                {
#ifndef NO_CF
                    if (rep_ == 0 || ((REP_MASK >> 11) & 1)) {
                    const int b = (it - n_att - n_fb) >> 3, mt0 = (it - n_att - n_fb) & 7;
                    RowC rc{zb, b}; EpiC ec{mrg, b, mt0};
                    slab_gemm<1, RowC, EpiC>(lds, fmc + (size_t)mt0 * 32 * 512, 512, rc, ec); }
#endif
                }
            }
        }
        SEAM(P + 3);
        for (int rep_ = 0; rep_ < 1 + ((l == 0) ? ((REP_MASK >> (1 + 4)) & 1) : 0); ++rep_)
        if (IN(P + 4)) {
            KA_DECL
            SchedPlain S{(l == 0 ? TT : T) / 256, 4, G, vcu, 1024, (const char*)wout_t};
            EpiG2 E{(l == 0) ? x_in : outp, ctx_in, outp, xc, modl};
            pg8::gemm_phase<EpiG2, SchedPlain>(lds, (const char*)mrg, 1024, S, E);
        }
        SEAM(P + 4);
        for (int rep_ = 0; rep_ < 1 + ((l == 0) ? ((REP_MASK >> 6) & 1) : 0); ++rep_)
        if (IN(P + 5)) {
            KA_DECL
            __syncthreads();
            LAS float* rw = (LAS float*)lds;
            LAS int* lcnt = (LAS int*)(lds + 81920);
            LAS unsigned* lent = (LAS unsigned*)(lds + 81920 + 256);
            LAS unsigned* lrank = lent + 1024;
            for (int i = tid; i < 1024 * 20; i += 512) { const int d = i / 20, j = i % 20;
                rw[((((j >> 2) * 4 + (d >> 8)) * 4 + (d & 3)) * 64 + ((d & 255) >> 2)) * 4 + (j & 3)] = (j < 4) ? w_grp[(size_t)l * 4096 + d * 4 + j] : w_rtr[(size_t)l * 16384 + d * 16 + (j - 4)]; }
            if (tid < 33) lcnt[tid] = 0;
            __syncthreads();
            const int nrows = (l == 0) ? TT : T; const int ngrp = nrows >> 2;
#pragma clang loop vectorize(disable) unroll(disable)
            for (int q = gw; q < ngrp; q += NGW) {
                const int rb4 = 4 * q; const bool isc = rb4 >= T; const int bsel = isc ? 4 : (rb4 >> 12);
                const float* src = isc ? xc + (size_t)(rb4 - T) * 1024 : outp + (size_t)rb4 * 1024;
                f32x4 v[4][4];
#pragma unroll
                for (int tk = 0; tk < 4; ++tk)
#pragma unroll
                    for (int j = 0; j < 4; ++j) v[tk][j] = *(const f32x4*)(src + (size_t)tk * 1024 + 4 * lane + 256 * j);
                float rstd[4];
#pragma unroll
                for (int tk = 0; tk < 4; ++tk) { float ss = 0.f;
#pragma unroll
                    for (int j = 0; j < 4; ++j) ss += (v[tk][j][0] * v[tk][j][0] + v[tk][j][1] * v[tk][j][1]) + (v[tk][j][2] * v[tk][j][2] + v[tk][j][3] * v[tk][j][3]);
                    rstd[tk] = 1.0f / sqrtf(wave_sum(ss) * (1.f / 1024.f) + 1e-6f); }
                const float* sh = modl + bsel * 6144 + 3 * 1024; const float* sc = sh + 1024; const float* gn = norm2_g + l * 1024;
                float lg[4][20];
#pragma unroll
                for (int tk = 0; tk < 4; ++tk)
#pragma unroll
                    for (int j = 0; j < 20; ++j) lg[tk][j] = 0.f;
#pragma unroll
                for (int j = 0; j < 4; ++j) {
                    const int c0 = 4 * lane + 256 * j; const f32x4 g = *(const f32x4*)(gn + c0), s1 = *(const f32x4*)(sc + c0), h1 = *(const f32x4*)(sh + c0);
                    f32x4 y[4];
#pragma unroll
                    for (int tk = 0; tk < 4; ++tk) { y[tk] = (v[tk][j] * rstd[tk]) * g * (s1 + 1.0f) + h1;
                        v2u o; o.x = pk2(y[tk][0], y[tk][1]); o.y = pk2(y[tk][2], y[tk][3]); *(v2u*)(hbuf + (size_t)(rb4 + tk) * 1024 + c0) = o; }
#pragma unroll
                    for (int e = 0; e < 4; ++e) {
#pragma unroll
                        for (int q5 = 0; q5 < 5; ++q5) { const f32x4 wv = *(const LAS f32x4*)(rw + (((q5 * 4 + j) * 4 + e) * 64 + lane) * 4);
#pragma unroll
                            for (int tk = 0; tk < 4; ++tk) { lg[tk][4 * q5] += y[tk][e] * wv[0]; lg[tk][4 * q5 + 1] += y[tk][e] * wv[1]; lg[tk][4 * q5 + 2] += y[tk][e] * wv[2]; lg[tk][4 * q5 + 3] += y[tk][e] * wv[3]; } }
                        __builtin_amdgcn_sched_barrier(0); }
                }
                float l2[20];
#pragma unroll
                for (int j = 0; j < 20; ++j) {
                    const float a0 = swap32_sum(lg[0][j], lg[2][j]);
                    const float a1 = swap32_sum(lg[1][j], lg[3][j]);
                    float t = swap16_sum(a0, a1);
                    t += dppf<0x128, 0xf>(t); t += dppf<0x124, 0xf>(t); t += dppf<0x122, 0xf>(t); t += dppf<0x121, 0xf>(t);
                    l2[j] = t;
                }
                const int tk = lane >> 4; const int r = rb4 + tk;
                float gl[4]; float gm = -1e30f;
#pragma unroll
                for (int j = 0; j < 4; ++j) { gl[j] = l2[j] + b_grp[l * 4 + j]; gm = fmaxf(gm, gl[j]); }
                float gs = 0.f; int gi = 0; float gb = -1e30f;
#pragma unroll
                for (int j = 0; j < 4; ++j) { const float e = expf(gl[j] - gm); gs += e; if (gl[j] > gb) { gb = gl[j]; gi = j; } }
                const float pg = expf(gb - gm) / gs;
                float el[4]; float em = -1e30f;
#pragma unroll
                for (int j = 0; j < 4; ++j) { float t_ = 0.f;
#pragma unroll
                    for (int g4 = 0; g4 < 4; ++g4) t_ = (gi == g4) ? (l2[4 + g4 * 4 + j] + b_rtr[l * 16 + g4 * 4 + j]) : t_;
                    el[j] = t_; em = fmaxf(em, t_); }
                float pe[4];
#pragma unroll
                for (int j = 0; j < 4; ++j) pe[j] = expf(el[j] - em);
                int i0 = 0; float b0 = -1.f;
#pragma unroll
                for (int j = 0; j < 4; ++j) if (pe[j] > b0) { b0 = pe[j]; i0 = j; }
                int i1 = 0; float b1 = -1.f;
#pragma unroll
                for (int j = 0; j < 4; ++j) if (j != i0 && pe[j] > b1) { b1 = pe[j]; i1 = j; }
                const float wsum = b0 + b1; const float w0 = pg * b0 / wsum, w1 = pg * b1 / wsum;
                if ((lane & 15) == 0 && rep_ == 0) {
                    wts[2 * r] = w0; wts[2 * r + 1] = w1;
                    const int e0 = gi * 4 + i0, e1 = gi * 4 + i1;
                    const int s0 = __hip_atomic_fetch_add((LAS int*)(lcnt + 16 + 16), 1, __ATOMIC_RELAXED, __HIP_MEMORY_SCOPE_WORKGROUP);
                    const int k0 = __hip_atomic_fetch_add((LAS int*)(lcnt + e0), 1, __ATOMIC_RELAXED, __HIP_MEMORY_SCOPE_WORKGROUP);
                    const int k1 = __hip_atomic_fetch_add((LAS int*)(lcnt + e1), 1, __ATOMIC_RELAXED, __HIP_MEMORY_SCOPE_WORKGROUP);
                    lent[2 * s0] = ((unsigned)(2 * r) << 4) | (unsigned)e0; lrank[2 * s0] = (unsigned)k0;
                    lent[2 * s0 + 1] = ((unsigned)(2 * r + 1) << 4) | (unsigned)e1; lrank[2 * s0 + 1] = (unsigned)k1;
                }
            }
            __syncthreads();
            if (tid < 16 && rep_ == 0) { const int c = lcnt[tid]; lcnt[16 + tid] = c ? (int)__hip_atomic_fetch_add((unsigned*)(ctl + CW_CNT + (l * 16 + tid) * 64), (unsigned)c, RLX_AGENT) : 0; }
            __syncthreads();
            const int ntot = rep_ == 0 ? 2 * lcnt[32] : 0;
            for (int i = tid; i < ntot; i += 512) { const unsigned en = lent[i]; const int e = en & 15; list[(size_t)e * TT + lcnt[16 + e] + lrank[i]] = en >> 4; }
            __syncthreads();
        }
        SEAM(P + 5);
        if (IN(P + 6) || IN(P + 7)) {
            KA_DECL
            __syncthreads();
            if (tid == 0) { int acc_ = 0; for (int e = 0; e < 16; ++e) { const int c = (int)__hip_atomic_load((unsigned*)(ctl + CW_CNT + (l * 16 + e) * 64), RLX_AGENT); ttab[e] = acc_; ttab[17 + e] = c; acc_ += (c + 255) >> 8; } ttab[16] = acc_; }
            __syncthreads();
        }
        if (DBG_NAIVE_MOE && IN(P + 6)) {
            KA_DECL
            const int nrows = (l == 0) ? TT : T; LAS float* hs = (LAS float*)lds; LAS float* as = hs + 1024;
            const int* eidg = (const int*)(ws + O_EID);
            LAS float* lgs = as + 512; LAS float* rt = lgs + 32;
            for (int r = vcu; r < nrows; r += G) {
                __syncthreads();
                for (int i = tid; i < 1024; i += 512) hs[i] = bf2f(hbuf[(size_t)r * 1024 + i]);
                __syncthreads();
                if (tid < 20) { float a = 0.f; for (int k = 0; k < 1024; ++k) a += hs[k] * ((tid < 4) ? w_grp[(size_t)l * 4096 + k * 4 + tid] : w_rtr[(size_t)l * 16384 + k * 16 + (tid - 4)]);
                    lgs[tid] = a + ((tid < 4) ? b_grp[l * 4 + tid] : b_rtr[l * 16 + tid - 4]); }
                __syncthreads();
                if (tid == 0) { int gi = 0; for (int j = 1; j < 4; ++j) if (lgs[j] > lgs[gi]) gi = j; float gs = 0.f; for (int j = 0; j < 4; ++j) gs += expf(lgs[j] - lgs[gi]); const float pg = 1.f / gs;
                    int i0 = 0; for (int j = 1; j < 4; ++j) if (lgs[4 + gi * 4 + j] > lgs[4 + gi * 4 + i0]) i0 = j; int i1 = -1; for (int j = 0; j < 4; ++j) if (j != i0 && (i1 < 0 || lgs[4 + gi * 4 + j] > lgs[4 + gi * 4 + i1])) i1 = j;
                    const float p0 = 1.f, p1 = expf(lgs[4 + gi * 4 + i1] - lgs[4 + gi * 4 + i0]); rt[0] = (float)(gi * 4 + i0); rt[1] = (float)(gi * 4 + i1); rt[2] = pg * p0 / (p0 + p1); rt[3] = pg * p1 / (p0 + p1); }
                __syncthreads();
                for (int sl = 0; sl < 2; ++sl) {
                    const int e = (DBG_NAIVE_ROUTE & 1) ? (int)rt[sl] : eidg[2 * r + sl]; const float w = (DBG_NAIVE_ROUTE & 2) ? rt[2 + sl] : wts[2 * r + sl];
                    __syncthreads();
                    const float* Wg = w_gate + (size_t)(l * 16 + e) * 1024 * 512 + tid; const float* Wu = w_up + (size_t)(l * 16 + e) * 1024 * 512 + tid;
                    float g = 0.f, u = 0.f;
#pragma unroll 8
                    for (int k = 0; k < 1024; ++k) { g += hs[k] * Wg[(size_t)k * 512]; u += hs[k] * Wu[(size_t)k * 512]; }
                    as[tid] = g / (1.f + expf(-g)) * u;
                    __syncthreads();
                    const float* Wd = w_down + (size_t)(l * 16 + e) * 512 * 1024 + tid;
                    float y0 = 0.f, y1 = 0.f;
#pragma unroll 8
                    for (int j = 0; j < 512; ++j) { y0 += as[j] * Wd[(size_t)j * 1024]; y1 += as[j] * Wd[(size_t)j * 1024 + 512]; }
                    y2[(size_t)(2 * r + sl) * 1024 + tid] = (bf16)f2bf(y0 * w); y2[(size_t)(2 * r + sl) * 1024 + 512 + tid] = (bf16)f2bf(y1 * w);
                }
            }
        }
        for (int rep_ = 0; rep_ < 1 + ((l == 0) ? ((REP_MASK >> 7) & 1) : 0); ++rep_)
        if (!DBG_NAIVE_MOE && IN(P + 6)) {
            KA_DECL
            SchedMoe S{G, vcu, 1024, ttab[16], 0, (const char*)wgu_t, list, ttab};
            EpiG3 E{act};
            pg8::gemm_phase<EpiG3, SchedMoe>(lds, (const char*)hbuf, 1024, S, E);
        }
        SEAM(P + 6);
        for (int rep_ = 0; rep_ < 1 + ((l == 0) ? ((REP_MASK >> 8) & 1) : 0); ++rep_)
        if (!DBG_NAIVE_MOE && IN(P + 7)) {
            KA_DECL
            SchedMoe S{G, vcu, 512, ttab[16], 1, (const char*)wd_t, list, ttab};
            EpiG4 E{y2, list, wts, ttab};
            pg8::gemm_phase<EpiG4, SchedMoe>(lds, (const char*)act, 512, S, E);
        }
        SEAM(P + 7);
    }

__global__ void __launch_bounds__(512, 2) fwd_kernel(Args args) {
    extern __shared__ __attribute__((aligned(16))) unsigned char lds_raw[];
    LAS unsigned char* lds = (LAS unsigned char*)lds_raw;
    const int tid = threadIdx.x, lane = tid & 63, wave = __builtin_amdgcn_readfirstlane(tid >> 6);
    const int G = gridDim.x; const int bx = blockIdx.x; const int vcu = (G % 8 == 0) ? (bx % 8) * (G / 8) + bx / 8 : bx;
    volatile LAS unsigned* MISC = (volatile LAS unsigned*)(lds + MISC_OFF);
    LAS float* trig = (LAS float*)(lds + TRIG_OFF);
    LAS int* ttab = (LAS int*)(lds + TILE_OFF);
    for (int u = tid; u < (LDS_BYTES - LDSCTL_OFF) / 4; u += 512) ((LAS unsigned*)(lds + LDSCTL_OFF))[u] = 0u;
    __syncthreads();
    if (tid < 64) { float s, c; sincospif((float)tid / 32.f, &s, &c); trig[tid] = c; trig[64 + tid] = s; }
    __syncthreads();
    XcdBarrier bar; bar.bar = nullptr; bar.x = 0; bar.st = nullptr;
    if (!MK_SPLIT) { KA_DECL bar = xcd_barrier_post((unsigned*)(ctl + CW_BAR), MISC + 8); }
    const int lo = args.ph_lo, hi = args.ph_hi;
    const int NGW = G * 8, NGT = G * 512;

    for (int rep_ = 0; rep_ < 1 + ((REP_MASK >> 0) & 1); ++rep_)
    if (IN(0)) {
        KA_DECL
        __syncthreads();
        {
            LAS float* sl = (LAS float*)lds;
            bool have = false;
            for (int it = vcu; it < 192; it += G) {
                if (!have) {
                    for (int i = tid; i < 5120; i += 512) { const int r = i >> 10, k = i & 1023; const float v = (r < 4) ? c_in[r * 1024 + k] : cctx_in[k]; sl[i] = v / (1.f + expf(-v)); }
                    __syncthreads(); have = true;
                }
                const int l = it / 96, cb = it % 96;
                const float* W = w_mod + (size_t)l * 1024 * 6144 + cb * 64 + lane;
                float a0 = 0.f, a1 = 0.f, a2 = 0.f, a3 = 0.f, a4 = 0.f; const int k0 = wave * 128;
#pragma unroll 16
                for (int k = 0; k < 128; ++k) { const float wv = W[(size_t)(k0 + k) * 6144]; const int kk = k0 + k;
                    a0 += sl[kk] * wv; a1 += sl[1024 + kk] * wv; a2 += sl[2048 + kk] * wv; a3 += sl[3072 + kk] * wv; a4 += sl[4096 + kk] * wv; }
                LAS float* part = sl + 5120;
                part[(wave * 5 + 0) * 64 + lane] = a0; part[(wave * 5 + 1) * 64 + lane] = a1; part[(wave * 5 + 2) * 64 + lane] = a2; part[(wave * 5 + 3) * 64 + lane] = a3; part[(wave * 5 + 4) * 64 + lane] = a4;
                __syncthreads();
                if (tid < 320) { const int r = tid >> 6, n = tid & 63; float s = b_mod[l * 6144 + cb * 64 + n];
#pragma unroll
                    for (int w = 0; w < 8; ++w) s += part[(w * 5 + r) * 64 + n];
                    modv[(size_t)(l * 5 + r) * 6144 + cb * 64 + n] = s; }
                __syncthreads();
            }
            __syncthreads();
        }
#pragma clang loop vectorize(disable) unroll(disable)
        for (int i = gt; i < 4096 * 32; i += NGT) {
            const int n = i >> 5, j = i & 31; const int jj = j & 15;
            const float inv = 1.0f / powf(10000.0f, (float)(2 * jj) / 32.0f);
            const float pos = (j < 16) ? (float)(n >> 6) : (float)(n & 63);
            const float ang = pos * inv; rope[i] = make_float2(cosf(ang), sinf(ang));
        }
#pragma clang loop vectorize(disable) unroll(disable)
        for (int i = gt; i < 4096; i += NGT) { float s, c; sincospif((float)i / 2048.f, &s, &c); twt[i] = make_float2(c, s); }
#pragma clang loop vectorize(disable) unroll(disable)
        for (int i = gt; i < 128 * 128; i += NGT) {
            const int m = i >> 7, k = i & 127; const int ri = m >> 6, k1 = m & 63, part = k >> 6, n1 = k & 63;
            float s, c; sincospif((float)((n1 * k1) & 63) / 32.f, &s, &c);
            float v; if (ri == 0) v = (part == 0) ? c : -s; else v = (part == 0) ? -s : -c;
            fma[i] = (bf16)f2bf(v);
        }
#pragma clang loop vectorize(disable) unroll(disable)
        for (int i = gt; i < 64 * 128; i += NGT) {
            const int k2 = i >> 7, k = i & 127; const int ri = k >> 6, n2 = k & 63;
            float s, c; sincospif((float)((n2 * k2) & 63) / 32.f, &s, &c);
            fmb[i] = (bf16)f2bf((ri == 0 ? c : s) * (1.f / 512.f));
        }
#pragma clang loop vectorize(disable) unroll(disable)
        for (int i = gt; i < 256 * 512; i += NGT) {
            const int kk = i >> 9, k = i & 511; const int part = k >> 8, n = k & 255;
            float s, c; sincospif((float)((n * kk) & 255) / 128.f, &s, &c);
            fmc[i] = (bf16)f2bf((part == 0 ? c : -s) * (1.f / 128.f));
        }
        {
            LAS float* Al = (LAS float*)lds;
            for (int it = vcu; it < 256; it += G) {
                const int combo = it & 15, jb = it >> 4; const int l = combo >> 3, g = (combo >> 1) & 3, which = combo & 1;
                const float* Wg = four_w + (size_t)(l * 4 + g) * 4096; const LAS float* tb = trig + which * 64;
                __syncthreads();
                { const int d = tid & 63, c0 = tid >> 6;
#pragma unroll 1
                  for (int i = 0; i < 8; ++i) { const int c = c0 + 8 * i; float a = 0.f;
#pragma unroll 8
                      for (int m = 0; m < 64; ++m) a += tb[(m * c) & 63] * Wg[m * 64 + d];
                      Al[c * 64 + d] = a; } }
                __syncthreads();
                { const int d = tid & 63, j0 = jb * 64 + 8 * (tid >> 6);
                  const float* wi = w_in + (size_t)l * 1024 * 1280 + (size_t)j0 * 1280 + 1024 + g * 64;
                  float o[8] = {0.f, 0.f, 0.f, 0.f, 0.f, 0.f, 0.f, 0.f};
#pragma unroll 2
                  for (int c = 0; c < 64; ++c) { const float av = Al[c * 64 + d];
#pragma unroll
                      for (int i = 0; i < 8; ++i) o[i] += wi[(size_t)i * 1280 + c] * av; }
                  v4u w; w.x = pk2(o[0], o[1]); w.y = pk2(o[2], o[3]); w.z = pk2(o[4], o[5]); w.w = pk2(o[6], o[7]);
                  *(v4u*)((bf16*)(ws + O_WIN + l * SZ_WIN1) + (size_t)(1024 + which * 256 + g * 64 + d) * 1024 + j0) = w; }
            }
            for (int it = vcu; it < 256; it += G) {
                const int combo = it & 7, nb = it >> 3; const int l = combo >> 2, g = combo & 3, n0 = nb * 32;
                __syncthreads();
                for (int i = tid; i < 2048; i += 512) { const int d = i >> 5, n = i & 31; Al[i] = pool_scale[l * 256 + g * 64 + d] * w_out[(size_t)l * 1024 * 1024 + (size_t)(g * 64 + d) * 1024 + n0 + n]; }
                __syncthreads();
                { const int n = tid & 31, c0 = 4 * (tid >> 5);
                  const float* pw = pool_w + (size_t)(l * 4 + g) * 4096 + (size_t)c0 * 64;
                  float o[4] = {0.f, 0.f, 0.f, 0.f};
#pragma unroll 4
                  for (int d = 0; d < 64; ++d) { const float sv = Al[d * 32 + n];
#pragma unroll
                      for (int i = 0; i < 4; ++i) o[i] += pw[i * 64 + d] * sv; }
                  v2u w; w.x = pk2(o[0], o[1]); w.y = pk2(o[2], o[3]);
                  *(v2u*)((bf16*)(ws + O_WOUT + l * SZ_WOUT1) + (size_t)(n0 + n) * 1024 + g * 64 + c0) = w; }
            }
            __syncthreads();
        }
        {
            LAS bf16* scr = (LAS bf16*)(lds + wave * 16384);
            constexpr int I_A = 256, I_B = 192, I_C = 4096, I_D = 2048, I_L = I_A + I_B + I_C + I_D;
#pragma clang loop vectorize(disable) unroll(disable)
            for (int it0 = gw; it0 < 2 * I_L; it0 += NGW) {
                const int l = it0 / I_L; int it = it0 % I_L;
                bf16* p_win_t = (bf16*)(ws + O_WIN + l * SZ_WIN1); bf16* p_wout_t = (bf16*)(ws + O_WOUT + l * SZ_WOUT1);
                bf16* p_wgu_t = (bf16*)(ws + O_WGU + l * SZ_WGU1); bf16* p_wd_t = (bf16*)(ws + O_WD + l * SZ_WD1);
                if (it < I_A) { const int kb = it >> 4, nb = it & 15; tr_block64(w_in + (size_t)l * 1024 * 1280 + (size_t)kb * 64 * 1280 + nb * 64, 1280, p_win_t + (size_t)nb * 64 * 1024 + kb * 64, 1024, scr, lane); continue; } it -= I_A;
                if (it < I_B) { const int kb = 4 + (it >> 4), nb = it & 15; tr_block64(w_out + (size_t)l * 1024 * 1024 + (size_t)kb * 64 * 1024 + nb * 64, 1024, p_wout_t + (size_t)nb * 64 * 1024 + kb * 64, 1024, scr, lane); continue; } it -= I_B;
                if (it < I_C) { const int up = it >> 11, r = it & 2047, e = r >> 7, kb = (r >> 3) & 15, nb = r & 7; const int n0 = nb * 64;
                    const float* src = (up ? w_up : w_gate) + ((size_t)(l * 16 + e) * 1024 + kb * 64) * 512 + n0;
                    const int drow = (n0 >> 7) * 256 + up * 128 + (n0 & 127);
                    tr_block64(src, 512, p_wgu_t + ((size_t)e * 1024 + drow) * 1024 + kb * 64, 1024, scr, lane); continue; } it -= I_C;
                { const int e = it >> 7, kb = (it >> 4) & 7, nb = it & 15;
                    tr_block64(w_down + ((size_t)(l * 16 + e) * 512 + kb * 64) * 1024 + nb * 64, 1024, p_wd_t + ((size_t)e * 1024 + nb * 64) * 512 + kb * 64, 512, scr, lane); }
            }
        }
    }
    SEAM(0);

    layer_body<0>(lds, G, vcu, bar, lo, hi);
    layer_body<1>(lds, G, vcu, bar, lo, hi);
    if (IN(17)) {
        KA_DECL
        const float* modp = modv + (size_t)5 * 6144;
#pragma clang loop vectorize(disable) unroll(disable)
        for (int r = gw; r < T; r += NGW) {
            const float* g2 = modp + (r >> 12) * 6144 + 5 * 1024; float* dst = outp + (size_t)r * 1024;
#pragma unroll
            for (int j = 0; j < 4; ++j) {
                const int c0 = 4 * lane + 256 * j; f32x4 v = *(const f32x4*)(dst + c0);
                const v2u ya = *(const v2u*)(y2 + (size_t)(2 * r) * 1024 + c0), yb = *(const v2u*)(y2 + (size_t)(2 * r + 1) * 1024 + c0);
                const f32x4 gv = *(const f32x4*)(g2 + c0);
                f32x4 yy; yy[0] = bflo(ya.x) + bflo(yb.x); yy[1] = bfhi(ya.x) + bfhi(yb.x); yy[2] = bflo(ya.y) + bflo(yb.y); yy[3] = bfhi(ya.y) + bfhi(yb.y);
                if (DBG_NO_MOE) yy = (f32x4){0.f, 0.f, 0.f, 0.f};
                *(f32x4*)(dst + c0) = v + gv * yy;
            }
        }
    }
#undef IN
#undef SEAM
}

#undef KA_DECL
#undef ws
#undef ctl
#undef x_in
#undef c_in
#undef ctx_in
#undef cctx_in
#undef w_mod
#undef b_mod
#undef norm1_g
#undef w_in
#undef q_norm_g
#undef k_norm_g
#undef attn_sink
#undef pool_w
#undef pool_scale
#undef four_w
#undef w_out
#undef norm2_g
#undef w_grp
#undef b_grp
#undef w_rtr
#undef b_rtr
#undef w_gate
#undef w_up
#undef w_down
#undef outp
#undef modv
#undef rope
#undef twt
#undef fma
#undef fmb
#undef fmc
#undef hbuf
#undef kall
#undef vall
#undef xc
#undef list
#undef wts
#undef act
#undef t2
#undef mrg
#undef qb
#undef pu
#undef zb
#undef y2
#undef modl
#undef win_t
#undef wout_t
#undef wgu_t
#undef wd_t
extern "C" void kernel_launch(void* const* d_in, const int* in_sizes, int n_in, void* d_out, int out_size, void* d_ws, size_t ws_size, hipStream_t stream) {
    static int grid = 0;
    if (grid == 0) {
        if (n_in != 23 || out_size != T * DM || ws_size < WS_END) { fprintf(stderr, "kernel_launch: unexpected shapes (n_in %d out %d ws %zu need %zu)\n", n_in, out_size, ws_size, (size_t)WS_END); grid = -1; return; }
        int dev = 0, cus = 0;
        if (hipGetDevice(&dev) != hipSuccess || hipDeviceGetAttribute(&cus, hipDeviceAttributeMultiprocessorCount, dev) != hipSuccess) { grid = -1; return; }
        if (hipFuncSetAttribute((const void*)fwd_kernel, hipFuncAttributeMaxDynamicSharedMemorySize, LDS_BYTES) != hipSuccess) { fprintf(stderr, "kernel_launch: hipFuncSetAttribute failed\n"); grid = -1; return; }
        (void)hipGetLastError();
        grid = cus;
    }
    if (grid < 0) return;
    (void)hipMemsetAsync((char*)d_ws + O_CTL, 0, SZ_CTL, stream);
    Args a{};
    for (int i = 0; i < 23; ++i) a.in[i] = (const float*)d_in[i];
    a.out = (float*)d_out; a.ws = (unsigned char*)d_ws;
#if MK_SPLIT
    for (int p = 0; p < NPHASE; ++p) { a.ph_lo = p; a.ph_hi = p + 1; hipLaunchKernelGGL(fwd_kernel, dim3(grid), dim3(512), LDS_BYTES, stream, a); }
#else
    a.ph_lo = 0; a.ph_hi = NPHASE;
    hipLaunchKernelGGL(fwd_kernel, dim3(grid), dim3(512), LDS_BYTES, stream, a);
#endif
}
```

```cpp
#include <hip/hip_runtime.h>
#include <cstdio>
#include <cstdint>

#define DBG_NO_FOUR 0
#define DBG_NO_POOL 0
#define DBG_NO_ATT 0
#define DBG_NO_MOE 0
#define DBG_MOE_SCALE 1.0f
#define DBG_NAIVE_MOE 0
#define REP_MASK 0x0
#define DBG_NAIVE_ROUTE 0
#define LAS __attribute__((address_space(3)))
#define GAS __attribute__((address_space(1)))
typedef unsigned short bf16;
typedef short bf16x8 __attribute__((ext_vector_type(8)));
typedef float f32x4 __attribute__((ext_vector_type(4)));
typedef float f32x16 __attribute__((ext_vector_type(16)));
typedef unsigned v4u __attribute__((ext_vector_type(4)));
typedef unsigned v2u __attribute__((ext_vector_type(2)));
typedef GAS unsigned gu32;

#ifndef MK_SPLIT
#define MK_SPLIT 0
#endif

constexpr int NB = 4, NSEQ = 4096, DM = 1024, LCTX = 256, DEPTH = 2;
constexpr int T = NB * NSEQ, TC = NB * LCTX, TT = T + TC;
constexpr int KVROWS = LCTX + NSEQ;
constexpr int NEXP = 16, DEXP = 512;
constexpr int NPHASE = 18;
constexpr int MAXTILES = 152;
constexpr float QSCALE = 0.125f * 1.4426950408889634f;
constexpr float LOG2E = 1.4426950408889634f;

constexpr size_t al256(size_t x) { return (x + 255) & ~(size_t)255; }
constexpr size_t O_CTL = 0, SZ_CTL = 1u << 20;
constexpr size_t O_MOD = O_CTL + SZ_CTL, SZ_MOD = (size_t)2 * 5 * 6144 * 4;
constexpr size_t O_ROPE = al256(O_MOD + SZ_MOD), SZ_ROPE = (size_t)4096 * 32 * 8;
constexpr size_t O_TW = al256(O_ROPE + SZ_ROPE), SZ_TW = 4096 * 8;
constexpr size_t O_FMA = al256(O_TW + SZ_TW), SZ_FMA = 128 * 128 * 2;
constexpr size_t O_FMB = al256(O_FMA + SZ_FMA), SZ_FMB = 64 * 128 * 2;
constexpr size_t O_FMC = al256(O_FMB + SZ_FMB), SZ_FMC = 256 * 512 * 2;
constexpr size_t O_WIN = al256(O_FMC + SZ_FMC), SZ_WIN1 = (size_t)1536 * 1024 * 2;
constexpr size_t O_WOUT = al256(O_WIN + 2 * SZ_WIN1), SZ_WOUT1 = (size_t)1024 * 1024 * 2;
constexpr size_t O_WGU = al256(O_WOUT + 2 * SZ_WOUT1), SZ_WGU1 = (size_t)16 * 1024 * 1024 * 2;
constexpr size_t O_WD = al256(O_WGU + 2 * SZ_WGU1), SZ_WD1 = (size_t)16 * 1024 * 512 * 2;
constexpr size_t O_H = al256(O_WD + 2 * SZ_WD1), SZ_H = (size_t)TT * 1024 * 2;
constexpr size_t O_KALL = al256(O_H + SZ_H), SZ_KV = (size_t)NB * KVROWS * 128 * 2;
constexpr size_t O_VALL = al256(O_KALL + SZ_KV);
constexpr size_t O_XC = al256(O_VALL + SZ_KV), SZ_XC = (size_t)TC * 1024 * 4;
constexpr size_t O_LIST = al256(O_XC + SZ_XC), SZ_LIST = (size_t)NEXP * TT * 4;
constexpr size_t O_WTS = al256(O_LIST + SZ_LIST), SZ_WTS = (size_t)TT * 2 * 4;
constexpr size_t O_EID = al256(O_WTS + SZ_WTS), SZ_EID = (size_t)TT * 2 * 4;
constexpr size_t O_ACT = al256(O_EID + SZ_EID), SZ_ACT = (size_t)MAXTILES * 256 * 512 * 2;
constexpr size_t O_T2 = O_ACT, SZ_T2 = (size_t)NB * 64 * 64 * 2 * 256 * 2;
constexpr size_t O_MRG = al256(O_ACT + SZ_ACT), SZ_MRG = (size_t)TT * 1024 * 2;
constexpr size_t O_Q = al256(O_MRG + SZ_MRG), SZ_Q = (size_t)TT * 512 * 2;
constexpr size_t O_PU = al256(O_Q + SZ_Q), SZ_PU = (size_t)TT * 256 * 2;
constexpr size_t O_Z = al256(O_PU + SZ_PU), SZ_Z = (size_t)TT * 512 * 2;
constexpr size_t O_Y2 = O_MRG, SZ_Y2 = (size_t)TT * 2 * 1024 * 2;
constexpr size_t WS_END = al256(O_Z + SZ_Z);
static_assert(SZ_T2 <= SZ_ACT, "T2 overlay");
static_assert(O_Y2 + SZ_Y2 <= WS_END, "y2 overlay");

constexpr int CW_TMO = 0;
constexpr int CW_BAR = 4096;
constexpr int CW_RDY = 32768;
constexpr int CW_CNT = 16384;

constexpr int RING_BYTES = 131072;
constexpr int LDSCTL_OFF = RING_BYTES, MISC_OFF = LDSCTL_OFF + 320;
constexpr int TRIG_OFF = LDSCTL_OFF + 1024;
constexpr int TILE_OFF = LDSCTL_OFF + 2048;
constexpr int LDS_BYTES = 147456;

#define RLX_AGENT __ATOMIC_RELAXED, __HIP_MEMORY_SCOPE_AGENT
#define LDS_WAIT() asm volatile("s_waitcnt lgkmcnt(0)" ::: "memory")
#define VM_WAIT() asm volatile("s_waitcnt vmcnt(0)" ::: "memory")

__device__ __forceinline__ unsigned f2bf(float f) { unsigned u = __builtin_bit_cast(unsigned, f); return (u + 0x7fffu + ((u >> 16) & 1u)) >> 16; }
__device__ __forceinline__ unsigned pk2(float lo, float hi) { return f2bf(lo) | (f2bf(hi) << 16); }
__device__ __forceinline__ float bflo(unsigned w) { return __builtin_bit_cast(float, w << 16); }
__device__ __forceinline__ float bfhi(unsigned w) { return __builtin_bit_cast(float, w & 0xffff0000u); }
__device__ __forceinline__ float bf2f(bf16 h) { return __builtin_bit_cast(float, (unsigned)h << 16); }
template <int CTRL, int RM> __device__ __forceinline__ float dppf(float v) { return __builtin_bit_cast(float, __builtin_amdgcn_update_dpp(0, __builtin_bit_cast(int, v), CTRL, RM, 0xf, true)); }
__device__ __forceinline__ float wave_sum(float v) {
    v += dppf<0x111, 0xf>(v); v += dppf<0x112, 0xf>(v); v += dppf<0x114, 0xf>(v); v += dppf<0x118, 0xf>(v);
    v += dppf<0x142, 0xa>(v); v += dppf<0x143, 0xc>(v);
    return __builtin_bit_cast(float, __builtin_amdgcn_readlane(__builtin_bit_cast(int, v), 63));
}

__device__ __forceinline__ float swap32_sum(float x, float y) {
    const auto rr = __builtin_amdgcn_permlane32_swap(__builtin_bit_cast(unsigned, x), __builtin_bit_cast(unsigned, y), false, false);
    unsigned r0 = rr[0], r1 = rr[1]; asm volatile("" : "+v"(r0), "+v"(r1));
    return __builtin_bit_cast(float, r0) + __builtin_bit_cast(float, r1);
}
__device__ __forceinline__ float swap16_sum(float x, float y) {
    const auto rr = __builtin_amdgcn_permlane16_swap(__builtin_bit_cast(unsigned, x), __builtin_bit_cast(unsigned, y), false, false);
    unsigned r0 = rr[0], r1 = rr[1]; asm volatile("" : "+v"(r0), "+v"(r1));
    return __builtin_bit_cast(float, r0) + __builtin_bit_cast(float, r1);
}

#define XB_TMO      128
#define XB_XCNT(j)  (256  + 64 * (j))
#define XB_XSUB(j)  (1280 + 64 * (j))
#define XB_XGEN(j)  (2304 + 64 * (j))
#define XB_TOP      3328
#define XB_TOPGEN   3392
#define XCD_BAR_WORDS 3456
#define XB_SPIN_CAP (1u << 18)
__device__ __forceinline__ unsigned xb_ld(unsigned* p)              { return __hip_atomic_load(p, __ATOMIC_RELAXED, __HIP_MEMORY_SCOPE_AGENT); }
__device__ __forceinline__ unsigned xb_add(unsigned* p, unsigned v) { return __hip_atomic_fetch_add(p, v, __ATOMIC_RELAXED, __HIP_MEMORY_SCOPE_AGENT); }
__device__ __forceinline__ unsigned xb_xcc_id() { return (unsigned)__builtin_amdgcn_s_getreg((3 << 11) | 20) & 0xFu; }
#define XB_SPIN(cond, bar) do { unsigned _sp = 0; while (cond) { __builtin_amdgcn_s_sleep(1); \
    if ((++_sp & 255u) == 0u) { if (xb_ld(&(bar)[XB_TMO])) break; if (_sp > XB_SPIN_CAP) { atomicAdd(&(bar)[XB_TMO], 1u); break; } } } } while (0)
struct XcdBarrier { unsigned* bar; unsigned x; volatile LAS unsigned* st; };
__device__ __forceinline__ XcdBarrier xcd_barrier_post(unsigned* bar, volatile LAS unsigned* st) {
    XcdBarrier b; b.bar = bar; b.x = xb_xcc_id(); b.st = st;
    if (threadIdx.x == 0) (void)xb_add(&bar[XB_XCNT(b.x)], 1u);
    return b;
}
__device__ __forceinline__ void xcd_barrier_complete(unsigned* bar, unsigned x, unsigned& nloc, unsigned& nx) {
    const unsigned G = gridDim.x * gridDim.y * gridDim.z;
    unsigned sum, cnt, mine, sp = 0u;
    for (;;) {
        sum = 0u; cnt = 0u; mine = 0u;
#pragma unroll
        for (unsigned j = 0; j < 16; ++j) { const unsigned c = xb_ld(&bar[XB_XCNT(j)]); sum += c; cnt += (c > 0u) ? 1u : 0u; mine = (j == x) ? c : mine; }
        if (sum == G) break;
        __builtin_amdgcn_s_sleep(1);
        if ((++sp & 255u) == 0u) { if (xb_ld(&bar[XB_TMO])) break; if (sp > XB_SPIN_CAP) { atomicAdd(&bar[XB_TMO], 1u); break; } }
    }
    nloc = mine > 0u ? mine : 1u; nx = cnt > 0u ? cnt : 1u;
}
__device__ __forceinline__ void xcd_barrier(const XcdBarrier& b) {
    asm volatile("s_waitcnt vmcnt(0)" ::: "memory");
    __syncthreads();
    if (threadIdx.x == 0) {
        unsigned* bar = b.bar;
        __builtin_amdgcn_s_waitcnt(0);
        unsigned nloc = b.st[0], nx = b.st[1];
        if (nloc == 0u) { xcd_barrier_complete(bar, b.x, nloc, nx); b.st[0] = nloc; b.st[1] = nx; }
        const unsigned old = xb_add(&bar[XB_XSUB(b.x)], 1u);
        const unsigned gen = old / nloc;
        if (old + 1u == (gen + 1u) * nloc) {
            __builtin_amdgcn_fence(__ATOMIC_RELEASE, "agent");
            asm volatile("s_waitcnt vmcnt(0)" ::: "memory");
            const unsigned og = xb_add(&bar[XB_TOP], 1u);
            const unsigned tg = og / nx;
            if (og + 1u == (tg + 1u) * nx) xb_add(&bar[XB_TOPGEN], 1u);
            else XB_SPIN(xb_ld(&bar[XB_TOPGEN]) == tg, bar);
            __builtin_amdgcn_fence(__ATOMIC_ACQUIRE, "agent");
            xb_add(&bar[XB_XGEN(b.x)], 1u);
            asm volatile("s_waitcnt vmcnt(0)" ::: "memory");
        } else {
            XB_SPIN(xb_ld(&bar[XB_XGEN(b.x)]) == gen, bar);
            __builtin_amdgcn_fence(__ATOMIC_ACQUIRE, "agent");
            asm volatile("s_waitcnt vmcnt(0)" ::: "memory");
        }
    }
    __syncthreads();
}

namespace pg8 {
constexpr int BM = 256, BK = 64, HALF = 128, HTB = HALF * BK * 2;
__host__ __device__ __forceinline__ int lds_byte(int r, int c) { const int st = (r >> 4) * 2 + (c >> 5), rr = r & 15, cc = c & 31, ob = rr * 64 + cc * 2; return st * 1024 + (ob ^ (((ob >> 9) & 1) << 5)); }
__host__ __device__ __forceinline__ void stage_rc(int b, int& R, int& C) { const int st = b / 1024, sb = b % 1024, swz = sb ^ (((sb >> 9) & 1) << 5); R = (st >> 1) * 16 + swz / 64; C = (st & 1) * 32 + (swz % 64) / 2; }
__host__ __device__ __forceinline__ int perm32(int rho) { const int n = rho >> 4, i = rho & 15; return 8 * (i >> 2) + 4 * n + (i & 3); }

struct Unit { int pm, pn, e, cnt, kind; };

template <class Epi, class Sched>
__device__ __forceinline__ void gemm_phase(LAS unsigned char* lds, const Sched& S, const Epi& E) {
    int tid = threadIdx.x; asm volatile("" : "+v"(tid));
    const int wid = __builtin_amdgcn_readfirstlane(tid >> 6), lane = tid & 63, wr = wid >> 2, wc = wid & 3, fr = lane & 15, fq = lane >> 4;
    int RA[2], CA[2], RB[2];
#pragma unroll
    for (int i = 0; i < 2; ++i) { int R, C; stage_rc(tid * 16 + i * 8192, R, C); RA[i] = R; CA[i] = C; RB[i] = Epi::PERM ? ((R & ~31) + perm32(R & 31)) : R; }
    const size_t kstep = (size_t)(BK * 2);
    const unsigned ldsw = (unsigned)wid * 1024u;
    const int aoff = lds_byte(wr * 64 + fr, fq * 8), boff = lds_byte(wc * 32 + fr, fq * 8);
#define PG8_SA(b, h) (((b) * 2 + (h)) * HTB)
#define PG8_SB(b, h) ((4 + (b) * 2 + (h)) * HTB)
#define PG8_STAGE2(bufoff, gbase, o0, o1) do { \
        __builtin_amdgcn_global_load_lds((const unsigned*)((const char*)(gbase) + (o0)), (LAS unsigned*)(lds + (bufoff) + ldsw), 16, 0, 0); \
        __builtin_amdgcn_global_load_lds((const unsigned*)((const char*)(gbase) + (o1)), (LAS unsigned*)(lds + (bufoff) + ldsw + 8192), 16, 0, 0); } while (0)
#define PG8_LDA(dst, b, h) do { _Pragma("unroll") for (int m = 0; m < 4; ++m) _Pragma("unroll") for (int k = 0; k < 2; ++k) dst[m][k] = *(const LAS bf16x8*)(lds + PG8_SA(b, h) + aoff + m * 2048 + k * 1024); } while (0)
#define PG8_LDB(dst, b, h) do { _Pragma("unroll") for (int n = 0; n < 2; ++n) _Pragma("unroll") for (int k = 0; k < 2; ++k) dst[n][k] = *(const LAS bf16x8*)(lds + PG8_SB(b, h) + boff + n * 2048 + k * 1024); } while (0)
#define PG8_MMA(ai, bj, At, Bt) do { __builtin_amdgcn_s_setprio(1); _Pragma("unroll") for (int m = 0; m < 4; ++m) _Pragma("unroll") for (int n = 0; n < 2; ++n) _Pragma("unroll") for (int k = 0; k < 2; ++k) \
        acc[ai][bj][m][n] = __builtin_amdgcn_mfma_f32_16x16x32_bf16(Bt[n][k], At[m][k], acc[ai][bj][m][n], 0, 0, 0); __builtin_amdgcn_s_setprio(0); } while (0)
#define PG8_WAIT_V(n) asm volatile("s_waitcnt vmcnt(" #n ")" ::: "memory")
#define PG8_WAIT_L(n) asm volatile("s_waitcnt lgkmcnt(" #n ")" ::: "memory")
#define PG8_BAR __builtin_amdgcn_s_barrier()
#define PG8_SCHED __builtin_amdgcn_sched_barrier(0)
    Unit cur, nxt; int ui = 0;
    if (!S.next(0, cur)) return;
    f32x4 acc[2][2][4][2];
#pragma unroll
    for (int a = 0; a < 2; ++a)
#pragma unroll
        for (int b = 0; b < 2; ++b)
#pragma unroll
            for (int m = 0; m < 4; ++m)
#pragma unroll
                for (int n = 0; n < 2; ++n) acc[a][b][m][n] = (f32x4){0.f, 0.f, 0.f, 0.f};
    bf16x8 At[4][2], B0[2][2], B1[2][2];
    int Kc = S.K(cur), Kn; const char* Ac = S.a_base(cur); const char* An; const char* cB = S.b_ptr(cur); const char* nB;
    unsigned oc00, oc01, oc10, oc11, on00, on01, on10, on11, vbc0, vbc1, vbn0, vbn1; size_t hsc, hsn;
    oc00 = S.a_off(cur, RA[0], CA[0]); oc01 = S.a_off(cur, RA[1], CA[1]); oc10 = S.a_off(cur, HALF + RA[0], CA[0]); oc11 = S.a_off(cur, HALF + RA[1], CA[1]);
    vbc0 = (unsigned)(RB[0] * Kc + CA[0]) * 2u; vbc1 = (unsigned)(RB[1] * Kc + CA[1]) * 2u; hsc = (size_t)HALF * Kc * 2;
    S.a_ready(cur);
    PG8_STAGE2(PG8_SB(0, 0), cB, vbc0, vbc1); PG8_STAGE2(PG8_SB(0, 1), cB + hsc, vbc0, vbc1); PG8_STAGE2(PG8_SA(0, 0), Ac, oc00, oc01); PG8_STAGE2(PG8_SA(0, 1), Ac, oc10, oc11);
    if (wr == 1) PG8_BAR;
    PG8_WAIT_V(2); PG8_BAR;
    PG8_STAGE2(PG8_SB(1, 0), cB + kstep, vbc0, vbc1); PG8_STAGE2(PG8_SA(1, 0), Ac + kstep, oc00, oc01); PG8_STAGE2(PG8_SB(1, 1), cB + hsc + kstep, vbc0, vbc1);
    PG8_WAIT_V(6); PG8_BAR;
    for (;;) {
        const bool has_next = S.next(ui + 1, nxt);
        Kn = Kc; An = Ac; nB = cB; on00 = oc00; on01 = oc01; on10 = oc10; on11 = oc11; vbn0 = vbc0; vbn1 = vbc1; hsn = hsc;
        if (has_next) { Kn = S.K(nxt); An = S.a_base(nxt); nB = S.b_ptr(nxt);
            on00 = S.a_off(nxt, RA[0], CA[0]); on01 = S.a_off(nxt, RA[1], CA[1]); on10 = S.a_off(nxt, HALF + RA[0], CA[0]); on11 = S.a_off(nxt, HALF + RA[1], CA[1]);
            vbn0 = (unsigned)(RB[0] * Kn + CA[0]) * 2u; vbn1 = (unsigned)(RB[1] * Kn + CA[1]) * 2u; hsn = (size_t)HALF * Kn * 2; }
        const int nt = Kc / BK;
        for (int t = 0; t < nt; t += 2) {
            const bool last = (t == nt - 2);
            if (last && has_next) S.a_ready(nxt);
            const char* a1 = Ac + (size_t)(t + 1) * kstep;
            const char* a2 = last ? An : Ac + (size_t)(t + 2) * kstep; const char* b2 = last ? nB : cB + (size_t)(t + 2) * kstep;
            const char* a3 = a2 + kstep; const char* b3 = b2 + kstep;
            const unsigned x00 = last ? on00 : oc00, x01 = last ? on01 : oc01, x10 = last ? on10 : oc10, x11 = last ? on11 : oc11;
            const unsigned y0 = last ? vbn0 : vbc0, y1 = last ? vbn1 : vbc1; const size_t hs2 = last ? hsn : hsc;
            PG8_LDB(B0, 0, 0); PG8_LDB(B1, 0, 1); PG8_SCHED; PG8_LDA(At, 0, 0); PG8_STAGE2(PG8_SA(1, 1), a1, oc10, oc11);
            PG8_WAIT_V(8); PG8_WAIT_L(0); PG8_BAR; PG8_MMA(0, 0, At, B0); PG8_MMA(0, 1, At, B1); PG8_BAR; PG8_SCHED;
            PG8_LDA(At, 0, 1); PG8_STAGE2(PG8_SB(0, 0), b2, y0, y1); PG8_STAGE2(PG8_SB(0, 1), b2 + hs2, y0, y1); PG8_STAGE2(PG8_SA(0, 0), a2, x00, x01);
            PG8_WAIT_V(8); PG8_WAIT_L(0); PG8_BAR; PG8_MMA(1, 0, At, B0); PG8_MMA(1, 1, At, B1); PG8_BAR; PG8_SCHED;
            PG8_LDB(B0, 1, 0); PG8_LDB(B1, 1, 1); PG8_SCHED; PG8_LDA(At, 1, 0); PG8_STAGE2(PG8_SA(0, 1), a2, x10, x11);
            PG8_WAIT_V(8); PG8_WAIT_L(0); PG8_BAR; PG8_MMA(0, 0, At, B0); PG8_MMA(0, 1, At, B1); PG8_BAR; PG8_SCHED;
            PG8_LDA(At, 1, 1); PG8_STAGE2(PG8_SB(1, 0), b3, y0, y1); PG8_STAGE2(PG8_SB(1, 1), b3 + hs2, y0, y1); PG8_STAGE2(PG8_SA(1, 0), a3, x00, x01);
            PG8_WAIT_V(8); PG8_WAIT_L(0); PG8_BAR; PG8_MMA(1, 0, At, B0); PG8_MMA(1, 1, At, B1); PG8_BAR; PG8_SCHED;
        }
        if (wr == 0) PG8_BAR;
        E(acc, cur, wr, wc, fr, fq);
        if (!has_next) break;
#pragma unroll
        for (int a = 0; a < 2; ++a)
#pragma unroll
            for (int b = 0; b < 2; ++b)
#pragma unroll
                for (int m = 0; m < 4; ++m)
#pragma unroll
                    for (int n = 0; n < 2; ++n) acc[a][b][m][n] = (f32x4){0.f, 0.f, 0.f, 0.f};
        cur = nxt; Kc = Kn; Ac = An; cB = nB; oc00 = on00; oc01 = on01; oc10 = on10; oc11 = on11; vbc0 = vbn0; vbc1 = vbn1; hsc = hsn; ++ui;
        if (wr == 1) PG8_BAR;
    }
    PG8_WAIT_V(0);
    PG8_BAR;
#undef PG8_SA
#undef PG8_SB
#undef PG8_STAGE2
#undef PG8_LDA
#undef PG8_LDB
#undef PG8_MMA
#undef PG8_WAIT_V
#undef PG8_WAIT_L
#undef PG8_BAR
#undef PG8_SCHED
}
}

__device__ __forceinline__ int krow_of(int r) {
    if (r < T) return (r >> 12) * KVROWS + LCTX + (r & 4095);
    const int rc = r - T; return (rc >> 8) * KVROWS + (rc & 255);
}
struct SchedPlain {
    int nM, nN, G, vcu, Kk; const char* A; const char* B;
    __device__ __forceinline__ bool next(int i, pg8::Unit& u) const { const int L = i * G + vcu; if (L >= nM * nN) return false; u.pm = L / nN; u.pn = L % nN; u.e = 0; u.cnt = 256; u.kind = 0; return true; }
    __device__ __forceinline__ int K(const pg8::Unit&) const { return Kk; }
    __device__ __forceinline__ const char* a_base(const pg8::Unit&) const { return A; }
    __device__ __forceinline__ unsigned a_off(const pg8::Unit& u, int row, int col) const { return (unsigned)((u.pm * 256 + row) * Kk + col) * 2u; }
    __device__ __forceinline__ const char* b_ptr(const pg8::Unit& u) const { return B + (size_t)u.pn * 256 * Kk * 2; }
    __device__ __forceinline__ void a_ready(const pg8::Unit&) const {}
};
struct EpiG1 {
    static constexpr bool PERM = true;
    bf16 *pu, *q, *kall, *vall, *z;
    __device__ __forceinline__ void operator()(const f32x4 (&acc)[2][2][4][2], const pg8::Unit& u, int wr, int wc, int fr, int fq) const {
        const int row0 = u.pm * 256 + wr * 64 + fr, c8 = wc * 32 + 8 * fq;
#pragma unroll
        for (int ai = 0; ai < 2; ++ai)
#pragma unroll
            for (int m = 0; m < 4; ++m) {
                const int row = row0 + ai * 128 + m * 16;
#pragma unroll
                for (int bj = 0; bj < 2; ++bj) {
                    const f32x4 v0 = acc[ai][bj][m][0], v1 = acc[ai][bj][m][1];
                    v4u w; w.x = pk2(v0[0], v0[1]); w.y = pk2(v0[2], v0[3]); w.z = pk2(v1[0], v1[1]); w.w = pk2(v1[2], v1[3]);
                    bf16* dst;
                    if (u.pn == 0) dst = pu + (size_t)row * 256 + bj * 128 + c8;
                    else if (u.pn <= 2) dst = q + (size_t)row * 512 + (u.pn - 1) * 256 + bj * 128 + c8;
                    else if (u.pn == 3) dst = (bj == 0 ? kall : vall) + (size_t)krow_of(row) * 128 + c8;
                    else dst = z + (size_t)row * 512 + (u.pn - 4) * 256 + bj * 128 + c8;
                    *(v4u*)dst = w;
                }
            }
    }
};
struct EpiG2 {
    static constexpr bool PERM = false;
    const float* xin; const float* cin; float* xout; float* cout; const float* mod;
    __device__ __forceinline__ void operator()(const f32x4 (&acc)[2][2][4][2], const pg8::Unit& u, int wr, int wc, int fr, int fq) const {
        const int rt0 = u.pm * 256; const bool isc = rt0 >= T;
        const int bsel = isc ? 4 : (rt0 >> 12);
        const float* g1 = mod + bsel * 6144 + 2048;
        const float* base = isc ? cin - (size_t)T * 1024 : xin; float* out = isc ? cout - (size_t)T * 1024 : xout;
        const int row0 = rt0 + wr * 64 + fr, col0 = u.pn * 256 + wc * 32 + 4 * fq;
#pragma unroll
        for (int bj = 0; bj < 2; ++bj)
#pragma unroll
            for (int n = 0; n < 2; ++n) {
                const int col = col0 + bj * 128 + n * 16; const f32x4 gv = *(const f32x4*)(g1 + col);
#pragma unroll
                for (int ai = 0; ai < 2; ++ai)
#pragma unroll
                    for (int m = 0; m < 4; ++m) { const size_t off = (size_t)(row0 + ai * 128 + m * 16) * 1024 + col; const f32x4 bs = *(const f32x4*)(base + off); *(f32x4*)(out + off) = bs + gv * acc[ai][bj][m][n]; }
            }
    }
};
struct SchedMoe {
    int G, vcu, ntile;
    const char* hb; const char* actb; const char* wgu; const char* wd; const unsigned* list; const LAS int* tt; unsigned* ready; unsigned* tmo;
    __device__ __forceinline__ bool next(int i, pg8::Unit& u) const {
        const int U = ntile * 4; const int r = U % G, q = U / G; const int n3 = q + (vcu < r ? 1 : 0); int L;
        if (i < n3) { L = i * G + vcu; u.kind = 0; }
        else { const int j = i - n3; const int nl = G - r;
            if (vcu >= r) L = (j == 0) ? (vcu - r) : (j == 1) ? nl + (vcu - r) : 2 * nl + (j - 2) * G + vcu;
            else L = 2 * nl + j * G + vcu;
            if (L >= U) return false; u.kind = 1; }
        const int tau = L >> 2; u.pn = L & 3; u.pm = tau; int e = 0;
#pragma unroll
        for (int k = 1; k < 16; ++k) e += (tt[k] <= tau) ? 1 : 0;
        u.e = e; const int r0 = (tau - tt[e]) * 256; const int c = tt[17 + e] - r0; u.cnt = c < 256 ? c : 256; return true;
    }
    __device__ __forceinline__ int K(const pg8::Unit& u) const { return u.kind ? 512 : 1024; }
    __device__ __forceinline__ const char* a_base(const pg8::Unit& u) const { return u.kind ? actb : hb; }
    __device__ __forceinline__ unsigned a_off(const pg8::Unit& u, int row, int col) const {
        if (u.kind) return (unsigned)((u.pm * 256 + row) * 512 + col) * 2u;
        const int r0 = (u.pm - tt[u.e]) * 256; unsigned tok = 0;
        if (row < u.cnt) tok = list[(size_t)u.e * TT + r0 + row] >> 1;
        return (tok * 1024u + (unsigned)col) * 2u;
    }
    __device__ __forceinline__ const char* b_ptr(const pg8::Unit& u) const { return u.kind ? wd + ((size_t)u.e * 1024 + (size_t)u.pn * 256) * 512 * 2 : wgu + ((size_t)u.e * 1024 + (size_t)u.pn * 256) * 1024 * 2; }
    __device__ __forceinline__ void a_ready(const pg8::Unit& u) const {
        if (!u.kind) return;
        if (threadIdx.x < 64) {
            unsigned* w = ready + 16 * u.pm; unsigned sp = 0;
            while ((unsigned)__builtin_amdgcn_readfirstlane(__hip_atomic_load(w, __ATOMIC_RELAXED, __HIP_MEMORY_SCOPE_AGENT)) < 32u) {
                __builtin_amdgcn_s_sleep(2);
                if (++sp > (1u << 22)) { if (threadIdx.x == 0) __hip_atomic_store(tmo, 1u, __ATOMIC_RELAXED, __HIP_MEMORY_SCOPE_AGENT); break; } }
            __builtin_amdgcn_fence(__ATOMIC_ACQUIRE, "agent");
            asm volatile("s_waitcnt vmcnt(0)" ::: "memory");
        }
        asm volatile("" ::: "memory"); __builtin_amdgcn_s_barrier(); asm volatile("" ::: "memory");
    }
};
__device__ __forceinline__ void store16_wt(void* p, v4u v) { asm volatile("global_store_dwordx4 %0, %1, off sc1\n\ts_nop 1" :: "v"(p), "v"(v) : "memory"); }
struct EpiG3 {
    static constexpr bool PERM = true;
    bf16* act; unsigned* ready;
    __device__ __forceinline__ void operator()(const f32x4 (&acc)[2][2][4][2], const pg8::Unit& u, int wr, int wc, int fr, int fq) const {
        const int row0 = u.pm * 256 + wr * 64 + fr, c8 = u.pn * 128 + wc * 32 + 8 * fq;
#pragma unroll
        for (int ai = 0; ai < 2; ++ai)
#pragma unroll
            for (int m = 0; m < 4; ++m) {
                float a[8];
#pragma unroll
                for (int n = 0; n < 2; ++n)
#pragma unroll
                    for (int k = 0; k < 4; ++k) { const float g = acc[ai][0][m][n][k], up = acc[ai][1][m][n][k]; a[n * 4 + k] = g / (1.f + __expf(-g)) * up; }
                v4u w; w.x = pk2(a[0], a[1]); w.y = pk2(a[2], a[3]); w.z = pk2(a[4], a[5]); w.w = pk2(a[6], a[7]);
                store16_wt(act + (size_t)(row0 + ai * 128 + m * 16) * 512 + c8, w);
            }
        asm volatile("s_waitcnt vmcnt(0)" ::: "memory");
        if ((threadIdx.x & 63) == 0) __hip_atomic_fetch_add(ready + 16 * u.pm, 1u, __ATOMIC_RELAXED, __HIP_MEMORY_SCOPE_AGENT);
    }
};
struct EpiG4 {
    static constexpr bool PERM = true;
    bf16* y2; const unsigned* list; const float* wts; const LAS int* tt;
    __device__ __forceinline__ void operator()(const f32x4 (&acc)[2][2][4][2], const pg8::Unit& u, int wr, int wc, int fr, int fq) const {
        const int r0 = (u.pm - tt[u.e]) * 256; const int c8 = u.pn * 256 + wc * 32 + 8 * fq;
#pragma unroll
        for (int ai = 0; ai < 2; ++ai)
#pragma unroll
            for (int m = 0; m < 4; ++m) {
                const int row = wr * 64 + fr + ai * 128 + m * 16;
                if (row < u.cnt) {
                    const unsigned ent = list[(size_t)u.e * TT + r0 + row]; const float w = wts[ent];
#pragma unroll
                    for (int bj = 0; bj < 2; ++bj) {
                        const f32x4 v0 = acc[ai][bj][m][0] * w, v1 = acc[ai][bj][m][1] * w;
                        v4u o; o.x = pk2(v0[0], v0[1]); o.y = pk2(v0[2], v0[3]); o.z = pk2(v1[0], v1[1]); o.w = pk2(v1[2], v1[3]);
                        *(v4u*)(y2 + (size_t)ent * 1024 + bj * 128 + c8) = o;
                    }
                }
            }
    }
};

struct EpiMoe { static constexpr bool PERM = true; EpiG3 e3; EpiG4 e4;
    __device__ __forceinline__ void operator()(const f32x4 (&acc)[2][2][4][2], const pg8::Unit& u, int wr, int wc, int fr, int fq) const { if (u.kind) e4(acc, u, wr, wc, fr, fq); else e3(acc, u, wr, wc, fr, fq); } };

#include <hip/hip_bf16.h>
#include <cmath>
namespace attn_body {
using bf16=__hip_bfloat16;
using bf16x8=__attribute__((ext_vector_type(8)))short;
using s16x4=__attribute__((ext_vector_type(4)))short;
using f32x16=__attribute__((ext_vector_type(16)))float;
using u32x4=__attribute__((ext_vector_type(4)))unsigned;
constexpr int D=64,QP=512,KVP=128,OP=1024;
constexpr int NW=8,QBLK=32,KVBLK=64;
__device__ __forceinline__ int crow(int r,int hi){return (r&3)+8*(r>>2)+4*hi;}
#define SBAR() __builtin_amdgcn_sched_barrier(0)
__device__ __forceinline__ void wmask(f32x16&p0,f32x16&p1,int kp0,int qpos,int hi){
  const float NEG=-INFINITY; const bool tile_ok=(unsigned)kp0<4096u; const int base=kp0+4*hi-qpos+128;
  #pragma unroll
  for(int r=0;r<16;++r){const int dd=base+(r&3)+8*(r>>2); if(!tile_ok||(unsigned)dd>256u)p0[r]=NEG; if(!tile_ok||(unsigned)(dd+32)>256u)p1[r]=NEG;}
}
constexpr int NSLOT=3, SLOTB=8192;
constexpr int LDS_K=0, LDS_V=NSLOT*SLOTB, LDS_WS=2*NSLOT*SLOTB, LDS_OST=LDS_WS+NW*64*4, LDS_BYTES=LDS_OST+NW*4096;
constexpr float C2=0.125f*1.4426950408889634f;
__device__ __forceinline__ void glds16(const void*gsrc,unsigned lds_dst){unsigned keep;
  asm volatile("s_mov_b32 %0, m0\n\ts_mov_b32 m0, %2\n\ts_nop 0\n\tglobal_load_lds_dwordx4 %1, off\n\ts_mov_b32 m0, %0":"=&s"(keep):"v"(gsrc),"s"(lds_dst):"memory");}
__device__ __forceinline__ float max3f(float a,float b,float c){float r;asm("v_max3_f32 %0, %1, %2, %3":"=v"(r):"v"(a),"v"(b),"v"(c));return r;}
__device__ __forceinline__ float max2f(float a,float b){float r;asm("v_max_f32_e32 %0, %1, %2":"=v"(r):"v"(a),"v"(b));return r;}
__device__ __forceinline__ float fadd_s(float a,float b){float r;asm("v_add_f32_e32 %0, %1, %2":"=v"(r):"v"(a),"v"(b));return r;}
__device__ __forceinline__ float fsub_s(float a,float b){float r;asm("v_sub_f32_e32 %0, %1, %2":"=v"(r):"v"(a),"v"(b));return r;}
typedef float f32x2_t __attribute__((ext_vector_type(2))); typedef __bf16 bf16x2_t __attribute__((ext_vector_type(2)));
__device__ __forceinline__ unsigned cvtpk_s(float lo,float hi){f32x2_t v={lo,hi};bf16x2_t b=__builtin_convertvector(v,bf16x2_t);return __builtin_bit_cast(unsigned,b);}
#define WAIT_BAR(N) asm volatile("s_waitcnt vmcnt(" #N ") lgkmcnt(0)\n\ts_barrier":::"memory")

__device__ __forceinline__ void qkt(f32x16&p0,f32x16&p1,const char*Kslot,const bf16x8*qr,const f32x16&negm,int r32,int hi){
  const char*kb=Kslot+hi*1024+r32*16;
  #pragma unroll
  for(int d0=0;d0<4;++d0){
    const bf16x8 b0=*reinterpret_cast<const bf16x8*>(kb+d0*2048);
    const bf16x8 b1=*reinterpret_cast<const bf16x8*>(kb+d0*2048+512);
    if(d0==0){p0=__builtin_amdgcn_mfma_f32_32x32x16_bf16(b0,qr[0],negm,0,0,0);p1=__builtin_amdgcn_mfma_f32_32x32x16_bf16(b1,qr[0],negm,0,0,0);}
    else{p0=__builtin_amdgcn_mfma_f32_32x32x16_bf16(b0,qr[d0],p0,0,0,0);p1=__builtin_amdgcn_mfma_f32_32x32x16_bf16(b1,qr[d0],p1,0,0,0);}}
}
typedef __attribute__((address_space(3))) const char* lds_cptr;
typedef short v4i16_t __attribute__((ext_vector_type(4)));
__device__ __forceinline__ void kload8(bf16x8*kf,lds_cptr kp){
  kf[0]=*(const __attribute__((address_space(3))) bf16x8*)(kp);      kf[1]=*(const __attribute__((address_space(3))) bf16x8*)(kp+512);
  kf[2]=*(const __attribute__((address_space(3))) bf16x8*)(kp+2048); kf[3]=*(const __attribute__((address_space(3))) bf16x8*)(kp+2560);
  kf[4]=*(const __attribute__((address_space(3))) bf16x8*)(kp+4096); kf[5]=*(const __attribute__((address_space(3))) bf16x8*)(kp+4608);
  kf[6]=*(const __attribute__((address_space(3))) bf16x8*)(kp+6144); kf[7]=*(const __attribute__((address_space(3))) bf16x8*)(kp+6656);
}
__device__ __forceinline__ void kload2(bf16x8*kf,lds_cptr kp,int j){ kf[2*j]=*(const __attribute__((address_space(3))) bf16x8*)(kp+j*2048); kf[2*j+1]=*(const __attribute__((address_space(3))) bf16x8*)(kp+j*2048+512); }
__device__ __forceinline__ s16x4 vtr(lds_cptr p){ return __builtin_bit_cast(s16x4,__builtin_amdgcn_ds_read_tr16_b64_v4i16((__attribute__((address_space(3))) v4i16_t*)p)); }
__device__ __forceinline__ float rowmax(const f32x16&p0,const f32x16&p1){
  float a=max3f(p0[0],p0[1],p1[0]),b=max3f(p0[2],p0[3],p1[1]);a=max3f(a,p1[2],p1[3]);
  #pragma unroll
  for(int r=4;r<16;r+=4){a=max3f(a,p0[r],p0[r+1]);b=max3f(b,p0[r+2],p0[r+3]);a=max3f(a,p1[r],p1[r+1]);b=max3f(b,p1[r+2],p1[r+3]);}
  const float m=max2f(a,b);
  auto rr=__builtin_amdgcn_permlane32_swap(__float_as_uint(m),__float_as_uint(m),false,false);
  return max2f(__uint_as_float(rr[0]),__uint_as_float(rr[1]));
}
__device__ __forceinline__ void pv(f32x16*o,int vb,bf16x8 pa0,bf16x8 pa1,bf16x8 pa2,bf16x8 pa3){
  #pragma unroll
  for(int d0=0;d0<2;++d0){s16x4 lo[4],hi[4];
    #pragma unroll
    for(int ks=0;ks<4;++ks){
      asm volatile("ds_read_b64_tr_b16 %0,%1 offset:%c2":"=&v"(lo[ks]):"v"(vb),"i"(d0*4096+ks*1024):"memory");
      asm volatile("ds_read_b64_tr_b16 %0,%1 offset:%c2":"=&v"(hi[ks]):"v"(vb),"i"(d0*4096+ks*1024+512):"memory");}
    asm volatile("s_waitcnt lgkmcnt(0)":::"memory");SBAR();
    #define PK(k) (bf16x8){lo[k][0],lo[k][1],lo[k][2],lo[k][3],hi[k][0],hi[k][1],hi[k][2],hi[k][3]}
    o[d0]=__builtin_amdgcn_mfma_f32_32x32x16_bf16(pa0,PK(0),o[d0],0,0,0);
    o[d0]=__builtin_amdgcn_mfma_f32_32x32x16_bf16(pa1,PK(1),o[d0],0,0,0);
    o[d0]=__builtin_amdgcn_mfma_f32_32x32x16_bf16(pa2,PK(2),o[d0],0,0,0);
    o[d0]=__builtin_amdgcn_mfma_f32_32x32x16_bf16(pa3,PK(3),o[d0],0,0,0);
    #undef PK
  }
}

#ifndef ATTN_STORE16
#define ATTN_STORE16(p,v) (*(u32x4*)(p)=(v))
#endif
template<int THRL> __device__ __forceinline__ void attn_unit(const bf16*Qu,const bf16*__restrict__ Kh,const bf16*__restrict__ Vh,bf16*Ou,const int p0,const int NT,const float* sinkp,const float* qg,const float2* ropet,char*shm){
  int tid=threadIdx.x; asm volatile("":"+v"(tid)); const int lane=tid&63,r32=lane&31,hi=lane>>5; const int wid=__builtin_amdgcn_readfirstlane(tid>>6);
  const int hsub=wid>>1, psub=(wid&1)*QBLK;
  const bf16*Qw=Qu+(long)psub*QP+hsub*D;
  const unsigned lds0=(unsigned)(uintptr_t)shm;
  float*wsf=(float*)(shm+LDS_WS)+wid*64;
  const bf16*ksrc=Kh+(long)lane*KVP+wid*8;
  const bf16*vsrc=Vh+(long)(16*(wid&3)+(lane>>2))*KVP+(wid>>2)*32+(lane&3)*8;
  const unsigned kdst=lds0+LDS_K+wid*1024, vdst=lds0+LDS_V+wid*1024;
  #define KP0(t) (p0-128+64*((t)-4))
  #define TROW(t) ((t)<4?64*(t):(((unsigned)KP0(t)<4096u)?256+KP0(t):256))
  #define DMA_K(t,slot) glds16(ksrc+(long)TROW(t)*KVP,(unsigned)__builtin_amdgcn_readfirstlane(kdst+(slot)))
  #define DMA_V(t,slot) glds16(vsrc+(long)TROW(t)*KVP,(unsigned)__builtin_amdgcn_readfirstlane(vdst+(slot)))
  const int vb0=(int)(lds0+LDS_V)+((lane>>4)&1)*32+(lane&3)*8+(4*hi+((lane&15)>>2))*64;
  const char*Kbase=shm+LDS_K; bf16x8 kf[8];
  const lds_cptr shm3=(lds_cptr)shm; const lds_cptr kp0=shm3+LDS_K+hi*1024+r32*16; const lds_cptr vp0=shm3+LDS_V+((lane>>4)&1)*32+(lane&3)*8+(4*hi+((lane&15)>>2))*64;
  DMA_K(0,0);DMA_V(0,0);DMA_K(1,SLOTB);
  bf16x8 qr[4];
  { bf16x8 qraw[4];
    #pragma unroll
    for(int d0=0;d0<4;++d0)qraw[d0]=*reinterpret_cast<const bf16x8*>(&Qw[(long)r32*QP+d0*16+hi*8]);
    float qf[4][8]; float ss=0.f;
    #pragma unroll
    for(int d0=0;d0<4;++d0)
      #pragma unroll
      for(int j=0;j<8;++j){ qf[d0][j]=__builtin_bit_cast(float,(unsigned)(unsigned short)qraw[d0][j]<<16); ss+=qf[d0][j]*qf[d0][j]; }
    ss+=__shfl_xor(ss,32);
    const float rstd=1.0f/sqrtf(ss*(1.f/64.f)+1e-6f)*C2;
    #pragma unroll
    for(int d0=0;d0<4;++d0)
      #pragma unroll
      for(int j=0;j<8;++j) qf[d0][j]*=rstd*qg[16*d0+8*hi+j];
    if(ropet){ const float2* rp=ropet+(long)(p0+psub+r32)*32+8*hi;
      #pragma unroll
      for(int j=0;j<8;++j){ const float2 c1=rp[j],c2=rp[16+j];
        const float a=qf[0][j],b=qf[1][j],c=qf[2][j],d=qf[3][j];
        qf[0][j]=a*c1.x-b*c1.y; qf[1][j]=b*c1.x+a*c1.y; qf[2][j]=c*c2.x-d*c2.y; qf[3][j]=d*c2.x+c*c2.y; } }
    #pragma unroll
    for(int d0=0;d0<4;++d0){ u32x4 w; w[0]=cvtpk_s(qf[d0][0],qf[d0][1]); w[1]=cvtpk_s(qf[d0][2],qf[d0][3]); w[2]=cvtpk_s(qf[d0][4],qf[d0][5]); w[3]=cvtpk_s(qf[d0][6],qf[d0][7]); qr[d0]=__builtin_bit_cast(bf16x8,w); } }
  float mhat=0.f,l_reg=0.f;f32x16 o[2];o[0]=f32x16{};o[1]=f32x16{};f32x16 negm=f32x16{};asm volatile("":"+v"(negm));
  const int qpos=p0+psub+r32;
  #define CMASK(P0,P1,t) do{ if((t)>=4)wmask(P0,P1,KP0(t),qpos,hi); }while(0)
  bool resc=false;
  #define START(P0,P1) do{ const float rm=rowmax(P0,P1); resc=false; \
    { const float dl=rm; mhat=fadd_s(mhat,dl); \
      _Pragma("unroll") for(int r=0;r<16;++r){P0[r]=fsub_s(P0[r],dl);P1[r]=fsub_s(P1[r],dl);} \
      _Pragma("unroll") for(int r=0;r<16;++r)negm[r]=-mhat; asm volatile("":"+v"(negm)); } \
    _Pragma("unroll") for(int r=0;r<16;++r)P0[r]=__builtin_amdgcn_exp2f(P0[r]); }while(0)
  #define RESC() do{ if(resc){ asm volatile("s_waitcnt lgkmcnt(0)":::"memory"); \
      _Pragma("unroll") for(int d_=0;d_<2;++d_) _Pragma("unroll") for(int r=0;r<16;++r)o[d_][r]*=wsf[crow(r,hi)]; } }while(0)
  f32x16 pA0,pA1,pB0,pB1;
  int sl_prev=0,sl_cur=0,sl_next=SLOTB;
  #define ROT() do{sl_prev=sl_cur;sl_cur=sl_next;sl_next=(sl_next==(NSLOT-1)*SLOTB)?0:sl_next+SLOTB;}while(0)
  DMA_K(2,2*SLOTB);
  WAIT_BAR(3);
  qkt(pA0,pA1,Kbase,qr,negm,r32,hi);asm volatile("s_nop 15\n\ts_nop 7":"+v"(pA0),"+v"(pA1));CMASK(pA0,pA1,0);
  START(pA0,pA1);
  _Pragma("unroll") for(int r=0;r<16;++r)pA1[r]=__builtin_amdgcn_exp2f(pA1[r]);
  WAIT_BAR(0);
  DMA_K(3,0);DMA_V(1,SLOTB);
  ROT();
  kload8(kf,kp0+sl_cur);
  WAIT_BAR(2);
  s16x4 vlo[8],vhi[8]; u32x4 pw0,pw1,pw2,pw3;
  #define PKW(P,B) cvtpk_s(P[B],P[B+1])
  #define PAF(k) __builtin_bit_cast(bf16x8,pw##k)
  #define VFR(i) (bf16x8){vlo[i][0],vlo[i][1],vlo[i][2],vlo[i][3],vhi[i][0],vhi[i][1],vhi[i][2],vhi[i][3]}
  #define PIN(x) asm volatile("":"+v"(x))
  #define MX3(a,b,c) __builtin_fmaxf(__builtin_fmaxf((a),(b)),(c))
  #define GAPA(MF,A0,A1,A2,A3,W0,W1,PW) do{ MF; sacc+=A0; sacc+=A1; sacc+=A2; sacc+=A3; PIN(sacc); W0; W1; PIN(PW); SBAR(); }while(0)
  #define EX(v) __builtin_amdgcn_exp2f(v)
  #define GAPB(MF,X,B) do{ MF; X[B]=EX(X[B]); X[B+1]=EX(X[B+1]); X[B+2]=EX(X[B+2]); X[B+3]=EX(X[B+3]); PIN(X); SBAR(); }while(0)
  #define VRD(i) do{ vlo[i]=vtr(vp_+(((i)>>2)*4096+((i)&3)*1024)); vhi[i]=vtr(vp_+(((i)>>2)*4096+((i)&3)*1024+512)); }while(0)
  #define KRD(G,j) do{ if(G){ kload2(kf,kp0+sl_next,j); SBAR(); } }while(0)
  #define STEP(C0,C1,P0,P1,t,GK,GV,GL) do{ SBAR(); \
    const lds_cptr vp_=vp0+sl_prev; \
    VRD(0); SBAR(); float sacc=(P0[0]+P0[1]); \
    GAPA(C0=__builtin_amdgcn_mfma_f32_32x32x16_bf16(kf[0],qr[0],negm,0,0,0), P0[2],P0[3],P0[4],P0[5],     pw0[0]=PKW(P0,0), pw0[1]=PKW(P0,2), pw0); \
    VRD(4); SBAR(); GAPA(C1=__builtin_amdgcn_mfma_f32_32x32x16_bf16(kf[1],qr[0],negm,0,0,0), P0[6],P0[7],P0[8],P0[9],     pw0[2]=PKW(P0,4), pw0[3]=PKW(P0,6), pw0); \
    VRD(1); SBAR(); GAPA(C0=__builtin_amdgcn_mfma_f32_32x32x16_bf16(kf[2],qr[1],C0,0,0,0),   P0[10],P0[11],P0[12],P0[13], pw1[0]=PKW(P0,8), pw1[1]=PKW(P0,10), pw1); \
    VRD(5); SBAR(); GAPA(C1=__builtin_amdgcn_mfma_f32_32x32x16_bf16(kf[3],qr[1],C1,0,0,0),   P0[14],P0[15],P1[0],P1[1],   pw1[2]=PKW(P0,12),pw1[3]=PKW(P0,14), pw1); \
    VRD(2); SBAR(); GAPA(C0=__builtin_amdgcn_mfma_f32_32x32x16_bf16(kf[4],qr[2],C0,0,0,0),   P1[2],P1[3],P1[4],P1[5],     pw2[0]=PKW(P1,0), pw2[1]=PKW(P1,2), pw2); \
    VRD(6); SBAR(); GAPA(C1=__builtin_amdgcn_mfma_f32_32x32x16_bf16(kf[5],qr[2],C1,0,0,0),   P1[6],P1[7],P1[8],P1[9],     pw2[2]=PKW(P1,4), pw2[3]=PKW(P1,6), pw2); \
    VRD(3); SBAR(); GAPA(C0=__builtin_amdgcn_mfma_f32_32x32x16_bf16(kf[6],qr[3],C0,0,0,0),   P1[10],P1[11],P1[12],P1[13], pw3[0]=PKW(P1,8), pw3[1]=PKW(P1,10), pw3); \
    VRD(7); SBAR(); GAPA(C1=__builtin_amdgcn_mfma_f32_32x32x16_bf16(kf[7],qr[3],C1,0,0,0),   P1[14],P1[15],0.f,0.f,       pw3[2]=PKW(P1,12),pw3[3]=PKW(P1,14), pw3); \
    l_reg+=sacc; \
    if(GK){DMA_K((t)+3,sl_cur);} if(GV){DMA_V((t)+1,sl_next);} \
    CMASK(C0,C1,t); \
    { float a=MX3(C0[0],C0[1],C1[0]),b=MX3(C0[2],C0[3],C1[1]); a=MX3(a,C1[2],C1[3]); \
      _Pragma("unroll") for(int r=4;r<16;r+=4){a=MX3(a,C0[r],C0[r+1]);b=MX3(b,C0[r+2],C0[r+3]);a=MX3(a,C1[r],C1[r+1]);b=MX3(b,C1[r+2],C1[r+3]);} \
      float rm=__builtin_fmaxf(a,b); { auto rr=__builtin_amdgcn_permlane32_swap(__float_as_uint(rm),__float_as_uint(rm),false,false); rm=__builtin_fmaxf(__uint_as_float(rr[0]),__uint_as_float(rr[1])); } \
      resc=false; \
      if(__builtin_expect(__any(rm>(float)THRL),0)){ const float dl=__builtin_fmaxf(rm,0.f); mhat+=dl; \
        _Pragma("unroll") for(int r=0;r<16;++r){C0[r]-=dl;C1[r]-=dl;} \
        _Pragma("unroll") for(int r=0;r<16;++r)negm[r]=-mhat; asm volatile("":"+v"(negm)); \
        const float f=__builtin_amdgcn_exp2f(-dl); l_reg*=f; if(hi==0)wsf[r32]=f; resc=true; } } \
    SBAR(); \
    GAPB(o[0]=__builtin_amdgcn_mfma_f32_32x32x16_bf16(PAF(0),VFR(0),o[0],0,0,0), C0,0); \
    GAPB(o[1]=__builtin_amdgcn_mfma_f32_32x32x16_bf16(PAF(0),VFR(4),o[1],0,0,0), C0,4); \
    KRD(GL,0); GAPB(o[0]=__builtin_amdgcn_mfma_f32_32x32x16_bf16(PAF(1),VFR(1),o[0],0,0,0), C0,8); \
    KRD(GL,1); GAPB(o[1]=__builtin_amdgcn_mfma_f32_32x32x16_bf16(PAF(1),VFR(5),o[1],0,0,0), C0,12); \
    KRD(GL,2); GAPB(o[0]=__builtin_amdgcn_mfma_f32_32x32x16_bf16(PAF(2),VFR(2),o[0],0,0,0), C1,0); \
    KRD(GL,3); GAPB(o[1]=__builtin_amdgcn_mfma_f32_32x32x16_bf16(PAF(2),VFR(6),o[1],0,0,0), C1,4); \
    GAPB(o[0]=__builtin_amdgcn_mfma_f32_32x32x16_bf16(PAF(3),VFR(3),o[0],0,0,0), C1,8); \
    GAPB(o[1]=__builtin_amdgcn_mfma_f32_32x32x16_bf16(PAF(3),VFR(7),o[1],0,0,0), C1,12); \
    }while(0)
  int t=1;
  for(;t+5<NT;t+=2){
    STEP(pB0,pB1,pA0,pA1,t,true,true,true);     WAIT_BAR(2); RESC(); ROT();
    STEP(pA0,pA1,pB0,pB1,t+1,true,true,true);   WAIT_BAR(2); RESC(); ROT();
  }
  #define ENDW(tt) do{ if((tt)+3<NT){WAIT_BAR(2);} else if((tt)+2<NT){WAIT_BAR(1);} else {WAIT_BAR(0);} }while(0)
  for(;t+1<NT;t+=2){
    STEP(pB0,pB1,pA0,pA1,t,(t+3<NT),(t+1<NT),(t+1<NT));       ENDW(t);   RESC(); ROT();
    STEP(pA0,pA1,pB0,pB1,t+1,(t+4<NT),(t+2<NT),(t+2<NT));     ENDW(t+1); RESC(); ROT();
  }
  STEP(pB0,pB1,pA0,pA1,NT-1,false,false,false); RESC();
  { float sacc=pB0[0]+pB0[1]; _Pragma("unroll") for(int r=2;r<16;++r)sacc+=pB0[r]; _Pragma("unroll") for(int r=0;r<16;++r)sacc+=pB1[r]; l_reg+=sacc;
    pw0=(u32x4){PKW(pB0,0),PKW(pB0,2),PKW(pB0,4),PKW(pB0,6)};pw1=(u32x4){PKW(pB0,8),PKW(pB0,10),PKW(pB0,12),PKW(pB0,14)};pw2=(u32x4){PKW(pB1,0),PKW(pB1,2),PKW(pB1,4),PKW(pB1,6)};pw3=(u32x4){PKW(pB1,8),PKW(pB1,10),PKW(pB1,12),PKW(pB1,14)};
    SBAR(); pv(o,vb0+sl_cur,PAF(0),PAF(1),PAF(2),PAF(3)); }
  #undef PKW
  #undef PAF
  #undef VFR
  #undef PIN
  #undef MX3
  #undef GAPA
  #undef GAPB
  #undef EX
  #undef VRD
  #undef KRD
  #undef STEP
  #undef ENDW
  l_reg+=__shfl_xor(l_reg,32);
  l_reg+=__builtin_amdgcn_exp2f(sinkp[hsub]*1.4426950408889634f-mhat);
  if(hi==0)wsf[32+r32]=l_reg;asm volatile("s_waitcnt lgkmcnt(0)":::"memory");
  float rli[16];
  #pragma unroll
  for(int r=0;r<16;++r)rli[r]=__builtin_amdgcn_rcpf(wsf[32+crow(r,hi)]);
  bf16*Ow=Ou+(long)psub*OP+hsub*D;
  { bf16*stg=(bf16*)(shm+LDS_OST)+wid*2048;
    #pragma unroll
    for(int r=0;r<16;++r){const int orow=crow(r,hi);
      #pragma unroll
      for(int d0=0;d0<2;++d0)stg[orow*64+d0*32+r32]=__float2bfloat16(o[d0][r]*rli[r]);}
    asm volatile("s_waitcnt lgkmcnt(0)":::"memory");
    #pragma unroll
    for(int i=0;i<4;++i){const int row=i*8+(lane>>3),ch=lane&7; const u32x4 v=*(const u32x4*)(stg+row*64+ch*8); ATTN_STORE16(Ow+(long)row*OP+ch*8,v);} }
  asm volatile("s_waitcnt lgkmcnt(0)\n\ts_barrier":::"memory");
  #undef DMA_K
  #undef DMA_V
  #undef KP0
  #undef TROW
  #undef CMASK
  #undef START
  #undef RESC
  #undef ROT
}
constexpr int ATTN_LDS_BYTES=LDS_BYTES;
#undef SBAR
#undef WAIT_BAR
}

constexpr int SLAB_PITCH = 288;
typedef short v4i16_t __attribute__((ext_vector_type(4)));
template <int MT, class RowAddr, class Epi>
__device__ __forceinline__ void slab_gemm(LAS unsigned char* lds, const bf16* Cmat, const int K, const RowAddr& RA, const Epi& E) {
    int tid = threadIdx.x; asm volatile("" : "+v"(tid));
    const int wid = tid >> 6, lane = tid & 63;
    LAS bf16* Dr = (LAS bf16*)lds;
    f32x16 acc[MT];
#pragma unroll
    for (int i = 0; i < MT; ++i)
#pragma unroll
        for (int r = 0; r < 16; ++r) acc[i][r] = 0.f;
    const int g = (lane >> 4) & 1, h = lane >> 5, qq = (lane & 15) >> 2, pp = lane & 3;
    const LAS bf16* trp = Dr + (8 * h + qq) * SLAB_PITCH + wid * 32 + 16 * g + 4 * pp;
    for (int kc = 0; kc < K; kc += 128) {
        {
            const int k = tid >> 2, qd = tid & 3;
            const bf16* src = RA(kc + k) + qd * 64;
            v4u v[8];
#pragma unroll
            for (int j = 0; j < 8; ++j) v[j] = *(const v4u*)(src + j * 8);
#pragma unroll
            for (int j = 0; j < 8; ++j) *(LAS v4u*)(Dr + k * SLAB_PITCH + qd * 64 + j * 8) = v[j];
        }
        __syncthreads();
        const int kh = h * 8;
#pragma unroll
        for (int s = 0; s < 8; ++s) {
            const v4i16_t b0 = __builtin_amdgcn_ds_read_tr16_b64_v4i16((LAS v4i16_t*)(trp + (16 * s) * SLAB_PITCH));
            const v4i16_t b1 = __builtin_amdgcn_ds_read_tr16_b64_v4i16((LAS v4i16_t*)(trp + (16 * s + 4) * SLAB_PITCH));
            const bf16x8 bfrag = (bf16x8){b0[0], b0[1], b0[2], b0[3], b1[0], b1[1], b1[2], b1[3]};
#pragma unroll
            for (int mt = 0; mt < MT; ++mt) {
                const bf16x8 afrag = *(const bf16x8*)(Cmat + (size_t)(mt * 32 + (lane & 31)) * K + kc + s * 16 + kh);
                acc[mt] = __builtin_amdgcn_mfma_f32_32x32x16_bf16(afrag, bfrag, acc[mt], 0, 0, 0);
            }
        }
        __syncthreads();
    }
    E(acc, wid, lane);
}

struct Args { const float* in[23]; float* out; unsigned char* ws; int ph_lo, ph_hi; };

struct RowA { const bf16* z; int b, n2; __device__ __forceinline__ const bf16* operator()(int k) const { return z + (size_t)(b * 4096 + 64 * (k & 63) + n2) * 512 + (k >> 6) * 256; } };
struct EpiA { bf16* t2; const float2* tw; int b, n2;
    __device__ __forceinline__ void operator()(const f32x16 (&acc)[4], int wid, int lane) const {
        const int ch = wid * 32 + (lane & 31);
#pragma unroll
        for (int mt = 0; mt < 2; ++mt)
#pragma unroll
            for (int r = 0; r < 16; ++r) {
                const int k1 = 32 * mt + (r & 3) + 8 * (r >> 2) + 4 * (lane >> 5);
                const float2 cs = tw[n2 * k1]; const float re = acc[mt][r], im = acc[mt + 2][r];
                const float re2 = cs.x * re + cs.y * im, im2 = cs.x * im - cs.y * re;
                bf16* d = t2 + ((size_t)((b * 64 + n2) * 64 + k1) * 2) * 256 + ch;
                d[0] = (bf16)f2bf(re2); d[256] = (bf16)f2bf(im2);
            }
    } };
struct RowB { const bf16* t2; int b, k1; __device__ __forceinline__ const bf16* operator()(int k) const { return t2 + ((size_t)((b * 64 + (k & 63)) * 64 + k1) * 2 + (k >> 6)) * 256; } };
struct EpiB { bf16* mrg; int b, k1;
    __device__ __forceinline__ void operator()(const f32x16 (&acc)[2], int wid, int lane) const {
        const int ch = wid * 32 + (lane & 31);
#pragma unroll
        for (int mt = 0; mt < 2; ++mt)
#pragma unroll
            for (int r = 0; r < 16; ++r) { const int k2 = 32 * mt + (r & 3) + 8 * (r >> 2) + 4 * (lane >> 5); mrg[(size_t)(b * 4096 + k1 + 64 * k2) * 1024 + 768 + ch] = (bf16)f2bf(DBG_NO_FOUR ? 0.f : acc[mt][r]); }
    } };
struct RowC { const bf16* z; int b; __device__ __forceinline__ const bf16* operator()(int k) const { return z + (size_t)(T + b * 256 + (k & 255)) * 512 + (k >> 8) * 256; } };
struct EpiC { bf16* mrg; int b, mt0;
    __device__ __forceinline__ void operator()(const f32x16 (&acc)[1], int wid, int lane) const {
        const int ch = wid * 32 + (lane & 31);
#pragma unroll
        for (int mt = 0; mt < 1; ++mt)
#pragma unroll
            for (int r = 0; r < 16; ++r) { const int kk = 32 * (mt0 + mt) + (r & 3) + 8 * (r >> 2) + 4 * (lane >> 5); mrg[(size_t)(T + b * 256 + kk) * 1024 + 768 + ch] = (bf16)f2bf(DBG_NO_FOUR ? 0.f : acc[mt][r]); }
    } };

__device__ __forceinline__ void tr_block(const float* src, int ldS, bf16* dst, int ldD, LAS float* scr, int lane) {
#pragma unroll 8
    for (int i = 0; i < 32; ++i) { const int kk = 2 * i + (lane >> 5); scr[kk * 33 + (lane & 31)] = src[(size_t)kk * ldS + (lane & 31)]; }
    LDS_WAIT(); asm volatile("" ::: "memory");
    const int c = lane & 7;
#pragma unroll
    for (int j = 0; j < 4; ++j) { const int n = (lane >> 3) + 8 * j; const LAS float* s = scr + (8 * c) * 33 + n;
        v4u o; o.x = pk2(s[0 * 33], s[1 * 33]); o.y = pk2(s[2 * 33], s[3 * 33]); o.z = pk2(s[4 * 33], s[5 * 33]); o.w = pk2(s[6 * 33], s[7 * 33]);
        *(GAS v4u*)(dst + (size_t)n * ldD + 8 * c) = o; }
    LDS_WAIT(); asm volatile("" ::: "memory");
}


__device__ __forceinline__ void tr_block64(const float* src, int ldS, bf16* dst, int ldD, LAS bf16* scr, int lane) {
    const int kr = lane >> 4, nc = lane & 15;
    f32x4 v[16];
#pragma unroll
    for (int i = 0; i < 16; ++i) v[i] = *(const f32x4*)(src + (size_t)(4 * i + kr) * ldS + 4 * nc);
#pragma unroll
    for (int i = 0; i < 16; ++i) { const int k = 4 * i + kr;
#pragma unroll
        for (int j = 0; j < 4; ++j) scr[(4 * nc + j) * 66 + k] = (bf16)f2bf(v[i][j]); }
    LDS_WAIT(); asm volatile("" ::: "memory");
    const int c = lane & 7;
#pragma unroll
    for (int j = 0; j < 8; ++j) { const int n = (lane >> 3) + 8 * j; const LAS unsigned* p = (const LAS unsigned*)(scr + n * 66 + 8 * c);
        v4u o; o.x = p[0]; o.y = p[1]; o.z = p[2]; o.w = p[3];
        *(GAS v4u*)(dst + (size_t)n * ldD + 8 * c) = o; }
    LDS_WAIT(); asm volatile("" ::: "memory");
}

typedef const __attribute__((address_space(4))) Args* kargs_t;
__device__ __forceinline__ kargs_t ka_launder() { kargs_t p = (kargs_t)__builtin_amdgcn_kernarg_segment_ptr(); asm volatile("" : "+s"(p)); return p; }
__device__ __forceinline__ int tid_launder() { int t = threadIdx.x; asm volatile("" : "+v"(t)); return t; }
#define KA_DECL const kargs_t KA = ka_launder(); const int tid = tid_launder(); const int lane = tid & 63; const int wave = __builtin_amdgcn_readfirstlane(tid >> 6); const int gw = vcu * 8 + wave; const int gt = vcu * 512 + tid; (void)lane; (void)wave; (void)gw; (void)gt;
#define ws (KA->ws)
#define ctl ((gu32*)(ws + O_CTL))
#define x_in (KA->in[0])
#define c_in (KA->in[1])
#define ctx_in (KA->in[2])
#define cctx_in (KA->in[3])
#define w_mod (KA->in[4])
#define b_mod (KA->in[5])
#define norm1_g (KA->in[6])
#define w_in (KA->in[7])
#define q_norm_g (KA->in[8])
#define k_norm_g (KA->in[9])
#define attn_sink (KA->in[10])
#define pool_w (KA->in[11])
#define pool_scale (KA->in[12])
#define four_w (KA->in[13])
#define w_out (KA->in[14])
#define norm2_g (KA->in[15])
#define w_grp (KA->in[16])
#define b_grp (KA->in[17])
#define w_rtr (KA->in[18])
#define b_rtr (KA->in[19])
#define w_gate (KA->in[20])
#define w_up (KA->in[21])
#define w_down (KA->in[22])
#define outp (KA->out)
#define modv ((float*)(ws + O_MOD))
#define rope ((float2*)(ws + O_ROPE))
#define twt ((float2*)(ws + O_TW))
#define fma ((bf16*)(ws + O_FMA))
#define fmb ((bf16*)(ws + O_FMB))
#define fmc ((bf16*)(ws + O_FMC))
#define hbuf ((bf16*)(ws + O_H))
#define kall ((bf16*)(ws + O_KALL))
#define vall ((bf16*)(ws + O_VALL))
#define xc ((float*)(ws + O_XC))
#define list ((unsigned*)(ws + O_LIST))
#define wts ((float*)(ws + O_WTS))
#define act ((bf16*)(ws + O_ACT))
#define t2 ((bf16*)(ws + O_T2))
#define mrg ((bf16*)(ws + O_MRG))
#define qb ((bf16*)(ws + O_Q))
#define pu ((bf16*)(ws + O_PU))
#define zb ((bf16*)(ws + O_Z))
#define y2 ((bf16*)(ws + O_Y2))

#ifndef PH_MASK
#define PH_MASK 0x3ffff
#endif
#define IN(k) (lo <= (k) && (k) < hi && ((PH_MASK >> (k)) & 1))
#define SEAM(k) do { if (IN(k) && IN((k) + 1)) xcd_barrier(bar); } while (0)
#define modl (modv + (size_t)l * 5 * 6144)
#define win_t ((bf16*)(ws + O_WIN + l * SZ_WIN1))
#define wout_t ((bf16*)(ws + O_WOUT + l * SZ_WOUT1))
#define wgu_t ((bf16*)(ws + O_WGU + l * SZ_WGU1))
#define wd_t ((bf16*)(ws + O_WD + l * SZ_WD1))
template <int l> __device__ __forceinline__ void layer_body(LAS unsigned char* lds, const int G, const int vcu, const XcdBarrier& bar, const int lo, const int hi) {
    const int NGW = G * 8, NGT = G * 512; LAS int* ttab = (LAS int*)(lds + TILE_OFF);
    constexpr int P = 1 + 8 * l;

        for (int rep_ = 0; rep_ < 1 + ((l == 0) ? ((REP_MASK >> (1 + 0)) & 1) : 0); ++rep_)
        if (IN(P + 0)) {
            KA_DECL
            const float* modp = modv;
#pragma clang loop vectorize(disable) unroll(disable)
            for (int r0 = gw; r0 < TT; r0 += 2 * NGW) {
                const int r1 = r0 + NGW; const bool has1 = r1 < TT;
                f32x4 va[4], vb[4]; v2u yaa[4], yab[4], yba[4], ybb[4];
                const float* srca; const float* srcb;
                { const bool isc = r0 >= T; srca = (l == 0) ? (isc ? ctx_in + (size_t)(r0 - T) * 1024 : x_in + (size_t)r0 * 1024) : (isc ? xc + (size_t)(r0 - T) * 1024 : outp + (size_t)r0 * 1024); }
                { const int rr = has1 ? r1 : r0; const bool isc = rr >= T; srcb = (l == 0) ? (isc ? ctx_in + (size_t)(rr - T) * 1024 : x_in + (size_t)rr * 1024) : (isc ? xc + (size_t)(rr - T) * 1024 : outp + (size_t)rr * 1024); }
#pragma unroll
                for (int j = 0; j < 4; ++j) { va[j] = *(const f32x4*)(srca + 4 * lane + 256 * j); vb[j] = *(const f32x4*)(srcb + 4 * lane + 256 * j); }
                if (l == 1) {
                    const int rr = has1 ? r1 : r0;
#pragma unroll
                    for (int j = 0; j < 4; ++j) { yaa[j] = *(const v2u*)(y2 + (size_t)(2 * r0) * 1024 + 4 * lane + 256 * j); yab[j] = *(const v2u*)(y2 + (size_t)(2 * r0 + 1) * 1024 + 4 * lane + 256 * j);
                        yba[j] = *(const v2u*)(y2 + (size_t)(2 * rr) * 1024 + 4 * lane + 256 * j); ybb[j] = *(const v2u*)(y2 + (size_t)(2 * rr + 1) * 1024 + 4 * lane + 256 * j); }
                }
#pragma unroll
                for (int half = 0; half < 2; ++half) {
                    if (half == 1 && !has1) break;
                    const int r = half ? r1 : r0; f32x4 (&v)[4] = half ? vb : va; v2u (&ya)[4] = half ? yba : yaa; v2u (&yb)[4] = half ? ybb : yab;
                    const bool isc = r >= T; const int bsel = isc ? 4 : (r >> 12);
                    if (l == 1) {
                        const float* g2 = modp + bsel * 6144 + 5 * 1024; float* dst = isc ? xc + (size_t)(r - T) * 1024 : outp + (size_t)r * 1024;
#pragma unroll
                        for (int j = 0; j < 4; ++j) {
                            const f32x4 gv = *(const f32x4*)(g2 + 4 * lane + 256 * j);
                            f32x4 yy; yy[0] = bflo(ya[j].x) + bflo(yb[j].x); yy[1] = bfhi(ya[j].x) + bfhi(yb[j].x); yy[2] = bflo(ya[j].y) + bflo(yb[j].y); yy[3] = bfhi(ya[j].y) + bfhi(yb[j].y);
                            if (DBG_NO_MOE) yy = (f32x4){0.f, 0.f, 0.f, 0.f};
                            v[j] = v[j] + gv * yy; *(f32x4*)(dst + 4 * lane + 256 * j) = v[j];
                        }
                    }
                    float ss = 0.f;
#pragma unroll
                    for (int j = 0; j < 4; ++j) ss += (v[j][0] * v[j][0] + v[j][1] * v[j][1]) + (v[j][2] * v[j][2] + v[j][3] * v[j][3]);
                    const float rstd = 1.0f / sqrtf(wave_sum(ss) * (1.f / 1024.f) + 1e-6f);
                    const float* sh = modl + bsel * 6144; const float* sc = sh + 1024; const float* gn = norm1_g + l * 1024;
#pragma unroll
                    for (int j = 0; j < 4; ++j) {
                        const int c0 = 4 * lane + 256 * j; const f32x4 g = *(const f32x4*)(gn + c0), s1 = *(const f32x4*)(sc + c0), h1 = *(const f32x4*)(sh + c0);
                        const f32x4 y = (v[j] * rstd) * g * (s1 + 1.0f) + h1;
                        v2u o; o.x = pk2(y[0], y[1]); o.y = pk2(y[2], y[3]); *(v2u*)(hbuf + (size_t)r * 1024 + c0) = o;
                    }
                }
            }
        }
        SEAM(P + 0);
        for (int rep_ = 0; rep_ < 1 + ((l == 0) ? ((REP_MASK >> (1 + 1)) & 1) : 0); ++rep_)
        if (IN(P + 1)) {
            KA_DECL
            SchedPlain S{TT / 256, 6, G, vcu, 1024, (const char*)hbuf, (const char*)win_t};
            EpiG1 E{pu, qb, kall, vall, zb};
            pg8::gemm_phase<EpiG1, SchedPlain>(lds, S, E);
        }
        SEAM(P + 1);
        for (int rep_ = 0; rep_ < 1 + ((l == 0) ? ((REP_MASK >> 3) & 1) : 0); ++rep_)
        if (IN(P + 2)) {
            KA_DECL
            __syncthreads();
            for (int it = vcu; it < 256; it += G) {
                const int b = it >> 6, n2 = it & 63;
                RowA ra{zb, b, n2}; EpiA ea{t2, twt, b, n2};
                slab_gemm<4, RowA, EpiA>(lds, fma, 128, ra, ea);
            }
            if (rep_ == 0)
#pragma clang loop vectorize(disable) unroll(disable)
            for (int i = gt; i < TT * 2; i += NGT) {
                const int r = i >> 1, hs = 8 + (i & 1); const bool isk = true; const bool isc = r >= T;
                bf16* p = isk ? kall + (size_t)krow_of(r) * 128 + (hs - 8) * 64 : qb + (size_t)r * 512 + hs * 64;
                float xv[64];
#pragma unroll
                for (int j = 0; j < 8; ++j) { const v4u w = *(const v4u*)(p + 8 * j); xv[8 * j] = bflo(w.x); xv[8 * j + 1] = bfhi(w.x); xv[8 * j + 2] = bflo(w.y); xv[8 * j + 3] = bfhi(w.y); xv[8 * j + 4] = bflo(w.z); xv[8 * j + 5] = bfhi(w.z); xv[8 * j + 6] = bflo(w.w); xv[8 * j + 7] = bfhi(w.w); }
                float ss = 0.f;
#pragma unroll
                for (int d = 0; d < 64; ++d) ss += xv[d] * xv[d];
                const float rstd = 1.0f / sqrtf(ss * (1.f / 64.f) + 1e-6f);
                const float* gg = (isk ? k_norm_g : q_norm_g) + l * 64;
#pragma unroll
                for (int d = 0; d < 64; ++d) { xv[d] = xv[d] * rstd * gg[d]; if ((d & 7) == 7) asm volatile("" ::: "memory"); }
                if (!isc) {
                    const float2* rp = rope + (size_t)(r & 4095) * 32;
#pragma unroll
                    for (int d = 0; d < 16; ++d) {
                        const float2 c1 = rp[d], c2 = rp[16 + d];
                        const float a = xv[d], bb = xv[16 + d], cc = xv[32 + d], dd = xv[48 + d];
                        xv[d] = a * c1.x - bb * c1.y; xv[16 + d] = bb * c1.x + a * c1.y;
                        xv[32 + d] = cc * c2.x - dd * c2.y; xv[48 + d] = dd * c2.x + cc * c2.y;
                        if ((d & 3) == 3) asm volatile("" ::: "memory");
                    }
                }
                const float sc = isk ? 1.0f : QSCALE;
#pragma unroll
                for (int j = 0; j < 8; ++j) { v4u w; w.x = pk2(xv[8 * j] * sc, xv[8 * j + 1] * sc); w.y = pk2(xv[8 * j + 2] * sc, xv[8 * j + 3] * sc); w.z = pk2(xv[8 * j + 4] * sc, xv[8 * j + 5] * sc); w.w = pk2(xv[8 * j + 6] * sc, xv[8 * j + 7] * sc); *(v4u*)(p + 8 * j) = w; }
            }
            const int prow = (l == 0) ? TT : T; const int nrb = prow >> 3;
#pragma clang loop vectorize(disable) unroll(disable)
            for (int i = gt; i < 32 * nrb; i += NGT) {
                const int ck8 = i & 7, rb = (i >> 3) % nrb, g = (i >> 3) / nrb;
                const int r0 = rb * 8; const bool isc = r0 >= T;
                const int nseq = isc ? LCTX : NSEQ; const int rbase = isc ? T + ((r0 - T) & ~255) : (r0 & ~4095); const int n0 = r0 - rbase;
                const int hw = 1 << g; const int col = g * 64 + ck8 * 8;
                const bf16* up = pu + (size_t)rbase * 256 + col;
                float sm[8] = {0.f, 0.f, 0.f, 0.f, 0.f, 0.f, 0.f, 0.f};
#define POOL_ACC(W, SGN) do { sm[0] += SGN bflo(W.x); sm[1] += SGN bfhi(W.x); sm[2] += SGN bflo(W.y); sm[3] += SGN bfhi(W.y); sm[4] += SGN bflo(W.z); sm[5] += SGN bfhi(W.z); sm[6] += SGN bflo(W.w); sm[7] += SGN bfhi(W.w); } while (0)
                for (int tpos = n0 - hw; tpos < n0 + hw; ++tpos) if (tpos >= 0 && tpos < nseq) { const v4u w = *(const v4u*)(up + (size_t)tpos * 256); POOL_ACC(w, +); }
#pragma unroll
                for (int k = 0; k < 8; ++k) {
                    const int n = n0 + k; int lo_ = n - hw; lo_ = lo_ < 0 ? 0 : lo_; int hi_ = n + hw - 1; hi_ = hi_ > nseq - 1 ? nseq - 1 : hi_;
                    const v4u w = *(const v4u*)(up + (size_t)n * 256); const float ic = 1.0f / (float)(hi_ - lo_ + 1);
                    v4u o; o.x = pk2(sm[0] * ic - bflo(w.x), sm[1] * ic - bfhi(w.x)); o.y = pk2(sm[2] * ic - bflo(w.y), sm[3] * ic - bfhi(w.y));
                    o.z = pk2(sm[4] * ic - bflo(w.z), sm[5] * ic - bfhi(w.z)); o.w = pk2(sm[6] * ic - bflo(w.w), sm[7] * ic - bfhi(w.w));
                    if (DBG_NO_POOL) o = (v4u){0u, 0u, 0u, 0u};
                    *(v4u*)(mrg + (size_t)(rbase + n) * 1024 + col) = o;
                    if (k < 7) { const int tin = n + hw, tout = n - hw;
                        if (tin < nseq) { const v4u wi = *(const v4u*)(up + (size_t)tin * 256); POOL_ACC(wi, +); }
                        if (tout >= 0) { const v4u wo = *(const v4u*)(up + (size_t)tout * 256); POOL_ACC(wo, -); } }
                }
#undef POOL_ACC
            }
        }
        SEAM(P + 2);
        for (int rep_ = 0; rep_ < 1 + ((l == 0) ? ((REP_MASK >> (1 + 3)) & 1) : 0); ++rep_)
        if (IN(P + 3)) {
            KA_DECL
            const int n_att = 512 + (l == 0 ? 32 : 0), n_fb = 256, n_cf = (l == 0 ? 32 : 0);
            for (int it = vcu; it < n_att + n_fb + n_cf; it += G) {
#ifndef NO_ATT
                if (it < n_att) { if (rep_ == 0 || ((REP_MASK >> 9) & 1)) {
                    const bool cu = it >= 512; const int uidx = cu ? it - 512 : it;
                    const int b = cu ? (uidx >> 3) : (uidx >> 7), kvh = cu ? ((uidx >> 2) & 1) : ((uidx >> 6) & 1), pb = cu ? (uidx & 3) : (uidx & 63);
                    const int p0 = pb * 64; const int qrow0 = cu ? T + b * 256 + p0 : b * 4096 + p0;
                    const attn_body::bf16* Qu = (const attn_body::bf16*)(qb + (size_t)qrow0 * 512 + kvh * 256);
                    const attn_body::bf16* Kh = (const attn_body::bf16*)(kall + (size_t)b * KVROWS * 128 + kvh * 64);
                    const attn_body::bf16* Vh = (const attn_body::bf16*)(vall + (size_t)b * KVROWS * 128 + kvh * 64);
                    attn_body::bf16* Ou = (attn_body::bf16*)(mrg + (size_t)qrow0 * 1024 + 256 + kvh * 256);
                    attn_body::attn_unit<8>(Qu, Kh, Vh, Ou, p0, cu ? 4 : 10, attn_sink + l * 8 + kvh * 4, q_norm_g + l * 64, cu ? (const float2*)nullptr : (const float2*)rope, (char*)lds);
                    __syncthreads(); }
                } else
#endif
#ifndef NO_FB
                if (it < n_att + n_fb) { if (rep_ == 0 || ((REP_MASK >> 10) & 1)) {
                    const int u2 = it - n_att; const int b = u2 >> 6, k1 = u2 & 63;
                    RowB rb{t2, b, k1}; EpiB eb{mrg, b, k1};
                    slab_gemm<2, RowB, EpiB>(lds, fmb, 128, rb, eb); }
                } else
#endif
                {
#ifndef NO_CF
                    if (rep_ == 0 || ((REP_MASK >> 11) & 1)) {
                    const int b = (it - n_att - n_fb) >> 3, mt0 = (it - n_att - n_fb) & 7;
                    RowC rc{zb, b}; EpiC ec{mrg, b, mt0};
                    slab_gemm<1, RowC, EpiC>(lds, fmc + (size_t)mt0 * 32 * 512, 512, rc, ec); }
#endif
                }
            }
        }
        SEAM(P + 3);
        for (int rep_ = 0; rep_ < 1 + ((l == 0) ? ((REP_MASK >> (1 + 4)) & 1) : 0); ++rep_)
        if (IN(P + 4)) {
            KA_DECL
            SchedPlain S{(l == 0 ? TT : T) / 256, 4, G, vcu, 1024, (const char*)mrg, (const char*)wout_t};
            EpiG2 E{(l == 0) ? x_in : outp, ctx_in, outp, xc, modl};
            pg8::gemm_phase<EpiG2, SchedPlain>(lds, S, E);
        }
        SEAM(P + 4);
        for (int rep_ = 0; rep_ < 1 + ((l == 0) ? ((REP_MASK >> 6) & 1) : 0); ++rep_)
        if (IN(P + 5)) {
            KA_DECL
            __syncthreads();
            LAS float* rw = (LAS float*)lds;
            LAS int* lcnt = (LAS int*)(lds + 81920);
            LAS unsigned* lent = (LAS unsigned*)(lds + 81920 + 256);
            LAS unsigned* lrank = lent + 1024;
            for (int i = tid; i < 1024 * 20; i += 512) { const int d = i / 20, j = i % 20;
                rw[((((j >> 2) * 4 + (d >> 8)) * 4 + (d & 3)) * 64 + ((d & 255) >> 2)) * 4 + (j & 3)] = (j < 4) ? w_grp[(size_t)l * 4096 + d * 4 + j] : w_rtr[(size_t)l * 16384 + d * 16 + (j - 4)]; }
            if (tid < 33) lcnt[tid] = 0;
            __syncthreads();
            const int nrows = (l == 0) ? TT : T; const int ngrp = nrows >> 2;
#pragma clang loop vectorize(disable) unroll(disable)
            for (int q = gw; q < ngrp; q += NGW) {
                const int rb4 = 4 * q; const bool isc = rb4 >= T; const int bsel = isc ? 4 : (rb4 >> 12);
                const float* src = isc ? xc + (size_t)(rb4 - T) * 1024 : outp + (size_t)rb4 * 1024;
                f32x4 v[4][4];
#pragma unroll
                for (int tk = 0; tk < 4; ++tk)
#pragma unroll
                    for (int j = 0; j < 4; ++j) v[tk][j] = *(const f32x4*)(src + (size_t)tk * 1024 + 4 * lane + 256 * j);
                float rstd[4];
#pragma unroll
                for (int tk = 0; tk < 4; ++tk) { float ss = 0.f;
#pragma unroll
                    for (int j = 0; j < 4; ++j) ss += (v[tk][j][0] * v[tk][j][0] + v[tk][j][1] * v[tk][j][1]) + (v[tk][j][2] * v[tk][j][2] + v[tk][j][3] * v[tk][j][3]);
                    rstd[tk] = 1.0f / sqrtf(wave_sum(ss) * (1.f / 1024.f) + 1e-6f); }
                const float* sh = modl + bsel * 6144 + 3 * 1024; const float* sc = sh + 1024; const float* gn = norm2_g + l * 1024;
                float lg[4][20];
#pragma unroll
                for (int tk = 0; tk < 4; ++tk)
#pragma unroll
                    for (int j = 0; j < 20; ++j) lg[tk][j] = 0.f;
#pragma unroll
                for (int j = 0; j < 4; ++j) {
                    const int c0 = 4 * lane + 256 * j; const f32x4 g = *(const f32x4*)(gn + c0), s1 = *(const f32x4*)(sc + c0), h1 = *(const f32x4*)(sh + c0);
                    f32x4 y[4];
#pragma unroll
                    for (int tk = 0; tk < 4; ++tk) { y[tk] = (v[tk][j] * rstd[tk]) * g * (s1 + 1.0f) + h1;
                        v2u o; o.x = pk2(y[tk][0], y[tk][1]); o.y = pk2(y[tk][2], y[tk][3]); *(v2u*)(hbuf + (size_t)(rb4 + tk) * 1024 + c0) = o; }
#pragma unroll
                    for (int e = 0; e < 4; ++e) {
#pragma unroll
                        for (int q5 = 0; q5 < 5; ++q5) { const f32x4 wv = *(const LAS f32x4*)(rw + (((q5 * 4 + j) * 4 + e) * 64 + lane) * 4);
#pragma unroll
                            for (int tk = 0; tk < 4; ++tk) { lg[tk][4 * q5] += y[tk][e] * wv[0]; lg[tk][4 * q5 + 1] += y[tk][e] * wv[1]; lg[tk][4 * q5 + 2] += y[tk][e] * wv[2]; lg[tk][4 * q5 + 3] += y[tk][e] * wv[3]; } }
                        __builtin_amdgcn_sched_barrier(0); }
                }
                float l2[20];
#pragma unroll
                for (int j = 0; j < 20; ++j) {
                    const float a0 = swap32_sum(lg[0][j], lg[2][j]);
                    const float a1 = swap32_sum(lg[1][j], lg[3][j]);
                    float t = swap16_sum(a0, a1);
                    t += dppf<0x128, 0xf>(t); t += dppf<0x124, 0xf>(t); t += dppf<0x122, 0xf>(t); t += dppf<0x121, 0xf>(t);
                    l2[j] = t;
                }
                const int tk = lane >> 4; const int r = rb4 + tk;
                float gl[4]; float gm = -1e30f;
#pragma unroll
                for (int j = 0; j < 4; ++j) { gl[j] = l2[j] + b_grp[l * 4 + j]; gm = fmaxf(gm, gl[j]); }
                float gs = 0.f; int gi = 0; float gb = -1e30f;
#pragma unroll
                for (int j = 0; j < 4; ++j) { const float e = expf(gl[j] - gm); gs += e; if (gl[j] > gb) { gb = gl[j]; gi = j; } }
                const float pg = expf(gb - gm) / gs;
                float el[4]; float em = -1e30f;
#pragma unroll
                for (int j = 0; j < 4; ++j) { float t_ = 0.f;
#pragma unroll
                    for (int g4 = 0; g4 < 4; ++g4) t_ = (gi == g4) ? (l2[4 + g4 * 4 + j] + b_rtr[l * 16 + g4 * 4 + j]) : t_;
                    el[j] = t_; em = fmaxf(em, t_); }
                float pe[4];
#pragma unroll
                for (int j = 0; j < 4; ++j) pe[j] = expf(el[j] - em);
                int i0 = 0; float b0 = -1.f;
#pragma unroll
                for (int j = 0; j < 4; ++j) if (pe[j] > b0) { b0 = pe[j]; i0 = j; }
                int i1 = 0; float b1 = -1.f;
#pragma unroll
                for (int j = 0; j < 4; ++j) if (j != i0 && pe[j] > b1) { b1 = pe[j]; i1 = j; }
                const float wsum = b0 + b1; const float w0 = pg * b0 / wsum, w1 = pg * b1 / wsum;
                if ((lane & 15) == 0 && rep_ == 0) {
                    wts[2 * r] = w0; wts[2 * r + 1] = w1;
                    const int e0 = gi * 4 + i0, e1 = gi * 4 + i1;
                    const int s0 = __hip_atomic_fetch_add((LAS int*)(lcnt + 16 + 16), 1, __ATOMIC_RELAXED, __HIP_MEMORY_SCOPE_WORKGROUP);
                    const int k0 = __hip_atomic_fetch_add((LAS int*)(lcnt + e0), 1, __ATOMIC_RELAXED, __HIP_MEMORY_SCOPE_WORKGROUP);
                    const int k1 = __hip_atomic_fetch_add((LAS int*)(lcnt + e1), 1, __ATOMIC_RELAXED, __HIP_MEMORY_SCOPE_WORKGROUP);
                    lent[2 * s0] = ((unsigned)(2 * r) << 4) | (unsigned)e0; lrank[2 * s0] = (unsigned)k0;
                    lent[2 * s0 + 1] = ((unsigned)(2 * r + 1) << 4) | (unsigned)e1; lrank[2 * s0 + 1] = (unsigned)k1;
                }
            }
            __syncthreads();
            if (tid < 16 && rep_ == 0) { const int c = lcnt[tid]; lcnt[16 + tid] = c ? (int)__hip_atomic_fetch_add((unsigned*)(ctl + CW_CNT + (l * 16 + tid) * 64), (unsigned)c, RLX_AGENT) : 0; }
            __syncthreads();
            const int ntot = rep_ == 0 ? 2 * lcnt[32] : 0;
            for (int i = tid; i < ntot; i += 512) { const unsigned en = lent[i]; const int e = en & 15; list[(size_t)e * TT + lcnt[16 + e] + lrank[i]] = en >> 4; }
            __syncthreads();
        }
        SEAM(P + 5);
        if (IN(P + 6) || IN(P + 7)) {
            KA_DECL
            __syncthreads();
            if (tid == 0) { int acc_ = 0; for (int e = 0; e < 16; ++e) { const int c = (int)__hip_atomic_load((unsigned*)(ctl + CW_CNT + (l * 16 + e) * 64), RLX_AGENT); ttab[e] = acc_; ttab[17 + e] = c; acc_ += (c + 255) >> 8; } ttab[16] = acc_; }
            __syncthreads();
        }
        if (DBG_NAIVE_MOE && IN(P + 6)) {
            KA_DECL
            const int nrows = (l == 0) ? TT : T; LAS float* hs = (LAS float*)lds; LAS float* as = hs + 1024;
            const int* eidg = (const int*)(ws + O_EID);
            LAS float* lgs = as + 512; LAS float* rt = lgs + 32;
            for (int r = vcu; r < nrows; r += G) {
                __syncthreads();
                for (int i = tid; i < 1024; i += 512) hs[i] = bf2f(hbuf[(size_t)r * 1024 + i]);
                __syncthreads();
                if (tid < 20) { float a = 0.f; for (int k = 0; k < 1024; ++k) a += hs[k] * ((tid < 4) ? w_grp[(size_t)l * 4096 + k * 4 + tid] : w_rtr[(size_t)l * 16384 + k * 16 + (tid - 4)]);
                    lgs[tid] = a + ((tid < 4) ? b_grp[l * 4 + tid] : b_rtr[l * 16 + tid - 4]); }
                __syncthreads();
                if (tid == 0) { int gi = 0; for (int j = 1; j < 4; ++j) if (lgs[j] > lgs[gi]) gi = j; float gs = 0.f; for (int j = 0; j < 4; ++j) gs += expf(lgs[j] - lgs[gi]); const float pg = 1.f / gs;
                    int i0 = 0; for (int j = 1; j < 4; ++j) if (lgs[4 + gi * 4 + j] > lgs[4 + gi * 4 + i0]) i0 = j; int i1 = -1; for (int j = 0; j < 4; ++j) if (j != i0 && (i1 < 0 || lgs[4 + gi * 4 + j] > lgs[4 + gi * 4 + i1])) i1 = j;
                    const float p0 = 1.f, p1 = expf(lgs[4 + gi * 4 + i1] - lgs[4 + gi * 4 + i0]); rt[0] = (float)(gi * 4 + i0); rt[1] = (float)(gi * 4 + i1); rt[2] = pg * p0 / (p0 + p1); rt[3] = pg * p1 / (p0 + p1); }
                __syncthreads();
                for (int sl = 0; sl < 2; ++sl) {
                    const int e = (DBG_NAIVE_ROUTE & 1) ? (int)rt[sl] : eidg[2 * r + sl]; const float w = (DBG_NAIVE_ROUTE & 2) ? rt[2 + sl] : wts[2 * r + sl];
                    __syncthreads();
                    const float* Wg = w_gate + (size_t)(l * 16 + e) * 1024 * 512 + tid; const float* Wu = w_up + (size_t)(l * 16 + e) * 1024 * 512 + tid;
                    float g = 0.f, u = 0.f;
#pragma unroll 8
                    for (int k = 0; k < 1024; ++k) { g += hs[k] * Wg[(size_t)k * 512]; u += hs[k] * Wu[(size_t)k * 512]; }
                    as[tid] = g / (1.f + expf(-g)) * u;
                    __syncthreads();
                    const float* Wd = w_down + (size_t)(l * 16 + e) * 512 * 1024 + tid;
                    float y0 = 0.f, y1 = 0.f;
#pragma unroll 8
                    for (int j = 0; j < 512; ++j) { y0 += as[j] * Wd[(size_t)j * 1024]; y1 += as[j] * Wd[(size_t)j * 1024 + 512]; }
                    y2[(size_t)(2 * r + sl) * 1024 + tid] = (bf16)f2bf(y0 * w); y2[(size_t)(2 * r + sl) * 1024 + 512 + tid] = (bf16)f2bf(y1 * w);
                }
            }
        }
        if (!DBG_NAIVE_MOE && IN(P + 6)) {
            KA_DECL
            unsigned* rdy = (unsigned*)(ctl + CW_RDY + l * 4096);
            SchedMoe S{G, vcu, ttab[16], (const char*)hbuf, (const char*)act, (const char*)wgu_t, (const char*)wd_t, list, ttab, rdy, (unsigned*)(ctl + CW_TMO)};
            EpiMoe E{EpiG3{act, rdy}, EpiG4{y2, list, wts, ttab}};
            pg8::gemm_phase<EpiMoe, SchedMoe>(lds, S, E);
        }
        SEAM(P + 7);
    }

__global__ void __launch_bounds__(512, 2) fwd_kernel(Args args) {
    extern __shared__ __attribute__((aligned(16))) unsigned char lds_raw[];
    LAS unsigned char* lds = (LAS unsigned char*)lds_raw;
    const int tid = threadIdx.x, lane = tid & 63, wave = __builtin_amdgcn_readfirstlane(tid >> 6);
    const int G = gridDim.x; const int bx = blockIdx.x; const int vcu = (G % 8 == 0) ? (bx % 8) * (G / 8) + bx / 8 : bx;
    volatile LAS unsigned* MISC = (volatile LAS unsigned*)(lds + MISC_OFF);
    LAS float* trig = (LAS float*)(lds + TRIG_OFF);
    LAS int* ttab = (LAS int*)(lds + TILE_OFF);
    for (int u = tid; u < (LDS_BYTES - LDSCTL_OFF) / 4; u += 512) ((LAS unsigned*)(lds + LDSCTL_OFF))[u] = 0u;
    __syncthreads();
    if (tid < 64) { float s, c; sincospif((float)tid / 32.f, &s, &c); trig[tid] = c; trig[64 + tid] = s; }
    __syncthreads();
    XcdBarrier bar; bar.bar = nullptr; bar.x = 0; bar.st = nullptr;
    if (!MK_SPLIT) { KA_DECL bar = xcd_barrier_post((unsigned*)(ctl + CW_BAR), MISC + 8); }
    const int lo = args.ph_lo, hi = args.ph_hi;
    const int NGW = G * 8, NGT = G * 512;

    for (int rep_ = 0; rep_ < 1 + ((REP_MASK >> 0) & 1); ++rep_)
    if (IN(0)) {
        KA_DECL
        __syncthreads();
        {
            LAS float* sl = (LAS float*)lds;
            bool have = false;
            for (int it = vcu; it < 192; it += G) {
                if (!have) {
                    for (int i = tid; i < 5120; i += 512) { const int r = i >> 10, k = i & 1023; const float v = (r < 4) ? c_in[r * 1024 + k] : cctx_in[k]; sl[i] = v / (1.f + expf(-v)); }
                    __syncthreads(); have = true;
                }
                const int l = it / 96, cb = it % 96;
                const float* W = w_mod + (size_t)l * 1024 * 6144 + cb * 64 + lane;
                float a0 = 0.f, a1 = 0.f, a2 = 0.f, a3 = 0.f, a4 = 0.f; const int k0 = wave * 128;
#pragma unroll 16
                for (int k = 0; k < 128; ++k) { const float wv = W[(size_t)(k0 + k) * 6144]; const int kk = k0 + k;
                    a0 += sl[kk] * wv; a1 += sl[1024 + kk] * wv; a2 += sl[2048 + kk] * wv; a3 += sl[3072 + kk] * wv; a4 += sl[4096 + kk] * wv; }
                LAS float* part = sl + 5120;
                part[(wave * 5 + 0) * 64 + lane] = a0; part[(wave * 5 + 1) * 64 + lane] = a1; part[(wave * 5 + 2) * 64 + lane] = a2; part[(wave * 5 + 3) * 64 + lane] = a3; part[(wave * 5 + 4) * 64 + lane] = a4;
                __syncthreads();
                if (tid < 320) { const int r = tid >> 6, n = tid & 63; float s = b_mod[l * 6144 + cb * 64 + n];
#pragma unroll
                    for (int w = 0; w < 8; ++w) s += part[(w * 5 + r) * 64 + n];
                    modv[(size_t)(l * 5 + r) * 6144 + cb * 64 + n] = s; }
                __syncthreads();
            }
            __syncthreads();
        }
#pragma clang loop vectorize(disable) unroll(disable)
        for (int i = gt; i < 4096 * 32; i += NGT) {
            const int n = i >> 5, j = i & 31; const int jj = j & 15;
            const float inv = 1.0f / powf(10000.0f, (float)(2 * jj) / 32.0f);
            const float pos = (j < 16) ? (float)(n >> 6) : (float)(n & 63);
            const float ang = pos * inv; rope[i] = make_float2(cosf(ang), sinf(ang));
        }
#pragma clang loop vectorize(disable) unroll(disable)
        for (int i = gt; i < 4096; i += NGT) { float s, c; sincospif((float)i / 2048.f, &s, &c); twt[i] = make_float2(c, s); }
#pragma clang loop vectorize(disable) unroll(disable)
        for (int i = gt; i < 128 * 128; i += NGT) {
            const int m = i >> 7, k = i & 127; const int ri = m >> 6, k1 = m & 63, part = k >> 6, n1 = k & 63;
            float s, c; sincospif((float)((n1 * k1) & 63) / 32.f, &s, &c);
            float v; if (ri == 0) v = (part == 0) ? c : -s; else v = (part == 0) ? -s : -c;
            fma[i] = (bf16)f2bf(v);
        }
#pragma clang loop vectorize(disable) unroll(disable)
        for (int i = gt; i < 64 * 128; i += NGT) {
            const int k2 = i >> 7, k = i & 127; const int ri = k >> 6, n2 = k & 63;
            float s, c; sincospif((float)((n2 * k2) & 63) / 32.f, &s, &c);
            fmb[i] = (bf16)f2bf((ri == 0 ? c : s) * (1.f / 512.f));
        }
#pragma clang loop vectorize(disable) unroll(disable)
        for (int i = gt; i < 256 * 512; i += NGT) {
            const int kk = i >> 9, k = i & 511; const int part = k >> 8, n = k & 255;
            float s, c; sincospif((float)((n * kk) & 255) / 128.f, &s, &c);
            fmc[i] = (bf16)f2bf((part == 0 ? c : -s) * (1.f / 128.f));
        }
        {
            LAS float* Al = (LAS float*)lds;
            for (int it = vcu; it < 256; it += G) {
                const int combo = it & 15, jb = it >> 4; const int l = combo >> 3, g = (combo >> 1) & 3, which = combo & 1;
                const float* Wg = four_w + (size_t)(l * 4 + g) * 4096; const LAS float* tb = trig + which * 64;
                __syncthreads();
                { const int d = tid & 63, c0 = tid >> 6;
#pragma unroll 1
                  for (int i = 0; i < 8; ++i) { const int c = c0 + 8 * i; float a = 0.f;
#pragma unroll 8
                      for (int m = 0; m < 64; ++m) a += tb[(m * c) & 63] * Wg[m * 64 + d];
                      Al[c * 64 + d] = a; } }
                __syncthreads();
                { const int d = tid & 63, j0 = jb * 64 + 8 * (tid >> 6);
                  const float* wi = w_in + (size_t)l * 1024 * 1280 + (size_t)j0 * 1280 + 1024 + g * 64;
                  float o[8] = {0.f, 0.f, 0.f, 0.f, 0.f, 0.f, 0.f, 0.f};
#pragma unroll 2
                  for (int c = 0; c < 64; ++c) { const float av = Al[c * 64 + d];
#pragma unroll
                      for (int i = 0; i < 8; ++i) o[i] += wi[(size_t)i * 1280 + c] * av; }
                  v4u w; w.x = pk2(o[0], o[1]); w.y = pk2(o[2], o[3]); w.z = pk2(o[4], o[5]); w.w = pk2(o[6], o[7]);
                  *(v4u*)((bf16*)(ws + O_WIN + l * SZ_WIN1) + (size_t)(1024 + which * 256 + g * 64 + d) * 1024 + j0) = w; }
            }
            for (int it = vcu; it < 256; it += G) {
                const int combo = it & 7, nb = it >> 3; const int l = combo >> 2, g = combo & 3, n0 = nb * 32;
                __syncthreads();
                for (int i = tid; i < 2048; i += 512) { const int d = i >> 5, n = i & 31; Al[i] = pool_scale[l * 256 + g * 64 + d] * w_out[(size_t)l * 1024 * 1024 + (size_t)(g * 64 + d) * 1024 + n0 + n]; }
                __syncthreads();
                { const int n = tid & 31, c0 = 4 * (tid >> 5);
                  const float* pw = pool_w + (size_t)(l * 4 + g) * 4096 + (size_t)c0 * 64;
                  float o[4] = {0.f, 0.f, 0.f, 0.f};
#pragma unroll 4
                  for (int d = 0; d < 64; ++d) { const float sv = Al[d * 32 + n];
#pragma unroll
                      for (int i = 0; i < 4; ++i) o[i] += pw[i * 64 + d] * sv; }
                  v2u w; w.x = pk2(o[0], o[1]); w.y = pk2(o[2], o[3]);
                  *(v2u*)((bf16*)(ws + O_WOUT + l * SZ_WOUT1) + (size_t)(n0 + n) * 1024 + g * 64 + c0) = w; }
            }
            __syncthreads();
        }
        {
            LAS bf16* scr = (LAS bf16*)(lds + wave * 16384);
            constexpr int I_A = 256, I_B = 192, I_C = 4096, I_D = 2048, I_L = I_A + I_B + I_C + I_D;
#pragma clang loop vectorize(disable) unroll(disable)
            for (int it0 = gw; it0 < 2 * I_L; it0 += NGW) {
                const int l = it0 / I_L; int it = it0 % I_L;
                bf16* p_win_t = (bf16*)(ws + O_WIN + l * SZ_WIN1); bf16* p_wout_t = (bf16*)(ws + O_WOUT + l * SZ_WOUT1);
                bf16* p_wgu_t = (bf16*)(ws + O_WGU + l * SZ_WGU1); bf16* p_wd_t = (bf16*)(ws + O_WD + l * SZ_WD1);
                if (it < I_A) { const int kb = it >> 4, nb = it & 15; tr_block64(w_in + (size_t)l * 1024 * 1280 + (size_t)kb * 64 * 1280 + nb * 64, 1280, p_win_t + (size_t)nb * 64 * 1024 + kb * 64, 1024, scr, lane); continue; } it -= I_A;
                if (it < I_B) { const int kb = 4 + (it >> 4), nb = it & 15; tr_block64(w_out + (size_t)l * 1024 * 1024 + (size_t)kb * 64 * 1024 + nb * 64, 1024, p_wout_t + (size_t)nb * 64 * 1024 + kb * 64, 1024, scr, lane); continue; } it -= I_B;
                if (it < I_C) { const int up = it >> 11, r = it & 2047, e = r >> 7, kb = (r >> 3) & 15, nb = r & 7; const int n0 = nb * 64;
                    const float* src = (up ? w_up : w_gate) + ((size_t)(l * 16 + e) * 1024 + kb * 64) * 512 + n0;
                    const int drow = (n0 >> 7) * 256 + up * 128 + (n0 & 127);
                    tr_block64(src, 512, p_wgu_t + ((size_t)e * 1024 + drow) * 1024 + kb * 64, 1024, scr, lane); continue; } it -= I_C;
                { const int e = it >> 7, kb = (it >> 4) & 7, nb = it & 15;
                    tr_block64(w_down + ((size_t)(l * 16 + e) * 512 + kb * 64) * 1024 + nb * 64, 1024, p_wd_t + ((size_t)e * 1024 + nb * 64) * 512 + kb * 64, 512, scr, lane); }
            }
        }
    }
    SEAM(0);
    if ((REP_MASK >> 12) & 1) { for (int k_ = 0; k_ < 4; ++k_) xcd_barrier(bar); }

    layer_body<0>(lds, G, vcu, bar, lo, hi);
    layer_body<1>(lds, G, vcu, bar, lo, hi);
    if (IN(17)) {
        KA_DECL
        const float* modp = modv + (size_t)5 * 6144;
#pragma clang loop vectorize(disable) unroll(disable)
        for (int r = gw; r < T; r += NGW) {
            const float* g2 = modp + (r >> 12) * 6144 + 5 * 1024; float* dst = outp + (size_t)r * 1024;
#pragma unroll
            for (int j = 0; j < 4; ++j) {
                const int c0 = 4 * lane + 256 * j; f32x4 v = *(const f32x4*)(dst + c0);
                const v2u ya = *(const v2u*)(y2 + (size_t)(2 * r) * 1024 + c0), yb = *(const v2u*)(y2 + (size_t)(2 * r + 1) * 1024 + c0);
                const f32x4 gv = *(const f32x4*)(g2 + c0);
                f32x4 yy; yy[0] = bflo(ya.x) + bflo(yb.x); yy[1] = bfhi(ya.x) + bfhi(yb.x); yy[2] = bflo(ya.y) + bflo(yb.y); yy[3] = bfhi(ya.y) + bfhi(yb.y);
                if (DBG_NO_MOE) yy = (f32x4){0.f, 0.f, 0.f, 0.f};
                *(f32x4*)(dst + c0) = v + gv * yy;
            }
        }
    }
#undef IN
#undef SEAM
}

#undef KA_DECL
#undef ws
#undef ctl
#undef x_in
#undef c_in
#undef ctx_in
#undef cctx_in
#undef w_mod
#undef b_mod
#undef norm1_g
#undef w_in
#undef q_norm_g
#undef k_norm_g
#undef attn_sink
#undef pool_w
#undef pool_scale
#undef four_w
#undef w_out
#undef norm2_g
#undef w_grp
#undef b_grp
#undef w_rtr
#undef b_rtr
#undef w_gate
#undef w_up
#undef w_down
#undef outp
#undef modv
#undef rope
#undef twt
#undef fma
#undef fmb
#undef fmc
#undef hbuf
#undef kall
#undef vall
#undef xc
#undef list
#undef wts
#undef act
#undef t2
#undef mrg
#undef qb
#undef pu
#undef zb
#undef y2
#undef modl
#undef win_t
#undef wout_t
#undef wgu_t
#undef wd_t
extern "C" void kernel_launch(void* const* d_in, const int* in_sizes, int n_in, void* d_out, int out_size, void* d_ws, size_t ws_size, hipStream_t stream) {
    static int grid = 0;
    if (grid == 0) {
        if (n_in != 23 || out_size != T * DM || ws_size < WS_END) { fprintf(stderr, "kernel_launch: unexpected shapes (n_in %d out %d ws %zu need %zu)\n", n_in, out_size, ws_size, (size_t)WS_END); grid = -1; return; }
        int dev = 0, cus = 0;
        if (hipGetDevice(&dev) != hipSuccess || hipDeviceGetAttribute(&cus, hipDeviceAttributeMultiprocessorCount, dev) != hipSuccess) { grid = -1; return; }
        if (hipFuncSetAttribute((const void*)fwd_kernel, hipFuncAttributeMaxDynamicSharedMemorySize, LDS_BYTES) != hipSuccess) { fprintf(stderr, "kernel_launch: hipFuncSetAttribute failed\n"); grid = -1; return; }
        (void)hipGetLastError();
        grid = cus;
    }
    if (grid < 0) return;
    (void)hipMemsetAsync((char*)d_ws + O_CTL, 0, SZ_CTL, stream);
    Args a{};
    for (int i = 0; i < 23; ++i) a.in[i] = (const float*)d_in[i];
    a.out = (float*)d_out; a.ws = (unsigned char*)d_ws;
#if MK_SPLIT
    for (int p = 0; p < NPHASE; ++p) { a.ph_lo = p; a.ph_hi = p + 1; hipLaunchKernelGGL(fwd_kernel, dim3(grid), dim3(512), LDS_BYTES, stream, a); }
#else
    a.ph_lo = 0; a.ph_hi = NPHASE;
    hipLaunchKernelGGL(fwd_kernel, dim3(grid), dim3(512), LDS_BYTES, stream, a);
#endif
}
```

```cpp
#include <hip/hip_runtime.h>
#include <cstdio>
#include <cstdint>

#define DBG_NO_FOUR 0
#define DBG_NO_POOL 0
#define DBG_NO_ATT 0
#define DBG_NO_MOE 0
#define DBG_MOE_SCALE 1.0f
#define DBG_NAIVE_MOE 0
#define REP_MASK 0x0
#define DBG_NAIVE_ROUTE 0
#define LAS __attribute__((address_space(3)))
#define GAS __attribute__((address_space(1)))
typedef unsigned short bf16;
typedef short bf16x8 __attribute__((ext_vector_type(8)));
typedef float f32x4 __attribute__((ext_vector_type(4)));
typedef float f32x16 __attribute__((ext_vector_type(16)));
typedef unsigned v4u __attribute__((ext_vector_type(4)));
typedef unsigned v2u __attribute__((ext_vector_type(2)));
typedef GAS unsigned gu32;

#ifndef MK_SPLIT
#define MK_SPLIT 0
#endif

constexpr int NB = 4, NSEQ = 4096, DM = 1024, LCTX = 256, DEPTH = 2;
constexpr int T = NB * NSEQ, TC = NB * LCTX, TT = T + TC;
constexpr int KVROWS = LCTX + NSEQ;
constexpr int NEXP = 16, DEXP = 512;
constexpr int NPHASE = 18;
constexpr int MAXTILES = 152;
constexpr float QSCALE = 0.125f * 1.4426950408889634f;
constexpr float LOG2E = 1.4426950408889634f;

constexpr size_t al256(size_t x) { return (x + 255) & ~(size_t)255; }
constexpr size_t O_CTL = 0, SZ_CTL = 1u << 20;
constexpr size_t O_MOD = O_CTL + SZ_CTL, SZ_MOD = (size_t)2 * 5 * 6144 * 4;
constexpr size_t O_ROPE = al256(O_MOD + SZ_MOD), SZ_ROPE = (size_t)4096 * 32 * 8;
constexpr size_t O_TW = al256(O_ROPE + SZ_ROPE), SZ_TW = 4096 * 8;
constexpr size_t O_FMA = al256(O_TW + SZ_TW), SZ_FMA = 128 * 128 * 2;
constexpr size_t O_FMB = al256(O_FMA + SZ_FMA), SZ_FMB = 64 * 128 * 2;
constexpr size_t O_FMC = al256(O_FMB + SZ_FMB), SZ_FMC = 256 * 512 * 2;
constexpr size_t O_WIN = al256(O_FMC + SZ_FMC), SZ_WIN1 = (size_t)1536 * 1024 * 2;
constexpr size_t O_WOUT = al256(O_WIN + 2 * SZ_WIN1), SZ_WOUT1 = (size_t)1024 * 1024 * 2;
constexpr size_t O_WGU = al256(O_WOUT + 2 * SZ_WOUT1), SZ_WGU1 = (size_t)16 * 1024 * 1024 * 2;
constexpr size_t O_WD = al256(O_WGU + 2 * SZ_WGU1), SZ_WD1 = (size_t)16 * 1024 * 512 * 2;
constexpr size_t O_H = al256(O_WD + 2 * SZ_WD1), SZ_H = (size_t)TT * 1024 * 2;
constexpr size_t O_KALL = al256(O_H + SZ_H), SZ_KV = (size_t)NB * KVROWS * 128 * 2;
constexpr size_t O_VALL = al256(O_KALL + SZ_KV);
constexpr size_t O_XC = al256(O_VALL + SZ_KV), SZ_XC = (size_t)TC * 1024 * 4;
constexpr size_t O_LIST = al256(O_XC + SZ_XC), SZ_LIST = (size_t)NEXP * TT * 4;
constexpr size_t O_WTS = al256(O_LIST + SZ_LIST), SZ_WTS = (size_t)TT * 2 * 4;
constexpr size_t O_EID = al256(O_WTS + SZ_WTS), SZ_EID = (size_t)TT * 2 * 4;
constexpr size_t O_ACT = al256(O_EID + SZ_EID), SZ_ACT = (size_t)MAXTILES * 256 * 512 * 2;
constexpr size_t O_T2 = O_ACT, SZ_T2 = (size_t)NB * 64 * 64 * 2 * 256 * 2;
constexpr size_t O_MRG = al256(O_ACT + SZ_ACT), SZ_MRG = (size_t)TT * 1024 * 2;
constexpr size_t O_Q = al256(O_MRG + SZ_MRG), SZ_Q = (size_t)TT * 512 * 2;
constexpr size_t O_PU = al256(O_Q + SZ_Q), SZ_PU = (size_t)TT * 256 * 2;
constexpr size_t O_Z = al256(O_PU + SZ_PU), SZ_Z = (size_t)TT * 512 * 2;
constexpr size_t O_Y2 = O_MRG, SZ_Y2 = (size_t)TT * 2 * 1024 * 2;
constexpr size_t WS_END = al256(O_Z + SZ_Z);
static_assert(SZ_T2 <= SZ_ACT, "T2 overlay");
static_assert(O_Y2 + SZ_Y2 <= WS_END, "y2 overlay");

constexpr int CW_TMO = 0;
constexpr int CW_BAR = 4096;
constexpr int CW_RDY = 32768;
constexpr int CW_Q = 2048;
constexpr int CW_DONE = 2560;
constexpr int CW_CNT = 16384;

constexpr int RING_BYTES = 131072;
constexpr int LDSCTL_OFF = RING_BYTES, MISC_OFF = LDSCTL_OFF + 320;
constexpr int TRIG_OFF = LDSCTL_OFF + 1024;
constexpr int TILE_OFF = LDSCTL_OFF + 2048;
constexpr int LDS_BYTES = 147456;

#define RLX_AGENT __ATOMIC_RELAXED, __HIP_MEMORY_SCOPE_AGENT
#define LDS_WAIT() asm volatile("s_waitcnt lgkmcnt(0)" ::: "memory")
#define VM_WAIT() asm volatile("s_waitcnt vmcnt(0)" ::: "memory")

__device__ __forceinline__ unsigned f2bf(float f) { unsigned u = __builtin_bit_cast(unsigned, f); return (u + 0x7fffu + ((u >> 16) & 1u)) >> 16; }
__device__ __forceinline__ unsigned pk2(float lo, float hi) { return f2bf(lo) | (f2bf(hi) << 16); }
__device__ __forceinline__ float bflo(unsigned w) { return __builtin_bit_cast(float, w << 16); }
__device__ __forceinline__ float bfhi(unsigned w) { return __builtin_bit_cast(float, w & 0xffff0000u); }
__device__ __forceinline__ float bf2f(bf16 h) { return __builtin_bit_cast(float, (unsigned)h << 16); }
template <int CTRL, int RM> __device__ __forceinline__ float dppf(float v) { return __builtin_bit_cast(float, __builtin_amdgcn_update_dpp(0, __builtin_bit_cast(int, v), CTRL, RM, 0xf, true)); }
__device__ __forceinline__ float wave_sum(float v) {
    v += dppf<0x111, 0xf>(v); v += dppf<0x112, 0xf>(v); v += dppf<0x114, 0xf>(v); v += dppf<0x118, 0xf>(v);
    v += dppf<0x142, 0xa>(v); v += dppf<0x143, 0xc>(v);
    return __builtin_bit_cast(float, __builtin_amdgcn_readlane(__builtin_bit_cast(int, v), 63));
}

__device__ __forceinline__ float swap32_sum(float x, float y) {
    const auto rr = __builtin_amdgcn_permlane32_swap(__builtin_bit_cast(unsigned, x), __builtin_bit_cast(unsigned, y), false, false);
    unsigned r0 = rr[0], r1 = rr[1]; asm volatile("" : "+v"(r0), "+v"(r1));
    return __builtin_bit_cast(float, r0) + __builtin_bit_cast(float, r1);
}
__device__ __forceinline__ float swap16_sum(float x, float y) {
    const auto rr = __builtin_amdgcn_permlane16_swap(__builtin_bit_cast(unsigned, x), __builtin_bit_cast(unsigned, y), false, false);
    unsigned r0 = rr[0], r1 = rr[1]; asm volatile("" : "+v"(r0), "+v"(r1));
    return __builtin_bit_cast(float, r0) + __builtin_bit_cast(float, r1);
}

#define XB_TMO      128
#define XB_XCNT(j)  (256  + 64 * (j))
#define XB_XSUB(j)  (1280 + 64 * (j))
#define XB_XGEN(j)  (2304 + 64 * (j))
#define XB_TOP      3328
#define XB_TOPGEN   3392
#define XCD_BAR_WORDS 3456
#define XB_SPIN_CAP (1u << 18)
__device__ __forceinline__ unsigned xb_ld(unsigned* p)              { return __hip_atomic_load(p, __ATOMIC_RELAXED, __HIP_MEMORY_SCOPE_AGENT); }
__device__ __forceinline__ unsigned xb_add(unsigned* p, unsigned v) { return __hip_atomic_fetch_add(p, v, __ATOMIC_RELAXED, __HIP_MEMORY_SCOPE_AGENT); }
__device__ __forceinline__ unsigned xb_xcc_id() { return (unsigned)__builtin_amdgcn_s_getreg((3 << 11) | 20) & 0xFu; }
#define XB_SPIN(cond, bar) do { unsigned _sp = 0; while (cond) { __builtin_amdgcn_s_sleep(1); \
    if ((++_sp & 255u) == 0u) { if (xb_ld(&(bar)[XB_TMO])) break; if (_sp > XB_SPIN_CAP) { atomicAdd(&(bar)[XB_TMO], 1u); break; } } } } while (0)
struct XcdBarrier { unsigned* bar; unsigned x; volatile LAS unsigned* st; };
__device__ __forceinline__ XcdBarrier xcd_barrier_post(unsigned* bar, volatile LAS unsigned* st) {
    XcdBarrier b; b.bar = bar; b.x = xb_xcc_id(); b.st = st;
    if (threadIdx.x == 0) (void)xb_add(&bar[XB_XCNT(b.x)], 1u);
    return b;
}
__device__ __forceinline__ void xcd_barrier_complete(unsigned* bar, unsigned x, unsigned& nloc, unsigned& nx) {
    const unsigned G = gridDim.x * gridDim.y * gridDim.z;
    unsigned sum, cnt, mine, sp = 0u;
    for (;;) {
        sum = 0u; cnt = 0u; mine = 0u;
#pragma unroll
        for (unsigned j = 0; j < 16; ++j) { const unsigned c = xb_ld(&bar[XB_XCNT(j)]); sum += c; cnt += (c > 0u) ? 1u : 0u; mine = (j == x) ? c : mine; }
        if (sum == G) break;
        __builtin_amdgcn_s_sleep(1);
        if ((++sp & 255u) == 0u) { if (xb_ld(&bar[XB_TMO])) break; if (sp > XB_SPIN_CAP) { atomicAdd(&bar[XB_TMO], 1u); break; } }
    }
    nloc = mine > 0u ? mine : 1u; nx = cnt > 0u ? cnt : 1u;
}
__device__ __forceinline__ void xcd_barrier(const XcdBarrier& b) {
    asm volatile("s_waitcnt vmcnt(0)" ::: "memory");
    __syncthreads();
    if (threadIdx.x == 0) {
        unsigned* bar = b.bar;
        __builtin_amdgcn_s_waitcnt(0);
        unsigned nloc = b.st[0], nx = b.st[1];
        if (nloc == 0u) { xcd_barrier_complete(bar, b.x, nloc, nx); b.st[0] = nloc; b.st[1] = nx; }
        const unsigned old = xb_add(&bar[XB_XSUB(b.x)], 1u);
        const unsigned gen = old / nloc;
        if (old + 1u == (gen + 1u) * nloc) {
            __builtin_amdgcn_fence(__ATOMIC_RELEASE, "agent");
            asm volatile("s_waitcnt vmcnt(0)" ::: "memory");
            const unsigned og = xb_add(&bar[XB_TOP], 1u);
            const unsigned tg = og / nx;
            if (og + 1u == (tg + 1u) * nx) xb_add(&bar[XB_TOPGEN], 1u);
            else XB_SPIN(xb_ld(&bar[XB_TOPGEN]) == tg, bar);
            __builtin_amdgcn_fence(__ATOMIC_ACQUIRE, "agent");
            xb_add(&bar[XB_XGEN(b.x)], 1u);
            asm volatile("s_waitcnt vmcnt(0)" ::: "memory");
        } else {
            XB_SPIN(xb_ld(&bar[XB_XGEN(b.x)]) == gen, bar);
            __builtin_amdgcn_fence(__ATOMIC_ACQUIRE, "agent");
            asm volatile("s_waitcnt vmcnt(0)" ::: "memory");
        }
    }
    __syncthreads();
}

namespace pg8 {
constexpr int BM = 256, BK = 64, HALF = 128, HTB = HALF * BK * 2;
__host__ __device__ __forceinline__ int lds_byte(int r, int c) { const int st = (r >> 4) * 2 + (c >> 5), rr = r & 15, cc = c & 31, ob = rr * 64 + cc * 2; return st * 1024 + (ob ^ (((ob >> 9) & 1) << 5)); }
__host__ __device__ __forceinline__ void stage_rc(int b, int& R, int& C) { const int st = b / 1024, sb = b % 1024, swz = sb ^ (((sb >> 9) & 1) << 5); R = (st >> 1) * 16 + swz / 64; C = (st & 1) * 32 + (swz % 64) / 2; }
__host__ __device__ __forceinline__ int perm32(int rho) { const int n = rho >> 4, i = rho & 15; return 8 * (i >> 2) + 4 * n + (i & 3); }

struct Unit { int pm, pn, e, cnt, kind; };

template <class Epi, class Sched>
__device__ __forceinline__ void gemm_phase(LAS unsigned char* lds, const Sched& S, const Epi& E) {
    int tid = threadIdx.x; asm volatile("" : "+v"(tid));
    const int wid = __builtin_amdgcn_readfirstlane(tid >> 6), lane = tid & 63, wr = wid >> 2, wc = wid & 3, fr = lane & 15, fq = lane >> 4;
    int RA[2], CA[2], RB[2];
#pragma unroll
    for (int i = 0; i < 2; ++i) { int R, C; stage_rc(tid * 16 + i * 8192, R, C); RA[i] = R; CA[i] = C; RB[i] = Epi::PERM ? ((R & ~31) + perm32(R & 31)) : R; }
    const size_t kstep = (size_t)(BK * 2);
    const unsigned ldsw = (unsigned)wid * 1024u;
    const int aoff = lds_byte(wr * 64 + fr, fq * 8), boff = lds_byte(wc * 32 + fr, fq * 8);
#define PG8_SA(b, h) (((b) * 2 + (h)) * HTB)
#define PG8_SB(b, h) ((4 + (b) * 2 + (h)) * HTB)
#define PG8_STAGE2(bufoff, gbase, o0, o1) do { \
        __builtin_amdgcn_global_load_lds((const unsigned*)((const char*)(gbase) + (o0)), (LAS unsigned*)(lds + (bufoff) + ldsw), 16, 0, 0); \
        __builtin_amdgcn_global_load_lds((const unsigned*)((const char*)(gbase) + (o1)), (LAS unsigned*)(lds + (bufoff) + ldsw + 8192), 16, 0, 0); } while (0)
#define PG8_LDA(dst, b, h) do { _Pragma("unroll") for (int m = 0; m < 4; ++m) _Pragma("unroll") for (int k = 0; k < 2; ++k) dst[m][k] = *(const LAS bf16x8*)(lds + PG8_SA(b, h) + aoff + m * 2048 + k * 1024); } while (0)
#define PG8_LDB(dst, b, h) do { _Pragma("unroll") for (int n = 0; n < 2; ++n) _Pragma("unroll") for (int k = 0; k < 2; ++k) dst[n][k] = *(const LAS bf16x8*)(lds + PG8_SB(b, h) + boff + n * 2048 + k * 1024); } while (0)
#define PG8_MMA(ai, bj, At, Bt) do { __builtin_amdgcn_s_setprio(1); _Pragma("unroll") for (int m = 0; m < 4; ++m) _Pragma("unroll") for (int n = 0; n < 2; ++n) _Pragma("unroll") for (int k = 0; k < 2; ++k) \
        acc[ai][bj][m][n] = __builtin_amdgcn_mfma_f32_16x16x32_bf16(Bt[n][k], At[m][k], acc[ai][bj][m][n], 0, 0, 0); __builtin_amdgcn_s_setprio(0); } while (0)
#define PG8_WAIT_V(n) asm volatile("s_waitcnt vmcnt(" #n ")" ::: "memory")
#define PG8_WAIT_L(n) asm volatile("s_waitcnt lgkmcnt(" #n ")" ::: "memory")
#define PG8_BAR __builtin_amdgcn_s_barrier()
#define PG8_SCHED __builtin_amdgcn_sched_barrier(0)
    Unit cur, nxt; int ui = 0;
    if (!S.next(0, cur)) return;
    f32x4 acc[2][2][4][2];
#pragma unroll
    for (int a = 0; a < 2; ++a)
#pragma unroll
        for (int b = 0; b < 2; ++b)
#pragma unroll
            for (int m = 0; m < 4; ++m)
#pragma unroll
                for (int n = 0; n < 2; ++n) acc[a][b][m][n] = (f32x4){0.f, 0.f, 0.f, 0.f};
    bf16x8 At[4][2], B0[2][2], B1[2][2];
    int Kc = S.K(cur), Kn; const char* Ac = S.a_base(cur); const char* An; const char* cB = S.b_ptr(cur); const char* nB;
    unsigned oc00, oc01, oc10, oc11, on00, on01, on10, on11, vbc0, vbc1, vbn0, vbn1; size_t hsc, hsn;
    oc00 = S.a_off(cur, RA[0], CA[0]); oc01 = S.a_off(cur, RA[1], CA[1]); oc10 = S.a_off(cur, HALF + RA[0], CA[0]); oc11 = S.a_off(cur, HALF + RA[1], CA[1]);
    vbc0 = (unsigned)(RB[0] * Kc + CA[0]) * 2u; vbc1 = (unsigned)(RB[1] * Kc + CA[1]) * 2u; hsc = (size_t)HALF * Kc * 2;
    S.a_ready(cur);
    PG8_STAGE2(PG8_SB(0, 0), cB, vbc0, vbc1); PG8_STAGE2(PG8_SB(0, 1), cB + hsc, vbc0, vbc1); PG8_STAGE2(PG8_SA(0, 0), Ac, oc00, oc01); PG8_STAGE2(PG8_SA(0, 1), Ac, oc10, oc11);
    if (wr == 1) PG8_BAR;
    PG8_WAIT_V(2); PG8_BAR;
    PG8_STAGE2(PG8_SB(1, 0), cB + kstep, vbc0, vbc1); PG8_STAGE2(PG8_SA(1, 0), Ac + kstep, oc00, oc01); PG8_STAGE2(PG8_SB(1, 1), cB + hsc + kstep, vbc0, vbc1);
    PG8_WAIT_V(6); PG8_BAR;
    for (;;) {
        const bool has_next = S.next(ui + 1, nxt);
        Kn = Kc; An = Ac; nB = cB; on00 = oc00; on01 = oc01; on10 = oc10; on11 = oc11; vbn0 = vbc0; vbn1 = vbc1; hsn = hsc;
        if (has_next) { Kn = S.K(nxt); An = S.a_base(nxt); nB = S.b_ptr(nxt);
            on00 = S.a_off(nxt, RA[0], CA[0]); on01 = S.a_off(nxt, RA[1], CA[1]); on10 = S.a_off(nxt, HALF + RA[0], CA[0]); on11 = S.a_off(nxt, HALF + RA[1], CA[1]);
            vbn0 = (unsigned)(RB[0] * Kn + CA[0]) * 2u; vbn1 = (unsigned)(RB[1] * Kn + CA[1]) * 2u; hsn = (size_t)HALF * Kn * 2; }
        const int nt = Kc / BK;
        for (int t = 0; t < nt; t += 2) {
            const bool last = (t == nt - 2);
            if (last && has_next) S.a_ready(nxt);
            const char* a1 = Ac + (size_t)(t + 1) * kstep;
            const char* a2 = last ? An : Ac + (size_t)(t + 2) * kstep; const char* b2 = last ? nB : cB + (size_t)(t + 2) * kstep;
            const char* a3 = a2 + kstep; const char* b3 = b2 + kstep;
            const unsigned x00 = last ? on00 : oc00, x01 = last ? on01 : oc01, x10 = last ? on10 : oc10, x11 = last ? on11 : oc11;
            const unsigned y0 = last ? vbn0 : vbc0, y1 = last ? vbn1 : vbc1; const size_t hs2 = last ? hsn : hsc;
            PG8_LDB(B0, 0, 0); PG8_LDB(B1, 0, 1); PG8_SCHED; PG8_LDA(At, 0, 0); PG8_STAGE2(PG8_SA(1, 1), a1, oc10, oc11);
            PG8_WAIT_V(8); PG8_WAIT_L(0); PG8_BAR; PG8_MMA(0, 0, At, B0); PG8_MMA(0, 1, At, B1); PG8_BAR; PG8_SCHED;
            PG8_LDA(At, 0, 1); PG8_STAGE2(PG8_SB(0, 0), b2, y0, y1); PG8_STAGE2(PG8_SB(0, 1), b2 + hs2, y0, y1); PG8_STAGE2(PG8_SA(0, 0), a2, x00, x01);
            PG8_WAIT_V(8); PG8_WAIT_L(0); PG8_BAR; PG8_MMA(1, 0, At, B0); PG8_MMA(1, 1, At, B1); PG8_BAR; PG8_SCHED;
            PG8_LDB(B0, 1, 0); PG8_LDB(B1, 1, 1); PG8_SCHED; PG8_LDA(At, 1, 0); PG8_STAGE2(PG8_SA(0, 1), a2, x10, x11);
            PG8_WAIT_V(8); PG8_WAIT_L(0); PG8_BAR; PG8_MMA(0, 0, At, B0); PG8_MMA(0, 1, At, B1); PG8_BAR; PG8_SCHED;
            PG8_LDA(At, 1, 1); PG8_STAGE2(PG8_SB(1, 0), b3, y0, y1); PG8_STAGE2(PG8_SB(1, 1), b3 + hs2, y0, y1); PG8_STAGE2(PG8_SA(1, 0), a3, x00, x01);
            PG8_WAIT_V(8); PG8_WAIT_L(0); PG8_BAR; PG8_MMA(1, 0, At, B0); PG8_MMA(1, 1, At, B1); PG8_BAR; PG8_SCHED;
        }
        if (wr == 0) PG8_BAR;
        E(acc, cur, wr, wc, fr, fq);
        if (!has_next) break;
#pragma unroll
        for (int a = 0; a < 2; ++a)
#pragma unroll
            for (int b = 0; b < 2; ++b)
#pragma unroll
                for (int m = 0; m < 4; ++m)
#pragma unroll
                    for (int n = 0; n < 2; ++n) acc[a][b][m][n] = (f32x4){0.f, 0.f, 0.f, 0.f};
        cur = nxt; Kc = Kn; Ac = An; cB = nB; oc00 = on00; oc01 = on01; oc10 = on10; oc11 = on11; vbc0 = vbn0; vbc1 = vbn1; hsc = hsn; ++ui;
        if (wr == 1) PG8_BAR;
    }
    PG8_WAIT_V(0);
    PG8_BAR;
#undef PG8_SA
#undef PG8_SB
#undef PG8_STAGE2
#undef PG8_LDA
#undef PG8_LDB
#undef PG8_MMA
#undef PG8_WAIT_V
#undef PG8_WAIT_L
#undef PG8_BAR
#undef PG8_SCHED
}
}

__device__ __forceinline__ int krow_of(int r) {
    if (r < T) return (r >> 12) * KVROWS + LCTX + (r & 4095);
    const int rc = r - T; return (rc >> 8) * KVROWS + (rc & 255);
}
struct SchedPlain {
    int nM, nN, G, vcu, Kk; const char* A; const char* B;
    __device__ __forceinline__ bool next(int i, pg8::Unit& u) const { const int L = i * G + vcu; if (L >= nM * nN) return false; u.pm = L / nN; u.pn = L % nN; u.e = 0; u.cnt = 256; u.kind = 0; return true; }
    __device__ __forceinline__ int K(const pg8::Unit&) const { return Kk; }
    __device__ __forceinline__ const char* a_base(const pg8::Unit&) const { return A; }
    __device__ __forceinline__ unsigned a_off(const pg8::Unit& u, int row, int col) const { return (unsigned)((u.pm * 256 + row) * Kk + col) * 2u; }
    __device__ __forceinline__ const char* b_ptr(const pg8::Unit& u) const { return B + (size_t)u.pn * 256 * Kk * 2; }
    __device__ __forceinline__ void a_ready(const pg8::Unit&) const {}
};
struct EpiG1 {
    static constexpr bool PERM = true;
    bf16 *pu, *q, *kall, *vall, *z;
    __device__ __forceinline__ void operator()(const f32x4 (&acc)[2][2][4][2], const pg8::Unit& u, int wr, int wc, int fr, int fq) const {
        const int row0 = u.pm * 256 + wr * 64 + fr, c8 = wc * 32 + 8 * fq;
#pragma unroll
        for (int ai = 0; ai < 2; ++ai)
#pragma unroll
            for (int m = 0; m < 4; ++m) {
                const int row = row0 + ai * 128 + m * 16;
#pragma unroll
                for (int bj = 0; bj < 2; ++bj) {
                    const f32x4 v0 = acc[ai][bj][m][0], v1 = acc[ai][bj][m][1];
                    v4u w; w.x = pk2(v0[0], v0[1]); w.y = pk2(v0[2], v0[3]); w.z = pk2(v1[0], v1[1]); w.w = pk2(v1[2], v1[3]);
                    bf16* dst;
                    if (u.pn == 0) dst = pu + (size_t)row * 256 + bj * 128 + c8;
                    else if (u.pn <= 2) dst = q + (size_t)row * 512 + (u.pn - 1) * 256 + bj * 128 + c8;
                    else if (u.pn == 3) dst = (bj == 0 ? kall : vall) + (size_t)krow_of(row) * 128 + c8;
                    else dst = z + (size_t)row * 512 + (u.pn - 4) * 256 + bj * 128 + c8;
                    *(v4u*)dst = w;
                }
            }
    }
};
struct EpiG2 {
    static constexpr bool PERM = false;
    const float* xin; const float* cin; float* xout; float* cout; const float* mod;
    __device__ __forceinline__ void operator()(const f32x4 (&acc)[2][2][4][2], const pg8::Unit& u, int wr, int wc, int fr, int fq) const {
        const int rt0 = u.pm * 256; const bool isc = rt0 >= T;
        const int bsel = isc ? 4 : (rt0 >> 12);
        const float* g1 = mod + bsel * 6144 + 2048;
        const float* base = isc ? cin - (size_t)T * 1024 : xin; float* out = isc ? cout - (size_t)T * 1024 : xout;
        const int row0 = rt0 + wr * 64 + fr, col0 = u.pn * 256 + wc * 32 + 4 * fq;
#pragma unroll
        for (int bj = 0; bj < 2; ++bj)
#pragma unroll
            for (int n = 0; n < 2; ++n) {
                const int col = col0 + bj * 128 + n * 16; const f32x4 gv = *(const f32x4*)(g1 + col);
#pragma unroll
                for (int ai = 0; ai < 2; ++ai)
#pragma unroll
                    for (int m = 0; m < 4; ++m) { const size_t off = (size_t)(row0 + ai * 128 + m * 16) * 1024 + col; const f32x4 bs = *(const f32x4*)(base + off); *(f32x4*)(out + off) = bs + gv * acc[ai][bj][m][n]; }
            }
    }
};
struct SchedMoe {
    int G, vcu, ntile;
    const char* hb; const char* actb; const char* wgu; const char* wd; const unsigned* list; const LAS int* tt; unsigned* ready; unsigned* tmo;
    __device__ __forceinline__ bool next(int i, pg8::Unit& u) const {
        const int U = ntile * 4; const int r = U % G, q = U / G; const int n3 = q + (vcu < r ? 1 : 0); int L;
        if (i < n3) { L = i * G + vcu; u.kind = 0; }
        else { const int j = i - n3; const int nl = G - r;
            if (vcu >= r) L = (j == 0) ? (vcu - r) : (j == 1) ? nl + (vcu - r) : 2 * nl + (j - 2) * G + vcu;
            else L = 2 * nl + j * G + vcu;
            if (L >= U) return false; u.kind = 1; }
        const int tau = L >> 2; u.pn = L & 3; u.pm = tau; int e = 0;
#pragma unroll
        for (int k = 1; k < 16; ++k) e += (tt[k] <= tau) ? 1 : 0;
        u.e = e; const int r0 = (tau - tt[e]) * 256; const int c = tt[17 + e] - r0; u.cnt = c < 256 ? c : 256; return true;
    }
    __device__ __forceinline__ int K(const pg8::Unit& u) const { return u.kind ? 512 : 1024; }
    __device__ __forceinline__ const char* a_base(const pg8::Unit& u) const { return u.kind ? actb : hb; }
    __device__ __forceinline__ unsigned a_off(const pg8::Unit& u, int row, int col) const {
        if (u.kind) return (unsigned)((u.pm * 256 + row) * 512 + col) * 2u;
        const int r0 = (u.pm - tt[u.e]) * 256; unsigned tok = 0;
        if (row < u.cnt) tok = list[(size_t)u.e * TT + r0 + row] >> 1;
        return (tok * 1024u + (unsigned)col) * 2u;
    }
    __device__ __forceinline__ const char* b_ptr(const pg8::Unit& u) const { return u.kind ? wd + ((size_t)u.e * 1024 + (size_t)u.pn * 256) * 512 * 2 : wgu + ((size_t)u.e * 1024 + (size_t)u.pn * 256) * 1024 * 2; }
    __device__ __forceinline__ void a_ready(const pg8::Unit& u) const {
        if (!u.kind) return;
        if (threadIdx.x < 64) {
            unsigned* w = ready + 16 * u.pm; unsigned sp = 0;
            while ((unsigned)__builtin_amdgcn_readfirstlane(__hip_atomic_load(w, __ATOMIC_RELAXED, __HIP_MEMORY_SCOPE_AGENT)) < 32u) {
                __builtin_amdgcn_s_sleep(2);
                if (++sp > (1u << 22)) { if (threadIdx.x == 0) __hip_atomic_store(tmo, 1u, __ATOMIC_RELAXED, __HIP_MEMORY_SCOPE_AGENT); break; } }
            __builtin_amdgcn_fence(__ATOMIC_ACQUIRE, "agent");
            asm volatile("s_waitcnt vmcnt(0)" ::: "memory");
        }
        asm volatile("" ::: "memory"); __builtin_amdgcn_s_barrier(); asm volatile("" ::: "memory");
    }
};
__device__ __forceinline__ void store16_wt(void* p, v4u v) { asm volatile("global_store_dwordx4 %0, %1, off sc1\n\ts_nop 1" :: "v"(p), "v"(v) : "memory"); }
struct EpiG3 {
    static constexpr bool PERM = true;
    bf16* act; unsigned* ready;
    __device__ __forceinline__ void operator()(const f32x4 (&acc)[2][2][4][2], const pg8::Unit& u, int wr, int wc, int fr, int fq) const {
        const int row0 = u.pm * 256 + wr * 64 + fr, c8 = u.pn * 128 + wc * 32 + 8 * fq;
#pragma unroll
        for (int ai = 0; ai < 2; ++ai)
#pragma unroll
            for (int m = 0; m < 4; ++m) {
                float a[8];
#pragma unroll
                for (int n = 0; n < 2; ++n)
#pragma unroll
                    for (int k = 0; k < 4; ++k) { const float g = acc[ai][0][m][n][k], up = acc[ai][1][m][n][k]; a[n * 4 + k] = g / (1.f + __expf(-g)) * up; }
                v4u w; w.x = pk2(a[0], a[1]); w.y = pk2(a[2], a[3]); w.z = pk2(a[4], a[5]); w.w = pk2(a[6], a[7]);
                store16_wt(act + (size_t)(row0 + ai * 128 + m * 16) * 512 + c8, w);
            }
        asm volatile("s_waitcnt vmcnt(0)" ::: "memory");
        if ((threadIdx.x & 63) == 0) __hip_atomic_fetch_add(ready + 16 * u.pm, 1u, __ATOMIC_RELAXED, __HIP_MEMORY_SCOPE_AGENT);
    }
};
struct EpiG4 {
    static constexpr bool PERM = true;
    bf16* y2; const unsigned* list; const float* wts; const LAS int* tt;
    __device__ __forceinline__ void operator()(const f32x4 (&acc)[2][2][4][2], const pg8::Unit& u, int wr, int wc, int fr, int fq) const {
        const int r0 = (u.pm - tt[u.e]) * 256; const int c8 = u.pn * 256 + wc * 32 + 8 * fq;
#pragma unroll
        for (int ai = 0; ai < 2; ++ai)
#pragma unroll
            for (int m = 0; m < 4; ++m) {
                const int row = wr * 64 + fr + ai * 128 + m * 16;
                if (row < u.cnt) {
                    const unsigned ent = list[(size_t)u.e * TT + r0 + row]; const float w = wts[ent];
#pragma unroll
                    for (int bj = 0; bj < 2; ++bj) {
                        const f32x4 v0 = acc[ai][bj][m][0] * w, v1 = acc[ai][bj][m][1] * w;
                        v4u o; o.x = pk2(v0[0], v0[1]); o.y = pk2(v0[2], v0[3]); o.z = pk2(v1[0], v1[1]); o.w = pk2(v1[2], v1[3]);
                        *(v4u*)(y2 + (size_t)ent * 1024 + bj * 128 + c8) = o;
                    }
                }
            }
    }
};

struct EpiMoe { static constexpr bool PERM = true; EpiG3 e3; EpiG4 e4;
    __device__ __forceinline__ void operator()(const f32x4 (&acc)[2][2][4][2], const pg8::Unit& u, int wr, int wc, int fr, int fq) const { if (u.kind) e4(acc, u, wr, wc, fr, fq); else e3(acc, u, wr, wc, fr, fq); } };

#include <hip/hip_bf16.h>
#include <cmath>
namespace attn_body {
using bf16=__hip_bfloat16;
using bf16x8=__attribute__((ext_vector_type(8)))short;
using s16x4=__attribute__((ext_vector_type(4)))short;
using f32x16=__attribute__((ext_vector_type(16)))float;
using u32x4=__attribute__((ext_vector_type(4)))unsigned;
constexpr int D=64,QP=512,KVP=128,OP=1024;
constexpr int NW=8,QBLK=32,KVBLK=64;
__device__ __forceinline__ int crow(int r,int hi){return (r&3)+8*(r>>2)+4*hi;}
#define SBAR() __builtin_amdgcn_sched_barrier(0)
__device__ __forceinline__ void wmask(f32x16&p0,f32x16&p1,int kp0,int qpos,int hi){
  const float NEG=-INFINITY; const bool tile_ok=(unsigned)kp0<4096u; const int base=kp0+4*hi-qpos+128;
  #pragma unroll
  for(int r=0;r<16;++r){const int dd=base+(r&3)+8*(r>>2); if(!tile_ok||(unsigned)dd>256u)p0[r]=NEG; if(!tile_ok||(unsigned)(dd+32)>256u)p1[r]=NEG;}
}
constexpr int NSLOT=3, SLOTB=8192;
constexpr int LDS_K=0, LDS_V=NSLOT*SLOTB, LDS_WS=2*NSLOT*SLOTB, LDS_OST=LDS_WS+NW*64*4, LDS_BYTES=LDS_OST+NW*4096;
constexpr float C2=0.125f*1.4426950408889634f;
__device__ __forceinline__ void glds16(const void*gsrc,unsigned lds_dst){unsigned keep;
  asm volatile("s_mov_b32 %0, m0\n\ts_mov_b32 m0, %2\n\ts_nop 0\n\tglobal_load_lds_dwordx4 %1, off\n\ts_mov_b32 m0, %0":"=&s"(keep):"v"(gsrc),"s"(lds_dst):"memory");}
__device__ __forceinline__ float max3f(float a,float b,float c){float r;asm("v_max3_f32 %0, %1, %2, %3":"=v"(r):"v"(a),"v"(b),"v"(c));return r;}
__device__ __forceinline__ float max2f(float a,float b){float r;asm("v_max_f32_e32 %0, %1, %2":"=v"(r):"v"(a),"v"(b));return r;}
__device__ __forceinline__ float fadd_s(float a,float b){float r;asm("v_add_f32_e32 %0, %1, %2":"=v"(r):"v"(a),"v"(b));return r;}
__device__ __forceinline__ float fsub_s(float a,float b){float r;asm("v_sub_f32_e32 %0, %1, %2":"=v"(r):"v"(a),"v"(b));return r;}
typedef float f32x2_t __attribute__((ext_vector_type(2))); typedef __bf16 bf16x2_t __attribute__((ext_vector_type(2)));
__device__ __forceinline__ unsigned cvtpk_s(float lo,float hi){f32x2_t v={lo,hi};bf16x2_t b=__builtin_convertvector(v,bf16x2_t);return __builtin_bit_cast(unsigned,b);}
#define WAIT_BAR(N) asm volatile("s_waitcnt vmcnt(" #N ") lgkmcnt(0)\n\ts_barrier":::"memory")

__device__ __forceinline__ void qkt(f32x16&p0,f32x16&p1,const char*Kslot,const bf16x8*qr,const f32x16&negm,int r32,int hi){
  const char*kb=Kslot+hi*1024+r32*16;
  #pragma unroll
  for(int d0=0;d0<4;++d0){
    const bf16x8 b0=*reinterpret_cast<const bf16x8*>(kb+d0*2048);
    const bf16x8 b1=*reinterpret_cast<const bf16x8*>(kb+d0*2048+512);
    if(d0==0){p0=__builtin_amdgcn_mfma_f32_32x32x16_bf16(b0,qr[0],negm,0,0,0);p1=__builtin_amdgcn_mfma_f32_32x32x16_bf16(b1,qr[0],negm,0,0,0);}
    else{p0=__builtin_amdgcn_mfma_f32_32x32x16_bf16(b0,qr[d0],p0,0,0,0);p1=__builtin_amdgcn_mfma_f32_32x32x16_bf16(b1,qr[d0],p1,0,0,0);}}
}
typedef __attribute__((address_space(3))) const char* lds_cptr;
typedef short v4i16_t __attribute__((ext_vector_type(4)));
__device__ __forceinline__ void kload8(bf16x8*kf,lds_cptr kp){
  kf[0]=*(const __attribute__((address_space(3))) bf16x8*)(kp);      kf[1]=*(const __attribute__((address_space(3))) bf16x8*)(kp+512);
  kf[2]=*(const __attribute__((address_space(3))) bf16x8*)(kp+2048); kf[3]=*(const __attribute__((address_space(3))) bf16x8*)(kp+2560);
  kf[4]=*(const __attribute__((address_space(3))) bf16x8*)(kp+4096); kf[5]=*(const __attribute__((address_space(3))) bf16x8*)(kp+4608);
  kf[6]=*(const __attribute__((address_space(3))) bf16x8*)(kp+6144); kf[7]=*(const __attribute__((address_space(3))) bf16x8*)(kp+6656);
}
__device__ __forceinline__ void kload2(bf16x8*kf,lds_cptr kp,int j){ kf[2*j]=*(const __attribute__((address_space(3))) bf16x8*)(kp+j*2048); kf[2*j+1]=*(const __attribute__((address_space(3))) bf16x8*)(kp+j*2048+512); }
__device__ __forceinline__ s16x4 vtr(lds_cptr p){ return __builtin_bit_cast(s16x4,__builtin_amdgcn_ds_read_tr16_b64_v4i16((__attribute__((address_space(3))) v4i16_t*)p)); }
__device__ __forceinline__ float rowmax(const f32x16&p0,const f32x16&p1){
  float a=max3f(p0[0],p0[1],p1[0]),b=max3f(p0[2],p0[3],p1[1]);a=max3f(a,p1[2],p1[3]);
  #pragma unroll
  for(int r=4;r<16;r+=4){a=max3f(a,p0[r],p0[r+1]);b=max3f(b,p0[r+2],p0[r+3]);a=max3f(a,p1[r],p1[r+1]);b=max3f(b,p1[r+2],p1[r+3]);}
  const float m=max2f(a,b);
  auto rr=__builtin_amdgcn_permlane32_swap(__float_as_uint(m),__float_as_uint(m),false,false);
  return max2f(__uint_as_float(rr[0]),__uint_as_float(rr[1]));
}
__device__ __forceinline__ void pv(f32x16*o,int vb,bf16x8 pa0,bf16x8 pa1,bf16x8 pa2,bf16x8 pa3){
  #pragma unroll
  for(int d0=0;d0<2;++d0){s16x4 lo[4],hi[4];
    #pragma unroll
    for(int ks=0;ks<4;++ks){
      asm volatile("ds_read_b64_tr_b16 %0,%1 offset:%c2":"=&v"(lo[ks]):"v"(vb),"i"(d0*4096+ks*1024):"memory");
      asm volatile("ds_read_b64_tr_b16 %0,%1 offset:%c2":"=&v"(hi[ks]):"v"(vb),"i"(d0*4096+ks*1024+512):"memory");}
    asm volatile("s_waitcnt lgkmcnt(0)":::"memory");SBAR();
    #define PK(k) (bf16x8){lo[k][0],lo[k][1],lo[k][2],lo[k][3],hi[k][0],hi[k][1],hi[k][2],hi[k][3]}
    o[d0]=__builtin_amdgcn_mfma_f32_32x32x16_bf16(pa0,PK(0),o[d0],0,0,0);
    o[d0]=__builtin_amdgcn_mfma_f32_32x32x16_bf16(pa1,PK(1),o[d0],0,0,0);
    o[d0]=__builtin_amdgcn_mfma_f32_32x32x16_bf16(pa2,PK(2),o[d0],0,0,0);
    o[d0]=__builtin_amdgcn_mfma_f32_32x32x16_bf16(pa3,PK(3),o[d0],0,0,0);
    #undef PK
  }
}

#ifndef ATTN_STORE16
#define ATTN_STORE16(p,v) (*(u32x4*)(p)=(v))
#endif
template<int THRL> __device__ __forceinline__ void attn_unit(const bf16*Qu,const bf16*__restrict__ Kh,const bf16*__restrict__ Vh,bf16*Ou,const int p0,const int NT,const float* sinkp,const float* qg,const float2* ropet,char*shm){
  int tid=threadIdx.x; asm volatile("":"+v"(tid)); const int lane=tid&63,r32=lane&31,hi=lane>>5; const int wid=__builtin_amdgcn_readfirstlane(tid>>6);
  const int hsub=wid>>1, psub=(wid&1)*QBLK;
  const bf16*Qw=Qu+(long)psub*QP+hsub*D;
  const unsigned lds0=(unsigned)(uintptr_t)shm;
  float*wsf=(float*)(shm+LDS_WS)+wid*64;
  const bf16*ksrc=Kh+(long)lane*KVP+wid*8;
  const bf16*vsrc=Vh+(long)(16*(wid&3)+(lane>>2))*KVP+(wid>>2)*32+(lane&3)*8;
  const unsigned kdst=lds0+LDS_K+wid*1024, vdst=lds0+LDS_V+wid*1024;
  #define KP0(t) (p0-128+64*((t)-4))
  #define TROW(t) ((t)<4?64*(t):(((unsigned)KP0(t)<4096u)?256+KP0(t):256))
  #define DMA_K(t,slot) glds16(ksrc+(long)TROW(t)*KVP,(unsigned)__builtin_amdgcn_readfirstlane(kdst+(slot)))
  #define DMA_V(t,slot) glds16(vsrc+(long)TROW(t)*KVP,(unsigned)__builtin_amdgcn_readfirstlane(vdst+(slot)))
  const int vb0=(int)(lds0+LDS_V)+((lane>>4)&1)*32+(lane&3)*8+(4*hi+((lane&15)>>2))*64;
  const char*Kbase=shm+LDS_K; bf16x8 kf[8];
  const lds_cptr shm3=(lds_cptr)shm; const lds_cptr kp0=shm3+LDS_K+hi*1024+r32*16; const lds_cptr vp0=shm3+LDS_V+((lane>>4)&1)*32+(lane&3)*8+(4*hi+((lane&15)>>2))*64;
  DMA_K(0,0);DMA_V(0,0);DMA_K(1,SLOTB);
  bf16x8 qr[4];
  { bf16x8 qraw[4];
    #pragma unroll
    for(int d0=0;d0<4;++d0)qraw[d0]=*reinterpret_cast<const bf16x8*>(&Qw[(long)r32*QP+d0*16+hi*8]);
    float qf[4][8]; float ss=0.f;
    #pragma unroll
    for(int d0=0;d0<4;++d0)
      #pragma unroll
      for(int j=0;j<8;++j){ qf[d0][j]=__builtin_bit_cast(float,(unsigned)(unsigned short)qraw[d0][j]<<16); ss+=qf[d0][j]*qf[d0][j]; }
    ss+=__shfl_xor(ss,32);
    const float rstd=1.0f/sqrtf(ss*(1.f/64.f)+1e-6f)*C2;
    #pragma unroll
    for(int d0=0;d0<4;++d0)
      #pragma unroll
      for(int j=0;j<8;++j) qf[d0][j]*=rstd*qg[16*d0+8*hi+j];
    if(ropet){ const float2* rp=ropet+(long)(p0+psub+r32)*32+8*hi;
      #pragma unroll
      for(int j=0;j<8;++j){ const float2 c1=rp[j],c2=rp[16+j];
        const float a=qf[0][j],b=qf[1][j],c=qf[2][j],d=qf[3][j];
        qf[0][j]=a*c1.x-b*c1.y; qf[1][j]=b*c1.x+a*c1.y; qf[2][j]=c*c2.x-d*c2.y; qf[3][j]=d*c2.x+c*c2.y; } }
    #pragma unroll
    for(int d0=0;d0<4;++d0){ u32x4 w; w[0]=cvtpk_s(qf[d0][0],qf[d0][1]); w[1]=cvtpk_s(qf[d0][2],qf[d0][3]); w[2]=cvtpk_s(qf[d0][4],qf[d0][5]); w[3]=cvtpk_s(qf[d0][6],qf[d0][7]); qr[d0]=__builtin_bit_cast(bf16x8,w); } }
  float mhat=0.f,l_reg=0.f;f32x16 o[2];o[0]=f32x16{};o[1]=f32x16{};f32x16 negm=f32x16{};asm volatile("":"+v"(negm));
  const int qpos=p0+psub+r32;
  #define CMASK(P0,P1,t) do{ if((t)>=4)wmask(P0,P1,KP0(t),qpos,hi); }while(0)
  bool resc=false;
  #define START(P0,P1) do{ const float rm=rowmax(P0,P1); resc=false; \
    { const float dl=rm; mhat=fadd_s(mhat,dl); \
      _Pragma("unroll") for(int r=0;r<16;++r){P0[r]=fsub_s(P0[r],dl);P1[r]=fsub_s(P1[r],dl);} \
      _Pragma("unroll") for(int r=0;r<16;++r)negm[r]=-mhat; asm volatile("":"+v"(negm)); } \
    _Pragma("unroll") for(int r=0;r<16;++r)P0[r]=__builtin_amdgcn_exp2f(P0[r]); }while(0)
  #define RESC() do{ if(resc){ asm volatile("s_waitcnt lgkmcnt(0)":::"memory"); \
      _Pragma("unroll") for(int d_=0;d_<2;++d_) _Pragma("unroll") for(int r=0;r<16;++r)o[d_][r]*=wsf[crow(r,hi)]; } }while(0)
  f32x16 pA0,pA1,pB0,pB1;
  int sl_prev=0,sl_cur=0,sl_next=SLOTB;
  #define ROT() do{sl_prev=sl_cur;sl_cur=sl_next;sl_next=(sl_next==(NSLOT-1)*SLOTB)?0:sl_next+SLOTB;}while(0)
  DMA_K(2,2*SLOTB);
  WAIT_BAR(3);
  qkt(pA0,pA1,Kbase,qr,negm,r32,hi);asm volatile("s_nop 15\n\ts_nop 7":"+v"(pA0),"+v"(pA1));CMASK(pA0,pA1,0);
  START(pA0,pA1);
  _Pragma("unroll") for(int r=0;r<16;++r)pA1[r]=__builtin_amdgcn_exp2f(pA1[r]);
  WAIT_BAR(0);
  DMA_K(3,0);DMA_V(1,SLOTB);
  ROT();
  kload8(kf,kp0+sl_cur);
  WAIT_BAR(2);
  s16x4 vlo[8],vhi[8]; u32x4 pw0,pw1,pw2,pw3;
  #define PKW(P,B) cvtpk_s(P[B],P[B+1])
  #define PAF(k) __builtin_bit_cast(bf16x8,pw##k)
  #define VFR(i) (bf16x8){vlo[i][0],vlo[i][1],vlo[i][2],vlo[i][3],vhi[i][0],vhi[i][1],vhi[i][2],vhi[i][3]}
  #define PIN(x) asm volatile("":"+v"(x))
  #define MX3(a,b,c) __builtin_fmaxf(__builtin_fmaxf((a),(b)),(c))
  #define GAPA(MF,A0,A1,A2,A3,W0,W1,PW) do{ MF; sacc+=A0; sacc+=A1; sacc+=A2; sacc+=A3; PIN(sacc); W0; W1; PIN(PW); SBAR(); }while(0)
  #define EX(v) __builtin_amdgcn_exp2f(v)
  #define GAPB(MF,X,B) do{ MF; X[B]=EX(X[B]); X[B+1]=EX(X[B+1]); X[B+2]=EX(X[B+2]); X[B+3]=EX(X[B+3]); PIN(X); SBAR(); }while(0)
  #define VRD(i) do{ vlo[i]=vtr(vp_+(((i)>>2)*4096+((i)&3)*1024)); vhi[i]=vtr(vp_+(((i)>>2)*4096+((i)&3)*1024+512)); }while(0)
  #define KRD(G,j) do{ if(G){ kload2(kf,kp0+sl_next,j); SBAR(); } }while(0)
  #define STEP(C0,C1,P0,P1,t,GK,GV,GL) do{ SBAR(); \
    const lds_cptr vp_=vp0+sl_prev; \
    VRD(0); SBAR(); float sacc=(P0[0]+P0[1]); \
    GAPA(C0=__builtin_amdgcn_mfma_f32_32x32x16_bf16(kf[0],qr[0],negm,0,0,0), P0[2],P0[3],P0[4],P0[5],     pw0[0]=PKW(P0,0), pw0[1]=PKW(P0,2), pw0); \
    VRD(4); SBAR(); GAPA(C1=__builtin_amdgcn_mfma_f32_32x32x16_bf16(kf[1],qr[0],negm,0,0,0), P0[6],P0[7],P0[8],P0[9],     pw0[2]=PKW(P0,4), pw0[3]=PKW(P0,6), pw0); \
    VRD(1); SBAR(); GAPA(C0=__builtin_amdgcn_mfma_f32_32x32x16_bf16(kf[2],qr[1],C0,0,0,0),   P0[10],P0[11],P0[12],P0[13], pw1[0]=PKW(P0,8), pw1[1]=PKW(P0,10), pw1); \
    VRD(5); SBAR(); GAPA(C1=__builtin_amdgcn_mfma_f32_32x32x16_bf16(kf[3],qr[1],C1,0,0,0),   P0[14],P0[15],P1[0],P1[1],   pw1[2]=PKW(P0,12),pw1[3]=PKW(P0,14), pw1); \
    VRD(2); SBAR(); GAPA(C0=__builtin_amdgcn_mfma_f32_32x32x16_bf16(kf[4],qr[2],C0,0,0,0),   P1[2],P1[3],P1[4],P1[5],     pw2[0]=PKW(P1,0), pw2[1]=PKW(P1,2), pw2); \
    VRD(6); SBAR(); GAPA(C1=__builtin_amdgcn_mfma_f32_32x32x16_bf16(kf[5],qr[2],C1,0,0,0),   P1[6],P1[7],P1[8],P1[9],     pw2[2]=PKW(P1,4), pw2[3]=PKW(P1,6), pw2); \
    VRD(3); SBAR(); GAPA(C0=__builtin_amdgcn_mfma_f32_32x32x16_bf16(kf[6],qr[3],C0,0,0,0),   P1[10],P1[11],P1[12],P1[13], pw3[0]=PKW(P1,8), pw3[1]=PKW(P1,10), pw3); \
    VRD(7); SBAR(); GAPA(C1=__builtin_amdgcn_mfma_f32_32x32x16_bf16(kf[7],qr[3],C1,0,0,0),   P1[14],P1[15],0.f,0.f,       pw3[2]=PKW(P1,12),pw3[3]=PKW(P1,14), pw3); \
    l_reg+=sacc; \
    if(GK){DMA_K((t)+3,sl_cur);} if(GV){DMA_V((t)+1,sl_next);} \
    CMASK(C0,C1,t); \
    { float a=MX3(C0[0],C0[1],C1[0]),b=MX3(C0[2],C0[3],C1[1]); a=MX3(a,C1[2],C1[3]); \
      _Pragma("unroll") for(int r=4;r<16;r+=4){a=MX3(a,C0[r],C0[r+1]);b=MX3(b,C0[r+2],C0[r+3]);a=MX3(a,C1[r],C1[r+1]);b=MX3(b,C1[r+2],C1[r+3]);} \
      float rm=__builtin_fmaxf(a,b); { auto rr=__builtin_amdgcn_permlane32_swap(__float_as_uint(rm),__float_as_uint(rm),false,false); rm=__builtin_fmaxf(__uint_as_float(rr[0]),__uint_as_float(rr[1])); } \
      resc=false; \
      if(__builtin_expect(__any(rm>(float)THRL),0)){ const float dl=__builtin_fmaxf(rm,0.f); mhat+=dl; \
        _Pragma("unroll") for(int r=0;r<16;++r){C0[r]-=dl;C1[r]-=dl;} \
        _Pragma("unroll") for(int r=0;r<16;++r)negm[r]=-mhat; asm volatile("":"+v"(negm)); \
        const float f=__builtin_amdgcn_exp2f(-dl); l_reg*=f; if(hi==0)wsf[r32]=f; resc=true; } } \
    SBAR(); \
    GAPB(o[0]=__builtin_amdgcn_mfma_f32_32x32x16_bf16(PAF(0),VFR(0),o[0],0,0,0), C0,0); \
    GAPB(o[1]=__builtin_amdgcn_mfma_f32_32x32x16_bf16(PAF(0),VFR(4),o[1],0,0,0), C0,4); \
    KRD(GL,0); GAPB(o[0]=__builtin_amdgcn_mfma_f32_32x32x16_bf16(PAF(1),VFR(1),o[0],0,0,0), C0,8); \
    KRD(GL,1); GAPB(o[1]=__builtin_amdgcn_mfma_f32_32x32x16_bf16(PAF(1),VFR(5),o[1],0,0,0), C0,12); \
    KRD(GL,2); GAPB(o[0]=__builtin_amdgcn_mfma_f32_32x32x16_bf16(PAF(2),VFR(2),o[0],0,0,0), C1,0); \
    KRD(GL,3); GAPB(o[1]=__builtin_amdgcn_mfma_f32_32x32x16_bf16(PAF(2),VFR(6),o[1],0,0,0), C1,4); \
    GAPB(o[0]=__builtin_amdgcn_mfma_f32_32x32x16_bf16(PAF(3),VFR(3),o[0],0,0,0), C1,8); \
    GAPB(o[1]=__builtin_amdgcn_mfma_f32_32x32x16_bf16(PAF(3),VFR(7),o[1],0,0,0), C1,12); \
    }while(0)
  int t=1;
  for(;t+5<NT;t+=2){
    STEP(pB0,pB1,pA0,pA1,t,true,true,true);     WAIT_BAR(2); RESC(); ROT();
    STEP(pA0,pA1,pB0,pB1,t+1,true,true,true);   WAIT_BAR(2); RESC(); ROT();
  }
  #define ENDW(tt) do{ if((tt)+3<NT){WAIT_BAR(2);} else if((tt)+2<NT){WAIT_BAR(1);} else {WAIT_BAR(0);} }while(0)
  for(;t+1<NT;t+=2){
    STEP(pB0,pB1,pA0,pA1,t,(t+3<NT),(t+1<NT),(t+1<NT));       ENDW(t);   RESC(); ROT();
    STEP(pA0,pA1,pB0,pB1,t+1,(t+4<NT),(t+2<NT),(t+2<NT));     ENDW(t+1); RESC(); ROT();
  }
  STEP(pB0,pB1,pA0,pA1,NT-1,false,false,false); RESC();
  { float sacc=pB0[0]+pB0[1]; _Pragma("unroll") for(int r=2;r<16;++r)sacc+=pB0[r]; _Pragma("unroll") for(int r=0;r<16;++r)sacc+=pB1[r]; l_reg+=sacc;
    pw0=(u32x4){PKW(pB0,0),PKW(pB0,2),PKW(pB0,4),PKW(pB0,6)};pw1=(u32x4){PKW(pB0,8),PKW(pB0,10),PKW(pB0,12),PKW(pB0,14)};pw2=(u32x4){PKW(pB1,0),PKW(pB1,2),PKW(pB1,4),PKW(pB1,6)};pw3=(u32x4){PKW(pB1,8),PKW(pB1,10),PKW(pB1,12),PKW(pB1,14)};
    SBAR(); pv(o,vb0+sl_cur,PAF(0),PAF(1),PAF(2),PAF(3)); }
  #undef PKW
  #undef PAF
  #undef VFR
  #undef PIN
  #undef MX3
  #undef GAPA
  #undef GAPB
  #undef EX
  #undef VRD
  #undef KRD
  #undef STEP
  #undef ENDW
  l_reg+=__shfl_xor(l_reg,32);
  l_reg+=__builtin_amdgcn_exp2f(sinkp[hsub]*1.4426950408889634f-mhat);
  if(hi==0)wsf[32+r32]=l_reg;asm volatile("s_waitcnt lgkmcnt(0)":::"memory");
  float rli[16];
  #pragma unroll
  for(int r=0;r<16;++r)rli[r]=__builtin_amdgcn_rcpf(wsf[32+crow(r,hi)]);
  bf16*Ow=Ou+(long)psub*OP+hsub*D;
  { bf16*stg=(bf16*)(shm+LDS_OST)+wid*2048;
    #pragma unroll
    for(int r=0;r<16;++r){const int orow=crow(r,hi);
      #pragma unroll
      for(int d0=0;d0<2;++d0)stg[orow*64+d0*32+r32]=__float2bfloat16(o[d0][r]*rli[r]);}
    asm volatile("s_waitcnt lgkmcnt(0)":::"memory");
    #pragma unroll
    for(int i=0;i<4;++i){const int row=i*8+(lane>>3),ch=lane&7; const u32x4 v=*(const u32x4*)(stg+row*64+ch*8); ATTN_STORE16(Ow+(long)row*OP+ch*8,v);} }
  asm volatile("s_waitcnt lgkmcnt(0)\n\ts_barrier":::"memory");
  #undef DMA_K
  #undef DMA_V
  #undef KP0
  #undef TROW
  #undef CMASK
  #undef START
  #undef RESC
  #undef ROT
}
constexpr int ATTN_LDS_BYTES=LDS_BYTES;
#undef SBAR
#undef WAIT_BAR
}

constexpr int SLAB_PITCH = 288;
typedef short v4i16_t __attribute__((ext_vector_type(4)));
template <int MT, class RowAddr, class Epi>
__device__ __forceinline__ void slab_gemm(LAS unsigned char* lds, const bf16* Cmat, const int K, const RowAddr& RA, const Epi& E) {
    int tid = threadIdx.x; asm volatile("" : "+v"(tid));
    const int wid = tid >> 6, lane = tid & 63;
    LAS bf16* Dr = (LAS bf16*)lds;
    f32x16 acc[MT];
#pragma unroll
    for (int i = 0; i < MT; ++i)
#pragma unroll
        for (int r = 0; r < 16; ++r) acc[i][r] = 0.f;
    const int g = (lane >> 4) & 1, h = lane >> 5, qq = (lane & 15) >> 2, pp = lane & 3;
    const LAS bf16* trp = Dr + (8 * h + qq) * SLAB_PITCH + wid * 32 + 16 * g + 4 * pp;
    for (int kc = 0; kc < K; kc += 128) {
        {
            const int k = tid >> 2, qd = tid & 3;
            const bf16* src = RA(kc + k) + qd * 64;
            v4u v[8];
#pragma unroll
            for (int j = 0; j < 8; ++j) v[j] = *(const v4u*)(src + j * 8);
#pragma unroll
            for (int j = 0; j < 8; ++j) *(LAS v4u*)(Dr + k * SLAB_PITCH + qd * 64 + j * 8) = v[j];
        }
        __syncthreads();
        const int kh = h * 8;
#pragma unroll
        for (int s = 0; s < 8; ++s) {
            const v4i16_t b0 = __builtin_amdgcn_ds_read_tr16_b64_v4i16((LAS v4i16_t*)(trp + (16 * s) * SLAB_PITCH));
            const v4i16_t b1 = __builtin_amdgcn_ds_read_tr16_b64_v4i16((LAS v4i16_t*)(trp + (16 * s + 4) * SLAB_PITCH));
            const bf16x8 bfrag = (bf16x8){b0[0], b0[1], b0[2], b0[3], b1[0], b1[1], b1[2], b1[3]};
#pragma unroll
            for (int mt = 0; mt < MT; ++mt) {
                const bf16x8 afrag = *(const bf16x8*)(Cmat + (size_t)(mt * 32 + (lane & 31)) * K + kc + s * 16 + kh);
                acc[mt] = __builtin_amdgcn_mfma_f32_32x32x16_bf16(afrag, bfrag, acc[mt], 0, 0, 0);
            }
        }
        __syncthreads();
    }
    E(acc, wid, lane);
}

struct Args { const float* in[23]; float* out; unsigned char* ws; int ph_lo, ph_hi; };

struct RowA { const bf16* z; int b, n2; __device__ __forceinline__ const bf16* operator()(int k) const { return z + (size_t)(b * 4096 + 64 * (k & 63) + n2) * 512 + (k >> 6) * 256; } };
struct EpiA { bf16* t2; const float2* tw; int b, n2;
    __device__ __forceinline__ void operator()(const f32x16 (&acc)[4], int wid, int lane) const {
        const int ch = wid * 32 + (lane & 31);
#pragma unroll
        for (int mt = 0; mt < 2; ++mt)
#pragma unroll
            for (int r = 0; r < 16; ++r) {
                const int k1 = 32 * mt + (r & 3) + 8 * (r >> 2) + 4 * (lane >> 5);
                const float2 cs = tw[n2 * k1]; const float re = acc[mt][r], im = acc[mt + 2][r];
                const float re2 = cs.x * re + cs.y * im, im2 = cs.x * im - cs.y * re;
                bf16* d = t2 + ((size_t)((b * 64 + n2) * 64 + k1) * 2) * 256 + ch;
                d[0] = (bf16)f2bf(re2); d[256] = (bf16)f2bf(im2);
            }
    } };
struct RowB { const bf16* t2; int b, k1; __device__ __forceinline__ const bf16* operator()(int k) const { return t2 + ((size_t)((b * 64 + (k & 63)) * 64 + k1) * 2 + (k >> 6)) * 256; } };
struct EpiB { bf16* mrg; int b, k1;
    __device__ __forceinline__ void operator()(const f32x16 (&acc)[2], int wid, int lane) const {
        const int ch = wid * 32 + (lane & 31);
#pragma unroll
        for (int mt = 0; mt < 2; ++mt)
#pragma unroll
            for (int r = 0; r < 16; ++r) { const int k2 = 32 * mt + (r & 3) + 8 * (r >> 2) + 4 * (lane >> 5); mrg[(size_t)(b * 4096 + k1 + 64 * k2) * 1024 + 768 + ch] = (bf16)f2bf(DBG_NO_FOUR ? 0.f : acc[mt][r]); }
    } };
struct RowC { const bf16* z; int b; __device__ __forceinline__ const bf16* operator()(int k) const { return z + (size_t)(T + b * 256 + (k & 255)) * 512 + (k >> 8) * 256; } };
struct EpiC { bf16* mrg; int b, mt0;
    __device__ __forceinline__ void operator()(const f32x16 (&acc)[1], int wid, int lane) const {
        const int ch = wid * 32 + (lane & 31);
#pragma unroll
        for (int mt = 0; mt < 1; ++mt)
#pragma unroll
            for (int r = 0; r < 16; ++r) { const int kk = 32 * (mt0 + mt) + (r & 3) + 8 * (r >> 2) + 4 * (lane >> 5); mrg[(size_t)(T + b * 256 + kk) * 1024 + 768 + ch] = (bf16)f2bf(DBG_NO_FOUR ? 0.f : acc[mt][r]); }
    } };

__device__ __forceinline__ void tr_block(const float* src, int ldS, bf16* dst, int ldD, LAS float* scr, int lane) {
#pragma unroll 8
    for (int i = 0; i < 32; ++i) { const int kk = 2 * i + (lane >> 5); scr[kk * 33 + (lane & 31)] = src[(size_t)kk * ldS + (lane & 31)]; }
    LDS_WAIT(); asm volatile("" ::: "memory");
    const int c = lane & 7;
#pragma unroll
    for (int j = 0; j < 4; ++j) { const int n = (lane >> 3) + 8 * j; const LAS float* s = scr + (8 * c) * 33 + n;
        v4u o; o.x = pk2(s[0 * 33], s[1 * 33]); o.y = pk2(s[2 * 33], s[3 * 33]); o.z = pk2(s[4 * 33], s[5 * 33]); o.w = pk2(s[6 * 33], s[7 * 33]);
        *(GAS v4u*)(dst + (size_t)n * ldD + 8 * c) = o; }
    LDS_WAIT(); asm volatile("" ::: "memory");
}


__device__ __forceinline__ void tr_block64(const float* src, int ldS, bf16* dst, int ldD, LAS bf16* scr, int lane) {
    const int kr = lane >> 4, nc = lane & 15;
    f32x4 v[16];
#pragma unroll
    for (int i = 0; i < 16; ++i) v[i] = *(const f32x4*)(src + (size_t)(4 * i + kr) * ldS + 4 * nc);
#pragma unroll
    for (int i = 0; i < 16; ++i) { const int k = 4 * i + kr;
#pragma unroll
        for (int j = 0; j < 4; ++j) scr[(4 * nc + j) * 66 + k] = (bf16)f2bf(v[i][j]); }
    LDS_WAIT(); asm volatile("" ::: "memory");
    const int c = lane & 7;
#pragma unroll
    for (int j = 0; j < 8; ++j) { const int n = (lane >> 3) + 8 * j; const LAS unsigned* p = (const LAS unsigned*)(scr + n * 66 + 8 * c);
        v4u o; o.x = p[0]; o.y = p[1]; o.z = p[2]; o.w = p[3];
        *(GAS v4u*)(dst + (size_t)n * ldD + 8 * c) = o; }
    LDS_WAIT(); asm volatile("" ::: "memory");
}

typedef const __attribute__((address_space(4))) Args* kargs_t;
__device__ __forceinline__ kargs_t ka_launder() { kargs_t p = (kargs_t)__builtin_amdgcn_kernarg_segment_ptr(); asm volatile("" : "+s"(p)); return p; }
__device__ __forceinline__ int tid_launder() { int t = threadIdx.x; asm volatile("" : "+v"(t)); return t; }
#define KA_DECL const kargs_t KA = ka_launder(); const int tid = tid_launder(); const int lane = tid & 63; const int wave = __builtin_amdgcn_readfirstlane(tid >> 6); const int gw = vcu * 8 + wave; const int gt = vcu * 512 + tid; (void)lane; (void)wave; (void)gw; (void)gt;
#define ws (KA->ws)
#define ctl ((gu32*)(ws + O_CTL))
#define x_in (KA->in[0])
#define c_in (KA->in[1])
#define ctx_in (KA->in[2])
#define cctx_in (KA->in[3])
#define w_mod (KA->in[4])
#define b_mod (KA->in[5])
#define norm1_g (KA->in[6])
#define w_in (KA->in[7])
#define q_norm_g (KA->in[8])
#define k_norm_g (KA->in[9])
#define attn_sink (KA->in[10])
#define pool_w (KA->in[11])
#define pool_scale (KA->in[12])
#define four_w (KA->in[13])
#define w_out (KA->in[14])
#define norm2_g (KA->in[15])
#define w_grp (KA->in[16])
#define b_grp (KA->in[17])
#define w_rtr (KA->in[18])
#define b_rtr (KA->in[19])
#define w_gate (KA->in[20])
#define w_up (KA->in[21])
#define w_down (KA->in[22])
#define outp (KA->out)
#define modv ((float*)(ws + O_MOD))
#define rope ((float2*)(ws + O_ROPE))
#define twt ((float2*)(ws + O_TW))
#define fma ((bf16*)(ws + O_FMA))
#define fmb ((bf16*)(ws + O_FMB))
#define fmc ((bf16*)(ws + O_FMC))
#define hbuf ((bf16*)(ws + O_H))
#define kall ((bf16*)(ws + O_KALL))
#define vall ((bf16*)(ws + O_VALL))
#define xc ((float*)(ws + O_XC))
#define list ((unsigned*)(ws + O_LIST))
#define wts ((float*)(ws + O_WTS))
#define act ((bf16*)(ws + O_ACT))
#define t2 ((bf16*)(ws + O_T2))
#define mrg ((bf16*)(ws + O_MRG))
#define qb ((bf16*)(ws + O_Q))
#define pu ((bf16*)(ws + O_PU))
#define zb ((bf16*)(ws + O_Z))
#define y2 ((bf16*)(ws + O_Y2))

#ifndef PH_MASK
#define PH_MASK 0x3ffff
#endif
#define IN(k) (lo <= (k) && (k) < hi && ((PH_MASK >> (k)) & 1))
#define SEAM(k) do { if (IN(k) && IN((k) + 1)) xcd_barrier(bar); } while (0)
#define modl (modv + (size_t)l * 5 * 6144)
#define win_t ((bf16*)(ws + O_WIN + l * SZ_WIN1))
#define wout_t ((bf16*)(ws + O_WOUT + l * SZ_WOUT1))
#define wgu_t ((bf16*)(ws + O_WGU + l * SZ_WGU1))
#define wd_t ((bf16*)(ws + O_WD + l * SZ_WD1))
constexpr int CV_A = 256, CV_B = 192, CV_C = 4096, CV_D = 2048, CV_L = CV_A + CV_B + CV_C + CV_D;
__device__ __forceinline__ void conv_item(const kargs_t KA, const int lw, int it, LAS bf16* scr, const int lane) {
    bf16* p_win_t = (bf16*)(ws + O_WIN + lw * SZ_WIN1); bf16* p_wout_t = (bf16*)(ws + O_WOUT + lw * SZ_WOUT1);
    bf16* p_wgu_t = (bf16*)(ws + O_WGU + lw * SZ_WGU1); bf16* p_wd_t = (bf16*)(ws + O_WD + lw * SZ_WD1);
    if (it < CV_A) { const int kb = it >> 4, nb = it & 15; tr_block64(w_in + (size_t)lw * 1024 * 1280 + (size_t)kb * 64 * 1280 + nb * 64, 1280, p_win_t + (size_t)nb * 64 * 1024 + kb * 64, 1024, scr, lane); return; } it -= CV_A;
    if (it < CV_B) { const int kb = 4 + (it >> 4), nb = it & 15; tr_block64(w_out + (size_t)lw * 1024 * 1024 + (size_t)kb * 64 * 1024 + nb * 64, 1024, p_wout_t + (size_t)nb * 64 * 1024 + kb * 64, 1024, scr, lane); return; } it -= CV_B;
    if (it < CV_C) { const int up = it >> 11, r = it & 2047, e = r >> 7, kb = (r >> 3) & 15, nb = r & 7; const int n0 = nb * 64;
        const float* src = (up ? w_up : w_gate) + ((size_t)(lw * 16 + e) * 1024 + kb * 64) * 512 + n0;
        const int drow = (n0 >> 7) * 256 + up * 128 + (n0 & 127);
        tr_block64(src, 512, p_wgu_t + ((size_t)e * 1024 + drow) * 1024 + kb * 64, 1024, scr, lane); return; } it -= CV_C;
    { const int e = it >> 7, kb = (it >> 4) & 7, nb = it & 15;
        tr_block64(w_down + ((size_t)(lw * 16 + e) * 512 + kb * 64) * 1024 + nb * 64, 1024, p_wd_t + ((size_t)e * 1024 + nb * 64) * 512 + kb * 64, 512, scr, lane); }
}
__device__ __forceinline__ void steal_convert(const kargs_t KA, LAS unsigned char* lds, const int G, const int done_idx, const bool drain) {
    int tid = threadIdx.x; asm volatile("" : "+v"(tid));
    const int lane = tid & 63, wave = __builtin_amdgcn_readfirstlane(tid >> 6);
    volatile LAS int* mb = (volatile LAS int*)(lds + MISC_OFF + 64);
    LAS bf16* scr = (LAS bf16*)(lds + wave * 16384);
    __syncthreads();
    if (tid == 0 && !drain) __hip_atomic_fetch_add((unsigned*)(ctl + CW_DONE + 64 * done_idx), 1u, RLX_AGENT);
    for (;;) {
        if (tid == 0) { int idx = -1;
            const bool stop = !drain && __hip_atomic_load((unsigned*)(ctl + CW_DONE + 64 * done_idx), RLX_AGENT) >= (unsigned)G;
            if (!stop) idx = (int)__hip_atomic_fetch_add((unsigned*)(ctl + CW_Q), 8u, RLX_AGENT);
            mb[0] = idx; }
        __syncthreads();
        const int idx = mb[0];
        __syncthreads();
        if (idx < 0 || idx >= CV_L) break;
        if (idx + wave < CV_L) conv_item(KA, 1, idx + wave, scr, lane);
    }
    __syncthreads();
}

template <int l> __device__ __forceinline__ void layer_body(LAS unsigned char* lds, const int G, const int vcu, const XcdBarrier& bar, const int lo, const int hi) {
    const int NGW = G * 8, NGT = G * 512; LAS int* ttab = (LAS int*)(lds + TILE_OFF);
    constexpr int P = 1 + 8 * l;

        for (int rep_ = 0; rep_ < 1 + ((l == 0) ? ((REP_MASK >> (1 + 0)) & 1) : 0); ++rep_)
        if (IN(P + 0)) {
            KA_DECL
            const float* modp = modv;
            if (l == 1) steal_convert(KA, lds, G, 3, true);
#pragma clang loop vectorize(disable) unroll(disable)
            for (int r0 = gw; r0 < TT; r0 += 2 * NGW) {
                const int r1 = r0 + NGW; const bool has1 = r1 < TT;
                f32x4 va[4], vb[4]; v2u yaa[4], yab[4], yba[4], ybb[4];
                const float* srca; const float* srcb;
                { const bool isc = r0 >= T; srca = (l == 0) ? (isc ? ctx_in + (size_t)(r0 - T) * 1024 : x_in + (size_t)r0 * 1024) : (isc ? xc + (size_t)(r0 - T) * 1024 : outp + (size_t)r0 * 1024); }
                { const int rr = has1 ? r1 : r0; const bool isc = rr >= T; srcb = (l == 0) ? (isc ? ctx_in + (size_t)(rr - T) * 1024 : x_in + (size_t)rr * 1024) : (isc ? xc + (size_t)(rr - T) * 1024 : outp + (size_t)rr * 1024); }
#pragma unroll
                for (int j = 0; j < 4; ++j) { va[j] = *(const f32x4*)(srca + 4 * lane + 256 * j); vb[j] = *(const f32x4*)(srcb + 4 * lane + 256 * j); }
                if (l == 1) {
                    const int rr = has1 ? r1 : r0;
#pragma unroll
                    for (int j = 0; j < 4; ++j) { yaa[j] = *(const v2u*)(y2 + (size_t)(2 * r0) * 1024 + 4 * lane + 256 * j); yab[j] = *(const v2u*)(y2 + (size_t)(2 * r0 + 1) * 1024 + 4 * lane + 256 * j);
                        yba[j] = *(const v2u*)(y2 + (size_t)(2 * rr) * 1024 + 4 * lane + 256 * j); ybb[j] = *(const v2u*)(y2 + (size_t)(2 * rr + 1) * 1024 + 4 * lane + 256 * j); }
                }
#pragma unroll
                for (int half = 0; half < 2; ++half) {
                    if (half == 1 && !has1) break;
                    const int r = half ? r1 : r0; f32x4 (&v)[4] = half ? vb : va; v2u (&ya)[4] = half ? yba : yaa; v2u (&yb)[4] = half ? ybb : yab;
                    const bool isc = r >= T; const int bsel = isc ? 4 : (r >> 12);
                    if (l == 1) {
                        const float* g2 = modp + bsel * 6144 + 5 * 1024; float* dst = isc ? xc + (size_t)(r - T) * 1024 : outp + (size_t)r * 1024;
#pragma unroll
                        for (int j = 0; j < 4; ++j) {
                            const f32x4 gv = *(const f32x4*)(g2 + 4 * lane + 256 * j);
                            f32x4 yy; yy[0] = bflo(ya[j].x) + bflo(yb[j].x); yy[1] = bfhi(ya[j].x) + bfhi(yb[j].x); yy[2] = bflo(ya[j].y) + bflo(yb[j].y); yy[3] = bfhi(ya[j].y) + bfhi(yb[j].y);
                            if (DBG_NO_MOE) yy = (f32x4){0.f, 0.f, 0.f, 0.f};
                            v[j] = v[j] + gv * yy; *(f32x4*)(dst + 4 * lane + 256 * j) = v[j];
                        }
                    }
                    float ss = 0.f;
#pragma unroll
                    for (int j = 0; j < 4; ++j) ss += (v[j][0] * v[j][0] + v[j][1] * v[j][1]) + (v[j][2] * v[j][2] + v[j][3] * v[j][3]);
                    const float rstd = 1.0f / sqrtf(wave_sum(ss) * (1.f / 1024.f) + 1e-6f);
                    const float* sh = modl + bsel * 6144; const float* sc = sh + 1024; const float* gn = norm1_g + l * 1024;
#pragma unroll
                    for (int j = 0; j < 4; ++j) {
                        const int c0 = 4 * lane + 256 * j; const f32x4 g = *(const f32x4*)(gn + c0), s1 = *(const f32x4*)(sc + c0), h1 = *(const f32x4*)(sh + c0);
                        const f32x4 y = (v[j] * rstd) * g * (s1 + 1.0f) + h1;
                        v2u o; o.x = pk2(y[0], y[1]); o.y = pk2(y[2], y[3]); *(v2u*)(hbuf + (size_t)r * 1024 + c0) = o;
                    }
                }
            }
        }
        SEAM(P + 0);
        for (int rep_ = 0; rep_ < 1 + ((l == 0) ? ((REP_MASK >> (1 + 1)) & 1) : 0); ++rep_)
        if (IN(P + 1)) {
            KA_DECL
            SchedPlain S{TT / 256, 6, G, vcu, 1024, (const char*)hbuf, (const char*)win_t};
            EpiG1 E{pu, qb, kall, vall, zb};
            pg8::gemm_phase<EpiG1, SchedPlain>(lds, S, E);
            if (l == 0 && !MK_SPLIT) steal_convert(KA, lds, G, 0, false);
        }
        SEAM(P + 1);
        for (int rep_ = 0; rep_ < 1 + ((l == 0) ? ((REP_MASK >> 3) & 1) : 0); ++rep_)
        if (IN(P + 2)) {
            KA_DECL
            __syncthreads();
            for (int it = vcu; it < 256; it += G) {
                const int b = it >> 6, n2 = it & 63;
                RowA ra{zb, b, n2}; EpiA ea{t2, twt, b, n2};
                slab_gemm<4, RowA, EpiA>(lds, fma, 128, ra, ea);
            }
            if (rep_ == 0)
#pragma clang loop vectorize(disable) unroll(disable)
            for (int i = gt; i < TT * 2; i += NGT) {
                const int r = i >> 1, hs = 8 + (i & 1); const bool isk = true; const bool isc = r >= T;
                bf16* p = isk ? kall + (size_t)krow_of(r) * 128 + (hs - 8) * 64 : qb + (size_t)r * 512 + hs * 64;
                float xv[64];
#pragma unroll
                for (int j = 0; j < 8; ++j) { const v4u w = *(const v4u*)(p + 8 * j); xv[8 * j] = bflo(w.x); xv[8 * j + 1] = bfhi(w.x); xv[8 * j + 2] = bflo(w.y); xv[8 * j + 3] = bfhi(w.y); xv[8 * j + 4] = bflo(w.z); xv[8 * j + 5] = bfhi(w.z); xv[8 * j + 6] = bflo(w.w); xv[8 * j + 7] = bfhi(w.w); }
                float ss = 0.f;
#pragma unroll
                for (int d = 0; d < 64; ++d) ss += xv[d] * xv[d];
                const float rstd = 1.0f / sqrtf(ss * (1.f / 64.f) + 1e-6f);
                const float* gg = (isk ? k_norm_g : q_norm_g) + l * 64;
#pragma unroll
                for (int d = 0; d < 64; ++d) { xv[d] = xv[d] * rstd * gg[d]; if ((d & 7) == 7) asm volatile("" ::: "memory"); }
                if (!isc) {
                    const float2* rp = rope + (size_t)(r & 4095) * 32;
#pragma unroll
                    for (int d = 0; d < 16; ++d) {
                        const float2 c1 = rp[d], c2 = rp[16 + d];
                        const float a = xv[d], bb = xv[16 + d], cc = xv[32 + d], dd = xv[48 + d];
                        xv[d] = a * c1.x - bb * c1.y; xv[16 + d] = bb * c1.x + a * c1.y;
                        xv[32 + d] = cc * c2.x - dd * c2.y; xv[48 + d] = dd * c2.x + cc * c2.y;
                        if ((d & 3) == 3) asm volatile("" ::: "memory");
                    }
                }
                const float sc = isk ? 1.0f : QSCALE;
#pragma unroll
                for (int j = 0; j < 8; ++j) { v4u w; w.x = pk2(xv[8 * j] * sc, xv[8 * j + 1] * sc); w.y = pk2(xv[8 * j + 2] * sc, xv[8 * j + 3] * sc); w.z = pk2(xv[8 * j + 4] * sc, xv[8 * j + 5] * sc); w.w = pk2(xv[8 * j + 6] * sc, xv[8 * j + 7] * sc); *(v4u*)(p + 8 * j) = w; }
            }
            const int prow = (l == 0) ? TT : T; const int nrb = prow >> 3;
#pragma clang loop vectorize(disable) unroll(disable)
            for (int i = gt; i < 32 * nrb; i += NGT) {
                const int ck8 = i & 7, rb = (i >> 3) % nrb, g = (i >> 3) / nrb;
                const int r0 = rb * 8; const bool isc = r0 >= T;
                const int nseq = isc ? LCTX : NSEQ; const int rbase = isc ? T + ((r0 - T) & ~255) : (r0 & ~4095); const int n0 = r0 - rbase;
                const int hw = 1 << g; const int col = g * 64 + ck8 * 8;
                const bf16* up = pu + (size_t)rbase * 256 + col;
                float sm[8] = {0.f, 0.f, 0.f, 0.f, 0.f, 0.f, 0.f, 0.f};
#define POOL_ACC(W, SGN) do { sm[0] += SGN bflo(W.x); sm[1] += SGN bfhi(W.x); sm[2] += SGN bflo(W.y); sm[3] += SGN bfhi(W.y); sm[4] += SGN bflo(W.z); sm[5] += SGN bfhi(W.z); sm[6] += SGN bflo(W.w); sm[7] += SGN bfhi(W.w); } while (0)
                for (int tpos = n0 - hw; tpos < n0 + hw; ++tpos) if (tpos >= 0 && tpos < nseq) { const v4u w = *(const v4u*)(up + (size_t)tpos * 256); POOL_ACC(w, +); }
#pragma unroll
                for (int k = 0; k < 8; ++k) {
                    const int n = n0 + k; int lo_ = n - hw; lo_ = lo_ < 0 ? 0 : lo_; int hi_ = n + hw - 1; hi_ = hi_ > nseq - 1 ? nseq - 1 : hi_;
                    const v4u w = *(const v4u*)(up + (size_t)n * 256); const float ic = 1.0f / (float)(hi_ - lo_ + 1);
                    v4u o; o.x = pk2(sm[0] * ic - bflo(w.x), sm[1] * ic - bfhi(w.x)); o.y = pk2(sm[2] * ic - bflo(w.y), sm[3] * ic - bfhi(w.y));
                    o.z = pk2(sm[4] * ic - bflo(w.z), sm[5] * ic - bfhi(w.z)); o.w = pk2(sm[6] * ic - bflo(w.w), sm[7] * ic - bfhi(w.w));
                    if (DBG_NO_POOL) o = (v4u){0u, 0u, 0u, 0u};
                    *(v4u*)(mrg + (size_t)(rbase + n) * 1024 + col) = o;
                    if (k < 7) { const int tin = n + hw, tout = n - hw;
                        if (tin < nseq) { const v4u wi = *(const v4u*)(up + (size_t)tin * 256); POOL_ACC(wi, +); }
                        if (tout >= 0) { const v4u wo = *(const v4u*)(up + (size_t)tout * 256); POOL_ACC(wo, -); } }
                }
#undef POOL_ACC
            }
        }
        SEAM(P + 2);
        for (int rep_ = 0; rep_ < 1 + ((l == 0) ? ((REP_MASK >> (1 + 3)) & 1) : 0); ++rep_)
        if (IN(P + 3)) {
            KA_DECL
            const int n_att = 512 + (l == 0 ? 32 : 0), n_fb = 256, n_cf = (l == 0 ? 32 : 0);
            for (int it = vcu; it < n_att + n_fb + n_cf; it += G) {
#ifndef NO_ATT
                if (it < n_att) { if (rep_ == 0 || ((REP_MASK >> 9) & 1)) {
                    const bool cu = it >= 512; const int uidx = cu ? it - 512 : it;
                    const int b = cu ? (uidx >> 3) : (uidx >> 7), kvh = cu ? ((uidx >> 2) & 1) : ((uidx >> 6) & 1), pb = cu ? (uidx & 3) : (uidx & 63);
                    const int p0 = pb * 64; const int qrow0 = cu ? T + b * 256 + p0 : b * 4096 + p0;
                    const attn_body::bf16* Qu = (const attn_body::bf16*)(qb + (size_t)qrow0 * 512 + kvh * 256);
                    const attn_body::bf16* Kh = (const attn_body::bf16*)(kall + (size_t)b * KVROWS * 128 + kvh * 64);
                    const attn_body::bf16* Vh = (const attn_body::bf16*)(vall + (size_t)b * KVROWS * 128 + kvh * 64);
                    attn_body::bf16* Ou = (attn_body::bf16*)(mrg + (size_t)qrow0 * 1024 + 256 + kvh * 256);
                    attn_body::attn_unit<8>(Qu, Kh, Vh, Ou, p0, cu ? 4 : 10, attn_sink + l * 8 + kvh * 4, q_norm_g + l * 64, cu ? (const float2*)nullptr : (const float2*)rope, (char*)lds);
                    __syncthreads(); }
                } else
#endif
#ifndef NO_FB
                if (it < n_att + n_fb) { if (rep_ == 0 || ((REP_MASK >> 10) & 1)) {
                    const int u2 = it - n_att; const int b = u2 >> 6, k1 = u2 & 63;
                    RowB rb{t2, b, k1}; EpiB eb{mrg, b, k1};
                    slab_gemm<2, RowB, EpiB>(lds, fmb, 128, rb, eb); }
                } else
#endif
                {
#ifndef NO_CF
                    if (rep_ == 0 || ((REP_MASK >> 11) & 1)) {
                    const int b = (it - n_att - n_fb) >> 3, mt0 = (it - n_att - n_fb) & 7;
                    RowC rc{zb, b}; EpiC ec{mrg, b, mt0};
                    slab_gemm<1, RowC, EpiC>(lds, fmc + (size_t)mt0 * 32 * 512, 512, rc, ec); }
#endif
                }
            }
        }
        SEAM(P + 3);
        for (int rep_ = 0; rep_ < 1 + ((l == 0) ? ((REP_MASK >> (1 + 4)) & 1) : 0); ++rep_)
        if (IN(P + 4)) {
            KA_DECL
            SchedPlain S{(l == 0 ? TT : T) / 256, 4, G, vcu, 1024, (const char*)mrg, (const char*)wout_t};
            EpiG2 E{(l == 0) ? x_in : outp, ctx_in, outp, xc, modl};
            pg8::gemm_phase<EpiG2, SchedPlain>(lds, S, E);
            if (l == 0 && !MK_SPLIT) steal_convert(KA, lds, G, 1, false);
        }
        SEAM(P + 4);
        for (int rep_ = 0; rep_ < 1 + ((l == 0) ? ((REP_MASK >> 6) & 1) : 0); ++rep_)
        if (IN(P + 5)) {
            KA_DECL
            __syncthreads();
            LAS float* rw = (LAS float*)lds;
            LAS int* lcnt = (LAS int*)(lds + 81920);
            LAS unsigned* lent = (LAS unsigned*)(lds + 81920 + 256);
            LAS unsigned* lrank = lent + 1024;
            for (int i = tid; i < 1024 * 20; i += 512) { const int d = i / 20, j = i % 20;
                rw[((((j >> 2) * 4 + (d >> 8)) * 4 + (d & 3)) * 64 + ((d & 255) >> 2)) * 4 + (j & 3)] = (j < 4) ? w_grp[(size_t)l * 4096 + d * 4 + j] : w_rtr[(size_t)l * 16384 + d * 16 + (j - 4)]; }
            if (tid < 33) lcnt[tid] = 0;
            __syncthreads();
            const int nrows = (l == 0) ? TT : T; const int ngrp = nrows >> 2;
#pragma clang loop vectorize(disable) unroll(disable)
            for (int q = gw; q < ngrp; q += NGW) {
                const int rb4 = 4 * q; const bool isc = rb4 >= T; const int bsel = isc ? 4 : (rb4 >> 12);
                const float* src = isc ? xc + (size_t)(rb4 - T) * 1024 : outp + (size_t)rb4 * 1024;
                f32x4 v[4][4];
#pragma unroll
                for (int tk = 0; tk < 4; ++tk)
#pragma unroll
                    for (int j = 0; j < 4; ++j) v[tk][j] = *(const f32x4*)(src + (size_t)tk * 1024 + 4 * lane + 256 * j);
                float rstd[4];
#pragma unroll
                for (int tk = 0; tk < 4; ++tk) { float ss = 0.f;
#pragma unroll
                    for (int j = 0; j < 4; ++j) ss += (v[tk][j][0] * v[tk][j][0] + v[tk][j][1] * v[tk][j][1]) + (v[tk][j][2] * v[tk][j][2] + v[tk][j][3] * v[tk][j][3]);
                    rstd[tk] = 1.0f / sqrtf(wave_sum(ss) * (1.f / 1024.f) + 1e-6f); }
                const float* sh = modl + bsel * 6144 + 3 * 1024; const float* sc = sh + 1024; const float* gn = norm2_g + l * 1024;
                float lg[4][20];
#pragma unroll
                for (int tk = 0; tk < 4; ++tk)
#pragma unroll
                    for (int j = 0; j < 20; ++j) lg[tk][j] = 0.f;
#pragma unroll
                for (int j = 0; j < 4; ++j) {
                    const int c0 = 4 * lane + 256 * j; const f32x4 g = *(const f32x4*)(gn + c0), s1 = *(const f32x4*)(sc + c0), h1 = *(const f32x4*)(sh + c0);
                    f32x4 y[4];
#pragma unroll
                    for (int tk = 0; tk < 4; ++tk) { y[tk] = (v[tk][j] * rstd[tk]) * g * (s1 + 1.0f) + h1;
                        v2u o; o.x = pk2(y[tk][0], y[tk][1]); o.y = pk2(y[tk][2], y[tk][3]); *(v2u*)(hbuf + (size_t)(rb4 + tk) * 1024 + c0) = o; }
#pragma unroll
                    for (int e = 0; e < 4; ++e) {
#pragma unroll
                        for (int q5 = 0; q5 < 5; ++q5) { const f32x4 wv = *(const LAS f32x4*)(rw + (((q5 * 4 + j) * 4 + e) * 64 + lane) * 4);
#pragma unroll
                            for (int tk = 0; tk < 4; ++tk) { lg[tk][4 * q5] += y[tk][e] * wv[0]; lg[tk][4 * q5 + 1] += y[tk][e] * wv[1]; lg[tk][4 * q5 + 2] += y[tk][e] * wv[2]; lg[tk][4 * q5 + 3] += y[tk][e] * wv[3]; } }
                        __builtin_amdgcn_sched_barrier(0); }
                }
                float l2[20];
#pragma unroll
                for (int j = 0; j < 20; ++j) {
                    const float a0 = swap32_sum(lg[0][j], lg[2][j]);
                    const float a1 = swap32_sum(lg[1][j], lg[3][j]);
                    float t = swap16_sum(a0, a1);
                    t += dppf<0x128, 0xf>(t); t += dppf<0x124, 0xf>(t); t += dppf<0x122, 0xf>(t); t += dppf<0x121, 0xf>(t);
                    l2[j] = t;
                }
                const int tk = lane >> 4; const int r = rb4 + tk;
                float gl[4]; float gm = -1e30f;
#pragma unroll
                for (int j = 0; j < 4; ++j) { gl[j] = l2[j] + b_grp[l * 4 + j]; gm = fmaxf(gm, gl[j]); }
                float gs = 0.f; int gi = 0; float gb = -1e30f;
#pragma unroll
                for (int j = 0; j < 4; ++j) { const float e = expf(gl[j] - gm); gs += e; if (gl[j] > gb) { gb = gl[j]; gi = j; } }
                const float pg = expf(gb - gm) / gs;
                float el[4]; float em = -1e30f;
#pragma unroll
                for (int j = 0; j < 4; ++j) { float t_ = 0.f;
#pragma unroll
                    for (int g4 = 0; g4 < 4; ++g4) t_ = (gi == g4) ? (l2[4 + g4 * 4 + j] + b_rtr[l * 16 + g4 * 4 + j]) : t_;
                    el[j] = t_; em = fmaxf(em, t_); }
                float pe[4];
#pragma unroll
                for (int j = 0; j < 4; ++j) pe[j] = expf(el[j] - em);
                int i0 = 0; float b0 = -1.f;
#pragma unroll
                for (int j = 0; j < 4; ++j) if (pe[j] > b0) { b0 = pe[j]; i0 = j; }
                int i1 = 0; float b1 = -1.f;
#pragma unroll
                for (int j = 0; j < 4; ++j) if (j != i0 && pe[j] > b1) { b1 = pe[j]; i1 = j; }
                const float wsum = b0 + b1; const float w0 = pg * b0 / wsum, w1 = pg * b1 / wsum;
                if ((lane & 15) == 0 && rep_ == 0) {
                    wts[2 * r] = w0; wts[2 * r + 1] = w1;
                    const int e0 = gi * 4 + i0, e1 = gi * 4 + i1;
                    const int s0 = __hip_atomic_fetch_add((LAS int*)(lcnt + 16 + 16), 1, __ATOMIC_RELAXED, __HIP_MEMORY_SCOPE_WORKGROUP);
                    const int k0 = __hip_atomic_fetch_add((LAS int*)(lcnt + e0), 1, __ATOMIC_RELAXED, __HIP_MEMORY_SCOPE_WORKGROUP);
                    const int k1 = __hip_atomic_fetch_add((LAS int*)(lcnt + e1), 1, __ATOMIC_RELAXED, __HIP_MEMORY_SCOPE_WORKGROUP);
                    lent[2 * s0] = ((unsigned)(2 * r) << 4) | (unsigned)e0; lrank[2 * s0] = (unsigned)k0;
                    lent[2 * s0 + 1] = ((unsigned)(2 * r + 1) << 4) | (unsigned)e1; lrank[2 * s0 + 1] = (unsigned)k1;
                }
            }
            __syncthreads();
            if (tid < 16 && rep_ == 0) { const int c = lcnt[tid]; lcnt[16 + tid] = c ? (int)__hip_atomic_fetch_add((unsigned*)(ctl + CW_CNT + (l * 16 + tid) * 64), (unsigned)c, RLX_AGENT) : 0; }
            __syncthreads();
            const int ntot = rep_ == 0 ? 2 * lcnt[32] : 0;
            for (int i = tid; i < ntot; i += 512) { const unsigned en = lent[i]; const int e = en & 15; list[(size_t)e * TT + lcnt[16 + e] + lrank[i]] = en >> 4; }
            __syncthreads();
        }
        SEAM(P + 5);
        if (IN(P + 6) || IN(P + 7)) {
            KA_DECL
            __syncthreads();
            if (tid == 0) { int acc_ = 0; for (int e = 0; e < 16; ++e) { const int c = (int)__hip_atomic_load((unsigned*)(ctl + CW_CNT + (l * 16 + e) * 64), RLX_AGENT); ttab[e] = acc_; ttab[17 + e] = c; acc_ += (c + 255) >> 8; } ttab[16] = acc_; }
            __syncthreads();
        }
        if (DBG_NAIVE_MOE && IN(P + 6)) {
            KA_DECL
            const int nrows = (l == 0) ? TT : T; LAS float* hs = (LAS float*)lds; LAS float* as = hs + 1024;
            const int* eidg = (const int*)(ws + O_EID);
            LAS float* lgs = as + 512; LAS float* rt = lgs + 32;
            for (int r = vcu; r < nrows; r += G) {
                __syncthreads();
                for (int i = tid; i < 1024; i += 512) hs[i] = bf2f(hbuf[(size_t)r * 1024 + i]);
                __syncthreads();
                if (tid < 20) { float a = 0.f; for (int k = 0; k < 1024; ++k) a += hs[k] * ((tid < 4) ? w_grp[(size_t)l * 4096 + k * 4 + tid] : w_rtr[(size_t)l * 16384 + k * 16 + (tid - 4)]);
                    lgs[tid] = a + ((tid < 4) ? b_grp[l * 4 + tid] : b_rtr[l * 16 + tid - 4]); }
                __syncthreads();
                if (tid == 0) { int gi = 0; for (int j = 1; j < 4; ++j) if (lgs[j] > lgs[gi]) gi = j; float gs = 0.f; for (int j = 0; j < 4; ++j) gs += expf(lgs[j] - lgs[gi]); const float pg = 1.f / gs;
                    int i0 = 0; for (int j = 1; j < 4; ++j) if (lgs[4 + gi * 4 + j] > lgs[4 + gi * 4 + i0]) i0 = j; int i1 = -1; for (int j = 0; j < 4; ++j) if (j != i0 && (i1 < 0 || lgs[4 + gi * 4 + j] > lgs[4 + gi * 4 + i1])) i1 = j;
                    const float p0 = 1.f, p1 = expf(lgs[4 + gi * 4 + i1] - lgs[4 + gi * 4 + i0]); rt[0] = (float)(gi * 4 + i0); rt[1] = (float)(gi * 4 + i1); rt[2] = pg * p0 / (p0 + p1); rt[3] = pg * p1 / (p0 + p1); }
                __syncthreads();
                for (int sl = 0; sl < 2; ++sl) {
                    const int e = (DBG_NAIVE_ROUTE & 1) ? (int)rt[sl] : eidg[2 * r + sl]; const float w = (DBG_NAIVE_ROUTE & 2) ? rt[2 + sl] : wts[2 * r + sl];
                    __syncthreads();
                    const float* Wg = w_gate + (size_t)(l * 16 + e) * 1024 * 512 + tid; const float* Wu = w_up + (size_t)(l * 16 + e) * 1024 * 512 + tid;
                    float g = 0.f, u = 0.f;
#pragma unroll 8
                    for (int k = 0; k < 1024; ++k) { g += hs[k] * Wg[(size_t)k * 512]; u += hs[k] * Wu[(size_t)k * 512]; }
                    as[tid] = g / (1.f + expf(-g)) * u;
                    __syncthreads();
                    const float* Wd = w_down + (size_t)(l * 16 + e) * 512 * 1024 + tid;
                    float y0 = 0.f, y1 = 0.f;
#pragma unroll 8
                    for (int j = 0; j < 512; ++j) { y0 += as[j] * Wd[(size_t)j * 1024]; y1 += as[j] * Wd[(size_t)j * 1024 + 512]; }
                    y2[(size_t)(2 * r + sl) * 1024 + tid] = (bf16)f2bf(y0 * w); y2[(size_t)(2 * r + sl) * 1024 + 512 + tid] = (bf16)f2bf(y1 * w);
                }
            }
        }
        if (!DBG_NAIVE_MOE && IN(P + 6)) {
            KA_DECL
            unsigned* rdy = (unsigned*)(ctl + CW_RDY + l * 4096);
            SchedMoe S{G, vcu, ttab[16], (const char*)hbuf, (const char*)act, (const char*)wgu_t, (const char*)wd_t, list, ttab, rdy, (unsigned*)(ctl + CW_TMO)};
            EpiMoe E{EpiG3{act, rdy}, EpiG4{y2, list, wts, ttab}};
            pg8::gemm_phase<EpiMoe, SchedMoe>(lds, S, E);
            if (l == 0 && !MK_SPLIT) steal_convert(KA, lds, G, 2, false);
        }
        SEAM(P + 7);
    }

__global__ void __launch_bounds__(512, 2) fwd_kernel(Args args) {
    extern __shared__ __attribute__((aligned(16))) unsigned char lds_raw[];
    LAS unsigned char* lds = (LAS unsigned char*)lds_raw;
    const int tid = threadIdx.x, lane = tid & 63, wave = __builtin_amdgcn_readfirstlane(tid >> 6);
    const int G = gridDim.x; const int bx = blockIdx.x; const int vcu = (G % 8 == 0) ? (bx % 8) * (G / 8) + bx / 8 : bx;
    volatile LAS unsigned* MISC = (volatile LAS unsigned*)(lds + MISC_OFF);
    LAS float* trig = (LAS float*)(lds + TRIG_OFF);
    LAS int* ttab = (LAS int*)(lds + TILE_OFF);
    for (int u = tid; u < (LDS_BYTES - LDSCTL_OFF) / 4; u += 512) ((LAS unsigned*)(lds + LDSCTL_OFF))[u] = 0u;
    __syncthreads();
    if (tid < 64) { float s, c; sincospif((float)tid / 32.f, &s, &c); trig[tid] = c; trig[64 + tid] = s; }
    __syncthreads();
    XcdBarrier bar; bar.bar = nullptr; bar.x = 0; bar.st = nullptr;
    if (!MK_SPLIT) { KA_DECL bar = xcd_barrier_post((unsigned*)(ctl + CW_BAR), MISC + 8); }
    const int lo = args.ph_lo, hi = args.ph_hi;
    const int NGW = G * 8, NGT = G * 512;

    for (int rep_ = 0; rep_ < 1 + ((REP_MASK >> 0) & 1); ++rep_)
    if (IN(0)) {
        KA_DECL
        __syncthreads();
        if (rep_ == 0 || ((REP_MASK >> 13) & 1)) {
            LAS float* sl = (LAS float*)lds;
            bool have = false;
            for (int it = vcu; it < 192; it += G) {
                if (!have) {
                    for (int i = tid; i < 5120; i += 512) { const int r = i >> 10, k = i & 1023; const float v = (r < 4) ? c_in[r * 1024 + k] : cctx_in[k]; sl[i] = v / (1.f + expf(-v)); }
                    __syncthreads(); have = true;
                }
                const int l = it / 96, cb = it % 96;
                const int r4 = lane >> 4, cq = lane & 15; const int k0 = wave * 128;
                const float* W = w_mod + (size_t)l * 1024 * 6144 + (size_t)(k0 + r4) * 6144 + cb * 64 + 4 * cq;
                f32x4 a0 = {0.f, 0.f, 0.f, 0.f}, a1 = a0, a2 = a0, a3 = a0, a4 = a0;
#pragma unroll 8
                for (int k = 0; k < 32; ++k) { const f32x4 wv = *(const f32x4*)(W + (size_t)(4 * k) * 6144); const int kk = k0 + 4 * k + r4;
                    a0 += wv * sl[kk]; a1 += wv * sl[1024 + kk]; a2 += wv * sl[2048 + kk]; a3 += wv * sl[3072 + kk]; a4 += wv * sl[4096 + kk]; }
                LAS float* part = sl + 5120;
                { LAS float* pp = part + (wave * 4 + r4) * 320 + 4 * cq;
                  *(LAS f32x4*)(pp) = a0; *(LAS f32x4*)(pp + 64) = a1; *(LAS f32x4*)(pp + 128) = a2; *(LAS f32x4*)(pp + 192) = a3; *(LAS f32x4*)(pp + 256) = a4; }
                __syncthreads();
                if (tid < 320) { const int r = tid >> 6, n = tid & 63; float sacc = b_mod[l * 6144 + cb * 64 + n];
#pragma unroll 8
                    for (int w = 0; w < 32; ++w) sacc += part[w * 320 + r * 64 + n];
                    modv[(size_t)(l * 5 + r) * 6144 + cb * 64 + n] = sacc; }
                __syncthreads();
            }
            __syncthreads();
        }
        if (rep_ == 0 || ((REP_MASK >> 14) & 1)) {
#pragma clang loop vectorize(disable) unroll(disable)
        for (int i = gt; i < 4096 * 32; i += NGT) {
            const int n = i >> 5, j = i & 31; const int jj = j & 15;
            const float inv = 1.0f / powf(10000.0f, (float)(2 * jj) / 32.0f);
            const float pos = (j < 16) ? (float)(n >> 6) : (float)(n & 63);
            const float ang = pos * inv; rope[i] = make_float2(cosf(ang), sinf(ang));
        }
#pragma clang loop vectorize(disable) unroll(disable)
        for (int i = gt; i < 4096; i += NGT) { float s, c; sincospif((float)i / 2048.f, &s, &c); twt[i] = make_float2(c, s); }
#pragma clang loop vectorize(disable) unroll(disable)
        for (int i = gt; i < 128 * 128; i += NGT) {
            const int m = i >> 7, k = i & 127; const int ri = m >> 6, k1 = m & 63, part = k >> 6, n1 = k & 63;
            float s, c; sincospif((float)((n1 * k1) & 63) / 32.f, &s, &c);
            float v; if (ri == 0) v = (part == 0) ? c : -s; else v = (part == 0) ? -s : -c;
            fma[i] = (bf16)f2bf(v);
        }
#pragma clang loop vectorize(disable) unroll(disable)
        for (int i = gt; i < 64 * 128; i += NGT) {
            const int k2 = i >> 7, k = i & 127; const int ri = k >> 6, n2 = k & 63;
            float s, c; sincospif((float)((n2 * k2) & 63) / 32.f, &s, &c);
            fmb[i] = (bf16)f2bf((ri == 0 ? c : s) * (1.f / 512.f));
        }
#pragma clang loop vectorize(disable) unroll(disable)
        for (int i = gt; i < 256 * 512; i += NGT) {
            const int kk = i >> 9, k = i & 511; const int part = k >> 8, n = k & 255;
            float s, c; sincospif((float)((n * kk) & 255) / 128.f, &s, &c);
            fmc[i] = (bf16)f2bf((part == 0 ? c : -s) * (1.f / 128.f));
        }
        }
        if (rep_ == 0 || ((REP_MASK >> 15) & 1)) {
            LAS float* Al = (LAS float*)lds;
            LAS float* Wl = Al + 4096;
            LAS float* Xl = Wl + 4096;
            for (int it = vcu; it < 256; it += G) {
                const int combo = it & 15, jb = it >> 4; const int l = combo >> 3, g = (combo >> 1) & 3, which = combo & 1;
                const float* Wg = four_w + (size_t)(l * 4 + g) * 4096; const LAS float* tb = trig + which * 64;
                const float* wi = w_in + (size_t)l * 1024 * 1280 + (size_t)(jb * 64) * 1280 + 1024 + g * 64;
                __syncthreads();
#pragma unroll
                for (int i = 0; i < 2; ++i) { const int idx = tid + 512 * i; *(LAS f32x4*)(Wl + 4 * idx) = *(const f32x4*)(Wg + 4 * idx); const int j = idx >> 4, c4 = idx & 15; *(LAS f32x4*)(Xl + j * 64 + 4 * c4) = *(const f32x4*)(wi + (size_t)j * 1280 + 4 * c4); }
                __syncthreads();
                { const int d = tid & 63, c0 = tid >> 6;
#pragma unroll 2
                  for (int i = 0; i < 8; ++i) { const int c = c0 + 8 * i; float a = 0.f;
#pragma unroll 16
                      for (int m = 0; m < 64; ++m) a += tb[(m * c) & 63] * Wl[m * 64 + d];
                      Al[c * 64 + d] = a; } }
                __syncthreads();
                { const int d = tid & 63, jl = 8 * (tid >> 6);
                  float o[8] = {0.f, 0.f, 0.f, 0.f, 0.f, 0.f, 0.f, 0.f};
#pragma unroll 4
                  for (int c = 0; c < 64; ++c) { const float av = Al[c * 64 + d];
#pragma unroll
                      for (int i = 0; i < 8; ++i) o[i] += Xl[(jl + i) * 64 + c] * av; }
                  v4u w; w.x = pk2(o[0], o[1]); w.y = pk2(o[2], o[3]); w.z = pk2(o[4], o[5]); w.w = pk2(o[6], o[7]);
                  *(v4u*)((bf16*)(ws + O_WIN + l * SZ_WIN1) + (size_t)(1024 + which * 256 + g * 64 + d) * 1024 + jb * 64 + jl) = w; }
            }
            for (int it = vcu; it < 256; it += G) {
                const int combo = it & 7, nb = it >> 3; const int l = combo >> 2, g = combo & 3, n0 = nb * 32;
                const float* pwg = pool_w + (size_t)(l * 4 + g) * 4096;
                __syncthreads();
#pragma unroll
                for (int i = 0; i < 2; ++i) { const int idx = tid + 512 * i; *(LAS f32x4*)(Wl + 4 * idx) = *(const f32x4*)(pwg + 4 * idx); }
                for (int i = tid; i < 2048; i += 512) { const int d = i >> 5, n = i & 31; Xl[i] = pool_scale[l * 256 + g * 64 + d] * w_out[(size_t)l * 1024 * 1024 + (size_t)(g * 64 + d) * 1024 + n0 + n]; }
                __syncthreads();
                { const int n = tid & 31, c0 = 4 * (tid >> 5);
                  float o[4] = {0.f, 0.f, 0.f, 0.f};
#pragma unroll 8
                  for (int d = 0; d < 64; ++d) { const float sv = Xl[d * 32 + n];
#pragma unroll
                      for (int i = 0; i < 4; ++i) o[i] += Wl[(c0 + i) * 64 + d] * sv; }
                  v2u w; w.x = pk2(o[0], o[1]); w.y = pk2(o[2], o[3]);
                  *(v2u*)((bf16*)(ws + O_WOUT + l * SZ_WOUT1) + (size_t)(n0 + n) * 1024 + g * 64 + c0) = w; }
            }
            __syncthreads();
        }
        if (rep_ == 0 || ((REP_MASK >> 16) & 1)) {
            LAS bf16* scr = (LAS bf16*)(lds + wave * 16384);
#pragma clang loop vectorize(disable) unroll(disable)
            for (int it0 = gw; it0 < CV_L; it0 += NGW) conv_item(KA, 0, it0, scr, lane);
        }
    }
    SEAM(0);
    if ((REP_MASK >> 12) & 1) { for (int k_ = 0; k_ < 4; ++k_) xcd_barrier(bar); }

    layer_body<0>(lds, G, vcu, bar, lo, hi);
    layer_body<1>(lds, G, vcu, bar, lo, hi);
    if (IN(17)) {
        KA_DECL
        const float* modp = modv + (size_t)5 * 6144;
#pragma clang loop vectorize(disable) unroll(disable)
        for (int r = gw; r < T; r += NGW) {
            const float* g2 = modp + (r >> 12) * 6144 + 5 * 1024; float* dst = outp + (size_t)r * 1024;
#pragma unroll
            for (int j = 0; j < 4; ++j) {
                const int c0 = 4 * lane + 256 * j; f32x4 v = *(const f32x4*)(dst + c0);
                const v2u ya = *(const v2u*)(y2 + (size_t)(2 * r) * 1024 + c0), yb = *(const v2u*)(y2 + (size_t)(2 * r + 1) * 1024 + c0);
                const f32x4 gv = *(const f32x4*)(g2 + c0);
                f32x4 yy; yy[0] = bflo(ya.x) + bflo(yb.x); yy[1] = bfhi(ya.x) + bfhi(yb.x); yy[2] = bflo(ya.y) + bflo(yb.y); yy[3] = bfhi(ya.y) + bfhi(yb.y);
                if (DBG_NO_MOE) yy = (f32x4){0.f, 0.f, 0.f, 0.f};
                *(f32x4*)(dst + c0) = v + gv * yy;
            }
        }
    }
#undef IN
#undef SEAM
}

#undef KA_DECL
#undef ws
#undef ctl
#undef x_in
#undef c_in
#undef ctx_in
#undef cctx_in
#undef w_mod
#undef b_mod
#undef norm1_g
#undef w_in
#undef q_norm_g
#undef k_norm_g
#undef attn_sink
#undef pool_w
#undef pool_scale
#undef four_w
#undef w_out
#undef norm2_g
#undef w_grp
#undef b_grp
#undef w_rtr
#undef b_rtr
#undef w_gate
#undef w_up
#undef w_down
#undef outp
#undef modv
#undef rope
#undef twt
#undef fma
#undef fmb
#undef fmc
#undef hbuf
#undef kall
#undef vall
#undef xc
#undef list
#undef wts
#undef act
#undef t2
#undef mrg
#undef qb
#undef pu
#undef zb
#undef y2
#undef modl
#undef win_t
#undef wout_t
#undef wgu_t
#undef wd_t
extern "C" void kernel_launch(void* const* d_in, const int* in_sizes, int n_in, void* d_out, int out_size, void* d_ws, size_t ws_size, hipStream_t stream) {
    static int grid = 0;
    if (grid == 0) {
        if (n_in != 23 || out_size != T * DM || ws_size < WS_END) { fprintf(stderr, "kernel_launch: unexpected shapes (n_in %d out %d ws %zu need %zu)\n", n_in, out_size, ws_size, (size_t)WS_END); grid = -1; return; }
        int dev = 0, cus = 0;
        if (hipGetDevice(&dev) != hipSuccess || hipDeviceGetAttribute(&cus, hipDeviceAttributeMultiprocessorCount, dev) != hipSuccess) { grid = -1; return; }
        if (hipFuncSetAttribute((const void*)fwd_kernel, hipFuncAttributeMaxDynamicSharedMemorySize, LDS_BYTES) != hipSuccess) { fprintf(stderr, "kernel_launch: hipFuncSetAttribute failed\n"); grid = -1; return; }
        (void)hipGetLastError();
        grid = cus;
    }
    if (grid < 0) return;
    (void)hipMemsetAsync((char*)d_ws + O_CTL, 0, SZ_CTL, stream);
    Args a{};
    for (int i = 0; i < 23; ++i) a.in[i] = (const float*)d_in[i];
    a.out = (float*)d_out; a.ws = (unsigned char*)d_ws;
#if MK_SPLIT
    for (int p = 0; p < NPHASE; ++p) { a.ph_lo = p; a.ph_hi = p + 1; hipLaunchKernelGGL(fwd_kernel, dim3(grid), dim3(512), LDS_BYTES, stream, a); }
#else
    a.ph_lo = 0; a.ph_hi = NPHASE;
    hipLaunchKernelGGL(fwd_kernel, dim3(grid), dim3(512), LDS_BYTES, stream, a);
#endif
}
```

```cpp
#include <hip/hip_runtime.h>
#include <cstdio>
#include <cstdint>

#define DBG_NO_FOUR 0
#define DBG_NO_POOL 0
#define DBG_NO_ATT 0
#define DBG_NO_MOE 0
#define DBG_MOE_SCALE 1.0f
#define DBG_NAIVE_MOE 0
#define REP_MASK 0x0
#define DBG_NAIVE_ROUTE 0
#define LAS __attribute__((address_space(3)))
#define GAS __attribute__((address_space(1)))
typedef unsigned short bf16;
typedef short bf16x8 __attribute__((ext_vector_type(8)));
typedef float f32x4 __attribute__((ext_vector_type(4)));
typedef float f32x16 __attribute__((ext_vector_type(16)));
typedef unsigned v4u __attribute__((ext_vector_type(4)));
typedef unsigned v2u __attribute__((ext_vector_type(2)));
typedef GAS unsigned gu32;

#ifndef MK_SPLIT
#define MK_SPLIT 0
#endif

constexpr int NB = 4, NSEQ = 4096, DM = 1024, LCTX = 256, DEPTH = 2;
constexpr int T = NB * NSEQ, TC = NB * LCTX, TT = T + TC;
constexpr int KVROWS = LCTX + NSEQ;
constexpr int NEXP = 16, DEXP = 512;
constexpr int NPHASE = 18;
constexpr int MAXTILES = 152;
constexpr float QSCALE = 0.125f * 1.4426950408889634f;
constexpr float LOG2E = 1.4426950408889634f;

constexpr size_t al256(size_t x) { return (x + 255) & ~(size_t)255; }
constexpr size_t O_CTL = 0, SZ_CTL = 1u << 20;
constexpr size_t O_MOD = O_CTL + SZ_CTL, SZ_MOD = (size_t)2 * 5 * 6144 * 4;
constexpr size_t O_ROPE = al256(O_MOD + SZ_MOD), SZ_ROPE = (size_t)4096 * 32 * 8;
constexpr size_t O_TW = al256(O_ROPE + SZ_ROPE), SZ_TW = 4096 * 8;
constexpr size_t O_FMA = al256(O_TW + SZ_TW), SZ_FMA = 128 * 128 * 2;
constexpr size_t O_FMB = al256(O_FMA + SZ_FMA), SZ_FMB = 64 * 128 * 2;
constexpr size_t O_FMC = al256(O_FMB + SZ_FMB), SZ_FMC = 256 * 512 * 2;
constexpr size_t O_WIN = al256(O_FMC + SZ_FMC), SZ_WIN1 = (size_t)1536 * 1024 * 2;
constexpr size_t O_WOUT = al256(O_WIN + 2 * SZ_WIN1), SZ_WOUT1 = (size_t)1024 * 1024 * 2;
constexpr size_t O_WGU = al256(O_WOUT + 2 * SZ_WOUT1), SZ_WGU1 = (size_t)16 * 1024 * 1024 * 2;
constexpr size_t O_WD = al256(O_WGU + 2 * SZ_WGU1), SZ_WD1 = (size_t)16 * 1024 * 512 * 2;
constexpr size_t O_H = al256(O_WD + 2 * SZ_WD1), SZ_H = (size_t)TT * 1024 * 2;
constexpr size_t O_KALL = al256(O_H + SZ_H), SZ_KV = (size_t)NB * KVROWS * 128 * 2;
constexpr size_t O_VALL = al256(O_KALL + SZ_KV);
constexpr size_t O_XC = al256(O_VALL + SZ_KV), SZ_XC = (size_t)TC * 1024 * 4;
constexpr size_t O_LIST = al256(O_XC + SZ_XC), SZ_LIST = (size_t)NEXP * TT * 4;
constexpr size_t O_WTS = al256(O_LIST + SZ_LIST), SZ_WTS = (size_t)TT * 2 * 4;
constexpr size_t O_EID = al256(O_WTS + SZ_WTS), SZ_EID = (size_t)TT * 2 * 4;
constexpr size_t O_ACT = al256(O_EID + SZ_EID), SZ_ACT = (size_t)MAXTILES * 256 * 512 * 2;
constexpr size_t O_T2 = O_ACT, SZ_T2 = (size_t)NB * 64 * 64 * 2 * 256 * 2;
constexpr size_t O_MRG = al256(O_ACT + SZ_ACT), SZ_MRG = (size_t)TT * 1024 * 2;
constexpr size_t O_Q = al256(O_MRG + SZ_MRG), SZ_Q = (size_t)TT * 512 * 2;
constexpr size_t O_PU = al256(O_Q + SZ_Q), SZ_PU = (size_t)TT * 256 * 2;
constexpr size_t O_Z = al256(O_PU + SZ_PU), SZ_Z = (size_t)TT * 512 * 2;
constexpr size_t O_Y2 = O_MRG, SZ_Y2 = (size_t)TT * 2 * 1024 * 2;
constexpr size_t WS_END = al256(O_Z + SZ_Z);
static_assert(SZ_T2 <= SZ_ACT, "T2 overlay");
static_assert(O_Y2 + SZ_Y2 <= WS_END, "y2 overlay");

constexpr int CW_TMO = 0;
constexpr int CW_BAR = 4096;
constexpr int CW_KF = 65536;
constexpr int CW_FA = 3072;
constexpr int CW_RDY = 32768;
constexpr int CW_Q = 2048;
constexpr int CW_DONE = 2560;
constexpr int CW_CNT = 16384;

constexpr int RING_BYTES = 131072;
constexpr int LDSCTL_OFF = RING_BYTES, MISC_OFF = LDSCTL_OFF + 320;
constexpr int TRIG_OFF = LDSCTL_OFF + 1024;
constexpr int TILE_OFF = LDSCTL_OFF + 2048;
constexpr int LDS_BYTES = 147456;

#define RLX_AGENT __ATOMIC_RELAXED, __HIP_MEMORY_SCOPE_AGENT
#define LDS_WAIT() asm volatile("s_waitcnt lgkmcnt(0)" ::: "memory")
#define VM_WAIT() asm volatile("s_waitcnt vmcnt(0)" ::: "memory")

__device__ __forceinline__ unsigned f2bf(float f) { unsigned u = __builtin_bit_cast(unsigned, f); return (u + 0x7fffu + ((u >> 16) & 1u)) >> 16; }
__device__ __forceinline__ unsigned pk2(float lo, float hi) { return f2bf(lo) | (f2bf(hi) << 16); }
__device__ __forceinline__ float bflo(unsigned w) { return __builtin_bit_cast(float, w << 16); }
__device__ __forceinline__ float bfhi(unsigned w) { return __builtin_bit_cast(float, w & 0xffff0000u); }
__device__ __forceinline__ float bf2f(bf16 h) { return __builtin_bit_cast(float, (unsigned)h << 16); }
template <int CTRL, int RM> __device__ __forceinline__ float dppf(float v) { return __builtin_bit_cast(float, __builtin_amdgcn_update_dpp(0, __builtin_bit_cast(int, v), CTRL, RM, 0xf, true)); }
__device__ __forceinline__ float wave_sum(float v) {
    v += dppf<0x111, 0xf>(v); v += dppf<0x112, 0xf>(v); v += dppf<0x114, 0xf>(v); v += dppf<0x118, 0xf>(v);
    v += dppf<0x142, 0xa>(v); v += dppf<0x143, 0xc>(v);
    return __builtin_bit_cast(float, __builtin_amdgcn_readlane(__builtin_bit_cast(int, v), 63));
}

__device__ __forceinline__ float swap32_sum(float x, float y) {
    const auto rr = __builtin_amdgcn_permlane32_swap(__builtin_bit_cast(unsigned, x), __builtin_bit_cast(unsigned, y), false, false);
    unsigned r0 = rr[0], r1 = rr[1]; asm volatile("" : "+v"(r0), "+v"(r1));
    return __builtin_bit_cast(float, r0) + __builtin_bit_cast(float, r1);
}
__device__ __forceinline__ float swap16_sum(float x, float y) {
    const auto rr = __builtin_amdgcn_permlane16_swap(__builtin_bit_cast(unsigned, x), __builtin_bit_cast(unsigned, y), false, false);
    unsigned r0 = rr[0], r1 = rr[1]; asm volatile("" : "+v"(r0), "+v"(r1));
    return __builtin_bit_cast(float, r0) + __builtin_bit_cast(float, r1);
}

#define XB_TMO      128
#define XB_XCNT(j)  (256  + 64 * (j))
#define XB_XSUB(j)  (1280 + 64 * (j))
#define XB_XGEN(j)  (2304 + 64 * (j))
#define XB_TOP      3328
#define XB_TOPGEN   3392
#define XCD_BAR_WORDS 3456
#define XB_SPIN_CAP (1u << 18)
__device__ __forceinline__ unsigned xb_ld(unsigned* p)              { return __hip_atomic_load(p, __ATOMIC_RELAXED, __HIP_MEMORY_SCOPE_AGENT); }
__device__ __forceinline__ unsigned xb_add(unsigned* p, unsigned v) { return __hip_atomic_fetch_add(p, v, __ATOMIC_RELAXED, __HIP_MEMORY_SCOPE_AGENT); }
__device__ __forceinline__ unsigned xb_xcc_id() { return (unsigned)__builtin_amdgcn_s_getreg((3 << 11) | 20) & 0xFu; }
#define XB_SPIN(cond, bar) do { unsigned _sp = 0; while (cond) { __builtin_amdgcn_s_sleep(1); \
    if ((++_sp & 255u) == 0u) { if (xb_ld(&(bar)[XB_TMO])) break; if (_sp > XB_SPIN_CAP) { atomicAdd(&(bar)[XB_TMO], 1u); break; } } } } while (0)
struct XcdBarrier { unsigned* bar; unsigned x; volatile LAS unsigned* st; };
__device__ __forceinline__ XcdBarrier xcd_barrier_post(unsigned* bar, volatile LAS unsigned* st) {
    XcdBarrier b; b.bar = bar; b.x = xb_xcc_id(); b.st = st;
    if (threadIdx.x == 0) (void)xb_add(&bar[XB_XCNT(b.x)], 1u);
    return b;
}
__device__ __forceinline__ void xcd_barrier_complete(unsigned* bar, unsigned x, unsigned& nloc, unsigned& nx) {
    const unsigned G = gridDim.x * gridDim.y * gridDim.z;
    unsigned sum, cnt, mine, sp = 0u;
    for (;;) {
        sum = 0u; cnt = 0u; mine = 0u;
#pragma unroll
        for (unsigned j = 0; j < 16; ++j) { const unsigned c = xb_ld(&bar[XB_XCNT(j)]); sum += c; cnt += (c > 0u) ? 1u : 0u; mine = (j == x) ? c : mine; }
        if (sum == G) break;
        __builtin_amdgcn_s_sleep(1);
        if ((++sp & 255u) == 0u) { if (xb_ld(&bar[XB_TMO])) break; if (sp > XB_SPIN_CAP) { atomicAdd(&bar[XB_TMO], 1u); break; } }
    }
    nloc = mine > 0u ? mine : 1u; nx = cnt > 0u ? cnt : 1u;
}
__device__ __forceinline__ void xcd_barrier(const XcdBarrier& b) {
    asm volatile("s_waitcnt vmcnt(0)" ::: "memory");
    __syncthreads();
    if (threadIdx.x == 0) {
        unsigned* bar = b.bar;
        __builtin_amdgcn_s_waitcnt(0);
        unsigned nloc = b.st[0], nx = b.st[1];
        if (nloc == 0u) { xcd_barrier_complete(bar, b.x, nloc, nx); b.st[0] = nloc; b.st[1] = nx; }
        const unsigned old = xb_add(&bar[XB_XSUB(b.x)], 1u);
        const unsigned gen = old / nloc;
        if (old + 1u == (gen + 1u) * nloc) {
            __builtin_amdgcn_fence(__ATOMIC_RELEASE, "agent");
            asm volatile("s_waitcnt vmcnt(0)" ::: "memory");
            const unsigned og = xb_add(&bar[XB_TOP], 1u);
            const unsigned tg = og / nx;
            if (og + 1u == (tg + 1u) * nx) xb_add(&bar[XB_TOPGEN], 1u);
            else XB_SPIN(xb_ld(&bar[XB_TOPGEN]) == tg, bar);
            __builtin_amdgcn_fence(__ATOMIC_ACQUIRE, "agent");
            xb_add(&bar[XB_XGEN(b.x)], 1u);
            asm volatile("s_waitcnt vmcnt(0)" ::: "memory");
        } else {
            XB_SPIN(xb_ld(&bar[XB_XGEN(b.x)]) == gen, bar);
            __builtin_amdgcn_fence(__ATOMIC_ACQUIRE, "agent");
            asm volatile("s_waitcnt vmcnt(0)" ::: "memory");
        }
    }
    __syncthreads();
}

namespace pg8 {
constexpr int BM = 256, BK = 64, HALF = 128, HTB = HALF * BK * 2;
__host__ __device__ __forceinline__ int lds_byte(int r, int c) { const int st = (r >> 4) * 2 + (c >> 5), rr = r & 15, cc = c & 31, ob = rr * 64 + cc * 2; return st * 1024 + (ob ^ (((ob >> 9) & 1) << 5)); }
__host__ __device__ __forceinline__ void stage_rc(int b, int& R, int& C) { const int st = b / 1024, sb = b % 1024, swz = sb ^ (((sb >> 9) & 1) << 5); R = (st >> 1) * 16 + swz / 64; C = (st & 1) * 32 + (swz % 64) / 2; }
__host__ __device__ __forceinline__ int perm32(int rho) { const int n = rho >> 4, i = rho & 15; return 8 * (i >> 2) + 4 * n + (i & 3); }

struct Unit { int pm, pn, e, cnt, kind; };

template <class Epi, class Sched>
__device__ __forceinline__ void gemm_phase(LAS unsigned char* lds, const Sched& S, const Epi& E) {
    int tid = threadIdx.x; asm volatile("" : "+v"(tid));
    const int wid = __builtin_amdgcn_readfirstlane(tid >> 6), lane = tid & 63, wr = wid >> 2, wc = wid & 3, fr = lane & 15, fq = lane >> 4;
    int RA[2], CA[2], RB[2];
#pragma unroll
    for (int i = 0; i < 2; ++i) { int R, C; stage_rc(tid * 16 + i * 8192, R, C); RA[i] = R; CA[i] = C; RB[i] = Epi::PERM ? ((R & ~31) + perm32(R & 31)) : R; }
    const size_t kstep = (size_t)(BK * 2);
    const unsigned ldsw = (unsigned)wid * 1024u;
    const int aoff = lds_byte(wr * 64 + fr, fq * 8), boff = lds_byte(wc * 32 + fr, fq * 8);
#define PG8_SA(b, h) (((b) * 2 + (h)) * HTB)
#define PG8_SB(b, h) ((4 + (b) * 2 + (h)) * HTB)
#define PG8_STAGE2(bufoff, gbase, o0, o1) do { \
        __builtin_amdgcn_global_load_lds((const unsigned*)((const char*)(gbase) + (o0)), (LAS unsigned*)(lds + (bufoff) + ldsw), 16, 0, 0); \
        __builtin_amdgcn_global_load_lds((const unsigned*)((const char*)(gbase) + (o1)), (LAS unsigned*)(lds + (bufoff) + ldsw + 8192), 16, 0, 0); } while (0)
#define PG8_LDA(dst, b, h) do { _Pragma("unroll") for (int m = 0; m < 4; ++m) _Pragma("unroll") for (int k = 0; k < 2; ++k) dst[m][k] = *(const LAS bf16x8*)(lds + PG8_SA(b, h) + aoff + m * 2048 + k * 1024); } while (0)
#define PG8_LDB(dst, b, h) do { _Pragma("unroll") for (int n = 0; n < 2; ++n) _Pragma("unroll") for (int k = 0; k < 2; ++k) dst[n][k] = *(const LAS bf16x8*)(lds + PG8_SB(b, h) + boff + n * 2048 + k * 1024); } while (0)
#define PG8_MMA(ai, bj, At, Bt) do { __builtin_amdgcn_s_setprio(1); _Pragma("unroll") for (int m = 0; m < 4; ++m) _Pragma("unroll") for (int n = 0; n < 2; ++n) _Pragma("unroll") for (int k = 0; k < 2; ++k) \
        acc[ai][bj][m][n] = __builtin_amdgcn_mfma_f32_16x16x32_bf16(Bt[n][k], At[m][k], acc[ai][bj][m][n], 0, 0, 0); __builtin_amdgcn_s_setprio(0); } while (0)
#define PG8_WAIT_V(n) asm volatile("s_waitcnt vmcnt(" #n ")" ::: "memory")
#define PG8_WAIT_L(n) asm volatile("s_waitcnt lgkmcnt(" #n ")" ::: "memory")
#define PG8_BAR __builtin_amdgcn_s_barrier()
#define PG8_SCHED __builtin_amdgcn_sched_barrier(0)
    Unit cur, nxt; int ui = 0;
    if (!S.next(0, cur)) return;
    f32x4 acc[2][2][4][2];
#pragma unroll
    for (int a = 0; a < 2; ++a)
#pragma unroll
        for (int b = 0; b < 2; ++b)
#pragma unroll
            for (int m = 0; m < 4; ++m)
#pragma unroll
                for (int n = 0; n < 2; ++n) acc[a][b][m][n] = (f32x4){0.f, 0.f, 0.f, 0.f};
    bf16x8 At[4][2], B0[2][2], B1[2][2];
    int Kc = S.K(cur), Kn; const char* Ac = S.a_base(cur); const char* An; const char* cB = S.b_ptr(cur); const char* nB;
    unsigned oc00, oc01, oc10, oc11, on00, on01, on10, on11, vbc0, vbc1, vbn0, vbn1; size_t hsc, hsn;
    oc00 = S.a_off(cur, RA[0], CA[0]); oc01 = S.a_off(cur, RA[1], CA[1]); oc10 = S.a_off(cur, HALF + RA[0], CA[0]); oc11 = S.a_off(cur, HALF + RA[1], CA[1]);
    vbc0 = (unsigned)(RB[0] * Kc + CA[0]) * 2u; vbc1 = (unsigned)(RB[1] * Kc + CA[1]) * 2u; hsc = (size_t)HALF * Kc * 2;
    S.a_ready(cur);
    PG8_STAGE2(PG8_SB(0, 0), cB, vbc0, vbc1); PG8_STAGE2(PG8_SB(0, 1), cB + hsc, vbc0, vbc1); PG8_STAGE2(PG8_SA(0, 0), Ac, oc00, oc01); PG8_STAGE2(PG8_SA(0, 1), Ac, oc10, oc11);
    if (wr == 1) PG8_BAR;
    PG8_WAIT_V(2); PG8_BAR;
    PG8_STAGE2(PG8_SB(1, 0), cB + kstep, vbc0, vbc1); PG8_STAGE2(PG8_SA(1, 0), Ac + kstep, oc00, oc01); PG8_STAGE2(PG8_SB(1, 1), cB + hsc + kstep, vbc0, vbc1);
    PG8_WAIT_V(6); PG8_BAR;
    for (;;) {
        const bool has_next = S.next(ui + 1, nxt);
        Kn = Kc; An = Ac; nB = cB; on00 = oc00; on01 = oc01; on10 = oc10; on11 = oc11; vbn0 = vbc0; vbn1 = vbc1; hsn = hsc;
        if (has_next) { Kn = S.K(nxt); An = S.a_base(nxt); nB = S.b_ptr(nxt);
            on00 = S.a_off(nxt, RA[0], CA[0]); on01 = S.a_off(nxt, RA[1], CA[1]); on10 = S.a_off(nxt, HALF + RA[0], CA[0]); on11 = S.a_off(nxt, HALF + RA[1], CA[1]);
            vbn0 = (unsigned)(RB[0] * Kn + CA[0]) * 2u; vbn1 = (unsigned)(RB[1] * Kn + CA[1]) * 2u; hsn = (size_t)HALF * Kn * 2; }
        const int nt = Kc / BK;
        for (int t = 0; t < nt; t += 2) {
            const bool last = (t == nt - 2);
            if (last && has_next) S.a_ready(nxt);
            const char* a1 = Ac + (size_t)(t + 1) * kstep;
            const char* a2 = last ? An : Ac + (size_t)(t + 2) * kstep; const char* b2 = last ? nB : cB + (size_t)(t + 2) * kstep;
            const char* a3 = a2 + kstep; const char* b3 = b2 + kstep;
            const unsigned x00 = last ? on00 : oc00, x01 = last ? on01 : oc01, x10 = last ? on10 : oc10, x11 = last ? on11 : oc11;
            const unsigned y0 = last ? vbn0 : vbc0, y1 = last ? vbn1 : vbc1; const size_t hs2 = last ? hsn : hsc;
            PG8_LDB(B0, 0, 0); PG8_LDB(B1, 0, 1); PG8_SCHED; PG8_LDA(At, 0, 0); PG8_STAGE2(PG8_SA(1, 1), a1, oc10, oc11);
            PG8_WAIT_V(8); PG8_WAIT_L(0); PG8_BAR; PG8_MMA(0, 0, At, B0); PG8_MMA(0, 1, At, B1); PG8_BAR; PG8_SCHED;
            PG8_LDA(At, 0, 1); PG8_STAGE2(PG8_SB(0, 0), b2, y0, y1); PG8_STAGE2(PG8_SB(0, 1), b2 + hs2, y0, y1); PG8_STAGE2(PG8_SA(0, 0), a2, x00, x01);
            PG8_WAIT_V(8); PG8_WAIT_L(0); PG8_BAR; PG8_MMA(1, 0, At, B0); PG8_MMA(1, 1, At, B1); PG8_BAR; PG8_SCHED;
            PG8_LDB(B0, 1, 0); PG8_LDB(B1, 1, 1); PG8_SCHED; PG8_LDA(At, 1, 0); PG8_STAGE2(PG8_SA(0, 1), a2, x10, x11);
            PG8_WAIT_V(8); PG8_WAIT_L(0); PG8_BAR; PG8_MMA(0, 0, At, B0); PG8_MMA(0, 1, At, B1); PG8_BAR; PG8_SCHED;
            PG8_LDA(At, 1, 1); PG8_STAGE2(PG8_SB(1, 0), b3, y0, y1); PG8_STAGE2(PG8_SB(1, 1), b3 + hs2, y0, y1); PG8_STAGE2(PG8_SA(1, 0), a3, x00, x01);
            PG8_WAIT_V(8); PG8_WAIT_L(0); PG8_BAR; PG8_MMA(1, 0, At, B0); PG8_MMA(1, 1, At, B1); PG8_BAR; PG8_SCHED;
        }
        if (wr == 0) PG8_BAR;
        E(acc, cur, wr, wc, fr, fq);
        if (!has_next) break;
#pragma unroll
        for (int a = 0; a < 2; ++a)
#pragma unroll
            for (int b = 0; b < 2; ++b)
#pragma unroll
                for (int m = 0; m < 4; ++m)
#pragma unroll
                    for (int n = 0; n < 2; ++n) acc[a][b][m][n] = (f32x4){0.f, 0.f, 0.f, 0.f};
        cur = nxt; Kc = Kn; Ac = An; cB = nB; oc00 = on00; oc01 = on01; oc10 = on10; oc11 = on11; vbc0 = vbn0; vbc1 = vbn1; hsc = hsn; ++ui;
        if (wr == 1) PG8_BAR;
    }
    PG8_WAIT_V(0);
    PG8_BAR;
#undef PG8_SA
#undef PG8_SB
#undef PG8_STAGE2
#undef PG8_LDA
#undef PG8_LDB
#undef PG8_MMA
#undef PG8_WAIT_V
#undef PG8_WAIT_L
#undef PG8_BAR
#undef PG8_SCHED
}
}

__device__ __forceinline__ int krow_of(int r) {
    if (r < T) return (r >> 12) * KVROWS + LCTX + (r & 4095);
    const int rc = r - T; return (rc >> 8) * KVROWS + (rc & 255);
}
struct SchedPlain {
    int nM, nN, G, vcu, Kk; const char* A; const char* B;
    __device__ __forceinline__ bool next(int i, pg8::Unit& u) const { const int L = i * G + vcu; if (L >= nM * nN) return false; u.pm = L / nN; u.pn = L % nN; u.e = 0; u.cnt = 256; u.kind = 0; return true; }
    __device__ __forceinline__ int K(const pg8::Unit&) const { return Kk; }
    __device__ __forceinline__ const char* a_base(const pg8::Unit&) const { return A; }
    __device__ __forceinline__ unsigned a_off(const pg8::Unit& u, int row, int col) const { return (unsigned)((u.pm * 256 + row) * Kk + col) * 2u; }
    __device__ __forceinline__ const char* b_ptr(const pg8::Unit& u) const { return B + (size_t)u.pn * 256 * Kk * 2; }
    __device__ __forceinline__ void a_ready(const pg8::Unit&) const {}
};
struct EpiG1 {
    static constexpr bool PERM = true;
    bf16 *pu, *q, *kall, *vall, *z;
    __device__ __forceinline__ void operator()(const f32x4 (&acc)[2][2][4][2], const pg8::Unit& u, int wr, int wc, int fr, int fq) const {
        const int row0 = u.pm * 256 + wr * 64 + fr, c8 = wc * 32 + 8 * fq;
#pragma unroll
        for (int ai = 0; ai < 2; ++ai)
#pragma unroll
            for (int m = 0; m < 4; ++m) {
                const int row = row0 + ai * 128 + m * 16;
#pragma unroll
                for (int bj = 0; bj < 2; ++bj) {
                    const f32x4 v0 = acc[ai][bj][m][0], v1 = acc[ai][bj][m][1];
                    v4u w; w.x = pk2(v0[0], v0[1]); w.y = pk2(v0[2], v0[3]); w.z = pk2(v1[0], v1[1]); w.w = pk2(v1[2], v1[3]);
                    bf16* dst;
                    if (u.pn == 0) dst = pu + (size_t)row * 256 + bj * 128 + c8;
                    else if (u.pn <= 2) dst = q + (size_t)row * 512 + (u.pn - 1) * 256 + bj * 128 + c8;
                    else if (u.pn == 3) dst = (bj == 0 ? kall : vall) + (size_t)krow_of(row) * 128 + c8;
                    else dst = z + (size_t)row * 512 + (u.pn - 4) * 256 + bj * 128 + c8;
                    *(v4u*)dst = w;
                }
            }
    }
};
struct EpiG2 {
    static constexpr bool PERM = false;
    const float* xin; const float* cin; float* xout; float* cout; const float* mod;
    __device__ __forceinline__ void operator()(const f32x4 (&acc)[2][2][4][2], const pg8::Unit& u, int wr, int wc, int fr, int fq) const {
        const int rt0 = u.pm * 256; const bool isc = rt0 >= T;
        const int bsel = isc ? 4 : (rt0 >> 12);
        const float* g1 = mod + bsel * 6144 + 2048;
        const float* base = isc ? cin - (size_t)T * 1024 : xin; float* out = isc ? cout - (size_t)T * 1024 : xout;
        const int row0 = rt0 + wr * 64 + fr, col0 = u.pn * 256 + wc * 32 + 4 * fq;
#pragma unroll
        for (int bj = 0; bj < 2; ++bj)
#pragma unroll
            for (int n = 0; n < 2; ++n) {
                const int col = col0 + bj * 128 + n * 16; const f32x4 gv = *(const f32x4*)(g1 + col);
#pragma unroll
                for (int ai = 0; ai < 2; ++ai)
#pragma unroll
                    for (int m = 0; m < 4; ++m) { const size_t off = (size_t)(row0 + ai * 128 + m * 16) * 1024 + col; const f32x4 bs = *(const f32x4*)(base + off); *(f32x4*)(out + off) = bs + gv * acc[ai][bj][m][n]; }
            }
    }
};
struct SchedMoe {
    int G, vcu, ntile;
    const char* hb; const char* actb; const char* wgu; const char* wd; const unsigned* list; const LAS int* tt; unsigned* ready; unsigned* tmo;
    __device__ __forceinline__ bool next(int i, pg8::Unit& u) const {
        const int U = ntile * 4; const int r = U % G, q = U / G; const int n3 = q + (vcu < r ? 1 : 0); int L;
        if (i < n3) { L = i * G + vcu; u.kind = 0; }
        else { const int j = i - n3; const int nl = G - r;
            if (vcu >= r) L = (j == 0) ? (vcu - r) : (j == 1) ? nl + (vcu - r) : 2 * nl + (j - 2) * G + vcu;
            else L = 2 * nl + j * G + vcu;
            if (L >= U) return false; u.kind = 1; }
        const int tau = L >> 2; u.pn = L & 3; u.pm = tau; int e = 0;
#pragma unroll
        for (int k = 1; k < 16; ++k) e += (tt[k] <= tau) ? 1 : 0;
        u.e = e; const int r0 = (tau - tt[e]) * 256; const int c = tt[17 + e] - r0; u.cnt = c < 256 ? c : 256; return true;
    }
    __device__ __forceinline__ int K(const pg8::Unit& u) const { return u.kind ? 512 : 1024; }
    __device__ __forceinline__ const char* a_base(const pg8::Unit& u) const { return u.kind ? actb : hb; }
    __device__ __forceinline__ unsigned a_off(const pg8::Unit& u, int row, int col) const {
        if (u.kind) return (unsigned)((u.pm * 256 + row) * 512 + col) * 2u;
        const int r0 = (u.pm - tt[u.e]) * 256; unsigned tok = 0;
        if (row < u.cnt) tok = list[(size_t)u.e * TT + r0 + row] >> 1;
        return (tok * 1024u + (unsigned)col) * 2u;
    }
    __device__ __forceinline__ const char* b_ptr(const pg8::Unit& u) const { return u.kind ? wd + ((size_t)u.e * 1024 + (size_t)u.pn * 256) * 512 * 2 : wgu + ((size_t)u.e * 1024 + (size_t)u.pn * 256) * 1024 * 2; }
    __device__ __forceinline__ void a_ready(const pg8::Unit& u) const {
        if (!u.kind) return;
        if (threadIdx.x < 64) {
            unsigned* w = ready + 16 * u.pm; unsigned sp = 0;
            while ((unsigned)__builtin_amdgcn_readfirstlane(__hip_atomic_load(w, __ATOMIC_RELAXED, __HIP_MEMORY_SCOPE_AGENT)) < 32u) {
                __builtin_amdgcn_s_sleep(2);
                if (++sp > (1u << 22)) { if (threadIdx.x == 0) __hip_atomic_store(tmo, 1u, __ATOMIC_RELAXED, __HIP_MEMORY_SCOPE_AGENT); break; } }
            __builtin_amdgcn_fence(__ATOMIC_ACQUIRE, "agent");
            asm volatile("s_waitcnt vmcnt(0)" ::: "memory");
        }
        asm volatile("" ::: "memory"); __builtin_amdgcn_s_barrier(); asm volatile("" ::: "memory");
    }
};
__device__ __forceinline__ void store16_wt(void* p, v4u v) { asm volatile("global_store_dwordx4 %0, %1, off sc1\n\ts_nop 1" :: "v"(p), "v"(v) : "memory"); }
struct EpiG3 {
    static constexpr bool PERM = true;
    bf16* act; unsigned* ready;
    __device__ __forceinline__ void operator()(const f32x4 (&acc)[2][2][4][2], const pg8::Unit& u, int wr, int wc, int fr, int fq) const {
        const int row0 = u.pm * 256 + wr * 64 + fr, c8 = u.pn * 128 + wc * 32 + 8 * fq;
#pragma unroll
        for (int ai = 0; ai < 2; ++ai)
#pragma unroll
            for (int m = 0; m < 4; ++m) {
                float a[8];
#pragma unroll
                for (int n = 0; n < 2; ++n)
#pragma unroll
                    for (int k = 0; k < 4; ++k) { const float g = acc[ai][0][m][n][k], up = acc[ai][1][m][n][k]; a[n * 4 + k] = g / (1.f + __expf(-g)) * up; }
                v4u w; w.x = pk2(a[0], a[1]); w.y = pk2(a[2], a[3]); w.z = pk2(a[4], a[5]); w.w = pk2(a[6], a[7]);
                store16_wt(act + (size_t)(row0 + ai * 128 + m * 16) * 512 + c8, w);
            }
        asm volatile("s_waitcnt vmcnt(0)" ::: "memory");
        if ((threadIdx.x & 63) == 0) __hip_atomic_fetch_add(ready + 16 * u.pm, 1u, __ATOMIC_RELAXED, __HIP_MEMORY_SCOPE_AGENT);
    }
};
struct EpiG4 {
    static constexpr bool PERM = true;
    bf16* y2; const unsigned* list; const float* wts; const LAS int* tt;
    __device__ __forceinline__ void operator()(const f32x4 (&acc)[2][2][4][2], const pg8::Unit& u, int wr, int wc, int fr, int fq) const {
        const int r0 = (u.pm - tt[u.e]) * 256; const int c8 = u.pn * 256 + wc * 32 + 8 * fq;
#pragma unroll
        for (int ai = 0; ai < 2; ++ai)
#pragma unroll
            for (int m = 0; m < 4; ++m) {
                const int row = wr * 64 + fr + ai * 128 + m * 16;
                if (row < u.cnt) {
                    const unsigned ent = list[(size_t)u.e * TT + r0 + row]; const float w = wts[ent];
#pragma unroll
                    for (int bj = 0; bj < 2; ++bj) {
                        const f32x4 v0 = acc[ai][bj][m][0] * w, v1 = acc[ai][bj][m][1] * w;
                        v4u o; o.x = pk2(v0[0], v0[1]); o.y = pk2(v0[2], v0[3]); o.z = pk2(v1[0], v1[1]); o.w = pk2(v1[2], v1[3]);
                        *(v4u*)(y2 + (size_t)ent * 1024 + bj * 128 + c8) = o;
                    }
                }
            }
    }
};

struct EpiMoe { static constexpr bool PERM = true; EpiG3 e3; EpiG4 e4;
    __device__ __forceinline__ void operator()(const f32x4 (&acc)[2][2][4][2], const pg8::Unit& u, int wr, int wc, int fr, int fq) const { if (u.kind) e4(acc, u, wr, wc, fr, fq); else e3(acc, u, wr, wc, fr, fq); } };

#include <hip/hip_bf16.h>
#include <cmath>
namespace attn_body {
using bf16=__hip_bfloat16;
using bf16x8=__attribute__((ext_vector_type(8)))short;
using s16x4=__attribute__((ext_vector_type(4)))short;
using f32x16=__attribute__((ext_vector_type(16)))float;
using u32x4=__attribute__((ext_vector_type(4)))unsigned;
constexpr int D=64,QP=512,KVP=128,OP=1024;
constexpr int NW=8,QBLK=32,KVBLK=64;
__device__ __forceinline__ int crow(int r,int hi){return (r&3)+8*(r>>2)+4*hi;}
#define SBAR() __builtin_amdgcn_sched_barrier(0)
__device__ __forceinline__ void wmask(f32x16&p0,f32x16&p1,int kp0,int qpos,int hi){
  const float NEG=-INFINITY; const bool tile_ok=(unsigned)kp0<4096u; const int base=kp0+4*hi-qpos+128;
  #pragma unroll
  for(int r=0;r<16;++r){const int dd=base+(r&3)+8*(r>>2); if(!tile_ok||(unsigned)dd>256u)p0[r]=NEG; if(!tile_ok||(unsigned)(dd+32)>256u)p1[r]=NEG;}
}
constexpr int NSLOT=3, SLOTB=8192;
constexpr int LDS_K=0, LDS_V=NSLOT*SLOTB, LDS_WS=2*NSLOT*SLOTB, LDS_OST=LDS_WS+NW*64*4, LDS_BYTES=LDS_OST+NW*4096;
constexpr float C2=0.125f*1.4426950408889634f;
__device__ __forceinline__ void glds16(const void*gsrc,unsigned lds_dst){unsigned keep;
  asm volatile("s_mov_b32 %0, m0\n\ts_mov_b32 m0, %2\n\ts_nop 0\n\tglobal_load_lds_dwordx4 %1, off\n\ts_mov_b32 m0, %0":"=&s"(keep):"v"(gsrc),"s"(lds_dst):"memory");}
__device__ __forceinline__ float max3f(float a,float b,float c){float r;asm("v_max3_f32 %0, %1, %2, %3":"=v"(r):"v"(a),"v"(b),"v"(c));return r;}
__device__ __forceinline__ float max2f(float a,float b){float r;asm("v_max_f32_e32 %0, %1, %2":"=v"(r):"v"(a),"v"(b));return r;}
__device__ __forceinline__ float fadd_s(float a,float b){float r;asm("v_add_f32_e32 %0, %1, %2":"=v"(r):"v"(a),"v"(b));return r;}
__device__ __forceinline__ float fsub_s(float a,float b){float r;asm("v_sub_f32_e32 %0, %1, %2":"=v"(r):"v"(a),"v"(b));return r;}
typedef float f32x2_t __attribute__((ext_vector_type(2))); typedef __bf16 bf16x2_t __attribute__((ext_vector_type(2)));
__device__ __forceinline__ unsigned cvtpk_s(float lo,float hi){f32x2_t v={lo,hi};bf16x2_t b=__builtin_convertvector(v,bf16x2_t);return __builtin_bit_cast(unsigned,b);}
#define WAIT_BAR(N) asm volatile("s_waitcnt vmcnt(" #N ") lgkmcnt(0)\n\ts_barrier":::"memory")

__device__ __forceinline__ void qkt(f32x16&p0,f32x16&p1,const char*Kslot,const bf16x8*qr,const f32x16&negm,int r32,int hi){
  const char*kb=Kslot+hi*1024+r32*16;
  #pragma unroll
  for(int d0=0;d0<4;++d0){
    const bf16x8 b0=*reinterpret_cast<const bf16x8*>(kb+d0*2048);
    const bf16x8 b1=*reinterpret_cast<const bf16x8*>(kb+d0*2048+512);
    if(d0==0){p0=__builtin_amdgcn_mfma_f32_32x32x16_bf16(b0,qr[0],negm,0,0,0);p1=__builtin_amdgcn_mfma_f32_32x32x16_bf16(b1,qr[0],negm,0,0,0);}
    else{p0=__builtin_amdgcn_mfma_f32_32x32x16_bf16(b0,qr[d0],p0,0,0,0);p1=__builtin_amdgcn_mfma_f32_32x32x16_bf16(b1,qr[d0],p1,0,0,0);}}
}
typedef __attribute__((address_space(3))) const char* lds_cptr;
typedef short v4i16_t __attribute__((ext_vector_type(4)));
__device__ __forceinline__ void kload8(bf16x8*kf,lds_cptr kp){
  kf[0]=*(const __attribute__((address_space(3))) bf16x8*)(kp);      kf[1]=*(const __attribute__((address_space(3))) bf16x8*)(kp+512);
  kf[2]=*(const __attribute__((address_space(3))) bf16x8*)(kp+2048); kf[3]=*(const __attribute__((address_space(3))) bf16x8*)(kp+2560);
  kf[4]=*(const __attribute__((address_space(3))) bf16x8*)(kp+4096); kf[5]=*(const __attribute__((address_space(3))) bf16x8*)(kp+4608);
  kf[6]=*(const __attribute__((address_space(3))) bf16x8*)(kp+6144); kf[7]=*(const __attribute__((address_space(3))) bf16x8*)(kp+6656);
}
__device__ __forceinline__ void kload2(bf16x8*kf,lds_cptr kp,int j){ kf[2*j]=*(const __attribute__((address_space(3))) bf16x8*)(kp+j*2048); kf[2*j+1]=*(const __attribute__((address_space(3))) bf16x8*)(kp+j*2048+512); }
__device__ __forceinline__ s16x4 vtr(lds_cptr p){ return __builtin_bit_cast(s16x4,__builtin_amdgcn_ds_read_tr16_b64_v4i16((__attribute__((address_space(3))) v4i16_t*)p)); }
__device__ __forceinline__ float rowmax(const f32x16&p0,const f32x16&p1){
  float a=max3f(p0[0],p0[1],p1[0]),b=max3f(p0[2],p0[3],p1[1]);a=max3f(a,p1[2],p1[3]);
  #pragma unroll
  for(int r=4;r<16;r+=4){a=max3f(a,p0[r],p0[r+1]);b=max3f(b,p0[r+2],p0[r+3]);a=max3f(a,p1[r],p1[r+1]);b=max3f(b,p1[r+2],p1[r+3]);}
  const float m=max2f(a,b);
  auto rr=__builtin_amdgcn_permlane32_swap(__float_as_uint(m),__float_as_uint(m),false,false);
  return max2f(__uint_as_float(rr[0]),__uint_as_float(rr[1]));
}
__device__ __forceinline__ void pv(f32x16*o,int vb,bf16x8 pa0,bf16x8 pa1,bf16x8 pa2,bf16x8 pa3){
  #pragma unroll
  for(int d0=0;d0<2;++d0){s16x4 lo[4],hi[4];
    #pragma unroll
    for(int ks=0;ks<4;++ks){
      asm volatile("ds_read_b64_tr_b16 %0,%1 offset:%c2":"=&v"(lo[ks]):"v"(vb),"i"(d0*4096+ks*1024):"memory");
      asm volatile("ds_read_b64_tr_b16 %0,%1 offset:%c2":"=&v"(hi[ks]):"v"(vb),"i"(d0*4096+ks*1024+512):"memory");}
    asm volatile("s_waitcnt lgkmcnt(0)":::"memory");SBAR();
    #define PK(k) (bf16x8){lo[k][0],lo[k][1],lo[k][2],lo[k][3],hi[k][0],hi[k][1],hi[k][2],hi[k][3]}
    o[d0]=__builtin_amdgcn_mfma_f32_32x32x16_bf16(pa0,PK(0),o[d0],0,0,0);
    o[d0]=__builtin_amdgcn_mfma_f32_32x32x16_bf16(pa1,PK(1),o[d0],0,0,0);
    o[d0]=__builtin_amdgcn_mfma_f32_32x32x16_bf16(pa2,PK(2),o[d0],0,0,0);
    o[d0]=__builtin_amdgcn_mfma_f32_32x32x16_bf16(pa3,PK(3),o[d0],0,0,0);
    #undef PK
  }
}

#ifndef ATTN_STORE16
#define ATTN_STORE16(p,v) (*(u32x4*)(p)=(v))
#endif
template<int THRL> __device__ __forceinline__ void attn_unit(const bf16*Qu,const bf16*__restrict__ Kh,const bf16*__restrict__ Vh,bf16*Ou,const int p0,const int NT,const float* sinkp,const float* qg,const float2* ropet,char*shm){
  int tid=threadIdx.x; asm volatile("":"+v"(tid)); const int lane=tid&63,r32=lane&31,hi=lane>>5; const int wid=__builtin_amdgcn_readfirstlane(tid>>6);
  const int hsub=wid>>1, psub=(wid&1)*QBLK;
  const bf16*Qw=Qu+(long)psub*QP+hsub*D;
  const unsigned lds0=(unsigned)(uintptr_t)shm;
  float*wsf=(float*)(shm+LDS_WS)+wid*64;
  const bf16*ksrc=Kh+(long)lane*KVP+wid*8;
  const bf16*vsrc=Vh+(long)(16*(wid&3)+(lane>>2))*KVP+(wid>>2)*32+(lane&3)*8;
  const unsigned kdst=lds0+LDS_K+wid*1024, vdst=lds0+LDS_V+wid*1024;
  #define KP0(t) (p0-128+64*((t)-4))
  #define TROW(t) ((t)<4?64*(t):(((unsigned)KP0(t)<4096u)?256+KP0(t):256))
  #define DMA_K(t,slot) glds16(ksrc+(long)TROW(t)*KVP,(unsigned)__builtin_amdgcn_readfirstlane(kdst+(slot)))
  #define DMA_V(t,slot) glds16(vsrc+(long)TROW(t)*KVP,(unsigned)__builtin_amdgcn_readfirstlane(vdst+(slot)))
  const int vb0=(int)(lds0+LDS_V)+((lane>>4)&1)*32+(lane&3)*8+(4*hi+((lane&15)>>2))*64;
  const char*Kbase=shm+LDS_K; bf16x8 kf[8];
  const lds_cptr shm3=(lds_cptr)shm; const lds_cptr kp0=shm3+LDS_K+hi*1024+r32*16; const lds_cptr vp0=shm3+LDS_V+((lane>>4)&1)*32+(lane&3)*8+(4*hi+((lane&15)>>2))*64;
  DMA_K(0,0);DMA_V(0,0);DMA_K(1,SLOTB);
  bf16x8 qr[4];
  { bf16x8 qraw[4];
    #pragma unroll
    for(int d0=0;d0<4;++d0)qraw[d0]=*reinterpret_cast<const bf16x8*>(&Qw[(long)r32*QP+d0*16+hi*8]);
    float qf[4][8]; float ss=0.f;
    #pragma unroll
    for(int d0=0;d0<4;++d0)
      #pragma unroll
      for(int j=0;j<8;++j){ qf[d0][j]=__builtin_bit_cast(float,(unsigned)(unsigned short)qraw[d0][j]<<16); ss+=qf[d0][j]*qf[d0][j]; }
    ss+=__shfl_xor(ss,32);
    const float rstd=1.0f/sqrtf(ss*(1.f/64.f)+1e-6f)*C2;
    #pragma unroll
    for(int d0=0;d0<4;++d0)
      #pragma unroll
      for(int j=0;j<8;++j) qf[d0][j]*=rstd*qg[16*d0+8*hi+j];
    if(ropet){ const float2* rp=ropet+(long)(p0+psub+r32)*32+8*hi;
      #pragma unroll
      for(int j=0;j<8;++j){ const float2 c1=rp[j],c2=rp[16+j];
        const float a=qf[0][j],b=qf[1][j],c=qf[2][j],d=qf[3][j];
        qf[0][j]=a*c1.x-b*c1.y; qf[1][j]=b*c1.x+a*c1.y; qf[2][j]=c*c2.x-d*c2.y; qf[3][j]=d*c2.x+c*c2.y; } }
    #pragma unroll
    for(int d0=0;d0<4;++d0){ u32x4 w; w[0]=cvtpk_s(qf[d0][0],qf[d0][1]); w[1]=cvtpk_s(qf[d0][2],qf[d0][3]); w[2]=cvtpk_s(qf[d0][4],qf[d0][5]); w[3]=cvtpk_s(qf[d0][6],qf[d0][7]); qr[d0]=__builtin_bit_cast(bf16x8,w); } }
  float mhat=0.f,l_reg=0.f;f32x16 o[2];o[0]=f32x16{};o[1]=f32x16{};f32x16 negm=f32x16{};asm volatile("":"+v"(negm));
  const int qpos=p0+psub+r32;
  #define CMASK(P0,P1,t) do{ if((t)>=4)wmask(P0,P1,KP0(t),qpos,hi); }while(0)
  bool resc=false;
  #define START(P0,P1) do{ const float rm=rowmax(P0,P1); resc=false; \
    { const float dl=rm; mhat=fadd_s(mhat,dl); \
      _Pragma("unroll") for(int r=0;r<16;++r){P0[r]=fsub_s(P0[r],dl);P1[r]=fsub_s(P1[r],dl);} \
      _Pragma("unroll") for(int r=0;r<16;++r)negm[r]=-mhat; asm volatile("":"+v"(negm)); } \
    _Pragma("unroll") for(int r=0;r<16;++r)P0[r]=__builtin_amdgcn_exp2f(P0[r]); }while(0)
  #define RESC() do{ if(resc){ asm volatile("s_waitcnt lgkmcnt(0)":::"memory"); \
      _Pragma("unroll") for(int d_=0;d_<2;++d_) _Pragma("unroll") for(int r=0;r<16;++r)o[d_][r]*=wsf[crow(r,hi)]; } }while(0)
  f32x16 pA0,pA1,pB0,pB1;
  int sl_prev=0,sl_cur=0,sl_next=SLOTB;
  #define ROT() do{sl_prev=sl_cur;sl_cur=sl_next;sl_next=(sl_next==(NSLOT-1)*SLOTB)?0:sl_next+SLOTB;}while(0)
  DMA_K(2,2*SLOTB);
  WAIT_BAR(3);
  qkt(pA0,pA1,Kbase,qr,negm,r32,hi);asm volatile("s_nop 15\n\ts_nop 7":"+v"(pA0),"+v"(pA1));CMASK(pA0,pA1,0);
  START(pA0,pA1);
  _Pragma("unroll") for(int r=0;r<16;++r)pA1[r]=__builtin_amdgcn_exp2f(pA1[r]);
  WAIT_BAR(0);
  DMA_K(3,0);DMA_V(1,SLOTB);
  ROT();
  kload8(kf,kp0+sl_cur);
  WAIT_BAR(2);
  s16x4 vlo[8],vhi[8]; u32x4 pw0,pw1,pw2,pw3;
  #define PKW(P,B) cvtpk_s(P[B],P[B+1])
  #define PAF(k) __builtin_bit_cast(bf16x8,pw##k)
  #define VFR(i) (bf16x8){vlo[i][0],vlo[i][1],vlo[i][2],vlo[i][3],vhi[i][0],vhi[i][1],vhi[i][2],vhi[i][3]}
  #define PIN(x) asm volatile("":"+v"(x))
  #define MX3(a,b,c) __builtin_fmaxf(__builtin_fmaxf((a),(b)),(c))
  #define GAPA(MF,A0,A1,A2,A3,W0,W1,PW) do{ MF; sacc+=A0; sacc+=A1; sacc+=A2; sacc+=A3; PIN(sacc); W0; W1; PIN(PW); SBAR(); }while(0)
  #define EX(v) __builtin_amdgcn_exp2f(v)
  #define GAPB(MF,X,B) do{ MF; X[B]=EX(X[B]); X[B+1]=EX(X[B+1]); X[B+2]=EX(X[B+2]); X[B+3]=EX(X[B+3]); PIN(X); SBAR(); }while(0)
  #define VRD(i) do{ vlo[i]=vtr(vp_+(((i)>>2)*4096+((i)&3)*1024)); vhi[i]=vtr(vp_+(((i)>>2)*4096+((i)&3)*1024+512)); }while(0)
  #define KRD(G,j) do{ if(G){ kload2(kf,kp0+sl_next,j); SBAR(); } }while(0)
  #define STEP(C0,C1,P0,P1,t,GK,GV,GL) do{ SBAR(); \
    const lds_cptr vp_=vp0+sl_prev; \
    VRD(0); SBAR(); float sacc=(P0[0]+P0[1]); \
    GAPA(C0=__builtin_amdgcn_mfma_f32_32x32x16_bf16(kf[0],qr[0],negm,0,0,0), P0[2],P0[3],P0[4],P0[5],     pw0[0]=PKW(P0,0), pw0[1]=PKW(P0,2), pw0); \
    VRD(4); SBAR(); GAPA(C1=__builtin_amdgcn_mfma_f32_32x32x16_bf16(kf[1],qr[0],negm,0,0,0), P0[6],P0[7],P0[8],P0[9],     pw0[2]=PKW(P0,4), pw0[3]=PKW(P0,6), pw0); \
    VRD(1); SBAR(); GAPA(C0=__builtin_amdgcn_mfma_f32_32x32x16_bf16(kf[2],qr[1],C0,0,0,0),   P0[10],P0[11],P0[12],P0[13], pw1[0]=PKW(P0,8), pw1[1]=PKW(P0,10), pw1); \
    VRD(5); SBAR(); GAPA(C1=__builtin_amdgcn_mfma_f32_32x32x16_bf16(kf[3],qr[1],C1,0,0,0),   P0[14],P0[15],P1[0],P1[1],   pw1[2]=PKW(P0,12),pw1[3]=PKW(P0,14), pw1); \
    VRD(2); SBAR(); GAPA(C0=__builtin_amdgcn_mfma_f32_32x32x16_bf16(kf[4],qr[2],C0,0,0,0),   P1[2],P1[3],P1[4],P1[5],     pw2[0]=PKW(P1,0), pw2[1]=PKW(P1,2), pw2); \
    VRD(6); SBAR(); GAPA(C1=__builtin_amdgcn_mfma_f32_32x32x16_bf16(kf[5],qr[2],C1,0,0,0),   P1[6],P1[7],P1[8],P1[9],     pw2[2]=PKW(P1,4), pw2[3]=PKW(P1,6), pw2); \
    VRD(3); SBAR(); GAPA(C0=__builtin_amdgcn_mfma_f32_32x32x16_bf16(kf[6],qr[3],C0,0,0,0),   P1[10],P1[11],P1[12],P1[13], pw3[0]=PKW(P1,8), pw3[1]=PKW(P1,10), pw3); \
    VRD(7); SBAR(); GAPA(C1=__builtin_amdgcn_mfma_f32_32x32x16_bf16(kf[7],qr[3],C1,0,0,0),   P1[14],P1[15],0.f,0.f,       pw3[2]=PKW(P1,12),pw3[3]=PKW(P1,14), pw3); \
    l_reg+=sacc; \
    if(GK){DMA_K((t)+3,sl_cur);} if(GV){DMA_V((t)+1,sl_next);} \
    CMASK(C0,C1,t); \
    { float a=MX3(C0[0],C0[1],C1[0]),b=MX3(C0[2],C0[3],C1[1]); a=MX3(a,C1[2],C1[3]); \
      _Pragma("unroll") for(int r=4;r<16;r+=4){a=MX3(a,C0[r],C0[r+1]);b=MX3(b,C0[r+2],C0[r+3]);a=MX3(a,C1[r],C1[r+1]);b=MX3(b,C1[r+2],C1[r+3]);} \
      float rm=__builtin_fmaxf(a,b); { auto rr=__builtin_amdgcn_permlane32_swap(__float_as_uint(rm),__float_as_uint(rm),false,false); rm=__builtin_fmaxf(__uint_as_float(rr[0]),__uint_as_float(rr[1])); } \
      resc=false; \
      if(__builtin_expect(__any(rm>(float)THRL),0)){ const float dl=__builtin_fmaxf(rm,0.f); mhat+=dl; \
        _Pragma("unroll") for(int r=0;r<16;++r){C0[r]-=dl;C1[r]-=dl;} \
        _Pragma("unroll") for(int r=0;r<16;++r)negm[r]=-mhat; asm volatile("":"+v"(negm)); \
        const float f=__builtin_amdgcn_exp2f(-dl); l_reg*=f; if(hi==0)wsf[r32]=f; resc=true; } } \
    SBAR(); \
    GAPB(o[0]=__builtin_amdgcn_mfma_f32_32x32x16_bf16(PAF(0),VFR(0),o[0],0,0,0), C0,0); \
    GAPB(o[1]=__builtin_amdgcn_mfma_f32_32x32x16_bf16(PAF(0),VFR(4),o[1],0,0,0), C0,4); \
    KRD(GL,0); GAPB(o[0]=__builtin_amdgcn_mfma_f32_32x32x16_bf16(PAF(1),VFR(1),o[0],0,0,0), C0,8); \
    KRD(GL,1); GAPB(o[1]=__builtin_amdgcn_mfma_f32_32x32x16_bf16(PAF(1),VFR(5),o[1],0,0,0), C0,12); \
    KRD(GL,2); GAPB(o[0]=__builtin_amdgcn_mfma_f32_32x32x16_bf16(PAF(2),VFR(2),o[0],0,0,0), C1,0); \
    KRD(GL,3); GAPB(o[1]=__builtin_amdgcn_mfma_f32_32x32x16_bf16(PAF(2),VFR(6),o[1],0,0,0), C1,4); \
    GAPB(o[0]=__builtin_amdgcn_mfma_f32_32x32x16_bf16(PAF(3),VFR(3),o[0],0,0,0), C1,8); \
    GAPB(o[1]=__builtin_amdgcn_mfma_f32_32x32x16_bf16(PAF(3),VFR(7),o[1],0,0,0), C1,12); \
    }while(0)
  int t=1;
  for(;t+5<NT;t+=2){
    STEP(pB0,pB1,pA0,pA1,t,true,true,true);     WAIT_BAR(2); RESC(); ROT();
    STEP(pA0,pA1,pB0,pB1,t+1,true,true,true);   WAIT_BAR(2); RESC(); ROT();
  }
  #define ENDW(tt) do{ if((tt)+3<NT){WAIT_BAR(2);} else if((tt)+2<NT){WAIT_BAR(1);} else {WAIT_BAR(0);} }while(0)
  for(;t+1<NT;t+=2){
    STEP(pB0,pB1,pA0,pA1,t,(t+3<NT),(t+1<NT),(t+1<NT));       ENDW(t);   RESC(); ROT();
    STEP(pA0,pA1,pB0,pB1,t+1,(t+4<NT),(t+2<NT),(t+2<NT));     ENDW(t+1); RESC(); ROT();
  }
  STEP(pB0,pB1,pA0,pA1,NT-1,false,false,false); RESC();
  { float sacc=pB0[0]+pB0[1]; _Pragma("unroll") for(int r=2;r<16;++r)sacc+=pB0[r]; _Pragma("unroll") for(int r=0;r<16;++r)sacc+=pB1[r]; l_reg+=sacc;
    pw0=(u32x4){PKW(pB0,0),PKW(pB0,2),PKW(pB0,4),PKW(pB0,6)};pw1=(u32x4){PKW(pB0,8),PKW(pB0,10),PKW(pB0,12),PKW(pB0,14)};pw2=(u32x4){PKW(pB1,0),PKW(pB1,2),PKW(pB1,4),PKW(pB1,6)};pw3=(u32x4){PKW(pB1,8),PKW(pB1,10),PKW(pB1,12),PKW(pB1,14)};
    SBAR(); pv(o,vb0+sl_cur,PAF(0),PAF(1),PAF(2),PAF(3)); }
  #undef PKW
  #undef PAF
  #undef VFR
  #undef PIN
  #undef MX3
  #undef GAPA
  #undef GAPB
  #undef EX
  #undef VRD
  #undef KRD
  #undef STEP
  #undef ENDW
  l_reg+=__shfl_xor(l_reg,32);
  l_reg+=__builtin_amdgcn_exp2f(sinkp[hsub]*1.4426950408889634f-mhat);
  if(hi==0)wsf[32+r32]=l_reg;asm volatile("s_waitcnt lgkmcnt(0)":::"memory");
  float rli[16];
  #pragma unroll
  for(int r=0;r<16;++r)rli[r]=__builtin_amdgcn_rcpf(wsf[32+crow(r,hi)]);
  bf16*Ow=Ou+(long)psub*OP+hsub*D;
  { bf16*stg=(bf16*)(shm+LDS_OST)+wid*2048;
    #pragma unroll
    for(int r=0;r<16;++r){const int orow=crow(r,hi);
      #pragma unroll
      for(int d0=0;d0<2;++d0)stg[orow*64+d0*32+r32]=__float2bfloat16(o[d0][r]*rli[r]);}
    asm volatile("s_waitcnt lgkmcnt(0)":::"memory");
    #pragma unroll
    for(int i=0;i<4;++i){const int row=i*8+(lane>>3),ch=lane&7; const u32x4 v=*(const u32x4*)(stg+row*64+ch*8); ATTN_STORE16(Ow+(long)row*OP+ch*8,v);} }
  asm volatile("s_waitcnt lgkmcnt(0)\n\ts_barrier":::"memory");
  #undef DMA_K
  #undef DMA_V
  #undef KP0
  #undef TROW
  #undef CMASK
  #undef START
  #undef RESC
  #undef ROT
}
constexpr int ATTN_LDS_BYTES=LDS_BYTES;
#undef SBAR
#undef WAIT_BAR
}

constexpr int SLAB_PITCH = 288;
typedef short v4i16_t __attribute__((ext_vector_type(4)));
template <int MT, class RowAddr, class Epi>
__device__ __forceinline__ void slab_gemm(LAS unsigned char* lds, const bf16* Cmat, const int K, const RowAddr& RA, const Epi& E) {
    int tid = threadIdx.x; asm volatile("" : "+v"(tid));
    const int wid = tid >> 6, lane = tid & 63;
    LAS bf16* Dr = (LAS bf16*)lds;
    f32x16 acc[MT];
#pragma unroll
    for (int i = 0; i < MT; ++i)
#pragma unroll
        for (int r = 0; r < 16; ++r) acc[i][r] = 0.f;
    const int g = (lane >> 4) & 1, h = lane >> 5, qq = (lane & 15) >> 2, pp = lane & 3;
    const LAS bf16* trp = Dr + (8 * h + qq) * SLAB_PITCH + wid * 32 + 16 * g + 4 * pp;
    for (int kc = 0; kc < K; kc += 128) {
        {
            const int k = tid >> 2, qd = tid & 3;
            const bf16* src = RA(kc + k) + qd * 64;
            v4u v[8];
#pragma unroll
            for (int j = 0; j < 8; ++j) v[j] = *(const v4u*)(src + j * 8);
#pragma unroll
            for (int j = 0; j < 8; ++j) *(LAS v4u*)(Dr + k * SLAB_PITCH + qd * 64 + j * 8) = v[j];
        }
        __syncthreads();
        const int kh = h * 8;
#pragma unroll
        for (int s = 0; s < 8; ++s) {
            const v4i16_t b0 = __builtin_amdgcn_ds_read_tr16_b64_v4i16((LAS v4i16_t*)(trp + (16 * s) * SLAB_PITCH));
            const v4i16_t b1 = __builtin_amdgcn_ds_read_tr16_b64_v4i16((LAS v4i16_t*)(trp + (16 * s + 4) * SLAB_PITCH));
            const bf16x8 bfrag = (bf16x8){b0[0], b0[1], b0[2], b0[3], b1[0], b1[1], b1[2], b1[3]};
#pragma unroll
            for (int mt = 0; mt < MT; ++mt) {
                const bf16x8 afrag = *(const bf16x8*)(Cmat + (size_t)(mt * 32 + (lane & 31)) * K + kc + s * 16 + kh);
                acc[mt] = __builtin_amdgcn_mfma_f32_32x32x16_bf16(afrag, bfrag, acc[mt], 0, 0, 0);
            }
        }
        __syncthreads();
    }
    E(acc, wid, lane, lds);
}

struct Args { const float* in[23]; float* out; unsigned char* ws; int ph_lo, ph_hi; };

constexpr int SOUT_PITCH = 264;
template <int NROWS, bool WT, class RowPtr>
__device__ __forceinline__ void slab_store_rows(LAS unsigned char* lds, const RowPtr& RP) {
    int tid = threadIdx.x; asm volatile("" : "+v"(tid));
    __syncthreads();
#pragma unroll
    for (int k = 0; k < NROWS / 16; ++k) { const int row = (tid >> 5) + 16 * k, chunk = tid & 31;
        const v4u v = *(const LAS v4u*)((LAS bf16*)lds + row * SOUT_PITCH + chunk * 8);
        bf16* dst = RP(row) + chunk * 8;
        if (WT) store16_wt(dst, v); else *(v4u*)dst = v; }
    __syncthreads();
}
struct RowA { const bf16* z; int b, n2; __device__ __forceinline__ const bf16* operator()(int k) const { return z + (size_t)(b * 4096 + 64 * (k & 63) + n2) * 512 + (k >> 6) * 256; } };
struct RowPA { bf16* t2; int b, n2; __device__ __forceinline__ bf16* operator()(int m) const { return t2 + ((size_t)((b * 64 + n2) * 64 + (m & 63)) * 2 + (m >> 6)) * 256; } };
template <bool WT> struct EpiA { bf16* t2; const float2* tw; int b, n2;
    __device__ __forceinline__ void operator()(const f32x16 (&acc)[4], int wid, int lane, LAS unsigned char* lds) const {
        const int ch = wid * 32 + (lane & 31); LAS bf16* so = (LAS bf16*)lds;
#pragma unroll
        for (int mt = 0; mt < 2; ++mt)
#pragma unroll
            for (int r = 0; r < 16; ++r) {
                const int k1 = 32 * mt + (r & 3) + 8 * (r >> 2) + 4 * (lane >> 5);
                const float2 cs = tw[n2 * k1]; const float re = acc[mt][r], im = acc[mt + 2][r];
                const float re2 = cs.x * re + cs.y * im, im2 = cs.x * im - cs.y * re;
                so[k1 * SOUT_PITCH + ch] = (bf16)f2bf(re2); so[(64 + k1) * SOUT_PITCH + ch] = (bf16)f2bf(im2);
            }
        RowPA rp{t2, b, n2}; slab_store_rows<128, WT, RowPA>(lds, rp);
    } };
struct RowB { const bf16* t2; int b, k1; __device__ __forceinline__ const bf16* operator()(int k) const { return t2 + ((size_t)((b * 64 + (k & 63)) * 64 + k1) * 2 + (k >> 6)) * 256; } };
struct RowPB { bf16* mrg; int b, k1; __device__ __forceinline__ bf16* operator()(int k2) const { return mrg + (size_t)(b * 4096 + k1 + 64 * k2) * 1024 + 768; } };
struct EpiB { bf16* mrg; int b, k1;
    __device__ __forceinline__ void operator()(const f32x16 (&acc)[2], int wid, int lane, LAS unsigned char* lds) const {
        const int ch = wid * 32 + (lane & 31); LAS bf16* so = (LAS bf16*)lds;
#pragma unroll
        for (int mt = 0; mt < 2; ++mt)
#pragma unroll
            for (int r = 0; r < 16; ++r) { const int k2 = 32 * mt + (r & 3) + 8 * (r >> 2) + 4 * (lane >> 5); so[k2 * SOUT_PITCH + ch] = (bf16)f2bf(DBG_NO_FOUR ? 0.f : acc[mt][r]); }
        RowPB rp{mrg, b, k1}; slab_store_rows<64, false, RowPB>(lds, rp);
    } };
struct RowC { const bf16* z; int b; __device__ __forceinline__ const bf16* operator()(int k) const { return z + (size_t)(T + b * 256 + (k & 255)) * 512 + (k >> 8) * 256; } };
struct RowPC { bf16* mrg; int b, mt0; __device__ __forceinline__ bf16* operator()(int kk) const { return mrg + (size_t)(T + b * 256 + 32 * mt0 + kk) * 1024 + 768; } };
struct EpiC { bf16* mrg; int b, mt0;
    __device__ __forceinline__ void operator()(const f32x16 (&acc)[1], int wid, int lane, LAS unsigned char* lds) const {
        const int ch = wid * 32 + (lane & 31); LAS bf16* so = (LAS bf16*)lds;
#pragma unroll
        for (int r = 0; r < 16; ++r) { const int kk = (r & 3) + 8 * (r >> 2) + 4 * (lane >> 5); so[kk * SOUT_PITCH + ch] = (bf16)f2bf(DBG_NO_FOUR ? 0.f : acc[0][r]); }
        RowPC rp{mrg, b, mt0}; slab_store_rows<32, false, RowPC>(lds, rp);
    } };

__device__ __forceinline__ void tr_block(const float* src, int ldS, bf16* dst, int ldD, LAS float* scr, int lane) {
#pragma unroll 8
    for (int i = 0; i < 32; ++i) { const int kk = 2 * i + (lane >> 5); scr[kk * 33 + (lane & 31)] = src[(size_t)kk * ldS + (lane & 31)]; }
    LDS_WAIT(); asm volatile("" ::: "memory");
    const int c = lane & 7;
#pragma unroll
    for (int j = 0; j < 4; ++j) { const int n = (lane >> 3) + 8 * j; const LAS float* s = scr + (8 * c) * 33 + n;
        v4u o; o.x = pk2(s[0 * 33], s[1 * 33]); o.y = pk2(s[2 * 33], s[3 * 33]); o.z = pk2(s[4 * 33], s[5 * 33]); o.w = pk2(s[6 * 33], s[7 * 33]);
        *(GAS v4u*)(dst + (size_t)n * ldD + 8 * c) = o; }
    LDS_WAIT(); asm volatile("" ::: "memory");
}


__device__ __forceinline__ void tr_block64(const float* src, int ldS, bf16* dst, int ldD, LAS bf16* scr, int lane) {
    const int kr = lane >> 4, nc = lane & 15;
    f32x4 v[16];
#pragma unroll
    for (int i = 0; i < 16; ++i) v[i] = *(const f32x4*)(src + (size_t)(4 * i + kr) * ldS + 4 * nc);
#pragma unroll
    for (int i = 0; i < 16; ++i) { const int k = 4 * i + kr;
#pragma unroll
        for (int j = 0; j < 4; ++j) scr[(4 * nc + j) * 66 + k] = (bf16)f2bf(v[i][j]); }
    LDS_WAIT(); asm volatile("" ::: "memory");
    const int c = lane & 7;
#pragma unroll
    for (int j = 0; j < 8; ++j) { const int n = (lane >> 3) + 8 * j; const LAS unsigned* p = (const LAS unsigned*)(scr + n * 66 + 8 * c);
        v4u o; o.x = p[0]; o.y = p[1]; o.z = p[2]; o.w = p[3];
        *(GAS v4u*)(dst + (size_t)n * ldD + 8 * c) = o; }
    LDS_WAIT(); asm volatile("" ::: "memory");
}

typedef const __attribute__((address_space(4))) Args* kargs_t;
__device__ __forceinline__ kargs_t ka_launder() { kargs_t p = (kargs_t)__builtin_amdgcn_kernarg_segment_ptr(); asm volatile("" : "+s"(p)); return p; }
__device__ __forceinline__ int tid_launder() { int t = threadIdx.x; asm volatile("" : "+v"(t)); return t; }
#define KA_DECL const kargs_t KA = ka_launder(); const int tid = tid_launder(); const int lane = tid & 63; const int wave = __builtin_amdgcn_readfirstlane(tid >> 6); const int gw = vcu * 8 + wave; const int gt = vcu * 512 + tid; (void)lane; (void)wave; (void)gw; (void)gt;
#define ws (KA->ws)
#define ctl ((gu32*)(ws + O_CTL))
#define x_in (KA->in[0])
#define c_in (KA->in[1])
#define ctx_in (KA->in[2])
#define cctx_in (KA->in[3])
#define w_mod (KA->in[4])
#define b_mod (KA->in[5])
#define norm1_g (KA->in[6])
#define w_in (KA->in[7])
#define q_norm_g (KA->in[8])
#define k_norm_g (KA->in[9])
#define attn_sink (KA->in[10])
#define pool_w (KA->in[11])
#define pool_scale (KA->in[12])
#define four_w (KA->in[13])
#define w_out (KA->in[14])
#define norm2_g (KA->in[15])
#define w_grp (KA->in[16])
#define b_grp (KA->in[17])
#define w_rtr (KA->in[18])
#define b_rtr (KA->in[19])
#define w_gate (KA->in[20])
#define w_up (KA->in[21])
#define w_down (KA->in[22])
#define outp (KA->out)
#define modv ((float*)(ws + O_MOD))
#define rope ((float2*)(ws + O_ROPE))
#define twt ((float2*)(ws + O_TW))
#define fma ((bf16*)(ws + O_FMA))
#define fmb ((bf16*)(ws + O_FMB))
#define fmc ((bf16*)(ws + O_FMC))
#define hbuf ((bf16*)(ws + O_H))
#define kall ((bf16*)(ws + O_KALL))
#define vall ((bf16*)(ws + O_VALL))
#define xc ((float*)(ws + O_XC))
#define list ((unsigned*)(ws + O_LIST))
#define wts ((float*)(ws + O_WTS))
#define act ((bf16*)(ws + O_ACT))
#define t2 ((bf16*)(ws + O_T2))
#define mrg ((bf16*)(ws + O_MRG))
#define qb ((bf16*)(ws + O_Q))
#define pu ((bf16*)(ws + O_PU))
#define zb ((bf16*)(ws + O_Z))
#define y2 ((bf16*)(ws + O_Y2))

#ifndef PH_MASK
#define PH_MASK 0x3ffff
#endif
#define IN(k) (lo <= (k) && (k) < hi && ((PH_MASK >> (k)) & 1))
#define SEAM(k) do { if (IN(k) && IN((k) + 1)) xcd_barrier(bar); } while (0)
#define modl (modv + (size_t)l * 5 * 6144)
#define win_t ((bf16*)(ws + O_WIN + l * SZ_WIN1))
#define wout_t ((bf16*)(ws + O_WOUT + l * SZ_WOUT1))
#define wgu_t ((bf16*)(ws + O_WGU + l * SZ_WGU1))
#define wd_t ((bf16*)(ws + O_WD + l * SZ_WD1))
constexpr int CV_A = 256, CV_B = 192, CV_C = 4096, CV_D = 2048, CV_L = CV_A + CV_B + CV_C + CV_D;
__device__ __forceinline__ void conv_item(const kargs_t KA, const int lw, int it, LAS bf16* scr, const int lane) {
    bf16* p_win_t = (bf16*)(ws + O_WIN + lw * SZ_WIN1); bf16* p_wout_t = (bf16*)(ws + O_WOUT + lw * SZ_WOUT1);
    bf16* p_wgu_t = (bf16*)(ws + O_WGU + lw * SZ_WGU1); bf16* p_wd_t = (bf16*)(ws + O_WD + lw * SZ_WD1);
    if (it < CV_A) { const int kb = it >> 4, nb = it & 15; tr_block64(w_in + (size_t)lw * 1024 * 1280 + (size_t)kb * 64 * 1280 + nb * 64, 1280, p_win_t + (size_t)nb * 64 * 1024 + kb * 64, 1024, scr, lane); return; } it -= CV_A;
    if (it < CV_B) { const int kb = 4 + (it >> 4), nb = it & 15; tr_block64(w_out + (size_t)lw * 1024 * 1024 + (size_t)kb * 64 * 1024 + nb * 64, 1024, p_wout_t + (size_t)nb * 64 * 1024 + kb * 64, 1024, scr, lane); return; } it -= CV_B;
    if (it < CV_C) { const int up = it >> 11, r = it & 2047, e = r >> 7, kb = (r >> 3) & 15, nb = r & 7; const int n0 = nb * 64;
        const float* src = (up ? w_up : w_gate) + ((size_t)(lw * 16 + e) * 1024 + kb * 64) * 512 + n0;
        const int drow = (n0 >> 7) * 256 + up * 128 + (n0 & 127);
        tr_block64(src, 512, p_wgu_t + ((size_t)e * 1024 + drow) * 1024 + kb * 64, 1024, scr, lane); return; } it -= CV_C;
    { const int e = it >> 7, kb = (it >> 4) & 7, nb = it & 15;
        tr_block64(w_down + ((size_t)(lw * 16 + e) * 512 + kb * 64) * 1024 + nb * 64, 1024, p_wd_t + ((size_t)e * 1024 + nb * 64) * 512 + kb * 64, 512, scr, lane); }
}
__device__ __forceinline__ void steal_convert(const kargs_t KA, LAS unsigned char* lds, const int G, const int done_idx, const bool drain) {
    int tid = threadIdx.x; asm volatile("" : "+v"(tid));
    const int lane = tid & 63, wave = __builtin_amdgcn_readfirstlane(tid >> 6);
    volatile LAS int* mb = (volatile LAS int*)(lds + MISC_OFF + 64);
    LAS bf16* scr = (LAS bf16*)(lds + wave * 16384);
    __syncthreads();
    if (tid == 0 && !drain) __hip_atomic_fetch_add((unsigned*)(ctl + CW_DONE + 64 * done_idx), 1u, RLX_AGENT);
    for (;;) {
        if (tid == 0) { int idx = -1;
            const bool stop = !drain && __hip_atomic_load((unsigned*)(ctl + CW_DONE + 64 * done_idx), RLX_AGENT) >= (unsigned)G;
            if (!stop) idx = (int)__hip_atomic_fetch_add((unsigned*)(ctl + CW_Q), 8u, RLX_AGENT);
            mb[0] = idx; }
        __syncthreads();
        const int idx = mb[0];
        __syncthreads();
        if (idx < 0 || idx >= CV_L) break;
        if (idx + wave < CV_L) conv_item(KA, 1, idx + wave, scr, lane);
    }
    __syncthreads();
}

template <int l> __device__ __forceinline__ void layer_body(LAS unsigned char* lds, const int G, const int vcu, const XcdBarrier& bar, const int lo, const int hi) {
    const int NGW = G * 8, NGT = G * 512; LAS int* ttab = (LAS int*)(lds + TILE_OFF);
    constexpr int P = 1 + 8 * l;

        for (int rep_ = 0; rep_ < 1 + ((l == 0) ? ((REP_MASK >> (1 + 0)) & 1) : 0); ++rep_)
        if (IN(P + 0)) {
            KA_DECL
            const float* modp = modv;
            if (l == 1) steal_convert(KA, lds, G, 3, true);
#pragma clang loop vectorize(disable) unroll(disable)
            for (int r0 = gw; r0 < TT; r0 += 2 * NGW) {
                const int r1 = r0 + NGW; const bool has1 = r1 < TT;
                f32x4 va[4], vb[4]; v2u yaa[4], yab[4], yba[4], ybb[4];
                const float* srca; const float* srcb;
                { const bool isc = r0 >= T; srca = (l == 0) ? (isc ? ctx_in + (size_t)(r0 - T) * 1024 : x_in + (size_t)r0 * 1024) : (isc ? xc + (size_t)(r0 - T) * 1024 : outp + (size_t)r0 * 1024); }
                { const int rr = has1 ? r1 : r0; const bool isc = rr >= T; srcb = (l == 0) ? (isc ? ctx_in + (size_t)(rr - T) * 1024 : x_in + (size_t)rr * 1024) : (isc ? xc + (size_t)(rr - T) * 1024 : outp + (size_t)rr * 1024); }
#pragma unroll
                for (int j = 0; j < 4; ++j) { va[j] = *(const f32x4*)(srca + 4 * lane + 256 * j); vb[j] = *(const f32x4*)(srcb + 4 * lane + 256 * j); }
                if (l == 1) {
                    const int rr = has1 ? r1 : r0;
#pragma unroll
                    for (int j = 0; j < 4; ++j) { yaa[j] = *(const v2u*)(y2 + (size_t)(2 * r0) * 1024 + 4 * lane + 256 * j); yab[j] = *(const v2u*)(y2 + (size_t)(2 * r0 + 1) * 1024 + 4 * lane + 256 * j);
                        yba[j] = *(const v2u*)(y2 + (size_t)(2 * rr) * 1024 + 4 * lane + 256 * j); ybb[j] = *(const v2u*)(y2 + (size_t)(2 * rr + 1) * 1024 + 4 * lane + 256 * j); }
                }
#pragma unroll
                for (int half = 0; half < 2; ++half) {
                    if (half == 1 && !has1) break;
                    const int r = half ? r1 : r0; f32x4 (&v)[4] = half ? vb : va; v2u (&ya)[4] = half ? yba : yaa; v2u (&yb)[4] = half ? ybb : yab;
                    const bool isc = r >= T; const int bsel = isc ? 4 : (r >> 12);
                    if (l == 1) {
                        const float* g2 = modp + bsel * 6144 + 5 * 1024; float* dst = isc ? xc + (size_t)(r - T) * 1024 : outp + (size_t)r * 1024;
#pragma unroll
                        for (int j = 0; j < 4; ++j) {
                            const f32x4 gv = *(const f32x4*)(g2 + 4 * lane + 256 * j);
                            f32x4 yy; yy[0] = bflo(ya[j].x) + bflo(yb[j].x); yy[1] = bfhi(ya[j].x) + bfhi(yb[j].x); yy[2] = bflo(ya[j].y) + bflo(yb[j].y); yy[3] = bfhi(ya[j].y) + bfhi(yb[j].y);
                            if (DBG_NO_MOE) yy = (f32x4){0.f, 0.f, 0.f, 0.f};
                            v[j] = v[j] + gv * yy; *(f32x4*)(dst + 4 * lane + 256 * j) = v[j];
                        }
                    }
                    float ss = 0.f;
#pragma unroll
                    for (int j = 0; j < 4; ++j) ss += (v[j][0] * v[j][0] + v[j][1] * v[j][1]) + (v[j][2] * v[j][2] + v[j][3] * v[j][3]);
                    const float rstd = 1.0f / sqrtf(wave_sum(ss) * (1.f / 1024.f) + 1e-6f);
                    const float* sh = modl + bsel * 6144; const float* sc = sh + 1024; const float* gn = norm1_g + l * 1024;
#pragma unroll
                    for (int j = 0; j < 4; ++j) {
                        const int c0 = 4 * lane + 256 * j; const f32x4 g = *(const f32x4*)(gn + c0), s1 = *(const f32x4*)(sc + c0), h1 = *(const f32x4*)(sh + c0);
                        const f32x4 y = (v[j] * rstd) * g * (s1 + 1.0f) + h1;
                        v2u o; o.x = pk2(y[0], y[1]); o.y = pk2(y[2], y[3]); *(v2u*)(hbuf + (size_t)r * 1024 + c0) = o;
                    }
                }
            }
        }
        SEAM(P + 0);
        for (int rep_ = 0; rep_ < 1 + ((l == 0) ? ((REP_MASK >> (1 + 1)) & 1) : 0); ++rep_)
        if (IN(P + 1)) {
            KA_DECL
            SchedPlain S{TT / 256, 6, G, vcu, 1024, (const char*)hbuf, (const char*)win_t};
            EpiG1 E{pu, qb, kall, vall, zb};
            pg8::gemm_phase<EpiG1, SchedPlain>(lds, S, E);
            if (l == 0 && !MK_SPLIT) steal_convert(KA, lds, G, 0, false);
        }
        SEAM(P + 1);
        if (IN(P + 3)) {
            KA_DECL
            gu32* kflag = ctl + CW_KF + l * 16384;
            gu32* facnt = ctl + CW_FA + l * 64;
            for (int it = vcu; it < 256; it += G) {
                const int b = it >> 6, n2 = it & 63;
                RowA ra{zb, b, n2}; EpiA<true> ea{t2, twt, b, n2};
                slab_gemm<4, RowA, EpiA<true>>(lds, fma, 128, ra, ea);
                asm volatile("s_waitcnt vmcnt(0)" ::: "memory");
                __syncthreads();
                if (tid == 0) __hip_atomic_fetch_add((unsigned*)(facnt + 16 * b), 1u, RLX_AGENT);
            }
            const int n_att = 512 + (l == 0 ? 32 : 0);
            for (int it = vcu; it < n_att; it += G) {
                const bool cu = it >= 512; const int uidx = cu ? it - 512 : it;
                const int b = cu ? (uidx >> 3) : (uidx >> 7), kvh = cu ? ((uidx >> 2) & 1) : ((uidx >> 6) & 1), pb = cu ? (uidx & 3) : (uidx & 63);
                const int p0 = pb * 64; const int qrow0 = cu ? T + b * 256 + p0 : b * 4096 + p0;
                if (!cu) {
                    const int row = tid >> 3, c = tid & 7;
                    const float* kg = k_norm_g + l * 64 + 8 * c;
#pragma unroll
                    for (int part = 0; part < 2; ++part) {
                        if (part == 1 && pb >= 4) break;
                        const int blk = part ? pb : 4 + pb;
                        bf16* p = kall + ((size_t)b * KVROWS + blk * 64 + row) * 128 + kvh * 64 + c * 8;
                        const v4u w = *(const v4u*)p;
                        float x[8] = {bflo(w.x), bfhi(w.x), bflo(w.y), bfhi(w.y), bflo(w.z), bfhi(w.z), bflo(w.w), bfhi(w.w)};
                        float ss = 0.f;
#pragma unroll
                        for (int i = 0; i < 8; ++i) ss += x[i] * x[i];
                        ss += __shfl_xor(ss, 1); ss += __shfl_xor(ss, 2); ss += __shfl_xor(ss, 4);
                        const float rstd = 1.0f / sqrtf(ss * (1.f / 64.f) + 1e-6f);
#pragma unroll
                        for (int i = 0; i < 8; ++i) x[i] *= rstd * kg[i];
                        if (part == 0) {
                            const float2* rp = rope + (size_t)(p0 + row) * 32 + ((c & 4) ? 16 : 0) + (c & 1) * 8;
#pragma unroll
                            for (int i = 0; i < 8; ++i) { const float y = __shfl_xor(x[i], 2); const float2 cs = rp[i]; x[i] = (c & 2) ? (x[i] * cs.x + y * cs.y) : (x[i] * cs.x - y * cs.y); }
                        }
                        v4u o; o.x = pk2(x[0], x[1]); o.y = pk2(x[2], x[3]); o.z = pk2(x[4], x[5]); o.w = pk2(x[6], x[7]);
                        store16_wt(p, o);
                    }
                    asm volatile("s_waitcnt vmcnt(0)" ::: "memory");
                    __syncthreads();
                    if (tid == 0) { __hip_atomic_store(kflag + 16 * ((b * 68 + 4 + pb) * 2 + kvh), 1u, RLX_AGENT); if (pb < 4) __hip_atomic_store(kflag + 16 * ((b * 68 + pb) * 2 + kvh), 1u, RLX_AGENT); }
                }
                if (tid < 64) {
                    int blk = -1;
                    if (lane < 4) blk = lane; else if (!cu && lane < 9) { const int q = pb + lane - 6; if (q >= 0 && q < 64) blk = 4 + q; }
                    unsigned sp = 0;
                    for (;;) { const unsigned f = (blk >= 0) ? __hip_atomic_load(kflag + 16 * ((b * 68 + blk) * 2 + kvh), RLX_AGENT) : 1u;
                        if (__all(f != 0u)) break; __builtin_amdgcn_s_sleep(2);
                        if (++sp > (1u << 22)) { if (tid == 0) __hip_atomic_store(ctl + CW_TMO, 2u, RLX_AGENT); break; } }
                    __builtin_amdgcn_fence(__ATOMIC_ACQUIRE, "agent");
                    asm volatile("s_waitcnt vmcnt(0)" ::: "memory");
                }
                __syncthreads();
                const attn_body::bf16* Qu = (const attn_body::bf16*)(qb + (size_t)qrow0 * 512 + kvh * 256);
                const attn_body::bf16* Kh = (const attn_body::bf16*)(kall + (size_t)b * KVROWS * 128 + kvh * 64);
                const attn_body::bf16* Vh = (const attn_body::bf16*)(vall + (size_t)b * KVROWS * 128 + kvh * 64);
                attn_body::bf16* Ou = (attn_body::bf16*)(mrg + (size_t)qrow0 * 1024 + 256 + kvh * 256);
                attn_body::attn_unit<8>(Qu, Kh, Vh, Ou, p0, cu ? 4 : 10, attn_sink + l * 8 + kvh * 4, q_norm_g + l * 64, cu ? (const float2*)nullptr : (const float2*)rope, (char*)lds);
                __syncthreads();
            }
            const int prow = (l == 0) ? TT : T; const int nrb = prow >> 3;
#pragma clang loop vectorize(disable) unroll(disable)
            for (int i = gt; i < 32 * nrb; i += NGT) {
                const int ck8 = i & 7, rb = (i >> 3) % nrb, g = (i >> 3) / nrb;
                const int r0 = rb * 8; const bool isc = r0 >= T;
                const int nseq = isc ? LCTX : NSEQ; const int rbase = isc ? T + ((r0 - T) & ~255) : (r0 & ~4095); const int n0 = r0 - rbase;
                const int hw = 1 << g; const int col = g * 64 + ck8 * 8;
                const bf16* up = pu + (size_t)rbase * 256 + col;
                float sm[8] = {0.f, 0.f, 0.f, 0.f, 0.f, 0.f, 0.f, 0.f};
#define POOL_ACC(W, SGN) do { sm[0] += SGN bflo(W.x); sm[1] += SGN bfhi(W.x); sm[2] += SGN bflo(W.y); sm[3] += SGN bfhi(W.y); sm[4] += SGN bflo(W.z); sm[5] += SGN bfhi(W.z); sm[6] += SGN bflo(W.w); sm[7] += SGN bfhi(W.w); } while (0)
                for (int tpos = n0 - hw; tpos < n0 + hw; ++tpos) if (tpos >= 0 && tpos < nseq) { const v4u w = *(const v4u*)(up + (size_t)tpos * 256); POOL_ACC(w, +); }
#pragma unroll
                for (int k = 0; k < 8; ++k) {
                    const int n = n0 + k; int lo_ = n - hw; lo_ = lo_ < 0 ? 0 : lo_; int hi_ = n + hw - 1; hi_ = hi_ > nseq - 1 ? nseq - 1 : hi_;
                    const v4u w = *(const v4u*)(up + (size_t)n * 256); const float ic = 1.0f / (float)(hi_ - lo_ + 1);
                    v4u o; o.x = pk2(sm[0] * ic - bflo(w.x), sm[1] * ic - bfhi(w.x)); o.y = pk2(sm[2] * ic - bflo(w.y), sm[3] * ic - bfhi(w.y));
                    o.z = pk2(sm[4] * ic - bflo(w.z), sm[5] * ic - bfhi(w.z)); o.w = pk2(sm[6] * ic - bflo(w.w), sm[7] * ic - bfhi(w.w));
                    if (DBG_NO_POOL) o = (v4u){0u, 0u, 0u, 0u};
                    *(v4u*)(mrg + (size_t)(rbase + n) * 1024 + col) = o;
                    if (k < 7) { const int tin = n + hw, tout = n - hw;
                        if (tin < nseq) { const v4u wi = *(const v4u*)(up + (size_t)tin * 256); POOL_ACC(wi, +); }
                        if (tout >= 0) { const v4u wo = *(const v4u*)(up + (size_t)tout * 256); POOL_ACC(wo, -); } }
                }
#undef POOL_ACC
            }
            for (int it = vcu; it < 256; it += G) {
                const int b = it >> 6, k1 = it & 63;
                __syncthreads();
                if (tid < 64) { unsigned sp = 0;
                    while ((unsigned)__builtin_amdgcn_readfirstlane(__hip_atomic_load((unsigned*)(facnt + 16 * b), RLX_AGENT)) < 64u) { __builtin_amdgcn_s_sleep(2); if (++sp > (1u << 22)) { if (tid == 0) __hip_atomic_store(ctl + CW_TMO, 3u, RLX_AGENT); break; } }
                    __builtin_amdgcn_fence(__ATOMIC_ACQUIRE, "agent");
                    asm volatile("s_waitcnt vmcnt(0)" ::: "memory"); }
                __syncthreads();
                RowB rb{t2, b, k1}; EpiB eb{mrg, b, k1};
                slab_gemm<2, RowB, EpiB>(lds, fmb, 128, rb, eb);
            }
            if (l == 0) for (int it = (G - 1 - vcu); it < 32; it += G) {
                const int b = it >> 3, mt0 = it & 7;
                RowC rc{zb, b}; EpiC ec{mrg, b, mt0};
                slab_gemm<1, RowC, EpiC>(lds, fmc + (size_t)mt0 * 32 * 512, 512, rc, ec);
            }
        }
        SEAM(P + 3);
        for (int rep_ = 0; rep_ < 1 + ((l == 0) ? ((REP_MASK >> (1 + 4)) & 1) : 0); ++rep_)
        if (IN(P + 4)) {
            KA_DECL
            SchedPlain S{(l == 0 ? TT : T) / 256, 4, G, vcu, 1024, (const char*)mrg, (const char*)wout_t};
            EpiG2 E{(l == 0) ? x_in : outp, ctx_in, outp, xc, modl};
            pg8::gemm_phase<EpiG2, SchedPlain>(lds, S, E);
            if (l == 0 && !MK_SPLIT) steal_convert(KA, lds, G, 1, false);
        }
        SEAM(P + 4);
        for (int rep_ = 0; rep_ < 1 + ((l == 0) ? ((REP_MASK >> 6) & 1) : 0); ++rep_)
        if (IN(P + 5)) {
            KA_DECL
            __syncthreads();
            LAS float* rw = (LAS float*)lds;
            LAS int* lcnt = (LAS int*)(lds + 81920);
            LAS unsigned* lent = (LAS unsigned*)(lds + 81920 + 256);
            LAS unsigned* lrank = lent + 1024;
            for (int i = tid; i < 1024 * 20; i += 512) { const int d = i / 20, j = i % 20;
                rw[((((j >> 2) * 4 + (d >> 8)) * 4 + (d & 3)) * 64 + ((d & 255) >> 2)) * 4 + (j & 3)] = (j < 4) ? w_grp[(size_t)l * 4096 + d * 4 + j] : w_rtr[(size_t)l * 16384 + d * 16 + (j - 4)]; }
            if (tid < 33) lcnt[tid] = 0;
            __syncthreads();
            const int nrows = (l == 0) ? TT : T; const int ngrp = nrows >> 2;
#pragma clang loop vectorize(disable) unroll(disable)
            for (int q = gw; q < ngrp; q += NGW) {
                const int rb4 = 4 * q; const bool isc = rb4 >= T; const int bsel = isc ? 4 : (rb4 >> 12);
                const float* src = isc ? xc + (size_t)(rb4 - T) * 1024 : outp + (size_t)rb4 * 1024;
                f32x4 v[4][4];
#pragma unroll
                for (int tk = 0; tk < 4; ++tk)
#pragma unroll
                    for (int j = 0; j < 4; ++j) v[tk][j] = *(const f32x4*)(src + (size_t)tk * 1024 + 4 * lane + 256 * j);
                float rstd[4];
#pragma unroll
                for (int tk = 0; tk < 4; ++tk) { float ss = 0.f;
#pragma unroll
                    for (int j = 0; j < 4; ++j) ss += (v[tk][j][0] * v[tk][j][0] + v[tk][j][1] * v[tk][j][1]) + (v[tk][j][2] * v[tk][j][2] + v[tk][j][3] * v[tk][j][3]);
                    rstd[tk] = 1.0f / sqrtf(wave_sum(ss) * (1.f / 1024.f) + 1e-6f); }
                const float* sh = modl + bsel * 6144 + 3 * 1024; const float* sc = sh + 1024; const float* gn = norm2_g + l * 1024;
                float lg[4][20];
#pragma unroll
                for (int tk = 0; tk < 4; ++tk)
#pragma unroll
                    for (int j = 0; j < 20; ++j) lg[tk][j] = 0.f;
#pragma unroll
                for (int j = 0; j < 4; ++j) {
                    const int c0 = 4 * lane + 256 * j; const f32x4 g = *(const f32x4*)(gn + c0), s1 = *(const f32x4*)(sc + c0), h1 = *(const f32x4*)(sh + c0);
                    f32x4 y[4];
#pragma unroll
                    for (int tk = 0; tk < 4; ++tk) { y[tk] = (v[tk][j] * rstd[tk]) * g * (s1 + 1.0f) + h1;
                        v2u o; o.x = pk2(y[tk][0], y[tk][1]); o.y = pk2(y[tk][2], y[tk][3]); *(v2u*)(hbuf + (size_t)(rb4 + tk) * 1024 + c0) = o; }
#pragma unroll
                    for (int e = 0; e < 4; ++e) {
#pragma unroll
                        for (int q5 = 0; q5 < 5; ++q5) { const f32x4 wv = *(const LAS f32x4*)(rw + (((q5 * 4 + j) * 4 + e) * 64 + lane) * 4);
#pragma unroll
                            for (int tk = 0; tk < 4; ++tk) { lg[tk][4 * q5] += y[tk][e] * wv[0]; lg[tk][4 * q5 + 1] += y[tk][e] * wv[1]; lg[tk][4 * q5 + 2] += y[tk][e] * wv[2]; lg[tk][4 * q5 + 3] += y[tk][e] * wv[3]; } }
                        __builtin_amdgcn_sched_barrier(0); }
                }
                float l2[20];
#pragma unroll
                for (int j = 0; j < 20; ++j) {
                    const float a0 = swap32_sum(lg[0][j], lg[2][j]);
                    const float a1 = swap32_sum(lg[1][j], lg[3][j]);
                    float t = swap16_sum(a0, a1);
                    t += dppf<0x128, 0xf>(t); t += dppf<0x124, 0xf>(t); t += dppf<0x122, 0xf>(t); t += dppf<0x121, 0xf>(t);
                    l2[j] = t;
                }
                const int tk = lane >> 4; const int r = rb4 + tk;
                float gl[4]; float gm = -1e30f;
#pragma unroll
                for (int j = 0; j < 4; ++j) { gl[j] = l2[j] + b_grp[l * 4 + j]; gm = fmaxf(gm, gl[j]); }
                float gs = 0.f; int gi = 0; float gb = -1e30f;
#pragma unroll
                for (int j = 0; j < 4; ++j) { const float e = expf(gl[j] - gm); gs += e; if (gl[j] > gb) { gb = gl[j]; gi = j; } }
                const float pg = expf(gb - gm) / gs;
                float el[4]; float em = -1e30f;
#pragma unroll
                for (int j = 0; j < 4; ++j) { float t_ = 0.f;
#pragma unroll
                    for (int g4 = 0; g4 < 4; ++g4) t_ = (gi == g4) ? (l2[4 + g4 * 4 + j] + b_rtr[l * 16 + g4 * 4 + j]) : t_;
                    el[j] = t_; em = fmaxf(em, t_); }
                float pe[4];
#pragma unroll
                for (int j = 0; j < 4; ++j) pe[j] = expf(el[j] - em);
                int i0 = 0; float b0 = -1.f;
#pragma unroll
                for (int j = 0; j < 4; ++j) if (pe[j] > b0) { b0 = pe[j]; i0 = j; }
                int i1 = 0; float b1 = -1.f;
#pragma unroll
                for (int j = 0; j < 4; ++j) if (j != i0 && pe[j] > b1) { b1 = pe[j]; i1 = j; }
                const float wsum = b0 + b1; const float w0 = pg * b0 / wsum, w1 = pg * b1 / wsum;
                if ((lane & 15) == 0 && rep_ == 0) {
                    wts[2 * r] = w0; wts[2 * r + 1] = w1;
                    const int e0 = gi * 4 + i0, e1 = gi * 4 + i1;
                    const int s0 = __hip_atomic_fetch_add((LAS int*)(lcnt + 16 + 16), 1, __ATOMIC_RELAXED, __HIP_MEMORY_SCOPE_WORKGROUP);
                    const int k0 = __hip_atomic_fetch_add((LAS int*)(lcnt + e0), 1, __ATOMIC_RELAXED, __HIP_MEMORY_SCOPE_WORKGROUP);
                    const int k1 = __hip_atomic_fetch_add((LAS int*)(lcnt + e1), 1, __ATOMIC_RELAXED, __HIP_MEMORY_SCOPE_WORKGROUP);
                    lent[2 * s0] = ((unsigned)(2 * r) << 4) | (unsigned)e0; lrank[2 * s0] = (unsigned)k0;
                    lent[2 * s0 + 1] = ((unsigned)(2 * r + 1) << 4) | (unsigned)e1; lrank[2 * s0 + 1] = (unsigned)k1;
                }
            }
            __syncthreads();
            if (tid < 16 && rep_ == 0) { const int c = lcnt[tid]; lcnt[16 + tid] = c ? (int)__hip_atomic_fetch_add((unsigned*)(ctl + CW_CNT + (l * 16 + tid) * 64), (unsigned)c, RLX_AGENT) : 0; }
            __syncthreads();
            const int ntot = rep_ == 0 ? 2 * lcnt[32] : 0;
            for (int i = tid; i < ntot; i += 512) { const unsigned en = lent[i]; const int e = en & 15; list[(size_t)e * TT + lcnt[16 + e] + lrank[i]] = en >> 4; }
            __syncthreads();
        }
        SEAM(P + 5);
        if (IN(P + 6) || IN(P + 7)) {
            KA_DECL
            __syncthreads();
            if (tid == 0) { int acc_ = 0; for (int e = 0; e < 16; ++e) { const int c = (int)__hip_atomic_load((unsigned*)(ctl + CW_CNT + (l * 16 + e) * 64), RLX_AGENT); ttab[e] = acc_; ttab[17 + e] = c; acc_ += (c + 255) >> 8; } ttab[16] = acc_; }
            __syncthreads();
        }
        if (DBG_NAIVE_MOE && IN(P + 6)) {
            KA_DECL
            const int nrows = (l == 0) ? TT : T; LAS float* hs = (LAS float*)lds; LAS float* as = hs + 1024;
            const int* eidg = (const int*)(ws + O_EID);
            LAS float* lgs = as + 512; LAS float* rt = lgs + 32;
            for (int r = vcu; r < nrows; r += G) {
                __syncthreads();
                for (int i = tid; i < 1024; i += 512) hs[i] = bf2f(hbuf[(size_t)r * 1024 + i]);
                __syncthreads();
                if (tid < 20) { float a = 0.f; for (int k = 0; k < 1024; ++k) a += hs[k] * ((tid < 4) ? w_grp[(size_t)l * 4096 + k * 4 + tid] : w_rtr[(size_t)l * 16384 + k * 16 + (tid - 4)]);
                    lgs[tid] = a + ((tid < 4) ? b_grp[l * 4 + tid] : b_rtr[l * 16 + tid - 4]); }
                __syncthreads();
                if (tid == 0) { int gi = 0; for (int j = 1; j < 4; ++j) if (lgs[j] > lgs[gi]) gi = j; float gs = 0.f; for (int j = 0; j < 4; ++j) gs += expf(lgs[j] - lgs[gi]); const float pg = 1.f / gs;
                    int i0 = 0; for (int j = 1; j < 4; ++j) if (lgs[4 + gi * 4 + j] > lgs[4 + gi * 4 + i0]) i0 = j; int i1 = -1; for (int j = 0; j < 4; ++j) if (j != i0 && (i1 < 0 || lgs[4 + gi * 4 + j] > lgs[4 + gi * 4 + i1])) i1 = j;
                    const float p0 = 1.f, p1 = expf(lgs[4 + gi * 4 + i1] - lgs[4 + gi * 4 + i0]); rt[0] = (float)(gi * 4 + i0); rt[1] = (float)(gi * 4 + i1); rt[2] = pg * p0 / (p0 + p1); rt[3] = pg * p1 / (p0 + p1); }
                __syncthreads();
                for (int sl = 0; sl < 2; ++sl) {
                    const int e = (DBG_NAIVE_ROUTE & 1) ? (int)rt[sl] : eidg[2 * r + sl]; const float w = (DBG_NAIVE_ROUTE & 2) ? rt[2 + sl] : wts[2 * r + sl];
                    __syncthreads();
                    const float* Wg = w_gate + (size_t)(l * 16 + e) * 1024 * 512 + tid; const float* Wu = w_up + (size_t)(l * 16 + e) * 1024 * 512 + tid;
                    float g = 0.f, u = 0.f;
#pragma unroll 8
                    for (int k = 0; k < 1024; ++k) { g += hs[k] * Wg[(size_t)k * 512]; u += hs[k] * Wu[(size_t)k * 512]; }
                    as[tid] = g / (1.f + expf(-g)) * u;
                    __syncthreads();
                    const float* Wd = w_down + (size_t)(l * 16 + e) * 512 * 1024 + tid;
                    float y0 = 0.f, y1 = 0.f;
#pragma unroll 8
                    for (int j = 0; j < 512; ++j) { y0 += as[j] * Wd[(size_t)j * 1024]; y1 += as[j] * Wd[(size_t)j * 1024 + 512]; }
                    y2[(size_t)(2 * r + sl) * 1024 + tid] = (bf16)f2bf(y0 * w); y2[(size_t)(2 * r + sl) * 1024 + 512 + tid] = (bf16)f2bf(y1 * w);
                }
            }
        }
        if (!DBG_NAIVE_MOE && IN(P + 6)) {
            KA_DECL
            unsigned* rdy = (unsigned*)(ctl + CW_RDY + l * 4096);
            SchedMoe S{G, vcu, ttab[16], (const char*)hbuf, (const char*)act, (const char*)wgu_t, (const char*)wd_t, list, ttab, rdy, (unsigned*)(ctl + CW_TMO)};
            EpiMoe E{EpiG3{act, rdy}, EpiG4{y2, list, wts, ttab}};
            pg8::gemm_phase<EpiMoe, SchedMoe>(lds, S, E);
            if (l == 0 && !MK_SPLIT) steal_convert(KA, lds, G, 2, false);
        }
        SEAM(P + 7);
    }

__global__ void __launch_bounds__(512, 2) fwd_kernel(Args args) {
    extern __shared__ __attribute__((aligned(16))) unsigned char lds_raw[];
    LAS unsigned char* lds = (LAS unsigned char*)lds_raw;
    const int tid = threadIdx.x, lane = tid & 63, wave = __builtin_amdgcn_readfirstlane(tid >> 6);
    const int G = gridDim.x; const int bx = blockIdx.x; const int vcu = (G % 8 == 0) ? (bx % 8) * (G / 8) + bx / 8 : bx;
    volatile LAS unsigned* MISC = (volatile LAS unsigned*)(lds + MISC_OFF);
    LAS float* trig = (LAS float*)(lds + TRIG_OFF);
    LAS int* ttab = (LAS int*)(lds + TILE_OFF);
    for (int u = tid; u < (LDS_BYTES - LDSCTL_OFF) / 4; u += 512) ((LAS unsigned*)(lds + LDSCTL_OFF))[u] = 0u;
    __syncthreads();
    if (tid < 64) { float s, c; sincospif((float)tid / 32.f, &s, &c); trig[tid] = c; trig[64 + tid] = s; }
    __syncthreads();
    XcdBarrier bar; bar.bar = nullptr; bar.x = 0; bar.st = nullptr;
    if (!MK_SPLIT) { KA_DECL bar = xcd_barrier_post((unsigned*)(ctl + CW_BAR), MISC + 8); }
    const int lo = args.ph_lo, hi = args.ph_hi;
    const int NGW = G * 8, NGT = G * 512;

    for (int rep_ = 0; rep_ < 1 + ((REP_MASK >> 0) & 1); ++rep_)
    if (IN(0)) {
        KA_DECL
        __syncthreads();
        if (rep_ == 0 || ((REP_MASK >> 13) & 1)) {
            LAS float* sl = (LAS float*)lds;
            bool have = false;
            for (int it = vcu; it < 192; it += G) {
                if (!have) {
                    for (int i = tid; i < 5120; i += 512) { const int r = i >> 10, k = i & 1023; const float v = (r < 4) ? c_in[r * 1024 + k] : cctx_in[k]; sl[i] = v / (1.f + expf(-v)); }
                    __syncthreads(); have = true;
                }
                const int l = it / 96, cb = it % 96;
                const int r4 = lane >> 4, cq = lane & 15; const int k0 = wave * 128;
                const float* W = w_mod + (size_t)l * 1024 * 6144 + (size_t)(k0 + r4) * 6144 + cb * 64 + 4 * cq;
                f32x4 a0 = {0.f, 0.f, 0.f, 0.f}, a1 = a0, a2 = a0, a3 = a0, a4 = a0;
#pragma unroll 8
                for (int k = 0; k < 32; ++k) { const f32x4 wv = *(const f32x4*)(W + (size_t)(4 * k) * 6144); const int kk = k0 + 4 * k + r4;
                    a0 += wv * sl[kk]; a1 += wv * sl[1024 + kk]; a2 += wv * sl[2048 + kk]; a3 += wv * sl[3072 + kk]; a4 += wv * sl[4096 + kk]; }
                LAS float* part = sl + 5120;
                { LAS float* pp = part + (wave * 4 + r4) * 320 + 4 * cq;
                  *(LAS f32x4*)(pp) = a0; *(LAS f32x4*)(pp + 64) = a1; *(LAS f32x4*)(pp + 128) = a2; *(LAS f32x4*)(pp + 192) = a3; *(LAS f32x4*)(pp + 256) = a4; }
                __syncthreads();
                if (tid < 320) { const int r = tid >> 6, n = tid & 63; float sacc = b_mod[l * 6144 + cb * 64 + n];
#pragma unroll 8
                    for (int w = 0; w < 32; ++w) sacc += part[w * 320 + r * 64 + n];
                    modv[(size_t)(l * 5 + r) * 6144 + cb * 64 + n] = sacc; }
                __syncthreads();
            }
            __syncthreads();
        }
        if (rep_ == 0 || ((REP_MASK >> 14) & 1)) {
#pragma clang loop vectorize(disable) unroll(disable)
        for (int i = gt; i < 4096 * 32; i += NGT) {
            const int n = i >> 5, j = i & 31; const int jj = j & 15;
            const float inv = 1.0f / powf(10000.0f, (float)(2 * jj) / 32.0f);
            const float pos = (j < 16) ? (float)(n >> 6) : (float)(n & 63);
            const float ang = pos * inv; rope[i] = make_float2(cosf(ang), sinf(ang));
        }
#pragma clang loop vectorize(disable) unroll(disable)
        for (int i = gt; i < 4096; i += NGT) { float s, c; sincospif((float)i / 2048.f, &s, &c); twt[i] = make_float2(c, s); }
#pragma clang loop vectorize(disable) unroll(disable)
        for (int i = gt; i < 128 * 128; i += NGT) {
            const int m = i >> 7, k = i & 127; const int ri = m >> 6, k1 = m & 63, part = k >> 6, n1 = k & 63;
            float s, c; sincospif((float)((n1 * k1) & 63) / 32.f, &s, &c);
            float v; if (ri == 0) v = (part == 0) ? c : -s; else v = (part == 0) ? -s : -c;
            fma[i] = (bf16)f2bf(v);
        }
#pragma clang loop vectorize(disable) unroll(disable)
        for (int i = gt; i < 64 * 128; i += NGT) {
            const int k2 = i >> 7, k = i & 127; const int ri = k >> 6, n2 = k & 63;
            float s, c; sincospif((float)((n2 * k2) & 63) / 32.f, &s, &c);
            fmb[i] = (bf16)f2bf((ri == 0 ? c : s) * (1.f / 512.f));
        }
#pragma clang loop vectorize(disable) unroll(disable)
        for (int i = gt; i < 256 * 512; i += NGT) {
            const int kk = i >> 9, k = i & 511; const int part = k >> 8, n = k & 255;
            float s, c; sincospif((float)((n * kk) & 255) / 128.f, &s, &c);
            fmc[i] = (bf16)f2bf((part == 0 ? c : -s) * (1.f / 128.f));
        }
        }
        if (rep_ == 0 || ((REP_MASK >> 15) & 1)) {
            LAS float* Al = (LAS float*)lds;
            LAS float* Wl = Al + 4096;
            LAS float* Xl = Wl + 4096;
            for (int it = vcu; it < 256; it += G) {
                const int combo = it & 15, jb = it >> 4; const int l = combo >> 3, g = (combo >> 1) & 3, which = combo & 1;
                const float* Wg = four_w + (size_t)(l * 4 + g) * 4096; const LAS float* tb = trig + which * 64;
                const float* wi = w_in + (size_t)l * 1024 * 1280 + (size_t)(jb * 64) * 1280 + 1024 + g * 64;
                __syncthreads();
#pragma unroll
                for (int i = 0; i < 2; ++i) { const int idx = tid + 512 * i; *(LAS f32x4*)(Wl + 4 * idx) = *(const f32x4*)(Wg + 4 * idx); const int j = idx >> 4, c4 = idx & 15; *(LAS f32x4*)(Xl + j * 64 + 4 * c4) = *(const f32x4*)(wi + (size_t)j * 1280 + 4 * c4); }
                __syncthreads();
                { const int d = tid & 63, c0 = tid >> 6;
#pragma unroll 2
                  for (int i = 0; i < 8; ++i) { const int c = c0 + 8 * i; float a = 0.f;
#pragma unroll 16
                      for (int m = 0; m < 64; ++m) a += tb[(m * c) & 63] * Wl[m * 64 + d];
                      Al[c * 64 + d] = a; } }
                __syncthreads();
                { const int d = tid & 63, jl = 8 * (tid >> 6);
                  float o[8] = {0.f, 0.f, 0.f, 0.f, 0.f, 0.f, 0.f, 0.f};
#pragma unroll 4
                  for (int c = 0; c < 64; ++c) { const float av = Al[c * 64 + d];
#pragma unroll
                      for (int i = 0; i < 8; ++i) o[i] += Xl[(jl + i) * 64 + c] * av; }
                  v4u w; w.x = pk2(o[0], o[1]); w.y = pk2(o[2], o[3]); w.z = pk2(o[4], o[5]); w.w = pk2(o[6], o[7]);
                  *(v4u*)((bf16*)(ws + O_WIN + l * SZ_WIN1) + (size_t)(1024 + which * 256 + g * 64 + d) * 1024 + jb * 64 + jl) = w; }
            }
            for (int it = vcu; it < 256; it += G) {
                const int combo = it & 7, nb = it >> 3; const int l = combo >> 2, g = combo & 3, n0 = nb * 32;
                const float* pwg = pool_w + (size_t)(l * 4 + g) * 4096;
                __syncthreads();
#pragma unroll
                for (int i = 0; i < 2; ++i) { const int idx = tid + 512 * i; *(LAS f32x4*)(Wl + 4 * idx) = *(const f32x4*)(pwg + 4 * idx); }
                for (int i = tid; i < 2048; i += 512) { const int d = i >> 5, n = i & 31; Xl[i] = pool_scale[l * 256 + g * 64 + d] * w_out[(size_t)l * 1024 * 1024 + (size_t)(g * 64 + d) * 1024 + n0 + n]; }
                __syncthreads();
                { const int n = tid & 31, c0 = 4 * (tid >> 5);
                  float o[4] = {0.f, 0.f, 0.f, 0.f};
#pragma unroll 8
                  for (int d = 0; d < 64; ++d) { const float sv = Xl[d * 32 + n];
#pragma unroll
                      for (int i = 0; i < 4; ++i) o[i] += Wl[(c0 + i) * 64 + d] * sv; }
                  v2u w; w.x = pk2(o[0], o[1]); w.y = pk2(o[2], o[3]);
                  *(v2u*)((bf16*)(ws + O_WOUT + l * SZ_WOUT1) + (size_t)(n0 + n) * 1024 + g * 64 + c0) = w; }
            }
            __syncthreads();
        }
        if (rep_ == 0 || ((REP_MASK >> 16) & 1)) {
            LAS bf16* scr = (LAS bf16*)(lds + wave * 16384);
#pragma clang loop vectorize(disable) unroll(disable)
            for (int it0 = gw; it0 < CV_L; it0 += NGW) conv_item(KA, 0, it0, scr, lane);
        }
    }
    SEAM(0);
    if ((REP_MASK >> 12) & 1) { for (int k_ = 0; k_ < 4; ++k_) xcd_barrier(bar); }

    layer_body<0>(lds, G, vcu, bar, lo, hi);
    layer_body<1>(lds, G, vcu, bar, lo, hi);
    if (IN(17)) {
        KA_DECL
        const float* modp = modv + (size_t)5 * 6144;
#pragma clang loop vectorize(disable) unroll(disable)
        for (int r = gw; r < T; r += NGW) {
            const float* g2 = modp + (r >> 12) * 6144 + 5 * 1024; float* dst = outp + (size_t)r * 1024;
#pragma unroll
            for (int j = 0; j < 4; ++j) {
                const int c0 = 4 * lane + 256 * j; f32x4 v = *(const f32x4*)(dst + c0);
                const v2u ya = *(const v2u*)(y2 + (size_t)(2 * r) * 1024 + c0), yb = *(const v2u*)(y2 + (size_t)(2 * r + 1) * 1024 + c0);
                const f32x4 gv = *(const f32x4*)(g2 + c0);
                f32x4 yy; yy[0] = bflo(ya.x) + bflo(yb.x); yy[1] = bfhi(ya.x) + bfhi(yb.x); yy[2] = bflo(ya.y) + bflo(yb.y); yy[3] = bfhi(ya.y) + bfhi(yb.y);
                if (DBG_NO_MOE) yy = (f32x4){0.f, 0.f, 0.f, 0.f};
                *(f32x4*)(dst + c0) = v + gv * yy;
            }
        }
    }
#undef IN
#undef SEAM
}

#undef KA_DECL
#undef ws
#undef ctl
#undef x_in
#undef c_in
#undef ctx_in
#undef cctx_in
#undef w_mod
#undef b_mod
#undef norm1_g
#undef w_in
#undef q_norm_g
#undef k_norm_g
#undef attn_sink
#undef pool_w
#undef pool_scale
#undef four_w
#undef w_out
#undef norm2_g
#undef w_grp
#undef b_grp
#undef w_rtr
#undef b_rtr
#undef w_gate
#undef w_up
#undef w_down
#undef outp
#undef modv
#undef rope
#undef twt
#undef fma
#undef fmb
#undef fmc
#undef hbuf
#undef kall
#undef vall
#undef xc
#undef list
#undef wts
#undef act
#undef t2
#undef mrg
#undef qb
#undef pu
#undef zb
#undef y2
#undef modl
#undef win_t
#undef wout_t
#undef wgu_t
#undef wd_t
extern "C" void kernel_launch(void* const* d_in, const int* in_sizes, int n_in, void* d_out, int out_size, void* d_ws, size_t ws_size, hipStream_t stream) {
    static int grid = 0;
    if (grid == 0) {
        if (n_in != 23 || out_size != T * DM || ws_size < WS_END) { fprintf(stderr, "kernel_launch: unexpected shapes (n_in %d out %d ws %zu need %zu)\n", n_in, out_size, ws_size, (size_t)WS_END); grid = -1; return; }
        int dev = 0, cus = 0;
        if (hipGetDevice(&dev) != hipSuccess || hipDeviceGetAttribute(&cus, hipDeviceAttributeMultiprocessorCount, dev) != hipSuccess) { grid = -1; return; }
        if (hipFuncSetAttribute((const void*)fwd_kernel, hipFuncAttributeMaxDynamicSharedMemorySize, LDS_BYTES) != hipSuccess) { fprintf(stderr, "kernel_launch: hipFuncSetAttribute failed\n"); grid = -1; return; }
        (void)hipGetLastError();
        grid = cus;
    }
    if (grid < 0) return;
    (void)hipMemsetAsync((char*)d_ws + O_CTL, 0, SZ_CTL, stream);
    Args a{};
    for (int i = 0; i < 23; ++i) a.in[i] = (const float*)d_in[i];
    a.out = (float*)d_out; a.ws = (unsigned char*)d_ws;
#if MK_SPLIT
    for (int p = 0; p < NPHASE; ++p) { a.ph_lo = p; a.ph_hi = p + 1; hipLaunchKernelGGL(fwd_kernel, dim3(grid), dim3(512), LDS_BYTES, stream, a); }
#else
    a.ph_lo = 0; a.ph_hi = NPHASE;
    hipLaunchKernelGGL(fwd_kernel, dim3(grid), dim3(512), LDS_BYTES, stream, a);
#endif
}
```

```cpp
#include <hip/hip_runtime.h>
#include <cstdio>
#include <cstdint>

#define DBG_NO_FOUR 0
#define DBG_NO_POOL 0
#define DBG_NO_ATT 0
#define DBG_NO_MOE 0
#define DBG_MOE_SCALE 1.0f
#define DBG_NAIVE_MOE 0
#define REP_MASK 0x0
#define DBG_NAIVE_ROUTE 0
#define LAS __attribute__((address_space(3)))
#define GAS __attribute__((address_space(1)))
typedef unsigned short bf16;
typedef short bf16x8 __attribute__((ext_vector_type(8)));
typedef float f32x4 __attribute__((ext_vector_type(4)));
typedef float f32x16 __attribute__((ext_vector_type(16)));
typedef unsigned v4u __attribute__((ext_vector_type(4)));
typedef unsigned v2u __attribute__((ext_vector_type(2)));
typedef GAS unsigned gu32;

#ifndef MK_SPLIT
#define MK_SPLIT 0
#endif

constexpr int NB = 4, NSEQ = 4096, DM = 1024, LCTX = 256, DEPTH = 2;
constexpr int T = NB * NSEQ, TC = NB * LCTX, TT = T + TC;
constexpr int KVROWS = LCTX + NSEQ;
constexpr int NEXP = 16, DEXP = 512;
constexpr int NPHASE = 18;
constexpr int MAXTILES = 152;
constexpr float QSCALE = 0.125f * 1.4426950408889634f;
constexpr float LOG2E = 1.4426950408889634f;

constexpr size_t al256(size_t x) { return (x + 255) & ~(size_t)255; }
constexpr size_t O_CTL = 0, SZ_CTL = 1u << 20;
constexpr size_t O_MOD = O_CTL + SZ_CTL, SZ_MOD = (size_t)2 * 5 * 6144 * 4;
constexpr size_t O_ROPE = al256(O_MOD + SZ_MOD), SZ_ROPE = (size_t)4096 * 32 * 8;
constexpr size_t O_TW = al256(O_ROPE + SZ_ROPE), SZ_TW = 4096 * 8;
constexpr size_t O_FMA = al256(O_TW + SZ_TW), SZ_FMA = 128 * 128 * 2;
constexpr size_t O_FMB = al256(O_FMA + SZ_FMA), SZ_FMB = 64 * 128 * 2;
constexpr size_t O_FMC = al256(O_FMB + SZ_FMB), SZ_FMC = 256 * 512 * 2;
constexpr size_t O_WIN = al256(O_FMC + SZ_FMC), SZ_WIN1 = (size_t)1536 * 1024 * 2;
constexpr size_t O_WOUT = al256(O_WIN + 2 * SZ_WIN1), SZ_WOUT1 = (size_t)1024 * 1024 * 2;
constexpr size_t O_WGU = al256(O_WOUT + 2 * SZ_WOUT1), SZ_WGU1 = (size_t)16 * 1024 * 1024 * 2;
constexpr size_t O_WD = al256(O_WGU + 2 * SZ_WGU1), SZ_WD1 = (size_t)16 * 1024 * 512 * 2;
constexpr size_t O_H = al256(O_WD + 2 * SZ_WD1), SZ_H = (size_t)TT * 1024 * 2;
constexpr size_t O_KALL = al256(O_H + SZ_H), SZ_KV = (size_t)NB * KVROWS * 128 * 2;
constexpr size_t O_VALL = al256(O_KALL + SZ_KV);
constexpr size_t O_XC = al256(O_VALL + SZ_KV), SZ_XC = (size_t)TC * 1024 * 4;
constexpr size_t O_LIST = al256(O_XC + SZ_XC), SZ_LIST = (size_t)NEXP * TT * 4;
constexpr size_t O_WTS = al256(O_LIST + SZ_LIST), SZ_WTS = (size_t)TT * 2 * 4;
constexpr size_t O_EID = al256(O_WTS + SZ_WTS), SZ_EID = (size_t)TT * 2 * 4;
constexpr size_t O_ACT = al256(O_EID + SZ_EID), SZ_ACT = (size_t)MAXTILES * 256 * 512 * 2;
constexpr size_t O_T2 = O_ACT, SZ_T2 = (size_t)NB * 64 * 64 * 2 * 256 * 2;
constexpr size_t O_MRG = al256(O_ACT + SZ_ACT), SZ_MRG = (size_t)TT * 1024 * 2;
constexpr size_t O_Q = al256(O_MRG + SZ_MRG), SZ_Q = (size_t)TT * 512 * 2;
constexpr size_t O_PU = al256(O_Q + SZ_Q), SZ_PU = (size_t)TT * 256 * 2;
constexpr size_t O_Z = al256(O_PU + SZ_PU), SZ_Z = (size_t)TT * 512 * 2;
constexpr size_t O_Y2 = O_MRG, SZ_Y2 = (size_t)TT * 2 * 1024 * 2;
constexpr size_t WS_END = al256(O_Z + SZ_Z);
static_assert(SZ_T2 <= SZ_ACT, "T2 overlay");
static_assert(O_Y2 + SZ_Y2 <= WS_END, "y2 overlay");

constexpr int CW_TMO = 0;
constexpr int CW_BAR = 4096;
constexpr int CW_KF = 65536;
constexpr int CW_FA = 3072;
constexpr int CW_G2 = 40960;
constexpr int CW_RDY = 32768;
constexpr int CW_Q = 2048;
constexpr int CW_DONE = 2560;
constexpr int CW_CNT = 16384;

constexpr int RING_BYTES = 131072;
constexpr int LDSCTL_OFF = RING_BYTES, MISC_OFF = LDSCTL_OFF + 320;
constexpr int TRIG_OFF = LDSCTL_OFF + 1024;
constexpr int TILE_OFF = LDSCTL_OFF + 2048;
constexpr int LDS_BYTES = 147456;

#define RLX_AGENT __ATOMIC_RELAXED, __HIP_MEMORY_SCOPE_AGENT
#define LDS_WAIT() asm volatile("s_waitcnt lgkmcnt(0)" ::: "memory")
#define VM_WAIT() asm volatile("s_waitcnt vmcnt(0)" ::: "memory")

__device__ __forceinline__ unsigned f2bf(float f) { unsigned u = __builtin_bit_cast(unsigned, f); return (u + 0x7fffu + ((u >> 16) & 1u)) >> 16; }
__device__ __forceinline__ unsigned pk2(float lo, float hi) { return f2bf(lo) | (f2bf(hi) << 16); }
__device__ __forceinline__ float bflo(unsigned w) { return __builtin_bit_cast(float, w << 16); }
__device__ __forceinline__ float bfhi(unsigned w) { return __builtin_bit_cast(float, w & 0xffff0000u); }
__device__ __forceinline__ float bf2f(bf16 h) { return __builtin_bit_cast(float, (unsigned)h << 16); }
template <int CTRL, int RM> __device__ __forceinline__ float dppf(float v) { return __builtin_bit_cast(float, __builtin_amdgcn_update_dpp(0, __builtin_bit_cast(int, v), CTRL, RM, 0xf, true)); }
__device__ __forceinline__ float wave_sum(float v) {
    v += dppf<0x111, 0xf>(v); v += dppf<0x112, 0xf>(v); v += dppf<0x114, 0xf>(v); v += dppf<0x118, 0xf>(v);
    v += dppf<0x142, 0xa>(v); v += dppf<0x143, 0xc>(v);
    return __builtin_bit_cast(float, __builtin_amdgcn_readlane(__builtin_bit_cast(int, v), 63));
}

__device__ __forceinline__ float swap32_sum(float x, float y) {
    const auto rr = __builtin_amdgcn_permlane32_swap(__builtin_bit_cast(unsigned, x), __builtin_bit_cast(unsigned, y), false, false);
    unsigned r0 = rr[0], r1 = rr[1]; asm volatile("" : "+v"(r0), "+v"(r1));
    return __builtin_bit_cast(float, r0) + __builtin_bit_cast(float, r1);
}
__device__ __forceinline__ float swap16_sum(float x, float y) {
    const auto rr = __builtin_amdgcn_permlane16_swap(__builtin_bit_cast(unsigned, x), __builtin_bit_cast(unsigned, y), false, false);
    unsigned r0 = rr[0], r1 = rr[1]; asm volatile("" : "+v"(r0), "+v"(r1));
    return __builtin_bit_cast(float, r0) + __builtin_bit_cast(float, r1);
}

#define XB_TMO      128
#define XB_XCNT(j)  (256  + 64 * (j))
#define XB_XSUB(j)  (1280 + 64 * (j))
#define XB_XGEN(j)  (2304 + 64 * (j))
#define XB_TOP      3328
#define XB_TOPGEN   3392
#define XCD_BAR_WORDS 3456
#define XB_SPIN_CAP (1u << 18)
__device__ __forceinline__ unsigned xb_ld(unsigned* p)              { return __hip_atomic_load(p, __ATOMIC_RELAXED, __HIP_MEMORY_SCOPE_AGENT); }
__device__ __forceinline__ unsigned xb_add(unsigned* p, unsigned v) { return __hip_atomic_fetch_add(p, v, __ATOMIC_RELAXED, __HIP_MEMORY_SCOPE_AGENT); }
__device__ __forceinline__ unsigned xb_xcc_id() { return (unsigned)__builtin_amdgcn_s_getreg((3 << 11) | 20) & 0xFu; }
#define XB_SPIN(cond, bar) do { unsigned _sp = 0; while (cond) { __builtin_amdgcn_s_sleep(1); \
    if ((++_sp & 255u) == 0u) { if (xb_ld(&(bar)[XB_TMO])) break; if (_sp > XB_SPIN_CAP) { atomicAdd(&(bar)[XB_TMO], 1u); break; } } } } while (0)
struct XcdBarrier { unsigned* bar; unsigned x; volatile LAS unsigned* st; };
__device__ __forceinline__ XcdBarrier xcd_barrier_post(unsigned* bar, volatile LAS unsigned* st) {
    XcdBarrier b; b.bar = bar; b.x = xb_xcc_id(); b.st = st;
    if (threadIdx.x == 0) (void)xb_add(&bar[XB_XCNT(b.x)], 1u);
    return b;
}
__device__ __forceinline__ void xcd_barrier_complete(unsigned* bar, unsigned x, unsigned& nloc, unsigned& nx) {
    const unsigned G = gridDim.x * gridDim.y * gridDim.z;
    unsigned sum, cnt, mine, sp = 0u;
    for (;;) {
        sum = 0u; cnt = 0u; mine = 0u;
#pragma unroll
        for (unsigned j = 0; j < 16; ++j) { const unsigned c = xb_ld(&bar[XB_XCNT(j)]); sum += c; cnt += (c > 0u) ? 1u : 0u; mine = (j == x) ? c : mine; }
        if (sum == G) break;
        __builtin_amdgcn_s_sleep(1);
        if ((++sp & 255u) == 0u) { if (xb_ld(&bar[XB_TMO])) break; if (sp > XB_SPIN_CAP) { atomicAdd(&bar[XB_TMO], 1u); break; } }
    }
    nloc = mine > 0u ? mine : 1u; nx = cnt > 0u ? cnt : 1u;
}
__device__ __forceinline__ void xcd_barrier(const XcdBarrier& b) {
    asm volatile("s_waitcnt vmcnt(0)" ::: "memory");
    __syncthreads();
    if (threadIdx.x == 0) {
        unsigned* bar = b.bar;
        __builtin_amdgcn_s_waitcnt(0);
        unsigned nloc = b.st[0], nx = b.st[1];
        if (nloc == 0u) { xcd_barrier_complete(bar, b.x, nloc, nx); b.st[0] = nloc; b.st[1] = nx; }
        const unsigned old = xb_add(&bar[XB_XSUB(b.x)], 1u);
        const unsigned gen = old / nloc;
        if (old + 1u == (gen + 1u) * nloc) {
            __builtin_amdgcn_fence(__ATOMIC_RELEASE, "agent");
            asm volatile("s_waitcnt vmcnt(0)" ::: "memory");
            const unsigned og = xb_add(&bar[XB_TOP], 1u);
            const unsigned tg = og / nx;
            if (og + 1u == (tg + 1u) * nx) xb_add(&bar[XB_TOPGEN], 1u);
            else XB_SPIN(xb_ld(&bar[XB_TOPGEN]) == tg, bar);
            __builtin_amdgcn_fence(__ATOMIC_ACQUIRE, "agent");
            xb_add(&bar[XB_XGEN(b.x)], 1u);
            asm volatile("s_waitcnt vmcnt(0)" ::: "memory");
        } else {
            XB_SPIN(xb_ld(&bar[XB_XGEN(b.x)]) == gen, bar);
            __builtin_amdgcn_fence(__ATOMIC_ACQUIRE, "agent");
            asm volatile("s_waitcnt vmcnt(0)" ::: "memory");
        }
    }
    __syncthreads();
}

namespace pg8 {
constexpr int BM = 256, BK = 64, HALF = 128, HTB = HALF * BK * 2;
__host__ __device__ __forceinline__ int lds_byte(int r, int c) { const int st = (r >> 4) * 2 + (c >> 5), rr = r & 15, cc = c & 31, ob = rr * 64 + cc * 2; return st * 1024 + (ob ^ (((ob >> 9) & 1) << 5)); }
__host__ __device__ __forceinline__ void stage_rc(int b, int& R, int& C) { const int st = b / 1024, sb = b % 1024, swz = sb ^ (((sb >> 9) & 1) << 5); R = (st >> 1) * 16 + swz / 64; C = (st & 1) * 32 + (swz % 64) / 2; }
__host__ __device__ __forceinline__ int perm32(int rho) { const int n = rho >> 4, i = rho & 15; return 8 * (i >> 2) + 4 * n + (i & 3); }

struct Unit { int pm, pn, e, cnt, kind; };

template <class Epi, class Sched>
__device__ __forceinline__ void gemm_phase(LAS unsigned char* lds, const Sched& S, const Epi& E) {
    int tid = threadIdx.x; asm volatile("" : "+v"(tid));
    const int wid = __builtin_amdgcn_readfirstlane(tid >> 6), lane = tid & 63, wr = wid >> 2, wc = wid & 3, fr = lane & 15, fq = lane >> 4;
    int RA[2], CA[2], RB[2];
#pragma unroll
    for (int i = 0; i < 2; ++i) { int R, C; stage_rc(tid * 16 + i * 8192, R, C); RA[i] = R; CA[i] = C; RB[i] = Epi::PERM ? ((R & ~31) + perm32(R & 31)) : R; }
    const size_t kstep = (size_t)(BK * 2);
    const unsigned ldsw = (unsigned)wid * 1024u;
    const int aoff = lds_byte(wr * 64 + fr, fq * 8), boff = lds_byte(wc * 32 + fr, fq * 8);
#define PG8_SA(b, h) (((b) * 2 + (h)) * HTB)
#define PG8_SB(b, h) ((4 + (b) * 2 + (h)) * HTB)
#define PG8_STAGE2(bufoff, gbase, o0, o1) do { \
        __builtin_amdgcn_global_load_lds((const unsigned*)((const char*)(gbase) + (o0)), (LAS unsigned*)(lds + (bufoff) + ldsw), 16, 0, 0); \
        __builtin_amdgcn_global_load_lds((const unsigned*)((const char*)(gbase) + (o1)), (LAS unsigned*)(lds + (bufoff) + ldsw + 8192), 16, 0, 0); } while (0)
#define PG8_LDA(dst, b, h) do { _Pragma("unroll") for (int m = 0; m < 4; ++m) _Pragma("unroll") for (int k = 0; k < 2; ++k) dst[m][k] = *(const LAS bf16x8*)(lds + PG8_SA(b, h) + aoff + m * 2048 + k * 1024); } while (0)
#define PG8_LDB(dst, b, h) do { _Pragma("unroll") for (int n = 0; n < 2; ++n) _Pragma("unroll") for (int k = 0; k < 2; ++k) dst[n][k] = *(const LAS bf16x8*)(lds + PG8_SB(b, h) + boff + n * 2048 + k * 1024); } while (0)
#define PG8_MMA(ai, bj, At, Bt) do { __builtin_amdgcn_s_setprio(1); _Pragma("unroll") for (int m = 0; m < 4; ++m) _Pragma("unroll") for (int n = 0; n < 2; ++n) _Pragma("unroll") for (int k = 0; k < 2; ++k) \
        acc[ai][bj][m][n] = __builtin_amdgcn_mfma_f32_16x16x32_bf16(Bt[n][k], At[m][k], acc[ai][bj][m][n], 0, 0, 0); __builtin_amdgcn_s_setprio(0); } while (0)
#define PG8_WAIT_V(n) asm volatile("s_waitcnt vmcnt(" #n ")" ::: "memory")
#define PG8_WAIT_L(n) asm volatile("s_waitcnt lgkmcnt(" #n ")" ::: "memory")
#define PG8_BAR __builtin_amdgcn_s_barrier()
#define PG8_SCHED __builtin_amdgcn_sched_barrier(0)
    Unit cur, nxt; int ui = 0;
    if (!S.next(0, cur)) return;
    f32x4 acc[2][2][4][2];
#pragma unroll
    for (int a = 0; a < 2; ++a)
#pragma unroll
        for (int b = 0; b < 2; ++b)
#pragma unroll
            for (int m = 0; m < 4; ++m)
#pragma unroll
                for (int n = 0; n < 2; ++n) acc[a][b][m][n] = (f32x4){0.f, 0.f, 0.f, 0.f};
    bf16x8 At[4][2], B0[2][2], B1[2][2];
    int Kc = S.K(cur), Kn; const char* Ac = S.a_base(cur); const char* An; const char* cB = S.b_ptr(cur); const char* nB;
    unsigned oc00, oc01, oc10, oc11, on00, on01, on10, on11, vbc0, vbc1, vbn0, vbn1; size_t hsc, hsn;
    oc00 = S.a_off(cur, RA[0], CA[0]); oc01 = S.a_off(cur, RA[1], CA[1]); oc10 = S.a_off(cur, HALF + RA[0], CA[0]); oc11 = S.a_off(cur, HALF + RA[1], CA[1]);
    vbc0 = (unsigned)(RB[0] * Kc + CA[0]) * 2u; vbc1 = (unsigned)(RB[1] * Kc + CA[1]) * 2u; hsc = (size_t)HALF * Kc * 2;
    S.a_ready(cur);
    PG8_STAGE2(PG8_SB(0, 0), cB, vbc0, vbc1); PG8_STAGE2(PG8_SB(0, 1), cB + hsc, vbc0, vbc1); PG8_STAGE2(PG8_SA(0, 0), Ac, oc00, oc01); PG8_STAGE2(PG8_SA(0, 1), Ac, oc10, oc11);
    if (wr == 1) PG8_BAR;
    PG8_WAIT_V(2); PG8_BAR;
    PG8_STAGE2(PG8_SB(1, 0), cB + kstep, vbc0, vbc1); PG8_STAGE2(PG8_SA(1, 0), Ac + kstep, oc00, oc01); PG8_STAGE2(PG8_SB(1, 1), cB + hsc + kstep, vbc0, vbc1);
    PG8_WAIT_V(6); PG8_BAR;
    for (;;) {
        const bool has_next = S.next(ui + 1, nxt);
        Kn = Kc; An = Ac; nB = cB; on00 = oc00; on01 = oc01; on10 = oc10; on11 = oc11; vbn0 = vbc0; vbn1 = vbc1; hsn = hsc;
        if (has_next) { Kn = S.K(nxt); An = S.a_base(nxt); nB = S.b_ptr(nxt);
            on00 = S.a_off(nxt, RA[0], CA[0]); on01 = S.a_off(nxt, RA[1], CA[1]); on10 = S.a_off(nxt, HALF + RA[0], CA[0]); on11 = S.a_off(nxt, HALF + RA[1], CA[1]);
            vbn0 = (unsigned)(RB[0] * Kn + CA[0]) * 2u; vbn1 = (unsigned)(RB[1] * Kn + CA[1]) * 2u; hsn = (size_t)HALF * Kn * 2; }
        const int nt = Kc / BK;
        for (int t = 0; t < nt; t += 2) {
            const bool last = (t == nt - 2);
            if (last && has_next) S.a_ready(nxt);
            const char* a1 = Ac + (size_t)(t + 1) * kstep;
            const char* a2 = last ? An : Ac + (size_t)(t + 2) * kstep; const char* b2 = last ? nB : cB + (size_t)(t + 2) * kstep;
            const char* a3 = a2 + kstep; const char* b3 = b2 + kstep;
            const unsigned x00 = last ? on00 : oc00, x01 = last ? on01 : oc01, x10 = last ? on10 : oc10, x11 = last ? on11 : oc11;
            const unsigned y0 = last ? vbn0 : vbc0, y1 = last ? vbn1 : vbc1; const size_t hs2 = last ? hsn : hsc;
            PG8_LDB(B0, 0, 0); PG8_LDB(B1, 0, 1); PG8_SCHED; PG8_LDA(At, 0, 0); PG8_STAGE2(PG8_SA(1, 1), a1, oc10, oc11);
            PG8_WAIT_V(8); PG8_WAIT_L(0); PG8_BAR; PG8_MMA(0, 0, At, B0); PG8_MMA(0, 1, At, B1); PG8_BAR; PG8_SCHED;
            PG8_LDA(At, 0, 1); PG8_STAGE2(PG8_SB(0, 0), b2, y0, y1); PG8_STAGE2(PG8_SB(0, 1), b2 + hs2, y0, y1); PG8_STAGE2(PG8_SA(0, 0), a2, x00, x01);
            PG8_WAIT_V(8); PG8_WAIT_L(0); PG8_BAR; PG8_MMA(1, 0, At, B0); PG8_MMA(1, 1, At, B1); PG8_BAR; PG8_SCHED;
            PG8_LDB(B0, 1, 0); PG8_LDB(B1, 1, 1); PG8_SCHED; PG8_LDA(At, 1, 0); PG8_STAGE2(PG8_SA(0, 1), a2, x10, x11);
            PG8_WAIT_V(8); PG8_WAIT_L(0); PG8_BAR; PG8_MMA(0, 0, At, B0); PG8_MMA(0, 1, At, B1); PG8_BAR; PG8_SCHED;
            PG8_LDA(At, 1, 1); PG8_STAGE2(PG8_SB(1, 0), b3, y0, y1); PG8_STAGE2(PG8_SB(1, 1), b3 + hs2, y0, y1); PG8_STAGE2(PG8_SA(1, 0), a3, x00, x01);
            PG8_WAIT_V(8); PG8_WAIT_L(0); PG8_BAR; PG8_MMA(1, 0, At, B0); PG8_MMA(1, 1, At, B1); PG8_BAR; PG8_SCHED;
        }
        if (wr == 0) PG8_BAR;
        E(acc, cur, wr, wc, fr, fq);
        if (!has_next) break;
#pragma unroll
        for (int a = 0; a < 2; ++a)
#pragma unroll
            for (int b = 0; b < 2; ++b)
#pragma unroll
                for (int m = 0; m < 4; ++m)
#pragma unroll
                    for (int n = 0; n < 2; ++n) acc[a][b][m][n] = (f32x4){0.f, 0.f, 0.f, 0.f};
        cur = nxt; Kc = Kn; Ac = An; cB = nB; oc00 = on00; oc01 = on01; oc10 = on10; oc11 = on11; vbc0 = vbn0; vbc1 = vbn1; hsc = hsn; ++ui;
        if (wr == 1) PG8_BAR;
    }
    PG8_WAIT_V(0);
    PG8_BAR;
#undef PG8_SA
#undef PG8_SB
#undef PG8_STAGE2
#undef PG8_LDA
#undef PG8_LDB
#undef PG8_MMA
#undef PG8_WAIT_V
#undef PG8_WAIT_L
#undef PG8_BAR
#undef PG8_SCHED
}
}

__device__ __forceinline__ void store16_wt(void* p, v4u v) { asm volatile("global_store_dwordx4 %0, %1, off sc1\n\ts_nop 1" :: "v"(p), "v"(v) : "memory"); }
__device__ __forceinline__ int krow_of(int r) {
    if (r < T) return (r >> 12) * KVROWS + LCTX + (r & 4095);
    const int rc = r - T; return (rc >> 8) * KVROWS + (rc & 255);
}
struct SchedPlain {
    int nM, nN, G, vcu, Kk; const char* A; const char* B;
    __device__ __forceinline__ bool next(int i, pg8::Unit& u) const { const int L = i * G + vcu; if (L >= nM * nN) return false; u.pm = L / nN; u.pn = L % nN; u.e = 0; u.cnt = 256; u.kind = 0; return true; }
    __device__ __forceinline__ int K(const pg8::Unit&) const { return Kk; }
    __device__ __forceinline__ const char* a_base(const pg8::Unit&) const { return A; }
    __device__ __forceinline__ unsigned a_off(const pg8::Unit& u, int row, int col) const { return (unsigned)((u.pm * 256 + row) * Kk + col) * 2u; }
    __device__ __forceinline__ const char* b_ptr(const pg8::Unit& u) const { return B + (size_t)u.pn * 256 * Kk * 2; }
    __device__ __forceinline__ void a_ready(const pg8::Unit&) const {}
};
struct EpiG1 {
    static constexpr bool PERM = true;
    bf16 *pu, *q, *kall, *vall, *z;
    __device__ __forceinline__ void operator()(const f32x4 (&acc)[2][2][4][2], const pg8::Unit& u, int wr, int wc, int fr, int fq) const {
        const int row0 = u.pm * 256 + wr * 64 + fr, c8 = wc * 32 + 8 * fq;
#pragma unroll
        for (int ai = 0; ai < 2; ++ai)
#pragma unroll
            for (int m = 0; m < 4; ++m) {
                const int row = row0 + ai * 128 + m * 16;
#pragma unroll
                for (int bj = 0; bj < 2; ++bj) {
                    const f32x4 v0 = acc[ai][bj][m][0], v1 = acc[ai][bj][m][1];
                    v4u w; w.x = pk2(v0[0], v0[1]); w.y = pk2(v0[2], v0[3]); w.z = pk2(v1[0], v1[1]); w.w = pk2(v1[2], v1[3]);
                    bf16* dst;
                    if (u.pn == 0) dst = pu + (size_t)row * 256 + bj * 128 + c8;
                    else if (u.pn <= 2) dst = q + (size_t)row * 512 + (u.pn - 1) * 256 + bj * 128 + c8;
                    else if (u.pn == 3) dst = (bj == 0 ? kall : vall) + (size_t)krow_of(row) * 128 + c8;
                    else dst = z + (size_t)row * 512 + (u.pn - 4) * 256 + bj * 128 + c8;
                    *(v4u*)dst = w;
                }
            }
    }
};
struct EpiG2 {
    static constexpr bool PERM = false;
    const float* xin; const float* cin; float* xout; float* cout; const float* mod; unsigned* ready;
    __device__ __forceinline__ void operator()(const f32x4 (&acc)[2][2][4][2], const pg8::Unit& u, int wr, int wc, int fr, int fq) const {
        const int rt0 = u.pm * 256; const bool isc = rt0 >= T;
        const int bsel = isc ? 4 : (rt0 >> 12);
        const float* g1 = mod + bsel * 6144 + 2048;
        const float* base = isc ? cin - (size_t)T * 1024 : xin; float* out = isc ? cout - (size_t)T * 1024 : xout;
        const int row0 = rt0 + wr * 64 + fr, col0 = u.pn * 256 + wc * 32 + 4 * fq;
#pragma unroll
        for (int bj = 0; bj < 2; ++bj)
#pragma unroll
            for (int n = 0; n < 2; ++n) {
                const int col = col0 + bj * 128 + n * 16; const f32x4 gv = *(const f32x4*)(g1 + col);
#pragma unroll
                for (int ai = 0; ai < 2; ++ai)
#pragma unroll
                    for (int m = 0; m < 4; ++m) { const size_t off = (size_t)(row0 + ai * 128 + m * 16) * 1024 + col; const f32x4 bs = *(const f32x4*)(base + off); const f32x4 o = bs + gv * acc[ai][bj][m][n]; store16_wt(out + off, __builtin_bit_cast(v4u, o)); }
            }
        asm volatile("s_waitcnt vmcnt(0)" ::: "memory");
        if ((threadIdx.x & 63) == 0) __hip_atomic_fetch_add(ready + 16 * u.pm, 1u, __ATOMIC_RELAXED, __HIP_MEMORY_SCOPE_AGENT);
    }
};
struct SchedMoe {
    int G, vcu, ntile;
    const char* hb; const char* actb; const char* wgu; const char* wd; const unsigned* list; const LAS int* tt; unsigned* ready; unsigned* tmo;
    __device__ __forceinline__ bool next(int i, pg8::Unit& u) const {
        const int U = ntile * 4; const int r = U % G, q = U / G; const int n3 = q + (vcu < r ? 1 : 0); int L;
        if (i < n3) { L = i * G + vcu; u.kind = 0; }
        else { const int j = i - n3; const int nl = G - r;
            if (vcu >= r) L = (j == 0) ? (vcu - r) : (j == 1) ? nl + (vcu - r) : 2 * nl + (j - 2) * G + vcu;
            else L = 2 * nl + j * G + vcu;
            if (L >= U) return false; u.kind = 1; }
        const int tau = L >> 2; u.pn = L & 3; u.pm = tau; int e = 0;
#pragma unroll
        for (int k = 1; k < 16; ++k) e += (tt[k] <= tau) ? 1 : 0;
        u.e = e; const int r0 = (tau - tt[e]) * 256; const int c = tt[17 + e] - r0; u.cnt = c < 256 ? c : 256; return true;
    }
    __device__ __forceinline__ int K(const pg8::Unit& u) const { return u.kind ? 512 : 1024; }
    __device__ __forceinline__ const char* a_base(const pg8::Unit& u) const { return u.kind ? actb : hb; }
    __device__ __forceinline__ unsigned a_off(const pg8::Unit& u, int row, int col) const {
        if (u.kind) return (unsigned)((u.pm * 256 + row) * 512 + col) * 2u;
        const int r0 = (u.pm - tt[u.e]) * 256; unsigned tok = 0;
        if (row < u.cnt) tok = list[(size_t)u.e * TT + r0 + row] >> 1;
        return (tok * 1024u + (unsigned)col) * 2u;
    }
    __device__ __forceinline__ const char* b_ptr(const pg8::Unit& u) const { return u.kind ? wd + ((size_t)u.e * 1024 + (size_t)u.pn * 256) * 512 * 2 : wgu + ((size_t)u.e * 1024 + (size_t)u.pn * 256) * 1024 * 2; }
    __device__ __forceinline__ void a_ready(const pg8::Unit& u) const {
        if (!u.kind) return;
        if (threadIdx.x < 64) {
            unsigned* w = ready + 16 * u.pm; unsigned sp = 0;
            while ((unsigned)__builtin_amdgcn_readfirstlane(__hip_atomic_load(w, __ATOMIC_RELAXED, __HIP_MEMORY_SCOPE_AGENT)) < 32u) {
                __builtin_amdgcn_s_sleep(2);
                if (++sp > (1u << 22)) { if (threadIdx.x == 0) __hip_atomic_store(tmo, 1u, __ATOMIC_RELAXED, __HIP_MEMORY_SCOPE_AGENT); break; } }
            __builtin_amdgcn_fence(__ATOMIC_ACQUIRE, "agent");
            asm volatile("s_waitcnt vmcnt(0)" ::: "memory");
        }
        asm volatile("" ::: "memory"); __builtin_amdgcn_s_barrier(); asm volatile("" ::: "memory");
    }
};
struct EpiG3 {
    static constexpr bool PERM = true;
    bf16* act; unsigned* ready;
    __device__ __forceinline__ void operator()(const f32x4 (&acc)[2][2][4][2], const pg8::Unit& u, int wr, int wc, int fr, int fq) const {
        const int row0 = u.pm * 256 + wr * 64 + fr, c8 = u.pn * 128 + wc * 32 + 8 * fq;
#pragma unroll
        for (int ai = 0; ai < 2; ++ai)
#pragma unroll
            for (int m = 0; m < 4; ++m) {
                float a[8];
#pragma unroll
                for (int n = 0; n < 2; ++n)
#pragma unroll
                    for (int k = 0; k < 4; ++k) { const float g = acc[ai][0][m][n][k], up = acc[ai][1][m][n][k]; a[n * 4 + k] = g / (1.f + __expf(-g)) * up; }
                v4u w; w.x = pk2(a[0], a[1]); w.y = pk2(a[2], a[3]); w.z = pk2(a[4], a[5]); w.w = pk2(a[6], a[7]);
                store16_wt(act + (size_t)(row0 + ai * 128 + m * 16) * 512 + c8, w);
            }
        asm volatile("s_waitcnt vmcnt(0)" ::: "memory");
        if ((threadIdx.x & 63) == 0) __hip_atomic_fetch_add(ready + 16 * u.pm, 1u, __ATOMIC_RELAXED, __HIP_MEMORY_SCOPE_AGENT);
    }
};
struct EpiG4 {
    static constexpr bool PERM = true;
    bf16* y2; const unsigned* list; const float* wts; const LAS int* tt;
    __device__ __forceinline__ void operator()(const f32x4 (&acc)[2][2][4][2], const pg8::Unit& u, int wr, int wc, int fr, int fq) const {
        const int r0 = (u.pm - tt[u.e]) * 256; const int c8 = u.pn * 256 + wc * 32 + 8 * fq;
#pragma unroll
        for (int ai = 0; ai < 2; ++ai)
#pragma unroll
            for (int m = 0; m < 4; ++m) {
                const int row = wr * 64 + fr + ai * 128 + m * 16;
                if (row < u.cnt) {
                    const unsigned ent = list[(size_t)u.e * TT + r0 + row]; const float w = wts[ent];
#pragma unroll
                    for (int bj = 0; bj < 2; ++bj) {
                        const f32x4 v0 = acc[ai][bj][m][0] * w, v1 = acc[ai][bj][m][1] * w;
                        v4u o; o.x = pk2(v0[0], v0[1]); o.y = pk2(v0[2], v0[3]); o.z = pk2(v1[0], v1[1]); o.w = pk2(v1[2], v1[3]);
                        *(v4u*)(y2 + (size_t)ent * 1024 + bj * 128 + c8) = o;
                    }
                }
            }
    }
};

struct EpiMoe { static constexpr bool PERM = true; EpiG3 e3; EpiG4 e4;
    __device__ __forceinline__ void operator()(const f32x4 (&acc)[2][2][4][2], const pg8::Unit& u, int wr, int wc, int fr, int fq) const { if (u.kind) e4(acc, u, wr, wc, fr, fq); else e3(acc, u, wr, wc, fr, fq); } };

#include <hip/hip_bf16.h>
#include <cmath>
namespace attn_body {
using bf16=__hip_bfloat16;
using bf16x8=__attribute__((ext_vector_type(8)))short;
using s16x4=__attribute__((ext_vector_type(4)))short;
using f32x16=__attribute__((ext_vector_type(16)))float;
using u32x4=__attribute__((ext_vector_type(4)))unsigned;
constexpr int D=64,QP=512,KVP=128,OP=1024;
constexpr int NW=8,QBLK=32,KVBLK=64;
__device__ __forceinline__ int crow(int r,int hi){return (r&3)+8*(r>>2)+4*hi;}
#define SBAR() __builtin_amdgcn_sched_barrier(0)
__device__ __forceinline__ void wmask(f32x16&p0,f32x16&p1,int kp0,int qpos,int hi){
  const float NEG=-INFINITY; const bool tile_ok=(unsigned)kp0<4096u; const int base=kp0+4*hi-qpos+128;
  #pragma unroll
  for(int r=0;r<16;++r){const int dd=base+(r&3)+8*(r>>2); if(!tile_ok||(unsigned)dd>256u)p0[r]=NEG; if(!tile_ok||(unsigned)(dd+32)>256u)p1[r]=NEG;}
}
constexpr int NSLOT=3, SLOTB=8192;
constexpr int LDS_K=0, LDS_V=NSLOT*SLOTB, LDS_WS=2*NSLOT*SLOTB, LDS_OST=LDS_WS+NW*64*4, LDS_BYTES=LDS_OST+NW*4096;
constexpr float C2=0.125f*1.4426950408889634f;
__device__ __forceinline__ void glds16(const void*gsrc,unsigned lds_dst){unsigned keep;
  asm volatile("s_mov_b32 %0, m0\n\ts_mov_b32 m0, %2\n\ts_nop 0\n\tglobal_load_lds_dwordx4 %1, off\n\ts_mov_b32 m0, %0":"=&s"(keep):"v"(gsrc),"s"(lds_dst):"memory");}
__device__ __forceinline__ float max3f(float a,float b,float c){float r;asm("v_max3_f32 %0, %1, %2, %3":"=v"(r):"v"(a),"v"(b),"v"(c));return r;}
__device__ __forceinline__ float max2f(float a,float b){float r;asm("v_max_f32_e32 %0, %1, %2":"=v"(r):"v"(a),"v"(b));return r;}
__device__ __forceinline__ float fadd_s(float a,float b){float r;asm("v_add_f32_e32 %0, %1, %2":"=v"(r):"v"(a),"v"(b));return r;}
__device__ __forceinline__ float fsub_s(float a,float b){float r;asm("v_sub_f32_e32 %0, %1, %2":"=v"(r):"v"(a),"v"(b));return r;}
typedef float f32x2_t __attribute__((ext_vector_type(2))); typedef __bf16 bf16x2_t __attribute__((ext_vector_type(2)));
__device__ __forceinline__ unsigned cvtpk_s(float lo,float hi){f32x2_t v={lo,hi};bf16x2_t b=__builtin_convertvector(v,bf16x2_t);return __builtin_bit_cast(unsigned,b);}
#define WAIT_BAR(N) asm volatile("s_waitcnt vmcnt(" #N ") lgkmcnt(0)\n\ts_barrier":::"memory")

__device__ __forceinline__ void qkt(f32x16&p0,f32x16&p1,const char*Kslot,const bf16x8*qr,const f32x16&negm,int r32,int hi){
  const char*kb=Kslot+hi*1024+r32*16;
  #pragma unroll
  for(int d0=0;d0<4;++d0){
    const bf16x8 b0=*reinterpret_cast<const bf16x8*>(kb+d0*2048);
    const bf16x8 b1=*reinterpret_cast<const bf16x8*>(kb+d0*2048+512);
    if(d0==0){p0=__builtin_amdgcn_mfma_f32_32x32x16_bf16(b0,qr[0],negm,0,0,0);p1=__builtin_amdgcn_mfma_f32_32x32x16_bf16(b1,qr[0],negm,0,0,0);}
    else{p0=__builtin_amdgcn_mfma_f32_32x32x16_bf16(b0,qr[d0],p0,0,0,0);p1=__builtin_amdgcn_mfma_f32_32x32x16_bf16(b1,qr[d0],p1,0,0,0);}}
}
typedef __attribute__((address_space(3))) const char* lds_cptr;
typedef short v4i16_t __attribute__((ext_vector_type(4)));
__device__ __forceinline__ void kload8(bf16x8*kf,lds_cptr kp){
  kf[0]=*(const __attribute__((address_space(3))) bf16x8*)(kp);      kf[1]=*(const __attribute__((address_space(3))) bf16x8*)(kp+512);
  kf[2]=*(const __attribute__((address_space(3))) bf16x8*)(kp+2048); kf[3]=*(const __attribute__((address_space(3))) bf16x8*)(kp+2560);
  kf[4]=*(const __attribute__((address_space(3))) bf16x8*)(kp+4096); kf[5]=*(const __attribute__((address_space(3))) bf16x8*)(kp+4608);
  kf[6]=*(const __attribute__((address_space(3))) bf16x8*)(kp+6144); kf[7]=*(const __attribute__((address_space(3))) bf16x8*)(kp+6656);
}
__device__ __forceinline__ void kload2(bf16x8*kf,lds_cptr kp,int j){ kf[2*j]=*(const __attribute__((address_space(3))) bf16x8*)(kp+j*2048); kf[2*j+1]=*(const __attribute__((address_space(3))) bf16x8*)(kp+j*2048+512); }
__device__ __forceinline__ s16x4 vtr(lds_cptr p){ return __builtin_bit_cast(s16x4,__builtin_amdgcn_ds_read_tr16_b64_v4i16((__attribute__((address_space(3))) v4i16_t*)p)); }
__device__ __forceinline__ float rowmax(const f32x16&p0,const f32x16&p1){
  float a=max3f(p0[0],p0[1],p1[0]),b=max3f(p0[2],p0[3],p1[1]);a=max3f(a,p1[2],p1[3]);
  #pragma unroll
  for(int r=4;r<16;r+=4){a=max3f(a,p0[r],p0[r+1]);b=max3f(b,p0[r+2],p0[r+3]);a=max3f(a,p1[r],p1[r+1]);b=max3f(b,p1[r+2],p1[r+3]);}
  const float m=max2f(a,b);
  auto rr=__builtin_amdgcn_permlane32_swap(__float_as_uint(m),__float_as_uint(m),false,false);
  return max2f(__uint_as_float(rr[0]),__uint_as_float(rr[1]));
}
__device__ __forceinline__ void pv(f32x16*o,int vb,bf16x8 pa0,bf16x8 pa1,bf16x8 pa2,bf16x8 pa3){
  #pragma unroll
  for(int d0=0;d0<2;++d0){s16x4 lo[4],hi[4];
    #pragma unroll
    for(int ks=0;ks<4;++ks){
      asm volatile("ds_read_b64_tr_b16 %0,%1 offset:%c2":"=&v"(lo[ks]):"v"(vb),"i"(d0*4096+ks*1024):"memory");
      asm volatile("ds_read_b64_tr_b16 %0,%1 offset:%c2":"=&v"(hi[ks]):"v"(vb),"i"(d0*4096+ks*1024+512):"memory");}
    asm volatile("s_waitcnt lgkmcnt(0)":::"memory");SBAR();
    #define PK(k) (bf16x8){lo[k][0],lo[k][1],lo[k][2],lo[k][3],hi[k][0],hi[k][1],hi[k][2],hi[k][3]}
    o[d0]=__builtin_amdgcn_mfma_f32_32x32x16_bf16(pa0,PK(0),o[d0],0,0,0);
    o[d0]=__builtin_amdgcn_mfma_f32_32x32x16_bf16(pa1,PK(1),o[d0],0,0,0);
    o[d0]=__builtin_amdgcn_mfma_f32_32x32x16_bf16(pa2,PK(2),o[d0],0,0,0);
    o[d0]=__builtin_amdgcn_mfma_f32_32x32x16_bf16(pa3,PK(3),o[d0],0,0,0);
    #undef PK
  }
}

#ifndef ATTN_STORE16
#define ATTN_STORE16(p,v) (*(u32x4*)(p)=(v))
#endif
template<int THRL> __device__ __forceinline__ void attn_unit(const bf16*Qu,const bf16*__restrict__ Kh,const bf16*__restrict__ Vh,bf16*Ou,const int p0,const int NT,const float* sinkp,const float* qg,const float2* ropet,char*shm){
  int tid=threadIdx.x; asm volatile("":"+v"(tid)); const int lane=tid&63,r32=lane&31,hi=lane>>5; const int wid=__builtin_amdgcn_readfirstlane(tid>>6);
  const int hsub=wid>>1, psub=(wid&1)*QBLK;
  const bf16*Qw=Qu+(long)psub*QP+hsub*D;
  const unsigned lds0=(unsigned)(uintptr_t)shm;
  float*wsf=(float*)(shm+LDS_WS)+wid*64;
  const bf16*ksrc=Kh+(long)lane*KVP+wid*8;
  const bf16*vsrc=Vh+(long)(16*(wid&3)+(lane>>2))*KVP+(wid>>2)*32+(lane&3)*8;
  const unsigned kdst=lds0+LDS_K+wid*1024, vdst=lds0+LDS_V+wid*1024;
  #define KP0(t) (p0-128+64*((t)-4))
  #define TROW(t) ((t)<4?64*(t):(((unsigned)KP0(t)<4096u)?256+KP0(t):256))
  #define DMA_K(t,slot) glds16(ksrc+(long)TROW(t)*KVP,(unsigned)__builtin_amdgcn_readfirstlane(kdst+(slot)))
  #define DMA_V(t,slot) glds16(vsrc+(long)TROW(t)*KVP,(unsigned)__builtin_amdgcn_readfirstlane(vdst+(slot)))
  const int vb0=(int)(lds0+LDS_V)+((lane>>4)&1)*32+(lane&3)*8+(4*hi+((lane&15)>>2))*64;
  const char*Kbase=shm+LDS_K; bf16x8 kf[8];
  const lds_cptr shm3=(lds_cptr)shm; const lds_cptr kp0=shm3+LDS_K+hi*1024+r32*16; const lds_cptr vp0=shm3+LDS_V+((lane>>4)&1)*32+(lane&3)*8+(4*hi+((lane&15)>>2))*64;
  DMA_K(0,0);DMA_V(0,0);DMA_K(1,SLOTB);
  bf16x8 qr[4];
  { bf16x8 qraw[4];
    #pragma unroll
    for(int d0=0;d0<4;++d0)qraw[d0]=*reinterpret_cast<const bf16x8*>(&Qw[(long)r32*QP+d0*16+hi*8]);
    float qf[4][8]; float ss=0.f;
    #pragma unroll
    for(int d0=0;d0<4;++d0)
      #pragma unroll
      for(int j=0;j<8;++j){ qf[d0][j]=__builtin_bit_cast(float,(unsigned)(unsigned short)qraw[d0][j]<<16); ss+=qf[d0][j]*qf[d0][j]; }
    ss+=__shfl_xor(ss,32);
    const float rstd=1.0f/sqrtf(ss*(1.f/64.f)+1e-6f)*C2;
    #pragma unroll
    for(int d0=0;d0<4;++d0)
      #pragma unroll
      for(int j=0;j<8;++j) qf[d0][j]*=rstd*qg[16*d0+8*hi+j];
    if(ropet){ const float2* rp=ropet+(long)(p0+psub+r32)*32+8*hi;
      #pragma unroll
      for(int j=0;j<8;++j){ const float2 c1=rp[j],c2=rp[16+j];
        const float a=qf[0][j],b=qf[1][j],c=qf[2][j],d=qf[3][j];
        qf[0][j]=a*c1.x-b*c1.y; qf[1][j]=b*c1.x+a*c1.y; qf[2][j]=c*c2.x-d*c2.y; qf[3][j]=d*c2.x+c*c2.y; } }
    #pragma unroll
    for(int d0=0;d0<4;++d0){ u32x4 w; w[0]=cvtpk_s(qf[d0][0],qf[d0][1]); w[1]=cvtpk_s(qf[d0][2],qf[d0][3]); w[2]=cvtpk_s(qf[d0][4],qf[d0][5]); w[3]=cvtpk_s(qf[d0][6],qf[d0][7]); qr[d0]=__builtin_bit_cast(bf16x8,w); } }
  float mhat=0.f,l_reg=0.f;f32x16 o[2];o[0]=f32x16{};o[1]=f32x16{};f32x16 negm=f32x16{};asm volatile("":"+v"(negm));
  const int qpos=p0+psub+r32;
  #define CMASK(P0,P1,t) do{ if((t)>=4)wmask(P0,P1,KP0(t),qpos,hi); }while(0)
  bool resc=false;
  #define START(P0,P1) do{ const float rm=rowmax(P0,P1); resc=false; \
    { const float dl=rm; mhat=fadd_s(mhat,dl); \
      _Pragma("unroll") for(int r=0;r<16;++r){P0[r]=fsub_s(P0[r],dl);P1[r]=fsub_s(P1[r],dl);} \
      _Pragma("unroll") for(int r=0;r<16;++r)negm[r]=-mhat; asm volatile("":"+v"(negm)); } \
    _Pragma("unroll") for(int r=0;r<16;++r)P0[r]=__builtin_amdgcn_exp2f(P0[r]); }while(0)
  #define RESC() do{ if(resc){ asm volatile("s_waitcnt lgkmcnt(0)":::"memory"); \
      _Pragma("unroll") for(int d_=0;d_<2;++d_) _Pragma("unroll") for(int r=0;r<16;++r)o[d_][r]*=wsf[crow(r,hi)]; } }while(0)
  f32x16 pA0,pA1,pB0,pB1;
  int sl_prev=0,sl_cur=0,sl_next=SLOTB;
  #define ROT() do{sl_prev=sl_cur;sl_cur=sl_next;sl_next=(sl_next==(NSLOT-1)*SLOTB)?0:sl_next+SLOTB;}while(0)
  DMA_K(2,2*SLOTB);
  WAIT_BAR(3);
  qkt(pA0,pA1,Kbase,qr,negm,r32,hi);asm volatile("s_nop 15\n\ts_nop 7":"+v"(pA0),"+v"(pA1));CMASK(pA0,pA1,0);
  START(pA0,pA1);
  _Pragma("unroll") for(int r=0;r<16;++r)pA1[r]=__builtin_amdgcn_exp2f(pA1[r]);
  WAIT_BAR(0);
  DMA_K(3,0);DMA_V(1,SLOTB);
  ROT();
  kload8(kf,kp0+sl_cur);
  WAIT_BAR(2);
  s16x4 vlo[8],vhi[8]; u32x4 pw0,pw1,pw2,pw3;
  #define PKW(P,B) cvtpk_s(P[B],P[B+1])
  #define PAF(k) __builtin_bit_cast(bf16x8,pw##k)
  #define VFR(i) (bf16x8){vlo[i][0],vlo[i][1],vlo[i][2],vlo[i][3],vhi[i][0],vhi[i][1],vhi[i][2],vhi[i][3]}
  #define PIN(x) asm volatile("":"+v"(x))
  #define MX3(a,b,c) __builtin_fmaxf(__builtin_fmaxf((a),(b)),(c))
  #define GAPA(MF,A0,A1,A2,A3,W0,W1,PW) do{ MF; sacc+=A0; sacc+=A1; sacc+=A2; sacc+=A3; PIN(sacc); W0; W1; PIN(PW); SBAR(); }while(0)
  #define EX(v) __builtin_amdgcn_exp2f(v)
  #define GAPB(MF,X,B) do{ MF; X[B]=EX(X[B]); X[B+1]=EX(X[B+1]); X[B+2]=EX(X[B+2]); X[B+3]=EX(X[B+3]); PIN(X); SBAR(); }while(0)
  #define VRD(i) do{ vlo[i]=vtr(vp_+(((i)>>2)*4096+((i)&3)*1024)); vhi[i]=vtr(vp_+(((i)>>2)*4096+((i)&3)*1024+512)); }while(0)
  #define KRD(G,j) do{ if(G){ kload2(kf,kp0+sl_next,j); SBAR(); } }while(0)
  #define STEP(C0,C1,P0,P1,t,GK,GV,GL) do{ SBAR(); \
    const lds_cptr vp_=vp0+sl_prev; \
    VRD(0); SBAR(); float sacc=(P0[0]+P0[1]); \
    GAPA(C0=__builtin_amdgcn_mfma_f32_32x32x16_bf16(kf[0],qr[0],negm,0,0,0), P0[2],P0[3],P0[4],P0[5],     pw0[0]=PKW(P0,0), pw0[1]=PKW(P0,2), pw0); \
    VRD(4); SBAR(); GAPA(C1=__builtin_amdgcn_mfma_f32_32x32x16_bf16(kf[1],qr[0],negm,0,0,0), P0[6],P0[7],P0[8],P0[9],     pw0[2]=PKW(P0,4), pw0[3]=PKW(P0,6), pw0); \
    VRD(1); SBAR(); GAPA(C0=__builtin_amdgcn_mfma_f32_32x32x16_bf16(kf[2],qr[1],C0,0,0,0),   P0[10],P0[11],P0[12],P0[13], pw1[0]=PKW(P0,8), pw1[1]=PKW(P0,10), pw1); \
    VRD(5); SBAR(); GAPA(C1=__builtin_amdgcn_mfma_f32_32x32x16_bf16(kf[3],qr[1],C1,0,0,0),   P0[14],P0[15],P1[0],P1[1],   pw1[2]=PKW(P0,12),pw1[3]=PKW(P0,14), pw1); \
    VRD(2); SBAR(); GAPA(C0=__builtin_amdgcn_mfma_f32_32x32x16_bf16(kf[4],qr[2],C0,0,0,0),   P1[2],P1[3],P1[4],P1[5],     pw2[0]=PKW(P1,0), pw2[1]=PKW(P1,2), pw2); \
    VRD(6); SBAR(); GAPA(C1=__builtin_amdgcn_mfma_f32_32x32x16_bf16(kf[5],qr[2],C1,0,0,0),   P1[6],P1[7],P1[8],P1[9],     pw2[2]=PKW(P1,4), pw2[3]=PKW(P1,6), pw2); \
    VRD(3); SBAR(); GAPA(C0=__builtin_amdgcn_mfma_f32_32x32x16_bf16(kf[6],qr[3],C0,0,0,0),   P1[10],P1[11],P1[12],P1[13], pw3[0]=PKW(P1,8), pw3[1]=PKW(P1,10), pw3); \
    VRD(7); SBAR(); GAPA(C1=__builtin_amdgcn_mfma_f32_32x32x16_bf16(kf[7],qr[3],C1,0,0,0),   P1[14],P1[15],0.f,0.f,       pw3[2]=PKW(P1,12),pw3[3]=PKW(P1,14), pw3); \
    l_reg+=sacc; \
    if(GK){DMA_K((t)+3,sl_cur);} if(GV){DMA_V((t)+1,sl_next);} \
    CMASK(C0,C1,t); \
    { float a=MX3(C0[0],C0[1],C1[0]),b=MX3(C0[2],C0[3],C1[1]); a=MX3(a,C1[2],C1[3]); \
      _Pragma("unroll") for(int r=4;r<16;r+=4){a=MX3(a,C0[r],C0[r+1]);b=MX3(b,C0[r+2],C0[r+3]);a=MX3(a,C1[r],C1[r+1]);b=MX3(b,C1[r+2],C1[r+3]);} \
      float rm=__builtin_fmaxf(a,b); { auto rr=__builtin_amdgcn_permlane32_swap(__float_as_uint(rm),__float_as_uint(rm),false,false); rm=__builtin_fmaxf(__uint_as_float(rr[0]),__uint_as_float(rr[1])); } \
      resc=false; \
      if(__builtin_expect(__any(rm>(float)THRL),0)){ const float dl=__builtin_fmaxf(rm,0.f); mhat+=dl; \
        _Pragma("unroll") for(int r=0;r<16;++r){C0[r]-=dl;C1[r]-=dl;} \
        _Pragma("unroll") for(int r=0;r<16;++r)negm[r]=-mhat; asm volatile("":"+v"(negm)); \
        const float f=__builtin_amdgcn_exp2f(-dl); l_reg*=f; if(hi==0)wsf[r32]=f; resc=true; } } \
    SBAR(); \
    GAPB(o[0]=__builtin_amdgcn_mfma_f32_32x32x16_bf16(PAF(0),VFR(0),o[0],0,0,0), C0,0); \
    GAPB(o[1]=__builtin_amdgcn_mfma_f32_32x32x16_bf16(PAF(0),VFR(4),o[1],0,0,0), C0,4); \
    KRD(GL,0); GAPB(o[0]=__builtin_amdgcn_mfma_f32_32x32x16_bf16(PAF(1),VFR(1),o[0],0,0,0), C0,8); \
    KRD(GL,1); GAPB(o[1]=__builtin_amdgcn_mfma_f32_32x32x16_bf16(PAF(1),VFR(5),o[1],0,0,0), C0,12); \
    KRD(GL,2); GAPB(o[0]=__builtin_amdgcn_mfma_f32_32x32x16_bf16(PAF(2),VFR(2),o[0],0,0,0), C1,0); \
    KRD(GL,3); GAPB(o[1]=__builtin_amdgcn_mfma_f32_32x32x16_bf16(PAF(2),VFR(6),o[1],0,0,0), C1,4); \
    GAPB(o[0]=__builtin_amdgcn_mfma_f32_32x32x16_bf16(PAF(3),VFR(3),o[0],0,0,0), C1,8); \
    GAPB(o[1]=__builtin_amdgcn_mfma_f32_32x32x16_bf16(PAF(3),VFR(7),o[1],0,0,0), C1,12); \
    }while(0)
  int t=1;
  for(;t+5<NT;t+=2){
    STEP(pB0,pB1,pA0,pA1,t,true,true,true);     WAIT_BAR(2); RESC(); ROT();
    STEP(pA0,pA1,pB0,pB1,t+1,true,true,true);   WAIT_BAR(2); RESC(); ROT();
  }
  #define ENDW(tt) do{ if((tt)+3<NT){WAIT_BAR(2);} else if((tt)+2<NT){WAIT_BAR(1);} else {WAIT_BAR(0);} }while(0)
  for(;t+1<NT;t+=2){
    STEP(pB0,pB1,pA0,pA1,t,(t+3<NT),(t+1<NT),(t+1<NT));       ENDW(t);   RESC(); ROT();
    STEP(pA0,pA1,pB0,pB1,t+1,(t+4<NT),(t+2<NT),(t+2<NT));     ENDW(t+1); RESC(); ROT();
  }
  STEP(pB0,pB1,pA0,pA1,NT-1,false,false,false); RESC();
  { float sacc=pB0[0]+pB0[1]; _Pragma("unroll") for(int r=2;r<16;++r)sacc+=pB0[r]; _Pragma("unroll") for(int r=0;r<16;++r)sacc+=pB1[r]; l_reg+=sacc;
    pw0=(u32x4){PKW(pB0,0),PKW(pB0,2),PKW(pB0,4),PKW(pB0,6)};pw1=(u32x4){PKW(pB0,8),PKW(pB0,10),PKW(pB0,12),PKW(pB0,14)};pw2=(u32x4){PKW(pB1,0),PKW(pB1,2),PKW(pB1,4),PKW(pB1,6)};pw3=(u32x4){PKW(pB1,8),PKW(pB1,10),PKW(pB1,12),PKW(pB1,14)};
    SBAR(); pv(o,vb0+sl_cur,PAF(0),PAF(1),PAF(2),PAF(3)); }
  #undef PKW
  #undef PAF
  #undef VFR
  #undef PIN
  #undef MX3
  #undef GAPA
  #undef GAPB
  #undef EX
  #undef VRD
  #undef KRD
  #undef STEP
  #undef ENDW
  l_reg+=__shfl_xor(l_reg,32);
  l_reg+=__builtin_amdgcn_exp2f(sinkp[hsub]*1.4426950408889634f-mhat);
  if(hi==0)wsf[32+r32]=l_reg;asm volatile("s_waitcnt lgkmcnt(0)":::"memory");
  float rli[16];
  #pragma unroll
  for(int r=0;r<16;++r)rli[r]=__builtin_amdgcn_rcpf(wsf[32+crow(r,hi)]);
  bf16*Ow=Ou+(long)psub*OP+hsub*D;
  { bf16*stg=(bf16*)(shm+LDS_OST)+wid*2048;
    #pragma unroll
    for(int r=0;r<16;++r){const int orow=crow(r,hi);
      #pragma unroll
      for(int d0=0;d0<2;++d0)stg[orow*64+d0*32+r32]=__float2bfloat16(o[d0][r]*rli[r]);}
    asm volatile("s_waitcnt lgkmcnt(0)":::"memory");
    #pragma unroll
    for(int i=0;i<4;++i){const int row=i*8+(lane>>3),ch=lane&7; const u32x4 v=*(const u32x4*)(stg+row*64+ch*8); ATTN_STORE16(Ow+(long)row*OP+ch*8,v);} }
  asm volatile("s_waitcnt lgkmcnt(0)\n\ts_barrier":::"memory");
  #undef DMA_K
  #undef DMA_V
  #undef KP0
  #undef TROW
  #undef CMASK
  #undef START
  #undef RESC
  #undef ROT
}
constexpr int ATTN_LDS_BYTES=LDS_BYTES;
#undef SBAR
#undef WAIT_BAR
}

constexpr int SLAB_PITCH = 288;
typedef short v4i16_t __attribute__((ext_vector_type(4)));
template <int MT, class RowAddr, class Epi>
__device__ __forceinline__ void slab_gemm(LAS unsigned char* lds, const bf16* Cmat, const int K, const RowAddr& RA, const Epi& E) {
    int tid = threadIdx.x; asm volatile("" : "+v"(tid));
    const int wid = tid >> 6, lane = tid & 63;
    LAS bf16* Dr = (LAS bf16*)lds;
    f32x16 acc[MT];
#pragma unroll
    for (int i = 0; i < MT; ++i)
#pragma unroll
        for (int r = 0; r < 16; ++r) acc[i][r] = 0.f;
    const int g = (lane >> 4) & 1, h = lane >> 5, qq = (lane & 15) >> 2, pp = lane & 3;
    const LAS bf16* trp = Dr + (8 * h + qq) * SLAB_PITCH + wid * 32 + 16 * g + 4 * pp;
    for (int kc = 0; kc < K; kc += 128) {
        {
            const int k = tid >> 2, qd = tid & 3;
            const bf16* src = RA(kc + k) + qd * 64;
            v4u v[8];
#pragma unroll
            for (int j = 0; j < 8; ++j) v[j] = *(const v4u*)(src + j * 8);
#pragma unroll
            for (int j = 0; j < 8; ++j) *(LAS v4u*)(Dr + k * SLAB_PITCH + qd * 64 + j * 8) = v[j];
        }
        __syncthreads();
        const int kh = h * 8;
#pragma unroll
        for (int s = 0; s < 8; ++s) {
            const v4i16_t b0 = __builtin_amdgcn_ds_read_tr16_b64_v4i16((LAS v4i16_t*)(trp + (16 * s) * SLAB_PITCH));
            const v4i16_t b1 = __builtin_amdgcn_ds_read_tr16_b64_v4i16((LAS v4i16_t*)(trp + (16 * s + 4) * SLAB_PITCH));
            const bf16x8 bfrag = (bf16x8){b0[0], b0[1], b0[2], b0[3], b1[0], b1[1], b1[2], b1[3]};
#pragma unroll
            for (int mt = 0; mt < MT; ++mt) {
                const bf16x8 afrag = *(const bf16x8*)(Cmat + (size_t)(mt * 32 + (lane & 31)) * K + kc + s * 16 + kh);
                acc[mt] = __builtin_amdgcn_mfma_f32_32x32x16_bf16(afrag, bfrag, acc[mt], 0, 0, 0);
            }
        }
        __syncthreads();
    }
    E(acc, wid, lane, lds);
}

struct Args { const float* in[23]; float* out; unsigned char* ws; int ph_lo, ph_hi; };

constexpr int SOUT_PITCH = 264;
template <int NROWS, bool WT, class RowPtr>
__device__ __forceinline__ void slab_store_rows(LAS unsigned char* lds, const RowPtr& RP) {
    int tid = threadIdx.x; asm volatile("" : "+v"(tid));
    __syncthreads();
#pragma unroll
    for (int k = 0; k < NROWS / 16; ++k) { const int row = (tid >> 5) + 16 * k, chunk = tid & 31;
        const v4u v = *(const LAS v4u*)((LAS bf16*)lds + row * SOUT_PITCH + chunk * 8);
        bf16* dst = RP(row) + chunk * 8;
        if (WT) store16_wt(dst, v); else *(v4u*)dst = v; }
    __syncthreads();
}
struct RowA { const bf16* z; int b, n2; __device__ __forceinline__ const bf16* operator()(int k) const { return z + (size_t)(b * 4096 + 64 * (k & 63) + n2) * 512 + (k >> 6) * 256; } };
struct RowPA { bf16* t2; int b, n2; __device__ __forceinline__ bf16* operator()(int m) const { return t2 + ((size_t)((b * 64 + n2) * 64 + (m & 63)) * 2 + (m >> 6)) * 256; } };
template <bool WT> struct EpiA { bf16* t2; const float2* tw; int b, n2;
    __device__ __forceinline__ void operator()(const f32x16 (&acc)[4], int wid, int lane, LAS unsigned char* lds) const {
        const int ch = wid * 32 + (lane & 31); LAS bf16* so = (LAS bf16*)lds;
#pragma unroll
        for (int mt = 0; mt < 2; ++mt)
#pragma unroll
            for (int r = 0; r < 16; ++r) {
                const int k1 = 32 * mt + (r & 3) + 8 * (r >> 2) + 4 * (lane >> 5);
                const float2 cs = tw[n2 * k1]; const float re = acc[mt][r], im = acc[mt + 2][r];
                const float re2 = cs.x * re + cs.y * im, im2 = cs.x * im - cs.y * re;
                so[k1 * SOUT_PITCH + ch] = (bf16)f2bf(re2); so[(64 + k1) * SOUT_PITCH + ch] = (bf16)f2bf(im2);
            }
        RowPA rp{t2, b, n2}; slab_store_rows<128, WT, RowPA>(lds, rp);
    } };
struct RowB { const bf16* t2; int b, k1; __device__ __forceinline__ const bf16* operator()(int k) const { return t2 + ((size_t)((b * 64 + (k & 63)) * 64 + k1) * 2 + (k >> 6)) * 256; } };
struct RowPB { bf16* mrg; int b, k1; __device__ __forceinline__ bf16* operator()(int k2) const { return mrg + (size_t)(b * 4096 + k1 + 64 * k2) * 1024 + 768; } };
struct EpiB { bf16* mrg; int b, k1;
    __device__ __forceinline__ void operator()(const f32x16 (&acc)[2], int wid, int lane, LAS unsigned char* lds) const {
        const int ch = wid * 32 + (lane & 31); LAS bf16* so = (LAS bf16*)lds;
#pragma unroll
        for (int mt = 0; mt < 2; ++mt)
#pragma unroll
            for (int r = 0; r < 16; ++r) { const int k2 = 32 * mt + (r & 3) + 8 * (r >> 2) + 4 * (lane >> 5); so[k2 * SOUT_PITCH + ch] = (bf16)f2bf(DBG_NO_FOUR ? 0.f : acc[mt][r]); }
        RowPB rp{mrg, b, k1}; slab_store_rows<64, false, RowPB>(lds, rp);
    } };
struct RowC { const bf16* z; int b; __device__ __forceinline__ const bf16* operator()(int k) const { return z + (size_t)(T + b * 256 + (k & 255)) * 512 + (k >> 8) * 256; } };
struct RowPC { bf16* mrg; int b, mt0; __device__ __forceinline__ bf16* operator()(int kk) const { return mrg + (size_t)(T + b * 256 + 32 * mt0 + kk) * 1024 + 768; } };
struct EpiC { bf16* mrg; int b, mt0;
    __device__ __forceinline__ void operator()(const f32x16 (&acc)[1], int wid, int lane, LAS unsigned char* lds) const {
        const int ch = wid * 32 + (lane & 31); LAS bf16* so = (LAS bf16*)lds;
#pragma unroll
        for (int r = 0; r < 16; ++r) { const int kk = (r & 3) + 8 * (r >> 2) + 4 * (lane >> 5); so[kk * SOUT_PITCH + ch] = (bf16)f2bf(DBG_NO_FOUR ? 0.f : acc[0][r]); }
        RowPC rp{mrg, b, mt0}; slab_store_rows<32, false, RowPC>(lds, rp);
    } };

__device__ __forceinline__ void tr_block(const float* src, int ldS, bf16* dst, int ldD, LAS float* scr, int lane) {
#pragma unroll 8
    for (int i = 0; i < 32; ++i) { const int kk = 2 * i + (lane >> 5); scr[kk * 33 + (lane & 31)] = src[(size_t)kk * ldS + (lane & 31)]; }
    LDS_WAIT(); asm volatile("" ::: "memory");
    const int c = lane & 7;
#pragma unroll
    for (int j = 0; j < 4; ++j) { const int n = (lane >> 3) + 8 * j; const LAS float* s = scr + (8 * c) * 33 + n;
        v4u o; o.x = pk2(s[0 * 33], s[1 * 33]); o.y = pk2(s[2 * 33], s[3 * 33]); o.z = pk2(s[4 * 33], s[5 * 33]); o.w = pk2(s[6 * 33], s[7 * 33]);
        *(GAS v4u*)(dst + (size_t)n * ldD + 8 * c) = o; }
    LDS_WAIT(); asm volatile("" ::: "memory");
}


__device__ __forceinline__ void tr_block64(const float* src, int ldS, bf16* dst, int ldD, LAS bf16* scr, int lane) {
    const int kr = lane >> 4, nc = lane & 15;
    f32x4 v[16];
#pragma unroll
    for (int i = 0; i < 16; ++i) v[i] = *(const f32x4*)(src + (size_t)(4 * i + kr) * ldS + 4 * nc);
#pragma unroll
    for (int i = 0; i < 16; ++i) { const int k = 4 * i + kr;
#pragma unroll
        for (int j = 0; j < 4; ++j) scr[(4 * nc + j) * 66 + k] = (bf16)f2bf(v[i][j]); }
    LDS_WAIT(); asm volatile("" ::: "memory");
    const int c = lane & 7;
#pragma unroll
    for (int j = 0; j < 8; ++j) { const int n = (lane >> 3) + 8 * j; const LAS unsigned* p = (const LAS unsigned*)(scr + n * 66 + 8 * c);
        v4u o; o.x = p[0]; o.y = p[1]; o.z = p[2]; o.w = p[3];
        *(GAS v4u*)(dst + (size_t)n * ldD + 8 * c) = o; }
    LDS_WAIT(); asm volatile("" ::: "memory");
}

typedef const __attribute__((address_space(4))) Args* kargs_t;
__device__ __forceinline__ kargs_t ka_launder() { kargs_t p = (kargs_t)__builtin_amdgcn_kernarg_segment_ptr(); asm volatile("" : "+s"(p)); return p; }
__device__ __forceinline__ int tid_launder() { int t = threadIdx.x; asm volatile("" : "+v"(t)); return t; }
#define KA_DECL const kargs_t KA = ka_launder(); const int tid = tid_launder(); const int lane = tid & 63; const int wave = __builtin_amdgcn_readfirstlane(tid >> 6); const int gw = vcu * 8 + wave; const int gt = vcu * 512 + tid; (void)lane; (void)wave; (void)gw; (void)gt;
#define ws (KA->ws)
#define ctl ((gu32*)(ws + O_CTL))
#define x_in (KA->in[0])
#define c_in (KA->in[1])
#define ctx_in (KA->in[2])
#define cctx_in (KA->in[3])
#define w_mod (KA->in[4])
#define b_mod (KA->in[5])
#define norm1_g (KA->in[6])
#define w_in (KA->in[7])
#define q_norm_g (KA->in[8])
#define k_norm_g (KA->in[9])
#define attn_sink (KA->in[10])
#define pool_w (KA->in[11])
#define pool_scale (KA->in[12])
#define four_w (KA->in[13])
#define w_out (KA->in[14])
#define norm2_g (KA->in[15])
#define w_grp (KA->in[16])
#define b_grp (KA->in[17])
#define w_rtr (KA->in[18])
#define b_rtr (KA->in[19])
#define w_gate (KA->in[20])
#define w_up (KA->in[21])
#define w_down (KA->in[22])
#define outp (KA->out)
#define modv ((float*)(ws + O_MOD))
#define rope ((float2*)(ws + O_ROPE))
#define twt ((float2*)(ws + O_TW))
#define fma ((bf16*)(ws + O_FMA))
#define fmb ((bf16*)(ws + O_FMB))
#define fmc ((bf16*)(ws + O_FMC))
#define hbuf ((bf16*)(ws + O_H))
#define kall ((bf16*)(ws + O_KALL))
#define vall ((bf16*)(ws + O_VALL))
#define xc ((float*)(ws + O_XC))
#define list ((unsigned*)(ws + O_LIST))
#define wts ((float*)(ws + O_WTS))
#define act ((bf16*)(ws + O_ACT))
#define t2 ((bf16*)(ws + O_T2))
#define mrg ((bf16*)(ws + O_MRG))
#define qb ((bf16*)(ws + O_Q))
#define pu ((bf16*)(ws + O_PU))
#define zb ((bf16*)(ws + O_Z))
#define y2 ((bf16*)(ws + O_Y2))

#ifndef PH_MASK
#define PH_MASK 0x3ffff
#endif
#define IN(k) (lo <= (k) && (k) < hi && ((PH_MASK >> (k)) & 1))
#define SEAM(k) do { if (IN(k) && IN((k) + 1)) xcd_barrier(bar); } while (0)
#define modl (modv + (size_t)l * 5 * 6144)
#define win_t ((bf16*)(ws + O_WIN + l * SZ_WIN1))
#define wout_t ((bf16*)(ws + O_WOUT + l * SZ_WOUT1))
#define wgu_t ((bf16*)(ws + O_WGU + l * SZ_WGU1))
#define wd_t ((bf16*)(ws + O_WD + l * SZ_WD1))
constexpr int CV_A = 256, CV_B = 192, CV_C = 4096, CV_D = 2048, CV_L = CV_A + CV_B + CV_C + CV_D;
__device__ __forceinline__ void conv_item(const kargs_t KA, const int lw, int it, LAS bf16* scr, const int lane) {
    bf16* p_win_t = (bf16*)(ws + O_WIN + lw * SZ_WIN1); bf16* p_wout_t = (bf16*)(ws + O_WOUT + lw * SZ_WOUT1);
    bf16* p_wgu_t = (bf16*)(ws + O_WGU + lw * SZ_WGU1); bf16* p_wd_t = (bf16*)(ws + O_WD + lw * SZ_WD1);
    if (it < CV_A) { const int kb = it >> 4, nb = it & 15; tr_block64(w_in + (size_t)lw * 1024 * 1280 + (size_t)kb * 64 * 1280 + nb * 64, 1280, p_win_t + (size_t)nb * 64 * 1024 + kb * 64, 1024, scr, lane); return; } it -= CV_A;
    if (it < CV_B) { const int kb = 4 + (it >> 4), nb = it & 15; tr_block64(w_out + (size_t)lw * 1024 * 1024 + (size_t)kb * 64 * 1024 + nb * 64, 1024, p_wout_t + (size_t)nb * 64 * 1024 + kb * 64, 1024, scr, lane); return; } it -= CV_B;
    if (it < CV_C) { const int up = it >> 11, r = it & 2047, e = r >> 7, kb = (r >> 3) & 15, nb = r & 7; const int n0 = nb * 64;
        const float* src = (up ? w_up : w_gate) + ((size_t)(lw * 16 + e) * 1024 + kb * 64) * 512 + n0;
        const int drow = (n0 >> 7) * 256 + up * 128 + (n0 & 127);
        tr_block64(src, 512, p_wgu_t + ((size_t)e * 1024 + drow) * 1024 + kb * 64, 1024, scr, lane); return; } it -= CV_C;
    { const int e = it >> 7, kb = (it >> 4) & 7, nb = it & 15;
        tr_block64(w_down + ((size_t)(lw * 16 + e) * 512 + kb * 64) * 1024 + nb * 64, 1024, p_wd_t + ((size_t)e * 1024 + nb * 64) * 512 + kb * 64, 512, scr, lane); }
}
__device__ __forceinline__ void steal_convert(const kargs_t KA, LAS unsigned char* lds, const int G, const int done_idx, const bool drain) {
    int tid = threadIdx.x; asm volatile("" : "+v"(tid));
    const int lane = tid & 63, wave = __builtin_amdgcn_readfirstlane(tid >> 6);
    volatile LAS int* mb = (volatile LAS int*)(lds + MISC_OFF + 64);
    LAS bf16* scr = (LAS bf16*)(lds + wave * 16384);
    __syncthreads();
    if (tid == 0 && !drain) __hip_atomic_fetch_add((unsigned*)(ctl + CW_DONE + 64 * done_idx), 1u, RLX_AGENT);
    for (;;) {
        if (tid == 0) { int idx = -1;
            const bool stop = !drain && __hip_atomic_load((unsigned*)(ctl + CW_DONE + 64 * done_idx), RLX_AGENT) >= (unsigned)G;
            if (!stop) idx = (int)__hip_atomic_fetch_add((unsigned*)(ctl + CW_Q), 8u, RLX_AGENT);
            mb[0] = idx; }
        __syncthreads();
        const int idx = mb[0];
        __syncthreads();
        if (idx < 0 || idx >= CV_L) break;
        if (idx + wave < CV_L) conv_item(KA, 1, idx + wave, scr, lane);
    }
    __syncthreads();
}

template <int l> __device__ __forceinline__ void layer_body(LAS unsigned char* lds, const int G, const int vcu, const XcdBarrier& bar, const int lo, const int hi) {
    const int NGW = G * 8, NGT = G * 512; LAS int* ttab = (LAS int*)(lds + TILE_OFF);
    constexpr int P = 1 + 8 * l;

        for (int rep_ = 0; rep_ < 1 + ((l == 0) ? ((REP_MASK >> (1 + 0)) & 1) : 0); ++rep_)
        if (IN(P + 0)) {
            KA_DECL
            const float* modp = modv;
            if (l == 1) steal_convert(KA, lds, G, 3, true);
#pragma clang loop vectorize(disable) unroll(disable)
            for (int r0 = gw; r0 < TT; r0 += 2 * NGW) {
                const int r1 = r0 + NGW; const bool has1 = r1 < TT;
                f32x4 va[4], vb[4]; v2u yaa[4], yab[4], yba[4], ybb[4];
                const float* srca; const float* srcb;
                { const bool isc = r0 >= T; srca = (l == 0) ? (isc ? ctx_in + (size_t)(r0 - T) * 1024 : x_in + (size_t)r0 * 1024) : (isc ? xc + (size_t)(r0 - T) * 1024 : outp + (size_t)r0 * 1024); }
                { const int rr = has1 ? r1 : r0; const bool isc = rr >= T; srcb = (l == 0) ? (isc ? ctx_in + (size_t)(rr - T) * 1024 : x_in + (size_t)rr * 1024) : (isc ? xc + (size_t)(rr - T) * 1024 : outp + (size_t)rr * 1024); }
#pragma unroll
                for (int j = 0; j < 4; ++j) { va[j] = *(const f32x4*)(srca + 4 * lane + 256 * j); vb[j] = *(const f32x4*)(srcb + 4 * lane + 256 * j); }
                if (l == 1) {
                    const int rr = has1 ? r1 : r0;
#pragma unroll
                    for (int j = 0; j < 4; ++j) { yaa[j] = *(const v2u*)(y2 + (size_t)(2 * r0) * 1024 + 4 * lane + 256 * j); yab[j] = *(const v2u*)(y2 + (size_t)(2 * r0 + 1) * 1024 + 4 * lane + 256 * j);
                        yba[j] = *(const v2u*)(y2 + (size_t)(2 * rr) * 1024 + 4 * lane + 256 * j); ybb[j] = *(const v2u*)(y2 + (size_t)(2 * rr + 1) * 1024 + 4 * lane + 256 * j); }
                }
#pragma unroll
                for (int half = 0; half < 2; ++half) {
                    if (half == 1 && !has1) break;
                    const int r = half ? r1 : r0; f32x4 (&v)[4] = half ? vb : va; v2u (&ya)[4] = half ? yba : yaa; v2u (&yb)[4] = half ? ybb : yab;
                    const bool isc = r >= T; const int bsel = isc ? 4 : (r >> 12);
                    if (l == 1) {
                        const float* g2 = modp + bsel * 6144 + 5 * 1024; float* dst = isc ? xc + (size_t)(r - T) * 1024 : outp + (size_t)r * 1024;
#pragma unroll
                        for (int j = 0; j < 4; ++j) {
                            const f32x4 gv = *(const f32x4*)(g2 + 4 * lane + 256 * j);
                            f32x4 yy; yy[0] = bflo(ya[j].x) + bflo(yb[j].x); yy[1] = bfhi(ya[j].x) + bfhi(yb[j].x); yy[2] = bflo(ya[j].y) + bflo(yb[j].y); yy[3] = bfhi(ya[j].y) + bfhi(yb[j].y);
                            if (DBG_NO_MOE) yy = (f32x4){0.f, 0.f, 0.f, 0.f};
                            v[j] = v[j] + gv * yy; *(f32x4*)(dst + 4 * lane + 256 * j) = v[j];
                        }
                    }
                    float ss = 0.f;
#pragma unroll
                    for (int j = 0; j < 4; ++j) ss += (v[j][0] * v[j][0] + v[j][1] * v[j][1]) + (v[j][2] * v[j][2] + v[j][3] * v[j][3]);
                    const float rstd = 1.0f / sqrtf(wave_sum(ss) * (1.f / 1024.f) + 1e-6f);
                    const float* sh = modl + bsel * 6144; const float* sc = sh + 1024; const float* gn = norm1_g + l * 1024;
#pragma unroll
                    for (int j = 0; j < 4; ++j) {
                        const int c0 = 4 * lane + 256 * j; const f32x4 g = *(const f32x4*)(gn + c0), s1 = *(const f32x4*)(sc + c0), h1 = *(const f32x4*)(sh + c0);
                        const f32x4 y = (v[j] * rstd) * g * (s1 + 1.0f) + h1;
                        v2u o; o.x = pk2(y[0], y[1]); o.y = pk2(y[2], y[3]); *(v2u*)(hbuf + (size_t)r * 1024 + c0) = o;
                    }
                }
            }
        }
        SEAM(P + 0);
        for (int rep_ = 0; rep_ < 1 + ((l == 0) ? ((REP_MASK >> (1 + 1)) & 1) : 0); ++rep_)
        if (IN(P + 1)) {
            KA_DECL
            SchedPlain S{TT / 256, 6, G, vcu, 1024, (const char*)hbuf, (const char*)win_t};
            EpiG1 E{pu, qb, kall, vall, zb};
            pg8::gemm_phase<EpiG1, SchedPlain>(lds, S, E);
            if (l == 0 && !MK_SPLIT) steal_convert(KA, lds, G, 0, false);
        }
        SEAM(P + 1);
        if (IN(P + 3)) {
            KA_DECL
            gu32* kflag = ctl + CW_KF + l * 16384;
            gu32* facnt = ctl + CW_FA + l * 64;
            for (int it = vcu; it < 256; it += G) {
                const int b = it >> 6, n2 = it & 63;
                RowA ra{zb, b, n2}; EpiA<true> ea{t2, twt, b, n2};
                slab_gemm<4, RowA, EpiA<true>>(lds, fma, 128, ra, ea);
                asm volatile("s_waitcnt vmcnt(0)" ::: "memory");
                __syncthreads();
                if (tid == 0) __hip_atomic_fetch_add((unsigned*)(facnt + 16 * b), 1u, RLX_AGENT);
            }
            const int n_att = 512 + (l == 0 ? 32 : 0);
            for (int it = vcu; it < n_att; it += G) {
                const bool cu = it >= 512; const int uidx = cu ? it - 512 : it;
                const int b = cu ? (uidx >> 3) : (uidx >> 7), kvh = cu ? ((uidx >> 2) & 1) : ((uidx >> 6) & 1), pb = cu ? (uidx & 3) : (uidx & 63);
                const int p0 = pb * 64; const int qrow0 = cu ? T + b * 256 + p0 : b * 4096 + p0;
                if (!cu) {
                    const int row = tid >> 3, c = tid & 7;
                    const float* kg = k_norm_g + l * 64 + 8 * c;
#pragma unroll
                    for (int part = 0; part < 2; ++part) {
                        if (part == 1 && pb >= 4) break;
                        const int blk = part ? pb : 4 + pb;
                        bf16* p = kall + ((size_t)b * KVROWS + blk * 64 + row) * 128 + kvh * 64 + c * 8;
                        const v4u w = *(const v4u*)p;
                        float x[8] = {bflo(w.x), bfhi(w.x), bflo(w.y), bfhi(w.y), bflo(w.z), bfhi(w.z), bflo(w.w), bfhi(w.w)};
                        float ss = 0.f;
#pragma unroll
                        for (int i = 0; i < 8; ++i) ss += x[i] * x[i];
                        ss += __shfl_xor(ss, 1); ss += __shfl_xor(ss, 2); ss += __shfl_xor(ss, 4);
                        const float rstd = 1.0f / sqrtf(ss * (1.f / 64.f) + 1e-6f);
#pragma unroll
                        for (int i = 0; i < 8; ++i) x[i] *= rstd * kg[i];
                        if (part == 0) {
                            const float2* rp = rope + (size_t)(p0 + row) * 32 + ((c & 4) ? 16 : 0) + (c & 1) * 8;
#pragma unroll
                            for (int i = 0; i < 8; ++i) { const float y = __shfl_xor(x[i], 2); const float2 cs = rp[i]; x[i] = (c & 2) ? (x[i] * cs.x + y * cs.y) : (x[i] * cs.x - y * cs.y); }
                        }
                        v4u o; o.x = pk2(x[0], x[1]); o.y = pk2(x[2], x[3]); o.z = pk2(x[4], x[5]); o.w = pk2(x[6], x[7]);
                        store16_wt(p, o);
                    }
                    asm volatile("s_waitcnt vmcnt(0)" ::: "memory");
                    __syncthreads();
                    if (tid == 0) { __hip_atomic_store(kflag + 16 * ((b * 68 + 4 + pb) * 2 + kvh), 1u, RLX_AGENT); if (pb < 4) __hip_atomic_store(kflag + 16 * ((b * 68 + pb) * 2 + kvh), 1u, RLX_AGENT); }
                }
                if (tid < 64) {
                    int blk = -1;
                    if (lane < 4) blk = lane; else if (!cu && lane < 9) { const int q = pb + lane - 6; if (q >= 0 && q < 64) blk = 4 + q; }
                    unsigned sp = 0;
                    for (;;) { const unsigned f = (blk >= 0) ? __hip_atomic_load(kflag + 16 * ((b * 68 + blk) * 2 + kvh), RLX_AGENT) : 1u;
                        if (__all(f != 0u)) break; __builtin_amdgcn_s_sleep(2);
                        if (++sp > (1u << 22)) { if (tid == 0) __hip_atomic_store(ctl + CW_TMO, 2u, RLX_AGENT); break; } }
                    __builtin_amdgcn_fence(__ATOMIC_ACQUIRE, "agent");
                    asm volatile("s_waitcnt vmcnt(0)" ::: "memory");
                }
                __syncthreads();
                const attn_body::bf16* Qu = (const attn_body::bf16*)(qb + (size_t)qrow0 * 512 + kvh * 256);
                const attn_body::bf16* Kh = (const attn_body::bf16*)(kall + (size_t)b * KVROWS * 128 + kvh * 64);
                const attn_body::bf16* Vh = (const attn_body::bf16*)(vall + (size_t)b * KVROWS * 128 + kvh * 64);
                attn_body::bf16* Ou = (attn_body::bf16*)(mrg + (size_t)qrow0 * 1024 + 256 + kvh * 256);
                attn_body::attn_unit<8>(Qu, Kh, Vh, Ou, p0, cu ? 4 : 10, attn_sink + l * 8 + kvh * 4, q_norm_g + l * 64, cu ? (const float2*)nullptr : (const float2*)rope, (char*)lds);
                __syncthreads();
            }
            const int prow = (l == 0) ? TT : T; const int nrb = prow >> 3;
#pragma clang loop vectorize(disable) unroll(disable)
            for (int i = gt; i < 32 * nrb; i += NGT) {
                const int ck8 = i & 7, rb = (i >> 3) % nrb, g = (i >> 3) / nrb;
                const int r0 = rb * 8; const bool isc = r0 >= T;
                const int nseq = isc ? LCTX : NSEQ; const int rbase = isc ? T + ((r0 - T) & ~255) : (r0 & ~4095); const int n0 = r0 - rbase;
                const int hw = 1 << g; const int col = g * 64 + ck8 * 8;
                const bf16* up = pu + (size_t)rbase * 256 + col;
                float sm[8] = {0.f, 0.f, 0.f, 0.f, 0.f, 0.f, 0.f, 0.f};
#define POOL_ACC(W, SGN) do { sm[0] += SGN bflo(W.x); sm[1] += SGN bfhi(W.x); sm[2] += SGN bflo(W.y); sm[3] += SGN bfhi(W.y); sm[4] += SGN bflo(W.z); sm[5] += SGN bfhi(W.z); sm[6] += SGN bflo(W.w); sm[7] += SGN bfhi(W.w); } while (0)
                for (int tpos = n0 - hw; tpos < n0 + hw; ++tpos) if (tpos >= 0 && tpos < nseq) { const v4u w = *(const v4u*)(up + (size_t)tpos * 256); POOL_ACC(w, +); }
#pragma unroll
                for (int k = 0; k < 8; ++k) {
                    const int n = n0 + k; int lo_ = n - hw; lo_ = lo_ < 0 ? 0 : lo_; int hi_ = n + hw - 1; hi_ = hi_ > nseq - 1 ? nseq - 1 : hi_;
                    const v4u w = *(const v4u*)(up + (size_t)n * 256); const float ic = 1.0f / (float)(hi_ - lo_ + 1);
                    v4u o; o.x = pk2(sm[0] * ic - bflo(w.x), sm[1] * ic - bfhi(w.x)); o.y = pk2(sm[2] * ic - bflo(w.y), sm[3] * ic - bfhi(w.y));
                    o.z = pk2(sm[4] * ic - bflo(w.z), sm[5] * ic - bfhi(w.z)); o.w = pk2(sm[6] * ic - bflo(w.w), sm[7] * ic - bfhi(w.w));
                    if (DBG_NO_POOL) o = (v4u){0u, 0u, 0u, 0u};
                    *(v4u*)(mrg + (size_t)(rbase + n) * 1024 + col) = o;
                    if (k < 7) { const int tin = n + hw, tout = n - hw;
                        if (tin < nseq) { const v4u wi = *(const v4u*)(up + (size_t)tin * 256); POOL_ACC(wi, +); }
                        if (tout >= 0) { const v4u wo = *(const v4u*)(up + (size_t)tout * 256); POOL_ACC(wo, -); } }
                }
#undef POOL_ACC
            }
            for (int it = vcu; it < 256; it += G) {
                const int b = it >> 6, k1 = it & 63;
                __syncthreads();
                if (tid < 64) { unsigned sp = 0;
                    while ((unsigned)__builtin_amdgcn_readfirstlane(__hip_atomic_load((unsigned*)(facnt + 16 * b), RLX_AGENT)) < 64u) { __builtin_amdgcn_s_sleep(2); if (++sp > (1u << 22)) { if (tid == 0) __hip_atomic_store(ctl + CW_TMO, 3u, RLX_AGENT); break; } }
                    __builtin_amdgcn_fence(__ATOMIC_ACQUIRE, "agent");
                    asm volatile("s_waitcnt vmcnt(0)" ::: "memory"); }
                __syncthreads();
                RowB rb{t2, b, k1}; EpiB eb{mrg, b, k1};
                slab_gemm<2, RowB, EpiB>(lds, fmb, 128, rb, eb);
            }
            if (l == 0) for (int it = (G - 1 - vcu); it < 32; it += G) {
                const int b = it >> 3, mt0 = it & 7;
                RowC rc{zb, b}; EpiC ec{mrg, b, mt0};
                slab_gemm<1, RowC, EpiC>(lds, fmc + (size_t)mt0 * 32 * 512, 512, rc, ec);
            }
        }
        SEAM(P + 3);
        if (IN(P + 4)) {
            KA_DECL
            unsigned* g2rdy = (unsigned*)(ctl + CW_G2 + l * 2048);
            {
                SchedPlain S{(l == 0 ? TT : T) / 256, 4, G, vcu, 1024, (const char*)mrg, (const char*)wout_t};
                EpiG2 E{(l == 0) ? x_in : outp, ctx_in, outp, xc, modl, g2rdy};
                pg8::gemm_phase<EpiG2, SchedPlain>(lds, S, E);
            }
            const int rep_ = 0;
            __syncthreads();
            LAS float* rw = (LAS float*)lds;
            LAS int* lcnt = (LAS int*)(lds + 81920);
            LAS unsigned* lent = (LAS unsigned*)(lds + 81920 + 256);
            LAS unsigned* lrank = lent + 1024;
            for (int i = tid; i < 1024 * 20; i += 512) { const int d = i / 20, j = i % 20;
                rw[((((j >> 2) * 4 + (d >> 8)) * 4 + (d & 3)) * 64 + ((d & 255) >> 2)) * 4 + (j & 3)] = (j < 4) ? w_grp[(size_t)l * 4096 + d * 4 + j] : w_rtr[(size_t)l * 16384 + d * 16 + (j - 4)]; }
            if (tid < 33) lcnt[tid] = 0;
            if (tid < 64) { unsigned sp = 0; unsigned* w = g2rdy + 16 * (vcu >> 2);
                while ((unsigned)__builtin_amdgcn_readfirstlane(__hip_atomic_load(w, RLX_AGENT)) < 32u) { __builtin_amdgcn_s_sleep(2); if (++sp > (1u << 22)) { if (tid == 0) __hip_atomic_store(ctl + CW_TMO, 4u, RLX_AGENT); break; } }
                __builtin_amdgcn_fence(__ATOMIC_ACQUIRE, "agent");
                asm volatile("s_waitcnt vmcnt(0)" ::: "memory"); }
            __syncthreads();
            const bool dbl = (l == 0) && (G == 256) && (vcu < 16);
            const int ngl = 16 + ((l == 0) ? 1 : 0) + (((l == 0) && (G == 256)) ? 2 : 0);
#pragma clang loop vectorize(disable) unroll(disable)
            for (int gix = wave; gix < ngl; gix += 8) {
                int q;
                if (gix < 16) { if (dbl) continue; q = 16 * vcu + gix; }
                else if (gix == 16) q = T / 4 + vcu;
                else { if (dbl) continue; const int o = (gix == 17) ? (vcu - 16) : (240 + vcu - 16); if (o >= 256 || (gix == 18 && vcu >= 32)) continue; q = o; }
                if (gix >= 17) {
                    unsigned sp = 0; unsigned* w = g2rdy + 16 * (q >> 6);
                    while ((unsigned)__builtin_amdgcn_readfirstlane(__hip_atomic_load(w, RLX_AGENT)) < 32u) { __builtin_amdgcn_s_sleep(2); if (++sp > (1u << 22)) { if (lane == 0) __hip_atomic_store(ctl + CW_TMO, 6u, RLX_AGENT); break; } }
                    __builtin_amdgcn_fence(__ATOMIC_ACQUIRE, "agent");
                    asm volatile("s_waitcnt vmcnt(0)" ::: "memory"); }
                if (gix == 16) { unsigned sp = 0; unsigned* w = g2rdy + 16 * (64 + (vcu >> 6));
                    while ((unsigned)__builtin_amdgcn_readfirstlane(__hip_atomic_load(w, RLX_AGENT)) < 32u) { __builtin_amdgcn_s_sleep(2); if (++sp > (1u << 22)) { if (lane == 0) __hip_atomic_store(ctl + CW_TMO, 5u, RLX_AGENT); break; } }
                    __builtin_amdgcn_fence(__ATOMIC_ACQUIRE, "agent");
                    asm volatile("s_waitcnt vmcnt(0)" ::: "memory"); }
                const int rb4 = 4 * q; const bool isc = rb4 >= T; const int bsel = isc ? 4 : (rb4 >> 12);
                const float* src = isc ? xc + (size_t)(rb4 - T) * 1024 : outp + (size_t)rb4 * 1024;
                f32x4 v[4][4];
#pragma unroll
                for (int tk = 0; tk < 4; ++tk)
#pragma unroll
                    for (int j = 0; j < 4; ++j) v[tk][j] = *(const f32x4*)(src + (size_t)tk * 1024 + 4 * lane + 256 * j);
                float rstd[4];
#pragma unroll
                for (int tk = 0; tk < 4; ++tk) { float ss = 0.f;
#pragma unroll
                    for (int j = 0; j < 4; ++j) ss += (v[tk][j][0] * v[tk][j][0] + v[tk][j][1] * v[tk][j][1]) + (v[tk][j][2] * v[tk][j][2] + v[tk][j][3] * v[tk][j][3]);
                    rstd[tk] = 1.0f / sqrtf(wave_sum(ss) * (1.f / 1024.f) + 1e-6f); }
                const float* sh = modl + bsel * 6144 + 3 * 1024; const float* sc = sh + 1024; const float* gn = norm2_g + l * 1024;
                float lg[4][20];
#pragma unroll
                for (int tk = 0; tk < 4; ++tk)
#pragma unroll
                    for (int j = 0; j < 20; ++j) lg[tk][j] = 0.f;
#pragma unroll
                for (int j = 0; j < 4; ++j) {
                    const int c0 = 4 * lane + 256 * j; const f32x4 g = *(const f32x4*)(gn + c0), s1 = *(const f32x4*)(sc + c0), h1 = *(const f32x4*)(sh + c0);
                    f32x4 y[4];
#pragma unroll
                    for (int tk = 0; tk < 4; ++tk) { y[tk] = (v[tk][j] * rstd[tk]) * g * (s1 + 1.0f) + h1;
                        v2u o; o.x = pk2(y[tk][0], y[tk][1]); o.y = pk2(y[tk][2], y[tk][3]); *(v2u*)(hbuf + (size_t)(rb4 + tk) * 1024 + c0) = o; }
#pragma unroll
                    for (int e = 0; e < 4; ++e) {
#pragma unroll
                        for (int q5 = 0; q5 < 5; ++q5) { const f32x4 wv = *(const LAS f32x4*)(rw + (((q5 * 4 + j) * 4 + e) * 64 + lane) * 4);
#pragma unroll
                            for (int tk = 0; tk < 4; ++tk) { lg[tk][4 * q5] += y[tk][e] * wv[0]; lg[tk][4 * q5 + 1] += y[tk][e] * wv[1]; lg[tk][4 * q5 + 2] += y[tk][e] * wv[2]; lg[tk][4 * q5 + 3] += y[tk][e] * wv[3]; } }
                        __builtin_amdgcn_sched_barrier(0); }
                }
                float l2[20];
#pragma unroll
                for (int j = 0; j < 20; ++j) {
                    const float a0 = swap32_sum(lg[0][j], lg[2][j]);
                    const float a1 = swap32_sum(lg[1][j], lg[3][j]);
                    float t = swap16_sum(a0, a1);
                    t += dppf<0x128, 0xf>(t); t += dppf<0x124, 0xf>(t); t += dppf<0x122, 0xf>(t); t += dppf<0x121, 0xf>(t);
                    l2[j] = t;
                }
                const int tk = lane >> 4; const int r = rb4 + tk;
                float gl[4]; float gm = -1e30f;
#pragma unroll
                for (int j = 0; j < 4; ++j) { gl[j] = l2[j] + b_grp[l * 4 + j]; gm = fmaxf(gm, gl[j]); }
                float gs = 0.f; int gi = 0; float gb = -1e30f;
#pragma unroll
                for (int j = 0; j < 4; ++j) { const float e = expf(gl[j] - gm); gs += e; if (gl[j] > gb) { gb = gl[j]; gi = j; } }
                const float pg = expf(gb - gm) / gs;
                float el[4]; float em = -1e30f;
#pragma unroll
                for (int j = 0; j < 4; ++j) { float t_ = 0.f;
#pragma unroll
                    for (int g4 = 0; g4 < 4; ++g4) t_ = (gi == g4) ? (l2[4 + g4 * 4 + j] + b_rtr[l * 16 + g4 * 4 + j]) : t_;
                    el[j] = t_; em = fmaxf(em, t_); }
                float pe[4];
#pragma unroll
                for (int j = 0; j < 4; ++j) pe[j] = expf(el[j] - em);
                int i0 = 0; float b0 = -1.f;
#pragma unroll
                for (int j = 0; j < 4; ++j) if (pe[j] > b0) { b0 = pe[j]; i0 = j; }
                int i1 = 0; float b1 = -1.f;
#pragma unroll
                for (int j = 0; j < 4; ++j) if (j != i0 && pe[j] > b1) { b1 = pe[j]; i1 = j; }
                const float wsum = b0 + b1; const float w0 = pg * b0 / wsum, w1 = pg * b1 / wsum;
                if ((lane & 15) == 0 && rep_ == 0) {
                    wts[2 * r] = w0; wts[2 * r + 1] = w1;
                    const int e0 = gi * 4 + i0, e1 = gi * 4 + i1;
                    const int s0 = __hip_atomic_fetch_add((LAS int*)(lcnt + 16 + 16), 1, __ATOMIC_RELAXED, __HIP_MEMORY_SCOPE_WORKGROUP);
                    const int k0 = __hip_atomic_fetch_add((LAS int*)(lcnt + e0), 1, __ATOMIC_RELAXED, __HIP_MEMORY_SCOPE_WORKGROUP);
                    const int k1 = __hip_atomic_fetch_add((LAS int*)(lcnt + e1), 1, __ATOMIC_RELAXED, __HIP_MEMORY_SCOPE_WORKGROUP);
                    lent[2 * s0] = ((unsigned)(2 * r) << 4) | (unsigned)e0; lrank[2 * s0] = (unsigned)k0;
                    lent[2 * s0 + 1] = ((unsigned)(2 * r + 1) << 4) | (unsigned)e1; lrank[2 * s0 + 1] = (unsigned)k1;
                }
            }
            __syncthreads();
            if (tid < 16 && rep_ == 0) { const int c = lcnt[tid]; lcnt[16 + tid] = c ? (int)__hip_atomic_fetch_add((unsigned*)(ctl + CW_CNT + (l * 16 + tid) * 64), (unsigned)c, RLX_AGENT) : 0; }
            __syncthreads();
            const int ntot = rep_ == 0 ? 2 * lcnt[32] : 0;
            for (int i = tid; i < ntot; i += 512) { const unsigned en = lent[i]; const int e = en & 15; list[(size_t)e * TT + lcnt[16 + e] + lrank[i]] = en >> 4; }
            __syncthreads();
            if (l == 0 && !MK_SPLIT) steal_convert(KA, lds, G, 1, false);
        }
        SEAM(P + 5);
        if (IN(P + 6) || IN(P + 7)) {
            KA_DECL
            __syncthreads();
            if (tid == 0) { int acc_ = 0; for (int e = 0; e < 16; ++e) { const int c = (int)__hip_atomic_load((unsigned*)(ctl + CW_CNT + (l * 16 + e) * 64), RLX_AGENT); ttab[e] = acc_; ttab[17 + e] = c; acc_ += (c + 255) >> 8; } ttab[16] = acc_; }
            __syncthreads();
        }
        if (DBG_NAIVE_MOE && IN(P + 6)) {
            KA_DECL
            const int nrows = (l == 0) ? TT : T; LAS float* hs = (LAS float*)lds; LAS float* as = hs + 1024;
            const int* eidg = (const int*)(ws + O_EID);
            LAS float* lgs = as + 512; LAS float* rt = lgs + 32;
            for (int r = vcu; r < nrows; r += G) {
                __syncthreads();
                for (int i = tid; i < 1024; i += 512) hs[i] = bf2f(hbuf[(size_t)r * 1024 + i]);
                __syncthreads();
                if (tid < 20) { float a = 0.f; for (int k = 0; k < 1024; ++k) a += hs[k] * ((tid < 4) ? w_grp[(size_t)l * 4096 + k * 4 + tid] : w_rtr[(size_t)l * 16384 + k * 16 + (tid - 4)]);
                    lgs[tid] = a + ((tid < 4) ? b_grp[l * 4 + tid] : b_rtr[l * 16 + tid - 4]); }
                __syncthreads();
                if (tid == 0) { int gi = 0; for (int j = 1; j < 4; ++j) if (lgs[j] > lgs[gi]) gi = j; float gs = 0.f; for (int j = 0; j < 4; ++j) gs += expf(lgs[j] - lgs[gi]); const float pg = 1.f / gs;
                    int i0 = 0; for (int j = 1; j < 4; ++j) if (lgs[4 + gi * 4 + j] > lgs[4 + gi * 4 + i0]) i0 = j; int i1 = -1; for (int j = 0; j < 4; ++j) if (j != i0 && (i1 < 0 || lgs[4 + gi * 4 + j] > lgs[4 + gi * 4 + i1])) i1 = j;
                    const float p0 = 1.f, p1 = expf(lgs[4 + gi * 4 + i1] - lgs[4 + gi * 4 + i0]); rt[0] = (float)(gi * 4 + i0); rt[1] = (float)(gi * 4 + i1); rt[2] = pg * p0 / (p0 + p1); rt[3] = pg * p1 / (p0 + p1); }
                __syncthreads();
                for (int sl = 0; sl < 2; ++sl) {
                    const int e = (DBG_NAIVE_ROUTE & 1) ? (int)rt[sl] : eidg[2 * r + sl]; const float w = (DBG_NAIVE_ROUTE & 2) ? rt[2 + sl] : wts[2 * r + sl];
                    __syncthreads();
                    const float* Wg = w_gate + (size_t)(l * 16 + e) * 1024 * 512 + tid; const float* Wu = w_up + (size_t)(l * 16 + e) * 1024 * 512 + tid;
                    float g = 0.f, u = 0.f;
#pragma unroll 8
                    for (int k = 0; k < 1024; ++k) { g += hs[k] * Wg[(size_t)k * 512]; u += hs[k] * Wu[(size_t)k * 512]; }
                    as[tid] = g / (1.f + expf(-g)) * u;
                    __syncthreads();
                    const float* Wd = w_down + (size_t)(l * 16 + e) * 512 * 1024 + tid;
                    float y0 = 0.f, y1 = 0.f;
#pragma unroll 8
                    for (int j = 0; j < 512; ++j) { y0 += as[j] * Wd[(size_t)j * 1024]; y1 += as[j] * Wd[(size_t)j * 1024 + 512]; }
                    y2[(size_t)(2 * r + sl) * 1024 + tid] = (bf16)f2bf(y0 * w); y2[(size_t)(2 * r + sl) * 1024 + 512 + tid] = (bf16)f2bf(y1 * w);
                }
            }
        }
        if (!DBG_NAIVE_MOE && IN(P + 6)) {
            KA_DECL
            unsigned* rdy = (unsigned*)(ctl + CW_RDY + l * 4096);
            SchedMoe S{G, vcu, ttab[16], (const char*)hbuf, (const char*)act, (const char*)wgu_t, (const char*)wd_t, list, ttab, rdy, (unsigned*)(ctl + CW_TMO)};
            EpiMoe E{EpiG3{act, rdy}, EpiG4{y2, list, wts, ttab}};
            pg8::gemm_phase<EpiMoe, SchedMoe>(lds, S, E);
            if (l == 0 && !MK_SPLIT) steal_convert(KA, lds, G, 2, false);
        }
        SEAM(P + 7);
    }

__global__ void __launch_bounds__(512, 2) fwd_kernel(Args args) {
    extern __shared__ __attribute__((aligned(16))) unsigned char lds_raw[];
    LAS unsigned char* lds = (LAS unsigned char*)lds_raw;
    const int tid = threadIdx.x, lane = tid & 63, wave = __builtin_amdgcn_readfirstlane(tid >> 6);
    const int G = gridDim.x; const int bx = blockIdx.x; const int vcu = (G % 8 == 0) ? (bx % 8) * (G / 8) + bx / 8 : bx;
    volatile LAS unsigned* MISC = (volatile LAS unsigned*)(lds + MISC_OFF);
    LAS float* trig = (LAS float*)(lds + TRIG_OFF);
    LAS int* ttab = (LAS int*)(lds + TILE_OFF);
    for (int u = tid; u < (LDS_BYTES - LDSCTL_OFF) / 4; u += 512) ((LAS unsigned*)(lds + LDSCTL_OFF))[u] = 0u;
    __syncthreads();
    if (tid < 64) { float s, c; sincospif((float)tid / 32.f, &s, &c); trig[tid] = c; trig[64 + tid] = s; }
    __syncthreads();
    XcdBarrier bar; bar.bar = nullptr; bar.x = 0; bar.st = nullptr;
    if (!MK_SPLIT) { KA_DECL bar = xcd_barrier_post((unsigned*)(ctl + CW_BAR), MISC + 8); }
    const int lo = args.ph_lo, hi = args.ph_hi;
    const int NGW = G * 8, NGT = G * 512;

    for (int rep_ = 0; rep_ < 1 + ((REP_MASK >> 0) & 1); ++rep_)
    if (IN(0)) {
        KA_DECL
        __syncthreads();
        if (rep_ == 0 || ((REP_MASK >> 13) & 1)) {
            LAS float* sl = (LAS float*)lds;
            bool have = false;
            for (int it = vcu; it < 192; it += G) {
                if (!have) {
                    for (int i = tid; i < 5120; i += 512) { const int r = i >> 10, k = i & 1023; const float v = (r < 4) ? c_in[r * 1024 + k] : cctx_in[k]; sl[i] = v / (1.f + expf(-v)); }
                    __syncthreads(); have = true;
                }
                const int l = it / 96, cb = it % 96;
                const int r4 = lane >> 4, cq = lane & 15; const int k0 = wave * 128;
                const float* W = w_mod + (size_t)l * 1024 * 6144 + (size_t)(k0 + r4) * 6144 + cb * 64 + 4 * cq;
                f32x4 a0 = {0.f, 0.f, 0.f, 0.f}, a1 = a0, a2 = a0, a3 = a0, a4 = a0;
#pragma unroll 8
                for (int k = 0; k < 32; ++k) { const f32x4 wv = *(const f32x4*)(W + (size_t)(4 * k) * 6144); const int kk = k0 + 4 * k + r4;
                    a0 += wv * sl[kk]; a1 += wv * sl[1024 + kk]; a2 += wv * sl[2048 + kk]; a3 += wv * sl[3072 + kk]; a4 += wv * sl[4096 + kk]; }
                LAS float* part = sl + 5120;
                { LAS float* pp = part + (wave * 4 + r4) * 320 + 4 * cq;
                  *(LAS f32x4*)(pp) = a0; *(LAS f32x4*)(pp + 64) = a1; *(LAS f32x4*)(pp + 128) = a2; *(LAS f32x4*)(pp + 192) = a3; *(LAS f32x4*)(pp + 256) = a4; }
                __syncthreads();
                if (tid < 320) { const int r = tid >> 6, n = tid & 63; float sacc = b_mod[l * 6144 + cb * 64 + n];
#pragma unroll 8
                    for (int w = 0; w < 32; ++w) sacc += part[w * 320 + r * 64 + n];
                    modv[(size_t)(l * 5 + r) * 6144 + cb * 64 + n] = sacc; }
                __syncthreads();
            }
            __syncthreads();
        }
        if (rep_ == 0 || ((REP_MASK >> 14) & 1)) {
#pragma clang loop vectorize(disable) unroll(disable)
        for (int i = gt; i < 4096 * 32; i += NGT) {
            const int n = i >> 5, j = i & 31; const int jj = j & 15;
            const float inv = 1.0f / powf(10000.0f, (float)(2 * jj) / 32.0f);
            const float pos = (j < 16) ? (float)(n >> 6) : (float)(n & 63);
            const float ang = pos * inv; rope[i] = make_float2(cosf(ang), sinf(ang));
        }
#pragma clang loop vectorize(disable) unroll(disable)
        for (int i = gt; i < 4096; i += NGT) { float s, c; sincospif((float)i / 2048.f, &s, &c); twt[i] = make_float2(c, s); }
#pragma clang loop vectorize(disable) unroll(disable)
        for (int i = gt; i < 128 * 128; i += NGT) {
            const int m = i >> 7, k = i & 127; const int ri = m >> 6, k1 = m & 63, part = k >> 6, n1 = k & 63;
            float s, c; sincospif((float)((n1 * k1) & 63) / 32.f, &s, &c);
            float v; if (ri == 0) v = (part == 0) ? c : -s; else v = (part == 0) ? -s : -c;
            fma[i] = (bf16)f2bf(v);
        }
#pragma clang loop vectorize(disable) unroll(disable)
        for (int i = gt; i < 64 * 128; i += NGT) {
            const int k2 = i >> 7, k = i & 127; const int ri = k >> 6, n2 = k & 63;
            float s, c; sincospif((float)((n2 * k2) & 63) / 32.f, &s, &c);
            fmb[i] = (bf16)f2bf((ri == 0 ? c : s) * (1.f / 512.f));
        }
#pragma clang loop vectorize(disable) unroll(disable)
        for (int i = gt; i < 256 * 512; i += NGT) {
            const int kk = i >> 9, k = i & 511; const int part = k >> 8, n = k & 255;
            float s, c; sincospif((float)((n * kk) & 255) / 128.f, &s, &c);
            fmc[i] = (bf16)f2bf((part == 0 ? c : -s) * (1.f / 128.f));
        }
        }
        if (rep_ == 0 || ((REP_MASK >> 15) & 1)) {
            LAS float* Al = (LAS float*)lds;
            LAS float* Wl = Al + 4096;
            LAS float* Xl = Wl + 4096;
            for (int it = vcu; it < 256; it += G) {
                const int combo = it & 15, jb = it >> 4; const int l = combo >> 3, g = (combo >> 1) & 3, which = combo & 1;
                const float* Wg = four_w + (size_t)(l * 4 + g) * 4096; const LAS float* tb = trig + which * 64;
                const float* wi = w_in + (size_t)l * 1024 * 1280 + (size_t)(jb * 64) * 1280 + 1024 + g * 64;
                __syncthreads();
#pragma unroll
                for (int i = 0; i < 2; ++i) { const int idx = tid + 512 * i; *(LAS f32x4*)(Wl + 4 * idx) = *(const f32x4*)(Wg + 4 * idx); const int j = idx >> 4, c4 = idx & 15; *(LAS f32x4*)(Xl + j * 64 + 4 * c4) = *(const f32x4*)(wi + (size_t)j * 1280 + 4 * c4); }
                __syncthreads();
                { const int d = tid & 63, c0 = tid >> 6;
#pragma unroll 2
                  for (int i = 0; i < 8; ++i) { const int c = c0 + 8 * i; float a = 0.f;
#pragma unroll 16
                      for (int m = 0; m < 64; ++m) a += tb[(m * c) & 63] * Wl[m * 64 + d];
                      Al[c * 64 + d] = a; } }
                __syncthreads();
                { const int d = tid & 63, jl = 8 * (tid >> 6);
                  float o[8] = {0.f, 0.f, 0.f, 0.f, 0.f, 0.f, 0.f, 0.f};
#pragma unroll 4
                  for (int c = 0; c < 64; ++c) { const float av = Al[c * 64 + d];
#pragma unroll
                      for (int i = 0; i < 8; ++i) o[i] += Xl[(jl + i) * 64 + c] * av; }
                  v4u w; w.x = pk2(o[0], o[1]); w.y = pk2(o[2], o[3]); w.z = pk2(o[4], o[5]); w.w = pk2(o[6], o[7]);
                  *(v4u*)((bf16*)(ws + O_WIN + l * SZ_WIN1) + (size_t)(1024 + which * 256 + g * 64 + d) * 1024 + jb * 64 + jl) = w; }
            }
            for (int it = vcu; it < 256; it += G) {
                const int combo = it & 7, nb = it >> 3; const int l = combo >> 2, g = combo & 3, n0 = nb * 32;
                const float* pwg = pool_w + (size_t)(l * 4 + g) * 4096;
                __syncthreads();
#pragma unroll
                for (int i = 0; i < 2; ++i) { const int idx = tid + 512 * i; *(LAS f32x4*)(Wl + 4 * idx) = *(const f32x4*)(pwg + 4 * idx); }
                for (int i = tid; i < 2048; i += 512) { const int d = i >> 5, n = i & 31; Xl[i] = pool_scale[l * 256 + g * 64 + d] * w_out[(size_t)l * 1024 * 1024 + (size_t)(g * 64 + d) * 1024 + n0 + n]; }
                __syncthreads();
                { const int n = tid & 31, c0 = 4 * (tid >> 5);
                  float o[4] = {0.f, 0.f, 0.f, 0.f};
#pragma unroll 8
                  for (int d = 0; d < 64; ++d) { const float sv = Xl[d * 32 + n];
#pragma unroll
                      for (int i = 0; i < 4; ++i) o[i] += Wl[(c0 + i) * 64 + d] * sv; }
                  v2u w; w.x = pk2(o[0], o[1]); w.y = pk2(o[2], o[3]);
                  *(v2u*)((bf16*)(ws + O_WOUT + l * SZ_WOUT1) + (size_t)(n0 + n) * 1024 + g * 64 + c0) = w; }
            }
            __syncthreads();
        }
        if (rep_ == 0 || ((REP_MASK >> 16) & 1)) {
            LAS bf16* scr = (LAS bf16*)(lds + wave * 16384);
#pragma clang loop vectorize(disable) unroll(disable)
            for (int it0 = gw; it0 < CV_L; it0 += NGW) conv_item(KA, 0, it0, scr, lane);
        }
    }
    SEAM(0);
    if ((REP_MASK >> 12) & 1) { for (int k_ = 0; k_ < 4; ++k_) xcd_barrier(bar); }

    layer_body<0>(lds, G, vcu, bar, lo, hi);
    layer_body<1>(lds, G, vcu, bar, lo, hi);
    if (IN(17)) {
        KA_DECL
        const float* modp = modv + (size_t)5 * 6144;
#pragma clang loop vectorize(disable) unroll(disable)
        for (int r = gw; r < T; r += NGW) {
            const float* g2 = modp + (r >> 12) * 6144 + 5 * 1024; float* dst = outp + (size_t)r * 1024;
#pragma unroll
            for (int j = 0; j < 4; ++j) {
                const int c0 = 4 * lane + 256 * j; f32x4 v = *(const f32x4*)(dst + c0);
                const v2u ya = *(const v2u*)(y2 + (size_t)(2 * r) * 1024 + c0), yb = *(const v2u*)(y2 + (size_t)(2 * r + 1) * 1024 + c0);
                const f32x4 gv = *(const f32x4*)(g2 + c0);
                f32x4 yy; yy[0] = bflo(ya.x) + bflo(yb.x); yy[1] = bfhi(ya.x) + bfhi(yb.x); yy[2] = bflo(ya.y) + bflo(yb.y); yy[3] = bfhi(ya.y) + bfhi(yb.y);
                if (DBG_NO_MOE) yy = (f32x4){0.f, 0.f, 0.f, 0.f};
                *(f32x4*)(dst + c0) = v + gv * yy;
            }
        }
    }
#undef IN
#undef SEAM
}

#undef KA_DECL
#undef ws
#undef ctl
#undef x_in
#undef c_in
#undef ctx_in
#undef cctx_in
#undef w_mod
#undef b_mod
#undef norm1_g
#undef w_in
#undef q_norm_g
#undef k_norm_g
#undef attn_sink
#undef pool_w
#undef pool_scale
#undef four_w
#undef w_out
#undef norm2_g
#undef w_grp
#undef b_grp
#undef w_rtr
#undef b_rtr
#undef w_gate
#undef w_up
#undef w_down
#undef outp
#undef modv
#undef rope
#undef twt
#undef fma
#undef fmb
#undef fmc
#undef hbuf
#undef kall
#undef vall
#undef xc
#undef list
#undef wts
#undef act
#undef t2
#undef mrg
#undef qb
#undef pu
#undef zb
#undef y2
#undef modl
#undef win_t
#undef wout_t
#undef wgu_t
#undef wd_t
extern "C" void kernel_launch(void* const* d_in, const int* in_sizes, int n_in, void* d_out, int out_size, void* d_ws, size_t ws_size, hipStream_t stream) {
    static int grid = 0;
    if (grid == 0) {
        if (n_in != 23 || out_size != T * DM || ws_size < WS_END) { fprintf(stderr, "kernel_launch: unexpected shapes (n_in %d out %d ws %zu need %zu)\n", n_in, out_size, ws_size, (size_t)WS_END); grid = -1; return; }
        int dev = 0, cus = 0;
        if (hipGetDevice(&dev) != hipSuccess || hipDeviceGetAttribute(&cus, hipDeviceAttributeMultiprocessorCount, dev) != hipSuccess) { grid = -1; return; }
        if (hipFuncSetAttribute((const void*)fwd_kernel, hipFuncAttributeMaxDynamicSharedMemorySize, LDS_BYTES) != hipSuccess) { fprintf(stderr, "kernel_launch: hipFuncSetAttribute failed\n"); grid = -1; return; }
        (void)hipGetLastError();
        grid = cus;
    }
    if (grid < 0) return;
    (void)hipMemsetAsync((char*)d_ws + O_CTL, 0, SZ_CTL, stream);
    Args a{};
    for (int i = 0; i < 23; ++i) a.in[i] = (const float*)d_in[i];
    a.out = (float*)d_out; a.ws = (unsigned char*)d_ws;
#if MK_SPLIT
    for (int p = 0; p < NPHASE; ++p) { a.ph_lo = p; a.ph_hi = p + 1; hipLaunchKernelGGL(fwd_kernel, dim3(grid), dim3(512), LDS_BYTES, stream, a); }
#else
    a.ph_lo = 0; a.ph_hi = NPHASE;
    hipLaunchKernelGGL(fwd_kernel, dim3(grid), dim3(512), LDS_BYTES, stream, a);
#endif
}
```

```cpp
#include <hip/hip_runtime.h>
#include <cstdio>
#include <cstdint>

#define DBG_NO_FOUR 0
#define DBG_NO_POOL 0
#define DBG_NO_ATT 0
#define DBG_NO_MOE 0
#define DBG_MOE_SCALE 1.0f
#define DBG_NAIVE_MOE 0
#define REP_MASK 0x0
#define DBG_NAIVE_ROUTE 0
#define LAS __attribute__((address_space(3)))
#define GAS __attribute__((address_space(1)))
typedef unsigned short bf16;
typedef short bf16x8 __attribute__((ext_vector_type(8)));
typedef float f32x4 __attribute__((ext_vector_type(4)));
typedef float f32x16 __attribute__((ext_vector_type(16)));
typedef unsigned v4u __attribute__((ext_vector_type(4)));
typedef unsigned v2u __attribute__((ext_vector_type(2)));
typedef GAS unsigned gu32;

#ifndef MK_SPLIT
#define MK_SPLIT 0
#endif

constexpr int NB = 4, NSEQ = 4096, DM = 1024, LCTX = 256, DEPTH = 2;
constexpr int T = NB * NSEQ, TC = NB * LCTX, TT = T + TC;
constexpr int KVROWS = LCTX + NSEQ;
constexpr int NEXP = 16, DEXP = 512;
constexpr int NPHASE = 18;
constexpr int MAXTILES = 152;
constexpr float QSCALE = 0.125f * 1.4426950408889634f;
constexpr float LOG2E = 1.4426950408889634f;

constexpr size_t al256(size_t x) { return (x + 255) & ~(size_t)255; }
constexpr size_t O_CTL = 0, SZ_CTL = 1u << 20;
constexpr size_t O_MOD = O_CTL + SZ_CTL, SZ_MOD = (size_t)2 * 5 * 6144 * 4;
constexpr size_t O_ROPE = al256(O_MOD + SZ_MOD), SZ_ROPE = (size_t)4096 * 32 * 8;
constexpr size_t O_TW = al256(O_ROPE + SZ_ROPE), SZ_TW = 4096 * 8;
constexpr size_t O_FMA = al256(O_TW + SZ_TW), SZ_FMA = 128 * 128 * 2;
constexpr size_t O_FMB = al256(O_FMA + SZ_FMA), SZ_FMB = 64 * 128 * 2;
constexpr size_t O_FMC = al256(O_FMB + SZ_FMB), SZ_FMC = 256 * 512 * 2;
constexpr size_t O_RW = al256(O_FMC + SZ_FMC), SZ_RW = (size_t)2 * 20480 * 4;
constexpr size_t O_WIN = al256(O_RW + SZ_RW), SZ_WIN1 = (size_t)1536 * 1024 * 2;
constexpr size_t O_WOUT = al256(O_WIN + 2 * SZ_WIN1), SZ_WOUT1 = (size_t)1024 * 1024 * 2;
constexpr size_t O_WGU = al256(O_WOUT + 2 * SZ_WOUT1), SZ_WGU1 = (size_t)16 * 1024 * 1024 * 2;
constexpr size_t O_WD = al256(O_WGU + 2 * SZ_WGU1), SZ_WD1 = (size_t)16 * 1024 * 512 * 2;
constexpr size_t O_H = al256(O_WD + 2 * SZ_WD1), SZ_H = (size_t)TT * 1024 * 2;
constexpr size_t O_KALL = al256(O_H + SZ_H), SZ_KV = (size_t)NB * KVROWS * 128 * 2;
constexpr size_t O_VALL = al256(O_KALL + SZ_KV);
constexpr size_t O_XC = al256(O_VALL + SZ_KV), SZ_XC = (size_t)TC * 1024 * 4;
constexpr size_t O_LIST = al256(O_XC + SZ_XC), SZ_LIST = (size_t)NEXP * TT * 4;
constexpr size_t O_WTS = al256(O_LIST + SZ_LIST), SZ_WTS = (size_t)TT * 2 * 4;
constexpr size_t O_EID = al256(O_WTS + SZ_WTS), SZ_EID = (size_t)TT * 2 * 4;
constexpr size_t O_ACT = al256(O_EID + SZ_EID), SZ_ACT = (size_t)MAXTILES * 256 * 512 * 2;
constexpr size_t O_T2 = O_ACT, SZ_T2 = (size_t)NB * 64 * 64 * 2 * 256 * 2;
constexpr size_t O_MRG = al256(O_ACT + SZ_ACT), SZ_MRG = (size_t)TT * 1024 * 2;
constexpr size_t O_Q = al256(O_MRG + SZ_MRG), SZ_Q = (size_t)TT * 512 * 2;
constexpr size_t O_PU = al256(O_Q + SZ_Q), SZ_PU = (size_t)TT * 256 * 2;
constexpr size_t O_Z = al256(O_PU + SZ_PU), SZ_Z = (size_t)TT * 512 * 2;
constexpr size_t O_Y2 = O_MRG, SZ_Y2 = (size_t)TT * 2 * 1024 * 2;
constexpr size_t WS_END = al256(O_Z + SZ_Z);
static_assert(SZ_T2 <= SZ_ACT, "T2 overlay");
static_assert(O_Y2 + SZ_Y2 <= WS_END, "y2 overlay");

constexpr int CW_TMO = 0;
constexpr int CW_BAR = 4096;
constexpr int CW_KF = 65536;
constexpr int CW_FA = 3072;
constexpr int CW_G2 = 40960;
constexpr int CW_RDY = 32768;
constexpr int CW_Q = 2048;
constexpr int CW_DONE = 2560;
constexpr int CW_CNT = 16384;

constexpr int RING_BYTES = 131072;
constexpr int LDSCTL_OFF = RING_BYTES, MISC_OFF = LDSCTL_OFF + 320;
constexpr int TRIG_OFF = LDSCTL_OFF + 1024;
constexpr int TILE_OFF = LDSCTL_OFF + 2048;
constexpr int LDS_BYTES = 147456;

#define RLX_AGENT __ATOMIC_RELAXED, __HIP_MEMORY_SCOPE_AGENT
#define LDS_WAIT() asm volatile("s_waitcnt lgkmcnt(0)" ::: "memory")
#define VM_WAIT() asm volatile("s_waitcnt vmcnt(0)" ::: "memory")

__device__ __forceinline__ unsigned f2bf(float f) { unsigned u = __builtin_bit_cast(unsigned, f); return (u + 0x7fffu + ((u >> 16) & 1u)) >> 16; }
__device__ __forceinline__ unsigned pk2(float lo, float hi) { return f2bf(lo) | (f2bf(hi) << 16); }
__device__ __forceinline__ float bflo(unsigned w) { return __builtin_bit_cast(float, w << 16); }
__device__ __forceinline__ float bfhi(unsigned w) { return __builtin_bit_cast(float, w & 0xffff0000u); }
__device__ __forceinline__ float bf2f(bf16 h) { return __builtin_bit_cast(float, (unsigned)h << 16); }
template <int CTRL, int RM> __device__ __forceinline__ float dppf(float v) { return __builtin_bit_cast(float, __builtin_amdgcn_update_dpp(0, __builtin_bit_cast(int, v), CTRL, RM, 0xf, true)); }
__device__ __forceinline__ float wave_sum(float v) {
    v += dppf<0x111, 0xf>(v); v += dppf<0x112, 0xf>(v); v += dppf<0x114, 0xf>(v); v += dppf<0x118, 0xf>(v);
    v += dppf<0x142, 0xa>(v); v += dppf<0x143, 0xc>(v);
    return __builtin_bit_cast(float, __builtin_amdgcn_readlane(__builtin_bit_cast(int, v), 63));
}

__device__ __forceinline__ float swap32_sum(float x, float y) {
    const auto rr = __builtin_amdgcn_permlane32_swap(__builtin_bit_cast(unsigned, x), __builtin_bit_cast(unsigned, y), false, false);
    unsigned r0 = rr[0], r1 = rr[1]; asm volatile("" : "+v"(r0), "+v"(r1));
    return __builtin_bit_cast(float, r0) + __builtin_bit_cast(float, r1);
}
__device__ __forceinline__ float swap16_sum(float x, float y) {
    const auto rr = __builtin_amdgcn_permlane16_swap(__builtin_bit_cast(unsigned, x), __builtin_bit_cast(unsigned, y), false, false);
    unsigned r0 = rr[0], r1 = rr[1]; asm volatile("" : "+v"(r0), "+v"(r1));
    return __builtin_bit_cast(float, r0) + __builtin_bit_cast(float, r1);
}

#define XB_TMO      128
#define XB_XCNT(j)  (256  + 64 * (j))
#define XB_XSUB(j)  (1280 + 64 * (j))
#define XB_XGEN(j)  (2304 + 64 * (j))
#define XB_TOP      3328
#define XB_TOPGEN   3392
#define XCD_BAR_WORDS 3456
#define XB_SPIN_CAP (1u << 18)
__device__ __forceinline__ unsigned xb_ld(unsigned* p)              { return __hip_atomic_load(p, __ATOMIC_RELAXED, __HIP_MEMORY_SCOPE_AGENT); }
__device__ __forceinline__ unsigned xb_add(unsigned* p, unsigned v) { return __hip_atomic_fetch_add(p, v, __ATOMIC_RELAXED, __HIP_MEMORY_SCOPE_AGENT); }
__device__ __forceinline__ unsigned xb_xcc_id() { return (unsigned)__builtin_amdgcn_s_getreg((3 << 11) | 20) & 0xFu; }
#define XB_SPIN(cond, bar) do { unsigned _sp = 0; while (cond) { __builtin_amdgcn_s_sleep(1); \
    if ((++_sp & 255u) == 0u) { if (xb_ld(&(bar)[XB_TMO])) break; if (_sp > XB_SPIN_CAP) { atomicAdd(&(bar)[XB_TMO], 1u); break; } } } } while (0)
struct XcdBarrier { unsigned* bar; unsigned x; volatile LAS unsigned* st; };
__device__ __forceinline__ XcdBarrier xcd_barrier_post(unsigned* bar, volatile LAS unsigned* st) {
    XcdBarrier b; b.bar = bar; b.x = xb_xcc_id(); b.st = st;
    if (threadIdx.x == 0) (void)xb_add(&bar[XB_XCNT(b.x)], 1u);
    return b;
}
__device__ __forceinline__ void xcd_barrier_complete(unsigned* bar, unsigned x, unsigned& nloc, unsigned& nx) {
    const unsigned G = gridDim.x * gridDim.y * gridDim.z;
    unsigned sum, cnt, mine, sp = 0u;
    for (;;) {
        sum = 0u; cnt = 0u; mine = 0u;
#pragma unroll
        for (unsigned j = 0; j < 16; ++j) { const unsigned c = xb_ld(&bar[XB_XCNT(j)]); sum += c; cnt += (c > 0u) ? 1u : 0u; mine = (j == x) ? c : mine; }
        if (sum == G) break;
        __builtin_amdgcn_s_sleep(1);
        if ((++sp & 255u) == 0u) { if (xb_ld(&bar[XB_TMO])) break; if (sp > XB_SPIN_CAP) { atomicAdd(&bar[XB_TMO], 1u); break; } }
    }
    nloc = mine > 0u ? mine : 1u; nx = cnt > 0u ? cnt : 1u;
}
__device__ __forceinline__ void xcd_barrier(const XcdBarrier& b) {
    asm volatile("s_waitcnt vmcnt(0)" ::: "memory");
    __syncthreads();
    if (threadIdx.x == 0) {
        unsigned* bar = b.bar;
        __builtin_amdgcn_s_waitcnt(0);
        unsigned nloc = b.st[0], nx = b.st[1];
        if (nloc == 0u) { xcd_barrier_complete(bar, b.x, nloc, nx); b.st[0] = nloc; b.st[1] = nx; }
        const unsigned old = xb_add(&bar[XB_XSUB(b.x)], 1u);
        const unsigned gen = old / nloc;
        if (old + 1u == (gen + 1u) * nloc) {
            __builtin_amdgcn_fence(__ATOMIC_RELEASE, "agent");
            asm volatile("s_waitcnt vmcnt(0)" ::: "memory");
            const unsigned og = xb_add(&bar[XB_TOP], 1u);
            const unsigned tg = og / nx;
            if (og + 1u == (tg + 1u) * nx) xb_add(&bar[XB_TOPGEN], 1u);
            else XB_SPIN(xb_ld(&bar[XB_TOPGEN]) == tg, bar);
            __builtin_amdgcn_fence(__ATOMIC_ACQUIRE, "agent");
            xb_add(&bar[XB_XGEN(b.x)], 1u);
            asm volatile("s_waitcnt vmcnt(0)" ::: "memory");
        } else {
            XB_SPIN(xb_ld(&bar[XB_XGEN(b.x)]) == gen, bar);
            __builtin_amdgcn_fence(__ATOMIC_ACQUIRE, "agent");
            asm volatile("s_waitcnt vmcnt(0)" ::: "memory");
        }
    }
    __syncthreads();
}

namespace pg8 {
constexpr int BM = 256, BK = 64, HALF = 128, HTB = HALF * BK * 2;
__host__ __device__ __forceinline__ int lds_byte(int r, int c) { const int st = (r >> 4) * 2 + (c >> 5), rr = r & 15, cc = c & 31, ob = rr * 64 + cc * 2; return st * 1024 + (ob ^ (((ob >> 9) & 1) << 5)); }
__host__ __device__ __forceinline__ void stage_rc(int b, int& R, int& C) { const int st = b / 1024, sb = b % 1024, swz = sb ^ (((sb >> 9) & 1) << 5); R = (st >> 1) * 16 + swz / 64; C = (st & 1) * 32 + (swz % 64) / 2; }
__host__ __device__ __forceinline__ int perm32(int rho) { const int n = rho >> 4, i = rho & 15; return 8 * (i >> 2) + 4 * n + (i & 3); }

struct Unit { int pm, pn, e, cnt, kind; };

template <class Epi, class Sched>
__device__ __forceinline__ void gemm_phase(LAS unsigned char* lds, const Sched& S, const Epi& E) {
    int tid = threadIdx.x; asm volatile("" : "+v"(tid));
    const int wid = __builtin_amdgcn_readfirstlane(tid >> 6), lane = tid & 63, wr = wid >> 2, wc = wid & 3, fr = lane & 15, fq = lane >> 4;
    int RA[2], CA[2], RB[2];
#pragma unroll
    for (int i = 0; i < 2; ++i) { int R, C; stage_rc(tid * 16 + i * 8192, R, C); RA[i] = R; CA[i] = C; RB[i] = Epi::PERM ? ((R & ~31) + perm32(R & 31)) : R; }
    const size_t kstep = (size_t)(BK * 2);
    const unsigned ldsw = (unsigned)wid * 1024u;
    const int aoff = lds_byte(wr * 64 + fr, fq * 8), boff = lds_byte(wc * 32 + fr, fq * 8);
#define PG8_SA(b, h) (((b) * 2 + (h)) * HTB)
#define PG8_SB(b, h) ((4 + (b) * 2 + (h)) * HTB)
#define PG8_STAGE2(bufoff, gbase, o0, o1) do { \
        __builtin_amdgcn_global_load_lds((const unsigned*)((const char*)(gbase) + (o0)), (LAS unsigned*)(lds + (bufoff) + ldsw), 16, 0, 0); \
        __builtin_amdgcn_global_load_lds((const unsigned*)((const char*)(gbase) + (o1)), (LAS unsigned*)(lds + (bufoff) + ldsw + 8192), 16, 0, 0); } while (0)
#define PG8_LDA(dst, b, h) do { _Pragma("unroll") for (int m = 0; m < 4; ++m) _Pragma("unroll") for (int k = 0; k < 2; ++k) dst[m][k] = *(const LAS bf16x8*)(lds + PG8_SA(b, h) + aoff + m * 2048 + k * 1024); } while (0)
#define PG8_LDB(dst, b, h) do { _Pragma("unroll") for (int n = 0; n < 2; ++n) _Pragma("unroll") for (int k = 0; k < 2; ++k) dst[n][k] = *(const LAS bf16x8*)(lds + PG8_SB(b, h) + boff + n * 2048 + k * 1024); } while (0)
#define PG8_MMA(ai, bj, At, Bt) do { __builtin_amdgcn_s_setprio(1); _Pragma("unroll") for (int m = 0; m < 4; ++m) _Pragma("unroll") for (int n = 0; n < 2; ++n) _Pragma("unroll") for (int k = 0; k < 2; ++k) \
        acc[ai][bj][m][n] = __builtin_amdgcn_mfma_f32_16x16x32_bf16(Bt[n][k], At[m][k], acc[ai][bj][m][n], 0, 0, 0); __builtin_amdgcn_s_setprio(0); } while (0)
#define PG8_WAIT_V(n) asm volatile("s_waitcnt vmcnt(" #n ")" ::: "memory")
#define PG8_WAIT_L(n) asm volatile("s_waitcnt lgkmcnt(" #n ")" ::: "memory")
#define PG8_BAR __builtin_amdgcn_s_barrier()
#define PG8_SCHED __builtin_amdgcn_sched_barrier(0)
    Unit cur, nxt; int ui = 0;
    if (!S.next(0, cur)) return;
    f32x4 acc[2][2][4][2];
#pragma unroll
    for (int a = 0; a < 2; ++a)
#pragma unroll
        for (int b = 0; b < 2; ++b)
#pragma unroll
            for (int m = 0; m < 4; ++m)
#pragma unroll
                for (int n = 0; n < 2; ++n) acc[a][b][m][n] = (f32x4){0.f, 0.f, 0.f, 0.f};
    bf16x8 At[4][2], B0[2][2], B1[2][2];
    int Kc = S.K(cur), Kn; const char* Ac = S.a_base(cur); const char* An; const char* cB = S.b_ptr(cur); const char* nB;
    unsigned oc00, oc01, oc10, oc11, on00, on01, on10, on11, vbc0, vbc1, vbn0, vbn1; size_t hsc, hsn;
    oc00 = S.a_off(cur, RA[0], CA[0]); oc01 = S.a_off(cur, RA[1], CA[1]); oc10 = S.a_off(cur, HALF + RA[0], CA[0]); oc11 = S.a_off(cur, HALF + RA[1], CA[1]);
    vbc0 = (unsigned)(RB[0] * Kc + CA[0]) * 2u; vbc1 = (unsigned)(RB[1] * Kc + CA[1]) * 2u; hsc = (size_t)HALF * Kc * 2;
    S.a_ready(cur);
    PG8_STAGE2(PG8_SB(0, 0), cB, vbc0, vbc1); PG8_STAGE2(PG8_SB(0, 1), cB + hsc, vbc0, vbc1); PG8_STAGE2(PG8_SA(0, 0), Ac, oc00, oc01); PG8_STAGE2(PG8_SA(0, 1), Ac, oc10, oc11);
    if (wr == 1) PG8_BAR;
    PG8_WAIT_V(2); PG8_BAR;
    PG8_STAGE2(PG8_SB(1, 0), cB + kstep, vbc0, vbc1); PG8_STAGE2(PG8_SA(1, 0), Ac + kstep, oc00, oc01); PG8_STAGE2(PG8_SB(1, 1), cB + hsc + kstep, vbc0, vbc1);
    PG8_WAIT_V(6); PG8_BAR;
    for (;;) {
        const bool has_next = S.next(ui + 1, nxt);
        Kn = Kc; An = Ac; nB = cB; on00 = oc00; on01 = oc01; on10 = oc10; on11 = oc11; vbn0 = vbc0; vbn1 = vbc1; hsn = hsc;
        if (has_next) { Kn = S.K(nxt); An = S.a_base(nxt); nB = S.b_ptr(nxt);
            on00 = S.a_off(nxt, RA[0], CA[0]); on01 = S.a_off(nxt, RA[1], CA[1]); on10 = S.a_off(nxt, HALF + RA[0], CA[0]); on11 = S.a_off(nxt, HALF + RA[1], CA[1]);
            vbn0 = (unsigned)(RB[0] * Kn + CA[0]) * 2u; vbn1 = (unsigned)(RB[1] * Kn + CA[1]) * 2u; hsn = (size_t)HALF * Kn * 2; }
        const int nt = Kc / BK;
        for (int t = 0; t < nt; t += 2) {
            const bool last = (t == nt - 2);
            if (last && has_next) S.a_ready(nxt);
            const char* a1 = Ac + (size_t)(t + 1) * kstep;
            const char* a2 = last ? An : Ac + (size_t)(t + 2) * kstep; const char* b2 = last ? nB : cB + (size_t)(t + 2) * kstep;
            const char* a3 = a2 + kstep; const char* b3 = b2 + kstep;
            const unsigned x00 = last ? on00 : oc00, x01 = last ? on01 : oc01, x10 = last ? on10 : oc10, x11 = last ? on11 : oc11;
            const unsigned y0 = last ? vbn0 : vbc0, y1 = last ? vbn1 : vbc1; const size_t hs2 = last ? hsn : hsc;
            PG8_LDB(B0, 0, 0); PG8_LDB(B1, 0, 1); PG8_SCHED; PG8_LDA(At, 0, 0); PG8_STAGE2(PG8_SA(1, 1), a1, oc10, oc11);
            PG8_WAIT_V(8); PG8_WAIT_L(0); PG8_BAR; PG8_MMA(0, 0, At, B0); PG8_MMA(0, 1, At, B1); PG8_BAR; PG8_SCHED;
            PG8_LDA(At, 0, 1); PG8_STAGE2(PG8_SB(0, 0), b2, y0, y1); PG8_STAGE2(PG8_SB(0, 1), b2 + hs2, y0, y1); PG8_STAGE2(PG8_SA(0, 0), a2, x00, x01);
            PG8_WAIT_V(8); PG8_WAIT_L(0); PG8_BAR; PG8_MMA(1, 0, At, B0); PG8_MMA(1, 1, At, B1); PG8_BAR; PG8_SCHED;
            PG8_LDB(B0, 1, 0); PG8_LDB(B1, 1, 1); PG8_SCHED; PG8_LDA(At, 1, 0); PG8_STAGE2(PG8_SA(0, 1), a2, x10, x11);
            PG8_WAIT_V(8); PG8_WAIT_L(0); PG8_BAR; PG8_MMA(0, 0, At, B0); PG8_MMA(0, 1, At, B1); PG8_BAR; PG8_SCHED;
            PG8_LDA(At, 1, 1); PG8_STAGE2(PG8_SB(1, 0), b3, y0, y1); PG8_STAGE2(PG8_SB(1, 1), b3 + hs2, y0, y1); PG8_STAGE2(PG8_SA(1, 0), a3, x00, x01);
            PG8_WAIT_V(8); PG8_WAIT_L(0); PG8_BAR; PG8_MMA(1, 0, At, B0); PG8_MMA(1, 1, At, B1); PG8_BAR; PG8_SCHED;
        }
        if (wr == 0) PG8_BAR;
        E(acc, cur, wr, wc, fr, fq);
        if (!has_next) break;
#pragma unroll
        for (int a = 0; a < 2; ++a)
#pragma unroll
            for (int b = 0; b < 2; ++b)
#pragma unroll
                for (int m = 0; m < 4; ++m)
#pragma unroll
                    for (int n = 0; n < 2; ++n) acc[a][b][m][n] = (f32x4){0.f, 0.f, 0.f, 0.f};
        cur = nxt; Kc = Kn; Ac = An; cB = nB; oc00 = on00; oc01 = on01; oc10 = on10; oc11 = on11; vbc0 = vbn0; vbc1 = vbn1; hsc = hsn; ++ui;
        if (wr == 1) PG8_BAR;
    }
    PG8_WAIT_V(0);
    PG8_BAR;
#undef PG8_SA
#undef PG8_SB
#undef PG8_STAGE2
#undef PG8_LDA
#undef PG8_LDB
#undef PG8_MMA
#undef PG8_WAIT_V
#undef PG8_WAIT_L
#undef PG8_BAR
#undef PG8_SCHED
}
}

__device__ __forceinline__ void store16_wt(void* p, v4u v) { asm volatile("global_store_dwordx4 %0, %1, off sc1\n\ts_nop 1" :: "v"(p), "v"(v) : "memory"); }
__device__ __forceinline__ int krow_of(int r) {
    if (r < T) return (r >> 12) * KVROWS + LCTX + (r & 4095);
    const int rc = r - T; return (rc >> 8) * KVROWS + (rc & 255);
}
struct SchedPlain {
    int nM, nN, G, vcu, Kk; const char* A; const char* B;
    __device__ __forceinline__ bool next(int i, pg8::Unit& u) const { const int L = i * G + vcu; if (L >= nM * nN) return false; u.pm = L / nN; u.pn = L % nN; u.e = 0; u.cnt = 256; u.kind = 0; return true; }
    __device__ __forceinline__ int K(const pg8::Unit&) const { return Kk; }
    __device__ __forceinline__ const char* a_base(const pg8::Unit&) const { return A; }
    __device__ __forceinline__ unsigned a_off(const pg8::Unit& u, int row, int col) const { return (unsigned)((u.pm * 256 + row) * Kk + col) * 2u; }
    __device__ __forceinline__ const char* b_ptr(const pg8::Unit& u) const { return B + (size_t)u.pn * 256 * Kk * 2; }
    __device__ __forceinline__ void a_ready(const pg8::Unit&) const {}
};
struct EpiG1 {
    static constexpr bool PERM = true;
    bf16 *pu, *q, *kall, *vall, *z;
    __device__ __forceinline__ void operator()(const f32x4 (&acc)[2][2][4][2], const pg8::Unit& u, int wr, int wc, int fr, int fq) const {
        const int row0 = u.pm * 256 + wr * 64 + fr, c8 = wc * 32 + 8 * fq;
#pragma unroll
        for (int ai = 0; ai < 2; ++ai)
#pragma unroll
            for (int m = 0; m < 4; ++m) {
                const int row = row0 + ai * 128 + m * 16;
#pragma unroll
                for (int bj = 0; bj < 2; ++bj) {
                    const f32x4 v0 = acc[ai][bj][m][0], v1 = acc[ai][bj][m][1];
                    v4u w; w.x = pk2(v0[0], v0[1]); w.y = pk2(v0[2], v0[3]); w.z = pk2(v1[0], v1[1]); w.w = pk2(v1[2], v1[3]);
                    bf16* dst;
                    if (u.pn == 0) dst = pu + (size_t)row * 256 + bj * 128 + c8;
                    else if (u.pn <= 2) dst = q + (size_t)row * 512 + (u.pn - 1) * 256 + bj * 128 + c8;
                    else if (u.pn == 3) dst = (bj == 0 ? kall : vall) + (size_t)krow_of(row) * 128 + c8;
                    else dst = z + (size_t)row * 512 + (u.pn - 4) * 256 + bj * 128 + c8;
                    *(v4u*)dst = w;
                }
            }
    }
};
struct EpiG2 {
    static constexpr bool PERM = false;
    const float* xin; const float* cin; float* xout; float* cout; const float* mod; unsigned* ready;
    __device__ __forceinline__ void operator()(const f32x4 (&acc)[2][2][4][2], const pg8::Unit& u, int wr, int wc, int fr, int fq) const {
        const int rt0 = u.pm * 256; const bool isc = rt0 >= T;
        const int bsel = isc ? 4 : (rt0 >> 12);
        const float* g1 = mod + bsel * 6144 + 2048;
        const float* base = isc ? cin - (size_t)T * 1024 : xin; float* out = isc ? cout - (size_t)T * 1024 : xout;
        const int row0 = rt0 + wr * 64 + fr, col0 = u.pn * 256 + wc * 32 + 4 * fq;
#pragma unroll
        for (int bj = 0; bj < 2; ++bj)
#pragma unroll
            for (int n = 0; n < 2; ++n) {
                const int col = col0 + bj * 128 + n * 16; const f32x4 gv = *(const f32x4*)(g1 + col);
#pragma unroll
                for (int ai = 0; ai < 2; ++ai)
#pragma unroll
                    for (int m = 0; m < 4; ++m) { const size_t off = (size_t)(row0 + ai * 128 + m * 16) * 1024 + col; const f32x4 bs = *(const f32x4*)(base + off); const f32x4 o = bs + gv * acc[ai][bj][m][n]; store16_wt(out + off, __builtin_bit_cast(v4u, o)); }
            }
        asm volatile("s_waitcnt vmcnt(0)" ::: "memory");
        if ((threadIdx.x & 63) == 0) __hip_atomic_fetch_add(ready + 16 * u.pm, 1u, __ATOMIC_RELAXED, __HIP_MEMORY_SCOPE_AGENT);
    }
};
struct SchedMoe {
    int G, vcu, ntile;
    const char* hb; const char* actb; const char* wgu; const char* wd; const unsigned* list; const LAS int* tt; unsigned* ready; unsigned* tmo;
    __device__ __forceinline__ bool next(int i, pg8::Unit& u) const {
        const int U = ntile * 4; const int r = U % G, q = U / G; const int n3 = q + (vcu < r ? 1 : 0); int L;
        if (i < n3) { L = i * G + vcu; u.kind = 0; }
        else { const int j = i - n3; const int nl = G - r;
            if (vcu >= r) L = (j == 0) ? (vcu - r) : (j == 1) ? nl + (vcu - r) : 2 * nl + (j - 2) * G + vcu;
            else L = 2 * nl + j * G + vcu;
            if (L >= U) return false; u.kind = 1; }
        const int tau = L >> 2; u.pn = L & 3; u.pm = tau; int e = 0;
#pragma unroll
        for (int k = 1; k < 16; ++k) e += (tt[k] <= tau) ? 1 : 0;
        u.e = e; const int r0 = (tau - tt[e]) * 256; const int c = tt[17 + e] - r0; u.cnt = c < 256 ? c : 256; return true;
    }
    __device__ __forceinline__ int K(const pg8::Unit& u) const { return u.kind ? 512 : 1024; }
    __device__ __forceinline__ const char* a_base(const pg8::Unit& u) const { return u.kind ? actb : hb; }
    __device__ __forceinline__ unsigned a_off(const pg8::Unit& u, int row, int col) const {
        if (u.kind) return (unsigned)((u.pm * 256 + row) * 512 + col) * 2u;
        const int r0 = (u.pm - tt[u.e]) * 256; unsigned tok = 0;
        if (row < u.cnt) tok = list[(size_t)u.e * TT + r0 + row] >> 1;
        return (tok * 1024u + (unsigned)col) * 2u;
    }
    __device__ __forceinline__ const char* b_ptr(const pg8::Unit& u) const { return u.kind ? wd + ((size_t)u.e * 1024 + (size_t)u.pn * 256) * 512 * 2 : wgu + ((size_t)u.e * 1024 + (size_t)u.pn * 256) * 1024 * 2; }
    __device__ __forceinline__ void a_ready(const pg8::Unit& u) const {
        if (!u.kind) return;
        if (threadIdx.x < 64) {
            unsigned* w = ready + 16 * u.pm; unsigned sp = 0;
            while ((unsigned)__builtin_amdgcn_readfirstlane(__hip_atomic_load(w, __ATOMIC_RELAXED, __HIP_MEMORY_SCOPE_AGENT)) < 32u) {
                __builtin_amdgcn_s_sleep(2);
                if (++sp > (1u << 22)) { if (threadIdx.x == 0) __hip_atomic_store(tmo, 1u, __ATOMIC_RELAXED, __HIP_MEMORY_SCOPE_AGENT); break; } }
            __builtin_amdgcn_fence(__ATOMIC_ACQUIRE, "agent");
            asm volatile("s_waitcnt vmcnt(0)" ::: "memory");
        }
        asm volatile("" ::: "memory"); __builtin_amdgcn_s_barrier(); asm volatile("" ::: "memory");
    }
};
struct EpiG3 {
    static constexpr bool PERM = true;
    bf16* act; unsigned* ready;
    __device__ __forceinline__ void operator()(const f32x4 (&acc)[2][2][4][2], const pg8::Unit& u, int wr, int wc, int fr, int fq) const {
        const int row0 = u.pm * 256 + wr * 64 + fr, c8 = u.pn * 128 + wc * 32 + 8 * fq;
#pragma unroll
        for (int ai = 0; ai < 2; ++ai)
#pragma unroll
            for (int m = 0; m < 4; ++m) {
                float a[8];
#pragma unroll
                for (int n = 0; n < 2; ++n)
#pragma unroll
                    for (int k = 0; k < 4; ++k) { const float g = acc[ai][0][m][n][k], up = acc[ai][1][m][n][k]; a[n * 4 + k] = g / (1.f + __expf(-g)) * up; }
                v4u w; w.x = pk2(a[0], a[1]); w.y = pk2(a[2], a[3]); w.z = pk2(a[4], a[5]); w.w = pk2(a[6], a[7]);
                store16_wt(act + (size_t)(row0 + ai * 128 + m * 16) * 512 + c8, w);
            }
        asm volatile("s_waitcnt vmcnt(0)" ::: "memory");
        if ((threadIdx.x & 63) == 0) __hip_atomic_fetch_add(ready + 16 * u.pm, 1u, __ATOMIC_RELAXED, __HIP_MEMORY_SCOPE_AGENT);
    }
};
struct EpiG4 {
    static constexpr bool PERM = true;
    bf16* y2; const unsigned* list; const float* wts; const LAS int* tt;
    __device__ __forceinline__ void operator()(const f32x4 (&acc)[2][2][4][2], const pg8::Unit& u, int wr, int wc, int fr, int fq) const {
        const int r0 = (u.pm - tt[u.e]) * 256; const int c8 = u.pn * 256 + wc * 32 + 8 * fq;
#pragma unroll
        for (int ai = 0; ai < 2; ++ai)
#pragma unroll
            for (int m = 0; m < 4; ++m) {
                const int row = wr * 64 + fr + ai * 128 + m * 16;
                if (row < u.cnt) {
                    const unsigned ent = list[(size_t)u.e * TT + r0 + row]; const float w = wts[ent];
#pragma unroll
                    for (int bj = 0; bj < 2; ++bj) {
                        const f32x4 v0 = acc[ai][bj][m][0] * w, v1 = acc[ai][bj][m][1] * w;
                        v4u o; o.x = pk2(v0[0], v0[1]); o.y = pk2(v0[2], v0[3]); o.z = pk2(v1[0], v1[1]); o.w = pk2(v1[2], v1[3]);
                        *(v4u*)(y2 + (size_t)ent * 1024 + bj * 128 + c8) = o;
                    }
                }
            }
    }
};

struct EpiMoe { static constexpr bool PERM = true; EpiG3 e3; EpiG4 e4;
    __device__ __forceinline__ void operator()(const f32x4 (&acc)[2][2][4][2], const pg8::Unit& u, int wr, int wc, int fr, int fq) const { if (u.kind) e4(acc, u, wr, wc, fr, fq); else e3(acc, u, wr, wc, fr, fq); } };

#include <hip/hip_bf16.h>
#include <cmath>
namespace attn_body {
using bf16=__hip_bfloat16;
using bf16x8=__attribute__((ext_vector_type(8)))short;
using s16x4=__attribute__((ext_vector_type(4)))short;
using f32x16=__attribute__((ext_vector_type(16)))float;
using u32x4=__attribute__((ext_vector_type(4)))unsigned;
constexpr int D=64,QP=512,KVP=128,OP=1024;
constexpr int NW=8,QBLK=32,KVBLK=64;
__device__ __forceinline__ int crow(int r,int hi){return (r&3)+8*(r>>2)+4*hi;}
#define SBAR() __builtin_amdgcn_sched_barrier(0)
__device__ __forceinline__ void wmask(f32x16&p0,f32x16&p1,int kp0,int qpos,int hi){
  const float NEG=-INFINITY; const bool tile_ok=(unsigned)kp0<4096u; const int base=kp0+4*hi-qpos+128;
  #pragma unroll
  for(int r=0;r<16;++r){const int dd=base+(r&3)+8*(r>>2); if(!tile_ok||(unsigned)dd>256u)p0[r]=NEG; if(!tile_ok||(unsigned)(dd+32)>256u)p1[r]=NEG;}
}
constexpr int NSLOT=3, SLOTB=8192;
constexpr int LDS_K=0, LDS_V=NSLOT*SLOTB, LDS_WS=2*NSLOT*SLOTB, LDS_OST=LDS_WS+NW*64*4, LDS_BYTES=LDS_OST+NW*4096;
constexpr float C2=0.125f*1.4426950408889634f;
__device__ __forceinline__ void glds16(const void*gsrc,unsigned lds_dst){unsigned keep;
  asm volatile("s_mov_b32 %0, m0\n\ts_mov_b32 m0, %2\n\ts_nop 0\n\tglobal_load_lds_dwordx4 %1, off\n\ts_mov_b32 m0, %0":"=&s"(keep):"v"(gsrc),"s"(lds_dst):"memory");}
__device__ __forceinline__ float max3f(float a,float b,float c){float r;asm("v_max3_f32 %0, %1, %2, %3":"=v"(r):"v"(a),"v"(b),"v"(c));return r;}
__device__ __forceinline__ float max2f(float a,float b){float r;asm("v_max_f32_e32 %0, %1, %2":"=v"(r):"v"(a),"v"(b));return r;}
__device__ __forceinline__ float fadd_s(float a,float b){float r;asm("v_add_f32_e32 %0, %1, %2":"=v"(r):"v"(a),"v"(b));return r;}
__device__ __forceinline__ float fsub_s(float a,float b){float r;asm("v_sub_f32_e32 %0, %1, %2":"=v"(r):"v"(a),"v"(b));return r;}
typedef float f32x2_t __attribute__((ext_vector_type(2))); typedef __bf16 bf16x2_t __attribute__((ext_vector_type(2)));
__device__ __forceinline__ unsigned cvtpk_s(float lo,float hi){f32x2_t v={lo,hi};bf16x2_t b=__builtin_convertvector(v,bf16x2_t);return __builtin_bit_cast(unsigned,b);}
#define WAIT_BAR(N) asm volatile("s_waitcnt vmcnt(" #N ") lgkmcnt(0)\n\ts_barrier":::"memory")

__device__ __forceinline__ void qkt(f32x16&p0,f32x16&p1,const char*Kslot,const bf16x8*qr,const f32x16&negm,int r32,int hi){
  const char*kb=Kslot+hi*1024+r32*16;
  #pragma unroll
  for(int d0=0;d0<4;++d0){
    const bf16x8 b0=*reinterpret_cast<const bf16x8*>(kb+d0*2048);
    const bf16x8 b1=*reinterpret_cast<const bf16x8*>(kb+d0*2048+512);
    if(d0==0){p0=__builtin_amdgcn_mfma_f32_32x32x16_bf16(b0,qr[0],negm,0,0,0);p1=__builtin_amdgcn_mfma_f32_32x32x16_bf16(b1,qr[0],negm,0,0,0);}
    else{p0=__builtin_amdgcn_mfma_f32_32x32x16_bf16(b0,qr[d0],p0,0,0,0);p1=__builtin_amdgcn_mfma_f32_32x32x16_bf16(b1,qr[d0],p1,0,0,0);}}
}
typedef __attribute__((address_space(3))) const char* lds_cptr;
typedef short v4i16_t __attribute__((ext_vector_type(4)));
__device__ __forceinline__ void kload8(bf16x8*kf,lds_cptr kp){
  kf[0]=*(const __attribute__((address_space(3))) bf16x8*)(kp);      kf[1]=*(const __attribute__((address_space(3))) bf16x8*)(kp+512);
  kf[2]=*(const __attribute__((address_space(3))) bf16x8*)(kp+2048); kf[3]=*(const __attribute__((address_space(3))) bf16x8*)(kp+2560);
  kf[4]=*(const __attribute__((address_space(3))) bf16x8*)(kp+4096); kf[5]=*(const __attribute__((address_space(3))) bf16x8*)(kp+4608);
  kf[6]=*(const __attribute__((address_space(3))) bf16x8*)(kp+6144); kf[7]=*(const __attribute__((address_space(3))) bf16x8*)(kp+6656);
}
__device__ __forceinline__ void kload2(bf16x8*kf,lds_cptr kp,int j){ kf[2*j]=*(const __attribute__((address_space(3))) bf16x8*)(kp+j*2048); kf[2*j+1]=*(const __attribute__((address_space(3))) bf16x8*)(kp+j*2048+512); }
__device__ __forceinline__ s16x4 vtr(lds_cptr p){ return __builtin_bit_cast(s16x4,__builtin_amdgcn_ds_read_tr16_b64_v4i16((__attribute__((address_space(3))) v4i16_t*)p)); }
__device__ __forceinline__ float rowmax(const f32x16&p0,const f32x16&p1){
  float a=max3f(p0[0],p0[1],p1[0]),b=max3f(p0[2],p0[3],p1[1]);a=max3f(a,p1[2],p1[3]);
  #pragma unroll
  for(int r=4;r<16;r+=4){a=max3f(a,p0[r],p0[r+1]);b=max3f(b,p0[r+2],p0[r+3]);a=max3f(a,p1[r],p1[r+1]);b=max3f(b,p1[r+2],p1[r+3]);}
  const float m=max2f(a,b);
  auto rr=__builtin_amdgcn_permlane32_swap(__float_as_uint(m),__float_as_uint(m),false,false);
  return max2f(__uint_as_float(rr[0]),__uint_as_float(rr[1]));
}
__device__ __forceinline__ void pv(f32x16*o,int vb,bf16x8 pa0,bf16x8 pa1,bf16x8 pa2,bf16x8 pa3){
  #pragma unroll
  for(int d0=0;d0<2;++d0){s16x4 lo[4],hi[4];
    #pragma unroll
    for(int ks=0;ks<4;++ks){
      asm volatile("ds_read_b64_tr_b16 %0,%1 offset:%c2":"=&v"(lo[ks]):"v"(vb),"i"(d0*4096+ks*1024):"memory");
      asm volatile("ds_read_b64_tr_b16 %0,%1 offset:%c2":"=&v"(hi[ks]):"v"(vb),"i"(d0*4096+ks*1024+512):"memory");}
    asm volatile("s_waitcnt lgkmcnt(0)":::"memory");SBAR();
    #define PK(k) (bf16x8){lo[k][0],lo[k][1],lo[k][2],lo[k][3],hi[k][0],hi[k][1],hi[k][2],hi[k][3]}
    o[d0]=__builtin_amdgcn_mfma_f32_32x32x16_bf16(pa0,PK(0),o[d0],0,0,0);
    o[d0]=__builtin_amdgcn_mfma_f32_32x32x16_bf16(pa1,PK(1),o[d0],0,0,0);
    o[d0]=__builtin_amdgcn_mfma_f32_32x32x16_bf16(pa2,PK(2),o[d0],0,0,0);
    o[d0]=__builtin_amdgcn_mfma_f32_32x32x16_bf16(pa3,PK(3),o[d0],0,0,0);
    #undef PK
  }
}

#ifndef ATTN_STORE16
#define ATTN_STORE16(p,v) (*(u32x4*)(p)=(v))
#endif
template<int THRL> __device__ __forceinline__ void attn_unit(const bf16*Qu,const bf16*__restrict__ Kh,const bf16*__restrict__ Vh,bf16*Ou,const int p0,const int NT,const float* sinkp,const float* qg,const float2* ropet,char*shm){
  int tid=threadIdx.x; asm volatile("":"+v"(tid)); const int lane=tid&63,r32=lane&31,hi=lane>>5; const int wid=__builtin_amdgcn_readfirstlane(tid>>6);
  const int hsub=wid>>1, psub=(wid&1)*QBLK;
  const bf16*Qw=Qu+(long)psub*QP+hsub*D;
  const unsigned lds0=(unsigned)(uintptr_t)shm;
  float*wsf=(float*)(shm+LDS_WS)+wid*64;
  const bf16*ksrc=Kh+(long)lane*KVP+wid*8;
  const bf16*vsrc=Vh+(long)(16*(wid&3)+(lane>>2))*KVP+(wid>>2)*32+(lane&3)*8;
  const unsigned kdst=lds0+LDS_K+wid*1024, vdst=lds0+LDS_V+wid*1024;
  #define KP0(t) (p0-128+64*((t)-4))
  #define TROW(t) ((t)<4?64*(t):(((unsigned)KP0(t)<4096u)?256+KP0(t):256))
  #define DMA_K(t,slot) glds16(ksrc+(long)TROW(t)*KVP,(unsigned)__builtin_amdgcn_readfirstlane(kdst+(slot)))
  #define DMA_V(t,slot) glds16(vsrc+(long)TROW(t)*KVP,(unsigned)__builtin_amdgcn_readfirstlane(vdst+(slot)))
  const int vb0=(int)(lds0+LDS_V)+((lane>>4)&1)*32+(lane&3)*8+(4*hi+((lane&15)>>2))*64;
  const char*Kbase=shm+LDS_K; bf16x8 kf[8];
  const lds_cptr shm3=(lds_cptr)shm; const lds_cptr kp0=shm3+LDS_K+hi*1024+r32*16; const lds_cptr vp0=shm3+LDS_V+((lane>>4)&1)*32+(lane&3)*8+(4*hi+((lane&15)>>2))*64;
  DMA_K(0,0);DMA_V(0,0);DMA_K(1,SLOTB);
  bf16x8 qr[4];
  { bf16x8 qraw[4];
    #pragma unroll
    for(int d0=0;d0<4;++d0)qraw[d0]=*reinterpret_cast<const bf16x8*>(&Qw[(long)r32*QP+d0*16+hi*8]);
    float qf[4][8]; float ss=0.f;
    #pragma unroll
    for(int d0=0;d0<4;++d0)
      #pragma unroll
      for(int j=0;j<8;++j){ qf[d0][j]=__builtin_bit_cast(float,(unsigned)(unsigned short)qraw[d0][j]<<16); ss+=qf[d0][j]*qf[d0][j]; }
    ss+=__shfl_xor(ss,32);
    const float rstd=1.0f/sqrtf(ss*(1.f/64.f)+1e-6f)*C2;
    #pragma unroll
    for(int d0=0;d0<4;++d0)
      #pragma unroll
      for(int j=0;j<8;++j) qf[d0][j]*=rstd*qg[16*d0+8*hi+j];
    if(ropet){ const float2* rp=ropet+(long)(p0+psub+r32)*32+8*hi;
      #pragma unroll
      for(int j=0;j<8;++j){ const float2 c1=rp[j],c2=rp[16+j];
        const float a=qf[0][j],b=qf[1][j],c=qf[2][j],d=qf[3][j];
        qf[0][j]=a*c1.x-b*c1.y; qf[1][j]=b*c1.x+a*c1.y; qf[2][j]=c*c2.x-d*c2.y; qf[3][j]=d*c2.x+c*c2.y; } }
    #pragma unroll
    for(int d0=0;d0<4;++d0){ u32x4 w; w[0]=cvtpk_s(qf[d0][0],qf[d0][1]); w[1]=cvtpk_s(qf[d0][2],qf[d0][3]); w[2]=cvtpk_s(qf[d0][4],qf[d0][5]); w[3]=cvtpk_s(qf[d0][6],qf[d0][7]); qr[d0]=__builtin_bit_cast(bf16x8,w); } }
  float mhat=0.f,l_reg=0.f;f32x16 o[2];o[0]=f32x16{};o[1]=f32x16{};f32x16 negm=f32x16{};asm volatile("":"+v"(negm));
  const int qpos=p0+psub+r32;
  #define CMASK(P0,P1,t) do{ if((t)>=4)wmask(P0,P1,KP0(t),qpos,hi); }while(0)
  bool resc=false;
  #define START(P0,P1) do{ const float rm=rowmax(P0,P1); resc=false; \
    { const float dl=rm; mhat=fadd_s(mhat,dl); \
      _Pragma("unroll") for(int r=0;r<16;++r){P0[r]=fsub_s(P0[r],dl);P1[r]=fsub_s(P1[r],dl);} \
      _Pragma("unroll") for(int r=0;r<16;++r)negm[r]=-mhat; asm volatile("":"+v"(negm)); } \
    _Pragma("unroll") for(int r=0;r<16;++r)P0[r]=__builtin_amdgcn_exp2f(P0[r]); }while(0)
  #define RESC() do{ if(resc){ asm volatile("s_waitcnt lgkmcnt(0)":::"memory"); \
      _Pragma("unroll") for(int d_=0;d_<2;++d_) _Pragma("unroll") for(int r=0;r<16;++r)o[d_][r]*=wsf[crow(r,hi)]; } }while(0)
  f32x16 pA0,pA1,pB0,pB1;
  int sl_prev=0,sl_cur=0,sl_next=SLOTB;
  #define ROT() do{sl_prev=sl_cur;sl_cur=sl_next;sl_next=(sl_next==(NSLOT-1)*SLOTB)?0:sl_next+SLOTB;}while(0)
  DMA_K(2,2*SLOTB);
  WAIT_BAR(3);
  qkt(pA0,pA1,Kbase,qr,negm,r32,hi);asm volatile("s_nop 15\n\ts_nop 7":"+v"(pA0),"+v"(pA1));CMASK(pA0,pA1,0);
  START(pA0,pA1);
  _Pragma("unroll") for(int r=0;r<16;++r)pA1[r]=__builtin_amdgcn_exp2f(pA1[r]);
  WAIT_BAR(0);
  DMA_K(3,0);DMA_V(1,SLOTB);
  ROT();
  kload8(kf,kp0+sl_cur);
  WAIT_BAR(2);
  s16x4 vlo[8],vhi[8]; u32x4 pw0,pw1,pw2,pw3;
  #define PKW(P,B) cvtpk_s(P[B],P[B+1])
  #define PAF(k) __builtin_bit_cast(bf16x8,pw##k)
  #define VFR(i) (bf16x8){vlo[i][0],vlo[i][1],vlo[i][2],vlo[i][3],vhi[i][0],vhi[i][1],vhi[i][2],vhi[i][3]}
  #define PIN(x) asm volatile("":"+v"(x))
  #define MX3(a,b,c) __builtin_fmaxf(__builtin_fmaxf((a),(b)),(c))
  #define GAPA(MF,A0,A1,A2,A3,W0,W1,PW) do{ MF; sacc+=A0; sacc+=A1; sacc+=A2; sacc+=A3; PIN(sacc); W0; W1; PIN(PW); SBAR(); }while(0)
  #define EX(v) __builtin_amdgcn_exp2f(v)
  #define GAPB(MF,X,B) do{ MF; X[B]=EX(X[B]); X[B+1]=EX(X[B+1]); X[B+2]=EX(X[B+2]); X[B+3]=EX(X[B+3]); PIN(X); SBAR(); }while(0)
  #define VRD(i) do{ vlo[i]=vtr(vp_+(((i)>>2)*4096+((i)&3)*1024)); vhi[i]=vtr(vp_+(((i)>>2)*4096+((i)&3)*1024+512)); }while(0)
  #define KRD(G,j) do{ if(G){ kload2(kf,kp0+sl_next,j); SBAR(); } }while(0)
  #define STEP(C0,C1,P0,P1,t,GK,GV,GL) do{ SBAR(); \
    const lds_cptr vp_=vp0+sl_prev; \
    VRD(0); SBAR(); float sacc=(P0[0]+P0[1]); \
    GAPA(C0=__builtin_amdgcn_mfma_f32_32x32x16_bf16(kf[0],qr[0],negm,0,0,0), P0[2],P0[3],P0[4],P0[5],     pw0[0]=PKW(P0,0), pw0[1]=PKW(P0,2), pw0); \
    VRD(4); SBAR(); GAPA(C1=__builtin_amdgcn_mfma_f32_32x32x16_bf16(kf[1],qr[0],negm,0,0,0), P0[6],P0[7],P0[8],P0[9],     pw0[2]=PKW(P0,4), pw0[3]=PKW(P0,6), pw0); \
    VRD(1); SBAR(); GAPA(C0=__builtin_amdgcn_mfma_f32_32x32x16_bf16(kf[2],qr[1],C0,0,0,0),   P0[10],P0[11],P0[12],P0[13], pw1[0]=PKW(P0,8), pw1[1]=PKW(P0,10), pw1); \
    VRD(5); SBAR(); GAPA(C1=__builtin_amdgcn_mfma_f32_32x32x16_bf16(kf[3],qr[1],C1,0,0,0),   P0[14],P0[15],P1[0],P1[1],   pw1[2]=PKW(P0,12),pw1[3]=PKW(P0,14), pw1); \
    VRD(2); SBAR(); GAPA(C0=__builtin_amdgcn_mfma_f32_32x32x16_bf16(kf[4],qr[2],C0,0,0,0),   P1[2],P1[3],P1[4],P1[5],     pw2[0]=PKW(P1,0), pw2[1]=PKW(P1,2), pw2); \
    VRD(6); SBAR(); GAPA(C1=__builtin_amdgcn_mfma_f32_32x32x16_bf16(kf[5],qr[2],C1,0,0,0),   P1[6],P1[7],P1[8],P1[9],     pw2[2]=PKW(P1,4), pw2[3]=PKW(P1,6), pw2); \
    VRD(3); SBAR(); GAPA(C0=__builtin_amdgcn_mfma_f32_32x32x16_bf16(kf[6],qr[3],C0,0,0,0),   P1[10],P1[11],P1[12],P1[13], pw3[0]=PKW(P1,8), pw3[1]=PKW(P1,10), pw3); \
    VRD(7); SBAR(); GAPA(C1=__builtin_amdgcn_mfma_f32_32x32x16_bf16(kf[7],qr[3],C1,0,0,0),   P1[14],P1[15],0.f,0.f,       pw3[2]=PKW(P1,12),pw3[3]=PKW(P1,14), pw3); \
    l_reg+=sacc; \
    if(GK){DMA_K((t)+3,sl_cur);} if(GV){DMA_V((t)+1,sl_next);} \
    CMASK(C0,C1,t); \
    { float a=MX3(C0[0],C0[1],C1[0]),b=MX3(C0[2],C0[3],C1[1]); a=MX3(a,C1[2],C1[3]); \
      _Pragma("unroll") for(int r=4;r<16;r+=4){a=MX3(a,C0[r],C0[r+1]);b=MX3(b,C0[r+2],C0[r+3]);a=MX3(a,C1[r],C1[r+1]);b=MX3(b,C1[r+2],C1[r+3]);} \
      float rm=__builtin_fmaxf(a,b); { auto rr=__builtin_amdgcn_permlane32_swap(__float_as_uint(rm),__float_as_uint(rm),false,false); rm=__builtin_fmaxf(__uint_as_float(rr[0]),__uint_as_float(rr[1])); } \
      resc=false; \
      if(__builtin_expect(__any(rm>(float)THRL),0)){ const float dl=__builtin_fmaxf(rm,0.f); mhat+=dl; \
        _Pragma("unroll") for(int r=0;r<16;++r){C0[r]-=dl;C1[r]-=dl;} \
        _Pragma("unroll") for(int r=0;r<16;++r)negm[r]=-mhat; asm volatile("":"+v"(negm)); \
        const float f=__builtin_amdgcn_exp2f(-dl); l_reg*=f; if(hi==0)wsf[r32]=f; resc=true; } } \
    SBAR(); \
    GAPB(o[0]=__builtin_amdgcn_mfma_f32_32x32x16_bf16(PAF(0),VFR(0),o[0],0,0,0), C0,0); \
    GAPB(o[1]=__builtin_amdgcn_mfma_f32_32x32x16_bf16(PAF(0),VFR(4),o[1],0,0,0), C0,4); \
    KRD(GL,0); GAPB(o[0]=__builtin_amdgcn_mfma_f32_32x32x16_bf16(PAF(1),VFR(1),o[0],0,0,0), C0,8); \
    KRD(GL,1); GAPB(o[1]=__builtin_amdgcn_mfma_f32_32x32x16_bf16(PAF(1),VFR(5),o[1],0,0,0), C0,12); \
    KRD(GL,2); GAPB(o[0]=__builtin_amdgcn_mfma_f32_32x32x16_bf16(PAF(2),VFR(2),o[0],0,0,0), C1,0); \
    KRD(GL,3); GAPB(o[1]=__builtin_amdgcn_mfma_f32_32x32x16_bf16(PAF(2),VFR(6),o[1],0,0,0), C1,4); \
    GAPB(o[0]=__builtin_amdgcn_mfma_f32_32x32x16_bf16(PAF(3),VFR(3),o[0],0,0,0), C1,8); \
    GAPB(o[1]=__builtin_amdgcn_mfma_f32_32x32x16_bf16(PAF(3),VFR(7),o[1],0,0,0), C1,12); \
    }while(0)
  int t=1;
  for(;t+5<NT;t+=2){
    STEP(pB0,pB1,pA0,pA1,t,true,true,true);     WAIT_BAR(2); RESC(); ROT();
    STEP(pA0,pA1,pB0,pB1,t+1,true,true,true);   WAIT_BAR(2); RESC(); ROT();
  }
  #define ENDW(tt) do{ if((tt)+3<NT){WAIT_BAR(2);} else if((tt)+2<NT){WAIT_BAR(1);} else {WAIT_BAR(0);} }while(0)
  for(;t+1<NT;t+=2){
    STEP(pB0,pB1,pA0,pA1,t,(t+3<NT),(t+1<NT),(t+1<NT));       ENDW(t);   RESC(); ROT();
    STEP(pA0,pA1,pB0,pB1,t+1,(t+4<NT),(t+2<NT),(t+2<NT));     ENDW(t+1); RESC(); ROT();
  }
  STEP(pB0,pB1,pA0,pA1,NT-1,false,false,false); RESC();
  { float sacc=pB0[0]+pB0[1]; _Pragma("unroll") for(int r=2;r<16;++r)sacc+=pB0[r]; _Pragma("unroll") for(int r=0;r<16;++r)sacc+=pB1[r]; l_reg+=sacc;
    pw0=(u32x4){PKW(pB0,0),PKW(pB0,2),PKW(pB0,4),PKW(pB0,6)};pw1=(u32x4){PKW(pB0,8),PKW(pB0,10),PKW(pB0,12),PKW(pB0,14)};pw2=(u32x4){PKW(pB1,0),PKW(pB1,2),PKW(pB1,4),PKW(pB1,6)};pw3=(u32x4){PKW(pB1,8),PKW(pB1,10),PKW(pB1,12),PKW(pB1,14)};
    SBAR(); pv(o,vb0+sl_cur,PAF(0),PAF(1),PAF(2),PAF(3)); }
  #undef PKW
  #undef PAF
  #undef VFR
  #undef PIN
  #undef MX3
  #undef GAPA
  #undef GAPB
  #undef EX
  #undef VRD
  #undef KRD
  #undef STEP
  #undef ENDW
  l_reg+=__shfl_xor(l_reg,32);
  l_reg+=__builtin_amdgcn_exp2f(sinkp[hsub]*1.4426950408889634f-mhat);
  if(hi==0)wsf[32+r32]=l_reg;asm volatile("s_waitcnt lgkmcnt(0)":::"memory");
  float rli[16];
  #pragma unroll
  for(int r=0;r<16;++r)rli[r]=__builtin_amdgcn_rcpf(wsf[32+crow(r,hi)]);
  bf16*Ow=Ou+(long)psub*OP+hsub*D;
  { bf16*stg=(bf16*)(shm+LDS_OST)+wid*2048;
    #pragma unroll
    for(int r=0;r<16;++r){const int orow=crow(r,hi);
      #pragma unroll
      for(int d0=0;d0<2;++d0)stg[orow*64+d0*32+r32]=__float2bfloat16(o[d0][r]*rli[r]);}
    asm volatile("s_waitcnt lgkmcnt(0)":::"memory");
    #pragma unroll
    for(int i=0;i<4;++i){const int row=i*8+(lane>>3),ch=lane&7; const u32x4 v=*(const u32x4*)(stg+row*64+ch*8); ATTN_STORE16(Ow+(long)row*OP+ch*8,v);} }
  asm volatile("s_waitcnt lgkmcnt(0)\n\ts_barrier":::"memory");
  #undef DMA_K
  #undef DMA_V
  #undef KP0
  #undef TROW
  #undef CMASK
  #undef START
  #undef RESC
  #undef ROT
}
constexpr int ATTN_LDS_BYTES=LDS_BYTES;
#undef SBAR
#undef WAIT_BAR
}

constexpr int SLAB_PITCH = 288;
typedef short v4i16_t __attribute__((ext_vector_type(4)));
template <int MT, class RowAddr, class Epi>
__device__ __forceinline__ void slab_gemm(LAS unsigned char* lds, const bf16* Cmat, const int K, const RowAddr& RA, const Epi& E) {
    int tid = threadIdx.x; asm volatile("" : "+v"(tid));
    const int wid = tid >> 6, lane = tid & 63;
    LAS bf16* Dr = (LAS bf16*)lds;
    f32x16 acc[MT];
#pragma unroll
    for (int i = 0; i < MT; ++i)
#pragma unroll
        for (int r = 0; r < 16; ++r) acc[i][r] = 0.f;
    const int g = (lane >> 4) & 1, h = lane >> 5, qq = (lane & 15) >> 2, pp = lane & 3;
    const LAS bf16* trp = Dr + (8 * h + qq) * SLAB_PITCH + wid * 32 + 16 * g + 4 * pp;
    for (int kc = 0; kc < K; kc += 128) {
        {
            const int k = tid >> 2, qd = tid & 3;
            const bf16* src = RA(kc + k) + qd * 64;
            v4u v[8];
#pragma unroll
            for (int j = 0; j < 8; ++j) v[j] = *(const v4u*)(src + j * 8);
#pragma unroll
            for (int j = 0; j < 8; ++j) *(LAS v4u*)(Dr + k * SLAB_PITCH + qd * 64 + j * 8) = v[j];
        }
        __syncthreads();
        const int kh = h * 8;
#pragma unroll
        for (int s = 0; s < 8; ++s) {
            const v4i16_t b0 = __builtin_amdgcn_ds_read_tr16_b64_v4i16((LAS v4i16_t*)(trp + (16 * s) * SLAB_PITCH));
            const v4i16_t b1 = __builtin_amdgcn_ds_read_tr16_b64_v4i16((LAS v4i16_t*)(trp + (16 * s + 4) * SLAB_PITCH));
            const bf16x8 bfrag = (bf16x8){b0[0], b0[1], b0[2], b0[3], b1[0], b1[1], b1[2], b1[3]};
#pragma unroll
            for (int mt = 0; mt < MT; ++mt) {
                const bf16x8 afrag = *(const bf16x8*)(Cmat + (size_t)(mt * 32 + (lane & 31)) * K + kc + s * 16 + kh);
                acc[mt] = __builtin_amdgcn_mfma_f32_32x32x16_bf16(afrag, bfrag, acc[mt], 0, 0, 0);
            }
        }
        __syncthreads();
    }
    E(acc, wid, lane, lds);
}

struct Args { const float* in[23]; float* out; unsigned char* ws; int ph_lo, ph_hi; };

constexpr int SOUT_PITCH = 264;
template <int NROWS, bool WT, class RowPtr>
__device__ __forceinline__ void slab_store_rows(LAS unsigned char* lds, const RowPtr& RP) {
    int tid = threadIdx.x; asm volatile("" : "+v"(tid));
    __syncthreads();
#pragma unroll
    for (int k = 0; k < NROWS / 16; ++k) { const int row = (tid >> 5) + 16 * k, chunk = tid & 31;
        const v4u v = *(const LAS v4u*)((LAS bf16*)lds + row * SOUT_PITCH + chunk * 8);
        bf16* dst = RP(row) + chunk * 8;
        if (WT) store16_wt(dst, v); else *(v4u*)dst = v; }
    __syncthreads();
}
struct RowA { const bf16* z; int b, n2; __device__ __forceinline__ const bf16* operator()(int k) const { return z + (size_t)(b * 4096 + 64 * (k & 63) + n2) * 512 + (k >> 6) * 256; } };
struct RowPA { bf16* t2; int b, n2; __device__ __forceinline__ bf16* operator()(int m) const { return t2 + ((size_t)((b * 64 + n2) * 64 + (m & 63)) * 2 + (m >> 6)) * 256; } };
template <bool WT> struct EpiA { bf16* t2; const float2* tw; int b, n2;
    __device__ __forceinline__ void operator()(const f32x16 (&acc)[4], int wid, int lane, LAS unsigned char* lds) const {
        const int ch = wid * 32 + (lane & 31); LAS bf16* so = (LAS bf16*)lds;
#pragma unroll
        for (int mt = 0; mt < 2; ++mt)
#pragma unroll
            for (int r = 0; r < 16; ++r) {
                const int k1 = 32 * mt + (r & 3) + 8 * (r >> 2) + 4 * (lane >> 5);
                const float2 cs = tw[n2 * k1]; const float re = acc[mt][r], im = acc[mt + 2][r];
                const float re2 = cs.x * re + cs.y * im, im2 = cs.x * im - cs.y * re;
                so[k1 * SOUT_PITCH + ch] = (bf16)f2bf(re2); so[(64 + k1) * SOUT_PITCH + ch] = (bf16)f2bf(im2);
            }
        RowPA rp{t2, b, n2}; slab_store_rows<128, WT, RowPA>(lds, rp);
    } };
struct RowB { const bf16* t2; int b, k1; __device__ __forceinline__ const bf16* operator()(int k) const { return t2 + ((size_t)((b * 64 + (k & 63)) * 64 + k1) * 2 + (k >> 6)) * 256; } };
struct RowPB { bf16* mrg; int b, k1; __device__ __forceinline__ bf16* operator()(int k2) const { return mrg + (size_t)(b * 4096 + k1 + 64 * k2) * 1024 + 768; } };
struct EpiB { bf16* mrg; int b, k1;
    __device__ __forceinline__ void operator()(const f32x16 (&acc)[2], int wid, int lane, LAS unsigned char* lds) const {
        const int ch = wid * 32 + (lane & 31); LAS bf16* so = (LAS bf16*)lds;
#pragma unroll
        for (int mt = 0; mt < 2; ++mt)
#pragma unroll
            for (int r = 0; r < 16; ++r) { const int k2 = 32 * mt + (r & 3) + 8 * (r >> 2) + 4 * (lane >> 5); so[k2 * SOUT_PITCH + ch] = (bf16)f2bf(DBG_NO_FOUR ? 0.f : acc[mt][r]); }
        RowPB rp{mrg, b, k1}; slab_store_rows<64, false, RowPB>(lds, rp);
    } };
struct RowC { const bf16* z; int b; __device__ __forceinline__ const bf16* operator()(int k) const { return z + (size_t)(T + b * 256 + (k & 255)) * 512 + (k >> 8) * 256; } };
struct RowPC { bf16* mrg; int b, mt0; __device__ __forceinline__ bf16* operator()(int kk) const { return mrg + (size_t)(T + b * 256 + 32 * mt0 + kk) * 1024 + 768; } };
struct EpiC { bf16* mrg; int b, mt0;
    __device__ __forceinline__ void operator()(const f32x16 (&acc)[1], int wid, int lane, LAS unsigned char* lds) const {
        const int ch = wid * 32 + (lane & 31); LAS bf16* so = (LAS bf16*)lds;
#pragma unroll
        for (int r = 0; r < 16; ++r) { const int kk = (r & 3) + 8 * (r >> 2) + 4 * (lane >> 5); so[kk * SOUT_PITCH + ch] = (bf16)f2bf(DBG_NO_FOUR ? 0.f : acc[0][r]); }
        RowPC rp{mrg, b, mt0}; slab_store_rows<32, false, RowPC>(lds, rp);
    } };

__device__ __forceinline__ void tr_block(const float* src, int ldS, bf16* dst, int ldD, LAS float* scr, int lane) {
#pragma unroll 8
    for (int i = 0; i < 32; ++i) { const int kk = 2 * i + (lane >> 5); scr[kk * 33 + (lane & 31)] = src[(size_t)kk * ldS + (lane & 31)]; }
    LDS_WAIT(); asm volatile("" ::: "memory");
    const int c = lane & 7;
#pragma unroll
    for (int j = 0; j < 4; ++j) { const int n = (lane >> 3) + 8 * j; const LAS float* s = scr + (8 * c) * 33 + n;
        v4u o; o.x = pk2(s[0 * 33], s[1 * 33]); o.y = pk2(s[2 * 33], s[3 * 33]); o.z = pk2(s[4 * 33], s[5 * 33]); o.w = pk2(s[6 * 33], s[7 * 33]);
        *(GAS v4u*)(dst + (size_t)n * ldD + 8 * c) = o; }
    LDS_WAIT(); asm volatile("" ::: "memory");
}


__device__ __forceinline__ void tr_block64(const float* src, int ldS, bf16* dst, int ldD, LAS bf16* scr, int lane) {
    const int kr = lane >> 4, nc = lane & 15;
    f32x4 v[16];
#pragma unroll
    for (int i = 0; i < 16; ++i) v[i] = *(const f32x4*)(src + (size_t)(4 * i + kr) * ldS + 4 * nc);
#pragma unroll
    for (int i = 0; i < 16; ++i) { const int k = 4 * i + kr;
#pragma unroll
        for (int j = 0; j < 4; ++j) scr[(4 * nc + j) * 66 + k] = (bf16)f2bf(v[i][j]); }
    LDS_WAIT(); asm volatile("" ::: "memory");
    const int c = lane & 7;
#pragma unroll
    for (int j = 0; j < 8; ++j) { const int n = (lane >> 3) + 8 * j; const LAS unsigned* p = (const LAS unsigned*)(scr + n * 66 + 8 * c);
        v4u o; o.x = p[0]; o.y = p[1]; o.z = p[2]; o.w = p[3];
        *(GAS v4u*)(dst + (size_t)n * ldD + 8 * c) = o; }
    LDS_WAIT(); asm volatile("" ::: "memory");
}

typedef const __attribute__((address_space(4))) Args* kargs_t;
__device__ __forceinline__ kargs_t ka_launder() { kargs_t p = (kargs_t)__builtin_amdgcn_kernarg_segment_ptr(); asm volatile("" : "+s"(p)); return p; }
__device__ __forceinline__ int tid_launder() { int t = threadIdx.x; asm volatile("" : "+v"(t)); return t; }
#define KA_DECL const kargs_t KA = ka_launder(); const int tid = tid_launder(); const int lane = tid & 63; const int wave = __builtin_amdgcn_readfirstlane(tid >> 6); const int gw = vcu * 8 + wave; const int gt = vcu * 512 + tid; (void)lane; (void)wave; (void)gw; (void)gt;
#define ws (KA->ws)
#define ctl ((gu32*)(ws + O_CTL))
#define x_in (KA->in[0])
#define c_in (KA->in[1])
#define ctx_in (KA->in[2])
#define cctx_in (KA->in[3])
#define w_mod (KA->in[4])
#define b_mod (KA->in[5])
#define norm1_g (KA->in[6])
#define w_in (KA->in[7])
#define q_norm_g (KA->in[8])
#define k_norm_g (KA->in[9])
#define attn_sink (KA->in[10])
#define pool_w (KA->in[11])
#define pool_scale (KA->in[12])
#define four_w (KA->in[13])
#define w_out (KA->in[14])
#define norm2_g (KA->in[15])
#define w_grp (KA->in[16])
#define b_grp (KA->in[17])
#define w_rtr (KA->in[18])
#define b_rtr (KA->in[19])
#define w_gate (KA->in[20])
#define w_up (KA->in[21])
#define w_down (KA->in[22])
#define outp (KA->out)
#define modv ((float*)(ws + O_MOD))
#define rope ((float2*)(ws + O_ROPE))
#define twt ((float2*)(ws + O_TW))
#define fma ((bf16*)(ws + O_FMA))
#define fmb ((bf16*)(ws + O_FMB))
#define fmc ((bf16*)(ws + O_FMC))
#define hbuf ((bf16*)(ws + O_H))
#define kall ((bf16*)(ws + O_KALL))
#define vall ((bf16*)(ws + O_VALL))
#define xc ((float*)(ws + O_XC))
#define list ((unsigned*)(ws + O_LIST))
#define wts ((float*)(ws + O_WTS))
#define act ((bf16*)(ws + O_ACT))
#define t2 ((bf16*)(ws + O_T2))
#define mrg ((bf16*)(ws + O_MRG))
#define qb ((bf16*)(ws + O_Q))
#define pu ((bf16*)(ws + O_PU))
#define zb ((bf16*)(ws + O_Z))
#define y2 ((bf16*)(ws + O_Y2))

#ifndef PH_MASK
#define PH_MASK 0x3ffff
#endif
#define IN(k) (lo <= (k) && (k) < hi && ((PH_MASK >> (k)) & 1))
#define SEAM(k) do { if (IN(k) && IN((k) + 1)) xcd_barrier(bar); } while (0)
#define modl (modv + (size_t)l * 5 * 6144)
#define win_t ((bf16*)(ws + O_WIN + l * SZ_WIN1))
#define wout_t ((bf16*)(ws + O_WOUT + l * SZ_WOUT1))
#define wgu_t ((bf16*)(ws + O_WGU + l * SZ_WGU1))
#define wd_t ((bf16*)(ws + O_WD + l * SZ_WD1))
constexpr int CV_A = 256, CV_B = 192, CV_C = 4096, CV_D = 2048, CV_L = CV_A + CV_B + CV_C + CV_D;
__device__ __forceinline__ void conv_item(const kargs_t KA, const int lw, int it, LAS bf16* scr, const int lane) {
    bf16* p_win_t = (bf16*)(ws + O_WIN + lw * SZ_WIN1); bf16* p_wout_t = (bf16*)(ws + O_WOUT + lw * SZ_WOUT1);
    bf16* p_wgu_t = (bf16*)(ws + O_WGU + lw * SZ_WGU1); bf16* p_wd_t = (bf16*)(ws + O_WD + lw * SZ_WD1);
    if (it < CV_A) { const int kb = it >> 4, nb = it & 15; tr_block64(w_in + (size_t)lw * 1024 * 1280 + (size_t)kb * 64 * 1280 + nb * 64, 1280, p_win_t + (size_t)nb * 64 * 1024 + kb * 64, 1024, scr, lane); return; } it -= CV_A;
    if (it < CV_B) { const int kb = 4 + (it >> 4), nb = it & 15; tr_block64(w_out + (size_t)lw * 1024 * 1024 + (size_t)kb * 64 * 1024 + nb * 64, 1024, p_wout_t + (size_t)nb * 64 * 1024 + kb * 64, 1024, scr, lane); return; } it -= CV_B;
    if (it < CV_C) { const int up = it >> 11, r = it & 2047, e = r >> 7, kb = (r >> 3) & 15, nb = r & 7; const int n0 = nb * 64;
        const float* src = (up ? w_up : w_gate) + ((size_t)(lw * 16 + e) * 1024 + kb * 64) * 512 + n0;
        const int drow = (n0 >> 7) * 256 + up * 128 + (n0 & 127);
        tr_block64(src, 512, p_wgu_t + ((size_t)e * 1024 + drow) * 1024 + kb * 64, 1024, scr, lane); return; } it -= CV_C;
    { const int e = it >> 7, kb = (it >> 4) & 7, nb = it & 15;
        tr_block64(w_down + ((size_t)(lw * 16 + e) * 512 + kb * 64) * 1024 + nb * 64, 1024, p_wd_t + ((size_t)e * 1024 + nb * 64) * 512 + kb * 64, 512, scr, lane); }
}
__device__ __forceinline__ void steal_convert(const kargs_t KA, LAS unsigned char* lds, const int G, const int done_idx, const bool drain) {
    int tid = threadIdx.x; asm volatile("" : "+v"(tid));
    const int lane = tid & 63, wave = __builtin_amdgcn_readfirstlane(tid >> 6);
    volatile LAS int* mb = (volatile LAS int*)(lds + MISC_OFF + 64);
    LAS bf16* scr = (LAS bf16*)(lds + wave * 16384);
    __syncthreads();
    if (tid == 0 && !drain) __hip_atomic_fetch_add((unsigned*)(ctl + CW_DONE + 64 * done_idx), 1u, RLX_AGENT);
    for (;;) {
        if (tid == 0) { int idx = -1;
            const bool stop = !drain && __hip_atomic_load((unsigned*)(ctl + CW_DONE + 64 * done_idx), RLX_AGENT) >= (unsigned)G;
            if (!stop) idx = (int)__hip_atomic_fetch_add((unsigned*)(ctl + CW_Q), 8u, RLX_AGENT);
            mb[0] = idx; }
        __syncthreads();
        const int idx = mb[0];
        __syncthreads();
        if (idx < 0 || idx >= CV_L) break;
        if (idx + wave < CV_L) conv_item(KA, 1, idx + wave, scr, lane);
    }
    __syncthreads();
}

template <int l> __device__ __forceinline__ void layer_body(LAS unsigned char* lds, const int G, const int vcu, const XcdBarrier& bar, const int lo, const int hi) {
    const int NGW = G * 8, NGT = G * 512; LAS int* ttab = (LAS int*)(lds + TILE_OFF);
    constexpr int P = 1 + 8 * l;

        for (int rep_ = 0; rep_ < 1 + ((l == 0) ? ((REP_MASK >> (1 + 0)) & 1) : 0); ++rep_)
        if (IN(P + 0)) {
            KA_DECL
            const float* modp = modv;
            if (l == 1) steal_convert(KA, lds, G, 3, true);
#pragma clang loop vectorize(disable) unroll(disable)
            for (int r0 = gw; r0 < TT; r0 += 2 * NGW) {
                const int r1 = r0 + NGW; const bool has1 = r1 < TT;
                f32x4 va[4], vb[4]; v2u yaa[4], yab[4], yba[4], ybb[4];
                const float* srca; const float* srcb;
                { const bool isc = r0 >= T; srca = (l == 0) ? (isc ? ctx_in + (size_t)(r0 - T) * 1024 : x_in + (size_t)r0 * 1024) : (isc ? xc + (size_t)(r0 - T) * 1024 : outp + (size_t)r0 * 1024); }
                { const int rr = has1 ? r1 : r0; const bool isc = rr >= T; srcb = (l == 0) ? (isc ? ctx_in + (size_t)(rr - T) * 1024 : x_in + (size_t)rr * 1024) : (isc ? xc + (size_t)(rr - T) * 1024 : outp + (size_t)rr * 1024); }
#pragma unroll
                for (int j = 0; j < 4; ++j) { va[j] = *(const f32x4*)(srca + 4 * lane + 256 * j); vb[j] = *(const f32x4*)(srcb + 4 * lane + 256 * j); }
                if (l == 1) {
                    const int rr = has1 ? r1 : r0;
#pragma unroll
                    for (int j = 0; j < 4; ++j) { yaa[j] = *(const v2u*)(y2 + (size_t)(2 * r0) * 1024 + 4 * lane + 256 * j); yab[j] = *(const v2u*)(y2 + (size_t)(2 * r0 + 1) * 1024 + 4 * lane + 256 * j);
                        yba[j] = *(const v2u*)(y2 + (size_t)(2 * rr) * 1024 + 4 * lane + 256 * j); ybb[j] = *(const v2u*)(y2 + (size_t)(2 * rr + 1) * 1024 + 4 * lane + 256 * j); }
                }
#pragma unroll
                for (int half = 0; half < 2; ++half) {
                    if (half == 1 && !has1) break;
                    const int r = half ? r1 : r0; f32x4 (&v)[4] = half ? vb : va; v2u (&ya)[4] = half ? yba : yaa; v2u (&yb)[4] = half ? ybb : yab;
                    const bool isc = r >= T; const int bsel = isc ? 4 : (r >> 12);
                    if (l == 1) {
                        const float* g2 = modp + bsel * 6144 + 5 * 1024; float* dst = isc ? xc + (size_t)(r - T) * 1024 : outp + (size_t)r * 1024;
#pragma unroll
                        for (int j = 0; j < 4; ++j) {
                            const f32x4 gv = *(const f32x4*)(g2 + 4 * lane + 256 * j);
                            f32x4 yy; yy[0] = bflo(ya[j].x) + bflo(yb[j].x); yy[1] = bfhi(ya[j].x) + bfhi(yb[j].x); yy[2] = bflo(ya[j].y) + bflo(yb[j].y); yy[3] = bfhi(ya[j].y) + bfhi(yb[j].y);
                            if (DBG_NO_MOE) yy = (f32x4){0.f, 0.f, 0.f, 0.f};
                            v[j] = v[j] + gv * yy; *(f32x4*)(dst + 4 * lane + 256 * j) = v[j];
                        }
                    }
                    float ss = 0.f;
#pragma unroll
                    for (int j = 0; j < 4; ++j) ss += (v[j][0] * v[j][0] + v[j][1] * v[j][1]) + (v[j][2] * v[j][2] + v[j][3] * v[j][3]);
                    const float rstd = 1.0f / sqrtf(wave_sum(ss) * (1.f / 1024.f) + 1e-6f);
                    const float* sh = modl + bsel * 6144; const float* sc = sh + 1024; const float* gn = norm1_g + l * 1024;
#pragma unroll
                    for (int j = 0; j < 4; ++j) {
                        const int c0 = 4 * lane + 256 * j; const f32x4 g = *(const f32x4*)(gn + c0), s1 = *(const f32x4*)(sc + c0), h1 = *(const f32x4*)(sh + c0);
                        const f32x4 y = (v[j] * rstd) * g * (s1 + 1.0f) + h1;
                        v2u o; o.x = pk2(y[0], y[1]); o.y = pk2(y[2], y[3]); *(v2u*)(hbuf + (size_t)r * 1024 + c0) = o;
                    }
                }
            }
        }
        SEAM(P + 0);
        for (int rep_ = 0; rep_ < 1 + ((l == 0) ? ((REP_MASK >> (1 + 1)) & 1) : 0); ++rep_)
        if (IN(P + 1)) {
            KA_DECL
            SchedPlain S{TT / 256, 6, G, vcu, 1024, (const char*)hbuf, (const char*)win_t};
            EpiG1 E{pu, qb, kall, vall, zb};
            pg8::gemm_phase<EpiG1, SchedPlain>(lds, S, E);
            if (l == 0 && !MK_SPLIT) steal_convert(KA, lds, G, 0, false);
        }
        SEAM(P + 1);
        if (IN(P + 3)) {
            KA_DECL
            gu32* kflag = ctl + CW_KF + l * 16384;
            gu32* facnt = ctl + CW_FA + l * 64;
            for (int it = vcu; it < 256; it += G) {
                const int b = it >> 6, n2 = it & 63;
                RowA ra{zb, b, n2}; EpiA<true> ea{t2, twt, b, n2};
                slab_gemm<4, RowA, EpiA<true>>(lds, fma, 128, ra, ea);
                asm volatile("s_waitcnt vmcnt(0)" ::: "memory");
                __syncthreads();
                if (tid == 0) __hip_atomic_fetch_add((unsigned*)(facnt + 16 * b), 1u, RLX_AGENT);
            }
            const int n_att = 512 + (l == 0 ? 32 : 0);
            for (int it = vcu; it < n_att; it += G) {
                const bool cu = it >= 512; const int uidx = cu ? it - 512 : it;
                const int b = cu ? (uidx >> 3) : (uidx >> 7), kvh = cu ? ((uidx >> 2) & 1) : ((uidx >> 6) & 1), pb = cu ? (uidx & 3) : (uidx & 63);
                const int p0 = pb * 64; const int qrow0 = cu ? T + b * 256 + p0 : b * 4096 + p0;
                if (!cu) {
                    const int row = tid >> 3, c = tid & 7;
                    const float* kg = k_norm_g + l * 64 + 8 * c;
#pragma unroll
                    for (int part = 0; part < 2; ++part) {
                        if (part == 1 && pb >= 4) break;
                        const int blk = part ? pb : 4 + pb;
                        bf16* p = kall + ((size_t)b * KVROWS + blk * 64 + row) * 128 + kvh * 64 + c * 8;
                        const v4u w = *(const v4u*)p;
                        float x[8] = {bflo(w.x), bfhi(w.x), bflo(w.y), bfhi(w.y), bflo(w.z), bfhi(w.z), bflo(w.w), bfhi(w.w)};
                        float ss = 0.f;
#pragma unroll
                        for (int i = 0; i < 8; ++i) ss += x[i] * x[i];
                        ss += __shfl_xor(ss, 1); ss += __shfl_xor(ss, 2); ss += __shfl_xor(ss, 4);
                        const float rstd = 1.0f / sqrtf(ss * (1.f / 64.f) + 1e-6f);
#pragma unroll
                        for (int i = 0; i < 8; ++i) x[i] *= rstd * kg[i];
                        if (part == 0) {
                            const float2* rp = rope + (size_t)(p0 + row) * 32 + ((c & 4) ? 16 : 0) + (c & 1) * 8;
#pragma unroll
                            for (int i = 0; i < 8; ++i) { const float y = __shfl_xor(x[i], 2); const float2 cs = rp[i]; x[i] = (c & 2) ? (x[i] * cs.x + y * cs.y) : (x[i] * cs.x - y * cs.y); }
                        }
                        v4u o; o.x = pk2(x[0], x[1]); o.y = pk2(x[2], x[3]); o.z = pk2(x[4], x[5]); o.w = pk2(x[6], x[7]);
                        store16_wt(p, o);
                    }
                    asm volatile("s_waitcnt vmcnt(0)" ::: "memory");
                    __syncthreads();
                    if (tid == 0) { __hip_atomic_store(kflag + 16 * ((b * 68 + 4 + pb) * 2 + kvh), 1u, RLX_AGENT); if (pb < 4) __hip_atomic_store(kflag + 16 * ((b * 68 + pb) * 2 + kvh), 1u, RLX_AGENT); }
                }
                if (tid < 64) {
                    int blk = -1;
                    if (lane < 4) blk = lane; else if (!cu && lane < 9) { const int q = pb + lane - 6; if (q >= 0 && q < 64) blk = 4 + q; }
                    unsigned sp = 0;
                    for (;;) { const unsigned f = (blk >= 0) ? __hip_atomic_load(kflag + 16 * ((b * 68 + blk) * 2 + kvh), RLX_AGENT) : 1u;
                        if (__all(f != 0u)) break; __builtin_amdgcn_s_sleep(2);
                        if (++sp > (1u << 22)) { if (tid == 0) __hip_atomic_store(ctl + CW_TMO, 2u, RLX_AGENT); break; } }
                    __builtin_amdgcn_fence(__ATOMIC_ACQUIRE, "agent");
                    asm volatile("s_waitcnt vmcnt(0)" ::: "memory");
                }
                __syncthreads();
                const attn_body::bf16* Qu = (const attn_body::bf16*)(qb + (size_t)qrow0 * 512 + kvh * 256);
                const attn_body::bf16* Kh = (const attn_body::bf16*)(kall + (size_t)b * KVROWS * 128 + kvh * 64);
                const attn_body::bf16* Vh = (const attn_body::bf16*)(vall + (size_t)b * KVROWS * 128 + kvh * 64);
                attn_body::bf16* Ou = (attn_body::bf16*)(mrg + (size_t)qrow0 * 1024 + 256 + kvh * 256);
                attn_body::attn_unit<8>(Qu, Kh, Vh, Ou, p0, cu ? 4 : 10, attn_sink + l * 8 + kvh * 4, q_norm_g + l * 64, cu ? (const float2*)nullptr : (const float2*)rope, (char*)lds);
                __syncthreads();
            }
            const int prow = (l == 0) ? TT : T; const int nrb = prow >> 3;
#pragma clang loop vectorize(disable) unroll(disable)
            for (int i = gt; i < 32 * nrb; i += NGT) {
                const int ck8 = i & 7, rb = (i >> 3) % nrb, g = (i >> 3) / nrb;
                const int r0 = rb * 8; const bool isc = r0 >= T;
                const int nseq = isc ? LCTX : NSEQ; const int rbase = isc ? T + ((r0 - T) & ~255) : (r0 & ~4095); const int n0 = r0 - rbase;
                const int hw = 1 << g; const int col = g * 64 + ck8 * 8;
                const bf16* up = pu + (size_t)rbase * 256 + col;
                float sm[8] = {0.f, 0.f, 0.f, 0.f, 0.f, 0.f, 0.f, 0.f};
#define POOL_ACC(W, SGN) do { sm[0] += SGN bflo(W.x); sm[1] += SGN bfhi(W.x); sm[2] += SGN bflo(W.y); sm[3] += SGN bfhi(W.y); sm[4] += SGN bflo(W.z); sm[5] += SGN bfhi(W.z); sm[6] += SGN bflo(W.w); sm[7] += SGN bfhi(W.w); } while (0)
                for (int tpos = n0 - hw; tpos < n0 + hw; ++tpos) if (tpos >= 0 && tpos < nseq) { const v4u w = *(const v4u*)(up + (size_t)tpos * 256); POOL_ACC(w, +); }
#pragma unroll
                for (int k = 0; k < 8; ++k) {
                    const int n = n0 + k; int lo_ = n - hw; lo_ = lo_ < 0 ? 0 : lo_; int hi_ = n + hw - 1; hi_ = hi_ > nseq - 1 ? nseq - 1 : hi_;
                    const v4u w = *(const v4u*)(up + (size_t)n * 256); const float ic = 1.0f / (float)(hi_ - lo_ + 1);
                    v4u o; o.x = pk2(sm[0] * ic - bflo(w.x), sm[1] * ic - bfhi(w.x)); o.y = pk2(sm[2] * ic - bflo(w.y), sm[3] * ic - bfhi(w.y));
                    o.z = pk2(sm[4] * ic - bflo(w.z), sm[5] * ic - bfhi(w.z)); o.w = pk2(sm[6] * ic - bflo(w.w), sm[7] * ic - bfhi(w.w));
                    if (DBG_NO_POOL) o = (v4u){0u, 0u, 0u, 0u};
                    *(v4u*)(mrg + (size_t)(rbase + n) * 1024 + col) = o;
                    if (k < 7) { const int tin = n + hw, tout = n - hw;
                        if (tin < nseq) { const v4u wi = *(const v4u*)(up + (size_t)tin * 256); POOL_ACC(wi, +); }
                        if (tout >= 0) { const v4u wo = *(const v4u*)(up + (size_t)tout * 256); POOL_ACC(wo, -); } }
                }
#undef POOL_ACC
            }
            for (int it = vcu; it < 256; it += G) {
                const int b = it >> 6, k1 = it & 63;
                __syncthreads();
                if (tid < 64) { unsigned sp = 0;
                    while ((unsigned)__builtin_amdgcn_readfirstlane(__hip_atomic_load((unsigned*)(facnt + 16 * b), RLX_AGENT)) < 64u) { __builtin_amdgcn_s_sleep(2); if (++sp > (1u << 22)) { if (tid == 0) __hip_atomic_store(ctl + CW_TMO, 3u, RLX_AGENT); break; } }
                    __builtin_amdgcn_fence(__ATOMIC_ACQUIRE, "agent");
                    asm volatile("s_waitcnt vmcnt(0)" ::: "memory"); }
                __syncthreads();
                RowB rb{t2, b, k1}; EpiB eb{mrg, b, k1};
                slab_gemm<2, RowB, EpiB>(lds, fmb, 128, rb, eb);
            }
            if (l == 0) for (int it = (G - 1 - vcu); it < 32; it += G) {
                const int b = it >> 3, mt0 = it & 7;
                RowC rc{zb, b}; EpiC ec{mrg, b, mt0};
                slab_gemm<1, RowC, EpiC>(lds, fmc + (size_t)mt0 * 32 * 512, 512, rc, ec);
            }
        }
        SEAM(P + 3);
        if (IN(P + 4)) {
            KA_DECL
            unsigned* g2rdy = (unsigned*)(ctl + CW_G2 + l * 2048);
            {
                SchedPlain S{(l == 0 ? TT : T) / 256, 4, G, vcu, 1024, (const char*)mrg, (const char*)wout_t};
                EpiG2 E{(l == 0) ? x_in : outp, ctx_in, outp, xc, modl, g2rdy};
                pg8::gemm_phase<EpiG2, SchedPlain>(lds, S, E);
            }
            const int rep_ = 0;
            __syncthreads();
            LAS float* rw = (LAS float*)lds;
            LAS int* lcnt = (LAS int*)(lds + 81920);
            LAS unsigned* lent = (LAS unsigned*)(lds + 81920 + 256);
            LAS unsigned* lrank = lent + 1024;
            { const float* rwg = (const float*)(ws + O_RW) + l * 20480;
#pragma unroll
              for (int i = 0; i < 10; ++i) { const int idx = tid + 512 * i; *(LAS f32x4*)(rw + 4 * idx) = *(const f32x4*)(rwg + 4 * idx); } }
            if (tid < 33) lcnt[tid] = 0;
            if (tid < 64) { unsigned sp = 0; unsigned* w = g2rdy + 16 * (vcu >> 2);
                while ((unsigned)__builtin_amdgcn_readfirstlane(__hip_atomic_load(w, RLX_AGENT)) < 32u) { __builtin_amdgcn_s_sleep(2); if (++sp > (1u << 22)) { if (tid == 0) __hip_atomic_store(ctl + CW_TMO, 4u, RLX_AGENT); break; } }
                __builtin_amdgcn_fence(__ATOMIC_ACQUIRE, "agent");
                asm volatile("s_waitcnt vmcnt(0)" ::: "memory"); }
            __syncthreads();
            const bool dbl = (l == 0) && (G == 256) && (vcu < 16);
            const int ngl = 16 + ((l == 0) ? 1 : 0) + (((l == 0) && (G == 256)) ? 2 : 0);
#pragma clang loop vectorize(disable) unroll(disable)
            for (int gix = wave; gix < ngl; gix += 8) {
                int q;
                if (gix < 16) { if (dbl) continue; q = 16 * vcu + gix; }
                else if (gix == 16) q = T / 4 + vcu;
                else { if (dbl) continue; const int o = (gix == 17) ? (vcu - 16) : (240 + vcu - 16); if (o >= 256 || (gix == 18 && vcu >= 32)) continue; q = o; }
                if (gix >= 17) {
                    unsigned sp = 0; unsigned* w = g2rdy + 16 * (q >> 6);
                    while ((unsigned)__builtin_amdgcn_readfirstlane(__hip_atomic_load(w, RLX_AGENT)) < 32u) { __builtin_amdgcn_s_sleep(2); if (++sp > (1u << 22)) { if (lane == 0) __hip_atomic_store(ctl + CW_TMO, 6u, RLX_AGENT); break; } }
                    __builtin_amdgcn_fence(__ATOMIC_ACQUIRE, "agent");
                    asm volatile("s_waitcnt vmcnt(0)" ::: "memory"); }
                if (gix == 16) { unsigned sp = 0; unsigned* w = g2rdy + 16 * (64 + (vcu >> 6));
                    while ((unsigned)__builtin_amdgcn_readfirstlane(__hip_atomic_load(w, RLX_AGENT)) < 32u) { __builtin_amdgcn_s_sleep(2); if (++sp > (1u << 22)) { if (lane == 0) __hip_atomic_store(ctl + CW_TMO, 5u, RLX_AGENT); break; } }
                    __builtin_amdgcn_fence(__ATOMIC_ACQUIRE, "agent");
                    asm volatile("s_waitcnt vmcnt(0)" ::: "memory"); }
                const int rb4 = 4 * q; const bool isc = rb4 >= T; const int bsel = isc ? 4 : (rb4 >> 12);
                const float* src = isc ? xc + (size_t)(rb4 - T) * 1024 : outp + (size_t)rb4 * 1024;
                f32x4 v[4][4];
#pragma unroll
                for (int tk = 0; tk < 4; ++tk)
#pragma unroll
                    for (int j = 0; j < 4; ++j) v[tk][j] = *(const f32x4*)(src + (size_t)tk * 1024 + 4 * lane + 256 * j);
                float rstd[4];
#pragma unroll
                for (int tk = 0; tk < 4; ++tk) { float ss = 0.f;
#pragma unroll
                    for (int j = 0; j < 4; ++j) ss += (v[tk][j][0] * v[tk][j][0] + v[tk][j][1] * v[tk][j][1]) + (v[tk][j][2] * v[tk][j][2] + v[tk][j][3] * v[tk][j][3]);
                    rstd[tk] = 1.0f / sqrtf(wave_sum(ss) * (1.f / 1024.f) + 1e-6f); }
                const float* sh = modl + bsel * 6144 + 3 * 1024; const float* sc = sh + 1024; const float* gn = norm2_g + l * 1024;
                float lg[4][20];
#pragma unroll
                for (int tk = 0; tk < 4; ++tk)
#pragma unroll
                    for (int j = 0; j < 20; ++j) lg[tk][j] = 0.f;
#pragma unroll
                for (int j = 0; j < 4; ++j) {
                    const int c0 = 4 * lane + 256 * j; const f32x4 g = *(const f32x4*)(gn + c0), s1 = *(const f32x4*)(sc + c0), h1 = *(const f32x4*)(sh + c0);
                    f32x4 y[4];
#pragma unroll
                    for (int tk = 0; tk < 4; ++tk) { y[tk] = (v[tk][j] * rstd[tk]) * g * (s1 + 1.0f) + h1;
                        v2u o; o.x = pk2(y[tk][0], y[tk][1]); o.y = pk2(y[tk][2], y[tk][3]); *(v2u*)(hbuf + (size_t)(rb4 + tk) * 1024 + c0) = o; }
#pragma unroll
                    for (int e = 0; e < 4; ++e) {
#pragma unroll
                        for (int q5 = 0; q5 < 5; ++q5) { const f32x4 wv = *(const LAS f32x4*)(rw + (((q5 * 4 + j) * 4 + e) * 64 + lane) * 4);
#pragma unroll
                            for (int tk = 0; tk < 4; ++tk) { lg[tk][4 * q5] += y[tk][e] * wv[0]; lg[tk][4 * q5 + 1] += y[tk][e] * wv[1]; lg[tk][4 * q5 + 2] += y[tk][e] * wv[2]; lg[tk][4 * q5 + 3] += y[tk][e] * wv[3]; } }
                        __builtin_amdgcn_sched_barrier(0); }
                }
                float l2[20];
#pragma unroll
                for (int j = 0; j < 20; ++j) {
                    const float a0 = swap32_sum(lg[0][j], lg[2][j]);
                    const float a1 = swap32_sum(lg[1][j], lg[3][j]);
                    float t = swap16_sum(a0, a1);
                    t += dppf<0x128, 0xf>(t); t += dppf<0x124, 0xf>(t); t += dppf<0x122, 0xf>(t); t += dppf<0x121, 0xf>(t);
                    l2[j] = t;
                }
                const int tk = lane >> 4; const int r = rb4 + tk;
                float gl[4]; float gm = -1e30f;
#pragma unroll
                for (int j = 0; j < 4; ++j) { gl[j] = l2[j] + b_grp[l * 4 + j]; gm = fmaxf(gm, gl[j]); }
                float gs = 0.f; int gi = 0; float gb = -1e30f;
#pragma unroll
                for (int j = 0; j < 4; ++j) { const float e = expf(gl[j] - gm); gs += e; if (gl[j] > gb) { gb = gl[j]; gi = j; } }
                const float pg = expf(gb - gm) / gs;
                float el[4]; float em = -1e30f;
#pragma unroll
                for (int j = 0; j < 4; ++j) { float t_ = 0.f;
#pragma unroll
                    for (int g4 = 0; g4 < 4; ++g4) t_ = (gi == g4) ? (l2[4 + g4 * 4 + j] + b_rtr[l * 16 + g4 * 4 + j]) : t_;
                    el[j] = t_; em = fmaxf(em, t_); }
                float pe[4];
#pragma unroll
                for (int j = 0; j < 4; ++j) pe[j] = expf(el[j] - em);
                int i0 = 0; float b0 = -1.f;
#pragma unroll
                for (int j = 0; j < 4; ++j) if (pe[j] > b0) { b0 = pe[j]; i0 = j; }
                int i1 = 0; float b1 = -1.f;
#pragma unroll
                for (int j = 0; j < 4; ++j) if (j != i0 && pe[j] > b1) { b1 = pe[j]; i1 = j; }
                const float wsum = b0 + b1; const float w0 = pg * b0 / wsum, w1 = pg * b1 / wsum;
                if ((lane & 15) == 0 && rep_ == 0) {
                    wts[2 * r] = w0; wts[2 * r + 1] = w1;
                    const int e0 = gi * 4 + i0, e1 = gi * 4 + i1;
                    const int s0 = __hip_atomic_fetch_add((LAS int*)(lcnt + 16 + 16), 1, __ATOMIC_RELAXED, __HIP_MEMORY_SCOPE_WORKGROUP);
                    const int k0 = __hip_atomic_fetch_add((LAS int*)(lcnt + e0), 1, __ATOMIC_RELAXED, __HIP_MEMORY_SCOPE_WORKGROUP);
                    const int k1 = __hip_atomic_fetch_add((LAS int*)(lcnt + e1), 1, __ATOMIC_RELAXED, __HIP_MEMORY_SCOPE_WORKGROUP);
                    lent[2 * s0] = ((unsigned)(2 * r) << 4) | (unsigned)e0; lrank[2 * s0] = (unsigned)k0;
                    lent[2 * s0 + 1] = ((unsigned)(2 * r + 1) << 4) | (unsigned)e1; lrank[2 * s0 + 1] = (unsigned)k1;
                }
            }
            __syncthreads();
            if (tid < 16 && rep_ == 0) { const int c = lcnt[tid]; lcnt[16 + tid] = c ? (int)__hip_atomic_fetch_add((unsigned*)(ctl + CW_CNT + (l * 16 + tid) * 64), (unsigned)c, RLX_AGENT) : 0; }
            __syncthreads();
            const int ntot = rep_ == 0 ? 2 * lcnt[32] : 0;
            for (int i = tid; i < ntot; i += 512) { const unsigned en = lent[i]; const int e = en & 15; list[(size_t)e * TT + lcnt[16 + e] + lrank[i]] = en >> 4; }
            __syncthreads();
            if (l == 0 && !MK_SPLIT) steal_convert(KA, lds, G, 1, false);
        }
        SEAM(P + 5);
        if (IN(P + 6) || IN(P + 7)) {
            KA_DECL
            __syncthreads();
            if (tid < 16) ttab[17 + tid] = (int)__hip_atomic_load((unsigned*)(ctl + CW_CNT + (l * 16 + tid) * 64), RLX_AGENT);
            __syncthreads();
            if (tid == 0) { int acc_ = 0; for (int e = 0; e < 16; ++e) { const int c = ttab[17 + e]; ttab[e] = acc_; acc_ += (c + 255) >> 8; } ttab[16] = acc_; }
            __syncthreads();
        }
        if (DBG_NAIVE_MOE && IN(P + 6)) {
            KA_DECL
            const int nrows = (l == 0) ? TT : T; LAS float* hs = (LAS float*)lds; LAS float* as = hs + 1024;
            const int* eidg = (const int*)(ws + O_EID);
            LAS float* lgs = as + 512; LAS float* rt = lgs + 32;
            for (int r = vcu; r < nrows; r += G) {
                __syncthreads();
                for (int i = tid; i < 1024; i += 512) hs[i] = bf2f(hbuf[(size_t)r * 1024 + i]);
                __syncthreads();
                if (tid < 20) { float a = 0.f; for (int k = 0; k < 1024; ++k) a += hs[k] * ((tid < 4) ? w_grp[(size_t)l * 4096 + k * 4 + tid] : w_rtr[(size_t)l * 16384 + k * 16 + (tid - 4)]);
                    lgs[tid] = a + ((tid < 4) ? b_grp[l * 4 + tid] : b_rtr[l * 16 + tid - 4]); }
                __syncthreads();
                if (tid == 0) { int gi = 0; for (int j = 1; j < 4; ++j) if (lgs[j] > lgs[gi]) gi = j; float gs = 0.f; for (int j = 0; j < 4; ++j) gs += expf(lgs[j] - lgs[gi]); const float pg = 1.f / gs;
                    int i0 = 0; for (int j = 1; j < 4; ++j) if (lgs[4 + gi * 4 + j] > lgs[4 + gi * 4 + i0]) i0 = j; int i1 = -1; for (int j = 0; j < 4; ++j) if (j != i0 && (i1 < 0 || lgs[4 + gi * 4 + j] > lgs[4 + gi * 4 + i1])) i1 = j;
                    const float p0 = 1.f, p1 = expf(lgs[4 + gi * 4 + i1] - lgs[4 + gi * 4 + i0]); rt[0] = (float)(gi * 4 + i0); rt[1] = (float)(gi * 4 + i1); rt[2] = pg * p0 / (p0 + p1); rt[3] = pg * p1 / (p0 + p1); }
                __syncthreads();
                for (int sl = 0; sl < 2; ++sl) {
                    const int e = (DBG_NAIVE_ROUTE & 1) ? (int)rt[sl] : eidg[2 * r + sl]; const float w = (DBG_NAIVE_ROUTE & 2) ? rt[2 + sl] : wts[2 * r + sl];
                    __syncthreads();
                    const float* Wg = w_gate + (size_t)(l * 16 + e) * 1024 * 512 + tid; const float* Wu = w_up + (size_t)(l * 16 + e) * 1024 * 512 + tid;
                    float g = 0.f, u = 0.f;
#pragma unroll 8
                    for (int k = 0; k < 1024; ++k) { g += hs[k] * Wg[(size_t)k * 512]; u += hs[k] * Wu[(size_t)k * 512]; }
                    as[tid] = g / (1.f + expf(-g)) * u;
                    __syncthreads();
                    const float* Wd = w_down + (size_t)(l * 16 + e) * 512 * 1024 + tid;
                    float y0 = 0.f, y1 = 0.f;
#pragma unroll 8
                    for (int j = 0; j < 512; ++j) { y0 += as[j] * Wd[(size_t)j * 1024]; y1 += as[j] * Wd[(size_t)j * 1024 + 512]; }
                    y2[(size_t)(2 * r + sl) * 1024 + tid] = (bf16)f2bf(y0 * w); y2[(size_t)(2 * r + sl) * 1024 + 512 + tid] = (bf16)f2bf(y1 * w);
                }
            }
        }
        if (!DBG_NAIVE_MOE && IN(P + 6)) {
            KA_DECL
            unsigned* rdy = (unsigned*)(ctl + CW_RDY + l * 4096);
            SchedMoe S{G, vcu, ttab[16], (const char*)hbuf, (const char*)act, (const char*)wgu_t, (const char*)wd_t, list, ttab, rdy, (unsigned*)(ctl + CW_TMO)};
            EpiMoe E{EpiG3{act, rdy}, EpiG4{y2, list, wts, ttab}};
            pg8::gemm_phase<EpiMoe, SchedMoe>(lds, S, E);
            if (l == 0 && !MK_SPLIT) steal_convert(KA, lds, G, 2, false);
        }
        SEAM(P + 7);
    }

__global__ void __launch_bounds__(512, 2) fwd_kernel(Args args) {
    extern __shared__ __attribute__((aligned(16))) unsigned char lds_raw[];
    LAS unsigned char* lds = (LAS unsigned char*)lds_raw;
    const int tid = threadIdx.x, lane = tid & 63, wave = __builtin_amdgcn_readfirstlane(tid >> 6);
    const int G = gridDim.x; const int bx = blockIdx.x; const int vcu = (G % 8 == 0) ? (bx % 8) * (G / 8) + bx / 8 : bx;
    volatile LAS unsigned* MISC = (volatile LAS unsigned*)(lds + MISC_OFF);
    LAS float* trig = (LAS float*)(lds + TRIG_OFF);
    LAS int* ttab = (LAS int*)(lds + TILE_OFF);
    for (int u = tid; u < (LDS_BYTES - LDSCTL_OFF) / 4; u += 512) ((LAS unsigned*)(lds + LDSCTL_OFF))[u] = 0u;
    __syncthreads();
    if (tid < 64) { float s, c; sincospif((float)tid / 32.f, &s, &c); trig[tid] = c; trig[64 + tid] = s; }
    __syncthreads();
    XcdBarrier bar; bar.bar = nullptr; bar.x = 0; bar.st = nullptr;
    if (!MK_SPLIT) { KA_DECL bar = xcd_barrier_post((unsigned*)(ctl + CW_BAR), MISC + 8); }
    const int lo = args.ph_lo, hi = args.ph_hi;
    const int NGW = G * 8, NGT = G * 512;

    for (int rep_ = 0; rep_ < 1 + ((REP_MASK >> 0) & 1); ++rep_)
    if (IN(0)) {
        KA_DECL
        __syncthreads();
        if (rep_ == 0 || ((REP_MASK >> 13) & 1)) {
            LAS float* sl = (LAS float*)lds;
            bool have = false;
            for (int it = vcu; it < 192; it += G) {
                if (!have) {
                    for (int i = tid; i < 5120; i += 512) { const int r = i >> 10, k = i & 1023; const float v = (r < 4) ? c_in[r * 1024 + k] : cctx_in[k]; sl[i] = v / (1.f + expf(-v)); }
                    __syncthreads(); have = true;
                }
                const int l = it / 96, cb = it % 96;
                const int r4 = lane >> 4, cq = lane & 15; const int k0 = wave * 128;
                const float* W = w_mod + (size_t)l * 1024 * 6144 + (size_t)(k0 + r4) * 6144 + cb * 64 + 4 * cq;
                f32x4 a0 = {0.f, 0.f, 0.f, 0.f}, a1 = a0, a2 = a0, a3 = a0, a4 = a0;
#pragma unroll 8
                for (int k = 0; k < 32; ++k) { const f32x4 wv = *(const f32x4*)(W + (size_t)(4 * k) * 6144); const int kk = k0 + 4 * k + r4;
                    a0 += wv * sl[kk]; a1 += wv * sl[1024 + kk]; a2 += wv * sl[2048 + kk]; a3 += wv * sl[3072 + kk]; a4 += wv * sl[4096 + kk]; }
                LAS float* part = sl + 5120;
                { LAS float* pp = part + (wave * 4 + r4) * 320 + 4 * cq;
                  *(LAS f32x4*)(pp) = a0; *(LAS f32x4*)(pp + 64) = a1; *(LAS f32x4*)(pp + 128) = a2; *(LAS f32x4*)(pp + 192) = a3; *(LAS f32x4*)(pp + 256) = a4; }
                __syncthreads();
                if (tid < 320) { const int r = tid >> 6, n = tid & 63; float sacc = b_mod[l * 6144 + cb * 64 + n];
#pragma unroll 8
                    for (int w = 0; w < 32; ++w) sacc += part[w * 320 + r * 64 + n];
                    modv[(size_t)(l * 5 + r) * 6144 + cb * 64 + n] = sacc; }
                __syncthreads();
            }
            __syncthreads();
        }
        if (rep_ == 0 || ((REP_MASK >> 14) & 1)) {
#pragma clang loop vectorize(disable) unroll(disable)
        for (int i = gt; i < 4096 * 32; i += NGT) {
            const int n = i >> 5, j = i & 31; const int jj = j & 15;
            const float inv = 1.0f / powf(10000.0f, (float)(2 * jj) / 32.0f);
            const float pos = (j < 16) ? (float)(n >> 6) : (float)(n & 63);
            const float ang = pos * inv; rope[i] = make_float2(cosf(ang), sinf(ang));
        }
#pragma clang loop vectorize(disable) unroll(disable)
        for (int i = gt; i < 4096; i += NGT) { float s, c; sincospif((float)i / 2048.f, &s, &c); twt[i] = make_float2(c, s); }
#pragma clang loop vectorize(disable) unroll(disable)
        for (int i = gt; i < 128 * 128; i += NGT) {
            const int m = i >> 7, k = i & 127; const int ri = m >> 6, k1 = m & 63, part = k >> 6, n1 = k & 63;
            float s, c; sincospif((float)((n1 * k1) & 63) / 32.f, &s, &c);
            float v; if (ri == 0) v = (part == 0) ? c : -s; else v = (part == 0) ? -s : -c;
            fma[i] = (bf16)f2bf(v);
        }
#pragma clang loop vectorize(disable) unroll(disable)
        for (int i = gt; i < 64 * 128; i += NGT) {
            const int k2 = i >> 7, k = i & 127; const int ri = k >> 6, n2 = k & 63;
            float s, c; sincospif((float)((n2 * k2) & 63) / 32.f, &s, &c);
            fmb[i] = (bf16)f2bf((ri == 0 ? c : s) * (1.f / 512.f));
        }
#pragma clang loop vectorize(disable) unroll(disable)
        for (int i = gt; i < 256 * 512; i += NGT) {
            const int kk = i >> 9, k = i & 511; const int part = k >> 8, n = k & 255;
            float s, c; sincospif((float)((n * kk) & 255) / 128.f, &s, &c);
            fmc[i] = (bf16)f2bf((part == 0 ? c : -s) * (1.f / 128.f));
        }
#pragma clang loop vectorize(disable) unroll(disable)
        for (int i = gt; i < 2 * 20480; i += NGT) {
            const int lw = i / 20480, r = i % 20480; const int d = r / 20, j = r % 20;
            ((float*)(ws + O_RW))[lw * 20480 + ((((j >> 2) * 4 + (d >> 8)) * 4 + (d & 3)) * 64 + ((d & 255) >> 2)) * 4 + (j & 3)] = (j < 4) ? w_grp[(size_t)lw * 4096 + d * 4 + j] : w_rtr[(size_t)lw * 16384 + d * 16 + (j - 4)];
        }
        }
        if (rep_ == 0 || ((REP_MASK >> 15) & 1)) {
            LAS float* Al = (LAS float*)lds;
            LAS float* Wl = Al + 4096;
            LAS float* Xl = Wl + 4096;
            for (int it = vcu; it < 256; it += G) {
                const int combo = it & 15, jb = it >> 4; const int l = combo >> 3, g = (combo >> 1) & 3, which = combo & 1;
                const float* Wg = four_w + (size_t)(l * 4 + g) * 4096; const LAS float* tb = trig + which * 64;
                const float* wi = w_in + (size_t)l * 1024 * 1280 + (size_t)(jb * 64) * 1280 + 1024 + g * 64;
                __syncthreads();
#pragma unroll
                for (int i = 0; i < 2; ++i) { const int idx = tid + 512 * i; *(LAS f32x4*)(Wl + 4 * idx) = *(const f32x4*)(Wg + 4 * idx); const int j = idx >> 4, c4 = idx & 15; *(LAS f32x4*)(Xl + j * 64 + 4 * c4) = *(const f32x4*)(wi + (size_t)j * 1280 + 4 * c4); }
                __syncthreads();
                { const int d = tid & 63, c0 = tid >> 6;
#pragma unroll 2
                  for (int i = 0; i < 8; ++i) { const int c = c0 + 8 * i; float a = 0.f;
#pragma unroll 16
                      for (int m = 0; m < 64; ++m) a += tb[(m * c) & 63] * Wl[m * 64 + d];
                      Al[c * 64 + d] = a; } }
                __syncthreads();
                { const int d = tid & 63, jl = 8 * (tid >> 6);
                  float o[8] = {0.f, 0.f, 0.f, 0.f, 0.f, 0.f, 0.f, 0.f};
#pragma unroll 4
                  for (int c = 0; c < 64; ++c) { const float av = Al[c * 64 + d];
#pragma unroll
                      for (int i = 0; i < 8; ++i) o[i] += Xl[(jl + i) * 64 + c] * av; }
                  v4u w; w.x = pk2(o[0], o[1]); w.y = pk2(o[2], o[3]); w.z = pk2(o[4], o[5]); w.w = pk2(o[6], o[7]);
                  *(v4u*)((bf16*)(ws + O_WIN + l * SZ_WIN1) + (size_t)(1024 + which * 256 + g * 64 + d) * 1024 + jb * 64 + jl) = w; }
            }
            for (int it = vcu; it < 256; it += G) {
                const int combo = it & 7, nb = it >> 3; const int l = combo >> 2, g = combo & 3, n0 = nb * 32;
                const float* pwg = pool_w + (size_t)(l * 4 + g) * 4096;
                __syncthreads();
#pragma unroll
                for (int i = 0; i < 2; ++i) { const int idx = tid + 512 * i; *(LAS f32x4*)(Wl + 4 * idx) = *(const f32x4*)(pwg + 4 * idx); }
                for (int i = tid; i < 2048; i += 512) { const int d = i >> 5, n = i & 31; Xl[i] = pool_scale[l * 256 + g * 64 + d] * w_out[(size_t)l * 1024 * 1024 + (size_t)(g * 64 + d) * 1024 + n0 + n]; }
                __syncthreads();
                { const int n = tid & 31, c0 = 4 * (tid >> 5);
                  float o[4] = {0.f, 0.f, 0.f, 0.f};
#pragma unroll 8
                  for (int d = 0; d < 64; ++d) { const float sv = Xl[d * 32 + n];
#pragma unroll
                      for (int i = 0; i < 4; ++i) o[i] += Wl[(c0 + i) * 64 + d] * sv; }
                  v2u w; w.x = pk2(o[0], o[1]); w.y = pk2(o[2], o[3]);
                  *(v2u*)((bf16*)(ws + O_WOUT + l * SZ_WOUT1) + (size_t)(n0 + n) * 1024 + g * 64 + c0) = w; }
            }
            __syncthreads();
        }
        if (rep_ == 0 || ((REP_MASK >> 16) & 1)) {
            LAS bf16* scr = (LAS bf16*)(lds + wave * 16384);
#pragma clang loop vectorize(disable) unroll(disable)
            for (int it0 = gw; it0 < CV_L; it0 += NGW) conv_item(KA, 0, it0, scr, lane);
        }
    }
    SEAM(0);
    if ((REP_MASK >> 12) & 1) { for (int k_ = 0; k_ < 4; ++k_) xcd_barrier(bar); }

    layer_body<0>(lds, G, vcu, bar, lo, hi);
    layer_body<1>(lds, G, vcu, bar, lo, hi);
    if (IN(17)) {
        KA_DECL
        const float* modp = modv + (size_t)5 * 6144;
#pragma clang loop vectorize(disable) unroll(disable)
        for (int r = gw; r < T; r += NGW) {
            const float* g2 = modp + (r >> 12) * 6144 + 5 * 1024; float* dst = outp + (size_t)r * 1024;
#pragma unroll
            for (int j = 0; j < 4; ++j) {
                const int c0 = 4 * lane + 256 * j; f32x4 v = *(const f32x4*)(dst + c0);
                const v2u ya = *(const v2u*)(y2 + (size_t)(2 * r) * 1024 + c0), yb = *(const v2u*)(y2 + (size_t)(2 * r + 1) * 1024 + c0);
                const f32x4 gv = *(const f32x4*)(g2 + c0);
                f32x4 yy; yy[0] = bflo(ya.x) + bflo(yb.x); yy[1] = bfhi(ya.x) + bfhi(yb.x); yy[2] = bflo(ya.y) + bflo(yb.y); yy[3] = bfhi(ya.y) + bfhi(yb.y);
                if (DBG_NO_MOE) yy = (f32x4){0.f, 0.f, 0.f, 0.f};
                *(f32x4*)(dst + c0) = v + gv * yy;
            }
        }
    }
#undef IN
#undef SEAM
}

#undef KA_DECL
#undef ws
#undef ctl
#undef x_in
#undef c_in
#undef ctx_in
#undef cctx_in
#undef w_mod
#undef b_mod
#undef norm1_g
#undef w_in
#undef q_norm_g
#undef k_norm_g
#undef attn_sink
#undef pool_w
#undef pool_scale
#undef four_w
#undef w_out
#undef norm2_g
#undef w_grp
#undef b_grp
#undef w_rtr
#undef b_rtr
#undef w_gate
#undef w_up
#undef w_down
#undef outp
#undef modv
#undef rope
#undef twt
#undef fma
#undef fmb
#undef fmc
#undef hbuf
#undef kall
#undef vall
#undef xc
#undef list
#undef wts
#undef act
#undef t2
#undef mrg
#undef qb
#undef pu
#undef zb
#undef y2
#undef modl
#undef win_t
#undef wout_t
#undef wgu_t
#undef wd_t
extern "C" void kernel_launch(void* const* d_in, const int* in_sizes, int n_in, void* d_out, int out_size, void* d_ws, size_t ws_size, hipStream_t stream) {
    static int grid = 0;
    if (grid == 0) {
        if (n_in != 23 || out_size != T * DM || ws_size < WS_END) { fprintf(stderr, "kernel_launch: unexpected shapes (n_in %d out %d ws %zu need %zu)\n", n_in, out_size, ws_size, (size_t)WS_END); grid = -1; return; }
        int dev = 0, cus = 0;
        if (hipGetDevice(&dev) != hipSuccess || hipDeviceGetAttribute(&cus, hipDeviceAttributeMultiprocessorCount, dev) != hipSuccess) { grid = -1; return; }
        if (cus != 256) { fprintf(stderr, "kernel_launch: built for a 256-CU device (row-tile hand-offs are laid out for 256 workgroups); found %d CUs; nothing launched\n", cus); grid = -1; return; }
        if (hipFuncSetAttribute((const void*)fwd_kernel, hipFuncAttributeMaxDynamicSharedMemorySize, LDS_BYTES) != hipSuccess) { fprintf(stderr, "kernel_launch: hipFuncSetAttribute failed\n"); grid = -1; return; }
        (void)hipGetLastError();
        grid = cus;
    }
    if (grid < 0) return;
    (void)hipMemsetAsync((char*)d_ws + O_CTL, 0, SZ_CTL, stream);
    Args a{};
    for (int i = 0; i < 23; ++i) a.in[i] = (const float*)d_in[i];
    a.out = (float*)d_out; a.ws = (unsigned char*)d_ws;
#if MK_SPLIT
    for (int p = 0; p < NPHASE; ++p) { a.ph_lo = p; a.ph_hi = p + 1; hipLaunchKernelGGL(fwd_kernel, dim3(grid), dim3(512), LDS_BYTES, stream, a); }
#else
    a.ph_lo = 0; a.ph_hi = NPHASE;
    hipLaunchKernelGGL(fwd_kernel, dim3(grid), dim3(512), LDS_BYTES, stream, a);
#endif
}
```

```cpp
#include <hip/hip_runtime.h>
#include <cstdio>
#include <cstdint>

#define DBG_NO_FOUR 0
#define DBG_NO_POOL 0
#define DBG_NO_ATT 0
#define DBG_NO_MOE 0
#define DBG_MOE_SCALE 1.0f
#define DBG_NAIVE_MOE 0
#define REP_MASK 0x0
#define DBG_NAIVE_ROUTE 0
#define LAS __attribute__((address_space(3)))
#define GAS __attribute__((address_space(1)))
typedef unsigned short bf16;
typedef short bf16x8 __attribute__((ext_vector_type(8)));
typedef float f32x4 __attribute__((ext_vector_type(4)));
typedef float f32x16 __attribute__((ext_vector_type(16)));
typedef unsigned v4u __attribute__((ext_vector_type(4)));
typedef unsigned v2u __attribute__((ext_vector_type(2)));
typedef GAS unsigned gu32;

#ifndef MK_SPLIT
#define MK_SPLIT 0
#endif

constexpr int NB = 4, NSEQ = 4096, DM = 1024, LCTX = 256, DEPTH = 2;
constexpr int T = NB * NSEQ, TC = NB * LCTX, TT = T + TC;
constexpr int KVROWS = LCTX + NSEQ;
constexpr int NEXP = 16, DEXP = 512;
constexpr int NPHASE = 18;
constexpr int MAXTILES = 152;
constexpr float QSCALE = 0.125f * 1.4426950408889634f;
constexpr float LOG2E = 1.4426950408889634f;

constexpr size_t al256(size_t x) { return (x + 255) & ~(size_t)255; }
constexpr size_t O_CTL = 0, SZ_CTL = 1u << 20;
constexpr size_t O_MOD = O_CTL + SZ_CTL, SZ_MOD = (size_t)2 * 5 * 6144 * 4;
constexpr size_t O_ROPE = al256(O_MOD + SZ_MOD), SZ_ROPE = (size_t)4096 * 32 * 8;
constexpr size_t O_TW = al256(O_ROPE + SZ_ROPE), SZ_TW = 4096 * 8;
constexpr size_t O_FMA = al256(O_TW + SZ_TW), SZ_FMA = 128 * 128 * 2;
constexpr size_t O_FMB = al256(O_FMA + SZ_FMA), SZ_FMB = 64 * 128 * 2;
constexpr size_t O_FMC = al256(O_FMB + SZ_FMB), SZ_FMC = 256 * 512 * 2;
constexpr size_t O_RW = al256(O_FMC + SZ_FMC), SZ_RW = (size_t)2 * 20480 * 4;
constexpr size_t O_WIN = al256(O_RW + SZ_RW), SZ_WIN1 = (size_t)1536 * 1024 * 2;
constexpr size_t O_WOUT = al256(O_WIN + 2 * SZ_WIN1), SZ_WOUT1 = (size_t)1024 * 1024 * 2;
constexpr size_t O_WGU = al256(O_WOUT + 2 * SZ_WOUT1), SZ_WGU1 = (size_t)16 * 1024 * 1024 * 2;
constexpr size_t O_WD = al256(O_WGU + 2 * SZ_WGU1), SZ_WD1 = (size_t)16 * 1024 * 512 * 2;
constexpr size_t O_H = al256(O_WD + 2 * SZ_WD1), SZ_H = (size_t)TT * 1024 * 2;
constexpr size_t O_KALL = al256(O_H + SZ_H), SZ_KV = (size_t)NB * KVROWS * 128 * 2;
constexpr size_t O_VALL = al256(O_KALL + SZ_KV);
constexpr size_t O_XC = al256(O_VALL + SZ_KV), SZ_XC = (size_t)TC * 1024 * 4;
constexpr size_t O_LIST = al256(O_XC + SZ_XC), SZ_LIST = (size_t)NEXP * TT * 4;
constexpr size_t O_WTS = al256(O_LIST + SZ_LIST), SZ_WTS = (size_t)TT * 2 * 4;
constexpr size_t O_EID = al256(O_WTS + SZ_WTS), SZ_EID = (size_t)TT * 2 * 4;
constexpr size_t O_ACT = al256(O_EID + SZ_EID), SZ_ACT = (size_t)MAXTILES * 256 * 512 * 2;
constexpr size_t O_T2 = O_ACT, SZ_T2 = (size_t)NB * 64 * 64 * 2 * 256 * 2;
constexpr size_t O_MRG = al256(O_ACT + SZ_ACT), SZ_MRG = (size_t)TT * 1024 * 2;
constexpr size_t O_Q = al256(O_MRG + SZ_MRG), SZ_Q = (size_t)TT * 512 * 2;
constexpr size_t O_PU = al256(O_Q + SZ_Q), SZ_PU = (size_t)TT * 256 * 2;
constexpr size_t O_Z = al256(O_PU + SZ_PU), SZ_Z = (size_t)TT * 512 * 2;
constexpr size_t O_Y2 = O_MRG, SZ_Y2 = (size_t)TT * 2 * 1024 * 2;
constexpr size_t WS_END = al256(O_Z + SZ_Z);
static_assert(SZ_T2 <= SZ_ACT, "T2 overlay");
static_assert(O_Y2 + SZ_Y2 <= WS_END, "y2 overlay");

constexpr int CW_TMO = 0;
constexpr int CW_BAR = 4096;
constexpr int CW_KF = 65536;
constexpr int CW_FA = 3072;
constexpr int CW_G2 = 40960;
constexpr int CW_RDY = 32768;
constexpr int CW_Q = 2048;
constexpr int CW_DONE = 2560;
constexpr int CW_CNT = 16384;

constexpr int RING_BYTES = 131072;
constexpr int LDSCTL_OFF = RING_BYTES, MISC_OFF = LDSCTL_OFF + 320;
constexpr int TRIG_OFF = LDSCTL_OFF + 1024;
constexpr int TILE_OFF = LDSCTL_OFF + 2048;
constexpr int LDS_BYTES = 147456;

#define RLX_AGENT __ATOMIC_RELAXED, __HIP_MEMORY_SCOPE_AGENT
#define LDS_WAIT() asm volatile("s_waitcnt lgkmcnt(0)" ::: "memory")
#define VM_WAIT() asm volatile("s_waitcnt vmcnt(0)" ::: "memory")

__device__ __forceinline__ unsigned f2bf(float f) { unsigned u = __builtin_bit_cast(unsigned, f); return (u + 0x7fffu + ((u >> 16) & 1u)) >> 16; }
__device__ __forceinline__ unsigned pk2(float lo, float hi) { return f2bf(lo) | (f2bf(hi) << 16); }
__device__ __forceinline__ unsigned pk4_f8(float a, float b, float c, float d) { unsigned w = 0; w = __builtin_amdgcn_cvt_pk_fp8_f32(a, b, w, false); w = __builtin_amdgcn_cvt_pk_fp8_f32(c, d, w, true); return w; }
__device__ __forceinline__ float bflo(unsigned w) { return __builtin_bit_cast(float, w << 16); }
__device__ __forceinline__ float bfhi(unsigned w) { return __builtin_bit_cast(float, w & 0xffff0000u); }
__device__ __forceinline__ float bf2f(bf16 h) { return __builtin_bit_cast(float, (unsigned)h << 16); }
template <int CTRL, int RM> __device__ __forceinline__ float dppf(float v) { return __builtin_bit_cast(float, __builtin_amdgcn_update_dpp(0, __builtin_bit_cast(int, v), CTRL, RM, 0xf, true)); }
__device__ __forceinline__ float wave_sum(float v) {
    v += dppf<0x111, 0xf>(v); v += dppf<0x112, 0xf>(v); v += dppf<0x114, 0xf>(v); v += dppf<0x118, 0xf>(v);
    v += dppf<0x142, 0xa>(v); v += dppf<0x143, 0xc>(v);
    return __builtin_bit_cast(float, __builtin_amdgcn_readlane(__builtin_bit_cast(int, v), 63));
}

__device__ __forceinline__ float swap32_sum(float x, float y) {
    const auto rr = __builtin_amdgcn_permlane32_swap(__builtin_bit_cast(unsigned, x), __builtin_bit_cast(unsigned, y), false, false);
    unsigned r0 = rr[0], r1 = rr[1]; asm volatile("" : "+v"(r0), "+v"(r1));
    return __builtin_bit_cast(float, r0) + __builtin_bit_cast(float, r1);
}
__device__ __forceinline__ float swap16_sum(float x, float y) {
    const auto rr = __builtin_amdgcn_permlane16_swap(__builtin_bit_cast(unsigned, x), __builtin_bit_cast(unsigned, y), false, false);
    unsigned r0 = rr[0], r1 = rr[1]; asm volatile("" : "+v"(r0), "+v"(r1));
    return __builtin_bit_cast(float, r0) + __builtin_bit_cast(float, r1);
}

#define XB_TMO      128
#define XB_XCNT(j)  (256  + 64 * (j))
#define XB_XSUB(j)  (1280 + 64 * (j))
#define XB_XGEN(j)  (2304 + 64 * (j))
#define XB_TOP      3328
#define XB_TOPGEN   3392
#define XCD_BAR_WORDS 3456
#define XB_SPIN_CAP (1u << 18)
__device__ __forceinline__ unsigned xb_ld(unsigned* p)              { return __hip_atomic_load(p, __ATOMIC_RELAXED, __HIP_MEMORY_SCOPE_AGENT); }
__device__ __forceinline__ unsigned xb_add(unsigned* p, unsigned v) { return __hip_atomic_fetch_add(p, v, __ATOMIC_RELAXED, __HIP_MEMORY_SCOPE_AGENT); }
__device__ __forceinline__ unsigned xb_xcc_id() { return (unsigned)__builtin_amdgcn_s_getreg((3 << 11) | 20) & 0xFu; }
#define XB_SPIN(cond, bar) do { unsigned _sp = 0; while (cond) { __builtin_amdgcn_s_sleep(1); \
    if ((++_sp & 255u) == 0u) { if (xb_ld(&(bar)[XB_TMO])) break; if (_sp > XB_SPIN_CAP) { atomicAdd(&(bar)[XB_TMO], 1u); break; } } } } while (0)
struct XcdBarrier { unsigned* bar; unsigned x; volatile LAS unsigned* st; };
__device__ __forceinline__ XcdBarrier xcd_barrier_post(unsigned* bar, volatile LAS unsigned* st) {
    XcdBarrier b; b.bar = bar; b.x = xb_xcc_id(); b.st = st;
    if (threadIdx.x == 0) (void)xb_add(&bar[XB_XCNT(b.x)], 1u);
    return b;
}
__device__ __forceinline__ void xcd_barrier_complete(unsigned* bar, unsigned x, unsigned& nloc, unsigned& nx) {
    const unsigned G = gridDim.x * gridDim.y * gridDim.z;
    unsigned sum, cnt, mine, sp = 0u;
    for (;;) {
        sum = 0u; cnt = 0u; mine = 0u;
#pragma unroll
        for (unsigned j = 0; j < 16; ++j) { const unsigned c = xb_ld(&bar[XB_XCNT(j)]); sum += c; cnt += (c > 0u) ? 1u : 0u; mine = (j == x) ? c : mine; }
        if (sum == G) break;
        __builtin_amdgcn_s_sleep(1);
        if ((++sp & 255u) == 0u) { if (xb_ld(&bar[XB_TMO])) break; if (sp > XB_SPIN_CAP) { atomicAdd(&bar[XB_TMO], 1u); break; } }
    }
    nloc = mine > 0u ? mine : 1u; nx = cnt > 0u ? cnt : 1u;
}
__device__ __forceinline__ void xcd_barrier(const XcdBarrier& b) {
    asm volatile("s_waitcnt vmcnt(0)" ::: "memory");
    __syncthreads();
    if (threadIdx.x == 0) {
        unsigned* bar = b.bar;
        __builtin_amdgcn_s_waitcnt(0);
        unsigned nloc = b.st[0], nx = b.st[1];
        if (nloc == 0u) { xcd_barrier_complete(bar, b.x, nloc, nx); b.st[0] = nloc; b.st[1] = nx; }
        const unsigned old = xb_add(&bar[XB_XSUB(b.x)], 1u);
        const unsigned gen = old / nloc;
        if (old + 1u == (gen + 1u) * nloc) {
            __builtin_amdgcn_fence(__ATOMIC_RELEASE, "agent");
            asm volatile("s_waitcnt vmcnt(0)" ::: "memory");
            const unsigned og = xb_add(&bar[XB_TOP], 1u);
            const unsigned tg = og / nx;
            if (og + 1u == (tg + 1u) * nx) xb_add(&bar[XB_TOPGEN], 1u);
            else XB_SPIN(xb_ld(&bar[XB_TOPGEN]) == tg, bar);
            __builtin_amdgcn_fence(__ATOMIC_ACQUIRE, "agent");
            xb_add(&bar[XB_XGEN(b.x)], 1u);
            asm volatile("s_waitcnt vmcnt(0)" ::: "memory");
        } else {
            XB_SPIN(xb_ld(&bar[XB_XGEN(b.x)]) == gen, bar);
            __builtin_amdgcn_fence(__ATOMIC_ACQUIRE, "agent");
            asm volatile("s_waitcnt vmcnt(0)" ::: "memory");
        }
    }
    __syncthreads();
}

namespace pg8 {
constexpr int BM = 256, BK = 64, HALF = 128, HTB = HALF * BK * 2;
__host__ __device__ __forceinline__ int lds_byte(int r, int c) { const int st = (r >> 4) * 2 + (c >> 5), rr = r & 15, cc = c & 31, ob = rr * 64 + cc * 2; return st * 1024 + (ob ^ (((ob >> 9) & 1) << 5)); }
__host__ __device__ __forceinline__ void stage_rc(int b, int& R, int& C) { const int st = b / 1024, sb = b % 1024, swz = sb ^ (((sb >> 9) & 1) << 5); R = (st >> 1) * 16 + swz / 64; C = (st & 1) * 32 + (swz % 64) / 2; }
__host__ __device__ __forceinline__ int perm32(int rho) { const int n = rho >> 4, i = rho & 15; return 8 * (i >> 2) + 4 * n + (i & 3); }

struct Unit { int pm, pn, e, cnt, kind; };

typedef int v8i __attribute__((ext_vector_type(8)));
typedef int v4i __attribute__((ext_vector_type(4)));
template <class Epi, class Sched, bool F8ALL = false>
__device__ __forceinline__ void gemm_phase(LAS unsigned char* lds, const Sched& S, const Epi& E) {
    int tid = threadIdx.x; asm volatile("" : "+v"(tid));
    const int wid = __builtin_amdgcn_readfirstlane(tid >> 6), lane = tid & 63, wr = wid >> 2, wc = wid & 3, fr = lane & 15, fq = lane >> 4;
#define PG8_RC() int RA[2], CA[2], RB[2]; { int tl_ = tid; asm volatile("" : "+v"(tl_)); _Pragma("unroll") for (int i = 0; i < 2; ++i) { int R, C; stage_rc(tl_ * 16 + i * 8192, R, C); RA[i] = R; CA[i] = C; RB[i] = Epi::PERM ? ((R & ~31) + perm32(R & 31)) : R; } }
    const size_t kstep = (size_t)(BK * 2);
    const unsigned ldsw = (unsigned)wid * 1024u;
    const int aoff = lds_byte(wr * 64 + fr, fq * 8), boff = lds_byte(wc * 32 + fr, fq * 8);
#define PG8_SA(b, h) (((b) * 2 + (h)) * HTB)
#define PG8_SB(b, h) ((4 + (b) * 2 + (h)) * HTB)
#define PG8_STAGE2(bufoff, gbase, o0, o1) do { \
        __builtin_amdgcn_global_load_lds((const unsigned*)((const char*)(gbase) + (o0)), (LAS unsigned*)(lds + (bufoff) + ldsw), 16, 0, 0); \
        __builtin_amdgcn_global_load_lds((const unsigned*)((const char*)(gbase) + (o1)), (LAS unsigned*)(lds + (bufoff) + ldsw + 8192), 16, 0, 0); } while (0)
#define PG8_LD8(p) __builtin_shufflevector(*(const LAS v4i*)(p), *(const LAS v4i*)((p) + 1024), 0, 1, 2, 3, 4, 5, 6, 7)
#define PG8_LDA(dst, b, h) do { _Pragma("unroll") for (int m = 0; m < 4; ++m) dst[m] = PG8_LD8(lds + PG8_SA(b, h) + aoff + m * 2048); } while (0)
#define PG8_LDB(dst, b, h) do { _Pragma("unroll") for (int n = 0; n < 2; ++n) dst[n] = PG8_LD8(lds + PG8_SB(b, h) + boff + n * 2048); } while (0)
#define PG8_LO(x) __builtin_bit_cast(bf16x8, __builtin_shufflevector(x, x, 0, 1, 2, 3))
#define PG8_HI(x) __builtin_bit_cast(bf16x8, __builtin_shufflevector(x, x, 4, 5, 6, 7))
#define PG8_MMA(ai, bj, At, Bt) do { __builtin_amdgcn_s_setprio(1); \
        if (F8ALL) { _Pragma("unroll") for (int m = 0; m < 4; ++m) _Pragma("unroll") for (int n = 0; n < 2; ++n) \
            asm volatile("v_mfma_scale_f32_16x16x128_f8f6f4 %0, %1, %2, %0, %3, %3 op_sel_hi:[0,0,0]" : "+v"(acc[ai][bj][m][n]) : "v"(Bt[n]), "v"(At[m]), "v"(f8sc)); } \
        else { _Pragma("unroll") for (int m = 0; m < 4; ++m) _Pragma("unroll") for (int n = 0; n < 2; ++n) { \
            acc[ai][bj][m][n] = __builtin_amdgcn_mfma_f32_16x16x32_bf16(PG8_LO(Bt[n]), PG8_LO(At[m]), acc[ai][bj][m][n], 0, 0, 0); \
            acc[ai][bj][m][n] = __builtin_amdgcn_mfma_f32_16x16x32_bf16(PG8_HI(Bt[n]), PG8_HI(At[m]), acc[ai][bj][m][n], 0, 0, 0); } } \
        __builtin_amdgcn_s_setprio(0); } while (0)
#define PG8_WAIT_V(n) asm volatile("s_waitcnt vmcnt(" #n ")" ::: "memory")
#define PG8_WAIT_L(n) asm volatile("s_waitcnt lgkmcnt(" #n ")" ::: "memory")
#define PG8_BAR __builtin_amdgcn_s_barrier()
#define PG8_SCHED __builtin_amdgcn_sched_barrier(0)
    Unit cur, nxt; int ui = 0;
    if (!S.next(0, cur)) return;
    f32x4 acc[2][2][4][2];
#pragma unroll
    for (int a = 0; a < 2; ++a)
#pragma unroll
        for (int b = 0; b < 2; ++b)
#pragma unroll
            for (int m = 0; m < 4; ++m)
#pragma unroll
                for (int n = 0; n < 2; ++n) acc[a][b][m][n] = (f32x4){0.f, 0.f, 0.f, 0.f};
    v8i At[4], B0[2], B1[2];
    int f8sc = 0x7c7c7c7c; asm volatile("" : "+v"(f8sc));
    int Kc = S.K(cur), Kn; const char* Ac = S.a_base(cur); const char* An; const char* cB = S.b_ptr(cur); const char* nB;
    unsigned oc00, oc01, oc10, oc11, on00, on01, on10, on11, vbc0, vbc1, vbn0, vbn1; size_t hsc, hsn;
    { PG8_RC()
    oc00 = S.a_off(cur, RA[0], CA[0]); oc01 = S.a_off(cur, RA[1], CA[1]); oc10 = S.a_off(cur, HALF + RA[0], CA[0]); oc11 = S.a_off(cur, HALF + RA[1], CA[1]);
    vbc0 = (unsigned)(RB[0] * Kc + CA[0]) * 2u; vbc1 = (unsigned)(RB[1] * Kc + CA[1]) * 2u; hsc = (size_t)HALF * Kc * 2; }
    S.a_ready(cur);
    PG8_STAGE2(PG8_SB(0, 0), cB, vbc0, vbc1); PG8_STAGE2(PG8_SB(0, 1), cB + hsc, vbc0, vbc1); PG8_STAGE2(PG8_SA(0, 0), Ac, oc00, oc01); PG8_STAGE2(PG8_SA(0, 1), Ac, oc10, oc11);
    if (wr == 1) PG8_BAR;
    PG8_WAIT_V(2); PG8_BAR;
    PG8_STAGE2(PG8_SB(1, 0), cB + kstep, vbc0, vbc1); PG8_STAGE2(PG8_SA(1, 0), Ac + kstep, oc00, oc01); PG8_STAGE2(PG8_SB(1, 1), cB + hsc + kstep, vbc0, vbc1);
    PG8_WAIT_V(6); PG8_BAR;
    for (;;) {
        const bool has_next = S.next(ui + 1, nxt);
        Kn = Kc; An = Ac; nB = cB; on00 = oc00; on01 = oc01; on10 = oc10; on11 = oc11; vbn0 = vbc0; vbn1 = vbc1; hsn = hsc;
        if (has_next) { Kn = S.K(nxt); An = S.a_base(nxt); nB = S.b_ptr(nxt); PG8_RC()
            on00 = S.a_off(nxt, RA[0], CA[0]); on01 = S.a_off(nxt, RA[1], CA[1]); on10 = S.a_off(nxt, HALF + RA[0], CA[0]); on11 = S.a_off(nxt, HALF + RA[1], CA[1]);
            vbn0 = (unsigned)(RB[0] * Kn + CA[0]) * 2u; vbn1 = (unsigned)(RB[1] * Kn + CA[1]) * 2u; hsn = (size_t)HALF * Kn * 2; }
        const int nt = Kc / BK;
#pragma clang loop unroll(disable)
        for (int t = 0; t < nt; t += 2) {
            const bool last = (t == nt - 2);
            if (last && has_next) S.a_ready(nxt);
            const char* a1 = Ac + (size_t)(t + 1) * kstep;
            const char* a2 = last ? An : Ac + (size_t)(t + 2) * kstep; const char* b2 = last ? nB : cB + (size_t)(t + 2) * kstep;
            const char* a3 = a2 + kstep; const char* b3 = b2 + kstep;
            const unsigned x00 = last ? on00 : oc00, x01 = last ? on01 : oc01, x10 = last ? on10 : oc10, x11 = last ? on11 : oc11;
            const unsigned y0 = last ? vbn0 : vbc0, y1 = last ? vbn1 : vbc1; const size_t hs2 = last ? hsn : hsc;
            PG8_LDB(B0, 0, 0); PG8_LDB(B1, 0, 1); PG8_SCHED; PG8_LDA(At, 0, 0); PG8_STAGE2(PG8_SA(1, 1), a1, oc10, oc11);
            PG8_WAIT_V(8); PG8_WAIT_L(0); PG8_BAR; PG8_MMA(0, 0, At, B0); PG8_MMA(0, 1, At, B1); PG8_BAR; PG8_SCHED;
            PG8_LDA(At, 0, 1); PG8_STAGE2(PG8_SB(0, 0), b2, y0, y1); PG8_STAGE2(PG8_SB(0, 1), b2 + hs2, y0, y1); PG8_STAGE2(PG8_SA(0, 0), a2, x00, x01);
            PG8_WAIT_V(8); PG8_WAIT_L(0); PG8_BAR; PG8_MMA(1, 0, At, B0); PG8_MMA(1, 1, At, B1); PG8_BAR; PG8_SCHED;
            PG8_LDB(B0, 1, 0); PG8_LDB(B1, 1, 1); PG8_SCHED; PG8_LDA(At, 1, 0); PG8_STAGE2(PG8_SA(0, 1), a2, x10, x11);
            PG8_WAIT_V(8); PG8_WAIT_L(0); PG8_BAR; PG8_MMA(0, 0, At, B0); PG8_MMA(0, 1, At, B1); PG8_BAR; PG8_SCHED;
            PG8_LDA(At, 1, 1); PG8_STAGE2(PG8_SB(1, 0), b3, y0, y1); PG8_STAGE2(PG8_SB(1, 1), b3 + hs2, y0, y1); PG8_STAGE2(PG8_SA(1, 0), a3, x00, x01);
            PG8_WAIT_V(8); PG8_WAIT_L(0); PG8_BAR; PG8_MMA(1, 0, At, B0); PG8_MMA(1, 1, At, B1); PG8_BAR; PG8_SCHED;
        }
        if (wr == 0) PG8_BAR;
        if (F8ALL) asm volatile("s_nop 15\n\ts_nop 15" ::: "memory");
        E(acc, cur, wr, wc, fr, fq);
        if (!has_next) break;
#pragma unroll
        for (int a = 0; a < 2; ++a)
#pragma unroll
            for (int b = 0; b < 2; ++b)
#pragma unroll
                for (int m = 0; m < 4; ++m)
#pragma unroll
                    for (int n = 0; n < 2; ++n) acc[a][b][m][n] = (f32x4){0.f, 0.f, 0.f, 0.f};
        cur = nxt; Kc = Kn; Ac = An; cB = nB; oc00 = on00; oc01 = on01; oc10 = on10; oc11 = on11; vbc0 = vbn0; vbc1 = vbn1; hsc = hsn; ++ui;
        if (wr == 1) PG8_BAR;
    }
    PG8_WAIT_V(0);
    PG8_BAR;
#undef PG8_RC
#undef PG8_SA
#undef PG8_SB
#undef PG8_STAGE2
#undef PG8_LDA
#undef PG8_LD8
#undef PG8_LO
#undef PG8_HI
#undef PG8_LDB
#undef PG8_MMA
#undef PG8_WAIT_V
#undef PG8_WAIT_L
#undef PG8_BAR
#undef PG8_SCHED
}
}

__device__ __forceinline__ void store16_wt(void* p, v4u v) { asm volatile("global_store_dwordx4 %0, %1, off sc1\n\ts_nop 1" :: "v"(p), "v"(v) : "memory"); }
__device__ __forceinline__ int krow_of(int r) {
    if (r < T) return (r >> 12) * KVROWS + LCTX + (r & 4095);
    const int rc = r - T; return (rc >> 8) * KVROWS + (rc & 255);
}
struct SchedPlain {
    int nM, nN, G, vcu, Kk; const char* A; const char* B;
    __device__ __forceinline__ bool next(int i, pg8::Unit& u) const { const int L = i * G + vcu; if (L >= nM * nN) return false; u.pm = L / nN; u.pn = L % nN; u.e = 0; u.cnt = 256; u.kind = 0; return true; }
    __device__ __forceinline__ int K(const pg8::Unit&) const { return Kk; }
    __device__ __forceinline__ const char* a_base(const pg8::Unit&) const { return A; }
    __device__ __forceinline__ unsigned a_off(const pg8::Unit& u, int row, int col) const { return (unsigned)((u.pm * 256 + row) * Kk + col) * 2u; }
    __device__ __forceinline__ const char* b_ptr(const pg8::Unit& u) const { return B + (size_t)u.pn * 256 * Kk * 2; }
    __device__ __forceinline__ void a_ready(const pg8::Unit&) const {}
};
struct EpiG1 {
    static constexpr bool PERM = true;
    bf16 *pu, *q, *kall, *vall, *z;
    __device__ __forceinline__ void operator()(const f32x4 (&acc)[2][2][4][2], const pg8::Unit& u, int wr, int wc, int fr, int fq) const {
        const int row0 = u.pm * 256 + wr * 64 + fr, c8 = wc * 32 + 8 * fq;
#pragma unroll
        for (int ai = 0; ai < 2; ++ai)
#pragma unroll
            for (int m = 0; m < 4; ++m) {
                const int row = row0 + ai * 128 + m * 16;
#pragma unroll
                for (int bj = 0; bj < 2; ++bj) {
                    const f32x4 v0 = acc[ai][bj][m][0], v1 = acc[ai][bj][m][1];
                    v4u w; w.x = pk2(v0[0], v0[1]); w.y = pk2(v0[2], v0[3]); w.z = pk2(v1[0], v1[1]); w.w = pk2(v1[2], v1[3]);
                    bf16* dst;
                    if (u.pn == 0) dst = pu + (size_t)row * 256 + bj * 128 + c8;
                    else if (u.pn <= 2) dst = q + (size_t)row * 512 + (u.pn - 1) * 256 + bj * 128 + c8;
                    else if (u.pn == 3) dst = (bj == 0 ? kall : vall) + (size_t)krow_of(row) * 128 + c8;
                    else dst = z + (size_t)row * 512 + (u.pn - 4) * 256 + bj * 128 + c8;
                    *(v4u*)dst = w;
                }
            }
    }
};
struct EpiG2 {
    static constexpr bool PERM = false;
    const float* xin; const float* cin; float* xout; float* cout; const float* mod; unsigned* ready;
    __device__ __forceinline__ void operator()(const f32x4 (&acc)[2][2][4][2], const pg8::Unit& u, int wr, int wc, int fr, int fq) const {
        const int rt0 = u.pm * 256; const bool isc = rt0 >= T;
        const int bsel = isc ? 4 : (rt0 >> 12);
        const float* g1 = mod + bsel * 6144 + 2048;
        const float* base = isc ? cin - (size_t)T * 1024 : xin; float* out = isc ? cout - (size_t)T * 1024 : xout;
        const int row0 = rt0 + wr * 64 + fr, col0 = u.pn * 256 + wc * 32 + 4 * fq;
#pragma unroll
        for (int bj = 0; bj < 2; ++bj)
#pragma unroll
            for (int n = 0; n < 2; ++n) {
                const int col = col0 + bj * 128 + n * 16; const f32x4 gv = *(const f32x4*)(g1 + col);
#pragma unroll
                for (int ai = 0; ai < 2; ++ai)
#pragma unroll
                    for (int m = 0; m < 4; ++m) { const size_t off = (size_t)(row0 + ai * 128 + m * 16) * 1024 + col; const f32x4 bs = *(const f32x4*)(base + off); const f32x4 o = bs + gv * acc[ai][bj][m][n]; store16_wt(out + off, __builtin_bit_cast(v4u, o)); }
            }
        asm volatile("s_waitcnt vmcnt(0)" ::: "memory");
        if ((threadIdx.x & 63) == 0) __hip_atomic_fetch_add(ready + 16 * u.pm, 1u, __ATOMIC_RELAXED, __HIP_MEMORY_SCOPE_AGENT);
    }
};
struct SchedMoe {
    int G, vcu, ntile;
    const char* hb; const char* actb; const char* wgu; const char* wd; const unsigned* list; const LAS int* tt; unsigned* ready; unsigned* tmo;
    __device__ __forceinline__ bool next(int i, pg8::Unit& u) const {
        const int U = ntile * 4; const int r = U % G, q = U / G; const int n3 = q + (vcu < r ? 1 : 0); int L;
        if (i < n3) { L = i * G + vcu; u.kind = 0; }
        else { const int j = i - n3; const int nl = G - r;
            if (vcu >= r) L = (j == 0) ? (vcu - r) : (j == 1) ? nl + (vcu - r) : 2 * nl + (j - 2) * G + vcu;
            else L = 2 * nl + j * G + vcu;
            if (L >= U) return false; u.kind = 1; }
        const int tau = L >> 2; u.pn = L & 3; u.pm = tau; int e = 0;
#pragma unroll
        for (int k = 1; k < 16; ++k) e += (tt[k] <= tau) ? 1 : 0;
        u.e = e; const int r0 = (tau - tt[e]) * 256; const int c = tt[17 + e] - r0; u.cnt = c < 256 ? c : 256; return true;
    }
    __device__ __forceinline__ int K(const pg8::Unit& u) const { return u.kind ? 256 : 512; }
    __device__ __forceinline__ const char* a_base(const pg8::Unit& u) const { return u.kind ? actb : hb; }
    __device__ __forceinline__ unsigned a_off(const pg8::Unit& u, int row, int col) const {
        if (u.kind) return (unsigned)((u.pm * 256 + row) * 256 + col) * 2u;
        const int r0 = (u.pm - tt[u.e]) * 256; const int rr = row < u.cnt ? row : u.cnt - 1;
        const unsigned tok = list[(size_t)u.e * TT + r0 + rr] >> 1;
        return (tok * 512u + (unsigned)col) * 2u;
    }
    __device__ __forceinline__ const char* b_ptr(const pg8::Unit& u) const { return u.kind ? wd + ((size_t)u.e * 1024 + (size_t)u.pn * 256) * 256 * 2 : wgu + ((size_t)u.e * 1024 + (size_t)u.pn * 256) * 512 * 2; }
    __device__ __forceinline__ void a_ready(const pg8::Unit& u) const {
        if (!u.kind) return;
        if (threadIdx.x < 64) {
            unsigned* w = ready + 16 * u.pm; unsigned sp = 0;
            while ((unsigned)__builtin_amdgcn_readfirstlane(__hip_atomic_load(w, __ATOMIC_RELAXED, __HIP_MEMORY_SCOPE_AGENT)) < 32u) {
                __builtin_amdgcn_s_sleep(2);
                if (++sp > (1u << 22)) { if (threadIdx.x == 0) __hip_atomic_store(tmo, 1u, __ATOMIC_RELAXED, __HIP_MEMORY_SCOPE_AGENT); break; } }
            __builtin_amdgcn_fence(__ATOMIC_ACQUIRE, "agent");
            asm volatile("s_waitcnt vmcnt(0)" ::: "memory");
        }
        asm volatile("" ::: "memory"); __builtin_amdgcn_s_barrier(); asm volatile("" ::: "memory");
    }
};
struct EpiG3 {
    static constexpr bool PERM = true;
    bf16* act; unsigned* ready;
    __device__ __forceinline__ void operator()(const f32x4 (&acc)[2][2][4][2], const pg8::Unit& u, int wr, int wc, int fr, int fq) const {
        const int row0 = u.pm * 256 + wr * 64 + fr, c8 = u.pn * 128 + wc * 32 + 8 * fq;
#pragma unroll
        for (int ai = 0; ai < 2; ++ai)
#pragma unroll
            for (int m = 0; m < 4; ++m) {
                float a[8];
#pragma unroll
                for (int n = 0; n < 2; ++n)
#pragma unroll
                    for (int k = 0; k < 4; ++k) { const float g = acc[ai][0][m][n][k], up = acc[ai][1][m][n][k]; a[n * 4 + k] = g / (1.f + __expf(-g)) * up; }
                const unsigned long long w8 = (unsigned long long)pk4_f8(a[0], a[1], a[2], a[3]) | ((unsigned long long)pk4_f8(a[4], a[5], a[6], a[7]) << 32);
                __hip_atomic_store((unsigned long long*)((unsigned char*)act + (size_t)(row0 + ai * 128 + m * 16) * 512 + c8), w8, __ATOMIC_RELAXED, __HIP_MEMORY_SCOPE_AGENT);
            }
        asm volatile("s_waitcnt vmcnt(0)" ::: "memory");
        if ((threadIdx.x & 63) == 0) __hip_atomic_fetch_add(ready + 16 * u.pm, 1u, __ATOMIC_RELAXED, __HIP_MEMORY_SCOPE_AGENT);
    }
};
struct EpiG4 {
    static constexpr bool PERM = true;
    bf16* y2; const unsigned* list; const float* wts; const LAS int* tt;
    __device__ __forceinline__ void operator()(const f32x4 (&acc)[2][2][4][2], const pg8::Unit& u, int wr, int wc, int fr, int fq) const {
        const int r0 = (u.pm - tt[u.e]) * 256; const int c8 = u.pn * 256 + wc * 32 + 8 * fq;
#pragma unroll
        for (int ai = 0; ai < 2; ++ai)
#pragma unroll
            for (int m = 0; m < 4; ++m) {
                const int row = wr * 64 + fr + ai * 128 + m * 16;
                if (row < u.cnt) {
                    const unsigned ent = list[(size_t)u.e * TT + r0 + row]; const float w = wts[ent];
#pragma unroll
                    for (int bj = 0; bj < 2; ++bj) {
                        const f32x4 v0 = acc[ai][bj][m][0] * w, v1 = acc[ai][bj][m][1] * w;
                        v4u o; o.x = pk2(v0[0], v0[1]); o.y = pk2(v0[2], v0[3]); o.z = pk2(v1[0], v1[1]); o.w = pk2(v1[2], v1[3]);
                        *(v4u*)(y2 + (size_t)ent * 1024 + bj * 128 + c8) = o;
                    }
                }
            }
    }
};

struct EpiMoe { static constexpr bool PERM = true; EpiG3 e3; EpiG4 e4;
    __device__ __forceinline__ void operator()(const f32x4 (&acc)[2][2][4][2], const pg8::Unit& u, int wr, int wc, int fr, int fq) const { if (u.kind) e4(acc, u, wr, wc, fr, fq); else e3(acc, u, wr, wc, fr, fq); } };

#include <hip/hip_bf16.h>
#include <cmath>
namespace attn_body {
using bf16=__hip_bfloat16;
using bf16x8=__attribute__((ext_vector_type(8)))short;
using s16x4=__attribute__((ext_vector_type(4)))short;
using f32x16=__attribute__((ext_vector_type(16)))float;
using u32x4=__attribute__((ext_vector_type(4)))unsigned;
constexpr int D=64,QP=512,KVP=128,OP=1024;
constexpr int NW=8,QBLK=32,KVBLK=64;
__device__ __forceinline__ int crow(int r,int hi){return (r&3)+8*(r>>2)+4*hi;}
#define SBAR() __builtin_amdgcn_sched_barrier(0)
__device__ __forceinline__ void wmask(f32x16&p0,f32x16&p1,int kp0,int qpos,int hi){
  const float NEG=-INFINITY; const bool tile_ok=(unsigned)kp0<4096u; const int base=kp0+4*hi-qpos+128;
  #pragma unroll
  for(int r=0;r<16;++r){const int dd=base+(r&3)+8*(r>>2); if(!tile_ok||(unsigned)dd>256u)p0[r]=NEG; if(!tile_ok||(unsigned)(dd+32)>256u)p1[r]=NEG;}
}
constexpr int NSLOT=3, SLOTB=8192;
constexpr int LDS_K=0, LDS_V=NSLOT*SLOTB, LDS_WS=2*NSLOT*SLOTB, LDS_OST=LDS_WS+NW*64*4, LDS_BYTES=LDS_OST+NW*4096;
constexpr float C2=0.125f*1.4426950408889634f;
__device__ __forceinline__ void glds16(const void*gsrc,unsigned lds_dst){unsigned keep;
  asm volatile("s_mov_b32 %0, m0\n\ts_mov_b32 m0, %2\n\ts_nop 0\n\tglobal_load_lds_dwordx4 %1, off\n\ts_mov_b32 m0, %0":"=&s"(keep):"v"(gsrc),"s"(lds_dst):"memory");}
__device__ __forceinline__ float max3f(float a,float b,float c){float r;asm("v_max3_f32 %0, %1, %2, %3":"=v"(r):"v"(a),"v"(b),"v"(c));return r;}
__device__ __forceinline__ float max2f(float a,float b){float r;asm("v_max_f32_e32 %0, %1, %2":"=v"(r):"v"(a),"v"(b));return r;}
__device__ __forceinline__ float fadd_s(float a,float b){float r;asm("v_add_f32_e32 %0, %1, %2":"=v"(r):"v"(a),"v"(b));return r;}
__device__ __forceinline__ float fsub_s(float a,float b){float r;asm("v_sub_f32_e32 %0, %1, %2":"=v"(r):"v"(a),"v"(b));return r;}
typedef float f32x2_t __attribute__((ext_vector_type(2))); typedef __bf16 bf16x2_t __attribute__((ext_vector_type(2)));
__device__ __forceinline__ unsigned cvtpk_s(float lo,float hi){f32x2_t v={lo,hi};bf16x2_t b=__builtin_convertvector(v,bf16x2_t);return __builtin_bit_cast(unsigned,b);}
#define WAIT_BAR(N) asm volatile("s_waitcnt vmcnt(" #N ") lgkmcnt(0)\n\ts_barrier":::"memory")

__device__ __forceinline__ void qkt(f32x16&p0,f32x16&p1,const char*Kslot,const bf16x8*qr,const f32x16&negm,int r32,int hi){
  const char*kb=Kslot+hi*1024+r32*16;
  #pragma unroll
  for(int d0=0;d0<4;++d0){
    const bf16x8 b0=*reinterpret_cast<const bf16x8*>(kb+d0*2048);
    const bf16x8 b1=*reinterpret_cast<const bf16x8*>(kb+d0*2048+512);
    if(d0==0){p0=__builtin_amdgcn_mfma_f32_32x32x16_bf16(b0,qr[0],negm,0,0,0);p1=__builtin_amdgcn_mfma_f32_32x32x16_bf16(b1,qr[0],negm,0,0,0);}
    else{p0=__builtin_amdgcn_mfma_f32_32x32x16_bf16(b0,qr[d0],p0,0,0,0);p1=__builtin_amdgcn_mfma_f32_32x32x16_bf16(b1,qr[d0],p1,0,0,0);}}
}
typedef __attribute__((address_space(3))) const char* lds_cptr;
typedef short v4i16_t __attribute__((ext_vector_type(4)));
__device__ __forceinline__ void kload8(bf16x8*kf,lds_cptr kp){
  kf[0]=*(const __attribute__((address_space(3))) bf16x8*)(kp);      kf[1]=*(const __attribute__((address_space(3))) bf16x8*)(kp+512);
  kf[2]=*(const __attribute__((address_space(3))) bf16x8*)(kp+2048); kf[3]=*(const __attribute__((address_space(3))) bf16x8*)(kp+2560);
  kf[4]=*(const __attribute__((address_space(3))) bf16x8*)(kp+4096); kf[5]=*(const __attribute__((address_space(3))) bf16x8*)(kp+4608);
  kf[6]=*(const __attribute__((address_space(3))) bf16x8*)(kp+6144); kf[7]=*(const __attribute__((address_space(3))) bf16x8*)(kp+6656);
}
__device__ __forceinline__ void kload2(bf16x8*kf,lds_cptr kp,int j){ kf[2*j]=*(const __attribute__((address_space(3))) bf16x8*)(kp+j*2048); kf[2*j+1]=*(const __attribute__((address_space(3))) bf16x8*)(kp+j*2048+512); }
__device__ __forceinline__ s16x4 vtr(lds_cptr p){ return __builtin_bit_cast(s16x4,__builtin_amdgcn_ds_read_tr16_b64_v4i16((__attribute__((address_space(3))) v4i16_t*)p)); }
__device__ __forceinline__ float rowmax(const f32x16&p0,const f32x16&p1){
  float a=max3f(p0[0],p0[1],p1[0]),b=max3f(p0[2],p0[3],p1[1]);a=max3f(a,p1[2],p1[3]);
  #pragma unroll
  for(int r=4;r<16;r+=4){a=max3f(a,p0[r],p0[r+1]);b=max3f(b,p0[r+2],p0[r+3]);a=max3f(a,p1[r],p1[r+1]);b=max3f(b,p1[r+2],p1[r+3]);}
  const float m=max2f(a,b);
  auto rr=__builtin_amdgcn_permlane32_swap(__float_as_uint(m),__float_as_uint(m),false,false);
  return max2f(__uint_as_float(rr[0]),__uint_as_float(rr[1]));
}
__device__ __forceinline__ void pv(f32x16*o,int vb,bf16x8 pa0,bf16x8 pa1,bf16x8 pa2,bf16x8 pa3){
  #pragma unroll
  for(int d0=0;d0<2;++d0){s16x4 lo[4],hi[4];
    #pragma unroll
    for(int ks=0;ks<4;++ks){
      asm volatile("ds_read_b64_tr_b16 %0,%1 offset:%c2":"=&v"(lo[ks]):"v"(vb),"i"(d0*4096+ks*1024):"memory");
      asm volatile("ds_read_b64_tr_b16 %0,%1 offset:%c2":"=&v"(hi[ks]):"v"(vb),"i"(d0*4096+ks*1024+512):"memory");}
    asm volatile("s_waitcnt lgkmcnt(0)":::"memory");SBAR();
    #define PK(k) (bf16x8){lo[k][0],lo[k][1],lo[k][2],lo[k][3],hi[k][0],hi[k][1],hi[k][2],hi[k][3]}
    o[d0]=__builtin_amdgcn_mfma_f32_32x32x16_bf16(pa0,PK(0),o[d0],0,0,0);
    o[d0]=__builtin_amdgcn_mfma_f32_32x32x16_bf16(pa1,PK(1),o[d0],0,0,0);
    o[d0]=__builtin_amdgcn_mfma_f32_32x32x16_bf16(pa2,PK(2),o[d0],0,0,0);
    o[d0]=__builtin_amdgcn_mfma_f32_32x32x16_bf16(pa3,PK(3),o[d0],0,0,0);
    #undef PK
  }
}

#ifndef ATTN_STORE16
#define ATTN_STORE16(p,v) (*(u32x4*)(p)=(v))
#endif
template<int THRL> __device__ __forceinline__ void attn_unit(const bf16*Qu,const bf16*__restrict__ Kh,const bf16*__restrict__ Vh,bf16*Ou,const int p0,const int NT,const float* sinkp,const float* qg,const float2* ropet,char*shm){
  int tid=threadIdx.x; asm volatile("":"+v"(tid)); const int lane=tid&63,r32=lane&31,hi=lane>>5; const int wid=__builtin_amdgcn_readfirstlane(tid>>6);
  const int hsub=wid>>1, psub=(wid&1)*QBLK;
  const bf16*Qw=Qu+(long)psub*QP+hsub*D;
  const unsigned lds0=(unsigned)(uintptr_t)shm;
  float*wsf=(float*)(shm+LDS_WS)+wid*64;
  const bf16*ksrc=Kh+(long)lane*KVP+wid*8;
  const bf16*vsrc=Vh+(long)(16*(wid&3)+(lane>>2))*KVP+(wid>>2)*32+(lane&3)*8;
  const unsigned kdst=lds0+LDS_K+wid*1024, vdst=lds0+LDS_V+wid*1024;
  #define KP0(t) (p0-128+64*((t)-4))
  #define TROW(t) ((t)<4?64*(t):(((unsigned)KP0(t)<4096u)?256+KP0(t):256))
  #define DMA_K(t,slot) glds16(ksrc+(long)TROW(t)*KVP,(unsigned)__builtin_amdgcn_readfirstlane(kdst+(slot)))
  #define DMA_V(t,slot) glds16(vsrc+(long)TROW(t)*KVP,(unsigned)__builtin_amdgcn_readfirstlane(vdst+(slot)))
  const int vb0=(int)(lds0+LDS_V)+((lane>>4)&1)*32+(lane&3)*8+(4*hi+((lane&15)>>2))*64;
  const char*Kbase=shm+LDS_K; bf16x8 kf[8];
  const lds_cptr shm3=(lds_cptr)shm; const lds_cptr kp0=shm3+LDS_K+hi*1024+r32*16; const lds_cptr vp0=shm3+LDS_V+((lane>>4)&1)*32+(lane&3)*8+(4*hi+((lane&15)>>2))*64;
  DMA_K(0,0);DMA_V(0,0);DMA_K(1,SLOTB);
  bf16x8 qr[4];
  { bf16x8 qraw[4];
    #pragma unroll
    for(int d0=0;d0<4;++d0)qraw[d0]=*reinterpret_cast<const bf16x8*>(&Qw[(long)r32*QP+d0*16+hi*8]);
    float qf[4][8]; float ss=0.f;
    #pragma unroll
    for(int d0=0;d0<4;++d0)
      #pragma unroll
      for(int j=0;j<8;++j){ qf[d0][j]=__builtin_bit_cast(float,(unsigned)(unsigned short)qraw[d0][j]<<16); ss+=qf[d0][j]*qf[d0][j]; }
    ss+=__shfl_xor(ss,32);
    const float rstd=1.0f/sqrtf(ss*(1.f/64.f)+1e-6f)*C2;
    #pragma unroll
    for(int d0=0;d0<4;++d0)
      #pragma unroll
      for(int j=0;j<8;++j) qf[d0][j]*=rstd*qg[16*d0+8*hi+j];
    if(ropet){ const float2* rp=ropet+(long)(p0+psub+r32)*32+8*hi;
      #pragma unroll
      for(int j=0;j<8;++j){ const float2 c1=rp[j],c2=rp[16+j];
        const float a=qf[0][j],b=qf[1][j],c=qf[2][j],d=qf[3][j];
        qf[0][j]=a*c1.x-b*c1.y; qf[1][j]=b*c1.x+a*c1.y; qf[2][j]=c*c2.x-d*c2.y; qf[3][j]=d*c2.x+c*c2.y; } }
    #pragma unroll
    for(int d0=0;d0<4;++d0){ u32x4 w; w[0]=cvtpk_s(qf[d0][0],qf[d0][1]); w[1]=cvtpk_s(qf[d0][2],qf[d0][3]); w[2]=cvtpk_s(qf[d0][4],qf[d0][5]); w[3]=cvtpk_s(qf[d0][6],qf[d0][7]); qr[d0]=__builtin_bit_cast(bf16x8,w); } }
  float mhat=0.f,l_reg=0.f;f32x16 o[2];o[0]=f32x16{};o[1]=f32x16{};f32x16 negm=f32x16{};asm volatile("":"+v"(negm));
  const int qpos=p0+psub+r32;
  #define CMASK(P0,P1,t) do{ if((t)>=4)wmask(P0,P1,KP0(t),qpos,hi); }while(0)
  bool resc=false;
  #define START(P0,P1) do{ const float rm=rowmax(P0,P1); resc=false; \
    { const float dl=rm; mhat=fadd_s(mhat,dl); \
      _Pragma("unroll") for(int r=0;r<16;++r){P0[r]=fsub_s(P0[r],dl);P1[r]=fsub_s(P1[r],dl);} \
      _Pragma("unroll") for(int r=0;r<16;++r)negm[r]=-mhat; asm volatile("":"+v"(negm)); } \
    _Pragma("unroll") for(int r=0;r<16;++r)P0[r]=__builtin_amdgcn_exp2f(P0[r]); }while(0)
  #define RESC() do{ if(resc){ asm volatile("s_waitcnt lgkmcnt(0)":::"memory"); \
      _Pragma("unroll") for(int d_=0;d_<2;++d_) _Pragma("unroll") for(int r=0;r<16;++r)o[d_][r]*=wsf[crow(r,hi)]; } }while(0)
  f32x16 pA0,pA1,pB0,pB1;
  int sl_prev=0,sl_cur=0,sl_next=SLOTB;
  #define ROT() do{sl_prev=sl_cur;sl_cur=sl_next;sl_next=(sl_next==(NSLOT-1)*SLOTB)?0:sl_next+SLOTB;}while(0)
  DMA_K(2,2*SLOTB);
  WAIT_BAR(3);
  qkt(pA0,pA1,Kbase,qr,negm,r32,hi);asm volatile("s_nop 15\n\ts_nop 7":"+v"(pA0),"+v"(pA1));CMASK(pA0,pA1,0);
  START(pA0,pA1);
  _Pragma("unroll") for(int r=0;r<16;++r)pA1[r]=__builtin_amdgcn_exp2f(pA1[r]);
  WAIT_BAR(0);
  DMA_K(3,0);DMA_V(1,SLOTB);
  ROT();
  kload8(kf,kp0+sl_cur);
  WAIT_BAR(2);
  s16x4 vlo[8],vhi[8]; u32x4 pw0,pw1,pw2,pw3;
  #define PKW(P,B) cvtpk_s(P[B],P[B+1])
  #define PAF(k) __builtin_bit_cast(bf16x8,pw##k)
  #define VFR(i) (bf16x8){vlo[i][0],vlo[i][1],vlo[i][2],vlo[i][3],vhi[i][0],vhi[i][1],vhi[i][2],vhi[i][3]}
  #define PIN(x) asm volatile("":"+v"(x))
  #define MX3(a,b,c) __builtin_fmaxf(__builtin_fmaxf((a),(b)),(c))
  #define GAPA(MF,A0,A1,A2,A3,W0,W1,PW) do{ MF; sacc+=A0; sacc+=A1; sacc+=A2; sacc+=A3; PIN(sacc); W0; W1; PIN(PW); SBAR(); }while(0)
  #define EX(v) __builtin_amdgcn_exp2f(v)
  #define GAPB(MF,X,B) do{ MF; X[B]=EX(X[B]); X[B+1]=EX(X[B+1]); X[B+2]=EX(X[B+2]); X[B+3]=EX(X[B+3]); PIN(X); SBAR(); }while(0)
  #define VRD(i) do{ vlo[i]=vtr(vp_+(((i)>>2)*4096+((i)&3)*1024)); vhi[i]=vtr(vp_+(((i)>>2)*4096+((i)&3)*1024+512)); }while(0)
  #define KRD(G,j) do{ if(G){ kload2(kf,kp0+sl_next,j); SBAR(); } }while(0)
  #define STEP(C0,C1,P0,P1,t,GK,GV,GL) do{ SBAR(); \
    const lds_cptr vp_=vp0+sl_prev; \
    VRD(0); SBAR(); float sacc=(P0[0]+P0[1]); \
    GAPA(C0=__builtin_amdgcn_mfma_f32_32x32x16_bf16(kf[0],qr[0],negm,0,0,0), P0[2],P0[3],P0[4],P0[5],     pw0[0]=PKW(P0,0), pw0[1]=PKW(P0,2), pw0); \
    VRD(4); SBAR(); GAPA(C1=__builtin_amdgcn_mfma_f32_32x32x16_bf16(kf[1],qr[0],negm,0,0,0), P0[6],P0[7],P0[8],P0[9],     pw0[2]=PKW(P0,4), pw0[3]=PKW(P0,6), pw0); \
    VRD(1); SBAR(); GAPA(C0=__builtin_amdgcn_mfma_f32_32x32x16_bf16(kf[2],qr[1],C0,0,0,0),   P0[10],P0[11],P0[12],P0[13], pw1[0]=PKW(P0,8), pw1[1]=PKW(P0,10), pw1); \
    VRD(5); SBAR(); GAPA(C1=__builtin_amdgcn_mfma_f32_32x32x16_bf16(kf[3],qr[1],C1,0,0,0),   P0[14],P0[15],P1[0],P1[1],   pw1[2]=PKW(P0,12),pw1[3]=PKW(P0,14), pw1); \
    VRD(2); SBAR(); GAPA(C0=__builtin_amdgcn_mfma_f32_32x32x16_bf16(kf[4],qr[2],C0,0,0,0),   P1[2],P1[3],P1[4],P1[5],     pw2[0]=PKW(P1,0), pw2[1]=PKW(P1,2), pw2); \
    VRD(6); SBAR(); GAPA(C1=__builtin_amdgcn_mfma_f32_32x32x16_bf16(kf[5],qr[2],C1,0,0,0),   P1[6],P1[7],P1[8],P1[9],     pw2[2]=PKW(P1,4), pw2[3]=PKW(P1,6), pw2); \
    VRD(3); SBAR(); GAPA(C0=__builtin_amdgcn_mfma_f32_32x32x16_bf16(kf[6],qr[3],C0,0,0,0),   P1[10],P1[11],P1[12],P1[13], pw3[0]=PKW(P1,8), pw3[1]=PKW(P1,10), pw3); \
    VRD(7); SBAR(); GAPA(C1=__builtin_amdgcn_mfma_f32_32x32x16_bf16(kf[7],qr[3],C1,0,0,0),   P1[14],P1[15],0.f,0.f,       pw3[2]=PKW(P1,12),pw3[3]=PKW(P1,14), pw3); \
    l_reg+=sacc; \
    if(GK){DMA_K((t)+3,sl_cur);} if(GV){DMA_V((t)+1,sl_next);} \
    CMASK(C0,C1,t); \
    { float a=MX3(C0[0],C0[1],C1[0]),b=MX3(C0[2],C0[3],C1[1]); a=MX3(a,C1[2],C1[3]); \
      _Pragma("unroll") for(int r=4;r<16;r+=4){a=MX3(a,C0[r],C0[r+1]);b=MX3(b,C0[r+2],C0[r+3]);a=MX3(a,C1[r],C1[r+1]);b=MX3(b,C1[r+2],C1[r+3]);} \
      float rm=__builtin_fmaxf(a,b); { auto rr=__builtin_amdgcn_permlane32_swap(__float_as_uint(rm),__float_as_uint(rm),false,false); rm=__builtin_fmaxf(__uint_as_float(rr[0]),__uint_as_float(rr[1])); } \
      resc=false; \
      if(__builtin_expect(__any(rm>(float)THRL),0)){ const float dl=__builtin_fmaxf(rm,0.f); mhat+=dl; \
        _Pragma("unroll") for(int r=0;r<16;++r){C0[r]-=dl;C1[r]-=dl;} \
        _Pragma("unroll") for(int r=0;r<16;++r)negm[r]=-mhat; asm volatile("":"+v"(negm)); \
        const float f=__builtin_amdgcn_exp2f(-dl); l_reg*=f; if(hi==0)wsf[r32]=f; resc=true; } } \
    SBAR(); \
    GAPB(o[0]=__builtin_amdgcn_mfma_f32_32x32x16_bf16(PAF(0),VFR(0),o[0],0,0,0), C0,0); \
    GAPB(o[1]=__builtin_amdgcn_mfma_f32_32x32x16_bf16(PAF(0),VFR(4),o[1],0,0,0), C0,4); \
    KRD(GL,0); GAPB(o[0]=__builtin_amdgcn_mfma_f32_32x32x16_bf16(PAF(1),VFR(1),o[0],0,0,0), C0,8); \
    KRD(GL,1); GAPB(o[1]=__builtin_amdgcn_mfma_f32_32x32x16_bf16(PAF(1),VFR(5),o[1],0,0,0), C0,12); \
    KRD(GL,2); GAPB(o[0]=__builtin_amdgcn_mfma_f32_32x32x16_bf16(PAF(2),VFR(2),o[0],0,0,0), C1,0); \
    KRD(GL,3); GAPB(o[1]=__builtin_amdgcn_mfma_f32_32x32x16_bf16(PAF(2),VFR(6),o[1],0,0,0), C1,4); \
    GAPB(o[0]=__builtin_amdgcn_mfma_f32_32x32x16_bf16(PAF(3),VFR(3),o[0],0,0,0), C1,8); \
    GAPB(o[1]=__builtin_amdgcn_mfma_f32_32x32x16_bf16(PAF(3),VFR(7),o[1],0,0,0), C1,12); \
    }while(0)
  int t=1;
  for(;t+5<NT;t+=2){
    STEP(pB0,pB1,pA0,pA1,t,true,true,true);     WAIT_BAR(2); RESC(); ROT();
    STEP(pA0,pA1,pB0,pB1,t+1,true,true,true);   WAIT_BAR(2); RESC(); ROT();
  }
  #define ENDW(tt) do{ if((tt)+3<NT){WAIT_BAR(2);} else if((tt)+2<NT){WAIT_BAR(1);} else {WAIT_BAR(0);} }while(0)
  for(;t+1<NT;t+=2){
    STEP(pB0,pB1,pA0,pA1,t,(t+3<NT),(t+1<NT),(t+1<NT));       ENDW(t);   RESC(); ROT();
    STEP(pA0,pA1,pB0,pB1,t+1,(t+4<NT),(t+2<NT),(t+2<NT));     ENDW(t+1); RESC(); ROT();
  }
  STEP(pB0,pB1,pA0,pA1,NT-1,false,false,false); RESC();
  { float sacc=pB0[0]+pB0[1]; _Pragma("unroll") for(int r=2;r<16;++r)sacc+=pB0[r]; _Pragma("unroll") for(int r=0;r<16;++r)sacc+=pB1[r]; l_reg+=sacc;
    pw0=(u32x4){PKW(pB0,0),PKW(pB0,2),PKW(pB0,4),PKW(pB0,6)};pw1=(u32x4){PKW(pB0,8),PKW(pB0,10),PKW(pB0,12),PKW(pB0,14)};pw2=(u32x4){PKW(pB1,0),PKW(pB1,2),PKW(pB1,4),PKW(pB1,6)};pw3=(u32x4){PKW(pB1,8),PKW(pB1,10),PKW(pB1,12),PKW(pB1,14)};
    SBAR(); pv(o,vb0+sl_cur,PAF(0),PAF(1),PAF(2),PAF(3)); }
  #undef PKW
  #undef PAF
  #undef VFR
  #undef PIN
  #undef MX3
  #undef GAPA
  #undef GAPB
  #undef EX
  #undef VRD
  #undef KRD
  #undef STEP
  #undef ENDW
  l_reg+=__shfl_xor(l_reg,32);
  l_reg+=__builtin_amdgcn_exp2f(sinkp[hsub]*1.4426950408889634f-mhat);
  if(hi==0)wsf[32+r32]=l_reg;asm volatile("s_waitcnt lgkmcnt(0)":::"memory");
  float rli[16];
  #pragma unroll
  for(int r=0;r<16;++r)rli[r]=__builtin_amdgcn_rcpf(wsf[32+crow(r,hi)]);
  bf16*Ow=Ou+(long)psub*OP+hsub*D;
  { bf16*stg=(bf16*)(shm+LDS_OST)+wid*2048;
    #pragma unroll
    for(int r=0;r<16;++r){const int orow=crow(r,hi);
      #pragma unroll
      for(int d0=0;d0<2;++d0)stg[orow*64+d0*32+r32]=__float2bfloat16(o[d0][r]*rli[r]);}
    asm volatile("s_waitcnt lgkmcnt(0)":::"memory");
    #pragma unroll
    for(int i=0;i<4;++i){const int row=i*8+(lane>>3),ch=lane&7; const u32x4 v=*(const u32x4*)(stg+row*64+ch*8); ATTN_STORE16(Ow+(long)row*OP+ch*8,v);} }
  asm volatile("s_waitcnt lgkmcnt(0)\n\ts_barrier":::"memory");
  #undef DMA_K
  #undef DMA_V
  #undef KP0
  #undef TROW
  #undef CMASK
  #undef START
  #undef RESC
  #undef ROT
}
constexpr int ATTN_LDS_BYTES=LDS_BYTES;
#undef SBAR
#undef WAIT_BAR
}

constexpr int SLAB_PITCH = 288;
typedef short v4i16_t __attribute__((ext_vector_type(4)));
template <int MT, class RowAddr, class Epi>
__device__ __forceinline__ void slab_gemm(LAS unsigned char* lds, const bf16* Cmat, const int K, const RowAddr& RA, const Epi& E) {
    int tid = threadIdx.x; asm volatile("" : "+v"(tid));
    const int wid = tid >> 6, lane = tid & 63;
    LAS bf16* Dr = (LAS bf16*)lds;
    f32x16 acc[MT];
#pragma unroll
    for (int i = 0; i < MT; ++i)
#pragma unroll
        for (int r = 0; r < 16; ++r) acc[i][r] = 0.f;
    const int g = (lane >> 4) & 1, h = lane >> 5, qq = (lane & 15) >> 2, pp = lane & 3;
    const LAS bf16* trp = Dr + (8 * h + qq) * SLAB_PITCH + wid * 32 + 16 * g + 4 * pp;
    for (int kc = 0; kc < K; kc += 128) {
        {
            const int k = tid >> 2, qd = tid & 3;
            const bf16* src = RA(kc + k) + qd * 64;
            v4u v[8];
#pragma unroll
            for (int j = 0; j < 8; ++j) v[j] = *(const v4u*)(src + j * 8);
#pragma unroll
            for (int j = 0; j < 8; ++j) *(LAS v4u*)(Dr + k * SLAB_PITCH + qd * 64 + j * 8) = v[j];
        }
        __syncthreads();
        const int kh = h * 8;
#pragma unroll
        for (int s = 0; s < 8; ++s) {
            const v4i16_t b0 = __builtin_amdgcn_ds_read_tr16_b64_v4i16((LAS v4i16_t*)(trp + (16 * s) * SLAB_PITCH));
            const v4i16_t b1 = __builtin_amdgcn_ds_read_tr16_b64_v4i16((LAS v4i16_t*)(trp + (16 * s + 4) * SLAB_PITCH));
            const bf16x8 bfrag = (bf16x8){b0[0], b0[1], b0[2], b0[3], b1[0], b1[1], b1[2], b1[3]};
#pragma unroll
            for (int mt = 0; mt < MT; ++mt) {
                const bf16x8 afrag = *(const bf16x8*)(Cmat + (size_t)(mt * 32 + (lane & 31)) * K + kc + s * 16 + kh);
                acc[mt] = __builtin_amdgcn_mfma_f32_32x32x16_bf16(afrag, bfrag, acc[mt], 0, 0, 0);
            }
        }
        __syncthreads();
    }
    E(acc, wid, lane, lds);
}

struct Args { const float* in[23]; float* out; unsigned char* ws; int ph_lo, ph_hi; };

constexpr int SOUT_PITCH = 264;
template <int NROWS, bool WT, class RowPtr>
__device__ __forceinline__ void slab_store_rows(LAS unsigned char* lds, const RowPtr& RP) {
    int tid = threadIdx.x; asm volatile("" : "+v"(tid));
    __syncthreads();
#pragma unroll
    for (int k = 0; k < NROWS / 16; ++k) { const int row = (tid >> 5) + 16 * k, chunk = tid & 31;
        const v4u v = *(const LAS v4u*)((LAS bf16*)lds + row * SOUT_PITCH + chunk * 8);
        bf16* dst = RP(row) + chunk * 8;
        if (WT) store16_wt(dst, v); else *(v4u*)dst = v; }
    __syncthreads();
}
struct RowA { const bf16* z; int b, n2; __device__ __forceinline__ const bf16* operator()(int k) const { return z + (size_t)(b * 4096 + 64 * (k & 63) + n2) * 512 + (k >> 6) * 256; } };
struct RowPA { bf16* t2; int b, n2; __device__ __forceinline__ bf16* operator()(int m) const { return t2 + ((size_t)((b * 64 + n2) * 64 + (m & 63)) * 2 + (m >> 6)) * 256; } };
template <bool WT> struct EpiA { bf16* t2; const float2* tw; int b, n2;
    __device__ __forceinline__ void operator()(const f32x16 (&acc)[4], int wid, int lane, LAS unsigned char* lds) const {
        const int ch = wid * 32 + (lane & 31); LAS bf16* so = (LAS bf16*)lds;
#pragma unroll
        for (int mt = 0; mt < 2; ++mt)
#pragma unroll
            for (int r = 0; r < 16; ++r) {
                const int k1 = 32 * mt + (r & 3) + 8 * (r >> 2) + 4 * (lane >> 5);
                const float2 cs = tw[n2 * k1]; const float re = acc[mt][r], im = acc[mt + 2][r];
                const float re2 = cs.x * re + cs.y * im, im2 = cs.x * im - cs.y * re;
                so[k1 * SOUT_PITCH + ch] = (bf16)f2bf(re2); so[(64 + k1) * SOUT_PITCH + ch] = (bf16)f2bf(im2);
            }
        RowPA rp{t2, b, n2}; slab_store_rows<128, WT, RowPA>(lds, rp);
    } };
struct RowB { const bf16* t2; int b, k1; __device__ __forceinline__ const bf16* operator()(int k) const { return t2 + ((size_t)((b * 64 + (k & 63)) * 64 + k1) * 2 + (k >> 6)) * 256; } };
struct RowPB { bf16* mrg; int b, k1; __device__ __forceinline__ bf16* operator()(int k2) const { return mrg + (size_t)(b * 4096 + k1 + 64 * k2) * 1024 + 768; } };
struct EpiB { bf16* mrg; int b, k1;
    __device__ __forceinline__ void operator()(const f32x16 (&acc)[2], int wid, int lane, LAS unsigned char* lds) const {
        const int ch = wid * 32 + (lane & 31); LAS bf16* so = (LAS bf16*)lds;
#pragma unroll
        for (int mt = 0; mt < 2; ++mt)
#pragma unroll
            for (int r = 0; r < 16; ++r) { const int k2 = 32 * mt + (r & 3) + 8 * (r >> 2) + 4 * (lane >> 5); so[k2 * SOUT_PITCH + ch] = (bf16)f2bf(DBG_NO_FOUR ? 0.f : acc[mt][r]); }
        RowPB rp{mrg, b, k1}; slab_store_rows<64, false, RowPB>(lds, rp);
    } };
struct RowC { const bf16* z; int b; __device__ __forceinline__ const bf16* operator()(int k) const { return z + (size_t)(T + b * 256 + (k & 255)) * 512 + (k >> 8) * 256; } };
struct RowPC { bf16* mrg; int b, mt0; __device__ __forceinline__ bf16* operator()(int kk) const { return mrg + (size_t)(T + b * 256 + 32 * mt0 + kk) * 1024 + 768; } };
struct EpiC { bf16* mrg; int b, mt0;
    __device__ __forceinline__ void operator()(const f32x16 (&acc)[1], int wid, int lane, LAS unsigned char* lds) const {
        const int ch = wid * 32 + (lane & 31); LAS bf16* so = (LAS bf16*)lds;
#pragma unroll
        for (int r = 0; r < 16; ++r) { const int kk = (r & 3) + 8 * (r >> 2) + 4 * (lane >> 5); so[kk * SOUT_PITCH + ch] = (bf16)f2bf(DBG_NO_FOUR ? 0.f : acc[0][r]); }
        RowPC rp{mrg, b, mt0}; slab_store_rows<32, false, RowPC>(lds, rp);
    } };

__device__ __forceinline__ void tr_block(const float* src, int ldS, bf16* dst, int ldD, LAS float* scr, int lane) {
#pragma unroll 8
    for (int i = 0; i < 32; ++i) { const int kk = 2 * i + (lane >> 5); scr[kk * 33 + (lane & 31)] = src[(size_t)kk * ldS + (lane & 31)]; }
    LDS_WAIT(); asm volatile("" ::: "memory");
    const int c = lane & 7;
#pragma unroll
    for (int j = 0; j < 4; ++j) { const int n = (lane >> 3) + 8 * j; const LAS float* s = scr + (8 * c) * 33 + n;
        v4u o; o.x = pk2(s[0 * 33], s[1 * 33]); o.y = pk2(s[2 * 33], s[3 * 33]); o.z = pk2(s[4 * 33], s[5 * 33]); o.w = pk2(s[6 * 33], s[7 * 33]);
        *(GAS v4u*)(dst + (size_t)n * ldD + 8 * c) = o; }
    LDS_WAIT(); asm volatile("" ::: "memory");
}


__device__ __forceinline__ void tr_block64(const float* src, int ldS, bf16* dst, int ldD, LAS bf16* scr, int lane) {
    const int kr = lane >> 4, nc = lane & 15;
    f32x4 v[16];
#pragma unroll
    for (int i = 0; i < 16; ++i) v[i] = *(const f32x4*)(src + (size_t)(4 * i + kr) * ldS + 4 * nc);
#pragma unroll
    for (int i = 0; i < 16; ++i) { const int k = 4 * i + kr;
#pragma unroll
        for (int j = 0; j < 4; ++j) scr[(4 * nc + j) * 66 + k] = (bf16)f2bf(v[i][j]); }
    LDS_WAIT(); asm volatile("" ::: "memory");
    const int c = lane & 7;
#pragma unroll
    for (int j = 0; j < 8; ++j) { const int n = (lane >> 3) + 8 * j; const LAS unsigned* p = (const LAS unsigned*)(scr + n * 66 + 8 * c);
        v4u o; o.x = p[0]; o.y = p[1]; o.z = p[2]; o.w = p[3];
        *(GAS v4u*)(dst + (size_t)n * ldD + 8 * c) = o; }
    LDS_WAIT(); asm volatile("" ::: "memory");
}

__device__ __forceinline__ void tr_block64_f8(const float* src, int ldS, unsigned char* dst, int ldD, LAS unsigned char* scr, int lane, float sc) {
    const int nq = lane & 15, kq0 = lane >> 4;
    f32x4 v[4][4];
#pragma unroll
    for (int sb = 0; sb < 4; ++sb)
#pragma unroll
        for (int r = 0; r < 4; ++r) v[sb][r] = *(const f32x4*)(src + (size_t)(4 * (kq0 + 4 * sb) + r) * ldS + 4 * nq);
#pragma unroll
    for (int sb = 0; sb < 4; ++sb)
#pragma unroll
        for (int j = 0; j < 4; ++j) *(LAS unsigned*)(scr + (4 * nq + j) * 68 + 4 * (kq0 + 4 * sb)) = pk4_f8(v[sb][0][j] * sc, v[sb][1][j] * sc, v[sb][2][j] * sc, v[sb][3][j] * sc);
    LDS_WAIT(); asm volatile("" ::: "memory");
    const int c = lane & 3;
#pragma unroll
    for (int jj = 0; jj < 4; ++jj) { const int n = (lane >> 2) + 16 * jj; const LAS unsigned* p = (const LAS unsigned*)(scr + n * 68 + 16 * c);
        v4u o; o.x = p[0]; o.y = p[1]; o.z = p[2]; o.w = p[3];
        *(GAS v4u*)(dst + (size_t)n * ldD + 16 * c) = o; }
    LDS_WAIT(); asm volatile("" ::: "memory");
}

typedef const __attribute__((address_space(4))) Args* kargs_t;
__device__ __forceinline__ kargs_t ka_launder() { kargs_t p = (kargs_t)__builtin_amdgcn_kernarg_segment_ptr(); asm volatile("" : "+s"(p)); return p; }
__device__ __forceinline__ int tid_launder() { int t = threadIdx.x; asm volatile("" : "+v"(t)); return t; }
#define KA_DECL const kargs_t KA = ka_launder(); const int tid = tid_launder(); const int lane = tid & 63; const int wave = __builtin_amdgcn_readfirstlane(tid >> 6); const int gw = vcu * 8 + wave; const int gt = vcu * 512 + tid; (void)lane; (void)wave; (void)gw; (void)gt;
#define ws (KA->ws)
#define ctl ((gu32*)(ws + O_CTL))
#define x_in (KA->in[0])
#define c_in (KA->in[1])
#define ctx_in (KA->in[2])
#define cctx_in (KA->in[3])
#define w_mod (KA->in[4])
#define b_mod (KA->in[5])
#define norm1_g (KA->in[6])
#define w_in (KA->in[7])
#define q_norm_g (KA->in[8])
#define k_norm_g (KA->in[9])
#define attn_sink (KA->in[10])
#define pool_w (KA->in[11])
#define pool_scale (KA->in[12])
#define four_w (KA->in[13])
#define w_out (KA->in[14])
#define norm2_g (KA->in[15])
#define w_grp (KA->in[16])
#define b_grp (KA->in[17])
#define w_rtr (KA->in[18])
#define b_rtr (KA->in[19])
#define w_gate (KA->in[20])
#define w_up (KA->in[21])
#define w_down (KA->in[22])
#define outp (KA->out)
#define modv ((float*)(ws + O_MOD))
#define rope ((float2*)(ws + O_ROPE))
#define twt ((float2*)(ws + O_TW))
#define fma ((bf16*)(ws + O_FMA))
#define fmb ((bf16*)(ws + O_FMB))
#define fmc ((bf16*)(ws + O_FMC))
#define hbuf ((bf16*)(ws + O_H))
#define kall ((bf16*)(ws + O_KALL))
#define vall ((bf16*)(ws + O_VALL))
#define xc ((float*)(ws + O_XC))
#define list ((unsigned*)(ws + O_LIST))
#define wts ((float*)(ws + O_WTS))
#define act ((bf16*)(ws + O_ACT))
#define t2 ((bf16*)(ws + O_T2))
#define mrg ((bf16*)(ws + O_MRG))
#define qb ((bf16*)(ws + O_Q))
#define pu ((bf16*)(ws + O_PU))
#define zb ((bf16*)(ws + O_Z))
#define y2 ((bf16*)(ws + O_Y2))

#ifndef PH_MASK
#define PH_MASK 0x3ffff
#endif
#define IN(k) (lo <= (k) && (k) < hi && ((PH_MASK >> (k)) & 1))
#define SEAM(k) do { if (IN(k) && IN((k) + 1)) xcd_barrier(bar); } while (0)
#define modl (modv + (size_t)l * 5 * 6144)
#define win_t ((bf16*)(ws + O_WIN + l * SZ_WIN1))
#define wout_t ((bf16*)(ws + O_WOUT + l * SZ_WOUT1))
#define wgu_t ((bf16*)(ws + O_WGU + l * SZ_WGU1))
#define wd_t ((bf16*)(ws + O_WD + l * SZ_WD1))
constexpr int CV_A = 256, CV_B = 192, CV_C = 4096, CV_D = 2048, CV_L = CV_A + CV_B + CV_C + CV_D;
__device__ __forceinline__ void conv_item(const kargs_t KA, const int lw, int it, LAS bf16* scr, const int lane) {
    bf16* p_win_t = (bf16*)(ws + O_WIN + lw * SZ_WIN1); bf16* p_wout_t = (bf16*)(ws + O_WOUT + lw * SZ_WOUT1);
    bf16* p_wgu_t = (bf16*)(ws + O_WGU + lw * SZ_WGU1); bf16* p_wd_t = (bf16*)(ws + O_WD + lw * SZ_WD1);
    if (it < CV_A) { const int kb = it >> 4, nb = it & 15; tr_block64(w_in + (size_t)lw * 1024 * 1280 + (size_t)kb * 64 * 1280 + nb * 64, 1280, p_win_t + (size_t)nb * 64 * 1024 + kb * 64, 1024, scr, lane); return; } it -= CV_A;
    if (it < CV_B) { const int kb = 4 + (it >> 4), nb = it & 15; tr_block64(w_out + (size_t)lw * 1024 * 1024 + (size_t)kb * 64 * 1024 + nb * 64, 1024, p_wout_t + (size_t)nb * 64 * 1024 + kb * 64, 1024, scr, lane); return; } it -= CV_B;
    if (it < CV_C) { const int up = it >> 11, r = it & 2047, e = r >> 7, kb = (r >> 3) & 15, nb = r & 7; const int n0 = nb * 64;
        const float* src = (up ? w_up : w_gate) + ((size_t)(lw * 16 + e) * 1024 + kb * 64) * 512 + n0;
        const int drow = (n0 >> 7) * 256 + up * 128 + (n0 & 127);
        tr_block64_f8(src, 512, (unsigned char*)p_wgu_t + ((size_t)e * 1024 + drow) * 1024 + kb * 64, 1024, (LAS unsigned char*)scr, lane, 64.0f); return; } it -= CV_C;
    { const int e = it >> 7, kb = (it >> 4) & 7, nb = it & 15;
        tr_block64_f8(w_down + ((size_t)(lw * 16 + e) * 512 + kb * 64) * 1024 + nb * 64, 1024, (unsigned char*)p_wd_t + ((size_t)e * 1024 + nb * 64) * 512 + kb * 64, 512, (LAS unsigned char*)scr, lane, 64.0f); }
}
__device__ __forceinline__ void steal_convert(const kargs_t KA, LAS unsigned char* lds, const int G, const int done_idx, const bool drain) {
    int tid = threadIdx.x; asm volatile("" : "+v"(tid));
    const int lane = tid & 63, wave = __builtin_amdgcn_readfirstlane(tid >> 6);
    volatile LAS int* mb = (volatile LAS int*)(lds + MISC_OFF + 64);
    LAS bf16* scr = (LAS bf16*)(lds + wave * 16384);
    __syncthreads();
    if (tid == 0 && !drain) __hip_atomic_fetch_add((unsigned*)(ctl + CW_DONE + 64 * done_idx), 1u, RLX_AGENT);
    for (;;) {
        if (tid == 0) { int idx = -1;
            const bool stop = !drain && __hip_atomic_load((unsigned*)(ctl + CW_DONE + 64 * done_idx), RLX_AGENT) >= (unsigned)G;
            if (!stop) idx = (int)__hip_atomic_fetch_add((unsigned*)(ctl + CW_Q), 8u, RLX_AGENT);
            mb[0] = idx; }
        __syncthreads();
        const int idx = mb[0];
        __syncthreads();
        if (idx < 0 || idx >= CV_L) break;
        if (idx + wave < CV_L) conv_item(KA, 1, idx + wave, scr, lane);
    }
    __syncthreads();
}

template <int l> __device__ __forceinline__ void layer_body(LAS unsigned char* lds, const int G, const int vcu, const XcdBarrier& bar, const int lo, const int hi) {
    const int NGW = G * 8, NGT = G * 512; LAS int* ttab = (LAS int*)(lds + TILE_OFF);
    constexpr int P = 1 + 8 * l;

        for (int rep_ = 0; rep_ < 1 + ((l == 0) ? ((REP_MASK >> (1 + 0)) & 1) : 0); ++rep_)
        if (IN(P + 0)) {
            KA_DECL
            const float* modp = modv;
            if (l == 1) steal_convert(KA, lds, G, 3, true);
#pragma clang loop vectorize(disable) unroll(disable)
            for (int r0 = gw; r0 < TT; r0 += 2 * NGW) {
                const int r1 = r0 + NGW; const bool has1 = r1 < TT;
                f32x4 va[4], vb[4]; v2u yaa[4], yab[4], yba[4], ybb[4];
                const float* srca; const float* srcb;
                { const bool isc = r0 >= T; srca = (l == 0) ? (isc ? ctx_in + (size_t)(r0 - T) * 1024 : x_in + (size_t)r0 * 1024) : (isc ? xc + (size_t)(r0 - T) * 1024 : outp + (size_t)r0 * 1024); }
                { const int rr = has1 ? r1 : r0; const bool isc = rr >= T; srcb = (l == 0) ? (isc ? ctx_in + (size_t)(rr - T) * 1024 : x_in + (size_t)rr * 1024) : (isc ? xc + (size_t)(rr - T) * 1024 : outp + (size_t)rr * 1024); }
#pragma unroll
                for (int j = 0; j < 4; ++j) { va[j] = *(const f32x4*)(srca + 4 * lane + 256 * j); vb[j] = *(const f32x4*)(srcb + 4 * lane + 256 * j); }
                if (l == 1) {
                    const int rr = has1 ? r1 : r0;
#pragma unroll
                    for (int j = 0; j < 4; ++j) { yaa[j] = *(const v2u*)(y2 + (size_t)(2 * r0) * 1024 + 4 * lane + 256 * j); yab[j] = *(const v2u*)(y2 + (size_t)(2 * r0 + 1) * 1024 + 4 * lane + 256 * j);
                        yba[j] = *(const v2u*)(y2 + (size_t)(2 * rr) * 1024 + 4 * lane + 256 * j); ybb[j] = *(const v2u*)(y2 + (size_t)(2 * rr + 1) * 1024 + 4 * lane + 256 * j); }
                }
#pragma unroll
                for (int half = 0; half < 2; ++half) {
                    if (half == 1 && !has1) break;
                    const int r = half ? r1 : r0; f32x4 (&v)[4] = half ? vb : va; v2u (&ya)[4] = half ? yba : yaa; v2u (&yb)[4] = half ? ybb : yab;
                    const bool isc = r >= T; const int bsel = isc ? 4 : (r >> 12);
                    if (l == 1) {
                        const float* g2 = modp + bsel * 6144 + 5 * 1024; float* dst = isc ? xc + (size_t)(r - T) * 1024 : outp + (size_t)r * 1024;
#pragma unroll
                        for (int j = 0; j < 4; ++j) {
                            const f32x4 gv = *(const f32x4*)(g2 + 4 * lane + 256 * j);
                            f32x4 yy; yy[0] = bflo(ya[j].x) + bflo(yb[j].x); yy[1] = bfhi(ya[j].x) + bfhi(yb[j].x); yy[2] = bflo(ya[j].y) + bflo(yb[j].y); yy[3] = bfhi(ya[j].y) + bfhi(yb[j].y);
                            if (DBG_NO_MOE) yy = (f32x4){0.f, 0.f, 0.f, 0.f};
                            v[j] = v[j] + gv * yy; *(f32x4*)(dst + 4 * lane + 256 * j) = v[j];
                        }
                    }
                    float ss = 0.f;
#pragma unroll
                    for (int j = 0; j < 4; ++j) ss += (v[j][0] * v[j][0] + v[j][1] * v[j][1]) + (v[j][2] * v[j][2] + v[j][3] * v[j][3]);
                    const float rstd = 1.0f / sqrtf(wave_sum(ss) * (1.f / 1024.f) + 1e-6f);
                    const float* sh = modl + bsel * 6144; const float* sc = sh + 1024; const float* gn = norm1_g + l * 1024;
#pragma unroll
                    for (int j = 0; j < 4; ++j) {
                        const int c0 = 4 * lane + 256 * j; const f32x4 g = *(const f32x4*)(gn + c0), s1 = *(const f32x4*)(sc + c0), h1 = *(const f32x4*)(sh + c0);
                        const f32x4 y = (v[j] * rstd) * g * (s1 + 1.0f) + h1;
                        v2u o; o.x = pk2(y[0], y[1]); o.y = pk2(y[2], y[3]); *(v2u*)(hbuf + (size_t)r * 1024 + c0) = o;
                    }
                }
            }
        }
        SEAM(P + 0);
        for (int rep_ = 0; rep_ < 1 + ((l == 0) ? ((REP_MASK >> (1 + 1)) & 1) : 0); ++rep_)
        if (IN(P + 1)) {
            KA_DECL
            SchedPlain S{TT / 256, 6, G, vcu, 1024, (const char*)hbuf, (const char*)win_t};
            EpiG1 E{pu, qb, kall, vall, zb};
            pg8::gemm_phase<EpiG1, SchedPlain>(lds, S, E);
            if (l == 0 && !MK_SPLIT) steal_convert(KA, lds, G, 0, false);
        }
        SEAM(P + 1);
        if (IN(P + 3)) {
            KA_DECL
            gu32* kflag = ctl + CW_KF + l * 16384;
            gu32* facnt = ctl + CW_FA + l * 64;
            for (int it = vcu; it < 256; it += G) {
                const int b = it >> 6, n2 = it & 63;
                RowA ra{zb, b, n2}; EpiA<true> ea{t2, twt, b, n2};
                slab_gemm<4, RowA, EpiA<true>>(lds, fma, 128, ra, ea);
                asm volatile("s_waitcnt vmcnt(0)" ::: "memory");
                __syncthreads();
                if (tid == 0) __hip_atomic_fetch_add((unsigned*)(facnt + 16 * b), 1u, RLX_AGENT);
            }
            const int n_att = 512 + (l == 0 ? 32 : 0);
            for (int it = vcu; it < n_att; it += G) {
                const bool cu = it >= 512; const int uidx = cu ? it - 512 : it;
                const int b = cu ? (uidx >> 3) : (uidx >> 7), kvh = cu ? ((uidx >> 2) & 1) : ((uidx >> 6) & 1), pb = cu ? (uidx & 3) : (uidx & 63);
                const int p0 = pb * 64; const int qrow0 = cu ? T + b * 256 + p0 : b * 4096 + p0;
                if (!cu) {
                    const int row = tid >> 3, c = tid & 7;
                    const float* kg = k_norm_g + l * 64 + 8 * c;
#pragma unroll
                    for (int part = 0; part < 2; ++part) {
                        if (part == 1 && pb >= 4) break;
                        const int blk = part ? pb : 4 + pb;
                        bf16* p = kall + ((size_t)b * KVROWS + blk * 64 + row) * 128 + kvh * 64 + c * 8;
                        const v4u w = *(const v4u*)p;
                        float x[8] = {bflo(w.x), bfhi(w.x), bflo(w.y), bfhi(w.y), bflo(w.z), bfhi(w.z), bflo(w.w), bfhi(w.w)};
                        float ss = 0.f;
#pragma unroll
                        for (int i = 0; i < 8; ++i) ss += x[i] * x[i];
                        ss += __shfl_xor(ss, 1); ss += __shfl_xor(ss, 2); ss += __shfl_xor(ss, 4);
                        const float rstd = 1.0f / sqrtf(ss * (1.f / 64.f) + 1e-6f);
#pragma unroll
                        for (int i = 0; i < 8; ++i) x[i] *= rstd * kg[i];
                        if (part == 0) {
                            const float2* rp = rope + (size_t)(p0 + row) * 32 + ((c & 4) ? 16 : 0) + (c & 1) * 8;
#pragma unroll
                            for (int i = 0; i < 8; ++i) { const float y = __shfl_xor(x[i], 2); const float2 cs = rp[i]; x[i] = (c & 2) ? (x[i] * cs.x + y * cs.y) : (x[i] * cs.x - y * cs.y); }
                        }
                        v4u o; o.x = pk2(x[0], x[1]); o.y = pk2(x[2], x[3]); o.z = pk2(x[4], x[5]); o.w = pk2(x[6], x[7]);
                        store16_wt(p, o);
                    }
                    asm volatile("s_waitcnt vmcnt(0)" ::: "memory");
                    __syncthreads();
                    if (tid == 0) { __hip_atomic_store(kflag + 16 * ((b * 68 + 4 + pb) * 2 + kvh), 1u, RLX_AGENT); if (pb < 4) __hip_atomic_store(kflag + 16 * ((b * 68 + pb) * 2 + kvh), 1u, RLX_AGENT); }
                }
                if (tid < 64) {
                    int blk = -1;
                    if (lane < 4) blk = lane; else if (!cu && lane < 9) { const int q = pb + lane - 6; if (q >= 0 && q < 64) blk = 4 + q; }
                    unsigned sp = 0;
                    for (;;) { const unsigned f = (blk >= 0) ? __hip_atomic_load(kflag + 16 * ((b * 68 + blk) * 2 + kvh), RLX_AGENT) : 1u;
                        if (__all(f != 0u)) break; __builtin_amdgcn_s_sleep(2);
                        if (++sp > (1u << 22)) { if (tid == 0) __hip_atomic_store(ctl + CW_TMO, 2u, RLX_AGENT); break; } }
                    __builtin_amdgcn_fence(__ATOMIC_ACQUIRE, "agent");
                    asm volatile("s_waitcnt vmcnt(0)" ::: "memory");
                }
                __syncthreads();
                const attn_body::bf16* Qu = (const attn_body::bf16*)(qb + (size_t)qrow0 * 512 + kvh * 256);
                const attn_body::bf16* Kh = (const attn_body::bf16*)(kall + (size_t)b * KVROWS * 128 + kvh * 64);
                const attn_body::bf16* Vh = (const attn_body::bf16*)(vall + (size_t)b * KVROWS * 128 + kvh * 64);
                attn_body::bf16* Ou = (attn_body::bf16*)(mrg + (size_t)qrow0 * 1024 + 256 + kvh * 256);
                attn_body::attn_unit<8>(Qu, Kh, Vh, Ou, p0, cu ? 4 : 10, attn_sink + l * 8 + kvh * 4, q_norm_g + l * 64, cu ? (const float2*)nullptr : (const float2*)rope, (char*)lds);
                __syncthreads();
            }
            const int prow = (l == 0) ? TT : T; const int nrb = prow >> 3;
#pragma clang loop vectorize(disable) unroll(disable)
            for (int i = gt; i < 32 * nrb; i += NGT) {
                const int ck8 = i & 7, rb = (i >> 3) % nrb, g = (i >> 3) / nrb;
                const int r0 = rb * 8; const bool isc = r0 >= T;
                const int nseq = isc ? LCTX : NSEQ; const int rbase = isc ? T + ((r0 - T) & ~255) : (r0 & ~4095); const int n0 = r0 - rbase;
                const int hw = 1 << g; const int col = g * 64 + ck8 * 8;
                const bf16* up = pu + (size_t)rbase * 256 + col;
                float sm[8] = {0.f, 0.f, 0.f, 0.f, 0.f, 0.f, 0.f, 0.f};
#define POOL_ACC(W, SGN) do { sm[0] += SGN bflo(W.x); sm[1] += SGN bfhi(W.x); sm[2] += SGN bflo(W.y); sm[3] += SGN bfhi(W.y); sm[4] += SGN bflo(W.z); sm[5] += SGN bfhi(W.z); sm[6] += SGN bflo(W.w); sm[7] += SGN bfhi(W.w); } while (0)
                for (int tpos = n0 - hw; tpos < n0 + hw; ++tpos) if (tpos >= 0 && tpos < nseq) { const v4u w = *(const v4u*)(up + (size_t)tpos * 256); POOL_ACC(w, +); }
#pragma unroll
                for (int k = 0; k < 8; ++k) {
                    const int n = n0 + k; int lo_ = n - hw; lo_ = lo_ < 0 ? 0 : lo_; int hi_ = n + hw - 1; hi_ = hi_ > nseq - 1 ? nseq - 1 : hi_;
                    const v4u w = *(const v4u*)(up + (size_t)n * 256); const float ic = 1.0f / (float)(hi_ - lo_ + 1);
                    v4u o; o.x = pk2(sm[0] * ic - bflo(w.x), sm[1] * ic - bfhi(w.x)); o.y = pk2(sm[2] * ic - bflo(w.y), sm[3] * ic - bfhi(w.y));
                    o.z = pk2(sm[4] * ic - bflo(w.z), sm[5] * ic - bfhi(w.z)); o.w = pk2(sm[6] * ic - bflo(w.w), sm[7] * ic - bfhi(w.w));
                    if (DBG_NO_POOL) o = (v4u){0u, 0u, 0u, 0u};
                    *(v4u*)(mrg + (size_t)(rbase + n) * 1024 + col) = o;
                    if (k < 7) { const int tin = n + hw, tout = n - hw;
                        if (tin < nseq) { const v4u wi = *(const v4u*)(up + (size_t)tin * 256); POOL_ACC(wi, +); }
                        if (tout >= 0) { const v4u wo = *(const v4u*)(up + (size_t)tout * 256); POOL_ACC(wo, -); } }
                }
#undef POOL_ACC
            }
            for (int it = vcu; it < 256; it += G) {
                const int b = it >> 6, k1 = it & 63;
                __syncthreads();
                if (tid < 64) { unsigned sp = 0;
                    while ((unsigned)__builtin_amdgcn_readfirstlane(__hip_atomic_load((unsigned*)(facnt + 16 * b), RLX_AGENT)) < 64u) { __builtin_amdgcn_s_sleep(2); if (++sp > (1u << 22)) { if (tid == 0) __hip_atomic_store(ctl + CW_TMO, 3u, RLX_AGENT); break; } }
                    __builtin_amdgcn_fence(__ATOMIC_ACQUIRE, "agent");
                    asm volatile("s_waitcnt vmcnt(0)" ::: "memory"); }
                __syncthreads();
                RowB rb{t2, b, k1}; EpiB eb{mrg, b, k1};
                slab_gemm<2, RowB, EpiB>(lds, fmb, 128, rb, eb);
            }
            if (l == 0) for (int it = (G - 1 - vcu); it < 32; it += G) {
                const int b = it >> 3, mt0 = it & 7;
                RowC rc{zb, b}; EpiC ec{mrg, b, mt0};
                slab_gemm<1, RowC, EpiC>(lds, fmc + (size_t)mt0 * 32 * 512, 512, rc, ec);
            }
        }
        SEAM(P + 3);
        if (IN(P + 4)) {
            KA_DECL
            unsigned* g2rdy = (unsigned*)(ctl + CW_G2 + l * 2048);
            {
                SchedPlain S{(l == 0 ? TT : T) / 256, 4, G, vcu, 1024, (const char*)mrg, (const char*)wout_t};
                EpiG2 E{(l == 0) ? x_in : outp, ctx_in, outp, xc, modl, g2rdy};
                pg8::gemm_phase<EpiG2, SchedPlain>(lds, S, E);
            }
            const int rep_ = 0;
            __syncthreads();
            LAS float* rw = (LAS float*)lds;
            LAS int* lcnt = (LAS int*)(lds + 81920);
            LAS unsigned* lent = (LAS unsigned*)(lds + 81920 + 256);
            LAS unsigned* lrank = lent + 1024;
            { const float* rwg = (const float*)(ws + O_RW) + l * 20480;
#pragma unroll
              for (int i = 0; i < 10; ++i) { const int idx = tid + 512 * i; *(LAS f32x4*)(rw + 4 * idx) = *(const f32x4*)(rwg + 4 * idx); } }
            if (tid < 33) lcnt[tid] = 0;
            if (tid < 64) { unsigned sp = 0; unsigned* w = g2rdy + 16 * (vcu >> 2);
                while ((unsigned)__builtin_amdgcn_readfirstlane(__hip_atomic_load(w, RLX_AGENT)) < 32u) { __builtin_amdgcn_s_sleep(2); if (++sp > (1u << 22)) { if (tid == 0) __hip_atomic_store(ctl + CW_TMO, 4u, RLX_AGENT); break; } }
                __builtin_amdgcn_fence(__ATOMIC_ACQUIRE, "agent");
                asm volatile("s_waitcnt vmcnt(0)" ::: "memory"); }
            __syncthreads();
            const bool dbl = (l == 0) && (G == 256) && (vcu < 16);
            const int ngl = 16 + ((l == 0) ? 1 : 0) + (((l == 0) && (G == 256)) ? 2 : 0);
#pragma clang loop vectorize(disable) unroll(disable)
            for (int gix = wave; gix < ngl; gix += 8) {
                int q;
                if (gix < 16) { if (dbl) continue; q = 16 * vcu + gix; }
                else if (gix == 16) q = T / 4 + vcu;
                else { if (dbl) continue; const int o = (gix == 17) ? (vcu - 16) : (240 + vcu - 16); if (o >= 256 || (gix == 18 && vcu >= 32)) continue; q = o; }
                if (gix >= 17) {
                    unsigned sp = 0; unsigned* w = g2rdy + 16 * (q >> 6);
                    while ((unsigned)__builtin_amdgcn_readfirstlane(__hip_atomic_load(w, RLX_AGENT)) < 32u) { __builtin_amdgcn_s_sleep(2); if (++sp > (1u << 22)) { if (lane == 0) __hip_atomic_store(ctl + CW_TMO, 6u, RLX_AGENT); break; } }
                    __builtin_amdgcn_fence(__ATOMIC_ACQUIRE, "agent");
                    asm volatile("s_waitcnt vmcnt(0)" ::: "memory"); }
                if (gix == 16) { unsigned sp = 0; unsigned* w = g2rdy + 16 * (64 + (vcu >> 6));
                    while ((unsigned)__builtin_amdgcn_readfirstlane(__hip_atomic_load(w, RLX_AGENT)) < 32u) { __builtin_amdgcn_s_sleep(2); if (++sp > (1u << 22)) { if (lane == 0) __hip_atomic_store(ctl + CW_TMO, 5u, RLX_AGENT); break; } }
                    __builtin_amdgcn_fence(__ATOMIC_ACQUIRE, "agent");
                    asm volatile("s_waitcnt vmcnt(0)" ::: "memory"); }
                const int rb4 = 4 * q; const bool isc = rb4 >= T; const int bsel = isc ? 4 : (rb4 >> 12);
                const float* src = isc ? xc + (size_t)(rb4 - T) * 1024 : outp + (size_t)rb4 * 1024;
                f32x4 v[4][4];
#pragma unroll
                for (int tk = 0; tk < 4; ++tk)
#pragma unroll
                    for (int j = 0; j < 4; ++j) v[tk][j] = *(const f32x4*)(src + (size_t)tk * 1024 + 4 * lane + 256 * j);
                float rstd[4];
#pragma unroll
                for (int tk = 0; tk < 4; ++tk) { float ss = 0.f;
#pragma unroll
                    for (int j = 0; j < 4; ++j) ss += (v[tk][j][0] * v[tk][j][0] + v[tk][j][1] * v[tk][j][1]) + (v[tk][j][2] * v[tk][j][2] + v[tk][j][3] * v[tk][j][3]);
                    rstd[tk] = 1.0f / sqrtf(wave_sum(ss) * (1.f / 1024.f) + 1e-6f); }
                const float* sh = modl + bsel * 6144 + 3 * 1024; const float* sc = sh + 1024; const float* gn = norm2_g + l * 1024;
                float lg[4][20];
#pragma unroll
                for (int tk = 0; tk < 4; ++tk)
#pragma unroll
                    for (int j = 0; j < 20; ++j) lg[tk][j] = 0.f;
#pragma unroll
                for (int j = 0; j < 4; ++j) {
                    const int c0 = 4 * lane + 256 * j; const f32x4 g = *(const f32x4*)(gn + c0), s1 = *(const f32x4*)(sc + c0), h1 = *(const f32x4*)(sh + c0);
                    f32x4 y[4];
#pragma unroll
                    for (int tk = 0; tk < 4; ++tk) { y[tk] = (v[tk][j] * rstd[tk]) * g * (s1 + 1.0f) + h1;
                        *(unsigned*)((unsigned char*)hbuf + (size_t)(rb4 + tk) * 1024 + c0) = pk4_f8(y[tk][0], y[tk][1], y[tk][2], y[tk][3]); }
#pragma unroll
                    for (int e = 0; e < 4; ++e) {
#pragma unroll
                        for (int q5 = 0; q5 < 5; ++q5) { const f32x4 wv = *(const LAS f32x4*)(rw + (((q5 * 4 + j) * 4 + e) * 64 + lane) * 4);
#pragma unroll
                            for (int tk = 0; tk < 4; ++tk) { lg[tk][4 * q5] += y[tk][e] * wv[0]; lg[tk][4 * q5 + 1] += y[tk][e] * wv[1]; lg[tk][4 * q5 + 2] += y[tk][e] * wv[2]; lg[tk][4 * q5 + 3] += y[tk][e] * wv[3]; } }
                        __builtin_amdgcn_sched_barrier(0); }
                }
                float l2[20];
#pragma unroll
                for (int j = 0; j < 20; ++j) {
                    const float a0 = swap32_sum(lg[0][j], lg[2][j]);
                    const float a1 = swap32_sum(lg[1][j], lg[3][j]);
                    float t = swap16_sum(a0, a1);
                    t += dppf<0x128, 0xf>(t); t += dppf<0x124, 0xf>(t); t += dppf<0x122, 0xf>(t); t += dppf<0x121, 0xf>(t);
                    l2[j] = t;
                }
                const int tk = lane >> 4; const int r = rb4 + tk;
                float gl[4]; float gm = -1e30f;
#pragma unroll
                for (int j = 0; j < 4; ++j) { gl[j] = l2[j] + b_grp[l * 4 + j]; gm = fmaxf(gm, gl[j]); }
                float gs = 0.f; int gi = 0; float gb = -1e30f;
#pragma unroll
                for (int j = 0; j < 4; ++j) { const float e = expf(gl[j] - gm); gs += e; if (gl[j] > gb) { gb = gl[j]; gi = j; } }
                const float pg = expf(gb - gm) / gs;
                float el[4]; float em = -1e30f;
#pragma unroll
                for (int j = 0; j < 4; ++j) { float t_ = 0.f;
#pragma unroll
                    for (int g4 = 0; g4 < 4; ++g4) t_ = (gi == g4) ? (l2[4 + g4 * 4 + j] + b_rtr[l * 16 + g4 * 4 + j]) : t_;
                    el[j] = t_; em = fmaxf(em, t_); }
                float pe[4];
#pragma unroll
                for (int j = 0; j < 4; ++j) pe[j] = expf(el[j] - em);
                int i0 = 0; float b0 = -1.f;
#pragma unroll
                for (int j = 0; j < 4; ++j) if (pe[j] > b0) { b0 = pe[j]; i0 = j; }
                int i1 = 0; float b1 = -1.f;
#pragma unroll
                for (int j = 0; j < 4; ++j) if (j != i0 && pe[j] > b1) { b1 = pe[j]; i1 = j; }
                const float wsum = b0 + b1; const float w0 = pg * b0 / wsum, w1 = pg * b1 / wsum;
                if ((lane & 15) == 0 && rep_ == 0) {
                    wts[2 * r] = w0; wts[2 * r + 1] = w1;
                    const int e0 = gi * 4 + i0, e1 = gi * 4 + i1;
                    const int s0 = __hip_atomic_fetch_add((LAS int*)(lcnt + 16 + 16), 1, __ATOMIC_RELAXED, __HIP_MEMORY_SCOPE_WORKGROUP);
                    const int k0 = __hip_atomic_fetch_add((LAS int*)(lcnt + e0), 1, __ATOMIC_RELAXED, __HIP_MEMORY_SCOPE_WORKGROUP);
                    const int k1 = __hip_atomic_fetch_add((LAS int*)(lcnt + e1), 1, __ATOMIC_RELAXED, __HIP_MEMORY_SCOPE_WORKGROUP);
                    lent[2 * s0] = ((unsigned)(2 * r) << 4) | (unsigned)e0; lrank[2 * s0] = (unsigned)k0;
                    lent[2 * s0 + 1] = ((unsigned)(2 * r + 1) << 4) | (unsigned)e1; lrank[2 * s0 + 1] = (unsigned)k1;
                }
            }
            __syncthreads();
            if (tid < 16 && rep_ == 0) { const int c = lcnt[tid]; lcnt[16 + tid] = c ? (int)__hip_atomic_fetch_add((unsigned*)(ctl + CW_CNT + (l * 16 + tid) * 64), (unsigned)c, RLX_AGENT) : 0; }
            __syncthreads();
            const int ntot = rep_ == 0 ? 2 * lcnt[32] : 0;
            for (int i = tid; i < ntot; i += 512) { const unsigned en = lent[i]; const int e = en & 15; list[(size_t)e * TT + lcnt[16 + e] + lrank[i]] = en >> 4; }
            __syncthreads();
            if (l == 0 && !MK_SPLIT) steal_convert(KA, lds, G, 1, false);
        }
        SEAM(P + 5);
        if (IN(P + 6) || IN(P + 7)) {
            KA_DECL
            __syncthreads();
            if (tid < 16) ttab[17 + tid] = (int)__hip_atomic_load((unsigned*)(ctl + CW_CNT + (l * 16 + tid) * 64), RLX_AGENT);
            __syncthreads();
            if (tid == 0) { int acc_ = 0; for (int e = 0; e < 16; ++e) { const int c = ttab[17 + e]; ttab[e] = acc_; acc_ += (c + 255) >> 8; } ttab[16] = acc_; }
            __syncthreads();
        }
        if (DBG_NAIVE_MOE && IN(P + 6)) {
            KA_DECL
            const int nrows = (l == 0) ? TT : T; LAS float* hs = (LAS float*)lds; LAS float* as = hs + 1024;
            const int* eidg = (const int*)(ws + O_EID);
            LAS float* lgs = as + 512; LAS float* rt = lgs + 32;
            for (int r = vcu; r < nrows; r += G) {
                __syncthreads();
                for (int i = tid; i < 1024; i += 512) hs[i] = bf2f(hbuf[(size_t)r * 1024 + i]);
                __syncthreads();
                if (tid < 20) { float a = 0.f; for (int k = 0; k < 1024; ++k) a += hs[k] * ((tid < 4) ? w_grp[(size_t)l * 4096 + k * 4 + tid] : w_rtr[(size_t)l * 16384 + k * 16 + (tid - 4)]);
                    lgs[tid] = a + ((tid < 4) ? b_grp[l * 4 + tid] : b_rtr[l * 16 + tid - 4]); }
                __syncthreads();
                if (tid == 0) { int gi = 0; for (int j = 1; j < 4; ++j) if (lgs[j] > lgs[gi]) gi = j; float gs = 0.f; for (int j = 0; j < 4; ++j) gs += expf(lgs[j] - lgs[gi]); const float pg = 1.f / gs;
                    int i0 = 0; for (int j = 1; j < 4; ++j) if (lgs[4 + gi * 4 + j] > lgs[4 + gi * 4 + i0]) i0 = j; int i1 = -1; for (int j = 0; j < 4; ++j) if (j != i0 && (i1 < 0 || lgs[4 + gi * 4 + j] > lgs[4 + gi * 4 + i1])) i1 = j;
                    const float p0 = 1.f, p1 = expf(lgs[4 + gi * 4 + i1] - lgs[4 + gi * 4 + i0]); rt[0] = (float)(gi * 4 + i0); rt[1] = (float)(gi * 4 + i1); rt[2] = pg * p0 / (p0 + p1); rt[3] = pg * p1 / (p0 + p1); }
                __syncthreads();
                for (int sl = 0; sl < 2; ++sl) {
                    const int e = (DBG_NAIVE_ROUTE & 1) ? (int)rt[sl] : eidg[2 * r + sl]; const float w = (DBG_NAIVE_ROUTE & 2) ? rt[2 + sl] : wts[2 * r + sl];
                    __syncthreads();
                    const float* Wg = w_gate + (size_t)(l * 16 + e) * 1024 * 512 + tid; const float* Wu = w_up + (size_t)(l * 16 + e) * 1024 * 512 + tid;
                    float g = 0.f, u = 0.f;
#pragma unroll 8
                    for (int k = 0; k < 1024; ++k) { g += hs[k] * Wg[(size_t)k * 512]; u += hs[k] * Wu[(size_t)k * 512]; }
                    as[tid] = g / (1.f + expf(-g)) * u;
                    __syncthreads();
                    const float* Wd = w_down + (size_t)(l * 16 + e) * 512 * 1024 + tid;
                    float y0 = 0.f, y1 = 0.f;
#pragma unroll 8
                    for (int j = 0; j < 512; ++j) { y0 += as[j] * Wd[(size_t)j * 1024]; y1 += as[j] * Wd[(size_t)j * 1024 + 512]; }
                    y2[(size_t)(2 * r + sl) * 1024 + tid] = (bf16)f2bf(y0 * w); y2[(size_t)(2 * r + sl) * 1024 + 512 + tid] = (bf16)f2bf(y1 * w);
                }
            }
        }
        if (!DBG_NAIVE_MOE && IN(P + 6)) {
            KA_DECL
            unsigned* rdy = (unsigned*)(ctl + CW_RDY + l * 4096);
            SchedMoe S{G, vcu, ttab[16], (const char*)hbuf, (const char*)act, (const char*)wgu_t, (const char*)wd_t, list, ttab, rdy, (unsigned*)(ctl + CW_TMO)};
            EpiMoe E{EpiG3{act, rdy}, EpiG4{y2, list, wts, ttab}};
            pg8::gemm_phase<EpiMoe, SchedMoe, true>(lds, S, E);
            if (l == 0 && !MK_SPLIT) steal_convert(KA, lds, G, 2, false);
        }
        SEAM(P + 7);
    }

__global__ void __launch_bounds__(512, 2) fwd_kernel(Args args) {
    extern __shared__ __attribute__((aligned(16))) unsigned char lds_raw[];
    LAS unsigned char* lds = (LAS unsigned char*)lds_raw;
    const int tid = threadIdx.x, lane = tid & 63, wave = __builtin_amdgcn_readfirstlane(tid >> 6);
    const int G = gridDim.x; const int bx = blockIdx.x; const int vcu = (G % 8 == 0) ? (bx % 8) * (G / 8) + bx / 8 : bx;
    volatile LAS unsigned* MISC = (volatile LAS unsigned*)(lds + MISC_OFF);
    LAS float* trig = (LAS float*)(lds + TRIG_OFF);
    LAS int* ttab = (LAS int*)(lds + TILE_OFF);
    for (int u = tid; u < (LDS_BYTES - LDSCTL_OFF) / 4; u += 512) ((LAS unsigned*)(lds + LDSCTL_OFF))[u] = 0u;
    __syncthreads();
    if (tid < 64) { float s, c; sincospif((float)tid / 32.f, &s, &c); trig[tid] = c; trig[64 + tid] = s; }
    __syncthreads();
    XcdBarrier bar; bar.bar = nullptr; bar.x = 0; bar.st = nullptr;
    if (!MK_SPLIT) { KA_DECL bar = xcd_barrier_post((unsigned*)(ctl + CW_BAR), MISC + 8); }
    const int lo = args.ph_lo, hi = args.ph_hi;
    const int NGW = G * 8, NGT = G * 512;

    for (int rep_ = 0; rep_ < 1 + ((REP_MASK >> 0) & 1); ++rep_)
    if (IN(0)) {
        KA_DECL
        __syncthreads();
        if (rep_ == 0 || ((REP_MASK >> 13) & 1)) {
            LAS float* sl = (LAS float*)lds;
            bool have = false;
            for (int it = vcu; it < 192; it += G) {
                if (!have) {
                    for (int i = tid; i < 5120; i += 512) { const int r = i >> 10, k = i & 1023; const float v = (r < 4) ? c_in[r * 1024 + k] : cctx_in[k]; sl[i] = v / (1.f + expf(-v)); }
                    __syncthreads(); have = true;
                }
                const int l = it / 96, cb = it % 96;
                const int r4 = lane >> 4, cq = lane & 15; const int k0 = wave * 128;
                const float* W = w_mod + (size_t)l * 1024 * 6144 + (size_t)(k0 + r4) * 6144 + cb * 64 + 4 * cq;
                f32x4 a0 = {0.f, 0.f, 0.f, 0.f}, a1 = a0, a2 = a0, a3 = a0, a4 = a0;
#pragma unroll 8
                for (int k = 0; k < 32; ++k) { const f32x4 wv = *(const f32x4*)(W + (size_t)(4 * k) * 6144); const int kk = k0 + 4 * k + r4;
                    a0 += wv * sl[kk]; a1 += wv * sl[1024 + kk]; a2 += wv * sl[2048 + kk]; a3 += wv * sl[3072 + kk]; a4 += wv * sl[4096 + kk]; }
                LAS float* part = sl + 5120;
                { LAS float* pp = part + (wave * 4 + r4) * 320 + 4 * cq;
                  *(LAS f32x4*)(pp) = a0; *(LAS f32x4*)(pp + 64) = a1; *(LAS f32x4*)(pp + 128) = a2; *(LAS f32x4*)(pp + 192) = a3; *(LAS f32x4*)(pp + 256) = a4; }
                __syncthreads();
                if (tid < 320) { const int r = tid >> 6, n = tid & 63; float sacc = b_mod[l * 6144 + cb * 64 + n];
#pragma unroll 8
                    for (int w = 0; w < 32; ++w) sacc += part[w * 320 + r * 64 + n];
                    modv[(size_t)(l * 5 + r) * 6144 + cb * 64 + n] = sacc; }
                __syncthreads();
            }
            __syncthreads();
        }
        if (rep_ == 0 || ((REP_MASK >> 14) & 1)) {
#pragma clang loop vectorize(disable) unroll(disable)
        for (int i = gt; i < 4096 * 32; i += NGT) {
            const int n = i >> 5, j = i & 31; const int jj = j & 15;
            const float inv = 1.0f / powf(10000.0f, (float)(2 * jj) / 32.0f);
            const float pos = (j < 16) ? (float)(n >> 6) : (float)(n & 63);
            const float ang = pos * inv; rope[i] = make_float2(cosf(ang), sinf(ang));
        }
#pragma clang loop vectorize(disable) unroll(disable)
        for (int i = gt; i < 4096; i += NGT) { float s, c; sincospif((float)i / 2048.f, &s, &c); twt[i] = make_float2(c, s); }
#pragma clang loop vectorize(disable) unroll(disable)
        for (int i = gt; i < 128 * 128; i += NGT) {
            const int m = i >> 7, k = i & 127; const int ri = m >> 6, k1 = m & 63, part = k >> 6, n1 = k & 63;
            float s, c; sincospif((float)((n1 * k1) & 63) / 32.f, &s, &c);
            float v; if (ri == 0) v = (part == 0) ? c : -s; else v = (part == 0) ? -s : -c;
            fma[i] = (bf16)f2bf(v);
        }
#pragma clang loop vectorize(disable) unroll(disable)
        for (int i = gt; i < 64 * 128; i += NGT) {
            const int k2 = i >> 7, k = i & 127; const int ri = k >> 6, n2 = k & 63;
            float s, c; sincospif((float)((n2 * k2) & 63) / 32.f, &s, &c);
            fmb[i] = (bf16)f2bf((ri == 0 ? c : s) * (1.f / 512.f));
        }
#pragma clang loop vectorize(disable) unroll(disable)
        for (int i = gt; i < 256 * 512; i += NGT) {
            const int kk = i >> 9, k = i & 511; const int part = k >> 8, n = k & 255;
            float s, c; sincospif((float)((n * kk) & 255) / 128.f, &s, &c);
            fmc[i] = (bf16)f2bf((part == 0 ? c : -s) * (1.f / 128.f));
        }
#pragma clang loop vectorize(disable) unroll(disable)
        for (int i = gt; i < 2 * 20480; i += NGT) {
            const int lw = i / 20480, r = i % 20480; const int d = r / 20, j = r % 20;
            ((float*)(ws + O_RW))[lw * 20480 + ((((j >> 2) * 4 + (d >> 8)) * 4 + (d & 3)) * 64 + ((d & 255) >> 2)) * 4 + (j & 3)] = (j < 4) ? w_grp[(size_t)lw * 4096 + d * 4 + j] : w_rtr[(size_t)lw * 16384 + d * 16 + (j - 4)];
        }
        }
        if (rep_ == 0 || ((REP_MASK >> 15) & 1)) {
            LAS float* Al = (LAS float*)lds;
            LAS float* Wl = Al + 4096;
            LAS float* Xl = Wl + 4096;
            for (int it = vcu; it < 256; it += G) {
                const int combo = it & 15, jb = it >> 4; const int l = combo >> 3, g = (combo >> 1) & 3, which = combo & 1;
                const float* Wg = four_w + (size_t)(l * 4 + g) * 4096; const LAS float* tb = trig + which * 64;
                const float* wi = w_in + (size_t)l * 1024 * 1280 + (size_t)(jb * 64) * 1280 + 1024 + g * 64;
                __syncthreads();
#pragma unroll
                for (int i = 0; i < 2; ++i) { const int idx = tid + 512 * i; *(LAS f32x4*)(Wl + 4 * idx) = *(const f32x4*)(Wg + 4 * idx); const int j = idx >> 4, c4 = idx & 15; *(LAS f32x4*)(Xl + j * 64 + 4 * c4) = *(const f32x4*)(wi + (size_t)j * 1280 + 4 * c4); }
                __syncthreads();
                { const int d = tid & 63, c0 = tid >> 6;
#pragma unroll 2
                  for (int i = 0; i < 8; ++i) { const int c = c0 + 8 * i; float a = 0.f;
#pragma unroll 16
                      for (int m = 0; m < 64; ++m) a += tb[(m * c) & 63] * Wl[m * 64 + d];
                      Al[c * 64 + d] = a; } }
                __syncthreads();
                { const int d = tid & 63, jl = 8 * (tid >> 6);
                  float o[8] = {0.f, 0.f, 0.f, 0.f, 0.f, 0.f, 0.f, 0.f};
#pragma unroll 4
                  for (int c = 0; c < 64; ++c) { const float av = Al[c * 64 + d];
#pragma unroll
                      for (int i = 0; i < 8; ++i) o[i] += Xl[(jl + i) * 64 + c] * av; }
                  v4u w; w.x = pk2(o[0], o[1]); w.y = pk2(o[2], o[3]); w.z = pk2(o[4], o[5]); w.w = pk2(o[6], o[7]);
                  *(v4u*)((bf16*)(ws + O_WIN + l * SZ_WIN1) + (size_t)(1024 + which * 256 + g * 64 + d) * 1024 + jb * 64 + jl) = w; }
            }
            for (int it = vcu; it < 256; it += G) {
                const int combo = it & 7, nb = it >> 3; const int l = combo >> 2, g = combo & 3, n0 = nb * 32;
                const float* pwg = pool_w + (size_t)(l * 4 + g) * 4096;
                __syncthreads();
#pragma unroll
                for (int i = 0; i < 2; ++i) { const int idx = tid + 512 * i; *(LAS f32x4*)(Wl + 4 * idx) = *(const f32x4*)(pwg + 4 * idx); }
                for (int i = tid; i < 2048; i += 512) { const int d = i >> 5, n = i & 31; Xl[i] = pool_scale[l * 256 + g * 64 + d] * w_out[(size_t)l * 1024 * 1024 + (size_t)(g * 64 + d) * 1024 + n0 + n]; }
                __syncthreads();
                { const int n = tid & 31, c0 = 4 * (tid >> 5);
                  float o[4] = {0.f, 0.f, 0.f, 0.f};
#pragma unroll 8
                  for (int d = 0; d < 64; ++d) { const float sv = Xl[d * 32 + n];
#pragma unroll
                      for (int i = 0; i < 4; ++i) o[i] += Wl[(c0 + i) * 64 + d] * sv; }
                  v2u w; w.x = pk2(o[0], o[1]); w.y = pk2(o[2], o[3]);
                  *(v2u*)((bf16*)(ws + O_WOUT + l * SZ_WOUT1) + (size_t)(n0 + n) * 1024 + g * 64 + c0) = w; }
            }
            __syncthreads();
        }
        if (rep_ == 0 || ((REP_MASK >> 16) & 1)) {
            LAS bf16* scr = (LAS bf16*)(lds + wave * 16384);
#pragma clang loop vectorize(disable) unroll(disable)
            for (int it0 = gw; it0 < CV_L; it0 += NGW) conv_item(KA, 0, it0, scr, lane);
        }
    }
    SEAM(0);
    if ((REP_MASK >> 12) & 1) { for (int k_ = 0; k_ < 4; ++k_) xcd_barrier(bar); }

    layer_body<0>(lds, G, vcu, bar, lo, hi);
    layer_body<1>(lds, G, vcu, bar, lo, hi);
    if (IN(17)) {
        KA_DECL
        const float* modp = modv + (size_t)5 * 6144;
#pragma clang loop vectorize(disable) unroll(disable)
        for (int r = gw; r < T; r += NGW) {
            const float* g2 = modp + (r >> 12) * 6144 + 5 * 1024; float* dst = outp + (size_t)r * 1024;
#pragma unroll
            for (int j = 0; j < 4; ++j) {
                const int c0 = 4 * lane + 256 * j; f32x4 v = *(const f32x4*)(dst + c0);
                const v2u ya = *(const v2u*)(y2 + (size_t)(2 * r) * 1024 + c0), yb = *(const v2u*)(y2 + (size_t)(2 * r + 1) * 1024 + c0);
                const f32x4 gv = *(const f32x4*)(g2 + c0);
                f32x4 yy; yy[0] = bflo(ya.x) + bflo(yb.x); yy[1] = bfhi(ya.x) + bfhi(yb.x); yy[2] = bflo(ya.y) + bflo(yb.y); yy[3] = bfhi(ya.y) + bfhi(yb.y);
                if (DBG_NO_MOE) yy = (f32x4){0.f, 0.f, 0.f, 0.f};
                *(f32x4*)(dst + c0) = v + gv * yy;
            }
        }
    }
#undef IN
#undef SEAM
}

#undef KA_DECL
#undef ws
#undef ctl
#undef x_in
#undef c_in
#undef ctx_in
#undef cctx_in
#undef w_mod
#undef b_mod
#undef norm1_g
#undef w_in
#undef q_norm_g
#undef k_norm_g
#undef attn_sink
#undef pool_w
#undef pool_scale
#undef four_w
#undef w_out
#undef norm2_g
#undef w_grp
#undef b_grp
#undef w_rtr
#undef b_rtr
#undef w_gate
#undef w_up
#undef w_down
#undef outp
#undef modv
#undef rope
#undef twt
#undef fma
#undef fmb
#undef fmc
#undef hbuf
#undef kall
#undef vall
#undef xc
#undef list
#undef wts
#undef act
#undef t2
#undef mrg
#undef qb
#undef pu
#undef zb
#undef y2
#undef modl
#undef win_t
#undef wout_t
#undef wgu_t
#undef wd_t
extern "C" void kernel_launch(void* const* d_in, const int* in_sizes, int n_in, void* d_out, int out_size, void* d_ws, size_t ws_size, hipStream_t stream) {
    static int grid = 0;
    if (grid == 0) {
        if (n_in != 23 || out_size != T * DM || ws_size < WS_END) { fprintf(stderr, "kernel_launch: unexpected shapes (n_in %d out %d ws %zu need %zu)\n", n_in, out_size, ws_size, (size_t)WS_END); grid = -1; return; }
        int dev = 0, cus = 0;
        if (hipGetDevice(&dev) != hipSuccess || hipDeviceGetAttribute(&cus, hipDeviceAttributeMultiprocessorCount, dev) != hipSuccess) { grid = -1; return; }
        if (cus != 256) { fprintf(stderr, "kernel_launch: built for a 256-CU device (row-tile hand-offs are laid out for 256 workgroups); found %d CUs; nothing launched\n", cus); grid = -1; return; }
        if (hipFuncSetAttribute((const void*)fwd_kernel, hipFuncAttributeMaxDynamicSharedMemorySize, LDS_BYTES) != hipSuccess) { fprintf(stderr, "kernel_launch: hipFuncSetAttribute failed\n"); grid = -1; return; }
        (void)hipGetLastError();
        grid = cus;
    }
    if (grid < 0) return;
    (void)hipMemsetAsync((char*)d_ws + O_CTL, 0, SZ_CTL, stream);
    Args a{};
    for (int i = 0; i < 23; ++i) a.in[i] = (const float*)d_in[i];
    a.out = (float*)d_out; a.ws = (unsigned char*)d_ws;
#if MK_SPLIT
    for (int p = 0; p < NPHASE; ++p) { a.ph_lo = p; a.ph_hi = p + 1; hipLaunchKernelGGL(fwd_kernel, dim3(grid), dim3(512), LDS_BYTES, stream, a); }
#else
    a.ph_lo = 0; a.ph_hi = NPHASE;
    hipLaunchKernelGGL(fwd_kernel, dim3(grid), dim3(512), LDS_BYTES, stream, a);
#endif
}
```

```cpp
#include <hip/hip_runtime.h>
#include <cstdio>
#include <cstdint>

#define DBG_NO_FOUR 0
#define DBG_NO_POOL 0
#define DBG_NO_ATT 0
#define DBG_NO_MOE 0
#define DBG_MOE_SCALE 1.0f
#define DBG_NAIVE_MOE 0
#define REP_MASK 0x0
#define DBG_NAIVE_ROUTE 0
#define LAS __attribute__((address_space(3)))
#define GAS __attribute__((address_space(1)))
typedef unsigned short bf16;
typedef short bf16x8 __attribute__((ext_vector_type(8)));
typedef float f32x4 __attribute__((ext_vector_type(4)));
typedef float f32x16 __attribute__((ext_vector_type(16)));
typedef unsigned v4u __attribute__((ext_vector_type(4)));
typedef unsigned v2u __attribute__((ext_vector_type(2)));
typedef GAS unsigned gu32;

#ifndef MK_SPLIT
#define MK_SPLIT 0
#endif

constexpr int NB = 4, NSEQ = 4096, DM = 1024, LCTX = 256, DEPTH = 2;
constexpr int T = NB * NSEQ, TC = NB * LCTX, TT = T + TC;
constexpr int KVROWS = LCTX + NSEQ;
constexpr int NEXP = 16, DEXP = 512;
constexpr int NPHASE = 18;
constexpr int MAXTILES = 152;
constexpr float QSCALE = 0.125f * 1.4426950408889634f;
constexpr float LOG2E = 1.4426950408889634f;

constexpr size_t al256(size_t x) { return (x + 255) & ~(size_t)255; }
constexpr size_t O_CTL = 0, SZ_CTL = 1u << 20;
constexpr size_t O_MOD = O_CTL + SZ_CTL, SZ_MOD = (size_t)2 * 5 * 6144 * 4;
constexpr size_t O_ROPE = al256(O_MOD + SZ_MOD), SZ_ROPE = (size_t)4096 * 32 * 8;
constexpr size_t O_TW = al256(O_ROPE + SZ_ROPE), SZ_TW = 4096 * 8;
constexpr size_t O_FMA = al256(O_TW + SZ_TW), SZ_FMA = 128 * 128 * 2;
constexpr size_t O_FMB = al256(O_FMA + SZ_FMA), SZ_FMB = 64 * 128 * 2;
constexpr size_t O_FMC = al256(O_FMB + SZ_FMB), SZ_FMC = 256 * 512 * 2;
constexpr size_t O_RW = al256(O_FMC + SZ_FMC), SZ_RW = (size_t)2 * 20480 * 4;
constexpr size_t O_WIN8 = al256(O_RW + SZ_RW), SZ_WIN8 = (size_t)768 * 1024;
constexpr size_t O_WIN = al256(O_WIN8 + 2 * SZ_WIN8), SZ_WIN1 = (size_t)1536 * 1024 * 2;
constexpr size_t O_WOUT = al256(O_WIN + 2 * SZ_WIN1), SZ_WOUT1 = (size_t)1024 * 1024 * 2;
constexpr size_t O_WGU = al256(O_WOUT + 2 * SZ_WOUT1), SZ_WGU1 = (size_t)16 * 1024 * 1024 * 2;
constexpr size_t O_WD = al256(O_WGU + 2 * SZ_WGU1), SZ_WD1 = (size_t)16 * 1024 * 512 * 2;
constexpr size_t O_H = al256(O_WD + 2 * SZ_WD1), SZ_H = (size_t)TT * 1024 * 2;
constexpr size_t O_KALL = al256(O_H + SZ_H), SZ_KV = (size_t)NB * KVROWS * 128 * 2;
constexpr size_t O_VALL = al256(O_KALL + SZ_KV);
constexpr size_t O_XC = al256(O_VALL + SZ_KV), SZ_XC = (size_t)TC * 1024 * 4;
constexpr size_t O_LIST = al256(O_XC + SZ_XC), SZ_LIST = (size_t)NEXP * TT * 4;
constexpr size_t O_WTS = al256(O_LIST + SZ_LIST), SZ_WTS = (size_t)TT * 2 * 4;
constexpr size_t O_EID = al256(O_WTS + SZ_WTS), SZ_EID = (size_t)TT * 2 * 4;
constexpr size_t O_ACT = al256(O_EID + SZ_EID), SZ_ACT = (size_t)MAXTILES * 256 * 512 * 2;
constexpr size_t O_T2 = O_ACT, SZ_T2 = (size_t)NB * 64 * 64 * 2 * 256 * 2;
constexpr size_t O_MRG = al256(O_ACT + SZ_ACT), SZ_MRG = (size_t)TT * 1024 * 2;
constexpr size_t O_Q = al256(O_MRG + SZ_MRG), SZ_Q = (size_t)TT * 512 * 2;
constexpr size_t O_PU = al256(O_Q + SZ_Q), SZ_PU = (size_t)TT * 256 * 2;
constexpr size_t O_Z = al256(O_PU + SZ_PU), SZ_Z = (size_t)TT * 512 * 2;
constexpr size_t O_Y2 = O_MRG, SZ_Y2 = (size_t)TT * 2 * 1024 * 2;
constexpr size_t WS_END = al256(O_Z + SZ_Z);
static_assert(SZ_T2 <= SZ_ACT, "T2 overlay");
static_assert(O_Y2 + SZ_Y2 <= WS_END, "y2 overlay");

constexpr int CW_TMO = 0;
constexpr int CW_BAR = 4096;
constexpr int CW_KF = 65536;
constexpr int CW_FA = 3072;
constexpr int CW_G2 = 40960;
constexpr int CW_RDY = 32768;
constexpr int CW_Q = 2048;
constexpr int CW_DONE = 2560;
constexpr int CW_CNT = 16384;

constexpr int RING_BYTES = 131072;
constexpr int LDSCTL_OFF = RING_BYTES, MISC_OFF = LDSCTL_OFF + 320;
constexpr int TRIG_OFF = LDSCTL_OFF + 1024;
constexpr int TILE_OFF = LDSCTL_OFF + 2048;
constexpr int LDS_BYTES = 147456;

#define RLX_AGENT __ATOMIC_RELAXED, __HIP_MEMORY_SCOPE_AGENT
#define LDS_WAIT() asm volatile("s_waitcnt lgkmcnt(0)" ::: "memory")
#define VM_WAIT() asm volatile("s_waitcnt vmcnt(0)" ::: "memory")

__device__ __forceinline__ unsigned f2bf(float f) { unsigned u = __builtin_bit_cast(unsigned, f); return (u + 0x7fffu + ((u >> 16) & 1u)) >> 16; }
__device__ __forceinline__ unsigned pk2(float lo, float hi) { return f2bf(lo) | (f2bf(hi) << 16); }
__device__ __forceinline__ unsigned pk4_f8(float a, float b, float c, float d) { unsigned w = 0; w = __builtin_amdgcn_cvt_pk_fp8_f32(a, b, w, false); w = __builtin_amdgcn_cvt_pk_fp8_f32(c, d, w, true); return w; }
__device__ __forceinline__ float bflo(unsigned w) { return __builtin_bit_cast(float, w << 16); }
__device__ __forceinline__ float bfhi(unsigned w) { return __builtin_bit_cast(float, w & 0xffff0000u); }
__device__ __forceinline__ float bf2f(bf16 h) { return __builtin_bit_cast(float, (unsigned)h << 16); }
template <int CTRL, int RM> __device__ __forceinline__ float dppf(float v) { return __builtin_bit_cast(float, __builtin_amdgcn_update_dpp(0, __builtin_bit_cast(int, v), CTRL, RM, 0xf, true)); }
__device__ __forceinline__ float wave_sum(float v) {
    v += dppf<0x111, 0xf>(v); v += dppf<0x112, 0xf>(v); v += dppf<0x114, 0xf>(v); v += dppf<0x118, 0xf>(v);
    v += dppf<0x142, 0xa>(v); v += dppf<0x143, 0xc>(v);
    return __builtin_bit_cast(float, __builtin_amdgcn_readlane(__builtin_bit_cast(int, v), 63));
}

__device__ __forceinline__ float swap32_sum(float x, float y) {
    const auto rr = __builtin_amdgcn_permlane32_swap(__builtin_bit_cast(unsigned, x), __builtin_bit_cast(unsigned, y), false, false);
    unsigned r0 = rr[0], r1 = rr[1]; asm volatile("" : "+v"(r0), "+v"(r1));
    return __builtin_bit_cast(float, r0) + __builtin_bit_cast(float, r1);
}
__device__ __forceinline__ float swap16_sum(float x, float y) {
    const auto rr = __builtin_amdgcn_permlane16_swap(__builtin_bit_cast(unsigned, x), __builtin_bit_cast(unsigned, y), false, false);
    unsigned r0 = rr[0], r1 = rr[1]; asm volatile("" : "+v"(r0), "+v"(r1));
    return __builtin_bit_cast(float, r0) + __builtin_bit_cast(float, r1);
}

#define XB_TMO      128
#define XB_XCNT(j)  (256  + 64 * (j))
#define XB_XSUB(j)  (1280 + 64 * (j))
#define XB_XGEN(j)  (2304 + 64 * (j))
#define XB_TOP      3328
#define XB_TOPGEN   3392
#define XCD_BAR_WORDS 3456
#define XB_SPIN_CAP (1u << 18)
__device__ __forceinline__ unsigned xb_ld(unsigned* p)              { return __hip_atomic_load(p, __ATOMIC_RELAXED, __HIP_MEMORY_SCOPE_AGENT); }
__device__ __forceinline__ unsigned xb_add(unsigned* p, unsigned v) { return __hip_atomic_fetch_add(p, v, __ATOMIC_RELAXED, __HIP_MEMORY_SCOPE_AGENT); }
__device__ __forceinline__ unsigned xb_xcc_id() { return (unsigned)__builtin_amdgcn_s_getreg((3 << 11) | 20) & 0xFu; }
#define XB_SPIN(cond, bar) do { unsigned _sp = 0; while (cond) { __builtin_amdgcn_s_sleep(1); \
    if ((++_sp & 255u) == 0u) { if (xb_ld(&(bar)[XB_TMO])) break; if (_sp > XB_SPIN_CAP) { atomicAdd(&(bar)[XB_TMO], 1u); break; } } } } while (0)
struct XcdBarrier { unsigned* bar; unsigned x; volatile LAS unsigned* st; };
__device__ __forceinline__ XcdBarrier xcd_barrier_post(unsigned* bar, volatile LAS unsigned* st) {
    XcdBarrier b; b.bar = bar; b.x = xb_xcc_id(); b.st = st;
    if (threadIdx.x == 0) (void)xb_add(&bar[XB_XCNT(b.x)], 1u);
    return b;
}
__device__ __forceinline__ void xcd_barrier_complete(unsigned* bar, unsigned x, unsigned& nloc, unsigned& nx) {
    const unsigned G = gridDim.x * gridDim.y * gridDim.z;
    unsigned sum, cnt, mine, sp = 0u;
    for (;;) {
        sum = 0u; cnt = 0u; mine = 0u;
#pragma unroll
        for (unsigned j = 0; j < 16; ++j) { const unsigned c = xb_ld(&bar[XB_XCNT(j)]); sum += c; cnt += (c > 0u) ? 1u : 0u; mine = (j == x) ? c : mine; }
        if (sum == G) break;
        __builtin_amdgcn_s_sleep(1);
        if ((++sp & 255u) == 0u) { if (xb_ld(&bar[XB_TMO])) break; if (sp > XB_SPIN_CAP) { atomicAdd(&bar[XB_TMO], 1u); break; } }
    }
    nloc = mine > 0u ? mine : 1u; nx = cnt > 0u ? cnt : 1u;
}
__device__ __forceinline__ void xcd_barrier(const XcdBarrier& b) {
    asm volatile("s_waitcnt vmcnt(0)" ::: "memory");
    __syncthreads();
    if (threadIdx.x == 0) {
        unsigned* bar = b.bar;
        __builtin_amdgcn_s_waitcnt(0);
        unsigned nloc = b.st[0], nx = b.st[1];
        if (nloc == 0u) { xcd_barrier_complete(bar, b.x, nloc, nx); b.st[0] = nloc; b.st[1] = nx; }
        const unsigned old = xb_add(&bar[XB_XSUB(b.x)], 1u);
        const unsigned gen = old / nloc;
        if (old + 1u == (gen + 1u) * nloc) {
            __builtin_amdgcn_fence(__ATOMIC_RELEASE, "agent");
            asm volatile("s_waitcnt vmcnt(0)" ::: "memory");
            const unsigned og = xb_add(&bar[XB_TOP], 1u);
            const unsigned tg = og / nx;
            if (og + 1u == (tg + 1u) * nx) xb_add(&bar[XB_TOPGEN], 1u);
            else XB_SPIN(xb_ld(&bar[XB_TOPGEN]) == tg, bar);
            __builtin_amdgcn_fence(__ATOMIC_ACQUIRE, "agent");
            xb_add(&bar[XB_XGEN(b.x)], 1u);
            asm volatile("s_waitcnt vmcnt(0)" ::: "memory");
        } else {
            XB_SPIN(xb_ld(&bar[XB_XGEN(b.x)]) == gen, bar);
            __builtin_amdgcn_fence(__ATOMIC_ACQUIRE, "agent");
            asm volatile("s_waitcnt vmcnt(0)" ::: "memory");
        }
    }
    __syncthreads();
}

namespace pg8 {
constexpr int BM = 256, BK = 64, HALF = 128, HTB = HALF * BK * 2;
__host__ __device__ __forceinline__ int lds_byte(int r, int c) { const int st = (r >> 4) * 2 + (c >> 5), rr = r & 15, cc = c & 31, ob = rr * 64 + cc * 2; return st * 1024 + (ob ^ (((ob >> 9) & 1) << 5)); }
__host__ __device__ __forceinline__ void stage_rc(int b, int& R, int& C) { const int st = b / 1024, sb = b % 1024, swz = sb ^ (((sb >> 9) & 1) << 5); R = (st >> 1) * 16 + swz / 64; C = (st & 1) * 32 + (swz % 64) / 2; }
__host__ __device__ __forceinline__ int perm32(int rho) { const int n = rho >> 4, i = rho & 15; return 8 * (i >> 2) + 4 * n + (i & 3); }

struct Unit { int pm, pn, e, cnt, kind; };

typedef int v8i __attribute__((ext_vector_type(8)));
typedef int v4i __attribute__((ext_vector_type(4)));
template <class Epi, class Sched, bool F8ALL = false>
__device__ __forceinline__ void gemm_phase(LAS unsigned char* lds, const Sched& S, const Epi& E) {
    int tid = threadIdx.x; asm volatile("" : "+v"(tid));
    const int wid = __builtin_amdgcn_readfirstlane(tid >> 6), lane = tid & 63, wr = wid >> 2, wc = wid & 3, fr = lane & 15, fq = lane >> 4;
#define PG8_RC() int RA[2], CA[2], RB[2]; { int tl_ = tid; asm volatile("" : "+v"(tl_)); _Pragma("unroll") for (int i = 0; i < 2; ++i) { int R, C; stage_rc(tl_ * 16 + i * 8192, R, C); RA[i] = R; CA[i] = C; RB[i] = Epi::PERM ? ((R & ~31) + perm32(R & 31)) : R; } }
    const size_t kstep = (size_t)(BK * 2);
    const unsigned ldsw = (unsigned)wid * 1024u;
    const int aoff = lds_byte(wr * 64 + fr, fq * 8), boff = lds_byte(wc * 32 + fr, fq * 8);
#define PG8_SA(b, h) (((b) * 2 + (h)) * HTB)
#define PG8_SB(b, h) ((4 + (b) * 2 + (h)) * HTB)
#define PG8_STAGE2(bufoff, gbase, o0, o1) do { \
        __builtin_amdgcn_global_load_lds((const unsigned*)((const char*)(gbase) + (o0)), (LAS unsigned*)(lds + (bufoff) + ldsw), 16, 0, 0); \
        __builtin_amdgcn_global_load_lds((const unsigned*)((const char*)(gbase) + (o1)), (LAS unsigned*)(lds + (bufoff) + ldsw + 8192), 16, 0, 0); } while (0)
#define PG8_LD8(p) __builtin_shufflevector(*(const LAS v4i*)(p), *(const LAS v4i*)((p) + 1024), 0, 1, 2, 3, 4, 5, 6, 7)
#define PG8_LDA(dst, b, h) do { _Pragma("unroll") for (int m = 0; m < 4; ++m) dst[m] = PG8_LD8(lds + PG8_SA(b, h) + aoff + m * 2048); } while (0)
#define PG8_LDB(dst, b, h) do { _Pragma("unroll") for (int n = 0; n < 2; ++n) dst[n] = PG8_LD8(lds + PG8_SB(b, h) + boff + n * 2048); } while (0)
#define PG8_LO(x) __builtin_bit_cast(bf16x8, __builtin_shufflevector(x, x, 0, 1, 2, 3))
#define PG8_HI(x) __builtin_bit_cast(bf16x8, __builtin_shufflevector(x, x, 4, 5, 6, 7))
#define PG8_MMA(ai, bj, At, Bt) do { __builtin_amdgcn_s_setprio(1); \
        if (F8ALL) { _Pragma("unroll") for (int m = 0; m < 4; ++m) _Pragma("unroll") for (int n = 0; n < 2; ++n) \
            asm volatile("v_mfma_scale_f32_16x16x128_f8f6f4 %0, %1, %2, %0, %3, %3 op_sel_hi:[0,0,0]" : "+v"(acc[ai][bj][m][n]) : "v"(Bt[n]), "v"(At[m]), "v"(f8sc)); } \
        else { _Pragma("unroll") for (int m = 0; m < 4; ++m) _Pragma("unroll") for (int n = 0; n < 2; ++n) { \
            acc[ai][bj][m][n] = __builtin_amdgcn_mfma_f32_16x16x32_bf16(PG8_LO(Bt[n]), PG8_LO(At[m]), acc[ai][bj][m][n], 0, 0, 0); \
            acc[ai][bj][m][n] = __builtin_amdgcn_mfma_f32_16x16x32_bf16(PG8_HI(Bt[n]), PG8_HI(At[m]), acc[ai][bj][m][n], 0, 0, 0); } } \
        __builtin_amdgcn_s_setprio(0); } while (0)
#define PG8_WAIT_V(n) asm volatile("s_waitcnt vmcnt(" #n ")" ::: "memory")
#define PG8_WAIT_L(n) asm volatile("s_waitcnt lgkmcnt(" #n ")" ::: "memory")
#define PG8_BAR __builtin_amdgcn_s_barrier()
#define PG8_SCHED __builtin_amdgcn_sched_barrier(0)
    Unit cur, nxt; int ui = 0;
    if (!S.next(0, cur)) return;
    f32x4 acc[2][2][4][2];
#pragma unroll
    for (int a = 0; a < 2; ++a)
#pragma unroll
        for (int b = 0; b < 2; ++b)
#pragma unroll
            for (int m = 0; m < 4; ++m)
#pragma unroll
                for (int n = 0; n < 2; ++n) acc[a][b][m][n] = (f32x4){0.f, 0.f, 0.f, 0.f};
    v8i At[4], B0[2], B1[2];
    int f8sc = 0x7c7c7c7c; asm volatile("" : "+v"(f8sc));
    int Kc = S.K(cur), Kn; const char* Ac = S.a_base(cur); const char* An; const char* cB = S.b_ptr(cur); const char* nB;
    unsigned oc00, oc01, oc10, oc11, on00, on01, on10, on11, vbc0, vbc1, vbn0, vbn1; size_t hsc, hsn;
    { PG8_RC()
    oc00 = S.a_off(cur, RA[0], CA[0]); oc01 = S.a_off(cur, RA[1], CA[1]); oc10 = S.a_off(cur, HALF + RA[0], CA[0]); oc11 = S.a_off(cur, HALF + RA[1], CA[1]);
    vbc0 = (unsigned)(RB[0] * Kc + CA[0]) * 2u; vbc1 = (unsigned)(RB[1] * Kc + CA[1]) * 2u; hsc = (size_t)HALF * Kc * 2; }
    S.a_ready(cur);
    PG8_STAGE2(PG8_SB(0, 0), cB, vbc0, vbc1); PG8_STAGE2(PG8_SB(0, 1), cB + hsc, vbc0, vbc1); PG8_STAGE2(PG8_SA(0, 0), Ac, oc00, oc01); PG8_STAGE2(PG8_SA(0, 1), Ac, oc10, oc11);
    if (wr == 1) PG8_BAR;
    PG8_WAIT_V(2); PG8_BAR;
    PG8_STAGE2(PG8_SB(1, 0), cB + kstep, vbc0, vbc1); PG8_STAGE2(PG8_SA(1, 0), Ac + kstep, oc00, oc01); PG8_STAGE2(PG8_SB(1, 1), cB + hsc + kstep, vbc0, vbc1);
    PG8_WAIT_V(6); PG8_BAR;
    for (;;) {
        const bool has_next = S.next(ui + 1, nxt);
        Kn = Kc; An = Ac; nB = cB; on00 = oc00; on01 = oc01; on10 = oc10; on11 = oc11; vbn0 = vbc0; vbn1 = vbc1; hsn = hsc;
        if (has_next) { Kn = S.K(nxt); An = S.a_base(nxt); nB = S.b_ptr(nxt); PG8_RC()
            on00 = S.a_off(nxt, RA[0], CA[0]); on01 = S.a_off(nxt, RA[1], CA[1]); on10 = S.a_off(nxt, HALF + RA[0], CA[0]); on11 = S.a_off(nxt, HALF + RA[1], CA[1]);
            vbn0 = (unsigned)(RB[0] * Kn + CA[0]) * 2u; vbn1 = (unsigned)(RB[1] * Kn + CA[1]) * 2u; hsn = (size_t)HALF * Kn * 2; }
        const int nt = Kc / BK;
#pragma clang loop unroll(disable)
        for (int t = 0; t < nt; t += 2) {
            const bool last = (t == nt - 2);
            if (last && has_next) S.a_ready(nxt);
            const char* a1 = Ac + (size_t)(t + 1) * kstep;
            const char* a2 = last ? An : Ac + (size_t)(t + 2) * kstep; const char* b2 = last ? nB : cB + (size_t)(t + 2) * kstep;
            const char* a3 = a2 + kstep; const char* b3 = b2 + kstep;
            const unsigned x00 = last ? on00 : oc00, x01 = last ? on01 : oc01, x10 = last ? on10 : oc10, x11 = last ? on11 : oc11;
            const unsigned y0 = last ? vbn0 : vbc0, y1 = last ? vbn1 : vbc1; const size_t hs2 = last ? hsn : hsc;
            PG8_LDB(B0, 0, 0); PG8_LDB(B1, 0, 1); PG8_SCHED; PG8_LDA(At, 0, 0); PG8_STAGE2(PG8_SA(1, 1), a1, oc10, oc11);
            PG8_WAIT_V(8); PG8_WAIT_L(0); PG8_BAR; PG8_MMA(0, 0, At, B0); PG8_MMA(0, 1, At, B1); PG8_BAR; PG8_SCHED;
            PG8_LDA(At, 0, 1); PG8_STAGE2(PG8_SB(0, 0), b2, y0, y1); PG8_STAGE2(PG8_SB(0, 1), b2 + hs2, y0, y1); PG8_STAGE2(PG8_SA(0, 0), a2, x00, x01);
            PG8_WAIT_V(8); PG8_WAIT_L(0); PG8_BAR; PG8_MMA(1, 0, At, B0); PG8_MMA(1, 1, At, B1); PG8_BAR; PG8_SCHED;
            PG8_LDB(B0, 1, 0); PG8_LDB(B1, 1, 1); PG8_SCHED; PG8_LDA(At, 1, 0); PG8_STAGE2(PG8_SA(0, 1), a2, x10, x11);
            PG8_WAIT_V(8); PG8_WAIT_L(0); PG8_BAR; PG8_MMA(0, 0, At, B0); PG8_MMA(0, 1, At, B1); PG8_BAR; PG8_SCHED;
            PG8_LDA(At, 1, 1); PG8_STAGE2(PG8_SB(1, 0), b3, y0, y1); PG8_STAGE2(PG8_SB(1, 1), b3 + hs2, y0, y1); PG8_STAGE2(PG8_SA(1, 0), a3, x00, x01);
            PG8_WAIT_V(8); PG8_WAIT_L(0); PG8_BAR; PG8_MMA(1, 0, At, B0); PG8_MMA(1, 1, At, B1); PG8_BAR; PG8_SCHED;
        }
        if (wr == 0) PG8_BAR;
        if (F8ALL) asm volatile("s_nop 15\n\ts_nop 15" ::: "memory");
        E(acc, cur, wr, wc, fr, fq);
        if (!has_next) break;
#pragma unroll
        for (int a = 0; a < 2; ++a)
#pragma unroll
            for (int b = 0; b < 2; ++b)
#pragma unroll
                for (int m = 0; m < 4; ++m)
#pragma unroll
                    for (int n = 0; n < 2; ++n) acc[a][b][m][n] = (f32x4){0.f, 0.f, 0.f, 0.f};
        cur = nxt; Kc = Kn; Ac = An; cB = nB; oc00 = on00; oc01 = on01; oc10 = on10; oc11 = on11; vbc0 = vbn0; vbc1 = vbn1; hsc = hsn; ++ui;
        if (wr == 1) PG8_BAR;
    }
    PG8_WAIT_V(0);
    PG8_BAR;
#undef PG8_RC
#undef PG8_SA
#undef PG8_SB
#undef PG8_STAGE2
#undef PG8_LDA
#undef PG8_LD8
#undef PG8_LO
#undef PG8_HI
#undef PG8_LDB
#undef PG8_MMA
#undef PG8_WAIT_V
#undef PG8_WAIT_L
#undef PG8_BAR
#undef PG8_SCHED
}
}

__device__ __forceinline__ void store16_wt(void* p, v4u v) { asm volatile("global_store_dwordx4 %0, %1, off sc1\n\ts_nop 1" :: "v"(p), "v"(v) : "memory"); }
__device__ __forceinline__ int krow_of(int r) {
    if (r < T) return (r >> 12) * KVROWS + LCTX + (r & 4095);
    const int rc = r - T; return (rc >> 8) * KVROWS + (rc & 255);
}
struct SchedPlain {
    int nM, nN, G, vcu, Kk; const char* A; const char* B;
    __device__ __forceinline__ bool next(int i, pg8::Unit& u) const { const int L = i * G + vcu; if (L >= nM * nN) return false; u.pm = L / nN; u.pn = L % nN; u.e = 0; u.cnt = 256; u.kind = 0; return true; }
    __device__ __forceinline__ int K(const pg8::Unit&) const { return Kk; }
    __device__ __forceinline__ const char* a_base(const pg8::Unit&) const { return A; }
    __device__ __forceinline__ unsigned a_off(const pg8::Unit& u, int row, int col) const { return (unsigned)((u.pm * 256 + row) * Kk + col) * 2u; }
    __device__ __forceinline__ const char* b_ptr(const pg8::Unit& u) const { return B + (size_t)u.pn * 256 * Kk * 2; }
    __device__ __forceinline__ void a_ready(const pg8::Unit&) const {}
};
struct SchedG1 {
    int G, vcu, f8; const char* A; const char* B;
    __device__ __forceinline__ bool next(int i, pg8::Unit& u) const { const int L = i * G + (f8 ? G - 1 - vcu : vcu); if (L >= (TT / 256) * 3) return false;
        u.pm = L / 3; const int j = L % 3; u.pn = f8 ? 1 + j : (j == 0 ? 0 : 3 + j); u.e = 0; u.cnt = 256; u.kind = 0; return true; }
    __device__ __forceinline__ int K(const pg8::Unit&) const { return f8 ? 512 : 1024; }
    __device__ __forceinline__ const char* a_base(const pg8::Unit&) const { return A; }
    __device__ __forceinline__ unsigned a_off(const pg8::Unit& u, int row, int col) const { return (unsigned)((u.pm * 256 + row) * (f8 ? 512 : 1024) + col) * 2u; }
    __device__ __forceinline__ const char* b_ptr(const pg8::Unit& u) const { return f8 ? B + (size_t)(u.pn - 1) * 256 * 1024 : B + (size_t)u.pn * 256 * 1024 * 2; }
    __device__ __forceinline__ void a_ready(const pg8::Unit&) const {}
};
struct EpiG1 {
    static constexpr bool PERM = true;
    bf16 *pu, *q, *kall, *vall, *z;
    __device__ __forceinline__ void operator()(const f32x4 (&acc)[2][2][4][2], const pg8::Unit& u, int wr, int wc, int fr, int fq) const {
        const int row0 = u.pm * 256 + wr * 64 + fr, c8 = wc * 32 + 8 * fq;
#pragma unroll
        for (int ai = 0; ai < 2; ++ai)
#pragma unroll
            for (int m = 0; m < 4; ++m) {
                const int row = row0 + ai * 128 + m * 16;
#pragma unroll
                for (int bj = 0; bj < 2; ++bj) {
                    const f32x4 v0 = acc[ai][bj][m][0], v1 = acc[ai][bj][m][1];
                    v4u w; w.x = pk2(v0[0], v0[1]); w.y = pk2(v0[2], v0[3]); w.z = pk2(v1[0], v1[1]); w.w = pk2(v1[2], v1[3]);
                    bf16* dst;
                    if (u.pn == 0) dst = pu + (size_t)row * 256 + bj * 128 + c8;
                    else if (u.pn <= 2) dst = q + (size_t)row * 512 + (u.pn - 1) * 256 + bj * 128 + c8;
                    else if (u.pn == 3) dst = (bj == 0 ? kall : vall) + (size_t)krow_of(row) * 128 + c8;
                    else dst = z + (size_t)row * 512 + (u.pn - 4) * 256 + bj * 128 + c8;
                    *(v4u*)dst = w;
                }
            }
    }
};
struct EpiG2 {
    static constexpr bool PERM = false;
    const float* xin; const float* cin; float* xout; float* cout; const float* mod; unsigned* ready;
    __device__ __forceinline__ void operator()(const f32x4 (&acc)[2][2][4][2], const pg8::Unit& u, int wr, int wc, int fr, int fq) const {
        const int rt0 = u.pm * 256; const bool isc = rt0 >= T;
        const int bsel = isc ? 4 : (rt0 >> 12);
        const float* g1 = mod + bsel * 6144 + 2048;
        const float* base = isc ? cin - (size_t)T * 1024 : xin; float* out = isc ? cout - (size_t)T * 1024 : xout;
        const int row0 = rt0 + wr * 64 + fr, col0 = u.pn * 256 + wc * 32 + 4 * fq;
#pragma unroll
        for (int bj = 0; bj < 2; ++bj)
#pragma unroll
            for (int n = 0; n < 2; ++n) {
                const int col = col0 + bj * 128 + n * 16; const f32x4 gv = *(const f32x4*)(g1 + col);
#pragma unroll
                for (int ai = 0; ai < 2; ++ai)
#pragma unroll
                    for (int m = 0; m < 4; ++m) { const size_t off = (size_t)(row0 + ai * 128 + m * 16) * 1024 + col; const f32x4 bs = *(const f32x4*)(base + off); const f32x4 o = bs + gv * acc[ai][bj][m][n]; store16_wt(out + off, __builtin_bit_cast(v4u, o)); }
            }
        asm volatile("s_waitcnt vmcnt(0)" ::: "memory");
        if ((threadIdx.x & 63) == 0) __hip_atomic_fetch_add(ready + 16 * u.pm, 1u, __ATOMIC_RELAXED, __HIP_MEMORY_SCOPE_AGENT);
    }
};
struct SchedMoe {
    int G, vcu, ntile;
    const char* hb; const char* actb; const char* wgu; const char* wd; const unsigned* list; const LAS int* tt; unsigned* ready; unsigned* tmo;
    __device__ __forceinline__ bool next(int i, pg8::Unit& u) const {
        const int U = ntile * 4; const int r = U % G, q = U / G; const int n3 = q + (vcu < r ? 1 : 0); int L;
        if (i < n3) { L = i * G + vcu; u.kind = 0; }
        else { const int j = i - n3; const int nl = G - r;
            if (vcu >= r) L = (j == 0) ? (vcu - r) : (j == 1) ? nl + (vcu - r) : 2 * nl + (j - 2) * G + vcu;
            else L = 2 * nl + j * G + vcu;
            if (L >= U) return false; u.kind = 1; }
        const int tau = L >> 2; u.pn = L & 3; u.pm = tau; int e = 0;
#pragma unroll
        for (int k = 1; k < 16; ++k) e += (tt[k] <= tau) ? 1 : 0;
        u.e = e; const int r0 = (tau - tt[e]) * 256; const int c = tt[17 + e] - r0; u.cnt = c < 256 ? c : 256; return true;
    }
    __device__ __forceinline__ int K(const pg8::Unit& u) const { return u.kind ? 256 : 512; }
    __device__ __forceinline__ const char* a_base(const pg8::Unit& u) const { return u.kind ? actb : hb; }
    __device__ __forceinline__ unsigned a_off(const pg8::Unit& u, int row, int col) const {
        if (u.kind) return (unsigned)((u.pm * 256 + row) * 256 + col) * 2u;
        const int r0 = (u.pm - tt[u.e]) * 256; const int rr = row < u.cnt ? row : u.cnt - 1;
        const unsigned tok = list[(size_t)u.e * TT + r0 + rr] >> 1;
        return (tok * 512u + (unsigned)col) * 2u;
    }
    __device__ __forceinline__ const char* b_ptr(const pg8::Unit& u) const { return u.kind ? wd + ((size_t)u.e * 1024 + (size_t)u.pn * 256) * 256 * 2 : wgu + ((size_t)u.e * 1024 + (size_t)u.pn * 256) * 512 * 2; }
    __device__ __forceinline__ void a_ready(const pg8::Unit& u) const {
        if (!u.kind) return;
        if (threadIdx.x < 64) {
            unsigned* w = ready + 16 * u.pm; unsigned sp = 0;
            while ((unsigned)__builtin_amdgcn_readfirstlane(__hip_atomic_load(w, __ATOMIC_RELAXED, __HIP_MEMORY_SCOPE_AGENT)) < 32u) {
                __builtin_amdgcn_s_sleep(2);
                if (++sp > (1u << 22)) { if (threadIdx.x == 0) __hip_atomic_store(tmo, 1u, __ATOMIC_RELAXED, __HIP_MEMORY_SCOPE_AGENT); break; } }
            __builtin_amdgcn_fence(__ATOMIC_ACQUIRE, "agent");
            asm volatile("s_waitcnt vmcnt(0)" ::: "memory");
        }
        asm volatile("" ::: "memory"); __builtin_amdgcn_s_barrier(); asm volatile("" ::: "memory");
    }
};
struct EpiG3 {
    static constexpr bool PERM = true;
    bf16* act; unsigned* ready;
    __device__ __forceinline__ void operator()(const f32x4 (&acc)[2][2][4][2], const pg8::Unit& u, int wr, int wc, int fr, int fq) const {
        const int row0 = u.pm * 256 + wr * 64 + fr, c8 = u.pn * 128 + wc * 32 + 8 * fq;
#pragma unroll
        for (int ai = 0; ai < 2; ++ai)
#pragma unroll
            for (int m = 0; m < 4; ++m) {
                float a[8];
#pragma unroll
                for (int n = 0; n < 2; ++n)
#pragma unroll
                    for (int k = 0; k < 4; ++k) { const float g = acc[ai][0][m][n][k], up = acc[ai][1][m][n][k]; a[n * 4 + k] = g / (1.f + __expf(-g)) * up; }
                const unsigned long long w8 = (unsigned long long)pk4_f8(a[0], a[1], a[2], a[3]) | ((unsigned long long)pk4_f8(a[4], a[5], a[6], a[7]) << 32);
                __hip_atomic_store((unsigned long long*)((unsigned char*)act + (size_t)(row0 + ai * 128 + m * 16) * 512 + c8), w8, __ATOMIC_RELAXED, __HIP_MEMORY_SCOPE_AGENT);
            }
        asm volatile("s_waitcnt vmcnt(0)" ::: "memory");
        if ((threadIdx.x & 63) == 0) __hip_atomic_fetch_add(ready + 16 * u.pm, 1u, __ATOMIC_RELAXED, __HIP_MEMORY_SCOPE_AGENT);
    }
};
struct EpiG4 {
    static constexpr bool PERM = true;
    bf16* y2; const unsigned* list; const float* wts; const LAS int* tt;
    __device__ __forceinline__ void operator()(const f32x4 (&acc)[2][2][4][2], const pg8::Unit& u, int wr, int wc, int fr, int fq) const {
        const int r0 = (u.pm - tt[u.e]) * 256; const int c8 = u.pn * 256 + wc * 32 + 8 * fq;
#pragma unroll
        for (int ai = 0; ai < 2; ++ai)
#pragma unroll
            for (int m = 0; m < 4; ++m) {
                const int row = wr * 64 + fr + ai * 128 + m * 16;
                if (row < u.cnt) {
                    const unsigned ent = list[(size_t)u.e * TT + r0 + row]; const float w = wts[ent];
#pragma unroll
                    for (int bj = 0; bj < 2; ++bj) {
                        const f32x4 v0 = acc[ai][bj][m][0] * w, v1 = acc[ai][bj][m][1] * w;
                        v4u o; o.x = pk2(v0[0], v0[1]); o.y = pk2(v0[2], v0[3]); o.z = pk2(v1[0], v1[1]); o.w = pk2(v1[2], v1[3]);
                        *(v4u*)(y2 + (size_t)ent * 1024 + bj * 128 + c8) = o;
                    }
                }
            }
    }
};

struct EpiMoe { static constexpr bool PERM = true; EpiG3 e3; EpiG4 e4;
    __device__ __forceinline__ void operator()(const f32x4 (&acc)[2][2][4][2], const pg8::Unit& u, int wr, int wc, int fr, int fq) const { if (u.kind) e4(acc, u, wr, wc, fr, fq); else e3(acc, u, wr, wc, fr, fq); } };

#include <hip/hip_bf16.h>
#include <cmath>
namespace attn_body {
using bf16=__hip_bfloat16;
using bf16x8=__attribute__((ext_vector_type(8)))short;
using s16x4=__attribute__((ext_vector_type(4)))short;
using f32x16=__attribute__((ext_vector_type(16)))float;
using u32x4=__attribute__((ext_vector_type(4)))unsigned;
constexpr int D=64,QP=512,KVP=128,OP=1024;
constexpr int NW=8,QBLK=32,KVBLK=64;
__device__ __forceinline__ int crow(int r,int hi){return (r&3)+8*(r>>2)+4*hi;}
#define SBAR() __builtin_amdgcn_sched_barrier(0)
__device__ __forceinline__ void wmask(f32x16&p0,f32x16&p1,int kp0,int qpos,int hi){
  const float NEG=-INFINITY; const bool tile_ok=(unsigned)kp0<4096u; const int base=kp0+4*hi-qpos+128;
  #pragma unroll
  for(int r=0;r<16;++r){const int dd=base+(r&3)+8*(r>>2); if(!tile_ok||(unsigned)dd>256u)p0[r]=NEG; if(!tile_ok||(unsigned)(dd+32)>256u)p1[r]=NEG;}
}
constexpr int NSLOT=3, SLOTB=8192;
constexpr int LDS_K=0, LDS_V=NSLOT*SLOTB, LDS_WS=2*NSLOT*SLOTB, LDS_OST=LDS_WS+NW*64*4, LDS_BYTES=LDS_OST+NW*4096;
constexpr float C2=0.125f*1.4426950408889634f;
__device__ __forceinline__ void glds16(const void*gsrc,unsigned lds_dst){unsigned keep;
  asm volatile("s_mov_b32 %0, m0\n\ts_mov_b32 m0, %2\n\ts_nop 0\n\tglobal_load_lds_dwordx4 %1, off\n\ts_mov_b32 m0, %0":"=&s"(keep):"v"(gsrc),"s"(lds_dst):"memory");}
__device__ __forceinline__ float max3f(float a,float b,float c){float r;asm("v_max3_f32 %0, %1, %2, %3":"=v"(r):"v"(a),"v"(b),"v"(c));return r;}
__device__ __forceinline__ float max2f(float a,float b){float r;asm("v_max_f32_e32 %0, %1, %2":"=v"(r):"v"(a),"v"(b));return r;}
__device__ __forceinline__ float fadd_s(float a,float b){float r;asm("v_add_f32_e32 %0, %1, %2":"=v"(r):"v"(a),"v"(b));return r;}
__device__ __forceinline__ float fsub_s(float a,float b){float r;asm("v_sub_f32_e32 %0, %1, %2":"=v"(r):"v"(a),"v"(b));return r;}
typedef float f32x2_t __attribute__((ext_vector_type(2))); typedef __bf16 bf16x2_t __attribute__((ext_vector_type(2)));
__device__ __forceinline__ unsigned cvtpk_s(float lo,float hi){f32x2_t v={lo,hi};bf16x2_t b=__builtin_convertvector(v,bf16x2_t);return __builtin_bit_cast(unsigned,b);}
#define WAIT_BAR(N) asm volatile("s_waitcnt vmcnt(" #N ") lgkmcnt(0)\n\ts_barrier":::"memory")

__device__ __forceinline__ void qkt(f32x16&p0,f32x16&p1,const char*Kslot,const bf16x8*qr,const f32x16&negm,int r32,int hi){
  const char*kb=Kslot+hi*1024+r32*16;
  #pragma unroll
  for(int d0=0;d0<4;++d0){
    const bf16x8 b0=*reinterpret_cast<const bf16x8*>(kb+d0*2048);
    const bf16x8 b1=*reinterpret_cast<const bf16x8*>(kb+d0*2048+512);
    if(d0==0){p0=__builtin_amdgcn_mfma_f32_32x32x16_bf16(b0,qr[0],negm,0,0,0);p1=__builtin_amdgcn_mfma_f32_32x32x16_bf16(b1,qr[0],negm,0,0,0);}
    else{p0=__builtin_amdgcn_mfma_f32_32x32x16_bf16(b0,qr[d0],p0,0,0,0);p1=__builtin_amdgcn_mfma_f32_32x32x16_bf16(b1,qr[d0],p1,0,0,0);}}
}
typedef __attribute__((address_space(3))) const char* lds_cptr;
typedef short v4i16_t __attribute__((ext_vector_type(4)));
__device__ __forceinline__ void kload8(bf16x8*kf,lds_cptr kp){
  kf[0]=*(const __attribute__((address_space(3))) bf16x8*)(kp);      kf[1]=*(const __attribute__((address_space(3))) bf16x8*)(kp+512);
  kf[2]=*(const __attribute__((address_space(3))) bf16x8*)(kp+2048); kf[3]=*(const __attribute__((address_space(3))) bf16x8*)(kp+2560);
  kf[4]=*(const __attribute__((address_space(3))) bf16x8*)(kp+4096); kf[5]=*(const __attribute__((address_space(3))) bf16x8*)(kp+4608);
  kf[6]=*(const __attribute__((address_space(3))) bf16x8*)(kp+6144); kf[7]=*(const __attribute__((address_space(3))) bf16x8*)(kp+6656);
}
__device__ __forceinline__ void kload2(bf16x8*kf,lds_cptr kp,int j){ kf[2*j]=*(const __attribute__((address_space(3))) bf16x8*)(kp+j*2048); kf[2*j+1]=*(const __attribute__((address_space(3))) bf16x8*)(kp+j*2048+512); }
__device__ __forceinline__ s16x4 vtr(lds_cptr p){ return __builtin_bit_cast(s16x4,__builtin_amdgcn_ds_read_tr16_b64_v4i16((__attribute__((address_space(3))) v4i16_t*)p)); }
__device__ __forceinline__ float rowmax(const f32x16&p0,const f32x16&p1){
  float a=max3f(p0[0],p0[1],p1[0]),b=max3f(p0[2],p0[3],p1[1]);a=max3f(a,p1[2],p1[3]);
  #pragma unroll
  for(int r=4;r<16;r+=4){a=max3f(a,p0[r],p0[r+1]);b=max3f(b,p0[r+2],p0[r+3]);a=max3f(a,p1[r],p1[r+1]);b=max3f(b,p1[r+2],p1[r+3]);}
  const float m=max2f(a,b);
  auto rr=__builtin_amdgcn_permlane32_swap(__float_as_uint(m),__float_as_uint(m),false,false);
  return max2f(__uint_as_float(rr[0]),__uint_as_float(rr[1]));
}
__device__ __forceinline__ void pv(f32x16*o,int vb,bf16x8 pa0,bf16x8 pa1,bf16x8 pa2,bf16x8 pa3){
  #pragma unroll
  for(int d0=0;d0<2;++d0){s16x4 lo[4],hi[4];
    #pragma unroll
    for(int ks=0;ks<4;++ks){
      asm volatile("ds_read_b64_tr_b16 %0,%1 offset:%c2":"=&v"(lo[ks]):"v"(vb),"i"(d0*4096+ks*1024):"memory");
      asm volatile("ds_read_b64_tr_b16 %0,%1 offset:%c2":"=&v"(hi[ks]):"v"(vb),"i"(d0*4096+ks*1024+512):"memory");}
    asm volatile("s_waitcnt lgkmcnt(0)":::"memory");SBAR();
    #define PK(k) (bf16x8){lo[k][0],lo[k][1],lo[k][2],lo[k][3],hi[k][0],hi[k][1],hi[k][2],hi[k][3]}
    o[d0]=__builtin_amdgcn_mfma_f32_32x32x16_bf16(pa0,PK(0),o[d0],0,0,0);
    o[d0]=__builtin_amdgcn_mfma_f32_32x32x16_bf16(pa1,PK(1),o[d0],0,0,0);
    o[d0]=__builtin_amdgcn_mfma_f32_32x32x16_bf16(pa2,PK(2),o[d0],0,0,0);
    o[d0]=__builtin_amdgcn_mfma_f32_32x32x16_bf16(pa3,PK(3),o[d0],0,0,0);
    #undef PK
  }
}

#ifndef ATTN_STORE16
#define ATTN_STORE16(p,v) (*(u32x4*)(p)=(v))
#endif
template<int THRL> __device__ __forceinline__ void attn_unit(const bf16*Qu,const bf16*__restrict__ Kh,const bf16*__restrict__ Vh,bf16*Ou,const int p0,const int NT,const float* sinkp,const float* qg,const float2* ropet,char*shm){
  int tid=threadIdx.x; asm volatile("":"+v"(tid)); const int lane=tid&63,r32=lane&31,hi=lane>>5; const int wid=__builtin_amdgcn_readfirstlane(tid>>6);
  const int hsub=wid>>1, psub=(wid&1)*QBLK;
  const bf16*Qw=Qu+(long)psub*QP+hsub*D;
  const unsigned lds0=(unsigned)(uintptr_t)shm;
  float*wsf=(float*)(shm+LDS_WS)+wid*64;
  const bf16*ksrc=Kh+(long)lane*KVP+wid*8;
  const bf16*vsrc=Vh+(long)(16*(wid&3)+(lane>>2))*KVP+(wid>>2)*32+(lane&3)*8;
  const unsigned kdst=lds0+LDS_K+wid*1024, vdst=lds0+LDS_V+wid*1024;
  #define KP0(t) (p0-128+64*((t)-4))
  #define TROW(t) ((t)<4?64*(t):(((unsigned)KP0(t)<4096u)?256+KP0(t):256))
  #define DMA_K(t,slot) glds16(ksrc+(long)TROW(t)*KVP,(unsigned)__builtin_amdgcn_readfirstlane(kdst+(slot)))
  #define DMA_V(t,slot) glds16(vsrc+(long)TROW(t)*KVP,(unsigned)__builtin_amdgcn_readfirstlane(vdst+(slot)))
  const int vb0=(int)(lds0+LDS_V)+((lane>>4)&1)*32+(lane&3)*8+(4*hi+((lane&15)>>2))*64;
  const char*Kbase=shm+LDS_K; bf16x8 kf[8];
  const lds_cptr shm3=(lds_cptr)shm; const lds_cptr kp0=shm3+LDS_K+hi*1024+r32*16; const lds_cptr vp0=shm3+LDS_V+((lane>>4)&1)*32+(lane&3)*8+(4*hi+((lane&15)>>2))*64;
  DMA_K(0,0);DMA_V(0,0);DMA_K(1,SLOTB);
  bf16x8 qr[4];
  { bf16x8 qraw[4];
    #pragma unroll
    for(int d0=0;d0<4;++d0)qraw[d0]=*reinterpret_cast<const bf16x8*>(&Qw[(long)r32*QP+d0*16+hi*8]);
    float qf[4][8]; float ss=0.f;
    #pragma unroll
    for(int d0=0;d0<4;++d0)
      #pragma unroll
      for(int j=0;j<8;++j){ qf[d0][j]=__builtin_bit_cast(float,(unsigned)(unsigned short)qraw[d0][j]<<16); ss+=qf[d0][j]*qf[d0][j]; }
    ss+=__shfl_xor(ss,32);
    const float rstd=1.0f/sqrtf(ss*(1.f/64.f)+1e-6f)*C2;
    #pragma unroll
    for(int d0=0;d0<4;++d0)
      #pragma unroll
      for(int j=0;j<8;++j) qf[d0][j]*=rstd*qg[16*d0+8*hi+j];
    if(ropet){ const float2* rp=ropet+(long)(p0+psub+r32)*32+8*hi;
      #pragma unroll
      for(int j=0;j<8;++j){ const float2 c1=rp[j],c2=rp[16+j];
        const float a=qf[0][j],b=qf[1][j],c=qf[2][j],d=qf[3][j];
        qf[0][j]=a*c1.x-b*c1.y; qf[1][j]=b*c1.x+a*c1.y; qf[2][j]=c*c2.x-d*c2.y; qf[3][j]=d*c2.x+c*c2.y; } }
    #pragma unroll
    for(int d0=0;d0<4;++d0){ u32x4 w; w[0]=cvtpk_s(qf[d0][0],qf[d0][1]); w[1]=cvtpk_s(qf[d0][2],qf[d0][3]); w[2]=cvtpk_s(qf[d0][4],qf[d0][5]); w[3]=cvtpk_s(qf[d0][6],qf[d0][7]); qr[d0]=__builtin_bit_cast(bf16x8,w); } }
  float mhat=0.f,l_reg=0.f;f32x16 o[2];o[0]=f32x16{};o[1]=f32x16{};f32x16 negm=f32x16{};asm volatile("":"+v"(negm));
  const int qpos=p0+psub+r32;
  #define CMASK(P0,P1,t) do{ if((t)>=4)wmask(P0,P1,KP0(t),qpos,hi); }while(0)
  bool resc=false;
  #define START(P0,P1) do{ const float rm=rowmax(P0,P1); resc=false; \
    { const float dl=rm; mhat=fadd_s(mhat,dl); \
      _Pragma("unroll") for(int r=0;r<16;++r){P0[r]=fsub_s(P0[r],dl);P1[r]=fsub_s(P1[r],dl);} \
      _Pragma("unroll") for(int r=0;r<16;++r)negm[r]=-mhat; asm volatile("":"+v"(negm)); } \
    _Pragma("unroll") for(int r=0;r<16;++r)P0[r]=__builtin_amdgcn_exp2f(P0[r]); }while(0)
  #define RESC() do{ if(resc){ asm volatile("s_waitcnt lgkmcnt(0)":::"memory"); \
      _Pragma("unroll") for(int d_=0;d_<2;++d_) _Pragma("unroll") for(int r=0;r<16;++r)o[d_][r]*=wsf[crow(r,hi)]; } }while(0)
  f32x16 pA0,pA1,pB0,pB1;
  int sl_prev=0,sl_cur=0,sl_next=SLOTB;
  #define ROT() do{sl_prev=sl_cur;sl_cur=sl_next;sl_next=(sl_next==(NSLOT-1)*SLOTB)?0:sl_next+SLOTB;}while(0)
  DMA_K(2,2*SLOTB);
  WAIT_BAR(3);
  qkt(pA0,pA1,Kbase,qr,negm,r32,hi);asm volatile("s_nop 15\n\ts_nop 7":"+v"(pA0),"+v"(pA1));CMASK(pA0,pA1,0);
  START(pA0,pA1);
  _Pragma("unroll") for(int r=0;r<16;++r)pA1[r]=__builtin_amdgcn_exp2f(pA1[r]);
  WAIT_BAR(0);
  DMA_K(3,0);DMA_V(1,SLOTB);
  ROT();
  kload8(kf,kp0+sl_cur);
  WAIT_BAR(2);
  s16x4 vlo[8],vhi[8]; u32x4 pw0,pw1,pw2,pw3;
  #define PKW(P,B) cvtpk_s(P[B],P[B+1])
  #define PAF(k) __builtin_bit_cast(bf16x8,pw##k)
  #define VFR(i) (bf16x8){vlo[i][0],vlo[i][1],vlo[i][2],vlo[i][3],vhi[i][0],vhi[i][1],vhi[i][2],vhi[i][3]}
  #define PIN(x) asm volatile("":"+v"(x))
  #define MX3(a,b,c) __builtin_fmaxf(__builtin_fmaxf((a),(b)),(c))
  #define GAPA(MF,A0,A1,A2,A3,W0,W1,PW) do{ MF; sacc+=A0; sacc+=A1; sacc+=A2; sacc+=A3; PIN(sacc); W0; W1; PIN(PW); SBAR(); }while(0)
  #define EX(v) __builtin_amdgcn_exp2f(v)
  #define GAPB(MF,X,B) do{ MF; X[B]=EX(X[B]); X[B+1]=EX(X[B+1]); X[B+2]=EX(X[B+2]); X[B+3]=EX(X[B+3]); PIN(X); SBAR(); }while(0)
  #define VRD(i) do{ vlo[i]=vtr(vp_+(((i)>>2)*4096+((i)&3)*1024)); vhi[i]=vtr(vp_+(((i)>>2)*4096+((i)&3)*1024+512)); }while(0)
  #define KRD(G,j) do{ if(G){ kload2(kf,kp0+sl_next,j); SBAR(); } }while(0)
  #define STEP(C0,C1,P0,P1,t,GK,GV,GL) do{ SBAR(); \
    const lds_cptr vp_=vp0+sl_prev; \
    VRD(0); SBAR(); float sacc=(P0[0]+P0[1]); \
    GAPA(C0=__builtin_amdgcn_mfma_f32_32x32x16_bf16(kf[0],qr[0],negm,0,0,0), P0[2],P0[3],P0[4],P0[5],     pw0[0]=PKW(P0,0), pw0[1]=PKW(P0,2), pw0); \
    VRD(4); SBAR(); GAPA(C1=__builtin_amdgcn_mfma_f32_32x32x16_bf16(kf[1],qr[0],negm,0,0,0), P0[6],P0[7],P0[8],P0[9],     pw0[2]=PKW(P0,4), pw0[3]=PKW(P0,6), pw0); \
    VRD(1); SBAR(); GAPA(C0=__builtin_amdgcn_mfma_f32_32x32x16_bf16(kf[2],qr[1],C0,0,0,0),   P0[10],P0[11],P0[12],P0[13], pw1[0]=PKW(P0,8), pw1[1]=PKW(P0,10), pw1); \
    VRD(5); SBAR(); GAPA(C1=__builtin_amdgcn_mfma_f32_32x32x16_bf16(kf[3],qr[1],C1,0,0,0),   P0[14],P0[15],P1[0],P1[1],   pw1[2]=PKW(P0,12),pw1[3]=PKW(P0,14), pw1); \
    VRD(2); SBAR(); GAPA(C0=__builtin_amdgcn_mfma_f32_32x32x16_bf16(kf[4],qr[2],C0,0,0,0),   P1[2],P1[3],P1[4],P1[5],     pw2[0]=PKW(P1,0), pw2[1]=PKW(P1,2), pw2); \
    VRD(6); SBAR(); GAPA(C1=__builtin_amdgcn_mfma_f32_32x32x16_bf16(kf[5],qr[2],C1,0,0,0),   P1[6],P1[7],P1[8],P1[9],     pw2[2]=PKW(P1,4), pw2[3]=PKW(P1,6), pw2); \
    VRD(3); SBAR(); GAPA(C0=__builtin_amdgcn_mfma_f32_32x32x16_bf16(kf[6],qr[3],C0,0,0,0),   P1[10],P1[11],P1[12],P1[13], pw3[0]=PKW(P1,8), pw3[1]=PKW(P1,10), pw3); \
    VRD(7); SBAR(); GAPA(C1=__builtin_amdgcn_mfma_f32_32x32x16_bf16(kf[7],qr[3],C1,0,0,0),   P1[14],P1[15],0.f,0.f,       pw3[2]=PKW(P1,12),pw3[3]=PKW(P1,14), pw3); \
    l_reg+=sacc; \
    if(GK){DMA_K((t)+3,sl_cur);} if(GV){DMA_V((t)+1,sl_next);} \
    CMASK(C0,C1,t); \
    { float a=MX3(C0[0],C0[1],C1[0]),b=MX3(C0[2],C0[3],C1[1]); a=MX3(a,C1[2],C1[3]); \
      _Pragma("unroll") for(int r=4;r<16;r+=4){a=MX3(a,C0[r],C0[r+1]);b=MX3(b,C0[r+2],C0[r+3]);a=MX3(a,C1[r],C1[r+1]);b=MX3(b,C1[r+2],C1[r+3]);} \
      float rm=__builtin_fmaxf(a,b); { auto rr=__builtin_amdgcn_permlane32_swap(__float_as_uint(rm),__float_as_uint(rm),false,false); rm=__builtin_fmaxf(__uint_as_float(rr[0]),__uint_as_float(rr[1])); } \
      resc=false; \
      if(__builtin_expect(__any(rm>(float)THRL),0)){ const float dl=__builtin_fmaxf(rm,0.f); mhat+=dl; \
        _Pragma("unroll") for(int r=0;r<16;++r){C0[r]-=dl;C1[r]-=dl;} \
        _Pragma("unroll") for(int r=0;r<16;++r)negm[r]=-mhat; asm volatile("":"+v"(negm)); \
        const float f=__builtin_amdgcn_exp2f(-dl); l_reg*=f; if(hi==0)wsf[r32]=f; resc=true; } } \
    SBAR(); \
    GAPB(o[0]=__builtin_amdgcn_mfma_f32_32x32x16_bf16(PAF(0),VFR(0),o[0],0,0,0), C0,0); \
    GAPB(o[1]=__builtin_amdgcn_mfma_f32_32x32x16_bf16(PAF(0),VFR(4),o[1],0,0,0), C0,4); \
    KRD(GL,0); GAPB(o[0]=__builtin_amdgcn_mfma_f32_32x32x16_bf16(PAF(1),VFR(1),o[0],0,0,0), C0,8); \
    KRD(GL,1); GAPB(o[1]=__builtin_amdgcn_mfma_f32_32x32x16_bf16(PAF(1),VFR(5),o[1],0,0,0), C0,12); \
    KRD(GL,2); GAPB(o[0]=__builtin_amdgcn_mfma_f32_32x32x16_bf16(PAF(2),VFR(2),o[0],0,0,0), C1,0); \
    KRD(GL,3); GAPB(o[1]=__builtin_amdgcn_mfma_f32_32x32x16_bf16(PAF(2),VFR(6),o[1],0,0,0), C1,4); \
    GAPB(o[0]=__builtin_amdgcn_mfma_f32_32x32x16_bf16(PAF(3),VFR(3),o[0],0,0,0), C1,8); \
    GAPB(o[1]=__builtin_amdgcn_mfma_f32_32x32x16_bf16(PAF(3),VFR(7),o[1],0,0,0), C1,12); \
    }while(0)
  int t=1;
  for(;t+5<NT;t+=2){
    STEP(pB0,pB1,pA0,pA1,t,true,true,true);     WAIT_BAR(2); RESC(); ROT();
    STEP(pA0,pA1,pB0,pB1,t+1,true,true,true);   WAIT_BAR(2); RESC(); ROT();
  }
  #define ENDW(tt) do{ if((tt)+3<NT){WAIT_BAR(2);} else if((tt)+2<NT){WAIT_BAR(1);} else {WAIT_BAR(0);} }while(0)
  for(;t+1<NT;t+=2){
    STEP(pB0,pB1,pA0,pA1,t,(t+3<NT),(t+1<NT),(t+1<NT));       ENDW(t);   RESC(); ROT();
    STEP(pA0,pA1,pB0,pB1,t+1,(t+4<NT),(t+2<NT),(t+2<NT));     ENDW(t+1); RESC(); ROT();
  }
  STEP(pB0,pB1,pA0,pA1,NT-1,false,false,false); RESC();
  { float sacc=pB0[0]+pB0[1]; _Pragma("unroll") for(int r=2;r<16;++r)sacc+=pB0[r]; _Pragma("unroll") for(int r=0;r<16;++r)sacc+=pB1[r]; l_reg+=sacc;
    pw0=(u32x4){PKW(pB0,0),PKW(pB0,2),PKW(pB0,4),PKW(pB0,6)};pw1=(u32x4){PKW(pB0,8),PKW(pB0,10),PKW(pB0,12),PKW(pB0,14)};pw2=(u32x4){PKW(pB1,0),PKW(pB1,2),PKW(pB1,4),PKW(pB1,6)};pw3=(u32x4){PKW(pB1,8),PKW(pB1,10),PKW(pB1,12),PKW(pB1,14)};
    SBAR(); pv(o,vb0+sl_cur,PAF(0),PAF(1),PAF(2),PAF(3)); }
  #undef PKW
  #undef PAF
  #undef VFR
  #undef PIN
  #undef MX3
  #undef GAPA
  #undef GAPB
  #undef EX
  #undef VRD
  #undef KRD
  #undef STEP
  #undef ENDW
  l_reg+=__shfl_xor(l_reg,32);
  l_reg+=__builtin_amdgcn_exp2f(sinkp[hsub]*1.4426950408889634f-mhat);
  if(hi==0)wsf[32+r32]=l_reg;asm volatile("s_waitcnt lgkmcnt(0)":::"memory");
  float rli[16];
  #pragma unroll
  for(int r=0;r<16;++r)rli[r]=__builtin_amdgcn_rcpf(wsf[32+crow(r,hi)]);
  bf16*Ow=Ou+(long)psub*OP+hsub*D;
  { bf16*stg=(bf16*)(shm+LDS_OST)+wid*2048;
    #pragma unroll
    for(int r=0;r<16;++r){const int orow=crow(r,hi);
      #pragma unroll
      for(int d0=0;d0<2;++d0)stg[orow*64+d0*32+r32]=__float2bfloat16(o[d0][r]*rli[r]);}
    asm volatile("s_waitcnt lgkmcnt(0)":::"memory");
    #pragma unroll
    for(int i=0;i<4;++i){const int row=i*8+(lane>>3),ch=lane&7; const u32x4 v=*(const u32x4*)(stg+row*64+ch*8); ATTN_STORE16(Ow+(long)row*OP+ch*8,v);} }
  asm volatile("s_waitcnt lgkmcnt(0)\n\ts_barrier":::"memory");
  #undef DMA_K
  #undef DMA_V
  #undef KP0
  #undef TROW
  #undef CMASK
  #undef START
  #undef RESC
  #undef ROT
}
constexpr int ATTN_LDS_BYTES=LDS_BYTES;
#undef SBAR
#undef WAIT_BAR
}

constexpr int SLAB_PITCH = 288;
typedef short v4i16_t __attribute__((ext_vector_type(4)));
template <int MT, class RowAddr, class Epi>
__device__ __forceinline__ void slab_gemm(LAS unsigned char* lds, const bf16* Cmat, const int K, const RowAddr& RA, const Epi& E) {
    int tid = threadIdx.x; asm volatile("" : "+v"(tid));
    const int wid = tid >> 6, lane = tid & 63;
    LAS bf16* Dr = (LAS bf16*)lds;
    f32x16 acc[MT];
#pragma unroll
    for (int i = 0; i < MT; ++i)
#pragma unroll
        for (int r = 0; r < 16; ++r) acc[i][r] = 0.f;
    const int g = (lane >> 4) & 1, h = lane >> 5, qq = (lane & 15) >> 2, pp = lane & 3;
    const LAS bf16* trp = Dr + (8 * h + qq) * SLAB_PITCH + wid * 32 + 16 * g + 4 * pp;
    for (int kc = 0; kc < K; kc += 128) {
        {
            const int k = tid >> 2, qd = tid & 3;
            const bf16* src = RA(kc + k) + qd * 64;
            v4u v[8];
#pragma unroll
            for (int j = 0; j < 8; ++j) v[j] = *(const v4u*)(src + j * 8);
#pragma unroll
            for (int j = 0; j < 8; ++j) *(LAS v4u*)(Dr + k * SLAB_PITCH + qd * 64 + j * 8) = v[j];
        }
        __syncthreads();
        const int kh = h * 8;
#pragma unroll
        for (int s = 0; s < 8; ++s) {
            const v4i16_t b0 = __builtin_amdgcn_ds_read_tr16_b64_v4i16((LAS v4i16_t*)(trp + (16 * s) * SLAB_PITCH));
            const v4i16_t b1 = __builtin_amdgcn_ds_read_tr16_b64_v4i16((LAS v4i16_t*)(trp + (16 * s + 4) * SLAB_PITCH));
            const bf16x8 bfrag = (bf16x8){b0[0], b0[1], b0[2], b0[3], b1[0], b1[1], b1[2], b1[3]};
#pragma unroll
            for (int mt = 0; mt < MT; ++mt) {
                const bf16x8 afrag = *(const bf16x8*)(Cmat + (size_t)(mt * 32 + (lane & 31)) * K + kc + s * 16 + kh);
                acc[mt] = __builtin_amdgcn_mfma_f32_32x32x16_bf16(afrag, bfrag, acc[mt], 0, 0, 0);
            }
        }
        __syncthreads();
    }
    E(acc, wid, lane, lds);
}

struct Args { const float* in[23]; float* out; unsigned char* ws; int ph_lo, ph_hi; };

constexpr int SOUT_PITCH = 264;
template <int NROWS, bool WT, class RowPtr>
__device__ __forceinline__ void slab_store_rows(LAS unsigned char* lds, const RowPtr& RP) {
    int tid = threadIdx.x; asm volatile("" : "+v"(tid));
    __syncthreads();
#pragma unroll
    for (int k = 0; k < NROWS / 16; ++k) { const int row = (tid >> 5) + 16 * k, chunk = tid & 31;
        const v4u v = *(const LAS v4u*)((LAS bf16*)lds + row * SOUT_PITCH + chunk * 8);
        bf16* dst = RP(row) + chunk * 8;
        if (WT) store16_wt(dst, v); else *(v4u*)dst = v; }
    __syncthreads();
}
struct RowA { const bf16* z; int b, n2; __device__ __forceinline__ const bf16* operator()(int k) const { return z + (size_t)(b * 4096 + 64 * (k & 63) + n2) * 512 + (k >> 6) * 256; } };
struct RowPA { bf16* t2; int b, n2; __device__ __forceinline__ bf16* operator()(int m) const { return t2 + ((size_t)((b * 64 + n2) * 64 + (m & 63)) * 2 + (m >> 6)) * 256; } };
template <bool WT> struct EpiA { bf16* t2; const float2* tw; int b, n2;
    __device__ __forceinline__ void operator()(const f32x16 (&acc)[4], int wid, int lane, LAS unsigned char* lds) const {
        const int ch = wid * 32 + (lane & 31); LAS bf16* so = (LAS bf16*)lds;
#pragma unroll
        for (int mt = 0; mt < 2; ++mt)
#pragma unroll
            for (int r = 0; r < 16; ++r) {
                const int k1 = 32 * mt + (r & 3) + 8 * (r >> 2) + 4 * (lane >> 5);
                const float2 cs = tw[n2 * k1]; const float re = acc[mt][r], im = acc[mt + 2][r];
                const float re2 = cs.x * re + cs.y * im, im2 = cs.x * im - cs.y * re;
                so[k1 * SOUT_PITCH + ch] = (bf16)f2bf(re2); so[(64 + k1) * SOUT_PITCH + ch] = (bf16)f2bf(im2);
            }
        RowPA rp{t2, b, n2}; slab_store_rows<128, WT, RowPA>(lds, rp);
    } };
struct RowB { const bf16* t2; int b, k1; __device__ __forceinline__ const bf16* operator()(int k) const { return t2 + ((size_t)((b * 64 + (k & 63)) * 64 + k1) * 2 + (k >> 6)) * 256; } };
struct RowPB { bf16* mrg; int b, k1; __device__ __forceinline__ bf16* operator()(int k2) const { return mrg + (size_t)(b * 4096 + k1 + 64 * k2) * 1024 + 768; } };
struct EpiB { bf16* mrg; int b, k1;
    __device__ __forceinline__ void operator()(const f32x16 (&acc)[2], int wid, int lane, LAS unsigned char* lds) const {
        const int ch = wid * 32 + (lane & 31); LAS bf16* so = (LAS bf16*)lds;
#pragma unroll
        for (int mt = 0; mt < 2; ++mt)
#pragma unroll
            for (int r = 0; r < 16; ++r) { const int k2 = 32 * mt + (r & 3) + 8 * (r >> 2) + 4 * (lane >> 5); so[k2 * SOUT_PITCH + ch] = (bf16)f2bf(DBG_NO_FOUR ? 0.f : acc[mt][r]); }
        RowPB rp{mrg, b, k1}; slab_store_rows<64, false, RowPB>(lds, rp);
    } };
struct RowC { const bf16* z; int b; __device__ __forceinline__ const bf16* operator()(int k) const { return z + (size_t)(T + b * 256 + (k & 255)) * 512 + (k >> 8) * 256; } };
struct RowPC { bf16* mrg; int b, mt0; __device__ __forceinline__ bf16* operator()(int kk) const { return mrg + (size_t)(T + b * 256 + 32 * mt0 + kk) * 1024 + 768; } };
struct EpiC { bf16* mrg; int b, mt0;
    __device__ __forceinline__ void operator()(const f32x16 (&acc)[1], int wid, int lane, LAS unsigned char* lds) const {
        const int ch = wid * 32 + (lane & 31); LAS bf16* so = (LAS bf16*)lds;
#pragma unroll
        for (int r = 0; r < 16; ++r) { const int kk = (r & 3) + 8 * (r >> 2) + 4 * (lane >> 5); so[kk * SOUT_PITCH + ch] = (bf16)f2bf(DBG_NO_FOUR ? 0.f : acc[0][r]); }
        RowPC rp{mrg, b, mt0}; slab_store_rows<32, false, RowPC>(lds, rp);
    } };

__device__ __forceinline__ void tr_block(const float* src, int ldS, bf16* dst, int ldD, LAS float* scr, int lane) {
#pragma unroll 8
    for (int i = 0; i < 32; ++i) { const int kk = 2 * i + (lane >> 5); scr[kk * 33 + (lane & 31)] = src[(size_t)kk * ldS + (lane & 31)]; }
    LDS_WAIT(); asm volatile("" ::: "memory");
    const int c = lane & 7;
#pragma unroll
    for (int j = 0; j < 4; ++j) { const int n = (lane >> 3) + 8 * j; const LAS float* s = scr + (8 * c) * 33 + n;
        v4u o; o.x = pk2(s[0 * 33], s[1 * 33]); o.y = pk2(s[2 * 33], s[3 * 33]); o.z = pk2(s[4 * 33], s[5 * 33]); o.w = pk2(s[6 * 33], s[7 * 33]);
        *(GAS v4u*)(dst + (size_t)n * ldD + 8 * c) = o; }
    LDS_WAIT(); asm volatile("" ::: "memory");
}


__device__ __forceinline__ void tr_block64(const float* src, int ldS, bf16* dst, int ldD, LAS bf16* scr, int lane) {
    const int kr = lane >> 4, nc = lane & 15;
    f32x4 v[16];
#pragma unroll
    for (int i = 0; i < 16; ++i) v[i] = *(const f32x4*)(src + (size_t)(4 * i + kr) * ldS + 4 * nc);
#pragma unroll
    for (int i = 0; i < 16; ++i) { const int k = 4 * i + kr;
#pragma unroll
        for (int j = 0; j < 4; ++j) scr[(4 * nc + j) * 66 + k] = (bf16)f2bf(v[i][j]); }
    LDS_WAIT(); asm volatile("" ::: "memory");
    const int c = lane & 7;
#pragma unroll
    for (int j = 0; j < 8; ++j) { const int n = (lane >> 3) + 8 * j; const LAS unsigned* p = (const LAS unsigned*)(scr + n * 66 + 8 * c);
        v4u o; o.x = p[0]; o.y = p[1]; o.z = p[2]; o.w = p[3];
        *(GAS v4u*)(dst + (size_t)n * ldD + 8 * c) = o; }
    LDS_WAIT(); asm volatile("" ::: "memory");
}

__device__ __forceinline__ void tr_block64_f8(const float* src, int ldS, unsigned char* dst, int ldD, LAS unsigned char* scr, int lane, float sc) {
    const int nq = lane & 15, kq0 = lane >> 4;
    f32x4 v[4][4];
#pragma unroll
    for (int sb = 0; sb < 4; ++sb)
#pragma unroll
        for (int r = 0; r < 4; ++r) v[sb][r] = *(const f32x4*)(src + (size_t)(4 * (kq0 + 4 * sb) + r) * ldS + 4 * nq);
#pragma unroll
    for (int sb = 0; sb < 4; ++sb)
#pragma unroll
        for (int j = 0; j < 4; ++j) *(LAS unsigned*)(scr + (4 * nq + j) * 68 + 4 * (kq0 + 4 * sb)) = pk4_f8(v[sb][0][j] * sc, v[sb][1][j] * sc, v[sb][2][j] * sc, v[sb][3][j] * sc);
    LDS_WAIT(); asm volatile("" ::: "memory");
    const int c = lane & 3;
#pragma unroll
    for (int jj = 0; jj < 4; ++jj) { const int n = (lane >> 2) + 16 * jj; const LAS unsigned* p = (const LAS unsigned*)(scr + n * 68 + 16 * c);
        v4u o; o.x = p[0]; o.y = p[1]; o.z = p[2]; o.w = p[3];
        *(GAS v4u*)(dst + (size_t)n * ldD + 16 * c) = o; }
    LDS_WAIT(); asm volatile("" ::: "memory");
}

typedef const __attribute__((address_space(4))) Args* kargs_t;
__device__ __forceinline__ kargs_t ka_launder() { kargs_t p = (kargs_t)__builtin_amdgcn_kernarg_segment_ptr(); asm volatile("" : "+s"(p)); return p; }
__device__ __forceinline__ int tid_launder() { int t = threadIdx.x; asm volatile("" : "+v"(t)); return t; }
#define KA_DECL const kargs_t KA = ka_launder(); const int tid = tid_launder(); const int lane = tid & 63; const int wave = __builtin_amdgcn_readfirstlane(tid >> 6); const int gw = vcu * 8 + wave; const int gt = vcu * 512 + tid; (void)lane; (void)wave; (void)gw; (void)gt;
#define ws (KA->ws)
#define ctl ((gu32*)(ws + O_CTL))
#define x_in (KA->in[0])
#define c_in (KA->in[1])
#define ctx_in (KA->in[2])
#define cctx_in (KA->in[3])
#define w_mod (KA->in[4])
#define b_mod (KA->in[5])
#define norm1_g (KA->in[6])
#define w_in (KA->in[7])
#define q_norm_g (KA->in[8])
#define k_norm_g (KA->in[9])
#define attn_sink (KA->in[10])
#define pool_w (KA->in[11])
#define pool_scale (KA->in[12])
#define four_w (KA->in[13])
#define w_out (KA->in[14])
#define norm2_g (KA->in[15])
#define w_grp (KA->in[16])
#define b_grp (KA->in[17])
#define w_rtr (KA->in[18])
#define b_rtr (KA->in[19])
#define w_gate (KA->in[20])
#define w_up (KA->in[21])
#define w_down (KA->in[22])
#define outp (KA->out)
#define modv ((float*)(ws + O_MOD))
#define rope ((float2*)(ws + O_ROPE))
#define twt ((float2*)(ws + O_TW))
#define fma ((bf16*)(ws + O_FMA))
#define fmb ((bf16*)(ws + O_FMB))
#define fmc ((bf16*)(ws + O_FMC))
#define hbuf ((bf16*)(ws + O_H))
#define kall ((bf16*)(ws + O_KALL))
#define vall ((bf16*)(ws + O_VALL))
#define xc ((float*)(ws + O_XC))
#define list ((unsigned*)(ws + O_LIST))
#define wts ((float*)(ws + O_WTS))
#define act ((bf16*)(ws + O_ACT))
#define t2 ((bf16*)(ws + O_T2))
#define mrg ((bf16*)(ws + O_MRG))
#define qb ((bf16*)(ws + O_Q))
#define pu ((bf16*)(ws + O_PU))
#define zb ((bf16*)(ws + O_Z))
#define y2 ((bf16*)(ws + O_Y2))

#ifndef PH_MASK
#define PH_MASK 0x3ffff
#endif
#define IN(k) (lo <= (k) && (k) < hi && ((PH_MASK >> (k)) & 1))
#define SEAM(k) do { if (IN(k) && IN((k) + 1)) xcd_barrier(bar); } while (0)
#define modl (modv + (size_t)l * 5 * 6144)
#define win_t ((bf16*)(ws + O_WIN + l * SZ_WIN1))
#define wout_t ((bf16*)(ws + O_WOUT + l * SZ_WOUT1))
#define wgu_t ((bf16*)(ws + O_WGU + l * SZ_WGU1))
#define wd_t ((bf16*)(ws + O_WD + l * SZ_WD1))
constexpr int CV_A = 256, CV_B = 192, CV_C = 4096, CV_D = 2048, CV_L = CV_A + CV_B + CV_C + CV_D;
__device__ __forceinline__ void conv_item(const kargs_t KA, const int lw, int it, LAS bf16* scr, const int lane) {
    bf16* p_win_t = (bf16*)(ws + O_WIN + lw * SZ_WIN1); bf16* p_wout_t = (bf16*)(ws + O_WOUT + lw * SZ_WOUT1);
    bf16* p_wgu_t = (bf16*)(ws + O_WGU + lw * SZ_WGU1); bf16* p_wd_t = (bf16*)(ws + O_WD + lw * SZ_WD1);
    if (it < CV_A) { const int kb = it >> 4, nb = it & 15; const float* src = w_in + (size_t)lw * 1024 * 1280 + (size_t)kb * 64 * 1280 + nb * 64;
        tr_block64(src, 1280, p_win_t + (size_t)nb * 64 * 1024 + kb * 64, 1024, scr, lane);
        if (nb >= 4) tr_block64_f8(src, 1280, (unsigned char*)(ws + O_WIN8 + lw * SZ_WIN8) + (size_t)(nb * 64 - 256) * 1024 + kb * 64, 1024, (LAS unsigned char*)scr, lane, 64.0f);
        return; } it -= CV_A;
    if (it < CV_B) { const int kb = 4 + (it >> 4), nb = it & 15; tr_block64(w_out + (size_t)lw * 1024 * 1024 + (size_t)kb * 64 * 1024 + nb * 64, 1024, p_wout_t + (size_t)nb * 64 * 1024 + kb * 64, 1024, scr, lane); return; } it -= CV_B;
    if (it < CV_C) { const int up = it >> 11, r = it & 2047, e = r >> 7, kb = (r >> 3) & 15, nb = r & 7; const int n0 = nb * 64;
        const float* src = (up ? w_up : w_gate) + ((size_t)(lw * 16 + e) * 1024 + kb * 64) * 512 + n0;
        const int drow = (n0 >> 7) * 256 + up * 128 + (n0 & 127);
        tr_block64_f8(src, 512, (unsigned char*)p_wgu_t + ((size_t)e * 1024 + drow) * 1024 + kb * 64, 1024, (LAS unsigned char*)scr, lane, 64.0f); return; } it -= CV_C;
    { const int e = it >> 7, kb = (it >> 4) & 7, nb = it & 15;
        tr_block64_f8(w_down + ((size_t)(lw * 16 + e) * 512 + kb * 64) * 1024 + nb * 64, 1024, (unsigned char*)p_wd_t + ((size_t)e * 1024 + nb * 64) * 512 + kb * 64, 512, (LAS unsigned char*)scr, lane, 64.0f); }
}
__device__ __forceinline__ void steal_convert(const kargs_t KA, LAS unsigned char* lds, const int G, const int done_idx, const bool drain) {
    int tid = threadIdx.x; asm volatile("" : "+v"(tid));
    const int lane = tid & 63, wave = __builtin_amdgcn_readfirstlane(tid >> 6);
    volatile LAS int* mb = (volatile LAS int*)(lds + MISC_OFF + 64);
    LAS bf16* scr = (LAS bf16*)(lds + wave * 16384);
    __syncthreads();
    if (tid == 0 && !drain) __hip_atomic_fetch_add((unsigned*)(ctl + CW_DONE + 64 * done_idx), 1u, RLX_AGENT);
    for (;;) {
        if (tid == 0) { int idx = -1;
            const bool stop = !drain && __hip_atomic_load((unsigned*)(ctl + CW_DONE + 64 * done_idx), RLX_AGENT) >= (unsigned)(G - G / 4);
            if (!stop) idx = (int)__hip_atomic_fetch_add((unsigned*)(ctl + CW_Q), 8u, RLX_AGENT);
            mb[0] = idx; }
        __syncthreads();
        const int idx = mb[0];
        __syncthreads();
        if (idx < 0 || idx >= CV_L) break;
        if (idx + wave < CV_L) conv_item(KA, 1, idx + wave, scr, lane);
    }
    __syncthreads();
}

template <int l> __device__ __forceinline__ void layer_body(LAS unsigned char* lds, const int G, const int vcu, const XcdBarrier& bar, const int lo, const int hi) {
    const int NGW = G * 8, NGT = G * 512; LAS int* ttab = (LAS int*)(lds + TILE_OFF);
    constexpr int P = 1 + 8 * l;

        for (int rep_ = 0; rep_ < 1 + ((l == 0) ? ((REP_MASK >> (1 + 0)) & 1) : 0); ++rep_)
        if (IN(P + 0)) {
            KA_DECL
            const float* modp = modv;
            if (l == 1) steal_convert(KA, lds, G, 3, true);
#pragma clang loop vectorize(disable) unroll(disable)
            for (int r0 = gw; r0 < TT; r0 += 2 * NGW) {
                const int r1 = r0 + NGW; const bool has1 = r1 < TT;
                f32x4 va[4], vb[4]; v2u yaa[4], yab[4], yba[4], ybb[4];
                const float* srca; const float* srcb;
                { const bool isc = r0 >= T; srca = (l == 0) ? (isc ? ctx_in + (size_t)(r0 - T) * 1024 : x_in + (size_t)r0 * 1024) : (isc ? xc + (size_t)(r0 - T) * 1024 : outp + (size_t)r0 * 1024); }
                { const int rr = has1 ? r1 : r0; const bool isc = rr >= T; srcb = (l == 0) ? (isc ? ctx_in + (size_t)(rr - T) * 1024 : x_in + (size_t)rr * 1024) : (isc ? xc + (size_t)(rr - T) * 1024 : outp + (size_t)rr * 1024); }
#pragma unroll
                for (int j = 0; j < 4; ++j) { va[j] = *(const f32x4*)(srca + 4 * lane + 256 * j); vb[j] = *(const f32x4*)(srcb + 4 * lane + 256 * j); }
                if (l == 1) {
                    const int rr = has1 ? r1 : r0;
#pragma unroll
                    for (int j = 0; j < 4; ++j) { yaa[j] = *(const v2u*)(y2 + (size_t)(2 * r0) * 1024 + 4 * lane + 256 * j); yab[j] = *(const v2u*)(y2 + (size_t)(2 * r0 + 1) * 1024 + 4 * lane + 256 * j);
                        yba[j] = *(const v2u*)(y2 + (size_t)(2 * rr) * 1024 + 4 * lane + 256 * j); ybb[j] = *(const v2u*)(y2 + (size_t)(2 * rr + 1) * 1024 + 4 * lane + 256 * j); }
                }
#pragma unroll
                for (int half = 0; half < 2; ++half) {
                    if (half == 1 && !has1) break;
                    const int r = half ? r1 : r0; f32x4 (&v)[4] = half ? vb : va; v2u (&ya)[4] = half ? yba : yaa; v2u (&yb)[4] = half ? ybb : yab;
                    const bool isc = r >= T; const int bsel = isc ? 4 : (r >> 12);
                    if (l == 1) {
                        const float* g2 = modp + bsel * 6144 + 5 * 1024; float* dst = isc ? xc + (size_t)(r - T) * 1024 : outp + (size_t)r * 1024;
#pragma unroll
                        for (int j = 0; j < 4; ++j) {
                            const f32x4 gv = *(const f32x4*)(g2 + 4 * lane + 256 * j);
                            f32x4 yy; yy[0] = bflo(ya[j].x) + bflo(yb[j].x); yy[1] = bfhi(ya[j].x) + bfhi(yb[j].x); yy[2] = bflo(ya[j].y) + bflo(yb[j].y); yy[3] = bfhi(ya[j].y) + bfhi(yb[j].y);
                            if (DBG_NO_MOE) yy = (f32x4){0.f, 0.f, 0.f, 0.f};
                            v[j] = v[j] + gv * yy; *(f32x4*)(dst + 4 * lane + 256 * j) = v[j];
                        }
                    }
                    float ss = 0.f;
#pragma unroll
                    for (int j = 0; j < 4; ++j) ss += (v[j][0] * v[j][0] + v[j][1] * v[j][1]) + (v[j][2] * v[j][2] + v[j][3] * v[j][3]);
                    const float rstd = 1.0f / sqrtf(wave_sum(ss) * (1.f / 1024.f) + 1e-6f);
                    const float* sh = modl + bsel * 6144; const float* sc = sh + 1024; const float* gn = norm1_g + l * 1024;
#pragma unroll
                    for (int j = 0; j < 4; ++j) {
                        const int c0 = 4 * lane + 256 * j; const f32x4 g = *(const f32x4*)(gn + c0), s1 = *(const f32x4*)(sc + c0), h1 = *(const f32x4*)(sh + c0);
                        const f32x4 y = (v[j] * rstd) * g * (s1 + 1.0f) + h1;
                        v2u o; o.x = pk2(y[0], y[1]); o.y = pk2(y[2], y[3]); *(v2u*)(hbuf + (size_t)r * 1024 + c0) = o;
                        *(unsigned*)((unsigned char*)(ws + O_ACT) + (size_t)r * 1024 + c0) = pk4_f8(y[0], y[1], y[2], y[3]);
                    }
                }
            }
        }
        SEAM(P + 0);
        for (int rep_ = 0; rep_ < 1 + ((l == 0) ? ((REP_MASK >> (1 + 1)) & 1) : 0); ++rep_)
        if (IN(P + 1)) {
            KA_DECL
            EpiG1 E{pu, qb, kall, vall, zb};
            { SchedG1 S{G, vcu, 0, (const char*)hbuf, (const char*)win_t}; pg8::gemm_phase<EpiG1, SchedG1, false>(lds, S, E); }
            { SchedG1 S{G, vcu, 1, (const char*)(ws + O_ACT), (const char*)(ws + O_WIN8 + l * SZ_WIN8)}; pg8::gemm_phase<EpiG1, SchedG1, true>(lds, S, E); }
            if (l == 0 && !MK_SPLIT) steal_convert(KA, lds, G, 0, false);
        }
        SEAM(P + 1);
        if (IN(P + 3)) {
            KA_DECL
            gu32* kflag = ctl + CW_KF + l * 16384;
            gu32* facnt = ctl + CW_FA + l * 64;
            for (int it = vcu; it < 256; it += G) {
                const int b = it >> 6, n2 = it & 63;
                RowA ra{zb, b, n2}; EpiA<true> ea{t2, twt, b, n2};
                slab_gemm<4, RowA, EpiA<true>>(lds, fma, 128, ra, ea);
                asm volatile("s_waitcnt vmcnt(0)" ::: "memory");
                __syncthreads();
                if (tid == 0) __hip_atomic_fetch_add((unsigned*)(facnt + 16 * b), 1u, RLX_AGENT);
            }
            const int n_att = 512 + (l == 0 ? 32 : 0);
            for (int it = vcu; it < n_att; it += G) {
                const bool cu = it >= 512; const int uidx = cu ? it - 512 : it;
                const int b = cu ? (uidx >> 3) : (uidx >> 7), kvh = cu ? ((uidx >> 2) & 1) : ((uidx >> 6) & 1), pb = cu ? (uidx & 3) : (uidx & 63);
                const int p0 = pb * 64; const int qrow0 = cu ? T + b * 256 + p0 : b * 4096 + p0;
                if (!cu) {
                    const int row = tid >> 3, c = tid & 7;
                    const float* kg = k_norm_g + l * 64 + 8 * c;
#pragma unroll
                    for (int part = 0; part < 2; ++part) {
                        if (part == 1 && pb >= 4) break;
                        const int blk = part ? pb : 4 + pb;
                        bf16* p = kall + ((size_t)b * KVROWS + blk * 64 + row) * 128 + kvh * 64 + c * 8;
                        const v4u w = *(const v4u*)p;
                        float x[8] = {bflo(w.x), bfhi(w.x), bflo(w.y), bfhi(w.y), bflo(w.z), bfhi(w.z), bflo(w.w), bfhi(w.w)};
                        float ss = 0.f;
#pragma unroll
                        for (int i = 0; i < 8; ++i) ss += x[i] * x[i];
                        ss += __shfl_xor(ss, 1); ss += __shfl_xor(ss, 2); ss += __shfl_xor(ss, 4);
                        const float rstd = 1.0f / sqrtf(ss * (1.f / 64.f) + 1e-6f);
#pragma unroll
                        for (int i = 0; i < 8; ++i) x[i] *= rstd * kg[i];
                        if (part == 0) {
                            const float2* rp = rope + (size_t)(p0 + row) * 32 + ((c & 4) ? 16 : 0) + (c & 1) * 8;
#pragma unroll
                            for (int i = 0; i < 8; ++i) { const float y = __shfl_xor(x[i], 2); const float2 cs = rp[i]; x[i] = (c & 2) ? (x[i] * cs.x + y * cs.y) : (x[i] * cs.x - y * cs.y); }
                        }
                        v4u o; o.x = pk2(x[0], x[1]); o.y = pk2(x[2], x[3]); o.z = pk2(x[4], x[5]); o.w = pk2(x[6], x[7]);
                        store16_wt(p, o);
                    }
                    asm volatile("s_waitcnt vmcnt(0)" ::: "memory");
                    __syncthreads();
                    if (tid == 0) { __hip_atomic_store(kflag + 16 * ((b * 68 + 4 + pb) * 2 + kvh), 1u, RLX_AGENT); if (pb < 4) __hip_atomic_store(kflag + 16 * ((b * 68 + pb) * 2 + kvh), 1u, RLX_AGENT); }
                }
                if (tid < 64) {
                    int blk = -1;
                    if (lane < 4) blk = lane; else if (!cu && lane < 9) { const int q = pb + lane - 6; if (q >= 0 && q < 64) blk = 4 + q; }
                    unsigned sp = 0;
                    for (;;) { const unsigned f = (blk >= 0) ? __hip_atomic_load(kflag + 16 * ((b * 68 + blk) * 2 + kvh), RLX_AGENT) : 1u;
                        if (__all(f != 0u)) break; __builtin_amdgcn_s_sleep(2);
                        if (++sp > (1u << 22)) { if (tid == 0) __hip_atomic_store(ctl + CW_TMO, 2u, RLX_AGENT); break; } }
                    __builtin_amdgcn_fence(__ATOMIC_ACQUIRE, "agent");
                    asm volatile("s_waitcnt vmcnt(0)" ::: "memory");
                }
                __syncthreads();
                const attn_body::bf16* Qu = (const attn_body::bf16*)(qb + (size_t)qrow0 * 512 + kvh * 256);
                const attn_body::bf16* Kh = (const attn_body::bf16*)(kall + (size_t)b * KVROWS * 128 + kvh * 64);
                const attn_body::bf16* Vh = (const attn_body::bf16*)(vall + (size_t)b * KVROWS * 128 + kvh * 64);
                attn_body::bf16* Ou = (attn_body::bf16*)(mrg + (size_t)qrow0 * 1024 + 256 + kvh * 256);
                attn_body::attn_unit<8>(Qu, Kh, Vh, Ou, p0, cu ? 4 : 10, attn_sink + l * 8 + kvh * 4, q_norm_g + l * 64, cu ? (const float2*)nullptr : (const float2*)rope, (char*)lds);
                __syncthreads();
            }
            const int prow = (l == 0) ? TT : T; const int nrb = prow >> 3;
#pragma clang loop vectorize(disable) unroll(disable)
            for (int i = gt; i < 32 * nrb; i += NGT) {
                const int ck8 = i & 7, rb = (i >> 3) % nrb, g = (i >> 3) / nrb;
                const int r0 = rb * 8; const bool isc = r0 >= T;
                const int nseq = isc ? LCTX : NSEQ; const int rbase = isc ? T + ((r0 - T) & ~255) : (r0 & ~4095); const int n0 = r0 - rbase;
                const int hw = 1 << g; const int col = g * 64 + ck8 * 8;
                const bf16* up = pu + (size_t)rbase * 256 + col;
                float sm[8] = {0.f, 0.f, 0.f, 0.f, 0.f, 0.f, 0.f, 0.f};
#define POOL_ACC(W, SGN) do { sm[0] += SGN bflo(W.x); sm[1] += SGN bfhi(W.x); sm[2] += SGN bflo(W.y); sm[3] += SGN bfhi(W.y); sm[4] += SGN bflo(W.z); sm[5] += SGN bfhi(W.z); sm[6] += SGN bflo(W.w); sm[7] += SGN bfhi(W.w); } while (0)
                for (int tpos = n0 - hw; tpos < n0 + hw; ++tpos) if (tpos >= 0 && tpos < nseq) { const v4u w = *(const v4u*)(up + (size_t)tpos * 256); POOL_ACC(w, +); }
#pragma unroll
                for (int k = 0; k < 8; ++k) {
                    const int n = n0 + k; int lo_ = n - hw; lo_ = lo_ < 0 ? 0 : lo_; int hi_ = n + hw - 1; hi_ = hi_ > nseq - 1 ? nseq - 1 : hi_;
                    const v4u w = *(const v4u*)(up + (size_t)n * 256); const float ic = 1.0f / (float)(hi_ - lo_ + 1);
                    v4u o; o.x = pk2(sm[0] * ic - bflo(w.x), sm[1] * ic - bfhi(w.x)); o.y = pk2(sm[2] * ic - bflo(w.y), sm[3] * ic - bfhi(w.y));
                    o.z = pk2(sm[4] * ic - bflo(w.z), sm[5] * ic - bfhi(w.z)); o.w = pk2(sm[6] * ic - bflo(w.w), sm[7] * ic - bfhi(w.w));
                    if (DBG_NO_POOL) o = (v4u){0u, 0u, 0u, 0u};
                    *(v4u*)(mrg + (size_t)(rbase + n) * 1024 + col) = o;
                    if (k < 7) { const int tin = n + hw, tout = n - hw;
                        if (tin < nseq) { const v4u wi = *(const v4u*)(up + (size_t)tin * 256); POOL_ACC(wi, +); }
                        if (tout >= 0) { const v4u wo = *(const v4u*)(up + (size_t)tout * 256); POOL_ACC(wo, -); } }
                }
#undef POOL_ACC
            }
            for (int it = vcu; it < 256; it += G) {
                const int b = it >> 6, k1 = it & 63;
                __syncthreads();
                if (tid < 64) { unsigned sp = 0;
                    while ((unsigned)__builtin_amdgcn_readfirstlane(__hip_atomic_load((unsigned*)(facnt + 16 * b), RLX_AGENT)) < 64u) { __builtin_amdgcn_s_sleep(2); if (++sp > (1u << 22)) { if (tid == 0) __hip_atomic_store(ctl + CW_TMO, 3u, RLX_AGENT); break; } }
                    __builtin_amdgcn_fence(__ATOMIC_ACQUIRE, "agent");
                    asm volatile("s_waitcnt vmcnt(0)" ::: "memory"); }
                __syncthreads();
                RowB rb{t2, b, k1}; EpiB eb{mrg, b, k1};
                slab_gemm<2, RowB, EpiB>(lds, fmb, 128, rb, eb);
            }
            if (l == 0) for (int it = (G - 1 - vcu); it < 32; it += G) {
                const int b = it >> 3, mt0 = it & 7;
                RowC rc{zb, b}; EpiC ec{mrg, b, mt0};
                slab_gemm<1, RowC, EpiC>(lds, fmc + (size_t)mt0 * 32 * 512, 512, rc, ec);
            }
        }
        SEAM(P + 3);
        if (IN(P + 4)) {
            KA_DECL
            unsigned* g2rdy = (unsigned*)(ctl + CW_G2 + l * 2048);
            {
                SchedPlain S{(l == 0 ? TT : T) / 256, 4, G, vcu, 1024, (const char*)mrg, (const char*)wout_t};
                EpiG2 E{(l == 0) ? x_in : outp, ctx_in, outp, xc, modl, g2rdy};
                pg8::gemm_phase<EpiG2, SchedPlain>(lds, S, E);
            }
            const int rep_ = 0;
            __syncthreads();
            LAS float* rw = (LAS float*)lds;
            LAS int* lcnt = (LAS int*)(lds + 81920);
            LAS unsigned* lent = (LAS unsigned*)(lds + 81920 + 256);
            LAS unsigned* lrank = lent + 1024;
            { const float* rwg = (const float*)(ws + O_RW) + l * 20480;
#pragma unroll
              for (int i = 0; i < 10; ++i) { const int idx = tid + 512 * i; *(LAS f32x4*)(rw + 4 * idx) = *(const f32x4*)(rwg + 4 * idx); } }
            if (tid < 33) lcnt[tid] = 0;
            if (tid < 64) { unsigned sp = 0; unsigned* w = g2rdy + 16 * (vcu >> 2);
                while ((unsigned)__builtin_amdgcn_readfirstlane(__hip_atomic_load(w, RLX_AGENT)) < 32u) { __builtin_amdgcn_s_sleep(2); if (++sp > (1u << 22)) { if (tid == 0) __hip_atomic_store(ctl + CW_TMO, 4u, RLX_AGENT); break; } }
                __builtin_amdgcn_fence(__ATOMIC_ACQUIRE, "agent");
                asm volatile("s_waitcnt vmcnt(0)" ::: "memory"); }
            __syncthreads();
            const bool dbl = (l == 0) && (G == 256) && (vcu < 16);
            const int ngl = 16 + ((l == 0) ? 1 : 0) + (((l == 0) && (G == 256)) ? 2 : 0);
#pragma clang loop vectorize(disable) unroll(disable)
            for (int gix = wave; gix < ngl; gix += 8) {
                int q;
                if (gix < 16) { if (dbl) continue; q = 16 * vcu + gix; }
                else if (gix == 16) q = T / 4 + vcu;
                else { if (dbl) continue; const int o = (gix == 17) ? (vcu - 16) : (240 + vcu - 16); if (o >= 256 || (gix == 18 && vcu >= 32)) continue; q = o; }
                if (gix >= 17) {
                    unsigned sp = 0; unsigned* w = g2rdy + 16 * (q >> 6);
                    while ((unsigned)__builtin_amdgcn_readfirstlane(__hip_atomic_load(w, RLX_AGENT)) < 32u) { __builtin_amdgcn_s_sleep(2); if (++sp > (1u << 22)) { if (lane == 0) __hip_atomic_store(ctl + CW_TMO, 6u, RLX_AGENT); break; } }
                    __builtin_amdgcn_fence(__ATOMIC_ACQUIRE, "agent");
                    asm volatile("s_waitcnt vmcnt(0)" ::: "memory"); }
                if (gix == 16) { unsigned sp = 0; unsigned* w = g2rdy + 16 * (64 + (vcu >> 6));
                    while ((unsigned)__builtin_amdgcn_readfirstlane(__hip_atomic_load(w, RLX_AGENT)) < 32u) { __builtin_amdgcn_s_sleep(2); if (++sp > (1u << 22)) { if (lane == 0) __hip_atomic_store(ctl + CW_TMO, 5u, RLX_AGENT); break; } }
                    __builtin_amdgcn_fence(__ATOMIC_ACQUIRE, "agent");
                    asm volatile("s_waitcnt vmcnt(0)" ::: "memory"); }
                const int rb4 = 4 * q; const bool isc = rb4 >= T; const int bsel = isc ? 4 : (rb4 >> 12);
                const float* src = isc ? xc + (size_t)(rb4 - T) * 1024 : outp + (size_t)rb4 * 1024;
                f32x4 v[4][4];
#pragma unroll
                for (int tk = 0; tk < 4; ++tk)
#pragma unroll
                    for (int j = 0; j < 4; ++j) v[tk][j] = *(const f32x4*)(src + (size_t)tk * 1024 + 4 * lane + 256 * j);
                float rstd[4];
#pragma unroll
                for (int tk = 0; tk < 4; ++tk) { float ss = 0.f;
#pragma unroll
                    for (int j = 0; j < 4; ++j) ss += (v[tk][j][0] * v[tk][j][0] + v[tk][j][1] * v[tk][j][1]) + (v[tk][j][2] * v[tk][j][2] + v[tk][j][3] * v[tk][j][3]);
                    rstd[tk] = 1.0f / sqrtf(wave_sum(ss) * (1.f / 1024.f) + 1e-6f); }
                const float* sh = modl + bsel * 6144 + 3 * 1024; const float* sc = sh + 1024; const float* gn = norm2_g + l * 1024;
                float lg[4][20];
#pragma unroll
                for (int tk = 0; tk < 4; ++tk)
#pragma unroll
                    for (int j = 0; j < 20; ++j) lg[tk][j] = 0.f;
#pragma unroll
                for (int j = 0; j < 4; ++j) {
                    const int c0 = 4 * lane + 256 * j; const f32x4 g = *(const f32x4*)(gn + c0), s1 = *(const f32x4*)(sc + c0), h1 = *(const f32x4*)(sh + c0);
                    f32x4 y[4];
#pragma unroll
                    for (int tk = 0; tk < 4; ++tk) { y[tk] = (v[tk][j] * rstd[tk]) * g * (s1 + 1.0f) + h1;
                        *(unsigned*)((unsigned char*)hbuf + (size_t)(rb4 + tk) * 1024 + c0) = pk4_f8(y[tk][0], y[tk][1], y[tk][2], y[tk][3]); }
#pragma unroll
                    for (int e = 0; e < 4; ++e) {
#pragma unroll
                        for (int q5 = 0; q5 < 5; ++q5) { const f32x4 wv = *(const LAS f32x4*)(rw + (((q5 * 4 + j) * 4 + e) * 64 + lane) * 4);
#pragma unroll
                            for (int tk = 0; tk < 4; ++tk) { lg[tk][4 * q5] += y[tk][e] * wv[0]; lg[tk][4 * q5 + 1] += y[tk][e] * wv[1]; lg[tk][4 * q5 + 2] += y[tk][e] * wv[2]; lg[tk][4 * q5 + 3] += y[tk][e] * wv[3]; } }
                        __builtin_amdgcn_sched_barrier(0); }
                }
                float l2[20];
#pragma unroll
                for (int j = 0; j < 20; ++j) {
                    const float a0 = swap32_sum(lg[0][j], lg[2][j]);
                    const float a1 = swap32_sum(lg[1][j], lg[3][j]);
                    float t = swap16_sum(a0, a1);
                    t += dppf<0x128, 0xf>(t); t += dppf<0x124, 0xf>(t); t += dppf<0x122, 0xf>(t); t += dppf<0x121, 0xf>(t);
                    l2[j] = t;
                }
                const int tk = lane >> 4; const int r = rb4 + tk;
                float gl[4]; float gm = -1e30f;
#pragma unroll
                for (int j = 0; j < 4; ++j) { gl[j] = l2[j] + b_grp[l * 4 + j]; gm = fmaxf(gm, gl[j]); }
                float gs = 0.f; int gi = 0; float gb = -1e30f;
#pragma unroll
                for (int j = 0; j < 4; ++j) { const float e = expf(gl[j] - gm); gs += e; if (gl[j] > gb) { gb = gl[j]; gi = j; } }
                const float pg = expf(gb - gm) / gs;
                float el[4]; float em = -1e30f;
#pragma unroll
                for (int j = 0; j < 4; ++j) { float t_ = 0.f;
#pragma unroll
                    for (int g4 = 0; g4 < 4; ++g4) t_ = (gi == g4) ? (l2[4 + g4 * 4 + j] + b_rtr[l * 16 + g4 * 4 + j]) : t_;
                    el[j] = t_; em = fmaxf(em, t_); }
                float pe[4];
#pragma unroll
                for (int j = 0; j < 4; ++j) pe[j] = expf(el[j] - em);
                int i0 = 0; float b0 = -1.f;
#pragma unroll
                for (int j = 0; j < 4; ++j) if (pe[j] > b0) { b0 = pe[j]; i0 = j; }
                int i1 = 0; float b1 = -1.f;
#pragma unroll
                for (int j = 0; j < 4; ++j) if (j != i0 && pe[j] > b1) { b1 = pe[j]; i1 = j; }
                const float wsum = b0 + b1; const float w0 = pg * b0 / wsum, w1 = pg * b1 / wsum;
                if ((lane & 15) == 0 && rep_ == 0) {
                    wts[2 * r] = w0; wts[2 * r + 1] = w1;
                    const int e0 = gi * 4 + i0, e1 = gi * 4 + i1;
                    const int s0 = __hip_atomic_fetch_add((LAS int*)(lcnt + 16 + 16), 1, __ATOMIC_RELAXED, __HIP_MEMORY_SCOPE_WORKGROUP);
                    const int k0 = __hip_atomic_fetch_add((LAS int*)(lcnt + e0), 1, __ATOMIC_RELAXED, __HIP_MEMORY_SCOPE_WORKGROUP);
                    const int k1 = __hip_atomic_fetch_add((LAS int*)(lcnt + e1), 1, __ATOMIC_RELAXED, __HIP_MEMORY_SCOPE_WORKGROUP);
                    lent[2 * s0] = ((unsigned)(2 * r) << 4) | (unsigned)e0; lrank[2 * s0] = (unsigned)k0;
                    lent[2 * s0 + 1] = ((unsigned)(2 * r + 1) << 4) | (unsigned)e1; lrank[2 * s0 + 1] = (unsigned)k1;
                }
            }
            __syncthreads();
            if (tid < 16 && rep_ == 0) { const int c = lcnt[tid]; lcnt[16 + tid] = c ? (int)__hip_atomic_fetch_add((unsigned*)(ctl + CW_CNT + (l * 16 + tid) * 64), (unsigned)c, RLX_AGENT) : 0; }
            __syncthreads();
            const int ntot = rep_ == 0 ? 2 * lcnt[32] : 0;
            for (int i = tid; i < ntot; i += 512) { const unsigned en = lent[i]; const int e = en & 15; list[(size_t)e * TT + lcnt[16 + e] + lrank[i]] = en >> 4; }
            __syncthreads();
            if (l == 0 && !MK_SPLIT) steal_convert(KA, lds, G, 1, false);
        }
        SEAM(P + 5);
        if (IN(P + 6) || IN(P + 7)) {
            KA_DECL
            __syncthreads();
            if (tid < 16) ttab[17 + tid] = (int)__hip_atomic_load((unsigned*)(ctl + CW_CNT + (l * 16 + tid) * 64), RLX_AGENT);
            __syncthreads();
            if (tid == 0) { int acc_ = 0; for (int e = 0; e < 16; ++e) { const int c = ttab[17 + e]; ttab[e] = acc_; acc_ += (c + 255) >> 8; } ttab[16] = acc_; }
            __syncthreads();
        }
        if (DBG_NAIVE_MOE && IN(P + 6)) {
            KA_DECL
            const int nrows = (l == 0) ? TT : T; LAS float* hs = (LAS float*)lds; LAS float* as = hs + 1024;
            const int* eidg = (const int*)(ws + O_EID);
            LAS float* lgs = as + 512; LAS float* rt = lgs + 32;
            for (int r = vcu; r < nrows; r += G) {
                __syncthreads();
                for (int i = tid; i < 1024; i += 512) hs[i] = bf2f(hbuf[(size_t)r * 1024 + i]);
                __syncthreads();
                if (tid < 20) { float a = 0.f; for (int k = 0; k < 1024; ++k) a += hs[k] * ((tid < 4) ? w_grp[(size_t)l * 4096 + k * 4 + tid] : w_rtr[(size_t)l * 16384 + k * 16 + (tid - 4)]);
                    lgs[tid] = a + ((tid < 4) ? b_grp[l * 4 + tid] : b_rtr[l * 16 + tid - 4]); }
                __syncthreads();
                if (tid == 0) { int gi = 0; for (int j = 1; j < 4; ++j) if (lgs[j] > lgs[gi]) gi = j; float gs = 0.f; for (int j = 0; j < 4; ++j) gs += expf(lgs[j] - lgs[gi]); const float pg = 1.f / gs;
                    int i0 = 0; for (int j = 1; j < 4; ++j) if (lgs[4 + gi * 4 + j] > lgs[4 + gi * 4 + i0]) i0 = j; int i1 = -1; for (int j = 0; j < 4; ++j) if (j != i0 && (i1 < 0 || lgs[4 + gi * 4 + j] > lgs[4 + gi * 4 + i1])) i1 = j;
                    const float p0 = 1.f, p1 = expf(lgs[4 + gi * 4 + i1] - lgs[4 + gi * 4 + i0]); rt[0] = (float)(gi * 4 + i0); rt[1] = (float)(gi * 4 + i1); rt[2] = pg * p0 / (p0 + p1); rt[3] = pg * p1 / (p0 + p1); }
                __syncthreads();
                for (int sl = 0; sl < 2; ++sl) {
                    const int e = (DBG_NAIVE_ROUTE & 1) ? (int)rt[sl] : eidg[2 * r + sl]; const float w = (DBG_NAIVE_ROUTE & 2) ? rt[2 + sl] : wts[2 * r + sl];
                    __syncthreads();
                    const float* Wg = w_gate + (size_t)(l * 16 + e) * 1024 * 512 + tid; const float* Wu = w_up + (size_t)(l * 16 + e) * 1024 * 512 + tid;
                    float g = 0.f, u = 0.f;
#pragma unroll 8
                    for (int k = 0; k < 1024; ++k) { g += hs[k] * Wg[(size_t)k * 512]; u += hs[k] * Wu[(size_t)k * 512]; }
                    as[tid] = g / (1.f + expf(-g)) * u;
                    __syncthreads();
                    const float* Wd = w_down + (size_t)(l * 16 + e) * 512 * 1024 + tid;
                    float y0 = 0.f, y1 = 0.f;
#pragma unroll 8
                    for (int j = 0; j < 512; ++j) { y0 += as[j] * Wd[(size_t)j * 1024]; y1 += as[j] * Wd[(size_t)j * 1024 + 512]; }
                    y2[(size_t)(2 * r + sl) * 1024 + tid] = (bf16)f2bf(y0 * w); y2[(size_t)(2 * r + sl) * 1024 + 512 + tid] = (bf16)f2bf(y1 * w);
                }
            }
        }
        if (!DBG_NAIVE_MOE && IN(P + 6)) {
            KA_DECL
            unsigned* rdy = (unsigned*)(ctl + CW_RDY + l * 4096);
            SchedMoe S{G, vcu, ttab[16], (const char*)hbuf, (const char*)act, (const char*)wgu_t, (const char*)wd_t, list, ttab, rdy, (unsigned*)(ctl + CW_TMO)};
            EpiMoe E{EpiG3{act, rdy}, EpiG4{y2, list, wts, ttab}};
            pg8::gemm_phase<EpiMoe, SchedMoe, true>(lds, S, E);
            if (l == 0 && !MK_SPLIT) steal_convert(KA, lds, G, 2, false);
        }
        SEAM(P + 7);
    }

__global__ void __launch_bounds__(512, 2) fwd_kernel(Args args) {
    extern __shared__ __attribute__((aligned(16))) unsigned char lds_raw[];
    LAS unsigned char* lds = (LAS unsigned char*)lds_raw;
    const int tid = threadIdx.x, lane = tid & 63, wave = __builtin_amdgcn_readfirstlane(tid >> 6);
    const int G = gridDim.x; const int bx = blockIdx.x; const int vcu = (G % 8 == 0) ? (bx % 8) * (G / 8) + bx / 8 : bx;
    volatile LAS unsigned* MISC = (volatile LAS unsigned*)(lds + MISC_OFF);
    LAS float* trig = (LAS float*)(lds + TRIG_OFF);
    LAS int* ttab = (LAS int*)(lds + TILE_OFF);
    for (int u = tid; u < (LDS_BYTES - LDSCTL_OFF) / 4; u += 512) ((LAS unsigned*)(lds + LDSCTL_OFF))[u] = 0u;
    __syncthreads();
    if (tid < 64) { float s, c; sincospif((float)tid / 32.f, &s, &c); trig[tid] = c; trig[64 + tid] = s; }
    __syncthreads();
    XcdBarrier bar; bar.bar = nullptr; bar.x = 0; bar.st = nullptr;
    if (!MK_SPLIT) { KA_DECL bar = xcd_barrier_post((unsigned*)(ctl + CW_BAR), MISC + 8); }
    const int lo = args.ph_lo, hi = args.ph_hi;
    const int NGW = G * 8, NGT = G * 512;

    for (int rep_ = 0; rep_ < 1 + ((REP_MASK >> 0) & 1); ++rep_)
    if (IN(0)) {
        KA_DECL
        __syncthreads();
        if (rep_ == 0 || ((REP_MASK >> 13) & 1)) {
            LAS float* sl = (LAS float*)lds;
            bool have = false;
            for (int it = vcu; it < 192; it += G) {
                if (!have) {
                    for (int i = tid; i < 5120; i += 512) { const int r = i >> 10, k = i & 1023; const float v = (r < 4) ? c_in[r * 1024 + k] : cctx_in[k]; sl[i] = v / (1.f + expf(-v)); }
                    __syncthreads(); have = true;
                }
                const int l = it / 96, cb = it % 96;
                const int r4 = lane >> 4, cq = lane & 15; const int k0 = wave * 128;
                const float* W = w_mod + (size_t)l * 1024 * 6144 + (size_t)(k0 + r4) * 6144 + cb * 64 + 4 * cq;
                f32x4 a0 = {0.f, 0.f, 0.f, 0.f}, a1 = a0, a2 = a0, a3 = a0, a4 = a0;
#pragma unroll 8
                for (int k = 0; k < 32; ++k) { const f32x4 wv = *(const f32x4*)(W + (size_t)(4 * k) * 6144); const int kk = k0 + 4 * k + r4;
                    a0 += wv * sl[kk]; a1 += wv * sl[1024 + kk]; a2 += wv * sl[2048 + kk]; a3 += wv * sl[3072 + kk]; a4 += wv * sl[4096 + kk]; }
                LAS float* part = sl + 5120;
                { LAS float* pp = part + (wave * 4 + r4) * 320 + 4 * cq;
                  *(LAS f32x4*)(pp) = a0; *(LAS f32x4*)(pp + 64) = a1; *(LAS f32x4*)(pp + 128) = a2; *(LAS f32x4*)(pp + 192) = a3; *(LAS f32x4*)(pp + 256) = a4; }
                __syncthreads();
                if (tid < 320) { const int r = tid >> 6, n = tid & 63; float sacc = b_mod[l * 6144 + cb * 64 + n];
#pragma unroll 8
                    for (int w = 0; w < 32; ++w) sacc += part[w * 320 + r * 64 + n];
                    modv[(size_t)(l * 5 + r) * 6144 + cb * 64 + n] = sacc; }
                __syncthreads();
            }
            __syncthreads();
        }
        if (rep_ == 0 || ((REP_MASK >> 14) & 1)) {
#pragma clang loop vectorize(disable) unroll(disable)
        for (int i = gt; i < 4096 * 32; i += NGT) {
            const int n = i >> 5, j = i & 31; const int jj = j & 15;
            const float inv = 1.0f / powf(10000.0f, (float)(2 * jj) / 32.0f);
            const float pos = (j < 16) ? (float)(n >> 6) : (float)(n & 63);
            const float ang = pos * inv; rope[i] = make_float2(cosf(ang), sinf(ang));
        }
#pragma clang loop vectorize(disable) unroll(disable)
        for (int i = gt; i < 4096; i += NGT) { float s, c; sincospif((float)i / 2048.f, &s, &c); twt[i] = make_float2(c, s); }
#pragma clang loop vectorize(disable) unroll(disable)
        for (int i = gt; i < 128 * 128; i += NGT) {
            const int m = i >> 7, k = i & 127; const int ri = m >> 6, k1 = m & 63, part = k >> 6, n1 = k & 63;
            float s, c; sincospif((float)((n1 * k1) & 63) / 32.f, &s, &c);
            float v; if (ri == 0) v = (part == 0) ? c : -s; else v = (part == 0) ? -s : -c;
            fma[i] = (bf16)f2bf(v);
        }
#pragma clang loop vectorize(disable) unroll(disable)
        for (int i = gt; i < 64 * 128; i += NGT) {
            const int k2 = i >> 7, k = i & 127; const int ri = k >> 6, n2 = k & 63;
            float s, c; sincospif((float)((n2 * k2) & 63) / 32.f, &s, &c);
            fmb[i] = (bf16)f2bf((ri == 0 ? c : s) * (1.f / 512.f));
        }
#pragma clang loop vectorize(disable) unroll(disable)
        for (int i = gt; i < 256 * 512; i += NGT) {
            const int kk = i >> 9, k = i & 511; const int part = k >> 8, n = k & 255;
            float s, c; sincospif((float)((n * kk) & 255) / 128.f, &s, &c);
            fmc[i] = (bf16)f2bf((part == 0 ? c : -s) * (1.f / 128.f));
        }
#pragma clang loop vectorize(disable) unroll(disable)
        for (int i = gt; i < 2 * 20480; i += NGT) {
            const int lw = i / 20480, r = i % 20480; const int d = r / 20, j = r % 20;
            ((float*)(ws + O_RW))[lw * 20480 + ((((j >> 2) * 4 + (d >> 8)) * 4 + (d & 3)) * 64 + ((d & 255) >> 2)) * 4 + (j & 3)] = (j < 4) ? w_grp[(size_t)lw * 4096 + d * 4 + j] : w_rtr[(size_t)lw * 16384 + d * 16 + (j - 4)];
        }
        }
        if (rep_ == 0 || ((REP_MASK >> 15) & 1)) {
            LAS float* Al = (LAS float*)lds;
            LAS float* Wl = Al + 4096;
            LAS float* Xl = Wl + 4096;
            for (int it = vcu; it < 256; it += G) {
                const int combo = it & 15, jb = it >> 4; const int l = combo >> 3, g = (combo >> 1) & 3, which = combo & 1;
                const float* Wg = four_w + (size_t)(l * 4 + g) * 4096; const LAS float* tb = trig + which * 64;
                const float* wi = w_in + (size_t)l * 1024 * 1280 + (size_t)(jb * 64) * 1280 + 1024 + g * 64;
                __syncthreads();
#pragma unroll
                for (int i = 0; i < 2; ++i) { const int idx = tid + 512 * i; *(LAS f32x4*)(Wl + 4 * idx) = *(const f32x4*)(Wg + 4 * idx); const int j = idx >> 4, c4 = idx & 15; *(LAS f32x4*)(Xl + j * 64 + 4 * c4) = *(const f32x4*)(wi + (size_t)j * 1280 + 4 * c4); }
                __syncthreads();
                { const int d = tid & 63, c0 = tid >> 6;
#pragma unroll 2
                  for (int i = 0; i < 8; ++i) { const int c = c0 + 8 * i; float a = 0.f;
#pragma unroll 16
                      for (int m = 0; m < 64; ++m) a += tb[(m * c) & 63] * Wl[m * 64 + d];
                      Al[c * 64 + d] = a; } }
                __syncthreads();
                { const int d = tid & 63, jl = 8 * (tid >> 6);
                  float o[8] = {0.f, 0.f, 0.f, 0.f, 0.f, 0.f, 0.f, 0.f};
#pragma unroll 4
                  for (int c = 0; c < 64; ++c) { const float av = Al[c * 64 + d];
#pragma unroll
                      for (int i = 0; i < 8; ++i) o[i] += Xl[(jl + i) * 64 + c] * av; }
                  v4u w; w.x = pk2(o[0], o[1]); w.y = pk2(o[2], o[3]); w.z = pk2(o[4], o[5]); w.w = pk2(o[6], o[7]);
                  *(v4u*)((bf16*)(ws + O_WIN + l * SZ_WIN1) + (size_t)(1024 + which * 256 + g * 64 + d) * 1024 + jb * 64 + jl) = w; }
            }
            for (int it = vcu; it < 256; it += G) {
                const int combo = it & 7, nb = it >> 3; const int l = combo >> 2, g = combo & 3, n0 = nb * 32;
                const float* pwg = pool_w + (size_t)(l * 4 + g) * 4096;
                __syncthreads();
#pragma unroll
                for (int i = 0; i < 2; ++i) { const int idx = tid + 512 * i; *(LAS f32x4*)(Wl + 4 * idx) = *(const f32x4*)(pwg + 4 * idx); }
                for (int i = tid; i < 2048; i += 512) { const int d = i >> 5, n = i & 31; Xl[i] = pool_scale[l * 256 + g * 64 + d] * w_out[(size_t)l * 1024 * 1024 + (size_t)(g * 64 + d) * 1024 + n0 + n]; }
                __syncthreads();
                { const int n = tid & 31, c0 = 4 * (tid >> 5);
                  float o[4] = {0.f, 0.f, 0.f, 0.f};
#pragma unroll 8
                  for (int d = 0; d < 64; ++d) { const float sv = Xl[d * 32 + n];
#pragma unroll
                      for (int i = 0; i < 4; ++i) o[i] += Wl[(c0 + i) * 64 + d] * sv; }
                  v2u w; w.x = pk2(o[0], o[1]); w.y = pk2(o[2], o[3]);
                  *(v2u*)((bf16*)(ws + O_WOUT + l * SZ_WOUT1) + (size_t)(n0 + n) * 1024 + g * 64 + c0) = w; }
            }
            __syncthreads();
        }
        if (rep_ == 0 || ((REP_MASK >> 16) & 1)) {
            LAS bf16* scr = (LAS bf16*)(lds + wave * 16384);
#pragma clang loop vectorize(disable) unroll(disable)
            for (int it0 = gw; it0 < CV_L; it0 += NGW) conv_item(KA, 0, it0, scr, lane);
        }
    }
    SEAM(0);
    if ((REP_MASK >> 12) & 1) { for (int k_ = 0; k_ < 4; ++k_) xcd_barrier(bar); }

    layer_body<0>(lds, G, vcu, bar, lo, hi);
    layer_body<1>(lds, G, vcu, bar, lo, hi);
    if (IN(17)) {
        KA_DECL
        const float* modp = modv + (size_t)5 * 6144;
#pragma clang loop vectorize(disable) unroll(disable)
        for (int r = gw; r < T; r += NGW) {
            const float* g2 = modp + (r >> 12) * 6144 + 5 * 1024; float* dst = outp + (size_t)r * 1024;
#pragma unroll
            for (int j = 0; j < 4; ++j) {
                const int c0 = 4 * lane + 256 * j; f32x4 v = *(const f32x4*)(dst + c0);
                const v2u ya = *(const v2u*)(y2 + (size_t)(2 * r) * 1024 + c0), yb = *(const v2u*)(y2 + (size_t)(2 * r + 1) * 1024 + c0);
                const f32x4 gv = *(const f32x4*)(g2 + c0);
                f32x4 yy; yy[0] = bflo(ya.x) + bflo(yb.x); yy[1] = bfhi(ya.x) + bfhi(yb.x); yy[2] = bflo(ya.y) + bflo(yb.y); yy[3] = bfhi(ya.y) + bfhi(yb.y);
                if (DBG_NO_MOE) yy = (f32x4){0.f, 0.f, 0.f, 0.f};
                *(f32x4*)(dst + c0) = v + gv * yy;
            }
        }
    }
#undef IN
#undef SEAM
}

#undef KA_DECL
#undef ws
#undef ctl
#undef x_in
#undef c_in
#undef ctx_in
#undef cctx_in
#undef w_mod
#undef b_mod
#undef norm1_g
#undef w_in
#undef q_norm_g
#undef k_norm_g
#undef attn_sink
#undef pool_w
#undef pool_scale
#undef four_w
#undef w_out
#undef norm2_g
#undef w_grp
#undef b_grp
#undef w_rtr
#undef b_rtr
#undef w_gate
#undef w_up
#undef w_down
#undef outp
#undef modv
#undef rope
#undef twt
#undef fma
#undef fmb
#undef fmc
#undef hbuf
#undef kall
#undef vall
#undef xc
#undef list
#undef wts
#undef act
#undef t2
#undef mrg
#undef qb
#undef pu
#undef zb
#undef y2
#undef modl
#undef win_t
#undef wout_t
#undef wgu_t
#undef wd_t
extern "C" void kernel_launch(void* const* d_in, const int* in_sizes, int n_in, void* d_out, int out_size, void* d_ws, size_t ws_size, hipStream_t stream) {
    static int grid = 0;
    if (grid == 0) {
        if (n_in != 23 || out_size != T * DM || ws_size < WS_END) { fprintf(stderr, "kernel_launch: unexpected shapes (n_in %d out %d ws %zu need %zu)\n", n_in, out_size, ws_size, (size_t)WS_END); grid = -1; return; }
        int dev = 0, cus = 0;
        if (hipGetDevice(&dev) != hipSuccess || hipDeviceGetAttribute(&cus, hipDeviceAttributeMultiprocessorCount, dev) != hipSuccess) { grid = -1; return; }
        if (cus != 256) { fprintf(stderr, "kernel_launch: built for a 256-CU device (row-tile hand-offs are laid out for 256 workgroups); found %d CUs; nothing launched\n", cus); grid = -1; return; }
        if (hipFuncSetAttribute((const void*)fwd_kernel, hipFuncAttributeMaxDynamicSharedMemorySize, LDS_BYTES) != hipSuccess) { fprintf(stderr, "kernel_launch: hipFuncSetAttribute failed\n"); grid = -1; return; }
        (void)hipGetLastError();
        grid = cus;
    }
    if (grid < 0) return;
    (void)hipMemsetAsync((char*)d_ws + O_CTL, 0, SZ_CTL, stream);
    Args a{};
    for (int i = 0; i < 23; ++i) a.in[i] = (const float*)d_in[i];
    a.out = (float*)d_out; a.ws = (unsigned char*)d_ws;
#if MK_SPLIT
    for (int p = 0; p < NPHASE; ++p) { a.ph_lo = p; a.ph_hi = p + 1; hipLaunchKernelGGL(fwd_kernel, dim3(grid), dim3(512), LDS_BYTES, stream, a); }
#else
    a.ph_lo = 0; a.ph_hi = NPHASE;
    hipLaunchKernelGGL(fwd_kernel, dim3(grid), dim3(512), LDS_BYTES, stream, a);
#endif
}
```

```cpp
#include <hip/hip_runtime.h>
#include <cstdio>
#include <cstdint>

#define DBG_NO_FOUR 0
#define DBG_NO_POOL 0
#define DBG_NO_ATT 0
#define DBG_NO_MOE 0
#define DBG_MOE_SCALE 1.0f
#define DBG_NAIVE_MOE 0
#define REP_MASK 0x0
#define DBG_NAIVE_ROUTE 0
#define LAS __attribute__((address_space(3)))
#define GAS __attribute__((address_space(1)))
typedef unsigned short bf16;
typedef short bf16x8 __attribute__((ext_vector_type(8)));
typedef float f32x4 __attribute__((ext_vector_type(4)));
typedef float f32x16 __attribute__((ext_vector_type(16)));
typedef unsigned v4u __attribute__((ext_vector_type(4)));
typedef unsigned v2u __attribute__((ext_vector_type(2)));
typedef GAS unsigned gu32;

#ifndef MK_SPLIT
#define MK_SPLIT 0
#endif

constexpr int NB = 4, NSEQ = 4096, DM = 1024, LCTX = 256, DEPTH = 2;
constexpr int T = NB * NSEQ, TC = NB * LCTX, TT = T + TC;
constexpr int KVROWS = LCTX + NSEQ;
constexpr int NEXP = 16, DEXP = 512;
constexpr int NPHASE = 18;
constexpr int MAXTILES = 152;
constexpr float QSCALE = 0.125f * 1.4426950408889634f;
constexpr float LOG2E = 1.4426950408889634f;

constexpr size_t al256(size_t x) { return (x + 255) & ~(size_t)255; }
constexpr size_t O_CTL = 0, SZ_CTL = 1u << 20;
constexpr size_t O_MOD = O_CTL + SZ_CTL, SZ_MOD = (size_t)2 * 5 * 6144 * 4;
constexpr size_t O_ROPE = al256(O_MOD + SZ_MOD), SZ_ROPE = (size_t)4096 * 32 * 8;
constexpr size_t O_TW = al256(O_ROPE + SZ_ROPE), SZ_TW = 4096 * 8;
constexpr size_t O_FMA = al256(O_TW + SZ_TW), SZ_FMA = 128 * 128 * 2;
constexpr size_t O_FMB = al256(O_FMA + SZ_FMA), SZ_FMB = 64 * 128 * 2;
constexpr size_t O_FMC = al256(O_FMB + SZ_FMB), SZ_FMC = 256 * 512 * 2;
constexpr size_t O_RW = al256(O_FMC + SZ_FMC), SZ_RW = (size_t)2 * 20480 * 4;
constexpr size_t O_WIN8 = al256(O_RW + SZ_RW), SZ_WIN8 = (size_t)768 * 1024;
constexpr size_t O_WIN = al256(O_WIN8 + 2 * SZ_WIN8), SZ_WIN1 = (size_t)1536 * 1024 * 2;
constexpr size_t O_WOUT = al256(O_WIN + 2 * SZ_WIN1), SZ_WOUT1 = (size_t)1024 * 1024 * 2;
constexpr size_t O_WGU = al256(O_WOUT + 2 * SZ_WOUT1), SZ_WGU1 = (size_t)16 * 1024 * 1024 * 2;
constexpr size_t O_WD = al256(O_WGU + 2 * SZ_WGU1), SZ_WD1 = (size_t)16 * 1024 * 512 * 2;
constexpr size_t O_H = al256(O_WD + 2 * SZ_WD1), SZ_H = (size_t)TT * 1024 * 2;
constexpr size_t O_KALL = al256(O_H + SZ_H), SZ_KV = (size_t)NB * KVROWS * 128 * 2;
constexpr size_t O_VALL = al256(O_KALL + SZ_KV);
constexpr size_t O_XC = al256(O_VALL + SZ_KV), SZ_XC = (size_t)TC * 1024 * 4;
constexpr size_t O_LIST = al256(O_XC + SZ_XC), SZ_LIST = (size_t)NEXP * TT * 4;
constexpr size_t O_WTS = al256(O_LIST + SZ_LIST), SZ_WTS = (size_t)TT * 2 * 4;
constexpr size_t O_EID = al256(O_WTS + SZ_WTS), SZ_EID = (size_t)TT * 2 * 4;
constexpr size_t O_ACT = al256(O_EID + SZ_EID), SZ_ACT = (size_t)MAXTILES * 256 * 512 * 2;
constexpr size_t O_T2 = O_ACT, SZ_T2 = (size_t)NB * 64 * 64 * 2 * 256 * 2;
constexpr size_t O_MRG = al256(O_ACT + SZ_ACT), SZ_MRG = (size_t)TT * 1024 * 2;
constexpr size_t O_Q = al256(O_MRG + SZ_MRG), SZ_Q = (size_t)TT * 512 * 2;
constexpr size_t O_PU = al256(O_Q + SZ_Q), SZ_PU = (size_t)TT * 256 * 2;
constexpr size_t O_Z = al256(O_PU + SZ_PU), SZ_Z = (size_t)TT * 512 * 2;
constexpr size_t O_Y2 = O_MRG, SZ_Y2 = (size_t)TT * 2 * 1024 * 2;
constexpr size_t O_XB = al256(O_Z + SZ_Z), SZ_XB = (size_t)TT * 1024 * 2;
constexpr size_t WS_END = al256(O_XB + SZ_XB);
static_assert(SZ_T2 <= SZ_ACT, "T2 overlay");
static_assert(O_Y2 + SZ_Y2 <= WS_END, "y2 overlay");

constexpr int CW_TMO = 0;
constexpr int CW_BAR = 4096;
constexpr int CW_KF = 65536;
constexpr int CW_FA = 3072;
constexpr int CW_G2 = 40960;
constexpr int CW_RDY = 32768;
constexpr int CW_Q = 2048;
constexpr int CW_DONE = 2560;
constexpr int CW_CNT = 16384;

constexpr int RING_BYTES = 131072;
constexpr int LDSCTL_OFF = RING_BYTES, MISC_OFF = LDSCTL_OFF + 320;
constexpr int TRIG_OFF = LDSCTL_OFF + 1024;
constexpr int TILE_OFF = LDSCTL_OFF + 2048;
constexpr int LDS_BYTES = 147456;

#define RLX_AGENT __ATOMIC_RELAXED, __HIP_MEMORY_SCOPE_AGENT
#define LDS_WAIT() asm volatile("s_waitcnt lgkmcnt(0)" ::: "memory")
#define VM_WAIT() asm volatile("s_waitcnt vmcnt(0)" ::: "memory")

__device__ __forceinline__ unsigned f2bf(float f) { unsigned u = __builtin_bit_cast(unsigned, f); return (u + 0x7fffu + ((u >> 16) & 1u)) >> 16; }
typedef float f32x2_t_ __attribute__((ext_vector_type(2))); typedef __bf16 bf16x2_t_ __attribute__((ext_vector_type(2)));
__device__ __forceinline__ unsigned pk2(float lo, float hi) { f32x2_t_ v = {lo, hi}; return __builtin_bit_cast(unsigned, __builtin_convertvector(v, bf16x2_t_)); }
__device__ __forceinline__ unsigned pk4_f8(float a, float b, float c, float d) { unsigned w = 0; w = __builtin_amdgcn_cvt_pk_fp8_f32(a, b, w, false); w = __builtin_amdgcn_cvt_pk_fp8_f32(c, d, w, true); return w; }
__device__ __forceinline__ float bflo(unsigned w) { return __builtin_bit_cast(float, w << 16); }
__device__ __forceinline__ float bfhi(unsigned w) { return __builtin_bit_cast(float, w & 0xffff0000u); }
__device__ __forceinline__ float bf2f(bf16 h) { return __builtin_bit_cast(float, (unsigned)h << 16); }
template <int CTRL, int RM> __device__ __forceinline__ float dppf(float v) { return __builtin_bit_cast(float, __builtin_amdgcn_update_dpp(0, __builtin_bit_cast(int, v), CTRL, RM, 0xf, true)); }
__device__ __forceinline__ float wave_sum(float v) {
    v += dppf<0x111, 0xf>(v); v += dppf<0x112, 0xf>(v); v += dppf<0x114, 0xf>(v); v += dppf<0x118, 0xf>(v);
    v += dppf<0x142, 0xa>(v); v += dppf<0x143, 0xc>(v);
    return __builtin_bit_cast(float, __builtin_amdgcn_readlane(__builtin_bit_cast(int, v), 63));
}

__device__ __forceinline__ float swap32_sum(float x, float y) {
    const auto rr = __builtin_amdgcn_permlane32_swap(__builtin_bit_cast(unsigned, x), __builtin_bit_cast(unsigned, y), false, false);
    unsigned r0 = rr[0], r1 = rr[1]; asm volatile("" : "+v"(r0), "+v"(r1));
    return __builtin_bit_cast(float, r0) + __builtin_bit_cast(float, r1);
}
__device__ __forceinline__ float swap16_sum(float x, float y) {
    const auto rr = __builtin_amdgcn_permlane16_swap(__builtin_bit_cast(unsigned, x), __builtin_bit_cast(unsigned, y), false, false);
    unsigned r0 = rr[0], r1 = rr[1]; asm volatile("" : "+v"(r0), "+v"(r1));
    return __builtin_bit_cast(float, r0) + __builtin_bit_cast(float, r1);
}

#define XB_TMO      128
#define XB_XCNT(j)  (256  + 64 * (j))
#define XB_XSUB(j)  (1280 + 64 * (j))
#define XB_XGEN(j)  (2304 + 64 * (j))
#define XB_TOP      3328
#define XB_TOPGEN   3392
#define XCD_BAR_WORDS 3456
#define XB_SPIN_CAP (1u << 18)
__device__ __forceinline__ unsigned xb_ld(unsigned* p)              { return __hip_atomic_load(p, __ATOMIC_RELAXED, __HIP_MEMORY_SCOPE_AGENT); }
__device__ __forceinline__ unsigned xb_add(unsigned* p, unsigned v) { return __hip_atomic_fetch_add(p, v, __ATOMIC_RELAXED, __HIP_MEMORY_SCOPE_AGENT); }
__device__ __forceinline__ unsigned xb_xcc_id() { return (unsigned)__builtin_amdgcn_s_getreg((3 << 11) | 20) & 0xFu; }
#define XB_SPIN(cond, bar) do { unsigned _sp = 0; while (cond) { __builtin_amdgcn_s_sleep(1); \
    if ((++_sp & 255u) == 0u) { if (xb_ld(&(bar)[XB_TMO])) break; if (_sp > XB_SPIN_CAP) { atomicAdd(&(bar)[XB_TMO], 1u); break; } } } } while (0)
struct XcdBarrier { unsigned* bar; unsigned x; volatile LAS unsigned* st; };
__device__ __forceinline__ XcdBarrier xcd_barrier_post(unsigned* bar, volatile LAS unsigned* st) {
    XcdBarrier b; b.bar = bar; b.x = xb_xcc_id(); b.st = st;
    if (threadIdx.x == 0) (void)xb_add(&bar[XB_XCNT(b.x)], 1u);
    return b;
}
__device__ __forceinline__ void xcd_barrier_complete(unsigned* bar, unsigned x, unsigned& nloc, unsigned& nx) {
    const unsigned G = gridDim.x * gridDim.y * gridDim.z;
    unsigned sum, cnt, mine, sp = 0u;
    for (;;) {
        sum = 0u; cnt = 0u; mine = 0u;
#pragma unroll
        for (unsigned j = 0; j < 16; ++j) { const unsigned c = xb_ld(&bar[XB_XCNT(j)]); sum += c; cnt += (c > 0u) ? 1u : 0u; mine = (j == x) ? c : mine; }
        if (sum == G) break;
        __builtin_amdgcn_s_sleep(1);
        if ((++sp & 255u) == 0u) { if (xb_ld(&bar[XB_TMO])) break; if (sp > XB_SPIN_CAP) { atomicAdd(&bar[XB_TMO], 1u); break; } }
    }
    nloc = mine > 0u ? mine : 1u; nx = cnt > 0u ? cnt : 1u;
}
__device__ __forceinline__ void xcd_barrier(const XcdBarrier& b) {
    asm volatile("s_waitcnt vmcnt(0)" ::: "memory");
    __syncthreads();
    if (threadIdx.x == 0) {
        unsigned* bar = b.bar;
        __builtin_amdgcn_s_waitcnt(0);
        unsigned nloc = b.st[0], nx = b.st[1];
        if (nloc == 0u) { xcd_barrier_complete(bar, b.x, nloc, nx); b.st[0] = nloc; b.st[1] = nx; }
        const unsigned old = xb_add(&bar[XB_XSUB(b.x)], 1u);
        const unsigned gen = old / nloc;
        if (old + 1u == (gen + 1u) * nloc) {
            __builtin_amdgcn_fence(__ATOMIC_RELEASE, "agent");
            asm volatile("s_waitcnt vmcnt(0)" ::: "memory");
            const unsigned og = xb_add(&bar[XB_TOP], 1u);
            const unsigned tg = og / nx;
            if (og + 1u == (tg + 1u) * nx) xb_add(&bar[XB_TOPGEN], 1u);
            else XB_SPIN(xb_ld(&bar[XB_TOPGEN]) == tg, bar);
            __builtin_amdgcn_fence(__ATOMIC_ACQUIRE, "agent");
            xb_add(&bar[XB_XGEN(b.x)], 1u);
            asm volatile("s_waitcnt vmcnt(0)" ::: "memory");
        } else {
            XB_SPIN(xb_ld(&bar[XB_XGEN(b.x)]) == gen, bar);
            __builtin_amdgcn_fence(__ATOMIC_ACQUIRE, "agent");
            asm volatile("s_waitcnt vmcnt(0)" ::: "memory");
        }
    }
    __syncthreads();
}

namespace pg8 {
constexpr int BM = 256, BK = 64, HALF = 128, HTB = HALF * BK * 2;
__host__ __device__ __forceinline__ int lds_byte(int r, int c) { const int st = (r >> 4) * 2 + (c >> 5), rr = r & 15, cc = c & 31, ob = rr * 64 + cc * 2; return st * 1024 + (ob ^ (((ob >> 9) & 1) << 5)); }
__host__ __device__ __forceinline__ void stage_rc(int b, int& R, int& C) { const int st = b / 1024, sb = b % 1024, swz = sb ^ (((sb >> 9) & 1) << 5); R = (st >> 1) * 16 + swz / 64; C = (st & 1) * 32 + (swz % 64) / 2; }
__host__ __device__ __forceinline__ int perm32(int rho) { const int n = rho >> 4, i = rho & 15; return 8 * (i >> 2) + 4 * n + (i & 3); }

struct Unit { int pm, pn, e, cnt, kind; };

typedef int v8i __attribute__((ext_vector_type(8)));
typedef int v4i __attribute__((ext_vector_type(4)));
template <class Epi, class Sched, bool F8ALL = false>
__device__ __forceinline__ void gemm_phase(LAS unsigned char* lds, const Sched& S, const Epi& E) {
    int tid = threadIdx.x; asm volatile("" : "+v"(tid));
    const int wid = __builtin_amdgcn_readfirstlane(tid >> 6), lane = tid & 63, wr = wid >> 2, wc = wid & 3, fr = lane & 15, fq = lane >> 4;
#define PG8_RC() int RA[2], CA[2], RB[2]; { int tl_ = tid; asm volatile("" : "+v"(tl_)); _Pragma("unroll") for (int i = 0; i < 2; ++i) { int R, C; stage_rc(tl_ * 16 + i * 8192, R, C); RA[i] = R; CA[i] = C; RB[i] = Epi::PERM ? ((R & ~31) + perm32(R & 31)) : R; } }
    const size_t kstep = (size_t)(BK * 2);
    const unsigned ldsw = (unsigned)wid * 1024u;
    const int aoff = lds_byte(wr * 64 + fr, fq * 8), boff = lds_byte(wc * 32 + fr, fq * 8);
#define PG8_SA(b, h) (((b) * 2 + (h)) * HTB)
#define PG8_SB(b, h) ((4 + (b) * 2 + (h)) * HTB)
#define PG8_STAGE2(bufoff, gbase, o0, o1) do { \
        __builtin_amdgcn_global_load_lds((const unsigned*)((const char*)(gbase) + (o0)), (LAS unsigned*)(lds + (bufoff) + ldsw), 16, 0, 0); \
        __builtin_amdgcn_global_load_lds((const unsigned*)((const char*)(gbase) + (o1)), (LAS unsigned*)(lds + (bufoff) + ldsw + 8192), 16, 0, 0); } while (0)
#define PG8_LD8(p) __builtin_shufflevector(*(const LAS v4i*)(p), *(const LAS v4i*)((p) + 1024), 0, 1, 2, 3, 4, 5, 6, 7)
#define PG8_LDA(dst, b, h) do { _Pragma("unroll") for (int m = 0; m < 4; ++m) dst[m] = PG8_LD8(lds + PG8_SA(b, h) + aoff + m * 2048); } while (0)
#define PG8_LDB(dst, b, h) do { _Pragma("unroll") for (int n = 0; n < 2; ++n) dst[n] = PG8_LD8(lds + PG8_SB(b, h) + boff + n * 2048); } while (0)
#define PG8_LO(x) __builtin_bit_cast(bf16x8, __builtin_shufflevector(x, x, 0, 1, 2, 3))
#define PG8_HI(x) __builtin_bit_cast(bf16x8, __builtin_shufflevector(x, x, 4, 5, 6, 7))
#define PG8_MMA(ai, bj, At, Bt) do { __builtin_amdgcn_s_setprio(1); \
        if (F8ALL) { _Pragma("unroll") for (int m = 0; m < 4; ++m) _Pragma("unroll") for (int n = 0; n < 2; ++n) \
            asm volatile("v_mfma_scale_f32_16x16x128_f8f6f4 %0, %1, %2, %0, %3, %3 op_sel_hi:[0,0,0]" : "+v"(acc[ai][bj][m][n]) : "v"(Bt[n]), "v"(At[m]), "v"(f8sc)); } \
        else { _Pragma("unroll") for (int m = 0; m < 4; ++m) _Pragma("unroll") for (int n = 0; n < 2; ++n) { \
            acc[ai][bj][m][n] = __builtin_amdgcn_mfma_f32_16x16x32_bf16(PG8_LO(Bt[n]), PG8_LO(At[m]), acc[ai][bj][m][n], 0, 0, 0); \
            acc[ai][bj][m][n] = __builtin_amdgcn_mfma_f32_16x16x32_bf16(PG8_HI(Bt[n]), PG8_HI(At[m]), acc[ai][bj][m][n], 0, 0, 0); } } \
        __builtin_amdgcn_s_setprio(0); } while (0)
#define PG8_WAIT_V(n) asm volatile("s_waitcnt vmcnt(" #n ")" ::: "memory")
#define PG8_WAIT_L(n) asm volatile("s_waitcnt lgkmcnt(" #n ")" ::: "memory")
#define PG8_BAR __builtin_amdgcn_s_barrier()
#define PG8_SCHED __builtin_amdgcn_sched_barrier(0)
    Unit cur, nxt; int ui = 0;
    if (!S.next(0, cur)) return;
    f32x4 acc[2][2][4][2];
#pragma unroll
    for (int a = 0; a < 2; ++a)
#pragma unroll
        for (int b = 0; b < 2; ++b)
#pragma unroll
            for (int m = 0; m < 4; ++m)
#pragma unroll
                for (int n = 0; n < 2; ++n) acc[a][b][m][n] = (f32x4){0.f, 0.f, 0.f, 0.f};
    v8i At[4], B0[2], B1[2];
    int f8sc = 0x7c7c7c7c; asm volatile("" : "+v"(f8sc));
    int Kc = S.K(cur), Kn; const char* Ac = S.a_base(cur); const char* An; const char* cB = S.b_ptr(cur); const char* nB;
    unsigned oc00, oc01, oc10, oc11, on00, on01, on10, on11, vbc0, vbc1, vbn0, vbn1; size_t hsc, hsn;
    { PG8_RC()
    oc00 = S.a_off(cur, RA[0], CA[0]); oc01 = S.a_off(cur, RA[1], CA[1]); oc10 = S.a_off(cur, HALF + RA[0], CA[0]); oc11 = S.a_off(cur, HALF + RA[1], CA[1]);
    vbc0 = (unsigned)(RB[0] * Kc + CA[0]) * 2u; vbc1 = (unsigned)(RB[1] * Kc + CA[1]) * 2u; hsc = (size_t)HALF * Kc * 2; }
    S.a_ready(cur);
    PG8_STAGE2(PG8_SB(0, 0), cB, vbc0, vbc1); PG8_STAGE2(PG8_SB(0, 1), cB + hsc, vbc0, vbc1); PG8_STAGE2(PG8_SA(0, 0), Ac, oc00, oc01); PG8_STAGE2(PG8_SA(0, 1), Ac, oc10, oc11);
    if (wr == 1) PG8_BAR;
    PG8_WAIT_V(2); PG8_BAR;
    PG8_STAGE2(PG8_SB(1, 0), cB + kstep, vbc0, vbc1); PG8_STAGE2(PG8_SA(1, 0), Ac + kstep, oc00, oc01); PG8_STAGE2(PG8_SB(1, 1), cB + hsc + kstep, vbc0, vbc1);
    PG8_WAIT_V(6); PG8_BAR;
    for (;;) {
        const bool has_next = S.next(ui + 1, nxt);
        Kn = Kc; An = Ac; nB = cB; on00 = oc00; on01 = oc01; on10 = oc10; on11 = oc11; vbn0 = vbc0; vbn1 = vbc1; hsn = hsc;
        if (has_next) { Kn = S.K(nxt); An = S.a_base(nxt); nB = S.b_ptr(nxt); PG8_RC()
            on00 = S.a_off(nxt, RA[0], CA[0]); on01 = S.a_off(nxt, RA[1], CA[1]); on10 = S.a_off(nxt, HALF + RA[0], CA[0]); on11 = S.a_off(nxt, HALF + RA[1], CA[1]);
            vbn0 = (unsigned)(RB[0] * Kn + CA[0]) * 2u; vbn1 = (unsigned)(RB[1] * Kn + CA[1]) * 2u; hsn = (size_t)HALF * Kn * 2; }
        const int nt = Kc / BK;
#pragma clang loop unroll(disable)
        for (int t = 0; t < nt; t += 2) {
            const bool last = (t == nt - 2);
            if (last && has_next) S.a_ready(nxt);
            const char* a1 = Ac + (size_t)(t + 1) * kstep;
            const char* a2 = last ? An : Ac + (size_t)(t + 2) * kstep; const char* b2 = last ? nB : cB + (size_t)(t + 2) * kstep;
            const char* a3 = a2 + kstep; const char* b3 = b2 + kstep;
            const unsigned x00 = last ? on00 : oc00, x01 = last ? on01 : oc01, x10 = last ? on10 : oc10, x11 = last ? on11 : oc11;
            const unsigned y0 = last ? vbn0 : vbc0, y1 = last ? vbn1 : vbc1; const size_t hs2 = last ? hsn : hsc;
            PG8_LDB(B0, 0, 0); PG8_LDB(B1, 0, 1); PG8_SCHED; PG8_LDA(At, 0, 0); PG8_STAGE2(PG8_SA(1, 1), a1, oc10, oc11);
            PG8_WAIT_V(8); PG8_WAIT_L(0); PG8_BAR; PG8_MMA(0, 0, At, B0); PG8_MMA(0, 1, At, B1); PG8_BAR; PG8_SCHED;
            PG8_LDA(At, 0, 1); PG8_STAGE2(PG8_SB(0, 0), b2, y0, y1); PG8_STAGE2(PG8_SB(0, 1), b2 + hs2, y0, y1); PG8_STAGE2(PG8_SA(0, 0), a2, x00, x01);
            PG8_WAIT_V(8); PG8_WAIT_L(0); PG8_BAR; PG8_MMA(1, 0, At, B0); PG8_MMA(1, 1, At, B1); PG8_BAR; PG8_SCHED;
            PG8_LDB(B0, 1, 0); PG8_LDB(B1, 1, 1); PG8_SCHED; PG8_LDA(At, 1, 0); PG8_STAGE2(PG8_SA(0, 1), a2, x10, x11);
            PG8_WAIT_V(8); PG8_WAIT_L(0); PG8_BAR; PG8_MMA(0, 0, At, B0); PG8_MMA(0, 1, At, B1); PG8_BAR; PG8_SCHED;
            PG8_LDA(At, 1, 1); PG8_STAGE2(PG8_SB(1, 0), b3, y0, y1); PG8_STAGE2(PG8_SB(1, 1), b3 + hs2, y0, y1); PG8_STAGE2(PG8_SA(1, 0), a3, x00, x01);
            PG8_WAIT_V(8); PG8_WAIT_L(0); PG8_BAR; PG8_MMA(1, 0, At, B0); PG8_MMA(1, 1, At, B1); PG8_BAR; PG8_SCHED;
        }
        if (wr == 0) PG8_BAR;
        if (F8ALL) asm volatile("s_nop 15\n\ts_nop 15" ::: "memory");
        E(acc, cur, wr, wc, fr, fq);
        if (!has_next) break;
#pragma unroll
        for (int a = 0; a < 2; ++a)
#pragma unroll
            for (int b = 0; b < 2; ++b)
#pragma unroll
                for (int m = 0; m < 4; ++m)
#pragma unroll
                    for (int n = 0; n < 2; ++n) acc[a][b][m][n] = (f32x4){0.f, 0.f, 0.f, 0.f};
        cur = nxt; Kc = Kn; Ac = An; cB = nB; oc00 = on00; oc01 = on01; oc10 = on10; oc11 = on11; vbc0 = vbn0; vbc1 = vbn1; hsc = hsn; ++ui;
        if (wr == 1) PG8_BAR;
    }
    PG8_WAIT_V(0);
    PG8_BAR;
#undef PG8_RC
#undef PG8_SA
#undef PG8_SB
#undef PG8_STAGE2
#undef PG8_LDA
#undef PG8_LD8
#undef PG8_LO
#undef PG8_HI
#undef PG8_LDB
#undef PG8_MMA
#undef PG8_WAIT_V
#undef PG8_WAIT_L
#undef PG8_BAR
#undef PG8_SCHED
}
}

__device__ __forceinline__ void store16_wt(void* p, v4u v) { asm volatile("global_store_dwordx4 %0, %1, off sc1\n\ts_nop 1" :: "v"(p), "v"(v) : "memory"); }
__device__ __forceinline__ int krow_of(int r) {
    if (r < T) return (r >> 12) * KVROWS + LCTX + (r & 4095);
    const int rc = r - T; return (rc >> 8) * KVROWS + (rc & 255);
}
struct SchedPlain {
    int nM, nN, G, vcu, Kk; const char* A; const char* B;
    __device__ __forceinline__ bool next(int i, pg8::Unit& u) const { const int L = i * G + vcu; if (L >= nM * nN) return false; u.pm = L / nN; u.pn = L % nN; u.e = 0; u.cnt = 256; u.kind = 0; return true; }
    __device__ __forceinline__ int K(const pg8::Unit&) const { return Kk; }
    __device__ __forceinline__ const char* a_base(const pg8::Unit&) const { return A; }
    __device__ __forceinline__ unsigned a_off(const pg8::Unit& u, int row, int col) const { return (unsigned)((u.pm * 256 + row) * Kk + col) * 2u; }
    __device__ __forceinline__ const char* b_ptr(const pg8::Unit& u) const { return B + (size_t)u.pn * 256 * Kk * 2; }
    __device__ __forceinline__ void a_ready(const pg8::Unit&) const {}
};
struct SchedG1 {
    int G, vcu, f8; const char* A; const char* B;
    __device__ __forceinline__ bool next(int i, pg8::Unit& u) const { const int L = i * G + (f8 ? G - 1 - vcu : vcu); if (L >= (TT / 256) * 3) return false;
        u.pm = L / 3; const int j = L % 3; u.pn = f8 ? 1 + j : (j == 0 ? 0 : 3 + j); u.e = 0; u.cnt = 256; u.kind = 0; return true; }
    __device__ __forceinline__ int K(const pg8::Unit&) const { return f8 ? 512 : 1024; }
    __device__ __forceinline__ const char* a_base(const pg8::Unit&) const { return A; }
    __device__ __forceinline__ unsigned a_off(const pg8::Unit& u, int row, int col) const { return (unsigned)((u.pm * 256 + row) * (f8 ? 512 : 1024) + col) * 2u; }
    __device__ __forceinline__ const char* b_ptr(const pg8::Unit& u) const { return f8 ? B + (size_t)(u.pn - 1) * 256 * 1024 : B + (size_t)u.pn * 256 * 1024 * 2; }
    __device__ __forceinline__ void a_ready(const pg8::Unit&) const {}
};
struct EpiG1 {
    static constexpr bool PERM = true;
    bf16 *pu, *q, *kall, *vall, *z;
    __device__ __forceinline__ void operator()(const f32x4 (&acc)[2][2][4][2], const pg8::Unit& u, int wr, int wc, int fr, int fq) const {
        const int row0 = u.pm * 256 + wr * 64 + fr, c8 = wc * 32 + 8 * fq;
#pragma unroll
        for (int ai = 0; ai < 2; ++ai)
#pragma unroll
            for (int m = 0; m < 4; ++m) {
                const int row = row0 + ai * 128 + m * 16;
#pragma unroll
                for (int bj = 0; bj < 2; ++bj) {
                    const f32x4 v0 = acc[ai][bj][m][0], v1 = acc[ai][bj][m][1];
                    v4u w; w.x = pk2(v0[0], v0[1]); w.y = pk2(v0[2], v0[3]); w.z = pk2(v1[0], v1[1]); w.w = pk2(v1[2], v1[3]);
                    bf16* dst;
                    if (u.pn == 0) dst = pu + (size_t)row * 256 + bj * 128 + c8;
                    else if (u.pn <= 2) dst = q + (size_t)row * 512 + (u.pn - 1) * 256 + bj * 128 + c8;
                    else if (u.pn == 3) dst = (bj == 0 ? kall : vall) + (size_t)krow_of(row) * 128 + c8;
                    else dst = z + (size_t)row * 512 + (u.pn - 4) * 256 + bj * 128 + c8;
                    *(v4u*)dst = w;
                }
            }
    }
};
template <bool BB> struct EpiG2 {
    static constexpr bool PERM = true;
    const float* xin; const float* cin; bf16* xs; const float* mod; unsigned* ready;
    __device__ __forceinline__ void operator()(const f32x4 (&acc)[2][2][4][2], const pg8::Unit& u, int wr, int wc, int fr, int fq) const {
        const int rt0 = u.pm * 256; const bool isc = rt0 >= T;
        const int bsel = isc ? 4 : (rt0 >> 12);
        const float* g1 = mod + bsel * 6144 + 2048;
        const float* base = isc ? cin - (size_t)T * 1024 : xin;
        const int row0 = rt0 + wr * 64 + fr, c8 = u.pn * 256 + wc * 32 + 8 * fq;
#pragma unroll
        for (int bj = 0; bj < 2; ++bj) {
            const int col = c8 + bj * 128; const f32x4 ga = *(const f32x4*)(g1 + col), gb = *(const f32x4*)(g1 + col + 4);
            if (BB) {
                v4u b[2][4];
#pragma unroll
                for (int ai = 0; ai < 2; ++ai)
#pragma unroll
                    for (int m = 0; m < 4; ++m) b[ai][m] = *(const v4u*)(xs + (size_t)(row0 + ai * 128 + m * 16) * 1024 + col);
#pragma unroll
                for (int ai = 0; ai < 2; ++ai)
#pragma unroll
                    for (int m = 0; m < 4; ++m) { const v4u w = b[ai][m]; const f32x4 a0 = acc[ai][bj][m][0], a1 = acc[ai][bj][m][1];
                        v4u o; o.x = pk2(bflo(w.x) + ga[0] * a0[0], bfhi(w.x) + ga[1] * a0[1]); o.y = pk2(bflo(w.y) + ga[2] * a0[2], bfhi(w.y) + ga[3] * a0[3]);
                        o.z = pk2(bflo(w.z) + gb[0] * a1[0], bfhi(w.z) + gb[1] * a1[1]); o.w = pk2(bflo(w.w) + gb[2] * a1[2], bfhi(w.w) + gb[3] * a1[3]);
                        store16_wt(xs + (size_t)(row0 + ai * 128 + m * 16) * 1024 + col, o); }
            } else {
#pragma unroll
                for (int ai = 0; ai < 2; ++ai) {
                    f32x4 b0[4], b1[4];
#pragma unroll
                    for (int m = 0; m < 4; ++m) { const float* bp = base + (size_t)(row0 + ai * 128 + m * 16) * 1024 + col; b0[m] = *(const f32x4*)bp; b1[m] = *(const f32x4*)(bp + 4); }
#pragma unroll
                    for (int m = 0; m < 4; ++m) { const f32x4 x0 = b0[m] + ga * acc[ai][bj][m][0], x1 = b1[m] + gb * acc[ai][bj][m][1];
                        v4u o; o.x = pk2(x0[0], x0[1]); o.y = pk2(x0[2], x0[3]); o.z = pk2(x1[0], x1[1]); o.w = pk2(x1[2], x1[3]);
                        store16_wt(xs + (size_t)(row0 + ai * 128 + m * 16) * 1024 + col, o); }
                }
            }
        }
        asm volatile("s_waitcnt vmcnt(0)" ::: "memory");
        if ((threadIdx.x & 63) == 0) __hip_atomic_fetch_add(ready + 16 * u.pm, 1u, __ATOMIC_RELAXED, __HIP_MEMORY_SCOPE_AGENT);
    }
};
struct SchedMoe {
    int G, vcu, ntile;
    const char* hb; const char* actb; const char* wgu; const char* wd; const unsigned* list; const LAS int* tt; unsigned* ready; unsigned* tmo;
    __device__ __forceinline__ bool next(int i, pg8::Unit& u) const {
        const int U = ntile * 4; const int r = U % G, q = U / G; const int n3 = q + (vcu < r ? 1 : 0); int L;
        if (i < n3) { L = i * G + vcu; u.kind = 0; }
        else { const int j = i - n3; const int nl = G - r;
            if (vcu >= r) L = (j == 0) ? (vcu - r) : (j == 1) ? nl + (vcu - r) : 2 * nl + (j - 2) * G + vcu;
            else L = 2 * nl + j * G + vcu;
            if (L >= U) return false; u.kind = 1; }
        const int tau = L >> 2; u.pn = L & 3; u.pm = tau; int e = 0;
#pragma unroll
        for (int k = 1; k < 16; ++k) e += (tt[k] <= tau) ? 1 : 0;
        u.e = e; const int r0 = (tau - tt[e]) * 256; const int c = tt[17 + e] - r0; u.cnt = c < 256 ? c : 256; return true;
    }
    __device__ __forceinline__ int K(const pg8::Unit& u) const { return u.kind ? 256 : 512; }
    __device__ __forceinline__ const char* a_base(const pg8::Unit& u) const { return u.kind ? actb : hb; }
    __device__ __forceinline__ unsigned a_off(const pg8::Unit& u, int row, int col) const {
        if (u.kind) return (unsigned)((u.pm * 256 + row) * 256 + col) * 2u;
        const int r0 = (u.pm - tt[u.e]) * 256; const int rr = row < u.cnt ? row : u.cnt - 1;
        const unsigned tok = list[(size_t)u.e * TT + r0 + rr] >> 1;
        return (tok * 512u + (unsigned)col) * 2u;
    }
    __device__ __forceinline__ const char* b_ptr(const pg8::Unit& u) const { return u.kind ? wd + ((size_t)u.e * 1024 + (size_t)u.pn * 256) * 256 * 2 : wgu + ((size_t)u.e * 1024 + (size_t)u.pn * 256) * 512 * 2; }
    __device__ __forceinline__ void a_ready(const pg8::Unit& u) const {
        if (!u.kind) return;
        if (threadIdx.x < 64) {
            unsigned* w = ready + 16 * u.pm; unsigned sp = 0;
            while ((unsigned)__builtin_amdgcn_readfirstlane(__hip_atomic_load(w, __ATOMIC_RELAXED, __HIP_MEMORY_SCOPE_AGENT)) < 32u) {
                __builtin_amdgcn_s_sleep(2);
                if (++sp > (1u << 22)) { if (threadIdx.x == 0) __hip_atomic_store(tmo, 1u, __ATOMIC_RELAXED, __HIP_MEMORY_SCOPE_AGENT); break; } }
            __builtin_amdgcn_fence(__ATOMIC_ACQUIRE, "agent");
            asm volatile("s_waitcnt vmcnt(0)" ::: "memory");
        }
        asm volatile("" ::: "memory"); __builtin_amdgcn_s_barrier(); asm volatile("" ::: "memory");
    }
};
struct EpiG3 {
    static constexpr bool PERM = true;
    bf16* act; unsigned* ready;
    __device__ __forceinline__ void operator()(const f32x4 (&acc)[2][2][4][2], const pg8::Unit& u, int wr, int wc, int fr, int fq) const {
        const int row0 = u.pm * 256 + wr * 64 + fr, c8 = u.pn * 128 + wc * 32 + 8 * fq;
#pragma unroll
        for (int ai = 0; ai < 2; ++ai)
#pragma unroll
            for (int m = 0; m < 4; ++m) {
                float a[8];
#pragma unroll
                for (int n = 0; n < 2; ++n)
#pragma unroll
                    for (int k = 0; k < 4; ++k) { const float g = acc[ai][0][m][n][k], up = acc[ai][1][m][n][k]; a[n * 4 + k] = g * __builtin_amdgcn_rcpf(1.f + __builtin_amdgcn_exp2f(-LOG2E * g)) * up; }
                const unsigned long long w8 = (unsigned long long)pk4_f8(a[0], a[1], a[2], a[3]) | ((unsigned long long)pk4_f8(a[4], a[5], a[6], a[7]) << 32);
                __hip_atomic_store((unsigned long long*)((unsigned char*)act + (size_t)(row0 + ai * 128 + m * 16) * 512 + c8), w8, __ATOMIC_RELAXED, __HIP_MEMORY_SCOPE_AGENT);
            }
        asm volatile("s_waitcnt vmcnt(0)" ::: "memory");
        if ((threadIdx.x & 63) == 0) __hip_atomic_fetch_add(ready + 16 * u.pm, 1u, __ATOMIC_RELAXED, __HIP_MEMORY_SCOPE_AGENT);
    }
};
struct EpiG4 {
    static constexpr bool PERM = true;
    bf16* y2; const unsigned* list; const float* wts; const LAS int* tt;
    __device__ __forceinline__ void operator()(const f32x4 (&acc)[2][2][4][2], const pg8::Unit& u, int wr, int wc, int fr, int fq) const {
        const int r0 = (u.pm - tt[u.e]) * 256; const int c8 = u.pn * 256 + wc * 32 + 8 * fq;
        unsigned ent[2][4]; float w[2][4];
#pragma unroll
        for (int ai = 0; ai < 2; ++ai)
#pragma unroll
            for (int m = 0; m < 4; ++m) { const int row = wr * 64 + fr + ai * 128 + m * 16; ent[ai][m] = list[(size_t)u.e * TT + r0 + (row < u.cnt ? row : u.cnt - 1)]; }
#pragma unroll
        for (int ai = 0; ai < 2; ++ai)
#pragma unroll
            for (int m = 0; m < 4; ++m) w[ai][m] = wts[ent[ai][m]];
#pragma unroll
        for (int ai = 0; ai < 2; ++ai)
#pragma unroll
            for (int m = 0; m < 4; ++m) {
                const int row = wr * 64 + fr + ai * 128 + m * 16;
                if (row < u.cnt) {
#pragma unroll
                    for (int bj = 0; bj < 2; ++bj) {
                        const f32x4 v0 = acc[ai][bj][m][0] * w[ai][m], v1 = acc[ai][bj][m][1] * w[ai][m];
                        v4u o; o.x = pk2(v0[0], v0[1]); o.y = pk2(v0[2], v0[3]); o.z = pk2(v1[0], v1[1]); o.w = pk2(v1[2], v1[3]);
                        *(v4u*)(y2 + (size_t)ent[ai][m] * 1024 + bj * 128 + c8) = o;
                    }
                }
            }
    }
};

struct EpiMoe { static constexpr bool PERM = true; EpiG3 e3; EpiG4 e4;
    __device__ __forceinline__ void operator()(const f32x4 (&acc)[2][2][4][2], const pg8::Unit& u, int wr, int wc, int fr, int fq) const { if (u.kind) e4(acc, u, wr, wc, fr, fq); else e3(acc, u, wr, wc, fr, fq); } };

#include <hip/hip_bf16.h>
#include <cmath>
namespace attn_body {
using bf16=__hip_bfloat16;
using bf16x8=__attribute__((ext_vector_type(8)))short;
using s16x4=__attribute__((ext_vector_type(4)))short;
using f32x16=__attribute__((ext_vector_type(16)))float;
using u32x4=__attribute__((ext_vector_type(4)))unsigned;
constexpr int D=64,QP=512,KVP=128,OP=1024;
constexpr int NW=8,QBLK=32,KVBLK=64;
__device__ __forceinline__ int crow(int r,int hi){return (r&3)+8*(r>>2)+4*hi;}
#define SBAR() __builtin_amdgcn_sched_barrier(0)
__device__ __forceinline__ void wmask(f32x16&p0,f32x16&p1,int kp0,int qpos,int hi){
  const float NEG=-INFINITY; const bool tile_ok=(unsigned)kp0<4096u; const int base=kp0+4*hi-qpos+128;
  #pragma unroll
  for(int r=0;r<16;++r){const int dd=base+(r&3)+8*(r>>2); if(!tile_ok||(unsigned)dd>256u)p0[r]=NEG; if(!tile_ok||(unsigned)(dd+32)>256u)p1[r]=NEG;}
}
constexpr int NSLOT=3, SLOTB=8192;
constexpr int LDS_K=0, LDS_V=NSLOT*SLOTB, LDS_WS=2*NSLOT*SLOTB, LDS_OST=LDS_WS+NW*64*4, LDS_BYTES=LDS_OST+NW*4096;
constexpr float C2=0.125f*1.4426950408889634f;
__device__ __forceinline__ void glds16(const void*gsrc,unsigned lds_dst){unsigned keep;
  asm volatile("s_mov_b32 %0, m0\n\ts_mov_b32 m0, %2\n\ts_nop 0\n\tglobal_load_lds_dwordx4 %1, off\n\ts_mov_b32 m0, %0":"=&s"(keep):"v"(gsrc),"s"(lds_dst):"memory");}
__device__ __forceinline__ float max3f(float a,float b,float c){float r;asm("v_max3_f32 %0, %1, %2, %3":"=v"(r):"v"(a),"v"(b),"v"(c));return r;}
__device__ __forceinline__ float max2f(float a,float b){float r;asm("v_max_f32_e32 %0, %1, %2":"=v"(r):"v"(a),"v"(b));return r;}
__device__ __forceinline__ float fadd_s(float a,float b){float r;asm("v_add_f32_e32 %0, %1, %2":"=v"(r):"v"(a),"v"(b));return r;}
__device__ __forceinline__ float fsub_s(float a,float b){float r;asm("v_sub_f32_e32 %0, %1, %2":"=v"(r):"v"(a),"v"(b));return r;}
typedef float f32x2_t __attribute__((ext_vector_type(2))); typedef __bf16 bf16x2_t __attribute__((ext_vector_type(2)));
__device__ __forceinline__ unsigned cvtpk_s(float lo,float hi){f32x2_t v={lo,hi};bf16x2_t b=__builtin_convertvector(v,bf16x2_t);return __builtin_bit_cast(unsigned,b);}
#define WAIT_BAR(N) asm volatile("s_waitcnt vmcnt(" #N ") lgkmcnt(0)\n\ts_barrier":::"memory")

__device__ __forceinline__ void qkt(f32x16&p0,f32x16&p1,const char*Kslot,const bf16x8*qr,const f32x16&negm,int r32,int hi){
  const char*kb=Kslot+hi*1024+r32*16;
  #pragma unroll
  for(int d0=0;d0<4;++d0){
    const bf16x8 b0=*reinterpret_cast<const bf16x8*>(kb+d0*2048);
    const bf16x8 b1=*reinterpret_cast<const bf16x8*>(kb+d0*2048+512);
    if(d0==0){p0=__builtin_amdgcn_mfma_f32_32x32x16_bf16(b0,qr[0],negm,0,0,0);p1=__builtin_amdgcn_mfma_f32_32x32x16_bf16(b1,qr[0],negm,0,0,0);}
    else{p0=__builtin_amdgcn_mfma_f32_32x32x16_bf16(b0,qr[d0],p0,0,0,0);p1=__builtin_amdgcn_mfma_f32_32x32x16_bf16(b1,qr[d0],p1,0,0,0);}}
}
typedef __attribute__((address_space(3))) const char* lds_cptr;
typedef short v4i16_t __attribute__((ext_vector_type(4)));
__device__ __forceinline__ void kload8(bf16x8*kf,lds_cptr kp){
  kf[0]=*(const __attribute__((address_space(3))) bf16x8*)(kp);      kf[1]=*(const __attribute__((address_space(3))) bf16x8*)(kp+512);
  kf[2]=*(const __attribute__((address_space(3))) bf16x8*)(kp+2048); kf[3]=*(const __attribute__((address_space(3))) bf16x8*)(kp+2560);
  kf[4]=*(const __attribute__((address_space(3))) bf16x8*)(kp+4096); kf[5]=*(const __attribute__((address_space(3))) bf16x8*)(kp+4608);
  kf[6]=*(const __attribute__((address_space(3))) bf16x8*)(kp+6144); kf[7]=*(const __attribute__((address_space(3))) bf16x8*)(kp+6656);
}
__device__ __forceinline__ void kload2(bf16x8*kf,lds_cptr kp,int j){ kf[2*j]=*(const __attribute__((address_space(3))) bf16x8*)(kp+j*2048); kf[2*j+1]=*(const __attribute__((address_space(3))) bf16x8*)(kp+j*2048+512); }
__device__ __forceinline__ s16x4 vtr(lds_cptr p){ return __builtin_bit_cast(s16x4,__builtin_amdgcn_ds_read_tr16_b64_v4i16((__attribute__((address_space(3))) v4i16_t*)p)); }
__device__ __forceinline__ float rowmax(const f32x16&p0,const f32x16&p1){
  float a=max3f(p0[0],p0[1],p1[0]),b=max3f(p0[2],p0[3],p1[1]);a=max3f(a,p1[2],p1[3]);
  #pragma unroll
  for(int r=4;r<16;r+=4){a=max3f(a,p0[r],p0[r+1]);b=max3f(b,p0[r+2],p0[r+3]);a=max3f(a,p1[r],p1[r+1]);b=max3f(b,p1[r+2],p1[r+3]);}
  const float m=max2f(a,b);
  auto rr=__builtin_amdgcn_permlane32_swap(__float_as_uint(m),__float_as_uint(m),false,false);
  return max2f(__uint_as_float(rr[0]),__uint_as_float(rr[1]));
}
__device__ __forceinline__ void pv(f32x16*o,int vb,bf16x8 pa0,bf16x8 pa1,bf16x8 pa2,bf16x8 pa3){
  #pragma unroll
  for(int d0=0;d0<2;++d0){s16x4 lo[4],hi[4];
    #pragma unroll
    for(int ks=0;ks<4;++ks){
      asm volatile("ds_read_b64_tr_b16 %0,%1 offset:%c2":"=&v"(lo[ks]):"v"(vb),"i"(d0*4096+ks*1024):"memory");
      asm volatile("ds_read_b64_tr_b16 %0,%1 offset:%c2":"=&v"(hi[ks]):"v"(vb),"i"(d0*4096+ks*1024+512):"memory");}
    asm volatile("s_waitcnt lgkmcnt(0)":::"memory");SBAR();
    #define PK(k) (bf16x8){lo[k][0],lo[k][1],lo[k][2],lo[k][3],hi[k][0],hi[k][1],hi[k][2],hi[k][3]}
    o[d0]=__builtin_amdgcn_mfma_f32_32x32x16_bf16(pa0,PK(0),o[d0],0,0,0);
    o[d0]=__builtin_amdgcn_mfma_f32_32x32x16_bf16(pa1,PK(1),o[d0],0,0,0);
    o[d0]=__builtin_amdgcn_mfma_f32_32x32x16_bf16(pa2,PK(2),o[d0],0,0,0);
    o[d0]=__builtin_amdgcn_mfma_f32_32x32x16_bf16(pa3,PK(3),o[d0],0,0,0);
    #undef PK
  }
}

#ifndef ATTN_STORE16
#define ATTN_STORE16(p,v) (*(u32x4*)(p)=(v))
#endif
template<int THRL> __device__ __forceinline__ void attn_unit(const bf16*Qu,const bf16*__restrict__ Kh,const bf16*__restrict__ Vh,bf16*Ou,const int p0,const int NT,const float* sinkp,const float* qg,const float2* ropet,char*shm){
  int tid=threadIdx.x; asm volatile("":"+v"(tid)); const int lane=tid&63,r32=lane&31,hi=lane>>5; const int wid=__builtin_amdgcn_readfirstlane(tid>>6);
  const int hsub=wid>>1, psub=(wid&1)*QBLK;
  const bf16*Qw=Qu+(long)psub*QP+hsub*D;
  const unsigned lds0=(unsigned)(uintptr_t)shm;
  float*wsf=(float*)(shm+LDS_WS)+wid*64;
  const bf16*ksrc=Kh+(long)lane*KVP+wid*8;
  const bf16*vsrc=Vh+(long)(16*(wid&3)+(lane>>2))*KVP+(wid>>2)*32+(lane&3)*8;
  const unsigned kdst=lds0+LDS_K+wid*1024, vdst=lds0+LDS_V+wid*1024;
  #define KP0(t) (p0-128+64*((t)-4))
  #define TROW(t) ((t)<4?64*(t):(((unsigned)KP0(t)<4096u)?256+KP0(t):256))
  #define DMA_K(t,slot) glds16(ksrc+(long)TROW(t)*KVP,(unsigned)__builtin_amdgcn_readfirstlane(kdst+(slot)))
  #define DMA_V(t,slot) glds16(vsrc+(long)TROW(t)*KVP,(unsigned)__builtin_amdgcn_readfirstlane(vdst+(slot)))
  const int vb0=(int)(lds0+LDS_V)+((lane>>4)&1)*32+(lane&3)*8+(4*hi+((lane&15)>>2))*64;
  const char*Kbase=shm+LDS_K; bf16x8 kf[8];
  const lds_cptr shm3=(lds_cptr)shm; const lds_cptr kp0=shm3+LDS_K+hi*1024+r32*16; const lds_cptr vp0=shm3+LDS_V+((lane>>4)&1)*32+(lane&3)*8+(4*hi+((lane&15)>>2))*64;
  DMA_K(0,0);DMA_V(0,0);DMA_K(1,SLOTB);
  bf16x8 qr[4];
  { bf16x8 qraw[4];
    #pragma unroll
    for(int d0=0;d0<4;++d0)qraw[d0]=*reinterpret_cast<const bf16x8*>(&Qw[(long)r32*QP+d0*16+hi*8]);
    float qf[4][8]; float ss=0.f;
    #pragma unroll
    for(int d0=0;d0<4;++d0)
      #pragma unroll
      for(int j=0;j<8;++j){ qf[d0][j]=__builtin_bit_cast(float,(unsigned)(unsigned short)qraw[d0][j]<<16); ss+=qf[d0][j]*qf[d0][j]; }
    ss+=__shfl_xor(ss,32);
    const float rstd=1.0f/sqrtf(ss*(1.f/64.f)+1e-6f)*C2;
    #pragma unroll
    for(int d0=0;d0<4;++d0)
      #pragma unroll
      for(int j=0;j<8;++j) qf[d0][j]*=rstd*qg[16*d0+8*hi+j];
    if(ropet){ const float2* rp=ropet+(long)(p0+psub+r32)*32+8*hi;
      #pragma unroll
      for(int j=0;j<8;++j){ const float2 c1=rp[j],c2=rp[16+j];
        const float a=qf[0][j],b=qf[1][j],c=qf[2][j],d=qf[3][j];
        qf[0][j]=a*c1.x-b*c1.y; qf[1][j]=b*c1.x+a*c1.y; qf[2][j]=c*c2.x-d*c2.y; qf[3][j]=d*c2.x+c*c2.y; } }
    #pragma unroll
    for(int d0=0;d0<4;++d0){ u32x4 w; w[0]=cvtpk_s(qf[d0][0],qf[d0][1]); w[1]=cvtpk_s(qf[d0][2],qf[d0][3]); w[2]=cvtpk_s(qf[d0][4],qf[d0][5]); w[3]=cvtpk_s(qf[d0][6],qf[d0][7]); qr[d0]=__builtin_bit_cast(bf16x8,w); } }
  float mhat=0.f,l_reg=0.f;f32x16 o[2];o[0]=f32x16{};o[1]=f32x16{};f32x16 negm=f32x16{};asm volatile("":"+v"(negm));
  const int qpos=p0+psub+r32;
  #define CMASK(P0,P1,t) do{ if((t)>=4)wmask(P0,P1,KP0(t),qpos,hi); }while(0)
  bool resc=false;
  #define START(P0,P1) do{ const float rm=rowmax(P0,P1); resc=false; \
    { const float dl=rm; mhat=fadd_s(mhat,dl); \
      _Pragma("unroll") for(int r=0;r<16;++r){P0[r]=fsub_s(P0[r],dl);P1[r]=fsub_s(P1[r],dl);} \
      _Pragma("unroll") for(int r=0;r<16;++r)negm[r]=-mhat; asm volatile("":"+v"(negm)); } \
    _Pragma("unroll") for(int r=0;r<16;++r)P0[r]=__builtin_amdgcn_exp2f(P0[r]); }while(0)
  #define RESC() do{ if(resc){ asm volatile("s_waitcnt lgkmcnt(0)":::"memory"); \
      _Pragma("unroll") for(int d_=0;d_<2;++d_) _Pragma("unroll") for(int r=0;r<16;++r)o[d_][r]*=wsf[crow(r,hi)]; } }while(0)
  f32x16 pA0,pA1,pB0,pB1;
  int sl_prev=0,sl_cur=0,sl_next=SLOTB;
  #define ROT() do{sl_prev=sl_cur;sl_cur=sl_next;sl_next=(sl_next==(NSLOT-1)*SLOTB)?0:sl_next+SLOTB;}while(0)
  DMA_K(2,2*SLOTB);
  WAIT_BAR(3);
  qkt(pA0,pA1,Kbase,qr,negm,r32,hi);asm volatile("s_nop 15\n\ts_nop 7":"+v"(pA0),"+v"(pA1));CMASK(pA0,pA1,0);
  START(pA0,pA1);
  _Pragma("unroll") for(int r=0;r<16;++r)pA1[r]=__builtin_amdgcn_exp2f(pA1[r]);
  WAIT_BAR(0);
  DMA_K(3,0);DMA_V(1,SLOTB);
  ROT();
  kload8(kf,kp0+sl_cur);
  WAIT_BAR(2);
  s16x4 vlo[8],vhi[8]; u32x4 pw0,pw1,pw2,pw3;
  #define PKW(P,B) cvtpk_s(P[B],P[B+1])
  #define PAF(k) __builtin_bit_cast(bf16x8,pw##k)
  #define VFR(i) (bf16x8){vlo[i][0],vlo[i][1],vlo[i][2],vlo[i][3],vhi[i][0],vhi[i][1],vhi[i][2],vhi[i][3]}
  #define PIN(x) asm volatile("":"+v"(x))
  #define MX3(a,b,c) __builtin_fmaxf(__builtin_fmaxf((a),(b)),(c))
  #define GAPA(MF,A0,A1,A2,A3,W0,W1,PW) do{ MF; sacc+=A0; sacc+=A1; sacc+=A2; sacc+=A3; PIN(sacc); W0; W1; PIN(PW); SBAR(); }while(0)
  #define EX(v) __builtin_amdgcn_exp2f(v)
  #define GAPB(MF,X,B) do{ MF; X[B]=EX(X[B]); X[B+1]=EX(X[B+1]); X[B+2]=EX(X[B+2]); X[B+3]=EX(X[B+3]); PIN(X); SBAR(); }while(0)
  #define VRD(i) do{ vlo[i]=vtr(vp_+(((i)>>2)*4096+((i)&3)*1024)); vhi[i]=vtr(vp_+(((i)>>2)*4096+((i)&3)*1024+512)); }while(0)
  #define KRD(G,j) do{ if(G){ kload2(kf,kp0+sl_next,j); SBAR(); } }while(0)
  #define STEP(C0,C1,P0,P1,t,GK,GV,GL) do{ SBAR(); \
    const lds_cptr vp_=vp0+sl_prev; \
    VRD(0); SBAR(); float sacc=(P0[0]+P0[1]); \
    GAPA(C0=__builtin_amdgcn_mfma_f32_32x32x16_bf16(kf[0],qr[0],negm,0,0,0), P0[2],P0[3],P0[4],P0[5],     pw0[0]=PKW(P0,0), pw0[1]=PKW(P0,2), pw0); \
    VRD(4); SBAR(); GAPA(C1=__builtin_amdgcn_mfma_f32_32x32x16_bf16(kf[1],qr[0],negm,0,0,0), P0[6],P0[7],P0[8],P0[9],     pw0[2]=PKW(P0,4), pw0[3]=PKW(P0,6), pw0); \
    VRD(1); SBAR(); GAPA(C0=__builtin_amdgcn_mfma_f32_32x32x16_bf16(kf[2],qr[1],C0,0,0,0),   P0[10],P0[11],P0[12],P0[13], pw1[0]=PKW(P0,8), pw1[1]=PKW(P0,10), pw1); \
    VRD(5); SBAR(); GAPA(C1=__builtin_amdgcn_mfma_f32_32x32x16_bf16(kf[3],qr[1],C1,0,0,0),   P0[14],P0[15],P1[0],P1[1],   pw1[2]=PKW(P0,12),pw1[3]=PKW(P0,14), pw1); \
    VRD(2); SBAR(); GAPA(C0=__builtin_amdgcn_mfma_f32_32x32x16_bf16(kf[4],qr[2],C0,0,0,0),   P1[2],P1[3],P1[4],P1[5],     pw2[0]=PKW(P1,0), pw2[1]=PKW(P1,2), pw2); \
    VRD(6); SBAR(); GAPA(C1=__builtin_amdgcn_mfma_f32_32x32x16_bf16(kf[5],qr[2],C1,0,0,0),   P1[6],P1[7],P1[8],P1[9],     pw2[2]=PKW(P1,4), pw2[3]=PKW(P1,6), pw2); \
    VRD(3); SBAR(); GAPA(C0=__builtin_amdgcn_mfma_f32_32x32x16_bf16(kf[6],qr[3],C0,0,0,0),   P1[10],P1[11],P1[12],P1[13], pw3[0]=PKW(P1,8), pw3[1]=PKW(P1,10), pw3); \
    VRD(7); SBAR(); GAPA(C1=__builtin_amdgcn_mfma_f32_32x32x16_bf16(kf[7],qr[3],C1,0,0,0),   P1[14],P1[15],0.f,0.f,       pw3[2]=PKW(P1,12),pw3[3]=PKW(P1,14), pw3); \
    l_reg+=sacc; \
    if(GK){DMA_K((t)+3,sl_cur);} if(GV){DMA_V((t)+1,sl_next);} \
    CMASK(C0,C1,t); \
    { float a=MX3(C0[0],C0[1],C1[0]),b=MX3(C0[2],C0[3],C1[1]); a=MX3(a,C1[2],C1[3]); \
      _Pragma("unroll") for(int r=4;r<16;r+=4){a=MX3(a,C0[r],C0[r+1]);b=MX3(b,C0[r+2],C0[r+3]);a=MX3(a,C1[r],C1[r+1]);b=MX3(b,C1[r+2],C1[r+3]);} \
      float rm=__builtin_fmaxf(a,b); { auto rr=__builtin_amdgcn_permlane32_swap(__float_as_uint(rm),__float_as_uint(rm),false,false); rm=__builtin_fmaxf(__uint_as_float(rr[0]),__uint_as_float(rr[1])); } \
      resc=false; \
      if(__builtin_expect(__any(rm>(float)THRL),0)){ const float dl=__builtin_fmaxf(rm,0.f); mhat+=dl; \
        _Pragma("unroll") for(int r=0;r<16;++r){C0[r]-=dl;C1[r]-=dl;} \
        _Pragma("unroll") for(int r=0;r<16;++r)negm[r]=-mhat; asm volatile("":"+v"(negm)); \
        const float f=__builtin_amdgcn_exp2f(-dl); l_reg*=f; if(hi==0)wsf[r32]=f; resc=true; } } \
    SBAR(); \
    GAPB(o[0]=__builtin_amdgcn_mfma_f32_32x32x16_bf16(PAF(0),VFR(0),o[0],0,0,0), C0,0); \
    GAPB(o[1]=__builtin_amdgcn_mfma_f32_32x32x16_bf16(PAF(0),VFR(4),o[1],0,0,0), C0,4); \
    KRD(GL,0); GAPB(o[0]=__builtin_amdgcn_mfma_f32_32x32x16_bf16(PAF(1),VFR(1),o[0],0,0,0), C0,8); \
    KRD(GL,1); GAPB(o[1]=__builtin_amdgcn_mfma_f32_32x32x16_bf16(PAF(1),VFR(5),o[1],0,0,0), C0,12); \
    KRD(GL,2); GAPB(o[0]=__builtin_amdgcn_mfma_f32_32x32x16_bf16(PAF(2),VFR(2),o[0],0,0,0), C1,0); \
    KRD(GL,3); GAPB(o[1]=__builtin_amdgcn_mfma_f32_32x32x16_bf16(PAF(2),VFR(6),o[1],0,0,0), C1,4); \
    GAPB(o[0]=__builtin_amdgcn_mfma_f32_32x32x16_bf16(PAF(3),VFR(3),o[0],0,0,0), C1,8); \
    GAPB(o[1]=__builtin_amdgcn_mfma_f32_32x32x16_bf16(PAF(3),VFR(7),o[1],0,0,0), C1,12); \
    }while(0)
  int t=1;
  for(;t+5<NT;t+=2){
    STEP(pB0,pB1,pA0,pA1,t,true,true,true);     WAIT_BAR(2); RESC(); ROT();
    STEP(pA0,pA1,pB0,pB1,t+1,true,true,true);   WAIT_BAR(2); RESC(); ROT();
  }
  #define ENDW(tt) do{ if((tt)+3<NT){WAIT_BAR(2);} else if((tt)+2<NT){WAIT_BAR(1);} else {WAIT_BAR(0);} }while(0)
  for(;t+1<NT;t+=2){
    STEP(pB0,pB1,pA0,pA1,t,(t+3<NT),(t+1<NT),(t+1<NT));       ENDW(t);   RESC(); ROT();
    STEP(pA0,pA1,pB0,pB1,t+1,(t+4<NT),(t+2<NT),(t+2<NT));     ENDW(t+1); RESC(); ROT();
  }
  STEP(pB0,pB1,pA0,pA1,NT-1,false,false,false); RESC();
  { float sacc=pB0[0]+pB0[1]; _Pragma("unroll") for(int r=2;r<16;++r)sacc+=pB0[r]; _Pragma("unroll") for(int r=0;r<16;++r)sacc+=pB1[r]; l_reg+=sacc;
    pw0=(u32x4){PKW(pB0,0),PKW(pB0,2),PKW(pB0,4),PKW(pB0,6)};pw1=(u32x4){PKW(pB0,8),PKW(pB0,10),PKW(pB0,12),PKW(pB0,14)};pw2=(u32x4){PKW(pB1,0),PKW(pB1,2),PKW(pB1,4),PKW(pB1,6)};pw3=(u32x4){PKW(pB1,8),PKW(pB1,10),PKW(pB1,12),PKW(pB1,14)};
    SBAR(); pv(o,vb0+sl_cur,PAF(0),PAF(1),PAF(2),PAF(3)); }
  #undef PKW
  #undef PAF
  #undef VFR
  #undef PIN
  #undef MX3
  #undef GAPA
  #undef GAPB
  #undef EX
  #undef VRD
  #undef KRD
  #undef STEP
  #undef ENDW
  l_reg+=__shfl_xor(l_reg,32);
  l_reg+=__builtin_amdgcn_exp2f(sinkp[hsub]*1.4426950408889634f-mhat);
  if(hi==0)wsf[32+r32]=l_reg;asm volatile("s_waitcnt lgkmcnt(0)":::"memory");
  float rli[16];
  #pragma unroll
  for(int r=0;r<16;++r)rli[r]=__builtin_amdgcn_rcpf(wsf[32+crow(r,hi)]);
  bf16*Ow=Ou+(long)psub*OP+hsub*D;
  { bf16*stg=(bf16*)(shm+LDS_OST)+wid*2048;
    #pragma unroll
    for(int r=0;r<16;++r){const int orow=crow(r,hi);
      #pragma unroll
      for(int d0=0;d0<2;++d0)stg[orow*64+d0*32+r32]=__float2bfloat16(o[d0][r]*rli[r]);}
    asm volatile("s_waitcnt lgkmcnt(0)":::"memory");
    #pragma unroll
    for(int i=0;i<4;++i){const int row=i*8+(lane>>3),ch=lane&7; const u32x4 v=*(const u32x4*)(stg+row*64+ch*8); ATTN_STORE16(Ow+(long)row*OP+ch*8,v);} }
  asm volatile("s_waitcnt lgkmcnt(0)\n\ts_barrier":::"memory");
  #undef DMA_K
  #undef DMA_V
  #undef KP0
  #undef TROW
  #undef CMASK
  #undef START
  #undef RESC
  #undef ROT
}
constexpr int ATTN_LDS_BYTES=LDS_BYTES;
#undef SBAR
#undef WAIT_BAR
}

constexpr int SLAB_PITCH = 288;
typedef short v4i16_t __attribute__((ext_vector_type(4)));
template <int MT, class RowAddr, class Epi>
__device__ __forceinline__ void slab_gemm(LAS unsigned char* lds, const bf16* Cmat, const int K, const RowAddr& RA, const Epi& E) {
    int tid = threadIdx.x; asm volatile("" : "+v"(tid));
    const int wid = tid >> 6, lane = tid & 63;
    LAS bf16* Dr = (LAS bf16*)lds;
    f32x16 acc[MT];
#pragma unroll
    for (int i = 0; i < MT; ++i)
#pragma unroll
        for (int r = 0; r < 16; ++r) acc[i][r] = 0.f;
    const int g = (lane >> 4) & 1, h = lane >> 5, qq = (lane & 15) >> 2, pp = lane & 3;
    const LAS bf16* trp = Dr + (8 * h + qq) * SLAB_PITCH + wid * 32 + 16 * g + 4 * pp;
    for (int kc = 0; kc < K; kc += 128) {
        {
            const int k = tid >> 2, qd = tid & 3;
            const bf16* src = RA(kc + k) + qd * 64;
            v4u v[8];
#pragma unroll
            for (int j = 0; j < 8; ++j) v[j] = *(const v4u*)(src + j * 8);
#pragma unroll
            for (int j = 0; j < 8; ++j) *(LAS v4u*)(Dr + k * SLAB_PITCH + qd * 64 + j * 8) = v[j];
        }
        __syncthreads();
        const int kh = h * 8;
#pragma unroll
        for (int s = 0; s < 8; ++s) {
            const v4i16_t b0 = __builtin_amdgcn_ds_read_tr16_b64_v4i16((LAS v4i16_t*)(trp + (16 * s) * SLAB_PITCH));
            const v4i16_t b1 = __builtin_amdgcn_ds_read_tr16_b64_v4i16((LAS v4i16_t*)(trp + (16 * s + 4) * SLAB_PITCH));
            const bf16x8 bfrag = (bf16x8){b0[0], b0[1], b0[2], b0[3], b1[0], b1[1], b1[2], b1[3]};
#pragma unroll
            for (int mt = 0; mt < MT; ++mt) {
                const bf16x8 afrag = *(const bf16x8*)(Cmat + (size_t)(mt * 32 + (lane & 31)) * K + kc + s * 16 + kh);
                acc[mt] = __builtin_amdgcn_mfma_f32_32x32x16_bf16(afrag, bfrag, acc[mt], 0, 0, 0);
            }
        }
        __syncthreads();
    }
    E(acc, wid, lane, lds);
}

struct Args { const float* in[23]; float* out; unsigned char* ws; int ph_lo, ph_hi; };

constexpr int SOUT_PITCH = 264;
template <int NROWS, bool WT, class RowPtr>
__device__ __forceinline__ void slab_store_rows(LAS unsigned char* lds, const RowPtr& RP) {
    int tid = threadIdx.x; asm volatile("" : "+v"(tid));
    __syncthreads();
#pragma unroll
    for (int k = 0; k < NROWS / 16; ++k) { const int row = (tid >> 5) + 16 * k, chunk = tid & 31;
        const v4u v = *(const LAS v4u*)((LAS bf16*)lds + row * SOUT_PITCH + chunk * 8);
        bf16* dst = RP(row) + chunk * 8;
        if (WT) store16_wt(dst, v); else *(v4u*)dst = v; }
    __syncthreads();
}
struct RowA { const bf16* z; int b, n2; __device__ __forceinline__ const bf16* operator()(int k) const { return z + (size_t)(b * 4096 + 64 * (k & 63) + n2) * 512 + (k >> 6) * 256; } };
struct RowPA { bf16* t2; int b, n2; __device__ __forceinline__ bf16* operator()(int m) const { return t2 + ((size_t)((b * 64 + n2) * 64 + (m & 63)) * 2 + (m >> 6)) * 256; } };
template <bool WT> struct EpiA { bf16* t2; const float2* tw; int b, n2;
    __device__ __forceinline__ void operator()(const f32x16 (&acc)[4], int wid, int lane, LAS unsigned char* lds) const {
        const int ch = wid * 32 + (lane & 31); LAS bf16* so = (LAS bf16*)lds;
#pragma unroll
        for (int mt = 0; mt < 2; ++mt)
#pragma unroll
            for (int r = 0; r < 16; ++r) {
                const int k1 = 32 * mt + (r & 3) + 8 * (r >> 2) + 4 * (lane >> 5);
                const float2 cs = tw[n2 * k1]; const float re = acc[mt][r], im = acc[mt + 2][r];
                const float re2 = cs.x * re + cs.y * im, im2 = cs.x * im - cs.y * re;
                so[k1 * SOUT_PITCH + ch] = (bf16)f2bf(re2); so[(64 + k1) * SOUT_PITCH + ch] = (bf16)f2bf(im2);
            }
        RowPA rp{t2, b, n2}; slab_store_rows<128, WT, RowPA>(lds, rp);
    } };
struct RowB { const bf16* t2; int b, k1; __device__ __forceinline__ const bf16* operator()(int k) const { return t2 + ((size_t)((b * 64 + (k & 63)) * 64 + k1) * 2 + (k >> 6)) * 256; } };
struct RowPB { bf16* mrg; int b, k1; __device__ __forceinline__ bf16* operator()(int k2) const { return mrg + (size_t)(b * 4096 + k1 + 64 * k2) * 1024 + 768; } };
struct EpiB { bf16* mrg; int b, k1;
    __device__ __forceinline__ void operator()(const f32x16 (&acc)[2], int wid, int lane, LAS unsigned char* lds) const {
        const int ch = wid * 32 + (lane & 31); LAS bf16* so = (LAS bf16*)lds;
#pragma unroll
        for (int mt = 0; mt < 2; ++mt)
#pragma unroll
            for (int r = 0; r < 16; ++r) { const int k2 = 32 * mt + (r & 3) + 8 * (r >> 2) + 4 * (lane >> 5); so[k2 * SOUT_PITCH + ch] = (bf16)f2bf(DBG_NO_FOUR ? 0.f : acc[mt][r]); }
        RowPB rp{mrg, b, k1}; slab_store_rows<64, false, RowPB>(lds, rp);
    } };
struct RowC { const bf16* z; int b; __device__ __forceinline__ const bf16* operator()(int k) const { return z + (size_t)(T + b * 256 + (k & 255)) * 512 + (k >> 8) * 256; } };
struct RowPC { bf16* mrg; int b, mt0; __device__ __forceinline__ bf16* operator()(int kk) const { return mrg + (size_t)(T + b * 256 + 32 * mt0 + kk) * 1024 + 768; } };
struct EpiC { bf16* mrg; int b, mt0;
    __device__ __forceinline__ void operator()(const f32x16 (&acc)[1], int wid, int lane, LAS unsigned char* lds) const {
        const int ch = wid * 32 + (lane & 31); LAS bf16* so = (LAS bf16*)lds;
#pragma unroll
        for (int r = 0; r < 16; ++r) { const int kk = (r & 3) + 8 * (r >> 2) + 4 * (lane >> 5); so[kk * SOUT_PITCH + ch] = (bf16)f2bf(DBG_NO_FOUR ? 0.f : acc[0][r]); }
        RowPC rp{mrg, b, mt0}; slab_store_rows<32, false, RowPC>(lds, rp);
    } };

__device__ __forceinline__ void tr_block(const float* src, int ldS, bf16* dst, int ldD, LAS float* scr, int lane) {
#pragma unroll 8
    for (int i = 0; i < 32; ++i) { const int kk = 2 * i + (lane >> 5); scr[kk * 33 + (lane & 31)] = src[(size_t)kk * ldS + (lane & 31)]; }
    LDS_WAIT(); asm volatile("" ::: "memory");
    const int c = lane & 7;
#pragma unroll
    for (int j = 0; j < 4; ++j) { const int n = (lane >> 3) + 8 * j; const LAS float* s = scr + (8 * c) * 33 + n;
        v4u o; o.x = pk2(s[0 * 33], s[1 * 33]); o.y = pk2(s[2 * 33], s[3 * 33]); o.z = pk2(s[4 * 33], s[5 * 33]); o.w = pk2(s[6 * 33], s[7 * 33]);
        *(GAS v4u*)(dst + (size_t)n * ldD + 8 * c) = o; }
    LDS_WAIT(); asm volatile("" ::: "memory");
}


__device__ __forceinline__ void tr_block64(const float* src, int ldS, bf16* dst, int ldD, LAS bf16* scr, int lane) {
    const int kr = lane >> 4, nc = lane & 15;
    f32x4 v[16];
#pragma unroll
    for (int i = 0; i < 16; ++i) v[i] = *(const f32x4*)(src + (size_t)(4 * i + kr) * ldS + 4 * nc);
#pragma unroll
    for (int i = 0; i < 16; ++i) { const int k = 4 * i + kr;
#pragma unroll
        for (int j = 0; j < 4; ++j) scr[(4 * nc + j) * 66 + k] = (bf16)f2bf(v[i][j]); }
    LDS_WAIT(); asm volatile("" ::: "memory");
    const int c = lane & 7;
#pragma unroll
    for (int j = 0; j < 8; ++j) { const int n = (lane >> 3) + 8 * j; const LAS unsigned* p = (const LAS unsigned*)(scr + n * 66 + 8 * c);
        v4u o; o.x = p[0]; o.y = p[1]; o.z = p[2]; o.w = p[3];
        *(GAS v4u*)(dst + (size_t)n * ldD + 8 * c) = o; }
    LDS_WAIT(); asm volatile("" ::: "memory");
}

__device__ __forceinline__ void tr_block64_f8(const float* src, int ldS, unsigned char* dst, int ldD, LAS unsigned char* scr, int lane, float sc) {
    const int nq = lane & 15, kq0 = lane >> 4;
    f32x4 v[4][4];
#pragma unroll
    for (int sb = 0; sb < 4; ++sb)
#pragma unroll
        for (int r = 0; r < 4; ++r) v[sb][r] = *(const f32x4*)(src + (size_t)(4 * (kq0 + 4 * sb) + r) * ldS + 4 * nq);
#pragma unroll
    for (int sb = 0; sb < 4; ++sb)
#pragma unroll
        for (int j = 0; j < 4; ++j) *(LAS unsigned*)(scr + (4 * nq + j) * 68 + 4 * (kq0 + 4 * sb)) = pk4_f8(v[sb][0][j] * sc, v[sb][1][j] * sc, v[sb][2][j] * sc, v[sb][3][j] * sc);
    LDS_WAIT(); asm volatile("" ::: "memory");
    const int c = lane & 3;
#pragma unroll
    for (int jj = 0; jj < 4; ++jj) { const int n = (lane >> 2) + 16 * jj; const LAS unsigned* p = (const LAS unsigned*)(scr + n * 68 + 16 * c);
        v4u o; o.x = p[0]; o.y = p[1]; o.z = p[2]; o.w = p[3];
        *(GAS v4u*)(dst + (size_t)n * ldD + 16 * c) = o; }
    LDS_WAIT(); asm volatile("" ::: "memory");
}

typedef const __attribute__((address_space(4))) Args* kargs_t;
__device__ __forceinline__ kargs_t ka_launder() { kargs_t p = (kargs_t)__builtin_amdgcn_kernarg_segment_ptr(); asm volatile("" : "+s"(p)); return p; }
__device__ __forceinline__ int tid_launder() { int t = threadIdx.x; asm volatile("" : "+v"(t)); return t; }
#define KA_DECL const kargs_t KA = ka_launder(); const int tid = tid_launder(); const int lane = tid & 63; const int wave = __builtin_amdgcn_readfirstlane(tid >> 6); const int gw = vcu * 8 + wave; const int gt = vcu * 512 + tid; (void)lane; (void)wave; (void)gw; (void)gt;
#define ws (KA->ws)
#define ctl ((gu32*)(ws + O_CTL))
#define x_in (KA->in[0])
#define c_in (KA->in[1])
#define ctx_in (KA->in[2])
#define cctx_in (KA->in[3])
#define w_mod (KA->in[4])
#define b_mod (KA->in[5])
#define norm1_g (KA->in[6])
#define w_in (KA->in[7])
#define q_norm_g (KA->in[8])
#define k_norm_g (KA->in[9])
#define attn_sink (KA->in[10])
#define pool_w (KA->in[11])
#define pool_scale (KA->in[12])
#define four_w (KA->in[13])
#define w_out (KA->in[14])
#define norm2_g (KA->in[15])
#define w_grp (KA->in[16])
#define b_grp (KA->in[17])
#define w_rtr (KA->in[18])
#define b_rtr (KA->in[19])
#define w_gate (KA->in[20])
#define w_up (KA->in[21])
#define w_down (KA->in[22])
#define outp (KA->out)
#define modv ((float*)(ws + O_MOD))
#define rope ((float2*)(ws + O_ROPE))
#define twt ((float2*)(ws + O_TW))
#define fma ((bf16*)(ws + O_FMA))
#define fmb ((bf16*)(ws + O_FMB))
#define fmc ((bf16*)(ws + O_FMC))
#define hbuf ((bf16*)(ws + O_H))
#define kall ((bf16*)(ws + O_KALL))
#define vall ((bf16*)(ws + O_VALL))
#define xc ((float*)(ws + O_XC))
#define xb ((bf16*)(ws + O_XB))
#define list ((unsigned*)(ws + O_LIST))
#define wts ((float*)(ws + O_WTS))
#define act ((bf16*)(ws + O_ACT))
#define t2 ((bf16*)(ws + O_T2))
#define mrg ((bf16*)(ws + O_MRG))
#define qb ((bf16*)(ws + O_Q))
#define pu ((bf16*)(ws + O_PU))
#define zb ((bf16*)(ws + O_Z))
#define y2 ((bf16*)(ws + O_Y2))

#ifndef PH_MASK
#define PH_MASK 0x3ffff
#endif
#define IN(k) (lo <= (k) && (k) < hi && ((PH_MASK >> (k)) & 1))
#define SEAM(k) do { if (IN(k) && IN((k) + 1)) xcd_barrier(bar); } while (0)
#define modl (modv + (size_t)l * 5 * 6144)
#define win_t ((bf16*)(ws + O_WIN + l * SZ_WIN1))
#define wout_t ((bf16*)(ws + O_WOUT + l * SZ_WOUT1))
#define wgu_t ((bf16*)(ws + O_WGU + l * SZ_WGU1))
#define wd_t ((bf16*)(ws + O_WD + l * SZ_WD1))
constexpr int CV_A = 256, CV_B = 192, CV_C = 4096, CV_D = 2048, CV_L = CV_A + CV_B + CV_C + CV_D;
__device__ __forceinline__ void conv_item(const kargs_t KA, const int lw, int it, LAS bf16* scr, const int lane) {
    bf16* p_win_t = (bf16*)(ws + O_WIN + lw * SZ_WIN1); bf16* p_wout_t = (bf16*)(ws + O_WOUT + lw * SZ_WOUT1);
    bf16* p_wgu_t = (bf16*)(ws + O_WGU + lw * SZ_WGU1); bf16* p_wd_t = (bf16*)(ws + O_WD + lw * SZ_WD1);
    if (it < CV_A) { const int kb = it >> 4, nb = it & 15; const float* src = w_in + (size_t)lw * 1024 * 1280 + (size_t)kb * 64 * 1280 + nb * 64;
        tr_block64(src, 1280, p_win_t + (size_t)nb * 64 * 1024 + kb * 64, 1024, scr, lane);
        if (nb >= 4) tr_block64_f8(src, 1280, (unsigned char*)(ws + O_WIN8 + lw * SZ_WIN8) + (size_t)(nb * 64 - 256) * 1024 + kb * 64, 1024, (LAS unsigned char*)scr, lane, 64.0f);
        return; } it -= CV_A;
    if (it < CV_B) { const int kb = 4 + (it >> 4), nb = it & 15; tr_block64(w_out + (size_t)lw * 1024 * 1024 + (size_t)kb * 64 * 1024 + nb * 64, 1024, p_wout_t + (size_t)nb * 64 * 1024 + kb * 64, 1024, scr, lane); return; } it -= CV_B;
    if (it < CV_C) { const int up = it >> 11, r = it & 2047, e = r >> 7, kb = (r >> 3) & 15, nb = r & 7; const int n0 = nb * 64;
        const float* src = (up ? w_up : w_gate) + ((size_t)(lw * 16 + e) * 1024 + kb * 64) * 512 + n0;
        const int drow = (n0 >> 7) * 256 + up * 128 + (n0 & 127);
        tr_block64_f8(src, 512, (unsigned char*)p_wgu_t + ((size_t)e * 1024 + drow) * 1024 + kb * 64, 1024, (LAS unsigned char*)scr, lane, 64.0f); return; } it -= CV_C;
    { const int e = it >> 7, kb = (it >> 4) & 7, nb = it & 15;
        tr_block64_f8(w_down + ((size_t)(lw * 16 + e) * 512 + kb * 64) * 1024 + nb * 64, 1024, (unsigned char*)p_wd_t + ((size_t)e * 1024 + nb * 64) * 512 + kb * 64, 512, (LAS unsigned char*)scr, lane, 64.0f); }
}
__device__ __forceinline__ void steal_convert(const kargs_t KA, LAS unsigned char* lds, const int G, const int done_idx, const bool drain) {
    int tid = threadIdx.x; asm volatile("" : "+v"(tid));
    const int lane = tid & 63, wave = __builtin_amdgcn_readfirstlane(tid >> 6);
    volatile LAS int* mb = (volatile LAS int*)(lds + MISC_OFF + 64);
    LAS bf16* scr = (LAS bf16*)(lds + wave * 16384);
    __syncthreads();
    if (tid == 0 && !drain) __hip_atomic_fetch_add((unsigned*)(ctl + CW_DONE + 64 * done_idx), 1u, RLX_AGENT);
    for (;;) {
        if (tid == 0) { int idx = -1;
            const bool stop = !drain && __hip_atomic_load((unsigned*)(ctl + CW_DONE + 64 * done_idx), RLX_AGENT) >= (unsigned)(G - G / 4);
            if (!stop) idx = (int)__hip_atomic_fetch_add((unsigned*)(ctl + CW_Q), 8u, RLX_AGENT);
            mb[0] = idx; }
        __syncthreads();
        const int idx = mb[0];
        __syncthreads();
        if (idx < 0 || idx >= CV_L) break;
        if (idx + wave < CV_L) conv_item(KA, 1, idx + wave, scr, lane);
    }
    __syncthreads();
}

template <int l> __device__ __forceinline__ void layer_body(LAS unsigned char* lds, const int G, const int vcu, const XcdBarrier& bar, const int lo, const int hi) {
    const int NGW = G * 8, NGT = G * 512; LAS int* ttab = (LAS int*)(lds + TILE_OFF);
    constexpr int P = 1 + 8 * l;

        for (int rep_ = 0; rep_ < 1 + ((l == 0) ? ((REP_MASK >> (1 + 0)) & 1) : 0); ++rep_)
        if (IN(P + 0)) {
            KA_DECL
            const float* modp = modv;
            if (l == 1) steal_convert(KA, lds, G, 3, true);
#pragma clang loop vectorize(disable) unroll(disable)
            for (int r0 = gw; r0 < TT; r0 += 2 * NGW) {
                const int r1 = r0 + NGW; const bool has1 = r1 < TT;
                f32x4 va[4], vb[4]; v2u yaa[4], yab[4], yba[4], ybb[4];
                if (l == 0) {
                    const float* srca; const float* srcb;
                    { const bool isc = r0 >= T; srca = isc ? ctx_in + (size_t)(r0 - T) * 1024 : x_in + (size_t)r0 * 1024; }
                    { const int rr = has1 ? r1 : r0; const bool isc = rr >= T; srcb = isc ? ctx_in + (size_t)(rr - T) * 1024 : x_in + (size_t)rr * 1024; }
#pragma unroll
                    for (int j = 0; j < 4; ++j) { va[j] = *(const f32x4*)(srca + 4 * lane + 256 * j); vb[j] = *(const f32x4*)(srcb + 4 * lane + 256 * j); }
                } else {
                    const int rr = has1 ? r1 : r0;
#pragma unroll
                    for (int j = 0; j < 4; ++j) { const v2u wa = *(const v2u*)(xb + (size_t)r0 * 1024 + 4 * lane + 256 * j), wb = *(const v2u*)(xb + (size_t)rr * 1024 + 4 * lane + 256 * j);
                        va[j] = (f32x4){bflo(wa.x), bfhi(wa.x), bflo(wa.y), bfhi(wa.y)}; vb[j] = (f32x4){bflo(wb.x), bfhi(wb.x), bflo(wb.y), bfhi(wb.y)}; }
                }
                if (l == 1) {
                    const int rr = has1 ? r1 : r0;
#pragma unroll
                    for (int j = 0; j < 4; ++j) { yaa[j] = *(const v2u*)(y2 + (size_t)(2 * r0) * 1024 + 4 * lane + 256 * j); yab[j] = *(const v2u*)(y2 + (size_t)(2 * r0 + 1) * 1024 + 4 * lane + 256 * j);
                        yba[j] = *(const v2u*)(y2 + (size_t)(2 * rr) * 1024 + 4 * lane + 256 * j); ybb[j] = *(const v2u*)(y2 + (size_t)(2 * rr + 1) * 1024 + 4 * lane + 256 * j); }
                }
#pragma unroll
                for (int half = 0; half < 2; ++half) {
                    if (half == 1 && !has1) break;
                    const int r = half ? r1 : r0; f32x4 (&v)[4] = half ? vb : va; v2u (&ya)[4] = half ? yba : yaa; v2u (&yb)[4] = half ? ybb : yab;
                    const bool isc = r >= T; const int bsel = isc ? 4 : (r >> 12);
                    if (l == 1) {
                        const float* g2 = modp + bsel * 6144 + 5 * 1024; bf16* dst = xb + (size_t)r * 1024;
#pragma unroll
                        for (int j = 0; j < 4; ++j) {
                            const f32x4 gv = *(const f32x4*)(g2 + 4 * lane + 256 * j);
                            f32x4 yy; yy[0] = bflo(ya[j].x) + bflo(yb[j].x); yy[1] = bfhi(ya[j].x) + bfhi(yb[j].x); yy[2] = bflo(ya[j].y) + bflo(yb[j].y); yy[3] = bfhi(ya[j].y) + bfhi(yb[j].y);
                            if (DBG_NO_MOE) yy = (f32x4){0.f, 0.f, 0.f, 0.f};
                            v[j] = v[j] + gv * yy; { v2u o; o.x = pk2(v[j][0], v[j][1]); o.y = pk2(v[j][2], v[j][3]); *(v2u*)(dst + 4 * lane + 256 * j) = o; }
                        }
                    }
                    float ss = 0.f;
#pragma unroll
                    for (int j = 0; j < 4; ++j) ss += (v[j][0] * v[j][0] + v[j][1] * v[j][1]) + (v[j][2] * v[j][2] + v[j][3] * v[j][3]);
                    const float rstd = 1.0f / sqrtf(wave_sum(ss) * (1.f / 1024.f) + 1e-6f);
                    const float* sh = modl + bsel * 6144; const float* sc = sh + 1024; const float* gn = norm1_g + l * 1024;
#pragma unroll
                    for (int j = 0; j < 4; ++j) {
                        const int c0 = 4 * lane + 256 * j; const f32x4 g = *(const f32x4*)(gn + c0), s1 = *(const f32x4*)(sc + c0), h1 = *(const f32x4*)(sh + c0);
                        const f32x4 y = (v[j] * rstd) * g * (s1 + 1.0f) + h1;
                        v2u o; o.x = pk2(y[0], y[1]); o.y = pk2(y[2], y[3]); *(v2u*)(hbuf + (size_t)r * 1024 + c0) = o;
                        *(unsigned*)((unsigned char*)(ws + O_ACT) + (size_t)r * 1024 + c0) = pk4_f8(y[0], y[1], y[2], y[3]);
                    }
                }
            }
        }
        SEAM(P + 0);
        for (int rep_ = 0; rep_ < 1 + ((l == 0) ? ((REP_MASK >> (1 + 1)) & 1) : 0); ++rep_)
        if (IN(P + 1)) {
            KA_DECL
            EpiG1 E{pu, qb, kall, vall, zb};
            { SchedG1 S{G, vcu, 0, (const char*)hbuf, (const char*)win_t}; pg8::gemm_phase<EpiG1, SchedG1, false>(lds, S, E); }
            { SchedG1 S{G, vcu, 1, (const char*)(ws + O_ACT), (const char*)(ws + O_WIN8 + l * SZ_WIN8)}; pg8::gemm_phase<EpiG1, SchedG1, true>(lds, S, E); }
            if (l == 0 && !MK_SPLIT) steal_convert(KA, lds, G, 0, false);
        }
        SEAM(P + 1);
        if (IN(P + 3)) {
            KA_DECL
            gu32* kflag = ctl + CW_KF + l * 16384;
            gu32* facnt = ctl + CW_FA + l * 64;
            for (int it = vcu; it < 256; it += G) {
                const int b = it >> 6, n2 = it & 63;
                RowA ra{zb, b, n2}; EpiA<true> ea{t2, twt, b, n2};
                slab_gemm<4, RowA, EpiA<true>>(lds, fma, 128, ra, ea);
                asm volatile("s_waitcnt vmcnt(0)" ::: "memory");
                __syncthreads();
                if (tid == 0) __hip_atomic_fetch_add((unsigned*)(facnt + 16 * b), 1u, RLX_AGENT);
            }
            const int n_att = 512 + (l == 0 ? 32 : 0);
            for (int it = vcu; it < n_att; it += G) {
                const bool cu = it >= 512; const int uidx = cu ? it - 512 : it;
                const int b = cu ? (uidx >> 3) : (uidx >> 7), kvh = cu ? ((uidx >> 2) & 1) : ((uidx >> 6) & 1), pb = cu ? (uidx & 3) : (uidx & 63);
                const int p0 = pb * 64; const int qrow0 = cu ? T + b * 256 + p0 : b * 4096 + p0;
                if (!cu) {
                    const int row = tid >> 3, c = tid & 7;
                    const float* kg = k_norm_g + l * 64 + 8 * c;
#pragma unroll
                    for (int part = 0; part < 2; ++part) {
                        if (part == 1 && pb >= 4) break;
                        const int blk = part ? pb : 4 + pb;
                        bf16* p = kall + ((size_t)b * KVROWS + blk * 64 + row) * 128 + kvh * 64 + c * 8;
                        const v4u w = *(const v4u*)p;
                        float x[8] = {bflo(w.x), bfhi(w.x), bflo(w.y), bfhi(w.y), bflo(w.z), bfhi(w.z), bflo(w.w), bfhi(w.w)};
                        float ss = 0.f;
#pragma unroll
                        for (int i = 0; i < 8; ++i) ss += x[i] * x[i];
                        ss += __shfl_xor(ss, 1); ss += __shfl_xor(ss, 2); ss += __shfl_xor(ss, 4);
                        const float rstd = 1.0f / sqrtf(ss * (1.f / 64.f) + 1e-6f);
#pragma unroll
                        for (int i = 0; i < 8; ++i) x[i] *= rstd * kg[i];
                        if (part == 0) {
                            const float2* rp = rope + (size_t)(p0 + row) * 32 + ((c & 4) ? 16 : 0) + (c & 1) * 8;
#pragma unroll
                            for (int i = 0; i < 8; ++i) { const float y = __shfl_xor(x[i], 2); const float2 cs = rp[i]; x[i] = (c & 2) ? (x[i] * cs.x + y * cs.y) : (x[i] * cs.x - y * cs.y); }
                        }
                        v4u o; o.x = pk2(x[0], x[1]); o.y = pk2(x[2], x[3]); o.z = pk2(x[4], x[5]); o.w = pk2(x[6], x[7]);
                        store16_wt(p, o);
                    }
                    asm volatile("s_waitcnt vmcnt(0)" ::: "memory");
                    __syncthreads();
                    if (tid == 0) { __hip_atomic_store(kflag + 16 * ((b * 68 + 4 + pb) * 2 + kvh), 1u, RLX_AGENT); if (pb < 4) __hip_atomic_store(kflag + 16 * ((b * 68 + pb) * 2 + kvh), 1u, RLX_AGENT); }
                }
                if (tid < 64) {
                    int blk = -1;
                    if (lane < 4) blk = lane; else if (!cu && lane < 9) { const int q = pb + lane - 6; if (q >= 0 && q < 64) blk = 4 + q; }
                    unsigned sp = 0;
                    for (;;) { const unsigned f = (blk >= 0) ? __hip_atomic_load(kflag + 16 * ((b * 68 + blk) * 2 + kvh), RLX_AGENT) : 1u;
                        if (__all(f != 0u)) break; __builtin_amdgcn_s_sleep(2);
                        if (++sp > (1u << 22)) { if (tid == 0) __hip_atomic_store(ctl + CW_TMO, 2u, RLX_AGENT); break; } }
                    __builtin_amdgcn_fence(__ATOMIC_ACQUIRE, "agent");
                    asm volatile("s_waitcnt vmcnt(0)" ::: "memory");
                }
                __syncthreads();
                const attn_body::bf16* Qu = (const attn_body::bf16*)(qb + (size_t)qrow0 * 512 + kvh * 256);
                const attn_body::bf16* Kh = (const attn_body::bf16*)(kall + (size_t)b * KVROWS * 128 + kvh * 64);
                const attn_body::bf16* Vh = (const attn_body::bf16*)(vall + (size_t)b * KVROWS * 128 + kvh * 64);
                attn_body::bf16* Ou = (attn_body::bf16*)(mrg + (size_t)qrow0 * 1024 + 256 + kvh * 256);
                attn_body::attn_unit<8>(Qu, Kh, Vh, Ou, p0, cu ? 4 : 10, attn_sink + l * 8 + kvh * 4, q_norm_g + l * 64, cu ? (const float2*)nullptr : (const float2*)rope, (char*)lds);
                __syncthreads();
            }
            const int prow = (l == 0) ? TT : T; const int nrb = prow >> 3;
#pragma clang loop vectorize(disable) unroll(disable)
            for (int i = gt; i < 32 * nrb; i += NGT) {
                const int ck8 = i & 7, rb = (i >> 3) % nrb, g = (i >> 3) / nrb;
                const int r0 = rb * 8; const bool isc = r0 >= T;
                const int nseq = isc ? LCTX : NSEQ; const int rbase = isc ? T + ((r0 - T) & ~255) : (r0 & ~4095); const int n0 = r0 - rbase;
                const int hw = 1 << g; const int col = g * 64 + ck8 * 8;
                const bf16* up = pu + (size_t)rbase * 256 + col;
                float sm[8] = {0.f, 0.f, 0.f, 0.f, 0.f, 0.f, 0.f, 0.f};
#define POOL_ACC(W, SGN) do { sm[0] += SGN bflo(W.x); sm[1] += SGN bfhi(W.x); sm[2] += SGN bflo(W.y); sm[3] += SGN bfhi(W.y); sm[4] += SGN bflo(W.z); sm[5] += SGN bfhi(W.z); sm[6] += SGN bflo(W.w); sm[7] += SGN bfhi(W.w); } while (0)
                for (int tpos = n0 - hw; tpos < n0 + hw; ++tpos) if (tpos >= 0 && tpos < nseq) { const v4u w = *(const v4u*)(up + (size_t)tpos * 256); POOL_ACC(w, +); }
#pragma unroll
                for (int k = 0; k < 8; ++k) {
                    const int n = n0 + k; int lo_ = n - hw; lo_ = lo_ < 0 ? 0 : lo_; int hi_ = n + hw - 1; hi_ = hi_ > nseq - 1 ? nseq - 1 : hi_;
                    const v4u w = *(const v4u*)(up + (size_t)n * 256); const float ic = 1.0f / (float)(hi_ - lo_ + 1);
                    v4u o; o.x = pk2(sm[0] * ic - bflo(w.x), sm[1] * ic - bfhi(w.x)); o.y = pk2(sm[2] * ic - bflo(w.y), sm[3] * ic - bfhi(w.y));
                    o.z = pk2(sm[4] * ic - bflo(w.z), sm[5] * ic - bfhi(w.z)); o.w = pk2(sm[6] * ic - bflo(w.w), sm[7] * ic - bfhi(w.w));
                    if (DBG_NO_POOL) o = (v4u){0u, 0u, 0u, 0u};
                    *(v4u*)(mrg + (size_t)(rbase + n) * 1024 + col) = o;
                    if (k < 7) { const int tin = n + hw, tout = n - hw;
                        if (tin < nseq) { const v4u wi = *(const v4u*)(up + (size_t)tin * 256); POOL_ACC(wi, +); }
                        if (tout >= 0) { const v4u wo = *(const v4u*)(up + (size_t)tout * 256); POOL_ACC(wo, -); } }
                }
#undef POOL_ACC
            }
            for (int it = vcu; it < 256; it += G) {
                const int b = it >> 6, k1 = it & 63;
                __syncthreads();
                if (tid < 64) { unsigned sp = 0;
                    while ((unsigned)__builtin_amdgcn_readfirstlane(__hip_atomic_load((unsigned*)(facnt + 16 * b), RLX_AGENT)) < 64u) { __builtin_amdgcn_s_sleep(2); if (++sp > (1u << 22)) { if (tid == 0) __hip_atomic_store(ctl + CW_TMO, 3u, RLX_AGENT); break; } }
                    __builtin_amdgcn_fence(__ATOMIC_ACQUIRE, "agent");
                    asm volatile("s_waitcnt vmcnt(0)" ::: "memory"); }
                __syncthreads();
                RowB rb{t2, b, k1}; EpiB eb{mrg, b, k1};
                slab_gemm<2, RowB, EpiB>(lds, fmb, 128, rb, eb);
            }
            if (l == 0) for (int it = (G - 1 - vcu); it < 32; it += G) {
                const int b = it >> 3, mt0 = it & 7;
                RowC rc{zb, b}; EpiC ec{mrg, b, mt0};
                slab_gemm<1, RowC, EpiC>(lds, fmc + (size_t)mt0 * 32 * 512, 512, rc, ec);
            }
        }
        SEAM(P + 3);
        if (IN(P + 4)) {
            KA_DECL
            unsigned* g2rdy = (unsigned*)(ctl + CW_G2 + l * 2048);
            {
                SchedPlain S{(l == 0 ? TT : T) / 256, 4, G, vcu, 1024, (const char*)mrg, (const char*)wout_t};
                EpiG2<(l != 0)> E{x_in, ctx_in, xb, modl, g2rdy};
                pg8::gemm_phase<EpiG2<(l != 0)>, SchedPlain>(lds, S, E);
            }
            const int rep_ = 0;
            __syncthreads();
            LAS float* rw = (LAS float*)lds;
            LAS int* lcnt = (LAS int*)(lds + 81920);
            LAS unsigned* lent = (LAS unsigned*)(lds + 81920 + 256);
            LAS unsigned* lrank = lent + 1024;
            { const float* rwg = (const float*)(ws + O_RW) + l * 20480;
#pragma unroll
              for (int i = 0; i < 10; ++i) { const int idx = tid + 512 * i; *(LAS f32x4*)(rw + 4 * idx) = *(const f32x4*)(rwg + 4 * idx); } }
            if (tid < 33) lcnt[tid] = 0;
            if (tid < 64) { unsigned sp = 0; unsigned* w = g2rdy + 16 * (vcu >> 2);
                while ((unsigned)__builtin_amdgcn_readfirstlane(__hip_atomic_load(w, RLX_AGENT)) < 32u) { __builtin_amdgcn_s_sleep(2); if (++sp > (1u << 22)) { if (tid == 0) __hip_atomic_store(ctl + CW_TMO, 4u, RLX_AGENT); break; } }
                __builtin_amdgcn_fence(__ATOMIC_ACQUIRE, "agent");
                asm volatile("s_waitcnt vmcnt(0)" ::: "memory"); }
            __syncthreads();
            const bool dbl = (l == 0) && (G == 256) && (vcu < 16);
            const int ngl = 16 + ((l == 0) ? 1 : 0) + (((l == 0) && (G == 256)) ? 2 : 0);
#pragma clang loop vectorize(disable) unroll(disable)
            for (int gix = wave; gix < ngl; gix += 8) {
                int q;
                if (gix < 16) { if (dbl) continue; q = 16 * vcu + gix; }
                else if (gix == 16) q = T / 4 + vcu;
                else { if (dbl) continue; const int o = (gix == 17) ? (vcu - 16) : (240 + vcu - 16); if (o >= 256 || (gix == 18 && vcu >= 32)) continue; q = o; }
                if (gix >= 17) {
                    unsigned sp = 0; unsigned* w = g2rdy + 16 * (q >> 6);
                    while ((unsigned)__builtin_amdgcn_readfirstlane(__hip_atomic_load(w, RLX_AGENT)) < 32u) { __builtin_amdgcn_s_sleep(2); if (++sp > (1u << 22)) { if (lane == 0) __hip_atomic_store(ctl + CW_TMO, 6u, RLX_AGENT); break; } }
                    __builtin_amdgcn_fence(__ATOMIC_ACQUIRE, "agent");
                    asm volatile("s_waitcnt vmcnt(0)" ::: "memory"); }
                if (gix == 16) { unsigned sp = 0; unsigned* w = g2rdy + 16 * (64 + (vcu >> 6));
                    while ((unsigned)__builtin_amdgcn_readfirstlane(__hip_atomic_load(w, RLX_AGENT)) < 32u) { __builtin_amdgcn_s_sleep(2); if (++sp > (1u << 22)) { if (lane == 0) __hip_atomic_store(ctl + CW_TMO, 5u, RLX_AGENT); break; } }
                    __builtin_amdgcn_fence(__ATOMIC_ACQUIRE, "agent");
                    asm volatile("s_waitcnt vmcnt(0)" ::: "memory"); }
                const int rb4 = 4 * q; const bool isc = rb4 >= T; const int bsel = isc ? 4 : (rb4 >> 12);
                const bf16* src = xb + (size_t)rb4 * 1024;
                f32x4 v[4][4];
#pragma unroll
                for (int tk = 0; tk < 4; ++tk)
#pragma unroll
                    for (int j = 0; j < 4; ++j) { const v2u w = *(const v2u*)(src + (size_t)tk * 1024 + 4 * lane + 256 * j); v[tk][j] = (f32x4){bflo(w.x), bfhi(w.x), bflo(w.y), bfhi(w.y)}; }
                float rstd[4];
#pragma unroll
                for (int tk = 0; tk < 4; ++tk) { float ss = 0.f;
#pragma unroll
                    for (int j = 0; j < 4; ++j) ss += (v[tk][j][0] * v[tk][j][0] + v[tk][j][1] * v[tk][j][1]) + (v[tk][j][2] * v[tk][j][2] + v[tk][j][3] * v[tk][j][3]);
                    rstd[tk] = 1.0f / sqrtf(wave_sum(ss) * (1.f / 1024.f) + 1e-6f); }
                const float* sh = modl + bsel * 6144 + 3 * 1024; const float* sc = sh + 1024; const float* gn = norm2_g + l * 1024;
                float lg[4][20];
#pragma unroll
                for (int tk = 0; tk < 4; ++tk)
#pragma unroll
                    for (int j = 0; j < 20; ++j) lg[tk][j] = 0.f;
#pragma unroll
                for (int j = 0; j < 4; ++j) {
                    const int c0 = 4 * lane + 256 * j; const f32x4 g = *(const f32x4*)(gn + c0), s1 = *(const f32x4*)(sc + c0), h1 = *(const f32x4*)(sh + c0);
                    f32x4 y[4];
#pragma unroll
                    for (int tk = 0; tk < 4; ++tk) { y[tk] = (v[tk][j] * rstd[tk]) * g * (s1 + 1.0f) + h1;
                        *(unsigned*)((unsigned char*)hbuf + (size_t)(rb4 + tk) * 1024 + c0) = pk4_f8(y[tk][0], y[tk][1], y[tk][2], y[tk][3]); }
#pragma unroll
                    for (int e = 0; e < 4; ++e) {
#pragma unroll
                        for (int q5 = 0; q5 < 5; ++q5) { const f32x4 wv = *(const LAS f32x4*)(rw + (((q5 * 4 + j) * 4 + e) * 64 + lane) * 4);
#pragma unroll
                            for (int tk = 0; tk < 4; ++tk) { lg[tk][4 * q5] += y[tk][e] * wv[0]; lg[tk][4 * q5 + 1] += y[tk][e] * wv[1]; lg[tk][4 * q5 + 2] += y[tk][e] * wv[2]; lg[tk][4 * q5 + 3] += y[tk][e] * wv[3]; } }
                        __builtin_amdgcn_sched_barrier(0); }
                }
                float l2[20];
#pragma unroll
                for (int j = 0; j < 20; ++j) {
                    const float a0 = swap32_sum(lg[0][j], lg[2][j]);
                    const float a1 = swap32_sum(lg[1][j], lg[3][j]);
                    float t = swap16_sum(a0, a1);
                    t += dppf<0x128, 0xf>(t); t += dppf<0x124, 0xf>(t); t += dppf<0x122, 0xf>(t); t += dppf<0x121, 0xf>(t);
                    l2[j] = t;
                }
                const int tk = lane >> 4; const int r = rb4 + tk;
                float gl[4]; float gm = -1e30f;
#pragma unroll
                for (int j = 0; j < 4; ++j) { gl[j] = l2[j] + b_grp[l * 4 + j]; gm = fmaxf(gm, gl[j]); }
                float gs = 0.f; int gi = 0; float gb = -1e30f;
#pragma unroll
                for (int j = 0; j < 4; ++j) { const float e = expf(gl[j] - gm); gs += e; if (gl[j] > gb) { gb = gl[j]; gi = j; } }
                const float pg = expf(gb - gm) / gs;
                float el[4]; float em = -1e30f;
#pragma unroll
                for (int j = 0; j < 4; ++j) { float t_ = 0.f;
#pragma unroll
                    for (int g4 = 0; g4 < 4; ++g4) t_ = (gi == g4) ? (l2[4 + g4 * 4 + j] + b_rtr[l * 16 + g4 * 4 + j]) : t_;
                    el[j] = t_; em = fmaxf(em, t_); }
                float pe[4];
#pragma unroll
                for (int j = 0; j < 4; ++j) pe[j] = expf(el[j] - em);
                int i0 = 0; float b0 = -1.f;
#pragma unroll
                for (int j = 0; j < 4; ++j) if (pe[j] > b0) { b0 = pe[j]; i0 = j; }
                int i1 = 0; float b1 = -1.f;
#pragma unroll
                for (int j = 0; j < 4; ++j) if (j != i0 && pe[j] > b1) { b1 = pe[j]; i1 = j; }
                const float wsum = b0 + b1; const float w0 = pg * b0 / wsum, w1 = pg * b1 / wsum;
                if ((lane & 15) == 0 && rep_ == 0) {
                    wts[2 * r] = w0; wts[2 * r + 1] = w1;
                    const int e0 = gi * 4 + i0, e1 = gi * 4 + i1;
                    const int s0 = __hip_atomic_fetch_add((LAS int*)(lcnt + 16 + 16), 1, __ATOMIC_RELAXED, __HIP_MEMORY_SCOPE_WORKGROUP);
                    const int k0 = __hip_atomic_fetch_add((LAS int*)(lcnt + e0), 1, __ATOMIC_RELAXED, __HIP_MEMORY_SCOPE_WORKGROUP);
                    const int k1 = __hip_atomic_fetch_add((LAS int*)(lcnt + e1), 1, __ATOMIC_RELAXED, __HIP_MEMORY_SCOPE_WORKGROUP);
                    lent[2 * s0] = ((unsigned)(2 * r) << 4) | (unsigned)e0; lrank[2 * s0] = (unsigned)k0;
                    lent[2 * s0 + 1] = ((unsigned)(2 * r + 1) << 4) | (unsigned)e1; lrank[2 * s0 + 1] = (unsigned)k1;
                }
            }
            __syncthreads();
            if (tid < 16 && rep_ == 0) { const int c = lcnt[tid]; lcnt[16 + tid] = c ? (int)__hip_atomic_fetch_add((unsigned*)(ctl + CW_CNT + (l * 16 + tid) * 64), (unsigned)c, RLX_AGENT) : 0; }
            __syncthreads();
            const int ntot = rep_ == 0 ? 2 * lcnt[32] : 0;
            for (int i = tid; i < ntot; i += 512) { const unsigned en = lent[i]; const int e = en & 15; list[(size_t)e * TT + lcnt[16 + e] + lrank[i]] = en >> 4; }
            __syncthreads();
            if (l == 0 && !MK_SPLIT) steal_convert(KA, lds, G, 1, false);
        }
        SEAM(P + 5);
        if (IN(P + 6) || IN(P + 7)) {
            KA_DECL
            __syncthreads();
            if (tid < 16) ttab[17 + tid] = (int)__hip_atomic_load((unsigned*)(ctl + CW_CNT + (l * 16 + tid) * 64), RLX_AGENT);
            __syncthreads();
            if (tid == 0) { int acc_ = 0; for (int e = 0; e < 16; ++e) { const int c = ttab[17 + e]; ttab[e] = acc_; acc_ += (c + 255) >> 8; } ttab[16] = acc_; }
            __syncthreads();
        }
        if (DBG_NAIVE_MOE && IN(P + 6)) {
            KA_DECL
            const int nrows = (l == 0) ? TT : T; LAS float* hs = (LAS float*)lds; LAS float* as = hs + 1024;
            const int* eidg = (const int*)(ws + O_EID);
            LAS float* lgs = as + 512; LAS float* rt = lgs + 32;
            for (int r = vcu; r < nrows; r += G) {
                __syncthreads();
                for (int i = tid; i < 1024; i += 512) hs[i] = bf2f(hbuf[(size_t)r * 1024 + i]);
                __syncthreads();
                if (tid < 20) { float a = 0.f; for (int k = 0; k < 1024; ++k) a += hs[k] * ((tid < 4) ? w_grp[(size_t)l * 4096 + k * 4 + tid] : w_rtr[(size_t)l * 16384 + k * 16 + (tid - 4)]);
                    lgs[tid] = a + ((tid < 4) ? b_grp[l * 4 + tid] : b_rtr[l * 16 + tid - 4]); }
                __syncthreads();
                if (tid == 0) { int gi = 0; for (int j = 1; j < 4; ++j) if (lgs[j] > lgs[gi]) gi = j; float gs = 0.f; for (int j = 0; j < 4; ++j) gs += expf(lgs[j] - lgs[gi]); const float pg = 1.f / gs;
                    int i0 = 0; for (int j = 1; j < 4; ++j) if (lgs[4 + gi * 4 + j] > lgs[4 + gi * 4 + i0]) i0 = j; int i1 = -1; for (int j = 0; j < 4; ++j) if (j != i0 && (i1 < 0 || lgs[4 + gi * 4 + j] > lgs[4 + gi * 4 + i1])) i1 = j;
                    const float p0 = 1.f, p1 = expf(lgs[4 + gi * 4 + i1] - lgs[4 + gi * 4 + i0]); rt[0] = (float)(gi * 4 + i0); rt[1] = (float)(gi * 4 + i1); rt[2] = pg * p0 / (p0 + p1); rt[3] = pg * p1 / (p0 + p1); }
                __syncthreads();
                for (int sl = 0; sl < 2; ++sl) {
                    const int e = (DBG_NAIVE_ROUTE & 1) ? (int)rt[sl] : eidg[2 * r + sl]; const float w = (DBG_NAIVE_ROUTE & 2) ? rt[2 + sl] : wts[2 * r + sl];
                    __syncthreads();
                    const float* Wg = w_gate + (size_t)(l * 16 + e) * 1024 * 512 + tid; const float* Wu = w_up + (size_t)(l * 16 + e) * 1024 * 512 + tid;
                    float g = 0.f, u = 0.f;
#pragma unroll 8
                    for (int k = 0; k < 1024; ++k) { g += hs[k] * Wg[(size_t)k * 512]; u += hs[k] * Wu[(size_t)k * 512]; }
                    as[tid] = g / (1.f + expf(-g)) * u;
                    __syncthreads();
                    const float* Wd = w_down + (size_t)(l * 16 + e) * 512 * 1024 + tid;
                    float y0 = 0.f, y1 = 0.f;
#pragma unroll 8
                    for (int j = 0; j < 512; ++j) { y0 += as[j] * Wd[(size_t)j * 1024]; y1 += as[j] * Wd[(size_t)j * 1024 + 512]; }
                    y2[(size_t)(2 * r + sl) * 1024 + tid] = (bf16)f2bf(y0 * w); y2[(size_t)(2 * r + sl) * 1024 + 512 + tid] = (bf16)f2bf(y1 * w);
                }
            }
        }
        if (!DBG_NAIVE_MOE && IN(P + 6)) {
            KA_DECL
            unsigned* rdy = (unsigned*)(ctl + CW_RDY + l * 4096);
            SchedMoe S{G, vcu, ttab[16], (const char*)hbuf, (const char*)act, (const char*)wgu_t, (const char*)wd_t, list, ttab, rdy, (unsigned*)(ctl + CW_TMO)};
            EpiMoe E{EpiG3{act, rdy}, EpiG4{y2, list, wts, ttab}};
            pg8::gemm_phase<EpiMoe, SchedMoe, true>(lds, S, E);
            if (l == 0 && !MK_SPLIT) steal_convert(KA, lds, G, 2, false);
        }
        SEAM(P + 7);
    }

__global__ void __launch_bounds__(512, 2) fwd_kernel(Args args) {
    extern __shared__ __attribute__((aligned(16))) unsigned char lds_raw[];
    LAS unsigned char* lds = (LAS unsigned char*)lds_raw;
    const int tid = threadIdx.x, lane = tid & 63, wave = __builtin_amdgcn_readfirstlane(tid >> 6);
    const int G = gridDim.x; const int bx = blockIdx.x; const int vcu = (G % 8 == 0) ? (bx % 8) * (G / 8) + bx / 8 : bx;
    volatile LAS unsigned* MISC = (volatile LAS unsigned*)(lds + MISC_OFF);
    LAS float* trig = (LAS float*)(lds + TRIG_OFF);
    LAS int* ttab = (LAS int*)(lds + TILE_OFF);
    for (int u = tid; u < (LDS_BYTES - LDSCTL_OFF) / 4; u += 512) ((LAS unsigned*)(lds + LDSCTL_OFF))[u] = 0u;
    __syncthreads();
    if (tid < 64) { float s, c; sincospif((float)tid / 32.f, &s, &c); trig[tid] = c; trig[64 + tid] = s; }
    __syncthreads();
    XcdBarrier bar; bar.bar = nullptr; bar.x = 0; bar.st = nullptr;
    if (!MK_SPLIT) { KA_DECL bar = xcd_barrier_post((unsigned*)(ctl + CW_BAR), MISC + 8); }
    const int lo = args.ph_lo, hi = args.ph_hi;
    const int NGW = G * 8, NGT = G * 512;

    for (int rep_ = 0; rep_ < 1 + ((REP_MASK >> 0) & 1); ++rep_)
    if (IN(0)) {
        KA_DECL
        __syncthreads();
        if (rep_ == 0 || ((REP_MASK >> 13) & 1)) {
            LAS float* sl = (LAS float*)lds;
            bool have = false;
            for (int it = vcu; it < 192; it += G) {
                if (!have) {
                    for (int i = tid; i < 5120; i += 512) { const int r = i >> 10, k = i & 1023; const float v = (r < 4) ? c_in[r * 1024 + k] : cctx_in[k]; sl[i] = v / (1.f + expf(-v)); }
                    __syncthreads(); have = true;
                }
                const int l = it / 96, cb = it % 96;
                const int r4 = lane >> 4, cq = lane & 15; const int k0 = wave * 128;
                const float* W = w_mod + (size_t)l * 1024 * 6144 + (size_t)(k0 + r4) * 6144 + cb * 64 + 4 * cq;
                f32x4 a0 = {0.f, 0.f, 0.f, 0.f}, a1 = a0, a2 = a0, a3 = a0, a4 = a0;
#pragma unroll 8
                for (int k = 0; k < 32; ++k) { const f32x4 wv = *(const f32x4*)(W + (size_t)(4 * k) * 6144); const int kk = k0 + 4 * k + r4;
                    a0 += wv * sl[kk]; a1 += wv * sl[1024 + kk]; a2 += wv * sl[2048 + kk]; a3 += wv * sl[3072 + kk]; a4 += wv * sl[4096 + kk]; }
                LAS float* part = sl + 5120;
                { LAS float* pp = part + (wave * 4 + r4) * 320 + 4 * cq;
                  *(LAS f32x4*)(pp) = a0; *(LAS f32x4*)(pp + 64) = a1; *(LAS f32x4*)(pp + 128) = a2; *(LAS f32x4*)(pp + 192) = a3; *(LAS f32x4*)(pp + 256) = a4; }
                __syncthreads();
                if (tid < 320) { const int r = tid >> 6, n = tid & 63; float sacc = b_mod[l * 6144 + cb * 64 + n];
#pragma unroll 8
                    for (int w = 0; w < 32; ++w) sacc += part[w * 320 + r * 64 + n];
                    modv[(size_t)(l * 5 + r) * 6144 + cb * 64 + n] = sacc; }
                __syncthreads();
            }
            __syncthreads();
        }
        if (rep_ == 0 || ((REP_MASK >> 14) & 1)) {
#pragma clang loop vectorize(disable) unroll(disable)
        for (int i = gt; i < 4096 * 32; i += NGT) {
            const int n = i >> 5, j = i & 31; const int jj = j & 15;
            const float inv = 1.0f / powf(10000.0f, (float)(2 * jj) / 32.0f);
            const float pos = (j < 16) ? (float)(n >> 6) : (float)(n & 63);
            const float ang = pos * inv; rope[i] = make_float2(cosf(ang), sinf(ang));
        }
#pragma clang loop vectorize(disable) unroll(disable)
        for (int i = gt; i < 4096; i += NGT) { float s, c; sincospif((float)i / 2048.f, &s, &c); twt[i] = make_float2(c, s); }
#pragma clang loop vectorize(disable) unroll(disable)
        for (int i = gt; i < 128 * 128; i += NGT) {
            const int m = i >> 7, k = i & 127; const int ri = m >> 6, k1 = m & 63, part = k >> 6, n1 = k & 63;
            float s, c; sincospif((float)((n1 * k1) & 63) / 32.f, &s, &c);
            float v; if (ri == 0) v = (part == 0) ? c : -s; else v = (part == 0) ? -s : -c;
            fma[i] = (bf16)f2bf(v);
        }
#pragma clang loop vectorize(disable) unroll(disable)
        for (int i = gt; i < 64 * 128; i += NGT) {
            const int k2 = i >> 7, k = i & 127; const int ri = k >> 6, n2 = k & 63;
            float s, c; sincospif((float)((n2 * k2) & 63) / 32.f, &s, &c);
            fmb[i] = (bf16)f2bf((ri == 0 ? c : s) * (1.f / 512.f));
        }
#pragma clang loop vectorize(disable) unroll(disable)
        for (int i = gt; i < 256 * 512; i += NGT) {
            const int kk = i >> 9, k = i & 511; const int part = k >> 8, n = k & 255;
            float s, c; sincospif((float)((n * kk) & 255) / 128.f, &s, &c);
            fmc[i] = (bf16)f2bf((part == 0 ? c : -s) * (1.f / 128.f));
        }
#pragma clang loop vectorize(disable) unroll(disable)
        for (int i = gt; i < 2 * 20480; i += NGT) {
            const int lw = i / 20480, r = i % 20480; const int d = r / 20, j = r % 20;
            ((float*)(ws + O_RW))[lw * 20480 + ((((j >> 2) * 4 + (d >> 8)) * 4 + (d & 3)) * 64 + ((d & 255) >> 2)) * 4 + (j & 3)] = (j < 4) ? w_grp[(size_t)lw * 4096 + d * 4 + j] : w_rtr[(size_t)lw * 16384 + d * 16 + (j - 4)];
        }
        }
        if (rep_ == 0 || ((REP_MASK >> 15) & 1)) {
            LAS float* Al = (LAS float*)lds;
            LAS float* Wl = Al + 4096;
            LAS float* Xl = Wl + 4096;
            for (int it = vcu; it < 256; it += G) {
                const int combo = it & 15, jb = it >> 4; const int l = combo >> 3, g = (combo >> 1) & 3, which = combo & 1;
                const float* Wg = four_w + (size_t)(l * 4 + g) * 4096; const LAS float* tb = trig + which * 64;
                const float* wi = w_in + (size_t)l * 1024 * 1280 + (size_t)(jb * 64) * 1280 + 1024 + g * 64;
                __syncthreads();
#pragma unroll
                for (int i = 0; i < 2; ++i) { const int idx = tid + 512 * i; *(LAS f32x4*)(Wl + 4 * idx) = *(const f32x4*)(Wg + 4 * idx); const int j = idx >> 4, c4 = idx & 15; *(LAS f32x4*)(Xl + j * 64 + 4 * c4) = *(const f32x4*)(wi + (size_t)j * 1280 + 4 * c4); }
                __syncthreads();
                { const int d = tid & 63, c0 = tid >> 6;
#pragma unroll 2
                  for (int i = 0; i < 8; ++i) { const int c = c0 + 8 * i; float a = 0.f;
#pragma unroll 16
                      for (int m = 0; m < 64; ++m) a += tb[(m * c) & 63] * Wl[m * 64 + d];
                      Al[c * 64 + d] = a; } }
                __syncthreads();
                { const int d = tid & 63, jl = 8 * (tid >> 6);
                  float o[8] = {0.f, 0.f, 0.f, 0.f, 0.f, 0.f, 0.f, 0.f};
#pragma unroll 4
                  for (int c = 0; c < 64; ++c) { const float av = Al[c * 64 + d];
#pragma unroll
                      for (int i = 0; i < 8; ++i) o[i] += Xl[(jl + i) * 64 + c] * av; }
                  v4u w; w.x = pk2(o[0], o[1]); w.y = pk2(o[2], o[3]); w.z = pk2(o[4], o[5]); w.w = pk2(o[6], o[7]);
                  *(v4u*)((bf16*)(ws + O_WIN + l * SZ_WIN1) + (size_t)(1024 + which * 256 + g * 64 + d) * 1024 + jb * 64 + jl) = w; }
            }
            for (int it = vcu; it < 256; it += G) {
                const int combo = it & 7, nb = it >> 3; const int l = combo >> 2, g = combo & 3, n0 = nb * 32;
                const float* pwg = pool_w + (size_t)(l * 4 + g) * 4096;
                __syncthreads();
#pragma unroll
                for (int i = 0; i < 2; ++i) { const int idx = tid + 512 * i; *(LAS f32x4*)(Wl + 4 * idx) = *(const f32x4*)(pwg + 4 * idx); }
                for (int i = tid; i < 2048; i += 512) { const int d = i >> 5, n = i & 31; Xl[i] = pool_scale[l * 256 + g * 64 + d] * w_out[(size_t)l * 1024 * 1024 + (size_t)(g * 64 + d) * 1024 + n0 + n]; }
                __syncthreads();
                { const int n = tid & 31, c0 = 4 * (tid >> 5);
                  float o[4] = {0.f, 0.f, 0.f, 0.f};
#pragma unroll 8
                  for (int d = 0; d < 64; ++d) { const float sv = Xl[d * 32 + n];
#pragma unroll
                      for (int i = 0; i < 4; ++i) o[i] += Wl[(c0 + i) * 64 + d] * sv; }
                  v2u w; w.x = pk2(o[0], o[1]); w.y = pk2(o[2], o[3]);
                  *(v2u*)((bf16*)(ws + O_WOUT + l * SZ_WOUT1) + (size_t)(n0 + n) * 1024 + g * 64 + c0) = w; }
            }
            __syncthreads();
        }
        if (rep_ == 0 || ((REP_MASK >> 16) & 1)) {
            LAS bf16* scr = (LAS bf16*)(lds + wave * 16384);
#pragma clang loop vectorize(disable) unroll(disable)
            for (int it0 = gw; it0 < CV_L; it0 += NGW) conv_item(KA, 0, it0, scr, lane);
        }
    }
    SEAM(0);
    if ((REP_MASK >> 12) & 1) { for (int k_ = 0; k_ < 4; ++k_) xcd_barrier(bar); }

    layer_body<0>(lds, G, vcu, bar, lo, hi);
    layer_body<1>(lds, G, vcu, bar, lo, hi);
    if (IN(17)) {
        KA_DECL
        const float* modp = modv + (size_t)5 * 6144;
#pragma clang loop vectorize(disable) unroll(disable)
        for (int r = gw; r < T; r += NGW) {
            const float* g2 = modp + (r >> 12) * 6144 + 5 * 1024; float* dst = outp + (size_t)r * 1024;
#pragma unroll
            for (int j = 0; j < 4; ++j) {
                const int c0 = 4 * lane + 256 * j; const v2u xw = *(const v2u*)(xb + (size_t)r * 1024 + c0); const f32x4 v = {bflo(xw.x), bfhi(xw.x), bflo(xw.y), bfhi(xw.y)};
                const v2u ya = *(const v2u*)(y2 + (size_t)(2 * r) * 1024 + c0), yb = *(const v2u*)(y2 + (size_t)(2 * r + 1) * 1024 + c0);
                const f32x4 gv = *(const f32x4*)(g2 + c0);
                f32x4 yy; yy[0] = bflo(ya.x) + bflo(yb.x); yy[1] = bfhi(ya.x) + bfhi(yb.x); yy[2] = bflo(ya.y) + bflo(yb.y); yy[3] = bfhi(ya.y) + bfhi(yb.y);
                if (DBG_NO_MOE) yy = (f32x4){0.f, 0.f, 0.f, 0.f};
                *(f32x4*)(dst + c0) = v + gv * yy;
            }
        }
    }
#undef IN
#undef SEAM
}

#undef KA_DECL
#undef ws
#undef ctl
#undef x_in
#undef c_in
#undef ctx_in
#undef cctx_in
#undef w_mod
#undef b_mod
#undef norm1_g
#undef w_in
#undef q_norm_g
#undef k_norm_g
#undef attn_sink
#undef pool_w
#undef pool_scale
#undef four_w
#undef w_out
#undef norm2_g
#undef w_grp
#undef b_grp
#undef w_rtr
#undef b_rtr
#undef w_gate
#undef w_up
#undef w_down
#undef outp
#undef modv
#undef rope
#undef twt
#undef fma
#undef fmb
#undef fmc
#undef hbuf
#undef kall
#undef vall
#undef xc
#undef xb
#undef list
#undef wts
#undef act
#undef t2
#undef mrg
#undef qb
#undef pu
#undef zb
#undef y2
#undef modl
#undef win_t
#undef wout_t
#undef wgu_t
#undef wd_t
extern "C" void kernel_launch(void* const* d_in, const int* in_sizes, int n_in, void* d_out, int out_size, void* d_ws, size_t ws_size, hipStream_t stream) {
    static int grid = 0;
    if (grid == 0) {
        if (n_in != 23 || out_size != T * DM || ws_size < WS_END) { fprintf(stderr, "kernel_launch: unexpected shapes (n_in %d out %d ws %zu need %zu)\n", n_in, out_size, ws_size, (size_t)WS_END); grid = -1; return; }
        int dev = 0, cus = 0;
        if (hipGetDevice(&dev) != hipSuccess || hipDeviceGetAttribute(&cus, hipDeviceAttributeMultiprocessorCount, dev) != hipSuccess) { grid = -1; return; }
        if (cus != 256) { fprintf(stderr, "kernel_launch: built for a 256-CU device (row-tile hand-offs are laid out for 256 workgroups); found %d CUs; nothing launched\n", cus); grid = -1; return; }
        if (hipFuncSetAttribute((const void*)fwd_kernel, hipFuncAttributeMaxDynamicSharedMemorySize, LDS_BYTES) != hipSuccess) { fprintf(stderr, "kernel_launch: hipFuncSetAttribute failed\n"); grid = -1; return; }
        (void)hipGetLastError();
        grid = cus;
    }
    if (grid < 0) return;
    (void)hipMemsetAsync((char*)d_ws + O_CTL, 0, SZ_CTL, stream);
    Args a{};
    for (int i = 0; i < 23; ++i) a.in[i] = (const float*)d_in[i];
    a.out = (float*)d_out; a.ws = (unsigned char*)d_ws;
#if MK_SPLIT
    for (int p = 0; p < NPHASE; ++p) { a.ph_lo = p; a.ph_hi = p + 1; hipLaunchKernelGGL(fwd_kernel, dim3(grid), dim3(512), LDS_BYTES, stream, a); }
#else
    a.ph_lo = 0; a.ph_hi = NPHASE;
    hipLaunchKernelGGL(fwd_kernel, dim3(grid), dim3(512), LDS_BYTES, stream, a);
#endif
}
```

```cpp
#include <hip/hip_runtime.h>
#include <cstdio>
#include <cstdint>

#define DBG_NO_FOUR 0
#define DBG_NO_POOL 0
#define DBG_NO_ATT 0
#define DBG_NO_MOE 0
#define DBG_MOE_SCALE 1.0f
#define DBG_NAIVE_MOE 0
#define REP_MASK 0x0
#define DBG_NAIVE_ROUTE 0
#define LAS __attribute__((address_space(3)))
#define GAS __attribute__((address_space(1)))
typedef unsigned short bf16;
typedef short bf16x8 __attribute__((ext_vector_type(8)));
typedef float f32x4 __attribute__((ext_vector_type(4)));
typedef float f32x16 __attribute__((ext_vector_type(16)));
typedef unsigned v4u __attribute__((ext_vector_type(4)));
typedef unsigned v2u __attribute__((ext_vector_type(2)));
typedef float f32x2 __attribute__((ext_vector_type(2)));
typedef GAS unsigned gu32;

#ifndef MK_SPLIT
#define MK_SPLIT 0
#endif

constexpr int NB = 4, NSEQ = 4096, DM = 1024, LCTX = 256, DEPTH = 2;
constexpr int T = NB * NSEQ, TC = NB * LCTX, TT = T + TC;
constexpr int KVROWS = LCTX + NSEQ;
constexpr int NEXP = 16, DEXP = 512;
constexpr int NPHASE = 18;
constexpr int MAXTILES = 152;
constexpr float QSCALE = 0.125f * 1.4426950408889634f;
constexpr float LOG2E = 1.4426950408889634f;

constexpr size_t al256(size_t x) { return (x + 255) & ~(size_t)255; }
constexpr size_t O_CTL = 0, SZ_CTL = 1u << 20;
constexpr size_t O_MOD = O_CTL + SZ_CTL, SZ_MOD = (size_t)2 * 5 * 6144 * 4;
constexpr size_t O_ROPE = al256(O_MOD + SZ_MOD), SZ_ROPE = (size_t)4096 * 32 * 8;
constexpr size_t O_TW = al256(O_ROPE + SZ_ROPE), SZ_TW = 4096 * 8;
constexpr size_t O_FMA = al256(O_TW + SZ_TW), SZ_FMA = 128 * 128 * 2;
constexpr size_t O_FMB = al256(O_FMA + SZ_FMA), SZ_FMB = 64 * 128 * 2;
constexpr size_t O_FMC = al256(O_FMB + SZ_FMB), SZ_FMC = 256 * 512 * 2;
constexpr size_t O_RW = al256(O_FMC + SZ_FMC), SZ_RW = (size_t)2 * 20480 * 4;
constexpr size_t O_WIN8 = al256(O_RW + SZ_RW), SZ_WIN8 = (size_t)1280 * 1024;
constexpr size_t O_WIN = al256(O_WIN8 + 2 * SZ_WIN8), SZ_WIN1 = (size_t)1536 * 1024 * 2;
constexpr size_t O_WOUT = al256(O_WIN + 2 * SZ_WIN1), SZ_WOUT1 = (size_t)1024 * 1024 * 2;
constexpr size_t O_WGU = al256(O_WOUT + 2 * SZ_WOUT1), SZ_WGU1 = (size_t)16 * 1024 * 1024 * 2;
constexpr size_t O_WD = al256(O_WGU + 2 * SZ_WGU1), SZ_WD1 = (size_t)16 * 1024 * 512 * 2;
constexpr size_t O_H = al256(O_WD + 2 * SZ_WD1), SZ_H = (size_t)TT * 1024 * 2;
constexpr size_t O_KALL = al256(O_H + SZ_H), SZ_KV = (size_t)NB * KVROWS * 128 * 2;
constexpr size_t O_VALL = al256(O_KALL + SZ_KV);
constexpr size_t O_XC = al256(O_VALL + SZ_KV), SZ_XC = (size_t)TC * 1024 * 4;
constexpr size_t O_LIST = al256(O_XC + SZ_XC), SZ_LIST = (size_t)NEXP * TT * 4;
constexpr size_t O_WTS = al256(O_LIST + SZ_LIST), SZ_WTS = (size_t)TT * 2 * 4;
constexpr size_t O_EID = al256(O_WTS + SZ_WTS), SZ_EID = (size_t)TT * 2 * 4;
constexpr size_t O_ACT = al256(O_EID + SZ_EID), SZ_ACT = (size_t)MAXTILES * 256 * 512 * 2;
constexpr size_t O_T2 = O_ACT, SZ_T2 = (size_t)NB * 64 * 64 * 2 * 256 * 2;
constexpr size_t O_MRG = al256(O_ACT + SZ_ACT), SZ_MRG = (size_t)TT * 1024 * 2;
constexpr size_t O_Q = al256(O_MRG + SZ_MRG), SZ_Q = (size_t)TT * 512 * 2;
constexpr size_t O_PU = al256(O_Q + SZ_Q), SZ_PU = (size_t)TT * 256 * 2;
constexpr size_t O_Z = al256(O_PU + SZ_PU), SZ_Z = (size_t)TT * 512 * 2;
constexpr size_t O_Y2 = O_MRG, SZ_Y2 = (size_t)TT * 2 * 1024 * 2;
constexpr size_t O_XB = al256(O_Z + SZ_Z), SZ_XB = (size_t)TT * 1024 * 2;
constexpr size_t WS_END = al256(O_XB + SZ_XB);
static_assert(SZ_T2 <= SZ_ACT, "T2 overlay");
static_assert(O_Y2 + SZ_Y2 <= WS_END, "y2 overlay");

constexpr int CW_TMO = 0;
constexpr int CW_BAR = 4096;
constexpr int CW_KF = 65536;
constexpr int CW_FA = 3072;
constexpr int CW_G2 = 40960;
constexpr int CW_RDY = 32768;
constexpr int CW_Q = 2048;
constexpr int CW_DONE = 2560;
constexpr int CW_CNT = 16384;

constexpr int RING_BYTES = 131072;
constexpr int LDSCTL_OFF = RING_BYTES, MISC_OFF = LDSCTL_OFF + 320;
constexpr int TRIG_OFF = LDSCTL_OFF + 1024;
constexpr int TILE_OFF = LDSCTL_OFF + 2048;
constexpr int LDS_BYTES = 147456;

#define RLX_AGENT __ATOMIC_RELAXED, __HIP_MEMORY_SCOPE_AGENT
#define LDS_WAIT() asm volatile("s_waitcnt lgkmcnt(0)" ::: "memory")
#define VM_WAIT() asm volatile("s_waitcnt vmcnt(0)" ::: "memory")

__device__ __forceinline__ unsigned f2bf(float f) { unsigned u = __builtin_bit_cast(unsigned, f); return (u + 0x7fffu + ((u >> 16) & 1u)) >> 16; }
typedef float f32x2_t_ __attribute__((ext_vector_type(2))); typedef __bf16 bf16x2_t_ __attribute__((ext_vector_type(2)));
__device__ __forceinline__ unsigned pk2(float lo, float hi) { f32x2_t_ v = {lo, hi}; return __builtin_bit_cast(unsigned, __builtin_convertvector(v, bf16x2_t_)); }
__device__ __forceinline__ unsigned pk4_f8(float a, float b, float c, float d) { unsigned w = 0; w = __builtin_amdgcn_cvt_pk_fp8_f32(a, b, w, false); w = __builtin_amdgcn_cvt_pk_fp8_f32(c, d, w, true); return w; }
__device__ __forceinline__ float bflo(unsigned w) { return __builtin_bit_cast(float, w << 16); }
__device__ __forceinline__ float bfhi(unsigned w) { return __builtin_bit_cast(float, w & 0xffff0000u); }
__device__ __forceinline__ float bf2f(bf16 h) { return __builtin_bit_cast(float, (unsigned)h << 16); }
template <int CTRL, int RM> __device__ __forceinline__ float dppf(float v) { return __builtin_bit_cast(float, __builtin_amdgcn_update_dpp(0, __builtin_bit_cast(int, v), CTRL, RM, 0xf, true)); }
__device__ __forceinline__ float wave_sum(float v) {
    v += dppf<0x111, 0xf>(v); v += dppf<0x112, 0xf>(v); v += dppf<0x114, 0xf>(v); v += dppf<0x118, 0xf>(v);
    v += dppf<0x142, 0xa>(v); v += dppf<0x143, 0xc>(v);
    return __builtin_bit_cast(float, __builtin_amdgcn_readlane(__builtin_bit_cast(int, v), 63));
}

__device__ __forceinline__ float swap32_sum(float x, float y) {
    const auto rr = __builtin_amdgcn_permlane32_swap(__builtin_bit_cast(unsigned, x), __builtin_bit_cast(unsigned, y), false, false);
    unsigned r0 = rr[0], r1 = rr[1]; asm volatile("" : "+v"(r0), "+v"(r1));
    return __builtin_bit_cast(float, r0) + __builtin_bit_cast(float, r1);
}
__device__ __forceinline__ float swap16_sum(float x, float y) {
    const auto rr = __builtin_amdgcn_permlane16_swap(__builtin_bit_cast(unsigned, x), __builtin_bit_cast(unsigned, y), false, false);
    unsigned r0 = rr[0], r1 = rr[1]; asm volatile("" : "+v"(r0), "+v"(r1));
    return __builtin_bit_cast(float, r0) + __builtin_bit_cast(float, r1);
}

#define XB_TMO      128
#define XB_XCNT(j)  (256  + 64 * (j))
#define XB_XSUB(j)  (1280 + 64 * (j))
#define XB_XGEN(j)  (2304 + 64 * (j))
#define XB_TOP      3328
#define XB_TOPGEN   3392
#define XCD_BAR_WORDS 3456
#define XB_SPIN_CAP (1u << 18)
__device__ __forceinline__ unsigned xb_ld(unsigned* p)              { return __hip_atomic_load(p, __ATOMIC_RELAXED, __HIP_MEMORY_SCOPE_AGENT); }
__device__ __forceinline__ unsigned xb_add(unsigned* p, unsigned v) { return __hip_atomic_fetch_add(p, v, __ATOMIC_RELAXED, __HIP_MEMORY_SCOPE_AGENT); }
__device__ __forceinline__ unsigned xb_xcc_id() { return (unsigned)__builtin_amdgcn_s_getreg((3 << 11) | 20) & 0xFu; }
#define XB_SPIN(cond, bar) do { unsigned _sp = 0; while (cond) { __builtin_amdgcn_s_sleep(1); \
    if ((++_sp & 255u) == 0u) { if (xb_ld(&(bar)[XB_TMO])) break; if (_sp > XB_SPIN_CAP) { atomicAdd(&(bar)[XB_TMO], 1u); break; } } } } while (0)
struct XcdBarrier { unsigned* bar; unsigned x; volatile LAS unsigned* st; };
__device__ __forceinline__ XcdBarrier xcd_barrier_post(unsigned* bar, volatile LAS unsigned* st) {
    XcdBarrier b; b.bar = bar; b.x = xb_xcc_id(); b.st = st;
    if (threadIdx.x == 0) (void)xb_add(&bar[XB_XCNT(b.x)], 1u);
    return b;
}
__device__ __forceinline__ void xcd_barrier_complete(unsigned* bar, unsigned x, unsigned& nloc, unsigned& nx) {
    const unsigned G = gridDim.x * gridDim.y * gridDim.z;
    unsigned sum, cnt, mine, sp = 0u;
    for (;;) {
        sum = 0u; cnt = 0u; mine = 0u;
#pragma unroll
        for (unsigned j = 0; j < 16; ++j) { const unsigned c = xb_ld(&bar[XB_XCNT(j)]); sum += c; cnt += (c > 0u) ? 1u : 0u; mine = (j == x) ? c : mine; }
        if (sum == G) break;
        __builtin_amdgcn_s_sleep(1);
        if ((++sp & 255u) == 0u) { if (xb_ld(&bar[XB_TMO])) break; if (sp > XB_SPIN_CAP) { atomicAdd(&bar[XB_TMO], 1u); break; } }
    }
    nloc = mine > 0u ? mine : 1u; nx = cnt > 0u ? cnt : 1u;
}
__device__ __forceinline__ void xcd_barrier(const XcdBarrier& b) {
    asm volatile("s_waitcnt vmcnt(0)" ::: "memory");
    __syncthreads();
    if (threadIdx.x == 0) {
        unsigned* bar = b.bar;
        __builtin_amdgcn_s_waitcnt(0);
        unsigned nloc = b.st[0], nx = b.st[1];
        if (nloc == 0u) { xcd_barrier_complete(bar, b.x, nloc, nx); b.st[0] = nloc; b.st[1] = nx; }
        const unsigned old = xb_add(&bar[XB_XSUB(b.x)], 1u);
        const unsigned gen = old / nloc;
        if (old + 1u == (gen + 1u) * nloc) {
            __builtin_amdgcn_fence(__ATOMIC_RELEASE, "agent");
            asm volatile("s_waitcnt vmcnt(0)" ::: "memory");
            const unsigned og = xb_add(&bar[XB_TOP], 1u);
            const unsigned tg = og / nx;
            if (og + 1u == (tg + 1u) * nx) xb_add(&bar[XB_TOPGEN], 1u);
            else XB_SPIN(xb_ld(&bar[XB_TOPGEN]) == tg, bar);
            __builtin_amdgcn_fence(__ATOMIC_ACQUIRE, "agent");
            xb_add(&bar[XB_XGEN(b.x)], 1u);
            asm volatile("s_waitcnt vmcnt(0)" ::: "memory");
        } else {
            XB_SPIN(xb_ld(&bar[XB_XGEN(b.x)]) == gen, bar);
            __builtin_amdgcn_fence(__ATOMIC_ACQUIRE, "agent");
            asm volatile("s_waitcnt vmcnt(0)" ::: "memory");
        }
    }
    __syncthreads();
}

namespace pg8 {
constexpr int BM = 256, BK = 64, HALF = 128, HTB = HALF * BK * 2;
__host__ __device__ __forceinline__ int lds_byte(int r, int c) { const int st = (r >> 4) * 2 + (c >> 5), rr = r & 15, cc = c & 31, ob = rr * 64 + cc * 2; return st * 1024 + (ob ^ (((ob >> 9) & 1) << 5)); }
__host__ __device__ __forceinline__ void stage_rc(int b, int& R, int& C) { const int st = b / 1024, sb = b % 1024, swz = sb ^ (((sb >> 9) & 1) << 5); R = (st >> 1) * 16 + swz / 64; C = (st & 1) * 32 + (swz % 64) / 2; }
__host__ __device__ __forceinline__ int perm32(int rho) { const int n = rho >> 4, i = rho & 15; return 8 * (i >> 2) + 4 * n + (i & 3); }

struct Unit { int pm, pn, e, cnt, kind; };

typedef int v8i __attribute__((ext_vector_type(8)));
typedef int v4i __attribute__((ext_vector_type(4)));
template <class Epi, class Sched, bool F8ALL = false>
__device__ __forceinline__ void gemm_phase(LAS unsigned char* lds, const Sched& S, const Epi& E) {
    int tid = threadIdx.x; asm volatile("" : "+v"(tid));
    const int wid = __builtin_amdgcn_readfirstlane(tid >> 6), lane = tid & 63, wr = wid >> 2, wc = wid & 3, fr = lane & 15, fq = lane >> 4;
#define PG8_RC() int RA[2], CA[2], RB[2]; { int tl_ = tid; asm volatile("" : "+v"(tl_)); _Pragma("unroll") for (int i = 0; i < 2; ++i) { int R, C; stage_rc(tl_ * 16 + i * 8192, R, C); RA[i] = R; CA[i] = C; RB[i] = Epi::PERM ? ((R & ~31) + perm32(R & 31)) : R; } }
    const size_t kstep = (size_t)(BK * 2);
    const unsigned ldsw = (unsigned)wid * 1024u;
    const int aoff = lds_byte(wr * 64 + fr, fq * 8), boff = lds_byte(wc * 32 + fr, fq * 8);
#define PG8_SA(b, h) (((b) * 2 + (h)) * HTB)
#define PG8_SB(b, h) ((4 + (b) * 2 + (h)) * HTB)
#define PG8_STAGE2(bufoff, gbase, o0, o1) do { \
        __builtin_amdgcn_global_load_lds((const unsigned*)((const char*)(gbase) + (o0)), (LAS unsigned*)(lds + (bufoff) + ldsw), 16, 0, 0); \
        __builtin_amdgcn_global_load_lds((const unsigned*)((const char*)(gbase) + (o1)), (LAS unsigned*)(lds + (bufoff) + ldsw + 8192), 16, 0, 0); } while (0)
#define PG8_LD8(p) __builtin_shufflevector(*(const LAS v4i*)(p), *(const LAS v4i*)((p) + 1024), 0, 1, 2, 3, 4, 5, 6, 7)
#define PG8_LDA(dst, b, h) do { _Pragma("unroll") for (int m = 0; m < 4; ++m) dst[m] = PG8_LD8(lds + PG8_SA(b, h) + aoff + m * 2048); } while (0)
#define PG8_LDB(dst, b, h) do { _Pragma("unroll") for (int n = 0; n < 2; ++n) dst[n] = PG8_LD8(lds + PG8_SB(b, h) + boff + n * 2048); } while (0)
#define PG8_LO(x) __builtin_bit_cast(bf16x8, __builtin_shufflevector(x, x, 0, 1, 2, 3))
#define PG8_HI(x) __builtin_bit_cast(bf16x8, __builtin_shufflevector(x, x, 4, 5, 6, 7))
#define PG8_MMA(ai, bj, At, Bt) do { __builtin_amdgcn_s_setprio(1); \
        if (F8ALL) { _Pragma("unroll") for (int m = 0; m < 4; ++m) _Pragma("unroll") for (int n = 0; n < 2; ++n) \
            asm volatile("v_mfma_scale_f32_16x16x128_f8f6f4 %0, %1, %2, %0, %3, %3 op_sel_hi:[0,0,0]" : "+v"(acc[ai][bj][m][n]) : "v"(Bt[n]), "v"(At[m]), "v"(f8sc)); } \
        else { _Pragma("unroll") for (int m = 0; m < 4; ++m) _Pragma("unroll") for (int n = 0; n < 2; ++n) { \
            acc[ai][bj][m][n] = __builtin_amdgcn_mfma_f32_16x16x32_bf16(PG8_LO(Bt[n]), PG8_LO(At[m]), acc[ai][bj][m][n], 0, 0, 0); \
            acc[ai][bj][m][n] = __builtin_amdgcn_mfma_f32_16x16x32_bf16(PG8_HI(Bt[n]), PG8_HI(At[m]), acc[ai][bj][m][n], 0, 0, 0); } } \
        __builtin_amdgcn_s_setprio(0); } while (0)
#define PG8_WAIT_V(n) asm volatile("s_waitcnt vmcnt(" #n ")" ::: "memory")
#define PG8_WAIT_L(n) asm volatile("s_waitcnt lgkmcnt(" #n ")" ::: "memory")
#define PG8_BAR __builtin_amdgcn_s_barrier()
#define PG8_SCHED __builtin_amdgcn_sched_barrier(0)
    Unit cur, nxt; int ui = 0;
    if (!S.next(0, cur)) return;
    f32x4 acc[2][2][4][2];
#pragma unroll
    for (int a = 0; a < 2; ++a)
#pragma unroll
        for (int b = 0; b < 2; ++b)
#pragma unroll
            for (int m = 0; m < 4; ++m)
#pragma unroll
                for (int n = 0; n < 2; ++n) acc[a][b][m][n] = (f32x4){0.f, 0.f, 0.f, 0.f};
    v8i At[4], B0[2], B1[2];
    int f8sc = 0x7c7c7c7c; asm volatile("" : "+v"(f8sc));
    int Kc = S.K(cur), Kn; const char* Ac = S.a_base(cur); const char* An; const char* cB = S.b_ptr(cur); const char* nB;
    unsigned oc00, oc01, oc10, oc11, on00, on01, on10, on11, vbc0, vbc1, vbn0, vbn1; size_t hsc, hsn;
    { PG8_RC()
    oc00 = S.a_off(cur, RA[0], CA[0]); oc01 = S.a_off(cur, RA[1], CA[1]); oc10 = S.a_off(cur, HALF + RA[0], CA[0]); oc11 = S.a_off(cur, HALF + RA[1], CA[1]);
    vbc0 = (unsigned)(RB[0] * Kc + CA[0]) * 2u; vbc1 = (unsigned)(RB[1] * Kc + CA[1]) * 2u; hsc = (size_t)HALF * Kc * 2; }
    S.a_ready(cur);
    PG8_STAGE2(PG8_SB(0, 0), cB, vbc0, vbc1); PG8_STAGE2(PG8_SB(0, 1), cB + hsc, vbc0, vbc1); PG8_STAGE2(PG8_SA(0, 0), Ac, oc00, oc01); PG8_STAGE2(PG8_SA(0, 1), Ac, oc10, oc11);
    if (wr == 1) PG8_BAR;
    PG8_WAIT_V(2); PG8_BAR;
    PG8_STAGE2(PG8_SB(1, 0), cB + kstep, vbc0, vbc1); PG8_STAGE2(PG8_SA(1, 0), Ac + kstep, oc00, oc01); PG8_STAGE2(PG8_SB(1, 1), cB + hsc + kstep, vbc0, vbc1);
    PG8_WAIT_V(6); PG8_BAR;
    for (;;) {
        const bool has_next = S.next(ui + 1, nxt);
        Kn = Kc; An = Ac; nB = cB; on00 = oc00; on01 = oc01; on10 = oc10; on11 = oc11; vbn0 = vbc0; vbn1 = vbc1; hsn = hsc;
        if (has_next) { Kn = S.K(nxt); An = S.a_base(nxt); nB = S.b_ptr(nxt); PG8_RC()
            on00 = S.a_off(nxt, RA[0], CA[0]); on01 = S.a_off(nxt, RA[1], CA[1]); on10 = S.a_off(nxt, HALF + RA[0], CA[0]); on11 = S.a_off(nxt, HALF + RA[1], CA[1]);
            vbn0 = (unsigned)(RB[0] * Kn + CA[0]) * 2u; vbn1 = (unsigned)(RB[1] * Kn + CA[1]) * 2u; hsn = (size_t)HALF * Kn * 2; }
        const int nt = Kc / BK;
#pragma clang loop unroll(disable)
        for (int t = 0; t < nt; t += 2) {
            const bool last = (t == nt - 2);
            if (last && has_next) S.a_ready(nxt);
            const char* a1 = Ac + (size_t)(t + 1) * kstep;
            const char* a2 = last ? An : Ac + (size_t)(t + 2) * kstep; const char* b2 = last ? nB : cB + (size_t)(t + 2) * kstep;
            const char* a3 = a2 + kstep; const char* b3 = b2 + kstep;
            const unsigned x00 = last ? on00 : oc00, x01 = last ? on01 : oc01, x10 = last ? on10 : oc10, x11 = last ? on11 : oc11;
            const unsigned y0 = last ? vbn0 : vbc0, y1 = last ? vbn1 : vbc1; const size_t hs2 = last ? hsn : hsc;
            PG8_LDB(B0, 0, 0); PG8_LDB(B1, 0, 1); PG8_SCHED; PG8_LDA(At, 0, 0); PG8_STAGE2(PG8_SA(1, 1), a1, oc10, oc11);
            PG8_WAIT_V(8); PG8_WAIT_L(0); PG8_BAR; PG8_MMA(0, 0, At, B0); PG8_MMA(0, 1, At, B1); PG8_BAR; PG8_SCHED;
            PG8_LDA(At, 0, 1); PG8_STAGE2(PG8_SB(0, 0), b2, y0, y1); PG8_STAGE2(PG8_SB(0, 1), b2 + hs2, y0, y1); PG8_STAGE2(PG8_SA(0, 0), a2, x00, x01);
            PG8_WAIT_V(8); PG8_WAIT_L(0); PG8_BAR; PG8_MMA(1, 0, At, B0); PG8_MMA(1, 1, At, B1); PG8_BAR; PG8_SCHED;
            PG8_LDB(B0, 1, 0); PG8_LDB(B1, 1, 1); PG8_SCHED; PG8_LDA(At, 1, 0); PG8_STAGE2(PG8_SA(0, 1), a2, x10, x11);
            PG8_WAIT_V(8); PG8_WAIT_L(0); PG8_BAR; PG8_MMA(0, 0, At, B0); PG8_MMA(0, 1, At, B1); PG8_BAR; PG8_SCHED;
            PG8_LDA(At, 1, 1); PG8_STAGE2(PG8_SB(1, 0), b3, y0, y1); PG8_STAGE2(PG8_SB(1, 1), b3 + hs2, y0, y1); PG8_STAGE2(PG8_SA(1, 0), a3, x00, x01);
            PG8_WAIT_V(8); PG8_WAIT_L(0); PG8_BAR; PG8_MMA(1, 0, At, B0); PG8_MMA(1, 1, At, B1); PG8_BAR; PG8_SCHED;
        }
        if (wr == 0) PG8_BAR;
        if (F8ALL) asm volatile("s_nop 15\n\ts_nop 15" ::: "memory");
        E(acc, cur, wr, wc, fr, fq);
        if (!has_next) break;
#pragma unroll
        for (int a = 0; a < 2; ++a)
#pragma unroll
            for (int b = 0; b < 2; ++b)
#pragma unroll
                for (int m = 0; m < 4; ++m)
#pragma unroll
                    for (int n = 0; n < 2; ++n) acc[a][b][m][n] = (f32x4){0.f, 0.f, 0.f, 0.f};
        cur = nxt; Kc = Kn; Ac = An; cB = nB; oc00 = on00; oc01 = on01; oc10 = on10; oc11 = on11; vbc0 = vbn0; vbc1 = vbn1; hsc = hsn; ++ui;
        if (wr == 1) PG8_BAR;
    }
    PG8_WAIT_V(0);
    PG8_BAR;
#undef PG8_RC
#undef PG8_SA
#undef PG8_SB
#undef PG8_STAGE2
#undef PG8_LDA
#undef PG8_LD8
#undef PG8_LO
#undef PG8_HI
#undef PG8_LDB
#undef PG8_MMA
#undef PG8_WAIT_V
#undef PG8_WAIT_L
#undef PG8_BAR
#undef PG8_SCHED
}
}

__device__ __forceinline__ void store16_wt(void* p, v4u v) { asm volatile("global_store_dwordx4 %0, %1, off sc1\n\ts_nop 1" :: "v"(p), "v"(v) : "memory"); }
__device__ __forceinline__ int krow_of(int r) {
    if (r < T) return (r >> 12) * KVROWS + LCTX + (r & 4095);
    const int rc = r - T; return (rc >> 8) * KVROWS + (rc & 255);
}
struct SchedPlain {
    int nM, nN, G, vcu, Kk; const char* A; const char* B;
    __device__ __forceinline__ bool next(int i, pg8::Unit& u) const { const int L = i * G + vcu; if (L >= nM * nN) return false; u.pm = L / nN; u.pn = L % nN; u.e = 0; u.cnt = 256; u.kind = 0; return true; }
    __device__ __forceinline__ int K(const pg8::Unit&) const { return Kk; }
    __device__ __forceinline__ const char* a_base(const pg8::Unit&) const { return A; }
    __device__ __forceinline__ unsigned a_off(const pg8::Unit& u, int row, int col) const { return (unsigned)((u.pm * 256 + row) * Kk + col) * 2u; }
    __device__ __forceinline__ const char* b_ptr(const pg8::Unit& u) const { return B + (size_t)u.pn * 256 * Kk * 2; }
    __device__ __forceinline__ void a_ready(const pg8::Unit&) const {}
};
struct SchedG1 {
    int G, vcu, f8, lyr; const char* A; const char* B;
    __device__ __forceinline__ bool next(int i, pg8::Unit& u) const {
        const int nb16 = lyr ? T / 256 : TT / 256;
        u.e = 0; u.cnt = 256; u.kind = 0;
        if (!f8) { if (i > 0 || vcu >= nb16) return false; u.pm = vcu; u.pn = 0; return true; }
        const int nW = G - nb16; if (vcu < nb16) return false;
        const int L = i * nW + (vcu - nb16); const int nlat = (T / 256) * 5; const int ntot = nlat + (lyr ? 4 : 20);
        if (L >= ntot) return false;
        if (L < nlat) { u.pm = L / 5; u.pn = 1 + L % 5; }
        else if (lyr) { u.pm = T / 256 + (L - nlat); u.pn = 3; }
        else { u.pm = T / 256 + (L - nlat) / 5; u.pn = 1 + (L - nlat) % 5; }
        return true; }
    __device__ __forceinline__ int K(const pg8::Unit&) const { return f8 ? 512 : 1024; }
    __device__ __forceinline__ const char* a_base(const pg8::Unit&) const { return A; }
    __device__ __forceinline__ unsigned a_off(const pg8::Unit& u, int row, int col) const { return (unsigned)((u.pm * 256 + row) * (f8 ? 512 : 1024) + col) * 2u; }
    __device__ __forceinline__ const char* b_ptr(const pg8::Unit& u) const { return f8 ? B + (size_t)(u.pn - 1) * 256 * 1024 : B + (size_t)u.pn * 256 * 1024 * 2; }
    __device__ __forceinline__ void a_ready(const pg8::Unit&) const {}
};
struct EpiG1 {
    static constexpr bool PERM = true;
    bf16 *pu, *q, *kall, *vall, *z;
    __device__ __forceinline__ void operator()(const f32x4 (&acc)[2][2][4][2], const pg8::Unit& u, int wr, int wc, int fr, int fq) const {
        const int row0 = u.pm * 256 + wr * 64 + fr, c8 = wc * 32 + 8 * fq;
#pragma unroll
        for (int ai = 0; ai < 2; ++ai)
#pragma unroll
            for (int m = 0; m < 4; ++m) {
                const int row = row0 + ai * 128 + m * 16;
#pragma unroll
                for (int bj = 0; bj < 2; ++bj) {
                    const f32x4 v0 = acc[ai][bj][m][0], v1 = acc[ai][bj][m][1];
                    v4u w; w.x = pk2(v0[0], v0[1]); w.y = pk2(v0[2], v0[3]); w.z = pk2(v1[0], v1[1]); w.w = pk2(v1[2], v1[3]);
                    bf16* dst;
                    if (u.pn == 0) dst = pu + (size_t)row * 256 + bj * 128 + c8;
                    else if (u.pn <= 2) dst = q + (size_t)row * 512 + (u.pn - 1) * 256 + bj * 128 + c8;
                    else if (u.pn == 3) dst = (bj == 0 ? kall : vall) + (size_t)krow_of(row) * 128 + c8;
                    else dst = z + (size_t)row * 512 + (u.pn - 4) * 256 + bj * 128 + c8;
                    *(v4u*)dst = w;
                }
            }
    }
};
template <bool BB> struct EpiG2 {
    static constexpr bool PERM = true;
    const float* xin; const float* cin; bf16* xs; const float* mod; unsigned* ready;
    __device__ __forceinline__ void operator()(const f32x4 (&acc)[2][2][4][2], const pg8::Unit& u, int wr, int wc, int fr, int fq) const {
        const int rt0 = u.pm * 256; const bool isc = rt0 >= T;
        const int bsel = isc ? 4 : (rt0 >> 12);
        const float* g1 = mod + bsel * 6144 + 2048;
        const float* base = isc ? cin - (size_t)T * 1024 : xin;
        const int row0 = rt0 + wr * 64 + fr, c8 = u.pn * 256 + wc * 32 + 8 * fq;
#pragma unroll
        for (int bj = 0; bj < 2; ++bj) {
            const int col = c8 + bj * 128; const f32x4 ga = *(const f32x4*)(g1 + col), gb = *(const f32x4*)(g1 + col + 4);
            if (BB) {
                v4u b[2][4];
#pragma unroll
                for (int ai = 0; ai < 2; ++ai)
#pragma unroll
                    for (int m = 0; m < 4; ++m) b[ai][m] = *(const v4u*)(xs + (size_t)(row0 + ai * 128 + m * 16) * 1024 + col);
#pragma unroll
                for (int ai = 0; ai < 2; ++ai)
#pragma unroll
                    for (int m = 0; m < 4; ++m) { const v4u w = b[ai][m]; const f32x4 a0 = acc[ai][bj][m][0], a1 = acc[ai][bj][m][1];
                        v4u o; o.x = pk2(bflo(w.x) + ga[0] * a0[0], bfhi(w.x) + ga[1] * a0[1]); o.y = pk2(bflo(w.y) + ga[2] * a0[2], bfhi(w.y) + ga[3] * a0[3]);
                        o.z = pk2(bflo(w.z) + gb[0] * a1[0], bfhi(w.z) + gb[1] * a1[1]); o.w = pk2(bflo(w.w) + gb[2] * a1[2], bfhi(w.w) + gb[3] * a1[3]);
                        store16_wt(xs + (size_t)(row0 + ai * 128 + m * 16) * 1024 + col, o); }
            } else {
#pragma unroll
                for (int ai = 0; ai < 2; ++ai) {
                    f32x4 b0[4], b1[4];
#pragma unroll
                    for (int m = 0; m < 4; ++m) { const float* bp = base + (size_t)(row0 + ai * 128 + m * 16) * 1024 + col; b0[m] = *(const f32x4*)bp; b1[m] = *(const f32x4*)(bp + 4); }
#pragma unroll
                    for (int m = 0; m < 4; ++m) { const f32x4 x0 = b0[m] + ga * acc[ai][bj][m][0], x1 = b1[m] + gb * acc[ai][bj][m][1];
                        v4u o; o.x = pk2(x0[0], x0[1]); o.y = pk2(x0[2], x0[3]); o.z = pk2(x1[0], x1[1]); o.w = pk2(x1[2], x1[3]);
                        store16_wt(xs + (size_t)(row0 + ai * 128 + m * 16) * 1024 + col, o); }
                }
            }
        }
        asm volatile("s_waitcnt vmcnt(0)" ::: "memory");
        if ((threadIdx.x & 63) == 0) __hip_atomic_fetch_add(ready + 16 * u.pm, 1u, __ATOMIC_RELAXED, __HIP_MEMORY_SCOPE_AGENT);
    }
};
struct SchedMoe {
    int G, vcu, ntile;
    const char* hb; const char* actb; const char* wgu; const char* wd; const unsigned* list; const LAS int* tt; unsigned* ready; unsigned* tmo;
    __device__ __forceinline__ bool next(int i, pg8::Unit& u) const {
        const int U = ntile * 4; const int r = U % G, q = U / G; const int n3 = q + (vcu < r ? 1 : 0); int L;
        if (i < n3) { L = i * G + vcu; u.kind = 0; }
        else { const int j = i - n3; const int nl = G - r;
            if (vcu >= r) L = (j == 0) ? (vcu - r) : (j == 1) ? nl + (vcu - r) : 2 * nl + (j - 2) * G + vcu;
            else L = 2 * nl + j * G + vcu;
            if (L >= U) return false; u.kind = 1; }
        const int tau = L >> 2; u.pn = L & 3; u.pm = tau; int e = 0;
#pragma unroll
        for (int k = 1; k < 16; ++k) e += (tt[k] <= tau) ? 1 : 0;
        u.e = e; const int r0 = (tau - tt[e]) * 256; const int c = tt[17 + e] - r0; u.cnt = c < 256 ? c : 256; return true;
    }
    __device__ __forceinline__ int K(const pg8::Unit& u) const { return u.kind ? 256 : 512; }
    __device__ __forceinline__ const char* a_base(const pg8::Unit& u) const { return u.kind ? actb : hb; }
    __device__ __forceinline__ unsigned a_off(const pg8::Unit& u, int row, int col) const {
        if (u.kind) return (unsigned)((u.pm * 256 + row) * 256 + col) * 2u;
        const int r0 = (u.pm - tt[u.e]) * 256; const int rr = row < u.cnt ? row : u.cnt - 1;
        const unsigned tok = list[(size_t)u.e * TT + r0 + rr] >> 1;
        return (tok * 512u + (unsigned)col) * 2u;
    }
    __device__ __forceinline__ const char* b_ptr(const pg8::Unit& u) const { return u.kind ? wd + ((size_t)u.e * 1024 + (size_t)u.pn * 256) * 256 * 2 : wgu + ((size_t)u.e * 1024 + (size_t)u.pn * 256) * 512 * 2; }
    __device__ __forceinline__ void a_ready(const pg8::Unit& u) const {
        if (!u.kind) return;
        if (threadIdx.x < 64) {
            unsigned* w = ready + 16 * u.pm; unsigned sp = 0;
            while ((unsigned)__builtin_amdgcn_readfirstlane(__hip_atomic_load(w, __ATOMIC_RELAXED, __HIP_MEMORY_SCOPE_AGENT)) < 32u) {
                __builtin_amdgcn_s_sleep(2);
                if (++sp > (1u << 22)) { if (threadIdx.x == 0) __hip_atomic_store(tmo, 1u, __ATOMIC_RELAXED, __HIP_MEMORY_SCOPE_AGENT); break; } }
            __builtin_amdgcn_fence(__ATOMIC_ACQUIRE, "agent");
            asm volatile("s_waitcnt vmcnt(0)" ::: "memory");
        }
        asm volatile("" ::: "memory"); __builtin_amdgcn_s_barrier(); asm volatile("" ::: "memory");
    }
};
struct EpiG3 {
    static constexpr bool PERM = true;
    bf16* act; unsigned* ready;
    __device__ __forceinline__ void operator()(const f32x4 (&acc)[2][2][4][2], const pg8::Unit& u, int wr, int wc, int fr, int fq) const {
        const int row0 = u.pm * 256 + wr * 64 + fr, c8 = u.pn * 128 + wc * 32 + 8 * fq;
#pragma unroll
        for (int ai = 0; ai < 2; ++ai)
#pragma unroll
            for (int m = 0; m < 4; ++m) {
                float a[8];
#pragma unroll
                for (int n = 0; n < 2; ++n)
#pragma unroll
                    for (int k = 0; k < 4; ++k) { const float g = acc[ai][0][m][n][k], up = acc[ai][1][m][n][k]; a[n * 4 + k] = g * __builtin_amdgcn_rcpf(1.f + __builtin_amdgcn_exp2f(-LOG2E * g)) * up; }
                const unsigned long long w8 = (unsigned long long)pk4_f8(a[0], a[1], a[2], a[3]) | ((unsigned long long)pk4_f8(a[4], a[5], a[6], a[7]) << 32);
                __hip_atomic_store((unsigned long long*)((unsigned char*)act + (size_t)(row0 + ai * 128 + m * 16) * 512 + c8), w8, __ATOMIC_RELAXED, __HIP_MEMORY_SCOPE_AGENT);
            }
        asm volatile("s_waitcnt vmcnt(0)" ::: "memory");
        if ((threadIdx.x & 63) == 0) __hip_atomic_fetch_add(ready + 16 * u.pm, 1u, __ATOMIC_RELAXED, __HIP_MEMORY_SCOPE_AGENT);
    }
};
struct EpiG4 {
    static constexpr bool PERM = true;
    bf16* y2; const unsigned* list; const float* wts; const LAS int* tt;
    __device__ __forceinline__ void operator()(const f32x4 (&acc)[2][2][4][2], const pg8::Unit& u, int wr, int wc, int fr, int fq) const {
        const int r0 = (u.pm - tt[u.e]) * 256; const int c8 = u.pn * 256 + wc * 32 + 8 * fq;
        unsigned ent[2][4]; float w[2][4];
#pragma unroll
        for (int ai = 0; ai < 2; ++ai)
#pragma unroll
            for (int m = 0; m < 4; ++m) { const int row = wr * 64 + fr + ai * 128 + m * 16; ent[ai][m] = list[(size_t)u.e * TT + r0 + (row < u.cnt ? row : u.cnt - 1)]; }
#pragma unroll
        for (int ai = 0; ai < 2; ++ai)
#pragma unroll
            for (int m = 0; m < 4; ++m) w[ai][m] = wts[ent[ai][m]];
#pragma unroll
        for (int ai = 0; ai < 2; ++ai)
#pragma unroll
            for (int m = 0; m < 4; ++m) {
                const int row = wr * 64 + fr + ai * 128 + m * 16;
                if (row < u.cnt) {
#pragma unroll
                    for (int bj = 0; bj < 2; ++bj) {
                        const f32x4 v0 = acc[ai][bj][m][0] * w[ai][m], v1 = acc[ai][bj][m][1] * w[ai][m];
                        v4u o; o.x = pk2(v0[0], v0[1]); o.y = pk2(v0[2], v0[3]); o.z = pk2(v1[0], v1[1]); o.w = pk2(v1[2], v1[3]);
                        *(v4u*)(y2 + (size_t)ent[ai][m] * 1024 + bj * 128 + c8) = o;
                    }
                }
            }
    }
};

struct EpiMoe { static constexpr bool PERM = true; EpiG3 e3; EpiG4 e4;
    __device__ __forceinline__ void operator()(const f32x4 (&acc)[2][2][4][2], const pg8::Unit& u, int wr, int wc, int fr, int fq) const { if (u.kind) e4(acc, u, wr, wc, fr, fq); else e3(acc, u, wr, wc, fr, fq); } };

#include <hip/hip_bf16.h>
#include <cmath>
namespace attn_body {
using bf16=__hip_bfloat16;
using bf16x8=__attribute__((ext_vector_type(8)))short;
using s16x4=__attribute__((ext_vector_type(4)))short;
using f32x16=__attribute__((ext_vector_type(16)))float;
using u32x4=__attribute__((ext_vector_type(4)))unsigned;
constexpr int D=64,QP=512,KVP=128,OP=1024;
constexpr int NW=8,QBLK=32,KVBLK=64;
__device__ __forceinline__ int crow(int r,int hi){return (r&3)+8*(r>>2)+4*hi;}
#define SBAR() __builtin_amdgcn_sched_barrier(0)
__device__ __forceinline__ void wmask(f32x16&p0,f32x16&p1,int kp0,int qpos,int hi){
  const float NEG=-INFINITY; const bool tile_ok=(unsigned)kp0<4096u; const int base=kp0+4*hi-qpos+128;
  #pragma unroll
  for(int r=0;r<16;++r){const int dd=base+(r&3)+8*(r>>2); if(!tile_ok||(unsigned)dd>256u)p0[r]=NEG; if(!tile_ok||(unsigned)(dd+32)>256u)p1[r]=NEG;}
}
constexpr int NSLOT=3, SLOTB=8192;
constexpr int LDS_K=0, LDS_V=NSLOT*SLOTB, LDS_WS=2*NSLOT*SLOTB, LDS_OST=LDS_WS+NW*64*4, LDS_BYTES=LDS_OST+NW*4096;
constexpr float C2=0.125f*1.4426950408889634f;
__device__ __forceinline__ void glds16(const void*gsrc,unsigned lds_dst){unsigned keep;
  asm volatile("s_mov_b32 %0, m0\n\ts_mov_b32 m0, %2\n\ts_nop 0\n\tglobal_load_lds_dwordx4 %1, off\n\ts_mov_b32 m0, %0":"=&s"(keep):"v"(gsrc),"s"(lds_dst):"memory");}
__device__ __forceinline__ float max3f(float a,float b,float c){float r;asm("v_max3_f32 %0, %1, %2, %3":"=v"(r):"v"(a),"v"(b),"v"(c));return r;}
__device__ __forceinline__ float max2f(float a,float b){float r;asm("v_max_f32_e32 %0, %1, %2":"=v"(r):"v"(a),"v"(b));return r;}
__device__ __forceinline__ float fadd_s(float a,float b){float r;asm("v_add_f32_e32 %0, %1, %2":"=v"(r):"v"(a),"v"(b));return r;}
__device__ __forceinline__ float fsub_s(float a,float b){float r;asm("v_sub_f32_e32 %0, %1, %2":"=v"(r):"v"(a),"v"(b));return r;}
typedef float f32x2_t __attribute__((ext_vector_type(2))); typedef __bf16 bf16x2_t __attribute__((ext_vector_type(2)));
__device__ __forceinline__ unsigned cvtpk_s(float lo,float hi){f32x2_t v={lo,hi};bf16x2_t b=__builtin_convertvector(v,bf16x2_t);return __builtin_bit_cast(unsigned,b);}
#define WAIT_BAR(N) asm volatile("s_waitcnt vmcnt(" #N ") lgkmcnt(0)\n\ts_barrier":::"memory")

__device__ __forceinline__ void qkt(f32x16&p0,f32x16&p1,const char*Kslot,const bf16x8*qr,const f32x16&negm,int r32,int hi){
  const char*kb=Kslot+hi*1024+r32*16;
  #pragma unroll
  for(int d0=0;d0<4;++d0){
    const bf16x8 b0=*reinterpret_cast<const bf16x8*>(kb+d0*2048);
    const bf16x8 b1=*reinterpret_cast<const bf16x8*>(kb+d0*2048+512);
    if(d0==0){p0=__builtin_amdgcn_mfma_f32_32x32x16_bf16(b0,qr[0],negm,0,0,0);p1=__builtin_amdgcn_mfma_f32_32x32x16_bf16(b1,qr[0],negm,0,0,0);}
    else{p0=__builtin_amdgcn_mfma_f32_32x32x16_bf16(b0,qr[d0],p0,0,0,0);p1=__builtin_amdgcn_mfma_f32_32x32x16_bf16(b1,qr[d0],p1,0,0,0);}}
}
typedef __attribute__((address_space(3))) const char* lds_cptr;
typedef short v4i16_t __attribute__((ext_vector_type(4)));
__device__ __forceinline__ void kload8(bf16x8*kf,lds_cptr kp){
  kf[0]=*(const __attribute__((address_space(3))) bf16x8*)(kp);      kf[1]=*(const __attribute__((address_space(3))) bf16x8*)(kp+512);
  kf[2]=*(const __attribute__((address_space(3))) bf16x8*)(kp+2048); kf[3]=*(const __attribute__((address_space(3))) bf16x8*)(kp+2560);
  kf[4]=*(const __attribute__((address_space(3))) bf16x8*)(kp+4096); kf[5]=*(const __attribute__((address_space(3))) bf16x8*)(kp+4608);
  kf[6]=*(const __attribute__((address_space(3))) bf16x8*)(kp+6144); kf[7]=*(const __attribute__((address_space(3))) bf16x8*)(kp+6656);
}
__device__ __forceinline__ void kload2(bf16x8*kf,lds_cptr kp,int j){ kf[2*j]=*(const __attribute__((address_space(3))) bf16x8*)(kp+j*2048); kf[2*j+1]=*(const __attribute__((address_space(3))) bf16x8*)(kp+j*2048+512); }
__device__ __forceinline__ s16x4 vtr(lds_cptr p){ return __builtin_bit_cast(s16x4,__builtin_amdgcn_ds_read_tr16_b64_v4i16((__attribute__((address_space(3))) v4i16_t*)p)); }
__device__ __forceinline__ float rowmax(const f32x16&p0,const f32x16&p1){
  float a=max3f(p0[0],p0[1],p1[0]),b=max3f(p0[2],p0[3],p1[1]);a=max3f(a,p1[2],p1[3]);
  #pragma unroll
  for(int r=4;r<16;r+=4){a=max3f(a,p0[r],p0[r+1]);b=max3f(b,p0[r+2],p0[r+3]);a=max3f(a,p1[r],p1[r+1]);b=max3f(b,p1[r+2],p1[r+3]);}
  const float m=max2f(a,b);
  auto rr=__builtin_amdgcn_permlane32_swap(__float_as_uint(m),__float_as_uint(m),false,false);
  return max2f(__uint_as_float(rr[0]),__uint_as_float(rr[1]));
}
__device__ __forceinline__ void pv(f32x16*o,int vb,bf16x8 pa0,bf16x8 pa1,bf16x8 pa2,bf16x8 pa3){
  #pragma unroll
  for(int d0=0;d0<2;++d0){s16x4 lo[4],hi[4];
    #pragma unroll
    for(int ks=0;ks<4;++ks){
      asm volatile("ds_read_b64_tr_b16 %0,%1 offset:%c2":"=&v"(lo[ks]):"v"(vb),"i"(d0*4096+ks*1024):"memory");
      asm volatile("ds_read_b64_tr_b16 %0,%1 offset:%c2":"=&v"(hi[ks]):"v"(vb),"i"(d0*4096+ks*1024+512):"memory");}
    asm volatile("s_waitcnt lgkmcnt(0)":::"memory");SBAR();
    #define PK(k) (bf16x8){lo[k][0],lo[k][1],lo[k][2],lo[k][3],hi[k][0],hi[k][1],hi[k][2],hi[k][3]}
    o[d0]=__builtin_amdgcn_mfma_f32_32x32x16_bf16(pa0,PK(0),o[d0],0,0,0);
    o[d0]=__builtin_amdgcn_mfma_f32_32x32x16_bf16(pa1,PK(1),o[d0],0,0,0);
    o[d0]=__builtin_amdgcn_mfma_f32_32x32x16_bf16(pa2,PK(2),o[d0],0,0,0);
    o[d0]=__builtin_amdgcn_mfma_f32_32x32x16_bf16(pa3,PK(3),o[d0],0,0,0);
    #undef PK
  }
}

#ifndef ATTN_STORE16
#define ATTN_STORE16(p,v) (*(u32x4*)(p)=(v))
#endif
template<int THRL> __device__ __forceinline__ void attn_unit(const bf16*Qu,const bf16*__restrict__ Kh,const bf16*__restrict__ Vh,bf16*Ou,const int p0,const int NT,const float* sinkp,const float* qg,const float2* ropet,char*shm){
  int tid=threadIdx.x; asm volatile("":"+v"(tid)); const int lane=tid&63,r32=lane&31,hi=lane>>5; const int wid=__builtin_amdgcn_readfirstlane(tid>>6);
  const int hsub=wid>>1, psub=(wid&1)*QBLK;
  const bf16*Qw=Qu+(long)psub*QP+hsub*D;
  const unsigned lds0=(unsigned)(uintptr_t)shm;
  float*wsf=(float*)(shm+LDS_WS)+wid*64;
  const bf16*ksrc=Kh+(long)lane*KVP+wid*8;
  const bf16*vsrc=Vh+(long)(16*(wid&3)+(lane>>2))*KVP+(wid>>2)*32+(lane&3)*8;
  const unsigned kdst=lds0+LDS_K+wid*1024, vdst=lds0+LDS_V+wid*1024;
  #define KP0(t) (p0-128+64*((t)-4))
  #define TROW(t) ((t)<4?64*(t):(((unsigned)KP0(t)<4096u)?256+KP0(t):256))
  #define DMA_K(t,slot) glds16(ksrc+(long)TROW(t)*KVP,(unsigned)__builtin_amdgcn_readfirstlane(kdst+(slot)))
  #define DMA_V(t,slot) glds16(vsrc+(long)TROW(t)*KVP,(unsigned)__builtin_amdgcn_readfirstlane(vdst+(slot)))
  const int vb0=(int)(lds0+LDS_V)+((lane>>4)&1)*32+(lane&3)*8+(4*hi+((lane&15)>>2))*64;
  const char*Kbase=shm+LDS_K; bf16x8 kf[8];
  const lds_cptr shm3=(lds_cptr)shm; const lds_cptr kp0=shm3+LDS_K+hi*1024+r32*16; const lds_cptr vp0=shm3+LDS_V+((lane>>4)&1)*32+(lane&3)*8+(4*hi+((lane&15)>>2))*64;
  DMA_K(0,0);DMA_V(0,0);DMA_K(1,SLOTB);
  bf16x8 qr[4];
  { bf16x8 qraw[4];
    #pragma unroll
    for(int d0=0;d0<4;++d0)qraw[d0]=*reinterpret_cast<const bf16x8*>(&Qw[(long)r32*QP+d0*16+hi*8]);
    float qf[4][8]; float ss=0.f;
    #pragma unroll
    for(int d0=0;d0<4;++d0)
      #pragma unroll
      for(int j=0;j<8;++j){ qf[d0][j]=__builtin_bit_cast(float,(unsigned)(unsigned short)qraw[d0][j]<<16); ss+=qf[d0][j]*qf[d0][j]; }
    ss+=__shfl_xor(ss,32);
    const float rstd=1.0f/sqrtf(ss*(1.f/64.f)+1e-6f)*C2;
    #pragma unroll
    for(int d0=0;d0<4;++d0)
      #pragma unroll
      for(int j=0;j<8;++j) qf[d0][j]*=rstd*qg[16*d0+8*hi+j];
    if(ropet){ const float2* rp=ropet+(long)(p0+psub+r32)*32+8*hi;
      #pragma unroll
      for(int j=0;j<8;++j){ const float2 c1=rp[j],c2=rp[16+j];
        const float a=qf[0][j],b=qf[1][j],c=qf[2][j],d=qf[3][j];
        qf[0][j]=a*c1.x-b*c1.y; qf[1][j]=b*c1.x+a*c1.y; qf[2][j]=c*c2.x-d*c2.y; qf[3][j]=d*c2.x+c*c2.y; } }
    #pragma unroll
    for(int d0=0;d0<4;++d0){ u32x4 w; w[0]=cvtpk_s(qf[d0][0],qf[d0][1]); w[1]=cvtpk_s(qf[d0][2],qf[d0][3]); w[2]=cvtpk_s(qf[d0][4],qf[d0][5]); w[3]=cvtpk_s(qf[d0][6],qf[d0][7]); qr[d0]=__builtin_bit_cast(bf16x8,w); } }
  float mhat=0.f,l_reg=0.f;f32x16 o[2];o[0]=f32x16{};o[1]=f32x16{};f32x16 negm=f32x16{};asm volatile("":"+v"(negm));
  const int qpos=p0+psub+r32;
  #define CMASK(P0,P1,t) do{ if((t)>=4)wmask(P0,P1,KP0(t),qpos,hi); }while(0)
  bool resc=false;
  #define START(P0,P1) do{ const float rm=rowmax(P0,P1); resc=false; \
    { const float dl=rm; mhat=fadd_s(mhat,dl); \
      _Pragma("unroll") for(int r=0;r<16;++r){P0[r]=fsub_s(P0[r],dl);P1[r]=fsub_s(P1[r],dl);} \
      _Pragma("unroll") for(int r=0;r<16;++r)negm[r]=-mhat; asm volatile("":"+v"(negm)); } \
    _Pragma("unroll") for(int r=0;r<16;++r)P0[r]=__builtin_amdgcn_exp2f(P0[r]); }while(0)
  #define RESC() do{ if(resc){ asm volatile("s_waitcnt lgkmcnt(0)":::"memory"); \
      _Pragma("unroll") for(int d_=0;d_<2;++d_) _Pragma("unroll") for(int r=0;r<16;++r)o[d_][r]*=wsf[crow(r,hi)]; } }while(0)
  f32x16 pA0,pA1,pB0,pB1;
  int sl_prev=0,sl_cur=0,sl_next=SLOTB;
  #define ROT() do{sl_prev=sl_cur;sl_cur=sl_next;sl_next=(sl_next==(NSLOT-1)*SLOTB)?0:sl_next+SLOTB;}while(0)
  DMA_K(2,2*SLOTB);
  WAIT_BAR(3);
  qkt(pA0,pA1,Kbase,qr,negm,r32,hi);asm volatile("s_nop 15\n\ts_nop 7":"+v"(pA0),"+v"(pA1));CMASK(pA0,pA1,0);
  START(pA0,pA1);
  _Pragma("unroll") for(int r=0;r<16;++r)pA1[r]=__builtin_amdgcn_exp2f(pA1[r]);
  WAIT_BAR(0);
  DMA_K(3,0);DMA_V(1,SLOTB);
  ROT();
  kload8(kf,kp0+sl_cur);
  WAIT_BAR(2);
  s16x4 vlo[8],vhi[8]; u32x4 pw0,pw1,pw2,pw3;
  #define PKW(P,B) cvtpk_s(P[B],P[B+1])
  #define PAF(k) __builtin_bit_cast(bf16x8,pw##k)
  #define VFR(i) (bf16x8){vlo[i][0],vlo[i][1],vlo[i][2],vlo[i][3],vhi[i][0],vhi[i][1],vhi[i][2],vhi[i][3]}
  #define PIN(x) asm volatile("":"+v"(x))
  #define MX3(a,b,c) __builtin_fmaxf(__builtin_fmaxf((a),(b)),(c))
  #define GAPA(MF,A0,A1,A2,A3,W0,W1,PW) do{ MF; sacc+=A0; sacc+=A1; sacc+=A2; sacc+=A3; PIN(sacc); W0; W1; PIN(PW); SBAR(); }while(0)
  #define EX(v) __builtin_amdgcn_exp2f(v)
  #define GAPB(MF,X,B) do{ MF; X[B]=EX(X[B]); X[B+1]=EX(X[B+1]); X[B+2]=EX(X[B+2]); X[B+3]=EX(X[B+3]); PIN(X); SBAR(); }while(0)
  #define VRD(i) do{ vlo[i]=vtr(vp_+(((i)>>2)*4096+((i)&3)*1024)); vhi[i]=vtr(vp_+(((i)>>2)*4096+((i)&3)*1024+512)); }while(0)
  #define KRD(G,j) do{ if(G){ kload2(kf,kp0+sl_next,j); SBAR(); } }while(0)
  #define STEP(C0,C1,P0,P1,t,GK,GV,GL) do{ SBAR(); \
    const lds_cptr vp_=vp0+sl_prev; \
    VRD(0); SBAR(); float sacc=(P0[0]+P0[1]); \
    GAPA(C0=__builtin_amdgcn_mfma_f32_32x32x16_bf16(kf[0],qr[0],negm,0,0,0), P0[2],P0[3],P0[4],P0[5],     pw0[0]=PKW(P0,0), pw0[1]=PKW(P0,2), pw0); \
    VRD(4); SBAR(); GAPA(C1=__builtin_amdgcn_mfma_f32_32x32x16_bf16(kf[1],qr[0],negm,0,0,0), P0[6],P0[7],P0[8],P0[9],     pw0[2]=PKW(P0,4), pw0[3]=PKW(P0,6), pw0); \
    VRD(1); SBAR(); GAPA(C0=__builtin_amdgcn_mfma_f32_32x32x16_bf16(kf[2],qr[1],C0,0,0,0),   P0[10],P0[11],P0[12],P0[13], pw1[0]=PKW(P0,8), pw1[1]=PKW(P0,10), pw1); \
    VRD(5); SBAR(); GAPA(C1=__builtin_amdgcn_mfma_f32_32x32x16_bf16(kf[3],qr[1],C1,0,0,0),   P0[14],P0[15],P1[0],P1[1],   pw1[2]=PKW(P0,12),pw1[3]=PKW(P0,14), pw1); \
    VRD(2); SBAR(); GAPA(C0=__builtin_amdgcn_mfma_f32_32x32x16_bf16(kf[4],qr[2],C0,0,0,0),   P1[2],P1[3],P1[4],P1[5],     pw2[0]=PKW(P1,0), pw2[1]=PKW(P1,2), pw2); \
    VRD(6); SBAR(); GAPA(C1=__builtin_amdgcn_mfma_f32_32x32x16_bf16(kf[5],qr[2],C1,0,0,0),   P1[6],P1[7],P1[8],P1[9],     pw2[2]=PKW(P1,4), pw2[3]=PKW(P1,6), pw2); \
    VRD(3); SBAR(); GAPA(C0=__builtin_amdgcn_mfma_f32_32x32x16_bf16(kf[6],qr[3],C0,0,0,0),   P1[10],P1[11],P1[12],P1[13], pw3[0]=PKW(P1,8), pw3[1]=PKW(P1,10), pw3); \
    VRD(7); SBAR(); GAPA(C1=__builtin_amdgcn_mfma_f32_32x32x16_bf16(kf[7],qr[3],C1,0,0,0),   P1[14],P1[15],0.f,0.f,       pw3[2]=PKW(P1,12),pw3[3]=PKW(P1,14), pw3); \
    l_reg+=sacc; \
    if(GK){DMA_K((t)+3,sl_cur);} if(GV){DMA_V((t)+1,sl_next);} \
    CMASK(C0,C1,t); \
    { float a=MX3(C0[0],C0[1],C1[0]),b=MX3(C0[2],C0[3],C1[1]); a=MX3(a,C1[2],C1[3]); \
      _Pragma("unroll") for(int r=4;r<16;r+=4){a=MX3(a,C0[r],C0[r+1]);b=MX3(b,C0[r+2],C0[r+3]);a=MX3(a,C1[r],C1[r+1]);b=MX3(b,C1[r+2],C1[r+3]);} \
      float rm=__builtin_fmaxf(a,b); { auto rr=__builtin_amdgcn_permlane32_swap(__float_as_uint(rm),__float_as_uint(rm),false,false); rm=__builtin_fmaxf(__uint_as_float(rr[0]),__uint_as_float(rr[1])); } \
      resc=false; \
      if(__builtin_expect(__any(rm>(float)THRL),0)){ const float dl=__builtin_fmaxf(rm,0.f); mhat+=dl; \
        _Pragma("unroll") for(int r=0;r<16;++r){C0[r]-=dl;C1[r]-=dl;} \
        _Pragma("unroll") for(int r=0;r<16;++r)negm[r]=-mhat; asm volatile("":"+v"(negm)); \
        const float f=__builtin_amdgcn_exp2f(-dl); l_reg*=f; if(hi==0)wsf[r32]=f; resc=true; } } \
    SBAR(); \
    GAPB(o[0]=__builtin_amdgcn_mfma_f32_32x32x16_bf16(PAF(0),VFR(0),o[0],0,0,0), C0,0); \
    GAPB(o[1]=__builtin_amdgcn_mfma_f32_32x32x16_bf16(PAF(0),VFR(4),o[1],0,0,0), C0,4); \
    KRD(GL,0); GAPB(o[0]=__builtin_amdgcn_mfma_f32_32x32x16_bf16(PAF(1),VFR(1),o[0],0,0,0), C0,8); \
    KRD(GL,1); GAPB(o[1]=__builtin_amdgcn_mfma_f32_32x32x16_bf16(PAF(1),VFR(5),o[1],0,0,0), C0,12); \
    KRD(GL,2); GAPB(o[0]=__builtin_amdgcn_mfma_f32_32x32x16_bf16(PAF(2),VFR(2),o[0],0,0,0), C1,0); \
    KRD(GL,3); GAPB(o[1]=__builtin_amdgcn_mfma_f32_32x32x16_bf16(PAF(2),VFR(6),o[1],0,0,0), C1,4); \
    GAPB(o[0]=__builtin_amdgcn_mfma_f32_32x32x16_bf16(PAF(3),VFR(3),o[0],0,0,0), C1,8); \
    GAPB(o[1]=__builtin_amdgcn_mfma_f32_32x32x16_bf16(PAF(3),VFR(7),o[1],0,0,0), C1,12); \
    }while(0)
  int t=1;
  for(;t+5<NT;t+=2){
    STEP(pB0,pB1,pA0,pA1,t,true,true,true);     WAIT_BAR(2); RESC(); ROT();
    STEP(pA0,pA1,pB0,pB1,t+1,true,true,true);   WAIT_BAR(2); RESC(); ROT();
  }
  #define ENDW(tt) do{ if((tt)+3<NT){WAIT_BAR(2);} else if((tt)+2<NT){WAIT_BAR(1);} else {WAIT_BAR(0);} }while(0)
  for(;t+1<NT;t+=2){
    STEP(pB0,pB1,pA0,pA1,t,(t+3<NT),(t+1<NT),(t+1<NT));       ENDW(t);   RESC(); ROT();
    STEP(pA0,pA1,pB0,pB1,t+1,(t+4<NT),(t+2<NT),(t+2<NT));     ENDW(t+1); RESC(); ROT();
  }
  STEP(pB0,pB1,pA0,pA1,NT-1,false,false,false); RESC();
  { float sacc=pB0[0]+pB0[1]; _Pragma("unroll") for(int r=2;r<16;++r)sacc+=pB0[r]; _Pragma("unroll") for(int r=0;r<16;++r)sacc+=pB1[r]; l_reg+=sacc;
    pw0=(u32x4){PKW(pB0,0),PKW(pB0,2),PKW(pB0,4),PKW(pB0,6)};pw1=(u32x4){PKW(pB0,8),PKW(pB0,10),PKW(pB0,12),PKW(pB0,14)};pw2=(u32x4){PKW(pB1,0),PKW(pB1,2),PKW(pB1,4),PKW(pB1,6)};pw3=(u32x4){PKW(pB1,8),PKW(pB1,10),PKW(pB1,12),PKW(pB1,14)};
    SBAR(); pv(o,vb0+sl_cur,PAF(0),PAF(1),PAF(2),PAF(3)); }
  #undef PKW
  #undef PAF
  #undef VFR
  #undef PIN
  #undef MX3
  #undef GAPA
  #undef GAPB
  #undef EX
  #undef VRD
  #undef KRD
  #undef STEP
  #undef ENDW
  l_reg+=__shfl_xor(l_reg,32);
  l_reg+=__builtin_amdgcn_exp2f(sinkp[hsub]*1.4426950408889634f-mhat);
  if(hi==0)wsf[32+r32]=l_reg;asm volatile("s_waitcnt lgkmcnt(0)":::"memory");
  float rli[16];
  #pragma unroll
  for(int r=0;r<16;++r)rli[r]=__builtin_amdgcn_rcpf(wsf[32+crow(r,hi)]);
  bf16*Ow=Ou+(long)psub*OP+hsub*D;
  { bf16*stg=(bf16*)(shm+LDS_OST)+wid*2048;
    #pragma unroll
    for(int r=0;r<16;++r){const int orow=crow(r,hi);
      #pragma unroll
      for(int d0=0;d0<2;++d0)stg[orow*64+d0*32+r32]=__float2bfloat16(o[d0][r]*rli[r]);}
    asm volatile("s_waitcnt lgkmcnt(0)":::"memory");
    #pragma unroll
    for(int i=0;i<4;++i){const int row=i*8+(lane>>3),ch=lane&7; const u32x4 v=*(const u32x4*)(stg+row*64+ch*8); ATTN_STORE16(Ow+(long)row*OP+ch*8,v);} }
  asm volatile("s_waitcnt lgkmcnt(0)\n\ts_barrier":::"memory");
  #undef DMA_K
  #undef DMA_V
  #undef KP0
  #undef TROW
  #undef CMASK
  #undef START
  #undef RESC
  #undef ROT
}
constexpr int ATTN_LDS_BYTES=LDS_BYTES;
#undef SBAR
#undef WAIT_BAR
}

constexpr int SLAB_PITCH = 288;
typedef short v4i16_t __attribute__((ext_vector_type(4)));
template <int MT, class RowAddr, class Epi>
__device__ __forceinline__ void slab_gemm(LAS unsigned char* lds, const bf16* Cmat, const int K, const RowAddr& RA, const Epi& E) {
    int tid = threadIdx.x; asm volatile("" : "+v"(tid));
    const int wid = tid >> 6, lane = tid & 63;
    LAS bf16* Dr = (LAS bf16*)lds;
    f32x16 acc[MT];
#pragma unroll
    for (int i = 0; i < MT; ++i)
#pragma unroll
        for (int r = 0; r < 16; ++r) acc[i][r] = 0.f;
    const int g = (lane >> 4) & 1, h = lane >> 5, qq = (lane & 15) >> 2, pp = lane & 3;
    const LAS bf16* trp = Dr + (8 * h + qq) * SLAB_PITCH + wid * 32 + 16 * g + 4 * pp;
    for (int kc = 0; kc < K; kc += 128) {
        {
            const int k = tid >> 2, qd = tid & 3;
            const bf16* src = RA(kc + k) + qd * 64;
            v4u v[8];
#pragma unroll
            for (int j = 0; j < 8; ++j) v[j] = *(const v4u*)(src + j * 8);
#pragma unroll
            for (int j = 0; j < 8; ++j) *(LAS v4u*)(Dr + k * SLAB_PITCH + qd * 64 + j * 8) = v[j];
        }
        __syncthreads();
        const int kh = h * 8;
#pragma unroll
        for (int s = 0; s < 8; ++s) {
            const v4i16_t b0 = __builtin_amdgcn_ds_read_tr16_b64_v4i16((LAS v4i16_t*)(trp + (16 * s) * SLAB_PITCH));
            const v4i16_t b1 = __builtin_amdgcn_ds_read_tr16_b64_v4i16((LAS v4i16_t*)(trp + (16 * s + 4) * SLAB_PITCH));
            const bf16x8 bfrag = (bf16x8){b0[0], b0[1], b0[2], b0[3], b1[0], b1[1], b1[2], b1[3]};
#pragma unroll
            for (int mt = 0; mt < MT; ++mt) {
                const bf16x8 afrag = *(const bf16x8*)(Cmat + (size_t)(mt * 32 + (lane & 31)) * K + kc + s * 16 + kh);
                acc[mt] = __builtin_amdgcn_mfma_f32_32x32x16_bf16(afrag, bfrag, acc[mt], 0, 0, 0);
            }
        }
        __syncthreads();
    }
    E(acc, wid, lane, lds);
}

struct Args { const float* in[23]; float* out; unsigned char* ws; int ph_lo, ph_hi; };

constexpr int SOUT_PITCH = 264;
template <int NROWS, bool WT, class RowPtr>
__device__ __forceinline__ void slab_store_rows(LAS unsigned char* lds, const RowPtr& RP) {
    int tid = threadIdx.x; asm volatile("" : "+v"(tid));
    __syncthreads();
#pragma unroll
    for (int k = 0; k < NROWS / 16; ++k) { const int row = (tid >> 5) + 16 * k, chunk = tid & 31;
        const v4u v = *(const LAS v4u*)((LAS bf16*)lds + row * SOUT_PITCH + chunk * 8);
        bf16* dst = RP(row) + chunk * 8;
        if (WT) store16_wt(dst, v); else *(v4u*)dst = v; }
    __syncthreads();
}
struct RowA { const bf16* z; int b, n2; __device__ __forceinline__ const bf16* operator()(int k) const { return z + (size_t)(b * 4096 + 64 * (k & 63) + n2) * 512 + (k >> 6) * 256; } };
struct RowPA { bf16* t2; int b, n2; __device__ __forceinline__ bf16* operator()(int m) const { return t2 + ((size_t)((b * 64 + n2) * 64 + (m & 63)) * 2 + (m >> 6)) * 256; } };
template <bool WT> struct EpiA { bf16* t2; const float2* tw; int b, n2;
    __device__ __forceinline__ void operator()(const f32x16 (&acc)[4], int wid, int lane, LAS unsigned char* lds) const {
        const int ch = wid * 32 + (lane & 31); LAS bf16* so = (LAS bf16*)lds;
#pragma unroll
        for (int mt = 0; mt < 2; ++mt)
#pragma unroll
            for (int r = 0; r < 16; ++r) {
                const int k1 = 32 * mt + (r & 3) + 8 * (r >> 2) + 4 * (lane >> 5);
                const float2 cs = tw[n2 * k1]; const float re = acc[mt][r], im = acc[mt + 2][r];
                const float re2 = cs.x * re + cs.y * im, im2 = cs.x * im - cs.y * re;
                so[k1 * SOUT_PITCH + ch] = (bf16)f2bf(re2); so[(64 + k1) * SOUT_PITCH + ch] = (bf16)f2bf(im2);
            }
        RowPA rp{t2, b, n2}; slab_store_rows<128, WT, RowPA>(lds, rp);
    } };
struct RowB { const bf16* t2; int b, k1; __device__ __forceinline__ const bf16* operator()(int k) const { return t2 + ((size_t)((b * 64 + (k & 63)) * 64 + k1) * 2 + (k >> 6)) * 256; } };
struct RowPB { bf16* mrg; int b, k1; __device__ __forceinline__ bf16* operator()(int k2) const { return mrg + (size_t)(b * 4096 + k1 + 64 * k2) * 1024 + 768; } };
struct EpiB { bf16* mrg; int b, k1;
    __device__ __forceinline__ void operator()(const f32x16 (&acc)[2], int wid, int lane, LAS unsigned char* lds) const {
        const int ch = wid * 32 + (lane & 31); LAS bf16* so = (LAS bf16*)lds;
#pragma unroll
        for (int mt = 0; mt < 2; ++mt)
#pragma unroll
            for (int r = 0; r < 16; ++r) { const int k2 = 32 * mt + (r & 3) + 8 * (r >> 2) + 4 * (lane >> 5); so[k2 * SOUT_PITCH + ch] = (bf16)f2bf(DBG_NO_FOUR ? 0.f : acc[mt][r]); }
        RowPB rp{mrg, b, k1}; slab_store_rows<64, false, RowPB>(lds, rp);
    } };
struct RowC { const bf16* z; int b; __device__ __forceinline__ const bf16* operator()(int k) const { return z + (size_t)(T + b * 256 + (k & 255)) * 512 + (k >> 8) * 256; } };
struct RowPC { bf16* mrg; int b, mt0; __device__ __forceinline__ bf16* operator()(int kk) const { return mrg + (size_t)(T + b * 256 + 32 * mt0 + kk) * 1024 + 768; } };
struct EpiC { bf16* mrg; int b, mt0;
    __device__ __forceinline__ void operator()(const f32x16 (&acc)[1], int wid, int lane, LAS unsigned char* lds) const {
        const int ch = wid * 32 + (lane & 31); LAS bf16* so = (LAS bf16*)lds;
#pragma unroll
        for (int r = 0; r < 16; ++r) { const int kk = (r & 3) + 8 * (r >> 2) + 4 * (lane >> 5); so[kk * SOUT_PITCH + ch] = (bf16)f2bf(DBG_NO_FOUR ? 0.f : acc[0][r]); }
        RowPC rp{mrg, b, mt0}; slab_store_rows<32, false, RowPC>(lds, rp);
    } };

__device__ __forceinline__ void tr_block(const float* src, int ldS, bf16* dst, int ldD, LAS float* scr, int lane) {
#pragma unroll 8
    for (int i = 0; i < 32; ++i) { const int kk = 2 * i + (lane >> 5); scr[kk * 33 + (lane & 31)] = src[(size_t)kk * ldS + (lane & 31)]; }
    LDS_WAIT(); asm volatile("" ::: "memory");
    const int c = lane & 7;
#pragma unroll
    for (int j = 0; j < 4; ++j) { const int n = (lane >> 3) + 8 * j; const LAS float* s = scr + (8 * c) * 33 + n;
        v4u o; o.x = pk2(s[0 * 33], s[1 * 33]); o.y = pk2(s[2 * 33], s[3 * 33]); o.z = pk2(s[4 * 33], s[5 * 33]); o.w = pk2(s[6 * 33], s[7 * 33]);
        *(GAS v4u*)(dst + (size_t)n * ldD + 8 * c) = o; }
    LDS_WAIT(); asm volatile("" ::: "memory");
}


__device__ __forceinline__ void tr_block64(const float* src, int ldS, bf16* dst, int ldD, LAS bf16* scr, int lane) {
    const int kr = lane >> 4, nc = lane & 15;
    f32x4 v[16];
#pragma unroll
    for (int i = 0; i < 16; ++i) v[i] = *(const f32x4*)(src + (size_t)(4 * i + kr) * ldS + 4 * nc);
#pragma unroll
    for (int i = 0; i < 16; ++i) { const int k = 4 * i + kr;
#pragma unroll
        for (int j = 0; j < 4; ++j) scr[(4 * nc + j) * 66 + k] = (bf16)f2bf(v[i][j]); }
    LDS_WAIT(); asm volatile("" ::: "memory");
    const int c = lane & 7;
#pragma unroll
    for (int j = 0; j < 8; ++j) { const int n = (lane >> 3) + 8 * j; const LAS unsigned* p = (const LAS unsigned*)(scr + n * 66 + 8 * c);
        v4u o; o.x = p[0]; o.y = p[1]; o.z = p[2]; o.w = p[3];
        *(GAS v4u*)(dst + (size_t)n * ldD + 8 * c) = o; }
    LDS_WAIT(); asm volatile("" ::: "memory");
}

__device__ __forceinline__ void tr_block64_f8(const float* src, int ldS, unsigned char* dst, int ldD, LAS unsigned char* scr, int lane, float sc) {
    const int nq = lane & 15, kq0 = lane >> 4;
    f32x4 v[4][4];
#pragma unroll
    for (int sb = 0; sb < 4; ++sb)
#pragma unroll
        for (int r = 0; r < 4; ++r) v[sb][r] = *(const f32x4*)(src + (size_t)(4 * (kq0 + 4 * sb) + r) * ldS + 4 * nq);
#pragma unroll
    for (int sb = 0; sb < 4; ++sb)
#pragma unroll
        for (int j = 0; j < 4; ++j) *(LAS unsigned*)(scr + (4 * nq + j) * 68 + 4 * (kq0 + 4 * sb)) = pk4_f8(v[sb][0][j] * sc, v[sb][1][j] * sc, v[sb][2][j] * sc, v[sb][3][j] * sc);
    LDS_WAIT(); asm volatile("" ::: "memory");
    const int c = lane & 3;
#pragma unroll
    for (int jj = 0; jj < 4; ++jj) { const int n = (lane >> 2) + 16 * jj; const LAS unsigned* p = (const LAS unsigned*)(scr + n * 68 + 16 * c);
        v4u o; o.x = p[0]; o.y = p[1]; o.z = p[2]; o.w = p[3];
        *(GAS v4u*)(dst + (size_t)n * ldD + 16 * c) = o; }
    LDS_WAIT(); asm volatile("" ::: "memory");
}

template <int HW> __device__ __forceinline__ void pool_item(const bf16* up, bf16* op, const int n0, const int nseq) {
    constexpr int NR = 2 * HW + 7;
    v4u w[NR];
#pragma unroll
    for (int j = 0; j < NR; ++j) { const int t = n0 - HW + j; const int tc = t < 0 ? 0 : (t > nseq - 1 ? nseq - 1 : t); w[j] = *(const v4u*)(up + (size_t)tc * 256); }
#pragma unroll
    for (int j = 0; j < NR; ++j) { const int t = n0 - HW + j; if (t < 0 || t >= nseq) w[j] = (v4u){0u, 0u, 0u, 0u}; }
    float sm[8] = {0.f, 0.f, 0.f, 0.f, 0.f, 0.f, 0.f, 0.f};
#define POOL_ACC(W, SGN) do { sm[0] += SGN bflo(W.x); sm[1] += SGN bfhi(W.x); sm[2] += SGN bflo(W.y); sm[3] += SGN bfhi(W.y); sm[4] += SGN bflo(W.z); sm[5] += SGN bfhi(W.z); sm[6] += SGN bflo(W.w); sm[7] += SGN bfhi(W.w); } while (0)
#pragma unroll
    for (int j = 0; j < 2 * HW; ++j) POOL_ACC(w[j], +);
#pragma unroll
    for (int k = 0; k < 8; ++k) {
        const int n = n0 + k; int lo_ = n - HW; lo_ = lo_ < 0 ? 0 : lo_; int hi_ = n + HW - 1; hi_ = hi_ > nseq - 1 ? nseq - 1 : hi_;
        const v4u c = w[HW + k]; const float ic = 1.0f / (float)(hi_ - lo_ + 1);
        v4u o; o.x = pk2(sm[0] * ic - bflo(c.x), sm[1] * ic - bfhi(c.x)); o.y = pk2(sm[2] * ic - bflo(c.y), sm[3] * ic - bfhi(c.y));
        o.z = pk2(sm[4] * ic - bflo(c.z), sm[5] * ic - bfhi(c.z)); o.w = pk2(sm[6] * ic - bflo(c.w), sm[7] * ic - bfhi(c.w));
        if (DBG_NO_POOL) o = (v4u){0u, 0u, 0u, 0u};
        *(v4u*)(op + (size_t)k * 1024) = o;
        if (k < 7) { POOL_ACC(w[k + 2 * HW], +); POOL_ACC(w[k], -); }
    }
#undef POOL_ACC
}

typedef const __attribute__((address_space(4))) Args* kargs_t;
__device__ __forceinline__ kargs_t ka_launder() { kargs_t p = (kargs_t)__builtin_amdgcn_kernarg_segment_ptr(); asm volatile("" : "+s"(p)); return p; }
__device__ __forceinline__ int tid_launder() { int t = threadIdx.x; asm volatile("" : "+v"(t)); return t; }
#define KA_DECL const kargs_t KA = ka_launder(); const int tid = tid_launder(); const int lane = tid & 63; const int wave = __builtin_amdgcn_readfirstlane(tid >> 6); const int gw = vcu * 8 + wave; const int gt = vcu * 512 + tid; (void)lane; (void)wave; (void)gw; (void)gt;
#define ws (KA->ws)
#define ctl ((gu32*)(ws + O_CTL))
#define x_in (KA->in[0])
#define c_in (KA->in[1])
#define ctx_in (KA->in[2])
#define cctx_in (KA->in[3])
#define w_mod (KA->in[4])
#define b_mod (KA->in[5])
#define norm1_g (KA->in[6])
#define w_in (KA->in[7])
#define q_norm_g (KA->in[8])
#define k_norm_g (KA->in[9])
#define attn_sink (KA->in[10])
#define pool_w (KA->in[11])
#define pool_scale (KA->in[12])
#define four_w (KA->in[13])
#define w_out (KA->in[14])
#define norm2_g (KA->in[15])
#define w_grp (KA->in[16])
#define b_grp (KA->in[17])
#define w_rtr (KA->in[18])
#define b_rtr (KA->in[19])
#define w_gate (KA->in[20])
#define w_up (KA->in[21])
#define w_down (KA->in[22])
#define outp (KA->out)
#define modv ((float*)(ws + O_MOD))
#define rope ((float2*)(ws + O_ROPE))
#define twt ((float2*)(ws + O_TW))
#define fma ((bf16*)(ws + O_FMA))
#define fmb ((bf16*)(ws + O_FMB))
#define fmc ((bf16*)(ws + O_FMC))
#define hbuf ((bf16*)(ws + O_H))
#define kall ((bf16*)(ws + O_KALL))
#define vall ((bf16*)(ws + O_VALL))
#define xc ((float*)(ws + O_XC))
#define xb ((bf16*)(ws + O_XB))
#define list ((unsigned*)(ws + O_LIST))
#define wts ((float*)(ws + O_WTS))
#define act ((bf16*)(ws + O_ACT))
#define t2 ((bf16*)(ws + O_T2))
#define mrg ((bf16*)(ws + O_MRG))
#define qb ((bf16*)(ws + O_Q))
#define pu ((bf16*)(ws + O_PU))
#define zb ((bf16*)(ws + O_Z))
#define y2 ((bf16*)(ws + O_Y2))

#ifndef PH_MASK
#define PH_MASK 0x3ffff
#endif
#define IN(k) (lo <= (k) && (k) < hi && ((PH_MASK >> (k)) & 1))
#define SEAM(k) do { if (IN(k) && IN((k) + 1)) xcd_barrier(bar); } while (0)
#define modl (modv + (size_t)l * 5 * 6144)
#define win_t ((bf16*)(ws + O_WIN + l * SZ_WIN1))
#define wout_t ((bf16*)(ws + O_WOUT + l * SZ_WOUT1))
#define wgu_t ((bf16*)(ws + O_WGU + l * SZ_WGU1))
#define wd_t ((bf16*)(ws + O_WD + l * SZ_WD1))
constexpr int CV_A = 256, CV_B = 192, CV_C = 4096, CV_D = 2048, CV_L = CV_A + CV_B + CV_C + CV_D;
__device__ __forceinline__ void conv_item(const kargs_t KA, const int lw, int it, LAS bf16* scr, const int lane) {
    bf16* p_win_t = (bf16*)(ws + O_WIN + lw * SZ_WIN1); bf16* p_wout_t = (bf16*)(ws + O_WOUT + lw * SZ_WOUT1);
    bf16* p_wgu_t = (bf16*)(ws + O_WGU + lw * SZ_WGU1); bf16* p_wd_t = (bf16*)(ws + O_WD + lw * SZ_WD1);
    if (it < CV_A) { const int kb = it >> 4, nb = it & 15; const float* src = w_in + (size_t)lw * 1024 * 1280 + (size_t)kb * 64 * 1280 + nb * 64;
        if (nb < 4) tr_block64(src, 1280, p_win_t + (size_t)nb * 64 * 1024 + kb * 64, 1024, scr, lane);
        else tr_block64_f8(src, 1280, (unsigned char*)(ws + O_WIN8 + lw * SZ_WIN8) + (size_t)(nb * 64 - 256) * 1024 + kb * 64, 1024, (LAS unsigned char*)scr, lane, 64.0f);
        return; } it -= CV_A;
    if (it < CV_B) { const int kb = 4 + (it >> 4), nb = it & 15; tr_block64(w_out + (size_t)lw * 1024 * 1024 + (size_t)kb * 64 * 1024 + nb * 64, 1024, p_wout_t + (size_t)nb * 64 * 1024 + kb * 64, 1024, scr, lane); return; } it -= CV_B;
    if (it < CV_C) { const int up = it >> 11, r = it & 2047, e = r >> 7, kb = (r >> 3) & 15, nb = r & 7; const int n0 = nb * 64;
        const float* src = (up ? w_up : w_gate) + ((size_t)(lw * 16 + e) * 1024 + kb * 64) * 512 + n0;
        const int drow = (n0 >> 7) * 256 + up * 128 + (n0 & 127);
        tr_block64_f8(src, 512, (unsigned char*)p_wgu_t + ((size_t)e * 1024 + drow) * 1024 + kb * 64, 1024, (LAS unsigned char*)scr, lane, 64.0f); return; } it -= CV_C;
    { const int e = it >> 7, kb = (it >> 4) & 7, nb = it & 15;
        tr_block64_f8(w_down + ((size_t)(lw * 16 + e) * 512 + kb * 64) * 1024 + nb * 64, 1024, (unsigned char*)p_wd_t + ((size_t)e * 1024 + nb * 64) * 512 + kb * 64, 512, (LAS unsigned char*)scr, lane, 64.0f); }
}
__device__ __forceinline__ void steal_convert(const kargs_t KA, LAS unsigned char* lds, const int G, const int done_idx, const bool drain) {
    int tid = threadIdx.x; asm volatile("" : "+v"(tid));
    const int lane = tid & 63, wave = __builtin_amdgcn_readfirstlane(tid >> 6);
    volatile LAS int* mb = (volatile LAS int*)(lds + MISC_OFF + 64);
    LAS bf16* scr = (LAS bf16*)(lds + wave * 16384);
    __syncthreads();
    if (tid == 0 && !drain) __hip_atomic_fetch_add((unsigned*)(ctl + CW_DONE + 64 * done_idx), 1u, RLX_AGENT);
    for (;;) {
        if (tid == 0) { int idx = -1;
            const bool stop = !drain && __hip_atomic_load((unsigned*)(ctl + CW_DONE + 64 * done_idx), RLX_AGENT) >= (unsigned)(G - G / 4);
            if (!stop) idx = (int)__hip_atomic_fetch_add((unsigned*)(ctl + CW_Q), 8u, RLX_AGENT);
            mb[0] = idx; }
        __syncthreads();
        const int idx = mb[0];
        __syncthreads();
        if (idx < 0 || idx >= CV_L) break;
        if (idx + wave < CV_L) conv_item(KA, 1, idx + wave, scr, lane);
    }
    __syncthreads();
}

template <int l> __device__ __forceinline__ void layer_body(LAS unsigned char* lds, const int G, const int vcu, const XcdBarrier& bar, const int lo, const int hi) {
    const int NGW = G * 8, NGT = G * 512; LAS int* ttab = (LAS int*)(lds + TILE_OFF);
    constexpr int P = 1 + 8 * l;

        for (int rep_ = 0; rep_ < 1 + ((l == 0) ? ((REP_MASK >> (1 + 0)) & 1) : 0); ++rep_)
        if (IN(P + 0)) {
            KA_DECL
            const float* modp = modv;
            if (l == 1) steal_convert(KA, lds, G, 3, true);
#pragma clang loop vectorize(disable) unroll(disable)
            for (int r0 = gw; r0 < TT; r0 += 2 * NGW) {
                const int r1 = r0 + NGW; const bool has1 = r1 < TT;
                f32x4 va[4], vb[4]; v2u yaa[4], yab[4], yba[4], ybb[4];
                if (l == 0) {
                    const float* srca; const float* srcb;
                    { const bool isc = r0 >= T; srca = isc ? ctx_in + (size_t)(r0 - T) * 1024 : x_in + (size_t)r0 * 1024; }
                    { const int rr = has1 ? r1 : r0; const bool isc = rr >= T; srcb = isc ? ctx_in + (size_t)(rr - T) * 1024 : x_in + (size_t)rr * 1024; }
#pragma unroll
                    for (int j = 0; j < 4; ++j) { va[j] = *(const f32x4*)(srca + 4 * lane + 256 * j); vb[j] = *(const f32x4*)(srcb + 4 * lane + 256 * j); }
                } else {
                    const int rr = has1 ? r1 : r0;
#pragma unroll
                    for (int j = 0; j < 4; ++j) { const v2u wa = *(const v2u*)(xb + (size_t)r0 * 1024 + 4 * lane + 256 * j), wb = *(const v2u*)(xb + (size_t)rr * 1024 + 4 * lane + 256 * j);
                        va[j] = (f32x4){bflo(wa.x), bfhi(wa.x), bflo(wa.y), bfhi(wa.y)}; vb[j] = (f32x4){bflo(wb.x), bfhi(wb.x), bflo(wb.y), bfhi(wb.y)}; }
                }
                if (l == 1) {
                    const int rr = has1 ? r1 : r0;
#pragma unroll
                    for (int j = 0; j < 4; ++j) { yaa[j] = *(const v2u*)(y2 + (size_t)(2 * r0) * 1024 + 4 * lane + 256 * j); yab[j] = *(const v2u*)(y2 + (size_t)(2 * r0 + 1) * 1024 + 4 * lane + 256 * j);
                        yba[j] = *(const v2u*)(y2 + (size_t)(2 * rr) * 1024 + 4 * lane + 256 * j); ybb[j] = *(const v2u*)(y2 + (size_t)(2 * rr + 1) * 1024 + 4 * lane + 256 * j); }
                }
#pragma unroll
                for (int half = 0; half < 2; ++half) {
                    if (half == 1 && !has1) break;
                    const int r = half ? r1 : r0; f32x4 (&v)[4] = half ? vb : va; v2u (&ya)[4] = half ? yba : yaa; v2u (&yb)[4] = half ? ybb : yab;
                    const bool isc = r >= T; const int bsel = isc ? 4 : (r >> 12);
                    if (l == 1) {
                        const float* g2 = modp + bsel * 6144 + 5 * 1024; bf16* dst = xb + (size_t)r * 1024;
#pragma unroll
                        for (int j = 0; j < 4; ++j) {
                            const f32x4 gv = *(const f32x4*)(g2 + 4 * lane + 256 * j);
                            f32x4 yy; yy[0] = bflo(ya[j].x) + bflo(yb[j].x); yy[1] = bfhi(ya[j].x) + bfhi(yb[j].x); yy[2] = bflo(ya[j].y) + bflo(yb[j].y); yy[3] = bfhi(ya[j].y) + bfhi(yb[j].y);
                            if (DBG_NO_MOE) yy = (f32x4){0.f, 0.f, 0.f, 0.f};
                            v[j] = v[j] + gv * yy; { v2u o; o.x = pk2(v[j][0], v[j][1]); o.y = pk2(v[j][2], v[j][3]); *(v2u*)(dst + 4 * lane + 256 * j) = o; }
                        }
                    }
                    float ss = 0.f;
#pragma unroll
                    for (int j = 0; j < 4; ++j) ss += (v[j][0] * v[j][0] + v[j][1] * v[j][1]) + (v[j][2] * v[j][2] + v[j][3] * v[j][3]);
                    const float rstd = 1.0f / sqrtf(wave_sum(ss) * (1.f / 1024.f) + 1e-6f);
                    const float* sh = modl + bsel * 6144; const float* sc = sh + 1024; const float* gn = norm1_g + l * 1024;
#pragma unroll
                    for (int j = 0; j < 4; ++j) {
                        const int c0 = 4 * lane + 256 * j; const f32x4 g = *(const f32x4*)(gn + c0), s1 = *(const f32x4*)(sc + c0), h1 = *(const f32x4*)(sh + c0);
                        const f32x4 y = (v[j] * rstd) * g * (s1 + 1.0f) + h1;
                        v2u o; o.x = pk2(y[0], y[1]); o.y = pk2(y[2], y[3]); *(v2u*)(hbuf + (size_t)r * 1024 + c0) = o;
                        *(unsigned*)((unsigned char*)(ws + O_ACT) + (size_t)r * 1024 + c0) = pk4_f8(y[0], y[1], y[2], y[3]);
                    }
                }
            }
        }
        SEAM(P + 0);
        for (int rep_ = 0; rep_ < 1 + ((l == 0) ? ((REP_MASK >> (1 + 1)) & 1) : 0); ++rep_)
        if (IN(P + 1)) {
            KA_DECL
            EpiG1 E{pu, qb, kall, vall, zb};
            { SchedG1 S{G, vcu, 0, l, (const char*)hbuf, (const char*)win_t}; pg8::gemm_phase<EpiG1, SchedG1, false>(lds, S, E); }
            { SchedG1 S{G, vcu, 1, l, (const char*)(ws + O_ACT), (const char*)(ws + O_WIN8 + l * SZ_WIN8)}; pg8::gemm_phase<EpiG1, SchedG1, true>(lds, S, E); }
            if (l == 0 && !MK_SPLIT) steal_convert(KA, lds, G, 0, false);
        }
        SEAM(P + 1);
        if (IN(P + 3)) {
            KA_DECL
            gu32* kflag = ctl + CW_KF + l * 16384;
            gu32* facnt = ctl + CW_FA + l * 64;
            for (int it = vcu; it < 256; it += G) {
                const int b = it >> 6, n2 = it & 63;
                RowA ra{zb, b, n2}; EpiA<true> ea{t2, twt, b, n2};
                slab_gemm<4, RowA, EpiA<true>>(lds, fma, 128, ra, ea);
                asm volatile("s_waitcnt vmcnt(0)" ::: "memory");
                __syncthreads();
                if (tid == 0) __hip_atomic_fetch_add((unsigned*)(facnt + 16 * b), 1u, RLX_AGENT);
            }
            const int n_att = 512 + (l == 0 ? 32 : 0);
            for (int it = vcu; it < n_att; it += G) {
                const bool cu = it >= 512; const int uidx = cu ? it - 512 : it;
                const int b = cu ? (uidx >> 3) : (uidx >> 7), kvh = cu ? ((uidx >> 2) & 1) : ((uidx >> 6) & 1), pb = cu ? (uidx & 3) : (uidx & 63);
                const int p0 = pb * 64; const int qrow0 = cu ? T + b * 256 + p0 : b * 4096 + p0;
                if (!cu) {
                    const int row = tid >> 3, c = tid & 7;
                    const float* kg = k_norm_g + l * 64 + 8 * c;
#pragma unroll
                    for (int part = 0; part < 2; ++part) {
                        if (part == 1 && pb >= 4) break;
                        const int blk = part ? pb : 4 + pb;
                        bf16* p = kall + ((size_t)b * KVROWS + blk * 64 + row) * 128 + kvh * 64 + c * 8;
                        const v4u w = *(const v4u*)p;
                        float x[8] = {bflo(w.x), bfhi(w.x), bflo(w.y), bfhi(w.y), bflo(w.z), bfhi(w.z), bflo(w.w), bfhi(w.w)};
                        float ss = 0.f;
#pragma unroll
                        for (int i = 0; i < 8; ++i) ss += x[i] * x[i];
                        ss += __shfl_xor(ss, 1); ss += __shfl_xor(ss, 2); ss += __shfl_xor(ss, 4);
                        const float rstd = 1.0f / sqrtf(ss * (1.f / 64.f) + 1e-6f);
#pragma unroll
                        for (int i = 0; i < 8; ++i) x[i] *= rstd * kg[i];
                        if (part == 0) {
                            const float2* rp = rope + (size_t)(p0 + row) * 32 + ((c & 4) ? 16 : 0) + (c & 1) * 8;
#pragma unroll
                            for (int i = 0; i < 8; ++i) { const float y = __shfl_xor(x[i], 2); const float2 cs = rp[i]; x[i] = (c & 2) ? (x[i] * cs.x + y * cs.y) : (x[i] * cs.x - y * cs.y); }
                        }
                        v4u o; o.x = pk2(x[0], x[1]); o.y = pk2(x[2], x[3]); o.z = pk2(x[4], x[5]); o.w = pk2(x[6], x[7]);
                        store16_wt(p, o);
                    }
                    asm volatile("s_waitcnt vmcnt(0)" ::: "memory");
                    __syncthreads();
                    if (tid == 0) { __hip_atomic_store(kflag + 16 * ((b * 68 + 4 + pb) * 2 + kvh), 1u, RLX_AGENT); if (pb < 4) __hip_atomic_store(kflag + 16 * ((b * 68 + pb) * 2 + kvh), 1u, RLX_AGENT); }
                }
                if (tid < 64) {
                    int blk = -1;
                    if (lane < 4) blk = lane; else if (!cu && lane < 9) { const int q = pb + lane - 6; if (q >= 0 && q < 64) blk = 4 + q; }
                    unsigned sp = 0;
                    for (;;) { const unsigned f = (blk >= 0) ? __hip_atomic_load(kflag + 16 * ((b * 68 + blk) * 2 + kvh), RLX_AGENT) : 1u;
                        if (__all(f != 0u)) break; __builtin_amdgcn_s_sleep(2);
                        if (++sp > (1u << 22)) { if (tid == 0) __hip_atomic_store(ctl + CW_TMO, 2u, RLX_AGENT); break; } }
                    __builtin_amdgcn_fence(__ATOMIC_ACQUIRE, "agent");
                    asm volatile("s_waitcnt vmcnt(0)" ::: "memory");
                }
                __syncthreads();
                const attn_body::bf16* Qu = (const attn_body::bf16*)(qb + (size_t)qrow0 * 512 + kvh * 256);
                const attn_body::bf16* Kh = (const attn_body::bf16*)(kall + (size_t)b * KVROWS * 128 + kvh * 64);
                const attn_body::bf16* Vh = (const attn_body::bf16*)(vall + (size_t)b * KVROWS * 128 + kvh * 64);
                attn_body::bf16* Ou = (attn_body::bf16*)(mrg + (size_t)qrow0 * 1024 + 256 + kvh * 256);
                attn_body::attn_unit<8>(Qu, Kh, Vh, Ou, p0, cu ? 4 : 10, attn_sink + l * 8 + kvh * 4, q_norm_g + l * 64, cu ? (const float2*)nullptr : (const float2*)rope, (char*)lds);
                __syncthreads();
            }
            const int prow = (l == 0) ? TT : T; const int nrb = prow >> 3;
#pragma clang loop vectorize(disable) unroll(disable)
            for (int i = gt; i < 32 * nrb; i += NGT) {
                const int ck8 = i & 7, rb = (i >> 3) % nrb, g = (i >> 3) / nrb;
                const int r0 = rb * 8; const bool isc = r0 >= T;
                const int nseq = isc ? LCTX : NSEQ; const int rbase = isc ? T + ((r0 - T) & ~255) : (r0 & ~4095); const int n0 = r0 - rbase;
                const int col = g * 64 + ck8 * 8;
                const bf16* up = pu + (size_t)rbase * 256 + col; bf16* op = mrg + (size_t)(rbase + n0) * 1024 + col;
                if (g == 0) pool_item<1>(up, op, n0, nseq); else if (g == 1) pool_item<2>(up, op, n0, nseq); else if (g == 2) pool_item<4>(up, op, n0, nseq); else pool_item<8>(up, op, n0, nseq);
            }
            for (int it = vcu; it < 256; it += G) {
                const int b = it >> 6, k1 = it & 63;
                __syncthreads();
                if (tid < 64) { unsigned sp = 0;
                    while ((unsigned)__builtin_amdgcn_readfirstlane(__hip_atomic_load((unsigned*)(facnt + 16 * b), RLX_AGENT)) < 64u) { __builtin_amdgcn_s_sleep(2); if (++sp > (1u << 22)) { if (tid == 0) __hip_atomic_store(ctl + CW_TMO, 3u, RLX_AGENT); break; } }
                    __builtin_amdgcn_fence(__ATOMIC_ACQUIRE, "agent");
                    asm volatile("s_waitcnt vmcnt(0)" ::: "memory"); }
                __syncthreads();
                RowB rb{t2, b, k1}; EpiB eb{mrg, b, k1};
                slab_gemm<2, RowB, EpiB>(lds, fmb, 128, rb, eb);
            }
            if (l == 0) for (int it = (G - 1 - vcu); it < 32; it += G) {
                const int b = it >> 3, mt0 = it & 7;
                RowC rc{zb, b}; EpiC ec{mrg, b, mt0};
                slab_gemm<1, RowC, EpiC>(lds, fmc + (size_t)mt0 * 32 * 512, 512, rc, ec);
            }
        }
        SEAM(P + 3);
        if (IN(P + 4)) {
            KA_DECL
            unsigned* g2rdy = (unsigned*)(ctl + CW_G2 + l * 2048);
            {
                SchedPlain S{(l == 0 ? TT : T) / 256, 4, G, vcu, 1024, (const char*)mrg, (const char*)wout_t};
                EpiG2<(l != 0)> E{x_in, ctx_in, xb, modl, g2rdy};
                pg8::gemm_phase<EpiG2<(l != 0)>, SchedPlain>(lds, S, E);
            }
            const int rep_ = 0;
            __syncthreads();
            LAS float* rw = (LAS float*)lds;
            LAS int* lcnt = (LAS int*)(lds + 81920);
            LAS unsigned* lent = (LAS unsigned*)(lds + 81920 + 256);
            LAS unsigned* lrank = lent + 1024;
            { const float* rwg = (const float*)(ws + O_RW) + l * 20480;
#pragma unroll
              for (int i = 0; i < 10; ++i) { const int idx = tid + 512 * i; *(LAS f32x4*)(rw + 4 * idx) = *(const f32x4*)(rwg + 4 * idx); } }
            if (tid < 33) lcnt[tid] = 0;
            if (tid < 64) { unsigned sp = 0; unsigned* w = g2rdy + 16 * (vcu >> 2);
                while ((unsigned)__builtin_amdgcn_readfirstlane(__hip_atomic_load(w, RLX_AGENT)) < 32u) { __builtin_amdgcn_s_sleep(2); if (++sp > (1u << 22)) { if (tid == 0) __hip_atomic_store(ctl + CW_TMO, 4u, RLX_AGENT); break; } }
                __builtin_amdgcn_fence(__ATOMIC_ACQUIRE, "agent");
                asm volatile("s_waitcnt vmcnt(0)" ::: "memory"); }
            __syncthreads();
            const bool dbl = (l == 0) && (G == 256) && (vcu < 16);
            const int ngl = 16 + ((l == 0) ? 1 : 0) + (((l == 0) && (G == 256)) ? 2 : 0);
#pragma clang loop vectorize(disable) unroll(disable)
            for (int gix = wave; gix < ngl; gix += 8) {
                int q;
                if (gix < 16) { if (dbl) continue; q = 16 * vcu + gix; }
                else if (gix == 16) q = T / 4 + vcu;
                else { if (dbl) continue; const int o = (gix == 17) ? (vcu - 16) : (240 + vcu - 16); if (o >= 256 || (gix == 18 && vcu >= 32)) continue; q = o; }
                if (gix >= 17) {
                    unsigned sp = 0; unsigned* w = g2rdy + 16 * (q >> 6);
                    while ((unsigned)__builtin_amdgcn_readfirstlane(__hip_atomic_load(w, RLX_AGENT)) < 32u) { __builtin_amdgcn_s_sleep(2); if (++sp > (1u << 22)) { if (lane == 0) __hip_atomic_store(ctl + CW_TMO, 6u, RLX_AGENT); break; } }
                    __builtin_amdgcn_fence(__ATOMIC_ACQUIRE, "agent");
                    asm volatile("s_waitcnt vmcnt(0)" ::: "memory"); }
                if (gix == 16) { unsigned sp = 0; unsigned* w = g2rdy + 16 * (64 + (vcu >> 6));
                    while ((unsigned)__builtin_amdgcn_readfirstlane(__hip_atomic_load(w, RLX_AGENT)) < 32u) { __builtin_amdgcn_s_sleep(2); if (++sp > (1u << 22)) { if (lane == 0) __hip_atomic_store(ctl + CW_TMO, 5u, RLX_AGENT); break; } }
                    __builtin_amdgcn_fence(__ATOMIC_ACQUIRE, "agent");
                    asm volatile("s_waitcnt vmcnt(0)" ::: "memory"); }
                const int rb4 = 4 * q; const bool isc = rb4 >= T; const int bsel = isc ? 4 : (rb4 >> 12);
                const bf16* src = xb + (size_t)rb4 * 1024;
                f32x4 v[4][4];
#pragma unroll
                for (int tk = 0; tk < 4; ++tk)
#pragma unroll
                    for (int j = 0; j < 4; ++j) { const v2u w = *(const v2u*)(src + (size_t)tk * 1024 + 4 * lane + 256 * j); v[tk][j] = (f32x4){bflo(w.x), bfhi(w.x), bflo(w.y), bfhi(w.y)}; }
                float rstd[4];
#pragma unroll
                for (int tk = 0; tk < 4; ++tk) { float ss = 0.f;
#pragma unroll
                    for (int j = 0; j < 4; ++j) ss += (v[tk][j][0] * v[tk][j][0] + v[tk][j][1] * v[tk][j][1]) + (v[tk][j][2] * v[tk][j][2] + v[tk][j][3] * v[tk][j][3]);
                    rstd[tk] = 1.0f / sqrtf(wave_sum(ss) * (1.f / 1024.f) + 1e-6f); }
                const float* sh = modl + bsel * 6144 + 3 * 1024; const float* sc = sh + 1024; const float* gn = norm2_g + l * 1024;
                f32x2 lg[4][10];
#pragma unroll
                for (int tk = 0; tk < 4; ++tk)
#pragma unroll
                    for (int j = 0; j < 10; ++j) lg[tk][j] = (f32x2){0.f, 0.f};
#pragma unroll
                for (int j = 0; j < 4; ++j) {
                    const int c0 = 4 * lane + 256 * j; const f32x4 g = *(const f32x4*)(gn + c0), s1 = *(const f32x4*)(sc + c0), h1 = *(const f32x4*)(sh + c0);
                    f32x4 y[4];
#pragma unroll
                    for (int tk = 0; tk < 4; ++tk) { y[tk] = (v[tk][j] * rstd[tk]) * g * (s1 + 1.0f) + h1;
                        *(unsigned*)((unsigned char*)hbuf + (size_t)(rb4 + tk) * 1024 + c0) = pk4_f8(y[tk][0], y[tk][1], y[tk][2], y[tk][3]); }
#pragma unroll
                    for (int e = 0; e < 4; ++e) {
#pragma unroll
                        for (int q5 = 0; q5 < 5; ++q5) { const f32x4 wv = *(const LAS f32x4*)(rw + (((q5 * 4 + j) * 4 + e) * 64 + lane) * 4);
                            const f32x2 w01 = {wv[0], wv[1]}, w23 = {wv[2], wv[3]};
#pragma unroll
                            for (int tk = 0; tk < 4; ++tk) { const f32x2 ys = {y[tk][e], y[tk][e]}; lg[tk][2 * q5] = __builtin_elementwise_fma(ys, w01, lg[tk][2 * q5]); lg[tk][2 * q5 + 1] = __builtin_elementwise_fma(ys, w23, lg[tk][2 * q5 + 1]); } }
                        __builtin_amdgcn_sched_barrier(0); }
                }
                float l2[20];
#pragma unroll
                for (int j = 0; j < 20; ++j) {
                    const float a0 = swap32_sum(lg[0][j >> 1][j & 1], lg[2][j >> 1][j & 1]);
                    const float a1 = swap32_sum(lg[1][j >> 1][j & 1], lg[3][j >> 1][j & 1]);
                    float t = swap16_sum(a0, a1);
                    t += dppf<0x128, 0xf>(t); t += dppf<0x124, 0xf>(t); t += dppf<0x122, 0xf>(t); t += dppf<0x121, 0xf>(t);
                    l2[j] = t;
                }
                const int tk = lane >> 4; const int r = rb4 + tk;
                float gl[4]; float gm = -1e30f;
#pragma unroll
                for (int j = 0; j < 4; ++j) { gl[j] = l2[j] + b_grp[l * 4 + j]; gm = fmaxf(gm, gl[j]); }
                float gs = 0.f; int gi = 0; float gb = -1e30f;
#pragma unroll
                for (int j = 0; j < 4; ++j) { const float e = expf(gl[j] - gm); gs += e; if (gl[j] > gb) { gb = gl[j]; gi = j; } }
                const float pg = expf(gb - gm) / gs;
                float el[4]; float em = -1e30f;
#pragma unroll
                for (int j = 0; j < 4; ++j) { float t_ = 0.f;
#pragma unroll
                    for (int g4 = 0; g4 < 4; ++g4) t_ = (gi == g4) ? (l2[4 + g4 * 4 + j] + b_rtr[l * 16 + g4 * 4 + j]) : t_;
                    el[j] = t_; em = fmaxf(em, t_); }
                float pe[4];
#pragma unroll
                for (int j = 0; j < 4; ++j) pe[j] = expf(el[j] - em);
                int i0 = 0; float b0 = -1.f;
#pragma unroll
                for (int j = 0; j < 4; ++j) if (pe[j] > b0) { b0 = pe[j]; i0 = j; }
                int i1 = 0; float b1 = -1.f;
#pragma unroll
                for (int j = 0; j < 4; ++j) if (j != i0 && pe[j] > b1) { b1 = pe[j]; i1 = j; }
                const float wsum = b0 + b1; const float w0 = pg * b0 / wsum, w1 = pg * b1 / wsum;
                if ((lane & 15) == 0 && rep_ == 0) {
                    wts[2 * r] = w0; wts[2 * r + 1] = w1;
                    const int e0 = gi * 4 + i0, e1 = gi * 4 + i1;
                    const int s0 = __hip_atomic_fetch_add((LAS int*)(lcnt + 16 + 16), 1, __ATOMIC_RELAXED, __HIP_MEMORY_SCOPE_WORKGROUP);
                    const int k0 = __hip_atomic_fetch_add((LAS int*)(lcnt + e0), 1, __ATOMIC_RELAXED, __HIP_MEMORY_SCOPE_WORKGROUP);
                    const int k1 = __hip_atomic_fetch_add((LAS int*)(lcnt + e1), 1, __ATOMIC_RELAXED, __HIP_MEMORY_SCOPE_WORKGROUP);
                    lent[2 * s0] = ((unsigned)(2 * r) << 4) | (unsigned)e0; lrank[2 * s0] = (unsigned)k0;
                    lent[2 * s0 + 1] = ((unsigned)(2 * r + 1) << 4) | (unsigned)e1; lrank[2 * s0 + 1] = (unsigned)k1;
                }
            }
            __syncthreads();
            if (tid < 16 && rep_ == 0) { const int c = lcnt[tid]; lcnt[16 + tid] = c ? (int)__hip_atomic_fetch_add((unsigned*)(ctl + CW_CNT + (l * 16 + tid) * 64), (unsigned)c, RLX_AGENT) : 0; }
            __syncthreads();
            const int ntot = rep_ == 0 ? 2 * lcnt[32] : 0;
            for (int i = tid; i < ntot; i += 512) { const unsigned en = lent[i]; const int e = en & 15; list[(size_t)e * TT + lcnt[16 + e] + lrank[i]] = en >> 4; }
            __syncthreads();
            if (l == 0 && !MK_SPLIT) steal_convert(KA, lds, G, 1, false);
        }
        SEAM(P + 5);
        if (IN(P + 6) || IN(P + 7)) {
            KA_DECL
            __syncthreads();
            if (tid < 16) ttab[17 + tid] = (int)__hip_atomic_load((unsigned*)(ctl + CW_CNT + (l * 16 + tid) * 64), RLX_AGENT);
            __syncthreads();
            if (tid == 0) { int acc_ = 0; for (int e = 0; e < 16; ++e) { const int c = ttab[17 + e]; ttab[e] = acc_; acc_ += (c + 255) >> 8; } ttab[16] = acc_; }
            __syncthreads();
        }
        if (DBG_NAIVE_MOE && IN(P + 6)) {
            KA_DECL
            const int nrows = (l == 0) ? TT : T; LAS float* hs = (LAS float*)lds; LAS float* as = hs + 1024;
            const int* eidg = (const int*)(ws + O_EID);
            LAS float* lgs = as + 512; LAS float* rt = lgs + 32;
            for (int r = vcu; r < nrows; r += G) {
                __syncthreads();
                for (int i = tid; i < 1024; i += 512) hs[i] = bf2f(hbuf[(size_t)r * 1024 + i]);
                __syncthreads();
                if (tid < 20) { float a = 0.f; for (int k = 0; k < 1024; ++k) a += hs[k] * ((tid < 4) ? w_grp[(size_t)l * 4096 + k * 4 + tid] : w_rtr[(size_t)l * 16384 + k * 16 + (tid - 4)]);
                    lgs[tid] = a + ((tid < 4) ? b_grp[l * 4 + tid] : b_rtr[l * 16 + tid - 4]); }
                __syncthreads();
                if (tid == 0) { int gi = 0; for (int j = 1; j < 4; ++j) if (lgs[j] > lgs[gi]) gi = j; float gs = 0.f; for (int j = 0; j < 4; ++j) gs += expf(lgs[j] - lgs[gi]); const float pg = 1.f / gs;
                    int i0 = 0; for (int j = 1; j < 4; ++j) if (lgs[4 + gi * 4 + j] > lgs[4 + gi * 4 + i0]) i0 = j; int i1 = -1; for (int j = 0; j < 4; ++j) if (j != i0 && (i1 < 0 || lgs[4 + gi * 4 + j] > lgs[4 + gi * 4 + i1])) i1 = j;
                    const float p0 = 1.f, p1 = expf(lgs[4 + gi * 4 + i1] - lgs[4 + gi * 4 + i0]); rt[0] = (float)(gi * 4 + i0); rt[1] = (float)(gi * 4 + i1); rt[2] = pg * p0 / (p0 + p1); rt[3] = pg * p1 / (p0 + p1); }
                __syncthreads();
                for (int sl = 0; sl < 2; ++sl) {
                    const int e = (DBG_NAIVE_ROUTE & 1) ? (int)rt[sl] : eidg[2 * r + sl]; const float w = (DBG_NAIVE_ROUTE & 2) ? rt[2 + sl] : wts[2 * r + sl];
                    __syncthreads();
                    const float* Wg = w_gate + (size_t)(l * 16 + e) * 1024 * 512 + tid; const float* Wu = w_up + (size_t)(l * 16 + e) * 1024 * 512 + tid;
                    float g = 0.f, u = 0.f;
#pragma unroll 8
                    for (int k = 0; k < 1024; ++k) { g += hs[k] * Wg[(size_t)k * 512]; u += hs[k] * Wu[(size_t)k * 512]; }
                    as[tid] = g / (1.f + expf(-g)) * u;
                    __syncthreads();
                    const float* Wd = w_down + (size_t)(l * 16 + e) * 512 * 1024 + tid;
                    float y0 = 0.f, y1 = 0.f;
#pragma unroll 8
                    for (int j = 0; j < 512; ++j) { y0 += as[j] * Wd[(size_t)j * 1024]; y1 += as[j] * Wd[(size_t)j * 1024 + 512]; }
                    y2[(size_t)(2 * r + sl) * 1024 + tid] = (bf16)f2bf(y0 * w); y2[(size_t)(2 * r + sl) * 1024 + 512 + tid] = (bf16)f2bf(y1 * w);
                }
            }
        }
        if (!DBG_NAIVE_MOE && IN(P + 6)) {
            KA_DECL
            unsigned* rdy = (unsigned*)(ctl + CW_RDY + l * 4096);
            SchedMoe S{G, vcu, ttab[16], (const char*)hbuf, (const char*)act, (const char*)wgu_t, (const char*)wd_t, list, ttab, rdy, (unsigned*)(ctl + CW_TMO)};
            EpiMoe E{EpiG3{act, rdy}, EpiG4{y2, list, wts, ttab}};
            pg8::gemm_phase<EpiMoe, SchedMoe, true>(lds, S, E);
            if (l == 0 && !MK_SPLIT) steal_convert(KA, lds, G, 2, false);
        }
        SEAM(P + 7);
    }

__global__ void __launch_bounds__(512, 2) fwd_kernel(Args args) {
    extern __shared__ __attribute__((aligned(16))) unsigned char lds_raw[];
    LAS unsigned char* lds = (LAS unsigned char*)lds_raw;
    const int tid = threadIdx.x, lane = tid & 63, wave = __builtin_amdgcn_readfirstlane(tid >> 6);
    const int G = gridDim.x; const int bx = blockIdx.x; const int vcu = (G % 8 == 0) ? (bx % 8) * (G / 8) + bx / 8 : bx;
    volatile LAS unsigned* MISC = (volatile LAS unsigned*)(lds + MISC_OFF);
    LAS float* trig = (LAS float*)(lds + TRIG_OFF);
    LAS int* ttab = (LAS int*)(lds + TILE_OFF);
    for (int u = tid; u < (LDS_BYTES - LDSCTL_OFF) / 4; u += 512) ((LAS unsigned*)(lds + LDSCTL_OFF))[u] = 0u;
    __syncthreads();
    if (tid < 64) { float s, c; sincospif((float)tid / 32.f, &s, &c); trig[tid] = c; trig[64 + tid] = s; }
    __syncthreads();
    XcdBarrier bar; bar.bar = nullptr; bar.x = 0; bar.st = nullptr;
    if (!MK_SPLIT) { KA_DECL bar = xcd_barrier_post((unsigned*)(ctl + CW_BAR), MISC + 8); }
    const int lo = args.ph_lo, hi = args.ph_hi;
    const int NGW = G * 8, NGT = G * 512;

    for (int rep_ = 0; rep_ < 1 + ((REP_MASK >> 0) & 1); ++rep_)
    if (IN(0)) {
        KA_DECL
        __syncthreads();
        if (rep_ == 0 || ((REP_MASK >> 13) & 1)) {
            LAS float* sl = (LAS float*)lds;
            bool have = false;
            for (int it = vcu; it < 192; it += G) {
                if (!have) {
                    for (int i = tid; i < 5120; i += 512) { const int r = i >> 10, k = i & 1023; const float v = (r < 4) ? c_in[r * 1024 + k] : cctx_in[k]; sl[i] = v / (1.f + expf(-v)); }
                    __syncthreads(); have = true;
                }
                const int l = it / 96, cb = it % 96;
                const int r4 = lane >> 4, cq = lane & 15; const int k0 = wave * 128;
                const float* W = w_mod + (size_t)l * 1024 * 6144 + (size_t)(k0 + r4) * 6144 + cb * 64 + 4 * cq;
                f32x4 a0 = {0.f, 0.f, 0.f, 0.f}, a1 = a0, a2 = a0, a3 = a0, a4 = a0;
#pragma unroll 8
                for (int k = 0; k < 32; ++k) { const f32x4 wv = *(const f32x4*)(W + (size_t)(4 * k) * 6144); const int kk = k0 + 4 * k + r4;
                    a0 += wv * sl[kk]; a1 += wv * sl[1024 + kk]; a2 += wv * sl[2048 + kk]; a3 += wv * sl[3072 + kk]; a4 += wv * sl[4096 + kk]; }
                LAS float* part = sl + 5120;
                { LAS float* pp = part + (wave * 4 + r4) * 320 + 4 * cq;
                  *(LAS f32x4*)(pp) = a0; *(LAS f32x4*)(pp + 64) = a1; *(LAS f32x4*)(pp + 128) = a2; *(LAS f32x4*)(pp + 192) = a3; *(LAS f32x4*)(pp + 256) = a4; }
                __syncthreads();
                if (tid < 320) { const int r = tid >> 6, n = tid & 63; float sacc = b_mod[l * 6144 + cb * 64 + n];
#pragma unroll 8
                    for (int w = 0; w < 32; ++w) sacc += part[w * 320 + r * 64 + n];
                    modv[(size_t)(l * 5 + r) * 6144 + cb * 64 + n] = sacc; }
                __syncthreads();
            }
            __syncthreads();
        }
        if (rep_ == 0 || ((REP_MASK >> 14) & 1)) {
#pragma clang loop vectorize(disable) unroll(disable)
        for (int i = gt; i < 4096 * 32; i += NGT) {
            const int n = i >> 5, j = i & 31; const int jj = j & 15;
            const float inv = 1.0f / powf(10000.0f, (float)(2 * jj) / 32.0f);
            const float pos = (j < 16) ? (float)(n >> 6) : (float)(n & 63);
            const float ang = pos * inv; rope[i] = make_float2(cosf(ang), sinf(ang));
        }
#pragma clang loop vectorize(disable) unroll(disable)
        for (int i = gt; i < 4096; i += NGT) { float s, c; sincospif((float)i / 2048.f, &s, &c); twt[i] = make_float2(c, s); }
#pragma clang loop vectorize(disable) unroll(disable)
        for (int i = gt; i < 128 * 128; i += NGT) {
            const int m = i >> 7, k = i & 127; const int ri = m >> 6, k1 = m & 63, part = k >> 6, n1 = k & 63;
            float s, c; sincospif((float)((n1 * k1) & 63) / 32.f, &s, &c);
            float v; if (ri == 0) v = (part == 0) ? c : -s; else v = (part == 0) ? -s : -c;
            fma[i] = (bf16)f2bf(v);
        }
#pragma clang loop vectorize(disable) unroll(disable)
        for (int i = gt; i < 64 * 128; i += NGT) {
            const int k2 = i >> 7, k = i & 127; const int ri = k >> 6, n2 = k & 63;
            float s, c; sincospif((float)((n2 * k2) & 63) / 32.f, &s, &c);
            fmb[i] = (bf16)f2bf((ri == 0 ? c : s) * (1.f / 512.f));
        }
#pragma clang loop vectorize(disable) unroll(disable)
        for (int i = gt; i < 256 * 512; i += NGT) {
            const int kk = i >> 9, k = i & 511; const int part = k >> 8, n = k & 255;
            float s, c; sincospif((float)((n * kk) & 255) / 128.f, &s, &c);
            fmc[i] = (bf16)f2bf((part == 0 ? c : -s) * (1.f / 128.f));
        }
#pragma clang loop vectorize(disable) unroll(disable)
        for (int i = gt; i < 2 * 20480; i += NGT) {
            const int lw = i / 20480, r = i % 20480; const int d = r / 20, j = r % 20;
            ((float*)(ws + O_RW))[lw * 20480 + ((((j >> 2) * 4 + (d >> 8)) * 4 + (d & 3)) * 64 + ((d & 255) >> 2)) * 4 + (j & 3)] = (j < 4) ? w_grp[(size_t)lw * 4096 + d * 4 + j] : w_rtr[(size_t)lw * 16384 + d * 16 + (j - 4)];
        }
        }
        if (rep_ == 0 || ((REP_MASK >> 15) & 1)) {
            LAS float* Al = (LAS float*)lds;
            LAS float* Wl = Al + 4096;
            LAS float* Xl = Wl + 4096;
            for (int it = vcu; it < 256; it += G) {
                const int combo = it & 15, jb = it >> 4; const int l = combo >> 3, g = (combo >> 1) & 3, which = combo & 1;
                const float* Wg = four_w + (size_t)(l * 4 + g) * 4096; const LAS float* tb = trig + which * 64;
                const float* wi = w_in + (size_t)l * 1024 * 1280 + (size_t)(jb * 64) * 1280 + 1024 + g * 64;
                __syncthreads();
#pragma unroll
                for (int i = 0; i < 2; ++i) { const int idx = tid + 512 * i; *(LAS f32x4*)(Wl + 4 * idx) = *(const f32x4*)(Wg + 4 * idx); const int j = idx >> 4, c4 = idx & 15; *(LAS f32x4*)(Xl + j * 64 + 4 * c4) = *(const f32x4*)(wi + (size_t)j * 1280 + 4 * c4); }
                __syncthreads();
                { const int d = tid & 63, c0 = tid >> 6;
#pragma unroll 2
                  for (int i = 0; i < 8; ++i) { const int c = c0 + 8 * i; float a = 0.f;
#pragma unroll 16
                      for (int m = 0; m < 64; ++m) a += tb[(m * c) & 63] * Wl[m * 64 + d];
                      Al[c * 64 + d] = a; } }
                __syncthreads();
                { const int d = tid & 63, jl = 8 * (tid >> 6);
                  float o[8] = {0.f, 0.f, 0.f, 0.f, 0.f, 0.f, 0.f, 0.f};
#pragma unroll 4
                  for (int c = 0; c < 64; ++c) { const float av = Al[c * 64 + d];
#pragma unroll
                      for (int i = 0; i < 8; ++i) o[i] += Xl[(jl + i) * 64 + c] * av; }
                  v2u w; w.x = pk4_f8(o[0] * 64.f, o[1] * 64.f, o[2] * 64.f, o[3] * 64.f); w.y = pk4_f8(o[4] * 64.f, o[5] * 64.f, o[6] * 64.f, o[7] * 64.f);
                  *(v2u*)((unsigned char*)(ws + O_WIN8 + l * SZ_WIN8) + (size_t)(768 + which * 256 + g * 64 + d) * 1024 + jb * 64 + jl) = w; }
            }
            for (int it = vcu; it < 256; it += G) {
                const int combo = it & 7, nb = it >> 3; const int l = combo >> 2, g = combo & 3, n0 = nb * 32;
                const float* pwg = pool_w + (size_t)(l * 4 + g) * 4096;
                __syncthreads();
#pragma unroll
                for (int i = 0; i < 2; ++i) { const int idx = tid + 512 * i; *(LAS f32x4*)(Wl + 4 * idx) = *(const f32x4*)(pwg + 4 * idx); }
                for (int i = tid; i < 2048; i += 512) { const int d = i >> 5, n = i & 31; Xl[i] = pool_scale[l * 256 + g * 64 + d] * w_out[(size_t)l * 1024 * 1024 + (size_t)(g * 64 + d) * 1024 + n0 + n]; }
                __syncthreads();
                { const int n = tid & 31, c0 = 4 * (tid >> 5);
                  float o[4] = {0.f, 0.f, 0.f, 0.f};
#pragma unroll 8
                  for (int d = 0; d < 64; ++d) { const float sv = Xl[d * 32 + n];
#pragma unroll
                      for (int i = 0; i < 4; ++i) o[i] += Wl[(c0 + i) * 64 + d] * sv; }
                  v2u w; w.x = pk2(o[0], o[1]); w.y = pk2(o[2], o[3]);
                  *(v2u*)((bf16*)(ws + O_WOUT + l * SZ_WOUT1) + (size_t)(n0 + n) * 1024 + g * 64 + c0) = w; }
            }
            __syncthreads();
        }
        if (rep_ == 0 || ((REP_MASK >> 16) & 1)) {
            LAS bf16* scr = (LAS bf16*)(lds + wave * 16384);
#pragma clang loop vectorize(disable) unroll(disable)
            for (int it0 = gw; it0 < CV_L; it0 += NGW) conv_item(KA, 0, it0, scr, lane);
        }
    }
    SEAM(0);
    if ((REP_MASK >> 12) & 1) { for (int k_ = 0; k_ < 4; ++k_) xcd_barrier(bar); }

    layer_body<0>(lds, G, vcu, bar, lo, hi);
    layer_body<1>(lds, G, vcu, bar, lo, hi);
    if (IN(17)) {
        KA_DECL
        const float* modp = modv + (size_t)5 * 6144;
#pragma clang loop vectorize(disable) unroll(disable)
        for (int r = gw; r < T; r += NGW) {
            const float* g2 = modp + (r >> 12) * 6144 + 5 * 1024; float* dst = outp + (size_t)r * 1024;
#pragma unroll
            for (int j = 0; j < 4; ++j) {
                const int c0 = 4 * lane + 256 * j; const v2u xw = *(const v2u*)(xb + (size_t)r * 1024 + c0); const f32x4 v = {bflo(xw.x), bfhi(xw.x), bflo(xw.y), bfhi(xw.y)};
                const v2u ya = *(const v2u*)(y2 + (size_t)(2 * r) * 1024 + c0), yb = *(const v2u*)(y2 + (size_t)(2 * r + 1) * 1024 + c0);
                const f32x4 gv = *(const f32x4*)(g2 + c0);
                f32x4 yy; yy[0] = bflo(ya.x) + bflo(yb.x); yy[1] = bfhi(ya.x) + bfhi(yb.x); yy[2] = bflo(ya.y) + bflo(yb.y); yy[3] = bfhi(ya.y) + bfhi(yb.y);
                if (DBG_NO_MOE) yy = (f32x4){0.f, 0.f, 0.f, 0.f};
                *(f32x4*)(dst + c0) = v + gv * yy;
            }
        }
    }
#undef IN
#undef SEAM
}

#undef KA_DECL
#undef ws
#undef ctl
#undef x_in
#undef c_in
#undef ctx_in
#undef cctx_in
#undef w_mod
#undef b_mod
#undef norm1_g
#undef w_in
#undef q_norm_g
#undef k_norm_g
#undef attn_sink
#undef pool_w
#undef pool_scale
#undef four_w
#undef w_out
#undef norm2_g
#undef w_grp
#undef b_grp
#undef w_rtr
#undef b_rtr
#undef w_gate
#undef w_up
#undef w_down
#undef outp
#undef modv
#undef rope
#undef twt
#undef fma
#undef fmb
#undef fmc
#undef hbuf
#undef kall
#undef vall
#undef xc
#undef xb
#undef list
#undef wts
#undef act
#undef t2
#undef mrg
#undef qb
#undef pu
#undef zb
#undef y2
#undef modl
#undef win_t
#undef wout_t
#undef wgu_t
#undef wd_t
extern "C" void kernel_launch(void* const* d_in, const int* in_sizes, int n_in, void* d_out, int out_size, void* d_ws, size_t ws_size, hipStream_t stream) {
    static int grid = 0;
    if (grid == 0) {
        if (n_in != 23 || out_size != T * DM || ws_size < WS_END) { fprintf(stderr, "kernel_launch: unexpected shapes (n_in %d out %d ws %zu need %zu)\n", n_in, out_size, ws_size, (size_t)WS_END); grid = -1; return; }
        int dev = 0, cus = 0;
        if (hipGetDevice(&dev) != hipSuccess || hipDeviceGetAttribute(&cus, hipDeviceAttributeMultiprocessorCount, dev) != hipSuccess) { grid = -1; return; }
        if (cus != 256) { fprintf(stderr, "kernel_launch: built for a 256-CU device (row-tile hand-offs are laid out for 256 workgroups); found %d CUs; nothing launched\n", cus); grid = -1; return; }
        if (hipFuncSetAttribute((const void*)fwd_kernel, hipFuncAttributeMaxDynamicSharedMemorySize, LDS_BYTES) != hipSuccess) { fprintf(stderr, "kernel_launch: hipFuncSetAttribute failed\n"); grid = -1; return; }
        (void)hipGetLastError();
        grid = cus;
    }
    if (grid < 0) return;
    (void)hipMemsetAsync((char*)d_ws + O_CTL, 0, SZ_CTL, stream);
    Args a{};
    for (int i = 0; i < 23; ++i) a.in[i] = (const float*)d_in[i];
    a.out = (float*)d_out; a.ws = (unsigned char*)d_ws;
#if MK_SPLIT
    for (int p = 0; p < NPHASE; ++p) { a.ph_lo = p; a.ph_hi = p + 1; hipLaunchKernelGGL(fwd_kernel, dim3(grid), dim3(512), LDS_BYTES, stream, a); }
#else
    a.ph_lo = 0; a.ph_hi = NPHASE;
    hipLaunchKernelGGL(fwd_kernel, dim3(grid), dim3(512), LDS_BYTES, stream, a);
#endif
}
```

```cpp
#include <hip/hip_runtime.h>
#include <cstdio>
#include <cstdint>

#define DBG_NO_FOUR 0
#define DBG_NO_POOL 0
#define DBG_NO_ATT 0
#define DBG_NO_MOE 0
#define DBG_MOE_SCALE 1.0f
#define DBG_NAIVE_MOE 0
#define REP_MASK 0x0
#define DBG_NAIVE_ROUTE 0
#define LAS __attribute__((address_space(3)))
#define GAS __attribute__((address_space(1)))
typedef unsigned short bf16;
typedef short bf16x8 __attribute__((ext_vector_type(8)));
typedef float f32x4 __attribute__((ext_vector_type(4)));
typedef float f32x16 __attribute__((ext_vector_type(16)));
typedef unsigned v4u __attribute__((ext_vector_type(4)));
typedef unsigned v2u __attribute__((ext_vector_type(2)));
typedef float f32x2 __attribute__((ext_vector_type(2)));
typedef GAS unsigned gu32;

#ifndef MK_SPLIT
#define MK_SPLIT 0
#endif

constexpr int NB = 4, NSEQ = 4096, DM = 1024, LCTX = 256, DEPTH = 2;
constexpr int T = NB * NSEQ, TC = NB * LCTX, TT = T + TC;
constexpr int KVROWS = LCTX + NSEQ;
constexpr int NEXP = 16, DEXP = 512;
constexpr int NPHASE = 18;
constexpr int MAXTILES = 152;
constexpr float QSCALE = 0.125f * 1.4426950408889634f;
constexpr float LOG2E = 1.4426950408889634f;

constexpr size_t al256(size_t x) { return (x + 255) & ~(size_t)255; }
constexpr size_t O_CTL = 0, SZ_CTL = 1u << 20;
constexpr size_t O_MOD = O_CTL + SZ_CTL, SZ_MOD = (size_t)2 * 5 * 6144 * 4;
constexpr size_t O_ROPE = al256(O_MOD + SZ_MOD), SZ_ROPE = (size_t)4096 * 32 * 8;
constexpr size_t O_TW = al256(O_ROPE + SZ_ROPE), SZ_TW = 4096 * 8;
constexpr size_t O_FMA = al256(O_TW + SZ_TW), SZ_FMA = 128 * 128 * 2;
constexpr size_t O_FMB = al256(O_FMA + SZ_FMA), SZ_FMB = 64 * 128 * 2;
constexpr size_t O_FMC = al256(O_FMB + SZ_FMB), SZ_FMC = 256 * 512 * 2;
constexpr size_t O_RW = al256(O_FMC + SZ_FMC), SZ_RW = (size_t)2 * 20480 * 4;
constexpr size_t O_WIN8 = al256(O_RW + SZ_RW), SZ_WIN8 = (size_t)1280 * 1024;
constexpr size_t O_WIN = al256(O_WIN8 + 2 * SZ_WIN8), SZ_WIN1 = (size_t)1536 * 1024 * 2;
constexpr size_t O_WOUT = al256(O_WIN + 2 * SZ_WIN1), SZ_WOUT1 = (size_t)1024 * 1024 * 2;
constexpr size_t O_WGU = al256(O_WOUT + 2 * SZ_WOUT1), SZ_WGU1 = (size_t)16 * 1024 * 1024 * 2;
constexpr size_t O_WD = al256(O_WGU + 2 * SZ_WGU1), SZ_WD1 = (size_t)16 * 1024 * 512 * 2;
constexpr size_t O_H = al256(O_WD + 2 * SZ_WD1), SZ_H = (size_t)TT * 1024 * 2;
constexpr size_t O_KALL = al256(O_H + SZ_H), SZ_KV = (size_t)NB * KVROWS * 128 * 2;
constexpr size_t O_VALL = al256(O_KALL + SZ_KV);
constexpr size_t O_XC = al256(O_VALL + SZ_KV), SZ_XC = (size_t)TC * 1024 * 4;
constexpr size_t O_LIST = al256(O_XC + SZ_XC), SZ_LIST = (size_t)NEXP * TT * 4;
constexpr size_t O_WTS = al256(O_LIST + SZ_LIST), SZ_WTS = (size_t)TT * 2 * 4;
constexpr size_t O_EID = al256(O_WTS + SZ_WTS), SZ_EID = (size_t)TT * 2 * 4;
constexpr size_t O_ACT = al256(O_EID + SZ_EID), SZ_ACT = (size_t)MAXTILES * 256 * 512 * 2;
constexpr size_t O_T2 = O_ACT, SZ_T2 = (size_t)NB * 64 * 64 * 2 * 256 * 2;
constexpr size_t O_MRG = al256(O_ACT + SZ_ACT), SZ_MRG = (size_t)TT * 1024 * 2;
constexpr size_t O_Q = al256(O_MRG + SZ_MRG), SZ_Q = (size_t)TT * 512 * 2;
constexpr size_t O_PU = al256(O_Q + SZ_Q), SZ_PU = (size_t)TT * 256 * 2;
constexpr size_t O_Z = al256(O_PU + SZ_PU), SZ_Z = (size_t)TT * 512 * 2;
constexpr size_t O_Y2 = O_MRG, SZ_Y2 = (size_t)TT * 2 * 1024 * 2;
constexpr size_t O_XB = al256(O_Z + SZ_Z), SZ_XB = (size_t)TT * 1024 * 2;
constexpr size_t WS_END = al256(O_XB + SZ_XB);
static_assert(SZ_T2 <= SZ_ACT, "T2 overlay");
static_assert(O_Y2 + SZ_Y2 <= WS_END, "y2 overlay");

constexpr int CW_TMO = 0;
constexpr int CW_BAR = 4096;
constexpr int CW_KF = 65536;
constexpr int CW_FA = 3072;
constexpr int CW_G2 = 40960;
constexpr int CW_RDY = 32768;
constexpr int CW_Q = 2048;
constexpr int CW_DONE = 2560;
constexpr int CW_CNT = 16384;

constexpr int RING_BYTES = 131072;
constexpr int LDSCTL_OFF = RING_BYTES, MISC_OFF = LDSCTL_OFF + 320;
constexpr int TRIG_OFF = LDSCTL_OFF + 1024;
constexpr int TILE_OFF = LDSCTL_OFF + 2048;
constexpr int LDS_BYTES = 147456;

#define RLX_AGENT __ATOMIC_RELAXED, __HIP_MEMORY_SCOPE_AGENT
#define LDS_WAIT() asm volatile("s_waitcnt lgkmcnt(0)" ::: "memory")
#define VM_WAIT() asm volatile("s_waitcnt vmcnt(0)" ::: "memory")

__device__ __forceinline__ unsigned f2bf(float f) { unsigned u = __builtin_bit_cast(unsigned, f); return (u + 0x7fffu + ((u >> 16) & 1u)) >> 16; }
typedef float f32x2_t_ __attribute__((ext_vector_type(2))); typedef __bf16 bf16x2_t_ __attribute__((ext_vector_type(2)));
__device__ __forceinline__ unsigned pk2(float lo, float hi) { f32x2_t_ v = {lo, hi}; return __builtin_bit_cast(unsigned, __builtin_convertvector(v, bf16x2_t_)); }
__device__ __forceinline__ unsigned pk4_f8(float a, float b, float c, float d) { unsigned w = 0; w = __builtin_amdgcn_cvt_pk_fp8_f32(a, b, w, false); w = __builtin_amdgcn_cvt_pk_fp8_f32(c, d, w, true); return w; }
__device__ __forceinline__ float bflo(unsigned w) { return __builtin_bit_cast(float, w << 16); }
__device__ __forceinline__ float bfhi(unsigned w) { return __builtin_bit_cast(float, w & 0xffff0000u); }
__device__ __forceinline__ float bf2f(bf16 h) { return __builtin_bit_cast(float, (unsigned)h << 16); }
template <int CTRL, int RM> __device__ __forceinline__ float dppf(float v) { return __builtin_bit_cast(float, __builtin_amdgcn_update_dpp(0, __builtin_bit_cast(int, v), CTRL, RM, 0xf, true)); }
__device__ __forceinline__ float wave_sum(float v) {
    v += dppf<0x111, 0xf>(v); v += dppf<0x112, 0xf>(v); v += dppf<0x114, 0xf>(v); v += dppf<0x118, 0xf>(v);
    v += dppf<0x142, 0xa>(v); v += dppf<0x143, 0xc>(v);
    return __builtin_bit_cast(float, __builtin_amdgcn_readlane(__builtin_bit_cast(int, v), 63));
}

__device__ __forceinline__ float swap32_sum(float x, float y) {
    const auto rr = __builtin_amdgcn_permlane32_swap(__builtin_bit_cast(unsigned, x), __builtin_bit_cast(unsigned, y), false, false);
    unsigned r0 = rr[0], r1 = rr[1]; asm volatile("" : "+v"(r0), "+v"(r1));
    return __builtin_bit_cast(float, r0) + __builtin_bit_cast(float, r1);
}
__device__ __forceinline__ float swap16_sum(float x, float y) {
    const auto rr = __builtin_amdgcn_permlane16_swap(__builtin_bit_cast(unsigned, x), __builtin_bit_cast(unsigned, y), false, false);
    unsigned r0 = rr[0], r1 = rr[1]; asm volatile("" : "+v"(r0), "+v"(r1));
    return __builtin_bit_cast(float, r0) + __builtin_bit_cast(float, r1);
}

#define XB_TMO      128
#define XB_XCNT(j)  (256  + 64 * (j))
#define XB_XSUB(j)  (1280 + 64 * (j))
#define XB_XGEN(j)  (2304 + 64 * (j))
#define XB_TOP      3328
#define XB_TOPGEN   3392
#define XCD_BAR_WORDS 3456
#define XB_SPIN_CAP (1u << 18)
__device__ __forceinline__ unsigned xb_ld(unsigned* p)              { return __hip_atomic_load(p, __ATOMIC_RELAXED, __HIP_MEMORY_SCOPE_AGENT); }
__device__ __forceinline__ unsigned xb_add(unsigned* p, unsigned v) { return __hip_atomic_fetch_add(p, v, __ATOMIC_RELAXED, __HIP_MEMORY_SCOPE_AGENT); }
__device__ __forceinline__ unsigned xb_xcc_id() { return (unsigned)__builtin_amdgcn_s_getreg((3 << 11) | 20) & 0xFu; }
#define XB_SPIN(cond, bar) do { unsigned _sp = 0; while (cond) { __builtin_amdgcn_s_sleep(1); \
    if ((++_sp & 255u) == 0u) { if (xb_ld(&(bar)[XB_TMO])) break; if (_sp > XB_SPIN_CAP) { atomicAdd(&(bar)[XB_TMO], 1u); break; } } } } while (0)
struct XcdBarrier { unsigned* bar; unsigned x; volatile LAS unsigned* st; };
__device__ __forceinline__ XcdBarrier xcd_barrier_post(unsigned* bar, volatile LAS unsigned* st) {
    XcdBarrier b; b.bar = bar; b.x = xb_xcc_id(); b.st = st;
    if (threadIdx.x == 0) (void)xb_add(&bar[XB_XCNT(b.x)], 1u);
    return b;
}
__device__ __forceinline__ void xcd_barrier_complete(unsigned* bar, unsigned x, unsigned& nloc, unsigned& nx) {
    const unsigned G = gridDim.x * gridDim.y * gridDim.z;
    unsigned sum, cnt, mine, sp = 0u;
    for (;;) {
        sum = 0u; cnt = 0u; mine = 0u;
#pragma unroll
        for (unsigned j = 0; j < 16; ++j) { const unsigned c = xb_ld(&bar[XB_XCNT(j)]); sum += c; cnt += (c > 0u) ? 1u : 0u; mine = (j == x) ? c : mine; }
        if (sum == G) break;
        __builtin_amdgcn_s_sleep(1);
        if ((++sp & 255u) == 0u) { if (xb_ld(&bar[XB_TMO])) break; if (sp > XB_SPIN_CAP) { atomicAdd(&bar[XB_TMO], 1u); break; } }
    }
    nloc = mine > 0u ? mine : 1u; nx = cnt > 0u ? cnt : 1u;
}
__device__ __forceinline__ void xcd_barrier(const XcdBarrier& b) {
    asm volatile("s_waitcnt vmcnt(0)" ::: "memory");
    __syncthreads();
    if (threadIdx.x == 0) {
        unsigned* bar = b.bar;
        __builtin_amdgcn_s_waitcnt(0);
        unsigned nloc = b.st[0], nx = b.st[1];
        if (nloc == 0u) { xcd_barrier_complete(bar, b.x, nloc, nx); b.st[0] = nloc; b.st[1] = nx; }
        const unsigned old = xb_add(&bar[XB_XSUB(b.x)], 1u);
        const unsigned gen = old / nloc;
        if (old + 1u == (gen + 1u) * nloc) {
            __builtin_amdgcn_fence(__ATOMIC_RELEASE, "agent");
            asm volatile("s_waitcnt vmcnt(0)" ::: "memory");
            const unsigned og = xb_add(&bar[XB_TOP], 1u);
            const unsigned tg = og / nx;
            if (og + 1u == (tg + 1u) * nx) xb_add(&bar[XB_TOPGEN], 1u);
            else XB_SPIN(xb_ld(&bar[XB_TOPGEN]) == tg, bar);
            __builtin_amdgcn_fence(__ATOMIC_ACQUIRE, "agent");
            xb_add(&bar[XB_XGEN(b.x)], 1u);
            asm volatile("s_waitcnt vmcnt(0)" ::: "memory");
        } else {
            XB_SPIN(xb_ld(&bar[XB_XGEN(b.x)]) == gen, bar);
            __builtin_amdgcn_fence(__ATOMIC_ACQUIRE, "agent");
            asm volatile("s_waitcnt vmcnt(0)" ::: "memory");
        }
    }
    __syncthreads();
}

namespace pg8 {
constexpr int BM = 256, BK = 64, HALF = 128, HTB = HALF * BK * 2;
__host__ __device__ __forceinline__ int lds_byte(int r, int c) { const int st = (r >> 4) * 2 + (c >> 5), rr = r & 15, cc = c & 31, ob = rr * 64 + cc * 2; return st * 1024 + (ob ^ (((ob >> 9) & 1) << 5)); }
__host__ __device__ __forceinline__ void stage_rc(int b, int& R, int& C) { const int st = b / 1024, sb = b % 1024, swz = sb ^ (((sb >> 9) & 1) << 5); R = (st >> 1) * 16 + swz / 64; C = (st & 1) * 32 + (swz % 64) / 2; }
__host__ __device__ __forceinline__ int perm32(int rho) { const int n = rho >> 4, i = rho & 15; return 8 * (i >> 2) + 4 * n + (i & 3); }

struct Unit { int pm, pn, e, cnt, kind; };

typedef int v8i __attribute__((ext_vector_type(8)));
typedef int v4i __attribute__((ext_vector_type(4)));
template <class Epi, class Sched, bool F8ALL = false>
__device__ __forceinline__ void gemm_phase(LAS unsigned char* lds, const Sched& S, const Epi& E) {
    int tid = threadIdx.x; asm volatile("" : "+v"(tid));
    const int wid = __builtin_amdgcn_readfirstlane(tid >> 6), lane = tid & 63, wr = wid >> 2, wc = wid & 3, fr = lane & 15, fq = lane >> 4;
#define PG8_RC() int RA[2], CA[2], RB[2]; { int tl_ = tid; asm volatile("" : "+v"(tl_)); _Pragma("unroll") for (int i = 0; i < 2; ++i) { int R, C; stage_rc(tl_ * 16 + i * 8192, R, C); RA[i] = R; CA[i] = C; RB[i] = Epi::PERM ? ((R & ~31) + perm32(R & 31)) : R; } }
    const size_t kstep = (size_t)(BK * 2);
    const unsigned ldsw = (unsigned)wid * 1024u;
    const int aoff = lds_byte(wr * 64 + fr, fq * 8), boff = lds_byte(wc * 32 + fr, fq * 8);
#define PG8_SA(b, h) (((b) * 2 + (h)) * HTB)
#define PG8_SB(b, h) ((4 + (b) * 2 + (h)) * HTB)
#define PG8_STAGE2(bufoff, gbase, o0, o1) do { \
        __builtin_amdgcn_global_load_lds((const unsigned*)((const char*)(gbase) + (o0)), (LAS unsigned*)(lds + (bufoff) + ldsw), 16, 0, 0); \
        __builtin_amdgcn_global_load_lds((const unsigned*)((const char*)(gbase) + (o1)), (LAS unsigned*)(lds + (bufoff) + ldsw + 8192), 16, 0, 0); } while (0)
#define PG8_LD8(p) __builtin_shufflevector(*(const LAS v4i*)(p), *(const LAS v4i*)((p) + 1024), 0, 1, 2, 3, 4, 5, 6, 7)
#define PG8_LDA(dst, b, h) do { _Pragma("unroll") for (int m = 0; m < 4; ++m) dst[m] = PG8_LD8(lds + PG8_SA(b, h) + aoff + m * 2048); } while (0)
#define PG8_LDB(dst, b, h) do { _Pragma("unroll") for (int n = 0; n < 2; ++n) dst[n] = PG8_LD8(lds + PG8_SB(b, h) + boff + n * 2048); } while (0)
#define PG8_LO(x) __builtin_bit_cast(bf16x8, __builtin_shufflevector(x, x, 0, 1, 2, 3))
#define PG8_HI(x) __builtin_bit_cast(bf16x8, __builtin_shufflevector(x, x, 4, 5, 6, 7))
#define PG8_MMA(ai, bj, At, Bt) do { __builtin_amdgcn_s_setprio(1); \
        if (F8ALL) { _Pragma("unroll") for (int m = 0; m < 4; ++m) _Pragma("unroll") for (int n = 0; n < 2; ++n) \
            asm volatile("v_mfma_scale_f32_16x16x128_f8f6f4 %0, %1, %2, %0, %3, %3 op_sel_hi:[0,0,0]" : "+v"(acc[ai][bj][m][n]) : "v"(Bt[n]), "v"(At[m]), "v"(f8sc)); } \
        else { _Pragma("unroll") for (int m = 0; m < 4; ++m) _Pragma("unroll") for (int n = 0; n < 2; ++n) { \
            acc[ai][bj][m][n] = __builtin_amdgcn_mfma_f32_16x16x32_bf16(PG8_LO(Bt[n]), PG8_LO(At[m]), acc[ai][bj][m][n], 0, 0, 0); \
            acc[ai][bj][m][n] = __builtin_amdgcn_mfma_f32_16x16x32_bf16(PG8_HI(Bt[n]), PG8_HI(At[m]), acc[ai][bj][m][n], 0, 0, 0); } } \
        __builtin_amdgcn_s_setprio(0); } while (0)
#define PG8_WAIT_V(n) asm volatile("s_waitcnt vmcnt(" #n ")" ::: "memory")
#define PG8_WAIT_L(n) asm volatile("s_waitcnt lgkmcnt(" #n ")" ::: "memory")
#define PG8_BAR __builtin_amdgcn_s_barrier()
#define PG8_SCHED __builtin_amdgcn_sched_barrier(0)
    Unit cur, nxt; int ui = 0;
    if (!S.next(0, cur)) return;
    f32x4 acc[2][2][4][2];
#pragma unroll
    for (int a = 0; a < 2; ++a)
#pragma unroll
        for (int b = 0; b < 2; ++b)
#pragma unroll
            for (int m = 0; m < 4; ++m)
#pragma unroll
                for (int n = 0; n < 2; ++n) acc[a][b][m][n] = (f32x4){0.f, 0.f, 0.f, 0.f};
    v8i At[4], B0[2], B1[2];
    int f8sc = 0x7c7c7c7c; asm volatile("" : "+v"(f8sc));
    int Kc = S.K(cur), Kn; const char* Ac = S.a_base(cur); const char* An; const char* cB = S.b_ptr(cur); const char* nB;
    unsigned oc00, oc01, oc10, oc11, on00, on01, on10, on11, vbc0, vbc1, vbn0, vbn1; size_t hsc, hsn;
    { PG8_RC()
    oc00 = S.a_off(cur, RA[0], CA[0]); oc01 = S.a_off(cur, RA[1], CA[1]); oc10 = S.a_off(cur, HALF + RA[0], CA[0]); oc11 = S.a_off(cur, HALF + RA[1], CA[1]);
    vbc0 = (unsigned)(RB[0] * Kc + CA[0]) * 2u; vbc1 = (unsigned)(RB[1] * Kc + CA[1]) * 2u; hsc = (size_t)HALF * Kc * 2; }
    S.a_ready(cur);
    PG8_STAGE2(PG8_SB(0, 0), cB, vbc0, vbc1); PG8_STAGE2(PG8_SB(0, 1), cB + hsc, vbc0, vbc1); PG8_STAGE2(PG8_SA(0, 0), Ac, oc00, oc01); PG8_STAGE2(PG8_SA(0, 1), Ac, oc10, oc11);
    if (wr == 1) PG8_BAR;
    PG8_WAIT_V(2); PG8_BAR;
    PG8_STAGE2(PG8_SB(1, 0), cB + kstep, vbc0, vbc1); PG8_STAGE2(PG8_SA(1, 0), Ac + kstep, oc00, oc01); PG8_STAGE2(PG8_SB(1, 1), cB + hsc + kstep, vbc0, vbc1);
    PG8_WAIT_V(6); PG8_BAR;
    for (;;) {
        const bool has_next = S.next(ui + 1, nxt);
        Kn = Kc; An = Ac; nB = cB; on00 = oc00; on01 = oc01; on10 = oc10; on11 = oc11; vbn0 = vbc0; vbn1 = vbc1; hsn = hsc;
        if (has_next) { Kn = S.K(nxt); An = S.a_base(nxt); nB = S.b_ptr(nxt); PG8_RC()
            on00 = S.a_off(nxt, RA[0], CA[0]); on01 = S.a_off(nxt, RA[1], CA[1]); on10 = S.a_off(nxt, HALF + RA[0], CA[0]); on11 = S.a_off(nxt, HALF + RA[1], CA[1]);
            vbn0 = (unsigned)(RB[0] * Kn + CA[0]) * 2u; vbn1 = (unsigned)(RB[1] * Kn + CA[1]) * 2u; hsn = (size_t)HALF * Kn * 2; }
        const int nt = Kc / BK;
#pragma clang loop unroll(disable)
        for (int t = 0; t < nt; t += 2) {
            const bool last = (t == nt - 2);
            if (last && has_next) S.a_ready(nxt);
            const char* a1 = Ac + (size_t)(t + 1) * kstep;
            const char* a2 = last ? An : Ac + (size_t)(t + 2) * kstep; const char* b2 = last ? nB : cB + (size_t)(t + 2) * kstep;
            const char* a3 = a2 + kstep; const char* b3 = b2 + kstep;
            const unsigned x00 = last ? on00 : oc00, x01 = last ? on01 : oc01, x10 = last ? on10 : oc10, x11 = last ? on11 : oc11;
            const unsigned y0 = last ? vbn0 : vbc0, y1 = last ? vbn1 : vbc1; const size_t hs2 = last ? hsn : hsc;
            PG8_LDB(B0, 0, 0); PG8_LDB(B1, 0, 1); PG8_SCHED; PG8_LDA(At, 0, 0); PG8_STAGE2(PG8_SA(1, 1), a1, oc10, oc11);
            PG8_WAIT_V(8); PG8_WAIT_L(0); PG8_BAR; PG8_MMA(0, 0, At, B0); PG8_MMA(0, 1, At, B1); PG8_BAR; PG8_SCHED;
            PG8_LDA(At, 0, 1); PG8_STAGE2(PG8_SB(0, 0), b2, y0, y1); PG8_STAGE2(PG8_SB(0, 1), b2 + hs2, y0, y1); PG8_STAGE2(PG8_SA(0, 0), a2, x00, x01);
            PG8_WAIT_V(8); PG8_WAIT_L(0); PG8_BAR; PG8_MMA(1, 0, At, B0); PG8_MMA(1, 1, At, B1); PG8_BAR; PG8_SCHED;
            PG8_LDB(B0, 1, 0); PG8_LDB(B1, 1, 1); PG8_SCHED; PG8_LDA(At, 1, 0); PG8_STAGE2(PG8_SA(0, 1), a2, x10, x11);
            PG8_WAIT_V(8); PG8_WAIT_L(0); PG8_BAR; PG8_MMA(0, 0, At, B0); PG8_MMA(0, 1, At, B1); PG8_BAR; PG8_SCHED;
            PG8_LDA(At, 1, 1); PG8_STAGE2(PG8_SB(1, 0), b3, y0, y1); PG8_STAGE2(PG8_SB(1, 1), b3 + hs2, y0, y1); PG8_STAGE2(PG8_SA(1, 0), a3, x00, x01);
            PG8_WAIT_V(8); PG8_WAIT_L(0); PG8_BAR; PG8_MMA(1, 0, At, B0); PG8_MMA(1, 1, At, B1); PG8_BAR; PG8_SCHED;
        }
        if (wr == 0) PG8_BAR;
        if (F8ALL) asm volatile("s_nop 15\n\ts_nop 15" ::: "memory");
        E(acc, cur, wr, wc, fr, fq);
        if (!has_next) break;
#pragma unroll
        for (int a = 0; a < 2; ++a)
#pragma unroll
            for (int b = 0; b < 2; ++b)
#pragma unroll
                for (int m = 0; m < 4; ++m)
#pragma unroll
                    for (int n = 0; n < 2; ++n) acc[a][b][m][n] = (f32x4){0.f, 0.f, 0.f, 0.f};
        cur = nxt; Kc = Kn; Ac = An; cB = nB; oc00 = on00; oc01 = on01; oc10 = on10; oc11 = on11; vbc0 = vbn0; vbc1 = vbn1; hsc = hsn; ++ui;
        if (wr == 1) PG8_BAR;
    }
    PG8_WAIT_V(0);
    PG8_BAR;
#undef PG8_RC
#undef PG8_SA
#undef PG8_SB
#undef PG8_STAGE2
#undef PG8_LDA
#undef PG8_LD8
#undef PG8_LO
#undef PG8_HI
#undef PG8_LDB
#undef PG8_MMA
#undef PG8_WAIT_V
#undef PG8_WAIT_L
#undef PG8_BAR
#undef PG8_SCHED
}
}

__device__ __forceinline__ void store16_wt(void* p, v4u v) { asm volatile("global_store_dwordx4 %0, %1, off sc1\n\ts_nop 1" :: "v"(p), "v"(v) : "memory"); }
__device__ __forceinline__ int krow_of(int r) {
    if (r < T) return (r >> 12) * KVROWS + LCTX + (r & 4095);
    const int rc = r - T; return (rc >> 8) * KVROWS + (rc & 255);
}
struct SchedPlain {
    int nM, nN, G, vcu, Kk; const char* A; const char* B;
    __device__ __forceinline__ bool next(int i, pg8::Unit& u) const { const int L = i * G + vcu; if (L >= nM * nN) return false; u.pm = L / nN; u.pn = L % nN; u.e = 0; u.cnt = 256; u.kind = 0; return true; }
    __device__ __forceinline__ int K(const pg8::Unit&) const { return Kk; }
    __device__ __forceinline__ const char* a_base(const pg8::Unit&) const { return A; }
    __device__ __forceinline__ unsigned a_off(const pg8::Unit& u, int row, int col) const { return (unsigned)((u.pm * 256 + row) * Kk + col) * 2u; }
    __device__ __forceinline__ const char* b_ptr(const pg8::Unit& u) const { return B + (size_t)u.pn * 256 * Kk * 2; }
    __device__ __forceinline__ void a_ready(const pg8::Unit&) const {}
};
struct SchedG1 {
    int G, vcu, f8, lyr; const char* A; const char* B;
    __device__ __forceinline__ bool next(int i, pg8::Unit& u) const {
        const int nb16 = lyr ? T / 256 : TT / 256;
        u.e = 0; u.cnt = 256; u.kind = 0;
        if (!f8) { if (i > 0 || vcu >= nb16) return false; u.pm = vcu; u.pn = 0; return true; }
        const int nW = G - nb16; if (vcu < nb16) return false;
        const int L = i * nW + (vcu - nb16); const int nlat = (T / 256) * 5; const int ntot = nlat + (lyr ? 4 : 20);
        if (L >= ntot) return false;
        if (L < nlat) { u.pm = L / 5; u.pn = 1 + L % 5; }
        else if (lyr) { u.pm = T / 256 + (L - nlat); u.pn = 3; }
        else { u.pm = T / 256 + (L - nlat) / 5; u.pn = 1 + (L - nlat) % 5; }
        return true; }
    __device__ __forceinline__ int K(const pg8::Unit&) const { return f8 ? 512 : 1024; }
    __device__ __forceinline__ const char* a_base(const pg8::Unit&) const { return A; }
    __device__ __forceinline__ unsigned a_off(const pg8::Unit& u, int row, int col) const { return (unsigned)((u.pm * 256 + row) * (f8 ? 512 : 1024) + col) * 2u; }
    __device__ __forceinline__ const char* b_ptr(const pg8::Unit& u) const { return f8 ? B + (size_t)(u.pn - 1) * 256 * 1024 : B + (size_t)u.pn * 256 * 1024 * 2; }
    __device__ __forceinline__ void a_ready(const pg8::Unit&) const {}
};
struct EpiG1 {
    static constexpr bool PERM = true;
    bf16 *pu, *q, *kall, *vall, *z;
    __device__ __forceinline__ void operator()(const f32x4 (&acc)[2][2][4][2], const pg8::Unit& u, int wr, int wc, int fr, int fq) const {
        const int row0 = u.pm * 256 + wr * 64 + fr, c8 = wc * 32 + 8 * fq;
#pragma unroll
        for (int ai = 0; ai < 2; ++ai)
#pragma unroll
            for (int m = 0; m < 4; ++m) {
                const int row = row0 + ai * 128 + m * 16;
#pragma unroll
                for (int bj = 0; bj < 2; ++bj) {
                    const f32x4 v0 = acc[ai][bj][m][0], v1 = acc[ai][bj][m][1];
                    v4u w; w.x = pk2(v0[0], v0[1]); w.y = pk2(v0[2], v0[3]); w.z = pk2(v1[0], v1[1]); w.w = pk2(v1[2], v1[3]);
                    bf16* dst;
                    if (u.pn == 0) dst = pu + (size_t)row * 256 + bj * 128 + c8;
                    else if (u.pn <= 2) dst = q + (size_t)row * 512 + (u.pn - 1) * 256 + bj * 128 + c8;
                    else if (u.pn == 3) dst = (bj == 0 ? kall : vall) + (size_t)krow_of(row) * 128 + c8;
                    else dst = z + (size_t)row * 512 + (u.pn - 4) * 256 + bj * 128 + c8;
                    *(v4u*)dst = w;
                }
            }
    }
};
template <bool BB> struct EpiG2 {
    static constexpr bool PERM = true;
    const float* xin; const float* cin; bf16* xs; const float* mod; unsigned* ready;
    __device__ __forceinline__ void operator()(const f32x4 (&acc)[2][2][4][2], const pg8::Unit& u, int wr, int wc, int fr, int fq) const {
        const int rt0 = u.pm * 256; const bool isc = rt0 >= T;
        const int bsel = isc ? 4 : (rt0 >> 12);
        const float* g1 = mod + bsel * 6144 + 2048;
        const float* base = isc ? cin - (size_t)T * 1024 : xin;
        const int row0 = rt0 + wr * 64 + fr, c8 = u.pn * 256 + wc * 32 + 8 * fq;
#pragma unroll
        for (int bj = 0; bj < 2; ++bj) {
            const int col = c8 + bj * 128; const f32x4 ga = *(const f32x4*)(g1 + col), gb = *(const f32x4*)(g1 + col + 4);
            if (BB) {
                v4u b[2][4];
#pragma unroll
                for (int ai = 0; ai < 2; ++ai)
#pragma unroll
                    for (int m = 0; m < 4; ++m) b[ai][m] = *(const v4u*)(xs + (size_t)(row0 + ai * 128 + m * 16) * 1024 + col);
#pragma unroll
                for (int ai = 0; ai < 2; ++ai)
#pragma unroll
                    for (int m = 0; m < 4; ++m) { const v4u w = b[ai][m]; const f32x4 a0 = acc[ai][bj][m][0], a1 = acc[ai][bj][m][1];
                        v4u o; o.x = pk2(bflo(w.x) + ga[0] * a0[0], bfhi(w.x) + ga[1] * a0[1]); o.y = pk2(bflo(w.y) + ga[2] * a0[2], bfhi(w.y) + ga[3] * a0[3]);
                        o.z = pk2(bflo(w.z) + gb[0] * a1[0], bfhi(w.z) + gb[1] * a1[1]); o.w = pk2(bflo(w.w) + gb[2] * a1[2], bfhi(w.w) + gb[3] * a1[3]);
                        store16_wt(xs + (size_t)(row0 + ai * 128 + m * 16) * 1024 + col, o); }
            } else {
#pragma unroll
                for (int ai = 0; ai < 2; ++ai) {
                    f32x4 b0[4], b1[4];
#pragma unroll
                    for (int m = 0; m < 4; ++m) { const float* bp = base + (size_t)(row0 + ai * 128 + m * 16) * 1024 + col; b0[m] = *(const f32x4*)bp; b1[m] = *(const f32x4*)(bp + 4); }
#pragma unroll
                    for (int m = 0; m < 4; ++m) { const f32x4 x0 = b0[m] + ga * acc[ai][bj][m][0], x1 = b1[m] + gb * acc[ai][bj][m][1];
                        v4u o; o.x = pk2(x0[0], x0[1]); o.y = pk2(x0[2], x0[3]); o.z = pk2(x1[0], x1[1]); o.w = pk2(x1[2], x1[3]);
                        store16_wt(xs + (size_t)(row0 + ai * 128 + m * 16) * 1024 + col, o); }
                }
            }
        }
        asm volatile("s_waitcnt vmcnt(0)" ::: "memory");
        if ((threadIdx.x & 63) == 0) __hip_atomic_fetch_add(ready + 16 * u.pm, 1u, __ATOMIC_RELAXED, __HIP_MEMORY_SCOPE_AGENT);
    }
};
struct SchedMoe {
    int G, vcu, ntile;
    const char* hb; const char* actb; const char* wgu; const char* wd; const unsigned* list; const LAS int* tt; unsigned* ready; unsigned* tmo;
    __device__ __forceinline__ bool next(int i, pg8::Unit& u) const {
        const int U = ntile * 4; const int r = U % G, q = U / G; const int n3 = q + (vcu < r ? 1 : 0); int L;
        if (i < n3) { L = i * G + vcu; u.kind = 0; }
        else { const int j = i - n3; const int nl = G - r;
            if (vcu >= r) L = (j == 0) ? (vcu - r) : (j == 1) ? nl + (vcu - r) : 2 * nl + (j - 2) * G + vcu;
            else L = 2 * nl + j * G + vcu;
            if (L >= U) return false; u.kind = 1; }
        const int tau = L >> 2; u.pn = L & 3; u.pm = tau; int e = 0;
#pragma unroll
        for (int k = 1; k < 16; ++k) e += (tt[k] <= tau) ? 1 : 0;
        u.e = e; const int r0 = (tau - tt[e]) * 256; const int c = tt[17 + e] - r0; u.cnt = c < 256 ? c : 256; return true;
    }
    __device__ __forceinline__ int K(const pg8::Unit& u) const { return u.kind ? 256 : 512; }
    __device__ __forceinline__ const char* a_base(const pg8::Unit& u) const { return u.kind ? actb : hb; }
    __device__ __forceinline__ unsigned a_off(const pg8::Unit& u, int row, int col) const {
        if (u.kind) return (unsigned)((u.pm * 256 + row) * 256 + col) * 2u;
        const int r0 = (u.pm - tt[u.e]) * 256; const int rr = row < u.cnt ? row : u.cnt - 1;
        const unsigned tok = list[(size_t)u.e * TT + r0 + rr] >> 1;
        return (tok * 512u + (unsigned)col) * 2u;
    }
    __device__ __forceinline__ const char* b_ptr(const pg8::Unit& u) const { return u.kind ? wd + ((size_t)u.e * 1024 + (size_t)u.pn * 256) * 256 * 2 : wgu + ((size_t)u.e * 1024 + (size_t)u.pn * 256) * 512 * 2; }
    __device__ __forceinline__ void a_ready(const pg8::Unit& u) const {
        if (!u.kind) return;
        if (threadIdx.x < 64) {
            unsigned* w = ready + 16 * u.pm; unsigned sp = 0;
            while ((unsigned)__builtin_amdgcn_readfirstlane(__hip_atomic_load(w, __ATOMIC_RELAXED, __HIP_MEMORY_SCOPE_AGENT)) < 32u) {
                __builtin_amdgcn_s_sleep(2);
                if (++sp > (1u << 22)) { if (threadIdx.x == 0) __hip_atomic_store(tmo, 1u, __ATOMIC_RELAXED, __HIP_MEMORY_SCOPE_AGENT); break; } }
            __builtin_amdgcn_fence(__ATOMIC_ACQUIRE, "agent");
            asm volatile("s_waitcnt vmcnt(0)" ::: "memory");
        }
        asm volatile("" ::: "memory"); __builtin_amdgcn_s_barrier(); asm volatile("" ::: "memory");
    }
};
struct EpiG3 {
    static constexpr bool PERM = true;
    bf16* act; unsigned* ready;
    __device__ __forceinline__ void operator()(const f32x4 (&acc)[2][2][4][2], const pg8::Unit& u, int wr, int wc, int fr, int fq) const {
        const int row0 = u.pm * 256 + wr * 64 + fr, c8 = u.pn * 128 + wc * 32 + 8 * fq;
#pragma unroll
        for (int ai = 0; ai < 2; ++ai)
#pragma unroll
            for (int m = 0; m < 4; ++m) {
                float a[8];
#pragma unroll
                for (int n = 0; n < 2; ++n)
#pragma unroll
                    for (int k = 0; k < 4; ++k) { const float g = acc[ai][0][m][n][k], up = acc[ai][1][m][n][k]; a[n * 4 + k] = g * __builtin_amdgcn_rcpf(1.f + __builtin_amdgcn_exp2f(-LOG2E * g)) * up; }
                const unsigned long long w8 = (unsigned long long)pk4_f8(a[0], a[1], a[2], a[3]) | ((unsigned long long)pk4_f8(a[4], a[5], a[6], a[7]) << 32);
                __hip_atomic_store((unsigned long long*)((unsigned char*)act + (size_t)(row0 + ai * 128 + m * 16) * 512 + c8), w8, __ATOMIC_RELAXED, __HIP_MEMORY_SCOPE_AGENT);
            }
        asm volatile("s_waitcnt vmcnt(0)" ::: "memory");
        if ((threadIdx.x & 63) == 0) __hip_atomic_fetch_add(ready + 16 * u.pm, 1u, __ATOMIC_RELAXED, __HIP_MEMORY_SCOPE_AGENT);
    }
};
struct EpiG4 {
    static constexpr bool PERM = true;
    bf16* y2; const unsigned* list; const float* wts; const LAS int* tt;
    __device__ __forceinline__ void operator()(const f32x4 (&acc)[2][2][4][2], const pg8::Unit& u, int wr, int wc, int fr, int fq) const {
        const int r0 = (u.pm - tt[u.e]) * 256; const int c8 = u.pn * 256 + wc * 32 + 8 * fq;
        unsigned ent[2][4]; float w[2][4];
#pragma unroll
        for (int ai = 0; ai < 2; ++ai)
#pragma unroll
            for (int m = 0; m < 4; ++m) { const int row = wr * 64 + fr + ai * 128 + m * 16; ent[ai][m] = list[(size_t)u.e * TT + r0 + (row < u.cnt ? row : u.cnt - 1)]; }
#pragma unroll
        for (int ai = 0; ai < 2; ++ai)
#pragma unroll
            for (int m = 0; m < 4; ++m) w[ai][m] = wts[ent[ai][m]];
#pragma unroll
        for (int ai = 0; ai < 2; ++ai)
#pragma unroll
            for (int m = 0; m < 4; ++m) {
                const int row = wr * 64 + fr + ai * 128 + m * 16;
                if (row < u.cnt) {
#pragma unroll
                    for (int bj = 0; bj < 2; ++bj) {
                        const f32x4 v0 = acc[ai][bj][m][0] * w[ai][m], v1 = acc[ai][bj][m][1] * w[ai][m];
                        v4u o; o.x = pk2(v0[0], v0[1]); o.y = pk2(v0[2], v0[3]); o.z = pk2(v1[0], v1[1]); o.w = pk2(v1[2], v1[3]);
                        *(v4u*)(y2 + (size_t)ent[ai][m] * 1024 + bj * 128 + c8) = o;
                    }
                }
            }
    }
};

struct EpiMoe { static constexpr bool PERM = true; EpiG3 e3; EpiG4 e4;
    __device__ __forceinline__ void operator()(const f32x4 (&acc)[2][2][4][2], const pg8::Unit& u, int wr, int wc, int fr, int fq) const { if (u.kind) e4(acc, u, wr, wc, fr, fq); else e3(acc, u, wr, wc, fr, fq); } };

#include <hip/hip_bf16.h>
#include <cmath>
namespace attn_body {
using bf16=__hip_bfloat16;
using bf16x8=__attribute__((ext_vector_type(8)))short;
using s16x4=__attribute__((ext_vector_type(4)))short;
using f32x16=__attribute__((ext_vector_type(16)))float;
using u32x4=__attribute__((ext_vector_type(4)))unsigned;
constexpr int D=64,QP=512,KVP=128,OP=1024;
constexpr int NW=8,QBLK=32,KVBLK=64;
__device__ __forceinline__ int crow(int r,int hi){return (r&3)+8*(r>>2)+4*hi;}
#define SBAR() __builtin_amdgcn_sched_barrier(0)
__device__ __forceinline__ void wmask(f32x16&p0,f32x16&p1,int kp0,int qpos,int hi){
  const float NEG=-INFINITY; const bool tile_ok=(unsigned)kp0<4096u; const int base=kp0+4*hi-qpos+128;
  #pragma unroll
  for(int r=0;r<16;++r){const int dd=base+(r&3)+8*(r>>2); if(!tile_ok||(unsigned)dd>256u)p0[r]=NEG; if(!tile_ok||(unsigned)(dd+32)>256u)p1[r]=NEG;}
}
constexpr int NSLOT=3, SLOTB=8192;
constexpr int LDS_K=0, LDS_V=NSLOT*SLOTB, LDS_WS=2*NSLOT*SLOTB, LDS_OST=LDS_WS+NW*64*4, LDS_BYTES=LDS_OST+NW*4096;
constexpr float C2=0.125f*1.4426950408889634f;
__device__ __forceinline__ void glds16(const void*gsrc,unsigned lds_dst){unsigned keep;
  asm volatile("s_mov_b32 %0, m0\n\ts_mov_b32 m0, %2\n\ts_nop 0\n\tglobal_load_lds_dwordx4 %1, off\n\ts_mov_b32 m0, %0":"=&s"(keep):"v"(gsrc),"s"(lds_dst):"memory");}
__device__ __forceinline__ float max3f(float a,float b,float c){float r;asm("v_max3_f32 %0, %1, %2, %3":"=v"(r):"v"(a),"v"(b),"v"(c));return r;}
__device__ __forceinline__ float max2f(float a,float b){float r;asm("v_max_f32_e32 %0, %1, %2":"=v"(r):"v"(a),"v"(b));return r;}
__device__ __forceinline__ float fadd_s(float a,float b){float r;asm("v_add_f32_e32 %0, %1, %2":"=v"(r):"v"(a),"v"(b));return r;}
__device__ __forceinline__ float fsub_s(float a,float b){float r;asm("v_sub_f32_e32 %0, %1, %2":"=v"(r):"v"(a),"v"(b));return r;}
typedef float f32x2_t __attribute__((ext_vector_type(2))); typedef __bf16 bf16x2_t __attribute__((ext_vector_type(2)));
__device__ __forceinline__ unsigned cvtpk_s(float lo,float hi){f32x2_t v={lo,hi};bf16x2_t b=__builtin_convertvector(v,bf16x2_t);return __builtin_bit_cast(unsigned,b);}
#define WAIT_BAR(N) asm volatile("s_waitcnt vmcnt(" #N ") lgkmcnt(0)\n\ts_barrier":::"memory")

__device__ __forceinline__ void qkt(f32x16&p0,f32x16&p1,const char*Kslot,const bf16x8*qr,const f32x16&negm,int r32,int hi){
  const char*kb=Kslot+hi*1024+r32*16;
  #pragma unroll
  for(int d0=0;d0<4;++d0){
    const bf16x8 b0=*reinterpret_cast<const bf16x8*>(kb+d0*2048);
    const bf16x8 b1=*reinterpret_cast<const bf16x8*>(kb+d0*2048+512);
    if(d0==0){p0=__builtin_amdgcn_mfma_f32_32x32x16_bf16(b0,qr[0],negm,0,0,0);p1=__builtin_amdgcn_mfma_f32_32x32x16_bf16(b1,qr[0],negm,0,0,0);}
    else{p0=__builtin_amdgcn_mfma_f32_32x32x16_bf16(b0,qr[d0],p0,0,0,0);p1=__builtin_amdgcn_mfma_f32_32x32x16_bf16(b1,qr[d0],p1,0,0,0);}}
}
typedef __attribute__((address_space(3))) const char* lds_cptr;
typedef short v4i16_t __attribute__((ext_vector_type(4)));
__device__ __forceinline__ void kload8(bf16x8*kf,lds_cptr kp){
  kf[0]=*(const __attribute__((address_space(3))) bf16x8*)(kp);      kf[1]=*(const __attribute__((address_space(3))) bf16x8*)(kp+512);
  kf[2]=*(const __attribute__((address_space(3))) bf16x8*)(kp+2048); kf[3]=*(const __attribute__((address_space(3))) bf16x8*)(kp+2560);
  kf[4]=*(const __attribute__((address_space(3))) bf16x8*)(kp+4096); kf[5]=*(const __attribute__((address_space(3))) bf16x8*)(kp+4608);
  kf[6]=*(const __attribute__((address_space(3))) bf16x8*)(kp+6144); kf[7]=*(const __attribute__((address_space(3))) bf16x8*)(kp+6656);
}
__device__ __forceinline__ void kload2(bf16x8*kf,lds_cptr kp,int j){ kf[2*j]=*(const __attribute__((address_space(3))) bf16x8*)(kp+j*2048); kf[2*j+1]=*(const __attribute__((address_space(3))) bf16x8*)(kp+j*2048+512); }
__device__ __forceinline__ s16x4 vtr(lds_cptr p){ return __builtin_bit_cast(s16x4,__builtin_amdgcn_ds_read_tr16_b64_v4i16((__attribute__((address_space(3))) v4i16_t*)p)); }
__device__ __forceinline__ float rowmax(const f32x16&p0,const f32x16&p1){
  float a=max3f(p0[0],p0[1],p1[0]),b=max3f(p0[2],p0[3],p1[1]);a=max3f(a,p1[2],p1[3]);
  #pragma unroll
  for(int r=4;r<16;r+=4){a=max3f(a,p0[r],p0[r+1]);b=max3f(b,p0[r+2],p0[r+3]);a=max3f(a,p1[r],p1[r+1]);b=max3f(b,p1[r+2],p1[r+3]);}
  const float m=max2f(a,b);
  auto rr=__builtin_amdgcn_permlane32_swap(__float_as_uint(m),__float_as_uint(m),false,false);
  return max2f(__uint_as_float(rr[0]),__uint_as_float(rr[1]));
}
__device__ __forceinline__ void pv(f32x16*o,int vb,bf16x8 pa0,bf16x8 pa1,bf16x8 pa2,bf16x8 pa3){
  #pragma unroll
  for(int d0=0;d0<2;++d0){s16x4 lo[4],hi[4];
    #pragma unroll
    for(int ks=0;ks<4;++ks){
      asm volatile("ds_read_b64_tr_b16 %0,%1 offset:%c2":"=&v"(lo[ks]):"v"(vb),"i"(d0*4096+ks*1024):"memory");
      asm volatile("ds_read_b64_tr_b16 %0,%1 offset:%c2":"=&v"(hi[ks]):"v"(vb),"i"(d0*4096+ks*1024+512):"memory");}
    asm volatile("s_waitcnt lgkmcnt(0)":::"memory");SBAR();
    #define PK(k) (bf16x8){lo[k][0],lo[k][1],lo[k][2],lo[k][3],hi[k][0],hi[k][1],hi[k][2],hi[k][3]}
    o[d0]=__builtin_amdgcn_mfma_f32_32x32x16_bf16(pa0,PK(0),o[d0],0,0,0);
    o[d0]=__builtin_amdgcn_mfma_f32_32x32x16_bf16(pa1,PK(1),o[d0],0,0,0);
    o[d0]=__builtin_amdgcn_mfma_f32_32x32x16_bf16(pa2,PK(2),o[d0],0,0,0);
    o[d0]=__builtin_amdgcn_mfma_f32_32x32x16_bf16(pa3,PK(3),o[d0],0,0,0);
    #undef PK
  }
}

#ifndef ATTN_STORE16
#define ATTN_STORE16(p,v) (*(u32x4*)(p)=(v))
#endif
template<int THRL> __device__ __forceinline__ void attn_unit(const bf16*Qu,const bf16*__restrict__ Kh,const bf16*__restrict__ Vh,bf16*Ou,const int p0,const int NT,const float* sinkp,const float* qg,const float2* ropet,char*shm){
  int tid=threadIdx.x; asm volatile("":"+v"(tid)); const int lane=tid&63,r32=lane&31,hi=lane>>5; const int wid=__builtin_amdgcn_readfirstlane(tid>>6);
  const int hsub=wid>>1, psub=(wid&1)*QBLK;
  const bf16*Qw=Qu+(long)psub*QP+hsub*D;
  const unsigned lds0=(unsigned)(uintptr_t)shm;
  float*wsf=(float*)(shm+LDS_WS)+wid*64;
  const bf16*ksrc=Kh+(long)lane*KVP+wid*8;
  const bf16*vsrc=Vh+(long)(16*(wid&3)+(lane>>2))*KVP+(wid>>2)*32+(lane&3)*8;
  const unsigned kdst=lds0+LDS_K+wid*1024, vdst=lds0+LDS_V+wid*1024;
  #define KP0(t) (p0-128+64*((t)-4))
  #define TROW(t) ((t)<4?64*(t):(((unsigned)KP0(t)<4096u)?256+KP0(t):256))
  #define DMA_K(t,slot) glds16(ksrc+(long)TROW(t)*KVP,(unsigned)__builtin_amdgcn_readfirstlane(kdst+(slot)))
  #define DMA_V(t,slot) glds16(vsrc+(long)TROW(t)*KVP,(unsigned)__builtin_amdgcn_readfirstlane(vdst+(slot)))
  const int vb0=(int)(lds0+LDS_V)+((lane>>4)&1)*32+(lane&3)*8+(4*hi+((lane&15)>>2))*64;
  const char*Kbase=shm+LDS_K; bf16x8 kf[8];
  const lds_cptr shm3=(lds_cptr)shm; const lds_cptr kp0=shm3+LDS_K+hi*1024+r32*16; const lds_cptr vp0=shm3+LDS_V+((lane>>4)&1)*32+(lane&3)*8+(4*hi+((lane&15)>>2))*64;
  DMA_K(0,0);DMA_V(0,0);DMA_K(1,SLOTB);
  bf16x8 qr[4];
  { bf16x8 qraw[4];
    #pragma unroll
    for(int d0=0;d0<4;++d0)qraw[d0]=*reinterpret_cast<const bf16x8*>(&Qw[(long)r32*QP+d0*16+hi*8]);
    float qf[4][8]; float ss=0.f;
    #pragma unroll
    for(int d0=0;d0<4;++d0)
      #pragma unroll
      for(int j=0;j<8;++j){ qf[d0][j]=__builtin_bit_cast(float,(unsigned)(unsigned short)qraw[d0][j]<<16); ss+=qf[d0][j]*qf[d0][j]; }
    ss+=__shfl_xor(ss,32);
    const float rstd=1.0f/sqrtf(ss*(1.f/64.f)+1e-6f)*C2;
    #pragma unroll
    for(int d0=0;d0<4;++d0)
      #pragma unroll
      for(int j=0;j<8;++j) qf[d0][j]*=rstd*qg[16*d0+8*hi+j];
    if(ropet){ const float2* rp=ropet+(long)(p0+psub+r32)*32+8*hi;
      #pragma unroll
      for(int j=0;j<8;++j){ const float2 c1=rp[j],c2=rp[16+j];
        const float a=qf[0][j],b=qf[1][j],c=qf[2][j],d=qf[3][j];
        qf[0][j]=a*c1.x-b*c1.y; qf[1][j]=b*c1.x+a*c1.y; qf[2][j]=c*c2.x-d*c2.y; qf[3][j]=d*c2.x+c*c2.y; } }
    #pragma unroll
    for(int d0=0;d0<4;++d0){ u32x4 w; w[0]=cvtpk_s(qf[d0][0],qf[d0][1]); w[1]=cvtpk_s(qf[d0][2],qf[d0][3]); w[2]=cvtpk_s(qf[d0][4],qf[d0][5]); w[3]=cvtpk_s(qf[d0][6],qf[d0][7]); qr[d0]=__builtin_bit_cast(bf16x8,w); } }
  float mhat=0.f,l_reg=0.f;f32x16 o[2];o[0]=f32x16{};o[1]=f32x16{};f32x16 negm=f32x16{};asm volatile("":"+v"(negm));
  const int qpos=p0+psub+r32;
  #define CMASK(P0,P1,t) do{ if((t)>=4)wmask(P0,P1,KP0(t),qpos,hi); }while(0)
  bool resc=false;
  #define START(P0,P1) do{ const float rm=rowmax(P0,P1); resc=false; \
    { const float dl=rm; mhat=fadd_s(mhat,dl); \
      _Pragma("unroll") for(int r=0;r<16;++r){P0[r]=fsub_s(P0[r],dl);P1[r]=fsub_s(P1[r],dl);} \
      _Pragma("unroll") for(int r=0;r<16;++r)negm[r]=-mhat; asm volatile("":"+v"(negm)); } \
    _Pragma("unroll") for(int r=0;r<16;++r)P0[r]=__builtin_amdgcn_exp2f(P0[r]); }while(0)
  #define RESC() do{ if(resc){ asm volatile("s_waitcnt lgkmcnt(0)":::"memory"); \
      _Pragma("unroll") for(int d_=0;d_<2;++d_) _Pragma("unroll") for(int r=0;r<16;++r)o[d_][r]*=wsf[crow(r,hi)]; } }while(0)
  f32x16 pA0,pA1,pB0,pB1;
  int sl_prev=0,sl_cur=0,sl_next=SLOTB;
  #define ROT() do{sl_prev=sl_cur;sl_cur=sl_next;sl_next=(sl_next==(NSLOT-1)*SLOTB)?0:sl_next+SLOTB;}while(0)
  DMA_K(2,2*SLOTB);
  WAIT_BAR(3);
  qkt(pA0,pA1,Kbase,qr,negm,r32,hi);asm volatile("s_nop 15\n\ts_nop 7":"+v"(pA0),"+v"(pA1));CMASK(pA0,pA1,0);
  START(pA0,pA1);
  _Pragma("unroll") for(int r=0;r<16;++r)pA1[r]=__builtin_amdgcn_exp2f(pA1[r]);
  WAIT_BAR(0);
  DMA_K(3,0);DMA_V(1,SLOTB);
  ROT();
  kload8(kf,kp0+sl_cur);
  WAIT_BAR(2);
  s16x4 vlo[8],vhi[8]; u32x4 pw0,pw1,pw2,pw3;
  #define PKW(P,B) cvtpk_s(P[B],P[B+1])
  #define PAF(k) __builtin_bit_cast(bf16x8,pw##k)
  #define VFR(i) (bf16x8){vlo[i][0],vlo[i][1],vlo[i][2],vlo[i][3],vhi[i][0],vhi[i][1],vhi[i][2],vhi[i][3]}
  #define PIN(x) asm volatile("":"+v"(x))
  #define MX3(a,b,c) __builtin_fmaxf(__builtin_fmaxf((a),(b)),(c))
  #define GAPA(MF,A0,A1,A2,A3,W0,W1,PW) do{ MF; sacc+=A0; sacc+=A1; sacc+=A2; sacc+=A3; PIN(sacc); W0; W1; PIN(PW); SBAR(); }while(0)
  #define EX(v) __builtin_amdgcn_exp2f(v)
  #define GAPB(MF,X,B) do{ MF; X[B]=EX(X[B]); X[B+1]=EX(X[B+1]); X[B+2]=EX(X[B+2]); X[B+3]=EX(X[B+3]); PIN(X); SBAR(); }while(0)
  #define VRD(i) do{ vlo[i]=vtr(vp_+(((i)>>2)*4096+((i)&3)*1024)); vhi[i]=vtr(vp_+(((i)>>2)*4096+((i)&3)*1024+512)); }while(0)
  #define KRD(G,j) do{ if(G){ kload2(kf,kp0+sl_next,j); SBAR(); } }while(0)
  #define STEP(C0,C1,P0,P1,t,GK,GV,GL) do{ SBAR(); \
    const lds_cptr vp_=vp0+sl_prev; \
    VRD(0); SBAR(); float sacc=(P0[0]+P0[1]); \
    GAPA(C0=__builtin_amdgcn_mfma_f32_32x32x16_bf16(kf[0],qr[0],negm,0,0,0), P0[2],P0[3],P0[4],P0[5],     pw0[0]=PKW(P0,0), pw0[1]=PKW(P0,2), pw0); \
    VRD(4); SBAR(); GAPA(C1=__builtin_amdgcn_mfma_f32_32x32x16_bf16(kf[1],qr[0],negm,0,0,0), P0[6],P0[7],P0[8],P0[9],     pw0[2]=PKW(P0,4), pw0[3]=PKW(P0,6), pw0); \
    VRD(1); SBAR(); GAPA(C0=__builtin_amdgcn_mfma_f32_32x32x16_bf16(kf[2],qr[1],C0,0,0,0),   P0[10],P0[11],P0[12],P0[13], pw1[0]=PKW(P0,8), pw1[1]=PKW(P0,10), pw1); \
    VRD(5); SBAR(); GAPA(C1=__builtin_amdgcn_mfma_f32_32x32x16_bf16(kf[3],qr[1],C1,0,0,0),   P0[14],P0[15],P1[0],P1[1],   pw1[2]=PKW(P0,12),pw1[3]=PKW(P0,14), pw1); \
    VRD(2); SBAR(); GAPA(C0=__builtin_amdgcn_mfma_f32_32x32x16_bf16(kf[4],qr[2],C0,0,0,0),   P1[2],P1[3],P1[4],P1[5],     pw2[0]=PKW(P1,0), pw2[1]=PKW(P1,2), pw2); \
    VRD(6); SBAR(); GAPA(C1=__builtin_amdgcn_mfma_f32_32x32x16_bf16(kf[5],qr[2],C1,0,0,0),   P1[6],P1[7],P1[8],P1[9],     pw2[2]=PKW(P1,4), pw2[3]=PKW(P1,6), pw2); \
    VRD(3); SBAR(); GAPA(C0=__builtin_amdgcn_mfma_f32_32x32x16_bf16(kf[6],qr[3],C0,0,0,0),   P1[10],P1[11],P1[12],P1[13], pw3[0]=PKW(P1,8), pw3[1]=PKW(P1,10), pw3); \
    VRD(7); SBAR(); GAPA(C1=__builtin_amdgcn_mfma_f32_32x32x16_bf16(kf[7],qr[3],C1,0,0,0),   P1[14],P1[15],0.f,0.f,       pw3[2]=PKW(P1,12),pw3[3]=PKW(P1,14), pw3); \
    l_reg+=sacc; \
    if(GK){DMA_K((t)+3,sl_cur);} if(GV){DMA_V((t)+1,sl_next);} \
    CMASK(C0,C1,t); \
    { float a=MX3(C0[0],C0[1],C1[0]),b=MX3(C0[2],C0[3],C1[1]); a=MX3(a,C1[2],C1[3]); \
      _Pragma("unroll") for(int r=4;r<16;r+=4){a=MX3(a,C0[r],C0[r+1]);b=MX3(b,C0[r+2],C0[r+3]);a=MX3(a,C1[r],C1[r+1]);b=MX3(b,C1[r+2],C1[r+3]);} \
      float rm=__builtin_fmaxf(a,b); { auto rr=__builtin_amdgcn_permlane32_swap(__float_as_uint(rm),__float_as_uint(rm),false,false); rm=__builtin_fmaxf(__uint_as_float(rr[0]),__uint_as_float(rr[1])); } \
      resc=false; \
      if(__builtin_expect(__any(rm>(float)THRL),0)){ const float dl=__builtin_fmaxf(rm,0.f); mhat+=dl; \
        _Pragma("unroll") for(int r=0;r<16;++r){C0[r]-=dl;C1[r]-=dl;} \
        _Pragma("unroll") for(int r=0;r<16;++r)negm[r]=-mhat; asm volatile("":"+v"(negm)); \
        const float f=__builtin_amdgcn_exp2f(-dl); l_reg*=f; if(hi==0)wsf[r32]=f; resc=true; } } \
    SBAR(); \
    GAPB(o[0]=__builtin_amdgcn_mfma_f32_32x32x16_bf16(PAF(0),VFR(0),o[0],0,0,0), C0,0); \
    GAPB(o[1]=__builtin_amdgcn_mfma_f32_32x32x16_bf16(PAF(0),VFR(4),o[1],0,0,0), C0,4); \
    KRD(GL,0); GAPB(o[0]=__builtin_amdgcn_mfma_f32_32x32x16_bf16(PAF(1),VFR(1),o[0],0,0,0), C0,8); \
    KRD(GL,1); GAPB(o[1]=__builtin_amdgcn_mfma_f32_32x32x16_bf16(PAF(1),VFR(5),o[1],0,0,0), C0,12); \
    KRD(GL,2); GAPB(o[0]=__builtin_amdgcn_mfma_f32_32x32x16_bf16(PAF(2),VFR(2),o[0],0,0,0), C1,0); \
    KRD(GL,3); GAPB(o[1]=__builtin_amdgcn_mfma_f32_32x32x16_bf16(PAF(2),VFR(6),o[1],0,0,0), C1,4); \
    GAPB(o[0]=__builtin_amdgcn_mfma_f32_32x32x16_bf16(PAF(3),VFR(3),o[0],0,0,0), C1,8); \
    GAPB(o[1]=__builtin_amdgcn_mfma_f32_32x32x16_bf16(PAF(3),VFR(7),o[1],0,0,0), C1,12); \
    }while(0)
  int t=1;
  for(;t+5<NT;t+=2){
    STEP(pB0,pB1,pA0,pA1,t,true,true,true);     WAIT_BAR(2); RESC(); ROT();
    STEP(pA0,pA1,pB0,pB1,t+1,true,true,true);   WAIT_BAR(2); RESC(); ROT();
  }
  #define ENDW(tt) do{ if((tt)+3<NT){WAIT_BAR(2);} else if((tt)+2<NT){WAIT_BAR(1);} else {WAIT_BAR(0);} }while(0)
  for(;t+1<NT;t+=2){
    STEP(pB0,pB1,pA0,pA1,t,(t+3<NT),(t+1<NT),(t+1<NT));       ENDW(t);   RESC(); ROT();
    STEP(pA0,pA1,pB0,pB1,t+1,(t+4<NT),(t+2<NT),(t+2<NT));     ENDW(t+1); RESC(); ROT();
  }
  STEP(pB0,pB1,pA0,pA1,NT-1,false,false,false); RESC();
  { float sacc=pB0[0]+pB0[1]; _Pragma("unroll") for(int r=2;r<16;++r)sacc+=pB0[r]; _Pragma("unroll") for(int r=0;r<16;++r)sacc+=pB1[r]; l_reg+=sacc;
    pw0=(u32x4){PKW(pB0,0),PKW(pB0,2),PKW(pB0,4),PKW(pB0,6)};pw1=(u32x4){PKW(pB0,8),PKW(pB0,10),PKW(pB0,12),PKW(pB0,14)};pw2=(u32x4){PKW(pB1,0),PKW(pB1,2),PKW(pB1,4),PKW(pB1,6)};pw3=(u32x4){PKW(pB1,8),PKW(pB1,10),PKW(pB1,12),PKW(pB1,14)};
    SBAR(); pv(o,vb0+sl_cur,PAF(0),PAF(1),PAF(2),PAF(3)); }
  #undef PKW
  #undef PAF
  #undef VFR
  #undef PIN
  #undef MX3
  #undef GAPA
  #undef GAPB
  #undef EX
  #undef VRD
  #undef KRD
  #undef STEP
  #undef ENDW
  l_reg+=__shfl_xor(l_reg,32);
  l_reg+=__builtin_amdgcn_exp2f(sinkp[hsub]*1.4426950408889634f-mhat);
  if(hi==0)wsf[32+r32]=l_reg;asm volatile("s_waitcnt lgkmcnt(0)":::"memory");
  float rli[16];
  #pragma unroll
  for(int r=0;r<16;++r)rli[r]=__builtin_amdgcn_rcpf(wsf[32+crow(r,hi)]);
  bf16*Ow=Ou+(long)psub*OP+hsub*D;
  { bf16*stg=(bf16*)(shm+LDS_OST)+wid*2048;
    #pragma unroll
    for(int r=0;r<16;++r){const int orow=crow(r,hi);
      #pragma unroll
      for(int d0=0;d0<2;++d0)stg[orow*64+d0*32+r32]=__float2bfloat16(o[d0][r]*rli[r]);}
    asm volatile("s_waitcnt lgkmcnt(0)":::"memory");
    #pragma unroll
    for(int i=0;i<4;++i){const int row=i*8+(lane>>3),ch=lane&7; const u32x4 v=*(const u32x4*)(stg+row*64+ch*8); ATTN_STORE16(Ow+(long)row*OP+ch*8,v);} }
  asm volatile("s_waitcnt lgkmcnt(0)\n\ts_barrier":::"memory");
  #undef DMA_K
  #undef DMA_V
  #undef KP0
  #undef TROW
  #undef CMASK
  #undef START
  #undef RESC
  #undef ROT
}
constexpr int ATTN_LDS_BYTES=LDS_BYTES;
#undef SBAR
#undef WAIT_BAR
}

constexpr int SLAB_PITCH = 288;
typedef short v4i16_t __attribute__((ext_vector_type(4)));
template <int MT, class RowAddr, class Epi>
__device__ __forceinline__ void slab_gemm(LAS unsigned char* lds, const bf16* Cmat, const int K, const RowAddr& RA, const Epi& E) {
    int tid = threadIdx.x; asm volatile("" : "+v"(tid));
    const int wid = tid >> 6, lane = tid & 63;
    LAS bf16* Dr = (LAS bf16*)lds;
    f32x16 acc[MT];
#pragma unroll
    for (int i = 0; i < MT; ++i)
#pragma unroll
        for (int r = 0; r < 16; ++r) acc[i][r] = 0.f;
    const int g = (lane >> 4) & 1, h = lane >> 5, qq = (lane & 15) >> 2, pp = lane & 3;
    const LAS bf16* trp = Dr + (8 * h + qq) * SLAB_PITCH + wid * 32 + 16 * g + 4 * pp;
    for (int kc = 0; kc < K; kc += 128) {
        {
            const int k = tid >> 2, qd = tid & 3;
            const bf16* src = RA(kc + k) + qd * 64;
            v4u v[8];
#pragma unroll
            for (int j = 0; j < 8; ++j) v[j] = *(const v4u*)(src + j * 8);
#pragma unroll
            for (int j = 0; j < 8; ++j) *(LAS v4u*)(Dr + k * SLAB_PITCH + qd * 64 + j * 8) = v[j];
        }
        __syncthreads();
        const int kh = h * 8;
#pragma unroll
        for (int s = 0; s < 8; ++s) {
            const v4i16_t b0 = __builtin_amdgcn_ds_read_tr16_b64_v4i16((LAS v4i16_t*)(trp + (16 * s) * SLAB_PITCH));
            const v4i16_t b1 = __builtin_amdgcn_ds_read_tr16_b64_v4i16((LAS v4i16_t*)(trp + (16 * s + 4) * SLAB_PITCH));
            const bf16x8 bfrag = (bf16x8){b0[0], b0[1], b0[2], b0[3], b1[0], b1[1], b1[2], b1[3]};
#pragma unroll
            for (int mt = 0; mt < MT; ++mt) {
                const bf16x8 afrag = *(const bf16x8*)(Cmat + (size_t)(mt * 32 + (lane & 31)) * K + kc + s * 16 + kh);
                acc[mt] = __builtin_amdgcn_mfma_f32_32x32x16_bf16(afrag, bfrag, acc[mt], 0, 0, 0);
            }
        }
        __syncthreads();
    }
    E(acc, wid, lane, lds);
}

struct Args { const float* in[23]; float* out; unsigned char* ws; int ph_lo, ph_hi; };

constexpr int SOUT_PITCH = 264;
template <int NROWS, bool WT, class RowPtr>
__device__ __forceinline__ void slab_store_rows(LAS unsigned char* lds, const RowPtr& RP) {
    int tid = threadIdx.x; asm volatile("" : "+v"(tid));
    __syncthreads();
#pragma unroll
    for (int k = 0; k < NROWS / 16; ++k) { const int row = (tid >> 5) + 16 * k, chunk = tid & 31;
        const v4u v = *(const LAS v4u*)((LAS bf16*)lds + row * SOUT_PITCH + chunk * 8);
        bf16* dst = RP(row) + chunk * 8;
        if (WT) store16_wt(dst, v); else *(v4u*)dst = v; }
    __syncthreads();
}
struct RowA { const bf16* z; int b, n2; __device__ __forceinline__ const bf16* operator()(int k) const { return z + (size_t)(b * 4096 + 64 * (k & 63) + n2) * 512 + (k >> 6) * 256; } };
struct RowPA { bf16* t2; int b, n2; __device__ __forceinline__ bf16* operator()(int m) const { return t2 + ((size_t)((b * 64 + n2) * 64 + (m & 63)) * 2 + (m >> 6)) * 256; } };
template <bool WT> struct EpiA { bf16* t2; const float2* tw; int b, n2;
    __device__ __forceinline__ void operator()(const f32x16 (&acc)[4], int wid, int lane, LAS unsigned char* lds) const {
        const int ch = wid * 32 + (lane & 31); LAS bf16* so = (LAS bf16*)lds;
#pragma unroll
        for (int mt = 0; mt < 2; ++mt)
#pragma unroll
            for (int r = 0; r < 16; ++r) {
                const int k1 = 32 * mt + (r & 3) + 8 * (r >> 2) + 4 * (lane >> 5);
                const float2 cs = tw[n2 * k1]; const float re = acc[mt][r], im = acc[mt + 2][r];
                const float re2 = cs.x * re + cs.y * im, im2 = cs.x * im - cs.y * re;
                so[k1 * SOUT_PITCH + ch] = (bf16)f2bf(re2); so[(64 + k1) * SOUT_PITCH + ch] = (bf16)f2bf(im2);
            }
        RowPA rp{t2, b, n2}; slab_store_rows<128, WT, RowPA>(lds, rp);
    } };
struct RowB { const bf16* t2; int b, k1; __device__ __forceinline__ const bf16* operator()(int k) const { return t2 + ((size_t)((b * 64 + (k & 63)) * 64 + k1) * 2 + (k >> 6)) * 256; } };
struct RowPB { bf16* mrg; int b, k1; __device__ __forceinline__ bf16* operator()(int k2) const { return mrg + (size_t)(b * 4096 + k1 + 64 * k2) * 1024 + 768; } };
struct EpiB { bf16* mrg; int b, k1;
    __device__ __forceinline__ void operator()(const f32x16 (&acc)[2], int wid, int lane, LAS unsigned char* lds) const {
        const int ch = wid * 32 + (lane & 31); LAS bf16* so = (LAS bf16*)lds;
#pragma unroll
        for (int mt = 0; mt < 2; ++mt)
#pragma unroll
            for (int r = 0; r < 16; ++r) { const int k2 = 32 * mt + (r & 3) + 8 * (r >> 2) + 4 * (lane >> 5); so[k2 * SOUT_PITCH + ch] = (bf16)f2bf(DBG_NO_FOUR ? 0.f : acc[mt][r]); }
        RowPB rp{mrg, b, k1}; slab_store_rows<64, false, RowPB>(lds, rp);
    } };
struct RowC { const bf16* z; int b; __device__ __forceinline__ const bf16* operator()(int k) const { return z + (size_t)(T + b * 256 + (k & 255)) * 512 + (k >> 8) * 256; } };
struct RowPC { bf16* mrg; int b, mt0; __device__ __forceinline__ bf16* operator()(int kk) const { return mrg + (size_t)(T + b * 256 + 32 * mt0 + kk) * 1024 + 768; } };
struct EpiC { bf16* mrg; int b, mt0;
    __device__ __forceinline__ void operator()(const f32x16 (&acc)[1], int wid, int lane, LAS unsigned char* lds) const {
        const int ch = wid * 32 + (lane & 31); LAS bf16* so = (LAS bf16*)lds;
#pragma unroll
        for (int r = 0; r < 16; ++r) { const int kk = (r & 3) + 8 * (r >> 2) + 4 * (lane >> 5); so[kk * SOUT_PITCH + ch] = (bf16)f2bf(DBG_NO_FOUR ? 0.f : acc[0][r]); }
        RowPC rp{mrg, b, mt0}; slab_store_rows<32, false, RowPC>(lds, rp);
    } };

__device__ __forceinline__ void tr_block(const float* src, int ldS, bf16* dst, int ldD, LAS float* scr, int lane) {
#pragma unroll 8
    for (int i = 0; i < 32; ++i) { const int kk = 2 * i + (lane >> 5); scr[kk * 33 + (lane & 31)] = src[(size_t)kk * ldS + (lane & 31)]; }
    LDS_WAIT(); asm volatile("" ::: "memory");
    const int c = lane & 7;
#pragma unroll
    for (int j = 0; j < 4; ++j) { const int n = (lane >> 3) + 8 * j; const LAS float* s = scr + (8 * c) * 33 + n;
        v4u o; o.x = pk2(s[0 * 33], s[1 * 33]); o.y = pk2(s[2 * 33], s[3 * 33]); o.z = pk2(s[4 * 33], s[5 * 33]); o.w = pk2(s[6 * 33], s[7 * 33]);
        *(GAS v4u*)(dst + (size_t)n * ldD + 8 * c) = o; }
    LDS_WAIT(); asm volatile("" ::: "memory");
}


__device__ __forceinline__ void tr_block64(const float* src, int ldS, bf16* dst, int ldD, LAS bf16* scr, int lane) {
    const int kr = lane >> 4, nc = lane & 15;
    f32x4 v[16];
#pragma unroll
    for (int i = 0; i < 16; ++i) v[i] = *(const f32x4*)(src + (size_t)(4 * i + kr) * ldS + 4 * nc);
#pragma unroll
    for (int i = 0; i < 16; ++i) { const int k = 4 * i + kr;
#pragma unroll
        for (int j = 0; j < 4; ++j) scr[(4 * nc + j) * 66 + k] = (bf16)f2bf(v[i][j]); }
    LDS_WAIT(); asm volatile("" ::: "memory");
    const int c = lane & 7;
#pragma unroll
    for (int j = 0; j < 8; ++j) { const int n = (lane >> 3) + 8 * j; const LAS unsigned* p = (const LAS unsigned*)(scr + n * 66 + 8 * c);
        v4u o; o.x = p[0]; o.y = p[1]; o.z = p[2]; o.w = p[3];
        *(GAS v4u*)(dst + (size_t)n * ldD + 8 * c) = o; }
    LDS_WAIT(); asm volatile("" ::: "memory");
}

__device__ __forceinline__ void tr_block64_f8(const float* src, int ldS, unsigned char* dst, int ldD, LAS unsigned char* scr, int lane, float sc) {
    const int nq = lane & 15, kq0 = lane >> 4;
    f32x4 v[4][4];
#pragma unroll
    for (int sb = 0; sb < 4; ++sb)
#pragma unroll
        for (int r = 0; r < 4; ++r) v[sb][r] = *(const f32x4*)(src + (size_t)(4 * (kq0 + 4 * sb) + r) * ldS + 4 * nq);
#pragma unroll
    for (int sb = 0; sb < 4; ++sb)
#pragma unroll
        for (int j = 0; j < 4; ++j) *(LAS unsigned*)(scr + (4 * nq + j) * 68 + 4 * (kq0 + 4 * sb)) = pk4_f8(v[sb][0][j] * sc, v[sb][1][j] * sc, v[sb][2][j] * sc, v[sb][3][j] * sc);
    LDS_WAIT(); asm volatile("" ::: "memory");
    const int c = lane & 3;
#pragma unroll
    for (int jj = 0; jj < 4; ++jj) { const int n = (lane >> 2) + 16 * jj; const LAS unsigned* p = (const LAS unsigned*)(scr + n * 68 + 16 * c);
        v4u o; o.x = p[0]; o.y = p[1]; o.z = p[2]; o.w = p[3];
        *(GAS v4u*)(dst + (size_t)n * ldD + 16 * c) = o; }
    LDS_WAIT(); asm volatile("" ::: "memory");
}

template <int HW> __device__ __forceinline__ void pool_item(const bf16* up, bf16* op, const int n0, const int nseq) {
    constexpr int NR = 2 * HW + 7;
    v4u w[NR];
#pragma unroll
    for (int j = 0; j < NR; ++j) { const int t = n0 - HW + j; const int tc = t < 0 ? 0 : (t > nseq - 1 ? nseq - 1 : t); w[j] = *(const v4u*)(up + (size_t)tc * 256); }
#pragma unroll
    for (int j = 0; j < NR; ++j) { const int t = n0 - HW + j; if (t < 0 || t >= nseq) w[j] = (v4u){0u, 0u, 0u, 0u}; }
    float sm[8] = {0.f, 0.f, 0.f, 0.f, 0.f, 0.f, 0.f, 0.f};
#define POOL_ACC(W, SGN) do { sm[0] += SGN bflo(W.x); sm[1] += SGN bfhi(W.x); sm[2] += SGN bflo(W.y); sm[3] += SGN bfhi(W.y); sm[4] += SGN bflo(W.z); sm[5] += SGN bfhi(W.z); sm[6] += SGN bflo(W.w); sm[7] += SGN bfhi(W.w); } while (0)
#pragma unroll
    for (int j = 0; j < 2 * HW; ++j) POOL_ACC(w[j], +);
#pragma unroll
    for (int k = 0; k < 8; ++k) {
        const int n = n0 + k; int lo_ = n - HW; lo_ = lo_ < 0 ? 0 : lo_; int hi_ = n + HW - 1; hi_ = hi_ > nseq - 1 ? nseq - 1 : hi_;
        const v4u c = w[HW + k]; const float ic = 1.0f / (float)(hi_ - lo_ + 1);
        v4u o; o.x = pk2(sm[0] * ic - bflo(c.x), sm[1] * ic - bfhi(c.x)); o.y = pk2(sm[2] * ic - bflo(c.y), sm[3] * ic - bfhi(c.y));
        o.z = pk2(sm[4] * ic - bflo(c.z), sm[5] * ic - bfhi(c.z)); o.w = pk2(sm[6] * ic - bflo(c.w), sm[7] * ic - bfhi(c.w));
        if (DBG_NO_POOL) o = (v4u){0u, 0u, 0u, 0u};
        *(v4u*)(op + (size_t)k * 1024) = o;
        if (k < 7) { POOL_ACC(w[k + 2 * HW], +); POOL_ACC(w[k], -); }
    }
#undef POOL_ACC
}

typedef const __attribute__((address_space(4))) Args* kargs_t;
__device__ __forceinline__ kargs_t ka_launder() { kargs_t p = (kargs_t)__builtin_amdgcn_kernarg_segment_ptr(); asm volatile("" : "+s"(p)); return p; }
__device__ __forceinline__ int tid_launder() { int t = threadIdx.x; asm volatile("" : "+v"(t)); return t; }
#define KA_DECL const kargs_t KA = ka_launder(); const int tid = tid_launder(); const int lane = tid & 63; const int wave = __builtin_amdgcn_readfirstlane(tid >> 6); const int gw = vcu * 8 + wave; const int gt = vcu * 512 + tid; (void)lane; (void)wave; (void)gw; (void)gt;
#define ws (KA->ws)
#define ctl ((gu32*)(ws + O_CTL))
#define x_in (KA->in[0])
#define c_in (KA->in[1])
#define ctx_in (KA->in[2])
#define cctx_in (KA->in[3])
#define w_mod (KA->in[4])
#define b_mod (KA->in[5])
#define norm1_g (KA->in[6])
#define w_in (KA->in[7])
#define q_norm_g (KA->in[8])
#define k_norm_g (KA->in[9])
#define attn_sink (KA->in[10])
#define pool_w (KA->in[11])
#define pool_scale (KA->in[12])
#define four_w (KA->in[13])
#define w_out (KA->in[14])
#define norm2_g (KA->in[15])
#define w_grp (KA->in[16])
#define b_grp (KA->in[17])
#define w_rtr (KA->in[18])
#define b_rtr (KA->in[19])
#define w_gate (KA->in[20])
#define w_up (KA->in[21])
#define w_down (KA->in[22])
#define outp (KA->out)
#define modv ((float*)(ws + O_MOD))
#define rope ((float2*)(ws + O_ROPE))
#define twt ((float2*)(ws + O_TW))
#define fma ((bf16*)(ws + O_FMA))
#define fmb ((bf16*)(ws + O_FMB))
#define fmc ((bf16*)(ws + O_FMC))
#define hbuf ((bf16*)(ws + O_H))
#define kall ((bf16*)(ws + O_KALL))
#define vall ((bf16*)(ws + O_VALL))
#define xc ((float*)(ws + O_XC))
#define xb ((bf16*)(ws + O_XB))
#define list ((unsigned*)(ws + O_LIST))
#define wts ((float*)(ws + O_WTS))
#define act ((bf16*)(ws + O_ACT))
#define t2 ((bf16*)(ws + O_T2))
#define mrg ((bf16*)(ws + O_MRG))
#define qb ((bf16*)(ws + O_Q))
#define pu ((bf16*)(ws + O_PU))
#define zb ((bf16*)(ws + O_Z))
#define y2 ((bf16*)(ws + O_Y2))

#ifndef PH_MASK
#define PH_MASK 0x3ffff
#endif
#define IN(k) (lo <= (k) && (k) < hi && ((PH_MASK >> (k)) & 1))
#define SEAM(k) do { if (IN(k) && IN((k) + 1)) xcd_barrier(bar); } while (0)
#define modl (modv + (size_t)l * 5 * 6144)
#define win_t ((bf16*)(ws + O_WIN + l * SZ_WIN1))
#define wout_t ((bf16*)(ws + O_WOUT + l * SZ_WOUT1))
#define wgu_t ((bf16*)(ws + O_WGU + l * SZ_WGU1))
#define wd_t ((bf16*)(ws + O_WD + l * SZ_WD1))
constexpr int CV_A = 256, CV_B = 192, CV_C = 4096, CV_D = 2048, CV_L = CV_A + CV_B + CV_C + CV_D;
__device__ __forceinline__ void conv_item(const kargs_t KA, const int lw, int it, LAS bf16* scr, const int lane) {
    bf16* p_win_t = (bf16*)(ws + O_WIN + lw * SZ_WIN1); bf16* p_wout_t = (bf16*)(ws + O_WOUT + lw * SZ_WOUT1);
    bf16* p_wgu_t = (bf16*)(ws + O_WGU + lw * SZ_WGU1); bf16* p_wd_t = (bf16*)(ws + O_WD + lw * SZ_WD1);
    if (it < CV_A) { const int kb = it >> 4, nb = it & 15; const float* src = w_in + (size_t)lw * 1024 * 1280 + (size_t)kb * 64 * 1280 + nb * 64;
        if (nb < 4) tr_block64(src, 1280, p_win_t + (size_t)nb * 64 * 1024 + kb * 64, 1024, scr, lane);
        else tr_block64_f8(src, 1280, (unsigned char*)(ws + O_WIN8 + lw * SZ_WIN8) + (size_t)(nb * 64 - 256) * 1024 + kb * 64, 1024, (LAS unsigned char*)scr, lane, 64.0f);
        return; } it -= CV_A;
    if (it < CV_B) { const int kb = 4 + (it >> 4), nb = it & 15; tr_block64(w_out + (size_t)lw * 1024 * 1024 + (size_t)kb * 64 * 1024 + nb * 64, 1024, p_wout_t + (size_t)nb * 64 * 1024 + kb * 64, 1024, scr, lane); return; } it -= CV_B;
    if (it < CV_C) { const int up = it >> 11, r = it & 2047, e = r >> 7, kb = (r >> 3) & 15, nb = r & 7; const int n0 = nb * 64;
        const float* src = (up ? w_up : w_gate) + ((size_t)(lw * 16 + e) * 1024 + kb * 64) * 512 + n0;
        const int drow = (n0 >> 7) * 256 + up * 128 + (n0 & 127);
        tr_block64_f8(src, 512, (unsigned char*)p_wgu_t + ((size_t)e * 1024 + drow) * 1024 + kb * 64, 1024, (LAS unsigned char*)scr, lane, 64.0f); return; } it -= CV_C;
    { const int e = it >> 7, kb = (it >> 4) & 7, nb = it & 15;
        tr_block64_f8(w_down + ((size_t)(lw * 16 + e) * 512 + kb * 64) * 1024 + nb * 64, 1024, (unsigned char*)p_wd_t + ((size_t)e * 1024 + nb * 64) * 512 + kb * 64, 512, (LAS unsigned char*)scr, lane, 64.0f); }
}
__device__ __forceinline__ void steal_convert(const kargs_t KA, LAS unsigned char* lds, const int G, const int done_idx, const bool drain) {
    int tid = threadIdx.x; asm volatile("" : "+v"(tid));
    const int lane = tid & 63, wave = __builtin_amdgcn_readfirstlane(tid >> 6);
    volatile LAS int* mb = (volatile LAS int*)(lds + MISC_OFF + 64);
    LAS bf16* scr = (LAS bf16*)(lds + wave * 16384);
    __syncthreads();
    if (tid == 0 && !drain) __hip_atomic_fetch_add((unsigned*)(ctl + CW_DONE + 64 * done_idx), 1u, RLX_AGENT);
    for (;;) {
        if (tid == 0) { int idx = -1;
            const bool stop = !drain && __hip_atomic_load((unsigned*)(ctl + CW_DONE + 64 * done_idx), RLX_AGENT) >= (unsigned)(G - G / 4);
            if (!stop) idx = (int)__hip_atomic_fetch_add((unsigned*)(ctl + CW_Q), 8u, RLX_AGENT);
            mb[0] = idx; }
        __syncthreads();
        const int idx = mb[0];
        __syncthreads();
        if (idx < 0 || idx >= CV_L) break;
        if (idx + wave < CV_L) conv_item(KA, 1, idx + wave, scr, lane);
    }
    __syncthreads();
}

template <int l> __device__ __forceinline__ void layer_body(LAS unsigned char* lds, const int G, const int vcu, const XcdBarrier& bar, const int lo, const int hi) {
    const int NGW = G * 8, NGT = G * 512; LAS int* ttab = (LAS int*)(lds + TILE_OFF);
    constexpr int P = 1 + 8 * l;

        for (int rep_ = 0; rep_ < 1 + ((l == 0) ? ((REP_MASK >> (1 + 0)) & 1) : 0); ++rep_)
        if (IN(P + 0)) {
            KA_DECL
            const float* modp = modv;
            if (l == 1) steal_convert(KA, lds, G, 3, true);
#pragma clang loop vectorize(disable) unroll(disable)
            for (int r0 = gw; r0 < TT; r0 += 2 * NGW) {
                const int r1 = r0 + NGW; const bool has1 = r1 < TT;
                f32x4 va[4], vb[4]; v2u yaa[4], yab[4], yba[4], ybb[4];
                if (l == 0) {
                    const float* srca; const float* srcb;
                    { const bool isc = r0 >= T; srca = isc ? ctx_in + (size_t)(r0 - T) * 1024 : x_in + (size_t)r0 * 1024; }
                    { const int rr = has1 ? r1 : r0; const bool isc = rr >= T; srcb = isc ? ctx_in + (size_t)(rr - T) * 1024 : x_in + (size_t)rr * 1024; }
#pragma unroll
                    for (int j = 0; j < 4; ++j) { va[j] = *(const f32x4*)(srca + 4 * lane + 256 * j); vb[j] = *(const f32x4*)(srcb + 4 * lane + 256 * j); }
                } else {
                    const int rr = has1 ? r1 : r0;
#pragma unroll
                    for (int j = 0; j < 4; ++j) { const v2u wa = *(const v2u*)(xb + (size_t)r0 * 1024 + 4 * lane + 256 * j), wb = *(const v2u*)(xb + (size_t)rr * 1024 + 4 * lane + 256 * j);
                        va[j] = (f32x4){bflo(wa.x), bfhi(wa.x), bflo(wa.y), bfhi(wa.y)}; vb[j] = (f32x4){bflo(wb.x), bfhi(wb.x), bflo(wb.y), bfhi(wb.y)}; }
                }
                if (l == 1) {
                    const int rr = has1 ? r1 : r0;
#pragma unroll
                    for (int j = 0; j < 4; ++j) { yaa[j] = *(const v2u*)(y2 + (size_t)(2 * r0) * 1024 + 4 * lane + 256 * j); yab[j] = *(const v2u*)(y2 + (size_t)(2 * r0 + 1) * 1024 + 4 * lane + 256 * j);
                        yba[j] = *(const v2u*)(y2 + (size_t)(2 * rr) * 1024 + 4 * lane + 256 * j); ybb[j] = *(const v2u*)(y2 + (size_t)(2 * rr + 1) * 1024 + 4 * lane + 256 * j); }
                }
#pragma unroll
                for (int half = 0; half < 2; ++half) {
                    if (half == 1 && !has1) break;
                    const int r = half ? r1 : r0; f32x4 (&v)[4] = half ? vb : va; v2u (&ya)[4] = half ? yba : yaa; v2u (&yb)[4] = half ? ybb : yab;
                    const bool isc = r >= T; const int bsel = isc ? 4 : (r >> 12);
                    if (l == 1) {
                        const float* g2 = modp + bsel * 6144 + 5 * 1024; bf16* dst = xb + (size_t)r * 1024;
#pragma unroll
                        for (int j = 0; j < 4; ++j) {
                            const f32x4 gv = *(const f32x4*)(g2 + 4 * lane + 256 * j);
                            f32x4 yy; yy[0] = bflo(ya[j].x) + bflo(yb[j].x); yy[1] = bfhi(ya[j].x) + bfhi(yb[j].x); yy[2] = bflo(ya[j].y) + bflo(yb[j].y); yy[3] = bfhi(ya[j].y) + bfhi(yb[j].y);
                            if (DBG_NO_MOE) yy = (f32x4){0.f, 0.f, 0.f, 0.f};
                            v[j] = v[j] + gv * yy; { v2u o; o.x = pk2(v[j][0], v[j][1]); o.y = pk2(v[j][2], v[j][3]); *(v2u*)(dst + 4 * lane + 256 * j) = o; }
                        }
                    }
                    float ss = 0.f;
#pragma unroll
                    for (int j = 0; j < 4; ++j) ss += (v[j][0] * v[j][0] + v[j][1] * v[j][1]) + (v[j][2] * v[j][2] + v[j][3] * v[j][3]);
                    const float rstd = 1.0f / sqrtf(wave_sum(ss) * (1.f / 1024.f) + 1e-6f);
                    const float* sh = modl + bsel * 6144; const float* sc = sh + 1024; const float* gn = norm1_g + l * 1024;
#pragma unroll
                    for (int j = 0; j < 4; ++j) {
                        const int c0 = 4 * lane + 256 * j; const f32x4 g = *(const f32x4*)(gn + c0), s1 = *(const f32x4*)(sc + c0), h1 = *(const f32x4*)(sh + c0);
                        const f32x4 y = (v[j] * rstd) * g * (s1 + 1.0f) + h1;
                        v2u o; o.x = pk2(y[0], y[1]); o.y = pk2(y[2], y[3]); *(v2u*)(hbuf + (size_t)r * 1024 + c0) = o;
                        *(unsigned*)((unsigned char*)(ws + O_ACT) + (size_t)r * 1024 + c0) = pk4_f8(y[0], y[1], y[2], y[3]);
                    }
                }
            }
        }
        SEAM(P + 0);
        for (int rep_ = 0; rep_ < 1 + ((l == 0) ? ((REP_MASK >> (1 + 1)) & 1) : 0); ++rep_)
        if (IN(P + 1)) {
            KA_DECL
            EpiG1 E{pu, qb, kall, vall, zb};
            { SchedG1 S{G, vcu, 0, l, (const char*)hbuf, (const char*)win_t}; pg8::gemm_phase<EpiG1, SchedG1, false>(lds, S, E); }
            { SchedG1 S{G, vcu, 1, l, (const char*)(ws + O_ACT), (const char*)(ws + O_WIN8 + l * SZ_WIN8)}; pg8::gemm_phase<EpiG1, SchedG1, true>(lds, S, E); }
            if (l == 0 && !MK_SPLIT) steal_convert(KA, lds, G, 0, false);
        }
        SEAM(P + 1);
        if (IN(P + 3)) {
            KA_DECL
            gu32* kflag = ctl + CW_KF + l * 16384;
            gu32* facnt = ctl + CW_FA + l * 64;
            for (int it = vcu; it < 256; it += G) {
                const int b = it >> 6, n2 = it & 63;
                RowA ra{zb, b, n2}; EpiA<true> ea{t2, twt, b, n2};
                slab_gemm<4, RowA, EpiA<true>>(lds, fma, 128, ra, ea);
                asm volatile("s_waitcnt vmcnt(0)" ::: "memory");
                __syncthreads();
                if (tid == 0) __hip_atomic_fetch_add((unsigned*)(facnt + 16 * b), 1u, RLX_AGENT);
            }
            const int n_att = 512 + (l == 0 ? 32 : 0);
            for (int it = vcu; it < n_att; it += G) {
                const bool cu = it >= 512; const int uidx = cu ? it - 512 : it;
                const int b = cu ? (uidx >> 3) : (uidx >> 7), kvh = cu ? ((uidx >> 2) & 1) : ((uidx >> 6) & 1), pb = cu ? (uidx & 3) : (uidx & 63);
                const int p0 = pb * 64; const int qrow0 = cu ? T + b * 256 + p0 : b * 4096 + p0;
                if (!cu) {
                    const int row = tid >> 3, c = tid & 7;
                    const float* kg = k_norm_g + l * 64 + 8 * c;
#pragma unroll
                    for (int part = 0; part < 2; ++part) {
                        if (part == 1 && pb >= 4) break;
                        const int blk = part ? pb : 4 + pb;
                        bf16* p = kall + ((size_t)b * KVROWS + blk * 64 + row) * 128 + kvh * 64 + c * 8;
                        const v4u w = *(const v4u*)p;
                        float x[8] = {bflo(w.x), bfhi(w.x), bflo(w.y), bfhi(w.y), bflo(w.z), bfhi(w.z), bflo(w.w), bfhi(w.w)};
                        float ss = 0.f;
#pragma unroll
                        for (int i = 0; i < 8; ++i) ss += x[i] * x[i];
                        ss += __shfl_xor(ss, 1); ss += __shfl_xor(ss, 2); ss += __shfl_xor(ss, 4);
                        const float rstd = 1.0f / sqrtf(ss * (1.f / 64.f) + 1e-6f);
#pragma unroll
                        for (int i = 0; i < 8; ++i) x[i] *= rstd * kg[i];
                        if (part == 0) {
                            const float2* rp = rope + (size_t)(p0 + row) * 32 + ((c & 4) ? 16 : 0) + (c & 1) * 8;
#pragma unroll
                            for (int i = 0; i < 8; ++i) { const float y = __shfl_xor(x[i], 2); const float2 cs = rp[i]; x[i] = (c & 2) ? (x[i] * cs.x + y * cs.y) : (x[i] * cs.x - y * cs.y); }
                        }
                        v4u o; o.x = pk2(x[0], x[1]); o.y = pk2(x[2], x[3]); o.z = pk2(x[4], x[5]); o.w = pk2(x[6], x[7]);
                        store16_wt(p, o);
                    }
                    asm volatile("s_waitcnt vmcnt(0)" ::: "memory");
                    __syncthreads();
                    if (tid == 0) { __hip_atomic_store(kflag + 16 * ((b * 68 + 4 + pb) * 2 + kvh), 1u, RLX_AGENT); if (pb < 4) __hip_atomic_store(kflag + 16 * ((b * 68 + pb) * 2 + kvh), 1u, RLX_AGENT); }
                }
                if (tid < 64) {
                    int blk = -1;
                    if (lane < 4) blk = lane; else if (!cu && lane < 9) { const int q = pb + lane - 6; if (q >= 0 && q < 64) blk = 4 + q; }
                    unsigned sp = 0;
                    for (;;) { const unsigned f = (blk >= 0) ? __hip_atomic_load(kflag + 16 * ((b * 68 + blk) * 2 + kvh), RLX_AGENT) : 1u;
                        if (__all(f != 0u)) break; __builtin_amdgcn_s_sleep(2);
                        if (++sp > (1u << 22)) { if (tid == 0) __hip_atomic_store(ctl + CW_TMO, 2u, RLX_AGENT); break; } }
                    __builtin_amdgcn_fence(__ATOMIC_ACQUIRE, "agent");
                    asm volatile("s_waitcnt vmcnt(0)" ::: "memory");
                }
                __syncthreads();
                const attn_body::bf16* Qu = (const attn_body::bf16*)(qb + (size_t)qrow0 * 512 + kvh * 256);
                const attn_body::bf16* Kh = (const attn_body::bf16*)(kall + (size_t)b * KVROWS * 128 + kvh * 64);
                const attn_body::bf16* Vh = (const attn_body::bf16*)(vall + (size_t)b * KVROWS * 128 + kvh * 64);
                attn_body::bf16* Ou = (attn_body::bf16*)(mrg + (size_t)qrow0 * 1024 + 256 + kvh * 256);
                attn_body::attn_unit<8>(Qu, Kh, Vh, Ou, p0, cu ? 4 : 10, attn_sink + l * 8 + kvh * 4, q_norm_g + l * 64, cu ? (const float2*)nullptr : (const float2*)rope, (char*)lds);
                __syncthreads();
            }
            const int prow = (l == 0) ? TT : T; const int nrb = prow >> 3;
#pragma clang loop vectorize(disable) unroll(disable)
            for (int i = gt; i < 32 * nrb; i += NGT) {
                const int ck8 = i & 7, rb = (i >> 3) % nrb, g = (i >> 3) / nrb;
                const int r0 = rb * 8; const bool isc = r0 >= T;
                const int nseq = isc ? LCTX : NSEQ; const int rbase = isc ? T + ((r0 - T) & ~255) : (r0 & ~4095); const int n0 = r0 - rbase;
                const int col = g * 64 + ck8 * 8;
                const bf16* up = pu + (size_t)rbase * 256 + col; bf16* op = mrg + (size_t)(rbase + n0) * 1024 + col;
                if (g == 0) pool_item<1>(up, op, n0, nseq); else if (g == 1) pool_item<2>(up, op, n0, nseq); else if (g == 2) pool_item<4>(up, op, n0, nseq); else pool_item<8>(up, op, n0, nseq);
            }
            for (int it = vcu; it < 256; it += G) {
                const int b = it >> 6, k1 = it & 63;
                __syncthreads();
                if (tid < 64) { unsigned sp = 0;
                    while ((unsigned)__builtin_amdgcn_readfirstlane(__hip_atomic_load((unsigned*)(facnt + 16 * b), RLX_AGENT)) < 64u) { __builtin_amdgcn_s_sleep(2); if (++sp > (1u << 22)) { if (tid == 0) __hip_atomic_store(ctl + CW_TMO, 3u, RLX_AGENT); break; } }
                    __builtin_amdgcn_fence(__ATOMIC_ACQUIRE, "agent");
                    asm volatile("s_waitcnt vmcnt(0)" ::: "memory"); }
                __syncthreads();
                RowB rb{t2, b, k1}; EpiB eb{mrg, b, k1};
                slab_gemm<2, RowB, EpiB>(lds, fmb, 128, rb, eb);
            }
            if (l == 0) for (int it = (G - 1 - vcu); it < 32; it += G) {
                const int b = it >> 3, mt0 = it & 7;
                RowC rc{zb, b}; EpiC ec{mrg, b, mt0};
                slab_gemm<1, RowC, EpiC>(lds, fmc + (size_t)mt0 * 32 * 512, 512, rc, ec);
            }
        }
        SEAM(P + 3);
        if (IN(P + 4)) {
            KA_DECL
            unsigned* g2rdy = (unsigned*)(ctl + CW_G2 + l * 2048);
            {
                SchedPlain S{(l == 0 ? TT : T) / 256, 4, G, vcu, 1024, (const char*)mrg, (const char*)wout_t};
                EpiG2<(l != 0)> E{x_in, ctx_in, xb, modl, g2rdy};
                pg8::gemm_phase<EpiG2<(l != 0)>, SchedPlain>(lds, S, E);
            }
            const int rep_ = 0;
            __syncthreads();
            LAS float* rw = (LAS float*)lds;
            LAS int* lcnt = (LAS int*)(lds + 81920);
            LAS unsigned* lent = (LAS unsigned*)(lds + 81920 + 256);
            LAS unsigned* lrank = lent + 1024;
            { const float* rwg = (const float*)(ws + O_RW) + l * 20480;
#pragma unroll
              for (int i = 0; i < 10; ++i) { const int idx = tid + 512 * i; *(LAS f32x4*)(rw + 4 * idx) = *(const f32x4*)(rwg + 4 * idx); } }
            if (tid < 33) lcnt[tid] = 0;
            if (tid < 64) { unsigned sp = 0; unsigned* w = g2rdy + 16 * (vcu >> 2);
                while ((unsigned)__builtin_amdgcn_readfirstlane(__hip_atomic_load(w, RLX_AGENT)) < 32u) { __builtin_amdgcn_s_sleep(2); if (++sp > (1u << 22)) { if (tid == 0) __hip_atomic_store(ctl + CW_TMO, 4u, RLX_AGENT); break; } }
                __builtin_amdgcn_fence(__ATOMIC_ACQUIRE, "agent");
                asm volatile("s_waitcnt vmcnt(0)" ::: "memory"); }
            __syncthreads();
            const bool dbl = (l == 0) && (G == 256) && (vcu < 16);
            const int ngl = 16 + ((l == 0) ? 1 : 0) + (((l == 0) && (G == 256)) ? 2 : 0);
#pragma clang loop vectorize(disable) unroll(disable)
            for (int gix = wave; gix < ngl; gix += 8) {
                int q;
                if (gix < 16) { if (dbl) continue; q = 16 * vcu + gix; }
                else if (gix == 16) q = T / 4 + vcu;
                else { if (dbl) continue; const int o = (gix == 17) ? (vcu - 16) : (240 + vcu - 16); if (o >= 256 || (gix == 18 && vcu >= 32)) continue; q = o; }
                if (gix >= 17) {
                    unsigned sp = 0; unsigned* w = g2rdy + 16 * (q >> 6);
                    while ((unsigned)__builtin_amdgcn_readfirstlane(__hip_atomic_load(w, RLX_AGENT)) < 32u) { __builtin_amdgcn_s_sleep(2); if (++sp > (1u << 22)) { if (lane == 0) __hip_atomic_store(ctl + CW_TMO, 6u, RLX_AGENT); break; } }
                    __builtin_amdgcn_fence(__ATOMIC_ACQUIRE, "agent");
                    asm volatile("s_waitcnt vmcnt(0)" ::: "memory"); }
                if (gix == 16) { unsigned sp = 0; unsigned* w = g2rdy + 16 * (64 + (vcu >> 6));
                    while ((unsigned)__builtin_amdgcn_readfirstlane(__hip_atomic_load(w, RLX_AGENT)) < 32u) { __builtin_amdgcn_s_sleep(2); if (++sp > (1u << 22)) { if (lane == 0) __hip_atomic_store(ctl + CW_TMO, 5u, RLX_AGENT); break; } }
                    __builtin_amdgcn_fence(__ATOMIC_ACQUIRE, "agent");
                    asm volatile("s_waitcnt vmcnt(0)" ::: "memory"); }
                const int rb4 = 4 * q; const bool isc = rb4 >= T; const int bsel = isc ? 4 : (rb4 >> 12);
                const bf16* src = xb + (size_t)rb4 * 1024;
                f32x4 v[4][4];
#pragma unroll
                for (int tk = 0; tk < 4; ++tk)
#pragma unroll
                    for (int j = 0; j < 4; ++j) { const v2u w = *(const v2u*)(src + (size_t)tk * 1024 + 4 * lane + 256 * j); v[tk][j] = (f32x4){bflo(w.x), bfhi(w.x), bflo(w.y), bfhi(w.y)}; }
                float rstd[4];
#pragma unroll
                for (int tk = 0; tk < 4; ++tk) { float ss = 0.f;
#pragma unroll
                    for (int j = 0; j < 4; ++j) ss += (v[tk][j][0] * v[tk][j][0] + v[tk][j][1] * v[tk][j][1]) + (v[tk][j][2] * v[tk][j][2] + v[tk][j][3] * v[tk][j][3]);
                    rstd[tk] = 1.0f / sqrtf(wave_sum(ss) * (1.f / 1024.f) + 1e-6f); }
                const float* sh = modl + bsel * 6144 + 3 * 1024; const float* sc = sh + 1024; const float* gn = norm2_g + l * 1024;
                f32x2 lg[4][10];
#pragma unroll
                for (int tk = 0; tk < 4; ++tk)
#pragma unroll
                    for (int j = 0; j < 10; ++j) lg[tk][j] = (f32x2){0.f, 0.f};
#pragma unroll
                for (int j = 0; j < 4; ++j) {
                    const int c0 = 4 * lane + 256 * j; const f32x4 g = *(const f32x4*)(gn + c0), s1 = *(const f32x4*)(sc + c0), h1 = *(const f32x4*)(sh + c0);
                    f32x4 y[4];
#pragma unroll
                    for (int tk = 0; tk < 4; ++tk) { y[tk] = (v[tk][j] * rstd[tk]) * g * (s1 + 1.0f) + h1;
                        *(unsigned*)((unsigned char*)hbuf + (size_t)(rb4 + tk) * 1024 + c0) = pk4_f8(y[tk][0], y[tk][1], y[tk][2], y[tk][3]); }
#pragma unroll
                    for (int e = 0; e < 4; ++e) {
#pragma unroll
                        for (int q5 = 0; q5 < 5; ++q5) { const f32x4 wv = *(const LAS f32x4*)(rw + (((q5 * 4 + j) * 4 + e) * 64 + lane) * 4);
                            const f32x2 w01 = {wv[0], wv[1]}, w23 = {wv[2], wv[3]};
#pragma unroll
                            for (int tk = 0; tk < 4; ++tk) { const f32x2 ys = {y[tk][e], y[tk][e]}; lg[tk][2 * q5] = __builtin_elementwise_fma(ys, w01, lg[tk][2 * q5]); lg[tk][2 * q5 + 1] = __builtin_elementwise_fma(ys, w23, lg[tk][2 * q5 + 1]); } }
                        __builtin_amdgcn_sched_barrier(0); }
                }
                float l2[20];
#pragma unroll
                for (int j = 0; j < 20; ++j) {
                    const float a0 = swap32_sum(lg[0][j >> 1][j & 1], lg[2][j >> 1][j & 1]);
                    const float a1 = swap32_sum(lg[1][j >> 1][j & 1], lg[3][j >> 1][j & 1]);
                    float t = swap16_sum(a0, a1);
                    t += dppf<0x128, 0xf>(t); t += dppf<0x124, 0xf>(t); t += dppf<0x122, 0xf>(t); t += dppf<0x121, 0xf>(t);
                    l2[j] = t;
                }
                const int tk = lane >> 4; const int r = rb4 + tk;
                float gl[4]; float gm = -1e30f;
#pragma unroll
                for (int j = 0; j < 4; ++j) { gl[j] = l2[j] + b_grp[l * 4 + j]; gm = fmaxf(gm, gl[j]); }
                float gs = 0.f; int gi = 0; float gb = -1e30f;
#pragma unroll
                for (int j = 0; j < 4; ++j) { const float e = expf(gl[j] - gm); gs += e; if (gl[j] > gb) { gb = gl[j]; gi = j; } }
                const float pg = expf(gb - gm) / gs;
                float el[4]; float em = -1e30f;
#pragma unroll
                for (int j = 0; j < 4; ++j) { float t_ = 0.f;
#pragma unroll
                    for (int g4 = 0; g4 < 4; ++g4) t_ = (gi == g4) ? (l2[4 + g4 * 4 + j] + b_rtr[l * 16 + g4 * 4 + j]) : t_;
                    el[j] = t_; em = fmaxf(em, t_); }
                float pe[4];
#pragma unroll
                for (int j = 0; j < 4; ++j) pe[j] = expf(el[j] - em);
                int i0 = 0; float b0 = -1.f;
#pragma unroll
                for (int j = 0; j < 4; ++j) if (pe[j] > b0) { b0 = pe[j]; i0 = j; }
                int i1 = 0; float b1 = -1.f;
#pragma unroll
                for (int j = 0; j < 4; ++j) if (j != i0 && pe[j] > b1) { b1 = pe[j]; i1 = j; }
                const float wsum = b0 + b1; const float w0 = pg * b0 / wsum, w1 = pg * b1 / wsum;
                if ((lane & 15) == 0 && rep_ == 0) {
                    wts[2 * r] = w0; wts[2 * r + 1] = w1;
                    const int e0 = gi * 4 + i0, e1 = gi * 4 + i1;
                    const int s0 = __hip_atomic_fetch_add((LAS int*)(lcnt + 16 + 16), 1, __ATOMIC_RELAXED, __HIP_MEMORY_SCOPE_WORKGROUP);
                    const int k0 = __hip_atomic_fetch_add((LAS int*)(lcnt + e0), 1, __ATOMIC_RELAXED, __HIP_MEMORY_SCOPE_WORKGROUP);
                    const int k1 = __hip_atomic_fetch_add((LAS int*)(lcnt + e1), 1, __ATOMIC_RELAXED, __HIP_MEMORY_SCOPE_WORKGROUP);
                    lent[2 * s0] = ((unsigned)(2 * r) << 4) | (unsigned)e0; lrank[2 * s0] = (unsigned)k0;
                    lent[2 * s0 + 1] = ((unsigned)(2 * r + 1) << 4) | (unsigned)e1; lrank[2 * s0 + 1] = (unsigned)k1;
                }
            }
            __syncthreads();
            if (tid < 16 && rep_ == 0) { const int c = lcnt[tid]; lcnt[16 + tid] = c ? (int)__hip_atomic_fetch_add((unsigned*)(ctl + CW_CNT + (l * 16 + tid) * 64), (unsigned)c, RLX_AGENT) : 0; }
            __syncthreads();
            const int ntot = rep_ == 0 ? 2 * lcnt[32] : 0;
            for (int i = tid; i < ntot; i += 512) { const unsigned en = lent[i]; const int e = en & 15; list[(size_t)e * TT + lcnt[16 + e] + lrank[i]] = en >> 4; }
            __syncthreads();
            if (l == 0 && !MK_SPLIT) steal_convert(KA, lds, G, 1, false);
        }
        SEAM(P + 5);
        if (IN(P + 6) || IN(P + 7)) {
            KA_DECL
            __syncthreads();
            if (tid < 16) ttab[17 + tid] = (int)__hip_atomic_load((unsigned*)(ctl + CW_CNT + (l * 16 + tid) * 64), RLX_AGENT);
            __syncthreads();
            if (tid == 0) { int acc_ = 0; for (int e = 0; e < 16; ++e) { const int c = ttab[17 + e]; ttab[e] = acc_; acc_ += (c + 255) >> 8; } ttab[16] = acc_; }
            __syncthreads();
        }
        if (DBG_NAIVE_MOE && IN(P + 6)) {
            KA_DECL
            const int nrows = (l == 0) ? TT : T; LAS float* hs = (LAS float*)lds; LAS float* as = hs + 1024;
            const int* eidg = (const int*)(ws + O_EID);
            LAS float* lgs = as + 512; LAS float* rt = lgs + 32;
            for (int r = vcu; r < nrows; r += G) {
                __syncthreads();
                for (int i = tid; i < 1024; i += 512) hs[i] = bf2f(hbuf[(size_t)r * 1024 + i]);
                __syncthreads();
                if (tid < 20) { float a = 0.f; for (int k = 0; k < 1024; ++k) a += hs[k] * ((tid < 4) ? w_grp[(size_t)l * 4096 + k * 4 + tid] : w_rtr[(size_t)l * 16384 + k * 16 + (tid - 4)]);
                    lgs[tid] = a + ((tid < 4) ? b_grp[l * 4 + tid] : b_rtr[l * 16 + tid - 4]); }
                __syncthreads();
                if (tid == 0) { int gi = 0; for (int j = 1; j < 4; ++j) if (lgs[j] > lgs[gi]) gi = j; float gs = 0.f; for (int j = 0; j < 4; ++j) gs += expf(lgs[j] - lgs[gi]); const float pg = 1.f / gs;
                    int i0 = 0; for (int j = 1; j < 4; ++j) if (lgs[4 + gi * 4 + j] > lgs[4 + gi * 4 + i0]) i0 = j; int i1 = -1; for (int j = 0; j < 4; ++j) if (j != i0 && (i1 < 0 || lgs[4 + gi * 4 + j] > lgs[4 + gi * 4 + i1])) i1 = j;
                    const float p0 = 1.f, p1 = expf(lgs[4 + gi * 4 + i1] - lgs[4 + gi * 4 + i0]); rt[0] = (float)(gi * 4 + i0); rt[1] = (float)(gi * 4 + i1); rt[2] = pg * p0 / (p0 + p1); rt[3] = pg * p1 / (p0 + p1); }
                __syncthreads();
                for (int sl = 0; sl < 2; ++sl) {
                    const int e = (DBG_NAIVE_ROUTE & 1) ? (int)rt[sl] : eidg[2 * r + sl]; const float w = (DBG_NAIVE_ROUTE & 2) ? rt[2 + sl] : wts[2 * r + sl];
                    __syncthreads();
                    const float* Wg = w_gate + (size_t)(l * 16 + e) * 1024 * 512 + tid; const float* Wu = w_up + (size_t)(l * 16 + e) * 1024 * 512 + tid;
                    float g = 0.f, u = 0.f;
#pragma unroll 8
                    for (int k = 0; k < 1024; ++k) { g += hs[k] * Wg[(size_t)k * 512]; u += hs[k] * Wu[(size_t)k * 512]; }
                    as[tid] = g / (1.f + expf(-g)) * u;
                    __syncthreads();
                    const float* Wd = w_down + (size_t)(l * 16 + e) * 512 * 1024 + tid;
                    float y0 = 0.f, y1 = 0.f;
#pragma unroll 8
                    for (int j = 0; j < 512; ++j) { y0 += as[j] * Wd[(size_t)j * 1024]; y1 += as[j] * Wd[(size_t)j * 1024 + 512]; }
                    y2[(size_t)(2 * r + sl) * 1024 + tid] = (bf16)f2bf(y0 * w); y2[(size_t)(2 * r + sl) * 1024 + 512 + tid] = (bf16)f2bf(y1 * w);
                }
            }
        }
        if (!DBG_NAIVE_MOE && IN(P + 6)) {
            KA_DECL
            unsigned* rdy = (unsigned*)(ctl + CW_RDY + l * 4096);
            SchedMoe S{G, vcu, ttab[16], (const char*)hbuf, (const char*)act, (const char*)wgu_t, (const char*)wd_t, list, ttab, rdy, (unsigned*)(ctl + CW_TMO)};
            EpiMoe E{EpiG3{act, rdy}, EpiG4{y2, list, wts, ttab}};
            pg8::gemm_phase<EpiMoe, SchedMoe, true>(lds, S, E);
            if (l == 0 && !MK_SPLIT) steal_convert(KA, lds, G, 2, false);
        }
        SEAM(P + 7);
    }

__global__ void __launch_bounds__(512, 2) fwd_kernel(Args args) {
    extern __shared__ __attribute__((aligned(16))) unsigned char lds_raw[];
    LAS unsigned char* lds = (LAS unsigned char*)lds_raw;
    const int tid = threadIdx.x, lane = tid & 63, wave = __builtin_amdgcn_readfirstlane(tid >> 6);
    const int G = gridDim.x; const int bx = blockIdx.x; const int vcu = (G % 8 == 0) ? (bx % 8) * (G / 8) + bx / 8 : bx;
    volatile LAS unsigned* MISC = (volatile LAS unsigned*)(lds + MISC_OFF);
    LAS float* trig = (LAS float*)(lds + TRIG_OFF);
    LAS int* ttab = (LAS int*)(lds + TILE_OFF);
    for (int u = tid; u < (LDS_BYTES - LDSCTL_OFF) / 4; u += 512) ((LAS unsigned*)(lds + LDSCTL_OFF))[u] = 0u;
    __syncthreads();
    if (tid < 64) { float s, c; sincospif((float)tid / 32.f, &s, &c); trig[tid] = c; trig[64 + tid] = s; }
    __syncthreads();
    XcdBarrier bar; bar.bar = nullptr; bar.x = 0; bar.st = nullptr;
    if (!MK_SPLIT) { KA_DECL bar = xcd_barrier_post((unsigned*)(ctl + CW_BAR), MISC + 8); }
    const int lo = args.ph_lo, hi = args.ph_hi;
    const int NGW = G * 8, NGT = G * 512;

    for (int rep_ = 0; rep_ < 1 + ((REP_MASK >> 0) & 1); ++rep_)
    if (IN(0)) {
        KA_DECL
        __syncthreads();
        if (rep_ == 0 || ((REP_MASK >> 13) & 1)) {
            LAS float* sl = (LAS float*)lds;
            bool have = false;
            for (int it = vcu; it < 192; it += G) {
                if (!have) {
                    for (int i = tid; i < 5120; i += 512) { const int r = i >> 10, k = i & 1023; const float v = (r < 4) ? c_in[r * 1024 + k] : cctx_in[k]; sl[i] = v / (1.f + expf(-v)); }
                    __syncthreads(); have = true;
                }
                const int l = it / 96, cb = it % 96;
                const int r4 = lane >> 4, cq = lane & 15; const int k0 = wave * 128;
                const float* W = w_mod + (size_t)l * 1024 * 6144 + (size_t)(k0 + r4) * 6144 + cb * 64 + 4 * cq;
                f32x4 a0 = {0.f, 0.f, 0.f, 0.f}, a1 = a0, a2 = a0, a3 = a0, a4 = a0;
#pragma unroll 8
                for (int k = 0; k < 32; ++k) { const f32x4 wv = *(const f32x4*)(W + (size_t)(4 * k) * 6144); const int kk = k0 + 4 * k + r4;
                    a0 += wv * sl[kk]; a1 += wv * sl[1024 + kk]; a2 += wv * sl[2048 + kk]; a3 += wv * sl[3072 + kk]; a4 += wv * sl[4096 + kk]; }
                LAS float* part = sl + 5120;
                { LAS float* pp = part + (wave * 4 + r4) * 320 + 4 * cq;
                  *(LAS f32x4*)(pp) = a0; *(LAS f32x4*)(pp + 64) = a1; *(LAS f32x4*)(pp + 128) = a2; *(LAS f32x4*)(pp + 192) = a3; *(LAS f32x4*)(pp + 256) = a4; }
                __syncthreads();
                if (tid < 320) { const int r = tid >> 6, n = tid & 63; float sacc = b_mod[l * 6144 + cb * 64 + n];
#pragma unroll 8
                    for (int w = 0; w < 32; ++w) sacc += part[w * 320 + r * 64 + n];
                    modv[(size_t)(l * 5 + r) * 6144 + cb * 64 + n] = sacc; }
                __syncthreads();
            }
            __syncthreads();
        }
        if (rep_ == 0 || ((REP_MASK >> 14) & 1)) {
#pragma clang loop vectorize(disable) unroll(disable)
        for (int i = gt; i < 4096 * 32; i += NGT) {
            const int n = i >> 5, j = i & 31; const int jj = j & 15;
            const float inv = 1.0f / powf(10000.0f, (float)(2 * jj) / 32.0f);
            const float pos = (j < 16) ? (float)(n >> 6) : (float)(n & 63);
            const float ang = pos * inv; rope[i] = make_float2(cosf(ang), sinf(ang));
        }
#pragma clang loop vectorize(disable) unroll(disable)
        for (int i = gt; i < 4096; i += NGT) { float s, c; sincospif((float)i / 2048.f, &s, &c); twt[i] = make_float2(c, s); }
#pragma clang loop vectorize(disable) unroll(disable)
        for (int i = gt; i < 128 * 128; i += NGT) {
            const int m = i >> 7, k = i & 127; const int ri = m >> 6, k1 = m & 63, part = k >> 6, n1 = k & 63;
            float s, c; sincospif((float)((n1 * k1) & 63) / 32.f, &s, &c);
            float v; if (ri == 0) v = (part == 0) ? c : -s; else v = (part == 0) ? -s : -c;
            fma[i] = (bf16)f2bf(v);
        }
#pragma clang loop vectorize(disable) unroll(disable)
        for (int i = gt; i < 64 * 128; i += NGT) {
            const int k2 = i >> 7, k = i & 127; const int ri = k >> 6, n2 = k & 63;
            float s, c; sincospif((float)((n2 * k2) & 63) / 32.f, &s, &c);
            fmb[i] = (bf16)f2bf((ri == 0 ? c : s) * (1.f / 512.f));
        }
#pragma clang loop vectorize(disable) unroll(disable)
        for (int i = gt; i < 256 * 512; i += NGT) {
            const int kk = i >> 9, k = i & 511; const int part = k >> 8, n = k & 255;
            float s, c; sincospif((float)((n * kk) & 255) / 128.f, &s, &c);
            fmc[i] = (bf16)f2bf((part == 0 ? c : -s) * (1.f / 128.f));
        }
#pragma clang loop vectorize(disable) unroll(disable)
        for (int i = gt; i < 2 * 20480; i += NGT) {
            const int lw = i / 20480, r = i % 20480; const int d = r / 20, j = r % 20;
            ((float*)(ws + O_RW))[lw * 20480 + ((((j >> 2) * 4 + (d >> 8)) * 4 + (d & 3)) * 64 + ((d & 255) >> 2)) * 4 + (j & 3)] = (j < 4) ? w_grp[(size_t)lw * 4096 + d * 4 + j] : w_rtr[(size_t)lw * 16384 + d * 16 + (j - 4)];
        }
        }
        if (rep_ == 0 || ((REP_MASK >> 15) & 1)) {
            LAS float* Al = (LAS float*)lds;
            LAS float* Wl = Al + 4096;
            LAS float* Xl = Wl + 4096;
            for (int it = vcu; it < 256; it += G) {
                const int combo = it & 15, jb = it >> 4; const int l = combo >> 3, g = (combo >> 1) & 3, which = combo & 1;
                const float* Wg = four_w + (size_t)(l * 4 + g) * 4096; const LAS float* tb = trig + which * 64;
                const float* wi = w_in + (size_t)l * 1024 * 1280 + (size_t)(jb * 64) * 1280 + 1024 + g * 64;
                __syncthreads();
#pragma unroll
                for (int i = 0; i < 2; ++i) { const int idx = tid + 512 * i; *(LAS f32x4*)(Wl + 4 * idx) = *(const f32x4*)(Wg + 4 * idx); const int j = idx >> 4, c4 = idx & 15;
                    const f32x4 xv = *(const f32x4*)(wi + (size_t)j * 1280 + 4 * c4);
                    Xl[(4 * c4) * 68 + j] = xv[0]; Xl[(4 * c4 + 1) * 68 + j] = xv[1]; Xl[(4 * c4 + 2) * 68 + j] = xv[2]; Xl[(4 * c4 + 3) * 68 + j] = xv[3]; }
                __syncthreads();
                { const int d4 = tid & 15, c = tid >> 4;
                  f32x4 a0 = {0.f, 0.f, 0.f, 0.f}, a1 = a0;
#pragma unroll 8
                  for (int m = 0; m < 64; ++m) { const f32x4 wv = *(const LAS f32x4*)(Wl + m * 64 + 4 * d4); a0 += wv * tb[(m * c) & 63]; a1 += wv * tb[(m * (c + 32)) & 63]; }
                  *(LAS f32x4*)(Al + c * 64 + 4 * d4) = a0; *(LAS f32x4*)(Al + (c + 32) * 64 + 4 * d4) = a1; }
                __syncthreads();
                { const int d = tid & 63, jl = 8 * (tid >> 6);
                  f32x4 o0 = {0.f, 0.f, 0.f, 0.f}, o1 = o0;
#pragma unroll 8
                  for (int c = 0; c < 64; ++c) { const float av = Al[c * 64 + d]; o0 += *(const LAS f32x4*)(Xl + c * 68 + jl) * av; o1 += *(const LAS f32x4*)(Xl + c * 68 + jl + 4) * av; }
                  v2u w; w.x = pk4_f8(o0[0] * 64.f, o0[1] * 64.f, o0[2] * 64.f, o0[3] * 64.f); w.y = pk4_f8(o1[0] * 64.f, o1[1] * 64.f, o1[2] * 64.f, o1[3] * 64.f);
                  *(v2u*)((unsigned char*)(ws + O_WIN8 + l * SZ_WIN8) + (size_t)(768 + which * 256 + g * 64 + d) * 1024 + jb * 64 + jl) = w; }
            }
            for (int it = vcu; it < 256; it += G) {
                const int combo = it & 7, nb = it >> 3; const int l = combo >> 2, g = combo & 3, n0 = nb * 32;
                const float* pwg = pool_w + (size_t)(l * 4 + g) * 4096;
                __syncthreads();
#pragma unroll
                for (int i = 0; i < 2; ++i) { const int idx = tid + 512 * i; *(LAS f32x4*)(Wl + 4 * idx) = *(const f32x4*)(pwg + 4 * idx); }
                { const int d = tid >> 3, n4 = tid & 7; const float ps = pool_scale[l * 256 + g * 64 + d];
                  *(LAS f32x4*)(Xl + d * 32 + 4 * n4) = *(const f32x4*)(w_out + (size_t)l * 1024 * 1024 + (size_t)(g * 64 + d) * 1024 + n0 + 4 * n4) * ps; }
                __syncthreads();
                { const int n = tid & 31, c0 = 4 * (tid >> 5);
                  float o[4] = {0.f, 0.f, 0.f, 0.f};
#pragma unroll 4
                  for (int d = 0; d < 64; d += 4) { const float s0 = Xl[d * 32 + n], s1 = Xl[(d + 1) * 32 + n], s2 = Xl[(d + 2) * 32 + n], s3 = Xl[(d + 3) * 32 + n];
#pragma unroll
                      for (int i = 0; i < 4; ++i) { const f32x4 wv = *(const LAS f32x4*)(Wl + (c0 + i) * 64 + d); o[i] += (wv[0] * s0 + wv[1] * s1) + (wv[2] * s2 + wv[3] * s3); } }
                  v2u w; w.x = pk2(o[0], o[1]); w.y = pk2(o[2], o[3]);
                  *(v2u*)((bf16*)(ws + O_WOUT + l * SZ_WOUT1) + (size_t)(n0 + n) * 1024 + g * 64 + c0) = w; }
            }
            __syncthreads();
        }
        if (rep_ == 0 || ((REP_MASK >> 16) & 1)) {
            LAS bf16* scr = (LAS bf16*)(lds + wave * 16384);
#pragma clang loop vectorize(disable) unroll(disable)
            for (int it0 = gw; it0 < CV_L; it0 += NGW) conv_item(KA, 0, it0, scr, lane);
        }
    }
    SEAM(0);
    if ((REP_MASK >> 12) & 1) { for (int k_ = 0; k_ < 4; ++k_) xcd_barrier(bar); }

    layer_body<0>(lds, G, vcu, bar, lo, hi);
    layer_body<1>(lds, G, vcu, bar, lo, hi);
    if (IN(17)) {
        KA_DECL
        const float* modp = modv + (size_t)5 * 6144;
#pragma clang loop vectorize(disable) unroll(disable)
        for (int r = gw; r < T; r += NGW) {
            const float* g2 = modp + (r >> 12) * 6144 + 5 * 1024; float* dst = outp + (size_t)r * 1024;
#pragma unroll
            for (int j = 0; j < 4; ++j) {
                const int c0 = 4 * lane + 256 * j; const v2u xw = *(const v2u*)(xb + (size_t)r * 1024 + c0); const f32x4 v = {bflo(xw.x), bfhi(xw.x), bflo(xw.y), bfhi(xw.y)};
                const v2u ya = *(const v2u*)(y2 + (size_t)(2 * r) * 1024 + c0), yb = *(const v2u*)(y2 + (size_t)(2 * r + 1) * 1024 + c0);
                const f32x4 gv = *(const f32x4*)(g2 + c0);
                f32x4 yy; yy[0] = bflo(ya.x) + bflo(yb.x); yy[1] = bfhi(ya.x) + bfhi(yb.x); yy[2] = bflo(ya.y) + bflo(yb.y); yy[3] = bfhi(ya.y) + bfhi(yb.y);
                if (DBG_NO_MOE) yy = (f32x4){0.f, 0.f, 0.f, 0.f};
                *(f32x4*)(dst + c0) = v + gv * yy;
            }
        }
    }
#undef IN
#undef SEAM
}

#undef KA_DECL
#undef ws
#undef ctl
#undef x_in
#undef c_in
#undef ctx_in
#undef cctx_in
#undef w_mod
#undef b_mod
#undef norm1_g
#undef w_in
#undef q_norm_g
#undef k_norm_g
#undef attn_sink
#undef pool_w
#undef pool_scale
#undef four_w
#undef w_out
#undef norm2_g
#undef w_grp
#undef b_grp
#undef w_rtr
#undef b_rtr
#undef w_gate
#undef w_up
#undef w_down
#undef outp
#undef modv
#undef rope
#undef twt
#undef fma
#undef fmb
#undef fmc
#undef hbuf
#undef kall
#undef vall
#undef xc
#undef xb
#undef list
#undef wts
#undef act
#undef t2
#undef mrg
#undef qb
#undef pu
#undef zb
#undef y2
#undef modl
#undef win_t
#undef wout_t
#undef wgu_t
#undef wd_t
extern "C" void kernel_launch(void* const* d_in, const int* in_sizes, int n_in, void* d_out, int out_size, void* d_ws, size_t ws_size, hipStream_t stream) {
    static int grid = 0;
    if (grid == 0) {
        if (n_in != 23 || out_size != T * DM || ws_size < WS_END) { fprintf(stderr, "kernel_launch: unexpected shapes (n_in %d out %d ws %zu need %zu)\n", n_in, out_size, ws_size, (size_t)WS_END); grid = -1; return; }
        int dev = 0, cus = 0;
        if (hipGetDevice(&dev) != hipSuccess || hipDeviceGetAttribute(&cus, hipDeviceAttributeMultiprocessorCount, dev) != hipSuccess) { grid = -1; return; }
        if (cus != 256) { fprintf(stderr, "kernel_launch: built for a 256-CU device (row-tile hand-offs are laid out for 256 workgroups); found %d CUs; nothing launched\n", cus); grid = -1; return; }
        if (hipFuncSetAttribute((const void*)fwd_kernel, hipFuncAttributeMaxDynamicSharedMemorySize, LDS_BYTES) != hipSuccess) { fprintf(stderr, "kernel_launch: hipFuncSetAttribute failed\n"); grid = -1; return; }
        (void)hipGetLastError();
        grid = cus;
    }
    if (grid < 0) return;
    (void)hipMemsetAsync((char*)d_ws + O_CTL, 0, SZ_CTL, stream);
    Args a{};
    for (int i = 0; i < 23; ++i) a.in[i] = (const float*)d_in[i];
    a.out = (float*)d_out; a.ws = (unsigned char*)d_ws;
#if MK_SPLIT
    for (int p = 0; p < NPHASE; ++p) { a.ph_lo = p; a.ph_hi = p + 1; hipLaunchKernelGGL(fwd_kernel, dim3(grid), dim3(512), LDS_BYTES, stream, a); }
#else
    a.ph_lo = 0; a.ph_hi = NPHASE;
    hipLaunchKernelGGL(fwd_kernel, dim3(grid), dim3(512), LDS_BYTES, stream, a);
#endif
}
```

```cpp
#include <hip/hip_runtime.h>
#include <cstdio>
#include <cstdint>

#define DBG_NO_FOUR 0
#define DBG_NO_POOL 0
#define DBG_NO_ATT 0
#define DBG_NO_MOE 0
#define DBG_MOE_SCALE 1.0f
#define DBG_NAIVE_MOE 0
#define REP_MASK 0x0
#define DBG_NAIVE_ROUTE 0
#define LAS __attribute__((address_space(3)))
#define GAS __attribute__((address_space(1)))
typedef unsigned short bf16;
typedef short bf16x8 __attribute__((ext_vector_type(8)));
typedef float f32x4 __attribute__((ext_vector_type(4)));
typedef float f32x16 __attribute__((ext_vector_type(16)));
typedef unsigned v4u __attribute__((ext_vector_type(4)));
typedef unsigned v2u __attribute__((ext_vector_type(2)));
typedef float f32x2 __attribute__((ext_vector_type(2)));
typedef GAS unsigned gu32;

#ifndef MK_SPLIT
#define MK_SPLIT 0
#endif

constexpr int NB = 4, NSEQ = 4096, DM = 1024, LCTX = 256, DEPTH = 2;
constexpr int T = NB * NSEQ, TC = NB * LCTX, TT = T + TC;
constexpr int KVROWS = LCTX + NSEQ;
constexpr int NEXP = 16, DEXP = 512;
constexpr int NPHASE = 18;
constexpr int MAXTILES = 152;
constexpr float QSCALE = 0.125f * 1.4426950408889634f;
constexpr float LOG2E = 1.4426950408889634f;
constexpr float Y2SC = 16.0f;

constexpr size_t al256(size_t x) { return (x + 255) & ~(size_t)255; }
constexpr size_t O_CTL = 0, SZ_CTL = 1u << 20;
constexpr size_t O_MOD = O_CTL + SZ_CTL, SZ_MOD = (size_t)2 * 5 * 6144 * 4;
constexpr size_t O_ROPE = al256(O_MOD + SZ_MOD), SZ_ROPE = (size_t)4096 * 32 * 8;
constexpr size_t O_TW = al256(O_ROPE + SZ_ROPE), SZ_TW = 4096 * 8;
constexpr size_t O_FMA = al256(O_TW + SZ_TW), SZ_FMA = 128 * 128 * 2;
constexpr size_t O_FMB = al256(O_FMA + SZ_FMA), SZ_FMB = 64 * 128 * 2;
constexpr size_t O_FMC = al256(O_FMB + SZ_FMB), SZ_FMC = 256 * 512 * 2;
constexpr size_t O_RW = al256(O_FMC + SZ_FMC), SZ_RW = (size_t)2 * 20480 * 4;
constexpr size_t O_WIN8 = al256(O_RW + SZ_RW), SZ_WIN8 = (size_t)1280 * 1024;
constexpr size_t O_WIN = al256(O_WIN8 + 2 * SZ_WIN8), SZ_WIN1 = (size_t)1536 * 1024 * 2;
constexpr size_t O_WOUT = al256(O_WIN + 2 * SZ_WIN1), SZ_WOUT1 = (size_t)1024 * 1024 * 2;
constexpr size_t O_WGU = al256(O_WOUT + 2 * SZ_WOUT1), SZ_WGU1 = (size_t)16 * 1024 * 1024 * 2;
constexpr size_t O_WD = al256(O_WGU + 2 * SZ_WGU1), SZ_WD1 = (size_t)16 * 1024 * 512 * 2;
constexpr size_t O_H = al256(O_WD + 2 * SZ_WD1), SZ_H = (size_t)TT * 1024 * 2;
constexpr size_t O_KALL = al256(O_H + SZ_H), SZ_KV = (size_t)NB * KVROWS * 128 * 2;
constexpr size_t O_VALL = al256(O_KALL + SZ_KV);
constexpr size_t O_XC = al256(O_VALL + SZ_KV), SZ_XC = (size_t)TC * 1024 * 4;
constexpr size_t O_LIST = al256(O_XC + SZ_XC), SZ_LIST = (size_t)NEXP * TT * 4;
constexpr size_t O_WTS = al256(O_LIST + SZ_LIST), SZ_WTS = (size_t)TT * 2 * 4;
constexpr size_t O_EID = al256(O_WTS + SZ_WTS), SZ_EID = (size_t)TT * 2 * 4;
constexpr size_t O_ACT = al256(O_EID + SZ_EID), SZ_ACT = (size_t)MAXTILES * 256 * 512 * 2;
constexpr size_t O_T2 = O_ACT, SZ_T2 = (size_t)NB * 64 * 64 * 2 * 256 * 2;
constexpr size_t O_MRG = al256(O_ACT + SZ_ACT), SZ_MRG = (size_t)TT * 1024 * 2;
constexpr size_t O_Q = al256(O_MRG + SZ_MRG), SZ_Q = (size_t)TT * 512 * 2;
constexpr size_t O_PU = al256(O_Q + SZ_Q), SZ_PU = (size_t)TT * 256 * 2;
constexpr size_t O_Z = al256(O_PU + SZ_PU), SZ_Z = (size_t)TT * 512 * 2;
constexpr size_t O_Y2 = O_MRG, SZ_Y2 = (size_t)TT * 2 * 1024 * 2;
constexpr size_t O_XB = al256(O_Z + SZ_Z), SZ_XB = (size_t)TT * 1024 * 2;
constexpr size_t WS_END = al256(O_XB + SZ_XB);
static_assert(SZ_T2 <= SZ_ACT, "T2 overlay");
static_assert(O_Y2 + SZ_Y2 <= WS_END, "y2 overlay");

constexpr int CW_TMO = 0;
constexpr int CW_BAR = 4096;
constexpr int CW_KF = 65536;
constexpr int CW_FA = 3072;
constexpr int CW_G2 = 40960;
constexpr int CW_RDY = 32768;
constexpr int CW_Q = 2048;
constexpr int CW_DONE = 2560;
constexpr int CW_CNT = 16384;

constexpr int RING_BYTES = 131072;
constexpr int LDSCTL_OFF = RING_BYTES, MISC_OFF = LDSCTL_OFF + 320;
constexpr int TRIG_OFF = LDSCTL_OFF + 1024;
constexpr int TILE_OFF = LDSCTL_OFF + 2048;
constexpr int LDS_BYTES = 147456;

#define RLX_AGENT __ATOMIC_RELAXED, __HIP_MEMORY_SCOPE_AGENT
#define LDS_WAIT() asm volatile("s_waitcnt lgkmcnt(0)" ::: "memory")
#define VM_WAIT() asm volatile("s_waitcnt vmcnt(0)" ::: "memory")

__device__ __forceinline__ unsigned f2bf(float f) { unsigned u = __builtin_bit_cast(unsigned, f); return (u + 0x7fffu + ((u >> 16) & 1u)) >> 16; }
typedef float f32x2_t_ __attribute__((ext_vector_type(2))); typedef __bf16 bf16x2_t_ __attribute__((ext_vector_type(2)));
__device__ __forceinline__ unsigned pk2(float lo, float hi) { f32x2_t_ v = {lo, hi}; return __builtin_bit_cast(unsigned, __builtin_convertvector(v, bf16x2_t_)); }
__device__ __forceinline__ unsigned pk4_f8(float a, float b, float c, float d) { unsigned w = 0; w = __builtin_amdgcn_cvt_pk_fp8_f32(a, b, w, false); w = __builtin_amdgcn_cvt_pk_fp8_f32(c, d, w, true); return w; }
__device__ __forceinline__ f32x4 f8x4_f32(unsigned w) { const auto lo = __builtin_amdgcn_cvt_pk_f32_fp8(w, false); const auto hi = __builtin_amdgcn_cvt_pk_f32_fp8(w, true); return (f32x4){lo[0], lo[1], hi[0], hi[1]}; }
__device__ __forceinline__ float bflo(unsigned w) { return __builtin_bit_cast(float, w << 16); }
__device__ __forceinline__ float bfhi(unsigned w) { return __builtin_bit_cast(float, w & 0xffff0000u); }
__device__ __forceinline__ float bf2f(bf16 h) { return __builtin_bit_cast(float, (unsigned)h << 16); }
template <int CTRL, int RM> __device__ __forceinline__ float dppf(float v) { return __builtin_bit_cast(float, __builtin_amdgcn_update_dpp(0, __builtin_bit_cast(int, v), CTRL, RM, 0xf, true)); }
__device__ __forceinline__ float wave_sum(float v) {
    v += dppf<0x111, 0xf>(v); v += dppf<0x112, 0xf>(v); v += dppf<0x114, 0xf>(v); v += dppf<0x118, 0xf>(v);
    v += dppf<0x142, 0xa>(v); v += dppf<0x143, 0xc>(v);
    return __builtin_bit_cast(float, __builtin_amdgcn_readlane(__builtin_bit_cast(int, v), 63));
}

__device__ __forceinline__ float swap32_sum(float x, float y) {
    const auto rr = __builtin_amdgcn_permlane32_swap(__builtin_bit_cast(unsigned, x), __builtin_bit_cast(unsigned, y), false, false);
    unsigned r0 = rr[0], r1 = rr[1]; asm volatile("" : "+v"(r0), "+v"(r1));
    return __builtin_bit_cast(float, r0) + __builtin_bit_cast(float, r1);
}
__device__ __forceinline__ float swap16_sum(float x, float y) {
    const auto rr = __builtin_amdgcn_permlane16_swap(__builtin_bit_cast(unsigned, x), __builtin_bit_cast(unsigned, y), false, false);
    unsigned r0 = rr[0], r1 = rr[1]; asm volatile("" : "+v"(r0), "+v"(r1));
    return __builtin_bit_cast(float, r0) + __builtin_bit_cast(float, r1);
}

#define XB_TMO      128
#define XB_XCNT(j)  (256  + 64 * (j))
#define XB_XSUB(j)  (1280 + 64 * (j))
#define XB_XGEN(j)  (2304 + 64 * (j))
#define XB_TOP      3328
#define XB_TOPGEN   3392
#define XCD_BAR_WORDS 3456
#define XB_SPIN_CAP (1u << 18)
__device__ __forceinline__ unsigned xb_ld(unsigned* p)              { return __hip_atomic_load(p, __ATOMIC_RELAXED, __HIP_MEMORY_SCOPE_AGENT); }
__device__ __forceinline__ unsigned xb_add(unsigned* p, unsigned v) { return __hip_atomic_fetch_add(p, v, __ATOMIC_RELAXED, __HIP_MEMORY_SCOPE_AGENT); }
__device__ __forceinline__ unsigned xb_xcc_id() { return (unsigned)__builtin_amdgcn_s_getreg((3 << 11) | 20) & 0xFu; }
#define XB_SPIN(cond, bar) do { unsigned _sp = 0; while (cond) { __builtin_amdgcn_s_sleep(1); \
    if ((++_sp & 255u) == 0u) { if (xb_ld(&(bar)[XB_TMO])) break; if (_sp > XB_SPIN_CAP) { atomicAdd(&(bar)[XB_TMO], 1u); break; } } } } while (0)
struct XcdBarrier { unsigned* bar; unsigned x; volatile LAS unsigned* st; };
__device__ __forceinline__ XcdBarrier xcd_barrier_post(unsigned* bar, volatile LAS unsigned* st) {
    XcdBarrier b; b.bar = bar; b.x = xb_xcc_id(); b.st = st;
    if (threadIdx.x == 0) (void)xb_add(&bar[XB_XCNT(b.x)], 1u);
    return b;
}
__device__ __forceinline__ void xcd_barrier_complete(unsigned* bar, unsigned x, unsigned& nloc, unsigned& nx) {
    const unsigned G = gridDim.x * gridDim.y * gridDim.z;
    unsigned sum, cnt, mine, sp = 0u;
    for (;;) {
        sum = 0u; cnt = 0u; mine = 0u;
#pragma unroll
        for (unsigned j = 0; j < 16; ++j) { const unsigned c = xb_ld(&bar[XB_XCNT(j)]); sum += c; cnt += (c > 0u) ? 1u : 0u; mine = (j == x) ? c : mine; }
        if (sum == G) break;
        __builtin_amdgcn_s_sleep(1);
        if ((++sp & 255u) == 0u) { if (xb_ld(&bar[XB_TMO])) break; if (sp > XB_SPIN_CAP) { atomicAdd(&bar[XB_TMO], 1u); break; } }
    }
    nloc = mine > 0u ? mine : 1u; nx = cnt > 0u ? cnt : 1u;
}
__device__ __forceinline__ void xcd_barrier(const XcdBarrier& b) {
    asm volatile("s_waitcnt vmcnt(0)" ::: "memory");
    __syncthreads();
    if (threadIdx.x == 0) {
        unsigned* bar = b.bar;
        __builtin_amdgcn_s_waitcnt(0);
        unsigned nloc = b.st[0], nx = b.st[1];
        if (nloc == 0u) { xcd_barrier_complete(bar, b.x, nloc, nx); b.st[0] = nloc; b.st[1] = nx; }
        const unsigned old = xb_add(&bar[XB_XSUB(b.x)], 1u);
        const unsigned gen = old / nloc;
        if (old + 1u == (gen + 1u) * nloc) {
            __builtin_amdgcn_fence(__ATOMIC_RELEASE, "agent");
            asm volatile("s_waitcnt vmcnt(0)" ::: "memory");
            const unsigned og = xb_add(&bar[XB_TOP], 1u);
            const unsigned tg = og / nx;
            if (og + 1u == (tg + 1u) * nx) xb_add(&bar[XB_TOPGEN], 1u);
            else XB_SPIN(xb_ld(&bar[XB_TOPGEN]) == tg, bar);
            __builtin_amdgcn_fence(__ATOMIC_ACQUIRE, "agent");
            xb_add(&bar[XB_XGEN(b.x)], 1u);
            asm volatile("s_waitcnt vmcnt(0)" ::: "memory");
        } else {
            XB_SPIN(xb_ld(&bar[XB_XGEN(b.x)]) == gen, bar);
            __builtin_amdgcn_fence(__ATOMIC_ACQUIRE, "agent");
            asm volatile("s_waitcnt vmcnt(0)" ::: "memory");
        }
    }
    __syncthreads();
}

namespace pg8 {
constexpr int BM = 256, BK = 64, HALF = 128, HTB = HALF * BK * 2;
__host__ __device__ __forceinline__ int lds_byte(int r, int c) { const int st = (r >> 4) * 2 + (c >> 5), rr = r & 15, cc = c & 31, ob = rr * 64 + cc * 2; return st * 1024 + (ob ^ (((ob >> 9) & 1) << 5)); }
__host__ __device__ __forceinline__ void stage_rc(int b, int& R, int& C) { const int st = b / 1024, sb = b % 1024, swz = sb ^ (((sb >> 9) & 1) << 5); R = (st >> 1) * 16 + swz / 64; C = (st & 1) * 32 + (swz % 64) / 2; }
__host__ __device__ __forceinline__ int perm32(int rho) { const int n = rho >> 4, i = rho & 15; return 8 * (i >> 2) + 4 * n + (i & 3); }

struct Unit { int pm, pn, e, cnt, kind; };

typedef int v8i __attribute__((ext_vector_type(8)));
typedef int v4i __attribute__((ext_vector_type(4)));
template <class Epi, class Sched, bool F8ALL = false>
__device__ __forceinline__ void gemm_phase(LAS unsigned char* lds, const Sched& S, const Epi& E) {
    int tid = threadIdx.x; asm volatile("" : "+v"(tid));
    const int wid = __builtin_amdgcn_readfirstlane(tid >> 6), lane = tid & 63, wr = wid >> 2, wc = wid & 3, fr = lane & 15, fq = lane >> 4;
#define PG8_RC() int RA[2], CA[2], RB[2]; { int tl_ = tid; asm volatile("" : "+v"(tl_)); _Pragma("unroll") for (int i = 0; i < 2; ++i) { int R, C; stage_rc(tl_ * 16 + i * 8192, R, C); RA[i] = R; CA[i] = C; RB[i] = Epi::PERM ? ((R & ~31) + perm32(R & 31)) : R; } }
    const size_t kstep = (size_t)(BK * 2);
    const unsigned ldsw = (unsigned)wid * 1024u;
    const int aoff = lds_byte(wr * 64 + fr, fq * 8), boff = lds_byte(wc * 32 + fr, fq * 8);
#define PG8_SA(b, h) (((b) * 2 + (h)) * HTB)
#define PG8_SB(b, h) ((4 + (b) * 2 + (h)) * HTB)
#define PG8_STAGE2(bufoff, gbase, o0, o1) do { \
        __builtin_amdgcn_global_load_lds((const unsigned*)((const char*)(gbase) + (o0)), (LAS unsigned*)(lds + (bufoff) + ldsw), 16, 0, 0); \
        __builtin_amdgcn_global_load_lds((const unsigned*)((const char*)(gbase) + (o1)), (LAS unsigned*)(lds + (bufoff) + ldsw + 8192), 16, 0, 0); } while (0)
#define PG8_LD8(p) __builtin_shufflevector(*(const LAS v4i*)(p), *(const LAS v4i*)((p) + 1024), 0, 1, 2, 3, 4, 5, 6, 7)
#define PG8_LDA(dst, b, h) do { _Pragma("unroll") for (int m = 0; m < 4; ++m) dst[m] = PG8_LD8(lds + PG8_SA(b, h) + aoff + m * 2048); } while (0)
#define PG8_LDB(dst, b, h) do { _Pragma("unroll") for (int n = 0; n < 2; ++n) dst[n] = PG8_LD8(lds + PG8_SB(b, h) + boff + n * 2048); } while (0)
#define PG8_LO(x) __builtin_bit_cast(bf16x8, __builtin_shufflevector(x, x, 0, 1, 2, 3))
#define PG8_HI(x) __builtin_bit_cast(bf16x8, __builtin_shufflevector(x, x, 4, 5, 6, 7))
#define PG8_MMA(ai, bj, At, Bt) do { __builtin_amdgcn_s_setprio(1); \
        if (F8ALL) { _Pragma("unroll") for (int m = 0; m < 4; ++m) _Pragma("unroll") for (int n = 0; n < 2; ++n) \
            asm volatile("v_mfma_scale_f32_16x16x128_f8f6f4 %0, %1, %2, %0, %3, %3 op_sel_hi:[0,0,0]" : "+v"(acc[ai][bj][m][n]) : "v"(Bt[n]), "v"(At[m]), "v"(f8sc)); } \
        else { _Pragma("unroll") for (int m = 0; m < 4; ++m) _Pragma("unroll") for (int n = 0; n < 2; ++n) { \
            acc[ai][bj][m][n] = __builtin_amdgcn_mfma_f32_16x16x32_bf16(PG8_LO(Bt[n]), PG8_LO(At[m]), acc[ai][bj][m][n], 0, 0, 0); \
            acc[ai][bj][m][n] = __builtin_amdgcn_mfma_f32_16x16x32_bf16(PG8_HI(Bt[n]), PG8_HI(At[m]), acc[ai][bj][m][n], 0, 0, 0); } } \
        __builtin_amdgcn_s_setprio(0); } while (0)
#define PG8_WAIT_V(n) asm volatile("s_waitcnt vmcnt(" #n ")" ::: "memory")
#define PG8_WAIT_L(n) asm volatile("s_waitcnt lgkmcnt(" #n ")" ::: "memory")
#define PG8_BAR __builtin_amdgcn_s_barrier()
#define PG8_SCHED __builtin_amdgcn_sched_barrier(0)
    Unit cur, nxt; int ui = 0;
    if (!S.next(0, cur)) return;
    f32x4 acc[2][2][4][2];
#pragma unroll
    for (int a = 0; a < 2; ++a)
#pragma unroll
        for (int b = 0; b < 2; ++b)
#pragma unroll
            for (int m = 0; m < 4; ++m)
#pragma unroll
                for (int n = 0; n < 2; ++n) acc[a][b][m][n] = (f32x4){0.f, 0.f, 0.f, 0.f};
    v8i At[4], B0[2], B1[2];
    int f8sc = 0x7c7c7c7c; asm volatile("" : "+v"(f8sc));
    int Kc = S.K(cur), Kn; const char* Ac = S.a_base(cur); const char* An; const char* cB = S.b_ptr(cur); const char* nB;
    unsigned oc00, oc01, oc10, oc11, on00, on01, on10, on11, vbc0, vbc1, vbn0, vbn1; size_t hsc, hsn;
    { PG8_RC()
    oc00 = S.a_off(cur, RA[0], CA[0]); oc01 = S.a_off(cur, RA[1], CA[1]); oc10 = S.a_off(cur, HALF + RA[0], CA[0]); oc11 = S.a_off(cur, HALF + RA[1], CA[1]);
    vbc0 = (unsigned)(RB[0] * Kc + CA[0]) * 2u; vbc1 = (unsigned)(RB[1] * Kc + CA[1]) * 2u; hsc = (size_t)HALF * Kc * 2; }
    S.a_ready(cur);
    PG8_STAGE2(PG8_SB(0, 0), cB, vbc0, vbc1); PG8_STAGE2(PG8_SB(0, 1), cB + hsc, vbc0, vbc1); PG8_STAGE2(PG8_SA(0, 0), Ac, oc00, oc01); PG8_STAGE2(PG8_SA(0, 1), Ac, oc10, oc11);
    if (wr == 1) PG8_BAR;
    PG8_WAIT_V(2); PG8_BAR;
    PG8_STAGE2(PG8_SB(1, 0), cB + kstep, vbc0, vbc1); PG8_STAGE2(PG8_SA(1, 0), Ac + kstep, oc00, oc01); PG8_STAGE2(PG8_SB(1, 1), cB + hsc + kstep, vbc0, vbc1);
    PG8_WAIT_V(6); PG8_BAR;
    for (;;) {
        const bool has_next = S.next(ui + 1, nxt);
        Kn = Kc; An = Ac; nB = cB; on00 = oc00; on01 = oc01; on10 = oc10; on11 = oc11; vbn0 = vbc0; vbn1 = vbc1; hsn = hsc;
        if (has_next) { Kn = S.K(nxt); An = S.a_base(nxt); nB = S.b_ptr(nxt); PG8_RC()
            on00 = S.a_off(nxt, RA[0], CA[0]); on01 = S.a_off(nxt, RA[1], CA[1]); on10 = S.a_off(nxt, HALF + RA[0], CA[0]); on11 = S.a_off(nxt, HALF + RA[1], CA[1]);
            vbn0 = (unsigned)(RB[0] * Kn + CA[0]) * 2u; vbn1 = (unsigned)(RB[1] * Kn + CA[1]) * 2u; hsn = (size_t)HALF * Kn * 2; }
        const int nt = Kc / BK;
#pragma clang loop unroll(disable)
        for (int t = 0; t < nt; t += 2) {
            const bool last = (t == nt - 2);
            if (last && has_next) S.a_ready(nxt);
            const char* a1 = Ac + (size_t)(t + 1) * kstep;
            const char* a2 = last ? An : Ac + (size_t)(t + 2) * kstep; const char* b2 = last ? nB : cB + (size_t)(t + 2) * kstep;
            const char* a3 = a2 + kstep; const char* b3 = b2 + kstep;
            const unsigned x00 = last ? on00 : oc00, x01 = last ? on01 : oc01, x10 = last ? on10 : oc10, x11 = last ? on11 : oc11;
            const unsigned y0 = last ? vbn0 : vbc0, y1 = last ? vbn1 : vbc1; const size_t hs2 = last ? hsn : hsc;
            PG8_LDB(B0, 0, 0); PG8_LDB(B1, 0, 1); PG8_SCHED; PG8_LDA(At, 0, 0); PG8_STAGE2(PG8_SA(1, 1), a1, oc10, oc11);
            PG8_WAIT_V(8); PG8_WAIT_L(0); PG8_BAR; PG8_MMA(0, 0, At, B0); PG8_MMA(0, 1, At, B1); PG8_BAR; PG8_SCHED;
            PG8_LDA(At, 0, 1); PG8_STAGE2(PG8_SB(0, 0), b2, y0, y1); PG8_STAGE2(PG8_SB(0, 1), b2 + hs2, y0, y1); PG8_STAGE2(PG8_SA(0, 0), a2, x00, x01);
            PG8_WAIT_V(8); PG8_WAIT_L(0); PG8_BAR; PG8_MMA(1, 0, At, B0); PG8_MMA(1, 1, At, B1); PG8_BAR; PG8_SCHED;
            PG8_LDB(B0, 1, 0); PG8_LDB(B1, 1, 1); PG8_SCHED; PG8_LDA(At, 1, 0); PG8_STAGE2(PG8_SA(0, 1), a2, x10, x11);
            PG8_WAIT_V(8); PG8_WAIT_L(0); PG8_BAR; PG8_MMA(0, 0, At, B0); PG8_MMA(0, 1, At, B1); PG8_BAR; PG8_SCHED;
            PG8_LDA(At, 1, 1); PG8_STAGE2(PG8_SB(1, 0), b3, y0, y1); PG8_STAGE2(PG8_SB(1, 1), b3 + hs2, y0, y1); PG8_STAGE2(PG8_SA(1, 0), a3, x00, x01);
            PG8_WAIT_V(8); PG8_WAIT_L(0); PG8_BAR; PG8_MMA(1, 0, At, B0); PG8_MMA(1, 1, At, B1); PG8_BAR; PG8_SCHED;
        }
        if (wr == 0) PG8_BAR;
        if (F8ALL) asm volatile("s_nop 15\n\ts_nop 15" ::: "memory");
        E(acc, cur, wr, wc, fr, fq);
        if (!has_next) break;
#pragma unroll
        for (int a = 0; a < 2; ++a)
#pragma unroll
            for (int b = 0; b < 2; ++b)
#pragma unroll
                for (int m = 0; m < 4; ++m)
#pragma unroll
                    for (int n = 0; n < 2; ++n) acc[a][b][m][n] = (f32x4){0.f, 0.f, 0.f, 0.f};
        cur = nxt; Kc = Kn; Ac = An; cB = nB; oc00 = on00; oc01 = on01; oc10 = on10; oc11 = on11; vbc0 = vbn0; vbc1 = vbn1; hsc = hsn; ++ui;
        if (wr == 1) PG8_BAR;
    }
    PG8_WAIT_V(0);
    PG8_BAR;
#undef PG8_RC
#undef PG8_SA
#undef PG8_SB
#undef PG8_STAGE2
#undef PG8_LDA
#undef PG8_LD8
#undef PG8_LO
#undef PG8_HI
#undef PG8_LDB
#undef PG8_MMA
#undef PG8_WAIT_V
#undef PG8_WAIT_L
#undef PG8_BAR
#undef PG8_SCHED
}
}

__device__ __forceinline__ void store16_wt(void* p, v4u v) { asm volatile("global_store_dwordx4 %0, %1, off sc1\n\ts_nop 1" :: "v"(p), "v"(v) : "memory"); }
__device__ __forceinline__ int krow_of(int r) {
    if (r < T) return (r >> 12) * KVROWS + LCTX + (r & 4095);
    const int rc = r - T; return (rc >> 8) * KVROWS + (rc & 255);
}
struct SchedPlain {
    int nM, nN, G, vcu, Kk; const char* A; const char* B;
    __device__ __forceinline__ bool next(int i, pg8::Unit& u) const { const int L = i * G + vcu; if (L >= nM * nN) return false; u.pm = L / nN; u.pn = L % nN; u.e = 0; u.cnt = 256; u.kind = 0; return true; }
    __device__ __forceinline__ int K(const pg8::Unit&) const { return Kk; }
    __device__ __forceinline__ const char* a_base(const pg8::Unit&) const { return A; }
    __device__ __forceinline__ unsigned a_off(const pg8::Unit& u, int row, int col) const { return (unsigned)((u.pm * 256 + row) * Kk + col) * 2u; }
    __device__ __forceinline__ const char* b_ptr(const pg8::Unit& u) const { return B + (size_t)u.pn * 256 * Kk * 2; }
    __device__ __forceinline__ void a_ready(const pg8::Unit&) const {}
};
struct SchedG1 {
    int G, vcu, f8, lyr; const char* A; const char* B;
    __device__ __forceinline__ bool next(int i, pg8::Unit& u) const {
        const int nb16 = lyr ? T / 256 : TT / 256;
        u.e = 0; u.cnt = 256; u.kind = 0;
        if (!f8) { if (i > 0 || vcu >= nb16) return false; u.pm = vcu; u.pn = 0; return true; }
        const int nW = G - nb16; if (vcu < nb16) return false;
        const int L = i * nW + (vcu - nb16); const int nlat = (T / 256) * 5; const int ntot = nlat + (lyr ? 4 : 20);
        if (L >= ntot) return false;
        if (L < nlat) { u.pm = L / 5; u.pn = 1 + L % 5; }
        else if (lyr) { u.pm = T / 256 + (L - nlat); u.pn = 3; }
        else { u.pm = T / 256 + (L - nlat) / 5; u.pn = 1 + (L - nlat) % 5; }
        return true; }
    __device__ __forceinline__ int K(const pg8::Unit&) const { return f8 ? 512 : 1024; }
    __device__ __forceinline__ const char* a_base(const pg8::Unit&) const { return A; }
    __device__ __forceinline__ unsigned a_off(const pg8::Unit& u, int row, int col) const { return (unsigned)((u.pm * 256 + row) * (f8 ? 512 : 1024) + col) * 2u; }
    __device__ __forceinline__ const char* b_ptr(const pg8::Unit& u) const { return f8 ? B + (size_t)(u.pn - 1) * 256 * 1024 : B + (size_t)u.pn * 256 * 1024 * 2; }
    __device__ __forceinline__ void a_ready(const pg8::Unit&) const {}
};
struct EpiG1 {
    static constexpr bool PERM = true;
    bf16 *pu, *q, *kall, *vall, *z;
    __device__ __forceinline__ void operator()(const f32x4 (&acc)[2][2][4][2], const pg8::Unit& u, int wr, int wc, int fr, int fq) const {
        const int row0 = u.pm * 256 + wr * 64 + fr, c8 = wc * 32 + 8 * fq;
#pragma unroll
        for (int ai = 0; ai < 2; ++ai)
#pragma unroll
            for (int m = 0; m < 4; ++m) {
                const int row = row0 + ai * 128 + m * 16;
#pragma unroll
                for (int bj = 0; bj < 2; ++bj) {
                    const f32x4 v0 = acc[ai][bj][m][0], v1 = acc[ai][bj][m][1];
                    v4u w; w.x = pk2(v0[0], v0[1]); w.y = pk2(v0[2], v0[3]); w.z = pk2(v1[0], v1[1]); w.w = pk2(v1[2], v1[3]);
                    bf16* dst;
                    if (u.pn == 0) dst = pu + (size_t)row * 256 + bj * 128 + c8;
                    else if (u.pn <= 2) dst = q + (size_t)row * 512 + (u.pn - 1) * 256 + bj * 128 + c8;
                    else if (u.pn == 3) dst = (bj == 0 ? kall : vall) + (size_t)krow_of(row) * 128 + c8;
                    else dst = z + (size_t)row * 512 + (u.pn - 4) * 256 + bj * 128 + c8;
                    *(v4u*)dst = w;
                }
            }
    }
};
template <bool BB> struct EpiG2 {
    static constexpr bool PERM = true;
    const float* xin; const float* cin; bf16* xs; const float* mod; unsigned* ready;
    __device__ __forceinline__ void operator()(const f32x4 (&acc)[2][2][4][2], const pg8::Unit& u, int wr, int wc, int fr, int fq) const {
        const int rt0 = u.pm * 256; const bool isc = rt0 >= T;
        const int bsel = isc ? 4 : (rt0 >> 12);
        const float* g1 = mod + bsel * 6144 + 2048;
        const float* base = isc ? cin - (size_t)T * 1024 : xin;
        const int row0 = rt0 + wr * 64 + fr, c8 = u.pn * 256 + wc * 32 + 8 * fq;
#pragma unroll
        for (int bj = 0; bj < 2; ++bj) {
            const int col = c8 + bj * 128; const f32x4 ga = *(const f32x4*)(g1 + col), gb = *(const f32x4*)(g1 + col + 4);
            if (BB) {
                v4u b[2][4];
#pragma unroll
                for (int ai = 0; ai < 2; ++ai)
#pragma unroll
                    for (int m = 0; m < 4; ++m) b[ai][m] = *(const v4u*)(xs + (size_t)(row0 + ai * 128 + m * 16) * 1024 + col);
#pragma unroll
                for (int ai = 0; ai < 2; ++ai)
#pragma unroll
                    for (int m = 0; m < 4; ++m) { const v4u w = b[ai][m]; const f32x4 a0 = acc[ai][bj][m][0], a1 = acc[ai][bj][m][1];
                        v4u o; o.x = pk2(bflo(w.x) + ga[0] * a0[0], bfhi(w.x) + ga[1] * a0[1]); o.y = pk2(bflo(w.y) + ga[2] * a0[2], bfhi(w.y) + ga[3] * a0[3]);
                        o.z = pk2(bflo(w.z) + gb[0] * a1[0], bfhi(w.z) + gb[1] * a1[1]); o.w = pk2(bflo(w.w) + gb[2] * a1[2], bfhi(w.w) + gb[3] * a1[3]);
                        store16_wt(xs + (size_t)(row0 + ai * 128 + m * 16) * 1024 + col, o); }
            } else {
#pragma unroll
                for (int ai = 0; ai < 2; ++ai) {
                    f32x4 b0[4], b1[4];
#pragma unroll
                    for (int m = 0; m < 4; ++m) { const float* bp = base + (size_t)(row0 + ai * 128 + m * 16) * 1024 + col; b0[m] = *(const f32x4*)bp; b1[m] = *(const f32x4*)(bp + 4); }
#pragma unroll
                    for (int m = 0; m < 4; ++m) { const f32x4 x0 = b0[m] + ga * acc[ai][bj][m][0], x1 = b1[m] + gb * acc[ai][bj][m][1];
                        v4u o; o.x = pk2(x0[0], x0[1]); o.y = pk2(x0[2], x0[3]); o.z = pk2(x1[0], x1[1]); o.w = pk2(x1[2], x1[3]);
                        store16_wt(xs + (size_t)(row0 + ai * 128 + m * 16) * 1024 + col, o); }
                }
            }
        }
        asm volatile("s_waitcnt vmcnt(0)" ::: "memory");
        if ((threadIdx.x & 63) == 0) __hip_atomic_fetch_add(ready + 16 * u.pm, 1u, __ATOMIC_RELAXED, __HIP_MEMORY_SCOPE_AGENT);
    }
};
struct SchedMoe {
    int G, vcu, ntile;
    const char* hb; const char* actb; const char* wgu; const char* wd; const unsigned* list; const LAS int* tt; unsigned* ready; unsigned* tmo;
    __device__ __forceinline__ bool next(int i, pg8::Unit& u) const {
        const int U = ntile * 4; const int r = U % G, q = U / G; const int n3 = q + (vcu < r ? 1 : 0); int L;
        if (i < n3) { L = i * G + vcu; u.kind = 0; }
        else { const int j = i - n3; const int nl = G - r;
            if (vcu >= r) L = (j == 0) ? (vcu - r) : (j == 1) ? nl + (vcu - r) : 2 * nl + (j - 2) * G + vcu;
            else L = 2 * nl + j * G + vcu;
            if (L >= U) return false; u.kind = 1; }
        const int tau = L >> 2; u.pn = L & 3; u.pm = tau; int e = 0;
#pragma unroll
        for (int k = 1; k < 16; ++k) e += (tt[k] <= tau) ? 1 : 0;
        u.e = e; const int r0 = (tau - tt[e]) * 256; const int c = tt[17 + e] - r0; u.cnt = c < 256 ? c : 256; return true;
    }
    __device__ __forceinline__ int K(const pg8::Unit& u) const { return u.kind ? 256 : 512; }
    __device__ __forceinline__ const char* a_base(const pg8::Unit& u) const { return u.kind ? actb : hb; }
    __device__ __forceinline__ unsigned a_off(const pg8::Unit& u, int row, int col) const {
        if (u.kind) return (unsigned)((u.pm * 256 + row) * 256 + col) * 2u;
        const int r0 = (u.pm - tt[u.e]) * 256; const int rr = row < u.cnt ? row : u.cnt - 1;
        const unsigned tok = list[(size_t)u.e * TT + r0 + rr] >> 1;
        return (tok * 512u + (unsigned)col) * 2u;
    }
    __device__ __forceinline__ const char* b_ptr(const pg8::Unit& u) const { return u.kind ? wd + ((size_t)u.e * 1024 + (size_t)u.pn * 256) * 256 * 2 : wgu + ((size_t)u.e * 1024 + (size_t)u.pn * 256) * 512 * 2; }
    __device__ __forceinline__ void a_ready(const pg8::Unit& u) const {
        if (!u.kind) return;
        if (threadIdx.x < 64) {
            unsigned* w = ready + 16 * u.pm; unsigned sp = 0;
            while ((unsigned)__builtin_amdgcn_readfirstlane(__hip_atomic_load(w, __ATOMIC_RELAXED, __HIP_MEMORY_SCOPE_AGENT)) < 32u) {
                __builtin_amdgcn_s_sleep(2);
                if (++sp > (1u << 22)) { if (threadIdx.x == 0) __hip_atomic_store(tmo, 1u, __ATOMIC_RELAXED, __HIP_MEMORY_SCOPE_AGENT); break; } }
            __builtin_amdgcn_fence(__ATOMIC_ACQUIRE, "agent");
            asm volatile("s_waitcnt vmcnt(0)" ::: "memory");
        }
        asm volatile("" ::: "memory"); __builtin_amdgcn_s_barrier(); asm volatile("" ::: "memory");
    }
};
struct EpiG3 {
    static constexpr bool PERM = true;
    bf16* act; unsigned* ready;
    __device__ __forceinline__ void operator()(const f32x4 (&acc)[2][2][4][2], const pg8::Unit& u, int wr, int wc, int fr, int fq) const {
        const int row0 = u.pm * 256 + wr * 64 + fr, c8 = u.pn * 128 + wc * 32 + 8 * fq;
#pragma unroll
        for (int ai = 0; ai < 2; ++ai)
#pragma unroll
            for (int m = 0; m < 4; ++m) {
                float a[8];
#pragma unroll
                for (int n = 0; n < 2; ++n)
#pragma unroll
                    for (int k = 0; k < 4; ++k) { const float g = acc[ai][0][m][n][k], up = acc[ai][1][m][n][k]; a[n * 4 + k] = g * __builtin_amdgcn_rcpf(1.f + __builtin_amdgcn_exp2f(-LOG2E * g)) * up; }
                const unsigned long long w8 = (unsigned long long)pk4_f8(a[0], a[1], a[2], a[3]) | ((unsigned long long)pk4_f8(a[4], a[5], a[6], a[7]) << 32);
                __hip_atomic_store((unsigned long long*)((unsigned char*)act + (size_t)(row0 + ai * 128 + m * 16) * 512 + c8), w8, __ATOMIC_RELAXED, __HIP_MEMORY_SCOPE_AGENT);
            }
        asm volatile("s_waitcnt vmcnt(0)" ::: "memory");
        if ((threadIdx.x & 63) == 0) __hip_atomic_fetch_add(ready + 16 * u.pm, 1u, __ATOMIC_RELAXED, __HIP_MEMORY_SCOPE_AGENT);
    }
};
struct EpiG4 {
    static constexpr bool PERM = true;
    unsigned char* y2; const unsigned* list; const float* wts; const LAS int* tt;
    __device__ __forceinline__ void operator()(const f32x4 (&acc)[2][2][4][2], const pg8::Unit& u, int wr, int wc, int fr, int fq) const {
        const int r0 = (u.pm - tt[u.e]) * 256; const int c8 = u.pn * 256 + wc * 32 + 8 * fq;
        unsigned ent[2][4]; float w[2][4];
#pragma unroll
        for (int ai = 0; ai < 2; ++ai)
#pragma unroll
            for (int m = 0; m < 4; ++m) { const int row = wr * 64 + fr + ai * 128 + m * 16; ent[ai][m] = list[(size_t)u.e * TT + r0 + (row < u.cnt ? row : u.cnt - 1)]; }
#pragma unroll
        for (int ai = 0; ai < 2; ++ai)
#pragma unroll
            for (int m = 0; m < 4; ++m) w[ai][m] = wts[ent[ai][m]] * Y2SC;
#pragma unroll
        for (int ai = 0; ai < 2; ++ai)
#pragma unroll
            for (int m = 0; m < 4; ++m) {
                const int row = wr * 64 + fr + ai * 128 + m * 16;
                if (row < u.cnt) {
#pragma unroll
                    for (int bj = 0; bj < 2; ++bj) {
                        const f32x4 v0 = acc[ai][bj][m][0] * w[ai][m], v1 = acc[ai][bj][m][1] * w[ai][m];
                        v2u o; o.x = pk4_f8(v0[0], v0[1], v0[2], v0[3]); o.y = pk4_f8(v1[0], v1[1], v1[2], v1[3]);
                        *(v2u*)(y2 + (size_t)ent[ai][m] * 1024 + bj * 128 + c8) = o;
                    }
                }
            }
    }
};

struct EpiMoe { static constexpr bool PERM = true; EpiG3 e3; EpiG4 e4;
    __device__ __forceinline__ void operator()(const f32x4 (&acc)[2][2][4][2], const pg8::Unit& u, int wr, int wc, int fr, int fq) const { if (u.kind) e4(acc, u, wr, wc, fr, fq); else e3(acc, u, wr, wc, fr, fq); } };

#include <hip/hip_bf16.h>
#include <cmath>
namespace attn_body {
using bf16=__hip_bfloat16;
using bf16x8=__attribute__((ext_vector_type(8)))short;
using s16x4=__attribute__((ext_vector_type(4)))short;
using f32x16=__attribute__((ext_vector_type(16)))float;
using u32x4=__attribute__((ext_vector_type(4)))unsigned;
constexpr int D=64,QP=512,KVP=128,OP=1024;
constexpr int NW=8,QBLK=32,KVBLK=64;
__device__ __forceinline__ int crow(int r,int hi){return (r&3)+8*(r>>2)+4*hi;}
#define SBAR() __builtin_amdgcn_sched_barrier(0)
__device__ __forceinline__ void wmask(f32x16&p0,f32x16&p1,int kp0,int qpos,int hi){
  const float NEG=-INFINITY; const bool tile_ok=(unsigned)kp0<4096u; const int base=kp0+4*hi-qpos+128;
  #pragma unroll
  for(int r=0;r<16;++r){const int dd=base+(r&3)+8*(r>>2); if(!tile_ok||(unsigned)dd>256u)p0[r]=NEG; if(!tile_ok||(unsigned)(dd+32)>256u)p1[r]=NEG;}
}
constexpr int NSLOT=3, SLOTB=8192;
constexpr int LDS_K=0, LDS_V=NSLOT*SLOTB, LDS_WS=2*NSLOT*SLOTB, LDS_OST=LDS_WS+NW*64*4, LDS_BYTES=LDS_OST+NW*4096;
constexpr float C2=0.125f*1.4426950408889634f;
__device__ __forceinline__ void glds16(const void*gsrc,unsigned lds_dst){unsigned keep;
  asm volatile("s_mov_b32 %0, m0\n\ts_mov_b32 m0, %2\n\ts_nop 0\n\tglobal_load_lds_dwordx4 %1, off\n\ts_mov_b32 m0, %0":"=&s"(keep):"v"(gsrc),"s"(lds_dst):"memory");}
__device__ __forceinline__ float max3f(float a,float b,float c){float r;asm("v_max3_f32 %0, %1, %2, %3":"=v"(r):"v"(a),"v"(b),"v"(c));return r;}
__device__ __forceinline__ float max2f(float a,float b){float r;asm("v_max_f32_e32 %0, %1, %2":"=v"(r):"v"(a),"v"(b));return r;}
__device__ __forceinline__ float fadd_s(float a,float b){float r;asm("v_add_f32_e32 %0, %1, %2":"=v"(r):"v"(a),"v"(b));return r;}
__device__ __forceinline__ float fsub_s(float a,float b){float r;asm("v_sub_f32_e32 %0, %1, %2":"=v"(r):"v"(a),"v"(b));return r;}
typedef float f32x2_t __attribute__((ext_vector_type(2))); typedef __bf16 bf16x2_t __attribute__((ext_vector_type(2)));
__device__ __forceinline__ unsigned cvtpk_s(float lo,float hi){f32x2_t v={lo,hi};bf16x2_t b=__builtin_convertvector(v,bf16x2_t);return __builtin_bit_cast(unsigned,b);}
#define WAIT_BAR(N) asm volatile("s_waitcnt vmcnt(" #N ") lgkmcnt(0)\n\ts_barrier":::"memory")

__device__ __forceinline__ void qkt(f32x16&p0,f32x16&p1,const char*Kslot,const bf16x8*qr,const f32x16&negm,int r32,int hi){
  const char*kb=Kslot+hi*1024+r32*16;
  #pragma unroll
  for(int d0=0;d0<4;++d0){
    const bf16x8 b0=*reinterpret_cast<const bf16x8*>(kb+d0*2048);
    const bf16x8 b1=*reinterpret_cast<const bf16x8*>(kb+d0*2048+512);
    if(d0==0){p0=__builtin_amdgcn_mfma_f32_32x32x16_bf16(b0,qr[0],negm,0,0,0);p1=__builtin_amdgcn_mfma_f32_32x32x16_bf16(b1,qr[0],negm,0,0,0);}
    else{p0=__builtin_amdgcn_mfma_f32_32x32x16_bf16(b0,qr[d0],p0,0,0,0);p1=__builtin_amdgcn_mfma_f32_32x32x16_bf16(b1,qr[d0],p1,0,0,0);}}
}
typedef __attribute__((address_space(3))) const char* lds_cptr;
typedef short v4i16_t __attribute__((ext_vector_type(4)));
__device__ __forceinline__ void kload8(bf16x8*kf,lds_cptr kp){
  kf[0]=*(const __attribute__((address_space(3))) bf16x8*)(kp);      kf[1]=*(const __attribute__((address_space(3))) bf16x8*)(kp+512);
  kf[2]=*(const __attribute__((address_space(3))) bf16x8*)(kp+2048); kf[3]=*(const __attribute__((address_space(3))) bf16x8*)(kp+2560);
  kf[4]=*(const __attribute__((address_space(3))) bf16x8*)(kp+4096); kf[5]=*(const __attribute__((address_space(3))) bf16x8*)(kp+4608);
  kf[6]=*(const __attribute__((address_space(3))) bf16x8*)(kp+6144); kf[7]=*(const __attribute__((address_space(3))) bf16x8*)(kp+6656);
}
__device__ __forceinline__ void kload2(bf16x8*kf,lds_cptr kp,int j){ kf[2*j]=*(const __attribute__((address_space(3))) bf16x8*)(kp+j*2048); kf[2*j+1]=*(const __attribute__((address_space(3))) bf16x8*)(kp+j*2048+512); }
__device__ __forceinline__ s16x4 vtr(lds_cptr p){ return __builtin_bit_cast(s16x4,__builtin_amdgcn_ds_read_tr16_b64_v4i16((__attribute__((address_space(3))) v4i16_t*)p)); }
__device__ __forceinline__ float rowmax(const f32x16&p0,const f32x16&p1){
  float a=max3f(p0[0],p0[1],p1[0]),b=max3f(p0[2],p0[3],p1[1]);a=max3f(a,p1[2],p1[3]);
  #pragma unroll
  for(int r=4;r<16;r+=4){a=max3f(a,p0[r],p0[r+1]);b=max3f(b,p0[r+2],p0[r+3]);a=max3f(a,p1[r],p1[r+1]);b=max3f(b,p1[r+2],p1[r+3]);}
  const float m=max2f(a,b);
  auto rr=__builtin_amdgcn_permlane32_swap(__float_as_uint(m),__float_as_uint(m),false,false);
  return max2f(__uint_as_float(rr[0]),__uint_as_float(rr[1]));
}
__device__ __forceinline__ void pv(f32x16*o,int vb,bf16x8 pa0,bf16x8 pa1,bf16x8 pa2,bf16x8 pa3){
  #pragma unroll
  for(int d0=0;d0<2;++d0){s16x4 lo[4],hi[4];
    #pragma unroll
    for(int ks=0;ks<4;++ks){
      asm volatile("ds_read_b64_tr_b16 %0,%1 offset:%c2":"=&v"(lo[ks]):"v"(vb),"i"(d0*4096+ks*1024):"memory");
      asm volatile("ds_read_b64_tr_b16 %0,%1 offset:%c2":"=&v"(hi[ks]):"v"(vb),"i"(d0*4096+ks*1024+512):"memory");}
    asm volatile("s_waitcnt lgkmcnt(0)":::"memory");SBAR();
    #define PK(k) (bf16x8){lo[k][0],lo[k][1],lo[k][2],lo[k][3],hi[k][0],hi[k][1],hi[k][2],hi[k][3]}
    o[d0]=__builtin_amdgcn_mfma_f32_32x32x16_bf16(pa0,PK(0),o[d0],0,0,0);
    o[d0]=__builtin_amdgcn_mfma_f32_32x32x16_bf16(pa1,PK(1),o[d0],0,0,0);
    o[d0]=__builtin_amdgcn_mfma_f32_32x32x16_bf16(pa2,PK(2),o[d0],0,0,0);
    o[d0]=__builtin_amdgcn_mfma_f32_32x32x16_bf16(pa3,PK(3),o[d0],0,0,0);
    #undef PK
  }
}

#ifndef ATTN_STORE16
#define ATTN_STORE16(p,v) (*(u32x4*)(p)=(v))
#endif
template<int THRL> __device__ __forceinline__ void attn_unit(const bf16*Qu,const bf16*__restrict__ Kh,const bf16*__restrict__ Vh,bf16*Ou,const int p0,const int NT,const float* sinkp,const float* qg,const float2* ropet,char*shm){
  int tid=threadIdx.x; asm volatile("":"+v"(tid)); const int lane=tid&63,r32=lane&31,hi=lane>>5; const int wid=__builtin_amdgcn_readfirstlane(tid>>6);
  const int hsub=wid>>1, psub=(wid&1)*QBLK;
  const bf16*Qw=Qu+(long)psub*QP+hsub*D;
  const unsigned lds0=(unsigned)(uintptr_t)shm;
  float*wsf=(float*)(shm+LDS_WS)+wid*64;
  const bf16*ksrc=Kh+(long)lane*KVP+wid*8;
  const bf16*vsrc=Vh+(long)(16*(wid&3)+(lane>>2))*KVP+(wid>>2)*32+(lane&3)*8;
  const unsigned kdst=lds0+LDS_K+wid*1024, vdst=lds0+LDS_V+wid*1024;
  #define KP0(t) (p0-128+64*((t)-4))
  #define TROW(t) ((t)<4?64*(t):(((unsigned)KP0(t)<4096u)?256+KP0(t):256))
  #define DMA_K(t,slot) glds16(ksrc+(long)TROW(t)*KVP,(unsigned)__builtin_amdgcn_readfirstlane(kdst+(slot)))
  #define DMA_V(t,slot) glds16(vsrc+(long)TROW(t)*KVP,(unsigned)__builtin_amdgcn_readfirstlane(vdst+(slot)))
  const int vb0=(int)(lds0+LDS_V)+((lane>>4)&1)*32+(lane&3)*8+(4*hi+((lane&15)>>2))*64;
  const char*Kbase=shm+LDS_K; bf16x8 kf[8];
  const lds_cptr shm3=(lds_cptr)shm; const lds_cptr kp0=shm3+LDS_K+hi*1024+r32*16; const lds_cptr vp0=shm3+LDS_V+((lane>>4)&1)*32+(lane&3)*8+(4*hi+((lane&15)>>2))*64;
  DMA_K(0,0);DMA_V(0,0);DMA_K(1,SLOTB);
  bf16x8 qr[4];
  { bf16x8 qraw[4];
    #pragma unroll
    for(int d0=0;d0<4;++d0)qraw[d0]=*reinterpret_cast<const bf16x8*>(&Qw[(long)r32*QP+d0*16+hi*8]);
    float qf[4][8]; float ss=0.f;
    #pragma unroll
    for(int d0=0;d0<4;++d0)
      #pragma unroll
      for(int j=0;j<8;++j){ qf[d0][j]=__builtin_bit_cast(float,(unsigned)(unsigned short)qraw[d0][j]<<16); ss+=qf[d0][j]*qf[d0][j]; }
    ss+=__shfl_xor(ss,32);
    const float rstd=1.0f/sqrtf(ss*(1.f/64.f)+1e-6f)*C2;
    #pragma unroll
    for(int d0=0;d0<4;++d0)
      #pragma unroll
      for(int j=0;j<8;++j) qf[d0][j]*=rstd*qg[16*d0+8*hi+j];
    if(ropet){ const float2* rp=ropet+(long)(p0+psub+r32)*32+8*hi;
      #pragma unroll
      for(int j=0;j<8;++j){ const float2 c1=rp[j],c2=rp[16+j];
        const float a=qf[0][j],b=qf[1][j],c=qf[2][j],d=qf[3][j];
        qf[0][j]=a*c1.x-b*c1.y; qf[1][j]=b*c1.x+a*c1.y; qf[2][j]=c*c2.x-d*c2.y; qf[3][j]=d*c2.x+c*c2.y; } }
    #pragma unroll
    for(int d0=0;d0<4;++d0){ u32x4 w; w[0]=cvtpk_s(qf[d0][0],qf[d0][1]); w[1]=cvtpk_s(qf[d0][2],qf[d0][3]); w[2]=cvtpk_s(qf[d0][4],qf[d0][5]); w[3]=cvtpk_s(qf[d0][6],qf[d0][7]); qr[d0]=__builtin_bit_cast(bf16x8,w); } }
  float mhat=0.f,l_reg=0.f;f32x16 o[2];o[0]=f32x16{};o[1]=f32x16{};f32x16 negm=f32x16{};asm volatile("":"+v"(negm));
  const int qpos=p0+psub+r32;
  #define CMASK(P0,P1,t) do{ if((t)>=4)wmask(P0,P1,KP0(t),qpos,hi); }while(0)
  bool resc=false;
  #define START(P0,P1) do{ const float rm=rowmax(P0,P1); resc=false; \
    { const float dl=rm; mhat=fadd_s(mhat,dl); \
      _Pragma("unroll") for(int r=0;r<16;++r){P0[r]=fsub_s(P0[r],dl);P1[r]=fsub_s(P1[r],dl);} \
      _Pragma("unroll") for(int r=0;r<16;++r)negm[r]=-mhat; asm volatile("":"+v"(negm)); } \
    _Pragma("unroll") for(int r=0;r<16;++r)P0[r]=__builtin_amdgcn_exp2f(P0[r]); }while(0)
  #define RESC() do{ if(resc){ asm volatile("s_waitcnt lgkmcnt(0)":::"memory"); \
      _Pragma("unroll") for(int d_=0;d_<2;++d_) _Pragma("unroll") for(int r=0;r<16;++r)o[d_][r]*=wsf[crow(r,hi)]; } }while(0)
  f32x16 pA0,pA1,pB0,pB1;
  int sl_prev=0,sl_cur=0,sl_next=SLOTB;
  #define ROT() do{sl_prev=sl_cur;sl_cur=sl_next;sl_next=(sl_next==(NSLOT-1)*SLOTB)?0:sl_next+SLOTB;}while(0)
  DMA_K(2,2*SLOTB);
  WAIT_BAR(3);
  qkt(pA0,pA1,Kbase,qr,negm,r32,hi);asm volatile("s_nop 15\n\ts_nop 7":"+v"(pA0),"+v"(pA1));CMASK(pA0,pA1,0);
  START(pA0,pA1);
  _Pragma("unroll") for(int r=0;r<16;++r)pA1[r]=__builtin_amdgcn_exp2f(pA1[r]);
  WAIT_BAR(0);
  DMA_K(3,0);DMA_V(1,SLOTB);
  ROT();
  kload8(kf,kp0+sl_cur);
  WAIT_BAR(2);
  s16x4 vlo[8],vhi[8]; u32x4 pw0,pw1,pw2,pw3;
  #define PKW(P,B) cvtpk_s(P[B],P[B+1])
  #define PAF(k) __builtin_bit_cast(bf16x8,pw##k)
  #define VFR(i) (bf16x8){vlo[i][0],vlo[i][1],vlo[i][2],vlo[i][3],vhi[i][0],vhi[i][1],vhi[i][2],vhi[i][3]}
  #define PIN(x) asm volatile("":"+v"(x))
  #define MX3(a,b,c) __builtin_fmaxf(__builtin_fmaxf((a),(b)),(c))
  #define GAPA(MF,A0,A1,A2,A3,W0,W1,PW) do{ MF; sacc+=A0; sacc+=A1; sacc+=A2; sacc+=A3; PIN(sacc); W0; W1; PIN(PW); SBAR(); }while(0)
  #define EX(v) __builtin_amdgcn_exp2f(v)
  #define GAPB(MF,X,B) do{ MF; X[B]=EX(X[B]); X[B+1]=EX(X[B+1]); X[B+2]=EX(X[B+2]); X[B+3]=EX(X[B+3]); PIN(X); SBAR(); }while(0)
  #define VRD(i) do{ vlo[i]=vtr(vp_+(((i)>>2)*4096+((i)&3)*1024)); vhi[i]=vtr(vp_+(((i)>>2)*4096+((i)&3)*1024+512)); }while(0)
  #define KRD(G,j) do{ if(G){ kload2(kf,kp0+sl_next,j); SBAR(); } }while(0)
  #define STEP(C0,C1,P0,P1,t,GK,GV,GL) do{ SBAR(); \
    const lds_cptr vp_=vp0+sl_prev; \
    VRD(0); SBAR(); float sacc=(P0[0]+P0[1]); \
    GAPA(C0=__builtin_amdgcn_mfma_f32_32x32x16_bf16(kf[0],qr[0],negm,0,0,0), P0[2],P0[3],P0[4],P0[5],     pw0[0]=PKW(P0,0), pw0[1]=PKW(P0,2), pw0); \
    VRD(4); SBAR(); GAPA(C1=__builtin_amdgcn_mfma_f32_32x32x16_bf16(kf[1],qr[0],negm,0,0,0), P0[6],P0[7],P0[8],P0[9],     pw0[2]=PKW(P0,4), pw0[3]=PKW(P0,6), pw0); \
    VRD(1); SBAR(); GAPA(C0=__builtin_amdgcn_mfma_f32_32x32x16_bf16(kf[2],qr[1],C0,0,0,0),   P0[10],P0[11],P0[12],P0[13], pw1[0]=PKW(P0,8), pw1[1]=PKW(P0,10), pw1); \
    VRD(5); SBAR(); GAPA(C1=__builtin_amdgcn_mfma_f32_32x32x16_bf16(kf[3],qr[1],C1,0,0,0),   P0[14],P0[15],P1[0],P1[1],   pw1[2]=PKW(P0,12),pw1[3]=PKW(P0,14), pw1); \
    VRD(2); SBAR(); GAPA(C0=__builtin_amdgcn_mfma_f32_32x32x16_bf16(kf[4],qr[2],C0,0,0,0),   P1[2],P1[3],P1[4],P1[5],     pw2[0]=PKW(P1,0), pw2[1]=PKW(P1,2), pw2); \
    VRD(6); SBAR(); GAPA(C1=__builtin_amdgcn_mfma_f32_32x32x16_bf16(kf[5],qr[2],C1,0,0,0),   P1[6],P1[7],P1[8],P1[9],     pw2[2]=PKW(P1,4), pw2[3]=PKW(P1,6), pw2); \
    VRD(3); SBAR(); GAPA(C0=__builtin_amdgcn_mfma_f32_32x32x16_bf16(kf[6],qr[3],C0,0,0,0),   P1[10],P1[11],P1[12],P1[13], pw3[0]=PKW(P1,8), pw3[1]=PKW(P1,10), pw3); \
    VRD(7); SBAR(); GAPA(C1=__builtin_amdgcn_mfma_f32_32x32x16_bf16(kf[7],qr[3],C1,0,0,0),   P1[14],P1[15],0.f,0.f,       pw3[2]=PKW(P1,12),pw3[3]=PKW(P1,14), pw3); \
    l_reg+=sacc; \
    if(GK){DMA_K((t)+3,sl_cur);} if(GV){DMA_V((t)+1,sl_next);} \
    CMASK(C0,C1,t); \
    { float a=MX3(C0[0],C0[1],C1[0]),b=MX3(C0[2],C0[3],C1[1]); a=MX3(a,C1[2],C1[3]); \
      _Pragma("unroll") for(int r=4;r<16;r+=4){a=MX3(a,C0[r],C0[r+1]);b=MX3(b,C0[r+2],C0[r+3]);a=MX3(a,C1[r],C1[r+1]);b=MX3(b,C1[r+2],C1[r+3]);} \
      float rm=__builtin_fmaxf(a,b); { auto rr=__builtin_amdgcn_permlane32_swap(__float_as_uint(rm),__float_as_uint(rm),false,false); rm=__builtin_fmaxf(__uint_as_float(rr[0]),__uint_as_float(rr[1])); } \
      resc=false; \
      if(__builtin_expect(__any(rm>(float)THRL),0)){ const float dl=__builtin_fmaxf(rm,0.f); mhat+=dl; \
        _Pragma("unroll") for(int r=0;r<16;++r){C0[r]-=dl;C1[r]-=dl;} \
        _Pragma("unroll") for(int r=0;r<16;++r)negm[r]=-mhat; asm volatile("":"+v"(negm)); \
        const float f=__builtin_amdgcn_exp2f(-dl); l_reg*=f; if(hi==0)wsf[r32]=f; resc=true; } } \
    SBAR(); \
    GAPB(o[0]=__builtin_amdgcn_mfma_f32_32x32x16_bf16(PAF(0),VFR(0),o[0],0,0,0), C0,0); \
    GAPB(o[1]=__builtin_amdgcn_mfma_f32_32x32x16_bf16(PAF(0),VFR(4),o[1],0,0,0), C0,4); \
    KRD(GL,0); GAPB(o[0]=__builtin_amdgcn_mfma_f32_32x32x16_bf16(PAF(1),VFR(1),o[0],0,0,0), C0,8); \
    KRD(GL,1); GAPB(o[1]=__builtin_amdgcn_mfma_f32_32x32x16_bf16(PAF(1),VFR(5),o[1],0,0,0), C0,12); \
    KRD(GL,2); GAPB(o[0]=__builtin_amdgcn_mfma_f32_32x32x16_bf16(PAF(2),VFR(2),o[0],0,0,0), C1,0); \
    KRD(GL,3); GAPB(o[1]=__builtin_amdgcn_mfma_f32_32x32x16_bf16(PAF(2),VFR(6),o[1],0,0,0), C1,4); \
    GAPB(o[0]=__builtin_amdgcn_mfma_f32_32x32x16_bf16(PAF(3),VFR(3),o[0],0,0,0), C1,8); \
    GAPB(o[1]=__builtin_amdgcn_mfma_f32_32x32x16_bf16(PAF(3),VFR(7),o[1],0,0,0), C1,12); \
    }while(0)
  int t=1;
  for(;t+5<NT;t+=2){
    STEP(pB0,pB1,pA0,pA1,t,true,true,true);     WAIT_BAR(2); RESC(); ROT();
    STEP(pA0,pA1,pB0,pB1,t+1,true,true,true);   WAIT_BAR(2); RESC(); ROT();
  }
  #define ENDW(tt) do{ if((tt)+3<NT){WAIT_BAR(2);} else if((tt)+2<NT){WAIT_BAR(1);} else {WAIT_BAR(0);} }while(0)
  for(;t+1<NT;t+=2){
    STEP(pB0,pB1,pA0,pA1,t,(t+3<NT),(t+1<NT),(t+1<NT));       ENDW(t);   RESC(); ROT();
    STEP(pA0,pA1,pB0,pB1,t+1,(t+4<NT),(t+2<NT),(t+2<NT));     ENDW(t+1); RESC(); ROT();
  }
  STEP(pB0,pB1,pA0,pA1,NT-1,false,false,false); RESC();
  { float sacc=pB0[0]+pB0[1]; _Pragma("unroll") for(int r=2;r<16;++r)sacc+=pB0[r]; _Pragma("unroll") for(int r=0;r<16;++r)sacc+=pB1[r]; l_reg+=sacc;
    pw0=(u32x4){PKW(pB0,0),PKW(pB0,2),PKW(pB0,4),PKW(pB0,6)};pw1=(u32x4){PKW(pB0,8),PKW(pB0,10),PKW(pB0,12),PKW(pB0,14)};pw2=(u32x4){PKW(pB1,0),PKW(pB1,2),PKW(pB1,4),PKW(pB1,6)};pw3=(u32x4){PKW(pB1,8),PKW(pB1,10),PKW(pB1,12),PKW(pB1,14)};
    SBAR(); pv(o,vb0+sl_cur,PAF(0),PAF(1),PAF(2),PAF(3)); }
  #undef PKW
  #undef PAF
  #undef VFR
  #undef PIN
  #undef MX3
  #undef GAPA
  #undef GAPB
  #undef EX
  #undef VRD
  #undef KRD
  #undef STEP
  #undef ENDW
  l_reg+=__shfl_xor(l_reg,32);
  l_reg+=__builtin_amdgcn_exp2f(sinkp[hsub]*1.4426950408889634f-mhat);
  if(hi==0)wsf[32+r32]=l_reg;asm volatile("s_waitcnt lgkmcnt(0)":::"memory");
  float rli[16];
  #pragma unroll
  for(int r=0;r<16;++r)rli[r]=__builtin_amdgcn_rcpf(wsf[32+crow(r,hi)]);
  bf16*Ow=Ou+(long)psub*OP+hsub*D;
  { bf16*stg=(bf16*)(shm+LDS_OST)+wid*2048;
    #pragma unroll
    for(int r=0;r<16;++r){const int orow=crow(r,hi);
      #pragma unroll
      for(int d0=0;d0<2;++d0)stg[orow*64+d0*32+r32]=__float2bfloat16(o[d0][r]*rli[r]);}
    asm volatile("s_waitcnt lgkmcnt(0)":::"memory");
    #pragma unroll
    for(int i=0;i<4;++i){const int row=i*8+(lane>>3),ch=lane&7; const u32x4 v=*(const u32x4*)(stg+row*64+ch*8); ATTN_STORE16(Ow+(long)row*OP+ch*8,v);} }
  asm volatile("s_waitcnt lgkmcnt(0)\n\ts_barrier":::"memory");
  #undef DMA_K
  #undef DMA_V
  #undef KP0
  #undef TROW
  #undef CMASK
  #undef START
  #undef RESC
  #undef ROT
}
constexpr int ATTN_LDS_BYTES=LDS_BYTES;
#undef SBAR
#undef WAIT_BAR
}

constexpr int SLAB_PITCH = 288;
typedef short v4i16_t __attribute__((ext_vector_type(4)));
template <int MT, class RowAddr, class Epi>
__device__ __forceinline__ void slab_gemm(LAS unsigned char* lds, const bf16* Cmat, const int K, const RowAddr& RA, const Epi& E) {
    int tid = threadIdx.x; asm volatile("" : "+v"(tid));
    const int wid = tid >> 6, lane = tid & 63;
    LAS bf16* Dr = (LAS bf16*)lds;
    f32x16 acc[MT];
#pragma unroll
    for (int i = 0; i < MT; ++i)
#pragma unroll
        for (int r = 0; r < 16; ++r) acc[i][r] = 0.f;
    const int g = (lane >> 4) & 1, h = lane >> 5, qq = (lane & 15) >> 2, pp = lane & 3;
    const LAS bf16* trp = Dr + (8 * h + qq) * SLAB_PITCH + wid * 32 + 16 * g + 4 * pp;
    for (int kc = 0; kc < K; kc += 128) {
        {
            const int k = tid >> 2, qd = tid & 3;
            const bf16* src = RA(kc + k) + qd * 64;
            v4u v[8];
#pragma unroll
            for (int j = 0; j < 8; ++j) v[j] = *(const v4u*)(src + j * 8);
#pragma unroll
            for (int j = 0; j < 8; ++j) *(LAS v4u*)(Dr + k * SLAB_PITCH + qd * 64 + j * 8) = v[j];
        }
        __syncthreads();
        const int kh = h * 8;
#pragma unroll
        for (int s = 0; s < 8; ++s) {
            const v4i16_t b0 = __builtin_amdgcn_ds_read_tr16_b64_v4i16((LAS v4i16_t*)(trp + (16 * s) * SLAB_PITCH));
            const v4i16_t b1 = __builtin_amdgcn_ds_read_tr16_b64_v4i16((LAS v4i16_t*)(trp + (16 * s + 4) * SLAB_PITCH));
            const bf16x8 bfrag = (bf16x8){b0[0], b0[1], b0[2], b0[3], b1[0], b1[1], b1[2], b1[3]};
#pragma unroll
            for (int mt = 0; mt < MT; ++mt) {
                const bf16x8 afrag = *(const bf16x8*)(Cmat + (size_t)(mt * 32 + (lane & 31)) * K + kc + s * 16 + kh);
                acc[mt] = __builtin_amdgcn_mfma_f32_32x32x16_bf16(afrag, bfrag, acc[mt], 0, 0, 0);
            }
        }
        __syncthreads();
    }
    E(acc, wid, lane, lds);
}

struct Args { const float* in[23]; float* out; unsigned char* ws; int ph_lo, ph_hi; };

constexpr int SOUT_PITCH = 264;
template <int NROWS, bool WT, class RowPtr>
__device__ __forceinline__ void slab_store_rows(LAS unsigned char* lds, const RowPtr& RP) {
    int tid = threadIdx.x; asm volatile("" : "+v"(tid));
    __syncthreads();
#pragma unroll
    for (int k = 0; k < NROWS / 16; ++k) { const int row = (tid >> 5) + 16 * k, chunk = tid & 31;
        const v4u v = *(const LAS v4u*)((LAS bf16*)lds + row * SOUT_PITCH + chunk * 8);
        bf16* dst = RP(row) + chunk * 8;
        if (WT) store16_wt(dst, v); else *(v4u*)dst = v; }
    __syncthreads();
}
struct RowA { const bf16* z; int b, n2; __device__ __forceinline__ const bf16* operator()(int k) const { return z + (size_t)(b * 4096 + 64 * (k & 63) + n2) * 512 + (k >> 6) * 256; } };
struct RowPA { bf16* t2; int b, n2; __device__ __forceinline__ bf16* operator()(int m) const { return t2 + ((size_t)((b * 64 + n2) * 64 + (m & 63)) * 2 + (m >> 6)) * 256; } };
template <bool WT> struct EpiA { bf16* t2; const float2* tw; int b, n2;
    __device__ __forceinline__ void operator()(const f32x16 (&acc)[4], int wid, int lane, LAS unsigned char* lds) const {
        const int ch = wid * 32 + (lane & 31); LAS bf16* so = (LAS bf16*)lds;
#pragma unroll
        for (int mt = 0; mt < 2; ++mt)
#pragma unroll
            for (int r = 0; r < 16; ++r) {
                const int k1 = 32 * mt + (r & 3) + 8 * (r >> 2) + 4 * (lane >> 5);
                const float2 cs = tw[n2 * k1]; const float re = acc[mt][r], im = acc[mt + 2][r];
                const float re2 = cs.x * re + cs.y * im, im2 = cs.x * im - cs.y * re;
                so[k1 * SOUT_PITCH + ch] = (bf16)f2bf(re2); so[(64 + k1) * SOUT_PITCH + ch] = (bf16)f2bf(im2);
            }
        RowPA rp{t2, b, n2}; slab_store_rows<128, WT, RowPA>(lds, rp);
    } };
struct RowB { const bf16* t2; int b, k1; __device__ __forceinline__ const bf16* operator()(int k) const { return t2 + ((size_t)((b * 64 + (k & 63)) * 64 + k1) * 2 + (k >> 6)) * 256; } };
struct RowPB { bf16* mrg; int b, k1; __device__ __forceinline__ bf16* operator()(int k2) const { return mrg + (size_t)(b * 4096 + k1 + 64 * k2) * 1024 + 768; } };
struct EpiB { bf16* mrg; int b, k1;
    __device__ __forceinline__ void operator()(const f32x16 (&acc)[2], int wid, int lane, LAS unsigned char* lds) const {
        const int ch = wid * 32 + (lane & 31); LAS bf16* so = (LAS bf16*)lds;
#pragma unroll
        for (int mt = 0; mt < 2; ++mt)
#pragma unroll
            for (int r = 0; r < 16; ++r) { const int k2 = 32 * mt + (r & 3) + 8 * (r >> 2) + 4 * (lane >> 5); so[k2 * SOUT_PITCH + ch] = (bf16)f2bf(DBG_NO_FOUR ? 0.f : acc[mt][r]); }
        RowPB rp{mrg, b, k1}; slab_store_rows<64, false, RowPB>(lds, rp);
    } };
struct RowC { const bf16* z; int b; __device__ __forceinline__ const bf16* operator()(int k) const { return z + (size_t)(T + b * 256 + (k & 255)) * 512 + (k >> 8) * 256; } };
struct RowPC { bf16* mrg; int b, mt0; __device__ __forceinline__ bf16* operator()(int kk) const { return mrg + (size_t)(T + b * 256 + 32 * mt0 + kk) * 1024 + 768; } };
struct EpiC { bf16* mrg; int b, mt0;
    __device__ __forceinline__ void operator()(const f32x16 (&acc)[1], int wid, int lane, LAS unsigned char* lds) const {
        const int ch = wid * 32 + (lane & 31); LAS bf16* so = (LAS bf16*)lds;
#pragma unroll
        for (int r = 0; r < 16; ++r) { const int kk = (r & 3) + 8 * (r >> 2) + 4 * (lane >> 5); so[kk * SOUT_PITCH + ch] = (bf16)f2bf(DBG_NO_FOUR ? 0.f : acc[0][r]); }
        RowPC rp{mrg, b, mt0}; slab_store_rows<32, false, RowPC>(lds, rp);
    } };

__device__ __forceinline__ void tr_block(const float* src, int ldS, bf16* dst, int ldD, LAS float* scr, int lane) {
#pragma unroll 8
    for (int i = 0; i < 32; ++i) { const int kk = 2 * i + (lane >> 5); scr[kk * 33 + (lane & 31)] = src[(size_t)kk * ldS + (lane & 31)]; }
    LDS_WAIT(); asm volatile("" ::: "memory");
    const int c = lane & 7;
#pragma unroll
    for (int j = 0; j < 4; ++j) { const int n = (lane >> 3) + 8 * j; const LAS float* s = scr + (8 * c) * 33 + n;
        v4u o; o.x = pk2(s[0 * 33], s[1 * 33]); o.y = pk2(s[2 * 33], s[3 * 33]); o.z = pk2(s[4 * 33], s[5 * 33]); o.w = pk2(s[6 * 33], s[7 * 33]);
        *(GAS v4u*)(dst + (size_t)n * ldD + 8 * c) = o; }
    LDS_WAIT(); asm volatile("" ::: "memory");
}


__device__ __forceinline__ void tr_block64(const float* src, int ldS, bf16* dst, int ldD, LAS bf16* scr, int lane) {
    const int kr = lane >> 4, nc = lane & 15;
    f32x4 v[16];
#pragma unroll
    for (int i = 0; i < 16; ++i) v[i] = *(const f32x4*)(src + (size_t)(4 * i + kr) * ldS + 4 * nc);
#pragma unroll
    for (int i = 0; i < 16; ++i) { const int k = 4 * i + kr;
#pragma unroll
        for (int j = 0; j < 4; ++j) scr[(4 * nc + j) * 66 + k] = (bf16)f2bf(v[i][j]); }
    LDS_WAIT(); asm volatile("" ::: "memory");
    const int c = lane & 7;
#pragma unroll
    for (int j = 0; j < 8; ++j) { const int n = (lane >> 3) + 8 * j; const LAS unsigned* p = (const LAS unsigned*)(scr + n * 66 + 8 * c);
        v4u o; o.x = p[0]; o.y = p[1]; o.z = p[2]; o.w = p[3];
        *(GAS v4u*)(dst + (size_t)n * ldD + 8 * c) = o; }
    LDS_WAIT(); asm volatile("" ::: "memory");
}

__device__ __forceinline__ void tr_block64_f8(const float* src, int ldS, unsigned char* dst, int ldD, LAS unsigned char* scr, int lane, float sc) {
    const int nq = lane & 15, kq0 = lane >> 4;
    f32x4 v[4][4];
#pragma unroll
    for (int sb = 0; sb < 4; ++sb)
#pragma unroll
        for (int r = 0; r < 4; ++r) v[sb][r] = *(const f32x4*)(src + (size_t)(4 * (kq0 + 4 * sb) + r) * ldS + 4 * nq);
#pragma unroll
    for (int sb = 0; sb < 4; ++sb)
#pragma unroll
        for (int j = 0; j < 4; ++j) *(LAS unsigned*)(scr + (4 * nq + j) * 68 + 4 * (kq0 + 4 * sb)) = pk4_f8(v[sb][0][j] * sc, v[sb][1][j] * sc, v[sb][2][j] * sc, v[sb][3][j] * sc);
    LDS_WAIT(); asm volatile("" ::: "memory");
    const int c = lane & 3;
#pragma unroll
    for (int jj = 0; jj < 4; ++jj) { const int n = (lane >> 2) + 16 * jj; const LAS unsigned* p = (const LAS unsigned*)(scr + n * 68 + 16 * c);
        v4u o; o.x = p[0]; o.y = p[1]; o.z = p[2]; o.w = p[3];
        *(GAS v4u*)(dst + (size_t)n * ldD + 16 * c) = o; }
    LDS_WAIT(); asm volatile("" ::: "memory");
}

template <int HW> __device__ __forceinline__ void pool_item(const bf16* up, bf16* op, const int n0, const int nseq) {
    constexpr int NR = 2 * HW + 7;
    v4u w[NR];
#pragma unroll
    for (int j = 0; j < NR; ++j) { const int t = n0 - HW + j; const int tc = t < 0 ? 0 : (t > nseq - 1 ? nseq - 1 : t); w[j] = *(const v4u*)(up + (size_t)tc * 256); }
#pragma unroll
    for (int j = 0; j < NR; ++j) { const int t = n0 - HW + j; if (t < 0 || t >= nseq) w[j] = (v4u){0u, 0u, 0u, 0u}; }
    float sm[8] = {0.f, 0.f, 0.f, 0.f, 0.f, 0.f, 0.f, 0.f};
#define POOL_ACC(W, SGN) do { sm[0] += SGN bflo(W.x); sm[1] += SGN bfhi(W.x); sm[2] += SGN bflo(W.y); sm[3] += SGN bfhi(W.y); sm[4] += SGN bflo(W.z); sm[5] += SGN bfhi(W.z); sm[6] += SGN bflo(W.w); sm[7] += SGN bfhi(W.w); } while (0)
#pragma unroll
    for (int j = 0; j < 2 * HW; ++j) POOL_ACC(w[j], +);
#pragma unroll
    for (int k = 0; k < 8; ++k) {
        const int n = n0 + k; int lo_ = n - HW; lo_ = lo_ < 0 ? 0 : lo_; int hi_ = n + HW - 1; hi_ = hi_ > nseq - 1 ? nseq - 1 : hi_;
        const v4u c = w[HW + k]; const float ic = 1.0f / (float)(hi_ - lo_ + 1);
        v4u o; o.x = pk2(sm[0] * ic - bflo(c.x), sm[1] * ic - bfhi(c.x)); o.y = pk2(sm[2] * ic - bflo(c.y), sm[3] * ic - bfhi(c.y));
        o.z = pk2(sm[4] * ic - bflo(c.z), sm[5] * ic - bfhi(c.z)); o.w = pk2(sm[6] * ic - bflo(c.w), sm[7] * ic - bfhi(c.w));
        if (DBG_NO_POOL) o = (v4u){0u, 0u, 0u, 0u};
        *(v4u*)(op + (size_t)k * 1024) = o;
        if (k < 7) { POOL_ACC(w[k + 2 * HW], +); POOL_ACC(w[k], -); }
    }
#undef POOL_ACC
}

typedef const __attribute__((address_space(4))) Args* kargs_t;
__device__ __forceinline__ kargs_t ka_launder() { kargs_t p = (kargs_t)__builtin_amdgcn_kernarg_segment_ptr(); asm volatile("" : "+s"(p)); return p; }
__device__ __forceinline__ int tid_launder() { int t = threadIdx.x; asm volatile("" : "+v"(t)); return t; }
#define KA_DECL const kargs_t KA = ka_launder(); const int tid = tid_launder(); const int lane = tid & 63; const int wave = __builtin_amdgcn_readfirstlane(tid >> 6); const int gw = vcu * 8 + wave; const int gt = vcu * 512 + tid; (void)lane; (void)wave; (void)gw; (void)gt;
#define ws (KA->ws)
#define ctl ((gu32*)(ws + O_CTL))
#define x_in (KA->in[0])
#define c_in (KA->in[1])
#define ctx_in (KA->in[2])
#define cctx_in (KA->in[3])
#define w_mod (KA->in[4])
#define b_mod (KA->in[5])
#define norm1_g (KA->in[6])
#define w_in (KA->in[7])
#define q_norm_g (KA->in[8])
#define k_norm_g (KA->in[9])
#define attn_sink (KA->in[10])
#define pool_w (KA->in[11])
#define pool_scale (KA->in[12])
#define four_w (KA->in[13])
#define w_out (KA->in[14])
#define norm2_g (KA->in[15])
#define w_grp (KA->in[16])
#define b_grp (KA->in[17])
#define w_rtr (KA->in[18])
#define b_rtr (KA->in[19])
#define w_gate (KA->in[20])
#define w_up (KA->in[21])
#define w_down (KA->in[22])
#define outp (KA->out)
#define modv ((float*)(ws + O_MOD))
#define rope ((float2*)(ws + O_ROPE))
#define twt ((float2*)(ws + O_TW))
#define fma ((bf16*)(ws + O_FMA))
#define fmb ((bf16*)(ws + O_FMB))
#define fmc ((bf16*)(ws + O_FMC))
#define hbuf ((bf16*)(ws + O_H))
#define kall ((bf16*)(ws + O_KALL))
#define vall ((bf16*)(ws + O_VALL))
#define xc ((float*)(ws + O_XC))
#define xb ((bf16*)(ws + O_XB))
#define list ((unsigned*)(ws + O_LIST))
#define wts ((float*)(ws + O_WTS))
#define act ((bf16*)(ws + O_ACT))
#define t2 ((bf16*)(ws + O_T2))
#define mrg ((bf16*)(ws + O_MRG))
#define qb ((bf16*)(ws + O_Q))
#define pu ((bf16*)(ws + O_PU))
#define zb ((bf16*)(ws + O_Z))
#define y2 ((bf16*)(ws + O_Y2))

#ifndef PH_MASK
#define PH_MASK 0x3ffff
#endif
#define IN(k) (lo <= (k) && (k) < hi && ((PH_MASK >> (k)) & 1))
#define SEAM(k) do { if (IN(k) && IN((k) + 1)) xcd_barrier(bar); } while (0)
#define modl (modv + (size_t)l * 5 * 6144)
#define win_t ((bf16*)(ws + O_WIN + l * SZ_WIN1))
#define wout_t ((bf16*)(ws + O_WOUT + l * SZ_WOUT1))
#define wgu_t ((bf16*)(ws + O_WGU + l * SZ_WGU1))
#define wd_t ((bf16*)(ws + O_WD + l * SZ_WD1))
constexpr int CV_A = 256, CV_B = 192, CV_C = 4096, CV_D = 2048, CV_L = CV_A + CV_B + CV_C + CV_D;
__device__ __forceinline__ void conv_item(const kargs_t KA, const int lw, int it, LAS bf16* scr, const int lane) {
    bf16* p_win_t = (bf16*)(ws + O_WIN + lw * SZ_WIN1); bf16* p_wout_t = (bf16*)(ws + O_WOUT + lw * SZ_WOUT1);
    bf16* p_wgu_t = (bf16*)(ws + O_WGU + lw * SZ_WGU1); bf16* p_wd_t = (bf16*)(ws + O_WD + lw * SZ_WD1);
    if (it < CV_A) { const int kb = it >> 4, nb = it & 15; const float* src = w_in + (size_t)lw * 1024 * 1280 + (size_t)kb * 64 * 1280 + nb * 64;
        if (nb < 4) tr_block64(src, 1280, p_win_t + (size_t)nb * 64 * 1024 + kb * 64, 1024, scr, lane);
        else tr_block64_f8(src, 1280, (unsigned char*)(ws + O_WIN8 + lw * SZ_WIN8) + (size_t)(nb * 64 - 256) * 1024 + kb * 64, 1024, (LAS unsigned char*)scr, lane, 64.0f);
        return; } it -= CV_A;
    if (it < CV_B) { const int kb = 4 + (it >> 4), nb = it & 15; tr_block64(w_out + (size_t)lw * 1024 * 1024 + (size_t)kb * 64 * 1024 + nb * 64, 1024, p_wout_t + (size_t)nb * 64 * 1024 + kb * 64, 1024, scr, lane); return; } it -= CV_B;
    if (it < CV_C) { const int up = it >> 11, r = it & 2047, e = r >> 7, kb = (r >> 3) & 15, nb = r & 7; const int n0 = nb * 64;
        const float* src = (up ? w_up : w_gate) + ((size_t)(lw * 16 + e) * 1024 + kb * 64) * 512 + n0;
        const int drow = (n0 >> 7) * 256 + up * 128 + (n0 & 127);
        tr_block64_f8(src, 512, (unsigned char*)p_wgu_t + ((size_t)e * 1024 + drow) * 1024 + kb * 64, 1024, (LAS unsigned char*)scr, lane, 64.0f); return; } it -= CV_C;
    { const int e = it >> 7, kb = (it >> 4) & 7, nb = it & 15;
        tr_block64_f8(w_down + ((size_t)(lw * 16 + e) * 512 + kb * 64) * 1024 + nb * 64, 1024, (unsigned char*)p_wd_t + ((size_t)e * 1024 + nb * 64) * 512 + kb * 64, 512, (LAS unsigned char*)scr, lane, 64.0f); }
}
__device__ __forceinline__ void steal_convert(const kargs_t KA, LAS unsigned char* lds, const int G, const int done_idx, const bool drain) {
    int tid = threadIdx.x; asm volatile("" : "+v"(tid));
    const int lane = tid & 63, wave = __builtin_amdgcn_readfirstlane(tid >> 6);
    volatile LAS int* mb = (volatile LAS int*)(lds + MISC_OFF + 64);
    LAS bf16* scr = (LAS bf16*)(lds + wave * 16384);
    __syncthreads();
    if (tid == 0 && !drain) __hip_atomic_fetch_add((unsigned*)(ctl + CW_DONE + 64 * done_idx), 1u, RLX_AGENT);
    for (;;) {
        if (tid == 0) { int idx = -1;
            const bool stop = !drain && __hip_atomic_load((unsigned*)(ctl + CW_DONE + 64 * done_idx), RLX_AGENT) >= (unsigned)(G - G / 4);
            if (!stop) idx = (int)__hip_atomic_fetch_add((unsigned*)(ctl + CW_Q), 8u, RLX_AGENT);
            mb[0] = idx; }
        __syncthreads();
        const int idx = mb[0];
        __syncthreads();
        if (idx < 0 || idx >= CV_L) break;
        if (idx + wave < CV_L) conv_item(KA, 1, idx + wave, scr, lane);
    }
    __syncthreads();
}

template <int l> __device__ __forceinline__ void layer_body(LAS unsigned char* lds, const int G, const int vcu, const XcdBarrier& bar, const int lo, const int hi) {
    const int NGW = G * 8, NGT = G * 512; LAS int* ttab = (LAS int*)(lds + TILE_OFF);
    constexpr int P = 1 + 8 * l;

        for (int rep_ = 0; rep_ < 1 + ((l == 0) ? ((REP_MASK >> (1 + 0)) & 1) : 0); ++rep_)
        if (IN(P + 0)) {
            KA_DECL
            const float* modp = modv;
            if (l == 1) steal_convert(KA, lds, G, 3, true);
#pragma clang loop vectorize(disable) unroll(disable)
            for (int r0 = gw; r0 < TT; r0 += 2 * NGW) {
                const int r1 = r0 + NGW; const bool has1 = r1 < TT;
                f32x4 va[4], vb[4]; unsigned yaa[4], yab[4], yba[4], ybb[4];
                if (l == 0) {
                    const float* srca; const float* srcb;
                    { const bool isc = r0 >= T; srca = isc ? ctx_in + (size_t)(r0 - T) * 1024 : x_in + (size_t)r0 * 1024; }
                    { const int rr = has1 ? r1 : r0; const bool isc = rr >= T; srcb = isc ? ctx_in + (size_t)(rr - T) * 1024 : x_in + (size_t)rr * 1024; }
#pragma unroll
                    for (int j = 0; j < 4; ++j) { va[j] = *(const f32x4*)(srca + 4 * lane + 256 * j); vb[j] = *(const f32x4*)(srcb + 4 * lane + 256 * j); }
                } else {
                    const int rr = has1 ? r1 : r0;
#pragma unroll
                    for (int j = 0; j < 4; ++j) { const v2u wa = *(const v2u*)(xb + (size_t)r0 * 1024 + 4 * lane + 256 * j), wb = *(const v2u*)(xb + (size_t)rr * 1024 + 4 * lane + 256 * j);
                        va[j] = (f32x4){bflo(wa.x), bfhi(wa.x), bflo(wa.y), bfhi(wa.y)}; vb[j] = (f32x4){bflo(wb.x), bfhi(wb.x), bflo(wb.y), bfhi(wb.y)}; }
                }
                if (l == 1) {
                    const int rr = has1 ? r1 : r0;
#pragma unroll
                    for (int j = 0; j < 4; ++j) { const unsigned char* yq = (const unsigned char*)y2 + 4 * lane + 256 * j;
                        yaa[j] = *(const unsigned*)(yq + (size_t)(2 * r0) * 1024); yab[j] = *(const unsigned*)(yq + (size_t)(2 * r0 + 1) * 1024);
                        yba[j] = *(const unsigned*)(yq + (size_t)(2 * rr) * 1024); ybb[j] = *(const unsigned*)(yq + (size_t)(2 * rr + 1) * 1024); }
                }
#pragma unroll
                for (int half = 0; half < 2; ++half) {
                    if (half == 1 && !has1) break;
                    const int r = half ? r1 : r0; f32x4 (&v)[4] = half ? vb : va; unsigned (&ya)[4] = half ? yba : yaa; unsigned (&yb)[4] = half ? ybb : yab;
                    const bool isc = r >= T; const int bsel = isc ? 4 : (r >> 12);
                    if (l == 1) {
                        const float* g2 = modp + bsel * 6144 + 5 * 1024; bf16* dst = xb + (size_t)r * 1024;
#pragma unroll
                        for (int j = 0; j < 4; ++j) {
                            const f32x4 gv = *(const f32x4*)(g2 + 4 * lane + 256 * j);
                            f32x4 yy = (f8x4_f32(ya[j]) + f8x4_f32(yb[j])) * (1.0f / Y2SC);
                            if (DBG_NO_MOE) yy = (f32x4){0.f, 0.f, 0.f, 0.f};
                            v[j] = v[j] + gv * yy; { v2u o; o.x = pk2(v[j][0], v[j][1]); o.y = pk2(v[j][2], v[j][3]); *(v2u*)(dst + 4 * lane + 256 * j) = o; }
                        }
                    }
                    float ss = 0.f;
#pragma unroll
                    for (int j = 0; j < 4; ++j) ss += (v[j][0] * v[j][0] + v[j][1] * v[j][1]) + (v[j][2] * v[j][2] + v[j][3] * v[j][3]);
                    const float rstd = 1.0f / sqrtf(wave_sum(ss) * (1.f / 1024.f) + 1e-6f);
                    const float* sh = modl + bsel * 6144; const float* sc = sh + 1024; const float* gn = norm1_g + l * 1024;
#pragma unroll
                    for (int j = 0; j < 4; ++j) {
                        const int c0 = 4 * lane + 256 * j; const f32x4 g = *(const f32x4*)(gn + c0), s1 = *(const f32x4*)(sc + c0), h1 = *(const f32x4*)(sh + c0);
                        const f32x4 y = (v[j] * rstd) * g * (s1 + 1.0f) + h1;
                        v2u o; o.x = pk2(y[0], y[1]); o.y = pk2(y[2], y[3]); *(v2u*)(hbuf + (size_t)r * 1024 + c0) = o;
                        *(unsigned*)((unsigned char*)(ws + O_ACT) + (size_t)r * 1024 + c0) = pk4_f8(y[0], y[1], y[2], y[3]);
                    }
                }
            }
        }
        SEAM(P + 0);
        for (int rep_ = 0; rep_ < 1 + ((l == 0) ? ((REP_MASK >> (1 + 1)) & 1) : 0); ++rep_)
        if (IN(P + 1)) {
            KA_DECL
            EpiG1 E{pu, qb, kall, vall, zb};
            { SchedG1 S{G, vcu, 0, l, (const char*)hbuf, (const char*)win_t}; pg8::gemm_phase<EpiG1, SchedG1, false>(lds, S, E); }
            { SchedG1 S{G, vcu, 1, l, (const char*)(ws + O_ACT), (const char*)(ws + O_WIN8 + l * SZ_WIN8)}; pg8::gemm_phase<EpiG1, SchedG1, true>(lds, S, E); }
            if (l == 0 && !MK_SPLIT) steal_convert(KA, lds, G, 0, false);
        }
        SEAM(P + 1);
        if (IN(P + 3)) {
            KA_DECL
            gu32* kflag = ctl + CW_KF + l * 16384;
            gu32* facnt = ctl + CW_FA + l * 64;
            for (int it = vcu; it < 256; it += G) {
                const int b = it >> 6, n2 = it & 63;
                RowA ra{zb, b, n2}; EpiA<true> ea{t2, twt, b, n2};
                slab_gemm<4, RowA, EpiA<true>>(lds, fma, 128, ra, ea);
                asm volatile("s_waitcnt vmcnt(0)" ::: "memory");
                __syncthreads();
                if (tid == 0) __hip_atomic_fetch_add((unsigned*)(facnt + 16 * b), 1u, RLX_AGENT);
            }
            const int n_att = 512 + (l == 0 ? 32 : 0);
            for (int it = vcu; it < n_att; it += G) {
                const bool cu = it >= 512; const int uidx = cu ? it - 512 : it;
                const int b = cu ? (uidx >> 3) : (uidx >> 7), kvh = cu ? ((uidx >> 2) & 1) : ((uidx >> 6) & 1), pb = cu ? (uidx & 3) : (uidx & 63);
                const int p0 = pb * 64; const int qrow0 = cu ? T + b * 256 + p0 : b * 4096 + p0;
                if (!cu) {
                    const int row = tid >> 3, c = tid & 7;
                    const float* kg = k_norm_g + l * 64 + 8 * c;
#pragma unroll
                    for (int part = 0; part < 2; ++part) {
                        if (part == 1 && pb >= 4) break;
                        const int blk = part ? pb : 4 + pb;
                        bf16* p = kall + ((size_t)b * KVROWS + blk * 64 + row) * 128 + kvh * 64 + c * 8;
                        const v4u w = *(const v4u*)p;
                        float x[8] = {bflo(w.x), bfhi(w.x), bflo(w.y), bfhi(w.y), bflo(w.z), bfhi(w.z), bflo(w.w), bfhi(w.w)};
                        float ss = 0.f;
#pragma unroll
                        for (int i = 0; i < 8; ++i) ss += x[i] * x[i];
                        ss += __shfl_xor(ss, 1); ss += __shfl_xor(ss, 2); ss += __shfl_xor(ss, 4);
                        const float rstd = 1.0f / sqrtf(ss * (1.f / 64.f) + 1e-6f);
#pragma unroll
                        for (int i = 0; i < 8; ++i) x[i] *= rstd * kg[i];
                        if (part == 0) {
                            const float2* rp = rope + (size_t)(p0 + row) * 32 + ((c & 4) ? 16 : 0) + (c & 1) * 8;
#pragma unroll
                            for (int i = 0; i < 8; ++i) { const float y = __shfl_xor(x[i], 2); const float2 cs = rp[i]; x[i] = (c & 2) ? (x[i] * cs.x + y * cs.y) : (x[i] * cs.x - y * cs.y); }
                        }
                        v4u o; o.x = pk2(x[0], x[1]); o.y = pk2(x[2], x[3]); o.z = pk2(x[4], x[5]); o.w = pk2(x[6], x[7]);
                        store16_wt(p, o);
                    }
                    asm volatile("s_waitcnt vmcnt(0)" ::: "memory");
                    __syncthreads();
                    if (tid == 0) { __hip_atomic_store(kflag + 16 * ((b * 68 + 4 + pb) * 2 + kvh), 1u, RLX_AGENT); if (pb < 4) __hip_atomic_store(kflag + 16 * ((b * 68 + pb) * 2 + kvh), 1u, RLX_AGENT); }
                }
                if (tid < 64) {
                    int blk = -1;
                    if (lane < 4) blk = lane; else if (!cu && lane < 9) { const int q = pb + lane - 6; if (q >= 0 && q < 64) blk = 4 + q; }
                    unsigned sp = 0;
                    for (;;) { const unsigned f = (blk >= 0) ? __hip_atomic_load(kflag + 16 * ((b * 68 + blk) * 2 + kvh), RLX_AGENT) : 1u;
                        if (__all(f != 0u)) break; __builtin_amdgcn_s_sleep(2);
                        if (++sp > (1u << 22)) { if (tid == 0) __hip_atomic_store(ctl + CW_TMO, 2u, RLX_AGENT); break; } }
                    __builtin_amdgcn_fence(__ATOMIC_ACQUIRE, "agent");
                    asm volatile("s_waitcnt vmcnt(0)" ::: "memory");
                }
                __syncthreads();
                const attn_body::bf16* Qu = (const attn_body::bf16*)(qb + (size_t)qrow0 * 512 + kvh * 256);
                const attn_body::bf16* Kh = (const attn_body::bf16*)(kall + (size_t)b * KVROWS * 128 + kvh * 64);
                const attn_body::bf16* Vh = (const attn_body::bf16*)(vall + (size_t)b * KVROWS * 128 + kvh * 64);
                attn_body::bf16* Ou = (attn_body::bf16*)(mrg + (size_t)qrow0 * 1024 + 256 + kvh * 256);
                attn_body::attn_unit<8>(Qu, Kh, Vh, Ou, p0, cu ? 4 : 10, attn_sink + l * 8 + kvh * 4, q_norm_g + l * 64, cu ? (const float2*)nullptr : (const float2*)rope, (char*)lds);
                __syncthreads();
            }
            const int prow = (l == 0) ? TT : T; const int nrb = prow >> 3;
#pragma clang loop vectorize(disable) unroll(disable)
            for (int i = gt; i < 32 * nrb; i += NGT) {
                const int ck8 = i & 7, rb = (i >> 3) % nrb, g = (i >> 3) / nrb;
                const int r0 = rb * 8; const bool isc = r0 >= T;
                const int nseq = isc ? LCTX : NSEQ; const int rbase = isc ? T + ((r0 - T) & ~255) : (r0 & ~4095); const int n0 = r0 - rbase;
                const int col = g * 64 + ck8 * 8;
                const bf16* up = pu + (size_t)rbase * 256 + col; bf16* op = mrg + (size_t)(rbase + n0) * 1024 + col;
                if (g == 0) pool_item<1>(up, op, n0, nseq); else if (g == 1) pool_item<2>(up, op, n0, nseq); else if (g == 2) pool_item<4>(up, op, n0, nseq); else pool_item<8>(up, op, n0, nseq);
            }
            for (int it = vcu; it < 256; it += G) {
                const int b = it >> 6, k1 = it & 63;
                __syncthreads();
                if (tid < 64) { unsigned sp = 0;
                    while ((unsigned)__builtin_amdgcn_readfirstlane(__hip_atomic_load((unsigned*)(facnt + 16 * b), RLX_AGENT)) < 64u) { __builtin_amdgcn_s_sleep(2); if (++sp > (1u << 22)) { if (tid == 0) __hip_atomic_store(ctl + CW_TMO, 3u, RLX_AGENT); break; } }
                    __builtin_amdgcn_fence(__ATOMIC_ACQUIRE, "agent");
                    asm volatile("s_waitcnt vmcnt(0)" ::: "memory"); }
                __syncthreads();
                RowB rb{t2, b, k1}; EpiB eb{mrg, b, k1};
                slab_gemm<2, RowB, EpiB>(lds, fmb, 128, rb, eb);
            }
            if (l == 0) for (int it = (G - 1 - vcu); it < 32; it += G) {
                const int b = it >> 3, mt0 = it & 7;
                RowC rc{zb, b}; EpiC ec{mrg, b, mt0};
                slab_gemm<1, RowC, EpiC>(lds, fmc + (size_t)mt0 * 32 * 512, 512, rc, ec);
            }
        }
        SEAM(P + 3);
        if (IN(P + 4)) {
            KA_DECL
            unsigned* g2rdy = (unsigned*)(ctl + CW_G2 + l * 2048);
            {
                SchedPlain S{(l == 0 ? TT : T) / 256, 4, G, vcu, 1024, (const char*)mrg, (const char*)wout_t};
                EpiG2<(l != 0)> E{x_in, ctx_in, xb, modl, g2rdy};
                pg8::gemm_phase<EpiG2<(l != 0)>, SchedPlain>(lds, S, E);
            }
            const int rep_ = 0;
            __syncthreads();
            LAS float* rw = (LAS float*)lds;
            LAS int* lcnt = (LAS int*)(lds + 81920);
            LAS unsigned* lent = (LAS unsigned*)(lds + 81920 + 256);
            LAS unsigned* lrank = lent + 1024;
            { const float* rwg = (const float*)(ws + O_RW) + l * 20480;
#pragma unroll
              for (int i = 0; i < 10; ++i) { const int idx = tid + 512 * i; *(LAS f32x4*)(rw + 4 * idx) = *(const f32x4*)(rwg + 4 * idx); } }
            if (tid < 33) lcnt[tid] = 0;
            if (tid < 64) { unsigned sp = 0; unsigned* w = g2rdy + 16 * (vcu >> 2);
                while ((unsigned)__builtin_amdgcn_readfirstlane(__hip_atomic_load(w, RLX_AGENT)) < 32u) { __builtin_amdgcn_s_sleep(2); if (++sp > (1u << 22)) { if (tid == 0) __hip_atomic_store(ctl + CW_TMO, 4u, RLX_AGENT); break; } }
                __builtin_amdgcn_fence(__ATOMIC_ACQUIRE, "agent");
                asm volatile("s_waitcnt vmcnt(0)" ::: "memory"); }
            __syncthreads();
            const bool dbl = (l == 0) && (G == 256) && (vcu < 16);
            const int ngl = 16 + ((l == 0) ? 1 : 0) + (((l == 0) && (G == 256)) ? 2 : 0);
#pragma clang loop vectorize(disable) unroll(disable)
            for (int gix = wave; gix < ngl; gix += 8) {
                int q;
                if (gix < 16) { if (dbl) continue; q = 16 * vcu + gix; }
                else if (gix == 16) q = T / 4 + vcu;
                else { if (dbl) continue; const int o = (gix == 17) ? (vcu - 16) : (240 + vcu - 16); if (o >= 256 || (gix == 18 && vcu >= 32)) continue; q = o; }
                if (gix >= 17) {
                    unsigned sp = 0; unsigned* w = g2rdy + 16 * (q >> 6);
                    while ((unsigned)__builtin_amdgcn_readfirstlane(__hip_atomic_load(w, RLX_AGENT)) < 32u) { __builtin_amdgcn_s_sleep(2); if (++sp > (1u << 22)) { if (lane == 0) __hip_atomic_store(ctl + CW_TMO, 6u, RLX_AGENT); break; } }
                    __builtin_amdgcn_fence(__ATOMIC_ACQUIRE, "agent");
                    asm volatile("s_waitcnt vmcnt(0)" ::: "memory"); }
                if (gix == 16) { unsigned sp = 0; unsigned* w = g2rdy + 16 * (64 + (vcu >> 6));
                    while ((unsigned)__builtin_amdgcn_readfirstlane(__hip_atomic_load(w, RLX_AGENT)) < 32u) { __builtin_amdgcn_s_sleep(2); if (++sp > (1u << 22)) { if (lane == 0) __hip_atomic_store(ctl + CW_TMO, 5u, RLX_AGENT); break; } }
                    __builtin_amdgcn_fence(__ATOMIC_ACQUIRE, "agent");
                    asm volatile("s_waitcnt vmcnt(0)" ::: "memory"); }
                const int rb4 = 4 * q; const bool isc = rb4 >= T; const int bsel = isc ? 4 : (rb4 >> 12);
                const bf16* src = xb + (size_t)rb4 * 1024;
                f32x4 v[4][4];
#pragma unroll
                for (int tk = 0; tk < 4; ++tk)
#pragma unroll
                    for (int j = 0; j < 4; ++j) { const v2u w = *(const v2u*)(src + (size_t)tk * 1024 + 4 * lane + 256 * j); v[tk][j] = (f32x4){bflo(w.x), bfhi(w.x), bflo(w.y), bfhi(w.y)}; }
                float rstd[4];
#pragma unroll
                for (int tk = 0; tk < 4; ++tk) { float ss = 0.f;
#pragma unroll
                    for (int j = 0; j < 4; ++j) ss += (v[tk][j][0] * v[tk][j][0] + v[tk][j][1] * v[tk][j][1]) + (v[tk][j][2] * v[tk][j][2] + v[tk][j][3] * v[tk][j][3]);
                    rstd[tk] = 1.0f / sqrtf(wave_sum(ss) * (1.f / 1024.f) + 1e-6f); }
                const float* sh = modl + bsel * 6144 + 3 * 1024; const float* sc = sh + 1024; const float* gn = norm2_g + l * 1024;
                f32x2 lg[4][10];
#pragma unroll
                for (int tk = 0; tk < 4; ++tk)
#pragma unroll
                    for (int j = 0; j < 10; ++j) lg[tk][j] = (f32x2){0.f, 0.f};
#pragma unroll
                for (int j = 0; j < 4; ++j) {
                    const int c0 = 4 * lane + 256 * j; const f32x4 g = *(const f32x4*)(gn + c0), s1 = *(const f32x4*)(sc + c0), h1 = *(const f32x4*)(sh + c0);
                    f32x4 y[4];
#pragma unroll
                    for (int tk = 0; tk < 4; ++tk) { y[tk] = (v[tk][j] * rstd[tk]) * g * (s1 + 1.0f) + h1;
                        *(unsigned*)((unsigned char*)hbuf + (size_t)(rb4 + tk) * 1024 + c0) = pk4_f8(y[tk][0], y[tk][1], y[tk][2], y[tk][3]); }
#pragma unroll
                    for (int e = 0; e < 4; ++e) {
#pragma unroll
                        for (int q5 = 0; q5 < 5; ++q5) { const f32x4 wv = *(const LAS f32x4*)(rw + (((q5 * 4 + j) * 4 + e) * 64 + lane) * 4);
                            const f32x2 w01 = {wv[0], wv[1]}, w23 = {wv[2], wv[3]};
#pragma unroll
                            for (int tk = 0; tk < 4; ++tk) { const f32x2 ys = {y[tk][e], y[tk][e]}; lg[tk][2 * q5] = __builtin_elementwise_fma(ys, w01, lg[tk][2 * q5]); lg[tk][2 * q5 + 1] = __builtin_elementwise_fma(ys, w23, lg[tk][2 * q5 + 1]); } }
                        __builtin_amdgcn_sched_barrier(0); }
                }
                float l2[20];
#pragma unroll
                for (int j = 0; j < 20; ++j) {
                    const float a0 = swap32_sum(lg[0][j >> 1][j & 1], lg[2][j >> 1][j & 1]);
                    const float a1 = swap32_sum(lg[1][j >> 1][j & 1], lg[3][j >> 1][j & 1]);
                    float t = swap16_sum(a0, a1);
                    t += dppf<0x128, 0xf>(t); t += dppf<0x124, 0xf>(t); t += dppf<0x122, 0xf>(t); t += dppf<0x121, 0xf>(t);
                    l2[j] = t;
                }
                const int tk = lane >> 4; const int r = rb4 + tk;
                float gl[4]; float gm = -1e30f;
#pragma unroll
                for (int j = 0; j < 4; ++j) { gl[j] = l2[j] + b_grp[l * 4 + j]; gm = fmaxf(gm, gl[j]); }
                float gs = 0.f; int gi = 0; float gb = -1e30f;
#pragma unroll
                for (int j = 0; j < 4; ++j) { const float e = expf(gl[j] - gm); gs += e; if (gl[j] > gb) { gb = gl[j]; gi = j; } }
                const float pg = expf(gb - gm) / gs;
                float el[4]; float em = -1e30f;
#pragma unroll
                for (int j = 0; j < 4; ++j) { float t_ = 0.f;
#pragma unroll
                    for (int g4 = 0; g4 < 4; ++g4) t_ = (gi == g4) ? (l2[4 + g4 * 4 + j] + b_rtr[l * 16 + g4 * 4 + j]) : t_;
                    el[j] = t_; em = fmaxf(em, t_); }
                float pe[4];
#pragma unroll
                for (int j = 0; j < 4; ++j) pe[j] = expf(el[j] - em);
                int i0 = 0; float b0 = -1.f;
#pragma unroll
                for (int j = 0; j < 4; ++j) if (pe[j] > b0) { b0 = pe[j]; i0 = j; }
                int i1 = 0; float b1 = -1.f;
#pragma unroll
                for (int j = 0; j < 4; ++j) if (j != i0 && pe[j] > b1) { b1 = pe[j]; i1 = j; }
                const float wsum = b0 + b1; const float w0 = pg * b0 / wsum, w1 = pg * b1 / wsum;
                if ((lane & 15) == 0 && rep_ == 0) {
                    wts[2 * r] = w0; wts[2 * r + 1] = w1;
                    const int e0 = gi * 4 + i0, e1 = gi * 4 + i1;
                    const int s0 = __hip_atomic_fetch_add((LAS int*)(lcnt + 16 + 16), 1, __ATOMIC_RELAXED, __HIP_MEMORY_SCOPE_WORKGROUP);
                    const int k0 = __hip_atomic_fetch_add((LAS int*)(lcnt + e0), 1, __ATOMIC_RELAXED, __HIP_MEMORY_SCOPE_WORKGROUP);
                    const int k1 = __hip_atomic_fetch_add((LAS int*)(lcnt + e1), 1, __ATOMIC_RELAXED, __HIP_MEMORY_SCOPE_WORKGROUP);
                    lent[2 * s0] = ((unsigned)(2 * r) << 4) | (unsigned)e0; lrank[2 * s0] = (unsigned)k0;
                    lent[2 * s0 + 1] = ((unsigned)(2 * r + 1) << 4) | (unsigned)e1; lrank[2 * s0 + 1] = (unsigned)k1;
                }
            }
            __syncthreads();
            if (tid < 16 && rep_ == 0) { const int c = lcnt[tid]; lcnt[16 + tid] = c ? (int)__hip_atomic_fetch_add((unsigned*)(ctl + CW_CNT + (l * 16 + tid) * 64), (unsigned)c, RLX_AGENT) : 0; }
            __syncthreads();
            const int ntot = rep_ == 0 ? 2 * lcnt[32] : 0;
            for (int i = tid; i < ntot; i += 512) { const unsigned en = lent[i]; const int e = en & 15; list[(size_t)e * TT + lcnt[16 + e] + lrank[i]] = en >> 4; }
            __syncthreads();
            if (l == 0 && !MK_SPLIT) steal_convert(KA, lds, G, 1, false);
        }
        SEAM(P + 5);
        if (IN(P + 6) || IN(P + 7)) {
            KA_DECL
            __syncthreads();
            if (tid < 16) ttab[17 + tid] = (int)__hip_atomic_load((unsigned*)(ctl + CW_CNT + (l * 16 + tid) * 64), RLX_AGENT);
            __syncthreads();
            if (tid == 0) { int acc_ = 0; for (int e = 0; e < 16; ++e) { const int c = ttab[17 + e]; ttab[e] = acc_; acc_ += (c + 255) >> 8; } ttab[16] = acc_; }
            __syncthreads();
        }
        if (DBG_NAIVE_MOE && IN(P + 6)) {
            KA_DECL
            const int nrows = (l == 0) ? TT : T; LAS float* hs = (LAS float*)lds; LAS float* as = hs + 1024;
            const int* eidg = (const int*)(ws + O_EID);
            LAS float* lgs = as + 512; LAS float* rt = lgs + 32;
            for (int r = vcu; r < nrows; r += G) {
                __syncthreads();
                for (int i = tid; i < 1024; i += 512) hs[i] = bf2f(hbuf[(size_t)r * 1024 + i]);
                __syncthreads();
                if (tid < 20) { float a = 0.f; for (int k = 0; k < 1024; ++k) a += hs[k] * ((tid < 4) ? w_grp[(size_t)l * 4096 + k * 4 + tid] : w_rtr[(size_t)l * 16384 + k * 16 + (tid - 4)]);
                    lgs[tid] = a + ((tid < 4) ? b_grp[l * 4 + tid] : b_rtr[l * 16 + tid - 4]); }
                __syncthreads();
                if (tid == 0) { int gi = 0; for (int j = 1; j < 4; ++j) if (lgs[j] > lgs[gi]) gi = j; float gs = 0.f; for (int j = 0; j < 4; ++j) gs += expf(lgs[j] - lgs[gi]); const float pg = 1.f / gs;
                    int i0 = 0; for (int j = 1; j < 4; ++j) if (lgs[4 + gi * 4 + j] > lgs[4 + gi * 4 + i0]) i0 = j; int i1 = -1; for (int j = 0; j < 4; ++j) if (j != i0 && (i1 < 0 || lgs[4 + gi * 4 + j] > lgs[4 + gi * 4 + i1])) i1 = j;
                    const float p0 = 1.f, p1 = expf(lgs[4 + gi * 4 + i1] - lgs[4 + gi * 4 + i0]); rt[0] = (float)(gi * 4 + i0); rt[1] = (float)(gi * 4 + i1); rt[2] = pg * p0 / (p0 + p1); rt[3] = pg * p1 / (p0 + p1); }
                __syncthreads();
                for (int sl = 0; sl < 2; ++sl) {
                    const int e = (DBG_NAIVE_ROUTE & 1) ? (int)rt[sl] : eidg[2 * r + sl]; const float w = (DBG_NAIVE_ROUTE & 2) ? rt[2 + sl] : wts[2 * r + sl];
                    __syncthreads();
                    const float* Wg = w_gate + (size_t)(l * 16 + e) * 1024 * 512 + tid; const float* Wu = w_up + (size_t)(l * 16 + e) * 1024 * 512 + tid;
                    float g = 0.f, u = 0.f;
#pragma unroll 8
                    for (int k = 0; k < 1024; ++k) { g += hs[k] * Wg[(size_t)k * 512]; u += hs[k] * Wu[(size_t)k * 512]; }
                    as[tid] = g / (1.f + expf(-g)) * u;
                    __syncthreads();
                    const float* Wd = w_down + (size_t)(l * 16 + e) * 512 * 1024 + tid;
                    float y0 = 0.f, y1 = 0.f;
#pragma unroll 8
                    for (int j = 0; j < 512; ++j) { y0 += as[j] * Wd[(size_t)j * 1024]; y1 += as[j] * Wd[(size_t)j * 1024 + 512]; }
                    y2[(size_t)(2 * r + sl) * 1024 + tid] = (bf16)f2bf(y0 * w); y2[(size_t)(2 * r + sl) * 1024 + 512 + tid] = (bf16)f2bf(y1 * w);
                }
            }
        }
        if (!DBG_NAIVE_MOE && IN(P + 6)) {
            KA_DECL
            unsigned* rdy = (unsigned*)(ctl + CW_RDY + l * 4096);
            SchedMoe S{G, vcu, ttab[16], (const char*)hbuf, (const char*)act, (const char*)wgu_t, (const char*)wd_t, list, ttab, rdy, (unsigned*)(ctl + CW_TMO)};
            EpiMoe E{EpiG3{act, rdy}, EpiG4{(unsigned char*)y2, list, wts, ttab}};
            pg8::gemm_phase<EpiMoe, SchedMoe, true>(lds, S, E);
            if (l == 0 && !MK_SPLIT) steal_convert(KA, lds, G, 2, false);
        }
        SEAM(P + 7);
    }

__global__ void __launch_bounds__(512, 2) fwd_kernel(Args args) {
    extern __shared__ __attribute__((aligned(16))) unsigned char lds_raw[];
    LAS unsigned char* lds = (LAS unsigned char*)lds_raw;
    const int tid = threadIdx.x, lane = tid & 63, wave = __builtin_amdgcn_readfirstlane(tid >> 6);
    const int G = gridDim.x; const int bx = blockIdx.x; const int vcu = (G % 8 == 0) ? (bx % 8) * (G / 8) + bx / 8 : bx;
    volatile LAS unsigned* MISC = (volatile LAS unsigned*)(lds + MISC_OFF);
    LAS float* trig = (LAS float*)(lds + TRIG_OFF);
    LAS int* ttab = (LAS int*)(lds + TILE_OFF);
    for (int u = tid; u < (LDS_BYTES - LDSCTL_OFF) / 4; u += 512) ((LAS unsigned*)(lds + LDSCTL_OFF))[u] = 0u;
    __syncthreads();
    if (tid < 64) { float s, c; sincospif((float)tid / 32.f, &s, &c); trig[tid] = c; trig[64 + tid] = s; }
    __syncthreads();
    XcdBarrier bar; bar.bar = nullptr; bar.x = 0; bar.st = nullptr;
    if (!MK_SPLIT) { KA_DECL bar = xcd_barrier_post((unsigned*)(ctl + CW_BAR), MISC + 8); }
    const int lo = args.ph_lo, hi = args.ph_hi;
    const int NGW = G * 8, NGT = G * 512;

    for (int rep_ = 0; rep_ < 1 + ((REP_MASK >> 0) & 1); ++rep_)
    if (IN(0)) {
        KA_DECL
        __syncthreads();
        if (rep_ == 0 || ((REP_MASK >> 13) & 1)) {
            LAS float* sl = (LAS float*)lds;
            bool have = false;
            for (int it = vcu; it < 192; it += G) {
                if (!have) {
                    for (int i = tid; i < 5120; i += 512) { const int r = i >> 10, k = i & 1023; const float v = (r < 4) ? c_in[r * 1024 + k] : cctx_in[k]; sl[i] = v / (1.f + expf(-v)); }
                    __syncthreads(); have = true;
                }
                const int l = it / 96, cb = it % 96;
                const int r4 = lane >> 4, cq = lane & 15; const int k0 = wave * 128;
                const float* W = w_mod + (size_t)l * 1024 * 6144 + (size_t)(k0 + r4) * 6144 + cb * 64 + 4 * cq;
                f32x4 a0 = {0.f, 0.f, 0.f, 0.f}, a1 = a0, a2 = a0, a3 = a0, a4 = a0;
#pragma unroll 8
                for (int k = 0; k < 32; ++k) { const f32x4 wv = *(const f32x4*)(W + (size_t)(4 * k) * 6144); const int kk = k0 + 4 * k + r4;
                    a0 += wv * sl[kk]; a1 += wv * sl[1024 + kk]; a2 += wv * sl[2048 + kk]; a3 += wv * sl[3072 + kk]; a4 += wv * sl[4096 + kk]; }
                LAS float* part = sl + 5120;
                { LAS float* pp = part + (wave * 4 + r4) * 320 + 4 * cq;
                  *(LAS f32x4*)(pp) = a0; *(LAS f32x4*)(pp + 64) = a1; *(LAS f32x4*)(pp + 128) = a2; *(LAS f32x4*)(pp + 192) = a3; *(LAS f32x4*)(pp + 256) = a4; }
                __syncthreads();
                if (tid < 320) { const int r = tid >> 6, n = tid & 63; float sacc = b_mod[l * 6144 + cb * 64 + n];
#pragma unroll 8
                    for (int w = 0; w < 32; ++w) sacc += part[w * 320 + r * 64 + n];
                    modv[(size_t)(l * 5 + r) * 6144 + cb * 64 + n] = sacc; }
                __syncthreads();
            }
            __syncthreads();
        }
        if (rep_ == 0 || ((REP_MASK >> 14) & 1)) {
#pragma clang loop vectorize(disable) unroll(disable)
        for (int i = gt; i < 4096 * 32; i += NGT) {
            const int n = i >> 5, j = i & 31; const int jj = j & 15;
            const float inv = 1.0f / powf(10000.0f, (float)(2 * jj) / 32.0f);
            const float pos = (j < 16) ? (float)(n >> 6) : (float)(n & 63);
            const float ang = pos * inv; rope[i] = make_float2(cosf(ang), sinf(ang));
        }
#pragma clang loop vectorize(disable) unroll(disable)
        for (int i = gt; i < 4096; i += NGT) { float s, c; sincospif((float)i / 2048.f, &s, &c); twt[i] = make_float2(c, s); }
#pragma clang loop vectorize(disable) unroll(disable)
        for (int i = gt; i < 128 * 128; i += NGT) {
            const int m = i >> 7, k = i & 127; const int ri = m >> 6, k1 = m & 63, part = k >> 6, n1 = k & 63;
            float s, c; sincospif((float)((n1 * k1) & 63) / 32.f, &s, &c);
            float v; if (ri == 0) v = (part == 0) ? c : -s; else v = (part == 0) ? -s : -c;
            fma[i] = (bf16)f2bf(v);
        }
#pragma clang loop vectorize(disable) unroll(disable)
        for (int i = gt; i < 64 * 128; i += NGT) {
            const int k2 = i >> 7, k = i & 127; const int ri = k >> 6, n2 = k & 63;
            float s, c; sincospif((float)((n2 * k2) & 63) / 32.f, &s, &c);
            fmb[i] = (bf16)f2bf((ri == 0 ? c : s) * (1.f / 512.f));
        }
#pragma clang loop vectorize(disable) unroll(disable)
        for (int i = gt; i < 256 * 512; i += NGT) {
            const int kk = i >> 9, k = i & 511; const int part = k >> 8, n = k & 255;
            float s, c; sincospif((float)((n * kk) & 255) / 128.f, &s, &c);
            fmc[i] = (bf16)f2bf((part == 0 ? c : -s) * (1.f / 128.f));
        }
#pragma clang loop vectorize(disable) unroll(disable)
        for (int i = gt; i < 2 * 20480; i += NGT) {
            const int lw = i / 20480, r = i % 20480; const int d = r / 20, j = r % 20;
            ((float*)(ws + O_RW))[lw * 20480 + ((((j >> 2) * 4 + (d >> 8)) * 4 + (d & 3)) * 64 + ((d & 255) >> 2)) * 4 + (j & 3)] = (j < 4) ? w_grp[(size_t)lw * 4096 + d * 4 + j] : w_rtr[(size_t)lw * 16384 + d * 16 + (j - 4)];
        }
        }
        if (rep_ == 0 || ((REP_MASK >> 15) & 1)) {
            LAS float* Al = (LAS float*)lds;
            LAS float* Wl = Al + 4096;
            LAS float* Xl = Wl + 4096;
            for (int it = vcu; it < 256; it += G) {
                const int combo = it & 15, jb = it >> 4; const int l = combo >> 3, g = (combo >> 1) & 3, which = combo & 1;
                const float* Wg = four_w + (size_t)(l * 4 + g) * 4096; const LAS float* tb = trig + which * 64;
                const float* wi = w_in + (size_t)l * 1024 * 1280 + (size_t)(jb * 64) * 1280 + 1024 + g * 64;
                __syncthreads();
#pragma unroll
                for (int i = 0; i < 2; ++i) { const int idx = tid + 512 * i; *(LAS f32x4*)(Wl + 4 * idx) = *(const f32x4*)(Wg + 4 * idx); const int j = idx >> 4, c4 = idx & 15;
                    const f32x4 xv = *(const f32x4*)(wi + (size_t)j * 1280 + 4 * c4);
                    Xl[(4 * c4) * 68 + j] = xv[0]; Xl[(4 * c4 + 1) * 68 + j] = xv[1]; Xl[(4 * c4 + 2) * 68 + j] = xv[2]; Xl[(4 * c4 + 3) * 68 + j] = xv[3]; }
                __syncthreads();
                { const int d4 = tid & 15, c = tid >> 4;
                  f32x4 a0 = {0.f, 0.f, 0.f, 0.f}, a1 = a0;
#pragma unroll 8
                  for (int m = 0; m < 64; ++m) { const f32x4 wv = *(const LAS f32x4*)(Wl + m * 64 + 4 * d4); a0 += wv * tb[(m * c) & 63]; a1 += wv * tb[(m * (c + 32)) & 63]; }
                  *(LAS f32x4*)(Al + c * 64 + 4 * d4) = a0; *(LAS f32x4*)(Al + (c + 32) * 64 + 4 * d4) = a1; }
                __syncthreads();
                { const int d = tid & 63, jl = 8 * (tid >> 6);
                  f32x4 o0 = {0.f, 0.f, 0.f, 0.f}, o1 = o0;
#pragma unroll 8
                  for (int c = 0; c < 64; ++c) { const float av = Al[c * 64 + d]; o0 += *(const LAS f32x4*)(Xl + c * 68 + jl) * av; o1 += *(const LAS f32x4*)(Xl + c * 68 + jl + 4) * av; }
                  v2u w; w.x = pk4_f8(o0[0] * 64.f, o0[1] * 64.f, o0[2] * 64.f, o0[3] * 64.f); w.y = pk4_f8(o1[0] * 64.f, o1[1] * 64.f, o1[2] * 64.f, o1[3] * 64.f);
                  *(v2u*)((unsigned char*)(ws + O_WIN8 + l * SZ_WIN8) + (size_t)(768 + which * 256 + g * 64 + d) * 1024 + jb * 64 + jl) = w; }
            }
            for (int it = vcu; it < 256; it += G) {
                const int combo = it & 7, nb = it >> 3; const int l = combo >> 2, g = combo & 3, n0 = nb * 32;
                const float* pwg = pool_w + (size_t)(l * 4 + g) * 4096;
                __syncthreads();
#pragma unroll
                for (int i = 0; i < 2; ++i) { const int idx = tid + 512 * i; *(LAS f32x4*)(Wl + 4 * idx) = *(const f32x4*)(pwg + 4 * idx); }
                { const int d = tid >> 3, n4 = tid & 7; const float ps = pool_scale[l * 256 + g * 64 + d];
                  *(LAS f32x4*)(Xl + d * 32 + 4 * n4) = *(const f32x4*)(w_out + (size_t)l * 1024 * 1024 + (size_t)(g * 64 + d) * 1024 + n0 + 4 * n4) * ps; }
                __syncthreads();
                { const int n = tid & 31, c0 = 4 * (tid >> 5);
                  float o[4] = {0.f, 0.f, 0.f, 0.f};
#pragma unroll 4
                  for (int d = 0; d < 64; d += 4) { const float s0 = Xl[d * 32 + n], s1 = Xl[(d + 1) * 32 + n], s2 = Xl[(d + 2) * 32 + n], s3 = Xl[(d + 3) * 32 + n];
#pragma unroll
                      for (int i = 0; i < 4; ++i) { const f32x4 wv = *(const LAS f32x4*)(Wl + (c0 + i) * 64 + d); o[i] += (wv[0] * s0 + wv[1] * s1) + (wv[2] * s2 + wv[3] * s3); } }
                  v2u w; w.x = pk2(o[0], o[1]); w.y = pk2(o[2], o[3]);
                  *(v2u*)((bf16*)(ws + O_WOUT + l * SZ_WOUT1) + (size_t)(n0 + n) * 1024 + g * 64 + c0) = w; }
            }
            __syncthreads();
        }
        if (rep_ == 0 || ((REP_MASK >> 16) & 1)) {
            LAS bf16* scr = (LAS bf16*)(lds + wave * 16384);
#pragma clang loop vectorize(disable) unroll(disable)
            for (int it0 = gw; it0 < CV_L; it0 += NGW) conv_item(KA, 0, it0, scr, lane);
        }
    }
    SEAM(0);
    if ((REP_MASK >> 12) & 1) { for (int k_ = 0; k_ < 4; ++k_) xcd_barrier(bar); }

    layer_body<0>(lds, G, vcu, bar, lo, hi);
    layer_body<1>(lds, G, vcu, bar, lo, hi);
    if (IN(17)) {
        KA_DECL
        const float* modp = modv + (size_t)5 * 6144;
#pragma clang loop vectorize(disable) unroll(disable)
        for (int r = gw; r < T; r += NGW) {
            const float* g2 = modp + (r >> 12) * 6144 + 5 * 1024; float* dst = outp + (size_t)r * 1024;
#pragma unroll
            for (int j = 0; j < 4; ++j) {
                const int c0 = 4 * lane + 256 * j; const v2u xw = *(const v2u*)(xb + (size_t)r * 1024 + c0); const f32x4 v = {bflo(xw.x), bfhi(xw.x), bflo(xw.y), bfhi(xw.y)};
                const unsigned ya = *(const unsigned*)((const unsigned char*)y2 + (size_t)(2 * r) * 1024 + c0), yb = *(const unsigned*)((const unsigned char*)y2 + (size_t)(2 * r + 1) * 1024 + c0);
                const f32x4 gv = *(const f32x4*)(g2 + c0);
                f32x4 yy = (f8x4_f32(ya) + f8x4_f32(yb)) * (1.0f / Y2SC);
                if (DBG_NO_MOE) yy = (f32x4){0.f, 0.f, 0.f, 0.f};
                *(f32x4*)(dst + c0) = v + gv * yy;
            }
        }
    }
#undef IN
#undef SEAM
}

#undef KA_DECL
#undef ws
#undef ctl
#undef x_in
#undef c_in
#undef ctx_in
#undef cctx_in
#undef w_mod
#undef b_mod
#undef norm1_g
#undef w_in
#undef q_norm_g
#undef k_norm_g
#undef attn_sink
#undef pool_w
#undef pool_scale
#undef four_w
#undef w_out
#undef norm2_g
#undef w_grp
#undef b_grp
#undef w_rtr
#undef b_rtr
#undef w_gate
#undef w_up
#undef w_down
#undef outp
#undef modv
#undef rope
#undef twt
#undef fma
#undef fmb
#undef fmc
#undef hbuf
#undef kall
#undef vall
#undef xc
#undef xb
#undef list
#undef wts
#undef act
#undef t2
#undef mrg
#undef qb
#undef pu
#undef zb
#undef y2
#undef modl
#undef win_t
#undef wout_t
#undef wgu_t
#undef wd_t
extern "C" void kernel_launch(void* const* d_in, const int* in_sizes, int n_in, void* d_out, int out_size, void* d_ws, size_t ws_size, hipStream_t stream) {
    static int grid = 0;
    if (grid == 0) {
        if (n_in != 23 || out_size != T * DM || ws_size < WS_END) { fprintf(stderr, "kernel_launch: unexpected shapes (n_in %d out %d ws %zu need %zu)\n", n_in, out_size, ws_size, (size_t)WS_END); grid = -1; return; }
        int dev = 0, cus = 0;
        if (hipGetDevice(&dev) != hipSuccess || hipDeviceGetAttribute(&cus, hipDeviceAttributeMultiprocessorCount, dev) != hipSuccess) { grid = -1; return; }
        if (cus != 256) { fprintf(stderr, "kernel_launch: built for a 256-CU device (row-tile hand-offs are laid out for 256 workgroups); found %d CUs; nothing launched\n", cus); grid = -1; return; }
        if (hipFuncSetAttribute((const void*)fwd_kernel, hipFuncAttributeMaxDynamicSharedMemorySize, LDS_BYTES) != hipSuccess) { fprintf(stderr, "kernel_launch: hipFuncSetAttribute failed\n"); grid = -1; return; }
        (void)hipGetLastError();
        grid = cus;
    }
    if (grid < 0) return;
    (void)hipMemsetAsync((char*)d_ws + O_CTL, 0, SZ_CTL, stream);
    Args a{};
    for (int i = 0; i < 23; ++i) a.in[i] = (const float*)d_in[i];
    a.out = (float*)d_out; a.ws = (unsigned char*)d_ws;
#if MK_SPLIT
    for (int p = 0; p < NPHASE; ++p) { a.ph_lo = p; a.ph_hi = p + 1; hipLaunchKernelGGL(fwd_kernel, dim3(grid), dim3(512), LDS_BYTES, stream, a); }
#else
    a.ph_lo = 0; a.ph_hi = NPHASE;
    hipLaunchKernelGGL(fwd_kernel, dim3(grid), dim3(512), LDS_BYTES, stream, a);
#endif
}
```

```cpp
#include <hip/hip_runtime.h>
#include <cstdio>
#include <cstdint>

#define DBG_NO_FOUR 0
#define DBG_NO_POOL 0
#define DBG_NO_ATT 0
#define DBG_NO_MOE 0
#define DBG_MOE_SCALE 1.0f
#define DBG_NAIVE_MOE 0
#define REP_MASK 0x0
#define DBG_NAIVE_ROUTE 0
#define LAS __attribute__((address_space(3)))
#define GAS __attribute__((address_space(1)))
typedef unsigned short bf16;
typedef short bf16x8 __attribute__((ext_vector_type(8)));
typedef float f32x4 __attribute__((ext_vector_type(4)));
typedef float f32x16 __attribute__((ext_vector_type(16)));
typedef unsigned v4u __attribute__((ext_vector_type(4)));
typedef unsigned v2u __attribute__((ext_vector_type(2)));
typedef float f32x2 __attribute__((ext_vector_type(2)));
typedef GAS unsigned gu32;

#ifndef MK_SPLIT
#define MK_SPLIT 0
#endif

constexpr int NB = 4, NSEQ = 4096, DM = 1024, LCTX = 256, DEPTH = 2;
constexpr int T = NB * NSEQ, TC = NB * LCTX, TT = T + TC;
constexpr int KVROWS = LCTX + NSEQ;
constexpr int NEXP = 16, DEXP = 512;
constexpr int NPHASE = 18;
constexpr int MAXTILES = 152;
constexpr float QSCALE = 0.125f * 1.4426950408889634f;
constexpr float LOG2E = 1.4426950408889634f;
constexpr float Y2SC = 16.0f;

constexpr size_t al256(size_t x) { return (x + 255) & ~(size_t)255; }
constexpr size_t O_CTL = 0, SZ_CTL = 1u << 20;
constexpr size_t O_MOD = O_CTL + SZ_CTL, SZ_MOD = (size_t)2 * 5 * 6144 * 4;
constexpr size_t O_ROPE = al256(O_MOD + SZ_MOD), SZ_ROPE = (size_t)4096 * 32 * 8;
constexpr size_t O_TW = al256(O_ROPE + SZ_ROPE), SZ_TW = 4096 * 8;
constexpr size_t O_FMA = al256(O_TW + SZ_TW), SZ_FMA = 128 * 128 * 2;
constexpr size_t O_FMB = al256(O_FMA + SZ_FMA), SZ_FMB = 64 * 128 * 2;
constexpr size_t O_FMC = al256(O_FMB + SZ_FMB), SZ_FMC = 256 * 512 * 2;
constexpr size_t O_RW = al256(O_FMC + SZ_FMC), SZ_RW = (size_t)2 * 20480 * 4;
constexpr size_t O_WIN8 = al256(O_RW + SZ_RW), SZ_WIN8 = (size_t)1280 * 1024;
constexpr size_t O_WIN = al256(O_WIN8 + 2 * SZ_WIN8), SZ_WIN1 = (size_t)1536 * 1024 * 2;
constexpr size_t O_WOUT = al256(O_WIN + 2 * SZ_WIN1), SZ_WOUT1 = (size_t)1024 * 1024 * 2;
constexpr size_t O_WGU = al256(O_WOUT + 2 * SZ_WOUT1), SZ_WGU1 = (size_t)16 * 1024 * 1024 * 2;
constexpr size_t O_WD = al256(O_WGU + 2 * SZ_WGU1), SZ_WD1 = (size_t)16 * 1024 * 512 * 2;
constexpr size_t O_H = al256(O_WD + 2 * SZ_WD1), SZ_H = (size_t)TT * 1024 * 2;
constexpr size_t O_KALL = al256(O_H + SZ_H), SZ_KV = (size_t)NB * KVROWS * 128 * 2;
constexpr size_t O_VALL = al256(O_KALL + SZ_KV);
constexpr size_t O_XC = al256(O_VALL + SZ_KV), SZ_XC = (size_t)TC * 1024 * 4;
constexpr size_t O_LIST = al256(O_XC + SZ_XC), SZ_LIST = (size_t)NEXP * TT * 4;
constexpr size_t O_WTS = al256(O_LIST + SZ_LIST), SZ_WTS = (size_t)TT * 2 * 4;
constexpr size_t O_EID = al256(O_WTS + SZ_WTS), SZ_EID = (size_t)TT * 2 * 4;
constexpr size_t O_ACT = al256(O_EID + SZ_EID), SZ_ACT = (size_t)MAXTILES * 256 * 512 * 2;
constexpr size_t O_T2 = O_ACT, SZ_T2 = (size_t)NB * 64 * 64 * 2 * 256 * 2;
constexpr size_t O_MRG = al256(O_ACT + SZ_ACT), SZ_MRG = (size_t)TT * 1024 * 2;
constexpr size_t O_Q = al256(O_MRG + SZ_MRG), SZ_Q = (size_t)TT * 512 * 2;
constexpr size_t O_PU = al256(O_Q + SZ_Q), SZ_PU = (size_t)TT * 256 * 2;
constexpr size_t O_Z = al256(O_PU + SZ_PU), SZ_Z = (size_t)TT * 512 * 2;
constexpr size_t O_Y2 = O_MRG, SZ_Y2 = (size_t)TT * 2 * 1024 * 2;
constexpr size_t O_XB = al256(O_Z + SZ_Z), SZ_XB = (size_t)TT * 1024 * 2;
constexpr size_t WS_END = al256(O_XB + SZ_XB);
static_assert(SZ_T2 <= SZ_ACT, "T2 overlay");
static_assert(O_Y2 + SZ_Y2 <= WS_END, "y2 overlay");

constexpr int CW_TMO = 0;
constexpr int CW_BAR = 4096;
constexpr int CW_KF = 65536;
constexpr int CW_FA = 3072;
constexpr int CW_G2 = 40960;
constexpr int CW_RDY = 32768;
constexpr int CW_Q = 2048;
constexpr int CW_DONE = 2560;
constexpr int CW_CNT = 16384;

constexpr int RING_BYTES = 131072;
constexpr int LDSCTL_OFF = RING_BYTES, MISC_OFF = LDSCTL_OFF + 320;
constexpr int TRIG_OFF = LDSCTL_OFF + 1024;
constexpr int TILE_OFF = LDSCTL_OFF + 2048;
constexpr int LDS_BYTES = 147456;

#define RLX_AGENT __ATOMIC_RELAXED, __HIP_MEMORY_SCOPE_AGENT
#define LDS_WAIT() asm volatile("s_waitcnt lgkmcnt(0)" ::: "memory")
#define VM_WAIT() asm volatile("s_waitcnt vmcnt(0)" ::: "memory")

__device__ __forceinline__ unsigned f2bf(float f) { unsigned u = __builtin_bit_cast(unsigned, f); return (u + 0x7fffu + ((u >> 16) & 1u)) >> 16; }
typedef float f32x2_t_ __attribute__((ext_vector_type(2))); typedef __bf16 bf16x2_t_ __attribute__((ext_vector_type(2)));
__device__ __forceinline__ unsigned pk2(float lo, float hi) { f32x2_t_ v = {lo, hi}; return __builtin_bit_cast(unsigned, __builtin_convertvector(v, bf16x2_t_)); }
__device__ __forceinline__ unsigned pk4_f8(float a, float b, float c, float d) { unsigned w = 0; w = __builtin_amdgcn_cvt_pk_fp8_f32(a, b, w, false); w = __builtin_amdgcn_cvt_pk_fp8_f32(c, d, w, true); return w; }
__device__ __forceinline__ f32x4 f8x4_f32(unsigned w) { const auto lo = __builtin_amdgcn_cvt_pk_f32_fp8(w, false); const auto hi = __builtin_amdgcn_cvt_pk_f32_fp8(w, true); return (f32x4){lo[0], lo[1], hi[0], hi[1]}; }
__device__ __forceinline__ float bflo(unsigned w) { return __builtin_bit_cast(float, w << 16); }
__device__ __forceinline__ float bfhi(unsigned w) { return __builtin_bit_cast(float, w & 0xffff0000u); }
__device__ __forceinline__ float bf2f(bf16 h) { return __builtin_bit_cast(float, (unsigned)h << 16); }
template <int CTRL, int RM> __device__ __forceinline__ float dppf(float v) { return __builtin_bit_cast(float, __builtin_amdgcn_update_dpp(0, __builtin_bit_cast(int, v), CTRL, RM, 0xf, true)); }
__device__ __forceinline__ float wave_sum(float v) {
    v += dppf<0x111, 0xf>(v); v += dppf<0x112, 0xf>(v); v += dppf<0x114, 0xf>(v); v += dppf<0x118, 0xf>(v);
    v += dppf<0x142, 0xa>(v); v += dppf<0x143, 0xc>(v);
    return __builtin_bit_cast(float, __builtin_amdgcn_readlane(__builtin_bit_cast(int, v), 63));
}

__device__ __forceinline__ float swap32_sum(float x, float y) {
    const auto rr = __builtin_amdgcn_permlane32_swap(__builtin_bit_cast(unsigned, x), __builtin_bit_cast(unsigned, y), false, false);
    unsigned r0 = rr[0], r1 = rr[1]; asm volatile("" : "+v"(r0), "+v"(r1));
    return __builtin_bit_cast(float, r0) + __builtin_bit_cast(float, r1);
}
__device__ __forceinline__ float swap16_sum(float x, float y) {
    const auto rr = __builtin_amdgcn_permlane16_swap(__builtin_bit_cast(unsigned, x), __builtin_bit_cast(unsigned, y), false, false);
    unsigned r0 = rr[0], r1 = rr[1]; asm volatile("" : "+v"(r0), "+v"(r1));
    return __builtin_bit_cast(float, r0) + __builtin_bit_cast(float, r1);
}

#define XB_TMO      128
#define XB_XCNT(j)  (256  + 64 * (j))
#define XB_XSUB(j)  (1280 + 64 * (j))
#define XB_XGEN(j)  (2304 + 64 * (j))
#define XB_TOP      3328
#define XB_TOPGEN   3392
#define XCD_BAR_WORDS 3456
#define XB_SPIN_CAP (1u << 18)
__device__ __forceinline__ unsigned xb_ld(unsigned* p)              { return __hip_atomic_load(p, __ATOMIC_RELAXED, __HIP_MEMORY_SCOPE_AGENT); }
__device__ __forceinline__ unsigned xb_add(unsigned* p, unsigned v) { return __hip_atomic_fetch_add(p, v, __ATOMIC_RELAXED, __HIP_MEMORY_SCOPE_AGENT); }
__device__ __forceinline__ unsigned xb_xcc_id() { return (unsigned)__builtin_amdgcn_s_getreg((3 << 11) | 20) & 0xFu; }
#define XB_SPIN(cond, bar) do { unsigned _sp = 0; while (cond) { __builtin_amdgcn_s_sleep(1); \
    if ((++_sp & 255u) == 0u) { if (xb_ld(&(bar)[XB_TMO])) break; if (_sp > XB_SPIN_CAP) { atomicAdd(&(bar)[XB_TMO], 1u); break; } } } } while (0)
struct XcdBarrier { unsigned* bar; unsigned x; volatile LAS unsigned* st; };
__device__ __forceinline__ XcdBarrier xcd_barrier_post(unsigned* bar, volatile LAS unsigned* st) {
    XcdBarrier b; b.bar = bar; b.x = xb_xcc_id(); b.st = st;
    if (threadIdx.x == 0) (void)xb_add(&bar[XB_XCNT(b.x)], 1u);
    return b;
}
__device__ __forceinline__ void xcd_barrier_complete(unsigned* bar, unsigned x, unsigned& nloc, unsigned& nx) {
    const unsigned G = gridDim.x * gridDim.y * gridDim.z;
    unsigned sum, cnt, mine, sp = 0u;
    for (;;) {
        sum = 0u; cnt = 0u; mine = 0u;
#pragma unroll
        for (unsigned j = 0; j < 16; ++j) { const unsigned c = xb_ld(&bar[XB_XCNT(j)]); sum += c; cnt += (c > 0u) ? 1u : 0u; mine = (j == x) ? c : mine; }
        if (sum == G) break;
        __builtin_amdgcn_s_sleep(1);
        if ((++sp & 255u) == 0u) { if (xb_ld(&bar[XB_TMO])) break; if (sp > XB_SPIN_CAP) { atomicAdd(&bar[XB_TMO], 1u); break; } }
    }
    nloc = mine > 0u ? mine : 1u; nx = cnt > 0u ? cnt : 1u;
}
__device__ __forceinline__ void xcd_barrier(const XcdBarrier& b) {
    asm volatile("s_waitcnt vmcnt(0)" ::: "memory");
    __syncthreads();
    if (threadIdx.x == 0) {
        unsigned* bar = b.bar;
        __builtin_amdgcn_s_waitcnt(0);
        unsigned nloc = b.st[0], nx = b.st[1];
        if (nloc == 0u) { xcd_barrier_complete(bar, b.x, nloc, nx); b.st[0] = nloc; b.st[1] = nx; }
        const unsigned old = xb_add(&bar[XB_XSUB(b.x)], 1u);
        const unsigned gen = old / nloc;
        if (old + 1u == (gen + 1u) * nloc) {
            __builtin_amdgcn_fence(__ATOMIC_RELEASE, "agent");
            asm volatile("s_waitcnt vmcnt(0)" ::: "memory");
            const unsigned og = xb_add(&bar[XB_TOP], 1u);
            const unsigned tg = og / nx;
            if (og + 1u == (tg + 1u) * nx) xb_add(&bar[XB_TOPGEN], 1u);
            else XB_SPIN(xb_ld(&bar[XB_TOPGEN]) == tg, bar);
            __builtin_amdgcn_fence(__ATOMIC_ACQUIRE, "agent");
            xb_add(&bar[XB_XGEN(b.x)], 1u);
            asm volatile("s_waitcnt vmcnt(0)" ::: "memory");
        } else {
            XB_SPIN(xb_ld(&bar[XB_XGEN(b.x)]) == gen, bar);
            __builtin_amdgcn_fence(__ATOMIC_ACQUIRE, "agent");
            asm volatile("s_waitcnt vmcnt(0)" ::: "memory");
        }
    }
    __syncthreads();
}

namespace pg8 {
constexpr int BM = 256, BK = 64, HALF = 128, HTB = HALF * BK * 2;
__host__ __device__ __forceinline__ int lds_byte(int r, int c) { const int st = (r >> 4) * 2 + (c >> 5), rr = r & 15, cc = c & 31, ob = rr * 64 + cc * 2; return st * 1024 + (ob ^ (((ob >> 9) & 1) << 5)); }
__host__ __device__ __forceinline__ void stage_rc(int b, int& R, int& C) { const int st = b / 1024, sb = b % 1024, swz = sb ^ (((sb >> 9) & 1) << 5); R = (st >> 1) * 16 + swz / 64; C = (st & 1) * 32 + (swz % 64) / 2; }
__host__ __device__ __forceinline__ int perm32(int rho) { const int n = rho >> 4, i = rho & 15; return 8 * (i >> 2) + 4 * n + (i & 3); }

struct Unit { int pm, pn, e, cnt, kind; };

typedef int v8i __attribute__((ext_vector_type(8)));
typedef int v4i __attribute__((ext_vector_type(4)));
template <class Epi, class Sched, bool F8ALL = false>
__device__ __forceinline__ void gemm_phase(LAS unsigned char* lds, const Sched& S, const Epi& E) {
    int tid = threadIdx.x; asm volatile("" : "+v"(tid));
    const int wid = __builtin_amdgcn_readfirstlane(tid >> 6), lane = tid & 63, wr = wid >> 2, wc = wid & 3, fr = lane & 15, fq = lane >> 4;
#define PG8_RC() int RA[2], CA[2], RB[2]; { int tl_ = tid; asm volatile("" : "+v"(tl_)); _Pragma("unroll") for (int i = 0; i < 2; ++i) { int R, C; stage_rc(tl_ * 16 + i * 8192, R, C); RA[i] = R; CA[i] = C; RB[i] = Epi::PERM ? ((R & ~31) + perm32(R & 31)) : R; } }
    const size_t kstep = (size_t)(BK * 2);
    const unsigned ldsw = (unsigned)wid * 1024u;
    const int aoff = lds_byte(wr * 64 + fr, fq * 8), boff = lds_byte(wc * 32 + fr, fq * 8);
#define PG8_SA(b, h) (((b) * 2 + (h)) * HTB)
#define PG8_SB(b, h) ((4 + (b) * 2 + (h)) * HTB)
#define PG8_STAGE2(bufoff, gbase, o0, o1) do { \
        __builtin_amdgcn_global_load_lds((const unsigned*)((const char*)(gbase) + (o0)), (LAS unsigned*)(lds + (bufoff) + ldsw), 16, 0, 0); \
        __builtin_amdgcn_global_load_lds((const unsigned*)((const char*)(gbase) + (o1)), (LAS unsigned*)(lds + (bufoff) + ldsw + 8192), 16, 0, 0); } while (0)
#define PG8_LD8(p) __builtin_shufflevector(*(const LAS v4i*)(p), *(const LAS v4i*)((p) + 1024), 0, 1, 2, 3, 4, 5, 6, 7)
#define PG8_LDA(dst, b, h) do { _Pragma("unroll") for (int m = 0; m < 4; ++m) dst[m] = PG8_LD8(lds + PG8_SA(b, h) + aoff + m * 2048); } while (0)
#define PG8_LDB(dst, b, h) do { _Pragma("unroll") for (int n = 0; n < 2; ++n) dst[n] = PG8_LD8(lds + PG8_SB(b, h) + boff + n * 2048); } while (0)
#define PG8_LO(x) __builtin_bit_cast(bf16x8, __builtin_shufflevector(x, x, 0, 1, 2, 3))
#define PG8_HI(x) __builtin_bit_cast(bf16x8, __builtin_shufflevector(x, x, 4, 5, 6, 7))
#define PG8_MMA(ai, bj, At, Bt) do { __builtin_amdgcn_s_setprio(1); \
        if (F8ALL) { _Pragma("unroll") for (int m = 0; m < 4; ++m) _Pragma("unroll") for (int n = 0; n < 2; ++n) \
            asm volatile("v_mfma_scale_f32_16x16x128_f8f6f4 %0, %1, %2, %0, %3, %3 op_sel_hi:[0,0,0]" : "+v"(acc[ai][bj][m][n]) : "v"(Bt[n]), "v"(At[m]), "v"(f8sc)); } \
        else { _Pragma("unroll") for (int m = 0; m < 4; ++m) _Pragma("unroll") for (int n = 0; n < 2; ++n) { \
            acc[ai][bj][m][n] = __builtin_amdgcn_mfma_f32_16x16x32_bf16(PG8_LO(Bt[n]), PG8_LO(At[m]), acc[ai][bj][m][n], 0, 0, 0); \
            acc[ai][bj][m][n] = __builtin_amdgcn_mfma_f32_16x16x32_bf16(PG8_HI(Bt[n]), PG8_HI(At[m]), acc[ai][bj][m][n], 0, 0, 0); } } \
        __builtin_amdgcn_s_setprio(0); } while (0)
#define PG8_WAIT_V(n) asm volatile("s_waitcnt vmcnt(" #n ")" ::: "memory")
#define PG8_WAIT_L(n) asm volatile("s_waitcnt lgkmcnt(" #n ")" ::: "memory")
#define PG8_BAR __builtin_amdgcn_s_barrier()
#define PG8_SCHED __builtin_amdgcn_sched_barrier(0)
    Unit cur, nxt; int ui = 0;
    if (!S.next(0, cur)) return;
    f32x4 acc[2][2][4][2];
#pragma unroll
    for (int a = 0; a < 2; ++a)
#pragma unroll
        for (int b = 0; b < 2; ++b)
#pragma unroll
            for (int m = 0; m < 4; ++m)
#pragma unroll
                for (int n = 0; n < 2; ++n) acc[a][b][m][n] = (f32x4){0.f, 0.f, 0.f, 0.f};
    v8i At[4], B0[2], B1[2];
    int f8sc = 0x7c7c7c7c; asm volatile("" : "+v"(f8sc));
    int Kc = S.K(cur), Kn; const char* Ac = S.a_base(cur); const char* An; const char* cB = S.b_ptr(cur); const char* nB;
    unsigned oc00, oc01, oc10, oc11, on00, on01, on10, on11, vbc0, vbc1, vbn0, vbn1; size_t hsc, hsn;
    { PG8_RC()
    oc00 = S.a_off(cur, RA[0], CA[0]); oc01 = S.a_off(cur, RA[1], CA[1]); oc10 = S.a_off(cur, HALF + RA[0], CA[0]); oc11 = S.a_off(cur, HALF + RA[1], CA[1]);
    vbc0 = (unsigned)(RB[0] * Kc + CA[0]) * 2u; vbc1 = (unsigned)(RB[1] * Kc + CA[1]) * 2u; hsc = (size_t)HALF * Kc * 2; }
    S.a_ready(cur);
    PG8_STAGE2(PG8_SB(0, 0), cB, vbc0, vbc1); PG8_STAGE2(PG8_SB(0, 1), cB + hsc, vbc0, vbc1); PG8_STAGE2(PG8_SA(0, 0), Ac, oc00, oc01); PG8_STAGE2(PG8_SA(0, 1), Ac, oc10, oc11);
    if (wr == 1) PG8_BAR;
    PG8_WAIT_V(2); PG8_BAR;
    PG8_STAGE2(PG8_SB(1, 0), cB + kstep, vbc0, vbc1); PG8_STAGE2(PG8_SA(1, 0), Ac + kstep, oc00, oc01); PG8_STAGE2(PG8_SB(1, 1), cB + hsc + kstep, vbc0, vbc1);
    PG8_WAIT_V(6); PG8_BAR;
    for (;;) {
        const bool has_next = S.next(ui + 1, nxt);
        Kn = Kc; An = Ac; nB = cB; on00 = oc00; on01 = oc01; on10 = oc10; on11 = oc11; vbn0 = vbc0; vbn1 = vbc1; hsn = hsc;
        if (has_next) { Kn = S.K(nxt); An = S.a_base(nxt); nB = S.b_ptr(nxt); PG8_RC()
            on00 = S.a_off(nxt, RA[0], CA[0]); on01 = S.a_off(nxt, RA[1], CA[1]); on10 = S.a_off(nxt, HALF + RA[0], CA[0]); on11 = S.a_off(nxt, HALF + RA[1], CA[1]);
            vbn0 = (unsigned)(RB[0] * Kn + CA[0]) * 2u; vbn1 = (unsigned)(RB[1] * Kn + CA[1]) * 2u; hsn = (size_t)HALF * Kn * 2; }
        const int nt = Kc / BK;
#pragma clang loop unroll(disable)
        for (int t = 0; t < nt; t += 2) {
            const bool last = (t == nt - 2);
            if (last && has_next) S.a_ready(nxt);
            const char* a1 = Ac + (size_t)(t + 1) * kstep;
            const char* a2 = last ? An : Ac + (size_t)(t + 2) * kstep; const char* b2 = last ? nB : cB + (size_t)(t + 2) * kstep;
            const char* a3 = a2 + kstep; const char* b3 = b2 + kstep;
            const unsigned x00 = last ? on00 : oc00, x01 = last ? on01 : oc01, x10 = last ? on10 : oc10, x11 = last ? on11 : oc11;
            const unsigned y0 = last ? vbn0 : vbc0, y1 = last ? vbn1 : vbc1; const size_t hs2 = last ? hsn : hsc;
            PG8_LDB(B0, 0, 0); PG8_LDB(B1, 0, 1); PG8_SCHED; PG8_LDA(At, 0, 0); PG8_STAGE2(PG8_SA(1, 1), a1, oc10, oc11);
            PG8_WAIT_V(8); PG8_WAIT_L(0); PG8_BAR; PG8_MMA(0, 0, At, B0); PG8_MMA(0, 1, At, B1); PG8_BAR; PG8_SCHED;
            PG8_LDA(At, 0, 1); PG8_STAGE2(PG8_SB(0, 0), b2, y0, y1); PG8_STAGE2(PG8_SB(0, 1), b2 + hs2, y0, y1); PG8_STAGE2(PG8_SA(0, 0), a2, x00, x01);
            PG8_WAIT_V(8); PG8_WAIT_L(0); PG8_BAR; PG8_MMA(1, 0, At, B0); PG8_MMA(1, 1, At, B1); PG8_BAR; PG8_SCHED;
            PG8_LDB(B0, 1, 0); PG8_LDB(B1, 1, 1); PG8_SCHED; PG8_LDA(At, 1, 0); PG8_STAGE2(PG8_SA(0, 1), a2, x10, x11);
            PG8_WAIT_V(8); PG8_WAIT_L(0); PG8_BAR; PG8_MMA(0, 0, At, B0); PG8_MMA(0, 1, At, B1); PG8_BAR; PG8_SCHED;
            PG8_LDA(At, 1, 1); PG8_STAGE2(PG8_SB(1, 0), b3, y0, y1); PG8_STAGE2(PG8_SB(1, 1), b3 + hs2, y0, y1); PG8_STAGE2(PG8_SA(1, 0), a3, x00, x01);
            PG8_WAIT_V(8); PG8_WAIT_L(0); PG8_BAR; PG8_MMA(1, 0, At, B0); PG8_MMA(1, 1, At, B1); PG8_BAR; PG8_SCHED;
        }
        if (wr == 0) PG8_BAR;
        if (F8ALL) asm volatile("s_nop 15\n\ts_nop 15" ::: "memory");
        E(acc, cur, wr, wc, fr, fq);
        if (!has_next) break;
#pragma unroll
        for (int a = 0; a < 2; ++a)
#pragma unroll
            for (int b = 0; b < 2; ++b)
#pragma unroll
                for (int m = 0; m < 4; ++m)
#pragma unroll
                    for (int n = 0; n < 2; ++n) acc[a][b][m][n] = (f32x4){0.f, 0.f, 0.f, 0.f};
        cur = nxt; Kc = Kn; Ac = An; cB = nB; oc00 = on00; oc01 = on01; oc10 = on10; oc11 = on11; vbc0 = vbn0; vbc1 = vbn1; hsc = hsn; ++ui;
        if (wr == 1) PG8_BAR;
    }
    PG8_WAIT_V(0);
    PG8_BAR;
#undef PG8_RC
#undef PG8_SA
#undef PG8_SB
#undef PG8_STAGE2
#undef PG8_LDA
#undef PG8_LD8
#undef PG8_LO
#undef PG8_HI
#undef PG8_LDB
#undef PG8_MMA
#undef PG8_WAIT_V
#undef PG8_WAIT_L
#undef PG8_BAR
#undef PG8_SCHED
}
}

__device__ __forceinline__ void store16_wt(void* p, v4u v) { asm volatile("global_store_dwordx4 %0, %1, off sc1\n\ts_nop 1" :: "v"(p), "v"(v) : "memory"); }
__device__ __forceinline__ int krow_of(int r) {
    if (r < T) return (r >> 12) * KVROWS + LCTX + (r & 4095);
    const int rc = r - T; return (rc >> 8) * KVROWS + (rc & 255);
}
struct SchedPlain {
    int nM, nN, G, vcu, Kk; const char* A; const char* B;
    __device__ __forceinline__ bool next(int i, pg8::Unit& u) const { const int L = i * G + vcu; if (L >= nM * nN) return false; u.pm = L / nN; u.pn = L % nN; u.e = 0; u.cnt = 256; u.kind = 0; return true; }
    __device__ __forceinline__ int K(const pg8::Unit&) const { return Kk; }
    __device__ __forceinline__ const char* a_base(const pg8::Unit&) const { return A; }
    __device__ __forceinline__ unsigned a_off(const pg8::Unit& u, int row, int col) const { return (unsigned)((u.pm * 256 + row) * Kk + col) * 2u; }
    __device__ __forceinline__ const char* b_ptr(const pg8::Unit& u) const { return B + (size_t)u.pn * 256 * Kk * 2; }
    __device__ __forceinline__ void a_ready(const pg8::Unit&) const {}
};
struct SchedG1 {
    int G, vcu, f8, lyr; const char* A; const char* B;
    __device__ __forceinline__ bool next(int i, pg8::Unit& u) const {
        const int nb16 = lyr ? T / 256 : TT / 256;
        u.e = 0; u.cnt = 256; u.kind = 0;
        if (!f8) { if (i > 0 || vcu >= nb16) return false; u.pm = vcu; u.pn = 0; return true; }
        const int nW = G - nb16; if (vcu < nb16) return false;
        const int L = i * nW + (vcu - nb16); const int nlat = (T / 256) * 5; const int ntot = nlat + (lyr ? 4 : 20);
        if (L >= ntot) return false;
        if (L < nlat) { u.pm = L / 5; u.pn = 1 + L % 5; }
        else if (lyr) { u.pm = T / 256 + (L - nlat); u.pn = 3; }
        else { u.pm = T / 256 + (L - nlat) / 5; u.pn = 1 + (L - nlat) % 5; }
        return true; }
    __device__ __forceinline__ int K(const pg8::Unit&) const { return f8 ? 512 : 1024; }
    __device__ __forceinline__ const char* a_base(const pg8::Unit&) const { return A; }
    __device__ __forceinline__ unsigned a_off(const pg8::Unit& u, int row, int col) const { return (unsigned)((u.pm * 256 + row) * (f8 ? 512 : 1024) + col) * 2u; }
    __device__ __forceinline__ const char* b_ptr(const pg8::Unit& u) const { return f8 ? B + (size_t)(u.pn - 1) * 256 * 1024 : B + (size_t)u.pn * 256 * 1024 * 2; }
    __device__ __forceinline__ void a_ready(const pg8::Unit&) const {}
};
struct EpiG1 {
    static constexpr bool PERM = true;
    bf16 *pu, *q, *kall, *vall, *z;
    __device__ __forceinline__ void operator()(const f32x4 (&acc)[2][2][4][2], const pg8::Unit& u, int wr, int wc, int fr, int fq) const {
        const int row0 = u.pm * 256 + wr * 64 + fr, c8 = wc * 32 + 8 * fq;
#pragma unroll
        for (int ai = 0; ai < 2; ++ai)
#pragma unroll
            for (int m = 0; m < 4; ++m) {
                const int row = row0 + ai * 128 + m * 16;
#pragma unroll
                for (int bj = 0; bj < 2; ++bj) {
                    const f32x4 v0 = acc[ai][bj][m][0], v1 = acc[ai][bj][m][1];
                    v4u w; w.x = pk2(v0[0], v0[1]); w.y = pk2(v0[2], v0[3]); w.z = pk2(v1[0], v1[1]); w.w = pk2(v1[2], v1[3]);
                    bf16* dst;
                    if (u.pn == 0) dst = pu + (size_t)row * 256 + bj * 128 + c8;
                    else if (u.pn <= 2) dst = q + (size_t)row * 512 + (u.pn - 1) * 256 + bj * 128 + c8;
                    else if (u.pn == 3) dst = (bj == 0 ? kall : vall) + (size_t)krow_of(row) * 128 + c8;
                    else dst = z + (size_t)row * 512 + (u.pn - 4) * 256 + bj * 128 + c8;
                    *(v4u*)dst = w;
                }
            }
    }
};
template <bool BB> struct EpiG2 {
    static constexpr bool PERM = true;
    const float* xin; const float* cin; bf16* xs; const float* mod; unsigned* ready;
    __device__ __forceinline__ void operator()(const f32x4 (&acc)[2][2][4][2], const pg8::Unit& u, int wr, int wc, int fr, int fq) const {
        const int rt0 = u.pm * 256; const bool isc = rt0 >= T;
        const int bsel = isc ? 4 : (rt0 >> 12);
        const float* g1 = mod + bsel * 6144 + 2048;
        const float* base = isc ? cin - (size_t)T * 1024 : xin;
        const int row0 = rt0 + wr * 64 + fr, c8 = u.pn * 256 + wc * 32 + 8 * fq;
#pragma unroll
        for (int bj = 0; bj < 2; ++bj) {
            const int col = c8 + bj * 128; const f32x4 ga = *(const f32x4*)(g1 + col), gb = *(const f32x4*)(g1 + col + 4);
            if (BB) {
                v4u b[2][4];
#pragma unroll
                for (int ai = 0; ai < 2; ++ai)
#pragma unroll
                    for (int m = 0; m < 4; ++m) b[ai][m] = *(const v4u*)(xs + (size_t)(row0 + ai * 128 + m * 16) * 1024 + col);
#pragma unroll
                for (int ai = 0; ai < 2; ++ai)
#pragma unroll
                    for (int m = 0; m < 4; ++m) { const v4u w = b[ai][m]; const f32x4 a0 = acc[ai][bj][m][0], a1 = acc[ai][bj][m][1];
                        v4u o; o.x = pk2(bflo(w.x) + ga[0] * a0[0], bfhi(w.x) + ga[1] * a0[1]); o.y = pk2(bflo(w.y) + ga[2] * a0[2], bfhi(w.y) + ga[3] * a0[3]);
                        o.z = pk2(bflo(w.z) + gb[0] * a1[0], bfhi(w.z) + gb[1] * a1[1]); o.w = pk2(bflo(w.w) + gb[2] * a1[2], bfhi(w.w) + gb[3] * a1[3]);
                        store16_wt(xs + (size_t)(row0 + ai * 128 + m * 16) * 1024 + col, o); }
            } else {
#pragma unroll
                for (int ai = 0; ai < 2; ++ai) {
                    f32x4 b0[4], b1[4];
#pragma unroll
                    for (int m = 0; m < 4; ++m) { const float* bp = base + (size_t)(row0 + ai * 128 + m * 16) * 1024 + col; b0[m] = *(const f32x4*)bp; b1[m] = *(const f32x4*)(bp + 4); }
#pragma unroll
                    for (int m = 0; m < 4; ++m) { const f32x4 x0 = b0[m] + ga * acc[ai][bj][m][0], x1 = b1[m] + gb * acc[ai][bj][m][1];
                        v4u o; o.x = pk2(x0[0], x0[1]); o.y = pk2(x0[2], x0[3]); o.z = pk2(x1[0], x1[1]); o.w = pk2(x1[2], x1[3]);
                        store16_wt(xs + (size_t)(row0 + ai * 128 + m * 16) * 1024 + col, o); }
                }
            }
        }
        asm volatile("s_waitcnt vmcnt(0)" ::: "memory");
        if ((threadIdx.x & 63) == 0) __hip_atomic_fetch_add(ready + 16 * u.pm, 1u, __ATOMIC_RELAXED, __HIP_MEMORY_SCOPE_AGENT);
    }
};
struct SchedMoe {
    int G, vcu, ntile;
    const char* hb; const char* actb; const char* wgu; const char* wd; const unsigned* list; const LAS int* tt; unsigned* ready; unsigned* tmo;
    __device__ __forceinline__ bool next(int i, pg8::Unit& u) const {
        const int U = ntile * 4; const int r = U % G, q = U / G; const int n3 = q + (vcu < r ? 1 : 0); int L;
        if (i < n3) { L = i * G + vcu; u.kind = 0; }
        else { const int j = i - n3; const int nl = G - r;
            if (vcu >= r) L = (j == 0) ? (vcu - r) : (j == 1) ? nl + (vcu - r) : 2 * nl + (j - 2) * G + vcu;
            else L = 2 * nl + j * G + vcu;
            if (L >= U) return false; u.kind = 1; }
        const int tau = L >> 2; u.pn = L & 3; u.pm = tau; int e = 0;
#pragma unroll
        for (int k = 1; k < 16; ++k) e += (tt[k] <= tau) ? 1 : 0;
        u.e = e; const int r0 = (tau - tt[e]) * 256; const int c = tt[17 + e] - r0; u.cnt = c < 256 ? c : 256; return true;
    }
    __device__ __forceinline__ int K(const pg8::Unit& u) const { return u.kind ? 256 : 512; }
    __device__ __forceinline__ const char* a_base(const pg8::Unit& u) const { return u.kind ? actb : hb; }
    __device__ __forceinline__ unsigned a_off(const pg8::Unit& u, int row, int col) const {
        if (u.kind) return (unsigned)((u.pm * 256 + row) * 256 + col) * 2u;
        const int r0 = (u.pm - tt[u.e]) * 256; const int rr = row < u.cnt ? row : u.cnt - 1;
        const unsigned tok = list[(size_t)u.e * TT + r0 + rr] >> 1;
        return (tok * 512u + (unsigned)col) * 2u;
    }
    __device__ __forceinline__ const char* b_ptr(const pg8::Unit& u) const { return u.kind ? wd + ((size_t)u.e * 1024 + (size_t)u.pn * 256) * 256 * 2 : wgu + ((size_t)u.e * 1024 + (size_t)u.pn * 256) * 512 * 2; }
    __device__ __forceinline__ void a_ready(const pg8::Unit& u) const {
        if (!u.kind) return;
        if (threadIdx.x < 64) {
            unsigned* w = ready + 16 * u.pm; unsigned sp = 0;
            while ((unsigned)__builtin_amdgcn_readfirstlane(__hip_atomic_load(w, __ATOMIC_RELAXED, __HIP_MEMORY_SCOPE_AGENT)) < 32u) {
                __builtin_amdgcn_s_sleep(2);
                if (++sp > (1u << 22)) { if (threadIdx.x == 0) __hip_atomic_store(tmo, 1u, __ATOMIC_RELAXED, __HIP_MEMORY_SCOPE_AGENT); break; } }
            __builtin_amdgcn_fence(__ATOMIC_ACQUIRE, "agent");
            asm volatile("s_waitcnt vmcnt(0)" ::: "memory");
        }
        asm volatile("" ::: "memory"); __builtin_amdgcn_s_barrier(); asm volatile("" ::: "memory");
    }
};
struct EpiG3 {
    static constexpr bool PERM = true;
    bf16* act; unsigned* ready;
    __device__ __forceinline__ void operator()(const f32x4 (&acc)[2][2][4][2], const pg8::Unit& u, int wr, int wc, int fr, int fq) const {
        const int row0 = u.pm * 256 + wr * 64 + fr, c8 = u.pn * 128 + wc * 32 + 8 * fq;
#pragma unroll
        for (int ai = 0; ai < 2; ++ai)
#pragma unroll
            for (int m = 0; m < 4; ++m) {
                float a[8];
#pragma unroll
                for (int n = 0; n < 2; ++n)
#pragma unroll
                    for (int k = 0; k < 4; ++k) { const float g = acc[ai][0][m][n][k], up = acc[ai][1][m][n][k]; a[n * 4 + k] = g * __builtin_amdgcn_rcpf(1.f + __builtin_amdgcn_exp2f(-LOG2E * g)) * up; }
                const unsigned long long w8 = (unsigned long long)pk4_f8(a[0], a[1], a[2], a[3]) | ((unsigned long long)pk4_f8(a[4], a[5], a[6], a[7]) << 32);
                __hip_atomic_store((unsigned long long*)((unsigned char*)act + (size_t)(row0 + ai * 128 + m * 16) * 512 + c8), w8, __ATOMIC_RELAXED, __HIP_MEMORY_SCOPE_AGENT);
            }
        asm volatile("s_waitcnt vmcnt(0)" ::: "memory");
        if ((threadIdx.x & 63) == 0) __hip_atomic_fetch_add(ready + 16 * u.pm, 1u, __ATOMIC_RELAXED, __HIP_MEMORY_SCOPE_AGENT);
    }
};
struct EpiG4 {
    static constexpr bool PERM = true;
    unsigned char* y2; const unsigned* list; const float* wts; const LAS int* tt;
    __device__ __forceinline__ void operator()(const f32x4 (&acc)[2][2][4][2], const pg8::Unit& u, int wr, int wc, int fr, int fq) const {
        const int r0 = (u.pm - tt[u.e]) * 256; const int c8 = u.pn * 256 + wc * 32 + 8 * fq;
        unsigned ent[2][4]; float w[2][4];
#pragma unroll
        for (int ai = 0; ai < 2; ++ai)
#pragma unroll
            for (int m = 0; m < 4; ++m) { const int row = wr * 64 + fr + ai * 128 + m * 16; ent[ai][m] = list[(size_t)u.e * TT + r0 + (row < u.cnt ? row : u.cnt - 1)]; }
#pragma unroll
        for (int ai = 0; ai < 2; ++ai)
#pragma unroll
            for (int m = 0; m < 4; ++m) w[ai][m] = wts[ent[ai][m]] * Y2SC;
#pragma unroll
        for (int ai = 0; ai < 2; ++ai)
#pragma unroll
            for (int m = 0; m < 4; ++m) {
                const int row = wr * 64 + fr + ai * 128 + m * 16;
                if (row < u.cnt) {
#pragma unroll
                    for (int bj = 0; bj < 2; ++bj) {
                        const f32x4 v0 = acc[ai][bj][m][0] * w[ai][m], v1 = acc[ai][bj][m][1] * w[ai][m];
                        v2u o; o.x = pk4_f8(v0[0], v0[1], v0[2], v0[3]); o.y = pk4_f8(v1[0], v1[1], v1[2], v1[3]);
                        *(v2u*)(y2 + (size_t)ent[ai][m] * 1024 + bj * 128 + c8) = o;
                    }
                }
            }
    }
};

struct EpiMoe { static constexpr bool PERM = true; EpiG3 e3; EpiG4 e4;
    __device__ __forceinline__ void operator()(const f32x4 (&acc)[2][2][4][2], const pg8::Unit& u, int wr, int wc, int fr, int fq) const { if (u.kind) e4(acc, u, wr, wc, fr, fq); else e3(acc, u, wr, wc, fr, fq); } };

#include <hip/hip_bf16.h>
#include <cmath>
namespace attn_body {
using bf16=__hip_bfloat16;
using bf16x8=__attribute__((ext_vector_type(8)))short;
using s16x4=__attribute__((ext_vector_type(4)))short;
using f32x16=__attribute__((ext_vector_type(16)))float;
using u32x4=__attribute__((ext_vector_type(4)))unsigned;
constexpr int D=64,QP=512,KVP=128,OP=1024;
constexpr int NW=8,QBLK=32,KVBLK=64;
__device__ __forceinline__ int crow(int r,int hi){return (r&3)+8*(r>>2)+4*hi;}
#define SBAR() __builtin_amdgcn_sched_barrier(0)
__device__ __forceinline__ void wmask(f32x16&p0,f32x16&p1,int kp0,int qpos,int hi){
  const float NEG=-INFINITY; const bool tile_ok=(unsigned)kp0<4096u; const int base=kp0+4*hi-qpos+128;
  #pragma unroll
  for(int r=0;r<16;++r){const int dd=base+(r&3)+8*(r>>2); if(!tile_ok||(unsigned)dd>256u)p0[r]=NEG; if(!tile_ok||(unsigned)(dd+32)>256u)p1[r]=NEG;}
}
constexpr int NSLOT=3, SLOTB=8192;
constexpr int LDS_K=0, LDS_V=NSLOT*SLOTB, LDS_WS=2*NSLOT*SLOTB, LDS_OST=LDS_WS+NW*64*4, LDS_BYTES=LDS_OST+NW*4096;
constexpr float C2=0.125f*1.4426950408889634f;
__device__ __forceinline__ void glds16(const void*gsrc,unsigned lds_dst){unsigned keep;
  asm volatile("s_mov_b32 %0, m0\n\ts_mov_b32 m0, %2\n\ts_nop 0\n\tglobal_load_lds_dwordx4 %1, off\n\ts_mov_b32 m0, %0":"=&s"(keep):"v"(gsrc),"s"(lds_dst):"memory");}
__device__ __forceinline__ float max3f(float a,float b,float c){float r;asm("v_max3_f32 %0, %1, %2, %3":"=v"(r):"v"(a),"v"(b),"v"(c));return r;}
__device__ __forceinline__ float max2f(float a,float b){float r;asm("v_max_f32_e32 %0, %1, %2":"=v"(r):"v"(a),"v"(b));return r;}
__device__ __forceinline__ float fadd_s(float a,float b){float r;asm("v_add_f32_e32 %0, %1, %2":"=v"(r):"v"(a),"v"(b));return r;}
__device__ __forceinline__ float fsub_s(float a,float b){float r;asm("v_sub_f32_e32 %0, %1, %2":"=v"(r):"v"(a),"v"(b));return r;}
typedef float f32x2_t __attribute__((ext_vector_type(2))); typedef __bf16 bf16x2_t __attribute__((ext_vector_type(2)));
__device__ __forceinline__ unsigned cvtpk_s(float lo,float hi){f32x2_t v={lo,hi};bf16x2_t b=__builtin_convertvector(v,bf16x2_t);return __builtin_bit_cast(unsigned,b);}
#define WAIT_BAR(N) asm volatile("s_waitcnt vmcnt(" #N ") lgkmcnt(0)\n\ts_barrier":::"memory")

__device__ __forceinline__ void qkt(f32x16&p0,f32x16&p1,const char*Kslot,const bf16x8*qr,const f32x16&negm,int r32,int hi){
  const char*kb=Kslot+hi*1024+r32*16;
  #pragma unroll
  for(int d0=0;d0<4;++d0){
    const bf16x8 b0=*reinterpret_cast<const bf16x8*>(kb+d0*2048);
    const bf16x8 b1=*reinterpret_cast<const bf16x8*>(kb+d0*2048+512);
    if(d0==0){p0=__builtin_amdgcn_mfma_f32_32x32x16_bf16(b0,qr[0],negm,0,0,0);p1=__builtin_amdgcn_mfma_f32_32x32x16_bf16(b1,qr[0],negm,0,0,0);}
    else{p0=__builtin_amdgcn_mfma_f32_32x32x16_bf16(b0,qr[d0],p0,0,0,0);p1=__builtin_amdgcn_mfma_f32_32x32x16_bf16(b1,qr[d0],p1,0,0,0);}}
}
typedef __attribute__((address_space(3))) const char* lds_cptr;
typedef short v4i16_t __attribute__((ext_vector_type(4)));
__device__ __forceinline__ void kload8(bf16x8*kf,lds_cptr kp){
  kf[0]=*(const __attribute__((address_space(3))) bf16x8*)(kp);      kf[1]=*(const __attribute__((address_space(3))) bf16x8*)(kp+512);
  kf[2]=*(const __attribute__((address_space(3))) bf16x8*)(kp+2048); kf[3]=*(const __attribute__((address_space(3))) bf16x8*)(kp+2560);
  kf[4]=*(const __attribute__((address_space(3))) bf16x8*)(kp+4096); kf[5]=*(const __attribute__((address_space(3))) bf16x8*)(kp+4608);
  kf[6]=*(const __attribute__((address_space(3))) bf16x8*)(kp+6144); kf[7]=*(const __attribute__((address_space(3))) bf16x8*)(kp+6656);
}
__device__ __forceinline__ void kload2(bf16x8*kf,lds_cptr kp,int j){ kf[2*j]=*(const __attribute__((address_space(3))) bf16x8*)(kp+j*2048); kf[2*j+1]=*(const __attribute__((address_space(3))) bf16x8*)(kp+j*2048+512); }
__device__ __forceinline__ s16x4 vtr(lds_cptr p){ return __builtin_bit_cast(s16x4,__builtin_amdgcn_ds_read_tr16_b64_v4i16((__attribute__((address_space(3))) v4i16_t*)p)); }
__device__ __forceinline__ float rowmax(const f32x16&p0,const f32x16&p1){
  float a=max3f(p0[0],p0[1],p1[0]),b=max3f(p0[2],p0[3],p1[1]);a=max3f(a,p1[2],p1[3]);
  #pragma unroll
  for(int r=4;r<16;r+=4){a=max3f(a,p0[r],p0[r+1]);b=max3f(b,p0[r+2],p0[r+3]);a=max3f(a,p1[r],p1[r+1]);b=max3f(b,p1[r+2],p1[r+3]);}
  const float m=max2f(a,b);
  auto rr=__builtin_amdgcn_permlane32_swap(__float_as_uint(m),__float_as_uint(m),false,false);
  return max2f(__uint_as_float(rr[0]),__uint_as_float(rr[1]));
}
__device__ __forceinline__ void pv(f32x16*o,int vb,bf16x8 pa0,bf16x8 pa1,bf16x8 pa2,bf16x8 pa3){
  #pragma unroll
  for(int d0=0;d0<2;++d0){s16x4 lo[4],hi[4];
    #pragma unroll
    for(int ks=0;ks<4;++ks){
      asm volatile("ds_read_b64_tr_b16 %0,%1 offset:%c2":"=&v"(lo[ks]):"v"(vb),"i"(d0*4096+ks*1024):"memory");
      asm volatile("ds_read_b64_tr_b16 %0,%1 offset:%c2":"=&v"(hi[ks]):"v"(vb),"i"(d0*4096+ks*1024+512):"memory");}
    asm volatile("s_waitcnt lgkmcnt(0)":::"memory");SBAR();
    #define PK(k) (bf16x8){lo[k][0],lo[k][1],lo[k][2],lo[k][3],hi[k][0],hi[k][1],hi[k][2],hi[k][3]}
    o[d0]=__builtin_amdgcn_mfma_f32_32x32x16_bf16(pa0,PK(0),o[d0],0,0,0);
    o[d0]=__builtin_amdgcn_mfma_f32_32x32x16_bf16(pa1,PK(1),o[d0],0,0,0);
    o[d0]=__builtin_amdgcn_mfma_f32_32x32x16_bf16(pa2,PK(2),o[d0],0,0,0);
    o[d0]=__builtin_amdgcn_mfma_f32_32x32x16_bf16(pa3,PK(3),o[d0],0,0,0);
    #undef PK
  }
}

#ifndef ATTN_STORE16
#define ATTN_STORE16(p,v) (*(u32x4*)(p)=(v))
#endif
template<int THRL> __device__ __forceinline__ void attn_unit(const bf16*Qu,const bf16*__restrict__ Kh,const bf16*__restrict__ Vh,bf16*Ou,const int p0,const int NT,const float* sinkp,const float* qg,const float2* ropet,char*shm){
  int tid=threadIdx.x; asm volatile("":"+v"(tid)); const int lane=tid&63,r32=lane&31,hi=lane>>5; const int wid=__builtin_amdgcn_readfirstlane(tid>>6);
  const int hsub=wid>>1, psub=(wid&1)*QBLK;
  const bf16*Qw=Qu+(long)psub*QP+hsub*D;
  const unsigned lds0=(unsigned)(uintptr_t)shm;
  float*wsf=(float*)(shm+LDS_WS)+wid*64;
  const bf16*ksrc=Kh+(long)lane*KVP+wid*8;
  const bf16*vsrc=Vh+(long)(16*(wid&3)+(lane>>2))*KVP+(wid>>2)*32+(lane&3)*8;
  const unsigned kdst=lds0+LDS_K+wid*1024, vdst=lds0+LDS_V+wid*1024;
  #define KP0(t) (p0-128+64*((t)-4))
  #define TROW(t) ((t)<4?64*(t):(((unsigned)KP0(t)<4096u)?256+KP0(t):256))
  #define DMA_K(t,slot) glds16(ksrc+(long)TROW(t)*KVP,(unsigned)__builtin_amdgcn_readfirstlane(kdst+(slot)))
  #define DMA_V(t,slot) glds16(vsrc+(long)TROW(t)*KVP,(unsigned)__builtin_amdgcn_readfirstlane(vdst+(slot)))
  const int vb0=(int)(lds0+LDS_V)+((lane>>4)&1)*32+(lane&3)*8+(4*hi+((lane&15)>>2))*64;
  const char*Kbase=shm+LDS_K; bf16x8 kf[8];
  const lds_cptr shm3=(lds_cptr)shm; const lds_cptr kp0=shm3+LDS_K+hi*1024+r32*16; const lds_cptr vp0=shm3+LDS_V+((lane>>4)&1)*32+(lane&3)*8+(4*hi+((lane&15)>>2))*64;
  DMA_K(0,0);DMA_V(0,0);DMA_K(1,SLOTB);
  bf16x8 qr[4];
  { bf16x8 qraw[4];
    #pragma unroll
    for(int d0=0;d0<4;++d0)qraw[d0]=*reinterpret_cast<const bf16x8*>(&Qw[(long)r32*QP+d0*16+hi*8]);
    float qf[4][8]; float ss=0.f;
    #pragma unroll
    for(int d0=0;d0<4;++d0)
      #pragma unroll
      for(int j=0;j<8;++j){ qf[d0][j]=__builtin_bit_cast(float,(unsigned)(unsigned short)qraw[d0][j]<<16); ss+=qf[d0][j]*qf[d0][j]; }
    ss+=__shfl_xor(ss,32);
    const float rstd=1.0f/sqrtf(ss*(1.f/64.f)+1e-6f)*C2;
    #pragma unroll
    for(int d0=0;d0<4;++d0)
      #pragma unroll
      for(int j=0;j<8;++j) qf[d0][j]*=rstd*qg[16*d0+8*hi+j];
    if(ropet){ const float2* rp=ropet+(long)(p0+psub+r32)*32+8*hi;
      #pragma unroll
      for(int j=0;j<8;++j){ const float2 c1=rp[j],c2=rp[16+j];
        const float a=qf[0][j],b=qf[1][j],c=qf[2][j],d=qf[3][j];
        qf[0][j]=a*c1.x-b*c1.y; qf[1][j]=b*c1.x+a*c1.y; qf[2][j]=c*c2.x-d*c2.y; qf[3][j]=d*c2.x+c*c2.y; } }
    #pragma unroll
    for(int d0=0;d0<4;++d0){ u32x4 w; w[0]=cvtpk_s(qf[d0][0],qf[d0][1]); w[1]=cvtpk_s(qf[d0][2],qf[d0][3]); w[2]=cvtpk_s(qf[d0][4],qf[d0][5]); w[3]=cvtpk_s(qf[d0][6],qf[d0][7]); qr[d0]=__builtin_bit_cast(bf16x8,w); } }
  float mhat=0.f,l_reg=0.f;f32x16 o[2];o[0]=f32x16{};o[1]=f32x16{};f32x16 negm=f32x16{};asm volatile("":"+v"(negm));
  const int qpos=p0+psub+r32;
  #define CMASK(P0,P1,t) do{ if((t)>=4)wmask(P0,P1,KP0(t),qpos,hi); }while(0)
  bool resc=false;
  #define START(P0,P1) do{ const float rm=rowmax(P0,P1); resc=false; \
    { const float dl=rm; mhat=fadd_s(mhat,dl); \
      _Pragma("unroll") for(int r=0;r<16;++r){P0[r]=fsub_s(P0[r],dl);P1[r]=fsub_s(P1[r],dl);} \
      _Pragma("unroll") for(int r=0;r<16;++r)negm[r]=-mhat; asm volatile("":"+v"(negm)); } \
    _Pragma("unroll") for(int r=0;r<16;++r)P0[r]=__builtin_amdgcn_exp2f(P0[r]); }while(0)
  #define RESC() do{ if(resc){ asm volatile("s_waitcnt lgkmcnt(0)":::"memory"); \
      _Pragma("unroll") for(int d_=0;d_<2;++d_) _Pragma("unroll") for(int r=0;r<16;++r)o[d_][r]*=wsf[crow(r,hi)]; } }while(0)
  f32x16 pA0,pA1,pB0,pB1;
  int sl_prev=0,sl_cur=0,sl_next=SLOTB;
  #define ROT() do{sl_prev=sl_cur;sl_cur=sl_next;sl_next=(sl_next==(NSLOT-1)*SLOTB)?0:sl_next+SLOTB;}while(0)
  DMA_K(2,2*SLOTB);
  WAIT_BAR(3);
  qkt(pA0,pA1,Kbase,qr,negm,r32,hi);asm volatile("s_nop 15\n\ts_nop 7":"+v"(pA0),"+v"(pA1));CMASK(pA0,pA1,0);
  START(pA0,pA1);
  _Pragma("unroll") for(int r=0;r<16;++r)pA1[r]=__builtin_amdgcn_exp2f(pA1[r]);
  WAIT_BAR(0);
  DMA_K(3,0);DMA_V(1,SLOTB);
  ROT();
  kload8(kf,kp0+sl_cur);
  WAIT_BAR(2);
  s16x4 vlo[8],vhi[8]; u32x4 pw0,pw1,pw2,pw3;
  #define PKW(P,B) cvtpk_s(P[B],P[B+1])
  #define PAF(k) __builtin_bit_cast(bf16x8,pw##k)
  #define VFR(i) (bf16x8){vlo[i][0],vlo[i][1],vlo[i][2],vlo[i][3],vhi[i][0],vhi[i][1],vhi[i][2],vhi[i][3]}
  #define PIN(x) asm volatile("":"+v"(x))
  #define MX3(a,b,c) __builtin_fmaxf(__builtin_fmaxf((a),(b)),(c))
  #define GAPA(MF,A0,A1,A2,A3,W0,W1,PW) do{ MF; sacc+=A0; sacc+=A1; sacc+=A2; sacc+=A3; PIN(sacc); W0; W1; PIN(PW); SBAR(); }while(0)
  #define EX(v) __builtin_amdgcn_exp2f(v)
  #define GAPB(MF,X,B) do{ MF; X[B]=EX(X[B]); X[B+1]=EX(X[B+1]); X[B+2]=EX(X[B+2]); X[B+3]=EX(X[B+3]); PIN(X); SBAR(); }while(0)
  #define VRD(i) do{ vlo[i]=vtr(vp_+(((i)>>2)*4096+((i)&3)*1024)); vhi[i]=vtr(vp_+(((i)>>2)*4096+((i)&3)*1024+512)); }while(0)
  #define KRD(G,j) do{ if(G){ kload2(kf,kp0+sl_next,j); SBAR(); } }while(0)
  #define STEP(C0,C1,P0,P1,t,GK,GV,GL) do{ SBAR(); \
    const lds_cptr vp_=vp0+sl_prev; \
    VRD(0); SBAR(); float sacc=(P0[0]+P0[1]); \
    GAPA(C0=__builtin_amdgcn_mfma_f32_32x32x16_bf16(kf[0],qr[0],negm,0,0,0), P0[2],P0[3],P0[4],P0[5],     pw0[0]=PKW(P0,0), pw0[1]=PKW(P0,2), pw0); \
    VRD(4); SBAR(); GAPA(C1=__builtin_amdgcn_mfma_f32_32x32x16_bf16(kf[1],qr[0],negm,0,0,0), P0[6],P0[7],P0[8],P0[9],     pw0[2]=PKW(P0,4), pw0[3]=PKW(P0,6), pw0); \
    VRD(1); SBAR(); GAPA(C0=__builtin_amdgcn_mfma_f32_32x32x16_bf16(kf[2],qr[1],C0,0,0,0),   P0[10],P0[11],P0[12],P0[13], pw1[0]=PKW(P0,8), pw1[1]=PKW(P0,10), pw1); \
    VRD(5); SBAR(); GAPA(C1=__builtin_amdgcn_mfma_f32_32x32x16_bf16(kf[3],qr[1],C1,0,0,0),   P0[14],P0[15],P1[0],P1[1],   pw1[2]=PKW(P0,12),pw1[3]=PKW(P0,14), pw1); \
    VRD(2); SBAR(); GAPA(C0=__builtin_amdgcn_mfma_f32_32x32x16_bf16(kf[4],qr[2],C0,0,0,0),   P1[2],P1[3],P1[4],P1[5],     pw2[0]=PKW(P1,0), pw2[1]=PKW(P1,2), pw2); \
    VRD(6); SBAR(); GAPA(C1=__builtin_amdgcn_mfma_f32_32x32x16_bf16(kf[5],qr[2],C1,0,0,0),   P1[6],P1[7],P1[8],P1[9],     pw2[2]=PKW(P1,4), pw2[3]=PKW(P1,6), pw2); \
    VRD(3); SBAR(); GAPA(C0=__builtin_amdgcn_mfma_f32_32x32x16_bf16(kf[6],qr[3],C0,0,0,0),   P1[10],P1[11],P1[12],P1[13], pw3[0]=PKW(P1,8), pw3[1]=PKW(P1,10), pw3); \
    VRD(7); SBAR(); GAPA(C1=__builtin_amdgcn_mfma_f32_32x32x16_bf16(kf[7],qr[3],C1,0,0,0),   P1[14],P1[15],0.f,0.f,       pw3[2]=PKW(P1,12),pw3[3]=PKW(P1,14), pw3); \
    l_reg+=sacc; \
    if(GK){DMA_K((t)+3,sl_cur);} if(GV){DMA_V((t)+1,sl_next);} \
    CMASK(C0,C1,t); \
    { float a=MX3(C0[0],C0[1],C1[0]),b=MX3(C0[2],C0[3],C1[1]); a=MX3(a,C1[2],C1[3]); \
      _Pragma("unroll") for(int r=4;r<16;r+=4){a=MX3(a,C0[r],C0[r+1]);b=MX3(b,C0[r+2],C0[r+3]);a=MX3(a,C1[r],C1[r+1]);b=MX3(b,C1[r+2],C1[r+3]);} \
      float rm=__builtin_fmaxf(a,b); { auto rr=__builtin_amdgcn_permlane32_swap(__float_as_uint(rm),__float_as_uint(rm),false,false); rm=__builtin_fmaxf(__uint_as_float(rr[0]),__uint_as_float(rr[1])); } \
      resc=false; \
      if(__builtin_expect(__any(rm>(float)THRL),0)){ const float dl=__builtin_fmaxf(rm,0.f); mhat+=dl; \
        _Pragma("unroll") for(int r=0;r<16;++r){C0[r]-=dl;C1[r]-=dl;} \
        _Pragma("unroll") for(int r=0;r<16;++r)negm[r]=-mhat; asm volatile("":"+v"(negm)); \
        const float f=__builtin_amdgcn_exp2f(-dl); l_reg*=f; if(hi==0)wsf[r32]=f; resc=true; } } \
    SBAR(); \
    GAPB(o[0]=__builtin_amdgcn_mfma_f32_32x32x16_bf16(PAF(0),VFR(0),o[0],0,0,0), C0,0); \
    GAPB(o[1]=__builtin_amdgcn_mfma_f32_32x32x16_bf16(PAF(0),VFR(4),o[1],0,0,0), C0,4); \
    KRD(GL,0); GAPB(o[0]=__builtin_amdgcn_mfma_f32_32x32x16_bf16(PAF(1),VFR(1),o[0],0,0,0), C0,8); \
    KRD(GL,1); GAPB(o[1]=__builtin_amdgcn_mfma_f32_32x32x16_bf16(PAF(1),VFR(5),o[1],0,0,0), C0,12); \
    KRD(GL,2); GAPB(o[0]=__builtin_amdgcn_mfma_f32_32x32x16_bf16(PAF(2),VFR(2),o[0],0,0,0), C1,0); \
    KRD(GL,3); GAPB(o[1]=__builtin_amdgcn_mfma_f32_32x32x16_bf16(PAF(2),VFR(6),o[1],0,0,0), C1,4); \
    GAPB(o[0]=__builtin_amdgcn_mfma_f32_32x32x16_bf16(PAF(3),VFR(3),o[0],0,0,0), C1,8); \
    GAPB(o[1]=__builtin_amdgcn_mfma_f32_32x32x16_bf16(PAF(3),VFR(7),o[1],0,0,0), C1,12); \
    }while(0)
  int t=1;
  for(;t+5<NT;t+=2){
    STEP(pB0,pB1,pA0,pA1,t,true,true,true);     WAIT_BAR(2); RESC(); ROT();
    STEP(pA0,pA1,pB0,pB1,t+1,true,true,true);   WAIT_BAR(2); RESC(); ROT();
  }
  #define ENDW(tt) do{ if((tt)+3<NT){WAIT_BAR(2);} else if((tt)+2<NT){WAIT_BAR(1);} else {WAIT_BAR(0);} }while(0)
  for(;t+1<NT;t+=2){
    STEP(pB0,pB1,pA0,pA1,t,(t+3<NT),(t+1<NT),(t+1<NT));       ENDW(t);   RESC(); ROT();
    STEP(pA0,pA1,pB0,pB1,t+1,(t+4<NT),(t+2<NT),(t+2<NT));     ENDW(t+1); RESC(); ROT();
  }
  STEP(pB0,pB1,pA0,pA1,NT-1,false,false,false); RESC();
  { float sacc=pB0[0]+pB0[1]; _Pragma("unroll") for(int r=2;r<16;++r)sacc+=pB0[r]; _Pragma("unroll") for(int r=0;r<16;++r)sacc+=pB1[r]; l_reg+=sacc;
    pw0=(u32x4){PKW(pB0,0),PKW(pB0,2),PKW(pB0,4),PKW(pB0,6)};pw1=(u32x4){PKW(pB0,8),PKW(pB0,10),PKW(pB0,12),PKW(pB0,14)};pw2=(u32x4){PKW(pB1,0),PKW(pB1,2),PKW(pB1,4),PKW(pB1,6)};pw3=(u32x4){PKW(pB1,8),PKW(pB1,10),PKW(pB1,12),PKW(pB1,14)};
    SBAR(); pv(o,vb0+sl_cur,PAF(0),PAF(1),PAF(2),PAF(3)); }
  #undef PKW
  #undef PAF
  #undef VFR
  #undef PIN
  #undef MX3
  #undef GAPA
  #undef GAPB
  #undef EX
  #undef VRD
  #undef KRD
  #undef STEP
  #undef ENDW
  l_reg+=__shfl_xor(l_reg,32);
  l_reg+=__builtin_amdgcn_exp2f(sinkp[hsub]*1.4426950408889634f-mhat);
  if(hi==0)wsf[32+r32]=l_reg;asm volatile("s_waitcnt lgkmcnt(0)":::"memory");
  float rli[16];
  #pragma unroll
  for(int r=0;r<16;++r)rli[r]=__builtin_amdgcn_rcpf(wsf[32+crow(r,hi)]);
  bf16*Ow=Ou+(long)psub*OP+hsub*D;
  { bf16*stg=(bf16*)(shm+LDS_OST)+wid*2048;
    #pragma unroll
    for(int r=0;r<16;++r){const int orow=crow(r,hi);
      #pragma unroll
      for(int d0=0;d0<2;++d0)stg[orow*64+d0*32+r32]=__float2bfloat16(o[d0][r]*rli[r]);}
    asm volatile("s_waitcnt lgkmcnt(0)":::"memory");
    #pragma unroll
    for(int i=0;i<4;++i){const int row=i*8+(lane>>3),ch=lane&7; const u32x4 v=*(const u32x4*)(stg+row*64+ch*8); ATTN_STORE16(Ow+(long)row*OP+ch*8,v);} }
  asm volatile("s_waitcnt lgkmcnt(0)\n\ts_barrier":::"memory");
  #undef DMA_K
  #undef DMA_V
  #undef KP0
  #undef TROW
  #undef CMASK
  #undef START
  #undef RESC
  #undef ROT
}
constexpr int ATTN_LDS_BYTES=LDS_BYTES;
#undef SBAR
#undef WAIT_BAR
}

constexpr int SLAB_PITCH = 288;
typedef short v4i16_t __attribute__((ext_vector_type(4)));
template <int MT, class RowAddr, class Epi>
__device__ __forceinline__ void slab_gemm(LAS unsigned char* lds, const bf16* Cmat, const int K, const RowAddr& RA, const Epi& E) {
    int tid = threadIdx.x; asm volatile("" : "+v"(tid));
    const int wid = tid >> 6, lane = tid & 63;
    LAS bf16* Dr = (LAS bf16*)lds;
    f32x16 acc[MT];
#pragma unroll
    for (int i = 0; i < MT; ++i)
#pragma unroll
        for (int r = 0; r < 16; ++r) acc[i][r] = 0.f;
    const int g = (lane >> 4) & 1, h = lane >> 5, qq = (lane & 15) >> 2, pp = lane & 3;
    const LAS bf16* trp = Dr + (8 * h + qq) * SLAB_PITCH + wid * 32 + 16 * g + 4 * pp;
    for (int kc = 0; kc < K; kc += 128) {
        {
            const int k = tid >> 2, qd = tid & 3;
            const bf16* src = RA(kc + k) + qd * 64;
            v4u v[8];
#pragma unroll
            for (int j = 0; j < 8; ++j) v[j] = *(const v4u*)(src + j * 8);
#pragma unroll
            for (int j = 0; j < 8; ++j) *(LAS v4u*)(Dr + k * SLAB_PITCH + qd * 64 + j * 8) = v[j];
        }
        __syncthreads();
        const int kh = h * 8;
#pragma unroll
        for (int s = 0; s < 8; ++s) {
            const v4i16_t b0 = __builtin_amdgcn_ds_read_tr16_b64_v4i16((LAS v4i16_t*)(trp + (16 * s) * SLAB_PITCH));
            const v4i16_t b1 = __builtin_amdgcn_ds_read_tr16_b64_v4i16((LAS v4i16_t*)(trp + (16 * s + 4) * SLAB_PITCH));
            const bf16x8 bfrag = (bf16x8){b0[0], b0[1], b0[2], b0[3], b1[0], b1[1], b1[2], b1[3]};
#pragma unroll
            for (int mt = 0; mt < MT; ++mt) {
                const bf16x8 afrag = *(const bf16x8*)(Cmat + (size_t)(mt * 32 + (lane & 31)) * K + kc + s * 16 + kh);
                acc[mt] = __builtin_amdgcn_mfma_f32_32x32x16_bf16(afrag, bfrag, acc[mt], 0, 0, 0);
            }
        }
        __syncthreads();
    }
    E(acc, wid, lane, lds);
}

struct Args { const float* in[23]; float* out; unsigned char* ws; int ph_lo, ph_hi; };

constexpr int SOUT_PITCH = 264;
template <int NROWS, bool WT, class RowPtr>
__device__ __forceinline__ void slab_store_rows(LAS unsigned char* lds, const RowPtr& RP) {
    int tid = threadIdx.x; asm volatile("" : "+v"(tid));
    __syncthreads();
#pragma unroll
    for (int k = 0; k < NROWS / 16; ++k) { const int row = (tid >> 5) + 16 * k, chunk = tid & 31;
        const v4u v = *(const LAS v4u*)((LAS bf16*)lds + row * SOUT_PITCH + chunk * 8);
        bf16* dst = RP(row) + chunk * 8;
        if (WT) store16_wt(dst, v); else *(v4u*)dst = v; }
    __syncthreads();
}
struct RowA { const bf16* z; int b, n2; __device__ __forceinline__ const bf16* operator()(int k) const { return z + (size_t)(b * 4096 + 64 * (k & 63) + n2) * 512 + (k >> 6) * 256; } };
struct RowPA { bf16* t2; int b, n2; __device__ __forceinline__ bf16* operator()(int m) const { return t2 + ((size_t)((b * 64 + n2) * 64 + (m & 63)) * 2 + (m >> 6)) * 256; } };
template <bool WT> struct EpiA { bf16* t2; const float2* tw; int b, n2;
    __device__ __forceinline__ void operator()(const f32x16 (&acc)[4], int wid, int lane, LAS unsigned char* lds) const {
        const int ch = wid * 32 + (lane & 31); LAS bf16* so = (LAS bf16*)lds;
#pragma unroll
        for (int mt = 0; mt < 2; ++mt)
#pragma unroll
            for (int r = 0; r < 16; ++r) {
                const int k1 = 32 * mt + (r & 3) + 8 * (r >> 2) + 4 * (lane >> 5);
                const float2 cs = tw[n2 * k1]; const float re = acc[mt][r], im = acc[mt + 2][r];
                const float re2 = cs.x * re + cs.y * im, im2 = cs.x * im - cs.y * re;
                so[k1 * SOUT_PITCH + ch] = (bf16)f2bf(re2); so[(64 + k1) * SOUT_PITCH + ch] = (bf16)f2bf(im2);
            }
        RowPA rp{t2, b, n2}; slab_store_rows<128, WT, RowPA>(lds, rp);
    } };
struct RowB { const bf16* t2; int b, k1; __device__ __forceinline__ const bf16* operator()(int k) const { return t2 + ((size_t)((b * 64 + (k & 63)) * 64 + k1) * 2 + (k >> 6)) * 256; } };
struct RowPB { bf16* mrg; int b, k1; __device__ __forceinline__ bf16* operator()(int k2) const { return mrg + (size_t)(b * 4096 + k1 + 64 * k2) * 1024 + 768; } };
struct EpiB { bf16* mrg; int b, k1;
    __device__ __forceinline__ void operator()(const f32x16 (&acc)[2], int wid, int lane, LAS unsigned char* lds) const {
        const int ch = wid * 32 + (lane & 31); LAS bf16* so = (LAS bf16*)lds;
#pragma unroll
        for (int mt = 0; mt < 2; ++mt)
#pragma unroll
            for (int r = 0; r < 16; ++r) { const int k2 = 32 * mt + (r & 3) + 8 * (r >> 2) + 4 * (lane >> 5); so[k2 * SOUT_PITCH + ch] = (bf16)f2bf(DBG_NO_FOUR ? 0.f : acc[mt][r]); }
        RowPB rp{mrg, b, k1}; slab_store_rows<64, false, RowPB>(lds, rp);
    } };
struct RowC { const bf16* z; int b; __device__ __forceinline__ const bf16* operator()(int k) const { return z + (size_t)(T + b * 256 + (k & 255)) * 512 + (k >> 8) * 256; } };
struct RowPC { bf16* mrg; int b, mt0; __device__ __forceinline__ bf16* operator()(int kk) const { return mrg + (size_t)(T + b * 256 + 32 * mt0 + kk) * 1024 + 768; } };
struct EpiC { bf16* mrg; int b, mt0;
    __device__ __forceinline__ void operator()(const f32x16 (&acc)[1], int wid, int lane, LAS unsigned char* lds) const {
        const int ch = wid * 32 + (lane & 31); LAS bf16* so = (LAS bf16*)lds;
#pragma unroll
        for (int r = 0; r < 16; ++r) { const int kk = (r & 3) + 8 * (r >> 2) + 4 * (lane >> 5); so[kk * SOUT_PITCH + ch] = (bf16)f2bf(DBG_NO_FOUR ? 0.f : acc[0][r]); }
        RowPC rp{mrg, b, mt0}; slab_store_rows<32, false, RowPC>(lds, rp);
    } };

__device__ __forceinline__ void tr_block(const float* src, int ldS, bf16* dst, int ldD, LAS float* scr, int lane) {
#pragma unroll 8
    for (int i = 0; i < 32; ++i) { const int kk = 2 * i + (lane >> 5); scr[kk * 33 + (lane & 31)] = src[(size_t)kk * ldS + (lane & 31)]; }
    LDS_WAIT(); asm volatile("" ::: "memory");
    const int c = lane & 7;
#pragma unroll
    for (int j = 0; j < 4; ++j) { const int n = (lane >> 3) + 8 * j; const LAS float* s = scr + (8 * c) * 33 + n;
        v4u o; o.x = pk2(s[0 * 33], s[1 * 33]); o.y = pk2(s[2 * 33], s[3 * 33]); o.z = pk2(s[4 * 33], s[5 * 33]); o.w = pk2(s[6 * 33], s[7 * 33]);
        *(GAS v4u*)(dst + (size_t)n * ldD + 8 * c) = o; }
    LDS_WAIT(); asm volatile("" ::: "memory");
}


__device__ __forceinline__ void tr_block64(const float* src, int ldS, bf16* dst, int ldD, LAS bf16* scr, int lane) {
    const int kr = lane >> 4, nc = lane & 15;
    f32x4 v[16];
#pragma unroll
    for (int i = 0; i < 16; ++i) v[i] = *(const f32x4*)(src + (size_t)(4 * i + kr) * ldS + 4 * nc);
#pragma unroll
    for (int i = 0; i < 16; ++i) { const int k = 4 * i + kr;
#pragma unroll
        for (int j = 0; j < 4; ++j) scr[(4 * nc + j) * 66 + k] = (bf16)f2bf(v[i][j]); }
    LDS_WAIT(); asm volatile("" ::: "memory");
    const int c = lane & 7;
#pragma unroll
    for (int j = 0; j < 8; ++j) { const int n = (lane >> 3) + 8 * j; const LAS unsigned* p = (const LAS unsigned*)(scr + n * 66 + 8 * c);
        v4u o; o.x = p[0]; o.y = p[1]; o.z = p[2]; o.w = p[3];
        *(GAS v4u*)(dst + (size_t)n * ldD + 8 * c) = o; }
    LDS_WAIT(); asm volatile("" ::: "memory");
}

__device__ __forceinline__ void tr_block64_f8(const float* src, int ldS, unsigned char* dst, int ldD, LAS unsigned char* scr, int lane, float sc) {
    const int nq = lane & 15, kq0 = lane >> 4;
    f32x4 v[4][4];
#pragma unroll
    for (int sb = 0; sb < 4; ++sb)
#pragma unroll
        for (int r = 0; r < 4; ++r) v[sb][r] = *(const f32x4*)(src + (size_t)(4 * (kq0 + 4 * sb) + r) * ldS + 4 * nq);
#pragma unroll
    for (int sb = 0; sb < 4; ++sb)
#pragma unroll
        for (int j = 0; j < 4; ++j) *(LAS unsigned*)(scr + (4 * nq + j) * 68 + 4 * (kq0 + 4 * sb)) = pk4_f8(v[sb][0][j] * sc, v[sb][1][j] * sc, v[sb][2][j] * sc, v[sb][3][j] * sc);
    LDS_WAIT(); asm volatile("" ::: "memory");
    const int c = lane & 3;
#pragma unroll
    for (int jj = 0; jj < 4; ++jj) { const int n = (lane >> 2) + 16 * jj; const LAS unsigned* p = (const LAS unsigned*)(scr + n * 68 + 16 * c);
        v4u o; o.x = p[0]; o.y = p[1]; o.z = p[2]; o.w = p[3];
        *(GAS v4u*)(dst + (size_t)n * ldD + 16 * c) = o; }
    LDS_WAIT(); asm volatile("" ::: "memory");
}

template <int HW> __device__ __forceinline__ void pool_item(const bf16* up, bf16* op, const int n0, const int nseq) {
    constexpr int NR = 2 * HW + 7;
    v4u w[NR];
#pragma unroll
    for (int j = 0; j < NR; ++j) { const int t = n0 - HW + j; const int tc = t < 0 ? 0 : (t > nseq - 1 ? nseq - 1 : t); w[j] = *(const v4u*)(up + (size_t)tc * 256); }
#pragma unroll
    for (int j = 0; j < NR; ++j) { const int t = n0 - HW + j; if (t < 0 || t >= nseq) w[j] = (v4u){0u, 0u, 0u, 0u}; }
    float sm[8] = {0.f, 0.f, 0.f, 0.f, 0.f, 0.f, 0.f, 0.f};
#define POOL_ACC(W, SGN) do { sm[0] += SGN bflo(W.x); sm[1] += SGN bfhi(W.x); sm[2] += SGN bflo(W.y); sm[3] += SGN bfhi(W.y); sm[4] += SGN bflo(W.z); sm[5] += SGN bfhi(W.z); sm[6] += SGN bflo(W.w); sm[7] += SGN bfhi(W.w); } while (0)
#pragma unroll
    for (int j = 0; j < 2 * HW; ++j) POOL_ACC(w[j], +);
#pragma unroll
    for (int k = 0; k < 8; ++k) {
        const int n = n0 + k; int lo_ = n - HW; lo_ = lo_ < 0 ? 0 : lo_; int hi_ = n + HW - 1; hi_ = hi_ > nseq - 1 ? nseq - 1 : hi_;
        const v4u c = w[HW + k]; const float ic = 1.0f / (float)(hi_ - lo_ + 1);
        v4u o; o.x = pk2(sm[0] * ic - bflo(c.x), sm[1] * ic - bfhi(c.x)); o.y = pk2(sm[2] * ic - bflo(c.y), sm[3] * ic - bfhi(c.y));
        o.z = pk2(sm[4] * ic - bflo(c.z), sm[5] * ic - bfhi(c.z)); o.w = pk2(sm[6] * ic - bflo(c.w), sm[7] * ic - bfhi(c.w));
        if (DBG_NO_POOL) o = (v4u){0u, 0u, 0u, 0u};
        *(v4u*)(op + (size_t)k * 1024) = o;
        if (k < 7) { POOL_ACC(w[k + 2 * HW], +); POOL_ACC(w[k], -); }
    }
#undef POOL_ACC
}

typedef const __attribute__((address_space(4))) Args* kargs_t;
__device__ __forceinline__ kargs_t ka_launder() { kargs_t p = (kargs_t)__builtin_amdgcn_kernarg_segment_ptr(); asm volatile("" : "+s"(p)); return p; }
__device__ __forceinline__ int tid_launder() { int t = threadIdx.x; asm volatile("" : "+v"(t)); return t; }
#define KA_DECL const kargs_t KA = ka_launder(); const int tid = tid_launder(); const int lane = tid & 63; const int wave = __builtin_amdgcn_readfirstlane(tid >> 6); const int gw = vcu * 8 + wave; const int gt = vcu * 512 + tid; (void)lane; (void)wave; (void)gw; (void)gt;
#define ws (KA->ws)
#define ctl ((gu32*)(ws + O_CTL))
#define x_in (KA->in[0])
#define c_in (KA->in[1])
#define ctx_in (KA->in[2])
#define cctx_in (KA->in[3])
#define w_mod (KA->in[4])
#define b_mod (KA->in[5])
#define norm1_g (KA->in[6])
#define w_in (KA->in[7])
#define q_norm_g (KA->in[8])
#define k_norm_g (KA->in[9])
#define attn_sink (KA->in[10])
#define pool_w (KA->in[11])
#define pool_scale (KA->in[12])
#define four_w (KA->in[13])
#define w_out (KA->in[14])
#define norm2_g (KA->in[15])
#define w_grp (KA->in[16])
#define b_grp (KA->in[17])
#define w_rtr (KA->in[18])
#define b_rtr (KA->in[19])
#define w_gate (KA->in[20])
#define w_up (KA->in[21])
#define w_down (KA->in[22])
#define outp (KA->out)
#define modv ((float*)(ws + O_MOD))
#define rope ((float2*)(ws + O_ROPE))
#define twt ((float2*)(ws + O_TW))
#define fma ((bf16*)(ws + O_FMA))
#define fmb ((bf16*)(ws + O_FMB))
#define fmc ((bf16*)(ws + O_FMC))
#define hbuf ((bf16*)(ws + O_H))
#define kall ((bf16*)(ws + O_KALL))
#define vall ((bf16*)(ws + O_VALL))
#define xc ((float*)(ws + O_XC))
#define xb ((bf16*)(ws + O_XB))
#define list ((unsigned*)(ws + O_LIST))
#define wts ((float*)(ws + O_WTS))
#define act ((bf16*)(ws + O_ACT))
#define t2 ((bf16*)(ws + O_T2))
#define mrg ((bf16*)(ws + O_MRG))
#define qb ((bf16*)(ws + O_Q))
#define pu ((bf16*)(ws + O_PU))
#define zb ((bf16*)(ws + O_Z))
#define y2 ((bf16*)(ws + O_Y2))

#ifndef PH_MASK
#define PH_MASK 0x3ffff
#endif
#define IN(k) (lo <= (k) && (k) < hi && ((PH_MASK >> (k)) & 1))
#define SEAM(k) do { if (IN(k) && IN((k) + 1)) xcd_barrier(bar); } while (0)
#define modl (modv + (size_t)l * 5 * 6144)
#define win_t ((bf16*)(ws + O_WIN + l * SZ_WIN1))
#define wout_t ((bf16*)(ws + O_WOUT + l * SZ_WOUT1))
#define wgu_t ((bf16*)(ws + O_WGU + l * SZ_WGU1))
#define wd_t ((bf16*)(ws + O_WD + l * SZ_WD1))
constexpr int CV_A = 256, CV_B = 192, CV_C = 4096, CV_D = 2048, CV_L = CV_A + CV_B + CV_C + CV_D;
__device__ __forceinline__ void conv_item(const kargs_t KA, const int lw, int it, LAS bf16* scr, const int lane) {
    bf16* p_win_t = (bf16*)(ws + O_WIN + lw * SZ_WIN1); bf16* p_wout_t = (bf16*)(ws + O_WOUT + lw * SZ_WOUT1);
    bf16* p_wgu_t = (bf16*)(ws + O_WGU + lw * SZ_WGU1); bf16* p_wd_t = (bf16*)(ws + O_WD + lw * SZ_WD1);
    if (it < CV_A) { const int kb = it >> 4, nb = it & 15; const float* src = w_in + (size_t)lw * 1024 * 1280 + (size_t)kb * 64 * 1280 + nb * 64;
        if (nb < 4) tr_block64(src, 1280, p_win_t + (size_t)nb * 64 * 1024 + kb * 64, 1024, scr, lane);
        else tr_block64_f8(src, 1280, (unsigned char*)(ws + O_WIN8 + lw * SZ_WIN8) + (size_t)(nb * 64 - 256) * 1024 + kb * 64, 1024, (LAS unsigned char*)scr, lane, 64.0f);
        return; } it -= CV_A;
    if (it < CV_B) { const int kb = 4 + (it >> 4), nb = it & 15; tr_block64(w_out + (size_t)lw * 1024 * 1024 + (size_t)kb * 64 * 1024 + nb * 64, 1024, p_wout_t + (size_t)nb * 64 * 1024 + kb * 64, 1024, scr, lane); return; } it -= CV_B;
    if (it < CV_C) { const int up = it >> 11, r = it & 2047, e = r >> 7, kb = (r >> 3) & 15, nb = r & 7; const int n0 = nb * 64;
        const float* src = (up ? w_up : w_gate) + ((size_t)(lw * 16 + e) * 1024 + kb * 64) * 512 + n0;
        const int drow = (n0 >> 7) * 256 + up * 128 + (n0 & 127);
        tr_block64_f8(src, 512, (unsigned char*)p_wgu_t + ((size_t)e * 1024 + drow) * 1024 + kb * 64, 1024, (LAS unsigned char*)scr, lane, 64.0f); return; } it -= CV_C;
    { const int e = it >> 7, kb = (it >> 4) & 7, nb = it & 15;
        tr_block64_f8(w_down + ((size_t)(lw * 16 + e) * 512 + kb * 64) * 1024 + nb * 64, 1024, (unsigned char*)p_wd_t + ((size_t)e * 1024 + nb * 64) * 512 + kb * 64, 512, (LAS unsigned char*)scr, lane, 64.0f); }
}
__device__ __forceinline__ void steal_convert(const kargs_t KA, LAS unsigned char* lds, const int G, const int done_idx, const bool drain) {
    int tid = threadIdx.x; asm volatile("" : "+v"(tid));
    const int lane = tid & 63, wave = __builtin_amdgcn_readfirstlane(tid >> 6);
    volatile LAS int* mb = (volatile LAS int*)(lds + MISC_OFF + 64);
    LAS bf16* scr = (LAS bf16*)(lds + wave * 16384);
    __syncthreads();
    if (tid == 0 && !drain) __hip_atomic_fetch_add((unsigned*)(ctl + CW_DONE + 64 * done_idx), 1u, RLX_AGENT);
    for (;;) {
        if (tid == 0) { int idx = -1;
            const bool stop = !drain && __hip_atomic_load((unsigned*)(ctl + CW_DONE + 64 * done_idx), RLX_AGENT) >= (unsigned)(G - G / 4);
            if (!stop) idx = (int)__hip_atomic_fetch_add((unsigned*)(ctl + CW_Q), 8u, RLX_AGENT);
            mb[0] = idx; }
        __syncthreads();
        const int idx = mb[0];
        __syncthreads();
        if (idx < 0 || idx >= CV_L) break;
        if (idx + wave < CV_L) conv_item(KA, 1, idx + wave, scr, lane);
    }
    __syncthreads();
}

template <int l> __device__ __forceinline__ void layer_body(LAS unsigned char* lds, const int G, const int vcu, const XcdBarrier& bar, const int lo, const int hi) {
    const int NGW = G * 8, NGT = G * 512; LAS int* ttab = (LAS int*)(lds + TILE_OFF);
    constexpr int P = 1 + 8 * l;

        for (int rep_ = 0; rep_ < 1 + ((l == 0) ? ((REP_MASK >> (1 + 0)) & 1) : 0); ++rep_)
        if (IN(P + 0)) {
            KA_DECL
            const float* modp = modv;
            if (l == 1) steal_convert(KA, lds, G, 3, true);
#pragma clang loop vectorize(disable) unroll(disable)
            for (int r0 = gw; r0 < TT; r0 += 2 * NGW) {
                const int r1 = r0 + NGW; const bool has1 = r1 < TT;
                f32x4 va[4], vb[4]; unsigned yaa[4], yab[4], yba[4], ybb[4];
                if (l == 0) {
                    const float* srca; const float* srcb;
                    { const bool isc = r0 >= T; srca = isc ? ctx_in + (size_t)(r0 - T) * 1024 : x_in + (size_t)r0 * 1024; }
                    { const int rr = has1 ? r1 : r0; const bool isc = rr >= T; srcb = isc ? ctx_in + (size_t)(rr - T) * 1024 : x_in + (size_t)rr * 1024; }
#pragma unroll
                    for (int j = 0; j < 4; ++j) { va[j] = *(const f32x4*)(srca + 4 * lane + 256 * j); vb[j] = *(const f32x4*)(srcb + 4 * lane + 256 * j); }
                } else {
                    const int rr = has1 ? r1 : r0;
#pragma unroll
                    for (int j = 0; j < 4; ++j) { const v2u wa = *(const v2u*)(xb + (size_t)r0 * 1024 + 4 * lane + 256 * j), wb = *(const v2u*)(xb + (size_t)rr * 1024 + 4 * lane + 256 * j);
                        va[j] = (f32x4){bflo(wa.x), bfhi(wa.x), bflo(wa.y), bfhi(wa.y)}; vb[j] = (f32x4){bflo(wb.x), bfhi(wb.x), bflo(wb.y), bfhi(wb.y)}; }
                }
                if (l == 1) {
                    const int rr = has1 ? r1 : r0;
#pragma unroll
                    for (int j = 0; j < 4; ++j) { const unsigned char* yq = (const unsigned char*)y2 + 4 * lane + 256 * j;
                        yaa[j] = *(const unsigned*)(yq + (size_t)(2 * r0) * 1024); yab[j] = *(const unsigned*)(yq + (size_t)(2 * r0 + 1) * 1024);
                        yba[j] = *(const unsigned*)(yq + (size_t)(2 * rr) * 1024); ybb[j] = *(const unsigned*)(yq + (size_t)(2 * rr + 1) * 1024); }
                }
#pragma unroll
                for (int half = 0; half < 2; ++half) {
                    if (half == 1 && !has1) break;
                    const int r = half ? r1 : r0; f32x4 (&v)[4] = half ? vb : va; unsigned (&ya)[4] = half ? yba : yaa; unsigned (&yb)[4] = half ? ybb : yab;
                    const bool isc = r >= T; const int bsel = isc ? 4 : (r >> 12);
                    if (l == 1) {
                        const float* g2 = modp + bsel * 6144 + 5 * 1024; bf16* dst = xb + (size_t)r * 1024;
#pragma unroll
                        for (int j = 0; j < 4; ++j) {
                            const f32x4 gv = *(const f32x4*)(g2 + 4 * lane + 256 * j);
                            f32x4 yy = (f8x4_f32(ya[j]) + f8x4_f32(yb[j])) * (1.0f / Y2SC);
                            if (DBG_NO_MOE) yy = (f32x4){0.f, 0.f, 0.f, 0.f};
                            v[j] = v[j] + gv * yy; { v2u o; o.x = pk2(v[j][0], v[j][1]); o.y = pk2(v[j][2], v[j][3]); *(v2u*)(dst + 4 * lane + 256 * j) = o; }
                        }
                    }
                    float ss = 0.f;
#pragma unroll
                    for (int j = 0; j < 4; ++j) ss += (v[j][0] * v[j][0] + v[j][1] * v[j][1]) + (v[j][2] * v[j][2] + v[j][3] * v[j][3]);
                    const float rstd = 1.0f / sqrtf(wave_sum(ss) * (1.f / 1024.f) + 1e-6f);
                    const float* sh = modl + bsel * 6144; const float* sc = sh + 1024; const float* gn = norm1_g + l * 1024;
#pragma unroll
                    for (int j = 0; j < 4; ++j) {
                        const int c0 = 4 * lane + 256 * j; const f32x4 g = *(const f32x4*)(gn + c0), s1 = *(const f32x4*)(sc + c0), h1 = *(const f32x4*)(sh + c0);
                        const f32x4 y = (v[j] * rstd) * g * (s1 + 1.0f) + h1;
                        v2u o; o.x = pk2(y[0], y[1]); o.y = pk2(y[2], y[3]); *(v2u*)(hbuf + (size_t)r * 1024 + c0) = o;
                        *(unsigned*)((unsigned char*)(ws + O_ACT) + (size_t)r * 1024 + c0) = pk4_f8(y[0], y[1], y[2], y[3]);
                    }
                }
            }
        }
        SEAM(P + 0);
        for (int rep_ = 0; rep_ < 1 + ((l == 0) ? ((REP_MASK >> (1 + 1)) & 1) : 0); ++rep_)
        if (IN(P + 1)) {
            KA_DECL
            EpiG1 E{pu, qb, kall, vall, zb};
            { SchedG1 S{G, vcu, 0, l, (const char*)hbuf, (const char*)win_t}; pg8::gemm_phase<EpiG1, SchedG1, false>(lds, S, E); }
            { SchedG1 S{G, vcu, 1, l, (const char*)(ws + O_ACT), (const char*)(ws + O_WIN8 + l * SZ_WIN8)}; pg8::gemm_phase<EpiG1, SchedG1, true>(lds, S, E); }
            if (l == 0 && !MK_SPLIT) steal_convert(KA, lds, G, 0, false);
        }
        SEAM(P + 1);
        if (IN(P + 3)) {
            KA_DECL
            gu32* kflag = ctl + CW_KF + l * 16384;
            gu32* facnt = ctl + CW_FA + l * 64;
            for (int it = vcu; it < 256; it += G) {
                const int b = it >> 6, n2 = it & 63;
                RowA ra{zb, b, n2}; EpiA<true> ea{t2, twt, b, n2};
                slab_gemm<4, RowA, EpiA<true>>(lds, fma, 128, ra, ea);
                asm volatile("s_waitcnt vmcnt(0)" ::: "memory");
                __syncthreads();
                if (tid == 0) __hip_atomic_fetch_add((unsigned*)(facnt + 16 * b), 1u, RLX_AGENT);
            }
            const int n_att = 512 + (l == 0 ? 32 : 0);
            for (int it = vcu; it < n_att; it += G) {
                const bool cu = it >= 512; const int uidx = cu ? it - 512 : it;
                const int b = cu ? (uidx >> 3) : (uidx >> 7), kvh = cu ? ((uidx >> 2) & 1) : ((uidx >> 6) & 1), pb = cu ? (uidx & 3) : (uidx & 63);
                const int p0 = pb * 64; const int qrow0 = cu ? T + b * 256 + p0 : b * 4096 + p0;
                if (!cu) {
                    const int row = tid >> 3, c = tid & 7;
                    const float* kg = k_norm_g + l * 64 + 8 * c;
#pragma unroll
                    for (int part = 0; part < 2; ++part) {
                        if (part == 1 && pb >= 4) break;
                        const int blk = part ? pb : 4 + pb;
                        bf16* p = kall + ((size_t)b * KVROWS + blk * 64 + row) * 128 + kvh * 64 + c * 8;
                        const v4u w = *(const v4u*)p;
                        float x[8] = {bflo(w.x), bfhi(w.x), bflo(w.y), bfhi(w.y), bflo(w.z), bfhi(w.z), bflo(w.w), bfhi(w.w)};
                        float ss = 0.f;
#pragma unroll
                        for (int i = 0; i < 8; ++i) ss += x[i] * x[i];
                        ss += __shfl_xor(ss, 1); ss += __shfl_xor(ss, 2); ss += __shfl_xor(ss, 4);
                        const float rstd = 1.0f / sqrtf(ss * (1.f / 64.f) + 1e-6f);
#pragma unroll
                        for (int i = 0; i < 8; ++i) x[i] *= rstd * kg[i];
                        if (part == 0) {
                            const float2* rp = rope + (size_t)(p0 + row) * 32 + ((c & 4) ? 16 : 0) + (c & 1) * 8;
#pragma unroll
                            for (int i = 0; i < 8; ++i) { const float y = __shfl_xor(x[i], 2); const float2 cs = rp[i]; x[i] = (c & 2) ? (x[i] * cs.x + y * cs.y) : (x[i] * cs.x - y * cs.y); }
                        }
                        v4u o; o.x = pk2(x[0], x[1]); o.y = pk2(x[2], x[3]); o.z = pk2(x[4], x[5]); o.w = pk2(x[6], x[7]);
                        store16_wt(p, o);
                    }
                    asm volatile("s_waitcnt vmcnt(0)" ::: "memory");
                    __syncthreads();
                    if (tid == 0) { __hip_atomic_store(kflag + 16 * ((b * 68 + 4 + pb) * 2 + kvh), 1u, RLX_AGENT); if (pb < 4) __hip_atomic_store(kflag + 16 * ((b * 68 + pb) * 2 + kvh), 1u, RLX_AGENT); }
                }
                if (tid < 64) {
                    int blk = -1;
                    if (lane < 4) blk = lane; else if (!cu && lane < 9) { const int q = pb + lane - 6; if (q >= 0 && q < 64) blk = 4 + q; }
                    unsigned sp = 0;
                    for (;;) { const unsigned f = (blk >= 0) ? __hip_atomic_load(kflag + 16 * ((b * 68 + blk) * 2 + kvh), RLX_AGENT) : 1u;
                        if (__all(f != 0u)) break; __builtin_amdgcn_s_sleep(2);
                        if (++sp > (1u << 22)) { if (tid == 0) __hip_atomic_store(ctl + CW_TMO, 2u, RLX_AGENT); break; } }
                    __builtin_amdgcn_fence(__ATOMIC_ACQUIRE, "agent");
                    asm volatile("s_waitcnt vmcnt(0)" ::: "memory");
                }
                __syncthreads();
                const attn_body::bf16* Qu = (const attn_body::bf16*)(qb + (size_t)qrow0 * 512 + kvh * 256);
                const attn_body::bf16* Kh = (const attn_body::bf16*)(kall + (size_t)b * KVROWS * 128 + kvh * 64);
                const attn_body::bf16* Vh = (const attn_body::bf16*)(vall + (size_t)b * KVROWS * 128 + kvh * 64);
                attn_body::bf16* Ou = (attn_body::bf16*)(mrg + (size_t)qrow0 * 1024 + 256 + kvh * 256);
                attn_body::attn_unit<8>(Qu, Kh, Vh, Ou, p0, cu ? 4 : 10, attn_sink + l * 8 + kvh * 4, q_norm_g + l * 64, cu ? (const float2*)nullptr : (const float2*)rope, (char*)lds);
                __syncthreads();
            }
            const int prow = (l == 0) ? TT : T; const int nrb = prow >> 3;
#pragma clang loop vectorize(disable) unroll(disable)
            for (int i = gt; i < 32 * nrb; i += NGT) {
                const int ck8 = i & 7, rb = (i >> 3) % nrb, g = (i >> 3) / nrb;
                const int r0 = rb * 8; const bool isc = r0 >= T;
                const int nseq = isc ? LCTX : NSEQ; const int rbase = isc ? T + ((r0 - T) & ~255) : (r0 & ~4095); const int n0 = r0 - rbase;
                const int col = g * 64 + ck8 * 8;
                const bf16* up = pu + (size_t)rbase * 256 + col; bf16* op = mrg + (size_t)(rbase + n0) * 1024 + col;
                if (g == 0) pool_item<1>(up, op, n0, nseq); else if (g == 1) pool_item<2>(up, op, n0, nseq); else if (g == 2) pool_item<4>(up, op, n0, nseq); else pool_item<8>(up, op, n0, nseq);
            }
            for (int it = vcu; it < 256; it += G) {
                const int b = it >> 6, k1 = it & 63;
                __syncthreads();
                if (tid < 64) { unsigned sp = 0;
                    while ((unsigned)__builtin_amdgcn_readfirstlane(__hip_atomic_load((unsigned*)(facnt + 16 * b), RLX_AGENT)) < 64u) { __builtin_amdgcn_s_sleep(2); if (++sp > (1u << 22)) { if (tid == 0) __hip_atomic_store(ctl + CW_TMO, 3u, RLX_AGENT); break; } }
                    __builtin_amdgcn_fence(__ATOMIC_ACQUIRE, "agent");
                    asm volatile("s_waitcnt vmcnt(0)" ::: "memory"); }
                __syncthreads();
                RowB rb{t2, b, k1}; EpiB eb{mrg, b, k1};
                slab_gemm<2, RowB, EpiB>(lds, fmb, 128, rb, eb);
            }
            if (l == 0) for (int it = (G - 1 - vcu); it < 32; it += G) {
                const int b = it >> 3, mt0 = it & 7;
                RowC rc{zb, b}; EpiC ec{mrg, b, mt0};
                slab_gemm<1, RowC, EpiC>(lds, fmc + (size_t)mt0 * 32 * 512, 512, rc, ec);
            }
        }
        SEAM(P + 3);
        if (IN(P + 4)) {
            KA_DECL
            unsigned* g2rdy = (unsigned*)(ctl + CW_G2 + l * 2048);
            {
                SchedPlain S{(l == 0 ? TT : T) / 256, 4, G, vcu, 1024, (const char*)mrg, (const char*)wout_t};
                EpiG2<(l != 0)> E{x_in, ctx_in, xb, modl, g2rdy};
                pg8::gemm_phase<EpiG2<(l != 0)>, SchedPlain>(lds, S, E);
            }
            const int rep_ = 0;
            __syncthreads();
            LAS float* rw = (LAS float*)lds;
            LAS int* lcnt = (LAS int*)(lds + 81920);
            LAS unsigned* lent = (LAS unsigned*)(lds + 81920 + 256);
            LAS unsigned* lrank = lent + 1024;
            { const float* rwg = (const float*)(ws + O_RW) + l * 20480;
#pragma unroll
              for (int i = 0; i < 10; ++i) { const int idx = tid + 512 * i; *(LAS f32x4*)(rw + 4 * idx) = *(const f32x4*)(rwg + 4 * idx); } }
            if (tid < 33) lcnt[tid] = 0;
            if (tid < 64) { unsigned sp = 0; unsigned* w = g2rdy + 16 * (vcu >> 2);
                while ((unsigned)__builtin_amdgcn_readfirstlane(__hip_atomic_load(w, RLX_AGENT)) < 32u) { __builtin_amdgcn_s_sleep(2); if (++sp > (1u << 22)) { if (tid == 0) __hip_atomic_store(ctl + CW_TMO, 4u, RLX_AGENT); break; } }
                __builtin_amdgcn_fence(__ATOMIC_ACQUIRE, "agent");
                asm volatile("s_waitcnt vmcnt(0)" ::: "memory"); }
            __syncthreads();
            const bool dbl = (l == 0) && (G == 256) && (vcu < 16);
            const int ngl = 16 + ((l == 0) ? 1 : 0) + (((l == 0) && (G == 256)) ? 2 : 0);
#pragma clang loop vectorize(disable) unroll(disable)
            for (int gix = wave; gix < ngl; gix += 8) {
                int q;
                if (gix < 16) { if (dbl) continue; q = 16 * vcu + gix; }
                else if (gix == 16) q = T / 4 + vcu;
                else { if (dbl) continue; const int o = (gix == 17) ? (vcu - 16) : (240 + vcu - 16); if (o >= 256 || (gix == 18 && vcu >= 32)) continue; q = o; }
                if (gix >= 17) {
                    unsigned sp = 0; unsigned* w = g2rdy + 16 * (q >> 6);
                    while ((unsigned)__builtin_amdgcn_readfirstlane(__hip_atomic_load(w, RLX_AGENT)) < 32u) { __builtin_amdgcn_s_sleep(2); if (++sp > (1u << 22)) { if (lane == 0) __hip_atomic_store(ctl + CW_TMO, 6u, RLX_AGENT); break; } }
                    __builtin_amdgcn_fence(__ATOMIC_ACQUIRE, "agent");
                    asm volatile("s_waitcnt vmcnt(0)" ::: "memory"); }
                if (gix == 16) { unsigned sp = 0; unsigned* w = g2rdy + 16 * (64 + (vcu >> 6));
                    while ((unsigned)__builtin_amdgcn_readfirstlane(__hip_atomic_load(w, RLX_AGENT)) < 32u) { __builtin_amdgcn_s_sleep(2); if (++sp > (1u << 22)) { if (lane == 0) __hip_atomic_store(ctl + CW_TMO, 5u, RLX_AGENT); break; } }
                    __builtin_amdgcn_fence(__ATOMIC_ACQUIRE, "agent");
                    asm volatile("s_waitcnt vmcnt(0)" ::: "memory"); }
                const int rb4 = 4 * q; const bool isc = rb4 >= T; const int bsel = isc ? 4 : (rb4 >> 12);
                const bf16* src = xb + (size_t)rb4 * 1024;
                f32x4 v[4][4];
#pragma unroll
                for (int tk = 0; tk < 4; ++tk)
#pragma unroll
                    for (int j = 0; j < 4; ++j) { const v2u w = *(const v2u*)(src + (size_t)tk * 1024 + 4 * lane + 256 * j); v[tk][j] = (f32x4){bflo(w.x), bfhi(w.x), bflo(w.y), bfhi(w.y)}; }
                float rstd[4];
#pragma unroll
                for (int tk = 0; tk < 4; ++tk) { float ss = 0.f;
#pragma unroll
                    for (int j = 0; j < 4; ++j) ss += (v[tk][j][0] * v[tk][j][0] + v[tk][j][1] * v[tk][j][1]) + (v[tk][j][2] * v[tk][j][2] + v[tk][j][3] * v[tk][j][3]);
                    rstd[tk] = 1.0f / sqrtf(wave_sum(ss) * (1.f / 1024.f) + 1e-6f); }
                const float* sh = modl + bsel * 6144 + 3 * 1024; const float* sc = sh + 1024; const float* gn = norm2_g + l * 1024;
                f32x2 lg[4][2];
#pragma unroll
                for (int tk = 0; tk < 4; ++tk) { lg[tk][0] = (f32x2){0.f, 0.f}; lg[tk][1] = (f32x2){0.f, 0.f}; }
#pragma unroll
                for (int j = 0; j < 4; ++j) {
                    const int c0 = 4 * lane + 256 * j; const f32x4 g = *(const f32x4*)(gn + c0), s1 = *(const f32x4*)(sc + c0), h1 = *(const f32x4*)(sh + c0);
#pragma unroll
                    for (int tk = 0; tk < 4; ++tk) { const f32x4 y = (v[tk][j] * rstd[tk]) * g * (s1 + 1.0f) + h1; v[tk][j] = y;
                        *(unsigned*)((unsigned char*)hbuf + (size_t)(rb4 + tk) * 1024 + c0) = pk4_f8(y[0], y[1], y[2], y[3]); }
#pragma unroll
                    for (int e = 0; e < 4; ++e) { const f32x4 wv = *(const LAS f32x4*)(rw + ((j * 4 + e) * 64 + lane) * 4);
                        const f32x2 w01 = {wv[0], wv[1]}, w23 = {wv[2], wv[3]};
#pragma unroll
                        for (int tk = 0; tk < 4; ++tk) { const f32x2 ys = {v[tk][j][e], v[tk][j][e]}; lg[tk][0] = __builtin_elementwise_fma(ys, w01, lg[tk][0]); lg[tk][1] = __builtin_elementwise_fma(ys, w23, lg[tk][1]); } }
                }
#define L6_RED4(DST) _Pragma("unroll") for (int j = 0; j < 4; ++j) { \
                    const float a0 = swap32_sum(lg[0][j >> 1][j & 1], lg[2][j >> 1][j & 1]); const float a1 = swap32_sum(lg[1][j >> 1][j & 1], lg[3][j >> 1][j & 1]); \
                    float t = swap16_sum(a0, a1); t += dppf<0x128, 0xf>(t); t += dppf<0x124, 0xf>(t); t += dppf<0x122, 0xf>(t); t += dppf<0x121, 0xf>(t); DST[j] = t; }
                float l2[4];
                L6_RED4(l2)
                const int tk = lane >> 4; const int r = rb4 + tk;
                float gl[4]; float gm = -1e30f;
#pragma unroll
                for (int j = 0; j < 4; ++j) { gl[j] = l2[j] + b_grp[l * 4 + j]; gm = fmaxf(gm, gl[j]); }
                float gs = 0.f; int gi = 0; float gb = -1e30f;
#pragma unroll
                for (int j = 0; j < 4; ++j) { const float e = expf(gl[j] - gm); gs += e; if (gl[j] > gb) { gb = gl[j]; gi = j; } }
                const float pg = expf(gb - gm) / gs;
#pragma unroll
                for (int k = 0; k < 4; ++k) { lg[k][0] = (f32x2){0.f, 0.f}; lg[k][1] = (f32x2){0.f, 0.f}; }
#pragma unroll
                for (int k = 0; k < 4; ++k) {
                    const int gk = __builtin_amdgcn_readlane(gi, 16 * k);
                    const LAS float* rwk = rw + (size_t)(1 + gk) * (16 * 64 * 4);
#pragma unroll
                    for (int j = 0; j < 4; ++j)
#pragma unroll
                        for (int e = 0; e < 4; ++e) { const f32x4 wv = *(const LAS f32x4*)(rwk + ((j * 4 + e) * 64 + lane) * 4);
                            const f32x2 w01 = {wv[0], wv[1]}, w23 = {wv[2], wv[3]}; const f32x2 ys = {v[k][j][e], v[k][j][e]};
                            lg[k][0] = __builtin_elementwise_fma(ys, w01, lg[k][0]); lg[k][1] = __builtin_elementwise_fma(ys, w23, lg[k][1]); }
                }
                float l3[4];
                L6_RED4(l3)
#undef L6_RED4
                float el[4]; float em = -1e30f;
#pragma unroll
                for (int j = 0; j < 4; ++j) { el[j] = l3[j] + b_rtr[l * 16 + gi * 4 + j]; em = fmaxf(em, el[j]); }
                float pe[4];
#pragma unroll
                for (int j = 0; j < 4; ++j) pe[j] = expf(el[j] - em);
                int i0 = 0; float b0 = -1.f;
#pragma unroll
                for (int j = 0; j < 4; ++j) if (pe[j] > b0) { b0 = pe[j]; i0 = j; }
                int i1 = 0; float b1 = -1.f;
#pragma unroll
                for (int j = 0; j < 4; ++j) if (j != i0 && pe[j] > b1) { b1 = pe[j]; i1 = j; }
                const float wsum = b0 + b1; const float w0 = pg * b0 / wsum, w1 = pg * b1 / wsum;
                if ((lane & 15) == 0 && rep_ == 0) {
                    wts[2 * r] = w0; wts[2 * r + 1] = w1;
                    const int e0 = gi * 4 + i0, e1 = gi * 4 + i1;
                    const int s0 = __hip_atomic_fetch_add((LAS int*)(lcnt + 16 + 16), 1, __ATOMIC_RELAXED, __HIP_MEMORY_SCOPE_WORKGROUP);
                    const int k0 = __hip_atomic_fetch_add((LAS int*)(lcnt + e0), 1, __ATOMIC_RELAXED, __HIP_MEMORY_SCOPE_WORKGROUP);
                    const int k1 = __hip_atomic_fetch_add((LAS int*)(lcnt + e1), 1, __ATOMIC_RELAXED, __HIP_MEMORY_SCOPE_WORKGROUP);
                    lent[2 * s0] = ((unsigned)(2 * r) << 4) | (unsigned)e0; lrank[2 * s0] = (unsigned)k0;
                    lent[2 * s0 + 1] = ((unsigned)(2 * r + 1) << 4) | (unsigned)e1; lrank[2 * s0 + 1] = (unsigned)k1;
                }
            }
            __syncthreads();
            if (tid < 16 && rep_ == 0) { const int c = lcnt[tid]; lcnt[16 + tid] = c ? (int)__hip_atomic_fetch_add((unsigned*)(ctl + CW_CNT + (l * 16 + tid) * 64), (unsigned)c, RLX_AGENT) : 0; }
            __syncthreads();
            const int ntot = rep_ == 0 ? 2 * lcnt[32] : 0;
            for (int i = tid; i < ntot; i += 512) { const unsigned en = lent[i]; const int e = en & 15; list[(size_t)e * TT + lcnt[16 + e] + lrank[i]] = en >> 4; }
            __syncthreads();
            if (l == 0 && !MK_SPLIT) steal_convert(KA, lds, G, 1, false);
        }
        SEAM(P + 5);
        if (IN(P + 6) || IN(P + 7)) {
            KA_DECL
            __syncthreads();
            if (tid < 16) ttab[17 + tid] = (int)__hip_atomic_load((unsigned*)(ctl + CW_CNT + (l * 16 + tid) * 64), RLX_AGENT);
            __syncthreads();
            if (tid == 0) { int acc_ = 0; for (int e = 0; e < 16; ++e) { const int c = ttab[17 + e]; ttab[e] = acc_; acc_ += (c + 255) >> 8; } ttab[16] = acc_; }
            __syncthreads();
        }
        if (DBG_NAIVE_MOE && IN(P + 6)) {
            KA_DECL
            const int nrows = (l == 0) ? TT : T; LAS float* hs = (LAS float*)lds; LAS float* as = hs + 1024;
            const int* eidg = (const int*)(ws + O_EID);
            LAS float* lgs = as + 512; LAS float* rt = lgs + 32;
            for (int r = vcu; r < nrows; r += G) {
                __syncthreads();
                for (int i = tid; i < 1024; i += 512) hs[i] = bf2f(hbuf[(size_t)r * 1024 + i]);
                __syncthreads();
                if (tid < 20) { float a = 0.f; for (int k = 0; k < 1024; ++k) a += hs[k] * ((tid < 4) ? w_grp[(size_t)l * 4096 + k * 4 + tid] : w_rtr[(size_t)l * 16384 + k * 16 + (tid - 4)]);
                    lgs[tid] = a + ((tid < 4) ? b_grp[l * 4 + tid] : b_rtr[l * 16 + tid - 4]); }
                __syncthreads();
                if (tid == 0) { int gi = 0; for (int j = 1; j < 4; ++j) if (lgs[j] > lgs[gi]) gi = j; float gs = 0.f; for (int j = 0; j < 4; ++j) gs += expf(lgs[j] - lgs[gi]); const float pg = 1.f / gs;
                    int i0 = 0; for (int j = 1; j < 4; ++j) if (lgs[4 + gi * 4 + j] > lgs[4 + gi * 4 + i0]) i0 = j; int i1 = -1; for (int j = 0; j < 4; ++j) if (j != i0 && (i1 < 0 || lgs[4 + gi * 4 + j] > lgs[4 + gi * 4 + i1])) i1 = j;
                    const float p0 = 1.f, p1 = expf(lgs[4 + gi * 4 + i1] - lgs[4 + gi * 4 + i0]); rt[0] = (float)(gi * 4 + i0); rt[1] = (float)(gi * 4 + i1); rt[2] = pg * p0 / (p0 + p1); rt[3] = pg * p1 / (p0 + p1); }
                __syncthreads();
                for (int sl = 0; sl < 2; ++sl) {
                    const int e = (DBG_NAIVE_ROUTE & 1) ? (int)rt[sl] : eidg[2 * r + sl]; const float w = (DBG_NAIVE_ROUTE & 2) ? rt[2 + sl] : wts[2 * r + sl];
                    __syncthreads();
                    const float* Wg = w_gate + (size_t)(l * 16 + e) * 1024 * 512 + tid; const float* Wu = w_up + (size_t)(l * 16 + e) * 1024 * 512 + tid;
                    float g = 0.f, u = 0.f;
#pragma unroll 8
                    for (int k = 0; k < 1024; ++k) { g += hs[k] * Wg[(size_t)k * 512]; u += hs[k] * Wu[(size_t)k * 512]; }
                    as[tid] = g / (1.f + expf(-g)) * u;
                    __syncthreads();
                    const float* Wd = w_down + (size_t)(l * 16 + e) * 512 * 1024 + tid;
                    float y0 = 0.f, y1 = 0.f;
#pragma unroll 8
                    for (int j = 0; j < 512; ++j) { y0 += as[j] * Wd[(size_t)j * 1024]; y1 += as[j] * Wd[(size_t)j * 1024 + 512]; }
                    y2[(size_t)(2 * r + sl) * 1024 + tid] = (bf16)f2bf(y0 * w); y2[(size_t)(2 * r + sl) * 1024 + 512 + tid] = (bf16)f2bf(y1 * w);
                }
            }
        }
        if (!DBG_NAIVE_MOE && IN(P + 6)) {
            KA_DECL
            unsigned* rdy = (unsigned*)(ctl + CW_RDY + l * 4096);
            SchedMoe S{G, vcu, ttab[16], (const char*)hbuf, (const char*)act, (const char*)wgu_t, (const char*)wd_t, list, ttab, rdy, (unsigned*)(ctl + CW_TMO)};
            EpiMoe E{EpiG3{act, rdy}, EpiG4{(unsigned char*)y2, list, wts, ttab}};
            pg8::gemm_phase<EpiMoe, SchedMoe, true>(lds, S, E);
            if (l == 0 && !MK_SPLIT) steal_convert(KA, lds, G, 2, false);
        }
        SEAM(P + 7);
    }

__global__ void __launch_bounds__(512, 2) fwd_kernel(Args args) {
    extern __shared__ __attribute__((aligned(16))) unsigned char lds_raw[];
    LAS unsigned char* lds = (LAS unsigned char*)lds_raw;
    const int tid = threadIdx.x, lane = tid & 63, wave = __builtin_amdgcn_readfirstlane(tid >> 6);
    const int G = gridDim.x; const int bx = blockIdx.x; const int vcu = (G % 8 == 0) ? (bx % 8) * (G / 8) + bx / 8 : bx;
    volatile LAS unsigned* MISC = (volatile LAS unsigned*)(lds + MISC_OFF);
    LAS float* trig = (LAS float*)(lds + TRIG_OFF);
    LAS int* ttab = (LAS int*)(lds + TILE_OFF);
    for (int u = tid; u < (LDS_BYTES - LDSCTL_OFF) / 4; u += 512) ((LAS unsigned*)(lds + LDSCTL_OFF))[u] = 0u;
    __syncthreads();
    if (tid < 64) { float s, c; sincospif((float)tid / 32.f, &s, &c); trig[tid] = c; trig[64 + tid] = s; }
    __syncthreads();
    XcdBarrier bar; bar.bar = nullptr; bar.x = 0; bar.st = nullptr;
    if (!MK_SPLIT) { KA_DECL bar = xcd_barrier_post((unsigned*)(ctl + CW_BAR), MISC + 8); }
    const int lo = args.ph_lo, hi = args.ph_hi;
    const int NGW = G * 8, NGT = G * 512;

    for (int rep_ = 0; rep_ < 1 + ((REP_MASK >> 0) & 1); ++rep_)
    if (IN(0)) {
        KA_DECL
        __syncthreads();
        if (rep_ == 0 || ((REP_MASK >> 13) & 1)) {
            LAS float* sl = (LAS float*)lds;
            bool have = false;
            for (int it = vcu; it < 192; it += G) {
                if (!have) {
                    for (int i = tid; i < 5120; i += 512) { const int r = i >> 10, k = i & 1023; const float v = (r < 4) ? c_in[r * 1024 + k] : cctx_in[k]; sl[i] = v / (1.f + expf(-v)); }
                    __syncthreads(); have = true;
                }
                const int l = it / 96, cb = it % 96;
                const int r4 = lane >> 4, cq = lane & 15; const int k0 = wave * 128;
                const float* W = w_mod + (size_t)l * 1024 * 6144 + (size_t)(k0 + r4) * 6144 + cb * 64 + 4 * cq;
                f32x4 a0 = {0.f, 0.f, 0.f, 0.f}, a1 = a0, a2 = a0, a3 = a0, a4 = a0;
#pragma unroll 8
                for (int k = 0; k < 32; ++k) { const f32x4 wv = *(const f32x4*)(W + (size_t)(4 * k) * 6144); const int kk = k0 + 4 * k + r4;
                    a0 += wv * sl[kk]; a1 += wv * sl[1024 + kk]; a2 += wv * sl[2048 + kk]; a3 += wv * sl[3072 + kk]; a4 += wv * sl[4096 + kk]; }
                LAS float* part = sl + 5120;
                { LAS float* pp = part + (wave * 4 + r4) * 320 + 4 * cq;
                  *(LAS f32x4*)(pp) = a0; *(LAS f32x4*)(pp + 64) = a1; *(LAS f32x4*)(pp + 128) = a2; *(LAS f32x4*)(pp + 192) = a3; *(LAS f32x4*)(pp + 256) = a4; }
                __syncthreads();
                if (tid < 320) { const int r = tid >> 6, n = tid & 63; float sacc = b_mod[l * 6144 + cb * 64 + n];
#pragma unroll 8
                    for (int w = 0; w < 32; ++w) sacc += part[w * 320 + r * 64 + n];
                    modv[(size_t)(l * 5 + r) * 6144 + cb * 64 + n] = sacc; }
                __syncthreads();
            }
            __syncthreads();
        }
        if (rep_ == 0 || ((REP_MASK >> 14) & 1)) {
#pragma clang loop vectorize(disable) unroll(disable)
        for (int i = gt; i < 4096 * 32; i += NGT) {
            const int n = i >> 5, j = i & 31; const int jj = j & 15;
            const float inv = 1.0f / powf(10000.0f, (float)(2 * jj) / 32.0f);
            const float pos = (j < 16) ? (float)(n >> 6) : (float)(n & 63);
            const float ang = pos * inv; rope[i] = make_float2(cosf(ang), sinf(ang));
        }
#pragma clang loop vectorize(disable) unroll(disable)
        for (int i = gt; i < 4096; i += NGT) { float s, c; sincospif((float)i / 2048.f, &s, &c); twt[i] = make_float2(c, s); }
#pragma clang loop vectorize(disable) unroll(disable)
        for (int i = gt; i < 128 * 128; i += NGT) {
            const int m = i >> 7, k = i & 127; const int ri = m >> 6, k1 = m & 63, part = k >> 6, n1 = k & 63;
            float s, c; sincospif((float)((n1 * k1) & 63) / 32.f, &s, &c);
            float v; if (ri == 0) v = (part == 0) ? c : -s; else v = (part == 0) ? -s : -c;
            fma[i] = (bf16)f2bf(v);
        }
#pragma clang loop vectorize(disable) unroll(disable)
        for (int i = gt; i < 64 * 128; i += NGT) {
            const int k2 = i >> 7, k = i & 127; const int ri = k >> 6, n2 = k & 63;
            float s, c; sincospif((float)((n2 * k2) & 63) / 32.f, &s, &c);
            fmb[i] = (bf16)f2bf((ri == 0 ? c : s) * (1.f / 512.f));
        }
#pragma clang loop vectorize(disable) unroll(disable)
        for (int i = gt; i < 256 * 512; i += NGT) {
            const int kk = i >> 9, k = i & 511; const int part = k >> 8, n = k & 255;
            float s, c; sincospif((float)((n * kk) & 255) / 128.f, &s, &c);
            fmc[i] = (bf16)f2bf((part == 0 ? c : -s) * (1.f / 128.f));
        }
#pragma clang loop vectorize(disable) unroll(disable)
        for (int i = gt; i < 2 * 20480; i += NGT) {
            const int lw = i / 20480, r = i % 20480; const int d = r / 20, j = r % 20;
            ((float*)(ws + O_RW))[lw * 20480 + ((((j >> 2) * 4 + (d >> 8)) * 4 + (d & 3)) * 64 + ((d & 255) >> 2)) * 4 + (j & 3)] = (j < 4) ? w_grp[(size_t)lw * 4096 + d * 4 + j] : w_rtr[(size_t)lw * 16384 + d * 16 + (j - 4)];
        }
        }
        if (rep_ == 0 || ((REP_MASK >> 15) & 1)) {
            LAS float* Al = (LAS float*)lds;
            LAS float* Wl = Al + 4096;
            LAS float* Xl = Wl + 4096;
            for (int it = vcu; it < 256; it += G) {
                const int combo = it & 15, jb = it >> 4; const int l = combo >> 3, g = (combo >> 1) & 3, which = combo & 1;
                const float* Wg = four_w + (size_t)(l * 4 + g) * 4096; const LAS float* tb = trig + which * 64;
                const float* wi = w_in + (size_t)l * 1024 * 1280 + (size_t)(jb * 64) * 1280 + 1024 + g * 64;
                __syncthreads();
#pragma unroll
                for (int i = 0; i < 2; ++i) { const int idx = tid + 512 * i; *(LAS f32x4*)(Wl + 4 * idx) = *(const f32x4*)(Wg + 4 * idx); const int j = idx >> 4, c4 = idx & 15;
                    const f32x4 xv = *(const f32x4*)(wi + (size_t)j * 1280 + 4 * c4);
                    Xl[(4 * c4) * 68 + j] = xv[0]; Xl[(4 * c4 + 1) * 68 + j] = xv[1]; Xl[(4 * c4 + 2) * 68 + j] = xv[2]; Xl[(4 * c4 + 3) * 68 + j] = xv[3]; }
                __syncthreads();
                { const int d4 = tid & 15, c = tid >> 4;
                  f32x4 a0 = {0.f, 0.f, 0.f, 0.f}, a1 = a0;
#pragma unroll 8
                  for (int m = 0; m < 64; ++m) { const f32x4 wv = *(const LAS f32x4*)(Wl + m * 64 + 4 * d4); a0 += wv * tb[(m * c) & 63]; a1 += wv * tb[(m * (c + 32)) & 63]; }
                  *(LAS f32x4*)(Al + c * 64 + 4 * d4) = a0; *(LAS f32x4*)(Al + (c + 32) * 64 + 4 * d4) = a1; }
                __syncthreads();
                { const int d = tid & 63, jl = 8 * (tid >> 6);
                  f32x4 o0 = {0.f, 0.f, 0.f, 0.f}, o1 = o0;
#pragma unroll 8
                  for (int c = 0; c < 64; ++c) { const float av = Al[c * 64 + d]; o0 += *(const LAS f32x4*)(Xl + c * 68 + jl) * av; o1 += *(const LAS f32x4*)(Xl + c * 68 + jl + 4) * av; }
                  v2u w; w.x = pk4_f8(o0[0] * 64.f, o0[1] * 64.f, o0[2] * 64.f, o0[3] * 64.f); w.y = pk4_f8(o1[0] * 64.f, o1[1] * 64.f, o1[2] * 64.f, o1[3] * 64.f);
                  *(v2u*)((unsigned char*)(ws + O_WIN8 + l * SZ_WIN8) + (size_t)(768 + which * 256 + g * 64 + d) * 1024 + jb * 64 + jl) = w; }
            }
            for (int it = vcu; it < 256; it += G) {
                const int combo = it & 7, nb = it >> 3; const int l = combo >> 2, g = combo & 3, n0 = nb * 32;
                const float* pwg = pool_w + (size_t)(l * 4 + g) * 4096;
                __syncthreads();
#pragma unroll
                for (int i = 0; i < 2; ++i) { const int idx = tid + 512 * i; *(LAS f32x4*)(Wl + 4 * idx) = *(const f32x4*)(pwg + 4 * idx); }
                { const int d = tid >> 3, n4 = tid & 7; const float ps = pool_scale[l * 256 + g * 64 + d];
                  *(LAS f32x4*)(Xl + d * 32 + 4 * n4) = *(const f32x4*)(w_out + (size_t)l * 1024 * 1024 + (size_t)(g * 64 + d) * 1024 + n0 + 4 * n4) * ps; }
                __syncthreads();
                { const int n = tid & 31, c0 = 4 * (tid >> 5);
                  float o[4] = {0.f, 0.f, 0.f, 0.f};
#pragma unroll 4
                  for (int d = 0; d < 64; d += 4) { const float s0 = Xl[d * 32 + n], s1 = Xl[(d + 1) * 32 + n], s2 = Xl[(d + 2) * 32 + n], s3 = Xl[(d + 3) * 32 + n];
#pragma unroll
                      for (int i = 0; i < 4; ++i) { const f32x4 wv = *(const LAS f32x4*)(Wl + (c0 + i) * 64 + d); o[i] += (wv[0] * s0 + wv[1] * s1) + (wv[2] * s2 + wv[3] * s3); } }
                  v2u w; w.x = pk2(o[0], o[1]); w.y = pk2(o[2], o[3]);
                  *(v2u*)((bf16*)(ws + O_WOUT + l * SZ_WOUT1) + (size_t)(n0 + n) * 1024 + g * 64 + c0) = w; }
            }
            __syncthreads();
        }
        if (rep_ == 0 || ((REP_MASK >> 16) & 1)) {
            LAS bf16* scr = (LAS bf16*)(lds + wave * 16384);
#pragma clang loop vectorize(disable) unroll(disable)
            for (int it0 = gw; it0 < CV_L; it0 += NGW) conv_item(KA, 0, it0, scr, lane);
        }
    }
    SEAM(0);
    if ((REP_MASK >> 12) & 1) { for (int k_ = 0; k_ < 4; ++k_) xcd_barrier(bar); }

    layer_body<0>(lds, G, vcu, bar, lo, hi);
    layer_body<1>(lds, G, vcu, bar, lo, hi);
    if (IN(17)) {
        KA_DECL
        const float* modp = modv + (size_t)5 * 6144;
#pragma clang loop vectorize(disable) unroll(disable)
        for (int r = gw; r < T; r += NGW) {
            const float* g2 = modp + (r >> 12) * 6144 + 5 * 1024; float* dst = outp + (size_t)r * 1024;
#pragma unroll
            for (int j = 0; j < 4; ++j) {
                const int c0 = 4 * lane + 256 * j; const v2u xw = *(const v2u*)(xb + (size_t)r * 1024 + c0); const f32x4 v = {bflo(xw.x), bfhi(xw.x), bflo(xw.y), bfhi(xw.y)};
                const unsigned ya = *(const unsigned*)((const unsigned char*)y2 + (size_t)(2 * r) * 1024 + c0), yb = *(const unsigned*)((const unsigned char*)y2 + (size_t)(2 * r + 1) * 1024 + c0);
                const f32x4 gv = *(const f32x4*)(g2 + c0);
                f32x4 yy = (f8x4_f32(ya) + f8x4_f32(yb)) * (1.0f / Y2SC);
                if (DBG_NO_MOE) yy = (f32x4){0.f, 0.f, 0.f, 0.f};
                *(f32x4*)(dst + c0) = v + gv * yy;
            }
        }
    }
#undef IN
#undef SEAM
}

#undef KA_DECL
#undef ws
#undef ctl
#undef x_in
#undef c_in
#undef ctx_in
#undef cctx_in
#undef w_mod
#undef b_mod
#undef norm1_g
#undef w_in
#undef q_norm_g
#undef k_norm_g
#undef attn_sink
#undef pool_w
#undef pool_scale
#undef four_w
#undef w_out
#undef norm2_g
#undef w_grp
#undef b_grp
#undef w_rtr
#undef b_rtr
#undef w_gate
#undef w_up
#undef w_down
#undef outp
#undef modv
#undef rope
#undef twt
#undef fma
#undef fmb
#undef fmc
#undef hbuf
#undef kall
#undef vall
#undef xc
#undef xb
#undef list
#undef wts
#undef act
#undef t2
#undef mrg
#undef qb
#undef pu
#undef zb
#undef y2
#undef modl
#undef win_t
#undef wout_t
#undef wgu_t
#undef wd_t
extern "C" void kernel_launch(void* const* d_in, const int* in_sizes, int n_in, void* d_out, int out_size, void* d_ws, size_t ws_size, hipStream_t stream) {
    static int grid = 0;
    if (grid == 0) {
        if (n_in != 23 || out_size != T * DM || ws_size < WS_END) { fprintf(stderr, "kernel_launch: unexpected shapes (n_in %d out %d ws %zu need %zu)\n", n_in, out_size, ws_size, (size_t)WS_END); grid = -1; return; }
        int dev = 0, cus = 0;
        if (hipGetDevice(&dev) != hipSuccess || hipDeviceGetAttribute(&cus, hipDeviceAttributeMultiprocessorCount, dev) != hipSuccess) { grid = -1; return; }
        if (cus != 256) { fprintf(stderr, "kernel_launch: built for a 256-CU device (row-tile hand-offs are laid out for 256 workgroups); found %d CUs; nothing launched\n", cus); grid = -1; return; }
        if (hipFuncSetAttribute((const void*)fwd_kernel, hipFuncAttributeMaxDynamicSharedMemorySize, LDS_BYTES) != hipSuccess) { fprintf(stderr, "kernel_launch: hipFuncSetAttribute failed\n"); grid = -1; return; }
        (void)hipGetLastError();
        grid = cus;
    }
    if (grid < 0) return;
    (void)hipMemsetAsync((char*)d_ws + O_CTL, 0, SZ_CTL, stream);
    Args a{};
    for (int i = 0; i < 23; ++i) a.in[i] = (const float*)d_in[i];
    a.out = (float*)d_out; a.ws = (unsigned char*)d_ws;
#if MK_SPLIT
    for (int p = 0; p < NPHASE; ++p) { a.ph_lo = p; a.ph_hi = p + 1; hipLaunchKernelGGL(fwd_kernel, dim3(grid), dim3(512), LDS_BYTES, stream, a); }
#else
    a.ph_lo = 0; a.ph_hi = NPHASE;
    hipLaunchKernelGGL(fwd_kernel, dim3(grid), dim3(512), LDS_BYTES, stream, a);
#endif
}
```
